# Optimizing an MI355X kernel written in HIP

```python
import math
import jax, jax.numpy as jnp
from jax import lax
import numpy as np

D_MODEL = 1024
BATCH = 16
SEQ = 2048
DEPTH = 2

CHUNK = 64
Q_BLOCK = 128
EPS = 1e-6

A_HEADS = 8
A_HEAD_DIM = 64
A_LATENT = 128
IDX_HEADS = 8
IDX_DIM = 64
TOPK_MAX = 256
REL_BUCKETS = 32
REL_MAX_DIST = 128
B_HEADS = 4
B_DK = 128
B_DV = 128
GM_CHUNK = 128
GM_WIDTH = D_MODEL
GM_GROUPS = 8
MEM_TOKENS = 256
X_HEADS = 4
X_HEAD_DIM = 128
FF_DIM = ((8 * D_MODEL // 3 + 255) // 256) * 256

kernel_name = 'hybrid_dsa_hgrn2_gmlp_stream_encoder'


def rmsnorm(x, g):
    xf = x.astype(jnp.float32)
    xf = xf * lax.rsqrt(jnp.mean(xf * xf, axis=-1, keepdims=True) + EPS)
    return xf.astype(x.dtype) * g


def layernorm(x, g, b):
    xf = x.astype(jnp.float32)
    mu = jnp.mean(xf, axis=-1, keepdims=True)
    var = jnp.mean(jnp.square(xf - mu), axis=-1, keepdims=True)
    return ((xf - mu) * lax.rsqrt(var + EPS)).astype(x.dtype) * g + b


def t5_bucket(rel):
    nb = REL_BUCKETS // 2
    max_exact = nb // 2
    ret = (rel > 0).astype(jnp.int32) * nb
    n = jnp.abs(rel)
    nf = jnp.maximum(n, 1).astype(jnp.float32)
    large = max_exact + (jnp.log(nf / max_exact) / math.log(REL_MAX_DIST / max_exact) * (nb - max_exact)).astype(jnp.int32)
    large = jnp.minimum(large, nb - 1)
    return ret + jnp.where(n < max_exact, n, large)


def dsa_sparse_attention(q_lat, c, qi, ki, wi, w_uv, rel_bias, topk):
    B, S, H, _ = q_lat.shape
    nblk = S // Q_BLOCK

    def blocks(a):
        return jnp.moveaxis(a.reshape((B, nblk, Q_BLOCK) + a.shape[2:]), 1, 0)

    ki32 = ki.astype(jnp.float32)
    kchunk = jnp.arange(S, dtype=jnp.int32) // CHUNK

    def one_block(args):
        ql, qib, wib, blk = args
        qpos = blk * Q_BLOCK + jnp.arange(Q_BLOCK, dtype=jnp.int32)
        qchunk = qpos // CHUNK
        admissible = kchunk[None, :] <= qchunk[:, None]
        dots = jnp.einsum('bthd,bsd->bths', qib.astype(jnp.float32), ki32) * (IDX_DIM ** -0.5)
        score = jnp.einsum('bth,bths->bts', wib.astype(jnp.float32), jax.nn.relu(dots))
        score = jnp.where(admissible[None], score, -jnp.inf)
        _, idx = lax.top_k(score, topk)
        sel = jax.vmap(lambda cb, ib: cb[ib])(c, idx)
        valid = (idx // CHUNK) <= qchunk[None, :, None]
        bias = rel_bias[t5_bucket(idx - qpos[None, :, None])]
        logits = jnp.einsum('bthc,btkc->bthk', ql, sel).astype(jnp.float32) * (A_HEAD_DIM ** -0.5)
        logits = logits + jnp.moveaxis(bias, -1, 2).astype(jnp.float32)
        logits = jnp.where(valid[:, :, None, :], logits, -jnp.inf)
        p = jax.nn.softmax(logits, axis=-1).astype(sel.dtype)
        o_lat = jnp.einsum('bthk,btkc->bthc', p, sel)
        return jnp.einsum('bthc,hcd->bthd', o_lat, w_uv).reshape(B, Q_BLOCK, H * A_HEAD_DIM)

    out = lax.map(one_block, (blocks(q_lat), blocks(qi), blocks(wi), jnp.arange(nblk, dtype=jnp.int32)))
    return jnp.moveaxis(out, 0, 1).reshape(B, S, H * A_HEAD_DIM)


def hgrn2_recurrence(q, f_logit, v, lb):
    B, S, H, DK = q.shape
    DV = v.shape[-1]
    f32 = jnp.float32
    f = lb + (1.0 - lb) * jax.nn.sigmoid(f_logit.astype(f32))
    g = jnp.log(f)
    k = 1.0 - f
    qf = jax.nn.silu(q.astype(f32))

    def to_chunks(a):
        return a.reshape(B, S // CHUNK, CHUNK, H, a.shape[-1]).transpose(1, 0, 3, 2, 4)

    tri = jnp.tril(jnp.ones((CHUNK, CHUNK), dtype=bool))

    def step(state, xs):
        qc, kc, gc, vc = xs
        b = jnp.cumsum(gc, axis=2)
        dec = jnp.where(tri[:, :, None], b[:, :, :, None, :] - b[:, :, None, :, :], -jnp.inf)
        scores = jnp.einsum('bhtd,bhsd,bhtsd->bhts', qc, kc, jnp.exp(dec))
        o = jnp.einsum('bhts,bhsv->bhtv', scores, vc) + jnp.einsum('bhtd,bhdv->bhtv', qc * jnp.exp(b), state)
        b_end = b[:, :, -1:, :]
        state = jnp.exp(b_end[:, :, 0, :])[..., None] * state + jnp.einsum('bhsd,bhsv->bhdv', kc * jnp.exp(b_end - b), vc)
        return state, o

    state0 = jnp.zeros((B, H, DK, DV), f32)
    _, o = lax.scan(step, state0, (to_chunks(qf), to_chunks(k), to_chunks(g), to_chunks(v.astype(f32))))
    return o.transpose(1, 0, 3, 2, 4).reshape(B, S, H, DV).astype(v.dtype)


def even_mixer(h, w_in, lat_g, w_uk, w_uv, o_g, w_out, rel_bias, lb, topk):
    B, S, _ = h.shape
    sizes = [A_HEADS * A_HEAD_DIM, A_LATENT, IDX_HEADS * IDX_DIM, IDX_DIM, IDX_HEADS,
             B_HEADS * B_DK, B_HEADS * B_DV, B_HEADS * B_DK, B_HEADS * B_DV]
    offsets = np.cumsum(sizes)[:-1].tolist()
    q_a, c, qi, ki, wi, f_b, i_b, q_b, g_b = jnp.split(h @ w_in, offsets, axis=-1)
    c = rmsnorm(c, lat_g)
    q_lat = jnp.einsum('bshd,hcd->bshc', q_a.reshape(B, S, A_HEADS, A_HEAD_DIM), w_uk)
    a_out = dsa_sparse_attention(q_lat, c, qi.reshape(B, S, IDX_HEADS, IDX_DIM), ki,
                                 wi * (IDX_HEADS ** -0.5), w_uv, rel_bias, topk)
    o = hgrn2_recurrence(q_b.reshape(B, S, B_HEADS, B_DK), f_b.reshape(B, S, B_HEADS, B_DK),
                         i_b.reshape(B, S, B_HEADS, B_DV), lb.reshape(B_HEADS, B_DK))
    b_out = (rmsnorm(o, o_g) * jax.nn.silu(g_b.reshape(B, S, B_HEADS, B_DV))).reshape(B, S, B_HEADS * B_DV)
    return jnp.concatenate([a_out, b_out], axis=-1) @ w_out


def gmlp_spatial_mixer(h, w_in, ln_g, ln_b, w_sp, b_sp, w_out):
    B, S, _ = h.shape
    u, v = jnp.split(jax.nn.gelu(h @ w_in, approximate=False), 2, axis=-1)
    v = layernorm(v, ln_g, ln_b)
    v = v.reshape(B, S // GM_CHUNK, GM_CHUNK, GM_GROUPS, GM_WIDTH // GM_GROUPS)
    w = jnp.where(jnp.tril(jnp.ones((GM_CHUNK, GM_CHUNK), dtype=bool)), w_sp, 0.0)
    mixed = jnp.einsum('gts,bnsgc->bntgc', w, v) + jnp.transpose(b_sp)[None, None, :, :, None]
    return (u * mixed.reshape(B, S, GM_WIDTH)) @ w_out


def memory_cross_attention(h, m, wq, wkv, wo):
    B, S, _ = h.shape
    M = m.shape[1]
    q = (h @ wq).reshape(B, S, X_HEADS, X_HEAD_DIM)
    k, v = jnp.split(m @ wkv, 2, axis=-1)
    k = k.reshape(B, M, X_HEADS, X_HEAD_DIM)
    v = v.reshape(B, M, X_HEADS, X_HEAD_DIM)
    logits = jnp.einsum('bshd,bmhd->bhsm', q, k).astype(jnp.float32) * (X_HEAD_DIM ** -0.5)
    p = jax.nn.softmax(logits, axis=-1).astype(v.dtype)
    return jnp.einsum('bhsm,bmhd->bshd', p, v).reshape(B, S, X_HEADS * X_HEAD_DIM) @ wo


def swiglu(h, w_gu, w_down):
    gate, up = jnp.split(h @ w_gu, 2, axis=-1)
    return (jax.nn.silu(gate) * up) @ w_down


def setup_inputs(seed: int = 0) -> dict:
    key = jax.random.key(seed)
    ks = list(jax.random.split(key, 40))
    cnt = [0]

    def nxt():
        k = ks[cnt[0]]
        cnt[0] += 1
        return k

    def nrm(shape, scale):
        return jax.random.normal(nxt(), shape, jnp.float32) * scale

    def gain(shape):
        return 1.0 + nrm(shape, 0.05)

    n_even = (DEPTH + 1) // 2
    n_odd = DEPTH // 2
    p_even = (A_HEADS * A_HEAD_DIM + A_LATENT + IDX_HEADS * IDX_DIM + IDX_DIM + IDX_HEADS
              + 2 * B_HEADS * B_DK + 2 * B_HEADS * B_DV)
    mix_even = A_HEADS * A_HEAD_DIM + B_HEADS * B_DV
    xw = X_HEADS * X_HEAD_DIM
    return {
        'x': nrm((BATCH, SEQ, D_MODEL), 1.0),
        'mem': nrm((BATCH, MEM_TOKENS, D_MODEL), 1.0),
        'rel_bias': nrm((REL_BUCKETS, A_HEADS), 0.5),
        'hgrn_lb': nrm((DEPTH + 1, B_HEADS * B_DK), 0.5),
        'mix_norm': gain((DEPTH, D_MODEL)),
        'e_w_in': nrm((n_even, D_MODEL, p_even), D_MODEL ** -0.5),
        'e_lat_norm': gain((n_even, A_LATENT)),
        'e_w_uk': nrm((n_even, A_HEADS, A_LATENT, A_HEAD_DIM), A_HEAD_DIM ** -0.5),
        'e_w_uv': nrm((n_even, A_HEADS, A_LATENT, A_HEAD_DIM), A_LATENT ** -0.5),
        'e_o_norm': gain((n_even, B_DV)),
        'e_w_out': nrm((n_even, mix_even, D_MODEL), mix_even ** -0.5),
        'o_w_in': nrm((n_odd, D_MODEL, 2 * GM_WIDTH), D_MODEL ** -0.5),
        'o_ln_g': gain((n_odd, GM_WIDTH)),
        'o_ln_b': nrm((n_odd, GM_WIDTH), 0.02),
        'o_w_sp': nrm((n_odd, GM_GROUPS, GM_CHUNK, GM_CHUNK), 0.5 * GM_CHUNK ** -0.5),
        'o_b_sp': 1.0 + nrm((n_odd, GM_GROUPS, GM_CHUNK), 0.1),
        'o_w_out': nrm((n_odd, GM_WIDTH, D_MODEL), GM_WIDTH ** -0.5),
        'x_norm': gain((DEPTH, D_MODEL)),
        'mem_norm': gain((DEPTH, D_MODEL)),
        'x_wq': nrm((DEPTH, D_MODEL, xw), D_MODEL ** -0.5),
        'x_wkv': nrm((DEPTH, D_MODEL, 2 * xw), D_MODEL ** -0.5),
        'x_wo': nrm((DEPTH, xw, D_MODEL), xw ** -0.5),
        'f_norm': gain((DEPTH, D_MODEL)),
        'f_w_gu': nrm((DEPTH, D_MODEL, 2 * FF_DIM), D_MODEL ** -0.5),
        'f_w_down': nrm((DEPTH, FF_DIM, D_MODEL), FF_DIM ** -0.5),
        'final_norm': gain((D_MODEL,)),
    }


def reference(x, mem, rel_bias, hgrn_lb, mix_norm, e_w_in, e_lat_norm, e_w_uk, e_w_uv, e_o_norm, e_w_out,
              o_w_in, o_ln_g, o_ln_b, o_w_sp, o_b_sp, o_w_out, x_norm, mem_norm, x_wq, x_wkv, x_wo,
              f_norm, f_w_gu, f_w_down, final_norm):
    topk = min(TOPK_MAX, x.shape[1] // 4)
    lb_all = jnp.cumsum(jax.nn.softmax(hgrn_lb.astype(jnp.float32), axis=0), axis=0)
    h = x
    for l in range(DEPTH):
        j = l // 2
        hn = rmsnorm(h, mix_norm[l])
        if l % 2 == 0:
            h = h + even_mixer(hn, e_w_in[j], e_lat_norm[j], e_w_uk[j], e_w_uv[j], e_o_norm[j], e_w_out[j],
                               rel_bias, lb_all[l], topk)
        else:
            h = h + gmlp_spatial_mixer(hn, o_w_in[j], o_ln_g[j], o_ln_b[j], o_w_sp[j], o_b_sp[j], o_w_out[j])
        h = h + memory_cross_attention(rmsnorm(h, x_norm[l]), rmsnorm(mem, mem_norm[l]), x_wq[l], x_wkv[l], x_wo[l])
        h = h + swiglu(rmsnorm(h, f_norm[l]), f_w_gu[l], f_w_down[l])
    return rmsnorm(h, final_norm)
```

```cpp
#include <hip/hip_runtime.h>
#include <hip/hip_cooperative_groups.h>
#include <stdint.h>
#include <stdio.h>
namespace cg = cooperative_groups;

#ifndef MEGA
#define MEGA 0
#endif

#define LAS __attribute__((address_space(3)))
typedef unsigned short bf16_t;
typedef short bf16x8 __attribute__((ext_vector_type(8)));
typedef float f32x4 __attribute__((ext_vector_type(4)));
typedef float f32x2 __attribute__((ext_vector_type(2)));
typedef unsigned u32x4 __attribute__((ext_vector_type(4)));
typedef unsigned u32x2 __attribute__((ext_vector_type(2)));

constexpr int D = 1024, BATCH = 16, SEQ = 2048, T = BATCH * SEQ;
constexpr int CHUNK = 64;
constexpr int MEMT = 256, MT = BATCH * MEMT;
constexpr int FF = 2816;
constexpr float EPS = 1e-6f;
constexpr int NTHREADS = 512, NWAVES = 8;

constexpr int P_QL = 0, P_C = 1024, P_QI = 1152, P_KI = 1664, P_FB = 1728, P_IB = 2240, P_QB = 2752, P_GB = 3264, P_WI = 3776, P_END = 3784, PW = 3840;
constexpr int KOUT = 1536;

constexpr size_t MiB = 1u << 20;
constexpr size_t WS_CTL = 0;
constexpr size_t WS_LB = 64 * 1024;
constexpr size_t WS_STATS = 128 * 1024;
constexpr size_t WS_WIN = 1 * MiB;
constexpr size_t WS_WOUT = WS_WIN + (size_t)PW * D * 2;
constexpr size_t WS_OWIN = WS_WOUT + (size_t)D * KOUT * 2;
constexpr size_t WS_OWOUT = WS_OWIN + (size_t)2048 * D * 2;
constexpr size_t WS_WQ = WS_OWOUT + (size_t)D * D * 2;
constexpr size_t WS_WKV = WS_WQ + 2 * (size_t)512 * D * 2;
constexpr size_t WS_WO = WS_WKV + 2 * (size_t)D * D * 2;
constexpr size_t WS_WGU = WS_WO + 2 * (size_t)D * 512 * 2;
constexpr size_t WS_WDN = WS_WGU + 2 * (size_t)2 * FF * D * 2;
constexpr size_t WS_WEND = WS_WDN + 2 * (size_t)D * FF * 2;
constexpr size_t WS_HN = 64 * MiB;
constexpr size_t WS_BIG = 128 * MiB;
constexpr size_t WS_CN = 368 * MiB;
constexpr size_t WS_CAT = 376 * MiB;
constexpr size_t WS_KV = 472 * MiB;
constexpr size_t WS_MEMN = 488 * MiB;
constexpr size_t WS_END = 496 * MiB;
static_assert(WS_WEND <= WS_HN, "weights fit below HN");

struct Params {
    const float* in[26];
    float* out;
    unsigned char* ws;
};

__device__ __forceinline__ float bf2f(unsigned short u) { return __uint_as_float(((unsigned)u) << 16); }
__device__ __forceinline__ unsigned f2bf(float f) { unsigned u = __float_as_uint(f); return (u + 0x7fffu + ((u >> 16) & 1u)) >> 16; }
__device__ __forceinline__ unsigned pk2(float lo, float hi) { return f2bf(lo) | (f2bf(hi) << 16); }
__device__ __forceinline__ float wave_sum(float v) {
#pragma unroll
    for (int o = 1; o < 64; o <<= 1) v += __shfl_xor(v, o);
    return v;
}
__device__ __forceinline__ float wave_max(float v) {
#pragma unroll
    for (int o = 1; o < 64; o <<= 1) v = fmaxf(v, __shfl_xor(v, o));
    return v;
}
#define WAVE_LDS_SYNC() asm volatile("s_waitcnt lgkmcnt(0)" ::: "memory")
__device__ __forceinline__ float silu_f(float x) { return x / (1.f + __expf(-x)); }
__device__ __forceinline__ float sigmoid_f(float x) { return 1.f / (1.f + __expf(-x)); }

struct Unit { int pm, pn; };
struct Gemm { const bf16_t* A; const bf16_t* Bt; int M, N, K; };
__device__ __forceinline__ int perm32(int rho) { const int n = rho >> 4, i = rho & 15; return 8 * (i >> 2) + 4 * n + (i & 3); }

struct EpiStoreBf16 {
    static constexpr bool PERM = true;
    bf16_t* O; int ldc;
    __device__ __forceinline__ void operator()(const f32x4 (&acc)[2][2][4][2], const Unit& u, int wr, int wc, int fr, int fq) const {
        const int row0 = u.pm * 256 + wr * 64 + fr, col0 = u.pn * 256 + wc * 32 + 8 * fq;
#pragma unroll
        for (int ai = 0; ai < 2; ++ai)
#pragma unroll
            for (int m = 0; m < 4; ++m) {
                bf16_t* rowp = O + (size_t)(row0 + ai * 128 + m * 16) * ldc + col0;
#pragma unroll
                for (int bj = 0; bj < 2; ++bj) {
                    const f32x4 v0 = acc[ai][bj][m][0], v1 = acc[ai][bj][m][1];
                    u32x4 w; w.x = pk2(v0[0], v0[1]); w.y = pk2(v0[2], v0[3]); w.z = pk2(v1[0], v1[1]); w.w = pk2(v1[2], v1[3]);
                    *(u32x4*)(rowp + bj * 128) = w;
                }
            }
    }
};
struct EpiGeluBf16 {
    static constexpr bool PERM = true;
    bf16_t* O; int ldc;
    __device__ __forceinline__ static float g(float x) { return 0.5f * x * (1.f + erff(x * 0.70710678118654752f)); }
    __device__ __forceinline__ void operator()(const f32x4 (&acc)[2][2][4][2], const Unit& u, int wr, int wc, int fr, int fq) const {
        const int row0 = u.pm * 256 + wr * 64 + fr, col0 = u.pn * 256 + wc * 32 + 8 * fq;
#pragma unroll
        for (int ai = 0; ai < 2; ++ai)
#pragma unroll
            for (int m = 0; m < 4; ++m) {
                bf16_t* rowp = O + (size_t)(row0 + ai * 128 + m * 16) * ldc + col0;
#pragma unroll
                for (int bj = 0; bj < 2; ++bj) {
                    const f32x4 v0 = acc[ai][bj][m][0], v1 = acc[ai][bj][m][1];
                    u32x4 w; w.x = pk2(g(v0[0]), g(v0[1])); w.y = pk2(g(v0[2]), g(v0[3])); w.z = pk2(g(v1[0]), g(v1[1])); w.w = pk2(g(v1[2]), g(v1[3]));
                    *(u32x4*)(rowp + bj * 128) = w;
                }
            }
    }
};
struct EpiSwigluBf16 {
    static constexpr bool PERM = true;
    bf16_t* O; int ldc;
    __device__ __forceinline__ void operator()(const f32x4 (&acc)[2][2][4][2], const Unit& u, int wr, int wc, int fr, int fq) const {
        const int row0 = u.pm * 256 + wr * 64 + fr, col0 = u.pn * 128 + wc * 32 + 8 * fq;
#pragma unroll
        for (int ai = 0; ai < 2; ++ai)
#pragma unroll
            for (int m = 0; m < 4; ++m) {
                bf16_t* rowp = O + (size_t)(row0 + ai * 128 + m * 16) * ldc + col0;
                const f32x4 g0 = acc[ai][0][m][0], g1 = acc[ai][0][m][1], u0 = acc[ai][1][m][0], u1 = acc[ai][1][m][1];
                u32x4 w;
                w.x = pk2(silu_f(g0[0]) * u0[0], silu_f(g0[1]) * u0[1]); w.y = pk2(silu_f(g0[2]) * u0[2], silu_f(g0[3]) * u0[3]);
                w.z = pk2(silu_f(g1[0]) * u1[0], silu_f(g1[1]) * u1[1]); w.w = pk2(silu_f(g1[2]) * u1[2], silu_f(g1[3]) * u1[3]);
                *(u32x4*)rowp = w;
            }
    }
};
struct EpiResidF32 {
    static constexpr bool PERM = false;
    const float* base; float* out; int ldc;
    __device__ __forceinline__ void operator()(const f32x4 (&acc)[2][2][4][2], const Unit& u, int wr, int wc, int fr, int fq) const {
        const int row0 = u.pm * 256 + wr * 64 + fr, col0 = u.pn * 256 + wc * 32 + 4 * fq;
#pragma unroll
        for (int ai = 0; ai < 2; ++ai)
#pragma unroll
            for (int m = 0; m < 4; ++m) {
                const size_t off = (size_t)(row0 + ai * 128 + m * 16) * ldc + col0;
#pragma unroll
                for (int bj = 0; bj < 2; ++bj)
#pragma unroll
                    for (int n = 0; n < 2; ++n) {
                        const f32x4 b = *(const f32x4*)(base + off + bj * 128 + n * 16);
                        *(f32x4*)(out + off + bj * 128 + n * 16) = b + acc[ai][bj][m][n];
                    }
            }
    }
};

template <class Epi>
__device__ __forceinline__ void gemm_simple(const Gemm g, const Epi& E, int vb, int nvb) {
    const int tid = threadIdx.x, wid = tid >> 6, lane = tid & 63, wr = wid >> 2, wc = wid & 3, fr = lane & 15, fq = lane >> 4;
    const int nM = g.M / 256, nN = g.N / 256, K = g.K;
    for (int ui = vb; ui < nM * nN; ui += nvb) {
        Unit u; u.pm = ui / nN; u.pn = ui % nN;
        f32x4 acc[2][2][4][2];
#pragma unroll
        for (int a = 0; a < 2; ++a)
#pragma unroll
            for (int b = 0; b < 2; ++b)
#pragma unroll
                for (int m = 0; m < 4; ++m)
#pragma unroll
                    for (int n = 0; n < 2; ++n) acc[a][b][m][n] = (f32x4){0.f, 0.f, 0.f, 0.f};
        const bf16_t* a0 = g.A + (size_t)(u.pm * 256 + wr * 64 + fr) * K + 8 * fq;
        const int br0 = Epi::PERM ? perm32(fr) : fr, br1 = Epi::PERM ? perm32(16 + fr) : 16 + fr;
        const bf16_t* b0 = g.Bt + (size_t)(u.pn * 256 + wc * 32 + br0) * K + 8 * fq;
        const bf16_t* b1 = g.Bt + (size_t)(u.pn * 256 + wc * 32 + br1) * K + 8 * fq;
        for (int k0 = 0; k0 < K; k0 += 32) {
            bf16x8 af[2][4], bfr[2][2];
#pragma unroll
            for (int ai = 0; ai < 2; ++ai)
#pragma unroll
                for (int m = 0; m < 4; ++m) af[ai][m] = *(const bf16x8*)(a0 + (size_t)(ai * 128 + m * 16) * K + k0);
#pragma unroll
            for (int bj = 0; bj < 2; ++bj) {
                bfr[bj][0] = *(const bf16x8*)(b0 + (size_t)(bj * 128) * K + k0);
                bfr[bj][1] = *(const bf16x8*)(b1 + (size_t)(bj * 128) * K + k0);
            }
#pragma unroll
            for (int ai = 0; ai < 2; ++ai)
#pragma unroll
                for (int bj = 0; bj < 2; ++bj)
#pragma unroll
                    for (int m = 0; m < 4; ++m)
#pragma unroll
                        for (int n = 0; n < 2; ++n)
                            acc[ai][bj][m][n] = __builtin_amdgcn_mfma_f32_16x16x32_bf16(bfr[bj][n], af[ai][m], acc[ai][bj][m][n], 0, 0, 0);
        }
        E(acc, u, wr, wc, fr, fq);
    }
}

enum { MAP_ID = 0, MAP_WIN = 1, MAP_GU = 2 };
struct PrepJob { const float* W; int K, N; const float* gain; bf16_t* dst; int r0, r1, ldd, koff, map; };
__device__ __forceinline__ int map_src(int map, int r, int N) {
    if (map == MAP_ID) return r < N ? r : -1;
    if (map == MAP_WIN) {
        if (r < 1728) return r - 512;
        if (r < 3776) return r - 504;
        if (r < 3784) return r - 2560;
        return -1;
    }
    { const int tile = r >> 8, w = r & 255, j = tile * 128 + (w & 127); return w < 128 ? j : FF + j; }
}
__device__ __forceinline__ void prep_job(const PrepJob& j, LAS float* tile  , int vb, int nvb) {
    const int nkt = j.K / 64, nrt = (j.r1 - j.r0 + 63) / 64;
    for (int t = vb; t < nkt * nrt; t += nvb) {
        const int kt = t % nkt, rt = t / nkt, k0 = kt * 64, r0 = j.r0 + rt * 64;
        __syncthreads();
        for (int i = threadIdx.x; i < 4096; i += NTHREADS) {
            const int kk = i >> 6, rr = i & 63, r = r0 + rr;
            float v = 0.f;
            if (r < j.r1) { const int s = map_src(j.map, r, j.N); if (s >= 0) { v = j.W[(size_t)(k0 + kk) * j.N + s]; if (j.gain) v *= j.gain[k0 + kk]; } }
            tile[kk * 65 + rr] = v;
        }
        __syncthreads();
        for (int i = threadIdx.x; i < 2048; i += NTHREADS) {
            const int rr = i >> 5, kk = (i & 31) * 2, r = r0 + rr;
            if (r < j.r1) *(unsigned*)(j.dst + (size_t)r * j.ldd + j.koff + k0 + kk) = pk2(tile[kk * 65 + rr], tile[(kk + 1) * 65 + rr]);
        }
    }
}
__device__ __forceinline__ void prep_fold_in(const float* w_in  , const float* w_uk  , const float* gain, bf16_t* dst, int vb, int nvb) {
    for (size_t i = (size_t)vb * NTHREADS + threadIdx.x; i < (size_t)1024 * 1024; i += (size_t)nvb * NTHREADS) {
        const int k = (int)(i & 1023), r = (int)(i >> 10), h = r >> 7;
        const float* a = w_in + (size_t)k * 3272 + h * 64; const float* b = w_uk + (size_t)r * 64;
        float s = 0.f;
#pragma unroll 8
        for (int d = 0; d < 64; ++d) s += a[d] * b[d];
        dst[(size_t)r * 1024 + k] = (bf16_t)f2bf(s * gain[k]);
    }
}
__device__ __forceinline__ void prep_fold_out(const float* w_out  , const float* w_uv  , bf16_t* dst  , int vb, int nvb) {
    for (size_t i = (size_t)vb * NTHREADS + threadIdx.x; i < (size_t)1024 * 1024; i += (size_t)nvb * NTHREADS) {
        const int n = (int)(i & 1023), kc = (int)(i >> 10), h = kc >> 7;
        const float* a = w_uv + (size_t)kc * 64; const float* b = w_out + (size_t)(h * 64) * 1024 + n;
        float s = 0.f;
#pragma unroll 8
        for (int d = 0; d < 64; ++d) s += a[d] * b[(size_t)d * 1024];
        dst[(size_t)n * KOUT + kc] = (bf16_t)f2bf(s);
    }
}
__device__ __forceinline__ void prep_lb(const float* hgrn_lb  , float* lb, int vb, int nvb) {
    for (int i = vb * NTHREADS + threadIdx.x; i < 512; i += nvb * NTHREADS) {
        const float a = hgrn_lb[i], b = hgrn_lb[512 + i], c = hgrn_lb[1024 + i], m = fmaxf(a, fmaxf(b, c));
        const float ea = __expf(a - m), eb = __expf(b - m), ec = __expf(c - m);
        lb[i] = ea / (ea + eb + ec);
    }
}

__device__ __forceinline__ void rmsnorm_rows(const float* X, bf16_t* Y, int nrows, int vb, int nvb) {
    const int lane = threadIdx.x & 63, gw = vb * NWAVES + __builtin_amdgcn_readfirstlane(threadIdx.x >> 6), ngw = nvb * NWAVES;
    for (int r = gw; r < nrows; r += ngw) {
        const f32x4* xr = (const f32x4*)(X + (size_t)r * D) + lane;
        f32x4 v[4]; float s = 0.f;
#pragma unroll
        for (int j = 0; j < 4; ++j) { v[j] = xr[64 * j]; s += (v[j].x * v[j].x + v[j].y * v[j].y) + (v[j].z * v[j].z + v[j].w * v[j].w); }
        const float rs = rsqrtf(wave_sum(s) * (1.f / D) + EPS);
        u32x2* o = (u32x2*)(Y + (size_t)r * D) + lane;
#pragma unroll
        for (int j = 0; j < 4; ++j) { u32x2 w; w.x = pk2(v[j].x * rs, v[j].y * rs); w.y = pk2(v[j].z * rs, v[j].w * rs); o[64 * j] = w; }
    }
}
__device__ __forceinline__ void final_norm_rows(float* X, const float* g, int vb, int nvb) {
    const int lane = threadIdx.x & 63, gw = vb * NWAVES + __builtin_amdgcn_readfirstlane(threadIdx.x >> 6), ngw = nvb * NWAVES;
    for (int r = gw; r < T; r += ngw) {
        f32x4* xr = (f32x4*)(X + (size_t)r * D) + lane;
        f32x4 v[4]; float s = 0.f;
#pragma unroll
        for (int j = 0; j < 4; ++j) { v[j] = xr[64 * j]; s += (v[j].x * v[j].x + v[j].y * v[j].y) + (v[j].z * v[j].z + v[j].w * v[j].w); }
        const float rs = rsqrtf(wave_sum(s) * (1.f / D) + EPS);
#pragma unroll
        for (int j = 0; j < 4; ++j) { const f32x4 gg = *((const f32x4*)g + lane + 64 * j); xr[64 * j] = v[j] * rs * gg; }
    }
}
__device__ __forceinline__ void cnorm_rows(const bf16_t* P, const float* lat_g, bf16_t* CN, int vb, int nvb) {
    const int lane = threadIdx.x & 63, gw = vb * NWAVES + __builtin_amdgcn_readfirstlane(threadIdx.x >> 6), ngw = nvb * NWAVES;
    const float g0 = lat_g[2 * lane], g1 = lat_g[2 * lane + 1];
    for (int r = gw; r < T; r += ngw) {
        const unsigned w = *(const unsigned*)(P + (size_t)r * PW + P_C + 2 * lane);
        const float a = bf2f((unsigned short)(w & 0xffffu)), b = bf2f((unsigned short)(w >> 16));
        const float rs = rsqrtf(wave_sum(a * a + b * b) * (1.f / 128.f) + EPS);
        *(unsigned*)(CN + (size_t)r * 128 + 2 * lane) = pk2(a * rs * g0, b * rs * g1);
    }
}
__device__ __forceinline__ void ln_stats_rows(const bf16_t* UV, float* stats, int vb, int nvb) {
    const int lane = threadIdx.x & 63, gw = vb * NWAVES + __builtin_amdgcn_readfirstlane(threadIdx.x >> 6), ngw = nvb * NWAVES;
    for (int r = gw; r < T; r += ngw) {
        const bf16x8* p = (const bf16x8*)(UV + (size_t)r * 2048 + 1024) + lane;
        float x[16]; float s = 0.f;
#pragma unroll
        for (int j = 0; j < 2; ++j) { const bf16x8 v = p[64 * j];
#pragma unroll
            for (int e = 0; e < 8; ++e) { x[j * 8 + e] = bf2f((unsigned short)v[e]); s += x[j * 8 + e]; } }
        const float mu = wave_sum(s) * (1.f / 1024.f); float q = 0.f;
#pragma unroll
        for (int e = 0; e < 16; ++e) { const float d = x[e] - mu; q += d * d; }
        const float rs = rsqrtf(wave_sum(q) * (1.f / 1024.f) + EPS);
        if (lane == 0) { stats[2 * r] = mu; stats[2 * r + 1] = rs; }
    }
}

constexpr int DSA_WAVE_F = 3856;
__device__ __forceinline__ int t5_bucket(int rel) {
    const int n = rel < 0 ? -rel : rel;
    int b = n < 8 ? n : 8 + (n >= 12) + (n >= 16) + (n >= 23) + (n >= 32) + (n >= 46) + (n >= 64) + (n >= 91);
    return b + (rel > 0 ? 16 : 0);
}
__device__ __forceinline__ unsigned sort_key(float x) { const unsigned u = __float_as_uint(x); return (u & 0x80000000u) ? ~u : (u | 0x80000000u); }

__device__ __forceinline__ void dsa_phase(const bf16_t* P, const bf16_t* CN, const float* rel_bias, bf16_t* CAT, LAS float* lds, int vb, int nvb) {
    const int tid = threadIdx.x, lane = tid & 63, wid = __builtin_amdgcn_readfirstlane(tid >> 6);
    LAS float* RB = lds;
    LAS float* W = lds + 256 + wid * DSA_WAVE_F;
    LAS float* SC = W; LAS float* QI = W + 2048; LAS float* QL = W + 2560; LAS int* IDX = (LAS int*)(W + 3584); LAS float* WI = W + 3840;
    __syncthreads();
    for (int i = tid; i < 256; i += NTHREADS) RB[i] = rel_bias[i];
    __syncthreads();
    const unsigned long long lt_mask = (lane == 0) ? 0ull : (~0ull >> (64 - lane));
    const int gw = vb * NWAVES + wid, ngw = nvb * NWAVES;
    for (int q = gw; q < T; q += ngw) {
        const int b = q / SEQ, t = q % SEQ, qchunk = t / CHUNK, nj = qchunk + 1, L = nj * CHUNK;
        const bf16_t* Prow = P + (size_t)q * PW;
        const bf16_t* Pb = P + (size_t)b * SEQ * PW;
        const bf16_t* CNb = CN + (size_t)b * SEQ * 128;
        { const bf16x8 v = *(const bf16x8*)(Prow + P_QI + lane * 8);
#pragma unroll
          for (int e = 0; e < 8; ++e) QI[lane * 8 + e] = bf2f((unsigned short)v[e]) * 0.125f;
#pragma unroll
          for (int j = 0; j < 2; ++j) { const bf16x8 w = *(const bf16x8*)(Prow + P_QL + j * 512 + lane * 8);
#pragma unroll
              for (int e = 0; e < 8; ++e) QL[j * 512 + lane * 8 + e] = bf2f((unsigned short)w[e]); }
          if (lane < 8) WI[lane] = bf2f(Prow[P_WI + lane]) * 0.35355339059327373f; }
        WAVE_LDS_SYNC();
        int nsel;
        if (nj > 4) {
            for (int j = 0; j < nj; ++j) {
                asm volatile("" ::: "memory");
                const bf16_t* kp = Pb + (size_t)(j * 64 + lane) * PW + P_KI;
                float kf[64];
#pragma unroll
                for (int c8 = 0; c8 < 8; ++c8) { const bf16x8 v = *(const bf16x8*)(kp + c8 * 8);
#pragma unroll
                    for (int e = 0; e < 8; ++e) kf[c8 * 8 + e] = bf2f((unsigned short)v[e]); }
                float sc = 0.f;
#pragma unroll 1
                for (int h = 0; h < 8; ++h) {
                    float a = 0.f;
#pragma unroll
                    for (int d = 0; d < 64; d += 4) { const f32x4 qv = *(const LAS f32x4*)(QI + h * 64 + d); a += qv.x * kf[d] + qv.y * kf[d + 1] + qv.z * kf[d + 2] + qv.w * kf[d + 3]; }
                    sc += WI[h] * fmaxf(a, 0.f);
                }
                SC[j * 64 + lane] = sc;
            }
            WAVE_LDS_SYNC();
            unsigned uk[32];
#pragma unroll
            for (int j = 0; j < 32; ++j) uk[j] = (j < nj) ? sort_key(SC[j * 64 + lane]) : 0u;
            unsigned Tk = 0u;
            for (int bit = 31; bit >= 0; --bit) {
                const unsigned cand = Tk | (1u << bit);
                int cnt = 0;
#pragma unroll
                for (int j = 0; j < 32; ++j) cnt += __popcll(__ballot(uk[j] >= cand));
                if (cnt >= 256) Tk = cand;
                if (cnt == 256) break;
            }
            int cgt = 0;
#pragma unroll
            for (int j = 0; j < 32; ++j) cgt += __popcll(__ballot(uk[j] > Tk));
            const int need = 256 - cgt;
            int base = 0, eqt = 0;
#pragma unroll
            for (int j = 0; j < 32; ++j) {
                const bool gt = uk[j] > Tk, eq = uk[j] == Tk;
                const unsigned long long meq = __ballot(eq);
                const int erank = eqt + __popcll(meq & lt_mask);
                const bool sel = gt || (eq && erank < need);
                const unsigned long long ms = __ballot(sel);
                if (sel) IDX[base + __popcll(ms & lt_mask)] = j * 64 + lane;
                base += __popcll(ms); eqt += __popcll(meq);
            }
            nsel = 256;
        } else {
#pragma unroll
            for (int i = 0; i < 4; ++i) IDX[i * 64 + lane] = i * 64 + lane;
            nsel = L;
        }
        WAVE_LDS_SYNC();
        for (int i = 0; i < 4; ++i) {
            asm volatile("" ::: "memory");
            const int k = lane + 64 * i; const bool valid = k < nsel;
            const int s = valid ? IDX[k] : 0;
            const bf16_t* cp = CNb + (size_t)s * 128;
            const int bk = t5_bucket(s - t);
#pragma unroll
            for (int half = 0; half < 2; ++half) {
                float cf[64];
#pragma unroll
                for (int c8 = 0; c8 < 8; ++c8) { const bf16x8 v = *(const bf16x8*)(cp + half * 64 + c8 * 8);
#pragma unroll
                    for (int e = 0; e < 8; ++e) cf[c8 * 8 + e] = bf2f((unsigned short)v[e]); }
#pragma unroll 1
                for (int h = 0; h < 8; ++h) {
                    float a = 0.f;
#pragma unroll
                    for (int d = 0; d < 64; d += 4) { const f32x4 qv = *(const LAS f32x4*)(QL + h * 128 + half * 64 + d); a += qv.x * cf[d] + qv.y * cf[d + 1] + qv.z * cf[d + 2] + qv.w * cf[d + 3]; }
                    if (half == 0) SC[h * 256 + k] = a;
                    else SC[h * 256 + k] = valid ? (SC[h * 256 + k] + a) * 0.125f + RB[bk * 8 + h] : -INFINITY;
                }
            }
        }
        WAVE_LDS_SYNC();
#pragma unroll
        for (int h = 0; h < 8; ++h) {
            const float l0 = SC[h * 256 + lane], l1 = SC[h * 256 + lane + 64], l2 = SC[h * 256 + lane + 128], l3 = SC[h * 256 + lane + 192];
            const float mx = wave_max(fmaxf(fmaxf(l0, l1), fmaxf(l2, l3)));
            const float e0 = __expf(l0 - mx), e1 = __expf(l1 - mx), e2 = __expf(l2 - mx), e3 = __expf(l3 - mx);
            const float inv = 1.f / wave_sum((e0 + e1) + (e2 + e3));
            SC[h * 256 + lane] = e0 * inv; SC[h * 256 + lane + 64] = e1 * inv; SC[h * 256 + lane + 128] = e2 * inv; SC[h * 256 + lane + 192] = e3 * inv;
        }
        WAVE_LDS_SYNC();
        float o[8][2];
#pragma unroll
        for (int h = 0; h < 8; ++h) { o[h][0] = 0.f; o[h][1] = 0.f; }
        for (int k = 0; k < nsel; ++k) {
            const int s = IDX[k];
            const unsigned w = *(const unsigned*)(CNb + (size_t)s * 128 + 2 * lane);
            const float c0 = bf2f((unsigned short)(w & 0xffffu)), c1 = bf2f((unsigned short)(w >> 16));
#pragma unroll
            for (int h = 0; h < 8; ++h) { const float p = SC[h * 256 + k]; o[h][0] += p * c0; o[h][1] += p * c1; }
        }
        unsigned* orow = (unsigned*)(CAT + (size_t)q * KOUT);
#pragma unroll
        for (int h = 0; h < 8; ++h) orow[h * 64 + lane] = pk2(o[h][0], o[h][1]);
        WAVE_LDS_SYNC();
    }
}

__device__ __forceinline__ void hgrn_phase(const bf16_t* P, const float* lb, const float* o_g, bf16_t* CAT, LAS float* lds, int vb, int nvb) {
    const int tid = threadIdx.x, v = tid & 127, dq = tid >> 7, lane = tid & 63, wid = tid >> 6;
    LAS float* F = lds; LAS float* KK = lds + 4096; LAS float* QQ = lds + 8192; LAS float* VV = lds + 12288; LAS float* OP = lds + 16384;
    for (int item = vb; item < BATCH * 4; item += nvb) {
        const int b = item >> 2, h = item & 3;
        float S[32];
#pragma unroll
        for (int i = 0; i < 32; ++i) S[i] = 0.f;
        const bf16_t* Pb = P + (size_t)b * SEQ * PW;
        for (int t0 = 0; t0 < SEQ; t0 += 32) {
            __syncthreads();
            for (int i = tid; i < 4096; i += NTHREADS) {
                const int tt = i >> 7, d = i & 127;
                const bf16_t* pr = Pb + (size_t)(t0 + tt) * PW;
                const float l = lb[h * 128 + d];
                const float f = l + (1.f - l) * sigmoid_f(bf2f(pr[P_FB + h * 128 + d]));
                F[i] = f; KK[i] = 1.f - f; QQ[i] = silu_f(bf2f(pr[P_QB + h * 128 + d])); VV[i] = bf2f(pr[P_IB + h * 128 + d]);
            }
            __syncthreads();
            for (int tt = 0; tt < 32; ++tt) {
                const float vv = VV[tt * 128 + v];
                float o = 0.f;
#pragma unroll
                for (int d4 = 0; d4 < 8; ++d4) {
                    const f32x4 f = *(const LAS f32x4*)(F + tt * 128 + dq * 32 + d4 * 4), k = *(const LAS f32x4*)(KK + tt * 128 + dq * 32 + d4 * 4), qq = *(const LAS f32x4*)(QQ + tt * 128 + dq * 32 + d4 * 4);
                    S[d4 * 4 + 0] = S[d4 * 4 + 0] * f.x + k.x * vv; o += qq.x * S[d4 * 4 + 0];
                    S[d4 * 4 + 1] = S[d4 * 4 + 1] * f.y + k.y * vv; o += qq.y * S[d4 * 4 + 1];
                    S[d4 * 4 + 2] = S[d4 * 4 + 2] * f.z + k.z * vv; o += qq.z * S[d4 * 4 + 2];
                    S[d4 * 4 + 3] = S[d4 * 4 + 3] * f.w + k.w * vv; o += qq.w * S[d4 * 4 + 3];
                }
                OP[(tt * 4 + dq) * 128 + v] = o;
            }
            __syncthreads();
#pragma unroll
            for (int r = 0; r < 4; ++r) {
                const int tt = wid * 4 + r;
                float o0 = 0.f, o1 = 0.f;
#pragma unroll
                for (int qd = 0; qd < 4; ++qd) { const f32x2 x = *(const LAS f32x2*)(OP + (tt * 4 + qd) * 128 + 2 * lane); o0 += x.x; o1 += x.y; }
                const float rs = rsqrtf(wave_sum(o0 * o0 + o1 * o1) * (1.f / 128.f) + EPS);
                const size_t row = (size_t)b * SEQ + t0 + tt;
                const unsigned gw = *(const unsigned*)(P + row * PW + P_GB + h * 128 + 2 * lane);
                const float g0 = silu_f(bf2f((unsigned short)(gw & 0xffffu))), g1 = silu_f(bf2f((unsigned short)(gw >> 16)));
                *(unsigned*)(CAT + row * KOUT + 1024 + h * 128 + 2 * lane) = pk2(o0 * rs * o_g[2 * lane] * g0, o1 * rs * o_g[2 * lane + 1] * g1);
            }
        }
    }
}

__device__ __forceinline__ void xattn_phase(const bf16_t* Q, const bf16_t* KV, bf16_t* O, LAS float* lds, int vb, int nvb) {
    const int tid = threadIdx.x, lane = tid & 63, wid = __builtin_amdgcn_readfirstlane(tid >> 6);
    LAS float* QF = lds + wid * 1536; LAS float* PWt = QF + 512;
    const int gw = vb * NWAVES + wid, ngw = nvb * NWAVES;
    for (int q = gw; q < T; q += ngw) {
        const int b = q / SEQ;
        const bf16_t* KVb = KV + (size_t)b * MEMT * 1024;
        { const bf16x8 v = *(const bf16x8*)(Q + (size_t)q * 512 + lane * 8);
#pragma unroll
          for (int e = 0; e < 8; ++e) QF[lane * 8 + e] = bf2f((unsigned short)v[e]) * 0.08838834764831845f; }
        WAVE_LDS_SYNC();
        for (int i = 0; i < 4; ++i) {
            const bf16_t* kp = KVb + (size_t)(lane + 64 * i) * 1024;
#pragma unroll
            for (int h = 0; h < 4; ++h) {
                float a = 0.f;
#pragma unroll
                for (int d8 = 0; d8 < 16; ++d8) {
                    const bf16x8 kv = *(const bf16x8*)(kp + h * 128 + d8 * 8);
                    const f32x4 q0 = *(const LAS f32x4*)(QF + h * 128 + d8 * 8), q1 = *(const LAS f32x4*)(QF + h * 128 + d8 * 8 + 4);
                    a += q0.x * bf2f((unsigned short)kv[0]) + q0.y * bf2f((unsigned short)kv[1]) + q0.z * bf2f((unsigned short)kv[2]) + q0.w * bf2f((unsigned short)kv[3])
                       + q1.x * bf2f((unsigned short)kv[4]) + q1.y * bf2f((unsigned short)kv[5]) + q1.z * bf2f((unsigned short)kv[6]) + q1.w * bf2f((unsigned short)kv[7]);
                }
                PWt[h * 256 + lane + 64 * i] = a;
            }
        }
        WAVE_LDS_SYNC();
#pragma unroll
        for (int h = 0; h < 4; ++h) {
            const float l0 = PWt[h * 256 + lane], l1 = PWt[h * 256 + lane + 64], l2 = PWt[h * 256 + lane + 128], l3 = PWt[h * 256 + lane + 192];
            const float mx = wave_max(fmaxf(fmaxf(l0, l1), fmaxf(l2, l3)));
            const float e0 = __expf(l0 - mx), e1 = __expf(l1 - mx), e2 = __expf(l2 - mx), e3 = __expf(l3 - mx);
            const float inv = 1.f / wave_sum((e0 + e1) + (e2 + e3));
            PWt[h * 256 + lane] = e0 * inv; PWt[h * 256 + lane + 64] = e1 * inv; PWt[h * 256 + lane + 128] = e2 * inv; PWt[h * 256 + lane + 192] = e3 * inv;
        }
        WAVE_LDS_SYNC();
        float o[4][2];
#pragma unroll
        for (int h = 0; h < 4; ++h) { o[h][0] = 0.f; o[h][1] = 0.f; }
        for (int m = 0; m < MEMT; ++m) {
            const bf16_t* vp = KVb + (size_t)m * 1024 + 512 + 2 * lane;
#pragma unroll
            for (int h = 0; h < 4; ++h) {
                const unsigned w = *(const unsigned*)(vp + h * 128);
                const float p = PWt[h * 256 + m];
                o[h][0] += p * bf2f((unsigned short)(w & 0xffffu)); o[h][1] += p * bf2f((unsigned short)(w >> 16));
            }
        }
        unsigned* orow = (unsigned*)(O + (size_t)q * 512);
#pragma unroll
        for (int h = 0; h < 4; ++h) orow[h * 64 + lane] = pk2(o[h][0], o[h][1]);
        WAVE_LDS_SYNC();
    }
}

__device__ __forceinline__ void gmlp_phase(const bf16_t* UV, const float* stats, const float* ln_g, const float* ln_b, const float* w_sp, const float* b_sp, bf16_t* G, LAS float* lds, int vb, int nvb) {
    const int tid = threadIdx.x, c = tid & 127, tq = tid >> 7;
    LAS float* VH = lds; LAS float* WT = lds + 16384;
    for (int item = vb; item < BATCH * 16 * 8; item += nvb) {
        const int g = item & 7, n = (item >> 3) & 15, b = item >> 7;
        const size_t row0 = (size_t)b * SEQ + n * 128;
        __syncthreads();
        for (int i = tid; i < 16384; i += NTHREADS) {
            const int s = i >> 7, cc = i & 127, ch = g * 128 + cc;
            const float x = bf2f(UV[(row0 + s) * 2048 + 1024 + ch]);
            VH[i] = (x - stats[2 * (row0 + s)]) * stats[2 * (row0 + s) + 1] * ln_g[ch] + ln_b[ch];
            WT[i] = w_sp[(size_t)g * 16384 + i];
        }
        __syncthreads();
        for (int i = 0; i < 32; ++i) {
            const int t = i * 4 + tq;
            float a = 0.f;
            for (int s = 0; s <= t; ++s) a += WT[t * 128 + s] * VH[s * 128 + c];
            a += b_sp[g * 128 + t];
            const float uu = bf2f(UV[(row0 + t) * 2048 + g * 128 + c]);
            G[(row0 + t) * 1024 + g * 128 + c] = (bf16_t)f2bf(uu * a);
        }
    }
}

constexpr int LDS_FLOATS = 256 + 8 * DSA_WAVE_F;
constexpr int LDS_BYTES = 32768 * 4;
static_assert(LDS_FLOATS <= 32768, "LDS");

enum Phase {
    PH_PREP = 0, PH_NORM0, PH_GEMM_IN, PH_CNORM, PH_MIX0  , PH_GEMM_OUT0,
    PH_XNORM0, PH_GEMM_Q0, PH_XATTN0, PH_GEMM_O0, PH_FNORM0, PH_GEMM_GU0, PH_GEMM_DN0,
    PH_NORM1, PH_GEMM_OIN, PH_LNSTATS, PH_GMLP, PH_GEMM_OOUT,
    PH_XNORM1, PH_GEMM_Q1, PH_XATTN1, PH_GEMM_O1, PH_FNORM1, PH_GEMM_GU1, PH_GEMM_DN1, PH_FINAL, PH_COUNT
};

__device__ __forceinline__ PrepJob make_job(const Params& p, int ji) {
    unsigned char* ws = p.ws; PrepJob j{};
    switch (ji) {
    case 0: j = PrepJob{p.in[5], 1024, 3272, p.in[4], (bf16_t*)(ws + WS_WIN), 1024, PW, 1024, 0, MAP_WIN}; break;
    case 1: j = PrepJob{p.in[10] + (size_t)512 * 1024, 512, 1024, nullptr, (bf16_t*)(ws + WS_WOUT), 0, 1024, KOUT, 1024, MAP_ID}; break;
    case 2: j = PrepJob{p.in[11], 1024, 2048, p.in[4] + 1024, (bf16_t*)(ws + WS_OWIN), 0, 2048, 1024, 0, MAP_ID}; break;
    case 3: j = PrepJob{p.in[16], 1024, 1024, nullptr, (bf16_t*)(ws + WS_OWOUT), 0, 1024, 1024, 0, MAP_ID}; break;
    case 4: case 5: { const int l = ji - 4; j = PrepJob{p.in[19] + (size_t)l * 1024 * 512, 1024, 512, p.in[17] + l * 1024, (bf16_t*)(ws + WS_WQ) + (size_t)l * 512 * 1024, 0, 512, 1024, 0, MAP_ID}; } break;
    case 6: case 7: { const int l = ji - 6; j = PrepJob{p.in[20] + (size_t)l * 1024 * 1024, 1024, 1024, p.in[18] + l * 1024, (bf16_t*)(ws + WS_WKV) + (size_t)l * 1024 * 1024, 0, 1024, 1024, 0, MAP_ID}; } break;
    case 8: case 9: { const int l = ji - 8; j = PrepJob{p.in[21] + (size_t)l * 512 * 1024, 512, 1024, nullptr, (bf16_t*)(ws + WS_WO) + (size_t)l * 1024 * 512, 0, 1024, 512, 0, MAP_ID}; } break;
    case 10: case 11: { const int l = ji - 10; j = PrepJob{p.in[23] + (size_t)l * 1024 * 2 * FF, 1024, 2 * FF, p.in[22] + l * 1024, (bf16_t*)(ws + WS_WGU) + (size_t)l * 2 * FF * 1024, 0, 2 * FF, 1024, 0, MAP_GU}; } break;
    default: { const int l = ji - 12; j = PrepJob{p.in[24] + (size_t)l * FF * 1024, FF, 1024, nullptr, (bf16_t*)(ws + WS_WDN) + (size_t)l * 1024 * FF, 0, 1024, FF, 0, MAP_ID}; } break;
    }
    return j;
}
constexpr int N_PREP_JOBS = 14;

template <int ph> __device__ __forceinline__ void run_phase(const Params& p, LAS float* lds, int vb, int nvb) {
    unsigned char* ws = p.ws;
    bf16_t* HN = (bf16_t*)(ws + WS_HN); bf16_t* BIG = (bf16_t*)(ws + WS_BIG); bf16_t* CN = (bf16_t*)(ws + WS_CN); bf16_t* CAT = (bf16_t*)(ws + WS_CAT);
    bf16_t* KV = (bf16_t*)(ws + WS_KV); bf16_t* MEMN = (bf16_t*)(ws + WS_MEMN); float* stats = (float*)(ws + WS_STATS); float* lb = (float*)(ws + WS_LB);
    bf16_t* XQ = BIG; bf16_t* XO = BIG + (size_t)T * 512;
    const int l = (ph >= PH_XNORM1) ? 1 : 0;
    switch (ph) {
    case PH_PREP:
        for (int ji = 0; ji < N_PREP_JOBS; ++ji) { const PrepJob j = make_job(p, ji); prep_job(j, lds, vb, nvb); }
        prep_fold_in(p.in[5], p.in[7], p.in[4], (bf16_t*)(ws + WS_WIN), vb, nvb);
        prep_fold_out(p.in[10], p.in[8], (bf16_t*)(ws + WS_WOUT), vb, nvb);
        prep_lb(p.in[3], lb, vb, nvb);
        rmsnorm_rows(p.in[1], MEMN, MT, vb, nvb);
        break;
    case PH_NORM0: rmsnorm_rows(p.in[0], HN, T, vb, nvb); break;
    case PH_GEMM_IN: {
        { Gemm g{HN, (const bf16_t*)(ws + WS_WIN), T, PW, 1024}; EpiStoreBf16 E{BIG, PW}; gemm_simple(g, E, vb, nvb); }
        for (int ll = 0; ll < 2; ++ll) { Gemm g{MEMN, (const bf16_t*)(ws + WS_WKV) + (size_t)ll * 1024 * 1024, MT, 1024, 1024}; EpiStoreBf16 E{KV + (size_t)ll * MT * 1024, 1024}; gemm_simple(g, E, vb, nvb); }
    } break;
    case PH_CNORM: cnorm_rows(BIG, p.in[6], CN, vb, nvb); break;
    case PH_MIX0:
#ifndef NO_HGRN
        hgrn_phase(BIG, lb, p.in[9], CAT, lds, vb, nvb);
#endif
#ifndef NO_DSA
        dsa_phase(BIG, CN, p.in[2], CAT, lds, vb, nvb);
#endif
        break;
    case PH_GEMM_OUT0: { Gemm g{CAT, (const bf16_t*)(ws + WS_WOUT), T, 1024, KOUT}; EpiResidF32 E{p.in[0], p.out, 1024}; gemm_simple(g, E, vb, nvb); } break;
    case PH_XNORM0: case PH_XNORM1: case PH_FNORM0: case PH_FNORM1: case PH_NORM1: rmsnorm_rows(p.out, HN, T, vb, nvb); break;
    case PH_GEMM_Q0: case PH_GEMM_Q1: { Gemm g{HN, (const bf16_t*)(ws + WS_WQ) + (size_t)l * 512 * 1024, T, 512, 1024}; EpiStoreBf16 E{XQ, 512}; gemm_simple(g, E, vb, nvb); } break;
    case PH_XATTN0: case PH_XATTN1: xattn_phase(XQ, KV + (size_t)l * MT * 1024, XO, lds, vb, nvb); break;
    case PH_GEMM_O0: case PH_GEMM_O1: { Gemm g{XO, (const bf16_t*)(ws + WS_WO) + (size_t)l * 1024 * 512, T, 1024, 512}; EpiResidF32 E{p.out, p.out, 1024}; gemm_simple(g, E, vb, nvb); } break;
    case PH_GEMM_GU0: case PH_GEMM_GU1: { Gemm g{HN, (const bf16_t*)(ws + WS_WGU) + (size_t)l * 2 * FF * 1024, T, 2 * FF, 1024}; EpiSwigluBf16 E{BIG, FF}; gemm_simple(g, E, vb, nvb); } break;
    case PH_GEMM_DN0: case PH_GEMM_DN1: { Gemm g{BIG, (const bf16_t*)(ws + WS_WDN) + (size_t)l * 1024 * FF, T, 1024, FF}; EpiResidF32 E{p.out, p.out, 1024}; gemm_simple(g, E, vb, nvb); } break;
    case PH_GEMM_OIN: { Gemm g{HN, (const bf16_t*)(ws + WS_OWIN), T, 2048, 1024}; EpiGeluBf16 E{BIG, 2048}; gemm_simple(g, E, vb, nvb); } break;
    case PH_LNSTATS: ln_stats_rows(BIG, stats, vb, nvb); break;
    case PH_GMLP: gmlp_phase(BIG, stats, p.in[12], p.in[13], p.in[14], p.in[15], CAT, lds, vb, nvb); break;
    case PH_GEMM_OOUT: { Gemm g{CAT, (const bf16_t*)(ws + WS_OWOUT), T, 1024, 1024}; EpiResidF32 E{p.out, p.out, 1024}; gemm_simple(g, E, vb, nvb); } break;
    case PH_FINAL: final_norm_rows(p.out, p.in[25], vb, nvb); break;
    default: break;
    }
}

template <int PH> __global__ void __launch_bounds__(NTHREADS) k_phase(Params p) {
    extern __shared__ __attribute__((aligned(16))) float smem[];
    run_phase<PH>(p, (LAS float*)smem, blockIdx.x, gridDim.x);
}

template <int PH> __device__ __forceinline__ void mega_phases(const Params& p, LAS float* lds, cg::grid_group& grid) {
    run_phase<PH>(p, lds, blockIdx.x, gridDim.x);
    if constexpr (PH + 1 < PH_COUNT) { grid.sync(); mega_phases<PH + 1>(p, lds, grid); }
}
__global__ void __launch_bounds__(NTHREADS) k_mega(Params p) {
    extern __shared__ __attribute__((aligned(16))) float smem[];
    cg::grid_group grid = cg::this_grid();
    mega_phases<0>(p, (LAS float*)smem, grid);
}

template <int PH> static void launch_phases(const Params& p, int grid, hipStream_t stream) {
    int g = grid * 4;
    if (PH == PH_MIX0 || PH == PH_XATTN0 || PH == PH_XATTN1 || PH == PH_GMLP) g = grid;
    (void)hipFuncSetAttribute((const void*)k_phase<PH>, hipFuncAttributeMaxDynamicSharedMemorySize, LDS_BYTES);
    hipLaunchKernelGGL(k_phase<PH>, dim3(g), dim3(NTHREADS), LDS_BYTES, stream, p);
    if constexpr (PH + 1 < PH_COUNT) launch_phases<PH + 1>(p, grid, stream);
}

extern "C" void kernel_launch(void* const* d_in, const int* in_sizes, int n_in, void* d_out, int out_size, void* d_ws, size_t ws_size, hipStream_t stream) {
    static int grid = 0;
    if (grid == 0) {
        if (n_in != 26 || out_size != T * D || ws_size < WS_END) { fprintf(stderr, "kernel_launch: unexpected shapes (n_in %d out %d ws %zu)\n", n_in, out_size, ws_size); grid = -1; return; }
        int dev = 0, cus = 0;
        (void)hipGetDevice(&dev); (void)hipDeviceGetAttribute(&cus, hipDeviceAttributeMultiprocessorCount, dev);
        (void)hipFuncSetAttribute((const void*)k_mega, hipFuncAttributeMaxDynamicSharedMemorySize, LDS_BYTES);
        int per_cu = 0;
        (void)hipOccupancyMaxActiveBlocksPerMultiprocessor(&per_cu, (const void*)k_mega, NTHREADS, LDS_BYTES);
        if (per_cu < 1) fprintf(stderr, "kernel_launch: occupancy query says %d blocks per CU\n", per_cu);
        (void)hipGetLastError();
        grid = cus > 0 ? cus : 256;
    }
    if (grid < 0) return;
    Params p{};
    for (int i = 0; i < 26; ++i) p.in[i] = (const float*)d_in[i];
    p.out = (float*)d_out; p.ws = (unsigned char*)d_ws;
#if MEGA
    void* args[] = {&p};
    hipError_t e = hipLaunchCooperativeKernel((const void*)k_mega, dim3(grid), dim3(NTHREADS), args, LDS_BYTES, stream);
    if (e != hipSuccess) fprintf(stderr, "cooperative launch failed: %s (grid %d)\n", hipGetErrorString(e), grid);
#else
    launch_phases<0>(p, grid, stream);
#endif
}
```

```cpp
#include <hip/hip_runtime.h>
#include <stdint.h>
#include <stdio.h>

#ifndef MEGA
#define MEGA 1
#endif

#define LAS __attribute__((address_space(3)))
typedef unsigned short bf16_t;
typedef short bf16x8 __attribute__((ext_vector_type(8)));
typedef float f32x4 __attribute__((ext_vector_type(4)));
typedef float f32x2 __attribute__((ext_vector_type(2)));
typedef unsigned u32x4 __attribute__((ext_vector_type(4)));
typedef unsigned u32x2 __attribute__((ext_vector_type(2)));
typedef float f32x16 __attribute__((ext_vector_type(16)));

constexpr int D = 1024, BATCH = 16, SEQ = 2048, T = BATCH * SEQ;
constexpr int CHUNK = 64;
constexpr int MEMT = 256, MT = BATCH * MEMT;
constexpr int FF = 2816;
constexpr float EPS = 1e-6f;
constexpr int NTHREADS = 512, NWAVES = 8;

constexpr int P_QL = 0, P_C = 1024, P_QI = 1152, P_KI = 1664, P_FB = 1728, P_IB = 2240, P_QB = 2752, P_GB = 3264, P_WI = 3776, P_END = 3784, PW = 3840;
constexpr int KOUT = 1536;

constexpr size_t MiB = 1u << 20;
constexpr size_t WS_CTL = 0;
constexpr size_t WS_LB = 64 * 1024;
constexpr size_t WS_SSQ = 496 * MiB;
constexpr size_t WS_LNP = 498 * MiB;
constexpr size_t WS_WIN = 1 * MiB;
constexpr size_t WS_WKV = WS_WIN + (size_t)PW * D * 2;
constexpr size_t WS_HN = WS_WKV + 2 * (size_t)D * D * 2;
constexpr size_t WS_MEMN = WS_HN + (size_t)T * D * 2;
constexpr size_t WS_WOUT = WS_MEMN + (size_t)MT * D * 2;
constexpr size_t WS_OWIN = WS_WOUT + (size_t)D * KOUT * 2;
constexpr size_t WS_OWOUT = WS_OWIN + (size_t)2048 * D * 2;
constexpr size_t WS_WQ = WS_OWOUT + (size_t)D * D * 2;
constexpr size_t WS_WO = WS_WQ + 2 * (size_t)512 * D * 2;
constexpr size_t WS_WGU = WS_WO + 2 * (size_t)D * 512 * 2;
constexpr size_t WS_WDN = WS_WGU + 2 * (size_t)2 * FF * D * 2;
constexpr size_t WS_WEND = WS_WDN + 2 * (size_t)D * FF * 2;
constexpr int TILE_WIN = 0, TILE_WKV = PW / 256, TILE_HN = TILE_WKV + 8, TILE_MEMN = TILE_HN + T / 256;
constexpr size_t WS_BIG = 132 * MiB;
constexpr size_t WS_CN = 372 * MiB;
constexpr size_t WS_CAT = 380 * MiB;
constexpr size_t WS_KB = 476 * MiB;
constexpr size_t WS_VT = 484 * MiB;
constexpr size_t WS_END = 502 * MiB;
static_assert(WS_WEND <= WS_BIG, "weights fit below BIG");

struct Params {
    const float* in[26];
    float* out;
    unsigned char* ws;
};

__device__ __forceinline__ float bf2f(unsigned short u) { return __uint_as_float(((unsigned)u) << 16); }
__device__ __forceinline__ unsigned f2bf(float f) { unsigned u = __float_as_uint(f); return (u + 0x7fffu + ((u >> 16) & 1u)) >> 16; }
typedef __bf16 bf16x2_t __attribute__((ext_vector_type(2)));
__device__ __forceinline__ unsigned pk2(float lo, float hi) { const f32x2 v = {lo, hi}; return __builtin_bit_cast(unsigned, __builtin_convertvector(v, bf16x2_t)); }
__device__ __forceinline__ float wave_sum(float v) {
#pragma unroll
    for (int o = 1; o < 64; o <<= 1) v += __shfl_xor(v, o);
    return v;
}
__device__ __forceinline__ float wave_max(float v) {
#pragma unroll
    for (int o = 1; o < 64; o <<= 1) v = fmaxf(v, __shfl_xor(v, o));
    return v;
}
__device__ __forceinline__ int otid() { int t = threadIdx.x; asm volatile("" : "+v"(t)); return t; }
#define WAVE_LDS_SYNC() asm volatile("s_waitcnt lgkmcnt(0)" ::: "memory")
__device__ __forceinline__ float silu_f(float x) { return x * __builtin_amdgcn_rcpf(1.f + __expf(-x)); }
__device__ __forceinline__ float sigmoid_f(float x) { return __builtin_amdgcn_rcpf(1.f + __expf(-x)); }

typedef int i32x4v __attribute__((ext_vector_type(4)));
typedef int i32x8v __attribute__((ext_vector_type(8)));
__device__ __forceinline__ unsigned pk4_f8(float a, float b, float c, float d) {
    a = __builtin_amdgcn_fmed3f(a, -448.f, 448.f); b = __builtin_amdgcn_fmed3f(b, -448.f, 448.f); c = __builtin_amdgcn_fmed3f(c, -448.f, 448.f); d = __builtin_amdgcn_fmed3f(d, -448.f, 448.f);
    int w = 0;
    w = __builtin_amdgcn_cvt_pk_fp8_f32(a, b, w, false);
    w = __builtin_amdgcn_cvt_pk_fp8_f32(c, d, w, true);
    return (unsigned)w;
}
constexpr float ACT_SC = 8.f, WDN_SC = 256.f, DN_UNSC = 1.f / (ACT_SC * WDN_SC);
struct Unit { int pm, pn; };
struct Gemm { const bf16_t* A; const bf16_t* Bt; int M, N, K; };
__device__ __forceinline__ int perm32(int rho) { const int n = rho >> 4, i = rho & 15; return 8 * (i >> 2) + 4 * n + (i & 3); }

__device__ __forceinline__ float row_rstd(const float* ssq, size_t row) {
    const f32x4* p = (const f32x4*)(ssq + row * 16);
    const f32x4 a = p[0], b = p[1], c = p[2], d = p[3];
    const float t = (((a.x + a.y) + (a.z + a.w)) + ((b.x + b.y) + (b.z + b.w))) + (((c.x + c.y) + (c.z + c.w)) + ((d.x + d.y) + (d.z + d.w)));
    return rsqrtf(t * (1.f / 1024.f) + EPS);
}
__device__ __forceinline__ void rows_rstd(const float* ssq, size_t row0, int fq, float (&rs)[2][4]) {
#pragma unroll
    for (int ai = 0; ai < 2; ++ai)
#pragma unroll
        for (int m = 0; m < 4; ++m) { const f32x4 a = *(const f32x4*)(ssq + (row0 + ai * 128 + m * 16) * 16 + 4 * fq); rs[ai][m] = (a.x + a.y) + (a.z + a.w); }
#pragma unroll
    for (int ai = 0; ai < 2; ++ai)
#pragma unroll
        for (int m = 0; m < 4; ++m) { float t = rs[ai][m]; t += __shfl_xor(t, 16); t += __shfl_xor(t, 32); rs[ai][m] = rsqrtf(t * (1.f / 1024.f) + EPS); }
}
struct EpiStoreBf16 {
    static constexpr bool PERM = true, AFTER_DRAIN = false;
    bf16_t* O; int ldc; const float* ssq;
    __device__ __forceinline__ void operator()(const f32x4 (&acc)[2][2][4][2], const Unit& u, int wr, int wc, int fr, int fq) const {
        const int row0 = u.pm * 256 + wr * 64 + fr, col0 = u.pn * 256 + wc * 32 + 8 * fq;
        float rsv[2][4]; rows_rstd(ssq, (size_t)row0, fq, rsv);
#pragma unroll
        for (int ai = 0; ai < 2; ++ai)
#pragma unroll
            for (int m = 0; m < 4; ++m) {
                const float rs = rsv[ai][m];
                bf16_t* rowp = O + (size_t)(row0 + ai * 128 + m * 16) * ldc + col0;
#pragma unroll
                for (int bj = 0; bj < 2; ++bj) {
                    const f32x4 v0 = acc[ai][bj][m][0] * rs, v1 = acc[ai][bj][m][1] * rs;
                    u32x4 w; w.x = pk2(v0[0], v0[1]); w.y = pk2(v0[2], v0[3]); w.z = pk2(v1[0], v1[1]); w.w = pk2(v1[2], v1[3]);
                    *(u32x4*)(rowp + bj * 128) = w;
                }
            }
    }
};
struct EpiIn {
    static constexpr bool PERM = true, AFTER_DRAIN = false;
    bf16_t* P; bf16_t* KB; bf16_t* VT; const float* ssq;
    __device__ __forceinline__ void operator()(const f32x4 (&acc)[2][2][4][2], const Unit& u, int wr, int wc, int fr, int fq) const {
        bf16_t* O; int ldc, rt, ct; const bool main_unit = u.pn < TILE_WKV;
        if (main_unit) { O = P; ldc = PW; rt = u.pm - TILE_HN; ct = u.pn; }
        else if (u.pm >= TILE_MEMN) { const int l = (u.pn - TILE_WKV) >> 2; O = KB + (size_t)l * MT * 512; ldc = 512; rt = u.pm - TILE_MEMN; ct = (u.pn - TILE_WKV) & 3; }
        else { const int l = (u.pm - TILE_WKV) >> 2; O = VT + (size_t)l * 512 * MT; ldc = MT; rt = ((u.pm - TILE_WKV) & 3) - 2; ct = u.pn - TILE_MEMN; }
        const int row0 = rt * 256 + wr * 64 + fr, col0 = ct * 256 + wc * 32 + 8 * fq;
        float rsv[2][4];
        if (main_unit) rows_rstd(ssq, (size_t)row0, fq, rsv);
        else {
#pragma unroll
            for (int ai = 0; ai < 2; ++ai)
#pragma unroll
                for (int m = 0; m < 4; ++m) rsv[ai][m] = 1.f; }
#pragma unroll
        for (int ai = 0; ai < 2; ++ai)
#pragma unroll
            for (int m = 0; m < 4; ++m) {
                const float rs = rsv[ai][m];
                bf16_t* rowp = O + (size_t)(row0 + ai * 128 + m * 16) * ldc + col0;
#pragma unroll
                for (int bj = 0; bj < 2; ++bj) {
                    const f32x4 v0 = acc[ai][bj][m][0] * rs, v1 = acc[ai][bj][m][1] * rs;
                    u32x4 w; w.x = pk2(v0[0], v0[1]); w.y = pk2(v0[2], v0[3]); w.z = pk2(v1[0], v1[1]); w.w = pk2(v1[2], v1[3]);
                    *(u32x4*)(rowp + bj * 128) = w;
                }
            }
    }
};
struct EpiGeluBf16 {
    static constexpr bool PERM = true, AFTER_DRAIN = false;
    bf16_t* O; int ldc; const float* ssq; float* lnp;
    __device__ __forceinline__ static f32x2 gelu_pk(f32x2 v) {
        const f32x2 av = __builtin_elementwise_abs(v), d = av * 0.2316418882f + 1.0f;
        f32x2 t; t.x = __builtin_amdgcn_rcpf(d.x); t.y = __builtin_amdgcn_rcpf(d.y);
        f32x2 q = t * 0.5307027145f + (-0.7265760135f); q = q * t + 0.7107068705f; q = q * t + (-0.142248368f); q = q * t + 0.127414796f; q = q * t;
        const f32x2 sq = (v * v) * (-0.72134752044f);
        f32x2 e; e.x = __builtin_amdgcn_exp2f(sq.x); e.y = __builtin_amdgcn_exp2f(sq.y);
        const f32x2 mm = v * (q * e), r = v - mm;
        f32x2 o; o.x = v.x < 0.f ? mm.x : r.x; o.y = v.y < 0.f ? mm.y : r.y; return o;
    }
    __device__ __forceinline__ static unsigned g2(float a, float b) { const f32x2 r = gelu_pk((f32x2){a, b}); return pk2(r.x, r.y); }
    __device__ __forceinline__ void operator()(const f32x4 (&acc)[2][2][4][2], const Unit& u, int wr, int wc, int fr, int fq) const {
        const int row0 = u.pm * 256 + wr * 64 + fr, col0 = u.pn * 256 + wc * 32 + 8 * fq;
        float rsv[2][4]; rows_rstd(ssq, (size_t)row0, fq, rsv);
#pragma unroll
        for (int ai = 0; ai < 2; ++ai)
#pragma unroll
            for (int m = 0; m < 4; ++m) {
                const size_t row = (size_t)(row0 + ai * 128 + m * 16);
                const float rs = rsv[ai][m];
                bf16_t* rowp = O + row * ldc + col0;
                float s1 = 0.f, s2 = 0.f;
#pragma unroll
                for (int bj = 0; bj < 2; ++bj) {
                    const f32x4 v0 = acc[ai][bj][m][0] * rs, v1 = acc[ai][bj][m][1] * rs;
                    const f32x2 ga = gelu_pk((f32x2){v0[0], v0[1]}), gb = gelu_pk((f32x2){v0[2], v0[3]}), gc = gelu_pk((f32x2){v1[0], v1[1]}), gd = gelu_pk((f32x2){v1[2], v1[3]});
                    u32x4 w; w.x = pk2(ga.x, ga.y); w.y = pk2(gb.x, gb.y); w.z = pk2(gc.x, gc.y); w.w = pk2(gd.x, gd.y);
                    *(u32x4*)(rowp + bj * 128) = w;
                    s1 += ((ga.x + ga.y) + (gb.x + gb.y)) + ((gc.x + gc.y) + (gd.x + gd.y));
                    s2 += ((ga.x * ga.x + ga.y * ga.y) + (gb.x * gb.x + gb.y * gb.y)) + ((gc.x * gc.x + gc.y * gc.y) + (gd.x * gd.x + gd.y * gd.y));
                }
                if (u.pn >= 4) {
                    s1 += __shfl_xor(s1, 16); s1 += __shfl_xor(s1, 32); s2 += __shfl_xor(s2, 16); s2 += __shfl_xor(s2, 32);
                    if (fq == 0) *(f32x2*)(lnp + (row * 16 + (u.pn - 4) * 4 + wc) * 2) = (f32x2){s1, s2};
                }
            }
    }
};
struct EpiSwigluBf16 {
    static constexpr bool PERM = true, AFTER_DRAIN = false;
    bf16_t* O; int ldc; const float* ssq;
    __device__ __forceinline__ void operator()(const f32x4 (&acc)[2][2][4][2], const Unit& u, int wr, int wc, int fr, int fq) const {
        const int row0 = u.pm * 256 + wr * 64 + fr, col0 = u.pn * 128 + wc * 32 + 8 * fq;
        float rsv[2][4]; rows_rstd(ssq, (size_t)row0, fq, rsv);
#pragma unroll
        for (int ai = 0; ai < 2; ++ai)
#pragma unroll
            for (int m = 0; m < 4; ++m) {
                const float rs = rsv[ai][m];
                bf16_t* rowp = O + (size_t)(row0 + ai * 128 + m * 16) * ldc + col0;
                const f32x4 g0 = acc[ai][0][m][0] * rs, g1 = acc[ai][0][m][1] * rs, u0 = acc[ai][1][m][0] * rs, u1 = acc[ai][1][m][1] * rs;
                u32x4 w;
                w.x = pk2(silu_f(g0[0]) * u0[0], silu_f(g0[1]) * u0[1]); w.y = pk2(silu_f(g0[2]) * u0[2], silu_f(g0[3]) * u0[3]);
                w.z = pk2(silu_f(g1[0]) * u1[0], silu_f(g1[1]) * u1[1]); w.w = pk2(silu_f(g1[2]) * u1[2], silu_f(g1[3]) * u1[3]);
                *(u32x4*)rowp = w;
            }
    }
};
struct EpiSwigluFp8 {
    static constexpr bool PERM = true, AFTER_DRAIN = false;
    unsigned char* O; int ldc; const float* ssq;
    __device__ __forceinline__ void operator()(const f32x4 (&acc)[2][2][4][2], const Unit& u, int wr, int wc, int fr, int fq) const {
        const int row0 = u.pm * 256 + wr * 64 + fr, col0 = u.pn * 128 + wc * 32 + 8 * fq;
        float rsv[2][4]; rows_rstd(ssq, (size_t)row0, fq, rsv);
#pragma unroll
        for (int ai = 0; ai < 2; ++ai)
#pragma unroll
            for (int m = 0; m < 4; ++m) {
                const float rs = rsv[ai][m], rsu = rs * ACT_SC;
                unsigned char* rowp = O + (size_t)(row0 + ai * 128 + m * 16) * ldc + col0;
                const f32x4 g0 = acc[ai][0][m][0] * rs, g1 = acc[ai][0][m][1] * rs, u0 = acc[ai][1][m][0] * rsu, u1 = acc[ai][1][m][1] * rsu;
                u32x2 w;
                w.x = pk4_f8(silu_f(g0[0]) * u0[0], silu_f(g0[1]) * u0[1], silu_f(g0[2]) * u0[2], silu_f(g0[3]) * u0[3]);
                w.y = pk4_f8(silu_f(g1[0]) * u1[0], silu_f(g1[1]) * u1[1], silu_f(g1[2]) * u1[2], silu_f(g1[3]) * u1[3]);
                *(u32x2*)rowp = w;
            }
    }
};
template <bool BASE_F32, bool SCALED = false> struct EpiResid {
    static constexpr bool PERM = true, AFTER_DRAIN = false;
    const float* xbase; bf16_t* H; float* ssq;
    __device__ __forceinline__ void operator()(const f32x4 (&acc)[2][2][4][2], const Unit& u, int wr, int wc, int fr, int fq) const {
        const int row0 = u.pm * 256 + wr * 64 + fr, col0 = u.pn * 256 + wc * 32 + 8 * fq;
#pragma unroll
        for (int ai = 0; ai < 2; ++ai)
#pragma unroll
            for (int m = 0; m < 4; ++m) {
                const size_t row = (size_t)(row0 + ai * 128 + m * 16);
                float ss = 0.f;
#pragma unroll
                for (int bj = 0; bj < 2; ++bj) {
                    const size_t off = row * 1024 + col0 + bj * 128;
                    f32x4 b0, b1;
                    if (BASE_F32) { b0 = *(const f32x4*)(xbase + off); b1 = *(const f32x4*)(xbase + off + 4); }
                    else { const u32x4 hw = *(const u32x4*)(H + off);
                        b0 = (f32x4){bf2f((unsigned short)(hw.x & 0xffffu)), bf2f((unsigned short)(hw.x >> 16)), bf2f((unsigned short)(hw.y & 0xffffu)), bf2f((unsigned short)(hw.y >> 16))};
                        b1 = (f32x4){bf2f((unsigned short)(hw.z & 0xffffu)), bf2f((unsigned short)(hw.z >> 16)), bf2f((unsigned short)(hw.w & 0xffffu)), bf2f((unsigned short)(hw.w >> 16))}; }
                    const float sc = SCALED ? DN_UNSC : 1.f;
                    const f32x4 v0 = b0 + acc[ai][bj][m][0] * sc, v1 = b1 + acc[ai][bj][m][1] * sc;
                    u32x4 w; w.x = pk2(v0[0], v0[1]); w.y = pk2(v0[2], v0[3]); w.z = pk2(v1[0], v1[1]); w.w = pk2(v1[2], v1[3]);
                    *(u32x4*)(H + off) = w;
                    ss += ((v0[0] * v0[0] + v0[1] * v0[1]) + (v0[2] * v0[2] + v0[3] * v0[3])) + ((v1[0] * v1[0] + v1[1] * v1[1]) + (v1[2] * v1[2] + v1[3] * v1[3]));
                }
                ss += __shfl_xor(ss, 16); ss += __shfl_xor(ss, 32);
                if (fq == 0) ssq[row * 16 + u.pn * 4 + wc] = ss;
            }
    }
};
namespace pg8 {
#define PG8_LAS __attribute__((address_space(3)))
constexpr int BM = 256, BK = 64, HALF = 128, HTB = HALF * BK * 2  , STAGE_BYTES = 8 * HTB, NXCD = 8, WGM = 8;
__host__ __device__ __forceinline__ int lds_byte(int r, int c) { const int st = (r >> 4) * 2 + (c >> 5), rr = r & 15, cc = c & 31, ob = rr * 64 + cc * 2; return st * 1024 + (ob ^ (((ob >> 9) & 1) << 5)); }
__host__ __device__ __forceinline__ void stage_rc(int b, int& R, int& C) { const int st = b / 1024, sb = b % 1024, swz = sb ^ (((sb >> 9) & 1) << 5); R = (st >> 1) * 16 + swz / 64; C = (st & 1) * 32 + (swz % 64) / 2; }
struct StaticOrder {
    int nM, nN, nwg, G, c;
    __host__ __device__ void init(int M, int N, int G_, int c_) { nM = M / BM; nN = N / BM; nwg = nM * nN; G = G_; c = c_; }
    __host__ __device__ bool next(int i, Unit& u) const {
        const long L = (long)i * G + c; if (L >= nwg) return false;
        int wgid = (int)L; { const int q = nwg / NXCD, r = nwg % NXCD, xcd = wgid % NXCD, off = wgid / NXCD; wgid = (xcd < r ? xcd * (q + 1) : r * (q + 1) + (xcd - r) * q) + off; }
        const int nig = WGM * nN, gid = wgid / nig, fm = gid * WGM, gsz = (nM - fm) < WGM ? (nM - fm) : WGM;
        u.pm = fm + ((wgid % nig) % gsz); u.pn = (wgid % nig) / gsz; return true;
    }
    __device__ __forceinline__ void a_ready(const Unit&) const {}
    __device__ __forceinline__ void done(const Unit&) const {}
};
struct ComboOrder {
    StaticOrder so;
    __host__ __device__ void init(int G_, int c_) { so.init(T, PW, G_, c_); }
    __host__ __device__ bool next(int i, Unit& u) const {
        const long L = (long)i * so.G + so.c;
        if (L < so.nwg) { so.next(i, u); u.pm += TILE_HN; return true; }
        const int j = (int)(L - so.nwg); if (j >= 128) return false;
        const int l = j >> 6, jj = j & 63;
        if (jj < 32) { u.pm = TILE_MEMN + (jj >> 1); u.pn = TILE_WKV + 4 * l + (jj & 1); }
        else { const int q = jj - 32; u.pm = TILE_WKV + 4 * l + 2 + (q >> 4); u.pn = TILE_MEMN + (q & 15); }
        return true;
    }
    __device__ __forceinline__ void a_ready(const Unit&) const {}
    __device__ __forceinline__ void done(const Unit&) const {}
};
template <class Epi, class Sched, bool ALIGN_EPI = false, bool SP2 = false, bool FP8 = false>
__device__ __forceinline__ void gemm_phase(PG8_LAS unsigned char* lds, const Gemm g, const Sched& S, const Epi& E) {
    const int tid = otid(), wid = __builtin_amdgcn_readfirstlane(tid >> 6), lane = tid & 63, wr = wid >> 2, wc = wid & 3, fr = lane & 15, fq = lane >> 4;
    const int K = g.K, nt = K / BK;
    unsigned voffA[2], voffB[2];
#pragma unroll
    for (int i = 0; i < 2; ++i) { int R, C; stage_rc(tid * 16 + i * 8192, R, C); const int Rb = Epi::PERM ? ((R & ~31) + perm32(R & 31)) : R;
        voffA[i] = (unsigned)(R * K + C) * 2u; voffB[i] = (unsigned)(Rb * K + C) * 2u; }
    const size_t kstep = (size_t)(BK * 2);
    const size_t hstep = (size_t)HALF * K * 2;
    const size_t tstep = 2 * hstep;
    const unsigned ldsw = (unsigned)wid * 1024u;
    const int aoff = lds_byte(wr * 64 + fr, fq * 8), boff = lds_byte(wc * 32 + fr, fq * 8);
#define PG8_SA(b, h) (((b) * 2 + (h)) * HTB)
#define PG8_SB(b, h) ((4 + (b) * 2 + (h)) * HTB)
#define PG8_STAGE(bufoff, gbase, voff) do { _Pragma("unroll") for (int _i = 0; _i < 2; ++_i) \
        __builtin_amdgcn_global_load_lds((const unsigned*)((const char*)(gbase) + (voff)[_i]), (PG8_LAS unsigned*)(lds + (bufoff) + ldsw + _i * 8192), 16, 0, 0); } while (0)
#define PG8_LD16(off) (*(const PG8_LAS bf16x8*)(lds + (off)))
#define PG8_LDA(dst, b, h) do { _Pragma("unroll") for (int m = 0; m < 4; ++m) { \
        if constexpr (FP8) dst##8[m] = PG8_CAT(PG8_LD16(PG8_SA(b, h) + aoff + m * 2048), PG8_LD16(PG8_SA(b, h) + aoff + m * 2048 + 1024)); \
        else { _Pragma("unroll") for (int k = 0; k < 2; ++k) dst[m][k] = PG8_LD16(PG8_SA(b, h) + aoff + m * 2048 + k * 1024); } } } while (0)
#define PG8_LDB(dst, b, h) do { _Pragma("unroll") for (int n = 0; n < 2; ++n) { \
        if constexpr (FP8) dst##8[n] = PG8_CAT(PG8_LD16(PG8_SB(b, h) + boff + n * 2048), PG8_LD16(PG8_SB(b, h) + boff + n * 2048 + 1024)); \
        else { _Pragma("unroll") for (int k = 0; k < 2; ++k) dst[n][k] = PG8_LD16(PG8_SB(b, h) + boff + n * 2048 + k * 1024); } } } while (0)
#define PG8_CAT(x, y) __builtin_shufflevector(__builtin_bit_cast(i32x4v, x), __builtin_bit_cast(i32x4v, y), 0, 1, 2, 3, 4, 5, 6, 7)
#define PG8_MMA(ai, bj, At, Bt) do { __builtin_amdgcn_s_setprio(1); \
        if constexpr (FP8) { _Pragma("unroll") for (int m = 0; m < 4; ++m) _Pragma("unroll") for (int n = 0; n < 2; ++n) \
            asm("v_mfma_f32_16x16x128_f8f6f4 %0, %1, %2, %0" : "+v"(acc[ai][bj][m][n]) : "v"(Bt##8[n]), "v"(At##8[m])); } \
        else { _Pragma("unroll") for (int m = 0; m < 4; ++m) _Pragma("unroll") for (int n = 0; n < 2; ++n) _Pragma("unroll") for (int k = 0; k < 2; ++k) \
            acc[ai][bj][m][n] = __builtin_amdgcn_mfma_f32_16x16x32_bf16(Bt[n][k], At[m][k], acc[ai][bj][m][n], 0, 0, 0); } \
        __builtin_amdgcn_s_setprio(0); } while (0)
#define PG8_WAIT_V(n) asm volatile("s_waitcnt vmcnt(" #n ")" ::: "memory")
#define PG8_WAIT_L(n) asm volatile("s_waitcnt lgkmcnt(" #n ")" ::: "memory")
#define PG8_BAR __builtin_amdgcn_s_barrier()
#define PG8_SCHED __builtin_amdgcn_sched_barrier(0)
    Unit cur, nxt; int ui = 0;
    if (!S.next(0, cur)) return;
    f32x4 acc[2][2][4][2];
#pragma unroll
    for (int a = 0; a < 2; ++a)
#pragma unroll
        for (int b = 0; b < 2; ++b)
#pragma unroll
            for (int m = 0; m < 4; ++m)
#pragma unroll
                for (int n = 0; n < 2; ++n) acc[a][b][m][n] = (f32x4){0.f, 0.f, 0.f, 0.f};
    bf16x8 At[4][2], B0[2][2], B1[2][2];
    i32x8v At8[4], B08[2], B18[2];
    const char* cA = (const char*)g.A + (size_t)cur.pm * tstep; const char* cB = (const char*)g.Bt + (size_t)cur.pn * tstep;
    S.a_ready(cur);
    if constexpr (SP2) {
        PG8_STAGE(PG8_SB(0, 0), cB, voffB); PG8_STAGE(PG8_SB(0, 1), cB + hstep, voffB); PG8_STAGE(PG8_SA(0, 0), cA, voffA); PG8_STAGE(PG8_SA(0, 1), cA + hstep, voffA);
        if (wr == 1) PG8_BAR;
        PG8_WAIT_V(2); PG8_BAR;
        PG8_STAGE(PG8_SB(1, 0), cB + kstep, voffB); PG8_STAGE(PG8_SA(1, 0), cA + kstep, voffA); PG8_STAGE(PG8_SB(1, 1), cB + hstep + kstep, voffB);
        PG8_WAIT_V(6); PG8_BAR;
    } else {
        PG8_STAGE(PG8_SB(0, 0), cB, voffB); PG8_STAGE(PG8_SA(0, 0), cA, voffA); PG8_STAGE(PG8_SB(0, 1), cB + hstep, voffB); PG8_STAGE(PG8_SA(0, 1), cA + hstep, voffA);
        if (wr == 1) PG8_BAR;
        PG8_WAIT_V(4); PG8_BAR;
        PG8_STAGE(PG8_SB(1, 0), cB + kstep, voffB); PG8_STAGE(PG8_SA(1, 0), cA + kstep, voffA); PG8_STAGE(PG8_SB(1, 1), cB + hstep + kstep, voffB);
        PG8_WAIT_V(6); PG8_BAR;
    }
    for (;;) {
        const bool has_next = S.next(ui + 1, nxt);
        const char* nA = has_next ? (const char*)g.A + (size_t)nxt.pm * tstep : cA; const char* nB = has_next ? (const char*)g.Bt + (size_t)nxt.pn * tstep : cB;
        for (int t = 0; t < nt; t += 2) {
            const bool last = (t == nt - 2);
            if constexpr (FP8) __builtin_amdgcn_s_waitcnt(0xC07F);
            const char* a1 = cA + (size_t)(t + 1) * kstep;
            const char* a2 = last ? nA : cA + (size_t)(t + 2) * kstep; const char* b2 = last ? nB : cB + (size_t)(t + 2) * kstep;
            const char* a3 = a2 + kstep; const char* b3 = b2 + kstep;
            if (last && has_next) S.a_ready(nxt);
            if constexpr (SP2) {
            PG8_LDB(B0, 0, 0); PG8_LDB(B1, 0, 1); PG8_SCHED; PG8_LDA(At, 0, 0); PG8_STAGE(PG8_SA(1, 1), a1 + hstep, voffA);
            PG8_WAIT_V(8); PG8_WAIT_L(0); PG8_BAR; PG8_MMA(0, 0, At, B0); PG8_MMA(0, 1, At, B1); PG8_BAR; PG8_SCHED;
            PG8_LDA(At, 0, 1); PG8_STAGE(PG8_SB(0, 0), b2, voffB); PG8_STAGE(PG8_SB(0, 1), b2 + hstep, voffB); PG8_STAGE(PG8_SA(0, 0), a2, voffA);
            PG8_WAIT_V(8); PG8_WAIT_L(0); PG8_BAR; PG8_MMA(1, 0, At, B0); PG8_MMA(1, 1, At, B1); PG8_BAR; PG8_SCHED;
            PG8_LDB(B0, 1, 0); PG8_LDB(B1, 1, 1); PG8_SCHED; PG8_LDA(At, 1, 0); PG8_STAGE(PG8_SA(0, 1), a2 + hstep, voffA);
            PG8_WAIT_V(8); PG8_WAIT_L(0); PG8_BAR; PG8_MMA(0, 0, At, B0); PG8_MMA(0, 1, At, B1); PG8_BAR; PG8_SCHED;
            PG8_LDA(At, 1, 1); PG8_STAGE(PG8_SB(1, 0), b3, voffB); PG8_STAGE(PG8_SB(1, 1), b3 + hstep, voffB); PG8_STAGE(PG8_SA(1, 0), a3, voffA);
            PG8_WAIT_V(8); PG8_WAIT_L(0); PG8_BAR; PG8_MMA(1, 0, At, B0); PG8_MMA(1, 1, At, B1); PG8_BAR; PG8_SCHED;
            } else {
            PG8_LDB(B0, 0, 0); PG8_SCHED; PG8_LDA(At, 0, 0); PG8_STAGE(PG8_SA(1, 1), a1 + hstep, voffA);
            PG8_WAIT_L(8); PG8_BAR; PG8_WAIT_L(0); PG8_MMA(0, 0, At, B0); PG8_BAR; PG8_SCHED;
            PG8_LDB(B1, 0, 1); PG8_STAGE(PG8_SB(0, 0), b2, voffB);
            PG8_BAR; PG8_WAIT_L(0); PG8_MMA(0, 1, At, B1); PG8_BAR;
            PG8_LDA(At, 0, 1); PG8_STAGE(PG8_SA(0, 0), a2, voffA);
            PG8_BAR; PG8_WAIT_L(0); PG8_MMA(1, 0, At, B0); PG8_BAR; PG8_SCHED;
            PG8_STAGE(PG8_SB(0, 1), b2 + hstep, voffB);
            PG8_WAIT_V(6); PG8_BAR; PG8_MMA(1, 1, At, B1); PG8_BAR;
            PG8_LDB(B0, 1, 0); PG8_SCHED; PG8_LDA(At, 1, 0); PG8_STAGE(PG8_SA(0, 1), a2 + hstep, voffA);
            PG8_WAIT_L(8); PG8_BAR; PG8_WAIT_L(0); PG8_MMA(0, 0, At, B0); PG8_BAR; PG8_SCHED;
            PG8_LDB(B1, 1, 1); PG8_STAGE(PG8_SB(1, 0), b3, voffB);
            PG8_BAR; PG8_WAIT_L(0); PG8_MMA(0, 1, At, B1); PG8_BAR;
            PG8_LDA(At, 1, 1); PG8_STAGE(PG8_SA(1, 0), a3, voffA);
            PG8_BAR; PG8_WAIT_L(0); PG8_MMA(1, 0, At, B0); PG8_BAR; PG8_SCHED;
            PG8_STAGE(PG8_SB(1, 1), b3 + hstep, voffB);
            PG8_WAIT_V(6); PG8_BAR; PG8_MMA(1, 1, At, B1); PG8_BAR;
            }
        }
        if constexpr (FP8) asm volatile("s_nop 15\n\ts_nop 15" ::: "memory");
        if constexpr (ALIGN_EPI) { if (wr == 0) PG8_BAR; }
        if constexpr (!Epi::AFTER_DRAIN) { E(acc, cur, wr, wc, fr, fq); S.done(cur); }
        if (!has_next) break;
#pragma unroll
        for (int a = 0; a < 2; ++a)
#pragma unroll
            for (int b = 0; b < 2; ++b)
#pragma unroll
                for (int m = 0; m < 4; ++m)
#pragma unroll
                    for (int n = 0; n < 2; ++n) acc[a][b][m][n] = (f32x4){0.f, 0.f, 0.f, 0.f};
        cur = nxt; cA = nA; cB = nB; ++ui;
        if constexpr (ALIGN_EPI) { if (wr == 1) PG8_BAR; }
    }
    PG8_WAIT_V(0);
    if constexpr (!ALIGN_EPI) { if (wr == 0) PG8_BAR; }
    PG8_BAR;
    if constexpr (Epi::AFTER_DRAIN) { E.fused(acc, cur, wr, wc, fr, fq, lds, wid, lane); S.done(cur); }
#undef PG8_SA
#undef PG8_SB
#undef PG8_STAGE
#undef PG8_LDA
#undef PG8_LD16
#undef PG8_LDB
#undef PG8_MMA
#undef PG8_CAT
#undef PG8_WAIT_V
#undef PG8_WAIT_L
#undef PG8_BAR
#undef PG8_SCHED
}
}

template <class Epi, bool FP8 = false>
__device__ __forceinline__ void run_gemm(const Gemm g, const Epi& E, LAS float* lds, int vb, int nvb) {
    pg8::StaticOrder S; S.init(g.M, g.N, nvb, vb);
    pg8::gemm_phase<Epi, pg8::StaticOrder, true, true, FP8>((LAS unsigned char*)lds, g, S, E);
}

enum { MAP_ID = 0, MAP_WIN = 1, MAP_GU = 2, MAP_ID8 = 3   };
struct PrepJob { const float* W; int K, N; const float* gain; bf16_t* dst; int r0, r1, ldd, koff, map; };
__device__ __forceinline__ int map_src(int map, int r, int N) {
    if (map == MAP_ID || map == MAP_ID8) return r < N ? r : -1;
    if (map == MAP_WIN) {
        if (r < 1728) return r - 512;
        if (r < 3776) return r - 504;
        if (r < 3784) return r - 2560;
        return -1;
    }
    { const int tile = r >> 8, w = r & 255, j = tile * 128 + (w & 127); return w < 128 ? j : FF + j; }
}
__device__ __forceinline__ void prep_tile_load(const PrepJob& j, int t, f32x4 (&v)[8]) {
    const int nkt = j.K / 64, kt = t % nkt, rt = t / nkt, k0 = kt * 64, r0 = j.r0 + rt * 256;
#pragma unroll
    for (int q = 0; q < 8; ++q) {
        const int i = (int)threadIdx.x + q * NTHREADS, kk = i >> 6, r4 = (i & 63) * 4;
        const int sc = map_src(j.map, r0 + r4, j.N);
        v[q] = sc >= 0 ? __builtin_nontemporal_load((const f32x4*)(j.W + (size_t)(k0 + kk) * j.N + sc)) : (f32x4){0.f, 0.f, 0.f, 0.f};
        if (j.gain) v[q] = v[q] * j.gain[k0 + kk];
    }
}
__device__ __forceinline__ void prep_tile_store(const PrepJob& j, int t, const f32x4 (&v)[8], LAS float* tile  ) {
    const int nkt = j.K / 64, kt = t % nkt, rt = t / nkt, k0 = kt * 64, r0 = j.r0 + rt * 256;
    __syncthreads();
#pragma unroll
    for (int q = 0; q < 8; ++q) { const int i = (int)threadIdx.x + q * NTHREADS, kk = i >> 6, r4 = (i & 63) * 4; *(LAS f32x4*)(tile + kk * 260 + r4) = v[q]; }
    __syncthreads();
#pragma unroll
    for (int q = 0; q < 4; ++q) {
        const int i = (int)threadIdx.x + q * NTHREADS, rr = i & 255, c8 = i >> 8;
        const LAS float* tp = tile + (c8 * 8) * 260 + rr;
        if (j.map == MAP_ID8) {
            u32x2 w; w.x = pk4_f8(tp[0] * WDN_SC, tp[260] * WDN_SC, tp[520] * WDN_SC, tp[780] * WDN_SC); w.y = pk4_f8(tp[1040] * WDN_SC, tp[1300] * WDN_SC, tp[1560] * WDN_SC, tp[1820] * WDN_SC);
            *(u32x2*)((unsigned char*)j.dst + (size_t)(r0 + rr) * j.ldd + j.koff + k0 + c8 * 8) = w;
        } else {
        u32x4 w; w.x = pk2(tp[0], tp[260]); w.y = pk2(tp[520], tp[780]); w.z = pk2(tp[1040], tp[1300]); w.w = pk2(tp[1560], tp[1820]);
        *(u32x4*)(j.dst + (size_t)(r0 + rr) * j.ldd + j.koff + k0 + c8 * 8) = w;
        }
    }
}
__device__ __forceinline__ void prep_fold_in(const float* w_in  , const float* w_uk  , const float* gain, bf16_t* dst, LAS float* lds, int vb, int nvb) {
    LAS float* A = lds; LAS float* B = lds + 32 * 65;
    const int tid = otid(), lane = tid & 63, wid = __builtin_amdgcn_readfirstlane(tid >> 6), l15 = lane & 15, dq = lane >> 4;
    for (int item = vb; item < 256; item += nvb) {
        const int h = item >> 5, k0 = (item & 31) * 32;
        __syncthreads();
        for (int i = tid; i < 2048; i += NTHREADS) { const int kk = i >> 6, d = i & 63; A[kk * 65 + d] = w_in[(size_t)(k0 + kk) * 3272 + h * 64 + d] * gain[k0 + kk]; }
        for (int i = tid; i < 8192; i += NTHREADS) { const int c = i >> 6, d = i & 63; B[c * 65 + d] = w_uk[(size_t)(h * 128 + c) * 64 + d]; }
        __syncthreads();
        f32x4 acc0 = (f32x4){0.f, 0.f, 0.f, 0.f}, acc1 = acc0;
#pragma unroll 4
        for (int d0 = 0; d0 < 64; d0 += 4) {
            const float b = B[(16 * wid + l15) * 65 + d0 + dq], a0 = A[l15 * 65 + d0 + dq], a1 = A[(16 + l15) * 65 + d0 + dq];
            acc0 = __builtin_amdgcn_mfma_f32_16x16x4f32(a0, b, acc0, 0, 0, 0);
            acc1 = __builtin_amdgcn_mfma_f32_16x16x4f32(a1, b, acc1, 0, 0, 0);
        }
        bf16_t* drow = dst + (size_t)(h * 128 + 16 * wid + l15) * 1024 + k0 + 4 * dq;
        { u32x2 w; w.x = pk2(acc0[0], acc0[1]); w.y = pk2(acc0[2], acc0[3]); *(u32x2*)drow = w; }
        { u32x2 w; w.x = pk2(acc1[0], acc1[1]); w.y = pk2(acc1[2], acc1[3]); *(u32x2*)(drow + 16) = w; }
    }
}
__device__ __forceinline__ void prep_fold_out(const float* w_out  , const float* w_uv  , bf16_t* dst  , LAS float* lds, int vb, int nvb) {
    LAS float* A = lds; LAS float* B = lds + 64 * 33;
    const int tid = otid(), lane = tid & 63, wid = __builtin_amdgcn_readfirstlane(tid >> 6), l15 = lane & 15, dq = lane >> 4;
    for (int item = vb; item < 256; item += nvb) {
        const int h = item >> 5, n0 = (item & 31) * 32;
        __syncthreads();
        for (int i = tid; i < 2048; i += NTHREADS) { const int d = i >> 5, nn = i & 31; A[d * 33 + nn] = w_out[(size_t)(h * 64 + d) * 1024 + n0 + nn]; }
        for (int i = tid; i < 8192; i += NTHREADS) { const int c = i >> 6, d = i & 63; B[c * 65 + d] = w_uv[(size_t)(h * 128 + c) * 64 + d]; }
        __syncthreads();
        f32x4 acc0 = (f32x4){0.f, 0.f, 0.f, 0.f}, acc1 = acc0;
#pragma unroll 4
        for (int d0 = 0; d0 < 64; d0 += 4) {
            const float a = B[(16 * wid + l15) * 65 + d0 + dq], b0 = A[(d0 + dq) * 33 + l15], b1 = A[(d0 + dq) * 33 + 16 + l15];
            acc0 = __builtin_amdgcn_mfma_f32_16x16x4f32(a, b0, acc0, 0, 0, 0);
            acc1 = __builtin_amdgcn_mfma_f32_16x16x4f32(a, b1, acc1, 0, 0, 0);
        }
        { u32x2 w; w.x = pk2(acc0[0], acc0[1]); w.y = pk2(acc0[2], acc0[3]); *(u32x2*)(dst + (size_t)(n0 + l15) * KOUT + h * 128 + 16 * wid + 4 * dq) = w; }
        { u32x2 w; w.x = pk2(acc1[0], acc1[1]); w.y = pk2(acc1[2], acc1[3]); *(u32x2*)(dst + (size_t)(n0 + 16 + l15) * KOUT + h * 128 + 16 * wid + 4 * dq) = w; }
    }
}
__device__ __forceinline__ void prep_lb(const float* hgrn_lb  , float* lb, int vb, int nvb) {
    for (int i = vb * NTHREADS + threadIdx.x; i < 512; i += nvb * NTHREADS) {
        const float a = hgrn_lb[i], b = hgrn_lb[512 + i], c = hgrn_lb[1024 + i], m = fmaxf(a, fmaxf(b, c));
        const float ea = __expf(a - m), eb = __expf(b - m), ec = __expf(c - m);
        lb[i] = ea / (ea + eb + ec);
    }
}

__device__ __forceinline__ void rmsnorm_rows(const float* X, bf16_t* Y, int nrows, int vb, int nvb) {
    const int tid = otid(), lane = tid & 63, gw = vb * NWAVES + __builtin_amdgcn_readfirstlane(tid >> 6), ngw = nvb * NWAVES;
    for (int r = gw; r < nrows; r += ngw) {
        const f32x4* xr = (const f32x4*)(X + (size_t)r * D) + lane;
        f32x4 v[4]; float s = 0.f;
#pragma unroll
        for (int j = 0; j < 4; ++j) { v[j] = xr[64 * j]; s += (v[j].x * v[j].x + v[j].y * v[j].y) + (v[j].z * v[j].z + v[j].w * v[j].w); }
        const float rs = rsqrtf(wave_sum(s) * (1.f / D) + EPS);
        u32x2* o = (u32x2*)(Y + (size_t)r * D) + lane;
#pragma unroll
        for (int j = 0; j < 4; ++j) { u32x2 w; w.x = pk2(v[j].x * rs, v[j].y * rs); w.y = pk2(v[j].z * rs, v[j].w * rs); o[64 * j] = w; }
    }
}
__device__ __forceinline__ void x_to_h_rows(const float* X, bf16_t* H, float* ssq, int vb, int nvb) {
    const int tid = otid(), lane = tid & 63, gw = vb * NWAVES + __builtin_amdgcn_readfirstlane(tid >> 6), ngw = nvb * NWAVES;
    for (int r = gw; r < T; r += 2 * ngw) {
        const int r2 = (r + ngw < T) ? r + ngw : r;
        f32x4 v[2][4];
#pragma unroll
        for (int j = 0; j < 4; ++j) { v[0][j] = __builtin_nontemporal_load((const f32x4*)(X + (size_t)r * D) + lane + 64 * j); v[1][j] = __builtin_nontemporal_load((const f32x4*)(X + (size_t)r2 * D) + lane + 64 * j); }
#pragma unroll
        for (int q = 0; q < 2; ++q) {
            const int rr = q ? r2 : r;
            u32x2* o = (u32x2*)(H + (size_t)rr * D) + lane;
            float s = 0.f;
#pragma unroll
            for (int j = 0; j < 4; ++j) { const f32x4 x = v[q][j]; u32x2 w; w.x = pk2(x.x, x.y); w.y = pk2(x.z, x.w); o[64 * j] = w;
                const float a = bf2f((unsigned short)(w.x & 0xffffu)), b = bf2f((unsigned short)(w.x >> 16)), c = bf2f((unsigned short)(w.y & 0xffffu)), d = bf2f((unsigned short)(w.y >> 16));
                s += (a * a + b * b) + (c * c + d * d); }
            s = wave_sum(s);
            if (lane < 16) ssq[(size_t)rr * 16 + lane] = lane == 0 ? s : 0.f;
        }
    }
}
__device__ __forceinline__ void final_rows(const bf16_t* H, const float* ssq, const float* g, float* out, int vb, int nvb) {
    const int tid = otid(), lane = tid & 63, gw = vb * NWAVES + __builtin_amdgcn_readfirstlane(tid >> 6), ngw = nvb * NWAVES;
    f32x4 gg[4];
#pragma unroll
    for (int j = 0; j < 4; ++j) gg[j] = *((const f32x4*)g + lane + 64 * j);
    for (int r = gw; r < T; r += 2 * ngw) {
        const int r2 = (r + ngw < T) ? r + ngw : r;
        u32x2 w[2][4]; float rs[2];
#pragma unroll
        for (int j = 0; j < 4; ++j) { w[0][j] = ((const u32x2*)(H + (size_t)r * D) + lane)[64 * j]; w[1][j] = ((const u32x2*)(H + (size_t)r2 * D) + lane)[64 * j]; }
        rs[0] = row_rstd(ssq, (size_t)r); rs[1] = row_rstd(ssq, (size_t)r2);
#pragma unroll
        for (int q = 0; q < 2; ++q) {
            f32x4* o = (f32x4*)(out + (size_t)(q ? r2 : r) * D) + lane;
#pragma unroll
            for (int j = 0; j < 4; ++j) { const u32x2 ww = w[q][j];
                __builtin_nontemporal_store((f32x4){bf2f((unsigned short)(ww.x & 0xffffu)) * rs[q] * gg[j].x, bf2f((unsigned short)(ww.x >> 16)) * rs[q] * gg[j].y, bf2f((unsigned short)(ww.y & 0xffffu)) * rs[q] * gg[j].z, bf2f((unsigned short)(ww.y >> 16)) * rs[q] * gg[j].w}, o + 64 * j); }
        }
    }
}
__device__ __forceinline__ float row16_sum(float v) {
    v += __uint_as_float((unsigned)__builtin_amdgcn_update_dpp(0, (int)__float_as_uint(v), 0x128, 0xf, 0xf, false));
    v += __uint_as_float((unsigned)__builtin_amdgcn_update_dpp(0, (int)__float_as_uint(v), 0x124, 0xf, 0xf, false));
    v += __uint_as_float((unsigned)__builtin_amdgcn_update_dpp(0, (int)__float_as_uint(v), 0x122, 0xf, 0xf, false));
    v += __uint_as_float((unsigned)__builtin_amdgcn_update_dpp(0, (int)__float_as_uint(v), 0x121, 0xf, 0xf, false));
    return v;
}
__device__ __forceinline__ void cnorm_rows(const bf16_t* P, const float* lat_g, bf16_t* CN, int vb, int nvb) {
    const int tid = otid(), lane = tid & 63, gw = vb * NWAVES + __builtin_amdgcn_readfirstlane(tid >> 6), ngw = nvb * NWAVES, r4 = lane >> 4, l16 = lane & 15;
    const f32x4 ga = *(const f32x4*)(lat_g + l16 * 8), gb = *(const f32x4*)(lat_g + l16 * 8 + 4);
    for (int r = gw * 8; r < T; r += ngw * 8) {
        u32x4 w[2];
#pragma unroll
        for (int q = 0; q < 2; ++q) w[q] = *(const u32x4*)(P + (size_t)(r + 4 * q + r4) * PW + P_C + l16 * 8);
#pragma unroll
        for (int q = 0; q < 2; ++q) {
            const float x0 = bf2f((unsigned short)(w[q].x & 0xffffu)), x1 = bf2f((unsigned short)(w[q].x >> 16)), x2 = bf2f((unsigned short)(w[q].y & 0xffffu)), x3 = bf2f((unsigned short)(w[q].y >> 16));
            const float x4 = bf2f((unsigned short)(w[q].z & 0xffffu)), x5 = bf2f((unsigned short)(w[q].z >> 16)), x6 = bf2f((unsigned short)(w[q].w & 0xffffu)), x7 = bf2f((unsigned short)(w[q].w >> 16));
            const float ss = row16_sum(((x0 * x0 + x1 * x1) + (x2 * x2 + x3 * x3)) + ((x4 * x4 + x5 * x5) + (x6 * x6 + x7 * x7)));
            const float rs = rsqrtf(ss * (1.f / 128.f) + EPS);
            u32x4 o; o.x = pk2(x0 * rs * ga.x, x1 * rs * ga.y); o.y = pk2(x2 * rs * ga.z, x3 * rs * ga.w); o.z = pk2(x4 * rs * gb.x, x5 * rs * gb.y); o.w = pk2(x6 * rs * gb.z, x7 * rs * gb.w);
            *(u32x4*)(CN + (size_t)(r + 4 * q + r4) * 128 + l16 * 8) = o;
        }
    }
}
__device__ __forceinline__ int t5_bucket(int rel) {
    const int n = rel < 0 ? -rel : rel;
    int b = n < 8 ? n : 8 + (n >= 12) + (n >= 16) + (n >= 23) + (n >= 32) + (n >= 46) + (n >= 64) + (n >= 91);
    return b + (rel > 0 ? 16 : 0);
}
__device__ __forceinline__ unsigned sort_key(float x) { const unsigned u = __float_as_uint(x); return (u & 0x80000000u) ? ~u : (u | 0x80000000u); }


template <int CTRL, int ROWMASK> __device__ __forceinline__ unsigned dpp0(unsigned v) { return (unsigned)__builtin_amdgcn_update_dpp(0, (int)v, CTRL, ROWMASK, 0xf, false); }
__device__ __forceinline__ unsigned wave_prefix_incl(unsigned v) {
    v += dpp0<0x111, 0xf>(v); v += dpp0<0x112, 0xf>(v); v += dpp0<0x114, 0xf>(v); v += dpp0<0x118, 0xf>(v);
    v += dpp0<0x142, 0xa>(v);
    v += dpp0<0x143, 0xc>(v);
    return v;
}
__device__ __forceinline__ float wave_max_u(float v) {
    v = fmaxf(v, __uint_as_float((unsigned)__builtin_amdgcn_update_dpp(0, (int)__float_as_uint(v), 0x128, 0xf, 0xf, false)));
    v = fmaxf(v, __uint_as_float((unsigned)__builtin_amdgcn_update_dpp(0, (int)__float_as_uint(v), 0x124, 0xf, 0xf, false)));
    v = fmaxf(v, __uint_as_float((unsigned)__builtin_amdgcn_update_dpp(0, (int)__float_as_uint(v), 0x122, 0xf, 0xf, false)));
    v = fmaxf(v, __uint_as_float((unsigned)__builtin_amdgcn_update_dpp(0, (int)__float_as_uint(v), 0x121, 0xf, 0xf, false)));
    const int b = (int)__float_as_uint(v);
    return fmaxf(fmaxf(__uint_as_float((unsigned)__builtin_amdgcn_readlane(b, 0)), __uint_as_float((unsigned)__builtin_amdgcn_readlane(b, 16))),
                 fmaxf(__uint_as_float((unsigned)__builtin_amdgcn_readlane(b, 32)), __uint_as_float((unsigned)__builtin_amdgcn_readlane(b, 48))));
}

typedef short v4i16_t __attribute__((ext_vector_type(4)));
constexpr int DSA_BT_OFF = 131072 + 256, DSA_WS_OFF = DSA_BT_OFF + 6144;
__device__ __forceinline__ unsigned dsa_bucket(float x, float lo, float sc) { const float f = (x - lo) * sc; const unsigned b = (unsigned)f; return b > 255u ? 255u : b; }
__device__ __forceinline__ unsigned off_b(unsigned row, unsigned ch) { return 256u * row + 16u * (ch ^ (((row & 3) << 2) | ((row >> 2) & 3))); }
__device__ __forceinline__ void dsa_mfma_phase(const bf16_t* P, const bf16_t* CN, const float* rel_bias, bf16_t* CAT, LAS unsigned char* lds, unsigned* qctr) {
    const int tid = otid(), lane = tid & 63, wid = __builtin_amdgcn_readfirstlane(tid >> 6);
    LAS float* BT = (LAS float*)(lds + DSA_BT_OFF);
    __syncthreads();
    for (int i = tid; i < 191 * 8; i += NTHREADS) { const int rel = (i >> 3) - 127; BT[i] = rel_bias[t5_bucket(rel) * 8 + (i & 7)]; }
    const unsigned long long lt_mask = (lane == 0) ? 0ull : (~0ull >> (64 - lane));
    volatile LAS int* qslot = (volatile LAS int*)(lds + 131072 + 64);
    int nxt = 0;
    if (tid == 0) { *qslot = (int)atomicAdd(qctr, 1u); nxt = (int)atomicAdd(qctr, 1u); }
    for (;;) {
        __syncthreads();
        const int u = *qslot;
        if (u >= T / 16) break;
        const int b = u & 15, qg = 127 - (u >> 4), t0 = qg * 16, nj = t0 / CHUNK + 1, L = nj * CHUNK, nt = L / 32;
        const bf16_t* Pb = P + (size_t)b * SEQ * PW;
        {
            int ln1 = lane; asm volatile("" : "+v"(ln1));
            const int rho = ln1 & 31, hf = ln1 >> 5;
            const int qq = 2 * ((rho >> 2) & 1) + (rho >> 4), hh = 4 * ((rho >> 3) & 1) + (rho & 3);
            bf16x8 qa[4][4], wa[4], wc[4];
#pragma unroll
            for (int qd = 0; qd < 4; ++qd) {
                const bf16_t* qrow = Pb + (size_t)(t0 + 4 * qd + qq) * PW + P_QI + hh * 64 + 8 * hf;
#pragma unroll
                for (int ks = 0; ks < 4; ++ks) qa[qd][ks] = *(const bf16x8*)(qrow + ks * 16);
                wa[qd] = *(const bf16x8*)(Pb + (size_t)(t0 + 4 * qd + 2 * hf) * PW + P_WI); wc[qd] = *(const bf16x8*)(Pb + (size_t)(t0 + 4 * qd + 2 * hf + 1) * PW + P_WI);
            }
            LAS float* sc0 = (LAS float*)lds + (2 * hf) * 2048 + rho;
            const bf16_t* kbase = Pb + (size_t)rho * PW + P_KI + 8 * hf;
            bf16x8 kb[4], kn[4];
#pragma unroll
            for (int ks = 0; ks < 4; ++ks) { kb[ks] = (bf16x8){0, 0, 0, 0, 0, 0, 0, 0}; kn[ks] = kb[ks]; }
            if (wid < nt) {
#pragma unroll
                for (int ks = 0; ks < 4; ++ks) kb[ks] = *(const bf16x8*)(kbase + (size_t)wid * 32 * PW + ks * 16);
            }
            for (int kt = wid; kt < nt; kt += 8) {
                if (kt + 8 < nt) {
#pragma unroll
                    for (int ks = 0; ks < 4; ++ks) kn[ks] = *(const bf16x8*)(kbase + (size_t)(kt + 8) * 32 * PW + ks * 16);
                }
#pragma unroll
                for (int qd = 0; qd < 4; ++qd) {
                    f32x16 acc;
#pragma unroll
                    for (int r = 0; r < 16; ++r) acc[r] = 0.f;
#pragma unroll
                    for (int ks = 0; ks < 4; ++ks) acc = __builtin_amdgcn_mfma_f32_32x32x16_bf16(qa[qd][ks], kb[ks], acc, 0, 0, 0);
                    float s0 = 0.f, s1 = 0.f;
#pragma unroll
                    for (int e = 0; e < 8; ++e) { s0 += bf2f((unsigned short)wa[qd][e]) * fmaxf(acc[e], 0.f); s1 += bf2f((unsigned short)wc[qd][e]) * fmaxf(acc[8 + e], 0.f); }
                    sc0[(4 * qd) * 2048 + kt * 32] = s0 * (0.35355339059327373f * 0.125f); sc0[(4 * qd + 1) * 2048 + kt * 32] = s1 * (0.35355339059327373f * 0.125f);
                }
#pragma unroll
                for (int ks = 0; ks < 4; ++ks) kb[ks] = kn[ks];
            }
        }
        __syncthreads();
        if (tid == 0) { *qslot = nxt; nxt = (int)atomicAdd(qctr, 1u); }
        LAS unsigned char* pair = lds + wid * 16384;
        LAS unsigned char* wsc = lds + DSA_WS_OFF + wid * 2560;
        LAS unsigned* HIST = (LAS unsigned*)wsc; LAS float* CANDV = (LAS float*)(wsc + 1024); LAS unsigned* CANDI = (LAS unsigned*)(wsc + 1280);
        const int nsel = L < 256 ? L : 256;
        int lna = lane; asm volatile("" : "+v"(lna));
#pragma unroll 1
        for (int e2 = 0; e2 < 2; ++e2) {
            LAS unsigned short* IDX = (LAS unsigned short*)(wsc + 1536 + e2 * 512);
            if (nj > 4) {
                const LAS float* SCq = (const LAS float*)(pair + e2 * 8192);
                float x[32];
#pragma unroll
                for (int j = 0; j < 32; ++j) x[j] = (j < nj) ? SCq[j * 64 + lna] : 0.f;
                float lo = INFINITY, hi = -INFINITY;
#pragma unroll
                for (int j = 0; j < 32; ++j) if (j < nj) { hi = fmaxf(hi, x[j]); lo = fminf(lo, x[j]); }
                hi = wave_max_u(hi); lo = -wave_max_u(-lo);
                bool done = false;
                if (hi > lo) {
                    const float sc = 256.f / (hi - lo);
                    *(LAS u32x4*)(HIST + 4 * lna) = (u32x4){0u, 0u, 0u, 0u};
                    WAVE_LDS_SYNC();
#pragma unroll
                    for (int j = 0; j < 32; ++j) if (j < nj) { const unsigned bk = dsa_bucket(x[j], lo, sc); __hip_atomic_fetch_add(HIST + bk, 1u, __ATOMIC_RELAXED, __HIP_MEMORY_SCOPE_WORKGROUP); }
                    WAVE_LDS_SYNC();
                    const u32x4 h4 = *(const LAS u32x4*)(HIST + 4 * lna);
                    const unsigned cl = (h4.x + h4.y) + (h4.z + h4.w);
                    const unsigned pfx = wave_prefix_incl(cl);
                    const unsigned Sx = (unsigned)__builtin_amdgcn_readlane((int)pfx, 63) - pfx + cl;
                    const int lstar = __popcll(__ballot(Sx >= 256u)) - 1;
                    const unsigned above = Sx - cl, t3 = above + h4.w, t2 = t3 + h4.z, t1 = t2 + h4.y;
                    const unsigned bl = t3 >= 256u ? 3u : (t2 >= 256u ? 2u : (t1 >= 256u ? 1u : 0u));
                    const unsigned al = bl == 3u ? above : (bl == 2u ? t3 : (bl == 1u ? t2 : t1));
                    const unsigned ml = bl == 3u ? h4.w : (bl == 2u ? h4.z : (bl == 1u ? h4.y : h4.x));
                    const unsigned bstar = (unsigned)__builtin_amdgcn_readlane((int)(4u * lna + bl), lstar);
                    const int a = __builtin_amdgcn_readlane((int)al, lstar), m = __builtin_amdgcn_readlane((int)ml, lstar);
                    if (m <= 64) {
                        done = true;
                        const int need = 256 - a;
                        unsigned msel = 0u, mcand = 0u;
#pragma unroll
                        for (int j = 31; j >= 0; --j) if (j < nj) { const unsigned bk = dsa_bucket(x[j], lo, sc); msel = msel + msel + (bk > bstar ? 1u : 0u); mcand = mcand + mcand + (bk == bstar ? 1u : 0u); }
                        const unsigned pk = (unsigned)__popc(msel) | ((unsigned)__popc(mcand) << 16);
                        const unsigned inc = wave_prefix_incl(pk);
                        unsigned off = (inc - pk) & 0xffffu, coff = (inc - pk) >> 16;
                        while (msel) { const int j = __ffs((int)msel) - 1; msel &= msel - 1u; IDX[off++] = (unsigned short)(j * 64 + lna); }
                        while (mcand) { const int j = __ffs((int)mcand) - 1; mcand &= mcand - 1u; CANDV[coff] = SCq[j * 64 + lna]; CANDI[coff] = (unsigned)(j * 64 + lna); ++coff; }
                        WAVE_LDS_SYNC();
                        const float cv = CANDV[lna < m ? lna : 0]; const unsigned ci = CANDI[lna < m ? lna : 0];
                        int rank = 0;
                        for (int k = 0; k < m; ++k) { const float v = __uint_as_float((unsigned)__builtin_amdgcn_readlane((int)__float_as_uint(cv), k)); const unsigned id = (unsigned)__builtin_amdgcn_readlane((int)ci, k); rank += (v > cv || (v == cv && id < ci)) ? 1 : 0; }
                        if (lna < m && rank < need) IDX[a + rank] = (unsigned short)ci;
                    }
                }
                if (!done) {
                    unsigned lo_k = 0xffffffffu, hi_k = 0u;
#pragma unroll
                    for (int j = 0; j < 32; ++j) if (j < nj) { const unsigned kx = sort_key(x[j]); hi_k = kx > hi_k ? kx : hi_k; lo_k = kx < lo_k ? kx : lo_k; }
#pragma unroll
                    for (int o = 1; o < 64; o <<= 1) { const unsigned h2 = (unsigned)__shfl_xor((int)hi_k, o), l2 = (unsigned)__shfl_xor((int)lo_k, o); hi_k = h2 > hi_k ? h2 : hi_k; lo_k = l2 < lo_k ? l2 : lo_k; }
                    lo_k = (unsigned)__builtin_amdgcn_readfirstlane((int)lo_k); hi_k = (unsigned)__builtin_amdgcn_readfirstlane((int)hi_k);
                    bool exact = false;
                    while (lo_k < hi_k) {
                        const unsigned mid = lo_k + ((hi_k - lo_k + 1u) >> 1);
                        int cnt = 0;
#pragma unroll
                        for (int j = 0; j < 32; ++j) cnt += __popcll(__ballot(j < nj && sort_key(x[j]) >= mid));
                        if (cnt == 256) { lo_k = mid; exact = true; break; }
                        if (cnt > 256) lo_k = mid; else hi_k = mid - 1u;
                    }
                    const unsigned Tv = lo_k;
                    int need = 0;
                    if (!exact) { int cgt = 0;
#pragma unroll
                        for (int j = 0; j < 32; ++j) cgt += __popcll(__ballot(j < nj && sort_key(x[j]) > Tv));
                        need = 256 - cgt; }
                    int base = 0, eqt = 0;
#pragma unroll
                    for (int j = 0; j < 32; ++j) {
                        const unsigned kx = sort_key(x[j]);
                        const bool gt = (j < nj) && (exact ? (kx >= Tv) : (kx > Tv)), eq = (j < nj) && !exact && (kx == Tv);
                        const unsigned long long meq = __ballot(eq);
                        const bool sel = gt || (eq && (eqt + __popcll(meq & lt_mask)) < need);
                        const unsigned long long ms = __ballot(sel);
                        if (sel) IDX[base + __popcll(ms & lt_mask)] = (unsigned short)(j * 64 + lna);
                        base += __popcll(ms); eqt += __popcll(meq);
                    }
                }
            } else {
#pragma unroll
                for (int i = 0; i < 4; ++i) IDX[i * 64 + lna] = (unsigned short)(i * 64 + lna);
            }
        }
        WAVE_LDS_SYNC();
        {
            int lnb = lane; asm volatile("" : "+v"(lnb));
            const int head = lnb & 15, kg = lnb >> 4, nblk = nsel >> 5;
            LAS unsigned char* GB = pair;
            const bf16_t* CNb = CN + (size_t)b * SEQ * 128;
            const int rho = lnb & 15;
            const unsigned rw0 = 8 * (rho >> 2) + (rho & 3), rw1 = rw0 + 4;
            const unsigned xa0 = ((rw0 & 3) << 2) | ((rw0 >> 2) & 3), xa1 = ((rw1 & 3) << 2) | ((rw1 >> 2) & 3);
            const unsigned q4 = (lnb & 15) >> 2, p4 = lnb & 3;
            u32x4 gA[8], gB[8];
#define DSA_GATHER(G, IX, blk) do { _Pragma("unroll") for (int it = 0; it < 8; ++it) { const int sp = (IX)[(blk) * 32 + (lnb >> 4) + 4 * it]; G[it] = *(const u32x4*)(CNb + (size_t)sp * 128 + (lnb & 15) * 8); } } while (0)
            { const LAS unsigned short* IDX0 = (const LAS unsigned short*)(wsc + 1536); DSA_GATHER(gA, IDX0, 0); DSA_GATHER(gB, IDX0, 1); }
#pragma unroll 1
            for (int e2 = 0; e2 < 2; ++e2) {
                const int t = t0 + 2 * wid + e2;
                const size_t row = (size_t)b * SEQ + t;
                const LAS unsigned short* IDX = (const LAS unsigned short*)(wsc + 1536 + e2 * 512);
                bf16x8 qlf[4];
#pragma unroll
                for (int s4 = 0; s4 < 4; ++s4) { qlf[s4] = *(const bf16x8*)(P + row * PW + P_QL + (head & 7) * 128 + s4 * 32 + 8 * kg); if (head >= 8) qlf[s4] = (bf16x8){0, 0, 0, 0, 0, 0, 0, 0}; }
                f32x4 o[8];
#pragma unroll
                for (int ct = 0; ct < 8; ++ct) o[ct] = (f32x4){0.f, 0.f, 0.f, 0.f};
                float m = -INFINITY, lsum = 0.f;
#define DSA_STEP(G, kbx) do { \
                    WAVE_LDS_SYNC();                              \
                    _Pragma("unroll") for (int it = 0; it < 8; ++it) *(LAS u32x4*)(GB + off_b((lnb >> 4) + 4 * it, lnb & 15)) = G[it]; \
                    const bf16x8 iv = *(const LAS bf16x8*)((const LAS unsigned char*)IDX + ((kbx) * 32 + 8 * kg) * 2);     \
                    if ((kbx) + 2 < nblk) DSA_GATHER(G, IDX, (kbx) + 2); else if (e2 == 0) DSA_GATHER(G, IDX + 256, (kbx) + 2 - nblk); \
                    WAVE_LDS_SYNC(); \
                      \
                    bf16x8 k0[4], k1[4], af[8]; \
                    _Pragma("unroll") for (int s4 = 0; s4 < 4; ++s4) { \
                        k0[s4] = *(const LAS bf16x8*)(GB + 256u * rw0 + 16u * ((4 * s4 + kg) ^ xa0)); \
                        k1[s4] = *(const LAS bf16x8*)(GB + 256u * rw1 + 16u * ((4 * s4 + kg) ^ xa1)); } \
                    float bia[8]; \
                    _Pragma("unroll") for (int e = 0; e < 8; ++e) { const int sp = (int)(unsigned short)iv[e]; int rel = sp - t; rel = rel < -127 ? -127 : rel; bia[e] = BT[(rel + 127) * 8 + (head & 7)]; } \
                      \
                    f32x4 a0 = (f32x4){0.f, 0.f, 0.f, 0.f}, a1 = (f32x4){0.f, 0.f, 0.f, 0.f}; \
                    _Pragma("unroll") for (int s4 = 0; s4 < 4; ++s4) { \
                        a0 = __builtin_amdgcn_mfma_f32_16x16x32_bf16(k0[s4], qlf[s4], a0, 0, 0, 0); \
                        a1 = __builtin_amdgcn_mfma_f32_16x16x32_bf16(k1[s4], qlf[s4], a1, 0, 0, 0); } \
                    asm volatile("" : "+v"(a0), "+v"(a1));        \
                    _Pragma("unroll") for (int ct = 0; ct < 8; ++ct) {              \
                        const v4i16_t lo4 = __builtin_amdgcn_ds_read_tr16_b64_v4i16((LAS v4i16_t*)(GB + off_b(8 * kg + q4, 2 * ct + (p4 >> 1)) + 8 * (p4 & 1))); \
                        const v4i16_t hi4 = __builtin_amdgcn_ds_read_tr16_b64_v4i16((LAS v4i16_t*)(GB + off_b(8 * kg + 4 + q4, 2 * ct + (p4 >> 1)) + 8 * (p4 & 1))); \
                        af[ct] = (bf16x8){lo4[0], lo4[1], lo4[2], lo4[3], hi4[0], hi4[1], hi4[2], hi4[3]}; } \
                      \
                    float lg[8]; \
                    _Pragma("unroll") for (int e = 0; e < 8; ++e) lg[e] = (e < 4 ? a0[e] : a1[e - 4]) * 0.125f + bia[e]; \
                    const float mloc = fmaxf(fmaxf(fmaxf(lg[0], lg[1]), fmaxf(lg[2], lg[3])), fmaxf(fmaxf(lg[4], lg[5]), fmaxf(lg[6], lg[7]))); \
                      \
                    float scl = 1.f; \
                    if (__any(mloc > m + 16.f)) { \
                        float mb = fmaxf(mloc, __shfl_xor(mloc, 16)); mb = fmaxf(mb, __shfl_xor(mb, 32)); \
                        const float mn = fmaxf(m, mb); scl = __expf(m - mn); m = mn; \
                        _Pragma("unroll") for (int ct = 0; ct < 8; ++ct) o[ct] = o[ct] * scl; } \
                    float ps = 0.f; float pe[8]; \
                    _Pragma("unroll") for (int e = 0; e < 8; ++e) { pe[e] = __expf(lg[e] - m); ps += pe[e]; } \
                    lsum = lsum * scl + ps; \
                    u32x4 pw; pw.x = pk2(pe[0], pe[1]); pw.y = pk2(pe[2], pe[3]); pw.z = pk2(pe[4], pe[5]); pw.w = pk2(pe[6], pe[7]); \
                    const bf16x8 pb = __builtin_bit_cast(bf16x8, pw); \
                    _Pragma("unroll") for (int ct = 0; ct < 8; ++ct) o[ct] = __builtin_amdgcn_mfma_f32_16x16x32_bf16(af[ct], pb, o[ct], 0, 0, 0); \
                } while (0)
#pragma unroll 1
                for (int kb2 = 0; kb2 < nblk; kb2 += 2) { DSA_STEP(gA, kb2); DSA_STEP(gB, kb2 + 1); }
#undef DSA_STEP
                lsum += __shfl_xor(lsum, 16); lsum += __shfl_xor(lsum, 32);
                const float inv = 1.f / lsum;
                if (head < 8) {
                    bf16_t* op = CAT + row * KOUT + head * 128 + 4 * kg;
#pragma unroll
                    for (int ct = 0; ct < 8; ++ct) { u32x2 w; w.x = pk2(o[ct][0] * inv, o[ct][1] * inv); w.y = pk2(o[ct][2] * inv, o[ct][3] * inv); *(u32x2*)(op + ct * 16) = w; }
                }
            }
#undef DSA_GATHER
        }
    }
}

constexpr size_t WS_DEC = 492 * MiB;
__device__ __forceinline__ void hgrn_prep(bf16_t* P, const float* lb, float* DEC, LAS unsigned char* lds, int vb, int nvb) {
    const int tid = otid(), cl = tid >> 7, d = tid & 127;
    LAS bf16_t* Ft = (LAS bf16_t*)lds; LAS bf16_t* Qt = (LAS bf16_t*)(lds + 65536);
    for (int it = vb; it < BATCH * 4 * 8; it += nvb) {
        const int b = it >> 5, h = (it >> 3) & 3, cg = it & 7;
        bf16_t* base = P + ((size_t)b * SEQ + cg * 256) * PW + h * 128;
        u32x4 v[16];
#pragma unroll
        for (int k = 0; k < 16; ++k) { const int i = tid + 512 * k, tl = i >> 12, r = (i >> 4) & 255, ch = i & 15; v[k] = *(const u32x4*)(base + (size_t)r * PW + (tl ? P_QB : P_FB) + ch * 8); }
        __syncthreads();
#pragma unroll
        for (int k = 0; k < 16; ++k) { const int i = tid + 512 * k, tl = i >> 12, r = (i >> 4) & 255, ch = i & 15; *(LAS u32x4*)(lds + tl * 65536 + r * 256 + ch * 16) = v[k]; }
        __syncthreads();
        {
            const float l = lb[h * 128 + d];
            LAS bf16_t* fcol = Ft + (cl * 64) * 128 + d; LAS bf16_t* qcol = Qt + (cl * 64) * 128 + d;
            float ref = 0.f;
#pragma unroll 8
            for (int t = 0; t < 32; ++t) ref += __logf(l + (1.f - l) * sigmoid_f(bf2f(fcol[t * 128])));
            float bi = 0.f;
#pragma unroll 8
            for (int t = 0; t < 64; ++t) {
                const float f = l + (1.f - l) * sigmoid_f(bf2f(fcol[t * 128]));
                bi += __logf(f);
                const float q = silu_f(bf2f(qcol[t * 128]));
                qcol[t * 128] = (bf16_t)f2bf(q * __expf(bi - ref));
                fcol[t * 128] = (bf16_t)f2bf((1.f - f) * __expf(ref - bi));
            }
            float* dc = DEC + ((size_t)((b * 4 + h) * 32 + cg * 4 + cl) * 3) * 128 + d;
            dc[0] = __expf(ref); dc[128] = __expf(bi); dc[256] = __expf(bi - ref);
        }
        __syncthreads();
#pragma unroll
        for (int k = 0; k < 16; ++k) { const int i = tid + 512 * k, tl = i >> 12, r = (i >> 4) & 255, ch = i & 15; *(u32x4*)(base + (size_t)r * PW + (tl ? P_QB : P_FB) + ch * 8) = *(const LAS u32x4*)(lds + tl * 65536 + r * 256 + ch * 16); }
    }
}

__device__ __forceinline__ void hgrn_scan(const bf16_t* P, const float* DEC, const float* o_g, bf16_t* CAT, LAS unsigned char* lds, int item) {
    const int tid = otid(), lane = tid & 63, wid = __builtin_amdgcn_readfirstlane(tid >> 6), li = lane & 15, kg = lane >> 4;
    const int b = item >> 2, h = item & 3, it = wid >> 1, vh = wid & 1;
    LAS unsigned char* ST = lds + 98304;
    LAS float* SSQ = (LAS float*)(lds + DSA_BT_OFF);
    const bf16_t* Pb = P + (size_t)b * SEQ * PW;
    const float* DECb = DEC + (size_t)((b * 4 + h) * 32) * 384;
    f32x4 S[8];
#pragma unroll
    for (int vt = 0; vt < 8; ++vt) S[vt] = (f32x4){0.f, 0.f, 0.f, 0.f};
    u32x4 sg[6];
    const int colbase[3] = {P_QB, P_FB, P_IB};
#define HG_LOAD(c) do { _Pragma("unroll") for (int k = 0; k < 6; ++k) { const int n = tid + 512 * k, tl = n >> 10, r = (n >> 4) & 63, ch = n & 15; \
        sg[k] = *(const u32x4*)(Pb + (size_t)((c) * 64 + r) * PW + colbase[tl] + h * 128 + ch * 8); } } while (0)
#define HG_STORE(buf) do { _Pragma("unroll") for (int k = 0; k < 6; ++k) { const int n = tid + 512 * k, tl = n >> 10, r = (n >> 4) & 63, ch = n & 15; \
        *(LAS u32x4*)(lds + (buf) * 49152 + tl * 16384 + off_b(r, ch)) = sg[k]; } } while (0)
    HG_LOAD(0);
    __syncthreads();
    HG_STORE(0);
    const unsigned q4 = (lane & 15) >> 2, p4 = lane & 3;
    f32x4 ogv[4];
#pragma unroll
    for (int vv = 0; vv < 4; ++vv) ogv[vv] = *(const f32x4*)(o_g + 16 * (4 * vh + vv) + 4 * kg);
    float er_next = DECb[16 * wid + li];
#pragma unroll 1
    for (int c = 0; c < 32; ++c) {
        const int buf = c & 1;
        LAS unsigned char* QI = lds + buf * 49152; LAS unsigned char* KI = QI + 16384; LAS unsigned char* VI = QI + 32768;
        if (c + 1 < 32) HG_LOAD(c + 1);
        const float er = er_next, e63 = DECb[c * 384 + 128 + 16 * wid + li], e6r = DECb[c * 384 + 256 + 16 * wid + li];
        er_next = DECb[(c + 1 < 32 ? c + 1 : c) * 384 + 16 * wid + li];
        u32x2 gwv[4];
#pragma unroll
        for (int vv = 0; vv < 4; ++vv) gwv[vv] = *(const u32x2*)(P + ((size_t)b * SEQ + c * 64 + 16 * it + li) * PW + P_GB + h * 128 + 16 * (4 * vh + vv) + 4 * kg);
        { const unsigned d = 16 * wid + li;
#pragma unroll
          for (int vt = 0; vt < 8; ++vt) { u32x2 w; w.x = pk2(S[vt][0] * er, S[vt][1] * er); w.y = pk2(S[vt][2] * er, S[vt][3] * er);
              *(LAS u32x2*)(ST + off_b(d, 2 * vt + (kg >> 1)) + 8 * (kg & 1)) = w; } }
        __syncthreads();
        bf16x8 qf[4];
#pragma unroll
        for (int ks = 0; ks < 4; ++ks) qf[ks] = *(const LAS bf16x8*)(QI + off_b(16 * it + li, 4 * ks + kg));
        f32x4 o[4];
#pragma unroll
        for (int vv = 0; vv < 4; ++vv) o[vv] = (f32x4){0.f, 0.f, 0.f, 0.f};
#pragma unroll
        for (int ks = 0; ks < 4; ++ks)
#pragma unroll
            for (int vv = 0; vv < 4; ++vv) {
                const int ct = 4 * vh + vv;
                const v4i16_t lo4 = __builtin_amdgcn_ds_read_tr16_b64_v4i16((LAS v4i16_t*)(ST + off_b(32 * ks + 8 * kg + q4, 2 * ct + (p4 >> 1)) + 8 * (p4 & 1)));
                const v4i16_t hi4 = __builtin_amdgcn_ds_read_tr16_b64_v4i16((LAS v4i16_t*)(ST + off_b(32 * ks + 8 * kg + 4 + q4, 2 * ct + (p4 >> 1)) + 8 * (p4 & 1)));
                const bf16x8 af = (bf16x8){lo4[0], lo4[1], lo4[2], lo4[3], hi4[0], hi4[1], hi4[2], hi4[3]};
                o[vv] = __builtin_amdgcn_mfma_f32_16x16x32_bf16(af, qf[ks], o[vv], 0, 0, 0);
            }
        const int njb = (it >> 1) + 1;
#pragma unroll
        for (int jb = 0; jb < 2; ++jb) {
            if (jb < njb) {
                f32x4 a0 = (f32x4){0.f, 0.f, 0.f, 0.f}, a1 = (f32x4){0.f, 0.f, 0.f, 0.f};
                const unsigned rw0 = 32 * jb + 8 * (li >> 2) + (li & 3), rw1 = rw0 + 4;
#pragma unroll
                for (int ks = 0; ks < 4; ++ks) {
                    const bf16x8 k0 = *(const LAS bf16x8*)(KI + off_b(rw0, 4 * ks + kg));
                    const bf16x8 k1 = *(const LAS bf16x8*)(KI + off_b(rw1, 4 * ks + kg));
                    a0 = __builtin_amdgcn_mfma_f32_16x16x32_bf16(k0, qf[ks], a0, 0, 0, 0);
                    a1 = __builtin_amdgcn_mfma_f32_16x16x32_bf16(k1, qf[ks], a1, 0, 0, 0);
                }
                const int ii = 16 * it + li, j0 = 32 * jb + 8 * kg;
                float am[8];
#pragma unroll
                for (int e = 0; e < 8; ++e) am[e] = (j0 + e <= ii) ? (e < 4 ? a0[e] : a1[e - 4]) : 0.f;
                u32x4 pw; pw.x = pk2(am[0], am[1]); pw.y = pk2(am[2], am[3]); pw.z = pk2(am[4], am[5]); pw.w = pk2(am[6], am[7]);
                const bf16x8 pb = __builtin_bit_cast(bf16x8, pw);
#pragma unroll
                for (int vv = 0; vv < 4; ++vv) {
                    const int ct = 4 * vh + vv;
                    const v4i16_t lo4 = __builtin_amdgcn_ds_read_tr16_b64_v4i16((LAS v4i16_t*)(VI + off_b(32 * jb + 8 * kg + q4, 2 * ct + (p4 >> 1)) + 8 * (p4 & 1)));
                    const v4i16_t hi4 = __builtin_amdgcn_ds_read_tr16_b64_v4i16((LAS v4i16_t*)(VI + off_b(32 * jb + 8 * kg + 4 + q4, 2 * ct + (p4 >> 1)) + 8 * (p4 & 1)));
                    const bf16x8 af = (bf16x8){lo4[0], lo4[1], lo4[2], lo4[3], hi4[0], hi4[1], hi4[2], hi4[3]};
                    o[vv] = __builtin_amdgcn_mfma_f32_16x16x32_bf16(af, pb, o[vv], 0, 0, 0);
                }
            }
        }
        {
            f32x4 U[8];
#pragma unroll
            for (int vt = 0; vt < 8; ++vt) U[vt] = (f32x4){0.f, 0.f, 0.f, 0.f};
#pragma unroll
            for (int ks = 0; ks < 2; ++ks) {
                const v4i16_t kl = __builtin_amdgcn_ds_read_tr16_b64_v4i16((LAS v4i16_t*)(KI + off_b(32 * ks + 8 * kg + q4, 2 * wid + (p4 >> 1)) + 8 * (p4 & 1)));
                const v4i16_t kh = __builtin_amdgcn_ds_read_tr16_b64_v4i16((LAS v4i16_t*)(KI + off_b(32 * ks + 8 * kg + 4 + q4, 2 * wid + (p4 >> 1)) + 8 * (p4 & 1)));
                const bf16x8 kfr = (bf16x8){kl[0], kl[1], kl[2], kl[3], kh[0], kh[1], kh[2], kh[3]};
#pragma unroll
                for (int vt = 0; vt < 8; ++vt) {
                    const v4i16_t lo4 = __builtin_amdgcn_ds_read_tr16_b64_v4i16((LAS v4i16_t*)(VI + off_b(32 * ks + 8 * kg + q4, 2 * vt + (p4 >> 1)) + 8 * (p4 & 1)));
                    const v4i16_t hi4 = __builtin_amdgcn_ds_read_tr16_b64_v4i16((LAS v4i16_t*)(VI + off_b(32 * ks + 8 * kg + 4 + q4, 2 * vt + (p4 >> 1)) + 8 * (p4 & 1)));
                    const bf16x8 af = (bf16x8){lo4[0], lo4[1], lo4[2], lo4[3], hi4[0], hi4[1], hi4[2], hi4[3]};
                    U[vt] = __builtin_amdgcn_mfma_f32_16x16x32_bf16(af, kfr, U[vt], 0, 0, 0);
                }
            }
#pragma unroll
            for (int vt = 0; vt < 8; ++vt) S[vt] = S[vt] * e63 + U[vt] * e6r;
        }
        float ss = 0.f;
#pragma unroll
        for (int vv = 0; vv < 4; ++vv) ss += (o[vv][0] * o[vv][0] + o[vv][1] * o[vv][1]) + (o[vv][2] * o[vv][2] + o[vv][3] * o[vv][3]);
        ss += __shfl_xor(ss, 16); ss += __shfl_xor(ss, 32);
        if (kg == 0) SSQ[(it * 2 + vh) * 16 + li] = ss;
        __syncthreads();
        if (c + 1 < 32) HG_STORE(buf ^ 1);
        {
            const float tot = SSQ[(it * 2) * 16 + li] + SSQ[(it * 2 + 1) * 16 + li];
            const float rs = rsqrtf(tot * (1.f / 128.f) + EPS);
            const size_t row = (size_t)b * SEQ + c * 64 + 16 * it + li;
#pragma unroll
            for (int vv = 0; vv < 4; ++vv) {
                const int v0 = 16 * (4 * vh + vv) + 4 * kg;
                const u32x2 gw = gwv[vv];
                const f32x4 og = ogv[vv];
                const float g0 = silu_f(bf2f((unsigned short)(gw.x & 0xffffu))), g1 = silu_f(bf2f((unsigned short)(gw.x >> 16))), g2 = silu_f(bf2f((unsigned short)(gw.y & 0xffffu))), g3 = silu_f(bf2f((unsigned short)(gw.y >> 16)));
                u32x2 w; w.x = pk2(o[vv][0] * rs * og.x * g0, o[vv][1] * rs * og.y * g1); w.y = pk2(o[vv][2] * rs * og.z * g2, o[vv][3] * rs * og.w * g3);
                *(u32x2*)(CAT + row * KOUT + 1024 + h * 128 + v0) = w;
            }
        }
    }
#undef HG_LOAD
#undef HG_STORE
}


__device__ __forceinline__ int swap23(int r) { return (r & ~12) | ((r & 4) << 1) | ((r & 8) >> 1); }
__device__ __forceinline__ void xattn_mfma_phase(const bf16_t* Q, const bf16_t* Kb, const bf16_t* VT, bf16_t* O, LAS unsigned char* lds, int vb, int nvb) {
    const int tid = otid(), lane = tid & 63, wid = __builtin_amdgcn_readfirstlane(tid >> 6), r32 = lane & 31, hf = lane >> 5;
    LAS unsigned char* Ks = lds; LAS unsigned char* Vs = lds + 65536;
    int koff[8], voff[8];
    { const int kr = swap23(r32), x = kr & 15, y = r32 & 15;
#pragma unroll
      for (int ks = 0; ks < 8; ++ks) koff[ks] = kr * 256 + (((ks * 2 + hf) ^ x) << 4);
#pragma unroll
      for (int e = 0; e < 8; ++e) voff[e] = r32 * 512 + (((e * 2 + hf) ^ y) << 4); }
    for (int pair = vb; pair < 256; pair += nvb) {
        const int bh = pair >> 2, b = bh >> 2, h = bh & 3;
        __syncthreads();
        int tio = tid; asm volatile("" : "+v"(tio));
        for (int i = tio; i < 4096; i += NTHREADS) { const int key = i >> 4, ch = i & 15;
            const u32x4 v = *(const u32x4*)(Kb + (size_t)(b * MEMT + key) * 512 + h * 128 + ch * 8);
            *(LAS u32x4*)(Ks + key * 256 + ((ch ^ (key & 15)) << 4)) = v; }
        for (int i = tio; i < 4096; i += NTHREADS) { const int d = i >> 5, ch = i & 31;
            const u32x4 v = *(const u32x4*)(VT + (size_t)(h * 128 + d) * MT + b * MEMT + ch * 8);
            *(LAS u32x4*)(Vs + d * 512 + ((ch ^ (d & 15)) << 4)) = v; }
        __syncthreads();
#pragma unroll 1
        for (int qq = 0; qq < 2; ++qq) {
            const size_t q0 = (size_t)b * SEQ + ((pair & 3) * 2 + qq) * 256 + wid * 32;
            bf16x8 qf[8];
#pragma unroll
            for (int ks = 0; ks < 8; ++ks) qf[ks] = *(const bf16x8*)(Q + (q0 + r32) * 512 + h * 128 + ks * 16 + 8 * hf);
            f32x16 st[8];
            __builtin_amdgcn_s_setprio(1);
#pragma unroll
            for (int kt = 0; kt < 8; ++kt) {
#pragma unroll
                for (int r = 0; r < 16; ++r) st[kt][r] = 0.f;
#pragma unroll
                for (int ks = 0; ks < 8; ++ks) {
                    const bf16x8 a = *(const LAS bf16x8*)(Ks + koff[ks] + kt * 8192);
                    st[kt] = __builtin_amdgcn_mfma_f32_32x32x16_bf16(a, qf[ks], st[kt], 0, 0, 0);
                }
            }
            __builtin_amdgcn_s_setprio(0);
            float mx = -INFINITY;
#pragma unroll
            for (int kt = 0; kt < 8; ++kt)
#pragma unroll
                for (int r = 0; r < 16; ++r) mx = fmaxf(mx, st[kt][r]);
            mx = fmaxf(mx, __shfl_xor(mx, 32));
            const float c = 0.08838834764831845f * 1.4426950408889634f;
            float sum = 0.f;
#pragma unroll
            for (int kt = 0; kt < 8; ++kt)
#pragma unroll
                for (int r = 0; r < 16; ++r) { const float e = __builtin_amdgcn_exp2f((st[kt][r] - mx) * c); st[kt][r] = e; sum += e; }
            sum += __shfl_xor(sum, 32);
            const float inv = 1.f / sum;
            bf16x8 pfr[8][2];
#pragma unroll
            for (int kt = 0; kt < 8; ++kt)
#pragma unroll
                for (int s2 = 0; s2 < 2; ++s2) {
                    u32x4 pw;
                    pw.x = pk2(st[kt][8 * s2 + 0], st[kt][8 * s2 + 1]); pw.y = pk2(st[kt][8 * s2 + 2], st[kt][8 * s2 + 3]);
                    pw.z = pk2(st[kt][8 * s2 + 4], st[kt][8 * s2 + 5]); pw.w = pk2(st[kt][8 * s2 + 6], st[kt][8 * s2 + 7]);
                    pfr[kt][s2] = __builtin_bit_cast(bf16x8, pw);
                }
#pragma unroll
            for (int kt = 0; kt < 8; ++kt) asm volatile("" : "+v"(pfr[kt][0]), "+v"(pfr[kt][1]));
            f32x16 o[4];
#pragma unroll
            for (int dt = 0; dt < 4; ++dt)
#pragma unroll
                for (int r = 0; r < 16; ++r) o[dt][r] = 0.f;
            __builtin_amdgcn_s_setprio(1);
#pragma unroll
            for (int kt = 0; kt < 8; ++kt)
#pragma unroll
                for (int s2 = 0; s2 < 2; ++s2)
#pragma unroll
                    for (int dt = 0; dt < 4; ++dt) {
                        const bf16x8 a = *(const LAS bf16x8*)(Vs + voff[(kt & 3) * 2 + s2] + dt * 16384 + (kt >> 2) * 256);
                        o[dt] = __builtin_amdgcn_mfma_f32_32x32x16_bf16(a, pfr[kt][s2], o[dt], 0, 0, 0);
                    }
            __builtin_amdgcn_s_setprio(0);
            bf16_t* orow = O + (q0 + r32) * 512 + h * 128 + 4 * hf;
#pragma unroll
            for (int dt = 0; dt < 4; ++dt)
#pragma unroll
                for (int g = 0; g < 4; ++g) {
                    u32x2 w; w.x = pk2(o[dt][4 * g] * inv, o[dt][4 * g + 1] * inv); w.y = pk2(o[dt][4 * g + 2] * inv, o[dt][4 * g + 3] * inv);
                    *(u32x2*)(orow + dt * 32 + 8 * g) = w;
                }
        }
    }
}


__device__ __forceinline__ void gmlp_mfma_phase(const bf16_t* UV, const float* lnp, const float* ln_g, const float* ln_b, const float* w_sp, const float* b_sp, bf16_t* G, LAS unsigned char* lds, int vb, int nvb) {
    const int tid = otid(), lane = tid & 63, wid = __builtin_amdgcn_readfirstlane(tid >> 6), fr = lane & 15, fq = lane >> 4;
    LAS unsigned char* Wb = lds; LAS unsigned char* VTs = lds + 32768; LAS float* STAT = (LAS float*)(lds + 65536);
    int gcur = -1;
    for (int grp = vb; grp < 256; grp += nvb) {
        const int g = grp >> 5;
        bf16x8 vch[4]; f32x4 lp[2];
#define GM_LOAD(uu_) do { const size_t r0_ = (size_t)((grp & 31) * 8 + (uu_)) * 128; \
            _Pragma("unroll") for (int k = 0; k < 4; ++k) { const int i = tid + 512 * k, sI = i >> 4, ch = i & 15; vch[k] = *(const bf16x8*)(UV + (r0_ + sI) * 2048 + 1024 + g * 128 + ch * 8); } \
            lp[0] = *(const f32x4*)(lnp + (r0_ + (tid >> 2)) * 32 + (tid & 3) * 8); lp[1] = *(const f32x4*)(lnp + (r0_ + (tid >> 2)) * 32 + (tid & 3) * 8 + 4); } while (0)
        GM_LOAD(0);
        const f32x4 g0 = *(const f32x4*)(ln_g + g * 128 + (tid & 15) * 8), g1 = *(const f32x4*)(ln_g + g * 128 + (tid & 15) * 8 + 4);
        const f32x4 b0 = *(const f32x4*)(ln_b + g * 128 + (tid & 15) * 8), b1 = *(const f32x4*)(ln_b + g * 128 + (tid & 15) * 8 + 4);
        const float gg[8] = {g0.x, g0.y, g0.z, g0.w, g1.x, g1.y, g1.z, g1.w}, bb[8] = {b0.x, b0.y, b0.z, b0.w, b1.x, b1.y, b1.z, b1.w};
        __syncthreads();
        if (g != gcur) {
            gcur = g;
            for (int i = tid; i < 2048; i += NTHREADS) { const int t = i >> 4, ch = i & 15;
                const f32x4 a = *(const f32x4*)(w_sp + (size_t)g * 16384 + t * 128 + ch * 8), b = *(const f32x4*)(w_sp + (size_t)g * 16384 + t * 128 + ch * 8 + 4);
                const int s0 = ch * 8;
                u32x4 w; w.x = pk2(s0 + 0 <= t ? a.x : 0.f, s0 + 1 <= t ? a.y : 0.f); w.y = pk2(s0 + 2 <= t ? a.z : 0.f, s0 + 3 <= t ? a.w : 0.f);
                w.z = pk2(s0 + 4 <= t ? b.x : 0.f, s0 + 5 <= t ? b.y : 0.f); w.w = pk2(s0 + 6 <= t ? b.z : 0.f, s0 + 7 <= t ? b.w : 0.f);
                *(LAS u32x4*)(Wb + t * 256 + ((ch ^ (t & 15)) << 4)) = w; }
        }
        const int trow = wid * 16 + fr;
        const float bias = b_sp[g * 128 + trow];
#pragma unroll 1
        for (int uu = 0; uu < 8; ++uu) {
            const int bn = (grp & 31) * 8 + uu;
            const size_t row0 = (size_t)bn * 128;
            if (uu) __syncthreads();
            { float s1 = (lp[0].x + lp[0].z) + (lp[1].x + lp[1].z), s2 = (lp[0].y + lp[0].w) + (lp[1].y + lp[1].w);
              s1 += __shfl_xor(s1, 1); s2 += __shfl_xor(s2, 1); s1 += __shfl_xor(s1, 2); s2 += __shfl_xor(s2, 2);
              const float mu = s1 * (1.f / 1024.f), var = fmaxf(s2 * (1.f / 1024.f) - mu * mu, 0.f);
              if ((tid & 3) == 0) { STAT[2 * (tid >> 2)] = mu; STAT[2 * (tid >> 2) + 1] = rsqrtf(var + EPS); } }
            __syncthreads();
#pragma unroll
            for (int k = 0; k < 4; ++k) { const int i = tid + 512 * k, sI = i >> 4, ch = i & 15;
                const float mu = STAT[2 * sI], rs = STAT[2 * sI + 1];
#pragma unroll
                for (int e = 0; e < 8; ++e) { const int c = ch * 8 + e; const float x = (bf2f((unsigned short)vch[k][e]) - mu) * rs * gg[e] + bb[e];
                    *(LAS bf16_t*)(VTs + c * 256 + (((sI >> 3) ^ ((c ^ (c >> 3)) & 15)) << 4) + (sI & 7) * 2) = (bf16_t)f2bf(x); } }
            if (uu + 1 < 8) GM_LOAD(uu + 1);
            const size_t orow = row0 + trow;
            u32x2 uwv[8];
#pragma unroll
            for (int ct = 0; ct < 8; ++ct) uwv[ct] = *(const u32x2*)(UV + orow * 2048 + g * 128 + ct * 16 + 4 * fq);
            __syncthreads();
            f32x4 acc[8];
#pragma unroll
            for (int ct = 0; ct < 8; ++ct) acc[ct] = (f32x4){0.f, 0.f, 0.f, 0.f};
#pragma unroll
            for (int ks = 0; ks < 4; ++ks) {
                const bf16x8 wf = *(const LAS bf16x8*)(Wb + trow * 256 + (((ks * 4 + fq) ^ (trow & 15)) << 4));
#pragma unroll
                for (int ct = 0; ct < 8; ++ct) {
                    const int crow = ct * 16 + fr;
                    const bf16x8 vf = *(const LAS bf16x8*)(VTs + crow * 256 + (((ks * 4 + fq) ^ ((crow ^ (crow >> 3)) & 15)) << 4));
                    acc[ct] = __builtin_amdgcn_mfma_f32_16x16x32_bf16(vf, wf, acc[ct], 0, 0, 0);
                }
            }
#pragma unroll
            for (int ct = 0; ct < 8; ++ct) {
                const int c = ct * 16 + 4 * fq;
                const u32x2 uw = uwv[ct];
                const float u0 = bf2f((unsigned short)(uw.x & 0xffffu)), u1 = bf2f((unsigned short)(uw.x >> 16)), u2 = bf2f((unsigned short)(uw.y & 0xffffu)), u3 = bf2f((unsigned short)(uw.y >> 16));
                u32x2 w; w.x = pk2(u0 * (acc[ct][0] + bias), u1 * (acc[ct][1] + bias)); w.y = pk2(u2 * (acc[ct][2] + bias), u3 * (acc[ct][3] + bias));
                *(u32x2*)(G + orow * 1024 + g * 128 + c) = w;
            }
        }
#undef GM_LOAD
    }
}

#define GAS __attribute__((address_space(1)))
typedef GAS unsigned gu32;
#define XB_TMO      128
#define XB_XCNT(j)  (256  + 64 * (j))
#define XB_XSUB(j)  (1280 + 64 * (j))
#define XB_XGEN(j)  (2304 + 64 * (j))
#define XB_TOP      3328
#define XB_TOPGEN   3392
#define XCD_BAR_WORDS 3456
#define XB_SPIN_CAP (1u << 18)

__device__ __forceinline__ unsigned xb_ld(unsigned* p)              { return __hip_atomic_load(p, __ATOMIC_RELAXED, __HIP_MEMORY_SCOPE_AGENT); }
__device__ __forceinline__ unsigned xb_add(unsigned* p, unsigned v) { return __hip_atomic_fetch_add(p, v, __ATOMIC_RELAXED, __HIP_MEMORY_SCOPE_AGENT); }
__device__ __forceinline__ unsigned xb_xcc_id() { return (unsigned)__builtin_amdgcn_s_getreg((3 << 11) | 20) & 0xFu; }
#define XB_SPIN(cond, bar) do { unsigned _sp = 0; while (cond) { __builtin_amdgcn_s_sleep(1); \
    if ((++_sp & 255u) == 0u) { if (xb_ld(&(bar)[XB_TMO])) break; if (_sp > XB_SPIN_CAP) { atomicAdd(&(bar)[XB_TMO], 1u); break; } } } } while (0)

struct XcdBarrier {
    unsigned* bar; unsigned x;
    volatile LAS unsigned* st;
};

__device__ __forceinline__ XcdBarrier xcd_barrier_post(unsigned* bar, volatile LAS unsigned* st) {
    XcdBarrier b; b.bar = bar; b.x = xb_xcc_id(); b.st = st;
    if (threadIdx.x == 0) (void)xb_add(&bar[XB_XCNT(b.x)], 1u);
    return b;
}
__device__ __forceinline__ void xcd_barrier_complete(unsigned* bar, unsigned x, unsigned& nloc, unsigned& nx) {
    const unsigned G = gridDim.x * gridDim.y * gridDim.z;
    unsigned sum, cnt, mine, sp = 0u;
    for (;;) {
        sum = 0u; cnt = 0u; mine = 0u;
#pragma unroll
        for (unsigned j = 0; j < 16; ++j) { const unsigned c = xb_ld(&bar[XB_XCNT(j)]); sum += c; cnt += (c > 0u) ? 1u : 0u; mine = (j == x) ? c : mine; }
        if (sum == G) break;
        __builtin_amdgcn_s_sleep(1);
        if ((++sp & 255u) == 0u) { if (xb_ld(&bar[XB_TMO])) break; if (sp > XB_SPIN_CAP) { atomicAdd(&bar[XB_TMO], 1u); break; } }
    }
    nloc = mine > 0u ? mine : 1u; nx = cnt > 0u ? cnt : 1u;
}

__device__ __forceinline__ void xcd_barrier(const XcdBarrier& b) {
    asm volatile("s_waitcnt vmcnt(0)" ::: "memory");
    __syncthreads();
    if (threadIdx.x == 0) {
        unsigned* bar = b.bar;
        __builtin_amdgcn_s_waitcnt(0);
        unsigned nloc = b.st[0], nx = b.st[1];
        if (nloc == 0u) { xcd_barrier_complete(bar, b.x, nloc, nx); b.st[0] = nloc; b.st[1] = nx; }
        const unsigned old = xb_add(&bar[XB_XSUB(b.x)], 1u);
        const unsigned gen = old / nloc;
        if (old + 1u == (gen + 1u) * nloc) {
            __builtin_amdgcn_fence(__ATOMIC_RELEASE, "agent");
            asm volatile("s_waitcnt vmcnt(0)" ::: "memory");
            const unsigned og = xb_add(&bar[XB_TOP], 1u);
            const unsigned tg = og / nx;
            if (og + 1u == (tg + 1u) * nx) xb_add(&bar[XB_TOPGEN], 1u);
            else XB_SPIN(xb_ld(&bar[XB_TOPGEN]) == tg, bar);
            __builtin_amdgcn_fence(__ATOMIC_ACQUIRE, "agent");
            xb_add(&bar[XB_XGEN(b.x)], 1u);
            asm volatile("s_waitcnt vmcnt(0)" ::: "memory");
        } else {
            XB_SPIN(xb_ld(&bar[XB_XGEN(b.x)]) == gen, bar);
            __builtin_amdgcn_fence(__ATOMIC_ACQUIRE, "agent");
            asm volatile("s_waitcnt vmcnt(0)" ::: "memory");
        }
    }
    __syncthreads();
}

constexpr int LDS_BYTES = 32768 * 4 + 256 + 6144 + 8 * 2560;

enum Phase {
    PH_PREP = 0, PH_GEMM_IN, PH_CNORM, PH_MIX0  , PH_GEMM_OUT0,
    PH_GEMM_Q0, PH_XATTN0, PH_GEMM_O0, PH_GEMM_GU0, PH_GEMM_DN0,
    PH_GEMM_OIN, PH_GMLP, PH_GEMM_OOUT,
    PH_GEMM_Q1, PH_XATTN1, PH_GEMM_O1, PH_GEMM_GU1, PH_GEMM_DN1, PH_FINAL, PH_COUNT
};

__device__ __forceinline__ PrepJob make_job(const Params& p, int ji) {
    unsigned char* ws = p.ws; PrepJob j{};
    switch (ji) {
    case 0: j = PrepJob{p.in[5], 1024, 3272, p.in[4], (bf16_t*)(ws + WS_WIN), 1024, PW, 1024, 0, MAP_WIN}; break;
    case 1: j = PrepJob{p.in[10] + (size_t)512 * 1024, 512, 1024, nullptr, (bf16_t*)(ws + WS_WOUT), 0, 1024, KOUT, 1024, MAP_ID}; break;
    case 2: j = PrepJob{p.in[11], 1024, 2048, p.in[4] + 1024, (bf16_t*)(ws + WS_OWIN), 0, 2048, 1024, 0, MAP_ID}; break;
    case 3: j = PrepJob{p.in[16], 1024, 1024, nullptr, (bf16_t*)(ws + WS_OWOUT), 0, 1024, 1024, 0, MAP_ID}; break;
    case 4: case 5: { const int l = ji - 4; j = PrepJob{p.in[19] + (size_t)l * 1024 * 512, 1024, 512, p.in[17] + l * 1024, (bf16_t*)(ws + WS_WQ) + (size_t)l * 512 * 1024, 0, 512, 1024, 0, MAP_ID}; } break;
    case 6: case 7: { const int l = ji - 6; j = PrepJob{p.in[20] + (size_t)l * 1024 * 1024, 1024, 1024, p.in[18] + l * 1024, (bf16_t*)(ws + WS_WKV) + (size_t)l * 1024 * 1024, 0, 1024, 1024, 0, MAP_ID}; } break;
    case 8: case 9: { const int l = ji - 8; j = PrepJob{p.in[21] + (size_t)l * 512 * 1024, 512, 1024, nullptr, (bf16_t*)(ws + WS_WO) + (size_t)l * 1024 * 512, 0, 1024, 512, 0, MAP_ID}; } break;
    case 10: case 11: { const int l = ji - 10; j = PrepJob{p.in[23] + (size_t)l * 1024 * 2 * FF, 1024, 2 * FF, p.in[22] + l * 1024, (bf16_t*)(ws + WS_WGU) + (size_t)l * 2 * FF * 1024, 0, 2 * FF, 1024, 0, MAP_GU}; } break;
    default: { const int l = ji - 12; j = PrepJob{p.in[24] + (size_t)l * FF * 1024, FF, 1024, nullptr, (bf16_t*)(ws + WS_WDN + (size_t)l * 1024 * FF), 0, 1024, FF, 0, MAP_ID8}; } break;
    }
    return j;
}
constexpr int N_PREP_JOBS = 14;

template <int ph> __device__ __forceinline__ void run_phase(const Params& p, LAS float* lds, int vb, int nvb) {
    unsigned char* ws = p.ws;
    bf16_t* HN = (bf16_t*)(ws + WS_HN); bf16_t* BIG = (bf16_t*)(ws + WS_BIG); bf16_t* CN = (bf16_t*)(ws + WS_CN); bf16_t* CAT = (bf16_t*)(ws + WS_CAT);
    bf16_t* KB = (bf16_t*)(ws + WS_KB); bf16_t* VTB = (bf16_t*)(ws + WS_VT); bf16_t* MEMN = (bf16_t*)(ws + WS_MEMN); float* lb = (float*)(ws + WS_LB);
    float* ssq = (float*)(ws + WS_SSQ); float* lnp = (float*)(ws + WS_LNP);
    bf16_t* XQ = BIG; bf16_t* XO = BIG + (size_t)T * 512;
    const int l = (ph >= PH_GEMM_Q1) ? 1 : 0;
    switch (ph) {
    case PH_PREP:
        x_to_h_rows(p.in[0], HN, ssq, vb, nvb);
        {
            constexpr int NT_[N_PREP_JOBS] = {16 * 11, 8 * 4, 16 * 8, 16 * 4, 16 * 2, 16 * 2, 16 * 4, 16 * 4, 8 * 4, 8 * 4, 16 * 22, 16 * 22, 44 * 4, 44 * 4};
            constexpr int CUM1 = NT_[0], CUM2 = CUM1 + NT_[1], CUM3 = CUM2 + NT_[2], CUM4 = CUM3 + NT_[3], CUM5 = CUM4 + NT_[4], CUM6 = CUM5 + NT_[5], CUM7 = CUM6 + NT_[6],
                          CUM8 = CUM7 + NT_[7], CUM9 = CUM8 + NT_[8], CUM10 = CUM9 + NT_[9], CUM11 = CUM10 + NT_[10], CUM12 = CUM11 + NT_[11], CUM13 = CUM12 + NT_[12], CUM14 = CUM13 + NT_[13];
#define PJ_FIND(it_, ji_, base_) do { ji_ = 0; base_ = 0; \
                PJ_STEP(it_, ji_, base_, 1, CUM1) PJ_STEP(it_, ji_, base_, 2, CUM2) PJ_STEP(it_, ji_, base_, 3, CUM3) PJ_STEP(it_, ji_, base_, 4, CUM4) PJ_STEP(it_, ji_, base_, 5, CUM5) PJ_STEP(it_, ji_, base_, 6, CUM6) PJ_STEP(it_, ji_, base_, 7, CUM7) \
                PJ_STEP(it_, ji_, base_, 8, CUM8) PJ_STEP(it_, ji_, base_, 9, CUM9) PJ_STEP(it_, ji_, base_, 10, CUM10) PJ_STEP(it_, ji_, base_, 11, CUM11) PJ_STEP(it_, ji_, base_, 12, CUM12) PJ_STEP(it_, ji_, base_, 13, CUM13) } while (0)
#define PJ_STEP(it_, ji_, base_, q, c) if ((it_) >= (c)) { ji_ = (q); base_ = (c); }
            f32x4 va[8], vn[8];
            int ji, base;
            if (vb < CUM14) { PJ_FIND(vb, ji, base); const PrepJob j = make_job(p, ji); prep_tile_load(j, vb - base, va); }
            for (int it = vb; it < CUM14; it += nvb) {
                PJ_FIND(it, ji, base);
                const PrepJob j = make_job(p, ji); const int tl = it - base;
                if (it + nvb < CUM14) { int jn, bn; PJ_FIND(it + nvb, jn, bn); const PrepJob j2 = make_job(p, jn); prep_tile_load(j2, it + nvb - bn, vn); }
                prep_tile_store(j, tl, va, lds);
#pragma unroll
                for (int q = 0; q < 8; ++q) va[q] = vn[q];
            }
#undef PJ_STEP
#undef PJ_FIND
        }
        prep_fold_in(p.in[5], p.in[7], p.in[4], (bf16_t*)(ws + WS_WIN), lds, vb, nvb);
        prep_fold_out(p.in[10], p.in[8], (bf16_t*)(ws + WS_WOUT), lds, vb, nvb);
        prep_lb(p.in[3], lb, vb, nvb);
        rmsnorm_rows(p.in[1], MEMN, MT, vb, nvb);
        break;
    case PH_GEMM_IN: {
        Gemm g{(const bf16_t*)(ws + WS_WIN), (const bf16_t*)(ws + WS_WIN), T, PW, 1024}; EpiIn E{BIG, KB, VTB, ssq};
        pg8::ComboOrder S; S.init(nvb, vb);
        pg8::gemm_phase<EpiIn, pg8::ComboOrder, true, true>((LAS unsigned char*)lds, g, S, E);
    } break;
    case PH_CNORM: cnorm_rows(BIG, p.in[6], CN, vb, nvb); hgrn_prep(BIG, lb, (float*)(ws + WS_DEC), (LAS unsigned char*)lds, vb, nvb); break;
    case PH_MIX0:
        for (int item = vb; item < 64; item += nvb) hgrn_scan(BIG, (const float*)(ws + WS_DEC), p.in[9], CAT, (LAS unsigned char*)lds, item);
        dsa_mfma_phase(BIG, CN, p.in[2], CAT, (LAS unsigned char*)lds, (unsigned*)(ws + WS_CTL) + 3600);
        break;
    case PH_GEMM_OUT0: { Gemm g{CAT, (const bf16_t*)(ws + WS_WOUT), T, 1024, KOUT}; EpiResid<false> E{nullptr, HN, ssq}; run_gemm(g, E, lds, vb, nvb); } break;
    case PH_GEMM_Q0: case PH_GEMM_Q1: { Gemm g{HN, (const bf16_t*)(ws + WS_WQ) + (size_t)l * 512 * 1024, T, 512, 1024}; EpiStoreBf16 E{XQ, 512, ssq}; run_gemm(g, E, lds, vb, nvb); } break;
    case PH_XATTN0: case PH_XATTN1: xattn_mfma_phase(XQ, KB + (size_t)l * MT * 512, VTB + (size_t)l * 512 * MT, XO, (LAS unsigned char*)lds, vb, nvb); break;
    case PH_GEMM_O0: case PH_GEMM_O1: { Gemm g{XO, (const bf16_t*)(ws + WS_WO) + (size_t)l * 1024 * 512, T, 1024, 512}; EpiResid<false> E{nullptr, HN, ssq}; run_gemm(g, E, lds, vb, nvb); } break;
    case PH_GEMM_GU0: case PH_GEMM_GU1: { Gemm g{HN, (const bf16_t*)(ws + WS_WGU) + (size_t)l * 2 * FF * 1024, T, 2 * FF, 1024}; EpiSwigluFp8 E{(unsigned char*)BIG, FF, ssq}; run_gemm(g, E, lds, vb, nvb); } break;
    case PH_GEMM_DN0: case PH_GEMM_DN1: { Gemm g{BIG, (const bf16_t*)(ws + WS_WDN + (size_t)l * 1024 * FF), T, 1024, FF / 2}; EpiResid<false, true> E{nullptr, HN, ssq}; run_gemm<EpiResid<false, true>, true>(g, E, lds, vb, nvb); } break;
    case PH_GEMM_OIN: { Gemm g{HN, (const bf16_t*)(ws + WS_OWIN), T, 2048, 1024}; EpiGeluBf16 E{BIG, 2048, ssq, lnp}; run_gemm(g, E, lds, vb, nvb); } break;
    case PH_GMLP: gmlp_mfma_phase(BIG, lnp, p.in[12], p.in[13], p.in[14], p.in[15], CAT, (LAS unsigned char*)lds, vb, nvb); break;
    case PH_GEMM_OOUT: { Gemm g{CAT, (const bf16_t*)(ws + WS_OWOUT), T, 1024, 1024}; EpiResid<false> E{nullptr, HN, ssq}; run_gemm(g, E, lds, vb, nvb); } break;
    case PH_FINAL: final_rows(HN, ssq, p.in[25], p.out, vb, nvb); break;
    default: break;
    }
}

template <int PH> __global__ void __launch_bounds__(NTHREADS) k_phase(Params p) {
    extern __shared__ __attribute__((aligned(16))) float smem[];
    run_phase<PH>(p, (LAS float*)smem, blockIdx.x, gridDim.x);
}

template <int PH> __device__ __forceinline__ void mega_phases(const Params& p, LAS float* lds, const XcdBarrier& bar) {
    run_phase<PH>(p, lds, blockIdx.x, gridDim.x);
#ifdef REPEAT_PH
    if constexpr (PH == REPEAT_PH) { xcd_barrier(bar); run_phase<PH>(p, lds, blockIdx.x, gridDim.x); }
#endif
    if constexpr (PH + 1 < PH_COUNT) { xcd_barrier(bar); mega_phases<PH + 1>(p, lds, bar); }
}
__global__ void __launch_bounds__(NTHREADS) k_mega(Params p) {
    extern __shared__ __attribute__((aligned(16))) float smem[];
    volatile LAS unsigned* st = (volatile LAS unsigned*)((LAS float*)smem + 32768);
    if (threadIdx.x < 2) st[threadIdx.x] = 0u;
    __syncthreads();
    const XcdBarrier bar = xcd_barrier_post((unsigned*)(p.ws + WS_CTL), st);
    mega_phases<0>(p, (LAS float*)smem, bar);
}

template <int PH> static void launch_phases(const Params& p, int grid, hipStream_t stream) {
    int g = grid * 4;
    if (PH == PH_MIX0 || PH == PH_XATTN0 || PH == PH_XATTN1 || PH == PH_GMLP) g = grid;
    (void)hipFuncSetAttribute((const void*)k_phase<PH>, hipFuncAttributeMaxDynamicSharedMemorySize, LDS_BYTES);
    hipLaunchKernelGGL(k_phase<PH>, dim3(g), dim3(NTHREADS), LDS_BYTES, stream, p);
    if constexpr (PH + 1 < PH_COUNT) launch_phases<PH + 1>(p, grid, stream);
}

extern "C" void kernel_launch(void* const* d_in, const int* in_sizes, int n_in, void* d_out, int out_size, void* d_ws, size_t ws_size, hipStream_t stream) {
    static int grid = 0;
    if (grid == 0) {
        if (n_in != 26 || out_size != T * D || ws_size < WS_END) { fprintf(stderr, "kernel_launch: unexpected shapes (n_in %d out %d ws %zu)\n", n_in, out_size, ws_size); grid = -1; return; }
        int dev = 0, cus = 0;
        (void)hipGetDevice(&dev); (void)hipDeviceGetAttribute(&cus, hipDeviceAttributeMultiprocessorCount, dev);
        (void)hipFuncSetAttribute((const void*)k_mega, hipFuncAttributeMaxDynamicSharedMemorySize, LDS_BYTES);
        int per_cu = 0;
        (void)hipOccupancyMaxActiveBlocksPerMultiprocessor(&per_cu, (const void*)k_mega, NTHREADS, LDS_BYTES);
        if (per_cu < 1) fprintf(stderr, "kernel_launch: occupancy query says %d blocks per CU\n", per_cu);
        (void)hipGetLastError();
        grid = cus > 0 ? cus : 256;
    }
    if (grid < 0) return;
    Params p{};
    for (int i = 0; i < 26; ++i) p.in[i] = (const float*)d_in[i];
    p.out = (float*)d_out; p.ws = (unsigned char*)d_ws;
    (void)hipMemsetAsync((char*)d_ws + WS_CTL, 0, 16384, stream);
#if MEGA
    hipLaunchKernelGGL(k_mega, dim3(grid), dim3(NTHREADS), LDS_BYTES, stream, p);
#else
    launch_phases<0>(p, grid, stream);
#endif
}
```

```cpp
#include <hip/hip_runtime.h>
#include <stdint.h>
#include <stdio.h>

#ifndef MEGA
#define MEGA 1
#endif
#ifndef DN_FP8
#define DN_FP8 0
#endif

#define LAS __attribute__((address_space(3)))
typedef unsigned short bf16_t;
typedef short bf16x8 __attribute__((ext_vector_type(8)));
typedef float f32x4 __attribute__((ext_vector_type(4)));
typedef float f32x2 __attribute__((ext_vector_type(2)));
typedef unsigned u32x4 __attribute__((ext_vector_type(4)));
typedef unsigned u32x2 __attribute__((ext_vector_type(2)));
typedef float f32x16 __attribute__((ext_vector_type(16)));

constexpr int D = 1024, BATCH = 16, SEQ = 2048, T = BATCH * SEQ;
constexpr int CHUNK = 64;
constexpr int MEMT = 256, MT = BATCH * MEMT;
constexpr int FF = 2816;
constexpr float EPS = 1e-6f;
constexpr int NTHREADS = 512, NWAVES = 8;

constexpr int P_QL = 0, P_C = 1024, P_QI = 1152, P_KI = 1664, P_FB = 1728, P_IB = 2240, P_QB = 2752, P_GB = 3264, P_WI = 3776, P_END = 3784, PW = 3840;
constexpr int KOUT = 1536;

constexpr size_t MiB = 1u << 20;
constexpr size_t WS_CTL = 0;
constexpr size_t WS_LB = 64 * 1024;
constexpr size_t WS_SSQ = 496 * MiB;
constexpr size_t WS_LNP = 498 * MiB;
constexpr size_t WS_WIN = 1 * MiB;
constexpr size_t WS_WKV = WS_WIN + (size_t)PW * D * 2;
constexpr size_t WS_HN = WS_WKV + 2 * (size_t)D * D * 2;
constexpr size_t WS_MEMN = WS_HN + (size_t)T * D * 2;
constexpr size_t WS_WOUT = WS_MEMN + (size_t)MT * D * 2;
constexpr size_t WS_OWIN = WS_WOUT + (size_t)D * KOUT * 2;
constexpr size_t WS_OWOUT = WS_OWIN + (size_t)2048 * D * 2;
constexpr size_t WS_WQ = WS_OWOUT + (size_t)D * D * 2;
constexpr size_t WS_WO = WS_WQ + 2 * (size_t)512 * D * 2;
constexpr size_t WS_WGU = WS_WO + 2 * (size_t)D * 512 * 2;
constexpr size_t WS_WDN = WS_WGU + 2 * (size_t)2 * FF * D * 2;
constexpr size_t WS_WEND = WS_WDN + 2 * (size_t)D * FF * 2;
constexpr int TILE_WIN = 0, TILE_WKV = PW / 256, TILE_HN = TILE_WKV + 8, TILE_MEMN = TILE_HN + T / 256;
constexpr size_t WS_BIG = 132 * MiB;
constexpr size_t WS_CN = 372 * MiB;
constexpr size_t WS_CAT = 380 * MiB;
constexpr size_t WS_H8 = WS_CAT + 64 * MiB;
constexpr size_t WS_KB = 476 * MiB;
constexpr size_t WS_VT = 484 * MiB;
constexpr size_t WS_END = 502 * MiB;
static_assert(WS_WEND <= WS_BIG, "weights fit below BIG");

struct Params {
    const float* in[26];
    float* out;
    unsigned char* ws;
};

__device__ __forceinline__ float bf2f(unsigned short u) { return __uint_as_float(((unsigned)u) << 16); }
__device__ __forceinline__ unsigned f2bf(float f) { unsigned u = __float_as_uint(f); return (u + 0x7fffu + ((u >> 16) & 1u)) >> 16; }
typedef __bf16 bf16x2_t __attribute__((ext_vector_type(2)));
__device__ __forceinline__ unsigned pk2(float lo, float hi) { const f32x2 v = {lo, hi}; return __builtin_bit_cast(unsigned, __builtin_convertvector(v, bf16x2_t)); }
__device__ __forceinline__ float wave_sum(float v) {
#pragma unroll
    for (int o = 1; o < 64; o <<= 1) v += __shfl_xor(v, o);
    return v;
}
__device__ __forceinline__ float wave_max(float v) {
#pragma unroll
    for (int o = 1; o < 64; o <<= 1) v = fmaxf(v, __shfl_xor(v, o));
    return v;
}
__device__ __forceinline__ int otid() { int t = threadIdx.x; asm volatile("" : "+v"(t)); return t; }
#define WAVE_LDS_SYNC() asm volatile("s_waitcnt lgkmcnt(0)" ::: "memory")
__device__ __forceinline__ float silu_f(float x) { return x * __builtin_amdgcn_rcpf(1.f + __expf(-x)); }
__device__ __forceinline__ float sigmoid_f(float x) { return __builtin_amdgcn_rcpf(1.f + __expf(-x)); }

typedef int i32x4v __attribute__((ext_vector_type(4)));
typedef int i32x8v __attribute__((ext_vector_type(8)));
__device__ __forceinline__ unsigned pk4_f8(float a, float b, float c, float d) {
    a = __builtin_amdgcn_fmed3f(a, -448.f, 448.f); b = __builtin_amdgcn_fmed3f(b, -448.f, 448.f); c = __builtin_amdgcn_fmed3f(c, -448.f, 448.f); d = __builtin_amdgcn_fmed3f(d, -448.f, 448.f);
    int w = 0;
    w = __builtin_amdgcn_cvt_pk_fp8_f32(a, b, w, false);
    w = __builtin_amdgcn_cvt_pk_fp8_f32(c, d, w, true);
    return (unsigned)w;
}
constexpr float ACT_SC = 8.f, WDN_SC = 256.f, DN_UNSC = 1.f / (ACT_SC * WDN_SC);
constexpr float HQ_GU0 = 127.f / 8.f, HQ_GU1 = 127.f / 10.f, WQ_GU = 127.f / 0.17f;
__device__ __forceinline__ unsigned pk4_i8(float a, float b, float c, float d) {
    a = __builtin_amdgcn_fmed3f(__builtin_rintf(a) + 128.f, 1.f, 255.f); b = __builtin_amdgcn_fmed3f(__builtin_rintf(b) + 128.f, 1.f, 255.f);
    c = __builtin_amdgcn_fmed3f(__builtin_rintf(c) + 128.f, 1.f, 255.f); d = __builtin_amdgcn_fmed3f(__builtin_rintf(d) + 128.f, 1.f, 255.f);
    unsigned w = 0;
    w = __builtin_amdgcn_cvt_pk_u8_f32(a, 0, w); w = __builtin_amdgcn_cvt_pk_u8_f32(b, 1, w); w = __builtin_amdgcn_cvt_pk_u8_f32(c, 2, w); w = __builtin_amdgcn_cvt_pk_u8_f32(d, 3, w);
    return w ^ 0x80808080u;
}
__device__ __forceinline__ f32x4 i2f4(f32x4 v) { const i32x4v t = __builtin_bit_cast(i32x4v, v); return (f32x4){(float)t.x, (float)t.y, (float)t.z, (float)t.w}; }
struct Unit { int pm, pn; };
struct Gemm { const bf16_t* A; const bf16_t* Bt; int M, N, K; };
__device__ __forceinline__ int perm32(int rho) { const int n = rho >> 4, i = rho & 15; return 8 * (i >> 2) + 4 * n + (i & 3); }

__device__ __forceinline__ float row_rstd(const float* ssq, size_t row) {
    const f32x4* p = (const f32x4*)(ssq + row * 16);
    const f32x4 a = p[0], b = p[1], c = p[2], d = p[3];
    const float t = (((a.x + a.y) + (a.z + a.w)) + ((b.x + b.y) + (b.z + b.w))) + (((c.x + c.y) + (c.z + c.w)) + ((d.x + d.y) + (d.z + d.w)));
    return rsqrtf(t * (1.f / 1024.f) + EPS);
}
__device__ __forceinline__ void rows_rstd(const float* ssq, size_t row0, int fq, float (&rs)[2][4]) {
#pragma unroll
    for (int ai = 0; ai < 2; ++ai)
#pragma unroll
        for (int m = 0; m < 4; ++m) { const f32x4 a = *(const f32x4*)(ssq + (row0 + ai * 128 + m * 16) * 16 + 4 * fq); rs[ai][m] = (a.x + a.y) + (a.z + a.w); }
#pragma unroll
    for (int ai = 0; ai < 2; ++ai)
#pragma unroll
        for (int m = 0; m < 4; ++m) { float t = rs[ai][m]; t += __shfl_xor(t, 16); t += __shfl_xor(t, 32); rs[ai][m] = rsqrtf(t * (1.f / 1024.f) + EPS); }
}
struct EpiStoreBf16 {
    static constexpr bool PERM = true, AFTER_DRAIN = false;
    bf16_t* O; int ldc; const float* ssq;
    __device__ __forceinline__ void operator()(const f32x4 (&acc)[2][2][4][2], const Unit& u, int wr, int wc, int fr, int fq) const {
        const int row0 = u.pm * 256 + wr * 64 + fr, col0 = u.pn * 256 + wc * 32 + 8 * fq;
        float rsv[2][4]; rows_rstd(ssq, (size_t)row0, fq, rsv);
#pragma unroll
        for (int ai = 0; ai < 2; ++ai)
#pragma unroll
            for (int m = 0; m < 4; ++m) {
                const float rs = rsv[ai][m];
                bf16_t* rowp = O + (size_t)(row0 + ai * 128 + m * 16) * ldc + col0;
#pragma unroll
                for (int bj = 0; bj < 2; ++bj) {
                    const f32x4 v0 = acc[ai][bj][m][0] * rs, v1 = acc[ai][bj][m][1] * rs;
                    u32x4 w; w.x = pk2(v0[0], v0[1]); w.y = pk2(v0[2], v0[3]); w.z = pk2(v1[0], v1[1]); w.w = pk2(v1[2], v1[3]);
                    *(u32x4*)(rowp + bj * 128) = w;
                }
            }
    }
};
struct EpiIn {
    static constexpr bool PERM = true, AFTER_DRAIN = false;
    bf16_t* P; bf16_t* KB; bf16_t* VT; const float* ssq;
    __device__ __forceinline__ void operator()(const f32x4 (&acc)[2][2][4][2], const Unit& u, int wr, int wc, int fr, int fq) const {
        bf16_t* O; int ldc, rt, ct; const bool main_unit = u.pn < TILE_WKV;
        if (main_unit) { O = P; ldc = PW; rt = u.pm - TILE_HN; ct = u.pn; }
        else if (u.pm >= TILE_MEMN) { const int l = (u.pn - TILE_WKV) >> 2; O = KB + (size_t)l * MT * 512; ldc = 512; rt = u.pm - TILE_MEMN; ct = (u.pn - TILE_WKV) & 3; }
        else { const int l = (u.pm - TILE_WKV) >> 2; O = VT + (size_t)l * 512 * MT; ldc = MT; rt = ((u.pm - TILE_WKV) & 3) - 2; ct = u.pn - TILE_MEMN; }
        const int row0 = rt * 256 + wr * 64 + fr, col0 = ct * 256 + wc * 32 + 8 * fq;
        float rsv[2][4];
        if (main_unit) rows_rstd(ssq, (size_t)row0, fq, rsv);
        else {
#pragma unroll
            for (int ai = 0; ai < 2; ++ai)
#pragma unroll
                for (int m = 0; m < 4; ++m) rsv[ai][m] = 1.f; }
#pragma unroll
        for (int ai = 0; ai < 2; ++ai)
#pragma unroll
            for (int m = 0; m < 4; ++m) {
                const float rs = rsv[ai][m];
                bf16_t* rowp = O + (size_t)(row0 + ai * 128 + m * 16) * ldc + col0;
#pragma unroll
                for (int bj = 0; bj < 2; ++bj) {
                    const f32x4 v0 = acc[ai][bj][m][0] * rs, v1 = acc[ai][bj][m][1] * rs;
                    u32x4 w; w.x = pk2(v0[0], v0[1]); w.y = pk2(v0[2], v0[3]); w.z = pk2(v1[0], v1[1]); w.w = pk2(v1[2], v1[3]);
                    *(u32x4*)(rowp + bj * 128) = w;
                }
            }
    }
};
struct EpiGeluBf16 {
    static constexpr bool PERM = true, AFTER_DRAIN = false;
    bf16_t* O; int ldc; const float* ssq; float* lnp;
    __device__ __forceinline__ static f32x2 gelu_pk(f32x2 v) {
        const f32x2 av = __builtin_elementwise_abs(v), d = av * 0.2316418882f + 1.0f;
        f32x2 t; t.x = __builtin_amdgcn_rcpf(d.x); t.y = __builtin_amdgcn_rcpf(d.y);
        f32x2 q = t * 0.5307027145f + (-0.7265760135f); q = q * t + 0.7107068705f; q = q * t + (-0.142248368f); q = q * t + 0.127414796f; q = q * t;
        const f32x2 sq = (v * v) * (-0.72134752044f);
        f32x2 e; e.x = __builtin_amdgcn_exp2f(sq.x); e.y = __builtin_amdgcn_exp2f(sq.y);
        const f32x2 mm = v * (q * e), r = v - mm;
        f32x2 o; o.x = v.x < 0.f ? mm.x : r.x; o.y = v.y < 0.f ? mm.y : r.y; return o;
    }
    __device__ __forceinline__ static unsigned g2(float a, float b) { const f32x2 r = gelu_pk((f32x2){a, b}); return pk2(r.x, r.y); }
    __device__ __forceinline__ void operator()(const f32x4 (&acc)[2][2][4][2], const Unit& u, int wr, int wc, int fr, int fq) const {
        const int row0 = u.pm * 256 + wr * 64 + fr, col0 = u.pn * 256 + wc * 32 + 8 * fq;
        float rsv[2][4]; rows_rstd(ssq, (size_t)row0, fq, rsv);
#pragma unroll
        for (int ai = 0; ai < 2; ++ai)
#pragma unroll
            for (int m = 0; m < 4; ++m) {
                const size_t row = (size_t)(row0 + ai * 128 + m * 16);
                const float rs = rsv[ai][m];
                bf16_t* rowp = O + row * ldc + col0;
                float s1 = 0.f, s2 = 0.f;
#pragma unroll
                for (int bj = 0; bj < 2; ++bj) {
                    const f32x4 v0 = acc[ai][bj][m][0] * rs, v1 = acc[ai][bj][m][1] * rs;
                    const f32x2 ga = gelu_pk((f32x2){v0[0], v0[1]}), gb = gelu_pk((f32x2){v0[2], v0[3]}), gc = gelu_pk((f32x2){v1[0], v1[1]}), gd = gelu_pk((f32x2){v1[2], v1[3]});
                    u32x4 w; w.x = pk2(ga.x, ga.y); w.y = pk2(gb.x, gb.y); w.z = pk2(gc.x, gc.y); w.w = pk2(gd.x, gd.y);
                    *(u32x4*)(rowp + bj * 128) = w;
                    s1 += ((ga.x + ga.y) + (gb.x + gb.y)) + ((gc.x + gc.y) + (gd.x + gd.y));
                    s2 += ((ga.x * ga.x + ga.y * ga.y) + (gb.x * gb.x + gb.y * gb.y)) + ((gc.x * gc.x + gc.y * gc.y) + (gd.x * gd.x + gd.y * gd.y));
                }
                if (u.pn >= 4) {
                    s1 += __shfl_xor(s1, 16); s1 += __shfl_xor(s1, 32); s2 += __shfl_xor(s2, 16); s2 += __shfl_xor(s2, 32);
                    if (fq == 0) *(f32x2*)(lnp + (row * 16 + (u.pn - 4) * 4 + wc) * 2) = (f32x2){s1, s2};
                }
            }
    }
};
struct EpiSwigluBf16 {
    static constexpr bool PERM = true, AFTER_DRAIN = false;
    bf16_t* O; int ldc; const float* ssq;
    __device__ __forceinline__ void operator()(const f32x4 (&acc)[2][2][4][2], const Unit& u, int wr, int wc, int fr, int fq) const {
        const int row0 = u.pm * 256 + wr * 64 + fr, col0 = u.pn * 128 + wc * 32 + 8 * fq;
        float rsv[2][4]; rows_rstd(ssq, (size_t)row0, fq, rsv);
#pragma unroll
        for (int ai = 0; ai < 2; ++ai)
#pragma unroll
            for (int m = 0; m < 4; ++m) {
                const float rs = rsv[ai][m];
                bf16_t* rowp = O + (size_t)(row0 + ai * 128 + m * 16) * ldc + col0;
                const f32x4 g0 = acc[ai][0][m][0] * rs, g1 = acc[ai][0][m][1] * rs, u0 = acc[ai][1][m][0] * rs, u1 = acc[ai][1][m][1] * rs;
                u32x4 w;
                w.x = pk2(silu_f(g0[0]) * u0[0], silu_f(g0[1]) * u0[1]); w.y = pk2(silu_f(g0[2]) * u0[2], silu_f(g0[3]) * u0[3]);
                w.z = pk2(silu_f(g1[0]) * u1[0], silu_f(g1[1]) * u1[1]); w.w = pk2(silu_f(g1[2]) * u1[2], silu_f(g1[3]) * u1[3]);
                *(u32x4*)rowp = w;
            }
    }
};
template <bool ACC_I8, bool OUT_F8> struct EpiSwigluQ {
    static constexpr bool PERM = true, AFTER_DRAIN = false;
    void* O; int ldc; const float* ssq; float dq;
    __device__ __forceinline__ void operator()(const f32x4 (&acc)[2][2][4][2], const Unit& u, int wr, int wc, int fr, int fq) const {
        const int row0 = u.pm * 256 + wr * 64 + fr, col0 = u.pn * 128 + wc * 32 + 8 * fq;
        float rsv[2][4]; rows_rstd(ssq, (size_t)row0, fq, rsv);
#pragma unroll
        for (int ai = 0; ai < 2; ++ai)
#pragma unroll
            for (int m = 0; m < 4; ++m) {
                const float rs = ACC_I8 ? rsv[ai][m] * dq : rsv[ai][m], rsu = OUT_F8 ? rs * ACT_SC : rs;
                f32x4 g0 = acc[ai][0][m][0], g1 = acc[ai][0][m][1], u0 = acc[ai][1][m][0], u1 = acc[ai][1][m][1];
                if (ACC_I8) { g0 = i2f4(g0); g1 = i2f4(g1); u0 = i2f4(u0); u1 = i2f4(u1); }
                g0 = g0 * rs; g1 = g1 * rs; u0 = u0 * rsu; u1 = u1 * rsu;
                if (OUT_F8) {
                    unsigned char* rowp = (unsigned char*)O + (size_t)(row0 + ai * 128 + m * 16) * ldc + col0;
                    u32x2 w;
                    w.x = pk4_f8(silu_f(g0[0]) * u0[0], silu_f(g0[1]) * u0[1], silu_f(g0[2]) * u0[2], silu_f(g0[3]) * u0[3]);
                    w.y = pk4_f8(silu_f(g1[0]) * u1[0], silu_f(g1[1]) * u1[1], silu_f(g1[2]) * u1[2], silu_f(g1[3]) * u1[3]);
                    *(u32x2*)rowp = w;
                } else {
                    bf16_t* rowp = (bf16_t*)O + (size_t)(row0 + ai * 128 + m * 16) * ldc + col0;
                    u32x4 w;
                    w.x = pk2(silu_f(g0[0]) * u0[0], silu_f(g0[1]) * u0[1]); w.y = pk2(silu_f(g0[2]) * u0[2], silu_f(g0[3]) * u0[3]);
                    w.z = pk2(silu_f(g1[0]) * u1[0], silu_f(g1[1]) * u1[1]); w.w = pk2(silu_f(g1[2]) * u1[2], silu_f(g1[3]) * u1[3]);
                    *(u32x4*)rowp = w;
                }
            }
    }
};
template <bool BASE_F32, bool SCALED = false, bool W8 = false> struct EpiResid {
    static constexpr bool PERM = true, AFTER_DRAIN = false;
    const float* xbase; bf16_t* H; float* ssq; unsigned char* H8 = nullptr; float hq = 0.f;
    __device__ __forceinline__ void operator()(const f32x4 (&acc)[2][2][4][2], const Unit& u, int wr, int wc, int fr, int fq) const {
        const int row0 = u.pm * 256 + wr * 64 + fr, col0 = u.pn * 256 + wc * 32 + 8 * fq;
#pragma unroll
        for (int ai = 0; ai < 2; ++ai)
#pragma unroll
            for (int m = 0; m < 4; ++m) {
                const size_t row = (size_t)(row0 + ai * 128 + m * 16);
                float ss = 0.f;
#pragma unroll
                for (int bj = 0; bj < 2; ++bj) {
                    const size_t off = row * 1024 + col0 + bj * 128;
                    f32x4 b0, b1;
                    if (BASE_F32) { b0 = *(const f32x4*)(xbase + off); b1 = *(const f32x4*)(xbase + off + 4); }
                    else { const u32x4 hw = *(const u32x4*)(H + off);
                        b0 = (f32x4){bf2f((unsigned short)(hw.x & 0xffffu)), bf2f((unsigned short)(hw.x >> 16)), bf2f((unsigned short)(hw.y & 0xffffu)), bf2f((unsigned short)(hw.y >> 16))};
                        b1 = (f32x4){bf2f((unsigned short)(hw.z & 0xffffu)), bf2f((unsigned short)(hw.z >> 16)), bf2f((unsigned short)(hw.w & 0xffffu)), bf2f((unsigned short)(hw.w >> 16))}; }
                    const float sc = SCALED ? DN_UNSC : 1.f;
                    const f32x4 v0 = b0 + acc[ai][bj][m][0] * sc, v1 = b1 + acc[ai][bj][m][1] * sc;
                    u32x4 w; w.x = pk2(v0[0], v0[1]); w.y = pk2(v0[2], v0[3]); w.z = pk2(v1[0], v1[1]); w.w = pk2(v1[2], v1[3]);
                    *(u32x4*)(H + off) = w;
                    if (W8) { u32x2 q; q.x = pk4_i8(v0[0] * hq, v0[1] * hq, v0[2] * hq, v0[3] * hq); q.y = pk4_i8(v1[0] * hq, v1[1] * hq, v1[2] * hq, v1[3] * hq); *(u32x2*)(H8 + off) = q; }
                    ss += ((v0[0] * v0[0] + v0[1] * v0[1]) + (v0[2] * v0[2] + v0[3] * v0[3])) + ((v1[0] * v1[0] + v1[1] * v1[1]) + (v1[2] * v1[2] + v1[3] * v1[3]));
                }
                ss += __shfl_xor(ss, 16); ss += __shfl_xor(ss, 32);
                if (fq == 0) ssq[row * 16 + u.pn * 4 + wc] = ss;
            }
    }
};
namespace pg8 {
#define PG8_LAS __attribute__((address_space(3)))
constexpr int BM = 256, BK = 64, HALF = 128, HTB = HALF * BK * 2  , STAGE_BYTES = 8 * HTB, NXCD = 8, WGM = 8;
__host__ __device__ __forceinline__ int lds_byte(int r, int c) { const int st = (r >> 4) * 2 + (c >> 5), rr = r & 15, cc = c & 31, ob = rr * 64 + cc * 2; return st * 1024 + (ob ^ (((ob >> 9) & 1) << 5)); }
__host__ __device__ __forceinline__ void stage_rc(int b, int& R, int& C) { const int st = b / 1024, sb = b % 1024, swz = sb ^ (((sb >> 9) & 1) << 5); R = (st >> 1) * 16 + swz / 64; C = (st & 1) * 32 + (swz % 64) / 2; }
struct StaticOrder {
    int nM, nN, nwg, G, c;
    __host__ __device__ void init(int M, int N, int G_, int c_) { nM = M / BM; nN = N / BM; nwg = nM * nN; G = G_; c = c_; }
    __host__ __device__ bool next(int i, Unit& u) const {
        const long L = (long)i * G + c; if (L >= nwg) return false;
        int wgid = (int)L; { const int q = nwg / NXCD, r = nwg % NXCD, xcd = wgid % NXCD, off = wgid / NXCD; wgid = (xcd < r ? xcd * (q + 1) : r * (q + 1) + (xcd - r) * q) + off; }
        const int nig = WGM * nN, gid = wgid / nig, fm = gid * WGM, gsz = (nM - fm) < WGM ? (nM - fm) : WGM;
        u.pm = fm + ((wgid % nig) % gsz); u.pn = (wgid % nig) / gsz; return true;
    }
    __device__ __forceinline__ void a_ready(const Unit&) const {}
    __device__ __forceinline__ void done(const Unit&) const {}
};
struct ComboOrder {
    StaticOrder so;
    __host__ __device__ void init(int G_, int c_) { so.init(T, PW, G_, c_); }
    __host__ __device__ bool next(int i, Unit& u) const {
        const long L = (long)i * so.G + so.c;
        if (L < so.nwg) { so.next(i, u); u.pm += TILE_HN; return true; }
        const int j = (int)(L - so.nwg); if (j >= 128) return false;
        const int l = j >> 6, jj = j & 63;
        if (jj < 32) { u.pm = TILE_MEMN + (jj >> 1); u.pn = TILE_WKV + 4 * l + (jj & 1); }
        else { const int q = jj - 32; u.pm = TILE_WKV + 4 * l + 2 + (q >> 4); u.pn = TILE_MEMN + (q & 15); }
        return true;
    }
    __device__ __forceinline__ void a_ready(const Unit&) const {}
    __device__ __forceinline__ void done(const Unit&) const {}
};
template <class Epi, class Sched, bool ALIGN_EPI = false, bool SP2 = false, int QM = 0  >
__device__ __forceinline__ void gemm_phase(PG8_LAS unsigned char* lds, const Gemm g, const Sched& S, const Epi& E) {
    const int tid = otid(), wid = __builtin_amdgcn_readfirstlane(tid >> 6), lane = tid & 63, wr = wid >> 2, wc = wid & 3, fr = lane & 15, fq = lane >> 4;
    constexpr bool FP8 = (QM == 1), I8 = (QM == 2);
    const int K = g.K, nt = K / BK;
    unsigned voffA[2], voffB[2];
#pragma unroll
    for (int i = 0; i < 2; ++i) { int R, C; stage_rc(tid * 16 + i * 8192, R, C); const int Rb = Epi::PERM ? ((R & ~31) + perm32(R & 31)) : R;
        voffA[i] = (unsigned)(R * K + C) * 2u; voffB[i] = (unsigned)(Rb * K + C) * 2u; }
    const size_t kstep = (size_t)(BK * 2);
    const size_t hstep = (size_t)HALF * K * 2;
    const size_t tstep = 2 * hstep;
    const unsigned ldsw = (unsigned)wid * 1024u;
    const int aoff = lds_byte(wr * 64 + fr, fq * 8), boff = lds_byte(wc * 32 + fr, fq * 8);
#define PG8_SA(b, h) (((b) * 2 + (h)) * HTB)
#define PG8_SB(b, h) ((4 + (b) * 2 + (h)) * HTB)
#define PG8_STAGE(bufoff, gbase, voff) do { _Pragma("unroll") for (int _i = 0; _i < 2; ++_i) \
        __builtin_amdgcn_global_load_lds((const unsigned*)((const char*)(gbase) + (voff)[_i]), (PG8_LAS unsigned*)(lds + (bufoff) + ldsw + _i * 8192), 16, 0, 0); } while (0)
#define PG8_LD16(off) (*(const PG8_LAS bf16x8*)(lds + (off)))
#define PG8_LDA(dst, b, h) do { _Pragma("unroll") for (int m = 0; m < 4; ++m) { \
        if constexpr (FP8) dst##8[m] = PG8_CAT(PG8_LD16(PG8_SA(b, h) + aoff + m * 2048), PG8_LD16(PG8_SA(b, h) + aoff + m * 2048 + 1024)); \
        else { _Pragma("unroll") for (int k = 0; k < 2; ++k) dst[m][k] = PG8_LD16(PG8_SA(b, h) + aoff + m * 2048 + k * 1024); } } } while (0)
#define PG8_LDB(dst, b, h) do { _Pragma("unroll") for (int n = 0; n < 2; ++n) { \
        if constexpr (FP8) dst##8[n] = PG8_CAT(PG8_LD16(PG8_SB(b, h) + boff + n * 2048), PG8_LD16(PG8_SB(b, h) + boff + n * 2048 + 1024)); \
        else { _Pragma("unroll") for (int k = 0; k < 2; ++k) dst[n][k] = PG8_LD16(PG8_SB(b, h) + boff + n * 2048 + k * 1024); } } } while (0)
#define PG8_CAT(x, y) __builtin_shufflevector(__builtin_bit_cast(i32x4v, x), __builtin_bit_cast(i32x4v, y), 0, 1, 2, 3, 4, 5, 6, 7)
#define PG8_MMA(ai, bj, At, Bt) do { __builtin_amdgcn_s_setprio(1); \
        if constexpr (FP8) { _Pragma("unroll") for (int m = 0; m < 4; ++m) _Pragma("unroll") for (int n = 0; n < 2; ++n) \
            asm("v_mfma_f32_16x16x128_f8f6f4 %0, %1, %2, %0" : "+v"(acc[ai][bj][m][n]) : "v"(Bt##8[n]), "v"(At##8[m])); } \
        else if constexpr (I8) { _Pragma("unroll") for (int m = 0; m < 4; ++m) _Pragma("unroll") for (int n = 0; n < 2; ++n) _Pragma("unroll") for (int k = 0; k < 2; ++k) \
            acc[ai][bj][m][n] = __builtin_bit_cast(f32x4, __builtin_amdgcn_mfma_i32_16x16x64_i8(__builtin_bit_cast(i32x4v, Bt[n][k]), __builtin_bit_cast(i32x4v, At[m][k]), __builtin_bit_cast(i32x4v, acc[ai][bj][m][n]), 0, 0, 0)); } \
        else { _Pragma("unroll") for (int m = 0; m < 4; ++m) _Pragma("unroll") for (int n = 0; n < 2; ++n) _Pragma("unroll") for (int k = 0; k < 2; ++k) \
            acc[ai][bj][m][n] = __builtin_amdgcn_mfma_f32_16x16x32_bf16(Bt[n][k], At[m][k], acc[ai][bj][m][n], 0, 0, 0); } \
        __builtin_amdgcn_s_setprio(0); } while (0)
#define PG8_WAIT_V(n) asm volatile("s_waitcnt vmcnt(" #n ")" ::: "memory")
#define PG8_WAIT_L(n) asm volatile("s_waitcnt lgkmcnt(" #n ")" ::: "memory")
#define PG8_BAR __builtin_amdgcn_s_barrier()
#define PG8_SCHED __builtin_amdgcn_sched_barrier(0)
    Unit cur, nxt; int ui = 0;
    if (!S.next(0, cur)) return;
    f32x4 acc[2][2][4][2];
#pragma unroll
    for (int a = 0; a < 2; ++a)
#pragma unroll
        for (int b = 0; b < 2; ++b)
#pragma unroll
            for (int m = 0; m < 4; ++m)
#pragma unroll
                for (int n = 0; n < 2; ++n) acc[a][b][m][n] = (f32x4){0.f, 0.f, 0.f, 0.f};
    bf16x8 At[4][2], B0[2][2], B1[2][2];
    i32x8v At8[4], B08[2], B18[2];
    const char* cA = (const char*)g.A + (size_t)cur.pm * tstep; const char* cB = (const char*)g.Bt + (size_t)cur.pn * tstep;
    S.a_ready(cur);
    if constexpr (SP2) {
        PG8_STAGE(PG8_SB(0, 0), cB, voffB); PG8_STAGE(PG8_SB(0, 1), cB + hstep, voffB); PG8_STAGE(PG8_SA(0, 0), cA, voffA); PG8_STAGE(PG8_SA(0, 1), cA + hstep, voffA);
        if (wr == 1) PG8_BAR;
        PG8_WAIT_V(2); PG8_BAR;
        PG8_STAGE(PG8_SB(1, 0), cB + kstep, voffB); PG8_STAGE(PG8_SA(1, 0), cA + kstep, voffA); PG8_STAGE(PG8_SB(1, 1), cB + hstep + kstep, voffB);
        PG8_WAIT_V(6); PG8_BAR;
    } else {
        PG8_STAGE(PG8_SB(0, 0), cB, voffB); PG8_STAGE(PG8_SA(0, 0), cA, voffA); PG8_STAGE(PG8_SB(0, 1), cB + hstep, voffB); PG8_STAGE(PG8_SA(0, 1), cA + hstep, voffA);
        if (wr == 1) PG8_BAR;
        PG8_WAIT_V(4); PG8_BAR;
        PG8_STAGE(PG8_SB(1, 0), cB + kstep, voffB); PG8_STAGE(PG8_SA(1, 0), cA + kstep, voffA); PG8_STAGE(PG8_SB(1, 1), cB + hstep + kstep, voffB);
        PG8_WAIT_V(6); PG8_BAR;
    }
    for (;;) {
        const bool has_next = S.next(ui + 1, nxt);
        const char* nA = has_next ? (const char*)g.A + (size_t)nxt.pm * tstep : cA; const char* nB = has_next ? (const char*)g.Bt + (size_t)nxt.pn * tstep : cB;
        for (int t = 0; t < nt; t += 2) {
            const bool last = (t == nt - 2);
            if constexpr (FP8) __builtin_amdgcn_s_waitcnt(0xC07F);
            const char* a1 = cA + (size_t)(t + 1) * kstep;
            const char* a2 = last ? nA : cA + (size_t)(t + 2) * kstep; const char* b2 = last ? nB : cB + (size_t)(t + 2) * kstep;
            const char* a3 = a2 + kstep; const char* b3 = b2 + kstep;
            if (last && has_next) S.a_ready(nxt);
            if constexpr (SP2) {
            PG8_LDB(B0, 0, 0); PG8_LDB(B1, 0, 1); PG8_SCHED; PG8_LDA(At, 0, 0); PG8_STAGE(PG8_SA(1, 1), a1 + hstep, voffA);
            PG8_WAIT_V(8); PG8_WAIT_L(0); PG8_BAR; PG8_MMA(0, 0, At, B0); PG8_MMA(0, 1, At, B1); PG8_BAR; PG8_SCHED;
            PG8_LDA(At, 0, 1); PG8_STAGE(PG8_SB(0, 0), b2, voffB); PG8_STAGE(PG8_SB(0, 1), b2 + hstep, voffB); PG8_STAGE(PG8_SA(0, 0), a2, voffA);
            PG8_WAIT_V(8); PG8_WAIT_L(0); PG8_BAR; PG8_MMA(1, 0, At, B0); PG8_MMA(1, 1, At, B1); PG8_BAR; PG8_SCHED;
            PG8_LDB(B0, 1, 0); PG8_LDB(B1, 1, 1); PG8_SCHED; PG8_LDA(At, 1, 0); PG8_STAGE(PG8_SA(0, 1), a2 + hstep, voffA);
            PG8_WAIT_V(8); PG8_WAIT_L(0); PG8_BAR; PG8_MMA(0, 0, At, B0); PG8_MMA(0, 1, At, B1); PG8_BAR; PG8_SCHED;
            PG8_LDA(At, 1, 1); PG8_STAGE(PG8_SB(1, 0), b3, voffB); PG8_STAGE(PG8_SB(1, 1), b3 + hstep, voffB); PG8_STAGE(PG8_SA(1, 0), a3, voffA);
            PG8_WAIT_V(8); PG8_WAIT_L(0); PG8_BAR; PG8_MMA(1, 0, At, B0); PG8_MMA(1, 1, At, B1); PG8_BAR; PG8_SCHED;
            } else {
            PG8_LDB(B0, 0, 0); PG8_SCHED; PG8_LDA(At, 0, 0); PG8_STAGE(PG8_SA(1, 1), a1 + hstep, voffA);
            PG8_WAIT_L(8); PG8_BAR; PG8_WAIT_L(0); PG8_MMA(0, 0, At, B0); PG8_BAR; PG8_SCHED;
            PG8_LDB(B1, 0, 1); PG8_STAGE(PG8_SB(0, 0), b2, voffB);
            PG8_BAR; PG8_WAIT_L(0); PG8_MMA(0, 1, At, B1); PG8_BAR;
            PG8_LDA(At, 0, 1); PG8_STAGE(PG8_SA(0, 0), a2, voffA);
            PG8_BAR; PG8_WAIT_L(0); PG8_MMA(1, 0, At, B0); PG8_BAR; PG8_SCHED;
            PG8_STAGE(PG8_SB(0, 1), b2 + hstep, voffB);
            PG8_WAIT_V(6); PG8_BAR; PG8_MMA(1, 1, At, B1); PG8_BAR;
            PG8_LDB(B0, 1, 0); PG8_SCHED; PG8_LDA(At, 1, 0); PG8_STAGE(PG8_SA(0, 1), a2 + hstep, voffA);
            PG8_WAIT_L(8); PG8_BAR; PG8_WAIT_L(0); PG8_MMA(0, 0, At, B0); PG8_BAR; PG8_SCHED;
            PG8_LDB(B1, 1, 1); PG8_STAGE(PG8_SB(1, 0), b3, voffB);
            PG8_BAR; PG8_WAIT_L(0); PG8_MMA(0, 1, At, B1); PG8_BAR;
            PG8_LDA(At, 1, 1); PG8_STAGE(PG8_SA(1, 0), a3, voffA);
            PG8_BAR; PG8_WAIT_L(0); PG8_MMA(1, 0, At, B0); PG8_BAR; PG8_SCHED;
            PG8_STAGE(PG8_SB(1, 1), b3 + hstep, voffB);
            PG8_WAIT_V(6); PG8_BAR; PG8_MMA(1, 1, At, B1); PG8_BAR;
            }
        }
        if constexpr (FP8) asm volatile("s_nop 15\n\ts_nop 15" ::: "memory");
        if constexpr (ALIGN_EPI) { if (wr == 0) PG8_BAR; }
        if constexpr (!Epi::AFTER_DRAIN) { E(acc, cur, wr, wc, fr, fq); S.done(cur); }
        if (!has_next) break;
#pragma unroll
        for (int a = 0; a < 2; ++a)
#pragma unroll
            for (int b = 0; b < 2; ++b)
#pragma unroll
                for (int m = 0; m < 4; ++m)
#pragma unroll
                    for (int n = 0; n < 2; ++n) acc[a][b][m][n] = (f32x4){0.f, 0.f, 0.f, 0.f};
        cur = nxt; cA = nA; cB = nB; ++ui;
        if constexpr (ALIGN_EPI) { if (wr == 1) PG8_BAR; }
    }
    PG8_WAIT_V(0);
    if constexpr (!ALIGN_EPI) { if (wr == 0) PG8_BAR; }
    PG8_BAR;
    if constexpr (Epi::AFTER_DRAIN) { E.fused(acc, cur, wr, wc, fr, fq, lds, wid, lane); S.done(cur); }
#undef PG8_SA
#undef PG8_SB
#undef PG8_STAGE
#undef PG8_LDA
#undef PG8_LD16
#undef PG8_LDB
#undef PG8_MMA
#undef PG8_CAT
#undef PG8_WAIT_V
#undef PG8_WAIT_L
#undef PG8_BAR
#undef PG8_SCHED
}
}

template <class Epi, int QM = 0>
__device__ __forceinline__ void run_gemm(const Gemm g, const Epi& E, LAS float* lds, int vb, int nvb) {
    pg8::StaticOrder S; S.init(g.M, g.N, nvb, vb);
    pg8::gemm_phase<Epi, pg8::StaticOrder, true, true, QM>((LAS unsigned char*)lds, g, S, E);
}

enum { MAP_ID = 0, MAP_WIN = 1, MAP_GU = 2 };
struct PrepJob { const float* W; int K, N; const float* gain; bf16_t* dst; int r0, r1, ldd, koff, map; int fmt; float osc; };
__device__ __forceinline__ int map_src(int map, int r, int N) {
    if (map == MAP_ID) return r < N ? r : -1;
    if (map == MAP_WIN) {
        if (r < 1728) return r - 512;
        if (r < 3776) return r - 504;
        if (r < 3784) return r - 2560;
        return -1;
    }
    { const int tile = r >> 8, w = r & 255, j = tile * 128 + (w & 127); return w < 128 ? j : FF + j; }
}
__device__ __forceinline__ void prep_tile_load(const PrepJob& j, int t, f32x4 (&v)[8]) {
    const int nkt = j.K / 64, kt = t % nkt, rt = t / nkt, k0 = kt * 64, r0 = j.r0 + rt * 256;
#pragma unroll
    for (int q = 0; q < 8; ++q) {
        const int i = (int)threadIdx.x + q * NTHREADS, kk = i >> 6, r4 = (i & 63) * 4;
        const int sc = map_src(j.map, r0 + r4, j.N);
        v[q] = sc >= 0 ? __builtin_nontemporal_load((const f32x4*)(j.W + (size_t)(k0 + kk) * j.N + sc)) : (f32x4){0.f, 0.f, 0.f, 0.f};
        if (j.gain) v[q] = v[q] * j.gain[k0 + kk];
    }
}
__device__ __forceinline__ void prep_tile_store(const PrepJob& j, int t, const f32x4 (&v)[8], LAS float* tile  ) {
    const int nkt = j.K / 64, kt = t % nkt, rt = t / nkt, k0 = kt * 64, r0 = j.r0 + rt * 256;
    __syncthreads();
#pragma unroll
    for (int q = 0; q < 8; ++q) { const int i = (int)threadIdx.x + q * NTHREADS, kk = i >> 6, r4 = (i & 63) * 4; *(LAS f32x4*)(tile + kk * 260 + r4) = v[q]; }
    __syncthreads();
#pragma unroll
    for (int q = 0; q < 4; ++q) {
        const int i = (int)threadIdx.x + q * NTHREADS, rr = i & 255, c8 = i >> 8;
        const LAS float* tp = tile + (c8 * 8) * 260 + rr;
        if (j.fmt != 0) {
            const float sc = j.osc; u32x2 w;
            if (j.fmt == 1) { w.x = pk4_f8(tp[0] * sc, tp[260] * sc, tp[520] * sc, tp[780] * sc); w.y = pk4_f8(tp[1040] * sc, tp[1300] * sc, tp[1560] * sc, tp[1820] * sc); }
            else { w.x = pk4_i8(tp[0] * sc, tp[260] * sc, tp[520] * sc, tp[780] * sc); w.y = pk4_i8(tp[1040] * sc, tp[1300] * sc, tp[1560] * sc, tp[1820] * sc); }
            *(u32x2*)((unsigned char*)j.dst + (size_t)(r0 + rr) * j.ldd + j.koff + k0 + c8 * 8) = w;
        } else {
        u32x4 w; w.x = pk2(tp[0], tp[260]); w.y = pk2(tp[520], tp[780]); w.z = pk2(tp[1040], tp[1300]); w.w = pk2(tp[1560], tp[1820]);
        *(u32x4*)(j.dst + (size_t)(r0 + rr) * j.ldd + j.koff + k0 + c8 * 8) = w;
        }
    }
}
__device__ __forceinline__ void prep_fold_in(const float* w_in  , const float* w_uk  , const float* gain, bf16_t* dst, LAS float* lds, int vb, int nvb) {
    LAS float* A = lds; LAS float* B = lds + 32 * 65;
    const int tid = otid(), lane = tid & 63, wid = __builtin_amdgcn_readfirstlane(tid >> 6), l15 = lane & 15, dq = lane >> 4;
    for (int item = vb; item < 256; item += nvb) {
        const int h = item >> 5, k0 = (item & 31) * 32;
        __syncthreads();
        for (int i = tid; i < 2048; i += NTHREADS) { const int kk = i >> 6, d = i & 63; A[kk * 65 + d] = w_in[(size_t)(k0 + kk) * 3272 + h * 64 + d] * gain[k0 + kk]; }
        for (int i = tid; i < 8192; i += NTHREADS) { const int c = i >> 6, d = i & 63; B[c * 65 + d] = w_uk[(size_t)(h * 128 + c) * 64 + d]; }
        __syncthreads();
        f32x4 acc0 = (f32x4){0.f, 0.f, 0.f, 0.f}, acc1 = acc0;
#pragma unroll 4
        for (int d0 = 0; d0 < 64; d0 += 4) {
            const float b = B[(16 * wid + l15) * 65 + d0 + dq], a0 = A[l15 * 65 + d0 + dq], a1 = A[(16 + l15) * 65 + d0 + dq];
            acc0 = __builtin_amdgcn_mfma_f32_16x16x4f32(a0, b, acc0, 0, 0, 0);
            acc1 = __builtin_amdgcn_mfma_f32_16x16x4f32(a1, b, acc1, 0, 0, 0);
        }
        bf16_t* drow = dst + (size_t)(h * 128 + 16 * wid + l15) * 1024 + k0 + 4 * dq;
        { u32x2 w; w.x = pk2(acc0[0], acc0[1]); w.y = pk2(acc0[2], acc0[3]); *(u32x2*)drow = w; }
        { u32x2 w; w.x = pk2(acc1[0], acc1[1]); w.y = pk2(acc1[2], acc1[3]); *(u32x2*)(drow + 16) = w; }
    }
}
__device__ __forceinline__ void prep_fold_out(const float* w_out  , const float* w_uv  , bf16_t* dst  , LAS float* lds, int vb, int nvb) {
    LAS float* A = lds; LAS float* B = lds + 64 * 33;
    const int tid = otid(), lane = tid & 63, wid = __builtin_amdgcn_readfirstlane(tid >> 6), l15 = lane & 15, dq = lane >> 4;
    for (int item = vb; item < 256; item += nvb) {
        const int h = item >> 5, n0 = (item & 31) * 32;
        __syncthreads();
        for (int i = tid; i < 2048; i += NTHREADS) { const int d = i >> 5, nn = i & 31; A[d * 33 + nn] = w_out[(size_t)(h * 64 + d) * 1024 + n0 + nn]; }
        for (int i = tid; i < 8192; i += NTHREADS) { const int c = i >> 6, d = i & 63; B[c * 65 + d] = w_uv[(size_t)(h * 128 + c) * 64 + d]; }
        __syncthreads();
        f32x4 acc0 = (f32x4){0.f, 0.f, 0.f, 0.f}, acc1 = acc0;
#pragma unroll 4
        for (int d0 = 0; d0 < 64; d0 += 4) {
            const float a = B[(16 * wid + l15) * 65 + d0 + dq], b0 = A[(d0 + dq) * 33 + l15], b1 = A[(d0 + dq) * 33 + 16 + l15];
            acc0 = __builtin_amdgcn_mfma_f32_16x16x4f32(a, b0, acc0, 0, 0, 0);
            acc1 = __builtin_amdgcn_mfma_f32_16x16x4f32(a, b1, acc1, 0, 0, 0);
        }
        { u32x2 w; w.x = pk2(acc0[0], acc0[1]); w.y = pk2(acc0[2], acc0[3]); *(u32x2*)(dst + (size_t)(n0 + l15) * KOUT + h * 128 + 16 * wid + 4 * dq) = w; }
        { u32x2 w; w.x = pk2(acc1[0], acc1[1]); w.y = pk2(acc1[2], acc1[3]); *(u32x2*)(dst + (size_t)(n0 + 16 + l15) * KOUT + h * 128 + 16 * wid + 4 * dq) = w; }
    }
}
__device__ __forceinline__ void prep_lb(const float* hgrn_lb  , float* lb, int vb, int nvb) {
    for (int i = vb * NTHREADS + threadIdx.x; i < 512; i += nvb * NTHREADS) {
        const float a = hgrn_lb[i], b = hgrn_lb[512 + i], c = hgrn_lb[1024 + i], m = fmaxf(a, fmaxf(b, c));
        const float ea = __expf(a - m), eb = __expf(b - m), ec = __expf(c - m);
        lb[i] = ea / (ea + eb + ec);
    }
}

__device__ __forceinline__ void rmsnorm_rows(const float* X, bf16_t* Y, int nrows, int vb, int nvb) {
    const int tid = otid(), lane = tid & 63, gw = vb * NWAVES + __builtin_amdgcn_readfirstlane(tid >> 6), ngw = nvb * NWAVES;
    for (int r = gw; r < nrows; r += ngw) {
        const f32x4* xr = (const f32x4*)(X + (size_t)r * D) + lane;
        f32x4 v[4]; float s = 0.f;
#pragma unroll
        for (int j = 0; j < 4; ++j) { v[j] = xr[64 * j]; s += (v[j].x * v[j].x + v[j].y * v[j].y) + (v[j].z * v[j].z + v[j].w * v[j].w); }
        const float rs = rsqrtf(wave_sum(s) * (1.f / D) + EPS);
        u32x2* o = (u32x2*)(Y + (size_t)r * D) + lane;
#pragma unroll
        for (int j = 0; j < 4; ++j) { u32x2 w; w.x = pk2(v[j].x * rs, v[j].y * rs); w.y = pk2(v[j].z * rs, v[j].w * rs); o[64 * j] = w; }
    }
}
__device__ __forceinline__ void x_to_h_rows(const float* X, bf16_t* H, float* ssq, int vb, int nvb) {
    const int tid = otid(), lane = tid & 63, gw = vb * NWAVES + __builtin_amdgcn_readfirstlane(tid >> 6), ngw = nvb * NWAVES;
    for (int r = gw; r < T; r += 2 * ngw) {
        const int r2 = (r + ngw < T) ? r + ngw : r;
        f32x4 v[2][4];
#pragma unroll
        for (int j = 0; j < 4; ++j) { v[0][j] = __builtin_nontemporal_load((const f32x4*)(X + (size_t)r * D) + lane + 64 * j); v[1][j] = __builtin_nontemporal_load((const f32x4*)(X + (size_t)r2 * D) + lane + 64 * j); }
#pragma unroll
        for (int q = 0; q < 2; ++q) {
            const int rr = q ? r2 : r;
            u32x2* o = (u32x2*)(H + (size_t)rr * D) + lane;
            float s = 0.f;
#pragma unroll
            for (int j = 0; j < 4; ++j) { const f32x4 x = v[q][j]; u32x2 w; w.x = pk2(x.x, x.y); w.y = pk2(x.z, x.w); o[64 * j] = w;
                const float a = bf2f((unsigned short)(w.x & 0xffffu)), b = bf2f((unsigned short)(w.x >> 16)), c = bf2f((unsigned short)(w.y & 0xffffu)), d = bf2f((unsigned short)(w.y >> 16));
                s += (a * a + b * b) + (c * c + d * d); }
            s = wave_sum(s);
            if (lane < 16) ssq[(size_t)rr * 16 + lane] = lane == 0 ? s : 0.f;
        }
    }
}
__device__ __forceinline__ void final_rows(const bf16_t* H, const float* ssq, const float* g, float* out, int vb, int nvb) {
    const int tid = otid(), lane = tid & 63, gw = vb * NWAVES + __builtin_amdgcn_readfirstlane(tid >> 6), ngw = nvb * NWAVES;
    f32x4 gg[4];
#pragma unroll
    for (int j = 0; j < 4; ++j) gg[j] = *((const f32x4*)g + lane + 64 * j);
    for (int r = gw; r < T; r += 2 * ngw) {
        const int r2 = (r + ngw < T) ? r + ngw : r;
        u32x2 w[2][4]; float rs[2];
#pragma unroll
        for (int j = 0; j < 4; ++j) { w[0][j] = ((const u32x2*)(H + (size_t)r * D) + lane)[64 * j]; w[1][j] = ((const u32x2*)(H + (size_t)r2 * D) + lane)[64 * j]; }
        rs[0] = row_rstd(ssq, (size_t)r); rs[1] = row_rstd(ssq, (size_t)r2);
#pragma unroll
        for (int q = 0; q < 2; ++q) {
            f32x4* o = (f32x4*)(out + (size_t)(q ? r2 : r) * D) + lane;
#pragma unroll
            for (int j = 0; j < 4; ++j) { const u32x2 ww = w[q][j];
                __builtin_nontemporal_store((f32x4){bf2f((unsigned short)(ww.x & 0xffffu)) * rs[q] * gg[j].x, bf2f((unsigned short)(ww.x >> 16)) * rs[q] * gg[j].y, bf2f((unsigned short)(ww.y & 0xffffu)) * rs[q] * gg[j].z, bf2f((unsigned short)(ww.y >> 16)) * rs[q] * gg[j].w}, o + 64 * j); }
        }
    }
}
__device__ __forceinline__ float row16_sum(float v) {
    v += __uint_as_float((unsigned)__builtin_amdgcn_update_dpp(0, (int)__float_as_uint(v), 0x128, 0xf, 0xf, false));
    v += __uint_as_float((unsigned)__builtin_amdgcn_update_dpp(0, (int)__float_as_uint(v), 0x124, 0xf, 0xf, false));
    v += __uint_as_float((unsigned)__builtin_amdgcn_update_dpp(0, (int)__float_as_uint(v), 0x122, 0xf, 0xf, false));
    v += __uint_as_float((unsigned)__builtin_amdgcn_update_dpp(0, (int)__float_as_uint(v), 0x121, 0xf, 0xf, false));
    return v;
}
__device__ __forceinline__ void cnorm_rows(const bf16_t* P, const float* lat_g, bf16_t* CN, int vb, int nvb) {
    const int tid = otid(), lane = tid & 63, gw = vb * NWAVES + __builtin_amdgcn_readfirstlane(tid >> 6), ngw = nvb * NWAVES, r4 = lane >> 4, l16 = lane & 15;
    const f32x4 ga = *(const f32x4*)(lat_g + l16 * 8), gb = *(const f32x4*)(lat_g + l16 * 8 + 4);
    for (int r = gw * 8; r < T; r += ngw * 8) {
        u32x4 w[2];
#pragma unroll
        for (int q = 0; q < 2; ++q) w[q] = *(const u32x4*)(P + (size_t)(r + 4 * q + r4) * PW + P_C + l16 * 8);
#pragma unroll
        for (int q = 0; q < 2; ++q) {
            const float x0 = bf2f((unsigned short)(w[q].x & 0xffffu)), x1 = bf2f((unsigned short)(w[q].x >> 16)), x2 = bf2f((unsigned short)(w[q].y & 0xffffu)), x3 = bf2f((unsigned short)(w[q].y >> 16));
            const float x4 = bf2f((unsigned short)(w[q].z & 0xffffu)), x5 = bf2f((unsigned short)(w[q].z >> 16)), x6 = bf2f((unsigned short)(w[q].w & 0xffffu)), x7 = bf2f((unsigned short)(w[q].w >> 16));
            const float ss = row16_sum(((x0 * x0 + x1 * x1) + (x2 * x2 + x3 * x3)) + ((x4 * x4 + x5 * x5) + (x6 * x6 + x7 * x7)));
            const float rs = rsqrtf(ss * (1.f / 128.f) + EPS);
            u32x4 o; o.x = pk2(x0 * rs * ga.x, x1 * rs * ga.y); o.y = pk2(x2 * rs * ga.z, x3 * rs * ga.w); o.z = pk2(x4 * rs * gb.x, x5 * rs * gb.y); o.w = pk2(x6 * rs * gb.z, x7 * rs * gb.w);
            *(u32x4*)(CN + (size_t)(r + 4 * q + r4) * 128 + l16 * 8) = o;
        }
    }
}
__device__ __forceinline__ int t5_bucket(int rel) {
    const int n = rel < 0 ? -rel : rel;
    int b = n < 8 ? n : 8 + (n >= 12) + (n >= 16) + (n >= 23) + (n >= 32) + (n >= 46) + (n >= 64) + (n >= 91);
    return b + (rel > 0 ? 16 : 0);
}
__device__ __forceinline__ unsigned sort_key(float x) { const unsigned u = __float_as_uint(x); return (u & 0x80000000u) ? ~u : (u | 0x80000000u); }


template <int CTRL, int ROWMASK> __device__ __forceinline__ unsigned dpp0(unsigned v) { return (unsigned)__builtin_amdgcn_update_dpp(0, (int)v, CTRL, ROWMASK, 0xf, false); }
__device__ __forceinline__ unsigned wave_prefix_incl(unsigned v) {
    v += dpp0<0x111, 0xf>(v); v += dpp0<0x112, 0xf>(v); v += dpp0<0x114, 0xf>(v); v += dpp0<0x118, 0xf>(v);
    v += dpp0<0x142, 0xa>(v);
    v += dpp0<0x143, 0xc>(v);
    return v;
}
__device__ __forceinline__ float wave_max_u(float v) {
    v = fmaxf(v, __uint_as_float((unsigned)__builtin_amdgcn_update_dpp(0, (int)__float_as_uint(v), 0x128, 0xf, 0xf, false)));
    v = fmaxf(v, __uint_as_float((unsigned)__builtin_amdgcn_update_dpp(0, (int)__float_as_uint(v), 0x124, 0xf, 0xf, false)));
    v = fmaxf(v, __uint_as_float((unsigned)__builtin_amdgcn_update_dpp(0, (int)__float_as_uint(v), 0x122, 0xf, 0xf, false)));
    v = fmaxf(v, __uint_as_float((unsigned)__builtin_amdgcn_update_dpp(0, (int)__float_as_uint(v), 0x121, 0xf, 0xf, false)));
    const int b = (int)__float_as_uint(v);
    return fmaxf(fmaxf(__uint_as_float((unsigned)__builtin_amdgcn_readlane(b, 0)), __uint_as_float((unsigned)__builtin_amdgcn_readlane(b, 16))),
                 fmaxf(__uint_as_float((unsigned)__builtin_amdgcn_readlane(b, 32)), __uint_as_float((unsigned)__builtin_amdgcn_readlane(b, 48))));
}

typedef short v4i16_t __attribute__((ext_vector_type(4)));
constexpr int DSA_BT_OFF = 131072 + 256, DSA_WS_OFF = DSA_BT_OFF + 6144;
__device__ __forceinline__ unsigned dsa_bucket(float x, float lo, float sc) { const float f = (x - lo) * sc; const unsigned b = (unsigned)f; return b > 255u ? 255u : b; }
__device__ __forceinline__ unsigned off_b(unsigned row, unsigned ch) { return 256u * row + 16u * (ch ^ (((row & 3) << 2) | ((row >> 2) & 3))); }
__device__ __forceinline__ void dsa_mfma_phase(const bf16_t* P, const bf16_t* CN, const float* rel_bias, bf16_t* CAT, LAS unsigned char* lds, unsigned* qctr) {
    const int tid = otid(), lane = tid & 63, wid = __builtin_amdgcn_readfirstlane(tid >> 6);
    LAS float* BT = (LAS float*)(lds + DSA_BT_OFF);
    __syncthreads();
    for (int i = tid; i < 191 * 8; i += NTHREADS) { const int rel = (i >> 3) - 127; BT[i] = rel_bias[t5_bucket(rel) * 8 + (i & 7)]; }
    const unsigned long long lt_mask = (lane == 0) ? 0ull : (~0ull >> (64 - lane));
    volatile LAS int* qslot = (volatile LAS int*)(lds + 131072 + 64);
    int nxt = 0;
    if (tid == 0) { *qslot = (int)atomicAdd(qctr, 1u); nxt = (int)atomicAdd(qctr, 1u); }
    for (;;) {
        __syncthreads();
        const int u = *qslot;
        if (u >= T / 16) break;
        const int b = u & 15, qg = 127 - (u >> 4), t0 = qg * 16, nj = t0 / CHUNK + 1, L = nj * CHUNK, nt = L / 32;
        const bf16_t* Pb = P + (size_t)b * SEQ * PW;
        {
            int ln1 = lane; asm volatile("" : "+v"(ln1));
            const int rho = ln1 & 31, hf = ln1 >> 5;
            const int qq = 2 * ((rho >> 2) & 1) + (rho >> 4), hh = 4 * ((rho >> 3) & 1) + (rho & 3);
            bf16x8 qa[4][4], wa[4], wc[4];
#pragma unroll
            for (int qd = 0; qd < 4; ++qd) {
                const bf16_t* qrow = Pb + (size_t)(t0 + 4 * qd + qq) * PW + P_QI + hh * 64 + 8 * hf;
#pragma unroll
                for (int ks = 0; ks < 4; ++ks) qa[qd][ks] = *(const bf16x8*)(qrow + ks * 16);
                wa[qd] = *(const bf16x8*)(Pb + (size_t)(t0 + 4 * qd + 2 * hf) * PW + P_WI); wc[qd] = *(const bf16x8*)(Pb + (size_t)(t0 + 4 * qd + 2 * hf + 1) * PW + P_WI);
            }
            LAS float* sc0 = (LAS float*)lds + (2 * hf) * 2048 + rho;
            const bf16_t* kbase = Pb + (size_t)rho * PW + P_KI + 8 * hf;
            bf16x8 kb[4], kn[4];
#pragma unroll
            for (int ks = 0; ks < 4; ++ks) { kb[ks] = (bf16x8){0, 0, 0, 0, 0, 0, 0, 0}; kn[ks] = kb[ks]; }
            if (wid < nt) {
#pragma unroll
                for (int ks = 0; ks < 4; ++ks) kb[ks] = *(const bf16x8*)(kbase + (size_t)wid * 32 * PW + ks * 16);
            }
            for (int kt = wid; kt < nt; kt += 8) {
                if (kt + 8 < nt) {
#pragma unroll
                    for (int ks = 0; ks < 4; ++ks) kn[ks] = *(const bf16x8*)(kbase + (size_t)(kt + 8) * 32 * PW + ks * 16);
                }
#pragma unroll
                for (int qd = 0; qd < 4; ++qd) {
                    f32x16 acc;
#pragma unroll
                    for (int r = 0; r < 16; ++r) acc[r] = 0.f;
#pragma unroll
                    for (int ks = 0; ks < 4; ++ks) acc = __builtin_amdgcn_mfma_f32_32x32x16_bf16(qa[qd][ks], kb[ks], acc, 0, 0, 0);
                    float s0 = 0.f, s1 = 0.f;
#pragma unroll
                    for (int e = 0; e < 8; ++e) { s0 += bf2f((unsigned short)wa[qd][e]) * fmaxf(acc[e], 0.f); s1 += bf2f((unsigned short)wc[qd][e]) * fmaxf(acc[8 + e], 0.f); }
                    sc0[(4 * qd) * 2048 + kt * 32] = s0 * (0.35355339059327373f * 0.125f); sc0[(4 * qd + 1) * 2048 + kt * 32] = s1 * (0.35355339059327373f * 0.125f);
                }
#pragma unroll
                for (int ks = 0; ks < 4; ++ks) kb[ks] = kn[ks];
            }
        }
        __syncthreads();
        if (tid == 0) { *qslot = nxt; nxt = (int)atomicAdd(qctr, 1u); }
        LAS unsigned char* pair = lds + wid * 16384;
        LAS unsigned char* wsc = lds + DSA_WS_OFF + wid * 2560;
        LAS unsigned* HIST = (LAS unsigned*)wsc; LAS float* CANDV = (LAS float*)(wsc + 1024); LAS unsigned* CANDI = (LAS unsigned*)(wsc + 1280);
        const int nsel = L < 256 ? L : 256;
        int lna = lane; asm volatile("" : "+v"(lna));
#pragma unroll 1
        for (int e2 = 0; e2 < 2; ++e2) {
            LAS unsigned short* IDX = (LAS unsigned short*)(wsc + 1536 + e2 * 512);
            if (nj > 4) {
                const LAS float* SCq = (const LAS float*)(pair + e2 * 8192);
                float x[32];
#pragma unroll
                for (int j = 0; j < 32; ++j) x[j] = (j < nj) ? SCq[j * 64 + lna] : 0.f;
                float lo = INFINITY, hi = -INFINITY;
#pragma unroll
                for (int j = 0; j < 32; ++j) if (j < nj) { hi = fmaxf(hi, x[j]); lo = fminf(lo, x[j]); }
                hi = wave_max_u(hi); lo = -wave_max_u(-lo);
                bool done = false;
                if (hi > lo) {
                    const float sc = 256.f / (hi - lo);
                    *(LAS u32x4*)(HIST + 4 * lna) = (u32x4){0u, 0u, 0u, 0u};
                    WAVE_LDS_SYNC();
#pragma unroll
                    for (int j = 0; j < 32; ++j) if (j < nj) { const unsigned bk = dsa_bucket(x[j], lo, sc); __hip_atomic_fetch_add(HIST + bk, 1u, __ATOMIC_RELAXED, __HIP_MEMORY_SCOPE_WORKGROUP); }
                    WAVE_LDS_SYNC();
                    const u32x4 h4 = *(const LAS u32x4*)(HIST + 4 * lna);
                    const unsigned cl = (h4.x + h4.y) + (h4.z + h4.w);
                    const unsigned pfx = wave_prefix_incl(cl);
                    const unsigned Sx = (unsigned)__builtin_amdgcn_readlane((int)pfx, 63) - pfx + cl;
                    const int lstar = __popcll(__ballot(Sx >= 256u)) - 1;
                    const unsigned above = Sx - cl, t3 = above + h4.w, t2 = t3 + h4.z, t1 = t2 + h4.y;
                    const unsigned bl = t3 >= 256u ? 3u : (t2 >= 256u ? 2u : (t1 >= 256u ? 1u : 0u));
                    const unsigned al = bl == 3u ? above : (bl == 2u ? t3 : (bl == 1u ? t2 : t1));
                    const unsigned ml = bl == 3u ? h4.w : (bl == 2u ? h4.z : (bl == 1u ? h4.y : h4.x));
                    const unsigned bstar = (unsigned)__builtin_amdgcn_readlane((int)(4u * lna + bl), lstar);
                    const int a = __builtin_amdgcn_readlane((int)al, lstar), m = __builtin_amdgcn_readlane((int)ml, lstar);
                    if (m <= 64) {
                        done = true;
                        const int need = 256 - a;
                        unsigned msel = 0u, mcand = 0u;
#pragma unroll
                        for (int j = 31; j >= 0; --j) if (j < nj) { const unsigned bk = dsa_bucket(x[j], lo, sc); msel = msel + msel + (bk > bstar ? 1u : 0u); mcand = mcand + mcand + (bk == bstar ? 1u : 0u); }
                        const unsigned pk = (unsigned)__popc(msel) | ((unsigned)__popc(mcand) << 16);
                        const unsigned inc = wave_prefix_incl(pk);
                        unsigned off = (inc - pk) & 0xffffu, coff = (inc - pk) >> 16;
                        while (msel) { const int j = __ffs((int)msel) - 1; msel &= msel - 1u; IDX[off++] = (unsigned short)(j * 64 + lna); }
                        while (mcand) { const int j = __ffs((int)mcand) - 1; mcand &= mcand - 1u; CANDV[coff] = SCq[j * 64 + lna]; CANDI[coff] = (unsigned)(j * 64 + lna); ++coff; }
                        WAVE_LDS_SYNC();
                        const float cv = CANDV[lna < m ? lna : 0]; const unsigned ci = CANDI[lna < m ? lna : 0];
                        int rank = 0;
                        for (int k = 0; k < m; ++k) { const float v = __uint_as_float((unsigned)__builtin_amdgcn_readlane((int)__float_as_uint(cv), k)); const unsigned id = (unsigned)__builtin_amdgcn_readlane((int)ci, k); rank += (v > cv || (v == cv && id < ci)) ? 1 : 0; }
                        if (lna < m && rank < need) IDX[a + rank] = (unsigned short)ci;
                    }
                }
                if (!done) {
                    unsigned lo_k = 0xffffffffu, hi_k = 0u;
#pragma unroll
                    for (int j = 0; j < 32; ++j) if (j < nj) { const unsigned kx = sort_key(x[j]); hi_k = kx > hi_k ? kx : hi_k; lo_k = kx < lo_k ? kx : lo_k; }
#pragma unroll
                    for (int o = 1; o < 64; o <<= 1) { const unsigned h2 = (unsigned)__shfl_xor((int)hi_k, o), l2 = (unsigned)__shfl_xor((int)lo_k, o); hi_k = h2 > hi_k ? h2 : hi_k; lo_k = l2 < lo_k ? l2 : lo_k; }
                    lo_k = (unsigned)__builtin_amdgcn_readfirstlane((int)lo_k); hi_k = (unsigned)__builtin_amdgcn_readfirstlane((int)hi_k);
                    bool exact = false;
                    while (lo_k < hi_k) {
                        const unsigned mid = lo_k + ((hi_k - lo_k + 1u) >> 1);
                        int cnt = 0;
#pragma unroll
                        for (int j = 0; j < 32; ++j) cnt += __popcll(__ballot(j < nj && sort_key(x[j]) >= mid));
                        if (cnt == 256) { lo_k = mid; exact = true; break; }
                        if (cnt > 256) lo_k = mid; else hi_k = mid - 1u;
                    }
                    const unsigned Tv = lo_k;
                    int need = 0;
                    if (!exact) { int cgt = 0;
#pragma unroll
                        for (int j = 0; j < 32; ++j) cgt += __popcll(__ballot(j < nj && sort_key(x[j]) > Tv));
                        need = 256 - cgt; }
                    int base = 0, eqt = 0;
#pragma unroll
                    for (int j = 0; j < 32; ++j) {
                        const unsigned kx = sort_key(x[j]);
                        const bool gt = (j < nj) && (exact ? (kx >= Tv) : (kx > Tv)), eq = (j < nj) && !exact && (kx == Tv);
                        const unsigned long long meq = __ballot(eq);
                        const bool sel = gt || (eq && (eqt + __popcll(meq & lt_mask)) < need);
                        const unsigned long long ms = __ballot(sel);
                        if (sel) IDX[base + __popcll(ms & lt_mask)] = (unsigned short)(j * 64 + lna);
                        base += __popcll(ms); eqt += __popcll(meq);
                    }
                }
            } else {
#pragma unroll
                for (int i = 0; i < 4; ++i) IDX[i * 64 + lna] = (unsigned short)(i * 64 + lna);
            }
        }
        WAVE_LDS_SYNC();
        {
            int lnb = lane; asm volatile("" : "+v"(lnb));
            const int head = lnb & 15, kg = lnb >> 4, nblk = nsel >> 5;
            LAS unsigned char* GB = pair;
            const bf16_t* CNb = CN + (size_t)b * SEQ * 128;
            const int rho = lnb & 15;
            const unsigned rw0 = 8 * (rho >> 2) + (rho & 3), rw1 = rw0 + 4;
            const unsigned xa0 = ((rw0 & 3) << 2) | ((rw0 >> 2) & 3), xa1 = ((rw1 & 3) << 2) | ((rw1 >> 2) & 3);
            const unsigned q4 = (lnb & 15) >> 2, p4 = lnb & 3;
            u32x4 gA[8], gB[8];
#define DSA_GATHER(G, IX, blk) do { _Pragma("unroll") for (int it = 0; it < 8; ++it) { const int sp = (IX)[(blk) * 32 + (lnb >> 4) + 4 * it]; G[it] = *(const u32x4*)(CNb + (size_t)sp * 128 + (lnb & 15) * 8); } } while (0)
            { const LAS unsigned short* IDX0 = (const LAS unsigned short*)(wsc + 1536); DSA_GATHER(gA, IDX0, 0); DSA_GATHER(gB, IDX0, 1); }
#pragma unroll 1
            for (int e2 = 0; e2 < 2; ++e2) {
                const int t = t0 + 2 * wid + e2;
                const size_t row = (size_t)b * SEQ + t;
                const LAS unsigned short* IDX = (const LAS unsigned short*)(wsc + 1536 + e2 * 512);
                bf16x8 qlf[4];
#pragma unroll
                for (int s4 = 0; s4 < 4; ++s4) { qlf[s4] = *(const bf16x8*)(P + row * PW + P_QL + (head & 7) * 128 + s4 * 32 + 8 * kg); if (head >= 8) qlf[s4] = (bf16x8){0, 0, 0, 0, 0, 0, 0, 0}; }
                f32x4 o[8];
#pragma unroll
                for (int ct = 0; ct < 8; ++ct) o[ct] = (f32x4){0.f, 0.f, 0.f, 0.f};
                float m = -INFINITY, lsum = 0.f;
#define DSA_STEP(G, kbx) do { \
                    WAVE_LDS_SYNC();                              \
                    _Pragma("unroll") for (int it = 0; it < 8; ++it) *(LAS u32x4*)(GB + off_b((lnb >> 4) + 4 * it, lnb & 15)) = G[it]; \
                    const bf16x8 iv = *(const LAS bf16x8*)((const LAS unsigned char*)IDX + ((kbx) * 32 + 8 * kg) * 2);     \
                    if ((kbx) + 2 < nblk) DSA_GATHER(G, IDX, (kbx) + 2); else if (e2 == 0) DSA_GATHER(G, IDX + 256, (kbx) + 2 - nblk); \
                    WAVE_LDS_SYNC(); \
                      \
                    bf16x8 k0[4], k1[4], af[8]; \
                    _Pragma("unroll") for (int s4 = 0; s4 < 4; ++s4) { \
                        k0[s4] = *(const LAS bf16x8*)(GB + 256u * rw0 + 16u * ((4 * s4 + kg) ^ xa0)); \
                        k1[s4] = *(const LAS bf16x8*)(GB + 256u * rw1 + 16u * ((4 * s4 + kg) ^ xa1)); } \
                    float bia[8]; \
                    _Pragma("unroll") for (int e = 0; e < 8; ++e) { const int sp = (int)(unsigned short)iv[e]; int rel = sp - t; rel = rel < -127 ? -127 : rel; bia[e] = BT[(rel + 127) * 8 + (head & 7)]; } \
                      \
                    f32x4 a0 = (f32x4){0.f, 0.f, 0.f, 0.f}, a1 = (f32x4){0.f, 0.f, 0.f, 0.f}; \
                    _Pragma("unroll") for (int s4 = 0; s4 < 4; ++s4) { \
                        a0 = __builtin_amdgcn_mfma_f32_16x16x32_bf16(k0[s4], qlf[s4], a0, 0, 0, 0); \
                        a1 = __builtin_amdgcn_mfma_f32_16x16x32_bf16(k1[s4], qlf[s4], a1, 0, 0, 0); } \
                    asm volatile("" : "+v"(a0), "+v"(a1));        \
                    _Pragma("unroll") for (int ct = 0; ct < 8; ++ct) {              \
                        const v4i16_t lo4 = __builtin_amdgcn_ds_read_tr16_b64_v4i16((LAS v4i16_t*)(GB + off_b(8 * kg + q4, 2 * ct + (p4 >> 1)) + 8 * (p4 & 1))); \
                        const v4i16_t hi4 = __builtin_amdgcn_ds_read_tr16_b64_v4i16((LAS v4i16_t*)(GB + off_b(8 * kg + 4 + q4, 2 * ct + (p4 >> 1)) + 8 * (p4 & 1))); \
                        af[ct] = (bf16x8){lo4[0], lo4[1], lo4[2], lo4[3], hi4[0], hi4[1], hi4[2], hi4[3]}; } \
                      \
                    float lg[8]; \
                    _Pragma("unroll") for (int e = 0; e < 8; ++e) lg[e] = (e < 4 ? a0[e] : a1[e - 4]) * 0.125f + bia[e]; \
                    const float mloc = fmaxf(fmaxf(fmaxf(lg[0], lg[1]), fmaxf(lg[2], lg[3])), fmaxf(fmaxf(lg[4], lg[5]), fmaxf(lg[6], lg[7]))); \
                      \
                    float scl = 1.f; \
                    if (__any(mloc > m + 16.f)) { \
                        float mb = fmaxf(mloc, __shfl_xor(mloc, 16)); mb = fmaxf(mb, __shfl_xor(mb, 32)); \
                        const float mn = fmaxf(m, mb); scl = __expf(m - mn); m = mn; \
                        _Pragma("unroll") for (int ct = 0; ct < 8; ++ct) o[ct] = o[ct] * scl; } \
                    float ps = 0.f; float pe[8]; \
                    _Pragma("unroll") for (int e = 0; e < 8; ++e) { pe[e] = __expf(lg[e] - m); ps += pe[e]; } \
                    lsum = lsum * scl + ps; \
                    u32x4 pw; pw.x = pk2(pe[0], pe[1]); pw.y = pk2(pe[2], pe[3]); pw.z = pk2(pe[4], pe[5]); pw.w = pk2(pe[6], pe[7]); \
                    const bf16x8 pb = __builtin_bit_cast(bf16x8, pw); \
                    _Pragma("unroll") for (int ct = 0; ct < 8; ++ct) o[ct] = __builtin_amdgcn_mfma_f32_16x16x32_bf16(af[ct], pb, o[ct], 0, 0, 0); \
                } while (0)
#pragma unroll 1
                for (int kb2 = 0; kb2 < nblk; kb2 += 2) { DSA_STEP(gA, kb2); DSA_STEP(gB, kb2 + 1); }
#undef DSA_STEP
                lsum += __shfl_xor(lsum, 16); lsum += __shfl_xor(lsum, 32);
                const float inv = 1.f / lsum;
                if (head < 8) {
                    bf16_t* op = CAT + row * KOUT + head * 128 + 4 * kg;
#pragma unroll
                    for (int ct = 0; ct < 8; ++ct) { u32x2 w; w.x = pk2(o[ct][0] * inv, o[ct][1] * inv); w.y = pk2(o[ct][2] * inv, o[ct][3] * inv); *(u32x2*)(op + ct * 16) = w; }
                }
            }
#undef DSA_GATHER
        }
    }
}

constexpr size_t WS_DEC = 492 * MiB;
__device__ __forceinline__ void hgrn_prep(bf16_t* P, const float* lb, float* DEC, LAS unsigned char* lds, int vb, int nvb) {
    const int tid = otid(), cl = tid >> 7, d = tid & 127;
    LAS bf16_t* Ft = (LAS bf16_t*)lds; LAS bf16_t* Qt = (LAS bf16_t*)(lds + 65536);
    for (int it = vb; it < BATCH * 4 * 8; it += nvb) {
        const int b = it >> 5, h = (it >> 3) & 3, cg = it & 7;
        bf16_t* base = P + ((size_t)b * SEQ + cg * 256) * PW + h * 128;
        u32x4 v[16];
#pragma unroll
        for (int k = 0; k < 16; ++k) { const int i = tid + 512 * k, tl = i >> 12, r = (i >> 4) & 255, ch = i & 15; v[k] = *(const u32x4*)(base + (size_t)r * PW + (tl ? P_QB : P_FB) + ch * 8); }
        __syncthreads();
#pragma unroll
        for (int k = 0; k < 16; ++k) { const int i = tid + 512 * k, tl = i >> 12, r = (i >> 4) & 255, ch = i & 15; *(LAS u32x4*)(lds + tl * 65536 + r * 256 + ch * 16) = v[k]; }
        __syncthreads();
        {
            const float l = lb[h * 128 + d];
            LAS bf16_t* fcol = Ft + (cl * 64) * 128 + d; LAS bf16_t* qcol = Qt + (cl * 64) * 128 + d;
            float ref = 0.f;
#pragma unroll 8
            for (int t = 0; t < 32; ++t) ref += __logf(l + (1.f - l) * sigmoid_f(bf2f(fcol[t * 128])));
            float bi = 0.f;
#pragma unroll 8
            for (int t = 0; t < 64; ++t) {
                const float f = l + (1.f - l) * sigmoid_f(bf2f(fcol[t * 128]));
                bi += __logf(f);
                const float q = silu_f(bf2f(qcol[t * 128]));
                qcol[t * 128] = (bf16_t)f2bf(q * __expf(bi - ref));
                fcol[t * 128] = (bf16_t)f2bf((1.f - f) * __expf(ref - bi));
            }
            float* dc = DEC + ((size_t)((b * 4 + h) * 32 + cg * 4 + cl) * 3) * 128 + d;
            dc[0] = __expf(ref); dc[128] = __expf(bi); dc[256] = __expf(bi - ref);
        }
        __syncthreads();
#pragma unroll
        for (int k = 0; k < 16; ++k) { const int i = tid + 512 * k, tl = i >> 12, r = (i >> 4) & 255, ch = i & 15; *(u32x4*)(base + (size_t)r * PW + (tl ? P_QB : P_FB) + ch * 8) = *(const LAS u32x4*)(lds + tl * 65536 + r * 256 + ch * 16); }
    }
}

__device__ __forceinline__ void hgrn_scan(const bf16_t* P, const float* DEC, const float* o_g, bf16_t* CAT, LAS unsigned char* lds, int item) {
    const int tid = otid(), lane = tid & 63, wid = __builtin_amdgcn_readfirstlane(tid >> 6), li = lane & 15, kg = lane >> 4;
    const int b = item >> 2, h = item & 3, it = wid >> 1, vh = wid & 1;
    LAS unsigned char* ST = lds + 98304;
    LAS float* SSQ = (LAS float*)(lds + DSA_BT_OFF);
    const bf16_t* Pb = P + (size_t)b * SEQ * PW;
    const float* DECb = DEC + (size_t)((b * 4 + h) * 32) * 384;
    f32x4 S[8];
#pragma unroll
    for (int vt = 0; vt < 8; ++vt) S[vt] = (f32x4){0.f, 0.f, 0.f, 0.f};
    u32x4 sg[6];
    const int colbase[3] = {P_QB, P_FB, P_IB};
#define HG_LOAD(c) do { _Pragma("unroll") for (int k = 0; k < 6; ++k) { const int n = tid + 512 * k, tl = n >> 10, r = (n >> 4) & 63, ch = n & 15; \
        sg[k] = *(const u32x4*)(Pb + (size_t)((c) * 64 + r) * PW + colbase[tl] + h * 128 + ch * 8); } } while (0)
#define HG_STORE(buf) do { _Pragma("unroll") for (int k = 0; k < 6; ++k) { const int n = tid + 512 * k, tl = n >> 10, r = (n >> 4) & 63, ch = n & 15; \
        *(LAS u32x4*)(lds + (buf) * 49152 + tl * 16384 + off_b(r, ch)) = sg[k]; } } while (0)
    HG_LOAD(0);
    __syncthreads();
    HG_STORE(0);
    const unsigned q4 = (lane & 15) >> 2, p4 = lane & 3;
    f32x4 ogv[4];
#pragma unroll
    for (int vv = 0; vv < 4; ++vv) ogv[vv] = *(const f32x4*)(o_g + 16 * (4 * vh + vv) + 4 * kg);
    float er_next = DECb[16 * wid + li];
#pragma unroll 1
    for (int c = 0; c < 32; ++c) {
        const int buf = c & 1;
        LAS unsigned char* QI = lds + buf * 49152; LAS unsigned char* KI = QI + 16384; LAS unsigned char* VI = QI + 32768;
        if (c + 1 < 32) HG_LOAD(c + 1);
        const float er = er_next, e63 = DECb[c * 384 + 128 + 16 * wid + li], e6r = DECb[c * 384 + 256 + 16 * wid + li];
        er_next = DECb[(c + 1 < 32 ? c + 1 : c) * 384 + 16 * wid + li];
        u32x2 gwv[4];
#pragma unroll
        for (int vv = 0; vv < 4; ++vv) gwv[vv] = *(const u32x2*)(P + ((size_t)b * SEQ + c * 64 + 16 * it + li) * PW + P_GB + h * 128 + 16 * (4 * vh + vv) + 4 * kg);
        { const unsigned d = 16 * wid + li;
#pragma unroll
          for (int vt = 0; vt < 8; ++vt) { u32x2 w; w.x = pk2(S[vt][0] * er, S[vt][1] * er); w.y = pk2(S[vt][2] * er, S[vt][3] * er);
              *(LAS u32x2*)(ST + off_b(d, 2 * vt + (kg >> 1)) + 8 * (kg & 1)) = w; } }
        __syncthreads();
        bf16x8 qf[4];
#pragma unroll
        for (int ks = 0; ks < 4; ++ks) qf[ks] = *(const LAS bf16x8*)(QI + off_b(16 * it + li, 4 * ks + kg));
        f32x4 o[4];
#pragma unroll
        for (int vv = 0; vv < 4; ++vv) o[vv] = (f32x4){0.f, 0.f, 0.f, 0.f};
#pragma unroll
        for (int ks = 0; ks < 4; ++ks)
#pragma unroll
            for (int vv = 0; vv < 4; ++vv) {
                const int ct = 4 * vh + vv;
                const v4i16_t lo4 = __builtin_amdgcn_ds_read_tr16_b64_v4i16((LAS v4i16_t*)(ST + off_b(32 * ks + 8 * kg + q4, 2 * ct + (p4 >> 1)) + 8 * (p4 & 1)));
                const v4i16_t hi4 = __builtin_amdgcn_ds_read_tr16_b64_v4i16((LAS v4i16_t*)(ST + off_b(32 * ks + 8 * kg + 4 + q4, 2 * ct + (p4 >> 1)) + 8 * (p4 & 1)));
                const bf16x8 af = (bf16x8){lo4[0], lo4[1], lo4[2], lo4[3], hi4[0], hi4[1], hi4[2], hi4[3]};
                o[vv] = __builtin_amdgcn_mfma_f32_16x16x32_bf16(af, qf[ks], o[vv], 0, 0, 0);
            }
        const int njb = (it >> 1) + 1;
#pragma unroll
        for (int jb = 0; jb < 2; ++jb) {
            if (jb < njb) {
                f32x4 a0 = (f32x4){0.f, 0.f, 0.f, 0.f}, a1 = (f32x4){0.f, 0.f, 0.f, 0.f};
                const unsigned rw0 = 32 * jb + 8 * (li >> 2) + (li & 3), rw1 = rw0 + 4;
#pragma unroll
                for (int ks = 0; ks < 4; ++ks) {
                    const bf16x8 k0 = *(const LAS bf16x8*)(KI + off_b(rw0, 4 * ks + kg));
                    const bf16x8 k1 = *(const LAS bf16x8*)(KI + off_b(rw1, 4 * ks + kg));
                    a0 = __builtin_amdgcn_mfma_f32_16x16x32_bf16(k0, qf[ks], a0, 0, 0, 0);
                    a1 = __builtin_amdgcn_mfma_f32_16x16x32_bf16(k1, qf[ks], a1, 0, 0, 0);
                }
                const int ii = 16 * it + li, j0 = 32 * jb + 8 * kg;
                float am[8];
#pragma unroll
                for (int e = 0; e < 8; ++e) am[e] = (j0 + e <= ii) ? (e < 4 ? a0[e] : a1[e - 4]) : 0.f;
                u32x4 pw; pw.x = pk2(am[0], am[1]); pw.y = pk2(am[2], am[3]); pw.z = pk2(am[4], am[5]); pw.w = pk2(am[6], am[7]);
                const bf16x8 pb = __builtin_bit_cast(bf16x8, pw);
#pragma unroll
                for (int vv = 0; vv < 4; ++vv) {
                    const int ct = 4 * vh + vv;
                    const v4i16_t lo4 = __builtin_amdgcn_ds_read_tr16_b64_v4i16((LAS v4i16_t*)(VI + off_b(32 * jb + 8 * kg + q4, 2 * ct + (p4 >> 1)) + 8 * (p4 & 1)));
                    const v4i16_t hi4 = __builtin_amdgcn_ds_read_tr16_b64_v4i16((LAS v4i16_t*)(VI + off_b(32 * jb + 8 * kg + 4 + q4, 2 * ct + (p4 >> 1)) + 8 * (p4 & 1)));
                    const bf16x8 af = (bf16x8){lo4[0], lo4[1], lo4[2], lo4[3], hi4[0], hi4[1], hi4[2], hi4[3]};
                    o[vv] = __builtin_amdgcn_mfma_f32_16x16x32_bf16(af, pb, o[vv], 0, 0, 0);
                }
            }
        }
        {
            f32x4 U[8];
#pragma unroll
            for (int vt = 0; vt < 8; ++vt) U[vt] = (f32x4){0.f, 0.f, 0.f, 0.f};
#pragma unroll
            for (int ks = 0; ks < 2; ++ks) {
                const v4i16_t kl = __builtin_amdgcn_ds_read_tr16_b64_v4i16((LAS v4i16_t*)(KI + off_b(32 * ks + 8 * kg + q4, 2 * wid + (p4 >> 1)) + 8 * (p4 & 1)));
                const v4i16_t kh = __builtin_amdgcn_ds_read_tr16_b64_v4i16((LAS v4i16_t*)(KI + off_b(32 * ks + 8 * kg + 4 + q4, 2 * wid + (p4 >> 1)) + 8 * (p4 & 1)));
                const bf16x8 kfr = (bf16x8){kl[0], kl[1], kl[2], kl[3], kh[0], kh[1], kh[2], kh[3]};
#pragma unroll
                for (int vt = 0; vt < 8; ++vt) {
                    const v4i16_t lo4 = __builtin_amdgcn_ds_read_tr16_b64_v4i16((LAS v4i16_t*)(VI + off_b(32 * ks + 8 * kg + q4, 2 * vt + (p4 >> 1)) + 8 * (p4 & 1)));
                    const v4i16_t hi4 = __builtin_amdgcn_ds_read_tr16_b64_v4i16((LAS v4i16_t*)(VI + off_b(32 * ks + 8 * kg + 4 + q4, 2 * vt + (p4 >> 1)) + 8 * (p4 & 1)));
                    const bf16x8 af = (bf16x8){lo4[0], lo4[1], lo4[2], lo4[3], hi4[0], hi4[1], hi4[2], hi4[3]};
                    U[vt] = __builtin_amdgcn_mfma_f32_16x16x32_bf16(af, kfr, U[vt], 0, 0, 0);
                }
            }
#pragma unroll
            for (int vt = 0; vt < 8; ++vt) S[vt] = S[vt] * e63 + U[vt] * e6r;
        }
        float ss = 0.f;
#pragma unroll
        for (int vv = 0; vv < 4; ++vv) ss += (o[vv][0] * o[vv][0] + o[vv][1] * o[vv][1]) + (o[vv][2] * o[vv][2] + o[vv][3] * o[vv][3]);
        ss += __shfl_xor(ss, 16); ss += __shfl_xor(ss, 32);
        if (kg == 0) SSQ[(it * 2 + vh) * 16 + li] = ss;
        __syncthreads();
        if (c + 1 < 32) HG_STORE(buf ^ 1);
        {
            const float tot = SSQ[(it * 2) * 16 + li] + SSQ[(it * 2 + 1) * 16 + li];
            const float rs = rsqrtf(tot * (1.f / 128.f) + EPS);
            const size_t row = (size_t)b * SEQ + c * 64 + 16 * it + li;
#pragma unroll
            for (int vv = 0; vv < 4; ++vv) {
                const int v0 = 16 * (4 * vh + vv) + 4 * kg;
                const u32x2 gw = gwv[vv];
                const f32x4 og = ogv[vv];
                const float g0 = silu_f(bf2f((unsigned short)(gw.x & 0xffffu))), g1 = silu_f(bf2f((unsigned short)(gw.x >> 16))), g2 = silu_f(bf2f((unsigned short)(gw.y & 0xffffu))), g3 = silu_f(bf2f((unsigned short)(gw.y >> 16)));
                u32x2 w; w.x = pk2(o[vv][0] * rs * og.x * g0, o[vv][1] * rs * og.y * g1); w.y = pk2(o[vv][2] * rs * og.z * g2, o[vv][3] * rs * og.w * g3);
                *(u32x2*)(CAT + row * KOUT + 1024 + h * 128 + v0) = w;
            }
        }
    }
#undef HG_LOAD
#undef HG_STORE
}


__device__ __forceinline__ int swap23(int r) { return (r & ~12) | ((r & 4) << 1) | ((r & 8) >> 1); }
__device__ __forceinline__ void xattn_mfma_phase(const bf16_t* Q, const bf16_t* Kb, const bf16_t* VT, bf16_t* O, LAS unsigned char* lds, int vb, int nvb) {
    const int tid = otid(), lane = tid & 63, wid = __builtin_amdgcn_readfirstlane(tid >> 6), r32 = lane & 31, hf = lane >> 5;
    LAS unsigned char* Ks = lds; LAS unsigned char* Vs = lds + 65536;
    int koff[8], voff[8];
    { const int kr = swap23(r32), x = kr & 15, y = r32 & 15;
#pragma unroll
      for (int ks = 0; ks < 8; ++ks) koff[ks] = kr * 256 + (((ks * 2 + hf) ^ x) << 4);
#pragma unroll
      for (int e = 0; e < 8; ++e) voff[e] = r32 * 512 + (((e * 2 + hf) ^ y) << 4); }
    for (int pair = vb; pair < 256; pair += nvb) {
        const int bh = pair >> 2, b = bh >> 2, h = bh & 3;
        __syncthreads();
        int tio = tid; asm volatile("" : "+v"(tio));
        for (int i = tio; i < 4096; i += NTHREADS) { const int key = i >> 4, ch = i & 15;
            const u32x4 v = *(const u32x4*)(Kb + (size_t)(b * MEMT + key) * 512 + h * 128 + ch * 8);
            *(LAS u32x4*)(Ks + key * 256 + ((ch ^ (key & 15)) << 4)) = v; }
        for (int i = tio; i < 4096; i += NTHREADS) { const int d = i >> 5, ch = i & 31;
            const u32x4 v = *(const u32x4*)(VT + (size_t)(h * 128 + d) * MT + b * MEMT + ch * 8);
            *(LAS u32x4*)(Vs + d * 512 + ((ch ^ (d & 15)) << 4)) = v; }
        __syncthreads();
#pragma unroll 1
        for (int qq = 0; qq < 2; ++qq) {
            const size_t q0 = (size_t)b * SEQ + ((pair & 3) * 2 + qq) * 256 + wid * 32;
            bf16x8 qf[8];
#pragma unroll
            for (int ks = 0; ks < 8; ++ks) qf[ks] = *(const bf16x8*)(Q + (q0 + r32) * 512 + h * 128 + ks * 16 + 8 * hf);
            f32x16 st[8];
            __builtin_amdgcn_s_setprio(1);
#pragma unroll
            for (int kt = 0; kt < 8; ++kt) {
#pragma unroll
                for (int r = 0; r < 16; ++r) st[kt][r] = 0.f;
#pragma unroll
                for (int ks = 0; ks < 8; ++ks) {
                    const bf16x8 a = *(const LAS bf16x8*)(Ks + koff[ks] + kt * 8192);
                    st[kt] = __builtin_amdgcn_mfma_f32_32x32x16_bf16(a, qf[ks], st[kt], 0, 0, 0);
                }
            }
            __builtin_amdgcn_s_setprio(0);
            float mx = -INFINITY;
#pragma unroll
            for (int kt = 0; kt < 8; ++kt)
#pragma unroll
                for (int r = 0; r < 16; ++r) mx = fmaxf(mx, st[kt][r]);
            mx = fmaxf(mx, __shfl_xor(mx, 32));
            const float c = 0.08838834764831845f * 1.4426950408889634f;
            float sum = 0.f;
#pragma unroll
            for (int kt = 0; kt < 8; ++kt)
#pragma unroll
                for (int r = 0; r < 16; ++r) { const float e = __builtin_amdgcn_exp2f((st[kt][r] - mx) * c); st[kt][r] = e; sum += e; }
            sum += __shfl_xor(sum, 32);
            const float inv = 1.f / sum;
            bf16x8 pfr[8][2];
#pragma unroll
            for (int kt = 0; kt < 8; ++kt)
#pragma unroll
                for (int s2 = 0; s2 < 2; ++s2) {
                    u32x4 pw;
                    pw.x = pk2(st[kt][8 * s2 + 0], st[kt][8 * s2 + 1]); pw.y = pk2(st[kt][8 * s2 + 2], st[kt][8 * s2 + 3]);
                    pw.z = pk2(st[kt][8 * s2 + 4], st[kt][8 * s2 + 5]); pw.w = pk2(st[kt][8 * s2 + 6], st[kt][8 * s2 + 7]);
                    pfr[kt][s2] = __builtin_bit_cast(bf16x8, pw);
                }
#pragma unroll
            for (int kt = 0; kt < 8; ++kt) asm volatile("" : "+v"(pfr[kt][0]), "+v"(pfr[kt][1]));
            f32x16 o[4];
#pragma unroll
            for (int dt = 0; dt < 4; ++dt)
#pragma unroll
                for (int r = 0; r < 16; ++r) o[dt][r] = 0.f;
            __builtin_amdgcn_s_setprio(1);
#pragma unroll
            for (int kt = 0; kt < 8; ++kt)
#pragma unroll
                for (int s2 = 0; s2 < 2; ++s2)
#pragma unroll
                    for (int dt = 0; dt < 4; ++dt) {
                        const bf16x8 a = *(const LAS bf16x8*)(Vs + voff[(kt & 3) * 2 + s2] + dt * 16384 + (kt >> 2) * 256);
                        o[dt] = __builtin_amdgcn_mfma_f32_32x32x16_bf16(a, pfr[kt][s2], o[dt], 0, 0, 0);
                    }
            __builtin_amdgcn_s_setprio(0);
            bf16_t* orow = O + (q0 + r32) * 512 + h * 128 + 4 * hf;
#pragma unroll
            for (int dt = 0; dt < 4; ++dt)
#pragma unroll
                for (int g = 0; g < 4; ++g) {
                    u32x2 w; w.x = pk2(o[dt][4 * g] * inv, o[dt][4 * g + 1] * inv); w.y = pk2(o[dt][4 * g + 2] * inv, o[dt][4 * g + 3] * inv);
                    *(u32x2*)(orow + dt * 32 + 8 * g) = w;
                }
        }
    }
}


__device__ __forceinline__ void gmlp_mfma_phase(const bf16_t* UV, const float* lnp, const float* ln_g, const float* ln_b, const float* w_sp, const float* b_sp, bf16_t* G, LAS unsigned char* lds, int vb, int nvb) {
    const int tid = otid(), lane = tid & 63, wid = __builtin_amdgcn_readfirstlane(tid >> 6), fr = lane & 15, fq = lane >> 4;
    LAS unsigned char* Wb = lds; LAS unsigned char* VTs = lds + 32768; LAS float* STAT = (LAS float*)(lds + 65536);
    int gcur = -1;
    for (int grp = vb; grp < 256; grp += nvb) {
        const int g = grp >> 5;
        bf16x8 vch[4]; f32x4 lp[2];
#define GM_LOAD(uu_) do { const size_t r0_ = (size_t)((grp & 31) * 8 + (uu_)) * 128; \
            _Pragma("unroll") for (int k = 0; k < 4; ++k) { const int i = tid + 512 * k, sI = i >> 4, ch = i & 15; vch[k] = *(const bf16x8*)(UV + (r0_ + sI) * 2048 + 1024 + g * 128 + ch * 8); } \
            lp[0] = *(const f32x4*)(lnp + (r0_ + (tid >> 2)) * 32 + (tid & 3) * 8); lp[1] = *(const f32x4*)(lnp + (r0_ + (tid >> 2)) * 32 + (tid & 3) * 8 + 4); } while (0)
        GM_LOAD(0);
        const f32x4 g0 = *(const f32x4*)(ln_g + g * 128 + (tid & 15) * 8), g1 = *(const f32x4*)(ln_g + g * 128 + (tid & 15) * 8 + 4);
        const f32x4 b0 = *(const f32x4*)(ln_b + g * 128 + (tid & 15) * 8), b1 = *(const f32x4*)(ln_b + g * 128 + (tid & 15) * 8 + 4);
        const float gg[8] = {g0.x, g0.y, g0.z, g0.w, g1.x, g1.y, g1.z, g1.w}, bb[8] = {b0.x, b0.y, b0.z, b0.w, b1.x, b1.y, b1.z, b1.w};
        __syncthreads();
        if (g != gcur) {
            gcur = g;
            for (int i = tid; i < 2048; i += NTHREADS) { const int t = i >> 4, ch = i & 15;
                const f32x4 a = *(const f32x4*)(w_sp + (size_t)g * 16384 + t * 128 + ch * 8), b = *(const f32x4*)(w_sp + (size_t)g * 16384 + t * 128 + ch * 8 + 4);
                const int s0 = ch * 8;
                u32x4 w; w.x = pk2(s0 + 0 <= t ? a.x : 0.f, s0 + 1 <= t ? a.y : 0.f); w.y = pk2(s0 + 2 <= t ? a.z : 0.f, s0 + 3 <= t ? a.w : 0.f);
                w.z = pk2(s0 + 4 <= t ? b.x : 0.f, s0 + 5 <= t ? b.y : 0.f); w.w = pk2(s0 + 6 <= t ? b.z : 0.f, s0 + 7 <= t ? b.w : 0.f);
                *(LAS u32x4*)(Wb + t * 256 + ((ch ^ (t & 15)) << 4)) = w; }
        }
        const int trow = wid * 16 + fr;
        const float bias = b_sp[g * 128 + trow];
#pragma unroll 1
        for (int uu = 0; uu < 8; ++uu) {
            const int bn = (grp & 31) * 8 + uu;
            const size_t row0 = (size_t)bn * 128;
            if (uu) __syncthreads();
            { float s1 = (lp[0].x + lp[0].z) + (lp[1].x + lp[1].z), s2 = (lp[0].y + lp[0].w) + (lp[1].y + lp[1].w);
              s1 += __shfl_xor(s1, 1); s2 += __shfl_xor(s2, 1); s1 += __shfl_xor(s1, 2); s2 += __shfl_xor(s2, 2);
              const float mu = s1 * (1.f / 1024.f), var = fmaxf(s2 * (1.f / 1024.f) - mu * mu, 0.f);
              if ((tid & 3) == 0) { STAT[2 * (tid >> 2)] = mu; STAT[2 * (tid >> 2) + 1] = rsqrtf(var + EPS); } }
            __syncthreads();
#pragma unroll
            for (int k = 0; k < 4; ++k) { const int i = tid + 512 * k, sI = i >> 4, ch = i & 15;
                const float mu = STAT[2 * sI], rs = STAT[2 * sI + 1];
#pragma unroll
                for (int e = 0; e < 8; ++e) { const int c = ch * 8 + e; const float x = (bf2f((unsigned short)vch[k][e]) - mu) * rs * gg[e] + bb[e];
                    *(LAS bf16_t*)(VTs + c * 256 + (((sI >> 3) ^ ((c ^ (c >> 3)) & 15)) << 4) + (sI & 7) * 2) = (bf16_t)f2bf(x); } }
            if (uu + 1 < 8) GM_LOAD(uu + 1);
            const size_t orow = row0 + trow;
            u32x2 uwv[8];
#pragma unroll
            for (int ct = 0; ct < 8; ++ct) uwv[ct] = *(const u32x2*)(UV + orow * 2048 + g * 128 + ct * 16 + 4 * fq);
            __syncthreads();
            f32x4 acc[8];
#pragma unroll
            for (int ct = 0; ct < 8; ++ct) acc[ct] = (f32x4){0.f, 0.f, 0.f, 0.f};
#pragma unroll
            for (int ks = 0; ks < 4; ++ks) {
                const bf16x8 wf = *(const LAS bf16x8*)(Wb + trow * 256 + (((ks * 4 + fq) ^ (trow & 15)) << 4));
#pragma unroll
                for (int ct = 0; ct < 8; ++ct) {
                    const int crow = ct * 16 + fr;
                    const bf16x8 vf = *(const LAS bf16x8*)(VTs + crow * 256 + (((ks * 4 + fq) ^ ((crow ^ (crow >> 3)) & 15)) << 4));
                    acc[ct] = __builtin_amdgcn_mfma_f32_16x16x32_bf16(vf, wf, acc[ct], 0, 0, 0);
                }
            }
#pragma unroll
            for (int ct = 0; ct < 8; ++ct) {
                const int c = ct * 16 + 4 * fq;
                const u32x2 uw = uwv[ct];
                const float u0 = bf2f((unsigned short)(uw.x & 0xffffu)), u1 = bf2f((unsigned short)(uw.x >> 16)), u2 = bf2f((unsigned short)(uw.y & 0xffffu)), u3 = bf2f((unsigned short)(uw.y >> 16));
                u32x2 w; w.x = pk2(u0 * (acc[ct][0] + bias), u1 * (acc[ct][1] + bias)); w.y = pk2(u2 * (acc[ct][2] + bias), u3 * (acc[ct][3] + bias));
                *(u32x2*)(G + orow * 1024 + g * 128 + c) = w;
            }
        }
#undef GM_LOAD
    }
}

#define GAS __attribute__((address_space(1)))
typedef GAS unsigned gu32;
#define XB_TMO      128
#define XB_XCNT(j)  (256  + 64 * (j))
#define XB_XSUB(j)  (1280 + 64 * (j))
#define XB_XGEN(j)  (2304 + 64 * (j))
#define XB_TOP      3328
#define XB_TOPGEN   3392
#define XCD_BAR_WORDS 3456
#define XB_SPIN_CAP (1u << 18)

__device__ __forceinline__ unsigned xb_ld(unsigned* p)              { return __hip_atomic_load(p, __ATOMIC_RELAXED, __HIP_MEMORY_SCOPE_AGENT); }
__device__ __forceinline__ unsigned xb_add(unsigned* p, unsigned v) { return __hip_atomic_fetch_add(p, v, __ATOMIC_RELAXED, __HIP_MEMORY_SCOPE_AGENT); }
__device__ __forceinline__ unsigned xb_xcc_id() { return (unsigned)__builtin_amdgcn_s_getreg((3 << 11) | 20) & 0xFu; }
#define XB_SPIN(cond, bar) do { unsigned _sp = 0; while (cond) { __builtin_amdgcn_s_sleep(1); \
    if ((++_sp & 255u) == 0u) { if (xb_ld(&(bar)[XB_TMO])) break; if (_sp > XB_SPIN_CAP) { atomicAdd(&(bar)[XB_TMO], 1u); break; } } } } while (0)

struct XcdBarrier {
    unsigned* bar; unsigned x;
    volatile LAS unsigned* st;
};

__device__ __forceinline__ XcdBarrier xcd_barrier_post(unsigned* bar, volatile LAS unsigned* st) {
    XcdBarrier b; b.bar = bar; b.x = xb_xcc_id(); b.st = st;
    if (threadIdx.x == 0) (void)xb_add(&bar[XB_XCNT(b.x)], 1u);
    return b;
}
__device__ __forceinline__ void xcd_barrier_complete(unsigned* bar, unsigned x, unsigned& nloc, unsigned& nx) {
    const unsigned G = gridDim.x * gridDim.y * gridDim.z;
    unsigned sum, cnt, mine, sp = 0u;
    for (;;) {
        sum = 0u; cnt = 0u; mine = 0u;
#pragma unroll
        for (unsigned j = 0; j < 16; ++j) { const unsigned c = xb_ld(&bar[XB_XCNT(j)]); sum += c; cnt += (c > 0u) ? 1u : 0u; mine = (j == x) ? c : mine; }
        if (sum == G) break;
        __builtin_amdgcn_s_sleep(1);
        if ((++sp & 255u) == 0u) { if (xb_ld(&bar[XB_TMO])) break; if (sp > XB_SPIN_CAP) { atomicAdd(&bar[XB_TMO], 1u); break; } }
    }
    nloc = mine > 0u ? mine : 1u; nx = cnt > 0u ? cnt : 1u;
}

__device__ __forceinline__ void xcd_barrier(const XcdBarrier& b) {
    asm volatile("s_waitcnt vmcnt(0)" ::: "memory");
    __syncthreads();
    if (threadIdx.x == 0) {
        unsigned* bar = b.bar;
        __builtin_amdgcn_s_waitcnt(0);
        unsigned nloc = b.st[0], nx = b.st[1];
        if (nloc == 0u) { xcd_barrier_complete(bar, b.x, nloc, nx); b.st[0] = nloc; b.st[1] = nx; }
        const unsigned old = xb_add(&bar[XB_XSUB(b.x)], 1u);
        const unsigned gen = old / nloc;
        if (old + 1u == (gen + 1u) * nloc) {
            __builtin_amdgcn_fence(__ATOMIC_RELEASE, "agent");
            asm volatile("s_waitcnt vmcnt(0)" ::: "memory");
            const unsigned og = xb_add(&bar[XB_TOP], 1u);
            const unsigned tg = og / nx;
            if (og + 1u == (tg + 1u) * nx) xb_add(&bar[XB_TOPGEN], 1u);
            else XB_SPIN(xb_ld(&bar[XB_TOPGEN]) == tg, bar);
            __builtin_amdgcn_fence(__ATOMIC_ACQUIRE, "agent");
            xb_add(&bar[XB_XGEN(b.x)], 1u);
            asm volatile("s_waitcnt vmcnt(0)" ::: "memory");
        } else {
            XB_SPIN(xb_ld(&bar[XB_XGEN(b.x)]) == gen, bar);
            __builtin_amdgcn_fence(__ATOMIC_ACQUIRE, "agent");
            asm volatile("s_waitcnt vmcnt(0)" ::: "memory");
        }
    }
    __syncthreads();
}

constexpr int LDS_BYTES = 32768 * 4 + 256 + 6144 + 8 * 2560;

enum Phase {
    PH_PREP = 0, PH_GEMM_IN, PH_CNORM, PH_MIX0  , PH_GEMM_OUT0,
    PH_GEMM_Q0, PH_XATTN0, PH_GEMM_O0, PH_GEMM_GU0, PH_GEMM_DN0,
    PH_GEMM_OIN, PH_GMLP, PH_GEMM_OOUT,
    PH_GEMM_Q1, PH_XATTN1, PH_GEMM_O1, PH_GEMM_GU1, PH_GEMM_DN1, PH_FINAL, PH_COUNT
};

__device__ __forceinline__ PrepJob make_job(const Params& p, int ji) {
    unsigned char* ws = p.ws; PrepJob j{};
    switch (ji) {
    case 0: j = PrepJob{p.in[5], 1024, 3272, p.in[4], (bf16_t*)(ws + WS_WIN), 1024, PW, 1024, 0, MAP_WIN}; break;
    case 1: j = PrepJob{p.in[10] + (size_t)512 * 1024, 512, 1024, nullptr, (bf16_t*)(ws + WS_WOUT), 0, 1024, KOUT, 1024, MAP_ID}; break;
    case 2: j = PrepJob{p.in[11], 1024, 2048, p.in[4] + 1024, (bf16_t*)(ws + WS_OWIN), 0, 2048, 1024, 0, MAP_ID}; break;
    case 3: j = PrepJob{p.in[16], 1024, 1024, nullptr, (bf16_t*)(ws + WS_OWOUT), 0, 1024, 1024, 0, MAP_ID}; break;
    case 4: case 5: { const int l = ji - 4; j = PrepJob{p.in[19] + (size_t)l * 1024 * 512, 1024, 512, p.in[17] + l * 1024, (bf16_t*)(ws + WS_WQ) + (size_t)l * 512 * 1024, 0, 512, 1024, 0, MAP_ID}; } break;
    case 6: case 7: { const int l = ji - 6; j = PrepJob{p.in[20] + (size_t)l * 1024 * 1024, 1024, 1024, p.in[18] + l * 1024, (bf16_t*)(ws + WS_WKV) + (size_t)l * 1024 * 1024, 0, 1024, 1024, 0, MAP_ID}; } break;
    case 8: case 9: { const int l = ji - 8; j = PrepJob{p.in[21] + (size_t)l * 512 * 1024, 512, 1024, nullptr, (bf16_t*)(ws + WS_WO) + (size_t)l * 1024 * 512, 0, 1024, 512, 0, MAP_ID}; } break;
    case 10: case 11: { const int l = ji - 10; j = PrepJob{p.in[23] + (size_t)l * 1024 * 2 * FF, 1024, 2 * FF, p.in[22] + l * 1024, (bf16_t*)(ws + WS_WGU + (size_t)l * 2 * FF * 1024), 0, 2 * FF, 1024, 0, MAP_GU, 2, WQ_GU}; } break;
#if DN_FP8
    default: { const int l = ji - 12; j = PrepJob{p.in[24] + (size_t)l * FF * 1024, FF, 1024, nullptr, (bf16_t*)(ws + WS_WDN + (size_t)l * 1024 * FF), 0, 1024, FF, 0, MAP_ID, 1, WDN_SC}; } break;
#else
    default: { const int l = ji - 12; j = PrepJob{p.in[24] + (size_t)l * FF * 1024, FF, 1024, nullptr, (bf16_t*)(ws + WS_WDN) + (size_t)l * 1024 * FF, 0, 1024, FF, 0, MAP_ID}; } break;
#endif
    }
    return j;
}
constexpr int N_PREP_JOBS = 14;

template <int ph> __device__ __forceinline__ void run_phase(const Params& p, LAS float* lds, int vb, int nvb) {
    unsigned char* ws = p.ws;
    bf16_t* HN = (bf16_t*)(ws + WS_HN); bf16_t* BIG = (bf16_t*)(ws + WS_BIG); bf16_t* CN = (bf16_t*)(ws + WS_CN); bf16_t* CAT = (bf16_t*)(ws + WS_CAT);
    bf16_t* KB = (bf16_t*)(ws + WS_KB); bf16_t* VTB = (bf16_t*)(ws + WS_VT); bf16_t* MEMN = (bf16_t*)(ws + WS_MEMN); float* lb = (float*)(ws + WS_LB);
    float* ssq = (float*)(ws + WS_SSQ); float* lnp = (float*)(ws + WS_LNP);
    bf16_t* XQ = BIG; bf16_t* XO = BIG + (size_t)T * 512;
    const int l = (ph >= PH_GEMM_Q1) ? 1 : 0;
    switch (ph) {
    case PH_PREP:
        x_to_h_rows(p.in[0], HN, ssq, vb, nvb);
        {
            constexpr int NT_[N_PREP_JOBS] = {16 * 11, 8 * 4, 16 * 8, 16 * 4, 16 * 2, 16 * 2, 16 * 4, 16 * 4, 8 * 4, 8 * 4, 16 * 22, 16 * 22, 44 * 4, 44 * 4};
            constexpr int CUM1 = NT_[0], CUM2 = CUM1 + NT_[1], CUM3 = CUM2 + NT_[2], CUM4 = CUM3 + NT_[3], CUM5 = CUM4 + NT_[4], CUM6 = CUM5 + NT_[5], CUM7 = CUM6 + NT_[6],
                          CUM8 = CUM7 + NT_[7], CUM9 = CUM8 + NT_[8], CUM10 = CUM9 + NT_[9], CUM11 = CUM10 + NT_[10], CUM12 = CUM11 + NT_[11], CUM13 = CUM12 + NT_[12], CUM14 = CUM13 + NT_[13];
#define PJ_FIND(it_, ji_, base_) do { ji_ = 0; base_ = 0; \
                PJ_STEP(it_, ji_, base_, 1, CUM1) PJ_STEP(it_, ji_, base_, 2, CUM2) PJ_STEP(it_, ji_, base_, 3, CUM3) PJ_STEP(it_, ji_, base_, 4, CUM4) PJ_STEP(it_, ji_, base_, 5, CUM5) PJ_STEP(it_, ji_, base_, 6, CUM6) PJ_STEP(it_, ji_, base_, 7, CUM7) \
                PJ_STEP(it_, ji_, base_, 8, CUM8) PJ_STEP(it_, ji_, base_, 9, CUM9) PJ_STEP(it_, ji_, base_, 10, CUM10) PJ_STEP(it_, ji_, base_, 11, CUM11) PJ_STEP(it_, ji_, base_, 12, CUM12) PJ_STEP(it_, ji_, base_, 13, CUM13) } while (0)
#define PJ_STEP(it_, ji_, base_, q, c) if ((it_) >= (c)) { ji_ = (q); base_ = (c); }
            f32x4 va[8], vn[8];
            int ji, base;
            if (vb < CUM14) { PJ_FIND(vb, ji, base); const PrepJob j = make_job(p, ji); prep_tile_load(j, vb - base, va); }
            for (int it = vb; it < CUM14; it += nvb) {
                PJ_FIND(it, ji, base);
                const PrepJob j = make_job(p, ji); const int tl = it - base;
                if (it + nvb < CUM14) { int jn, bn; PJ_FIND(it + nvb, jn, bn); const PrepJob j2 = make_job(p, jn); prep_tile_load(j2, it + nvb - bn, vn); }
                prep_tile_store(j, tl, va, lds);
#pragma unroll
                for (int q = 0; q < 8; ++q) va[q] = vn[q];
            }
#undef PJ_STEP
#undef PJ_FIND
        }
        prep_fold_in(p.in[5], p.in[7], p.in[4], (bf16_t*)(ws + WS_WIN), lds, vb, nvb);
        prep_fold_out(p.in[10], p.in[8], (bf16_t*)(ws + WS_WOUT), lds, vb, nvb);
        prep_lb(p.in[3], lb, vb, nvb);
        rmsnorm_rows(p.in[1], MEMN, MT, vb, nvb);
        break;
    case PH_GEMM_IN: {
        Gemm g{(const bf16_t*)(ws + WS_WIN), (const bf16_t*)(ws + WS_WIN), T, PW, 1024}; EpiIn E{BIG, KB, VTB, ssq};
        pg8::ComboOrder S; S.init(nvb, vb);
        pg8::gemm_phase<EpiIn, pg8::ComboOrder, true, true>((LAS unsigned char*)lds, g, S, E);
    } break;
    case PH_CNORM: cnorm_rows(BIG, p.in[6], CN, vb, nvb); hgrn_prep(BIG, lb, (float*)(ws + WS_DEC), (LAS unsigned char*)lds, vb, nvb); break;
    case PH_MIX0:
        for (int item = vb; item < 64; item += nvb) hgrn_scan(BIG, (const float*)(ws + WS_DEC), p.in[9], CAT, (LAS unsigned char*)lds, item);
        dsa_mfma_phase(BIG, CN, p.in[2], CAT, (LAS unsigned char*)lds, (unsigned*)(ws + WS_CTL) + 3600);
        break;
    case PH_GEMM_OUT0: { Gemm g{CAT, (const bf16_t*)(ws + WS_WOUT), T, 1024, KOUT}; EpiResid<false> E{nullptr, HN, ssq}; run_gemm(g, E, lds, vb, nvb); } break;
    case PH_GEMM_Q0: case PH_GEMM_Q1: { Gemm g{HN, (const bf16_t*)(ws + WS_WQ) + (size_t)l * 512 * 1024, T, 512, 1024}; EpiStoreBf16 E{XQ, 512, ssq}; run_gemm(g, E, lds, vb, nvb); } break;
    case PH_XATTN0: case PH_XATTN1: xattn_mfma_phase(XQ, KB + (size_t)l * MT * 512, VTB + (size_t)l * 512 * MT, XO, (LAS unsigned char*)lds, vb, nvb); break;
    case PH_GEMM_O0: case PH_GEMM_O1: { Gemm g{XO, (const bf16_t*)(ws + WS_WO) + (size_t)l * 1024 * 512, T, 1024, 512}; EpiResid<false, false, true> E{nullptr, HN, ssq, ws + WS_H8, l ? HQ_GU1 : HQ_GU0}; run_gemm(g, E, lds, vb, nvb); } break;
    case PH_GEMM_GU0: case PH_GEMM_GU1: { Gemm g{(const bf16_t*)(ws + WS_H8), (const bf16_t*)(ws + WS_WGU + (size_t)l * 2 * FF * 1024), T, 2 * FF, 512}; EpiSwigluQ<true, DN_FP8 != 0> E{BIG, FF, ssq, 1.f / ((l ? HQ_GU1 : HQ_GU0) * WQ_GU)}; run_gemm<EpiSwigluQ<true, DN_FP8 != 0>, 2>(g, E, lds, vb, nvb); } break;
    case PH_GEMM_DN0: case PH_GEMM_DN1:
#if DN_FP8
        { Gemm g{BIG, (const bf16_t*)(ws + WS_WDN + (size_t)l * 1024 * FF), T, 1024, FF / 2}; EpiResid<false, true> E{nullptr, HN, ssq}; run_gemm<EpiResid<false, true>, 1>(g, E, lds, vb, nvb); } break;
#else
        { Gemm g{BIG, (const bf16_t*)(ws + WS_WDN) + (size_t)l * 1024 * FF, T, 1024, FF}; EpiResid<false> E{nullptr, HN, ssq}; run_gemm(g, E, lds, vb, nvb); } break;
#endif
    case PH_GEMM_OIN: { Gemm g{HN, (const bf16_t*)(ws + WS_OWIN), T, 2048, 1024}; EpiGeluBf16 E{BIG, 2048, ssq, lnp}; run_gemm(g, E, lds, vb, nvb); } break;
    case PH_GMLP: gmlp_mfma_phase(BIG, lnp, p.in[12], p.in[13], p.in[14], p.in[15], CAT, (LAS unsigned char*)lds, vb, nvb); break;
    case PH_GEMM_OOUT: { Gemm g{CAT, (const bf16_t*)(ws + WS_OWOUT), T, 1024, 1024}; EpiResid<false> E{nullptr, HN, ssq}; run_gemm(g, E, lds, vb, nvb); } break;
    case PH_FINAL: final_rows(HN, ssq, p.in[25], p.out, vb, nvb); break;
    default: break;
    }
}

template <int PH> __global__ void __launch_bounds__(NTHREADS) k_phase(Params p) {
    extern __shared__ __attribute__((aligned(16))) float smem[];
    run_phase<PH>(p, (LAS float*)smem, blockIdx.x, gridDim.x);
}

template <int PH> __device__ __forceinline__ void mega_phases(const Params& p, LAS float* lds, const XcdBarrier& bar) {
    run_phase<PH>(p, lds, blockIdx.x, gridDim.x);
#ifdef REPEAT_PH
    if constexpr (PH == REPEAT_PH) { xcd_barrier(bar); run_phase<PH>(p, lds, blockIdx.x, gridDim.x); }
#endif
    if constexpr (PH + 1 < PH_COUNT) { xcd_barrier(bar); mega_phases<PH + 1>(p, lds, bar); }
}
__global__ void __launch_bounds__(NTHREADS) k_mega(Params p) {
    extern __shared__ __attribute__((aligned(16))) float smem[];
    volatile LAS unsigned* st = (volatile LAS unsigned*)((LAS float*)smem + 32768);
    if (threadIdx.x < 2) st[threadIdx.x] = 0u;
    __syncthreads();
    const XcdBarrier bar = xcd_barrier_post((unsigned*)(p.ws + WS_CTL), st);
    mega_phases<0>(p, (LAS float*)smem, bar);
}

template <int PH> static void launch_phases(const Params& p, int grid, hipStream_t stream) {
    int g = grid * 4;
    if (PH == PH_MIX0 || PH == PH_XATTN0 || PH == PH_XATTN1 || PH == PH_GMLP) g = grid;
    (void)hipFuncSetAttribute((const void*)k_phase<PH>, hipFuncAttributeMaxDynamicSharedMemorySize, LDS_BYTES);
    hipLaunchKernelGGL(k_phase<PH>, dim3(g), dim3(NTHREADS), LDS_BYTES, stream, p);
    if constexpr (PH + 1 < PH_COUNT) launch_phases<PH + 1>(p, grid, stream);
}

extern "C" void kernel_launch(void* const* d_in, const int* in_sizes, int n_in, void* d_out, int out_size, void* d_ws, size_t ws_size, hipStream_t stream) {
    static int grid = 0;
    if (grid == 0) {
        if (n_in != 26 || out_size != T * D || ws_size < WS_END) { fprintf(stderr, "kernel_launch: unexpected shapes (n_in %d out %d ws %zu)\n", n_in, out_size, ws_size); grid = -1; return; }
        int dev = 0, cus = 0;
        (void)hipGetDevice(&dev); (void)hipDeviceGetAttribute(&cus, hipDeviceAttributeMultiprocessorCount, dev);
        (void)hipFuncSetAttribute((const void*)k_mega, hipFuncAttributeMaxDynamicSharedMemorySize, LDS_BYTES);
        int per_cu = 0;
        (void)hipOccupancyMaxActiveBlocksPerMultiprocessor(&per_cu, (const void*)k_mega, NTHREADS, LDS_BYTES);
        if (per_cu < 1) fprintf(stderr, "kernel_launch: occupancy query says %d blocks per CU\n", per_cu);
        (void)hipGetLastError();
        grid = cus > 0 ? cus : 256;
    }
    if (grid < 0) return;
    Params p{};
    for (int i = 0; i < 26; ++i) p.in[i] = (const float*)d_in[i];
    p.out = (float*)d_out; p.ws = (unsigned char*)d_ws;
    (void)hipMemsetAsync((char*)d_ws + WS_CTL, 0, 16384, stream);
#if MEGA
    hipLaunchKernelGGL(k_mega, dim3(grid), dim3(NTHREADS), LDS_BYTES, stream, p);
#else
    launch_phases<0>(p, grid, stream);
#endif
}
```

```cpp
#include <hip/hip_runtime.h>
#include <stdint.h>
#include <stdio.h>

#ifndef MEGA
#define MEGA 1
#endif
#ifndef DN_FP8
#define DN_FP8 0
#endif

#define LAS __attribute__((address_space(3)))
typedef unsigned short bf16_t;
typedef short bf16x8 __attribute__((ext_vector_type(8)));
typedef float f32x4 __attribute__((ext_vector_type(4)));
typedef float f32x2 __attribute__((ext_vector_type(2)));
typedef unsigned u32x4 __attribute__((ext_vector_type(4)));
typedef unsigned u32x2 __attribute__((ext_vector_type(2)));
typedef float f32x16 __attribute__((ext_vector_type(16)));

constexpr int D = 1024, BATCH = 16, SEQ = 2048, T = BATCH * SEQ;
constexpr int CHUNK = 64;
constexpr int MEMT = 256, MT = BATCH * MEMT;
constexpr int FF = 2816;
constexpr float EPS = 1e-6f;
constexpr int NTHREADS = 512, NWAVES = 8;

constexpr int P_QL = 0, P_C = 1024, P_QI = 1152, P_KI = 1664, P_FB = 1728, P_IB = 2240, P_QB = 2752, P_GB = 3264, P_WI = 3776, P_END = 3784, PW = 3840;
constexpr int KOUT = 1536;

constexpr size_t MiB = 1u << 20;
constexpr size_t WS_CTL = 0;
constexpr size_t WS_LB = 64 * 1024;
constexpr size_t WS_SSQ = 496 * MiB;
constexpr size_t WS_LNP = 498 * MiB;
constexpr size_t WS_WIN = 1 * MiB;
constexpr size_t WS_WKV = WS_WIN + (size_t)PW * D * 2;
constexpr size_t WS_HN = WS_WKV + 2 * (size_t)D * D * 2;
constexpr size_t WS_MEMN = WS_HN + (size_t)T * D * 2;
constexpr size_t WS_WOUT = WS_MEMN + (size_t)MT * D * 2;
constexpr size_t WS_OWIN = WS_WOUT + (size_t)D * KOUT * 2;
constexpr size_t WS_OWOUT = WS_OWIN + (size_t)2048 * D * 2;
constexpr size_t WS_WQ = WS_OWOUT + (size_t)D * D * 2;
constexpr size_t WS_WO = WS_WQ + 2 * (size_t)512 * D * 2;
constexpr size_t WS_WGU = WS_WO + 2 * (size_t)D * 512 * 2;
constexpr size_t WS_WDN = WS_WGU + 2 * (size_t)2 * FF * D * 2;
constexpr size_t WS_WEND = WS_WDN + 2 * (size_t)D * FF * 2;
constexpr int TILE_WIN = 0, TILE_WKV = PW / 256, TILE_HN = TILE_WKV + 8, TILE_MEMN = TILE_HN + T / 256;
constexpr size_t WS_BIG = 132 * MiB;
constexpr size_t WS_CN = 372 * MiB;
constexpr size_t WS_CAT = 380 * MiB;
constexpr size_t WS_H8 = WS_BIG + 200 * MiB;
constexpr size_t WS_KB = 476 * MiB;
constexpr size_t WS_VT = 484 * MiB;
constexpr size_t WS_END = 502 * MiB;
static_assert(WS_WEND <= WS_BIG, "weights fit below BIG");

struct Params {
    const float* in[26];
    float* out;
    unsigned char* ws;
};

__device__ __forceinline__ float bf2f(unsigned short u) { return __uint_as_float(((unsigned)u) << 16); }
__device__ __forceinline__ unsigned f2bf(float f) { unsigned u = __float_as_uint(f); return (u + 0x7fffu + ((u >> 16) & 1u)) >> 16; }
typedef __bf16 bf16x2_t __attribute__((ext_vector_type(2)));
__device__ __forceinline__ unsigned pk2(float lo, float hi) { const f32x2 v = {lo, hi}; return __builtin_bit_cast(unsigned, __builtin_convertvector(v, bf16x2_t)); }
__device__ __forceinline__ float wave_sum(float v) {
#pragma unroll
    for (int o = 1; o < 64; o <<= 1) v += __shfl_xor(v, o);
    return v;
}
__device__ __forceinline__ float wave_max(float v) {
#pragma unroll
    for (int o = 1; o < 64; o <<= 1) v = fmaxf(v, __shfl_xor(v, o));
    return v;
}
__device__ __forceinline__ int otid() { int t = threadIdx.x; asm volatile("" : "+v"(t)); return t; }
#define WAVE_LDS_SYNC() asm volatile("s_waitcnt lgkmcnt(0)" ::: "memory")
__device__ __forceinline__ float silu_f(float x) { return x * __builtin_amdgcn_rcpf(1.f + __expf(-x)); }
__device__ __forceinline__ float sigmoid_f(float x) { return __builtin_amdgcn_rcpf(1.f + __expf(-x)); }

typedef int i32x4v __attribute__((ext_vector_type(4)));
typedef int i32x8v __attribute__((ext_vector_type(8)));
__device__ __forceinline__ unsigned pk4_f8(float a, float b, float c, float d) {
    a = __builtin_amdgcn_fmed3f(a, -448.f, 448.f); b = __builtin_amdgcn_fmed3f(b, -448.f, 448.f); c = __builtin_amdgcn_fmed3f(c, -448.f, 448.f); d = __builtin_amdgcn_fmed3f(d, -448.f, 448.f);
    int w = 0;
    w = __builtin_amdgcn_cvt_pk_fp8_f32(a, b, w, false);
    w = __builtin_amdgcn_cvt_pk_fp8_f32(c, d, w, true);
    return (unsigned)w;
}
constexpr float ACT_SC = 8.f, WDN_SC = 256.f, DN_UNSC = 1.f / (ACT_SC * WDN_SC);
constexpr float HQ_Q0 = 127.f / 6.5f, HQ_GU0 = 127.f / 6.5f, HQ_OIN = 127.f / 7.f, HQ_Q1 = 127.f / 8.f, HQ_GU1 = 127.f / 8.f, WQ_GU = 127.f / 0.14f;
__device__ __forceinline__ unsigned pk4_i8(float a, float b, float c, float d) {
    a = __builtin_amdgcn_fmed3f(__builtin_rintf(a) + 128.f, 1.f, 255.f); b = __builtin_amdgcn_fmed3f(__builtin_rintf(b) + 128.f, 1.f, 255.f);
    c = __builtin_amdgcn_fmed3f(__builtin_rintf(c) + 128.f, 1.f, 255.f); d = __builtin_amdgcn_fmed3f(__builtin_rintf(d) + 128.f, 1.f, 255.f);
    unsigned w = 0;
    w = __builtin_amdgcn_cvt_pk_u8_f32(a, 0, w); w = __builtin_amdgcn_cvt_pk_u8_f32(b, 1, w); w = __builtin_amdgcn_cvt_pk_u8_f32(c, 2, w); w = __builtin_amdgcn_cvt_pk_u8_f32(d, 3, w);
    return w ^ 0x80808080u;
}
__device__ __forceinline__ f32x4 i2f4(f32x4 v) { const i32x4v t = __builtin_bit_cast(i32x4v, v); return (f32x4){(float)t.x, (float)t.y, (float)t.z, (float)t.w}; }
struct Unit { int pm, pn; };
struct Gemm { const bf16_t* A; const bf16_t* Bt; int M, N, K; };
__device__ __forceinline__ int perm32(int rho) { const int n = rho >> 4, i = rho & 15; return 8 * (i >> 2) + 4 * n + (i & 3); }

__device__ __forceinline__ float row_rstd(const float* ssq, size_t row) {
    const f32x4* p = (const f32x4*)(ssq + row * 16);
    const f32x4 a = p[0], b = p[1], c = p[2], d = p[3];
    const float t = (((a.x + a.y) + (a.z + a.w)) + ((b.x + b.y) + (b.z + b.w))) + (((c.x + c.y) + (c.z + c.w)) + ((d.x + d.y) + (d.z + d.w)));
    return rsqrtf(t * (1.f / 1024.f) + EPS);
}
__device__ __forceinline__ void rows_rstd(const float* ssq, size_t row0, int fq, float (&rs)[2][4]) {
#pragma unroll
    for (int ai = 0; ai < 2; ++ai)
#pragma unroll
        for (int m = 0; m < 4; ++m) { const f32x4 a = *(const f32x4*)(ssq + (row0 + ai * 128 + m * 16) * 16 + 4 * fq); rs[ai][m] = (a.x + a.y) + (a.z + a.w); }
#pragma unroll
    for (int ai = 0; ai < 2; ++ai)
#pragma unroll
        for (int m = 0; m < 4; ++m) { float t = rs[ai][m]; t += __shfl_xor(t, 16); t += __shfl_xor(t, 32); rs[ai][m] = rsqrtf(t * (1.f / 1024.f) + EPS); }
}
template <bool ACC_I8 = false> struct EpiStoreBf16 {
    static constexpr bool PERM = true, AFTER_DRAIN = false;
    bf16_t* O; int ldc; const float* ssq; float dq = 1.f;
    __device__ __forceinline__ void operator()(const f32x4 (&acc)[2][2][4][2], const Unit& u, int wr, int wc, int fr, int fq) const {
        const int row0 = u.pm * 256 + wr * 64 + fr, col0 = u.pn * 256 + wc * 32 + 8 * fq;
        float rsv[2][4]; rows_rstd(ssq, (size_t)row0, fq, rsv);
#pragma unroll
        for (int ai = 0; ai < 2; ++ai)
#pragma unroll
            for (int m = 0; m < 4; ++m) {
                const float rs = ACC_I8 ? rsv[ai][m] * dq : rsv[ai][m];
                bf16_t* rowp = O + (size_t)(row0 + ai * 128 + m * 16) * ldc + col0;
#pragma unroll
                for (int bj = 0; bj < 2; ++bj) {
                    const f32x4 v0 = (ACC_I8 ? i2f4(acc[ai][bj][m][0]) : acc[ai][bj][m][0]) * rs, v1 = (ACC_I8 ? i2f4(acc[ai][bj][m][1]) : acc[ai][bj][m][1]) * rs;
                    u32x4 w; w.x = pk2(v0[0], v0[1]); w.y = pk2(v0[2], v0[3]); w.z = pk2(v1[0], v1[1]); w.w = pk2(v1[2], v1[3]);
                    *(u32x4*)(rowp + bj * 128) = w;
                }
            }
    }
};
struct EpiIn {
    static constexpr bool PERM = true, AFTER_DRAIN = false;
    bf16_t* P; bf16_t* KB; bf16_t* VT; const float* ssq;
    __device__ __forceinline__ void operator()(const f32x4 (&acc)[2][2][4][2], const Unit& u, int wr, int wc, int fr, int fq) const {
        bf16_t* O; int ldc, rt, ct; const bool main_unit = u.pn < TILE_WKV;
        if (main_unit) { O = P; ldc = PW; rt = u.pm - TILE_HN; ct = u.pn; }
        else if (u.pm >= TILE_MEMN) { const int l = (u.pn - TILE_WKV) >> 2; O = KB + (size_t)l * MT * 512; ldc = 512; rt = u.pm - TILE_MEMN; ct = (u.pn - TILE_WKV) & 3; }
        else { const int l = (u.pm - TILE_WKV) >> 2; O = VT + (size_t)l * 512 * MT; ldc = MT; rt = ((u.pm - TILE_WKV) & 3) - 2; ct = u.pn - TILE_MEMN; }
        const int row0 = rt * 256 + wr * 64 + fr, col0 = ct * 256 + wc * 32 + 8 * fq;
        float rsv[2][4];
        if (main_unit) rows_rstd(ssq, (size_t)row0, fq, rsv);
        else {
#pragma unroll
            for (int ai = 0; ai < 2; ++ai)
#pragma unroll
                for (int m = 0; m < 4; ++m) rsv[ai][m] = 1.f; }
#pragma unroll
        for (int ai = 0; ai < 2; ++ai)
#pragma unroll
            for (int m = 0; m < 4; ++m) {
                const float rs = rsv[ai][m];
                bf16_t* rowp = O + (size_t)(row0 + ai * 128 + m * 16) * ldc + col0;
#pragma unroll
                for (int bj = 0; bj < 2; ++bj) {
                    const f32x4 v0 = acc[ai][bj][m][0] * rs, v1 = acc[ai][bj][m][1] * rs;
                    u32x4 w; w.x = pk2(v0[0], v0[1]); w.y = pk2(v0[2], v0[3]); w.z = pk2(v1[0], v1[1]); w.w = pk2(v1[2], v1[3]);
                    *(u32x4*)(rowp + bj * 128) = w;
                }
            }
    }
};
template <bool ACC_I8 = false> struct EpiGeluBf16 {
    static constexpr bool PERM = true, AFTER_DRAIN = false;
    bf16_t* O; int ldc; const float* ssq; float* lnp; float dq = 1.f;
    __device__ __forceinline__ static f32x2 gelu_pk(f32x2 v) {
        const f32x2 av = __builtin_elementwise_abs(v), d = av * 0.2316418882f + 1.0f;
        f32x2 t; t.x = __builtin_amdgcn_rcpf(d.x); t.y = __builtin_amdgcn_rcpf(d.y);
        f32x2 q = t * 0.5307027145f + (-0.7265760135f); q = q * t + 0.7107068705f; q = q * t + (-0.142248368f); q = q * t + 0.127414796f; q = q * t;
        const f32x2 sq = (v * v) * (-0.72134752044f);
        f32x2 e; e.x = __builtin_amdgcn_exp2f(sq.x); e.y = __builtin_amdgcn_exp2f(sq.y);
        const f32x2 mm = v * (q * e), r = v - mm;
        f32x2 o; o.x = v.x < 0.f ? mm.x : r.x; o.y = v.y < 0.f ? mm.y : r.y; return o;
    }
    __device__ __forceinline__ static unsigned g2(float a, float b) { const f32x2 r = gelu_pk((f32x2){a, b}); return pk2(r.x, r.y); }
    __device__ __forceinline__ void operator()(const f32x4 (&acc)[2][2][4][2], const Unit& u, int wr, int wc, int fr, int fq) const {
        const int row0 = u.pm * 256 + wr * 64 + fr, col0 = u.pn * 256 + wc * 32 + 8 * fq;
        float rsv[2][4]; rows_rstd(ssq, (size_t)row0, fq, rsv);
#pragma unroll
        for (int ai = 0; ai < 2; ++ai)
#pragma unroll
            for (int m = 0; m < 4; ++m) {
                const size_t row = (size_t)(row0 + ai * 128 + m * 16);
                const float rs = ACC_I8 ? rsv[ai][m] * dq : rsv[ai][m];
                bf16_t* rowp = O + row * ldc + col0;
                float s1 = 0.f, s2 = 0.f;
#pragma unroll
                for (int bj = 0; bj < 2; ++bj) {
                    const f32x4 v0 = (ACC_I8 ? i2f4(acc[ai][bj][m][0]) : acc[ai][bj][m][0]) * rs, v1 = (ACC_I8 ? i2f4(acc[ai][bj][m][1]) : acc[ai][bj][m][1]) * rs;
                    const f32x2 ga = gelu_pk((f32x2){v0[0], v0[1]}), gb = gelu_pk((f32x2){v0[2], v0[3]}), gc = gelu_pk((f32x2){v1[0], v1[1]}), gd = gelu_pk((f32x2){v1[2], v1[3]});
                    u32x4 w; w.x = pk2(ga.x, ga.y); w.y = pk2(gb.x, gb.y); w.z = pk2(gc.x, gc.y); w.w = pk2(gd.x, gd.y);
                    *(u32x4*)(rowp + bj * 128) = w;
                    s1 += ((ga.x + ga.y) + (gb.x + gb.y)) + ((gc.x + gc.y) + (gd.x + gd.y));
                    s2 += ((ga.x * ga.x + ga.y * ga.y) + (gb.x * gb.x + gb.y * gb.y)) + ((gc.x * gc.x + gc.y * gc.y) + (gd.x * gd.x + gd.y * gd.y));
                }
                if (u.pn >= 4) {
                    s1 += __shfl_xor(s1, 16); s1 += __shfl_xor(s1, 32); s2 += __shfl_xor(s2, 16); s2 += __shfl_xor(s2, 32);
                    if (fq == 0) *(f32x2*)(lnp + (row * 16 + (u.pn - 4) * 4 + wc) * 2) = (f32x2){s1, s2};
                }
            }
    }
};
struct EpiSwigluBf16 {
    static constexpr bool PERM = true, AFTER_DRAIN = false;
    bf16_t* O; int ldc; const float* ssq;
    __device__ __forceinline__ void operator()(const f32x4 (&acc)[2][2][4][2], const Unit& u, int wr, int wc, int fr, int fq) const {
        const int row0 = u.pm * 256 + wr * 64 + fr, col0 = u.pn * 128 + wc * 32 + 8 * fq;
        float rsv[2][4]; rows_rstd(ssq, (size_t)row0, fq, rsv);
#pragma unroll
        for (int ai = 0; ai < 2; ++ai)
#pragma unroll
            for (int m = 0; m < 4; ++m) {
                const float rs = rsv[ai][m];
                bf16_t* rowp = O + (size_t)(row0 + ai * 128 + m * 16) * ldc + col0;
                const f32x4 g0 = acc[ai][0][m][0] * rs, g1 = acc[ai][0][m][1] * rs, u0 = acc[ai][1][m][0] * rs, u1 = acc[ai][1][m][1] * rs;
                u32x4 w;
                w.x = pk2(silu_f(g0[0]) * u0[0], silu_f(g0[1]) * u0[1]); w.y = pk2(silu_f(g0[2]) * u0[2], silu_f(g0[3]) * u0[3]);
                w.z = pk2(silu_f(g1[0]) * u1[0], silu_f(g1[1]) * u1[1]); w.w = pk2(silu_f(g1[2]) * u1[2], silu_f(g1[3]) * u1[3]);
                *(u32x4*)rowp = w;
            }
    }
};
template <bool ACC_I8, bool OUT_F8> struct EpiSwigluQ {
    static constexpr bool PERM = true, AFTER_DRAIN = false;
    void* O; int ldc; const float* ssq; float dq;
    __device__ __forceinline__ void operator()(const f32x4 (&acc)[2][2][4][2], const Unit& u, int wr, int wc, int fr, int fq) const {
        const int row0 = u.pm * 256 + wr * 64 + fr, col0 = u.pn * 128 + wc * 32 + 8 * fq;
        float rsv[2][4]; rows_rstd(ssq, (size_t)row0, fq, rsv);
#pragma unroll
        for (int ai = 0; ai < 2; ++ai)
#pragma unroll
            for (int m = 0; m < 4; ++m) {
                const float rs = ACC_I8 ? rsv[ai][m] * dq : rsv[ai][m], rsu = OUT_F8 ? rs * ACT_SC : rs;
                f32x4 g0 = acc[ai][0][m][0], g1 = acc[ai][0][m][1], u0 = acc[ai][1][m][0], u1 = acc[ai][1][m][1];
                if (ACC_I8) { g0 = i2f4(g0); g1 = i2f4(g1); u0 = i2f4(u0); u1 = i2f4(u1); }
                g0 = g0 * rs; g1 = g1 * rs; u0 = u0 * rsu; u1 = u1 * rsu;
                if (OUT_F8) {
                    unsigned char* rowp = (unsigned char*)O + (size_t)(row0 + ai * 128 + m * 16) * ldc + col0;
                    u32x2 w;
                    w.x = pk4_f8(silu_f(g0[0]) * u0[0], silu_f(g0[1]) * u0[1], silu_f(g0[2]) * u0[2], silu_f(g0[3]) * u0[3]);
                    w.y = pk4_f8(silu_f(g1[0]) * u1[0], silu_f(g1[1]) * u1[1], silu_f(g1[2]) * u1[2], silu_f(g1[3]) * u1[3]);
                    *(u32x2*)rowp = w;
                } else {
                    bf16_t* rowp = (bf16_t*)O + (size_t)(row0 + ai * 128 + m * 16) * ldc + col0;
                    u32x4 w;
                    w.x = pk2(silu_f(g0[0]) * u0[0], silu_f(g0[1]) * u0[1]); w.y = pk2(silu_f(g0[2]) * u0[2], silu_f(g0[3]) * u0[3]);
                    w.z = pk2(silu_f(g1[0]) * u1[0], silu_f(g1[1]) * u1[1]); w.w = pk2(silu_f(g1[2]) * u1[2], silu_f(g1[3]) * u1[3]);
                    *(u32x4*)rowp = w;
                }
            }
    }
};
template <bool BASE_F32, bool SCALED = false, bool W8 = false> struct EpiResid {
    static constexpr bool PERM = true, AFTER_DRAIN = false;
    const float* xbase; bf16_t* H; float* ssq; unsigned char* H8 = nullptr; float hq = 0.f;
    __device__ __forceinline__ void operator()(const f32x4 (&acc)[2][2][4][2], const Unit& u, int wr, int wc, int fr, int fq) const {
        const int row0 = u.pm * 256 + wr * 64 + fr, col0 = u.pn * 256 + wc * 32 + 8 * fq;
#pragma unroll
        for (int ai = 0; ai < 2; ++ai)
#pragma unroll
            for (int m = 0; m < 4; ++m) {
                const size_t row = (size_t)(row0 + ai * 128 + m * 16);
                float ss = 0.f;
#pragma unroll
                for (int bj = 0; bj < 2; ++bj) {
                    const size_t off = row * 1024 + col0 + bj * 128;
                    f32x4 b0, b1;
                    if (BASE_F32) { b0 = *(const f32x4*)(xbase + off); b1 = *(const f32x4*)(xbase + off + 4); }
                    else { const u32x4 hw = *(const u32x4*)(H + off);
                        b0 = (f32x4){bf2f((unsigned short)(hw.x & 0xffffu)), bf2f((unsigned short)(hw.x >> 16)), bf2f((unsigned short)(hw.y & 0xffffu)), bf2f((unsigned short)(hw.y >> 16))};
                        b1 = (f32x4){bf2f((unsigned short)(hw.z & 0xffffu)), bf2f((unsigned short)(hw.z >> 16)), bf2f((unsigned short)(hw.w & 0xffffu)), bf2f((unsigned short)(hw.w >> 16))}; }
                    const float sc = SCALED ? DN_UNSC : 1.f;
                    const f32x4 v0 = b0 + acc[ai][bj][m][0] * sc, v1 = b1 + acc[ai][bj][m][1] * sc;
                    u32x4 w; w.x = pk2(v0[0], v0[1]); w.y = pk2(v0[2], v0[3]); w.z = pk2(v1[0], v1[1]); w.w = pk2(v1[2], v1[3]);
                    *(u32x4*)(H + off) = w;
                    if (W8) { u32x2 q; q.x = pk4_i8(v0[0] * hq, v0[1] * hq, v0[2] * hq, v0[3] * hq); q.y = pk4_i8(v1[0] * hq, v1[1] * hq, v1[2] * hq, v1[3] * hq); *(u32x2*)(H8 + off) = q; }
                    ss += ((v0[0] * v0[0] + v0[1] * v0[1]) + (v0[2] * v0[2] + v0[3] * v0[3])) + ((v1[0] * v1[0] + v1[1] * v1[1]) + (v1[2] * v1[2] + v1[3] * v1[3]));
                }
                ss += __shfl_xor(ss, 16); ss += __shfl_xor(ss, 32);
                if (fq == 0) ssq[row * 16 + u.pn * 4 + wc] = ss;
            }
    }
};
namespace pg8 {
#define PG8_LAS __attribute__((address_space(3)))
constexpr int BM = 256, BK = 64, HALF = 128, HTB = HALF * BK * 2  , STAGE_BYTES = 8 * HTB, NXCD = 8, WGM = 8;
__host__ __device__ __forceinline__ int lds_byte(int r, int c) { const int st = (r >> 4) * 2 + (c >> 5), rr = r & 15, cc = c & 31, ob = rr * 64 + cc * 2; return st * 1024 + (ob ^ (((ob >> 9) & 1) << 5)); }
__host__ __device__ __forceinline__ void stage_rc(int b, int& R, int& C) { const int st = b / 1024, sb = b % 1024, swz = sb ^ (((sb >> 9) & 1) << 5); R = (st >> 1) * 16 + swz / 64; C = (st & 1) * 32 + (swz % 64) / 2; }
struct StaticOrder {
    int nM, nN, nwg, G, c;
    __host__ __device__ void init(int M, int N, int G_, int c_) { nM = M / BM; nN = N / BM; nwg = nM * nN; G = G_; c = c_; }
    __host__ __device__ bool next(int i, Unit& u) const {
        const long L = (long)i * G + c; if (L >= nwg) return false;
        int wgid = (int)L; { const int q = nwg / NXCD, r = nwg % NXCD, xcd = wgid % NXCD, off = wgid / NXCD; wgid = (xcd < r ? xcd * (q + 1) : r * (q + 1) + (xcd - r) * q) + off; }
        const int nig = WGM * nN, gid = wgid / nig, fm = gid * WGM, gsz = (nM - fm) < WGM ? (nM - fm) : WGM;
        u.pm = fm + ((wgid % nig) % gsz); u.pn = (wgid % nig) / gsz; return true;
    }
    __device__ __forceinline__ void a_ready(const Unit&) const {}
    __device__ __forceinline__ void done(const Unit&) const {}
};
struct ComboOrder {
    StaticOrder so;
    __host__ __device__ void init(int G_, int c_) { so.init(T, PW, G_, c_); }
    __host__ __device__ bool next(int i, Unit& u) const {
        const long L = (long)i * so.G + so.c;
        if (L < so.nwg) { so.next(i, u); u.pm += TILE_HN; return true; }
        const int j = (int)(L - so.nwg); if (j >= 128) return false;
        const int l = j >> 6, jj = j & 63;
        if (jj < 32) { u.pm = TILE_MEMN + (jj >> 1); u.pn = TILE_WKV + 4 * l + (jj & 1); }
        else { const int q = jj - 32; u.pm = TILE_WKV + 4 * l + 2 + (q >> 4); u.pn = TILE_MEMN + (q & 15); }
        return true;
    }
    __device__ __forceinline__ void a_ready(const Unit&) const {}
    __device__ __forceinline__ void done(const Unit&) const {}
};
template <class Epi, class Sched, bool ALIGN_EPI = false, bool SP2 = false, int QM = 0  >
__device__ __forceinline__ void gemm_phase(PG8_LAS unsigned char* lds, const Gemm g, const Sched& S, const Epi& E) {
    const int tid = otid(), wid = __builtin_amdgcn_readfirstlane(tid >> 6), lane = tid & 63, wr = wid >> 2, wc = wid & 3, fr = lane & 15, fq = lane >> 4;
    constexpr bool FP8 = (QM == 1), I8 = (QM == 2);
    const int K = g.K, nt = K / BK;
    unsigned voffA[2], voffB[2];
#pragma unroll
    for (int i = 0; i < 2; ++i) { int R, C; stage_rc(tid * 16 + i * 8192, R, C); const int Rb = Epi::PERM ? ((R & ~31) + perm32(R & 31)) : R;
        voffA[i] = (unsigned)(R * K + C) * 2u; voffB[i] = (unsigned)(Rb * K + C) * 2u; }
    const size_t kstep = (size_t)(BK * 2);
    const size_t hstep = (size_t)HALF * K * 2;
    const size_t tstep = 2 * hstep;
    const unsigned ldsw = (unsigned)wid * 1024u;
    const int aoff = lds_byte(wr * 64 + fr, fq * 8), boff = lds_byte(wc * 32 + fr, fq * 8);
#define PG8_SA(b, h) (((b) * 2 + (h)) * HTB)
#define PG8_SB(b, h) ((4 + (b) * 2 + (h)) * HTB)
#define PG8_STAGE(bufoff, gbase, voff) do { _Pragma("unroll") for (int _i = 0; _i < 2; ++_i) \
        __builtin_amdgcn_global_load_lds((const unsigned*)((const char*)(gbase) + (voff)[_i]), (PG8_LAS unsigned*)(lds + (bufoff) + ldsw + _i * 8192), 16, 0, 0); } while (0)
#define PG8_LD16(off) (*(const PG8_LAS bf16x8*)(lds + (off)))
#define PG8_LDA(dst, b, h) do { _Pragma("unroll") for (int m = 0; m < 4; ++m) { \
        if constexpr (FP8) dst##8[m] = PG8_CAT(PG8_LD16(PG8_SA(b, h) + aoff + m * 2048), PG8_LD16(PG8_SA(b, h) + aoff + m * 2048 + 1024)); \
        else { _Pragma("unroll") for (int k = 0; k < 2; ++k) dst[m][k] = PG8_LD16(PG8_SA(b, h) + aoff + m * 2048 + k * 1024); } } } while (0)
#define PG8_LDB(dst, b, h) do { _Pragma("unroll") for (int n = 0; n < 2; ++n) { \
        if constexpr (FP8) dst##8[n] = PG8_CAT(PG8_LD16(PG8_SB(b, h) + boff + n * 2048), PG8_LD16(PG8_SB(b, h) + boff + n * 2048 + 1024)); \
        else { _Pragma("unroll") for (int k = 0; k < 2; ++k) dst[n][k] = PG8_LD16(PG8_SB(b, h) + boff + n * 2048 + k * 1024); } } } while (0)
#define PG8_CAT(x, y) __builtin_shufflevector(__builtin_bit_cast(i32x4v, x), __builtin_bit_cast(i32x4v, y), 0, 1, 2, 3, 4, 5, 6, 7)
#define PG8_MMA(ai, bj, At, Bt) do { __builtin_amdgcn_s_setprio(1); \
        if constexpr (FP8) { _Pragma("unroll") for (int m = 0; m < 4; ++m) _Pragma("unroll") for (int n = 0; n < 2; ++n) \
            asm("v_mfma_f32_16x16x128_f8f6f4 %0, %1, %2, %0" : "+v"(acc[ai][bj][m][n]) : "v"(Bt##8[n]), "v"(At##8[m])); } \
        else if constexpr (I8) { _Pragma("unroll") for (int m = 0; m < 4; ++m) _Pragma("unroll") for (int n = 0; n < 2; ++n) _Pragma("unroll") for (int k = 0; k < 2; ++k) \
            acc[ai][bj][m][n] = __builtin_bit_cast(f32x4, __builtin_amdgcn_mfma_i32_16x16x64_i8(__builtin_bit_cast(i32x4v, Bt[n][k]), __builtin_bit_cast(i32x4v, At[m][k]), __builtin_bit_cast(i32x4v, acc[ai][bj][m][n]), 0, 0, 0)); } \
        else { _Pragma("unroll") for (int m = 0; m < 4; ++m) _Pragma("unroll") for (int n = 0; n < 2; ++n) _Pragma("unroll") for (int k = 0; k < 2; ++k) \
            acc[ai][bj][m][n] = __builtin_amdgcn_mfma_f32_16x16x32_bf16(Bt[n][k], At[m][k], acc[ai][bj][m][n], 0, 0, 0); } \
        __builtin_amdgcn_s_setprio(0); } while (0)
#define PG8_WAIT_V(n) asm volatile("s_waitcnt vmcnt(" #n ")" ::: "memory")
#define PG8_WAIT_L(n) asm volatile("s_waitcnt lgkmcnt(" #n ")" ::: "memory")
#define PG8_BAR __builtin_amdgcn_s_barrier()
#define PG8_SCHED __builtin_amdgcn_sched_barrier(0)
    Unit cur, nxt; int ui = 0;
    if (!S.next(0, cur)) return;
    f32x4 acc[2][2][4][2];
#pragma unroll
    for (int a = 0; a < 2; ++a)
#pragma unroll
        for (int b = 0; b < 2; ++b)
#pragma unroll
            for (int m = 0; m < 4; ++m)
#pragma unroll
                for (int n = 0; n < 2; ++n) acc[a][b][m][n] = (f32x4){0.f, 0.f, 0.f, 0.f};
    bf16x8 At[4][2], B0[2][2], B1[2][2];
    i32x8v At8[4], B08[2], B18[2];
    const char* cA = (const char*)g.A + (size_t)cur.pm * tstep; const char* cB = (const char*)g.Bt + (size_t)cur.pn * tstep;
    S.a_ready(cur);
    if constexpr (SP2) {
        PG8_STAGE(PG8_SB(0, 0), cB, voffB); PG8_STAGE(PG8_SB(0, 1), cB + hstep, voffB); PG8_STAGE(PG8_SA(0, 0), cA, voffA); PG8_STAGE(PG8_SA(0, 1), cA + hstep, voffA);
        if (wr == 1) PG8_BAR;
        PG8_WAIT_V(2); PG8_BAR;
        PG8_STAGE(PG8_SB(1, 0), cB + kstep, voffB); PG8_STAGE(PG8_SA(1, 0), cA + kstep, voffA); PG8_STAGE(PG8_SB(1, 1), cB + hstep + kstep, voffB);
        PG8_WAIT_V(6); PG8_BAR;
    } else {
        PG8_STAGE(PG8_SB(0, 0), cB, voffB); PG8_STAGE(PG8_SA(0, 0), cA, voffA); PG8_STAGE(PG8_SB(0, 1), cB + hstep, voffB); PG8_STAGE(PG8_SA(0, 1), cA + hstep, voffA);
        if (wr == 1) PG8_BAR;
        PG8_WAIT_V(4); PG8_BAR;
        PG8_STAGE(PG8_SB(1, 0), cB + kstep, voffB); PG8_STAGE(PG8_SA(1, 0), cA + kstep, voffA); PG8_STAGE(PG8_SB(1, 1), cB + hstep + kstep, voffB);
        PG8_WAIT_V(6); PG8_BAR;
    }
    for (;;) {
        const bool has_next = S.next(ui + 1, nxt);
        const char* nA = has_next ? (const char*)g.A + (size_t)nxt.pm * tstep : cA; const char* nB = has_next ? (const char*)g.Bt + (size_t)nxt.pn * tstep : cB;
        for (int t = 0; t < nt; t += 2) {
            const bool last = (t == nt - 2);
            if constexpr (FP8) __builtin_amdgcn_s_waitcnt(0xC07F);
            const char* a1 = cA + (size_t)(t + 1) * kstep;
            const char* a2 = last ? nA : cA + (size_t)(t + 2) * kstep; const char* b2 = last ? nB : cB + (size_t)(t + 2) * kstep;
            const char* a3 = a2 + kstep; const char* b3 = b2 + kstep;
            if (last && has_next) S.a_ready(nxt);
            if constexpr (SP2) {
            PG8_LDB(B0, 0, 0); PG8_LDB(B1, 0, 1); PG8_SCHED; PG8_LDA(At, 0, 0); PG8_STAGE(PG8_SA(1, 1), a1 + hstep, voffA);
            PG8_WAIT_V(8); PG8_WAIT_L(0); PG8_BAR; PG8_MMA(0, 0, At, B0); PG8_MMA(0, 1, At, B1); PG8_BAR; PG8_SCHED;
            PG8_LDA(At, 0, 1); PG8_STAGE(PG8_SB(0, 0), b2, voffB); PG8_STAGE(PG8_SB(0, 1), b2 + hstep, voffB); PG8_STAGE(PG8_SA(0, 0), a2, voffA);
            PG8_WAIT_V(8); PG8_WAIT_L(0); PG8_BAR; PG8_MMA(1, 0, At, B0); PG8_MMA(1, 1, At, B1); PG8_BAR; PG8_SCHED;
            PG8_LDB(B0, 1, 0); PG8_LDB(B1, 1, 1); PG8_SCHED; PG8_LDA(At, 1, 0); PG8_STAGE(PG8_SA(0, 1), a2 + hstep, voffA);
            PG8_WAIT_V(8); PG8_WAIT_L(0); PG8_BAR; PG8_MMA(0, 0, At, B0); PG8_MMA(0, 1, At, B1); PG8_BAR; PG8_SCHED;
            PG8_LDA(At, 1, 1); PG8_STAGE(PG8_SB(1, 0), b3, voffB); PG8_STAGE(PG8_SB(1, 1), b3 + hstep, voffB); PG8_STAGE(PG8_SA(1, 0), a3, voffA);
            PG8_WAIT_V(8); PG8_WAIT_L(0); PG8_BAR; PG8_MMA(1, 0, At, B0); PG8_MMA(1, 1, At, B1); PG8_BAR; PG8_SCHED;
            } else {
            PG8_LDB(B0, 0, 0); PG8_SCHED; PG8_LDA(At, 0, 0); PG8_STAGE(PG8_SA(1, 1), a1 + hstep, voffA);
            PG8_WAIT_L(8); PG8_BAR; PG8_WAIT_L(0); PG8_MMA(0, 0, At, B0); PG8_BAR; PG8_SCHED;
            PG8_LDB(B1, 0, 1); PG8_STAGE(PG8_SB(0, 0), b2, voffB);
            PG8_BAR; PG8_WAIT_L(0); PG8_MMA(0, 1, At, B1); PG8_BAR;
            PG8_LDA(At, 0, 1); PG8_STAGE(PG8_SA(0, 0), a2, voffA);
            PG8_BAR; PG8_WAIT_L(0); PG8_MMA(1, 0, At, B0); PG8_BAR; PG8_SCHED;
            PG8_STAGE(PG8_SB(0, 1), b2 + hstep, voffB);
            PG8_WAIT_V(6); PG8_BAR; PG8_MMA(1, 1, At, B1); PG8_BAR;
            PG8_LDB(B0, 1, 0); PG8_SCHED; PG8_LDA(At, 1, 0); PG8_STAGE(PG8_SA(0, 1), a2 + hstep, voffA);
            PG8_WAIT_L(8); PG8_BAR; PG8_WAIT_L(0); PG8_MMA(0, 0, At, B0); PG8_BAR; PG8_SCHED;
            PG8_LDB(B1, 1, 1); PG8_STAGE(PG8_SB(1, 0), b3, voffB);
            PG8_BAR; PG8_WAIT_L(0); PG8_MMA(0, 1, At, B1); PG8_BAR;
            PG8_LDA(At, 1, 1); PG8_STAGE(PG8_SA(1, 0), a3, voffA);
            PG8_BAR; PG8_WAIT_L(0); PG8_MMA(1, 0, At, B0); PG8_BAR; PG8_SCHED;
            PG8_STAGE(PG8_SB(1, 1), b3 + hstep, voffB);
            PG8_WAIT_V(6); PG8_BAR; PG8_MMA(1, 1, At, B1); PG8_BAR;
            }
        }
        if constexpr (FP8) asm volatile("s_nop 15\n\ts_nop 15" ::: "memory");
        if constexpr (ALIGN_EPI) { if (wr == 0) PG8_BAR; }
        if constexpr (!Epi::AFTER_DRAIN) { E(acc, cur, wr, wc, fr, fq); S.done(cur); }
        if (!has_next) break;
#pragma unroll
        for (int a = 0; a < 2; ++a)
#pragma unroll
            for (int b = 0; b < 2; ++b)
#pragma unroll
                for (int m = 0; m < 4; ++m)
#pragma unroll
                    for (int n = 0; n < 2; ++n) acc[a][b][m][n] = (f32x4){0.f, 0.f, 0.f, 0.f};
        cur = nxt; cA = nA; cB = nB; ++ui;
        if constexpr (ALIGN_EPI) { if (wr == 1) PG8_BAR; }
    }
    PG8_WAIT_V(0);
    if constexpr (!ALIGN_EPI) { if (wr == 0) PG8_BAR; }
    PG8_BAR;
    if constexpr (Epi::AFTER_DRAIN) { E.fused(acc, cur, wr, wc, fr, fq, lds, wid, lane); S.done(cur); }
#undef PG8_SA
#undef PG8_SB
#undef PG8_STAGE
#undef PG8_LDA
#undef PG8_LD16
#undef PG8_LDB
#undef PG8_MMA
#undef PG8_CAT
#undef PG8_WAIT_V
#undef PG8_WAIT_L
#undef PG8_BAR
#undef PG8_SCHED
}
}

template <class Epi, int QM = 0>
__device__ __forceinline__ void run_gemm(const Gemm g, const Epi& E, LAS float* lds, int vb, int nvb) {
    pg8::StaticOrder S; S.init(g.M, g.N, nvb, vb);
    pg8::gemm_phase<Epi, pg8::StaticOrder, true, true, QM>((LAS unsigned char*)lds, g, S, E);
}

enum { MAP_ID = 0, MAP_WIN = 1, MAP_GU = 2 };
struct PrepJob { const float* W; int K, N; const float* gain; bf16_t* dst; int r0, r1, ldd, koff, map; int fmt; float osc; };
__device__ __forceinline__ int map_src(int map, int r, int N) {
    if (map == MAP_ID) return r < N ? r : -1;
    if (map == MAP_WIN) {
        if (r < 1728) return r - 512;
        if (r < 3776) return r - 504;
        if (r < 3784) return r - 2560;
        return -1;
    }
    { const int tile = r >> 8, w = r & 255, j = tile * 128 + (w & 127); return w < 128 ? j : FF + j; }
}
__device__ __forceinline__ void prep_tile_load(const PrepJob& j, int t, f32x4 (&v)[8]) {
    const int nkt = j.K / 64, kt = t % nkt, rt = t / nkt, k0 = kt * 64, r0 = j.r0 + rt * 256;
#pragma unroll
    for (int q = 0; q < 8; ++q) {
        const int i = (int)threadIdx.x + q * NTHREADS, kk = i >> 6, r4 = (i & 63) * 4;
        const int sc = map_src(j.map, r0 + r4, j.N);
        v[q] = sc >= 0 ? __builtin_nontemporal_load((const f32x4*)(j.W + (size_t)(k0 + kk) * j.N + sc)) : (f32x4){0.f, 0.f, 0.f, 0.f};
        if (j.gain) v[q] = v[q] * j.gain[k0 + kk];
    }
}
__device__ __forceinline__ void prep_tile_store(const PrepJob& j, int t, const f32x4 (&v)[8], LAS float* tile  ) {
    const int nkt = j.K / 64, kt = t % nkt, rt = t / nkt, k0 = kt * 64, r0 = j.r0 + rt * 256;
    __syncthreads();
#pragma unroll
    for (int q = 0; q < 8; ++q) { const int i = (int)threadIdx.x + q * NTHREADS, kk = i >> 6, r4 = (i & 63) * 4; *(LAS f32x4*)(tile + kk * 260 + r4) = v[q]; }
    __syncthreads();
#pragma unroll
    for (int q = 0; q < 4; ++q) {
        const int i = (int)threadIdx.x + q * NTHREADS, rr = i & 255, c8 = i >> 8;
        const LAS float* tp = tile + (c8 * 8) * 260 + rr;
        if (j.fmt != 0) {
            const float sc = j.osc; u32x2 w;
            if (j.fmt == 1) { w.x = pk4_f8(tp[0] * sc, tp[260] * sc, tp[520] * sc, tp[780] * sc); w.y = pk4_f8(tp[1040] * sc, tp[1300] * sc, tp[1560] * sc, tp[1820] * sc); }
            else { w.x = pk4_i8(tp[0] * sc, tp[260] * sc, tp[520] * sc, tp[780] * sc); w.y = pk4_i8(tp[1040] * sc, tp[1300] * sc, tp[1560] * sc, tp[1820] * sc); }
            *(u32x2*)((unsigned char*)j.dst + (size_t)(r0 + rr) * j.ldd + j.koff + k0 + c8 * 8) = w;
        } else {
        u32x4 w; w.x = pk2(tp[0], tp[260]); w.y = pk2(tp[520], tp[780]); w.z = pk2(tp[1040], tp[1300]); w.w = pk2(tp[1560], tp[1820]);
        *(u32x4*)(j.dst + (size_t)(r0 + rr) * j.ldd + j.koff + k0 + c8 * 8) = w;
        }
    }
}
__device__ __forceinline__ void prep_fold_in(const float* w_in  , const float* w_uk  , const float* gain, bf16_t* dst, LAS float* lds, int vb, int nvb) {
    LAS float* A = lds; LAS float* B = lds + 32 * 65;
    const int tid = otid(), lane = tid & 63, wid = __builtin_amdgcn_readfirstlane(tid >> 6), l15 = lane & 15, dq = lane >> 4;
    for (int item = vb; item < 256; item += nvb) {
        const int h = item >> 5, k0 = (item & 31) * 32;
        __syncthreads();
        for (int i = tid; i < 2048; i += NTHREADS) { const int kk = i >> 6, d = i & 63; A[kk * 65 + d] = w_in[(size_t)(k0 + kk) * 3272 + h * 64 + d] * gain[k0 + kk]; }
        for (int i = tid; i < 8192; i += NTHREADS) { const int c = i >> 6, d = i & 63; B[c * 65 + d] = w_uk[(size_t)(h * 128 + c) * 64 + d]; }
        __syncthreads();
        f32x4 acc0 = (f32x4){0.f, 0.f, 0.f, 0.f}, acc1 = acc0;
#pragma unroll 4
        for (int d0 = 0; d0 < 64; d0 += 4) {
            const float b = B[(16 * wid + l15) * 65 + d0 + dq], a0 = A[l15 * 65 + d0 + dq], a1 = A[(16 + l15) * 65 + d0 + dq];
            acc0 = __builtin_amdgcn_mfma_f32_16x16x4f32(a0, b, acc0, 0, 0, 0);
            acc1 = __builtin_amdgcn_mfma_f32_16x16x4f32(a1, b, acc1, 0, 0, 0);
        }
        bf16_t* drow = dst + (size_t)(h * 128 + 16 * wid + l15) * 1024 + k0 + 4 * dq;
        { u32x2 w; w.x = pk2(acc0[0], acc0[1]); w.y = pk2(acc0[2], acc0[3]); *(u32x2*)drow = w; }
        { u32x2 w; w.x = pk2(acc1[0], acc1[1]); w.y = pk2(acc1[2], acc1[3]); *(u32x2*)(drow + 16) = w; }
    }
}
__device__ __forceinline__ void prep_fold_out(const float* w_out  , const float* w_uv  , bf16_t* dst  , LAS float* lds, int vb, int nvb) {
    LAS float* A = lds; LAS float* B = lds + 64 * 33;
    const int tid = otid(), lane = tid & 63, wid = __builtin_amdgcn_readfirstlane(tid >> 6), l15 = lane & 15, dq = lane >> 4;
    for (int item = vb; item < 256; item += nvb) {
        const int h = item >> 5, n0 = (item & 31) * 32;
        __syncthreads();
        for (int i = tid; i < 2048; i += NTHREADS) { const int d = i >> 5, nn = i & 31; A[d * 33 + nn] = w_out[(size_t)(h * 64 + d) * 1024 + n0 + nn]; }
        for (int i = tid; i < 8192; i += NTHREADS) { const int c = i >> 6, d = i & 63; B[c * 65 + d] = w_uv[(size_t)(h * 128 + c) * 64 + d]; }
        __syncthreads();
        f32x4 acc0 = (f32x4){0.f, 0.f, 0.f, 0.f}, acc1 = acc0;
#pragma unroll 4
        for (int d0 = 0; d0 < 64; d0 += 4) {
            const float a = B[(16 * wid + l15) * 65 + d0 + dq], b0 = A[(d0 + dq) * 33 + l15], b1 = A[(d0 + dq) * 33 + 16 + l15];
            acc0 = __builtin_amdgcn_mfma_f32_16x16x4f32(a, b0, acc0, 0, 0, 0);
            acc1 = __builtin_amdgcn_mfma_f32_16x16x4f32(a, b1, acc1, 0, 0, 0);
        }
        { u32x2 w; w.x = pk2(acc0[0], acc0[1]); w.y = pk2(acc0[2], acc0[3]); *(u32x2*)(dst + (size_t)(n0 + l15) * KOUT + h * 128 + 16 * wid + 4 * dq) = w; }
        { u32x2 w; w.x = pk2(acc1[0], acc1[1]); w.y = pk2(acc1[2], acc1[3]); *(u32x2*)(dst + (size_t)(n0 + 16 + l15) * KOUT + h * 128 + 16 * wid + 4 * dq) = w; }
    }
}
__device__ __forceinline__ void prep_lb(const float* hgrn_lb  , float* lb, int vb, int nvb) {
    for (int i = vb * NTHREADS + threadIdx.x; i < 512; i += nvb * NTHREADS) {
        const float a = hgrn_lb[i], b = hgrn_lb[512 + i], c = hgrn_lb[1024 + i], m = fmaxf(a, fmaxf(b, c));
        const float ea = __expf(a - m), eb = __expf(b - m), ec = __expf(c - m);
        lb[i] = ea / (ea + eb + ec);
    }
}

__device__ __forceinline__ void rmsnorm_rows(const float* X, bf16_t* Y, int nrows, int vb, int nvb) {
    const int tid = otid(), lane = tid & 63, gw = vb * NWAVES + __builtin_amdgcn_readfirstlane(tid >> 6), ngw = nvb * NWAVES;
    for (int r = gw; r < nrows; r += ngw) {
        const f32x4* xr = (const f32x4*)(X + (size_t)r * D) + lane;
        f32x4 v[4]; float s = 0.f;
#pragma unroll
        for (int j = 0; j < 4; ++j) { v[j] = xr[64 * j]; s += (v[j].x * v[j].x + v[j].y * v[j].y) + (v[j].z * v[j].z + v[j].w * v[j].w); }
        const float rs = rsqrtf(wave_sum(s) * (1.f / D) + EPS);
        u32x2* o = (u32x2*)(Y + (size_t)r * D) + lane;
#pragma unroll
        for (int j = 0; j < 4; ++j) { u32x2 w; w.x = pk2(v[j].x * rs, v[j].y * rs); w.y = pk2(v[j].z * rs, v[j].w * rs); o[64 * j] = w; }
    }
}
__device__ __forceinline__ void x_to_h_rows(const float* X, bf16_t* H, float* ssq, int vb, int nvb) {
    const int tid = otid(), lane = tid & 63, gw = vb * NWAVES + __builtin_amdgcn_readfirstlane(tid >> 6), ngw = nvb * NWAVES;
    for (int r = gw; r < T; r += 2 * ngw) {
        const int r2 = (r + ngw < T) ? r + ngw : r;
        f32x4 v[2][4];
#pragma unroll
        for (int j = 0; j < 4; ++j) { v[0][j] = __builtin_nontemporal_load((const f32x4*)(X + (size_t)r * D) + lane + 64 * j); v[1][j] = __builtin_nontemporal_load((const f32x4*)(X + (size_t)r2 * D) + lane + 64 * j); }
#pragma unroll
        for (int q = 0; q < 2; ++q) {
            const int rr = q ? r2 : r;
            u32x2* o = (u32x2*)(H + (size_t)rr * D) + lane;
            float s = 0.f;
#pragma unroll
            for (int j = 0; j < 4; ++j) { const f32x4 x = v[q][j]; u32x2 w; w.x = pk2(x.x, x.y); w.y = pk2(x.z, x.w); o[64 * j] = w;
                const float a = bf2f((unsigned short)(w.x & 0xffffu)), b = bf2f((unsigned short)(w.x >> 16)), c = bf2f((unsigned short)(w.y & 0xffffu)), d = bf2f((unsigned short)(w.y >> 16));
                s += (a * a + b * b) + (c * c + d * d); }
            s = wave_sum(s);
            if (lane < 16) ssq[(size_t)rr * 16 + lane] = lane == 0 ? s : 0.f;
        }
    }
}
__device__ __forceinline__ void final_rows(const bf16_t* H, const float* ssq, const float* g, float* out, int vb, int nvb) {
    const int tid = otid(), lane = tid & 63, gw = vb * NWAVES + __builtin_amdgcn_readfirstlane(tid >> 6), ngw = nvb * NWAVES;
    f32x4 gg[4];
#pragma unroll
    for (int j = 0; j < 4; ++j) gg[j] = *((const f32x4*)g + lane + 64 * j);
    for (int r = gw; r < T; r += 2 * ngw) {
        const int r2 = (r + ngw < T) ? r + ngw : r;
        u32x2 w[2][4]; float rs[2];
#pragma unroll
        for (int j = 0; j < 4; ++j) { w[0][j] = ((const u32x2*)(H + (size_t)r * D) + lane)[64 * j]; w[1][j] = ((const u32x2*)(H + (size_t)r2 * D) + lane)[64 * j]; }
        rs[0] = row_rstd(ssq, (size_t)r); rs[1] = row_rstd(ssq, (size_t)r2);
#pragma unroll
        for (int q = 0; q < 2; ++q) {
            f32x4* o = (f32x4*)(out + (size_t)(q ? r2 : r) * D) + lane;
#pragma unroll
            for (int j = 0; j < 4; ++j) { const u32x2 ww = w[q][j];
                __builtin_nontemporal_store((f32x4){bf2f((unsigned short)(ww.x & 0xffffu)) * rs[q] * gg[j].x, bf2f((unsigned short)(ww.x >> 16)) * rs[q] * gg[j].y, bf2f((unsigned short)(ww.y & 0xffffu)) * rs[q] * gg[j].z, bf2f((unsigned short)(ww.y >> 16)) * rs[q] * gg[j].w}, o + 64 * j); }
        }
    }
}
__device__ __forceinline__ float row16_sum(float v) {
    v += __uint_as_float((unsigned)__builtin_amdgcn_update_dpp(0, (int)__float_as_uint(v), 0x128, 0xf, 0xf, false));
    v += __uint_as_float((unsigned)__builtin_amdgcn_update_dpp(0, (int)__float_as_uint(v), 0x124, 0xf, 0xf, false));
    v += __uint_as_float((unsigned)__builtin_amdgcn_update_dpp(0, (int)__float_as_uint(v), 0x122, 0xf, 0xf, false));
    v += __uint_as_float((unsigned)__builtin_amdgcn_update_dpp(0, (int)__float_as_uint(v), 0x121, 0xf, 0xf, false));
    return v;
}
__device__ __forceinline__ void cnorm_rows(const bf16_t* P, const float* lat_g, bf16_t* CN, int vb, int nvb) {
    const int tid = otid(), lane = tid & 63, gw = vb * NWAVES + __builtin_amdgcn_readfirstlane(tid >> 6), ngw = nvb * NWAVES, r4 = lane >> 4, l16 = lane & 15;
    const f32x4 ga = *(const f32x4*)(lat_g + l16 * 8), gb = *(const f32x4*)(lat_g + l16 * 8 + 4);
    for (int r = gw * 8; r < T; r += ngw * 8) {
        u32x4 w[2];
#pragma unroll
        for (int q = 0; q < 2; ++q) w[q] = *(const u32x4*)(P + (size_t)(r + 4 * q + r4) * PW + P_C + l16 * 8);
#pragma unroll
        for (int q = 0; q < 2; ++q) {
            const float x0 = bf2f((unsigned short)(w[q].x & 0xffffu)), x1 = bf2f((unsigned short)(w[q].x >> 16)), x2 = bf2f((unsigned short)(w[q].y & 0xffffu)), x3 = bf2f((unsigned short)(w[q].y >> 16));
            const float x4 = bf2f((unsigned short)(w[q].z & 0xffffu)), x5 = bf2f((unsigned short)(w[q].z >> 16)), x6 = bf2f((unsigned short)(w[q].w & 0xffffu)), x7 = bf2f((unsigned short)(w[q].w >> 16));
            const float ss = row16_sum(((x0 * x0 + x1 * x1) + (x2 * x2 + x3 * x3)) + ((x4 * x4 + x5 * x5) + (x6 * x6 + x7 * x7)));
            const float rs = rsqrtf(ss * (1.f / 128.f) + EPS);
            u32x4 o; o.x = pk2(x0 * rs * ga.x, x1 * rs * ga.y); o.y = pk2(x2 * rs * ga.z, x3 * rs * ga.w); o.z = pk2(x4 * rs * gb.x, x5 * rs * gb.y); o.w = pk2(x6 * rs * gb.z, x7 * rs * gb.w);
            *(u32x4*)(CN + (size_t)(r + 4 * q + r4) * 128 + l16 * 8) = o;
        }
    }
}
__device__ __forceinline__ int t5_bucket(int rel) {
    const int n = rel < 0 ? -rel : rel;
    int b = n < 8 ? n : 8 + (n >= 12) + (n >= 16) + (n >= 23) + (n >= 32) + (n >= 46) + (n >= 64) + (n >= 91);
    return b + (rel > 0 ? 16 : 0);
}
__device__ __forceinline__ unsigned sort_key(float x) { const unsigned u = __float_as_uint(x); return (u & 0x80000000u) ? ~u : (u | 0x80000000u); }


template <int CTRL, int ROWMASK> __device__ __forceinline__ unsigned dpp0(unsigned v) { return (unsigned)__builtin_amdgcn_update_dpp(0, (int)v, CTRL, ROWMASK, 0xf, false); }
__device__ __forceinline__ unsigned wave_prefix_incl(unsigned v) {
    v += dpp0<0x111, 0xf>(v); v += dpp0<0x112, 0xf>(v); v += dpp0<0x114, 0xf>(v); v += dpp0<0x118, 0xf>(v);
    v += dpp0<0x142, 0xa>(v);
    v += dpp0<0x143, 0xc>(v);
    return v;
}
__device__ __forceinline__ float wave_max_u(float v) {
    v = fmaxf(v, __uint_as_float((unsigned)__builtin_amdgcn_update_dpp(0, (int)__float_as_uint(v), 0x128, 0xf, 0xf, false)));
    v = fmaxf(v, __uint_as_float((unsigned)__builtin_amdgcn_update_dpp(0, (int)__float_as_uint(v), 0x124, 0xf, 0xf, false)));
    v = fmaxf(v, __uint_as_float((unsigned)__builtin_amdgcn_update_dpp(0, (int)__float_as_uint(v), 0x122, 0xf, 0xf, false)));
    v = fmaxf(v, __uint_as_float((unsigned)__builtin_amdgcn_update_dpp(0, (int)__float_as_uint(v), 0x121, 0xf, 0xf, false)));
    const int b = (int)__float_as_uint(v);
    return fmaxf(fmaxf(__uint_as_float((unsigned)__builtin_amdgcn_readlane(b, 0)), __uint_as_float((unsigned)__builtin_amdgcn_readlane(b, 16))),
                 fmaxf(__uint_as_float((unsigned)__builtin_amdgcn_readlane(b, 32)), __uint_as_float((unsigned)__builtin_amdgcn_readlane(b, 48))));
}

typedef short v4i16_t __attribute__((ext_vector_type(4)));
constexpr int DSA_BT_OFF = 131072 + 256, DSA_WS_OFF = DSA_BT_OFF + 6144;
__device__ __forceinline__ unsigned dsa_bucket(float x, float lo, float sc) { const float f = (x - lo) * sc; const unsigned b = (unsigned)f; return b > 255u ? 255u : b; }
__device__ __forceinline__ unsigned off_b(unsigned row, unsigned ch) { return 256u * row + 16u * (ch ^ (((row & 3) << 2) | ((row >> 2) & 3))); }
__device__ __forceinline__ void dsa_mfma_phase(const bf16_t* P, const bf16_t* CN, const float* rel_bias, bf16_t* CAT, LAS unsigned char* lds, unsigned* qctr) {
    const int tid = otid(), lane = tid & 63, wid = __builtin_amdgcn_readfirstlane(tid >> 6);
    LAS float* BT = (LAS float*)(lds + DSA_BT_OFF);
    __syncthreads();
    for (int i = tid; i < 191 * 8; i += NTHREADS) { const int rel = (i >> 3) - 127; BT[i] = rel_bias[t5_bucket(rel) * 8 + (i & 7)]; }
    const unsigned long long lt_mask = (lane == 0) ? 0ull : (~0ull >> (64 - lane));
    volatile LAS int* qslot = (volatile LAS int*)(lds + 131072 + 64);
    int nxt = 0;
    if (tid == 0) { *qslot = (int)atomicAdd(qctr, 1u); nxt = (int)atomicAdd(qctr, 1u); }
    for (;;) {
        __syncthreads();
        const int u = *qslot;
        if (u >= T / 16) break;
        const int b = u & 15, qg = 127 - (u >> 4), t0 = qg * 16, nj = t0 / CHUNK + 1, L = nj * CHUNK, nt = L / 32;
        const bf16_t* Pb = P + (size_t)b * SEQ * PW;
        {
            int ln1 = lane; asm volatile("" : "+v"(ln1));
            const int rho = ln1 & 31, hf = ln1 >> 5;
            const int qq = 2 * ((rho >> 2) & 1) + (rho >> 4), hh = 4 * ((rho >> 3) & 1) + (rho & 3);
            bf16x8 qa[4][4], wa[4], wc[4];
#pragma unroll
            for (int qd = 0; qd < 4; ++qd) {
                const bf16_t* qrow = Pb + (size_t)(t0 + 4 * qd + qq) * PW + P_QI + hh * 64 + 8 * hf;
#pragma unroll
                for (int ks = 0; ks < 4; ++ks) qa[qd][ks] = *(const bf16x8*)(qrow + ks * 16);
                wa[qd] = *(const bf16x8*)(Pb + (size_t)(t0 + 4 * qd + 2 * hf) * PW + P_WI); wc[qd] = *(const bf16x8*)(Pb + (size_t)(t0 + 4 * qd + 2 * hf + 1) * PW + P_WI);
            }
            LAS float* sc0 = (LAS float*)lds + (2 * hf) * 2048 + rho;
            const bf16_t* kbase = Pb + (size_t)rho * PW + P_KI + 8 * hf;
            bf16x8 kb[4], kn[4];
#pragma unroll
            for (int ks = 0; ks < 4; ++ks) { kb[ks] = (bf16x8){0, 0, 0, 0, 0, 0, 0, 0}; kn[ks] = kb[ks]; }
            if (wid < nt) {
#pragma unroll
                for (int ks = 0; ks < 4; ++ks) kb[ks] = *(const bf16x8*)(kbase + (size_t)wid * 32 * PW + ks * 16);
            }
            for (int kt = wid; kt < nt; kt += 8) {
                if (kt + 8 < nt) {
#pragma unroll
                    for (int ks = 0; ks < 4; ++ks) kn[ks] = *(const bf16x8*)(kbase + (size_t)(kt + 8) * 32 * PW + ks * 16);
                }
#pragma unroll
                for (int qd = 0; qd < 4; ++qd) {
                    f32x16 acc;
#pragma unroll
                    for (int r = 0; r < 16; ++r) acc[r] = 0.f;
#pragma unroll
                    for (int ks = 0; ks < 4; ++ks) acc = __builtin_amdgcn_mfma_f32_32x32x16_bf16(qa[qd][ks], kb[ks], acc, 0, 0, 0);
                    float s0 = 0.f, s1 = 0.f;
#pragma unroll
                    for (int e = 0; e < 8; ++e) { s0 += bf2f((unsigned short)wa[qd][e]) * fmaxf(acc[e], 0.f); s1 += bf2f((unsigned short)wc[qd][e]) * fmaxf(acc[8 + e], 0.f); }
                    sc0[(4 * qd) * 2048 + kt * 32] = s0 * (0.35355339059327373f * 0.125f); sc0[(4 * qd + 1) * 2048 + kt * 32] = s1 * (0.35355339059327373f * 0.125f);
                }
#pragma unroll
                for (int ks = 0; ks < 4; ++ks) kb[ks] = kn[ks];
            }
        }
        __syncthreads();
        if (tid == 0) { *qslot = nxt; nxt = (int)atomicAdd(qctr, 1u); }
        LAS unsigned char* pair = lds + wid * 16384;
        LAS unsigned char* wsc = lds + DSA_WS_OFF + wid * 2560;
        LAS unsigned* HIST = (LAS unsigned*)wsc; LAS float* CANDV = (LAS float*)(wsc + 1024); LAS unsigned* CANDI = (LAS unsigned*)(wsc + 1280);
        const int nsel = L < 256 ? L : 256;
        int lna = lane; asm volatile("" : "+v"(lna));
#pragma unroll 1
        for (int e2 = 0; e2 < 2; ++e2) {
            LAS unsigned short* IDX = (LAS unsigned short*)(wsc + 1536 + e2 * 512);
            if (nj > 4) {
                const LAS float* SCq = (const LAS float*)(pair + e2 * 8192);
                float x[32];
#pragma unroll
                for (int j = 0; j < 32; ++j) x[j] = (j < nj) ? SCq[j * 64 + lna] : 0.f;
                float lo = INFINITY, hi = -INFINITY;
#pragma unroll
                for (int j = 0; j < 32; ++j) if (j < nj) { hi = fmaxf(hi, x[j]); lo = fminf(lo, x[j]); }
                hi = wave_max_u(hi); lo = -wave_max_u(-lo);
                bool done = false;
                if (hi > lo) {
                    const float sc = 256.f / (hi - lo);
                    *(LAS u32x4*)(HIST + 4 * lna) = (u32x4){0u, 0u, 0u, 0u};
                    WAVE_LDS_SYNC();
#pragma unroll
                    for (int j = 0; j < 32; ++j) if (j < nj) { const unsigned bk = dsa_bucket(x[j], lo, sc); __hip_atomic_fetch_add(HIST + bk, 1u, __ATOMIC_RELAXED, __HIP_MEMORY_SCOPE_WORKGROUP); }
                    WAVE_LDS_SYNC();
                    const u32x4 h4 = *(const LAS u32x4*)(HIST + 4 * lna);
                    const unsigned cl = (h4.x + h4.y) + (h4.z + h4.w);
                    const unsigned pfx = wave_prefix_incl(cl);
                    const unsigned Sx = (unsigned)__builtin_amdgcn_readlane((int)pfx, 63) - pfx + cl;
                    const int lstar = __popcll(__ballot(Sx >= 256u)) - 1;
                    const unsigned above = Sx - cl, t3 = above + h4.w, t2 = t3 + h4.z, t1 = t2 + h4.y;
                    const unsigned bl = t3 >= 256u ? 3u : (t2 >= 256u ? 2u : (t1 >= 256u ? 1u : 0u));
                    const unsigned al = bl == 3u ? above : (bl == 2u ? t3 : (bl == 1u ? t2 : t1));
                    const unsigned ml = bl == 3u ? h4.w : (bl == 2u ? h4.z : (bl == 1u ? h4.y : h4.x));
                    const unsigned bstar = (unsigned)__builtin_amdgcn_readlane((int)(4u * lna + bl), lstar);
                    const int a = __builtin_amdgcn_readlane((int)al, lstar), m = __builtin_amdgcn_readlane((int)ml, lstar);
                    if (m <= 64) {
                        done = true;
                        const int need = 256 - a;
                        unsigned msel = 0u, mcand = 0u;
#pragma unroll
                        for (int j = 31; j >= 0; --j) if (j < nj) { const unsigned bk = dsa_bucket(x[j], lo, sc); msel = msel + msel + (bk > bstar ? 1u : 0u); mcand = mcand + mcand + (bk == bstar ? 1u : 0u); }
                        const unsigned pk = (unsigned)__popc(msel) | ((unsigned)__popc(mcand) << 16);
                        const unsigned inc = wave_prefix_incl(pk);
                        unsigned off = (inc - pk) & 0xffffu, coff = (inc - pk) >> 16;
                        while (msel) { const int j = __ffs((int)msel) - 1; msel &= msel - 1u; IDX[off++] = (unsigned short)(j * 64 + lna); }
                        while (mcand) { const int j = __ffs((int)mcand) - 1; mcand &= mcand - 1u; CANDV[coff] = SCq[j * 64 + lna]; CANDI[coff] = (unsigned)(j * 64 + lna); ++coff; }
                        WAVE_LDS_SYNC();
                        const float cv = CANDV[lna < m ? lna : 0]; const unsigned ci = CANDI[lna < m ? lna : 0];
                        int rank = 0;
                        for (int k = 0; k < m; ++k) { const float v = __uint_as_float((unsigned)__builtin_amdgcn_readlane((int)__float_as_uint(cv), k)); const unsigned id = (unsigned)__builtin_amdgcn_readlane((int)ci, k); rank += (v > cv || (v == cv && id < ci)) ? 1 : 0; }
                        if (lna < m && rank < need) IDX[a + rank] = (unsigned short)ci;
                    }
                }
                if (!done) {
                    unsigned lo_k = 0xffffffffu, hi_k = 0u;
#pragma unroll
                    for (int j = 0; j < 32; ++j) if (j < nj) { const unsigned kx = sort_key(x[j]); hi_k = kx > hi_k ? kx : hi_k; lo_k = kx < lo_k ? kx : lo_k; }
#pragma unroll
                    for (int o = 1; o < 64; o <<= 1) { const unsigned h2 = (unsigned)__shfl_xor((int)hi_k, o), l2 = (unsigned)__shfl_xor((int)lo_k, o); hi_k = h2 > hi_k ? h2 : hi_k; lo_k = l2 < lo_k ? l2 : lo_k; }
                    lo_k = (unsigned)__builtin_amdgcn_readfirstlane((int)lo_k); hi_k = (unsigned)__builtin_amdgcn_readfirstlane((int)hi_k);
                    bool exact = false;
                    while (lo_k < hi_k) {
                        const unsigned mid = lo_k + ((hi_k - lo_k + 1u) >> 1);
                        int cnt = 0;
#pragma unroll
                        for (int j = 0; j < 32; ++j) cnt += __popcll(__ballot(j < nj && sort_key(x[j]) >= mid));
                        if (cnt == 256) { lo_k = mid; exact = true; break; }
                        if (cnt > 256) lo_k = mid; else hi_k = mid - 1u;
                    }
                    const unsigned Tv = lo_k;
                    int need = 0;
                    if (!exact) { int cgt = 0;
#pragma unroll
                        for (int j = 0; j < 32; ++j) cgt += __popcll(__ballot(j < nj && sort_key(x[j]) > Tv));
                        need = 256 - cgt; }
                    int base = 0, eqt = 0;
#pragma unroll
                    for (int j = 0; j < 32; ++j) {
                        const unsigned kx = sort_key(x[j]);
                        const bool gt = (j < nj) && (exact ? (kx >= Tv) : (kx > Tv)), eq = (j < nj) && !exact && (kx == Tv);
                        const unsigned long long meq = __ballot(eq);
                        const bool sel = gt || (eq && (eqt + __popcll(meq & lt_mask)) < need);
                        const unsigned long long ms = __ballot(sel);
                        if (sel) IDX[base + __popcll(ms & lt_mask)] = (unsigned short)(j * 64 + lna);
                        base += __popcll(ms); eqt += __popcll(meq);
                    }
                }
            } else {
#pragma unroll
                for (int i = 0; i < 4; ++i) IDX[i * 64 + lna] = (unsigned short)(i * 64 + lna);
            }
        }
        WAVE_LDS_SYNC();
        {
            int lnb = lane; asm volatile("" : "+v"(lnb));
            const int head = lnb & 15, kg = lnb >> 4, nblk = nsel >> 5;
            LAS unsigned char* GB = pair;
            const bf16_t* CNb = CN + (size_t)b * SEQ * 128;
            const int rho = lnb & 15;
            const unsigned rw0 = 8 * (rho >> 2) + (rho & 3), rw1 = rw0 + 4;
            const unsigned xa0 = ((rw0 & 3) << 2) | ((rw0 >> 2) & 3), xa1 = ((rw1 & 3) << 2) | ((rw1 >> 2) & 3);
            const unsigned q4 = (lnb & 15) >> 2, p4 = lnb & 3;
            u32x4 gA[8], gB[8];
#define DSA_GATHER(G, IX, blk) do { _Pragma("unroll") for (int it = 0; it < 8; ++it) { const int sp = (IX)[(blk) * 32 + (lnb >> 4) + 4 * it]; G[it] = *(const u32x4*)(CNb + (size_t)sp * 128 + (lnb & 15) * 8); } } while (0)
            { const LAS unsigned short* IDX0 = (const LAS unsigned short*)(wsc + 1536); DSA_GATHER(gA, IDX0, 0); DSA_GATHER(gB, IDX0, 1); }
#pragma unroll 1
            for (int e2 = 0; e2 < 2; ++e2) {
                const int t = t0 + 2 * wid + e2;
                const size_t row = (size_t)b * SEQ + t;
                const LAS unsigned short* IDX = (const LAS unsigned short*)(wsc + 1536 + e2 * 512);
                bf16x8 qlf[4];
#pragma unroll
                for (int s4 = 0; s4 < 4; ++s4) { qlf[s4] = *(const bf16x8*)(P + row * PW + P_QL + (head & 7) * 128 + s4 * 32 + 8 * kg); if (head >= 8) qlf[s4] = (bf16x8){0, 0, 0, 0, 0, 0, 0, 0}; }
                f32x4 o[8];
#pragma unroll
                for (int ct = 0; ct < 8; ++ct) o[ct] = (f32x4){0.f, 0.f, 0.f, 0.f};
                float m = -INFINITY, lsum = 0.f;
#define DSA_STEP(G, kbx) do { \
                    WAVE_LDS_SYNC();                              \
                    _Pragma("unroll") for (int it = 0; it < 8; ++it) *(LAS u32x4*)(GB + off_b((lnb >> 4) + 4 * it, lnb & 15)) = G[it]; \
                    const bf16x8 iv = *(const LAS bf16x8*)((const LAS unsigned char*)IDX + ((kbx) * 32 + 8 * kg) * 2);     \
                    if ((kbx) + 2 < nblk) DSA_GATHER(G, IDX, (kbx) + 2); else if (e2 == 0) DSA_GATHER(G, IDX + 256, (kbx) + 2 - nblk); \
                    WAVE_LDS_SYNC(); \
                      \
                    bf16x8 k0[4], k1[4], af[8]; \
                    _Pragma("unroll") for (int s4 = 0; s4 < 4; ++s4) { \
                        k0[s4] = *(const LAS bf16x8*)(GB + 256u * rw0 + 16u * ((4 * s4 + kg) ^ xa0)); \
                        k1[s4] = *(const LAS bf16x8*)(GB + 256u * rw1 + 16u * ((4 * s4 + kg) ^ xa1)); } \
                    float bia[8]; \
                    _Pragma("unroll") for (int e = 0; e < 8; ++e) { const int sp = (int)(unsigned short)iv[e]; int rel = sp - t; rel = rel < -127 ? -127 : rel; bia[e] = BT[(rel + 127) * 8 + (head & 7)]; } \
                      \
                    f32x4 a0 = (f32x4){0.f, 0.f, 0.f, 0.f}, a1 = (f32x4){0.f, 0.f, 0.f, 0.f}; \
                    _Pragma("unroll") for (int s4 = 0; s4 < 4; ++s4) { \
                        a0 = __builtin_amdgcn_mfma_f32_16x16x32_bf16(k0[s4], qlf[s4], a0, 0, 0, 0); \
                        a1 = __builtin_amdgcn_mfma_f32_16x16x32_bf16(k1[s4], qlf[s4], a1, 0, 0, 0); } \
                    asm volatile("" : "+v"(a0), "+v"(a1));        \
                    _Pragma("unroll") for (int ct = 0; ct < 8; ++ct) {              \
                        const v4i16_t lo4 = __builtin_amdgcn_ds_read_tr16_b64_v4i16((LAS v4i16_t*)(GB + off_b(8 * kg + q4, 2 * ct + (p4 >> 1)) + 8 * (p4 & 1))); \
                        const v4i16_t hi4 = __builtin_amdgcn_ds_read_tr16_b64_v4i16((LAS v4i16_t*)(GB + off_b(8 * kg + 4 + q4, 2 * ct + (p4 >> 1)) + 8 * (p4 & 1))); \
                        af[ct] = (bf16x8){lo4[0], lo4[1], lo4[2], lo4[3], hi4[0], hi4[1], hi4[2], hi4[3]}; } \
                      \
                    float lg[8]; \
                    _Pragma("unroll") for (int e = 0; e < 8; ++e) lg[e] = (e < 4 ? a0[e] : a1[e - 4]) * 0.125f + bia[e]; \
                    const float mloc = fmaxf(fmaxf(fmaxf(lg[0], lg[1]), fmaxf(lg[2], lg[3])), fmaxf(fmaxf(lg[4], lg[5]), fmaxf(lg[6], lg[7]))); \
                      \
                    float scl = 1.f; \
                    if (__any(mloc > m + 16.f)) { \
                        float mb = fmaxf(mloc, __shfl_xor(mloc, 16)); mb = fmaxf(mb, __shfl_xor(mb, 32)); \
                        const float mn = fmaxf(m, mb); scl = __expf(m - mn); m = mn; \
                        _Pragma("unroll") for (int ct = 0; ct < 8; ++ct) o[ct] = o[ct] * scl; } \
                    float ps = 0.f; float pe[8]; \
                    _Pragma("unroll") for (int e = 0; e < 8; ++e) { pe[e] = __expf(lg[e] - m); ps += pe[e]; } \
                    lsum = lsum * scl + ps; \
                    u32x4 pw; pw.x = pk2(pe[0], pe[1]); pw.y = pk2(pe[2], pe[3]); pw.z = pk2(pe[4], pe[5]); pw.w = pk2(pe[6], pe[7]); \
                    const bf16x8 pb = __builtin_bit_cast(bf16x8, pw); \
                    _Pragma("unroll") for (int ct = 0; ct < 8; ++ct) o[ct] = __builtin_amdgcn_mfma_f32_16x16x32_bf16(af[ct], pb, o[ct], 0, 0, 0); \
                } while (0)
#pragma unroll 1
                for (int kb2 = 0; kb2 < nblk; kb2 += 2) { DSA_STEP(gA, kb2); DSA_STEP(gB, kb2 + 1); }
#undef DSA_STEP
                lsum += __shfl_xor(lsum, 16); lsum += __shfl_xor(lsum, 32);
                const float inv = 1.f / lsum;
                if (head < 8) {
                    bf16_t* op = CAT + row * KOUT + head * 128 + 4 * kg;
#pragma unroll
                    for (int ct = 0; ct < 8; ++ct) { u32x2 w; w.x = pk2(o[ct][0] * inv, o[ct][1] * inv); w.y = pk2(o[ct][2] * inv, o[ct][3] * inv); *(u32x2*)(op + ct * 16) = w; }
                }
            }
#undef DSA_GATHER
        }
    }
}

constexpr size_t WS_DEC = 492 * MiB;
__device__ __forceinline__ void hgrn_prep(bf16_t* P, const float* lb, float* DEC, LAS unsigned char* lds, int vb, int nvb) {
    const int tid = otid(), cl = tid >> 7, d = tid & 127;
    LAS bf16_t* Ft = (LAS bf16_t*)lds; LAS bf16_t* Qt = (LAS bf16_t*)(lds + 65536);
    for (int it = vb; it < BATCH * 4 * 8; it += nvb) {
        const int b = it >> 5, h = (it >> 3) & 3, cg = it & 7;
        bf16_t* base = P + ((size_t)b * SEQ + cg * 256) * PW + h * 128;
        u32x4 v[16];
#pragma unroll
        for (int k = 0; k < 16; ++k) { const int i = tid + 512 * k, tl = i >> 12, r = (i >> 4) & 255, ch = i & 15; v[k] = *(const u32x4*)(base + (size_t)r * PW + (tl ? P_QB : P_FB) + ch * 8); }
        __syncthreads();
#pragma unroll
        for (int k = 0; k < 16; ++k) { const int i = tid + 512 * k, tl = i >> 12, r = (i >> 4) & 255, ch = i & 15; *(LAS u32x4*)(lds + tl * 65536 + r * 256 + ch * 16) = v[k]; }
        __syncthreads();
        {
            const float l = lb[h * 128 + d];
            LAS bf16_t* fcol = Ft + (cl * 64) * 128 + d; LAS bf16_t* qcol = Qt + (cl * 64) * 128 + d;
            float ref = 0.f;
#pragma unroll 8
            for (int t = 0; t < 32; ++t) ref += __logf(l + (1.f - l) * sigmoid_f(bf2f(fcol[t * 128])));
            float bi = 0.f;
#pragma unroll 8
            for (int t = 0; t < 64; ++t) {
                const float f = l + (1.f - l) * sigmoid_f(bf2f(fcol[t * 128]));
                bi += __logf(f);
                const float q = silu_f(bf2f(qcol[t * 128]));
                qcol[t * 128] = (bf16_t)f2bf(q * __expf(bi - ref));
                fcol[t * 128] = (bf16_t)f2bf((1.f - f) * __expf(ref - bi));
            }
            float* dc = DEC + ((size_t)((b * 4 + h) * 32 + cg * 4 + cl) * 3) * 128 + d;
            dc[0] = __expf(ref); dc[128] = __expf(bi); dc[256] = __expf(bi - ref);
        }
        __syncthreads();
#pragma unroll
        for (int k = 0; k < 16; ++k) { const int i = tid + 512 * k, tl = i >> 12, r = (i >> 4) & 255, ch = i & 15; *(u32x4*)(base + (size_t)r * PW + (tl ? P_QB : P_FB) + ch * 8) = *(const LAS u32x4*)(lds + tl * 65536 + r * 256 + ch * 16); }
    }
}

__device__ __forceinline__ void hgrn_scan(const bf16_t* P, const float* DEC, const float* o_g, bf16_t* CAT, LAS unsigned char* lds, int item) {
    const int tid = otid(), lane = tid & 63, wid = __builtin_amdgcn_readfirstlane(tid >> 6), li = lane & 15, kg = lane >> 4;
    const int b = item >> 2, h = item & 3, it = wid >> 1, vh = wid & 1;
    LAS unsigned char* ST = lds + 98304;
    LAS float* SSQ = (LAS float*)(lds + DSA_BT_OFF);
    const bf16_t* Pb = P + (size_t)b * SEQ * PW;
    const float* DECb = DEC + (size_t)((b * 4 + h) * 32) * 384;
    f32x4 S[8];
#pragma unroll
    for (int vt = 0; vt < 8; ++vt) S[vt] = (f32x4){0.f, 0.f, 0.f, 0.f};
    u32x4 sg[6];
    const int colbase[3] = {P_QB, P_FB, P_IB};
#define HG_LOAD(c) do { _Pragma("unroll") for (int k = 0; k < 6; ++k) { const int n = tid + 512 * k, tl = n >> 10, r = (n >> 4) & 63, ch = n & 15; \
        sg[k] = *(const u32x4*)(Pb + (size_t)((c) * 64 + r) * PW + colbase[tl] + h * 128 + ch * 8); } } while (0)
#define HG_STORE(buf) do { _Pragma("unroll") for (int k = 0; k < 6; ++k) { const int n = tid + 512 * k, tl = n >> 10, r = (n >> 4) & 63, ch = n & 15; \
        *(LAS u32x4*)(lds + (buf) * 49152 + tl * 16384 + off_b(r, ch)) = sg[k]; } } while (0)
    HG_LOAD(0);
    __syncthreads();
    HG_STORE(0);
    const unsigned q4 = (lane & 15) >> 2, p4 = lane & 3;
    f32x4 ogv[4];
#pragma unroll
    for (int vv = 0; vv < 4; ++vv) ogv[vv] = *(const f32x4*)(o_g + 16 * (4 * vh + vv) + 4 * kg);
    float er_next = DECb[16 * wid + li];
#pragma unroll 1
    for (int c = 0; c < 32; ++c) {
        const int buf = c & 1;
        LAS unsigned char* QI = lds + buf * 49152; LAS unsigned char* KI = QI + 16384; LAS unsigned char* VI = QI + 32768;
        if (c + 1 < 32) HG_LOAD(c + 1);
        const float er = er_next, e63 = DECb[c * 384 + 128 + 16 * wid + li], e6r = DECb[c * 384 + 256 + 16 * wid + li];
        er_next = DECb[(c + 1 < 32 ? c + 1 : c) * 384 + 16 * wid + li];
        u32x2 gwv[4];
#pragma unroll
        for (int vv = 0; vv < 4; ++vv) gwv[vv] = *(const u32x2*)(P + ((size_t)b * SEQ + c * 64 + 16 * it + li) * PW + P_GB + h * 128 + 16 * (4 * vh + vv) + 4 * kg);
        { const unsigned d = 16 * wid + li;
#pragma unroll
          for (int vt = 0; vt < 8; ++vt) { u32x2 w; w.x = pk2(S[vt][0] * er, S[vt][1] * er); w.y = pk2(S[vt][2] * er, S[vt][3] * er);
              *(LAS u32x2*)(ST + off_b(d, 2 * vt + (kg >> 1)) + 8 * (kg & 1)) = w; } }
        __syncthreads();
        bf16x8 qf[4];
#pragma unroll
        for (int ks = 0; ks < 4; ++ks) qf[ks] = *(const LAS bf16x8*)(QI + off_b(16 * it + li, 4 * ks + kg));
        f32x4 o[4];
#pragma unroll
        for (int vv = 0; vv < 4; ++vv) o[vv] = (f32x4){0.f, 0.f, 0.f, 0.f};
#pragma unroll
        for (int ks = 0; ks < 4; ++ks)
#pragma unroll
            for (int vv = 0; vv < 4; ++vv) {
                const int ct = 4 * vh + vv;
                const v4i16_t lo4 = __builtin_amdgcn_ds_read_tr16_b64_v4i16((LAS v4i16_t*)(ST + off_b(32 * ks + 8 * kg + q4, 2 * ct + (p4 >> 1)) + 8 * (p4 & 1)));
                const v4i16_t hi4 = __builtin_amdgcn_ds_read_tr16_b64_v4i16((LAS v4i16_t*)(ST + off_b(32 * ks + 8 * kg + 4 + q4, 2 * ct + (p4 >> 1)) + 8 * (p4 & 1)));
                const bf16x8 af = (bf16x8){lo4[0], lo4[1], lo4[2], lo4[3], hi4[0], hi4[1], hi4[2], hi4[3]};
                o[vv] = __builtin_amdgcn_mfma_f32_16x16x32_bf16(af, qf[ks], o[vv], 0, 0, 0);
            }
        const int njb = (it >> 1) + 1;
#pragma unroll
        for (int jb = 0; jb < 2; ++jb) {
            if (jb < njb) {
                f32x4 a0 = (f32x4){0.f, 0.f, 0.f, 0.f}, a1 = (f32x4){0.f, 0.f, 0.f, 0.f};
                const unsigned rw0 = 32 * jb + 8 * (li >> 2) + (li & 3), rw1 = rw0 + 4;
#pragma unroll
                for (int ks = 0; ks < 4; ++ks) {
                    const bf16x8 k0 = *(const LAS bf16x8*)(KI + off_b(rw0, 4 * ks + kg));
                    const bf16x8 k1 = *(const LAS bf16x8*)(KI + off_b(rw1, 4 * ks + kg));
                    a0 = __builtin_amdgcn_mfma_f32_16x16x32_bf16(k0, qf[ks], a0, 0, 0, 0);
                    a1 = __builtin_amdgcn_mfma_f32_16x16x32_bf16(k1, qf[ks], a1, 0, 0, 0);
                }
                const int ii = 16 * it + li, j0 = 32 * jb + 8 * kg;
                float am[8];
#pragma unroll
                for (int e = 0; e < 8; ++e) am[e] = (j0 + e <= ii) ? (e < 4 ? a0[e] : a1[e - 4]) : 0.f;
                u32x4 pw; pw.x = pk2(am[0], am[1]); pw.y = pk2(am[2], am[3]); pw.z = pk2(am[4], am[5]); pw.w = pk2(am[6], am[7]);
                const bf16x8 pb = __builtin_bit_cast(bf16x8, pw);
#pragma unroll
                for (int vv = 0; vv < 4; ++vv) {
                    const int ct = 4 * vh + vv;
                    const v4i16_t lo4 = __builtin_amdgcn_ds_read_tr16_b64_v4i16((LAS v4i16_t*)(VI + off_b(32 * jb + 8 * kg + q4, 2 * ct + (p4 >> 1)) + 8 * (p4 & 1)));
                    const v4i16_t hi4 = __builtin_amdgcn_ds_read_tr16_b64_v4i16((LAS v4i16_t*)(VI + off_b(32 * jb + 8 * kg + 4 + q4, 2 * ct + (p4 >> 1)) + 8 * (p4 & 1)));
                    const bf16x8 af = (bf16x8){lo4[0], lo4[1], lo4[2], lo4[3], hi4[0], hi4[1], hi4[2], hi4[3]};
                    o[vv] = __builtin_amdgcn_mfma_f32_16x16x32_bf16(af, pb, o[vv], 0, 0, 0);
                }
            }
        }
        {
            f32x4 U[8];
#pragma unroll
            for (int vt = 0; vt < 8; ++vt) U[vt] = (f32x4){0.f, 0.f, 0.f, 0.f};
#pragma unroll
            for (int ks = 0; ks < 2; ++ks) {
                const v4i16_t kl = __builtin_amdgcn_ds_read_tr16_b64_v4i16((LAS v4i16_t*)(KI + off_b(32 * ks + 8 * kg + q4, 2 * wid + (p4 >> 1)) + 8 * (p4 & 1)));
                const v4i16_t kh = __builtin_amdgcn_ds_read_tr16_b64_v4i16((LAS v4i16_t*)(KI + off_b(32 * ks + 8 * kg + 4 + q4, 2 * wid + (p4 >> 1)) + 8 * (p4 & 1)));
                const bf16x8 kfr = (bf16x8){kl[0], kl[1], kl[2], kl[3], kh[0], kh[1], kh[2], kh[3]};
#pragma unroll
                for (int vt = 0; vt < 8; ++vt) {
                    const v4i16_t lo4 = __builtin_amdgcn_ds_read_tr16_b64_v4i16((LAS v4i16_t*)(VI + off_b(32 * ks + 8 * kg + q4, 2 * vt + (p4 >> 1)) + 8 * (p4 & 1)));
                    const v4i16_t hi4 = __builtin_amdgcn_ds_read_tr16_b64_v4i16((LAS v4i16_t*)(VI + off_b(32 * ks + 8 * kg + 4 + q4, 2 * vt + (p4 >> 1)) + 8 * (p4 & 1)));
                    const bf16x8 af = (bf16x8){lo4[0], lo4[1], lo4[2], lo4[3], hi4[0], hi4[1], hi4[2], hi4[3]};
                    U[vt] = __builtin_amdgcn_mfma_f32_16x16x32_bf16(af, kfr, U[vt], 0, 0, 0);
                }
            }
#pragma unroll
            for (int vt = 0; vt < 8; ++vt) S[vt] = S[vt] * e63 + U[vt] * e6r;
        }
        float ss = 0.f;
#pragma unroll
        for (int vv = 0; vv < 4; ++vv) ss += (o[vv][0] * o[vv][0] + o[vv][1] * o[vv][1]) + (o[vv][2] * o[vv][2] + o[vv][3] * o[vv][3]);
        ss += __shfl_xor(ss, 16); ss += __shfl_xor(ss, 32);
        if (kg == 0) SSQ[(it * 2 + vh) * 16 + li] = ss;
        __syncthreads();
        if (c + 1 < 32) HG_STORE(buf ^ 1);
        {
            const float tot = SSQ[(it * 2) * 16 + li] + SSQ[(it * 2 + 1) * 16 + li];
            const float rs = rsqrtf(tot * (1.f / 128.f) + EPS);
            const size_t row = (size_t)b * SEQ + c * 64 + 16 * it + li;
#pragma unroll
            for (int vv = 0; vv < 4; ++vv) {
                const int v0 = 16 * (4 * vh + vv) + 4 * kg;
                const u32x2 gw = gwv[vv];
                const f32x4 og = ogv[vv];
                const float g0 = silu_f(bf2f((unsigned short)(gw.x & 0xffffu))), g1 = silu_f(bf2f((unsigned short)(gw.x >> 16))), g2 = silu_f(bf2f((unsigned short)(gw.y & 0xffffu))), g3 = silu_f(bf2f((unsigned short)(gw.y >> 16)));
                u32x2 w; w.x = pk2(o[vv][0] * rs * og.x * g0, o[vv][1] * rs * og.y * g1); w.y = pk2(o[vv][2] * rs * og.z * g2, o[vv][3] * rs * og.w * g3);
                *(u32x2*)(CAT + row * KOUT + 1024 + h * 128 + v0) = w;
            }
        }
    }
#undef HG_LOAD
#undef HG_STORE
}


__device__ __forceinline__ int swap23(int r) { return (r & ~12) | ((r & 4) << 1) | ((r & 8) >> 1); }
__device__ __forceinline__ void xattn_mfma_phase(const bf16_t* Q, const bf16_t* Kb, const bf16_t* VT, bf16_t* O, LAS unsigned char* lds, int vb, int nvb) {
    const int tid = otid(), lane = tid & 63, wid = __builtin_amdgcn_readfirstlane(tid >> 6), r32 = lane & 31, hf = lane >> 5;
    LAS unsigned char* Ks = lds; LAS unsigned char* Vs = lds + 65536;
    int koff[8], voff[8];
    { const int kr = swap23(r32), x = kr & 15, y = r32 & 15;
#pragma unroll
      for (int ks = 0; ks < 8; ++ks) koff[ks] = kr * 256 + (((ks * 2 + hf) ^ x) << 4);
#pragma unroll
      for (int e = 0; e < 8; ++e) voff[e] = r32 * 512 + (((e * 2 + hf) ^ y) << 4); }
    for (int pair = vb; pair < 256; pair += nvb) {
        const int bh = pair >> 2, b = bh >> 2, h = bh & 3;
        __syncthreads();
        int tio = tid; asm volatile("" : "+v"(tio));
        for (int i = tio; i < 4096; i += NTHREADS) { const int key = i >> 4, ch = i & 15;
            const u32x4 v = *(const u32x4*)(Kb + (size_t)(b * MEMT + key) * 512 + h * 128 + ch * 8);
            *(LAS u32x4*)(Ks + key * 256 + ((ch ^ (key & 15)) << 4)) = v; }
        for (int i = tio; i < 4096; i += NTHREADS) { const int d = i >> 5, ch = i & 31;
            const u32x4 v = *(const u32x4*)(VT + (size_t)(h * 128 + d) * MT + b * MEMT + ch * 8);
            *(LAS u32x4*)(Vs + d * 512 + ((ch ^ (d & 15)) << 4)) = v; }
        __syncthreads();
#pragma unroll 1
        for (int qq = 0; qq < 2; ++qq) {
            const size_t q0 = (size_t)b * SEQ + ((pair & 3) * 2 + qq) * 256 + wid * 32;
            bf16x8 qf[8];
#pragma unroll
            for (int ks = 0; ks < 8; ++ks) qf[ks] = *(const bf16x8*)(Q + (q0 + r32) * 512 + h * 128 + ks * 16 + 8 * hf);
            f32x16 st[8];
            __builtin_amdgcn_s_setprio(1);
#pragma unroll
            for (int kt = 0; kt < 8; ++kt) {
#pragma unroll
                for (int r = 0; r < 16; ++r) st[kt][r] = 0.f;
#pragma unroll
                for (int ks = 0; ks < 8; ++ks) {
                    const bf16x8 a = *(const LAS bf16x8*)(Ks + koff[ks] + kt * 8192);
                    st[kt] = __builtin_amdgcn_mfma_f32_32x32x16_bf16(a, qf[ks], st[kt], 0, 0, 0);
                }
            }
            __builtin_amdgcn_s_setprio(0);
            float mx = -INFINITY;
#pragma unroll
            for (int kt = 0; kt < 8; ++kt)
#pragma unroll
                for (int r = 0; r < 16; ++r) mx = fmaxf(mx, st[kt][r]);
            mx = fmaxf(mx, __shfl_xor(mx, 32));
            const float c = 0.08838834764831845f * 1.4426950408889634f;
            float sum = 0.f;
#pragma unroll
            for (int kt = 0; kt < 8; ++kt)
#pragma unroll
                for (int r = 0; r < 16; ++r) { const float e = __builtin_amdgcn_exp2f((st[kt][r] - mx) * c); st[kt][r] = e; sum += e; }
            sum += __shfl_xor(sum, 32);
            const float inv = 1.f / sum;
            bf16x8 pfr[8][2];
#pragma unroll
            for (int kt = 0; kt < 8; ++kt)
#pragma unroll
                for (int s2 = 0; s2 < 2; ++s2) {
                    u32x4 pw;
                    pw.x = pk2(st[kt][8 * s2 + 0], st[kt][8 * s2 + 1]); pw.y = pk2(st[kt][8 * s2 + 2], st[kt][8 * s2 + 3]);
                    pw.z = pk2(st[kt][8 * s2 + 4], st[kt][8 * s2 + 5]); pw.w = pk2(st[kt][8 * s2 + 6], st[kt][8 * s2 + 7]);
                    pfr[kt][s2] = __builtin_bit_cast(bf16x8, pw);
                }
#pragma unroll
            for (int kt = 0; kt < 8; ++kt) asm volatile("" : "+v"(pfr[kt][0]), "+v"(pfr[kt][1]));
            f32x16 o[4];
#pragma unroll
            for (int dt = 0; dt < 4; ++dt)
#pragma unroll
                for (int r = 0; r < 16; ++r) o[dt][r] = 0.f;
            __builtin_amdgcn_s_setprio(1);
#pragma unroll
            for (int kt = 0; kt < 8; ++kt)
#pragma unroll
                for (int s2 = 0; s2 < 2; ++s2)
#pragma unroll
                    for (int dt = 0; dt < 4; ++dt) {
                        const bf16x8 a = *(const LAS bf16x8*)(Vs + voff[(kt & 3) * 2 + s2] + dt * 16384 + (kt >> 2) * 256);
                        o[dt] = __builtin_amdgcn_mfma_f32_32x32x16_bf16(a, pfr[kt][s2], o[dt], 0, 0, 0);
                    }
            __builtin_amdgcn_s_setprio(0);
            bf16_t* orow = O + (q0 + r32) * 512 + h * 128 + 4 * hf;
#pragma unroll
            for (int dt = 0; dt < 4; ++dt)
#pragma unroll
                for (int g = 0; g < 4; ++g) {
                    u32x2 w; w.x = pk2(o[dt][4 * g] * inv, o[dt][4 * g + 1] * inv); w.y = pk2(o[dt][4 * g + 2] * inv, o[dt][4 * g + 3] * inv);
                    *(u32x2*)(orow + dt * 32 + 8 * g) = w;
                }
        }
    }
}


__device__ __forceinline__ void gmlp_mfma_phase(const bf16_t* UV, const float* lnp, const float* ln_g, const float* ln_b, const float* w_sp, const float* b_sp, bf16_t* G, LAS unsigned char* lds, int vb, int nvb) {
    const int tid = otid(), lane = tid & 63, wid = __builtin_amdgcn_readfirstlane(tid >> 6), fr = lane & 15, fq = lane >> 4;
    LAS unsigned char* Wb = lds; LAS unsigned char* VTs = lds + 32768; LAS float* STAT = (LAS float*)(lds + 65536);
    int gcur = -1;
    for (int grp = vb; grp < 256; grp += nvb) {
        const int g = grp >> 5;
        bf16x8 vch[4]; f32x4 lp[2];
#define GM_LOAD(uu_) do { const size_t r0_ = (size_t)((grp & 31) * 8 + (uu_)) * 128; \
            _Pragma("unroll") for (int k = 0; k < 4; ++k) { const int i = tid + 512 * k, sI = i >> 4, ch = i & 15; vch[k] = *(const bf16x8*)(UV + (r0_ + sI) * 2048 + 1024 + g * 128 + ch * 8); } \
            lp[0] = *(const f32x4*)(lnp + (r0_ + (tid >> 2)) * 32 + (tid & 3) * 8); lp[1] = *(const f32x4*)(lnp + (r0_ + (tid >> 2)) * 32 + (tid & 3) * 8 + 4); } while (0)
        GM_LOAD(0);
        const f32x4 g0 = *(const f32x4*)(ln_g + g * 128 + (tid & 15) * 8), g1 = *(const f32x4*)(ln_g + g * 128 + (tid & 15) * 8 + 4);
        const f32x4 b0 = *(const f32x4*)(ln_b + g * 128 + (tid & 15) * 8), b1 = *(const f32x4*)(ln_b + g * 128 + (tid & 15) * 8 + 4);
        const float gg[8] = {g0.x, g0.y, g0.z, g0.w, g1.x, g1.y, g1.z, g1.w}, bb[8] = {b0.x, b0.y, b0.z, b0.w, b1.x, b1.y, b1.z, b1.w};
        __syncthreads();
        if (g != gcur) {
            gcur = g;
            for (int i = tid; i < 2048; i += NTHREADS) { const int t = i >> 4, ch = i & 15;
                const f32x4 a = *(const f32x4*)(w_sp + (size_t)g * 16384 + t * 128 + ch * 8), b = *(const f32x4*)(w_sp + (size_t)g * 16384 + t * 128 + ch * 8 + 4);
                const int s0 = ch * 8;
                u32x4 w; w.x = pk2(s0 + 0 <= t ? a.x : 0.f, s0 + 1 <= t ? a.y : 0.f); w.y = pk2(s0 + 2 <= t ? a.z : 0.f, s0 + 3 <= t ? a.w : 0.f);
                w.z = pk2(s0 + 4 <= t ? b.x : 0.f, s0 + 5 <= t ? b.y : 0.f); w.w = pk2(s0 + 6 <= t ? b.z : 0.f, s0 + 7 <= t ? b.w : 0.f);
                *(LAS u32x4*)(Wb + t * 256 + ((ch ^ (t & 15)) << 4)) = w; }
        }
        const int trow = wid * 16 + fr;
        const float bias = b_sp[g * 128 + trow];
#pragma unroll 1
        for (int uu = 0; uu < 8; ++uu) {
            const int bn = (grp & 31) * 8 + uu;
            const size_t row0 = (size_t)bn * 128;
            if (uu) __syncthreads();
            { float s1 = (lp[0].x + lp[0].z) + (lp[1].x + lp[1].z), s2 = (lp[0].y + lp[0].w) + (lp[1].y + lp[1].w);
              s1 += __shfl_xor(s1, 1); s2 += __shfl_xor(s2, 1); s1 += __shfl_xor(s1, 2); s2 += __shfl_xor(s2, 2);
              const float mu = s1 * (1.f / 1024.f), var = fmaxf(s2 * (1.f / 1024.f) - mu * mu, 0.f);
              if ((tid & 3) == 0) { STAT[2 * (tid >> 2)] = mu; STAT[2 * (tid >> 2) + 1] = rsqrtf(var + EPS); } }
            __syncthreads();
#pragma unroll
            for (int k = 0; k < 4; ++k) { const int i = tid + 512 * k, sI = i >> 4, ch = i & 15;
                const float mu = STAT[2 * sI], rs = STAT[2 * sI + 1];
#pragma unroll
                for (int e = 0; e < 8; ++e) { const int c = ch * 8 + e; const float x = (bf2f((unsigned short)vch[k][e]) - mu) * rs * gg[e] + bb[e];
                    *(LAS bf16_t*)(VTs + c * 256 + (((sI >> 3) ^ ((c ^ (c >> 3)) & 15)) << 4) + (sI & 7) * 2) = (bf16_t)f2bf(x); } }
            if (uu + 1 < 8) GM_LOAD(uu + 1);
            const size_t orow = row0 + trow;
            u32x2 uwv[8];
#pragma unroll
            for (int ct = 0; ct < 8; ++ct) uwv[ct] = *(const u32x2*)(UV + orow * 2048 + g * 128 + ct * 16 + 4 * fq);
            __syncthreads();
            f32x4 acc[8];
#pragma unroll
            for (int ct = 0; ct < 8; ++ct) acc[ct] = (f32x4){0.f, 0.f, 0.f, 0.f};
#pragma unroll
            for (int ks = 0; ks < 4; ++ks) {
                const bf16x8 wf = *(const LAS bf16x8*)(Wb + trow * 256 + (((ks * 4 + fq) ^ (trow & 15)) << 4));
#pragma unroll
                for (int ct = 0; ct < 8; ++ct) {
                    const int crow = ct * 16 + fr;
                    const bf16x8 vf = *(const LAS bf16x8*)(VTs + crow * 256 + (((ks * 4 + fq) ^ ((crow ^ (crow >> 3)) & 15)) << 4));
                    acc[ct] = __builtin_amdgcn_mfma_f32_16x16x32_bf16(vf, wf, acc[ct], 0, 0, 0);
                }
            }
#pragma unroll
            for (int ct = 0; ct < 8; ++ct) {
                const int c = ct * 16 + 4 * fq;
                const u32x2 uw = uwv[ct];
                const float u0 = bf2f((unsigned short)(uw.x & 0xffffu)), u1 = bf2f((unsigned short)(uw.x >> 16)), u2 = bf2f((unsigned short)(uw.y & 0xffffu)), u3 = bf2f((unsigned short)(uw.y >> 16));
                u32x2 w; w.x = pk2(u0 * (acc[ct][0] + bias), u1 * (acc[ct][1] + bias)); w.y = pk2(u2 * (acc[ct][2] + bias), u3 * (acc[ct][3] + bias));
                *(u32x2*)(G + orow * 1024 + g * 128 + c) = w;
            }
        }
#undef GM_LOAD
    }
}

#define GAS __attribute__((address_space(1)))
typedef GAS unsigned gu32;
#define XB_TMO      128
#define XB_XCNT(j)  (256  + 64 * (j))
#define XB_XSUB(j)  (1280 + 64 * (j))
#define XB_XGEN(j)  (2304 + 64 * (j))
#define XB_TOP      3328
#define XB_TOPGEN   3392
#define XCD_BAR_WORDS 3456
#define XB_SPIN_CAP (1u << 18)

__device__ __forceinline__ unsigned xb_ld(unsigned* p)              { return __hip_atomic_load(p, __ATOMIC_RELAXED, __HIP_MEMORY_SCOPE_AGENT); }
__device__ __forceinline__ unsigned xb_add(unsigned* p, unsigned v) { return __hip_atomic_fetch_add(p, v, __ATOMIC_RELAXED, __HIP_MEMORY_SCOPE_AGENT); }
__device__ __forceinline__ unsigned xb_xcc_id() { return (unsigned)__builtin_amdgcn_s_getreg((3 << 11) | 20) & 0xFu; }
#define XB_SPIN(cond, bar) do { unsigned _sp = 0; while (cond) { __builtin_amdgcn_s_sleep(1); \
    if ((++_sp & 255u) == 0u) { if (xb_ld(&(bar)[XB_TMO])) break; if (_sp > XB_SPIN_CAP) { atomicAdd(&(bar)[XB_TMO], 1u); break; } } } } while (0)

struct XcdBarrier {
    unsigned* bar; unsigned x;
    volatile LAS unsigned* st;
};

__device__ __forceinline__ XcdBarrier xcd_barrier_post(unsigned* bar, volatile LAS unsigned* st) {
    XcdBarrier b; b.bar = bar; b.x = xb_xcc_id(); b.st = st;
    if (threadIdx.x == 0) (void)xb_add(&bar[XB_XCNT(b.x)], 1u);
    return b;
}
__device__ __forceinline__ void xcd_barrier_complete(unsigned* bar, unsigned x, unsigned& nloc, unsigned& nx) {
    const unsigned G = gridDim.x * gridDim.y * gridDim.z;
    unsigned sum, cnt, mine, sp = 0u;
    for (;;) {
        sum = 0u; cnt = 0u; mine = 0u;
#pragma unroll
        for (unsigned j = 0; j < 16; ++j) { const unsigned c = xb_ld(&bar[XB_XCNT(j)]); sum += c; cnt += (c > 0u) ? 1u : 0u; mine = (j == x) ? c : mine; }
        if (sum == G) break;
        __builtin_amdgcn_s_sleep(1);
        if ((++sp & 255u) == 0u) { if (xb_ld(&bar[XB_TMO])) break; if (sp > XB_SPIN_CAP) { atomicAdd(&bar[XB_TMO], 1u); break; } }
    }
    nloc = mine > 0u ? mine : 1u; nx = cnt > 0u ? cnt : 1u;
}

__device__ __forceinline__ void xcd_barrier(const XcdBarrier& b) {
    asm volatile("s_waitcnt vmcnt(0)" ::: "memory");
    __syncthreads();
    if (threadIdx.x == 0) {
        unsigned* bar = b.bar;
        __builtin_amdgcn_s_waitcnt(0);
        unsigned nloc = b.st[0], nx = b.st[1];
        if (nloc == 0u) { xcd_barrier_complete(bar, b.x, nloc, nx); b.st[0] = nloc; b.st[1] = nx; }
        const unsigned old = xb_add(&bar[XB_XSUB(b.x)], 1u);
        const unsigned gen = old / nloc;
        if (old + 1u == (gen + 1u) * nloc) {
            __builtin_amdgcn_fence(__ATOMIC_RELEASE, "agent");
            asm volatile("s_waitcnt vmcnt(0)" ::: "memory");
            const unsigned og = xb_add(&bar[XB_TOP], 1u);
            const unsigned tg = og / nx;
            if (og + 1u == (tg + 1u) * nx) xb_add(&bar[XB_TOPGEN], 1u);
            else XB_SPIN(xb_ld(&bar[XB_TOPGEN]) == tg, bar);
            __builtin_amdgcn_fence(__ATOMIC_ACQUIRE, "agent");
            xb_add(&bar[XB_XGEN(b.x)], 1u);
            asm volatile("s_waitcnt vmcnt(0)" ::: "memory");
        } else {
            XB_SPIN(xb_ld(&bar[XB_XGEN(b.x)]) == gen, bar);
            __builtin_amdgcn_fence(__ATOMIC_ACQUIRE, "agent");
            asm volatile("s_waitcnt vmcnt(0)" ::: "memory");
        }
    }
    __syncthreads();
}

constexpr int LDS_BYTES = 32768 * 4 + 256 + 6144 + 8 * 2560;

enum Phase {
    PH_PREP = 0, PH_GEMM_IN, PH_CNORM, PH_MIX0  , PH_GEMM_OUT0,
    PH_GEMM_Q0, PH_XATTN0, PH_GEMM_O0, PH_GEMM_GU0, PH_GEMM_DN0,
    PH_GEMM_OIN, PH_GMLP, PH_GEMM_OOUT,
    PH_GEMM_Q1, PH_XATTN1, PH_GEMM_O1, PH_GEMM_GU1, PH_GEMM_DN1, PH_FINAL, PH_COUNT
};

__device__ __forceinline__ PrepJob make_job(const Params& p, int ji) {
    unsigned char* ws = p.ws; PrepJob j{};
    switch (ji) {
    case 0: j = PrepJob{p.in[5], 1024, 3272, p.in[4], (bf16_t*)(ws + WS_WIN), 1024, PW, 1024, 0, MAP_WIN}; break;
    case 1: j = PrepJob{p.in[10] + (size_t)512 * 1024, 512, 1024, nullptr, (bf16_t*)(ws + WS_WOUT), 0, 1024, KOUT, 1024, MAP_ID}; break;
    case 2: j = PrepJob{p.in[11], 1024, 2048, p.in[4] + 1024, (bf16_t*)(ws + WS_OWIN), 0, 2048, 1024, 0, MAP_ID, 2, WQ_GU}; break;
    case 3: j = PrepJob{p.in[16], 1024, 1024, nullptr, (bf16_t*)(ws + WS_OWOUT), 0, 1024, 1024, 0, MAP_ID}; break;
    case 4: case 5: { const int l = ji - 4; j = PrepJob{p.in[19] + (size_t)l * 1024 * 512, 1024, 512, p.in[17] + l * 1024, (bf16_t*)(ws + WS_WQ + (size_t)l * 512 * 1024), 0, 512, 1024, 0, MAP_ID, 2, WQ_GU}; } break;
    case 6: case 7: { const int l = ji - 6; j = PrepJob{p.in[20] + (size_t)l * 1024 * 1024, 1024, 1024, p.in[18] + l * 1024, (bf16_t*)(ws + WS_WKV) + (size_t)l * 1024 * 1024, 0, 1024, 1024, 0, MAP_ID}; } break;
    case 8: case 9: { const int l = ji - 8; j = PrepJob{p.in[21] + (size_t)l * 512 * 1024, 512, 1024, nullptr, (bf16_t*)(ws + WS_WO) + (size_t)l * 1024 * 512, 0, 1024, 512, 0, MAP_ID}; } break;
    case 10: case 11: { const int l = ji - 10; j = PrepJob{p.in[23] + (size_t)l * 1024 * 2 * FF, 1024, 2 * FF, p.in[22] + l * 1024, (bf16_t*)(ws + WS_WGU + (size_t)l * 2 * FF * 1024), 0, 2 * FF, 1024, 0, MAP_GU, 2, WQ_GU}; } break;
#if DN_FP8
    default: { const int l = ji - 12; j = PrepJob{p.in[24] + (size_t)l * FF * 1024, FF, 1024, nullptr, (bf16_t*)(ws + WS_WDN + (size_t)l * 1024 * FF), 0, 1024, FF, 0, MAP_ID, 1, WDN_SC}; } break;
#else
    default: { const int l = ji - 12; j = PrepJob{p.in[24] + (size_t)l * FF * 1024, FF, 1024, nullptr, (bf16_t*)(ws + WS_WDN) + (size_t)l * 1024 * FF, 0, 1024, FF, 0, MAP_ID}; } break;
#endif
    }
    return j;
}
constexpr int N_PREP_JOBS = 14;

template <int ph> __device__ __forceinline__ void run_phase(const Params& p, LAS float* lds, int vb, int nvb) {
    unsigned char* ws = p.ws;
    bf16_t* HN = (bf16_t*)(ws + WS_HN); bf16_t* BIG = (bf16_t*)(ws + WS_BIG); bf16_t* CN = (bf16_t*)(ws + WS_CN); bf16_t* CAT = (bf16_t*)(ws + WS_CAT);
    bf16_t* KB = (bf16_t*)(ws + WS_KB); bf16_t* VTB = (bf16_t*)(ws + WS_VT); bf16_t* MEMN = (bf16_t*)(ws + WS_MEMN); float* lb = (float*)(ws + WS_LB);
    float* ssq = (float*)(ws + WS_SSQ); float* lnp = (float*)(ws + WS_LNP);
    bf16_t* XQ = BIG; bf16_t* XO = BIG + (size_t)T * 512;
    const int l = (ph >= PH_GEMM_Q1) ? 1 : 0;
    switch (ph) {
    case PH_PREP:
        x_to_h_rows(p.in[0], HN, ssq, vb, nvb);
        {
            constexpr int NT_[N_PREP_JOBS] = {16 * 11, 8 * 4, 16 * 8, 16 * 4, 16 * 2, 16 * 2, 16 * 4, 16 * 4, 8 * 4, 8 * 4, 16 * 22, 16 * 22, 44 * 4, 44 * 4};
            constexpr int CUM1 = NT_[0], CUM2 = CUM1 + NT_[1], CUM3 = CUM2 + NT_[2], CUM4 = CUM3 + NT_[3], CUM5 = CUM4 + NT_[4], CUM6 = CUM5 + NT_[5], CUM7 = CUM6 + NT_[6],
                          CUM8 = CUM7 + NT_[7], CUM9 = CUM8 + NT_[8], CUM10 = CUM9 + NT_[9], CUM11 = CUM10 + NT_[10], CUM12 = CUM11 + NT_[11], CUM13 = CUM12 + NT_[12], CUM14 = CUM13 + NT_[13];
#define PJ_FIND(it_, ji_, base_) do { ji_ = 0; base_ = 0; \
                PJ_STEP(it_, ji_, base_, 1, CUM1) PJ_STEP(it_, ji_, base_, 2, CUM2) PJ_STEP(it_, ji_, base_, 3, CUM3) PJ_STEP(it_, ji_, base_, 4, CUM4) PJ_STEP(it_, ji_, base_, 5, CUM5) PJ_STEP(it_, ji_, base_, 6, CUM6) PJ_STEP(it_, ji_, base_, 7, CUM7) \
                PJ_STEP(it_, ji_, base_, 8, CUM8) PJ_STEP(it_, ji_, base_, 9, CUM9) PJ_STEP(it_, ji_, base_, 10, CUM10) PJ_STEP(it_, ji_, base_, 11, CUM11) PJ_STEP(it_, ji_, base_, 12, CUM12) PJ_STEP(it_, ji_, base_, 13, CUM13) } while (0)
#define PJ_STEP(it_, ji_, base_, q, c) if ((it_) >= (c)) { ji_ = (q); base_ = (c); }
            f32x4 va[8], vn[8];
            int ji, base;
            if (vb < CUM14) { PJ_FIND(vb, ji, base); const PrepJob j = make_job(p, ji); prep_tile_load(j, vb - base, va); }
            for (int it = vb; it < CUM14; it += nvb) {
                PJ_FIND(it, ji, base);
                const PrepJob j = make_job(p, ji); const int tl = it - base;
                if (it + nvb < CUM14) { int jn, bn; PJ_FIND(it + nvb, jn, bn); const PrepJob j2 = make_job(p, jn); prep_tile_load(j2, it + nvb - bn, vn); }
                prep_tile_store(j, tl, va, lds);
#pragma unroll
                for (int q = 0; q < 8; ++q) va[q] = vn[q];
            }
#undef PJ_STEP
#undef PJ_FIND
        }
        prep_fold_in(p.in[5], p.in[7], p.in[4], (bf16_t*)(ws + WS_WIN), lds, vb, nvb);
        prep_fold_out(p.in[10], p.in[8], (bf16_t*)(ws + WS_WOUT), lds, vb, nvb);
        prep_lb(p.in[3], lb, vb, nvb);
        rmsnorm_rows(p.in[1], MEMN, MT, vb, nvb);
        break;
    case PH_GEMM_IN: {
        Gemm g{(const bf16_t*)(ws + WS_WIN), (const bf16_t*)(ws + WS_WIN), T, PW, 1024}; EpiIn E{BIG, KB, VTB, ssq};
        pg8::ComboOrder S; S.init(nvb, vb);
        pg8::gemm_phase<EpiIn, pg8::ComboOrder, true, true>((LAS unsigned char*)lds, g, S, E);
    } break;
    case PH_CNORM: cnorm_rows(BIG, p.in[6], CN, vb, nvb); hgrn_prep(BIG, lb, (float*)(ws + WS_DEC), (LAS unsigned char*)lds, vb, nvb); break;
    case PH_MIX0:
        for (int item = vb; item < 64; item += nvb) hgrn_scan(BIG, (const float*)(ws + WS_DEC), p.in[9], CAT, (LAS unsigned char*)lds, item);
        dsa_mfma_phase(BIG, CN, p.in[2], CAT, (LAS unsigned char*)lds, (unsigned*)(ws + WS_CTL) + 3600);
        break;
    case PH_GEMM_OUT0: { Gemm g{CAT, (const bf16_t*)(ws + WS_WOUT), T, 1024, KOUT}; EpiResid<false, false, true> E{nullptr, HN, ssq, ws + WS_H8, HQ_Q0}; run_gemm(g, E, lds, vb, nvb); } break;
    case PH_GEMM_Q0: case PH_GEMM_Q1: { Gemm g{(const bf16_t*)(ws + WS_H8), (const bf16_t*)(ws + WS_WQ + (size_t)l * 512 * 1024), T, 512, 512}; EpiStoreBf16<true> E{XQ, 512, ssq, 1.f / ((l ? HQ_Q1 : HQ_Q0) * WQ_GU)}; run_gemm<EpiStoreBf16<true>, 2>(g, E, lds, vb, nvb); } break;
    case PH_XATTN0: case PH_XATTN1: xattn_mfma_phase(XQ, KB + (size_t)l * MT * 512, VTB + (size_t)l * 512 * MT, XO, (LAS unsigned char*)lds, vb, nvb); break;
    case PH_GEMM_O0: case PH_GEMM_O1: { Gemm g{XO, (const bf16_t*)(ws + WS_WO) + (size_t)l * 1024 * 512, T, 1024, 512}; EpiResid<false, false, true> E{nullptr, HN, ssq, ws + WS_H8, l ? HQ_GU1 : HQ_GU0}; run_gemm(g, E, lds, vb, nvb); } break;
    case PH_GEMM_GU0: case PH_GEMM_GU1: { Gemm g{(const bf16_t*)(ws + WS_H8), (const bf16_t*)(ws + WS_WGU + (size_t)l * 2 * FF * 1024), T, 2 * FF, 512}; EpiSwigluQ<true, DN_FP8 != 0> E{BIG, FF, ssq, 1.f / ((l ? HQ_GU1 : HQ_GU0) * WQ_GU)}; run_gemm<EpiSwigluQ<true, DN_FP8 != 0>, 2>(g, E, lds, vb, nvb); } break;
    case PH_GEMM_DN0: case PH_GEMM_DN1:
#if DN_FP8
        { Gemm g{BIG, (const bf16_t*)(ws + WS_WDN + (size_t)l * 1024 * FF), T, 1024, FF / 2}; EpiResid<false, true, ph == PH_GEMM_DN0> E{nullptr, HN, ssq, ws + WS_H8, HQ_OIN}; run_gemm<EpiResid<false, true, ph == PH_GEMM_DN0>, 1>(g, E, lds, vb, nvb); } break;
#else
        { Gemm g{BIG, (const bf16_t*)(ws + WS_WDN) + (size_t)l * 1024 * FF, T, 1024, FF}; EpiResid<false, false, ph == PH_GEMM_DN0> E{nullptr, HN, ssq, ws + WS_H8, HQ_OIN}; run_gemm(g, E, lds, vb, nvb); } break;
#endif
    case PH_GEMM_OIN: { Gemm g{(const bf16_t*)(ws + WS_H8), (const bf16_t*)(ws + WS_OWIN), T, 2048, 512}; EpiGeluBf16<true> E{BIG, 2048, ssq, lnp, 1.f / (HQ_OIN * WQ_GU)}; run_gemm<EpiGeluBf16<true>, 2>(g, E, lds, vb, nvb); } break;
    case PH_GMLP: gmlp_mfma_phase(BIG, lnp, p.in[12], p.in[13], p.in[14], p.in[15], CAT, (LAS unsigned char*)lds, vb, nvb); break;
    case PH_GEMM_OOUT: { Gemm g{CAT, (const bf16_t*)(ws + WS_OWOUT), T, 1024, 1024}; EpiResid<false, false, true> E{nullptr, HN, ssq, ws + WS_H8, HQ_Q1}; run_gemm(g, E, lds, vb, nvb); } break;
    case PH_FINAL: final_rows(HN, ssq, p.in[25], p.out, vb, nvb); break;
    default: break;
    }
}

template <int PH> __global__ void __launch_bounds__(NTHREADS) k_phase(Params p) {
    extern __shared__ __attribute__((aligned(16))) float smem[];
    run_phase<PH>(p, (LAS float*)smem, blockIdx.x, gridDim.x);
}

template <int PH> __device__ __forceinline__ void mega_phases(const Params& p, LAS float* lds, const XcdBarrier& bar) {
    run_phase<PH>(p, lds, blockIdx.x, gridDim.x);
#ifdef REPEAT_PH
    if constexpr (PH == REPEAT_PH) { xcd_barrier(bar); run_phase<PH>(p, lds, blockIdx.x, gridDim.x); }
#endif
    if constexpr (PH + 1 < PH_COUNT) { xcd_barrier(bar); mega_phases<PH + 1>(p, lds, bar); }
}
__global__ void __launch_bounds__(NTHREADS) k_mega(Params p) {
    extern __shared__ __attribute__((aligned(16))) float smem[];
    volatile LAS unsigned* st = (volatile LAS unsigned*)((LAS float*)smem + 32768);
    if (threadIdx.x < 2) st[threadIdx.x] = 0u;
    __syncthreads();
    const XcdBarrier bar = xcd_barrier_post((unsigned*)(p.ws + WS_CTL), st);
    mega_phases<0>(p, (LAS float*)smem, bar);
}

template <int PH> static void launch_phases(const Params& p, int grid, hipStream_t stream) {
    int g = grid * 4;
    if (PH == PH_MIX0 || PH == PH_XATTN0 || PH == PH_XATTN1 || PH == PH_GMLP) g = grid;
    (void)hipFuncSetAttribute((const void*)k_phase<PH>, hipFuncAttributeMaxDynamicSharedMemorySize, LDS_BYTES);
    hipLaunchKernelGGL(k_phase<PH>, dim3(g), dim3(NTHREADS), LDS_BYTES, stream, p);
    if constexpr (PH + 1 < PH_COUNT) launch_phases<PH + 1>(p, grid, stream);
}

extern "C" void kernel_launch(void* const* d_in, const int* in_sizes, int n_in, void* d_out, int out_size, void* d_ws, size_t ws_size, hipStream_t stream) {
    static int grid = 0;
    if (grid == 0) {
        if (n_in != 26 || out_size != T * D || ws_size < WS_END) { fprintf(stderr, "kernel_launch: unexpected shapes (n_in %d out %d ws %zu)\n", n_in, out_size, ws_size); grid = -1; return; }
        int dev = 0, cus = 0;
        (void)hipGetDevice(&dev); (void)hipDeviceGetAttribute(&cus, hipDeviceAttributeMultiprocessorCount, dev);
        (void)hipFuncSetAttribute((const void*)k_mega, hipFuncAttributeMaxDynamicSharedMemorySize, LDS_BYTES);
        int per_cu = 0;
        (void)hipOccupancyMaxActiveBlocksPerMultiprocessor(&per_cu, (const void*)k_mega, NTHREADS, LDS_BYTES);
        if (per_cu < 1) fprintf(stderr, "kernel_launch: occupancy query says %d blocks per CU\n", per_cu);
        (void)hipGetLastError();
        grid = cus > 0 ? cus : 256;
    }
    if (grid < 0) return;
    Params p{};
    for (int i = 0; i < 26; ++i) p.in[i] = (const float*)d_in[i];
    p.out = (float*)d_out; p.ws = (unsigned char*)d_ws;
    (void)hipMemsetAsync((char*)d_ws + WS_CTL, 0, 16384, stream);
#if MEGA
    hipLaunchKernelGGL(k_mega, dim3(grid), dim3(NTHREADS), LDS_BYTES, stream, p);
#else
    launch_phases<0>(p, grid, stream);
#endif
}
```

```cpp
#include <hip/hip_runtime.h>
#include <stdint.h>
#include <stdio.h>

#ifndef MEGA
#define MEGA 1
#endif
#ifndef DN_FP8
#define DN_FP8 0
#endif

#define LAS __attribute__((address_space(3)))
typedef unsigned short bf16_t;
typedef short bf16x8 __attribute__((ext_vector_type(8)));
typedef float f32x4 __attribute__((ext_vector_type(4)));
typedef float f32x2 __attribute__((ext_vector_type(2)));
typedef unsigned u32x4 __attribute__((ext_vector_type(4)));
typedef unsigned u32x2 __attribute__((ext_vector_type(2)));
typedef float f32x16 __attribute__((ext_vector_type(16)));

constexpr int D = 1024, BATCH = 16, SEQ = 2048, T = BATCH * SEQ;
constexpr int CHUNK = 64;
constexpr int MEMT = 256, MT = BATCH * MEMT;
constexpr int FF = 2816;
constexpr float EPS = 1e-6f;
constexpr int NTHREADS = 512, NWAVES = 8;

constexpr int P_QL = 0, P_C = 1024, P_QI = 1152, P_KI = 1664, P_FB = 1728, P_IB = 2240, P_QB = 2752, P_GB = 3264, P_WI = 3776, P_END = 3784, PW = 3840;
constexpr int KOUT = 1536;

constexpr size_t MiB = 1u << 20;
constexpr size_t WS_CTL = 0;
constexpr size_t WS_LB = 64 * 1024;
constexpr size_t WS_SSQ = 496 * MiB;
constexpr size_t WS_LNP = 498 * MiB;
constexpr size_t WS_WIN = 1 * MiB;
constexpr size_t WS_WKV = WS_WIN + (size_t)PW * D * 2;
constexpr size_t WS_HN = WS_WKV + 2 * (size_t)D * D * 2;
constexpr size_t WS_MEMN = WS_HN + (size_t)T * D * 2;
constexpr size_t WS_WOUT = WS_MEMN + (size_t)MT * D * 2;
constexpr size_t WS_OWIN = WS_WOUT + (size_t)D * KOUT * 2;
constexpr size_t WS_OWOUT = WS_OWIN + (size_t)2048 * D * 2;
constexpr size_t WS_WQ = WS_OWOUT + (size_t)D * D * 2;
constexpr size_t WS_WO = WS_WQ + 2 * (size_t)512 * D * 2;
constexpr size_t WS_WGU = WS_WO + 2 * (size_t)D * 512 * 2;
constexpr size_t WS_WDN = WS_WGU + 2 * (size_t)2 * FF * D * 2;
constexpr size_t WS_WEND = WS_WDN + 2 * (size_t)D * FF * 2;
constexpr int TILE_WIN = 0, TILE_WKV = PW / 256, TILE_HN = TILE_WKV + 8, TILE_MEMN = TILE_HN + T / 256;
constexpr size_t WS_BIG = 132 * MiB;
constexpr size_t WS_CN = 372 * MiB;
constexpr size_t WS_CAT = 380 * MiB;
constexpr size_t WS_H8 = WS_BIG + 200 * MiB;
constexpr size_t WS_KB = 476 * MiB;
constexpr size_t WS_VT = 484 * MiB;
constexpr size_t WS_END = 502 * MiB;
static_assert(WS_WEND <= WS_BIG, "weights fit below BIG");

struct Params {
    const float* in[26];
    float* out;
    unsigned char* ws;
};

__device__ __forceinline__ float bf2f(unsigned short u) { return __uint_as_float(((unsigned)u) << 16); }
__device__ __forceinline__ unsigned f2bf(float f) { unsigned u = __float_as_uint(f); return (u + 0x7fffu + ((u >> 16) & 1u)) >> 16; }
typedef __bf16 bf16x2_t __attribute__((ext_vector_type(2)));
__device__ __forceinline__ unsigned pk2(float lo, float hi) { const f32x2 v = {lo, hi}; return __builtin_bit_cast(unsigned, __builtin_convertvector(v, bf16x2_t)); }
__device__ __forceinline__ float wave_sum(float v) {
#pragma unroll
    for (int o = 1; o < 64; o <<= 1) v += __shfl_xor(v, o);
    return v;
}
__device__ __forceinline__ float wave_max(float v) {
#pragma unroll
    for (int o = 1; o < 64; o <<= 1) v = fmaxf(v, __shfl_xor(v, o));
    return v;
}
__device__ __forceinline__ int otid() { int t = threadIdx.x; asm volatile("" : "+v"(t)); return t; }
#define WAVE_LDS_SYNC() asm volatile("s_waitcnt lgkmcnt(0)" ::: "memory")
__device__ __forceinline__ float silu_f(float x) { return x * __builtin_amdgcn_rcpf(1.f + __expf(-x)); }
__device__ __forceinline__ float sigmoid_f(float x) { return __builtin_amdgcn_rcpf(1.f + __expf(-x)); }

typedef int i32x4v __attribute__((ext_vector_type(4)));
typedef int i32x8v __attribute__((ext_vector_type(8)));
__device__ __forceinline__ unsigned pk4_f8(float a, float b, float c, float d) {
    a = __builtin_amdgcn_fmed3f(a, -448.f, 448.f); b = __builtin_amdgcn_fmed3f(b, -448.f, 448.f); c = __builtin_amdgcn_fmed3f(c, -448.f, 448.f); d = __builtin_amdgcn_fmed3f(d, -448.f, 448.f);
    int w = 0;
    w = __builtin_amdgcn_cvt_pk_fp8_f32(a, b, w, false);
    w = __builtin_amdgcn_cvt_pk_fp8_f32(c, d, w, true);
    return (unsigned)w;
}
constexpr float ACT_SC = 8.f, WDN_SC = 256.f, DN_UNSC = 1.f / (ACT_SC * WDN_SC);
constexpr float HQ_Q0 = 127.f / 6.5f, HQ_GU0 = 127.f / 6.5f, HQ_OIN = 127.f / 7.f, HQ_Q1 = 127.f / 8.f, HQ_GU1 = 127.f / 8.f, WQ_GU = 127.f / 0.14f;
__device__ __forceinline__ unsigned pk4_i8(float a, float b, float c, float d) {
    a = __builtin_amdgcn_fmed3f(__builtin_rintf(a) + 128.f, 1.f, 255.f); b = __builtin_amdgcn_fmed3f(__builtin_rintf(b) + 128.f, 1.f, 255.f);
    c = __builtin_amdgcn_fmed3f(__builtin_rintf(c) + 128.f, 1.f, 255.f); d = __builtin_amdgcn_fmed3f(__builtin_rintf(d) + 128.f, 1.f, 255.f);
    unsigned w = 0;
    w = __builtin_amdgcn_cvt_pk_u8_f32(a, 0, w); w = __builtin_amdgcn_cvt_pk_u8_f32(b, 1, w); w = __builtin_amdgcn_cvt_pk_u8_f32(c, 2, w); w = __builtin_amdgcn_cvt_pk_u8_f32(d, 3, w);
    return w ^ 0x80808080u;
}
__device__ __forceinline__ int kperm8(int k) { const int r = k & 255; return (k & ~255) + ((r >> 5) & 3) * 64 + ((r >> 3) & 3) * 16 + (r >> 7) * 8 + (r & 7); }
__device__ __forceinline__ f32x4 i2f4(f32x4 v) { const i32x4v t = __builtin_bit_cast(i32x4v, v); return (f32x4){(float)t.x, (float)t.y, (float)t.z, (float)t.w}; }
struct Unit { int pm, pn; };
struct Gemm { const bf16_t* A; const bf16_t* Bt; int M, N, K; };
__device__ __forceinline__ int perm32(int rho) { const int n = rho >> 4, i = rho & 15; return 8 * (i >> 2) + 4 * n + (i & 3); }

__device__ __forceinline__ float row_rstd(const float* ssq, size_t row) {
    const f32x4* p = (const f32x4*)(ssq + row * 16);
    const f32x4 a = p[0], b = p[1], c = p[2], d = p[3];
    const float t = (((a.x + a.y) + (a.z + a.w)) + ((b.x + b.y) + (b.z + b.w))) + (((c.x + c.y) + (c.z + c.w)) + ((d.x + d.y) + (d.z + d.w)));
    return rsqrtf(t * (1.f / 1024.f) + EPS);
}
__device__ __forceinline__ void rows_rstd(const float* ssq, size_t row0, int fq, float (&rs)[2][4]) {
#pragma unroll
    for (int ai = 0; ai < 2; ++ai)
#pragma unroll
        for (int m = 0; m < 4; ++m) { const f32x4 a = *(const f32x4*)(ssq + (row0 + ai * 128 + m * 16) * 16 + 4 * fq); rs[ai][m] = (a.x + a.y) + (a.z + a.w); }
#pragma unroll
    for (int ai = 0; ai < 2; ++ai)
#pragma unroll
        for (int m = 0; m < 4; ++m) { float t = rs[ai][m]; t += __shfl_xor(t, 16); t += __shfl_xor(t, 32); rs[ai][m] = rsqrtf(t * (1.f / 1024.f) + EPS); }
}
template <bool ACC_I8 = false> struct EpiStoreBf16 {
    static constexpr bool PERM = true, AFTER_DRAIN = false;
    bf16_t* O; int ldc; const float* ssq; float dq = 1.f;
    __device__ __forceinline__ void operator()(const f32x4 (&acc)[2][2][4][2], const Unit& u, int wr, int wc, int fr, int fq) const {
        const int row0 = u.pm * 256 + wr * 64 + fr, col0 = u.pn * 256 + wc * 32 + 8 * fq;
        float rsv[2][4]; rows_rstd(ssq, (size_t)row0, fq, rsv);
#pragma unroll
        for (int ai = 0; ai < 2; ++ai)
#pragma unroll
            for (int m = 0; m < 4; ++m) {
                const float rs = ACC_I8 ? rsv[ai][m] * dq : rsv[ai][m];
                bf16_t* rowp = O + (size_t)(row0 + ai * 128 + m * 16) * ldc + col0;
#pragma unroll
                for (int bj = 0; bj < 2; ++bj) {
                    const f32x4 v0 = (ACC_I8 ? i2f4(acc[ai][bj][m][0]) : acc[ai][bj][m][0]) * rs, v1 = (ACC_I8 ? i2f4(acc[ai][bj][m][1]) : acc[ai][bj][m][1]) * rs;
                    u32x4 w; w.x = pk2(v0[0], v0[1]); w.y = pk2(v0[2], v0[3]); w.z = pk2(v1[0], v1[1]); w.w = pk2(v1[2], v1[3]);
                    *(u32x4*)(rowp + bj * 128) = w;
                }
            }
    }
};
struct EpiIn {
    static constexpr bool PERM = true, AFTER_DRAIN = false;
    bf16_t* P; bf16_t* KB; bf16_t* VT; const float* ssq;
    __device__ __forceinline__ void operator()(const f32x4 (&acc)[2][2][4][2], const Unit& u, int wr, int wc, int fr, int fq) const {
        bf16_t* O; int ldc, rt, ct; const bool main_unit = u.pn < TILE_WKV;
        if (main_unit) { O = P; ldc = PW; rt = u.pm - TILE_HN; ct = u.pn; }
        else if (u.pm >= TILE_MEMN) { const int l = (u.pn - TILE_WKV) >> 2; O = KB + (size_t)l * MT * 512; ldc = 512; rt = u.pm - TILE_MEMN; ct = (u.pn - TILE_WKV) & 3; }
        else { const int l = (u.pm - TILE_WKV) >> 2; O = VT + (size_t)l * 512 * MT; ldc = MT; rt = ((u.pm - TILE_WKV) & 3) - 2; ct = u.pn - TILE_MEMN; }
        const int row0 = rt * 256 + wr * 64 + fr, col0 = ct * 256 + wc * 32 + 8 * fq;
        float rsv[2][4];
        if (main_unit) rows_rstd(ssq, (size_t)row0, fq, rsv);
        else {
#pragma unroll
            for (int ai = 0; ai < 2; ++ai)
#pragma unroll
                for (int m = 0; m < 4; ++m) rsv[ai][m] = 1.f; }
#pragma unroll
        for (int ai = 0; ai < 2; ++ai)
#pragma unroll
            for (int m = 0; m < 4; ++m) {
                const float rs = rsv[ai][m];
                bf16_t* rowp = O + (size_t)(row0 + ai * 128 + m * 16) * ldc + col0;
#pragma unroll
                for (int bj = 0; bj < 2; ++bj) {
                    const f32x4 v0 = acc[ai][bj][m][0] * rs, v1 = acc[ai][bj][m][1] * rs;
                    u32x4 w; w.x = pk2(v0[0], v0[1]); w.y = pk2(v0[2], v0[3]); w.z = pk2(v1[0], v1[1]); w.w = pk2(v1[2], v1[3]);
                    *(u32x4*)(rowp + bj * 128) = w;
                }
            }
    }
};
template <bool ACC_I8 = false> struct EpiGeluBf16 {
    static constexpr bool PERM = true, AFTER_DRAIN = false;
    bf16_t* O; int ldc; const float* ssq; float* lnp; float dq = 1.f;
    __device__ __forceinline__ static f32x2 gelu_pk(f32x2 v) {
        const f32x2 av = __builtin_elementwise_abs(v), d = av * 0.2316418882f + 1.0f;
        f32x2 t; t.x = __builtin_amdgcn_rcpf(d.x); t.y = __builtin_amdgcn_rcpf(d.y);
        f32x2 q = t * 0.5307027145f + (-0.7265760135f); q = q * t + 0.7107068705f; q = q * t + (-0.142248368f); q = q * t + 0.127414796f; q = q * t;
        const f32x2 sq = (v * v) * (-0.72134752044f);
        f32x2 e; e.x = __builtin_amdgcn_exp2f(sq.x); e.y = __builtin_amdgcn_exp2f(sq.y);
        const f32x2 mm = v * (q * e), r = v - mm;
        f32x2 o; o.x = v.x < 0.f ? mm.x : r.x; o.y = v.y < 0.f ? mm.y : r.y; return o;
    }
    __device__ __forceinline__ static unsigned g2(float a, float b) { const f32x2 r = gelu_pk((f32x2){a, b}); return pk2(r.x, r.y); }
    __device__ __forceinline__ void operator()(const f32x4 (&acc)[2][2][4][2], const Unit& u, int wr, int wc, int fr, int fq) const {
        const int row0 = u.pm * 256 + wr * 64 + fr, col0 = u.pn * 256 + wc * 32 + 8 * fq;
        float rsv[2][4]; rows_rstd(ssq, (size_t)row0, fq, rsv);
#pragma unroll
        for (int ai = 0; ai < 2; ++ai)
#pragma unroll
            for (int m = 0; m < 4; ++m) {
                const size_t row = (size_t)(row0 + ai * 128 + m * 16);
                const float rs = ACC_I8 ? rsv[ai][m] * dq : rsv[ai][m];
                bf16_t* rowp = O + row * ldc + col0;
                float s1 = 0.f, s2 = 0.f;
#pragma unroll
                for (int bj = 0; bj < 2; ++bj) {
                    const f32x4 v0 = (ACC_I8 ? i2f4(acc[ai][bj][m][0]) : acc[ai][bj][m][0]) * rs, v1 = (ACC_I8 ? i2f4(acc[ai][bj][m][1]) : acc[ai][bj][m][1]) * rs;
                    const f32x2 ga = gelu_pk((f32x2){v0[0], v0[1]}), gb = gelu_pk((f32x2){v0[2], v0[3]}), gc = gelu_pk((f32x2){v1[0], v1[1]}), gd = gelu_pk((f32x2){v1[2], v1[3]});
                    u32x4 w; w.x = pk2(ga.x, ga.y); w.y = pk2(gb.x, gb.y); w.z = pk2(gc.x, gc.y); w.w = pk2(gd.x, gd.y);
                    *(u32x4*)(rowp + bj * 128) = w;
                    s1 += ((ga.x + ga.y) + (gb.x + gb.y)) + ((gc.x + gc.y) + (gd.x + gd.y));
                    s2 += ((ga.x * ga.x + ga.y * ga.y) + (gb.x * gb.x + gb.y * gb.y)) + ((gc.x * gc.x + gc.y * gc.y) + (gd.x * gd.x + gd.y * gd.y));
                }
                if (u.pn >= 4) {
                    s1 += __shfl_xor(s1, 16); s1 += __shfl_xor(s1, 32); s2 += __shfl_xor(s2, 16); s2 += __shfl_xor(s2, 32);
                    if (fq == 0) *(f32x2*)(lnp + (row * 16 + (u.pn - 4) * 4 + wc) * 2) = (f32x2){s1, s2};
                }
            }
    }
};
struct EpiSwigluBf16 {
    static constexpr bool PERM = true, AFTER_DRAIN = false;
    bf16_t* O; int ldc; const float* ssq;
    __device__ __forceinline__ void operator()(const f32x4 (&acc)[2][2][4][2], const Unit& u, int wr, int wc, int fr, int fq) const {
        const int row0 = u.pm * 256 + wr * 64 + fr, col0 = u.pn * 128 + wc * 32 + 8 * fq;
        float rsv[2][4]; rows_rstd(ssq, (size_t)row0, fq, rsv);
#pragma unroll
        for (int ai = 0; ai < 2; ++ai)
#pragma unroll
            for (int m = 0; m < 4; ++m) {
                const float rs = rsv[ai][m];
                bf16_t* rowp = O + (size_t)(row0 + ai * 128 + m * 16) * ldc + col0;
                const f32x4 g0 = acc[ai][0][m][0] * rs, g1 = acc[ai][0][m][1] * rs, u0 = acc[ai][1][m][0] * rs, u1 = acc[ai][1][m][1] * rs;
                u32x4 w;
                w.x = pk2(silu_f(g0[0]) * u0[0], silu_f(g0[1]) * u0[1]); w.y = pk2(silu_f(g0[2]) * u0[2], silu_f(g0[3]) * u0[3]);
                w.z = pk2(silu_f(g1[0]) * u1[0], silu_f(g1[1]) * u1[1]); w.w = pk2(silu_f(g1[2]) * u1[2], silu_f(g1[3]) * u1[3]);
                *(u32x4*)rowp = w;
            }
    }
};
template <bool ACC_I8, bool OUT_F8> struct EpiSwigluQ {
    static constexpr bool PERM = true, AFTER_DRAIN = false;
    void* O; int ldc; const float* ssq; float dq;
    __device__ __forceinline__ void operator()(const f32x4 (&acc)[2][2][4][2], const Unit& u, int wr, int wc, int fr, int fq) const {
        const int row0 = u.pm * 256 + wr * 64 + fr, col0 = u.pn * 128 + wc * 32 + 8 * fq;
        float rsv[2][4]; rows_rstd(ssq, (size_t)row0, fq, rsv);
#pragma unroll
        for (int ai = 0; ai < 2; ++ai)
#pragma unroll
            for (int m = 0; m < 4; ++m) {
                const float rs = ACC_I8 ? rsv[ai][m] * dq : rsv[ai][m], rsu = OUT_F8 ? rs * ACT_SC : rs;
                f32x4 g0 = acc[ai][0][m][0], g1 = acc[ai][0][m][1], u0 = acc[ai][1][m][0], u1 = acc[ai][1][m][1];
                if (ACC_I8) { g0 = i2f4(g0); g1 = i2f4(g1); u0 = i2f4(u0); u1 = i2f4(u1); }
                g0 = g0 * rs; g1 = g1 * rs; u0 = u0 * rsu; u1 = u1 * rsu;
                if (OUT_F8) {
                    unsigned char* rowp = (unsigned char*)O + (size_t)(row0 + ai * 128 + m * 16) * ldc + col0;
                    u32x2 w;
                    w.x = pk4_f8(silu_f(g0[0]) * u0[0], silu_f(g0[1]) * u0[1], silu_f(g0[2]) * u0[2], silu_f(g0[3]) * u0[3]);
                    w.y = pk4_f8(silu_f(g1[0]) * u1[0], silu_f(g1[1]) * u1[1], silu_f(g1[2]) * u1[2], silu_f(g1[3]) * u1[3]);
                    *(u32x2*)rowp = w;
                } else {
                    bf16_t* rowp = (bf16_t*)O + (size_t)(row0 + ai * 128 + m * 16) * ldc + col0;
                    u32x4 w;
                    w.x = pk2(silu_f(g0[0]) * u0[0], silu_f(g0[1]) * u0[1]); w.y = pk2(silu_f(g0[2]) * u0[2], silu_f(g0[3]) * u0[3]);
                    w.z = pk2(silu_f(g1[0]) * u1[0], silu_f(g1[1]) * u1[1]); w.w = pk2(silu_f(g1[2]) * u1[2], silu_f(g1[3]) * u1[3]);
                    *(u32x4*)rowp = w;
                }
            }
    }
};
template <bool BASE_F32, bool SCALED = false, bool W8 = false> struct EpiResid {
    static constexpr bool PERM = true, AFTER_DRAIN = false;
    const float* xbase; bf16_t* H; float* ssq; unsigned char* H8 = nullptr; float hq = 0.f;
    __device__ __forceinline__ void operator()(const f32x4 (&acc)[2][2][4][2], const Unit& u, int wr, int wc, int fr, int fq) const {
        const int row0 = u.pm * 256 + wr * 64 + fr, col0 = u.pn * 256 + wc * 32 + 8 * fq;
#pragma unroll
        for (int ai = 0; ai < 2; ++ai)
#pragma unroll
            for (int m = 0; m < 4; ++m) {
                const size_t row = (size_t)(row0 + ai * 128 + m * 16);
                float ss = 0.f; u32x4 q8 = (u32x4){0u, 0u, 0u, 0u};
#pragma unroll
                for (int bj = 0; bj < 2; ++bj) {
                    const size_t off = row * 1024 + col0 + bj * 128;
                    f32x4 b0, b1;
                    if (BASE_F32) { b0 = *(const f32x4*)(xbase + off); b1 = *(const f32x4*)(xbase + off + 4); }
                    else { const u32x4 hw = *(const u32x4*)(H + off);
                        b0 = (f32x4){bf2f((unsigned short)(hw.x & 0xffffu)), bf2f((unsigned short)(hw.x >> 16)), bf2f((unsigned short)(hw.y & 0xffffu)), bf2f((unsigned short)(hw.y >> 16))};
                        b1 = (f32x4){bf2f((unsigned short)(hw.z & 0xffffu)), bf2f((unsigned short)(hw.z >> 16)), bf2f((unsigned short)(hw.w & 0xffffu)), bf2f((unsigned short)(hw.w >> 16))}; }
                    const float sc = SCALED ? DN_UNSC : 1.f;
                    const f32x4 v0 = b0 + acc[ai][bj][m][0] * sc, v1 = b1 + acc[ai][bj][m][1] * sc;
                    u32x4 w; w.x = pk2(v0[0], v0[1]); w.y = pk2(v0[2], v0[3]); w.z = pk2(v1[0], v1[1]); w.w = pk2(v1[2], v1[3]);
                    *(u32x4*)(H + off) = w;
                    if (W8) { q8[2 * bj] = pk4_i8(v0[0] * hq, v0[1] * hq, v0[2] * hq, v0[3] * hq); q8[2 * bj + 1] = pk4_i8(v1[0] * hq, v1[1] * hq, v1[2] * hq, v1[3] * hq); }
                    ss += ((v0[0] * v0[0] + v0[1] * v0[1]) + (v0[2] * v0[2] + v0[3] * v0[3])) + ((v1[0] * v1[0] + v1[1] * v1[1]) + (v1[2] * v1[2] + v1[3] * v1[3]));
                }
                if (W8) *(u32x4*)(H8 + row * 1024 + u.pn * 256 + wc * 64 + fq * 16) = q8;
                ss += __shfl_xor(ss, 16); ss += __shfl_xor(ss, 32);
                if (fq == 0) ssq[row * 16 + u.pn * 4 + wc] = ss;
            }
    }
};
namespace pg8 {
#define PG8_LAS __attribute__((address_space(3)))
constexpr int BM = 256, BK = 64, HALF = 128, HTB = HALF * BK * 2  , STAGE_BYTES = 8 * HTB, NXCD = 8, WGM = 8;
__host__ __device__ __forceinline__ int lds_byte(int r, int c) { const int st = (r >> 4) * 2 + (c >> 5), rr = r & 15, cc = c & 31, ob = rr * 64 + cc * 2; return st * 1024 + (ob ^ (((ob >> 9) & 1) << 5)); }
__host__ __device__ __forceinline__ void stage_rc(int b, int& R, int& C) { const int st = b / 1024, sb = b % 1024, swz = sb ^ (((sb >> 9) & 1) << 5); R = (st >> 1) * 16 + swz / 64; C = (st & 1) * 32 + (swz % 64) / 2; }
struct StaticOrder {
    int nM, nN, nwg, G, c;
    __host__ __device__ void init(int M, int N, int G_, int c_) { nM = M / BM; nN = N / BM; nwg = nM * nN; G = G_; c = c_; }
    __host__ __device__ bool next(int i, Unit& u) const {
        const long L = (long)i * G + c; if (L >= nwg) return false;
        int wgid = (int)L; { const int q = nwg / NXCD, r = nwg % NXCD, xcd = wgid % NXCD, off = wgid / NXCD; wgid = (xcd < r ? xcd * (q + 1) : r * (q + 1) + (xcd - r) * q) + off; }
        const int nig = WGM * nN, gid = wgid / nig, fm = gid * WGM, gsz = (nM - fm) < WGM ? (nM - fm) : WGM;
        u.pm = fm + ((wgid % nig) % gsz); u.pn = (wgid % nig) / gsz; return true;
    }
    __device__ __forceinline__ void a_ready(const Unit&) const {}
    __device__ __forceinline__ void done(const Unit&) const {}
};
struct ComboOrder {
    StaticOrder so;
    __host__ __device__ void init(int G_, int c_) { so.init(T, PW, G_, c_); }
    __host__ __device__ bool next(int i, Unit& u) const {
        const long L = (long)i * so.G + so.c;
        if (L < so.nwg) { so.next(i, u); u.pm += TILE_HN; return true; }
        const int j = (int)(L - so.nwg); if (j >= 128) return false;
        const int l = j >> 6, jj = j & 63;
        if (jj < 32) { u.pm = TILE_MEMN + (jj >> 1); u.pn = TILE_WKV + 4 * l + (jj & 1); }
        else { const int q = jj - 32; u.pm = TILE_WKV + 4 * l + 2 + (q >> 4); u.pn = TILE_MEMN + (q & 15); }
        return true;
    }
    __device__ __forceinline__ void a_ready(const Unit&) const {}
    __device__ __forceinline__ void done(const Unit&) const {}
};
template <class Epi, class Sched, bool ALIGN_EPI = false, bool SP2 = false, int QM = 0  >
__device__ __forceinline__ void gemm_phase(PG8_LAS unsigned char* lds, const Gemm g, const Sched& S, const Epi& E) {
    const int tid = otid(), wid = __builtin_amdgcn_readfirstlane(tid >> 6), lane = tid & 63, wr = wid >> 2, wc = wid & 3, fr = lane & 15, fq = lane >> 4;
    constexpr bool FP8 = (QM == 1), I8 = (QM == 2);
    const int K = g.K, nt = K / BK;
    unsigned voffA[2], voffB[2];
#pragma unroll
    for (int i = 0; i < 2; ++i) { int R, C; stage_rc(tid * 16 + i * 8192, R, C); const int Rb = Epi::PERM ? ((R & ~31) + perm32(R & 31)) : R;
        voffA[i] = (unsigned)(R * K + C) * 2u; voffB[i] = (unsigned)(Rb * K + C) * 2u; }
    const size_t kstep = (size_t)(BK * 2);
    const size_t hstep = (size_t)HALF * K * 2;
    const size_t tstep = 2 * hstep;
    const unsigned ldsw = (unsigned)wid * 1024u;
    const int aoff = lds_byte(wr * 64 + fr, fq * 8), boff = lds_byte(wc * 32 + fr, fq * 8);
#define PG8_SA(b, h) (((b) * 2 + (h)) * HTB)
#define PG8_SB(b, h) ((4 + (b) * 2 + (h)) * HTB)
#define PG8_STAGE(bufoff, gbase, voff) do { _Pragma("unroll") for (int _i = 0; _i < 2; ++_i) \
        __builtin_amdgcn_global_load_lds((const unsigned*)((const char*)(gbase) + (voff)[_i]), (PG8_LAS unsigned*)(lds + (bufoff) + ldsw + _i * 8192), 16, 0, 0); } while (0)
#define PG8_LD16(off) (*(const PG8_LAS bf16x8*)(lds + (off)))
#define PG8_LDA(dst, b, h) do { _Pragma("unroll") for (int m = 0; m < 4; ++m) { \
        if constexpr (FP8) dst##8[m] = PG8_CAT(PG8_LD16(PG8_SA(b, h) + aoff + m * 2048), PG8_LD16(PG8_SA(b, h) + aoff + m * 2048 + 1024)); \
        else { _Pragma("unroll") for (int k = 0; k < 2; ++k) dst[m][k] = PG8_LD16(PG8_SA(b, h) + aoff + m * 2048 + k * 1024); } } } while (0)
#define PG8_LDB(dst, b, h) do { _Pragma("unroll") for (int n = 0; n < 2; ++n) { \
        if constexpr (FP8) dst##8[n] = PG8_CAT(PG8_LD16(PG8_SB(b, h) + boff + n * 2048), PG8_LD16(PG8_SB(b, h) + boff + n * 2048 + 1024)); \
        else { _Pragma("unroll") for (int k = 0; k < 2; ++k) dst[n][k] = PG8_LD16(PG8_SB(b, h) + boff + n * 2048 + k * 1024); } } } while (0)
#define PG8_CAT(x, y) __builtin_shufflevector(__builtin_bit_cast(i32x4v, x), __builtin_bit_cast(i32x4v, y), 0, 1, 2, 3, 4, 5, 6, 7)
#define PG8_MMA(ai, bj, At, Bt) do { __builtin_amdgcn_s_setprio(1); \
        if constexpr (FP8) { _Pragma("unroll") for (int m = 0; m < 4; ++m) _Pragma("unroll") for (int n = 0; n < 2; ++n) \
            asm("v_mfma_f32_16x16x128_f8f6f4 %0, %1, %2, %0" : "+v"(acc[ai][bj][m][n]) : "v"(Bt##8[n]), "v"(At##8[m])); } \
        else if constexpr (I8) { _Pragma("unroll") for (int m = 0; m < 4; ++m) _Pragma("unroll") for (int n = 0; n < 2; ++n) _Pragma("unroll") for (int k = 0; k < 2; ++k) \
            acc[ai][bj][m][n] = __builtin_bit_cast(f32x4, __builtin_amdgcn_mfma_i32_16x16x64_i8(__builtin_bit_cast(i32x4v, Bt[n][k]), __builtin_bit_cast(i32x4v, At[m][k]), __builtin_bit_cast(i32x4v, acc[ai][bj][m][n]), 0, 0, 0)); } \
        else { _Pragma("unroll") for (int m = 0; m < 4; ++m) _Pragma("unroll") for (int n = 0; n < 2; ++n) _Pragma("unroll") for (int k = 0; k < 2; ++k) \
            acc[ai][bj][m][n] = __builtin_amdgcn_mfma_f32_16x16x32_bf16(Bt[n][k], At[m][k], acc[ai][bj][m][n], 0, 0, 0); } \
        __builtin_amdgcn_s_setprio(0); } while (0)
#define PG8_WAIT_V(n) asm volatile("s_waitcnt vmcnt(" #n ")" ::: "memory")
#define PG8_WAIT_L(n) asm volatile("s_waitcnt lgkmcnt(" #n ")" ::: "memory")
#define PG8_BAR __builtin_amdgcn_s_barrier()
#define PG8_SCHED __builtin_amdgcn_sched_barrier(0)
    Unit cur, nxt; int ui = 0;
    if (!S.next(0, cur)) return;
    f32x4 acc[2][2][4][2];
#pragma unroll
    for (int a = 0; a < 2; ++a)
#pragma unroll
        for (int b = 0; b < 2; ++b)
#pragma unroll
            for (int m = 0; m < 4; ++m)
#pragma unroll
                for (int n = 0; n < 2; ++n) acc[a][b][m][n] = (f32x4){0.f, 0.f, 0.f, 0.f};
    bf16x8 At[4][2], B0[2][2], B1[2][2];
    i32x8v At8[4], B08[2], B18[2];
    const char* cA = (const char*)g.A + (size_t)cur.pm * tstep; const char* cB = (const char*)g.Bt + (size_t)cur.pn * tstep;
    S.a_ready(cur);
    if constexpr (SP2) {
        PG8_STAGE(PG8_SB(0, 0), cB, voffB); PG8_STAGE(PG8_SB(0, 1), cB + hstep, voffB); PG8_STAGE(PG8_SA(0, 0), cA, voffA); PG8_STAGE(PG8_SA(0, 1), cA + hstep, voffA);
        if (wr == 1) PG8_BAR;
        PG8_WAIT_V(2); PG8_BAR;
        PG8_STAGE(PG8_SB(1, 0), cB + kstep, voffB); PG8_STAGE(PG8_SA(1, 0), cA + kstep, voffA); PG8_STAGE(PG8_SB(1, 1), cB + hstep + kstep, voffB);
        PG8_WAIT_V(6); PG8_BAR;
    } else {
        PG8_STAGE(PG8_SB(0, 0), cB, voffB); PG8_STAGE(PG8_SA(0, 0), cA, voffA); PG8_STAGE(PG8_SB(0, 1), cB + hstep, voffB); PG8_STAGE(PG8_SA(0, 1), cA + hstep, voffA);
        if (wr == 1) PG8_BAR;
        PG8_WAIT_V(4); PG8_BAR;
        PG8_STAGE(PG8_SB(1, 0), cB + kstep, voffB); PG8_STAGE(PG8_SA(1, 0), cA + kstep, voffA); PG8_STAGE(PG8_SB(1, 1), cB + hstep + kstep, voffB);
        PG8_WAIT_V(6); PG8_BAR;
    }
    for (;;) {
        const bool has_next = S.next(ui + 1, nxt);
        const char* nA = has_next ? (const char*)g.A + (size_t)nxt.pm * tstep : cA; const char* nB = has_next ? (const char*)g.Bt + (size_t)nxt.pn * tstep : cB;
        for (int t = 0; t < nt; t += 2) {
            const bool last = (t == nt - 2);
            if constexpr (FP8) __builtin_amdgcn_s_waitcnt(0xC07F);
            const char* a1 = cA + (size_t)(t + 1) * kstep;
            const char* a2 = last ? nA : cA + (size_t)(t + 2) * kstep; const char* b2 = last ? nB : cB + (size_t)(t + 2) * kstep;
            const char* a3 = a2 + kstep; const char* b3 = b2 + kstep;
            if (last && has_next) S.a_ready(nxt);
            if constexpr (SP2) {
            PG8_LDB(B0, 0, 0); PG8_LDB(B1, 0, 1); PG8_SCHED; PG8_LDA(At, 0, 0); PG8_STAGE(PG8_SA(1, 1), a1 + hstep, voffA);
            PG8_WAIT_V(8); PG8_WAIT_L(0); PG8_BAR; PG8_MMA(0, 0, At, B0); PG8_MMA(0, 1, At, B1); PG8_BAR; PG8_SCHED;
            PG8_LDA(At, 0, 1); PG8_STAGE(PG8_SB(0, 0), b2, voffB); PG8_STAGE(PG8_SB(0, 1), b2 + hstep, voffB); PG8_STAGE(PG8_SA(0, 0), a2, voffA);
            PG8_WAIT_V(8); PG8_WAIT_L(0); PG8_BAR; PG8_MMA(1, 0, At, B0); PG8_MMA(1, 1, At, B1); PG8_BAR; PG8_SCHED;
            PG8_LDB(B0, 1, 0); PG8_LDB(B1, 1, 1); PG8_SCHED; PG8_LDA(At, 1, 0); PG8_STAGE(PG8_SA(0, 1), a2 + hstep, voffA);
            PG8_WAIT_V(8); PG8_WAIT_L(0); PG8_BAR; PG8_MMA(0, 0, At, B0); PG8_MMA(0, 1, At, B1); PG8_BAR; PG8_SCHED;
            PG8_LDA(At, 1, 1); PG8_STAGE(PG8_SB(1, 0), b3, voffB); PG8_STAGE(PG8_SB(1, 1), b3 + hstep, voffB); PG8_STAGE(PG8_SA(1, 0), a3, voffA);
            PG8_WAIT_V(8); PG8_WAIT_L(0); PG8_BAR; PG8_MMA(1, 0, At, B0); PG8_MMA(1, 1, At, B1); PG8_BAR; PG8_SCHED;
            } else {
            PG8_LDB(B0, 0, 0); PG8_SCHED; PG8_LDA(At, 0, 0); PG8_STAGE(PG8_SA(1, 1), a1 + hstep, voffA);
            PG8_WAIT_L(8); PG8_BAR; PG8_WAIT_L(0); PG8_MMA(0, 0, At, B0); PG8_BAR; PG8_SCHED;
            PG8_LDB(B1, 0, 1); PG8_STAGE(PG8_SB(0, 0), b2, voffB);
            PG8_BAR; PG8_WAIT_L(0); PG8_MMA(0, 1, At, B1); PG8_BAR;
            PG8_LDA(At, 0, 1); PG8_STAGE(PG8_SA(0, 0), a2, voffA);
            PG8_BAR; PG8_WAIT_L(0); PG8_MMA(1, 0, At, B0); PG8_BAR; PG8_SCHED;
            PG8_STAGE(PG8_SB(0, 1), b2 + hstep, voffB);
            PG8_WAIT_V(6); PG8_BAR; PG8_MMA(1, 1, At, B1); PG8_BAR;
            PG8_LDB(B0, 1, 0); PG8_SCHED; PG8_LDA(At, 1, 0); PG8_STAGE(PG8_SA(0, 1), a2 + hstep, voffA);
            PG8_WAIT_L(8); PG8_BAR; PG8_WAIT_L(0); PG8_MMA(0, 0, At, B0); PG8_BAR; PG8_SCHED;
            PG8_LDB(B1, 1, 1); PG8_STAGE(PG8_SB(1, 0), b3, voffB);
            PG8_BAR; PG8_WAIT_L(0); PG8_MMA(0, 1, At, B1); PG8_BAR;
            PG8_LDA(At, 1, 1); PG8_STAGE(PG8_SA(1, 0), a3, voffA);
            PG8_BAR; PG8_WAIT_L(0); PG8_MMA(1, 0, At, B0); PG8_BAR; PG8_SCHED;
            PG8_STAGE(PG8_SB(1, 1), b3 + hstep, voffB);
            PG8_WAIT_V(6); PG8_BAR; PG8_MMA(1, 1, At, B1); PG8_BAR;
            }
        }
        if constexpr (FP8) asm volatile("s_nop 15\n\ts_nop 15" ::: "memory");
        if constexpr (ALIGN_EPI) { if (wr == 0) PG8_BAR; }
        if constexpr (!Epi::AFTER_DRAIN) { E(acc, cur, wr, wc, fr, fq); S.done(cur); }
        if (!has_next) break;
#pragma unroll
        for (int a = 0; a < 2; ++a)
#pragma unroll
            for (int b = 0; b < 2; ++b)
#pragma unroll
                for (int m = 0; m < 4; ++m)
#pragma unroll
                    for (int n = 0; n < 2; ++n) acc[a][b][m][n] = (f32x4){0.f, 0.f, 0.f, 0.f};
        cur = nxt; cA = nA; cB = nB; ++ui;
        if constexpr (ALIGN_EPI) { if (wr == 1) PG8_BAR; }
    }
    PG8_WAIT_V(0);
    if constexpr (!ALIGN_EPI) { if (wr == 0) PG8_BAR; }
    PG8_BAR;
    if constexpr (Epi::AFTER_DRAIN) { E.fused(acc, cur, wr, wc, fr, fq, lds, wid, lane); S.done(cur); }
#undef PG8_SA
#undef PG8_SB
#undef PG8_STAGE
#undef PG8_LDA
#undef PG8_LD16
#undef PG8_LDB
#undef PG8_MMA
#undef PG8_CAT
#undef PG8_WAIT_V
#undef PG8_WAIT_L
#undef PG8_BAR
#undef PG8_SCHED
}
}

template <class Epi, int QM = 0>
__device__ __forceinline__ void run_gemm(const Gemm g, const Epi& E, LAS float* lds, int vb, int nvb) {
    pg8::StaticOrder S; S.init(g.M, g.N, nvb, vb);
    pg8::gemm_phase<Epi, pg8::StaticOrder, true, true, QM>((LAS unsigned char*)lds, g, S, E);
}

enum { MAP_ID = 0, MAP_WIN = 1, MAP_GU = 2 };
struct PrepJob { const float* W; int K, N; const float* gain; bf16_t* dst; int r0, r1, ldd, koff, map; int fmt; float osc; };
__device__ __forceinline__ int map_src(int map, int r, int N) {
    if (map == MAP_ID) return r < N ? r : -1;
    if (map == MAP_WIN) {
        if (r < 1728) return r - 512;
        if (r < 3776) return r - 504;
        if (r < 3784) return r - 2560;
        return -1;
    }
    { const int tile = r >> 8, w = r & 255, j = tile * 128 + (w & 127); return w < 128 ? j : FF + j; }
}
__device__ __forceinline__ void prep_tile_load(const PrepJob& j, int t, f32x4 (&v)[8]) {
    const int nkt = j.K / 64, kt = t % nkt, rt = t / nkt, k0 = kt * 64, r0 = j.r0 + rt * 256;
#pragma unroll
    for (int q = 0; q < 8; ++q) {
        const int i = (int)threadIdx.x + q * NTHREADS, kk = i >> 6, r4 = (i & 63) * 4;
        const int sc = map_src(j.map, r0 + r4, j.N);
        v[q] = sc >= 0 ? __builtin_nontemporal_load((const f32x4*)(j.W + (size_t)(k0 + kk) * j.N + sc)) : (f32x4){0.f, 0.f, 0.f, 0.f};
        if (j.gain) v[q] = v[q] * j.gain[k0 + kk];
    }
}
__device__ __forceinline__ void prep_tile_store(const PrepJob& j, int t, const f32x4 (&v)[8], LAS float* tile  ) {
    const int nkt = j.K / 64, kt = t % nkt, rt = t / nkt, k0 = kt * 64, r0 = j.r0 + rt * 256;
    __syncthreads();
#pragma unroll
    for (int q = 0; q < 8; ++q) { const int i = (int)threadIdx.x + q * NTHREADS, kk = i >> 6, r4 = (i & 63) * 4; *(LAS f32x4*)(tile + kk * 260 + r4) = v[q]; }
    __syncthreads();
#pragma unroll
    for (int q = 0; q < 4; ++q) {
        const int i = (int)threadIdx.x + q * NTHREADS, rr = i & 255, c8 = i >> 8;
        const LAS float* tp = tile + (c8 * 8) * 260 + rr;
        if (j.fmt != 0) {
            const float sc = j.osc; u32x2 w;
            if (j.fmt == 1) { w.x = pk4_f8(tp[0] * sc, tp[260] * sc, tp[520] * sc, tp[780] * sc); w.y = pk4_f8(tp[1040] * sc, tp[1300] * sc, tp[1560] * sc, tp[1820] * sc); }
            else { w.x = pk4_i8(tp[0] * sc, tp[260] * sc, tp[520] * sc, tp[780] * sc); w.y = pk4_i8(tp[1040] * sc, tp[1300] * sc, tp[1560] * sc, tp[1820] * sc); }
            *(u32x2*)((unsigned char*)j.dst + (size_t)(r0 + rr) * j.ldd + j.koff + (j.fmt == 2 ? kperm8(k0 + c8 * 8) : k0 + c8 * 8)) = w;
        } else {
        u32x4 w; w.x = pk2(tp[0], tp[260]); w.y = pk2(tp[520], tp[780]); w.z = pk2(tp[1040], tp[1300]); w.w = pk2(tp[1560], tp[1820]);
        *(u32x4*)(j.dst + (size_t)(r0 + rr) * j.ldd + j.koff + k0 + c8 * 8) = w;
        }
    }
}
__device__ __forceinline__ void prep_fold_in(const float* w_in  , const float* w_uk  , const float* gain, bf16_t* dst, LAS float* lds, int vb, int nvb) {
    LAS float* A = lds; LAS float* B = lds + 32 * 65;
    const int tid = otid(), lane = tid & 63, wid = __builtin_amdgcn_readfirstlane(tid >> 6), l15 = lane & 15, dq = lane >> 4;
    for (int item = vb; item < 256; item += nvb) {
        const int h = item >> 5, k0 = (item & 31) * 32;
        __syncthreads();
        for (int i = tid; i < 2048; i += NTHREADS) { const int kk = i >> 6, d = i & 63; A[kk * 65 + d] = w_in[(size_t)(k0 + kk) * 3272 + h * 64 + d] * gain[k0 + kk]; }
        for (int i = tid; i < 8192; i += NTHREADS) { const int c = i >> 6, d = i & 63; B[c * 65 + d] = w_uk[(size_t)(h * 128 + c) * 64 + d]; }
        __syncthreads();
        f32x4 acc0 = (f32x4){0.f, 0.f, 0.f, 0.f}, acc1 = acc0;
#pragma unroll 4
        for (int d0 = 0; d0 < 64; d0 += 4) {
            const float b = B[(16 * wid + l15) * 65 + d0 + dq], a0 = A[l15 * 65 + d0 + dq], a1 = A[(16 + l15) * 65 + d0 + dq];
            acc0 = __builtin_amdgcn_mfma_f32_16x16x4f32(a0, b, acc0, 0, 0, 0);
            acc1 = __builtin_amdgcn_mfma_f32_16x16x4f32(a1, b, acc1, 0, 0, 0);
        }
        bf16_t* drow = dst + (size_t)(h * 128 + 16 * wid + l15) * 1024 + k0 + 4 * dq;
        { u32x2 w; w.x = pk2(acc0[0], acc0[1]); w.y = pk2(acc0[2], acc0[3]); *(u32x2*)drow = w; }
        { u32x2 w; w.x = pk2(acc1[0], acc1[1]); w.y = pk2(acc1[2], acc1[3]); *(u32x2*)(drow + 16) = w; }
    }
}
__device__ __forceinline__ void prep_fold_out(const float* w_out  , const float* w_uv  , bf16_t* dst  , LAS float* lds, int vb, int nvb) {
    LAS float* A = lds; LAS float* B = lds + 64 * 33;
    const int tid = otid(), lane = tid & 63, wid = __builtin_amdgcn_readfirstlane(tid >> 6), l15 = lane & 15, dq = lane >> 4;
    for (int item = vb; item < 256; item += nvb) {
        const int h = item >> 5, n0 = (item & 31) * 32;
        __syncthreads();
        for (int i = tid; i < 2048; i += NTHREADS) { const int d = i >> 5, nn = i & 31; A[d * 33 + nn] = w_out[(size_t)(h * 64 + d) * 1024 + n0 + nn]; }
        for (int i = tid; i < 8192; i += NTHREADS) { const int c = i >> 6, d = i & 63; B[c * 65 + d] = w_uv[(size_t)(h * 128 + c) * 64 + d]; }
        __syncthreads();
        f32x4 acc0 = (f32x4){0.f, 0.f, 0.f, 0.f}, acc1 = acc0;
#pragma unroll 4
        for (int d0 = 0; d0 < 64; d0 += 4) {
            const float a = B[(16 * wid + l15) * 65 + d0 + dq], b0 = A[(d0 + dq) * 33 + l15], b1 = A[(d0 + dq) * 33 + 16 + l15];
            acc0 = __builtin_amdgcn_mfma_f32_16x16x4f32(a, b0, acc0, 0, 0, 0);
            acc1 = __builtin_amdgcn_mfma_f32_16x16x4f32(a, b1, acc1, 0, 0, 0);
        }
        { u32x2 w; w.x = pk2(acc0[0], acc0[1]); w.y = pk2(acc0[2], acc0[3]); *(u32x2*)(dst + (size_t)(n0 + l15) * KOUT + h * 128 + 16 * wid + 4 * dq) = w; }
        { u32x2 w; w.x = pk2(acc1[0], acc1[1]); w.y = pk2(acc1[2], acc1[3]); *(u32x2*)(dst + (size_t)(n0 + 16 + l15) * KOUT + h * 128 + 16 * wid + 4 * dq) = w; }
    }
}
__device__ __forceinline__ void prep_lb(const float* hgrn_lb  , float* lb, int vb, int nvb) {
    for (int i = vb * NTHREADS + threadIdx.x; i < 512; i += nvb * NTHREADS) {
        const float a = hgrn_lb[i], b = hgrn_lb[512 + i], c = hgrn_lb[1024 + i], m = fmaxf(a, fmaxf(b, c));
        const float ea = __expf(a - m), eb = __expf(b - m), ec = __expf(c - m);
        lb[i] = ea / (ea + eb + ec);
    }
}

__device__ __forceinline__ void rmsnorm_rows(const float* X, bf16_t* Y, int nrows, int vb, int nvb) {
    const int tid = otid(), lane = tid & 63, gw = vb * NWAVES + __builtin_amdgcn_readfirstlane(tid >> 6), ngw = nvb * NWAVES;
    for (int r = gw; r < nrows; r += ngw) {
        const f32x4* xr = (const f32x4*)(X + (size_t)r * D) + lane;
        f32x4 v[4]; float s = 0.f;
#pragma unroll
        for (int j = 0; j < 4; ++j) { v[j] = xr[64 * j]; s += (v[j].x * v[j].x + v[j].y * v[j].y) + (v[j].z * v[j].z + v[j].w * v[j].w); }
        const float rs = rsqrtf(wave_sum(s) * (1.f / D) + EPS);
        u32x2* o = (u32x2*)(Y + (size_t)r * D) + lane;
#pragma unroll
        for (int j = 0; j < 4; ++j) { u32x2 w; w.x = pk2(v[j].x * rs, v[j].y * rs); w.y = pk2(v[j].z * rs, v[j].w * rs); o[64 * j] = w; }
    }
}
__device__ __forceinline__ void x_to_h_rows(const float* X, bf16_t* H, float* ssq, int vb, int nvb) {
    const int tid = otid(), lane = tid & 63, gw = vb * NWAVES + __builtin_amdgcn_readfirstlane(tid >> 6), ngw = nvb * NWAVES;
    for (int r = gw; r < T; r += 2 * ngw) {
        const int r2 = (r + ngw < T) ? r + ngw : r;
        f32x4 v[2][4];
#pragma unroll
        for (int j = 0; j < 4; ++j) { v[0][j] = __builtin_nontemporal_load((const f32x4*)(X + (size_t)r * D) + lane + 64 * j); v[1][j] = __builtin_nontemporal_load((const f32x4*)(X + (size_t)r2 * D) + lane + 64 * j); }
#pragma unroll
        for (int q = 0; q < 2; ++q) {
            const int rr = q ? r2 : r;
            u32x2* o = (u32x2*)(H + (size_t)rr * D) + lane;
            float s = 0.f;
#pragma unroll
            for (int j = 0; j < 4; ++j) { const f32x4 x = v[q][j]; u32x2 w; w.x = pk2(x.x, x.y); w.y = pk2(x.z, x.w); o[64 * j] = w;
                const float a = bf2f((unsigned short)(w.x & 0xffffu)), b = bf2f((unsigned short)(w.x >> 16)), c = bf2f((unsigned short)(w.y & 0xffffu)), d = bf2f((unsigned short)(w.y >> 16));
                s += (a * a + b * b) + (c * c + d * d); }
            s = wave_sum(s);
            if (lane < 16) ssq[(size_t)rr * 16 + lane] = lane == 0 ? s : 0.f;
        }
    }
}
__device__ __forceinline__ void final_rows(const bf16_t* H, const float* ssq, const float* g, float* out, int vb, int nvb) {
    const int tid = otid(), lane = tid & 63, gw = vb * NWAVES + __builtin_amdgcn_readfirstlane(tid >> 6), ngw = nvb * NWAVES;
    f32x4 gg[4];
#pragma unroll
    for (int j = 0; j < 4; ++j) gg[j] = *((const f32x4*)g + lane + 64 * j);
    for (int r = gw; r < T; r += 2 * ngw) {
        const int r2 = (r + ngw < T) ? r + ngw : r;
        u32x2 w[2][4]; float rs[2];
#pragma unroll
        for (int j = 0; j < 4; ++j) { w[0][j] = ((const u32x2*)(H + (size_t)r * D) + lane)[64 * j]; w[1][j] = ((const u32x2*)(H + (size_t)r2 * D) + lane)[64 * j]; }
        rs[0] = row_rstd(ssq, (size_t)r); rs[1] = row_rstd(ssq, (size_t)r2);
#pragma unroll
        for (int q = 0; q < 2; ++q) {
            f32x4* o = (f32x4*)(out + (size_t)(q ? r2 : r) * D) + lane;
#pragma unroll
            for (int j = 0; j < 4; ++j) { const u32x2 ww = w[q][j];
                __builtin_nontemporal_store((f32x4){bf2f((unsigned short)(ww.x & 0xffffu)) * rs[q] * gg[j].x, bf2f((unsigned short)(ww.x >> 16)) * rs[q] * gg[j].y, bf2f((unsigned short)(ww.y & 0xffffu)) * rs[q] * gg[j].z, bf2f((unsigned short)(ww.y >> 16)) * rs[q] * gg[j].w}, o + 64 * j); }
        }
    }
}
__device__ __forceinline__ float row16_sum(float v) {
    v += __uint_as_float((unsigned)__builtin_amdgcn_update_dpp(0, (int)__float_as_uint(v), 0x128, 0xf, 0xf, false));
    v += __uint_as_float((unsigned)__builtin_amdgcn_update_dpp(0, (int)__float_as_uint(v), 0x124, 0xf, 0xf, false));
    v += __uint_as_float((unsigned)__builtin_amdgcn_update_dpp(0, (int)__float_as_uint(v), 0x122, 0xf, 0xf, false));
    v += __uint_as_float((unsigned)__builtin_amdgcn_update_dpp(0, (int)__float_as_uint(v), 0x121, 0xf, 0xf, false));
    return v;
}
__device__ __forceinline__ void cnorm_rows(const bf16_t* P, const float* lat_g, bf16_t* CN, int vb, int nvb) {
    const int tid = otid(), lane = tid & 63, gw = vb * NWAVES + __builtin_amdgcn_readfirstlane(tid >> 6), ngw = nvb * NWAVES, r4 = lane >> 4, l16 = lane & 15;
    const f32x4 ga = *(const f32x4*)(lat_g + l16 * 8), gb = *(const f32x4*)(lat_g + l16 * 8 + 4);
    for (int r = gw * 8; r < T; r += ngw * 8) {
        u32x4 w[2];
#pragma unroll
        for (int q = 0; q < 2; ++q) w[q] = *(const u32x4*)(P + (size_t)(r + 4 * q + r4) * PW + P_C + l16 * 8);
#pragma unroll
        for (int q = 0; q < 2; ++q) {
            const float x0 = bf2f((unsigned short)(w[q].x & 0xffffu)), x1 = bf2f((unsigned short)(w[q].x >> 16)), x2 = bf2f((unsigned short)(w[q].y & 0xffffu)), x3 = bf2f((unsigned short)(w[q].y >> 16));
            const float x4 = bf2f((unsigned short)(w[q].z & 0xffffu)), x5 = bf2f((unsigned short)(w[q].z >> 16)), x6 = bf2f((unsigned short)(w[q].w & 0xffffu)), x7 = bf2f((unsigned short)(w[q].w >> 16));
            const float ss = row16_sum(((x0 * x0 + x1 * x1) + (x2 * x2 + x3 * x3)) + ((x4 * x4 + x5 * x5) + (x6 * x6 + x7 * x7)));
            const float rs = rsqrtf(ss * (1.f / 128.f) + EPS);
            u32x4 o; o.x = pk2(x0 * rs * ga.x, x1 * rs * ga.y); o.y = pk2(x2 * rs * ga.z, x3 * rs * ga.w); o.z = pk2(x4 * rs * gb.x, x5 * rs * gb.y); o.w = pk2(x6 * rs * gb.z, x7 * rs * gb.w);
            *(u32x4*)(CN + (size_t)(r + 4 * q + r4) * 128 + l16 * 8) = o;
        }
    }
}
__device__ __forceinline__ int t5_bucket(int rel) {
    const int n = rel < 0 ? -rel : rel;
    int b = n < 8 ? n : 8 + (n >= 12) + (n >= 16) + (n >= 23) + (n >= 32) + (n >= 46) + (n >= 64) + (n >= 91);
    return b + (rel > 0 ? 16 : 0);
}
__device__ __forceinline__ unsigned sort_key(float x) { const unsigned u = __float_as_uint(x); return (u & 0x80000000u) ? ~u : (u | 0x80000000u); }


template <int CTRL, int ROWMASK> __device__ __forceinline__ unsigned dpp0(unsigned v) { return (unsigned)__builtin_amdgcn_update_dpp(0, (int)v, CTRL, ROWMASK, 0xf, false); }
__device__ __forceinline__ unsigned wave_prefix_incl(unsigned v) {
    v += dpp0<0x111, 0xf>(v); v += dpp0<0x112, 0xf>(v); v += dpp0<0x114, 0xf>(v); v += dpp0<0x118, 0xf>(v);
    v += dpp0<0x142, 0xa>(v);
    v += dpp0<0x143, 0xc>(v);
    return v;
}
__device__ __forceinline__ float wave_max_u(float v) {
    v = fmaxf(v, __uint_as_float((unsigned)__builtin_amdgcn_update_dpp(0, (int)__float_as_uint(v), 0x128, 0xf, 0xf, false)));
    v = fmaxf(v, __uint_as_float((unsigned)__builtin_amdgcn_update_dpp(0, (int)__float_as_uint(v), 0x124, 0xf, 0xf, false)));
    v = fmaxf(v, __uint_as_float((unsigned)__builtin_amdgcn_update_dpp(0, (int)__float_as_uint(v), 0x122, 0xf, 0xf, false)));
    v = fmaxf(v, __uint_as_float((unsigned)__builtin_amdgcn_update_dpp(0, (int)__float_as_uint(v), 0x121, 0xf, 0xf, false)));
    const int b = (int)__float_as_uint(v);
    return fmaxf(fmaxf(__uint_as_float((unsigned)__builtin_amdgcn_readlane(b, 0)), __uint_as_float((unsigned)__builtin_amdgcn_readlane(b, 16))),
                 fmaxf(__uint_as_float((unsigned)__builtin_amdgcn_readlane(b, 32)), __uint_as_float((unsigned)__builtin_amdgcn_readlane(b, 48))));
}

typedef short v4i16_t __attribute__((ext_vector_type(4)));
constexpr int DSA_BT_OFF = 131072 + 256, DSA_WS_OFF = DSA_BT_OFF + 6144;
__device__ __forceinline__ unsigned dsa_bucket(float x, float lo, float sc) { const float f = (x - lo) * sc; const unsigned b = (unsigned)f; return b > 255u ? 255u : b; }
__device__ __forceinline__ unsigned off_b(unsigned row, unsigned ch) { return 256u * row + 16u * (ch ^ (((row & 3) << 2) | ((row >> 2) & 3))); }
__device__ __forceinline__ void dsa_mfma_phase(const bf16_t* P, const bf16_t* CN, const float* rel_bias, bf16_t* CAT, LAS unsigned char* lds, unsigned* qctr) {
    const int tid = otid(), lane = tid & 63, wid = __builtin_amdgcn_readfirstlane(tid >> 6);
    LAS float* BT = (LAS float*)(lds + DSA_BT_OFF);
    __syncthreads();
    for (int i = tid; i < 191 * 8; i += NTHREADS) { const int rel = (i >> 3) - 127; BT[i] = rel_bias[t5_bucket(rel) * 8 + (i & 7)]; }
    const unsigned long long lt_mask = (lane == 0) ? 0ull : (~0ull >> (64 - lane));
    volatile LAS int* qslot = (volatile LAS int*)(lds + 131072 + 64);
    int nxt = 0;
    if (tid == 0) { *qslot = (int)atomicAdd(qctr, 1u); nxt = (int)atomicAdd(qctr, 1u); }
    for (;;) {
        __syncthreads();
        const int u = *qslot;
        if (u >= T / 16) break;
        const int b = u & 15, qg = 127 - (u >> 4), t0 = qg * 16, nj = t0 / CHUNK + 1, L = nj * CHUNK, nt = L / 32;
        const bf16_t* Pb = P + (size_t)b * SEQ * PW;
        {
            int ln1 = lane; asm volatile("" : "+v"(ln1));
            const int rho = ln1 & 31, hf = ln1 >> 5;
            const int qq = 2 * ((rho >> 2) & 1) + (rho >> 4), hh = 4 * ((rho >> 3) & 1) + (rho & 3);
            bf16x8 qa[4][4], wa[4], wc[4];
#pragma unroll
            for (int qd = 0; qd < 4; ++qd) {
                const bf16_t* qrow = Pb + (size_t)(t0 + 4 * qd + qq) * PW + P_QI + hh * 64 + 8 * hf;
#pragma unroll
                for (int ks = 0; ks < 4; ++ks) qa[qd][ks] = *(const bf16x8*)(qrow + ks * 16);
                wa[qd] = *(const bf16x8*)(Pb + (size_t)(t0 + 4 * qd + 2 * hf) * PW + P_WI); wc[qd] = *(const bf16x8*)(Pb + (size_t)(t0 + 4 * qd + 2 * hf + 1) * PW + P_WI);
            }
            LAS float* sc0 = (LAS float*)lds + (2 * hf) * 2048 + rho;
            const bf16_t* kbase = Pb + (size_t)rho * PW + P_KI + 8 * hf;
            bf16x8 kb[4], kn[4];
#pragma unroll
            for (int ks = 0; ks < 4; ++ks) { kb[ks] = (bf16x8){0, 0, 0, 0, 0, 0, 0, 0}; kn[ks] = kb[ks]; }
            if (wid < nt) {
#pragma unroll
                for (int ks = 0; ks < 4; ++ks) kb[ks] = *(const bf16x8*)(kbase + (size_t)wid * 32 * PW + ks * 16);
            }
            for (int kt = wid; kt < nt; kt += 8) {
                if (kt + 8 < nt) {
#pragma unroll
                    for (int ks = 0; ks < 4; ++ks) kn[ks] = *(const bf16x8*)(kbase + (size_t)(kt + 8) * 32 * PW + ks * 16);
                }
#pragma unroll
                for (int qd = 0; qd < 4; ++qd) {
                    f32x16 acc;
#pragma unroll
                    for (int r = 0; r < 16; ++r) acc[r] = 0.f;
#pragma unroll
                    for (int ks = 0; ks < 4; ++ks) acc = __builtin_amdgcn_mfma_f32_32x32x16_bf16(qa[qd][ks], kb[ks], acc, 0, 0, 0);
                    float s0 = 0.f, s1 = 0.f;
#pragma unroll
                    for (int e = 0; e < 8; ++e) { s0 += bf2f((unsigned short)wa[qd][e]) * fmaxf(acc[e], 0.f); s1 += bf2f((unsigned short)wc[qd][e]) * fmaxf(acc[8 + e], 0.f); }
                    sc0[(4 * qd) * 2048 + kt * 32] = s0 * (0.35355339059327373f * 0.125f); sc0[(4 * qd + 1) * 2048 + kt * 32] = s1 * (0.35355339059327373f * 0.125f);
                }
#pragma unroll
                for (int ks = 0; ks < 4; ++ks) kb[ks] = kn[ks];
            }
        }
        __syncthreads();
        if (tid == 0) { *qslot = nxt; nxt = (int)atomicAdd(qctr, 1u); }
        LAS unsigned char* pair = lds + wid * 16384;
        LAS unsigned char* wsc = lds + DSA_WS_OFF + wid * 2560;
        LAS unsigned* HIST = (LAS unsigned*)wsc; LAS float* CANDV = (LAS float*)(wsc + 1024); LAS unsigned* CANDI = (LAS unsigned*)(wsc + 1280);
        const int nsel = L < 256 ? L : 256;
        int lna = lane; asm volatile("" : "+v"(lna));
#pragma unroll 1
        for (int e2 = 0; e2 < 2; ++e2) {
            LAS unsigned short* IDX = (LAS unsigned short*)(wsc + 1536 + e2 * 512);
            if (nj > 4) {
                const LAS float* SCq = (const LAS float*)(pair + e2 * 8192);
                float x[32];
#pragma unroll
                for (int j = 0; j < 32; ++j) x[j] = (j < nj) ? SCq[j * 64 + lna] : 0.f;
                float lo = INFINITY, hi = -INFINITY;
#pragma unroll
                for (int j = 0; j < 32; ++j) if (j < nj) { hi = fmaxf(hi, x[j]); lo = fminf(lo, x[j]); }
                hi = wave_max_u(hi); lo = -wave_max_u(-lo);
                bool done = false;
                if (hi > lo) {
                    const float sc = 256.f / (hi - lo);
                    *(LAS u32x4*)(HIST + 4 * lna) = (u32x4){0u, 0u, 0u, 0u};
                    WAVE_LDS_SYNC();
#pragma unroll
                    for (int j = 0; j < 32; ++j) if (j < nj) { const unsigned bk = dsa_bucket(x[j], lo, sc); __hip_atomic_fetch_add(HIST + bk, 1u, __ATOMIC_RELAXED, __HIP_MEMORY_SCOPE_WORKGROUP); }
                    WAVE_LDS_SYNC();
                    const u32x4 h4 = *(const LAS u32x4*)(HIST + 4 * lna);
                    const unsigned cl = (h4.x + h4.y) + (h4.z + h4.w);
                    const unsigned pfx = wave_prefix_incl(cl);
                    const unsigned Sx = (unsigned)__builtin_amdgcn_readlane((int)pfx, 63) - pfx + cl;
                    const int lstar = __popcll(__ballot(Sx >= 256u)) - 1;
                    const unsigned above = Sx - cl, t3 = above + h4.w, t2 = t3 + h4.z, t1 = t2 + h4.y;
                    const unsigned bl = t3 >= 256u ? 3u : (t2 >= 256u ? 2u : (t1 >= 256u ? 1u : 0u));
                    const unsigned al = bl == 3u ? above : (bl == 2u ? t3 : (bl == 1u ? t2 : t1));
                    const unsigned ml = bl == 3u ? h4.w : (bl == 2u ? h4.z : (bl == 1u ? h4.y : h4.x));
                    const unsigned bstar = (unsigned)__builtin_amdgcn_readlane((int)(4u * lna + bl), lstar);
                    const int a = __builtin_amdgcn_readlane((int)al, lstar), m = __builtin_amdgcn_readlane((int)ml, lstar);
                    if (m <= 64) {
                        done = true;
                        const int need = 256 - a;
                        unsigned msel = 0u, mcand = 0u;
#pragma unroll
                        for (int j = 31; j >= 0; --j) if (j < nj) { const unsigned bk = dsa_bucket(x[j], lo, sc); msel = msel + msel + (bk > bstar ? 1u : 0u); mcand = mcand + mcand + (bk == bstar ? 1u : 0u); }
                        const unsigned pk = (unsigned)__popc(msel) | ((unsigned)__popc(mcand) << 16);
                        const unsigned inc = wave_prefix_incl(pk);
                        unsigned off = (inc - pk) & 0xffffu, coff = (inc - pk) >> 16;
                        while (msel) { const int j = __ffs((int)msel) - 1; msel &= msel - 1u; IDX[off++] = (unsigned short)(j * 64 + lna); }
                        while (mcand) { const int j = __ffs((int)mcand) - 1; mcand &= mcand - 1u; CANDV[coff] = SCq[j * 64 + lna]; CANDI[coff] = (unsigned)(j * 64 + lna); ++coff; }
                        WAVE_LDS_SYNC();
                        const float cv = CANDV[lna < m ? lna : 0]; const unsigned ci = CANDI[lna < m ? lna : 0];
                        int rank = 0;
                        for (int k = 0; k < m; ++k) { const float v = __uint_as_float((unsigned)__builtin_amdgcn_readlane((int)__float_as_uint(cv), k)); const unsigned id = (unsigned)__builtin_amdgcn_readlane((int)ci, k); rank += (v > cv || (v == cv && id < ci)) ? 1 : 0; }
                        if (lna < m && rank < need) IDX[a + rank] = (unsigned short)ci;
                    }
                }
                if (!done) {
                    unsigned lo_k = 0xffffffffu, hi_k = 0u;
#pragma unroll
                    for (int j = 0; j < 32; ++j) if (j < nj) { const unsigned kx = sort_key(x[j]); hi_k = kx > hi_k ? kx : hi_k; lo_k = kx < lo_k ? kx : lo_k; }
#pragma unroll
                    for (int o = 1; o < 64; o <<= 1) { const unsigned h2 = (unsigned)__shfl_xor((int)hi_k, o), l2 = (unsigned)__shfl_xor((int)lo_k, o); hi_k = h2 > hi_k ? h2 : hi_k; lo_k = l2 < lo_k ? l2 : lo_k; }
                    lo_k = (unsigned)__builtin_amdgcn_readfirstlane((int)lo_k); hi_k = (unsigned)__builtin_amdgcn_readfirstlane((int)hi_k);
                    bool exact = false;
                    while (lo_k < hi_k) {
                        const unsigned mid = lo_k + ((hi_k - lo_k + 1u) >> 1);
                        int cnt = 0;
#pragma unroll
                        for (int j = 0; j < 32; ++j) cnt += __popcll(__ballot(j < nj && sort_key(x[j]) >= mid));
                        if (cnt == 256) { lo_k = mid; exact = true; break; }
                        if (cnt > 256) lo_k = mid; else hi_k = mid - 1u;
                    }
                    const unsigned Tv = lo_k;
                    int need = 0;
                    if (!exact) { int cgt = 0;
#pragma unroll
                        for (int j = 0; j < 32; ++j) cgt += __popcll(__ballot(j < nj && sort_key(x[j]) > Tv));
                        need = 256 - cgt; }
                    int base = 0, eqt = 0;
#pragma unroll
                    for (int j = 0; j < 32; ++j) {
                        const unsigned kx = sort_key(x[j]);
                        const bool gt = (j < nj) && (exact ? (kx >= Tv) : (kx > Tv)), eq = (j < nj) && !exact && (kx == Tv);
                        const unsigned long long meq = __ballot(eq);
                        const bool sel = gt || (eq && (eqt + __popcll(meq & lt_mask)) < need);
                        const unsigned long long ms = __ballot(sel);
                        if (sel) IDX[base + __popcll(ms & lt_mask)] = (unsigned short)(j * 64 + lna);
                        base += __popcll(ms); eqt += __popcll(meq);
                    }
                }
            } else {
#pragma unroll
                for (int i = 0; i < 4; ++i) IDX[i * 64 + lna] = (unsigned short)(i * 64 + lna);
            }
        }
        WAVE_LDS_SYNC();
        {
            int lnb = lane; asm volatile("" : "+v"(lnb));
            const int head = lnb & 15, kg = lnb >> 4, nblk = nsel >> 5;
            LAS unsigned char* GB = pair;
            const bf16_t* CNb = CN + (size_t)b * SEQ * 128;
            const int rho = lnb & 15;
            const unsigned rw0 = 8 * (rho >> 2) + (rho & 3), rw1 = rw0 + 4;
            const unsigned xa0 = ((rw0 & 3) << 2) | ((rw0 >> 2) & 3), xa1 = ((rw1 & 3) << 2) | ((rw1 >> 2) & 3);
            const unsigned q4 = (lnb & 15) >> 2, p4 = lnb & 3;
            u32x4 gA[8], gB[8];
#define DSA_GATHER(G, IX, blk) do { _Pragma("unroll") for (int it = 0; it < 8; ++it) { const int sp = (IX)[(blk) * 32 + (lnb >> 4) + 4 * it]; G[it] = *(const u32x4*)(CNb + (size_t)sp * 128 + (lnb & 15) * 8); } } while (0)
            { const LAS unsigned short* IDX0 = (const LAS unsigned short*)(wsc + 1536); DSA_GATHER(gA, IDX0, 0); DSA_GATHER(gB, IDX0, 1); }
#pragma unroll 1
            for (int e2 = 0; e2 < 2; ++e2) {
                const int t = t0 + 2 * wid + e2;
                const size_t row = (size_t)b * SEQ + t;
                const LAS unsigned short* IDX = (const LAS unsigned short*)(wsc + 1536 + e2 * 512);
                bf16x8 qlf[4];
#pragma unroll
                for (int s4 = 0; s4 < 4; ++s4) { qlf[s4] = *(const bf16x8*)(P + row * PW + P_QL + (head & 7) * 128 + s4 * 32 + 8 * kg); if (head >= 8) qlf[s4] = (bf16x8){0, 0, 0, 0, 0, 0, 0, 0}; }
                f32x4 o[8];
#pragma unroll
                for (int ct = 0; ct < 8; ++ct) o[ct] = (f32x4){0.f, 0.f, 0.f, 0.f};
                float m = -INFINITY, lsum = 0.f;
#define DSA_STEP(G, kbx) do { \
                    WAVE_LDS_SYNC();                              \
                    _Pragma("unroll") for (int it = 0; it < 8; ++it) *(LAS u32x4*)(GB + off_b((lnb >> 4) + 4 * it, lnb & 15)) = G[it]; \
                    const bf16x8 iv = *(const LAS bf16x8*)((const LAS unsigned char*)IDX + ((kbx) * 32 + 8 * kg) * 2);     \
                    if ((kbx) + 2 < nblk) DSA_GATHER(G, IDX, (kbx) + 2); else if (e2 == 0) DSA_GATHER(G, IDX + 256, (kbx) + 2 - nblk); \
                    WAVE_LDS_SYNC(); \
                      \
                    bf16x8 k0[4], k1[4], af[8]; \
                    _Pragma("unroll") for (int s4 = 0; s4 < 4; ++s4) { \
                        k0[s4] = *(const LAS bf16x8*)(GB + 256u * rw0 + 16u * ((4 * s4 + kg) ^ xa0)); \
                        k1[s4] = *(const LAS bf16x8*)(GB + 256u * rw1 + 16u * ((4 * s4 + kg) ^ xa1)); } \
                    float bia[8]; \
                    _Pragma("unroll") for (int e = 0; e < 8; ++e) { const int sp = (int)(unsigned short)iv[e]; int rel = sp - t; rel = rel < -127 ? -127 : rel; bia[e] = BT[(rel + 127) * 8 + (head & 7)]; } \
                      \
                    f32x4 a0 = (f32x4){0.f, 0.f, 0.f, 0.f}, a1 = (f32x4){0.f, 0.f, 0.f, 0.f}; \
                    _Pragma("unroll") for (int s4 = 0; s4 < 4; ++s4) { \
                        a0 = __builtin_amdgcn_mfma_f32_16x16x32_bf16(k0[s4], qlf[s4], a0, 0, 0, 0); \
                        a1 = __builtin_amdgcn_mfma_f32_16x16x32_bf16(k1[s4], qlf[s4], a1, 0, 0, 0); } \
                    asm volatile("" : "+v"(a0), "+v"(a1));        \
                    _Pragma("unroll") for (int ct = 0; ct < 8; ++ct) {              \
                        const v4i16_t lo4 = __builtin_amdgcn_ds_read_tr16_b64_v4i16((LAS v4i16_t*)(GB + off_b(8 * kg + q4, 2 * ct + (p4 >> 1)) + 8 * (p4 & 1))); \
                        const v4i16_t hi4 = __builtin_amdgcn_ds_read_tr16_b64_v4i16((LAS v4i16_t*)(GB + off_b(8 * kg + 4 + q4, 2 * ct + (p4 >> 1)) + 8 * (p4 & 1))); \
                        af[ct] = (bf16x8){lo4[0], lo4[1], lo4[2], lo4[3], hi4[0], hi4[1], hi4[2], hi4[3]}; } \
                      \
                    float lg[8]; \
                    _Pragma("unroll") for (int e = 0; e < 8; ++e) lg[e] = (e < 4 ? a0[e] : a1[e - 4]) * 0.125f + bia[e]; \
                    const float mloc = fmaxf(fmaxf(fmaxf(lg[0], lg[1]), fmaxf(lg[2], lg[3])), fmaxf(fmaxf(lg[4], lg[5]), fmaxf(lg[6], lg[7]))); \
                      \
                    float scl = 1.f; \
                    if (__any(mloc > m + 16.f)) { \
                        float mb = fmaxf(mloc, __shfl_xor(mloc, 16)); mb = fmaxf(mb, __shfl_xor(mb, 32)); \
                        const float mn = fmaxf(m, mb); scl = __expf(m - mn); m = mn; \
                        _Pragma("unroll") for (int ct = 0; ct < 8; ++ct) o[ct] = o[ct] * scl; } \
                    float ps = 0.f; float pe[8]; \
                    _Pragma("unroll") for (int e = 0; e < 8; ++e) { pe[e] = __expf(lg[e] - m); ps += pe[e]; } \
                    lsum = lsum * scl + ps; \
                    u32x4 pw; pw.x = pk2(pe[0], pe[1]); pw.y = pk2(pe[2], pe[3]); pw.z = pk2(pe[4], pe[5]); pw.w = pk2(pe[6], pe[7]); \
                    const bf16x8 pb = __builtin_bit_cast(bf16x8, pw); \
                    _Pragma("unroll") for (int ct = 0; ct < 8; ++ct) o[ct] = __builtin_amdgcn_mfma_f32_16x16x32_bf16(af[ct], pb, o[ct], 0, 0, 0); \
                } while (0)
#pragma unroll 1
                for (int kb2 = 0; kb2 < nblk; kb2 += 2) { DSA_STEP(gA, kb2); DSA_STEP(gB, kb2 + 1); }
#undef DSA_STEP
                lsum += __shfl_xor(lsum, 16); lsum += __shfl_xor(lsum, 32);
                const float inv = 1.f / lsum;
                if (head < 8) {
                    bf16_t* op = CAT + row * KOUT + head * 128 + 4 * kg;
#pragma unroll
                    for (int ct = 0; ct < 8; ++ct) { u32x2 w; w.x = pk2(o[ct][0] * inv, o[ct][1] * inv); w.y = pk2(o[ct][2] * inv, o[ct][3] * inv); *(u32x2*)(op + ct * 16) = w; }
                }
            }
#undef DSA_GATHER
        }
    }
}

constexpr size_t WS_DEC = 492 * MiB;
__device__ __forceinline__ void hgrn_prep(bf16_t* P, const float* lb, float* DEC, LAS unsigned char* lds, int vb, int nvb) {
    const int tid = otid(), cl = tid >> 7, d = tid & 127;
    LAS bf16_t* Ft = (LAS bf16_t*)lds; LAS bf16_t* Qt = (LAS bf16_t*)(lds + 65536);
    for (int it = vb; it < BATCH * 4 * 8; it += nvb) {
        const int b = it >> 5, h = (it >> 3) & 3, cg = it & 7;
        bf16_t* base = P + ((size_t)b * SEQ + cg * 256) * PW + h * 128;
        u32x4 v[16];
#pragma unroll
        for (int k = 0; k < 16; ++k) { const int i = tid + 512 * k, tl = i >> 12, r = (i >> 4) & 255, ch = i & 15; v[k] = *(const u32x4*)(base + (size_t)r * PW + (tl ? P_QB : P_FB) + ch * 8); }
        __syncthreads();
#pragma unroll
        for (int k = 0; k < 16; ++k) { const int i = tid + 512 * k, tl = i >> 12, r = (i >> 4) & 255, ch = i & 15; *(LAS u32x4*)(lds + tl * 65536 + r * 256 + ch * 16) = v[k]; }
        __syncthreads();
        {
            const float l = lb[h * 128 + d];
            LAS bf16_t* fcol = Ft + (cl * 64) * 128 + d; LAS bf16_t* qcol = Qt + (cl * 64) * 128 + d;
            float ref = 0.f;
#pragma unroll 8
            for (int t = 0; t < 32; ++t) ref += __logf(l + (1.f - l) * sigmoid_f(bf2f(fcol[t * 128])));
            float bi = 0.f;
#pragma unroll 8
            for (int t = 0; t < 64; ++t) {
                const float f = l + (1.f - l) * sigmoid_f(bf2f(fcol[t * 128]));
                bi += __logf(f);
                const float q = silu_f(bf2f(qcol[t * 128]));
                qcol[t * 128] = (bf16_t)f2bf(q * __expf(bi - ref));
                fcol[t * 128] = (bf16_t)f2bf((1.f - f) * __expf(ref - bi));
            }
            float* dc = DEC + ((size_t)((b * 4 + h) * 32 + cg * 4 + cl) * 3) * 128 + d;
            dc[0] = __expf(ref); dc[128] = __expf(bi); dc[256] = __expf(bi - ref);
        }
        __syncthreads();
#pragma unroll
        for (int k = 0; k < 16; ++k) { const int i = tid + 512 * k, tl = i >> 12, r = (i >> 4) & 255, ch = i & 15; *(u32x4*)(base + (size_t)r * PW + (tl ? P_QB : P_FB) + ch * 8) = *(const LAS u32x4*)(lds + tl * 65536 + r * 256 + ch * 16); }
    }
}

__device__ __forceinline__ void hgrn_scan(const bf16_t* P, const float* DEC, const float* o_g, bf16_t* CAT, LAS unsigned char* lds, int item) {
    const int tid = otid(), lane = tid & 63, wid = __builtin_amdgcn_readfirstlane(tid >> 6), li = lane & 15, kg = lane >> 4;
    const int b = item >> 2, h = item & 3, it = wid >> 1, vh = wid & 1;
    LAS unsigned char* ST = lds + 98304;
    LAS float* SSQ = (LAS float*)(lds + DSA_BT_OFF);
    const bf16_t* Pb = P + (size_t)b * SEQ * PW;
    const float* DECb = DEC + (size_t)((b * 4 + h) * 32) * 384;
    f32x4 S[8];
#pragma unroll
    for (int vt = 0; vt < 8; ++vt) S[vt] = (f32x4){0.f, 0.f, 0.f, 0.f};
    u32x4 sg[6];
    const int colbase[3] = {P_QB, P_FB, P_IB};
#define HG_LOAD(c) do { _Pragma("unroll") for (int k = 0; k < 6; ++k) { const int n = tid + 512 * k, tl = n >> 10, r = (n >> 4) & 63, ch = n & 15; \
        sg[k] = *(const u32x4*)(Pb + (size_t)((c) * 64 + r) * PW + colbase[tl] + h * 128 + ch * 8); } } while (0)
#define HG_STORE(buf) do { _Pragma("unroll") for (int k = 0; k < 6; ++k) { const int n = tid + 512 * k, tl = n >> 10, r = (n >> 4) & 63, ch = n & 15; \
        *(LAS u32x4*)(lds + (buf) * 49152 + tl * 16384 + off_b(r, ch)) = sg[k]; } } while (0)
    HG_LOAD(0);
    __syncthreads();
    HG_STORE(0);
    const unsigned q4 = (lane & 15) >> 2, p4 = lane & 3;
    f32x4 ogv[4];
#pragma unroll
    for (int vv = 0; vv < 4; ++vv) ogv[vv] = *(const f32x4*)(o_g + 16 * (4 * vh + vv) + 4 * kg);
    float er_next = DECb[16 * wid + li];
#pragma unroll 1
    for (int c = 0; c < 32; ++c) {
        const int buf = c & 1;
        LAS unsigned char* QI = lds + buf * 49152; LAS unsigned char* KI = QI + 16384; LAS unsigned char* VI = QI + 32768;
        if (c + 1 < 32) HG_LOAD(c + 1);
        const float er = er_next, e63 = DECb[c * 384 + 128 + 16 * wid + li], e6r = DECb[c * 384 + 256 + 16 * wid + li];
        er_next = DECb[(c + 1 < 32 ? c + 1 : c) * 384 + 16 * wid + li];
        u32x2 gwv[4];
#pragma unroll
        for (int vv = 0; vv < 4; ++vv) gwv[vv] = *(const u32x2*)(P + ((size_t)b * SEQ + c * 64 + 16 * it + li) * PW + P_GB + h * 128 + 16 * (4 * vh + vv) + 4 * kg);
        { const unsigned d = 16 * wid + li;
#pragma unroll
          for (int vt = 0; vt < 8; ++vt) { u32x2 w; w.x = pk2(S[vt][0] * er, S[vt][1] * er); w.y = pk2(S[vt][2] * er, S[vt][3] * er);
              *(LAS u32x2*)(ST + off_b(d, 2 * vt + (kg >> 1)) + 8 * (kg & 1)) = w; } }
        __syncthreads();
        bf16x8 qf[4];
#pragma unroll
        for (int ks = 0; ks < 4; ++ks) qf[ks] = *(const LAS bf16x8*)(QI + off_b(16 * it + li, 4 * ks + kg));
        f32x4 o[4];
#pragma unroll
        for (int vv = 0; vv < 4; ++vv) o[vv] = (f32x4){0.f, 0.f, 0.f, 0.f};
#pragma unroll
        for (int ks = 0; ks < 4; ++ks)
#pragma unroll
            for (int vv = 0; vv < 4; ++vv) {
                const int ct = 4 * vh + vv;
                const v4i16_t lo4 = __builtin_amdgcn_ds_read_tr16_b64_v4i16((LAS v4i16_t*)(ST + off_b(32 * ks + 8 * kg + q4, 2 * ct + (p4 >> 1)) + 8 * (p4 & 1)));
                const v4i16_t hi4 = __builtin_amdgcn_ds_read_tr16_b64_v4i16((LAS v4i16_t*)(ST + off_b(32 * ks + 8 * kg + 4 + q4, 2 * ct + (p4 >> 1)) + 8 * (p4 & 1)));
                const bf16x8 af = (bf16x8){lo4[0], lo4[1], lo4[2], lo4[3], hi4[0], hi4[1], hi4[2], hi4[3]};
                o[vv] = __builtin_amdgcn_mfma_f32_16x16x32_bf16(af, qf[ks], o[vv], 0, 0, 0);
            }
        const int njb = (it >> 1) + 1;
#pragma unroll
        for (int jb = 0; jb < 2; ++jb) {
            if (jb < njb) {
                f32x4 a0 = (f32x4){0.f, 0.f, 0.f, 0.f}, a1 = (f32x4){0.f, 0.f, 0.f, 0.f};
                const unsigned rw0 = 32 * jb + 8 * (li >> 2) + (li & 3), rw1 = rw0 + 4;
#pragma unroll
                for (int ks = 0; ks < 4; ++ks) {
                    const bf16x8 k0 = *(const LAS bf16x8*)(KI + off_b(rw0, 4 * ks + kg));
                    const bf16x8 k1 = *(const LAS bf16x8*)(KI + off_b(rw1, 4 * ks + kg));
                    a0 = __builtin_amdgcn_mfma_f32_16x16x32_bf16(k0, qf[ks], a0, 0, 0, 0);
                    a1 = __builtin_amdgcn_mfma_f32_16x16x32_bf16(k1, qf[ks], a1, 0, 0, 0);
                }
                const int ii = 16 * it + li, j0 = 32 * jb + 8 * kg;
                float am[8];
#pragma unroll
                for (int e = 0; e < 8; ++e) am[e] = (j0 + e <= ii) ? (e < 4 ? a0[e] : a1[e - 4]) : 0.f;
                u32x4 pw; pw.x = pk2(am[0], am[1]); pw.y = pk2(am[2], am[3]); pw.z = pk2(am[4], am[5]); pw.w = pk2(am[6], am[7]);
                const bf16x8 pb = __builtin_bit_cast(bf16x8, pw);
#pragma unroll
                for (int vv = 0; vv < 4; ++vv) {
                    const int ct = 4 * vh + vv;
                    const v4i16_t lo4 = __builtin_amdgcn_ds_read_tr16_b64_v4i16((LAS v4i16_t*)(VI + off_b(32 * jb + 8 * kg + q4, 2 * ct + (p4 >> 1)) + 8 * (p4 & 1)));
                    const v4i16_t hi4 = __builtin_amdgcn_ds_read_tr16_b64_v4i16((LAS v4i16_t*)(VI + off_b(32 * jb + 8 * kg + 4 + q4, 2 * ct + (p4 >> 1)) + 8 * (p4 & 1)));
                    const bf16x8 af = (bf16x8){lo4[0], lo4[1], lo4[2], lo4[3], hi4[0], hi4[1], hi4[2], hi4[3]};
                    o[vv] = __builtin_amdgcn_mfma_f32_16x16x32_bf16(af, pb, o[vv], 0, 0, 0);
                }
            }
        }
        {
            f32x4 U[8];
#pragma unroll
            for (int vt = 0; vt < 8; ++vt) U[vt] = (f32x4){0.f, 0.f, 0.f, 0.f};
#pragma unroll
            for (int ks = 0; ks < 2; ++ks) {
                const v4i16_t kl = __builtin_amdgcn_ds_read_tr16_b64_v4i16((LAS v4i16_t*)(KI + off_b(32 * ks + 8 * kg + q4, 2 * wid + (p4 >> 1)) + 8 * (p4 & 1)));
                const v4i16_t kh = __builtin_amdgcn_ds_read_tr16_b64_v4i16((LAS v4i16_t*)(KI + off_b(32 * ks + 8 * kg + 4 + q4, 2 * wid + (p4 >> 1)) + 8 * (p4 & 1)));
                const bf16x8 kfr = (bf16x8){kl[0], kl[1], kl[2], kl[3], kh[0], kh[1], kh[2], kh[3]};
#pragma unroll
                for (int vt = 0; vt < 8; ++vt) {
                    const v4i16_t lo4 = __builtin_amdgcn_ds_read_tr16_b64_v4i16((LAS v4i16_t*)(VI + off_b(32 * ks + 8 * kg + q4, 2 * vt + (p4 >> 1)) + 8 * (p4 & 1)));
                    const v4i16_t hi4 = __builtin_amdgcn_ds_read_tr16_b64_v4i16((LAS v4i16_t*)(VI + off_b(32 * ks + 8 * kg + 4 + q4, 2 * vt + (p4 >> 1)) + 8 * (p4 & 1)));
                    const bf16x8 af = (bf16x8){lo4[0], lo4[1], lo4[2], lo4[3], hi4[0], hi4[1], hi4[2], hi4[3]};
                    U[vt] = __builtin_amdgcn_mfma_f32_16x16x32_bf16(af, kfr, U[vt], 0, 0, 0);
                }
            }
#pragma unroll
            for (int vt = 0; vt < 8; ++vt) S[vt] = S[vt] * e63 + U[vt] * e6r;
        }
        float ss = 0.f;
#pragma unroll
        for (int vv = 0; vv < 4; ++vv) ss += (o[vv][0] * o[vv][0] + o[vv][1] * o[vv][1]) + (o[vv][2] * o[vv][2] + o[vv][3] * o[vv][3]);
        ss += __shfl_xor(ss, 16); ss += __shfl_xor(ss, 32);
        if (kg == 0) SSQ[(it * 2 + vh) * 16 + li] = ss;
        __syncthreads();
        if (c + 1 < 32) HG_STORE(buf ^ 1);
        {
            const float tot = SSQ[(it * 2) * 16 + li] + SSQ[(it * 2 + 1) * 16 + li];
            const float rs = rsqrtf(tot * (1.f / 128.f) + EPS);
            const size_t row = (size_t)b * SEQ + c * 64 + 16 * it + li;
#pragma unroll
            for (int vv = 0; vv < 4; ++vv) {
                const int v0 = 16 * (4 * vh + vv) + 4 * kg;
                const u32x2 gw = gwv[vv];
                const f32x4 og = ogv[vv];
                const float g0 = silu_f(bf2f((unsigned short)(gw.x & 0xffffu))), g1 = silu_f(bf2f((unsigned short)(gw.x >> 16))), g2 = silu_f(bf2f((unsigned short)(gw.y & 0xffffu))), g3 = silu_f(bf2f((unsigned short)(gw.y >> 16)));
                u32x2 w; w.x = pk2(o[vv][0] * rs * og.x * g0, o[vv][1] * rs * og.y * g1); w.y = pk2(o[vv][2] * rs * og.z * g2, o[vv][3] * rs * og.w * g3);
                *(u32x2*)(CAT + row * KOUT + 1024 + h * 128 + v0) = w;
            }
        }
    }
#undef HG_LOAD
#undef HG_STORE
}


__device__ __forceinline__ int swap23(int r) { return (r & ~12) | ((r & 4) << 1) | ((r & 8) >> 1); }
__device__ __forceinline__ void xattn_mfma_phase(const bf16_t* Q, const bf16_t* Kb, const bf16_t* VT, bf16_t* O, LAS unsigned char* lds, int vb, int nvb) {
    const int tid = otid(), lane = tid & 63, wid = __builtin_amdgcn_readfirstlane(tid >> 6), r32 = lane & 31, hf = lane >> 5;
    LAS unsigned char* Ks = lds; LAS unsigned char* Vs = lds + 65536;
    int koff[8], voff[8];
    { const int kr = swap23(r32), x = kr & 15, y = r32 & 15;
#pragma unroll
      for (int ks = 0; ks < 8; ++ks) koff[ks] = kr * 256 + (((ks * 2 + hf) ^ x) << 4);
#pragma unroll
      for (int e = 0; e < 8; ++e) voff[e] = r32 * 512 + (((e * 2 + hf) ^ y) << 4); }
    for (int pair = vb; pair < 256; pair += nvb) {
        const int bh = pair >> 2, b = bh >> 2, h = bh & 3;
        __syncthreads();
        int tio = tid; asm volatile("" : "+v"(tio));
        for (int i = tio; i < 4096; i += NTHREADS) { const int key = i >> 4, ch = i & 15;
            const u32x4 v = *(const u32x4*)(Kb + (size_t)(b * MEMT + key) * 512 + h * 128 + ch * 8);
            *(LAS u32x4*)(Ks + key * 256 + ((ch ^ (key & 15)) << 4)) = v; }
        for (int i = tio; i < 4096; i += NTHREADS) { const int d = i >> 5, ch = i & 31;
            const u32x4 v = *(const u32x4*)(VT + (size_t)(h * 128 + d) * MT + b * MEMT + ch * 8);
            *(LAS u32x4*)(Vs + d * 512 + ((ch ^ (d & 15)) << 4)) = v; }
        __syncthreads();
#pragma unroll 1
        for (int qq = 0; qq < 2; ++qq) {
            const size_t q0 = (size_t)b * SEQ + ((pair & 3) * 2 + qq) * 256 + wid * 32;
            bf16x8 qf[8];
#pragma unroll
            for (int ks = 0; ks < 8; ++ks) qf[ks] = *(const bf16x8*)(Q + (q0 + r32) * 512 + h * 128 + ks * 16 + 8 * hf);
            f32x16 st[8];
            __builtin_amdgcn_s_setprio(1);
#pragma unroll
            for (int kt = 0; kt < 8; ++kt) {
#pragma unroll
                for (int r = 0; r < 16; ++r) st[kt][r] = 0.f;
#pragma unroll
                for (int ks = 0; ks < 8; ++ks) {
                    const bf16x8 a = *(const LAS bf16x8*)(Ks + koff[ks] + kt * 8192);
                    st[kt] = __builtin_amdgcn_mfma_f32_32x32x16_bf16(a, qf[ks], st[kt], 0, 0, 0);
                }
            }
            __builtin_amdgcn_s_setprio(0);
            float mx = -INFINITY;
#pragma unroll
            for (int kt = 0; kt < 8; ++kt)
#pragma unroll
                for (int r = 0; r < 16; ++r) mx = fmaxf(mx, st[kt][r]);
            mx = fmaxf(mx, __shfl_xor(mx, 32));
            const float c = 0.08838834764831845f * 1.4426950408889634f;
            float sum = 0.f;
#pragma unroll
            for (int kt = 0; kt < 8; ++kt)
#pragma unroll
                for (int r = 0; r < 16; ++r) { const float e = __builtin_amdgcn_exp2f((st[kt][r] - mx) * c); st[kt][r] = e; sum += e; }
            sum += __shfl_xor(sum, 32);
            const float inv = 1.f / sum;
            bf16x8 pfr[8][2];
#pragma unroll
            for (int kt = 0; kt < 8; ++kt)
#pragma unroll
                for (int s2 = 0; s2 < 2; ++s2) {
                    u32x4 pw;
                    pw.x = pk2(st[kt][8 * s2 + 0], st[kt][8 * s2 + 1]); pw.y = pk2(st[kt][8 * s2 + 2], st[kt][8 * s2 + 3]);
                    pw.z = pk2(st[kt][8 * s2 + 4], st[kt][8 * s2 + 5]); pw.w = pk2(st[kt][8 * s2 + 6], st[kt][8 * s2 + 7]);
                    pfr[kt][s2] = __builtin_bit_cast(bf16x8, pw);
                }
#pragma unroll
            for (int kt = 0; kt < 8; ++kt) asm volatile("" : "+v"(pfr[kt][0]), "+v"(pfr[kt][1]));
            f32x16 o[4];
#pragma unroll
            for (int dt = 0; dt < 4; ++dt)
#pragma unroll
                for (int r = 0; r < 16; ++r) o[dt][r] = 0.f;
            __builtin_amdgcn_s_setprio(1);
#pragma unroll
            for (int kt = 0; kt < 8; ++kt)
#pragma unroll
                for (int s2 = 0; s2 < 2; ++s2)
#pragma unroll
                    for (int dt = 0; dt < 4; ++dt) {
                        const bf16x8 a = *(const LAS bf16x8*)(Vs + voff[(kt & 3) * 2 + s2] + dt * 16384 + (kt >> 2) * 256);
                        o[dt] = __builtin_amdgcn_mfma_f32_32x32x16_bf16(a, pfr[kt][s2], o[dt], 0, 0, 0);
                    }
            __builtin_amdgcn_s_setprio(0);
            bf16_t* orow = O + (q0 + r32) * 512 + h * 128 + 4 * hf;
#pragma unroll
            for (int dt = 0; dt < 4; ++dt)
#pragma unroll
                for (int g = 0; g < 4; ++g) {
                    u32x2 w; w.x = pk2(o[dt][4 * g] * inv, o[dt][4 * g + 1] * inv); w.y = pk2(o[dt][4 * g + 2] * inv, o[dt][4 * g + 3] * inv);
                    *(u32x2*)(orow + dt * 32 + 8 * g) = w;
                }
        }
    }
}


__device__ __forceinline__ void gmlp_mfma_phase(const bf16_t* UV, const float* lnp, const float* ln_g, const float* ln_b, const float* w_sp, const float* b_sp, bf16_t* G, LAS unsigned char* lds, int vb, int nvb) {
    const int tid = otid(), lane = tid & 63, wid = __builtin_amdgcn_readfirstlane(tid >> 6), fr = lane & 15, fq = lane >> 4;
    LAS unsigned char* Wb = lds; LAS unsigned char* VTs = lds + 32768; LAS float* STAT = (LAS float*)(lds + 65536);
    int gcur = -1;
    for (int grp = vb; grp < 256; grp += nvb) {
        const int g = grp >> 5;
        bf16x8 vch[4]; f32x4 lp[2];
#define GM_LOAD(uu_) do { const size_t r0_ = (size_t)((grp & 31) * 8 + (uu_)) * 128; \
            _Pragma("unroll") for (int k = 0; k < 4; ++k) { const int i = tid + 512 * k, sI = i >> 4, ch = i & 15; vch[k] = *(const bf16x8*)(UV + (r0_ + sI) * 2048 + 1024 + g * 128 + ch * 8); } \
            lp[0] = *(const f32x4*)(lnp + (r0_ + (tid >> 2)) * 32 + (tid & 3) * 8); lp[1] = *(const f32x4*)(lnp + (r0_ + (tid >> 2)) * 32 + (tid & 3) * 8 + 4); } while (0)
        GM_LOAD(0);
        const f32x4 g0 = *(const f32x4*)(ln_g + g * 128 + (tid & 15) * 8), g1 = *(const f32x4*)(ln_g + g * 128 + (tid & 15) * 8 + 4);
        const f32x4 b0 = *(const f32x4*)(ln_b + g * 128 + (tid & 15) * 8), b1 = *(const f32x4*)(ln_b + g * 128 + (tid & 15) * 8 + 4);
        const float gg[8] = {g0.x, g0.y, g0.z, g0.w, g1.x, g1.y, g1.z, g1.w}, bb[8] = {b0.x, b0.y, b0.z, b0.w, b1.x, b1.y, b1.z, b1.w};
        __syncthreads();
        if (g != gcur) {
            gcur = g;
            for (int i = tid; i < 2048; i += NTHREADS) { const int t = i >> 4, ch = i & 15;
                const f32x4 a = *(const f32x4*)(w_sp + (size_t)g * 16384 + t * 128 + ch * 8), b = *(const f32x4*)(w_sp + (size_t)g * 16384 + t * 128 + ch * 8 + 4);
                const int s0 = ch * 8;
                u32x4 w; w.x = pk2(s0 + 0 <= t ? a.x : 0.f, s0 + 1 <= t ? a.y : 0.f); w.y = pk2(s0 + 2 <= t ? a.z : 0.f, s0 + 3 <= t ? a.w : 0.f);
                w.z = pk2(s0 + 4 <= t ? b.x : 0.f, s0 + 5 <= t ? b.y : 0.f); w.w = pk2(s0 + 6 <= t ? b.z : 0.f, s0 + 7 <= t ? b.w : 0.f);
                *(LAS u32x4*)(Wb + t * 256 + ((ch ^ (t & 15)) << 4)) = w; }
        }
        const int trow = wid * 16 + fr;
        const float bias = b_sp[g * 128 + trow];
#pragma unroll 1
        for (int uu = 0; uu < 8; ++uu) {
            const int bn = (grp & 31) * 8 + uu;
            const size_t row0 = (size_t)bn * 128;
            if (uu) __syncthreads();
            { float s1 = (lp[0].x + lp[0].z) + (lp[1].x + lp[1].z), s2 = (lp[0].y + lp[0].w) + (lp[1].y + lp[1].w);
              s1 += __shfl_xor(s1, 1); s2 += __shfl_xor(s2, 1); s1 += __shfl_xor(s1, 2); s2 += __shfl_xor(s2, 2);
              const float mu = s1 * (1.f / 1024.f), var = fmaxf(s2 * (1.f / 1024.f) - mu * mu, 0.f);
              if ((tid & 3) == 0) { STAT[2 * (tid >> 2)] = mu; STAT[2 * (tid >> 2) + 1] = rsqrtf(var + EPS); } }
            __syncthreads();
#pragma unroll
            for (int k = 0; k < 4; ++k) { const int i = tid + 512 * k, sI = i >> 4, ch = i & 15;
                const float mu = STAT[2 * sI], rs = STAT[2 * sI + 1];
#pragma unroll
                for (int e = 0; e < 8; ++e) { const int c = ch * 8 + e; const float x = (bf2f((unsigned short)vch[k][e]) - mu) * rs * gg[e] + bb[e];
                    *(LAS bf16_t*)(VTs + c * 256 + (((sI >> 3) ^ ((c ^ (c >> 3)) & 15)) << 4) + (sI & 7) * 2) = (bf16_t)f2bf(x); } }
            if (uu + 1 < 8) GM_LOAD(uu + 1);
            const size_t orow = row0 + trow;
            u32x2 uwv[8];
#pragma unroll
            for (int ct = 0; ct < 8; ++ct) uwv[ct] = *(const u32x2*)(UV + orow * 2048 + g * 128 + ct * 16 + 4 * fq);
            __syncthreads();
            f32x4 acc[8];
#pragma unroll
            for (int ct = 0; ct < 8; ++ct) acc[ct] = (f32x4){0.f, 0.f, 0.f, 0.f};
#pragma unroll
            for (int ks = 0; ks < 4; ++ks) {
                const bf16x8 wf = *(const LAS bf16x8*)(Wb + trow * 256 + (((ks * 4 + fq) ^ (trow & 15)) << 4));
#pragma unroll
                for (int ct = 0; ct < 8; ++ct) {
                    const int crow = ct * 16 + fr;
                    const bf16x8 vf = *(const LAS bf16x8*)(VTs + crow * 256 + (((ks * 4 + fq) ^ ((crow ^ (crow >> 3)) & 15)) << 4));
                    acc[ct] = __builtin_amdgcn_mfma_f32_16x16x32_bf16(vf, wf, acc[ct], 0, 0, 0);
                }
            }
#pragma unroll
            for (int ct = 0; ct < 8; ++ct) {
                const int c = ct * 16 + 4 * fq;
                const u32x2 uw = uwv[ct];
                const float u0 = bf2f((unsigned short)(uw.x & 0xffffu)), u1 = bf2f((unsigned short)(uw.x >> 16)), u2 = bf2f((unsigned short)(uw.y & 0xffffu)), u3 = bf2f((unsigned short)(uw.y >> 16));
                u32x2 w; w.x = pk2(u0 * (acc[ct][0] + bias), u1 * (acc[ct][1] + bias)); w.y = pk2(u2 * (acc[ct][2] + bias), u3 * (acc[ct][3] + bias));
                *(u32x2*)(G + orow * 1024 + g * 128 + c) = w;
            }
        }
#undef GM_LOAD
    }
}

#define GAS __attribute__((address_space(1)))
typedef GAS unsigned gu32;
#define XB_TMO      128
#define XB_XCNT(j)  (256  + 64 * (j))
#define XB_XSUB(j)  (1280 + 64 * (j))
#define XB_XGEN(j)  (2304 + 64 * (j))
#define XB_TOP      3328
#define XB_TOPGEN   3392
#define XCD_BAR_WORDS 3456
#define XB_SPIN_CAP (1u << 18)

__device__ __forceinline__ unsigned xb_ld(unsigned* p)              { return __hip_atomic_load(p, __ATOMIC_RELAXED, __HIP_MEMORY_SCOPE_AGENT); }
__device__ __forceinline__ unsigned xb_add(unsigned* p, unsigned v) { return __hip_atomic_fetch_add(p, v, __ATOMIC_RELAXED, __HIP_MEMORY_SCOPE_AGENT); }
__device__ __forceinline__ unsigned xb_xcc_id() { return (unsigned)__builtin_amdgcn_s_getreg((3 << 11) | 20) & 0xFu; }
#define XB_SPIN(cond, bar) do { unsigned _sp = 0; while (cond) { __builtin_amdgcn_s_sleep(1); \
    if ((++_sp & 255u) == 0u) { if (xb_ld(&(bar)[XB_TMO])) break; if (_sp > XB_SPIN_CAP) { atomicAdd(&(bar)[XB_TMO], 1u); break; } } } } while (0)

struct XcdBarrier {
    unsigned* bar; unsigned x;
    volatile LAS unsigned* st;
};

__device__ __forceinline__ XcdBarrier xcd_barrier_post(unsigned* bar, volatile LAS unsigned* st) {
    XcdBarrier b; b.bar = bar; b.x = xb_xcc_id(); b.st = st;
    if (threadIdx.x == 0) (void)xb_add(&bar[XB_XCNT(b.x)], 1u);
    return b;
}
__device__ __forceinline__ void xcd_barrier_complete(unsigned* bar, unsigned x, unsigned& nloc, unsigned& nx) {
    const unsigned G = gridDim.x * gridDim.y * gridDim.z;
    unsigned sum, cnt, mine, sp = 0u;
    for (;;) {
        sum = 0u; cnt = 0u; mine = 0u;
#pragma unroll
        for (unsigned j = 0; j < 16; ++j) { const unsigned c = xb_ld(&bar[XB_XCNT(j)]); sum += c; cnt += (c > 0u) ? 1u : 0u; mine = (j == x) ? c : mine; }
        if (sum == G) break;
        __builtin_amdgcn_s_sleep(1);
        if ((++sp & 255u) == 0u) { if (xb_ld(&bar[XB_TMO])) break; if (sp > XB_SPIN_CAP) { atomicAdd(&bar[XB_TMO], 1u); break; } }
    }
    nloc = mine > 0u ? mine : 1u; nx = cnt > 0u ? cnt : 1u;
}

__device__ __forceinline__ void xcd_barrier(const XcdBarrier& b) {
    asm volatile("s_waitcnt vmcnt(0)" ::: "memory");
    __syncthreads();
    if (threadIdx.x == 0) {
        unsigned* bar = b.bar;
        __builtin_amdgcn_s_waitcnt(0);
        unsigned nloc = b.st[0], nx = b.st[1];
        if (nloc == 0u) { xcd_barrier_complete(bar, b.x, nloc, nx); b.st[0] = nloc; b.st[1] = nx; }
        const unsigned old = xb_add(&bar[XB_XSUB(b.x)], 1u);
        const unsigned gen = old / nloc;
        if (old + 1u == (gen + 1u) * nloc) {
            __builtin_amdgcn_fence(__ATOMIC_RELEASE, "agent");
            asm volatile("s_waitcnt vmcnt(0)" ::: "memory");
            const unsigned og = xb_add(&bar[XB_TOP], 1u);
            const unsigned tg = og / nx;
            if (og + 1u == (tg + 1u) * nx) xb_add(&bar[XB_TOPGEN], 1u);
            else XB_SPIN(xb_ld(&bar[XB_TOPGEN]) == tg, bar);
            __builtin_amdgcn_fence(__ATOMIC_ACQUIRE, "agent");
            xb_add(&bar[XB_XGEN(b.x)], 1u);
            asm volatile("s_waitcnt vmcnt(0)" ::: "memory");
        } else {
            XB_SPIN(xb_ld(&bar[XB_XGEN(b.x)]) == gen, bar);
            __builtin_amdgcn_fence(__ATOMIC_ACQUIRE, "agent");
            asm volatile("s_waitcnt vmcnt(0)" ::: "memory");
        }
    }
    __syncthreads();
}

constexpr int LDS_BYTES = 32768 * 4 + 256 + 6144 + 8 * 2560;

enum Phase {
    PH_PREP = 0, PH_GEMM_IN, PH_CNORM, PH_MIX0  , PH_GEMM_OUT0,
    PH_GEMM_Q0, PH_XATTN0, PH_GEMM_O0, PH_GEMM_GU0, PH_GEMM_DN0,
    PH_GEMM_OIN, PH_GMLP, PH_GEMM_OOUT,
    PH_GEMM_Q1, PH_XATTN1, PH_GEMM_O1, PH_GEMM_GU1, PH_GEMM_DN1, PH_FINAL, PH_COUNT
};

__device__ __forceinline__ PrepJob make_job(const Params& p, int ji) {
    unsigned char* ws = p.ws; PrepJob j{};
    switch (ji) {
    case 0: j = PrepJob{p.in[5], 1024, 3272, p.in[4], (bf16_t*)(ws + WS_WIN), 1024, PW, 1024, 0, MAP_WIN}; break;
    case 1: j = PrepJob{p.in[10] + (size_t)512 * 1024, 512, 1024, nullptr, (bf16_t*)(ws + WS_WOUT), 0, 1024, KOUT, 1024, MAP_ID}; break;
    case 2: j = PrepJob{p.in[11], 1024, 2048, p.in[4] + 1024, (bf16_t*)(ws + WS_OWIN), 0, 2048, 1024, 0, MAP_ID, 2, WQ_GU}; break;
    case 3: j = PrepJob{p.in[16], 1024, 1024, nullptr, (bf16_t*)(ws + WS_OWOUT), 0, 1024, 1024, 0, MAP_ID}; break;
    case 4: case 5: { const int l = ji - 4; j = PrepJob{p.in[19] + (size_t)l * 1024 * 512, 1024, 512, p.in[17] + l * 1024, (bf16_t*)(ws + WS_WQ + (size_t)l * 512 * 1024), 0, 512, 1024, 0, MAP_ID, 2, WQ_GU}; } break;
    case 6: case 7: { const int l = ji - 6; j = PrepJob{p.in[20] + (size_t)l * 1024 * 1024, 1024, 1024, p.in[18] + l * 1024, (bf16_t*)(ws + WS_WKV) + (size_t)l * 1024 * 1024, 0, 1024, 1024, 0, MAP_ID}; } break;
    case 8: case 9: { const int l = ji - 8; j = PrepJob{p.in[21] + (size_t)l * 512 * 1024, 512, 1024, nullptr, (bf16_t*)(ws + WS_WO) + (size_t)l * 1024 * 512, 0, 1024, 512, 0, MAP_ID}; } break;
    case 10: case 11: { const int l = ji - 10; j = PrepJob{p.in[23] + (size_t)l * 1024 * 2 * FF, 1024, 2 * FF, p.in[22] + l * 1024, (bf16_t*)(ws + WS_WGU + (size_t)l * 2 * FF * 1024), 0, 2 * FF, 1024, 0, MAP_GU, 2, WQ_GU}; } break;
#if DN_FP8
    default: { const int l = ji - 12; j = PrepJob{p.in[24] + (size_t)l * FF * 1024, FF, 1024, nullptr, (bf16_t*)(ws + WS_WDN + (size_t)l * 1024 * FF), 0, 1024, FF, 0, MAP_ID, 1, WDN_SC}; } break;
#else
    default: { const int l = ji - 12; j = PrepJob{p.in[24] + (size_t)l * FF * 1024, FF, 1024, nullptr, (bf16_t*)(ws + WS_WDN) + (size_t)l * 1024 * FF, 0, 1024, FF, 0, MAP_ID}; } break;
#endif
    }
    return j;
}
constexpr int N_PREP_JOBS = 14;

template <int ph> __device__ __forceinline__ void run_phase(const Params& p, LAS float* lds, int vb, int nvb) {
    unsigned char* ws = p.ws;
    bf16_t* HN = (bf16_t*)(ws + WS_HN); bf16_t* BIG = (bf16_t*)(ws + WS_BIG); bf16_t* CN = (bf16_t*)(ws + WS_CN); bf16_t* CAT = (bf16_t*)(ws + WS_CAT);
    bf16_t* KB = (bf16_t*)(ws + WS_KB); bf16_t* VTB = (bf16_t*)(ws + WS_VT); bf16_t* MEMN = (bf16_t*)(ws + WS_MEMN); float* lb = (float*)(ws + WS_LB);
    float* ssq = (float*)(ws + WS_SSQ); float* lnp = (float*)(ws + WS_LNP);
    bf16_t* XQ = BIG; bf16_t* XO = BIG + (size_t)T * 512;
    const int l = (ph >= PH_GEMM_Q1) ? 1 : 0;
    switch (ph) {
    case PH_PREP:
        x_to_h_rows(p.in[0], HN, ssq, vb, nvb);
        {
            constexpr int NT_[N_PREP_JOBS] = {16 * 11, 8 * 4, 16 * 8, 16 * 4, 16 * 2, 16 * 2, 16 * 4, 16 * 4, 8 * 4, 8 * 4, 16 * 22, 16 * 22, 44 * 4, 44 * 4};
            constexpr int CUM1 = NT_[0], CUM2 = CUM1 + NT_[1], CUM3 = CUM2 + NT_[2], CUM4 = CUM3 + NT_[3], CUM5 = CUM4 + NT_[4], CUM6 = CUM5 + NT_[5], CUM7 = CUM6 + NT_[6],
                          CUM8 = CUM7 + NT_[7], CUM9 = CUM8 + NT_[8], CUM10 = CUM9 + NT_[9], CUM11 = CUM10 + NT_[10], CUM12 = CUM11 + NT_[11], CUM13 = CUM12 + NT_[12], CUM14 = CUM13 + NT_[13];
#define PJ_FIND(it_, ji_, base_) do { ji_ = 0; base_ = 0; \
                PJ_STEP(it_, ji_, base_, 1, CUM1) PJ_STEP(it_, ji_, base_, 2, CUM2) PJ_STEP(it_, ji_, base_, 3, CUM3) PJ_STEP(it_, ji_, base_, 4, CUM4) PJ_STEP(it_, ji_, base_, 5, CUM5) PJ_STEP(it_, ji_, base_, 6, CUM6) PJ_STEP(it_, ji_, base_, 7, CUM7) \
                PJ_STEP(it_, ji_, base_, 8, CUM8) PJ_STEP(it_, ji_, base_, 9, CUM9) PJ_STEP(it_, ji_, base_, 10, CUM10) PJ_STEP(it_, ji_, base_, 11, CUM11) PJ_STEP(it_, ji_, base_, 12, CUM12) PJ_STEP(it_, ji_, base_, 13, CUM13) } while (0)
#define PJ_STEP(it_, ji_, base_, q, c) if ((it_) >= (c)) { ji_ = (q); base_ = (c); }
            f32x4 va[8], vn[8];
            int ji, base;
            if (vb < CUM14) { PJ_FIND(vb, ji, base); const PrepJob j = make_job(p, ji); prep_tile_load(j, vb - base, va); }
            for (int it = vb; it < CUM14; it += nvb) {
                PJ_FIND(it, ji, base);
                const PrepJob j = make_job(p, ji); const int tl = it - base;
                if (it + nvb < CUM14) { int jn, bn; PJ_FIND(it + nvb, jn, bn); const PrepJob j2 = make_job(p, jn); prep_tile_load(j2, it + nvb - bn, vn); }
                prep_tile_store(j, tl, va, lds);
#pragma unroll
                for (int q = 0; q < 8; ++q) va[q] = vn[q];
            }
#undef PJ_STEP
#undef PJ_FIND
        }
        prep_fold_in(p.in[5], p.in[7], p.in[4], (bf16_t*)(ws + WS_WIN), lds, vb, nvb);
        prep_fold_out(p.in[10], p.in[8], (bf16_t*)(ws + WS_WOUT), lds, vb, nvb);
        prep_lb(p.in[3], lb, vb, nvb);
        rmsnorm_rows(p.in[1], MEMN, MT, vb, nvb);
        break;
    case PH_GEMM_IN: {
        Gemm g{(const bf16_t*)(ws + WS_WIN), (const bf16_t*)(ws + WS_WIN), T, PW, 1024}; EpiIn E{BIG, KB, VTB, ssq};
        pg8::ComboOrder S; S.init(nvb, vb);
        pg8::gemm_phase<EpiIn, pg8::ComboOrder, true, true>((LAS unsigned char*)lds, g, S, E);
    } break;
    case PH_CNORM: cnorm_rows(BIG, p.in[6], CN, vb, nvb); hgrn_prep(BIG, lb, (float*)(ws + WS_DEC), (LAS unsigned char*)lds, vb, nvb); break;
    case PH_MIX0:
        for (int item = vb; item < 64; item += nvb) hgrn_scan(BIG, (const float*)(ws + WS_DEC), p.in[9], CAT, (LAS unsigned char*)lds, item);
        dsa_mfma_phase(BIG, CN, p.in[2], CAT, (LAS unsigned char*)lds, (unsigned*)(ws + WS_CTL) + 3600);
        break;
    case PH_GEMM_OUT0: { Gemm g{CAT, (const bf16_t*)(ws + WS_WOUT), T, 1024, KOUT}; EpiResid<false, false, true> E{nullptr, HN, ssq, ws + WS_H8, HQ_Q0}; run_gemm(g, E, lds, vb, nvb); } break;
    case PH_GEMM_Q0: case PH_GEMM_Q1: { Gemm g{(const bf16_t*)(ws + WS_H8), (const bf16_t*)(ws + WS_WQ + (size_t)l * 512 * 1024), T, 512, 512}; EpiStoreBf16<true> E{XQ, 512, ssq, 1.f / ((l ? HQ_Q1 : HQ_Q0) * WQ_GU)}; run_gemm<EpiStoreBf16<true>, 2>(g, E, lds, vb, nvb); } break;
    case PH_XATTN0: case PH_XATTN1: xattn_mfma_phase(XQ, KB + (size_t)l * MT * 512, VTB + (size_t)l * 512 * MT, XO, (LAS unsigned char*)lds, vb, nvb); break;
    case PH_GEMM_O0: case PH_GEMM_O1: { Gemm g{XO, (const bf16_t*)(ws + WS_WO) + (size_t)l * 1024 * 512, T, 1024, 512}; EpiResid<false, false, true> E{nullptr, HN, ssq, ws + WS_H8, l ? HQ_GU1 : HQ_GU0}; run_gemm(g, E, lds, vb, nvb); } break;
    case PH_GEMM_GU0: case PH_GEMM_GU1: { Gemm g{(const bf16_t*)(ws + WS_H8), (const bf16_t*)(ws + WS_WGU + (size_t)l * 2 * FF * 1024), T, 2 * FF, 512}; EpiSwigluQ<true, DN_FP8 != 0> E{BIG, FF, ssq, 1.f / ((l ? HQ_GU1 : HQ_GU0) * WQ_GU)}; run_gemm<EpiSwigluQ<true, DN_FP8 != 0>, 2>(g, E, lds, vb, nvb); } break;
    case PH_GEMM_DN0: case PH_GEMM_DN1:
#if DN_FP8
        { Gemm g{BIG, (const bf16_t*)(ws + WS_WDN + (size_t)l * 1024 * FF), T, 1024, FF / 2}; EpiResid<false, true, ph == PH_GEMM_DN0> E{nullptr, HN, ssq, ws + WS_H8, HQ_OIN}; run_gemm<EpiResid<false, true, ph == PH_GEMM_DN0>, 1>(g, E, lds, vb, nvb); } break;
#else
        { Gemm g{BIG, (const bf16_t*)(ws + WS_WDN) + (size_t)l * 1024 * FF, T, 1024, FF}; EpiResid<false, false, ph == PH_GEMM_DN0> E{nullptr, HN, ssq, ws + WS_H8, HQ_OIN}; run_gemm(g, E, lds, vb, nvb); } break;
#endif
    case PH_GEMM_OIN: { Gemm g{(const bf16_t*)(ws + WS_H8), (const bf16_t*)(ws + WS_OWIN), T, 2048, 512}; EpiGeluBf16<true> E{BIG, 2048, ssq, lnp, 1.f / (HQ_OIN * WQ_GU)}; run_gemm<EpiGeluBf16<true>, 2>(g, E, lds, vb, nvb); } break;
    case PH_GMLP: gmlp_mfma_phase(BIG, lnp, p.in[12], p.in[13], p.in[14], p.in[15], CAT, (LAS unsigned char*)lds, vb, nvb); break;
    case PH_GEMM_OOUT: { Gemm g{CAT, (const bf16_t*)(ws + WS_OWOUT), T, 1024, 1024}; EpiResid<false, false, true> E{nullptr, HN, ssq, ws + WS_H8, HQ_Q1}; run_gemm(g, E, lds, vb, nvb); } break;
    case PH_FINAL: final_rows(HN, ssq, p.in[25], p.out, vb, nvb); break;
    default: break;
    }
}

template <int PH> __global__ void __launch_bounds__(NTHREADS) k_phase(Params p) {
    extern __shared__ __attribute__((aligned(16))) float smem[];
    run_phase<PH>(p, (LAS float*)smem, blockIdx.x, gridDim.x);
}

template <int PH> __device__ __forceinline__ void mega_phases(const Params& p, LAS float* lds, const XcdBarrier& bar) {
    run_phase<PH>(p, lds, blockIdx.x, gridDim.x);
#ifdef REPEAT_PH
    if constexpr (PH == REPEAT_PH) { xcd_barrier(bar); run_phase<PH>(p, lds, blockIdx.x, gridDim.x); }
#endif
    if constexpr (PH + 1 < PH_COUNT) { xcd_barrier(bar); mega_phases<PH + 1>(p, lds, bar); }
}
__global__ void __launch_bounds__(NTHREADS) k_mega(Params p) {
    extern __shared__ __attribute__((aligned(16))) float smem[];
    volatile LAS unsigned* st = (volatile LAS unsigned*)((LAS float*)smem + 32768);
    if (threadIdx.x < 2) st[threadIdx.x] = 0u;
    __syncthreads();
    const XcdBarrier bar = xcd_barrier_post((unsigned*)(p.ws + WS_CTL), st);
    mega_phases<0>(p, (LAS float*)smem, bar);
}

template <int PH> static void launch_phases(const Params& p, int grid, hipStream_t stream) {
    int g = grid * 4;
    if (PH == PH_MIX0 || PH == PH_XATTN0 || PH == PH_XATTN1 || PH == PH_GMLP) g = grid;
    (void)hipFuncSetAttribute((const void*)k_phase<PH>, hipFuncAttributeMaxDynamicSharedMemorySize, LDS_BYTES);
    hipLaunchKernelGGL(k_phase<PH>, dim3(g), dim3(NTHREADS), LDS_BYTES, stream, p);
    if constexpr (PH + 1 < PH_COUNT) launch_phases<PH + 1>(p, grid, stream);
}

extern "C" void kernel_launch(void* const* d_in, const int* in_sizes, int n_in, void* d_out, int out_size, void* d_ws, size_t ws_size, hipStream_t stream) {
    static int grid = 0;
    if (grid == 0) {
        if (n_in != 26 || out_size != T * D || ws_size < WS_END) { fprintf(stderr, "kernel_launch: unexpected shapes (n_in %d out %d ws %zu)\n", n_in, out_size, ws_size); grid = -1; return; }
        int dev = 0, cus = 0;
        (void)hipGetDevice(&dev); (void)hipDeviceGetAttribute(&cus, hipDeviceAttributeMultiprocessorCount, dev);
        (void)hipFuncSetAttribute((const void*)k_mega, hipFuncAttributeMaxDynamicSharedMemorySize, LDS_BYTES);
        int per_cu = 0;
        (void)hipOccupancyMaxActiveBlocksPerMultiprocessor(&per_cu, (const void*)k_mega, NTHREADS, LDS_BYTES);
        if (per_cu < 1) fprintf(stderr, "kernel_launch: occupancy query says %d blocks per CU\n", per_cu);
        (void)hipGetLastError();
        grid = cus > 0 ? cus : 256;
    }
    if (grid < 0) return;
    Params p{};
    for (int i = 0; i < 26; ++i) p.in[i] = (const float*)d_in[i];
    p.out = (float*)d_out; p.ws = (unsigned char*)d_ws;
    (void)hipMemsetAsync((char*)d_ws + WS_CTL, 0, 16384, stream);
#if MEGA
    hipLaunchKernelGGL(k_mega, dim3(grid), dim3(NTHREADS), LDS_BYTES, stream, p);
#else
    launch_phases<0>(p, grid, stream);
#endif
}
```

```cpp
#include <hip/hip_runtime.h>
#include <stdint.h>
#include <stdio.h>

#ifndef MEGA
#define MEGA 1
#endif
#ifndef DN_FP8
#define DN_FP8 0
#endif

#define LAS __attribute__((address_space(3)))
typedef unsigned short bf16_t;
typedef short bf16x8 __attribute__((ext_vector_type(8)));
typedef float f32x4 __attribute__((ext_vector_type(4)));
typedef float f32x2 __attribute__((ext_vector_type(2)));
typedef unsigned u32x4 __attribute__((ext_vector_type(4)));
typedef unsigned u32x2 __attribute__((ext_vector_type(2)));
typedef float f32x16 __attribute__((ext_vector_type(16)));

constexpr int D = 1024, BATCH = 16, SEQ = 2048, T = BATCH * SEQ;
constexpr int CHUNK = 64;
constexpr int MEMT = 256, MT = BATCH * MEMT;
constexpr int FF = 2816;
constexpr float EPS = 1e-6f;
constexpr int NTHREADS = 512, NWAVES = 8;

constexpr int P_QL = 0, P_C = 1024, P_QI = 1152, P_KI = 1664, P_FB = 1728, P_IB = 2240, P_QB = 2752, P_GB = 3264, P_WI = 3776, P_END = 3784, PW = 3840;
constexpr int KOUT = 1536;

constexpr size_t MiB = 1u << 20;
constexpr size_t WS_CTL = 0;
constexpr size_t WS_LB = 64 * 1024;
constexpr size_t WS_SSQ = 496 * MiB;
constexpr size_t WS_LNP = 498 * MiB;
constexpr size_t WS_WIN = 1 * MiB;
constexpr size_t WS_WKV = WS_WIN + (size_t)PW * D * 2;
constexpr size_t WS_HN = WS_WKV + 2 * (size_t)D * D * 2;
constexpr size_t WS_MEMN = WS_HN + (size_t)T * D * 2;
constexpr size_t WS_WOUT = WS_MEMN + (size_t)MT * D * 2;
constexpr size_t WS_OWIN = WS_WOUT + (size_t)D * KOUT * 2;
constexpr size_t WS_OWOUT = WS_OWIN + (size_t)2048 * D * 2;
constexpr size_t WS_WQ = WS_OWOUT + (size_t)D * D * 2;
constexpr size_t WS_WO = WS_WQ + 2 * (size_t)512 * D * 2;
constexpr size_t WS_WGU = WS_WO + 2 * (size_t)D * 512 * 2;
constexpr size_t WS_WDN = WS_WGU + 2 * (size_t)2 * FF * D * 2;
constexpr size_t WS_WEND = WS_WDN + 2 * (size_t)D * FF * 2;
constexpr int TILE_WIN = 0, TILE_WKV = PW / 256, TILE_HN = TILE_WKV + 8, TILE_MEMN = TILE_HN + T / 256;
constexpr size_t WS_BIG = 132 * MiB;
constexpr size_t WS_CN = 372 * MiB;
constexpr size_t WS_CAT = 380 * MiB;
constexpr size_t WS_H8 = WS_BIG + 200 * MiB;
constexpr size_t WS_KB = 476 * MiB;
constexpr size_t WS_VT = 484 * MiB;
constexpr size_t WS_END = 502 * MiB;
static_assert(WS_WEND <= WS_BIG, "weights fit below BIG");

struct Params {
    const float* in[26];
    float* out;
    unsigned char* ws;
};

__device__ __forceinline__ float bf2f(unsigned short u) { return __uint_as_float(((unsigned)u) << 16); }
__device__ __forceinline__ unsigned f2bf(float f) { unsigned u = __float_as_uint(f); return (u + 0x7fffu + ((u >> 16) & 1u)) >> 16; }
typedef __bf16 bf16x2_t __attribute__((ext_vector_type(2)));
__device__ __forceinline__ unsigned pk2(float lo, float hi) { const f32x2 v = {lo, hi}; return __builtin_bit_cast(unsigned, __builtin_convertvector(v, bf16x2_t)); }
__device__ __forceinline__ float wave_sum(float v) {
#pragma unroll
    for (int o = 1; o < 64; o <<= 1) v += __shfl_xor(v, o);
    return v;
}
__device__ __forceinline__ float wave_max(float v) {
#pragma unroll
    for (int o = 1; o < 64; o <<= 1) v = fmaxf(v, __shfl_xor(v, o));
    return v;
}
__device__ __forceinline__ int otid() { int t = threadIdx.x; asm volatile("" : "+v"(t)); return t; }
#define WAVE_LDS_SYNC() asm volatile("s_waitcnt lgkmcnt(0)" ::: "memory")
__device__ __forceinline__ float silu_f(float x) { return x * __builtin_amdgcn_rcpf(1.f + __expf(-x)); }
__device__ __forceinline__ float sigmoid_f(float x) { return __builtin_amdgcn_rcpf(1.f + __expf(-x)); }

typedef int i32x4v __attribute__((ext_vector_type(4)));
typedef int i32x8v __attribute__((ext_vector_type(8)));
__device__ __forceinline__ unsigned pk4_f8(float a, float b, float c, float d) {
    a = __builtin_amdgcn_fmed3f(a, -448.f, 448.f); b = __builtin_amdgcn_fmed3f(b, -448.f, 448.f); c = __builtin_amdgcn_fmed3f(c, -448.f, 448.f); d = __builtin_amdgcn_fmed3f(d, -448.f, 448.f);
    int w = 0;
    w = __builtin_amdgcn_cvt_pk_fp8_f32(a, b, w, false);
    w = __builtin_amdgcn_cvt_pk_fp8_f32(c, d, w, true);
    return (unsigned)w;
}
constexpr float ACT_SC = 8.f, WDN_SC = 256.f, DN_UNSC = 1.f / (ACT_SC * WDN_SC);
constexpr float HQ_Q0 = 127.f / 6.5f, HQ_GU0 = 127.f / 6.5f, HQ_OIN = 127.f / 7.f, HQ_Q1 = 127.f / 8.f, HQ_GU1 = 127.f / 8.f, WQ_GU = 127.f / 0.14f;
__device__ __forceinline__ unsigned pk4_i8(float a, float b, float c, float d, float sc) {
    constexpr float MG = 12582912.f;
    const unsigned ua = __float_as_uint(__builtin_amdgcn_fmed3f(__builtin_fmaf(a, sc, MG), MG - 127.f, MG + 127.f)), ub = __float_as_uint(__builtin_amdgcn_fmed3f(__builtin_fmaf(b, sc, MG), MG - 127.f, MG + 127.f));
    const unsigned uc = __float_as_uint(__builtin_amdgcn_fmed3f(__builtin_fmaf(c, sc, MG), MG - 127.f, MG + 127.f)), ud = __float_as_uint(__builtin_amdgcn_fmed3f(__builtin_fmaf(d, sc, MG), MG - 127.f, MG + 127.f));
    return __builtin_amdgcn_perm(ub, ua, 0x0c0c0400u) | __builtin_amdgcn_perm(ud, uc, 0x04000c0cu);
}
__device__ __forceinline__ int kperm8(int k) { const int r = k & 255; return (k & ~255) + ((r >> 5) & 3) * 64 + ((r >> 3) & 3) * 16 + (r >> 7) * 8 + (r & 7); }
__device__ __forceinline__ f32x4 i2f4(f32x4 v) { const i32x4v t = __builtin_bit_cast(i32x4v, v); return (f32x4){(float)t.x, (float)t.y, (float)t.z, (float)t.w}; }
struct Unit { int pm, pn; };
struct Gemm { const bf16_t* A; const bf16_t* Bt; int M, N, K; };
__device__ __forceinline__ int perm32(int rho) { const int n = rho >> 4, i = rho & 15; return 8 * (i >> 2) + 4 * n + (i & 3); }

__device__ __forceinline__ float row_rstd(const float* ssq, size_t row) {
    const f32x4* p = (const f32x4*)(ssq + row * 16);
    const f32x4 a = p[0], b = p[1], c = p[2], d = p[3];
    const float t = (((a.x + a.y) + (a.z + a.w)) + ((b.x + b.y) + (b.z + b.w))) + (((c.x + c.y) + (c.z + c.w)) + ((d.x + d.y) + (d.z + d.w)));
    return rsqrtf(t * (1.f / 1024.f) + EPS);
}
__device__ __forceinline__ void rows_rstd(const float* ssq, size_t row0, int fq, float (&rs)[2][4]) {
#pragma unroll
    for (int ai = 0; ai < 2; ++ai)
#pragma unroll
        for (int m = 0; m < 4; ++m) { const f32x4 a = *(const f32x4*)(ssq + (row0 + ai * 128 + m * 16) * 16 + 4 * fq); rs[ai][m] = (a.x + a.y) + (a.z + a.w); }
#pragma unroll
    for (int ai = 0; ai < 2; ++ai)
#pragma unroll
        for (int m = 0; m < 4; ++m) { float t = rs[ai][m]; t += __shfl_xor(t, 16); t += __shfl_xor(t, 32); rs[ai][m] = rsqrtf(t * (1.f / 1024.f) + EPS); }
}
template <bool ACC_I8 = false> struct EpiStoreBf16 {
    static constexpr bool PERM = true, AFTER_DRAIN = false;
    bf16_t* O; int ldc; const float* ssq; float dq = 1.f;
    __device__ __forceinline__ void operator()(const f32x4 (&acc)[2][2][4][2], const Unit& u, int wr, int wc, int fr, int fq) const {
        const int row0 = u.pm * 256 + wr * 64 + fr, col0 = u.pn * 256 + wc * 32 + 8 * fq;
        float rsv[2][4]; rows_rstd(ssq, (size_t)row0, fq, rsv);
#pragma unroll
        for (int ai = 0; ai < 2; ++ai)
#pragma unroll
            for (int m = 0; m < 4; ++m) {
                const float rs = ACC_I8 ? rsv[ai][m] * dq : rsv[ai][m];
                bf16_t* rowp = O + (size_t)(row0 + ai * 128 + m * 16) * ldc + col0;
#pragma unroll
                for (int bj = 0; bj < 2; ++bj) {
                    const f32x4 v0 = (ACC_I8 ? i2f4(acc[ai][bj][m][0]) : acc[ai][bj][m][0]) * rs, v1 = (ACC_I8 ? i2f4(acc[ai][bj][m][1]) : acc[ai][bj][m][1]) * rs;
                    u32x4 w; w.x = pk2(v0[0], v0[1]); w.y = pk2(v0[2], v0[3]); w.z = pk2(v1[0], v1[1]); w.w = pk2(v1[2], v1[3]);
                    *(u32x4*)(rowp + bj * 128) = w;
                }
            }
    }
};
struct EpiIn {
    static constexpr bool PERM = true, AFTER_DRAIN = false;
    bf16_t* P; bf16_t* KB; bf16_t* VT; const float* ssq;
    __device__ __forceinline__ void operator()(const f32x4 (&acc)[2][2][4][2], const Unit& u, int wr, int wc, int fr, int fq) const {
        bf16_t* O; int ldc, rt, ct; const bool main_unit = u.pn < TILE_WKV;
        if (main_unit) { O = P; ldc = PW; rt = u.pm - TILE_HN; ct = u.pn; }
        else if (u.pm >= TILE_MEMN) { const int l = (u.pn - TILE_WKV) >> 2; O = KB + (size_t)l * MT * 512; ldc = 512; rt = u.pm - TILE_MEMN; ct = (u.pn - TILE_WKV) & 3; }
        else { const int l = (u.pm - TILE_WKV) >> 2; O = VT + (size_t)l * 512 * MT; ldc = MT; rt = ((u.pm - TILE_WKV) & 3) - 2; ct = u.pn - TILE_MEMN; }
        const int row0 = rt * 256 + wr * 64 + fr, col0 = ct * 256 + wc * 32 + 8 * fq;
        float rsv[2][4];
        if (main_unit) rows_rstd(ssq, (size_t)row0, fq, rsv);
        else {
#pragma unroll
            for (int ai = 0; ai < 2; ++ai)
#pragma unroll
                for (int m = 0; m < 4; ++m) rsv[ai][m] = 1.f; }
#pragma unroll
        for (int ai = 0; ai < 2; ++ai)
#pragma unroll
            for (int m = 0; m < 4; ++m) {
                const float rs = rsv[ai][m];
                bf16_t* rowp = O + (size_t)(row0 + ai * 128 + m * 16) * ldc + col0;
#pragma unroll
                for (int bj = 0; bj < 2; ++bj) {
                    const f32x4 v0 = acc[ai][bj][m][0] * rs, v1 = acc[ai][bj][m][1] * rs;
                    u32x4 w; w.x = pk2(v0[0], v0[1]); w.y = pk2(v0[2], v0[3]); w.z = pk2(v1[0], v1[1]); w.w = pk2(v1[2], v1[3]);
                    *(u32x4*)(rowp + bj * 128) = w;
                }
            }
    }
};
template <bool ACC_I8 = false> struct EpiGeluBf16 {
    static constexpr bool PERM = true, AFTER_DRAIN = false;
    bf16_t* O; int ldc; const float* ssq; float* lnp; float dq = 1.f;
    __device__ __forceinline__ static f32x2 gelu_pk(f32x2 v) {
        const f32x2 av = __builtin_elementwise_abs(v), d = av * 0.2316418882f + 1.0f;
        f32x2 t; t.x = __builtin_amdgcn_rcpf(d.x); t.y = __builtin_amdgcn_rcpf(d.y);
        f32x2 q = t * 0.5307027145f + (-0.7265760135f); q = q * t + 0.7107068705f; q = q * t + (-0.142248368f); q = q * t + 0.127414796f; q = q * t;
        const f32x2 sq = (v * v) * (-0.72134752044f);
        f32x2 e; e.x = __builtin_amdgcn_exp2f(sq.x); e.y = __builtin_amdgcn_exp2f(sq.y);
        const f32x2 mm = v * (q * e), r = v - mm;
        f32x2 o; o.x = v.x < 0.f ? mm.x : r.x; o.y = v.y < 0.f ? mm.y : r.y; return o;
    }
    __device__ __forceinline__ static unsigned g2(float a, float b) { const f32x2 r = gelu_pk((f32x2){a, b}); return pk2(r.x, r.y); }
    __device__ __forceinline__ void operator()(const f32x4 (&acc)[2][2][4][2], const Unit& u, int wr, int wc, int fr, int fq) const {
        const int row0 = u.pm * 256 + wr * 64 + fr, col0 = u.pn * 256 + wc * 32 + 8 * fq;
        float rsv[2][4]; rows_rstd(ssq, (size_t)row0, fq, rsv);
#pragma unroll
        for (int ai = 0; ai < 2; ++ai)
#pragma unroll
            for (int m = 0; m < 4; ++m) {
                const size_t row = (size_t)(row0 + ai * 128 + m * 16);
                const float rs = ACC_I8 ? rsv[ai][m] * dq : rsv[ai][m];
                bf16_t* rowp = O + row * ldc + col0;
                float s1 = 0.f, s2 = 0.f;
#pragma unroll
                for (int bj = 0; bj < 2; ++bj) {
                    const f32x4 v0 = (ACC_I8 ? i2f4(acc[ai][bj][m][0]) : acc[ai][bj][m][0]) * rs, v1 = (ACC_I8 ? i2f4(acc[ai][bj][m][1]) : acc[ai][bj][m][1]) * rs;
                    const f32x2 ga = gelu_pk((f32x2){v0[0], v0[1]}), gb = gelu_pk((f32x2){v0[2], v0[3]}), gc = gelu_pk((f32x2){v1[0], v1[1]}), gd = gelu_pk((f32x2){v1[2], v1[3]});
                    u32x4 w; w.x = pk2(ga.x, ga.y); w.y = pk2(gb.x, gb.y); w.z = pk2(gc.x, gc.y); w.w = pk2(gd.x, gd.y);
                    *(u32x4*)(rowp + bj * 128) = w;
                    s1 += ((ga.x + ga.y) + (gb.x + gb.y)) + ((gc.x + gc.y) + (gd.x + gd.y));
                    s2 += ((ga.x * ga.x + ga.y * ga.y) + (gb.x * gb.x + gb.y * gb.y)) + ((gc.x * gc.x + gc.y * gc.y) + (gd.x * gd.x + gd.y * gd.y));
                }
                if (u.pn >= 4) {
                    s1 += __shfl_xor(s1, 16); s1 += __shfl_xor(s1, 32); s2 += __shfl_xor(s2, 16); s2 += __shfl_xor(s2, 32);
                    if (fq == 0) *(f32x2*)(lnp + (row * 16 + (u.pn - 4) * 4 + wc) * 2) = (f32x2){s1, s2};
                }
            }
    }
};
struct EpiSwigluBf16 {
    static constexpr bool PERM = true, AFTER_DRAIN = false;
    bf16_t* O; int ldc; const float* ssq;
    __device__ __forceinline__ void operator()(const f32x4 (&acc)[2][2][4][2], const Unit& u, int wr, int wc, int fr, int fq) const {
        const int row0 = u.pm * 256 + wr * 64 + fr, col0 = u.pn * 128 + wc * 32 + 8 * fq;
        float rsv[2][4]; rows_rstd(ssq, (size_t)row0, fq, rsv);
#pragma unroll
        for (int ai = 0; ai < 2; ++ai)
#pragma unroll
            for (int m = 0; m < 4; ++m) {
                const float rs = rsv[ai][m];
                bf16_t* rowp = O + (size_t)(row0 + ai * 128 + m * 16) * ldc + col0;
                const f32x4 g0 = acc[ai][0][m][0] * rs, g1 = acc[ai][0][m][1] * rs, u0 = acc[ai][1][m][0] * rs, u1 = acc[ai][1][m][1] * rs;
                u32x4 w;
                w.x = pk2(silu_f(g0[0]) * u0[0], silu_f(g0[1]) * u0[1]); w.y = pk2(silu_f(g0[2]) * u0[2], silu_f(g0[3]) * u0[3]);
                w.z = pk2(silu_f(g1[0]) * u1[0], silu_f(g1[1]) * u1[1]); w.w = pk2(silu_f(g1[2]) * u1[2], silu_f(g1[3]) * u1[3]);
                *(u32x4*)rowp = w;
            }
    }
};
template <bool ACC_I8, bool OUT_F8> struct EpiSwigluQ {
    static constexpr bool PERM = true, AFTER_DRAIN = false;
    void* O; int ldc; const float* ssq; float dq;
    __device__ __forceinline__ void operator()(const f32x4 (&acc)[2][2][4][2], const Unit& u, int wr, int wc, int fr, int fq) const {
        const int row0 = u.pm * 256 + wr * 64 + fr, col0 = u.pn * 128 + wc * 32 + 8 * fq;
        float rsv[2][4]; rows_rstd(ssq, (size_t)row0, fq, rsv);
#pragma unroll
        for (int ai = 0; ai < 2; ++ai)
#pragma unroll
            for (int m = 0; m < 4; ++m) {
                const float rs = ACC_I8 ? rsv[ai][m] * dq : rsv[ai][m], rsu = OUT_F8 ? rs * ACT_SC : rs;
                f32x4 g0 = acc[ai][0][m][0], g1 = acc[ai][0][m][1], u0 = acc[ai][1][m][0], u1 = acc[ai][1][m][1];
                if (ACC_I8) { g0 = i2f4(g0); g1 = i2f4(g1); u0 = i2f4(u0); u1 = i2f4(u1); }
                g0 = g0 * rs; g1 = g1 * rs; u0 = u0 * rsu; u1 = u1 * rsu;
                if (OUT_F8) {
                    unsigned char* rowp = (unsigned char*)O + (size_t)(row0 + ai * 128 + m * 16) * ldc + col0;
                    u32x2 w;
                    w.x = pk4_f8(silu_f(g0[0]) * u0[0], silu_f(g0[1]) * u0[1], silu_f(g0[2]) * u0[2], silu_f(g0[3]) * u0[3]);
                    w.y = pk4_f8(silu_f(g1[0]) * u1[0], silu_f(g1[1]) * u1[1], silu_f(g1[2]) * u1[2], silu_f(g1[3]) * u1[3]);
                    *(u32x2*)rowp = w;
                } else {
                    bf16_t* rowp = (bf16_t*)O + (size_t)(row0 + ai * 128 + m * 16) * ldc + col0;
                    u32x4 w;
                    w.x = pk2(silu_f(g0[0]) * u0[0], silu_f(g0[1]) * u0[1]); w.y = pk2(silu_f(g0[2]) * u0[2], silu_f(g0[3]) * u0[3]);
                    w.z = pk2(silu_f(g1[0]) * u1[0], silu_f(g1[1]) * u1[1]); w.w = pk2(silu_f(g1[2]) * u1[2], silu_f(g1[3]) * u1[3]);
                    *(u32x4*)rowp = w;
                }
            }
    }
};
template <bool BASE_F32, bool SCALED = false, bool W8 = false> struct EpiResid {
    static constexpr bool PERM = true, AFTER_DRAIN = false;
    const float* xbase; bf16_t* H; float* ssq; unsigned char* H8 = nullptr; float hq = 0.f;
    __device__ __forceinline__ void operator()(const f32x4 (&acc)[2][2][4][2], const Unit& u, int wr, int wc, int fr, int fq) const {
        const int row0 = u.pm * 256 + wr * 64 + fr, col0 = u.pn * 256 + wc * 32 + 8 * fq;
#pragma unroll
        for (int ai = 0; ai < 2; ++ai)
#pragma unroll
            for (int m = 0; m < 4; ++m) {
                const size_t row = (size_t)(row0 + ai * 128 + m * 16);
                float ss = 0.f; u32x4 q8 = (u32x4){0u, 0u, 0u, 0u};
#pragma unroll
                for (int bj = 0; bj < 2; ++bj) {
                    const size_t off = row * 1024 + col0 + bj * 128;
                    f32x4 b0, b1;
                    if (BASE_F32) { b0 = *(const f32x4*)(xbase + off); b1 = *(const f32x4*)(xbase + off + 4); }
                    else { const u32x4 hw = *(const u32x4*)(H + off);
                        b0 = (f32x4){bf2f((unsigned short)(hw.x & 0xffffu)), bf2f((unsigned short)(hw.x >> 16)), bf2f((unsigned short)(hw.y & 0xffffu)), bf2f((unsigned short)(hw.y >> 16))};
                        b1 = (f32x4){bf2f((unsigned short)(hw.z & 0xffffu)), bf2f((unsigned short)(hw.z >> 16)), bf2f((unsigned short)(hw.w & 0xffffu)), bf2f((unsigned short)(hw.w >> 16))}; }
                    const float sc = SCALED ? DN_UNSC : 1.f;
                    const f32x4 v0 = b0 + acc[ai][bj][m][0] * sc, v1 = b1 + acc[ai][bj][m][1] * sc;
                    u32x4 w; w.x = pk2(v0[0], v0[1]); w.y = pk2(v0[2], v0[3]); w.z = pk2(v1[0], v1[1]); w.w = pk2(v1[2], v1[3]);
                    *(u32x4*)(H + off) = w;
                    if (W8) { q8[2 * bj] = pk4_i8(v0[0], v0[1], v0[2], v0[3], hq); q8[2 * bj + 1] = pk4_i8(v1[0], v1[1], v1[2], v1[3], hq); }
                    ss += ((v0[0] * v0[0] + v0[1] * v0[1]) + (v0[2] * v0[2] + v0[3] * v0[3])) + ((v1[0] * v1[0] + v1[1] * v1[1]) + (v1[2] * v1[2] + v1[3] * v1[3]));
                }
                if (W8) *(u32x4*)(H8 + row * 1024 + u.pn * 256 + wc * 64 + fq * 16) = q8;
                ss += __shfl_xor(ss, 16); ss += __shfl_xor(ss, 32);
                if (fq == 0) ssq[row * 16 + u.pn * 4 + wc] = ss;
            }
    }
};
namespace pg8 {
#define PG8_LAS __attribute__((address_space(3)))
constexpr int BM = 256, BK = 64, HALF = 128, HTB = HALF * BK * 2  , STAGE_BYTES = 8 * HTB, NXCD = 8, WGM = 8;
__host__ __device__ __forceinline__ int lds_byte(int r, int c) { const int st = (r >> 4) * 2 + (c >> 5), rr = r & 15, cc = c & 31, ob = rr * 64 + cc * 2; return st * 1024 + (ob ^ (((ob >> 9) & 1) << 5)); }
__host__ __device__ __forceinline__ void stage_rc(int b, int& R, int& C) { const int st = b / 1024, sb = b % 1024, swz = sb ^ (((sb >> 9) & 1) << 5); R = (st >> 1) * 16 + swz / 64; C = (st & 1) * 32 + (swz % 64) / 2; }
struct StaticOrder {
    int nM, nN, nwg, G, c;
    __host__ __device__ void init(int M, int N, int G_, int c_) { nM = M / BM; nN = N / BM; nwg = nM * nN; G = G_; c = c_; }
    __host__ __device__ bool next(int i, Unit& u) const {
        const long L = (long)i * G + c; if (L >= nwg) return false;
        int wgid = (int)L; { const int q = nwg / NXCD, r = nwg % NXCD, xcd = wgid % NXCD, off = wgid / NXCD; wgid = (xcd < r ? xcd * (q + 1) : r * (q + 1) + (xcd - r) * q) + off; }
        const int nig = WGM * nN, gid = wgid / nig, fm = gid * WGM, gsz = (nM - fm) < WGM ? (nM - fm) : WGM;
        u.pm = fm + ((wgid % nig) % gsz); u.pn = (wgid % nig) / gsz; return true;
    }
    __device__ __forceinline__ void a_ready(const Unit&) const {}
    __device__ __forceinline__ void done(const Unit&) const {}
};
struct ComboOrder {
    StaticOrder so;
    __host__ __device__ void init(int G_, int c_) { so.init(T, PW, G_, c_); }
    __host__ __device__ bool next(int i, Unit& u) const {
        const long L = (long)i * so.G + so.c;
        if (L < so.nwg) { so.next(i, u); u.pm += TILE_HN; return true; }
        const int j = (int)(L - so.nwg); if (j >= 128) return false;
        const int l = j >> 6, jj = j & 63;
        if (jj < 32) { u.pm = TILE_MEMN + (jj >> 1); u.pn = TILE_WKV + 4 * l + (jj & 1); }
        else { const int q = jj - 32; u.pm = TILE_WKV + 4 * l + 2 + (q >> 4); u.pn = TILE_MEMN + (q & 15); }
        return true;
    }
    __device__ __forceinline__ void a_ready(const Unit&) const {}
    __device__ __forceinline__ void done(const Unit&) const {}
};
template <class Epi, class Sched, bool ALIGN_EPI = false, bool SP2 = false, int QM = 0  >
__device__ __forceinline__ void gemm_phase(PG8_LAS unsigned char* lds, const Gemm g, const Sched& S, const Epi& E) {
    const int tid = otid(), wid = __builtin_amdgcn_readfirstlane(tid >> 6), lane = tid & 63, wr = wid >> 2, wc = wid & 3, fr = lane & 15, fq = lane >> 4;
    constexpr bool FP8 = (QM == 1), I8 = (QM == 2);
    const int K = g.K, nt = K / BK;
    unsigned voffA[2], voffB[2];
#pragma unroll
    for (int i = 0; i < 2; ++i) { int R, C; stage_rc(tid * 16 + i * 8192, R, C); const int Rb = Epi::PERM ? ((R & ~31) + perm32(R & 31)) : R;
        voffA[i] = (unsigned)(R * K + C) * 2u; voffB[i] = (unsigned)(Rb * K + C) * 2u; }
    const size_t kstep = (size_t)(BK * 2);
    const size_t hstep = (size_t)HALF * K * 2;
    const size_t tstep = 2 * hstep;
    const unsigned ldsw = (unsigned)wid * 1024u;
    const int aoff = lds_byte(wr * 64 + fr, fq * 8), boff = lds_byte(wc * 32 + fr, fq * 8);
#define PG8_SA(b, h) (((b) * 2 + (h)) * HTB)
#define PG8_SB(b, h) ((4 + (b) * 2 + (h)) * HTB)
#define PG8_STAGE(bufoff, gbase, voff) do { _Pragma("unroll") for (int _i = 0; _i < 2; ++_i) \
        __builtin_amdgcn_global_load_lds((const unsigned*)((const char*)(gbase) + (voff)[_i]), (PG8_LAS unsigned*)(lds + (bufoff) + ldsw + _i * 8192), 16, 0, 0); } while (0)
#define PG8_LD16(off) (*(const PG8_LAS bf16x8*)(lds + (off)))
#define PG8_LDA(dst, b, h) do { _Pragma("unroll") for (int m = 0; m < 4; ++m) { \
        if constexpr (FP8) dst##8[m] = PG8_CAT(PG8_LD16(PG8_SA(b, h) + aoff + m * 2048), PG8_LD16(PG8_SA(b, h) + aoff + m * 2048 + 1024)); \
        else { _Pragma("unroll") for (int k = 0; k < 2; ++k) dst[m][k] = PG8_LD16(PG8_SA(b, h) + aoff + m * 2048 + k * 1024); } } } while (0)
#define PG8_LDB(dst, b, h) do { _Pragma("unroll") for (int n = 0; n < 2; ++n) { \
        if constexpr (FP8) dst##8[n] = PG8_CAT(PG8_LD16(PG8_SB(b, h) + boff + n * 2048), PG8_LD16(PG8_SB(b, h) + boff + n * 2048 + 1024)); \
        else { _Pragma("unroll") for (int k = 0; k < 2; ++k) dst[n][k] = PG8_LD16(PG8_SB(b, h) + boff + n * 2048 + k * 1024); } } } while (0)
#define PG8_CAT(x, y) __builtin_shufflevector(__builtin_bit_cast(i32x4v, x), __builtin_bit_cast(i32x4v, y), 0, 1, 2, 3, 4, 5, 6, 7)
#define PG8_MMA(ai, bj, At, Bt) do { __builtin_amdgcn_s_setprio(1); \
        if constexpr (FP8) { _Pragma("unroll") for (int m = 0; m < 4; ++m) _Pragma("unroll") for (int n = 0; n < 2; ++n) \
            asm("v_mfma_f32_16x16x128_f8f6f4 %0, %1, %2, %0" : "+v"(acc[ai][bj][m][n]) : "v"(Bt##8[n]), "v"(At##8[m])); } \
        else if constexpr (I8) { _Pragma("unroll") for (int m = 0; m < 4; ++m) _Pragma("unroll") for (int n = 0; n < 2; ++n) _Pragma("unroll") for (int k = 0; k < 2; ++k) \
            acc[ai][bj][m][n] = __builtin_bit_cast(f32x4, __builtin_amdgcn_mfma_i32_16x16x64_i8(__builtin_bit_cast(i32x4v, Bt[n][k]), __builtin_bit_cast(i32x4v, At[m][k]), __builtin_bit_cast(i32x4v, acc[ai][bj][m][n]), 0, 0, 0)); } \
        else { _Pragma("unroll") for (int m = 0; m < 4; ++m) _Pragma("unroll") for (int n = 0; n < 2; ++n) _Pragma("unroll") for (int k = 0; k < 2; ++k) \
            acc[ai][bj][m][n] = __builtin_amdgcn_mfma_f32_16x16x32_bf16(Bt[n][k], At[m][k], acc[ai][bj][m][n], 0, 0, 0); } \
        __builtin_amdgcn_s_setprio(0); } while (0)
#define PG8_WAIT_V(n) asm volatile("s_waitcnt vmcnt(" #n ")" ::: "memory")
#define PG8_WAIT_L(n) asm volatile("s_waitcnt lgkmcnt(" #n ")" ::: "memory")
#define PG8_BAR __builtin_amdgcn_s_barrier()
#define PG8_SCHED __builtin_amdgcn_sched_barrier(0)
    Unit cur, nxt; int ui = 0;
    if (!S.next(0, cur)) return;
    f32x4 acc[2][2][4][2];
#pragma unroll
    for (int a = 0; a < 2; ++a)
#pragma unroll
        for (int b = 0; b < 2; ++b)
#pragma unroll
            for (int m = 0; m < 4; ++m)
#pragma unroll
                for (int n = 0; n < 2; ++n) acc[a][b][m][n] = (f32x4){0.f, 0.f, 0.f, 0.f};
    bf16x8 At[4][2], B0[2][2], B1[2][2];
    i32x8v At8[4], B08[2], B18[2];
    const char* cA = (const char*)g.A + (size_t)cur.pm * tstep; const char* cB = (const char*)g.Bt + (size_t)cur.pn * tstep;
    S.a_ready(cur);
    if constexpr (SP2) {
        PG8_STAGE(PG8_SB(0, 0), cB, voffB); PG8_STAGE(PG8_SB(0, 1), cB + hstep, voffB); PG8_STAGE(PG8_SA(0, 0), cA, voffA); PG8_STAGE(PG8_SA(0, 1), cA + hstep, voffA);
        if (wr == 1) PG8_BAR;
        PG8_WAIT_V(2); PG8_BAR;
        PG8_STAGE(PG8_SB(1, 0), cB + kstep, voffB); PG8_STAGE(PG8_SA(1, 0), cA + kstep, voffA); PG8_STAGE(PG8_SB(1, 1), cB + hstep + kstep, voffB);
        PG8_WAIT_V(6); PG8_BAR;
    } else {
        PG8_STAGE(PG8_SB(0, 0), cB, voffB); PG8_STAGE(PG8_SA(0, 0), cA, voffA); PG8_STAGE(PG8_SB(0, 1), cB + hstep, voffB); PG8_STAGE(PG8_SA(0, 1), cA + hstep, voffA);
        if (wr == 1) PG8_BAR;
        PG8_WAIT_V(4); PG8_BAR;
        PG8_STAGE(PG8_SB(1, 0), cB + kstep, voffB); PG8_STAGE(PG8_SA(1, 0), cA + kstep, voffA); PG8_STAGE(PG8_SB(1, 1), cB + hstep + kstep, voffB);
        PG8_WAIT_V(6); PG8_BAR;
    }
    for (;;) {
        const bool has_next = S.next(ui + 1, nxt);
        const char* nA = has_next ? (const char*)g.A + (size_t)nxt.pm * tstep : cA; const char* nB = has_next ? (const char*)g.Bt + (size_t)nxt.pn * tstep : cB;
        for (int t = 0; t < nt; t += 2) {
            const bool last = (t == nt - 2);
            if constexpr (FP8) __builtin_amdgcn_s_waitcnt(0xC07F);
            const char* a1 = cA + (size_t)(t + 1) * kstep;
            const char* a2 = last ? nA : cA + (size_t)(t + 2) * kstep; const char* b2 = last ? nB : cB + (size_t)(t + 2) * kstep;
            const char* a3 = a2 + kstep; const char* b3 = b2 + kstep;
            if (last && has_next) S.a_ready(nxt);
            if constexpr (SP2) {
            PG8_LDB(B0, 0, 0); PG8_LDB(B1, 0, 1); PG8_SCHED; PG8_LDA(At, 0, 0); PG8_STAGE(PG8_SA(1, 1), a1 + hstep, voffA);
            PG8_WAIT_V(8); PG8_WAIT_L(0); PG8_BAR; PG8_MMA(0, 0, At, B0); PG8_MMA(0, 1, At, B1); PG8_BAR; PG8_SCHED;
            PG8_LDA(At, 0, 1); PG8_STAGE(PG8_SB(0, 0), b2, voffB); PG8_STAGE(PG8_SB(0, 1), b2 + hstep, voffB); PG8_STAGE(PG8_SA(0, 0), a2, voffA);
            PG8_WAIT_V(8); PG8_WAIT_L(0); PG8_BAR; PG8_MMA(1, 0, At, B0); PG8_MMA(1, 1, At, B1); PG8_BAR; PG8_SCHED;
            PG8_LDB(B0, 1, 0); PG8_LDB(B1, 1, 1); PG8_SCHED; PG8_LDA(At, 1, 0); PG8_STAGE(PG8_SA(0, 1), a2 + hstep, voffA);
            PG8_WAIT_V(8); PG8_WAIT_L(0); PG8_BAR; PG8_MMA(0, 0, At, B0); PG8_MMA(0, 1, At, B1); PG8_BAR; PG8_SCHED;
            PG8_LDA(At, 1, 1); PG8_STAGE(PG8_SB(1, 0), b3, voffB); PG8_STAGE(PG8_SB(1, 1), b3 + hstep, voffB); PG8_STAGE(PG8_SA(1, 0), a3, voffA);
            PG8_WAIT_V(8); PG8_WAIT_L(0); PG8_BAR; PG8_MMA(1, 0, At, B0); PG8_MMA(1, 1, At, B1); PG8_BAR; PG8_SCHED;
            } else {
            PG8_LDB(B0, 0, 0); PG8_SCHED; PG8_LDA(At, 0, 0); PG8_STAGE(PG8_SA(1, 1), a1 + hstep, voffA);
            PG8_WAIT_L(8); PG8_BAR; PG8_WAIT_L(0); PG8_MMA(0, 0, At, B0); PG8_BAR; PG8_SCHED;
            PG8_LDB(B1, 0, 1); PG8_STAGE(PG8_SB(0, 0), b2, voffB);
            PG8_BAR; PG8_WAIT_L(0); PG8_MMA(0, 1, At, B1); PG8_BAR;
            PG8_LDA(At, 0, 1); PG8_STAGE(PG8_SA(0, 0), a2, voffA);
            PG8_BAR; PG8_WAIT_L(0); PG8_MMA(1, 0, At, B0); PG8_BAR; PG8_SCHED;
            PG8_STAGE(PG8_SB(0, 1), b2 + hstep, voffB);
            PG8_WAIT_V(6); PG8_BAR; PG8_MMA(1, 1, At, B1); PG8_BAR;
            PG8_LDB(B0, 1, 0); PG8_SCHED; PG8_LDA(At, 1, 0); PG8_STAGE(PG8_SA(0, 1), a2 + hstep, voffA);
            PG8_WAIT_L(8); PG8_BAR; PG8_WAIT_L(0); PG8_MMA(0, 0, At, B0); PG8_BAR; PG8_SCHED;
            PG8_LDB(B1, 1, 1); PG8_STAGE(PG8_SB(1, 0), b3, voffB);
            PG8_BAR; PG8_WAIT_L(0); PG8_MMA(0, 1, At, B1); PG8_BAR;
            PG8_LDA(At, 1, 1); PG8_STAGE(PG8_SA(1, 0), a3, voffA);
            PG8_BAR; PG8_WAIT_L(0); PG8_MMA(1, 0, At, B0); PG8_BAR; PG8_SCHED;
            PG8_STAGE(PG8_SB(1, 1), b3 + hstep, voffB);
            PG8_WAIT_V(6); PG8_BAR; PG8_MMA(1, 1, At, B1); PG8_BAR;
            }
        }
        if constexpr (FP8) asm volatile("s_nop 15\n\ts_nop 15" ::: "memory");
        if constexpr (ALIGN_EPI) { if (wr == 0) PG8_BAR; }
        if constexpr (!Epi::AFTER_DRAIN) { E(acc, cur, wr, wc, fr, fq); S.done(cur); }
        if (!has_next) break;
#pragma unroll
        for (int a = 0; a < 2; ++a)
#pragma unroll
            for (int b = 0; b < 2; ++b)
#pragma unroll
                for (int m = 0; m < 4; ++m)
#pragma unroll
                    for (int n = 0; n < 2; ++n) acc[a][b][m][n] = (f32x4){0.f, 0.f, 0.f, 0.f};
        cur = nxt; cA = nA; cB = nB; ++ui;
        if constexpr (ALIGN_EPI) { if (wr == 1) PG8_BAR; }
    }
    PG8_WAIT_V(0);
    if constexpr (!ALIGN_EPI) { if (wr == 0) PG8_BAR; }
    PG8_BAR;
    if constexpr (Epi::AFTER_DRAIN) { E.fused(acc, cur, wr, wc, fr, fq, lds, wid, lane); S.done(cur); }
#undef PG8_SA
#undef PG8_SB
#undef PG8_STAGE
#undef PG8_LDA
#undef PG8_LD16
#undef PG8_LDB
#undef PG8_MMA
#undef PG8_CAT
#undef PG8_WAIT_V
#undef PG8_WAIT_L
#undef PG8_BAR
#undef PG8_SCHED
}
}

template <class Epi, int QM = 0>
__device__ __forceinline__ void run_gemm(const Gemm g, const Epi& E, LAS float* lds, int vb, int nvb) {
    pg8::StaticOrder S; S.init(g.M, g.N, nvb, vb);
    pg8::gemm_phase<Epi, pg8::StaticOrder, true, true, QM>((LAS unsigned char*)lds, g, S, E);
}

enum { MAP_ID = 0, MAP_WIN = 1, MAP_GU = 2 };
struct PrepJob { const float* W; int K, N; const float* gain; bf16_t* dst; int r0, r1, ldd, koff, map; int fmt; float osc; };
__device__ __forceinline__ int map_src(int map, int r, int N) {
    if (map == MAP_ID) return r < N ? r : -1;
    if (map == MAP_WIN) {
        if (r < 1728) return r - 512;
        if (r < 3776) return r - 504;
        if (r < 3784) return r - 2560;
        return -1;
    }
    { const int tile = r >> 8, w = r & 255, j = tile * 128 + (w & 127); return w < 128 ? j : FF + j; }
}
__device__ __forceinline__ void prep_tile_load(const PrepJob& j, int t, f32x4 (&v)[8]) {
    const int nkt = j.K / 64, kt = t % nkt, rt = t / nkt, k0 = kt * 64, r0 = j.r0 + rt * 256;
#pragma unroll
    for (int q = 0; q < 8; ++q) {
        const int i = (int)threadIdx.x + q * NTHREADS, kk = i >> 6, r4 = (i & 63) * 4;
        const int sc = map_src(j.map, r0 + r4, j.N);
        v[q] = sc >= 0 ? __builtin_nontemporal_load((const f32x4*)(j.W + (size_t)(k0 + kk) * j.N + sc)) : (f32x4){0.f, 0.f, 0.f, 0.f};
        if (j.gain) v[q] = v[q] * j.gain[k0 + kk];
    }
}
__device__ __forceinline__ void prep_tile_store(const PrepJob& j, int t, const f32x4 (&v)[8], LAS float* tile  ) {
    const int nkt = j.K / 64, kt = t % nkt, rt = t / nkt, k0 = kt * 64, r0 = j.r0 + rt * 256;
    __syncthreads();
#pragma unroll
    for (int q = 0; q < 8; ++q) { const int i = (int)threadIdx.x + q * NTHREADS, kk = i >> 6, r4 = (i & 63) * 4; *(LAS f32x4*)(tile + kk * 260 + r4) = v[q]; }
    __syncthreads();
#pragma unroll
    for (int q = 0; q < 4; ++q) {
        const int i = (int)threadIdx.x + q * NTHREADS, rr = i & 255, c8 = i >> 8;
        const LAS float* tp = tile + (c8 * 8) * 260 + rr;
        if (j.fmt != 0) {
            const float sc = j.osc; u32x2 w;
            if (j.fmt == 1) { w.x = pk4_f8(tp[0] * sc, tp[260] * sc, tp[520] * sc, tp[780] * sc); w.y = pk4_f8(tp[1040] * sc, tp[1300] * sc, tp[1560] * sc, tp[1820] * sc); }
            else { w.x = pk4_i8(tp[0], tp[260], tp[520], tp[780], sc); w.y = pk4_i8(tp[1040], tp[1300], tp[1560], tp[1820], sc); }
            *(u32x2*)((unsigned char*)j.dst + (size_t)(r0 + rr) * j.ldd + j.koff + (j.fmt == 2 ? kperm8(k0 + c8 * 8) : k0 + c8 * 8)) = w;
        } else {
        u32x4 w; w.x = pk2(tp[0], tp[260]); w.y = pk2(tp[520], tp[780]); w.z = pk2(tp[1040], tp[1300]); w.w = pk2(tp[1560], tp[1820]);
        *(u32x4*)(j.dst + (size_t)(r0 + rr) * j.ldd + j.koff + k0 + c8 * 8) = w;
        }
    }
}
__device__ __forceinline__ void prep_fold_in(const float* w_in  , const float* w_uk  , const float* gain, bf16_t* dst, LAS float* lds, int vb, int nvb) {
    LAS float* A = lds; LAS float* B = lds + 32 * 65;
    const int tid = otid(), lane = tid & 63, wid = __builtin_amdgcn_readfirstlane(tid >> 6), l15 = lane & 15, dq = lane >> 4;
    for (int item = vb; item < 256; item += nvb) {
        const int h = item >> 5, k0 = (item & 31) * 32;
        __syncthreads();
        for (int i = tid; i < 2048; i += NTHREADS) { const int kk = i >> 6, d = i & 63; A[kk * 65 + d] = w_in[(size_t)(k0 + kk) * 3272 + h * 64 + d] * gain[k0 + kk]; }
        for (int i = tid; i < 8192; i += NTHREADS) { const int c = i >> 6, d = i & 63; B[c * 65 + d] = w_uk[(size_t)(h * 128 + c) * 64 + d]; }
        __syncthreads();
        f32x4 acc0 = (f32x4){0.f, 0.f, 0.f, 0.f}, acc1 = acc0;
#pragma unroll 4
        for (int d0 = 0; d0 < 64; d0 += 4) {
            const float b = B[(16 * wid + l15) * 65 + d0 + dq], a0 = A[l15 * 65 + d0 + dq], a1 = A[(16 + l15) * 65 + d0 + dq];
            acc0 = __builtin_amdgcn_mfma_f32_16x16x4f32(a0, b, acc0, 0, 0, 0);
            acc1 = __builtin_amdgcn_mfma_f32_16x16x4f32(a1, b, acc1, 0, 0, 0);
        }
        bf16_t* drow = dst + (size_t)(h * 128 + 16 * wid + l15) * 1024 + k0 + 4 * dq;
        { u32x2 w; w.x = pk2(acc0[0], acc0[1]); w.y = pk2(acc0[2], acc0[3]); *(u32x2*)drow = w; }
        { u32x2 w; w.x = pk2(acc1[0], acc1[1]); w.y = pk2(acc1[2], acc1[3]); *(u32x2*)(drow + 16) = w; }
    }
}
__device__ __forceinline__ void prep_fold_out(const float* w_out  , const float* w_uv  , bf16_t* dst  , LAS float* lds, int vb, int nvb) {
    LAS float* A = lds; LAS float* B = lds + 64 * 33;
    const int tid = otid(), lane = tid & 63, wid = __builtin_amdgcn_readfirstlane(tid >> 6), l15 = lane & 15, dq = lane >> 4;
    for (int item = vb; item < 256; item += nvb) {
        const int h = item >> 5, n0 = (item & 31) * 32;
        __syncthreads();
        for (int i = tid; i < 2048; i += NTHREADS) { const int d = i >> 5, nn = i & 31; A[d * 33 + nn] = w_out[(size_t)(h * 64 + d) * 1024 + n0 + nn]; }
        for (int i = tid; i < 8192; i += NTHREADS) { const int c = i >> 6, d = i & 63; B[c * 65 + d] = w_uv[(size_t)(h * 128 + c) * 64 + d]; }
        __syncthreads();
        f32x4 acc0 = (f32x4){0.f, 0.f, 0.f, 0.f}, acc1 = acc0;
#pragma unroll 4
        for (int d0 = 0; d0 < 64; d0 += 4) {
            const float a = B[(16 * wid + l15) * 65 + d0 + dq], b0 = A[(d0 + dq) * 33 + l15], b1 = A[(d0 + dq) * 33 + 16 + l15];
            acc0 = __builtin_amdgcn_mfma_f32_16x16x4f32(a, b0, acc0, 0, 0, 0);
            acc1 = __builtin_amdgcn_mfma_f32_16x16x4f32(a, b1, acc1, 0, 0, 0);
        }
        { u32x2 w; w.x = pk2(acc0[0], acc0[1]); w.y = pk2(acc0[2], acc0[3]); *(u32x2*)(dst + (size_t)(n0 + l15) * KOUT + h * 128 + 16 * wid + 4 * dq) = w; }
        { u32x2 w; w.x = pk2(acc1[0], acc1[1]); w.y = pk2(acc1[2], acc1[3]); *(u32x2*)(dst + (size_t)(n0 + 16 + l15) * KOUT + h * 128 + 16 * wid + 4 * dq) = w; }
    }
}
__device__ __forceinline__ void prep_lb(const float* hgrn_lb  , float* lb, int vb, int nvb) {
    for (int i = vb * NTHREADS + threadIdx.x; i < 512; i += nvb * NTHREADS) {
        const float a = hgrn_lb[i], b = hgrn_lb[512 + i], c = hgrn_lb[1024 + i], m = fmaxf(a, fmaxf(b, c));
        const float ea = __expf(a - m), eb = __expf(b - m), ec = __expf(c - m);
        lb[i] = ea / (ea + eb + ec);
    }
}

__device__ __forceinline__ void rmsnorm_rows(const float* X, bf16_t* Y, int nrows, int vb, int nvb) {
    const int tid = otid(), lane = tid & 63, gw = vb * NWAVES + __builtin_amdgcn_readfirstlane(tid >> 6), ngw = nvb * NWAVES;
    for (int r = gw; r < nrows; r += ngw) {
        const f32x4* xr = (const f32x4*)(X + (size_t)r * D) + lane;
        f32x4 v[4]; float s = 0.f;
#pragma unroll
        for (int j = 0; j < 4; ++j) { v[j] = xr[64 * j]; s += (v[j].x * v[j].x + v[j].y * v[j].y) + (v[j].z * v[j].z + v[j].w * v[j].w); }
        const float rs = rsqrtf(wave_sum(s) * (1.f / D) + EPS);
        u32x2* o = (u32x2*)(Y + (size_t)r * D) + lane;
#pragma unroll
        for (int j = 0; j < 4; ++j) { u32x2 w; w.x = pk2(v[j].x * rs, v[j].y * rs); w.y = pk2(v[j].z * rs, v[j].w * rs); o[64 * j] = w; }
    }
}
__device__ __forceinline__ void x_to_h_rows(const float* X, bf16_t* H, float* ssq, int vb, int nvb) {
    const int tid = otid(), lane = tid & 63, gw = vb * NWAVES + __builtin_amdgcn_readfirstlane(tid >> 6), ngw = nvb * NWAVES;
    for (int r = gw; r < T; r += 2 * ngw) {
        const int r2 = (r + ngw < T) ? r + ngw : r;
        f32x4 v[2][4];
#pragma unroll
        for (int j = 0; j < 4; ++j) { v[0][j] = __builtin_nontemporal_load((const f32x4*)(X + (size_t)r * D) + lane + 64 * j); v[1][j] = __builtin_nontemporal_load((const f32x4*)(X + (size_t)r2 * D) + lane + 64 * j); }
#pragma unroll
        for (int q = 0; q < 2; ++q) {
            const int rr = q ? r2 : r;
            u32x2* o = (u32x2*)(H + (size_t)rr * D) + lane;
            float s = 0.f;
#pragma unroll
            for (int j = 0; j < 4; ++j) { const f32x4 x = v[q][j]; u32x2 w; w.x = pk2(x.x, x.y); w.y = pk2(x.z, x.w); o[64 * j] = w;
                const float a = bf2f((unsigned short)(w.x & 0xffffu)), b = bf2f((unsigned short)(w.x >> 16)), c = bf2f((unsigned short)(w.y & 0xffffu)), d = bf2f((unsigned short)(w.y >> 16));
                s += (a * a + b * b) + (c * c + d * d); }
            s = wave_sum(s);
            if (lane < 16) ssq[(size_t)rr * 16 + lane] = lane == 0 ? s : 0.f;
        }
    }
}
__device__ __forceinline__ void final_rows(const bf16_t* H, const float* ssq, const float* g, float* out, int vb, int nvb) {
    const int tid = otid(), lane = tid & 63, gw = vb * NWAVES + __builtin_amdgcn_readfirstlane(tid >> 6), ngw = nvb * NWAVES;
    f32x4 gg[4];
#pragma unroll
    for (int j = 0; j < 4; ++j) gg[j] = *((const f32x4*)g + lane + 64 * j);
    for (int r = gw; r < T; r += 2 * ngw) {
        const int r2 = (r + ngw < T) ? r + ngw : r;
        u32x2 w[2][4]; float rs[2];
#pragma unroll
        for (int j = 0; j < 4; ++j) { w[0][j] = ((const u32x2*)(H + (size_t)r * D) + lane)[64 * j]; w[1][j] = ((const u32x2*)(H + (size_t)r2 * D) + lane)[64 * j]; }
        rs[0] = row_rstd(ssq, (size_t)r); rs[1] = row_rstd(ssq, (size_t)r2);
#pragma unroll
        for (int q = 0; q < 2; ++q) {
            f32x4* o = (f32x4*)(out + (size_t)(q ? r2 : r) * D) + lane;
#pragma unroll
            for (int j = 0; j < 4; ++j) { const u32x2 ww = w[q][j];
                __builtin_nontemporal_store((f32x4){bf2f((unsigned short)(ww.x & 0xffffu)) * rs[q] * gg[j].x, bf2f((unsigned short)(ww.x >> 16)) * rs[q] * gg[j].y, bf2f((unsigned short)(ww.y & 0xffffu)) * rs[q] * gg[j].z, bf2f((unsigned short)(ww.y >> 16)) * rs[q] * gg[j].w}, o + 64 * j); }
        }
    }
}
__device__ __forceinline__ float row16_sum(float v) {
    v += __uint_as_float((unsigned)__builtin_amdgcn_update_dpp(0, (int)__float_as_uint(v), 0x128, 0xf, 0xf, false));
    v += __uint_as_float((unsigned)__builtin_amdgcn_update_dpp(0, (int)__float_as_uint(v), 0x124, 0xf, 0xf, false));
    v += __uint_as_float((unsigned)__builtin_amdgcn_update_dpp(0, (int)__float_as_uint(v), 0x122, 0xf, 0xf, false));
    v += __uint_as_float((unsigned)__builtin_amdgcn_update_dpp(0, (int)__float_as_uint(v), 0x121, 0xf, 0xf, false));
    return v;
}
__device__ __forceinline__ void cnorm_rows(const bf16_t* P, const float* lat_g, bf16_t* CN, int vb, int nvb) {
    const int tid = otid(), lane = tid & 63, gw = vb * NWAVES + __builtin_amdgcn_readfirstlane(tid >> 6), ngw = nvb * NWAVES, r4 = lane >> 4, l16 = lane & 15;
    const f32x4 ga = *(const f32x4*)(lat_g + l16 * 8), gb = *(const f32x4*)(lat_g + l16 * 8 + 4);
    for (int r = gw * 8; r < T; r += ngw * 8) {
        u32x4 w[2];
#pragma unroll
        for (int q = 0; q < 2; ++q) w[q] = *(const u32x4*)(P + (size_t)(r + 4 * q + r4) * PW + P_C + l16 * 8);
#pragma unroll
        for (int q = 0; q < 2; ++q) {
            const float x0 = bf2f((unsigned short)(w[q].x & 0xffffu)), x1 = bf2f((unsigned short)(w[q].x >> 16)), x2 = bf2f((unsigned short)(w[q].y & 0xffffu)), x3 = bf2f((unsigned short)(w[q].y >> 16));
            const float x4 = bf2f((unsigned short)(w[q].z & 0xffffu)), x5 = bf2f((unsigned short)(w[q].z >> 16)), x6 = bf2f((unsigned short)(w[q].w & 0xffffu)), x7 = bf2f((unsigned short)(w[q].w >> 16));
            const float ss = row16_sum(((x0 * x0 + x1 * x1) + (x2 * x2 + x3 * x3)) + ((x4 * x4 + x5 * x5) + (x6 * x6 + x7 * x7)));
            const float rs = rsqrtf(ss * (1.f / 128.f) + EPS);
            u32x4 o; o.x = pk2(x0 * rs * ga.x, x1 * rs * ga.y); o.y = pk2(x2 * rs * ga.z, x3 * rs * ga.w); o.z = pk2(x4 * rs * gb.x, x5 * rs * gb.y); o.w = pk2(x6 * rs * gb.z, x7 * rs * gb.w);
            *(u32x4*)(CN + (size_t)(r + 4 * q + r4) * 128 + l16 * 8) = o;
        }
    }
}
__device__ __forceinline__ int t5_bucket(int rel) {
    const int n = rel < 0 ? -rel : rel;
    int b = n < 8 ? n : 8 + (n >= 12) + (n >= 16) + (n >= 23) + (n >= 32) + (n >= 46) + (n >= 64) + (n >= 91);
    return b + (rel > 0 ? 16 : 0);
}
__device__ __forceinline__ unsigned sort_key(float x) { const unsigned u = __float_as_uint(x); return (u & 0x80000000u) ? ~u : (u | 0x80000000u); }


template <int CTRL, int ROWMASK> __device__ __forceinline__ unsigned dpp0(unsigned v) { return (unsigned)__builtin_amdgcn_update_dpp(0, (int)v, CTRL, ROWMASK, 0xf, false); }
__device__ __forceinline__ unsigned wave_prefix_incl(unsigned v) {
    v += dpp0<0x111, 0xf>(v); v += dpp0<0x112, 0xf>(v); v += dpp0<0x114, 0xf>(v); v += dpp0<0x118, 0xf>(v);
    v += dpp0<0x142, 0xa>(v);
    v += dpp0<0x143, 0xc>(v);
    return v;
}
__device__ __forceinline__ float wave_max_u(float v) {
    v = fmaxf(v, __uint_as_float((unsigned)__builtin_amdgcn_update_dpp(0, (int)__float_as_uint(v), 0x128, 0xf, 0xf, false)));
    v = fmaxf(v, __uint_as_float((unsigned)__builtin_amdgcn_update_dpp(0, (int)__float_as_uint(v), 0x124, 0xf, 0xf, false)));
    v = fmaxf(v, __uint_as_float((unsigned)__builtin_amdgcn_update_dpp(0, (int)__float_as_uint(v), 0x122, 0xf, 0xf, false)));
    v = fmaxf(v, __uint_as_float((unsigned)__builtin_amdgcn_update_dpp(0, (int)__float_as_uint(v), 0x121, 0xf, 0xf, false)));
    const int b = (int)__float_as_uint(v);
    return fmaxf(fmaxf(__uint_as_float((unsigned)__builtin_amdgcn_readlane(b, 0)), __uint_as_float((unsigned)__builtin_amdgcn_readlane(b, 16))),
                 fmaxf(__uint_as_float((unsigned)__builtin_amdgcn_readlane(b, 32)), __uint_as_float((unsigned)__builtin_amdgcn_readlane(b, 48))));
}

typedef short v4i16_t __attribute__((ext_vector_type(4)));
constexpr int DSA_BT_OFF = 131072 + 256, DSA_WS_OFF = DSA_BT_OFF + 6144;
__device__ __forceinline__ unsigned dsa_bucket(float x, float lo, float sc) { const float f = (x - lo) * sc; const unsigned b = (unsigned)f; return b > 255u ? 255u : b; }
__device__ __forceinline__ unsigned off_b(unsigned row, unsigned ch) { return 256u * row + 16u * (ch ^ (((row & 3) << 2) | ((row >> 2) & 3))); }
__device__ __forceinline__ void dsa_mfma_phase(const bf16_t* P, const bf16_t* CN, const float* rel_bias, bf16_t* CAT, LAS unsigned char* lds, unsigned* qctr) {
    const int tid = otid(), lane = tid & 63, wid = __builtin_amdgcn_readfirstlane(tid >> 6);
    LAS float* BT = (LAS float*)(lds + DSA_BT_OFF);
    __syncthreads();
    for (int i = tid; i < 191 * 8; i += NTHREADS) { const int rel = (i >> 3) - 127; BT[i] = rel_bias[t5_bucket(rel) * 8 + (i & 7)]; }
    const unsigned long long lt_mask = (lane == 0) ? 0ull : (~0ull >> (64 - lane));
    volatile LAS int* qslot = (volatile LAS int*)(lds + 131072 + 64);
    int nxt = 0;
    if (tid == 0) { *qslot = (int)atomicAdd(qctr, 1u); nxt = (int)atomicAdd(qctr, 1u); }
    for (;;) {
        __syncthreads();
        const int u = *qslot;
        if (u >= T / 16) break;
        const int b = u & 15, qg = 127 - (u >> 4), t0 = qg * 16, nj = t0 / CHUNK + 1, L = nj * CHUNK, nt = L / 32;
        const bf16_t* Pb = P + (size_t)b * SEQ * PW;
        {
            int ln1 = lane; asm volatile("" : "+v"(ln1));
            const int rho = ln1 & 31, hf = ln1 >> 5;
            const int qq = 2 * ((rho >> 2) & 1) + (rho >> 4), hh = 4 * ((rho >> 3) & 1) + (rho & 3);
            bf16x8 qa[4][4], wa[4], wc[4];
#pragma unroll
            for (int qd = 0; qd < 4; ++qd) {
                const bf16_t* qrow = Pb + (size_t)(t0 + 4 * qd + qq) * PW + P_QI + hh * 64 + 8 * hf;
#pragma unroll
                for (int ks = 0; ks < 4; ++ks) qa[qd][ks] = *(const bf16x8*)(qrow + ks * 16);
                wa[qd] = *(const bf16x8*)(Pb + (size_t)(t0 + 4 * qd + 2 * hf) * PW + P_WI); wc[qd] = *(const bf16x8*)(Pb + (size_t)(t0 + 4 * qd + 2 * hf + 1) * PW + P_WI);
            }
            LAS float* sc0 = (LAS float*)lds + (2 * hf) * 2048 + rho;
            const bf16_t* kbase = Pb + (size_t)rho * PW + P_KI + 8 * hf;
            bf16x8 kb[4], kn[4];
#pragma unroll
            for (int ks = 0; ks < 4; ++ks) { kb[ks] = (bf16x8){0, 0, 0, 0, 0, 0, 0, 0}; kn[ks] = kb[ks]; }
            if (wid < nt) {
#pragma unroll
                for (int ks = 0; ks < 4; ++ks) kb[ks] = *(const bf16x8*)(kbase + (size_t)wid * 32 * PW + ks * 16);
            }
            for (int kt = wid; kt < nt; kt += 8) {
                if (kt + 8 < nt) {
#pragma unroll
                    for (int ks = 0; ks < 4; ++ks) kn[ks] = *(const bf16x8*)(kbase + (size_t)(kt + 8) * 32 * PW + ks * 16);
                }
#pragma unroll
                for (int qd = 0; qd < 4; ++qd) {
                    f32x16 acc;
#pragma unroll
                    for (int r = 0; r < 16; ++r) acc[r] = 0.f;
#pragma unroll
                    for (int ks = 0; ks < 4; ++ks) acc = __builtin_amdgcn_mfma_f32_32x32x16_bf16(qa[qd][ks], kb[ks], acc, 0, 0, 0);
                    float s0 = 0.f, s1 = 0.f;
#pragma unroll
                    for (int e = 0; e < 8; ++e) { s0 += bf2f((unsigned short)wa[qd][e]) * fmaxf(acc[e], 0.f); s1 += bf2f((unsigned short)wc[qd][e]) * fmaxf(acc[8 + e], 0.f); }
                    sc0[(4 * qd) * 2048 + kt * 32] = s0 * (0.35355339059327373f * 0.125f); sc0[(4 * qd + 1) * 2048 + kt * 32] = s1 * (0.35355339059327373f * 0.125f);
                }
#pragma unroll
                for (int ks = 0; ks < 4; ++ks) kb[ks] = kn[ks];
            }
        }
        __syncthreads();
        if (tid == 0) { *qslot = nxt; nxt = (int)atomicAdd(qctr, 1u); }
        LAS unsigned char* pair = lds + wid * 16384;
        LAS unsigned char* wsc = lds + DSA_WS_OFF + wid * 2560;
        LAS unsigned* HIST = (LAS unsigned*)wsc; LAS float* CANDV = (LAS float*)(wsc + 1024); LAS unsigned* CANDI = (LAS unsigned*)(wsc + 1280);
        const int nsel = L < 256 ? L : 256;
        int lna = lane; asm volatile("" : "+v"(lna));
#pragma unroll 1
        for (int e2 = 0; e2 < 2; ++e2) {
            LAS unsigned short* IDX = (LAS unsigned short*)(wsc + 1536 + e2 * 512);
            if (nj > 4) {
                const LAS float* SCq = (const LAS float*)(pair + e2 * 8192);
                float x[32];
#pragma unroll
                for (int j = 0; j < 32; ++j) x[j] = (j < nj) ? SCq[j * 64 + lna] : 0.f;
                float lo = INFINITY, hi = -INFINITY;
#pragma unroll
                for (int j = 0; j < 32; ++j) if (j < nj) { hi = fmaxf(hi, x[j]); lo = fminf(lo, x[j]); }
                hi = wave_max_u(hi); lo = -wave_max_u(-lo);
                bool done = false;
                if (hi > lo) {
                    const float sc = 256.f / (hi - lo);
                    *(LAS u32x4*)(HIST + 4 * lna) = (u32x4){0u, 0u, 0u, 0u};
                    WAVE_LDS_SYNC();
#pragma unroll
                    for (int j = 0; j < 32; ++j) if (j < nj) { const unsigned bk = dsa_bucket(x[j], lo, sc); __hip_atomic_fetch_add(HIST + bk, 1u, __ATOMIC_RELAXED, __HIP_MEMORY_SCOPE_WORKGROUP); }
                    WAVE_LDS_SYNC();
                    const u32x4 h4 = *(const LAS u32x4*)(HIST + 4 * lna);
                    const unsigned cl = (h4.x + h4.y) + (h4.z + h4.w);
                    const unsigned pfx = wave_prefix_incl(cl);
                    const unsigned Sx = (unsigned)__builtin_amdgcn_readlane((int)pfx, 63) - pfx + cl;
                    const int lstar = __popcll(__ballot(Sx >= 256u)) - 1;
                    const unsigned above = Sx - cl, t3 = above + h4.w, t2 = t3 + h4.z, t1 = t2 + h4.y;
                    const unsigned bl = t3 >= 256u ? 3u : (t2 >= 256u ? 2u : (t1 >= 256u ? 1u : 0u));
                    const unsigned al = bl == 3u ? above : (bl == 2u ? t3 : (bl == 1u ? t2 : t1));
                    const unsigned ml = bl == 3u ? h4.w : (bl == 2u ? h4.z : (bl == 1u ? h4.y : h4.x));
                    const unsigned bstar = (unsigned)__builtin_amdgcn_readlane((int)(4u * lna + bl), lstar);
                    const int a = __builtin_amdgcn_readlane((int)al, lstar), m = __builtin_amdgcn_readlane((int)ml, lstar);
                    if (m <= 64) {
                        done = true;
                        const int need = 256 - a;
                        unsigned msel = 0u, mcand = 0u;
#pragma unroll
                        for (int j = 31; j >= 0; --j) if (j < nj) { const unsigned bk = dsa_bucket(x[j], lo, sc); msel = msel + msel + (bk > bstar ? 1u : 0u); mcand = mcand + mcand + (bk == bstar ? 1u : 0u); }
                        const unsigned pk = (unsigned)__popc(msel) | ((unsigned)__popc(mcand) << 16);
                        const unsigned inc = wave_prefix_incl(pk);
                        unsigned off = (inc - pk) & 0xffffu, coff = (inc - pk) >> 16;
                        while (msel) { const int j = __ffs((int)msel) - 1; msel &= msel - 1u; IDX[off++] = (unsigned short)(j * 64 + lna); }
                        while (mcand) { const int j = __ffs((int)mcand) - 1; mcand &= mcand - 1u; CANDV[coff] = SCq[j * 64 + lna]; CANDI[coff] = (unsigned)(j * 64 + lna); ++coff; }
                        WAVE_LDS_SYNC();
                        const float cv = CANDV[lna < m ? lna : 0]; const unsigned ci = CANDI[lna < m ? lna : 0];
                        int rank = 0;
                        for (int k = 0; k < m; ++k) { const float v = __uint_as_float((unsigned)__builtin_amdgcn_readlane((int)__float_as_uint(cv), k)); const unsigned id = (unsigned)__builtin_amdgcn_readlane((int)ci, k); rank += (v > cv || (v == cv && id < ci)) ? 1 : 0; }
                        if (lna < m && rank < need) IDX[a + rank] = (unsigned short)ci;
                    }
                }
                if (!done) {
                    unsigned lo_k = 0xffffffffu, hi_k = 0u;
#pragma unroll
                    for (int j = 0; j < 32; ++j) if (j < nj) { const unsigned kx = sort_key(x[j]); hi_k = kx > hi_k ? kx : hi_k; lo_k = kx < lo_k ? kx : lo_k; }
#pragma unroll
                    for (int o = 1; o < 64; o <<= 1) { const unsigned h2 = (unsigned)__shfl_xor((int)hi_k, o), l2 = (unsigned)__shfl_xor((int)lo_k, o); hi_k = h2 > hi_k ? h2 : hi_k; lo_k = l2 < lo_k ? l2 : lo_k; }
                    lo_k = (unsigned)__builtin_amdgcn_readfirstlane((int)lo_k); hi_k = (unsigned)__builtin_amdgcn_readfirstlane((int)hi_k);
                    bool exact = false;
                    while (lo_k < hi_k) {
                        const unsigned mid = lo_k + ((hi_k - lo_k + 1u) >> 1);
                        int cnt = 0;
#pragma unroll
                        for (int j = 0; j < 32; ++j) cnt += __popcll(__ballot(j < nj && sort_key(x[j]) >= mid));
                        if (cnt == 256) { lo_k = mid; exact = true; break; }
                        if (cnt > 256) lo_k = mid; else hi_k = mid - 1u;
                    }
                    const unsigned Tv = lo_k;
                    int need = 0;
                    if (!exact) { int cgt = 0;
#pragma unroll
                        for (int j = 0; j < 32; ++j) cgt += __popcll(__ballot(j < nj && sort_key(x[j]) > Tv));
                        need = 256 - cgt; }
                    int base = 0, eqt = 0;
#pragma unroll
                    for (int j = 0; j < 32; ++j) {
                        const unsigned kx = sort_key(x[j]);
                        const bool gt = (j < nj) && (exact ? (kx >= Tv) : (kx > Tv)), eq = (j < nj) && !exact && (kx == Tv);
                        const unsigned long long meq = __ballot(eq);
                        const bool sel = gt || (eq && (eqt + __popcll(meq & lt_mask)) < need);
                        const unsigned long long ms = __ballot(sel);
                        if (sel) IDX[base + __popcll(ms & lt_mask)] = (unsigned short)(j * 64 + lna);
                        base += __popcll(ms); eqt += __popcll(meq);
                    }
                }
            } else {
#pragma unroll
                for (int i = 0; i < 4; ++i) IDX[i * 64 + lna] = (unsigned short)(i * 64 + lna);
            }
        }
        WAVE_LDS_SYNC();
        {
            int lnb = lane; asm volatile("" : "+v"(lnb));
            const int head = lnb & 15, kg = lnb >> 4, nblk = nsel >> 5;
            LAS unsigned char* GB = pair;
            const bf16_t* CNb = CN + (size_t)b * SEQ * 128;
            const int rho = lnb & 15;
            const unsigned rw0 = 8 * (rho >> 2) + (rho & 3), rw1 = rw0 + 4;
            const unsigned xa0 = ((rw0 & 3) << 2) | ((rw0 >> 2) & 3), xa1 = ((rw1 & 3) << 2) | ((rw1 >> 2) & 3);
            const unsigned q4 = (lnb & 15) >> 2, p4 = lnb & 3;
            u32x4 gA[8], gB[8];
#define DSA_GATHER(G, IX, blk) do { _Pragma("unroll") for (int it = 0; it < 8; ++it) { const int sp = (IX)[(blk) * 32 + (lnb >> 4) + 4 * it]; G[it] = *(const u32x4*)(CNb + (size_t)sp * 128 + (lnb & 15) * 8); } } while (0)
            { const LAS unsigned short* IDX0 = (const LAS unsigned short*)(wsc + 1536); DSA_GATHER(gA, IDX0, 0); DSA_GATHER(gB, IDX0, 1); }
#pragma unroll 1
            for (int e2 = 0; e2 < 2; ++e2) {
                const int t = t0 + 2 * wid + e2;
                const size_t row = (size_t)b * SEQ + t;
                const LAS unsigned short* IDX = (const LAS unsigned short*)(wsc + 1536 + e2 * 512);
                bf16x8 qlf[4];
#pragma unroll
                for (int s4 = 0; s4 < 4; ++s4) { qlf[s4] = *(const bf16x8*)(P + row * PW + P_QL + (head & 7) * 128 + s4 * 32 + 8 * kg); if (head >= 8) qlf[s4] = (bf16x8){0, 0, 0, 0, 0, 0, 0, 0}; }
                f32x4 o[8];
#pragma unroll
                for (int ct = 0; ct < 8; ++ct) o[ct] = (f32x4){0.f, 0.f, 0.f, 0.f};
                float m = -INFINITY, lsum = 0.f;
#define DSA_STEP(G, kbx) do { \
                    WAVE_LDS_SYNC();                              \
                    _Pragma("unroll") for (int it = 0; it < 8; ++it) *(LAS u32x4*)(GB + off_b((lnb >> 4) + 4 * it, lnb & 15)) = G[it]; \
                    const bf16x8 iv = *(const LAS bf16x8*)((const LAS unsigned char*)IDX + ((kbx) * 32 + 8 * kg) * 2);     \
                    if ((kbx) + 2 < nblk) DSA_GATHER(G, IDX, (kbx) + 2); else if (e2 == 0) DSA_GATHER(G, IDX + 256, (kbx) + 2 - nblk); \
                    WAVE_LDS_SYNC(); \
                      \
                    bf16x8 k0[4], k1[4], af[8]; \
                    _Pragma("unroll") for (int s4 = 0; s4 < 4; ++s4) { \
                        k0[s4] = *(const LAS bf16x8*)(GB + 256u * rw0 + 16u * ((4 * s4 + kg) ^ xa0)); \
                        k1[s4] = *(const LAS bf16x8*)(GB + 256u * rw1 + 16u * ((4 * s4 + kg) ^ xa1)); } \
                    float bia[8]; \
                    _Pragma("unroll") for (int e = 0; e < 8; ++e) { const int sp = (int)(unsigned short)iv[e]; int rel = sp - t; rel = rel < -127 ? -127 : rel; bia[e] = BT[(rel + 127) * 8 + (head & 7)]; } \
                      \
                    f32x4 a0 = (f32x4){0.f, 0.f, 0.f, 0.f}, a1 = (f32x4){0.f, 0.f, 0.f, 0.f}; \
                    _Pragma("unroll") for (int s4 = 0; s4 < 4; ++s4) { \
                        a0 = __builtin_amdgcn_mfma_f32_16x16x32_bf16(k0[s4], qlf[s4], a0, 0, 0, 0); \
                        a1 = __builtin_amdgcn_mfma_f32_16x16x32_bf16(k1[s4], qlf[s4], a1, 0, 0, 0); } \
                    asm volatile("" : "+v"(a0), "+v"(a1));        \
                    _Pragma("unroll") for (int ct = 0; ct < 8; ++ct) {              \
                        const v4i16_t lo4 = __builtin_amdgcn_ds_read_tr16_b64_v4i16((LAS v4i16_t*)(GB + off_b(8 * kg + q4, 2 * ct + (p4 >> 1)) + 8 * (p4 & 1))); \
                        const v4i16_t hi4 = __builtin_amdgcn_ds_read_tr16_b64_v4i16((LAS v4i16_t*)(GB + off_b(8 * kg + 4 + q4, 2 * ct + (p4 >> 1)) + 8 * (p4 & 1))); \
                        af[ct] = (bf16x8){lo4[0], lo4[1], lo4[2], lo4[3], hi4[0], hi4[1], hi4[2], hi4[3]}; } \
                      \
                    float lg[8]; \
                    _Pragma("unroll") for (int e = 0; e < 8; ++e) lg[e] = (e < 4 ? a0[e] : a1[e - 4]) * 0.125f + bia[e]; \
                    const float mloc = fmaxf(fmaxf(fmaxf(lg[0], lg[1]), fmaxf(lg[2], lg[3])), fmaxf(fmaxf(lg[4], lg[5]), fmaxf(lg[6], lg[7]))); \
                      \
                    float scl = 1.f; \
                    if (__any(mloc > m + 16.f)) { \
                        float mb = fmaxf(mloc, __shfl_xor(mloc, 16)); mb = fmaxf(mb, __shfl_xor(mb, 32)); \
                        const float mn = fmaxf(m, mb); scl = __expf(m - mn); m = mn; \
                        _Pragma("unroll") for (int ct = 0; ct < 8; ++ct) o[ct] = o[ct] * scl; } \
                    float ps = 0.f; float pe[8]; \
                    _Pragma("unroll") for (int e = 0; e < 8; ++e) { pe[e] = __expf(lg[e] - m); ps += pe[e]; } \
                    lsum = lsum * scl + ps; \
                    u32x4 pw; pw.x = pk2(pe[0], pe[1]); pw.y = pk2(pe[2], pe[3]); pw.z = pk2(pe[4], pe[5]); pw.w = pk2(pe[6], pe[7]); \
                    const bf16x8 pb = __builtin_bit_cast(bf16x8, pw); \
                    _Pragma("unroll") for (int ct = 0; ct < 8; ++ct) o[ct] = __builtin_amdgcn_mfma_f32_16x16x32_bf16(af[ct], pb, o[ct], 0, 0, 0); \
                } while (0)
#pragma unroll 1
                for (int kb2 = 0; kb2 < nblk; kb2 += 2) { DSA_STEP(gA, kb2); DSA_STEP(gB, kb2 + 1); }
#undef DSA_STEP
                lsum += __shfl_xor(lsum, 16); lsum += __shfl_xor(lsum, 32);
                const float inv = 1.f / lsum;
                if (head < 8) {
                    bf16_t* op = CAT + row * KOUT + head * 128 + 4 * kg;
#pragma unroll
                    for (int ct = 0; ct < 8; ++ct) { u32x2 w; w.x = pk2(o[ct][0] * inv, o[ct][1] * inv); w.y = pk2(o[ct][2] * inv, o[ct][3] * inv); *(u32x2*)(op + ct * 16) = w; }
                }
            }
#undef DSA_GATHER
        }
    }
}

constexpr size_t WS_DEC = 492 * MiB;
__device__ __forceinline__ void hgrn_prep(bf16_t* P, const float* lb, float* DEC, LAS unsigned char* lds, int vb, int nvb) {
    const int tid = otid(), cl = tid >> 7, d = tid & 127;
    LAS bf16_t* Ft = (LAS bf16_t*)lds; LAS bf16_t* Qt = (LAS bf16_t*)(lds + 65536);
    for (int it = vb; it < BATCH * 4 * 8; it += nvb) {
        const int b = it >> 5, h = (it >> 3) & 3, cg = it & 7;
        bf16_t* base = P + ((size_t)b * SEQ + cg * 256) * PW + h * 128;
        u32x4 v[16];
#pragma unroll
        for (int k = 0; k < 16; ++k) { const int i = tid + 512 * k, tl = i >> 12, r = (i >> 4) & 255, ch = i & 15; v[k] = *(const u32x4*)(base + (size_t)r * PW + (tl ? P_QB : P_FB) + ch * 8); }
        __syncthreads();
#pragma unroll
        for (int k = 0; k < 16; ++k) { const int i = tid + 512 * k, tl = i >> 12, r = (i >> 4) & 255, ch = i & 15; *(LAS u32x4*)(lds + tl * 65536 + r * 256 + ch * 16) = v[k]; }
        __syncthreads();
        {
            const float l = lb[h * 128 + d];
            LAS bf16_t* fcol = Ft + (cl * 64) * 128 + d; LAS bf16_t* qcol = Qt + (cl * 64) * 128 + d;
            float ref = 0.f;
#pragma unroll 8
            for (int t = 0; t < 32; ++t) ref += __logf(l + (1.f - l) * sigmoid_f(bf2f(fcol[t * 128])));
            float bi = 0.f;
#pragma unroll 8
            for (int t = 0; t < 64; ++t) {
                const float f = l + (1.f - l) * sigmoid_f(bf2f(fcol[t * 128]));
                bi += __logf(f);
                const float q = silu_f(bf2f(qcol[t * 128]));
                qcol[t * 128] = (bf16_t)f2bf(q * __expf(bi - ref));
                fcol[t * 128] = (bf16_t)f2bf((1.f - f) * __expf(ref - bi));
            }
            float* dc = DEC + ((size_t)((b * 4 + h) * 32 + cg * 4 + cl) * 3) * 128 + d;
            dc[0] = __expf(ref); dc[128] = __expf(bi); dc[256] = __expf(bi - ref);
        }
        __syncthreads();
#pragma unroll
        for (int k = 0; k < 16; ++k) { const int i = tid + 512 * k, tl = i >> 12, r = (i >> 4) & 255, ch = i & 15; *(u32x4*)(base + (size_t)r * PW + (tl ? P_QB : P_FB) + ch * 8) = *(const LAS u32x4*)(lds + tl * 65536 + r * 256 + ch * 16); }
    }
}

__device__ __forceinline__ void hgrn_scan(const bf16_t* P, const float* DEC, const float* o_g, bf16_t* CAT, LAS unsigned char* lds, int item) {
    const int tid = otid(), lane = tid & 63, wid = __builtin_amdgcn_readfirstlane(tid >> 6), li = lane & 15, kg = lane >> 4;
    const int b = item >> 2, h = item & 3, it = wid >> 1, vh = wid & 1;
    LAS unsigned char* ST = lds + 98304;
    LAS float* SSQ = (LAS float*)(lds + DSA_BT_OFF);
    const bf16_t* Pb = P + (size_t)b * SEQ * PW;
    const float* DECb = DEC + (size_t)((b * 4 + h) * 32) * 384;
    f32x4 S[8];
#pragma unroll
    for (int vt = 0; vt < 8; ++vt) S[vt] = (f32x4){0.f, 0.f, 0.f, 0.f};
    u32x4 sg[6];
    const int colbase[3] = {P_QB, P_FB, P_IB};
#define HG_LOAD(c) do { _Pragma("unroll") for (int k = 0; k < 6; ++k) { const int n = tid + 512 * k, tl = n >> 10, r = (n >> 4) & 63, ch = n & 15; \
        sg[k] = *(const u32x4*)(Pb + (size_t)((c) * 64 + r) * PW + colbase[tl] + h * 128 + ch * 8); } } while (0)
#define HG_STORE(buf) do { _Pragma("unroll") for (int k = 0; k < 6; ++k) { const int n = tid + 512 * k, tl = n >> 10, r = (n >> 4) & 63, ch = n & 15; \
        *(LAS u32x4*)(lds + (buf) * 49152 + tl * 16384 + off_b(r, ch)) = sg[k]; } } while (0)
    HG_LOAD(0);
    __syncthreads();
    HG_STORE(0);
    const unsigned q4 = (lane & 15) >> 2, p4 = lane & 3;
    f32x4 ogv[4];
#pragma unroll
    for (int vv = 0; vv < 4; ++vv) ogv[vv] = *(const f32x4*)(o_g + 16 * (4 * vh + vv) + 4 * kg);
    float er_next = DECb[16 * wid + li];
#pragma unroll 1
    for (int c = 0; c < 32; ++c) {
        const int buf = c & 1;
        LAS unsigned char* QI = lds + buf * 49152; LAS unsigned char* KI = QI + 16384; LAS unsigned char* VI = QI + 32768;
        if (c + 1 < 32) HG_LOAD(c + 1);
        const float er = er_next, e63 = DECb[c * 384 + 128 + 16 * wid + li], e6r = DECb[c * 384 + 256 + 16 * wid + li];
        er_next = DECb[(c + 1 < 32 ? c + 1 : c) * 384 + 16 * wid + li];
        u32x2 gwv[4];
#pragma unroll
        for (int vv = 0; vv < 4; ++vv) gwv[vv] = *(const u32x2*)(P + ((size_t)b * SEQ + c * 64 + 16 * it + li) * PW + P_GB + h * 128 + 16 * (4 * vh + vv) + 4 * kg);
        { const unsigned d = 16 * wid + li;
#pragma unroll
          for (int vt = 0; vt < 8; ++vt) { u32x2 w; w.x = pk2(S[vt][0] * er, S[vt][1] * er); w.y = pk2(S[vt][2] * er, S[vt][3] * er);
              *(LAS u32x2*)(ST + off_b(d, 2 * vt + (kg >> 1)) + 8 * (kg & 1)) = w; } }
        __syncthreads();
        bf16x8 qf[4];
#pragma unroll
        for (int ks = 0; ks < 4; ++ks) qf[ks] = *(const LAS bf16x8*)(QI + off_b(16 * it + li, 4 * ks + kg));
        f32x4 o[4];
#pragma unroll
        for (int vv = 0; vv < 4; ++vv) o[vv] = (f32x4){0.f, 0.f, 0.f, 0.f};
#pragma unroll
        for (int ks = 0; ks < 4; ++ks)
#pragma unroll
            for (int vv = 0; vv < 4; ++vv) {
                const int ct = 4 * vh + vv;
                const v4i16_t lo4 = __builtin_amdgcn_ds_read_tr16_b64_v4i16((LAS v4i16_t*)(ST + off_b(32 * ks + 8 * kg + q4, 2 * ct + (p4 >> 1)) + 8 * (p4 & 1)));
                const v4i16_t hi4 = __builtin_amdgcn_ds_read_tr16_b64_v4i16((LAS v4i16_t*)(ST + off_b(32 * ks + 8 * kg + 4 + q4, 2 * ct + (p4 >> 1)) + 8 * (p4 & 1)));
                const bf16x8 af = (bf16x8){lo4[0], lo4[1], lo4[2], lo4[3], hi4[0], hi4[1], hi4[2], hi4[3]};
                o[vv] = __builtin_amdgcn_mfma_f32_16x16x32_bf16(af, qf[ks], o[vv], 0, 0, 0);
            }
        const int njb = (it >> 1) + 1;
#pragma unroll
        for (int jb = 0; jb < 2; ++jb) {
            if (jb < njb) {
                f32x4 a0 = (f32x4){0.f, 0.f, 0.f, 0.f}, a1 = (f32x4){0.f, 0.f, 0.f, 0.f};
                const unsigned rw0 = 32 * jb + 8 * (li >> 2) + (li & 3), rw1 = rw0 + 4;
#pragma unroll
                for (int ks = 0; ks < 4; ++ks) {
                    const bf16x8 k0 = *(const LAS bf16x8*)(KI + off_b(rw0, 4 * ks + kg));
                    const bf16x8 k1 = *(const LAS bf16x8*)(KI + off_b(rw1, 4 * ks + kg));
                    a0 = __builtin_amdgcn_mfma_f32_16x16x32_bf16(k0, qf[ks], a0, 0, 0, 0);
                    a1 = __builtin_amdgcn_mfma_f32_16x16x32_bf16(k1, qf[ks], a1, 0, 0, 0);
                }
                const int ii = 16 * it + li, j0 = 32 * jb + 8 * kg;
                float am[8];
#pragma unroll
                for (int e = 0; e < 8; ++e) am[e] = (j0 + e <= ii) ? (e < 4 ? a0[e] : a1[e - 4]) : 0.f;
                u32x4 pw; pw.x = pk2(am[0], am[1]); pw.y = pk2(am[2], am[3]); pw.z = pk2(am[4], am[5]); pw.w = pk2(am[6], am[7]);
                const bf16x8 pb = __builtin_bit_cast(bf16x8, pw);
#pragma unroll
                for (int vv = 0; vv < 4; ++vv) {
                    const int ct = 4 * vh + vv;
                    const v4i16_t lo4 = __builtin_amdgcn_ds_read_tr16_b64_v4i16((LAS v4i16_t*)(VI + off_b(32 * jb + 8 * kg + q4, 2 * ct + (p4 >> 1)) + 8 * (p4 & 1)));
                    const v4i16_t hi4 = __builtin_amdgcn_ds_read_tr16_b64_v4i16((LAS v4i16_t*)(VI + off_b(32 * jb + 8 * kg + 4 + q4, 2 * ct + (p4 >> 1)) + 8 * (p4 & 1)));
                    const bf16x8 af = (bf16x8){lo4[0], lo4[1], lo4[2], lo4[3], hi4[0], hi4[1], hi4[2], hi4[3]};
                    o[vv] = __builtin_amdgcn_mfma_f32_16x16x32_bf16(af, pb, o[vv], 0, 0, 0);
                }
            }
        }
        {
            f32x4 U[8];
#pragma unroll
            for (int vt = 0; vt < 8; ++vt) U[vt] = (f32x4){0.f, 0.f, 0.f, 0.f};
#pragma unroll
            for (int ks = 0; ks < 2; ++ks) {
                const v4i16_t kl = __builtin_amdgcn_ds_read_tr16_b64_v4i16((LAS v4i16_t*)(KI + off_b(32 * ks + 8 * kg + q4, 2 * wid + (p4 >> 1)) + 8 * (p4 & 1)));
                const v4i16_t kh = __builtin_amdgcn_ds_read_tr16_b64_v4i16((LAS v4i16_t*)(KI + off_b(32 * ks + 8 * kg + 4 + q4, 2 * wid + (p4 >> 1)) + 8 * (p4 & 1)));
                const bf16x8 kfr = (bf16x8){kl[0], kl[1], kl[2], kl[3], kh[0], kh[1], kh[2], kh[3]};
#pragma unroll
                for (int vt = 0; vt < 8; ++vt) {
                    const v4i16_t lo4 = __builtin_amdgcn_ds_read_tr16_b64_v4i16((LAS v4i16_t*)(VI + off_b(32 * ks + 8 * kg + q4, 2 * vt + (p4 >> 1)) + 8 * (p4 & 1)));
                    const v4i16_t hi4 = __builtin_amdgcn_ds_read_tr16_b64_v4i16((LAS v4i16_t*)(VI + off_b(32 * ks + 8 * kg + 4 + q4, 2 * vt + (p4 >> 1)) + 8 * (p4 & 1)));
                    const bf16x8 af = (bf16x8){lo4[0], lo4[1], lo4[2], lo4[3], hi4[0], hi4[1], hi4[2], hi4[3]};
                    U[vt] = __builtin_amdgcn_mfma_f32_16x16x32_bf16(af, kfr, U[vt], 0, 0, 0);
                }
            }
#pragma unroll
            for (int vt = 0; vt < 8; ++vt) S[vt] = S[vt] * e63 + U[vt] * e6r;
        }
        float ss = 0.f;
#pragma unroll
        for (int vv = 0; vv < 4; ++vv) ss += (o[vv][0] * o[vv][0] + o[vv][1] * o[vv][1]) + (o[vv][2] * o[vv][2] + o[vv][3] * o[vv][3]);
        ss += __shfl_xor(ss, 16); ss += __shfl_xor(ss, 32);
        if (kg == 0) SSQ[(it * 2 + vh) * 16 + li] = ss;
        __syncthreads();
        if (c + 1 < 32) HG_STORE(buf ^ 1);
        {
            const float tot = SSQ[(it * 2) * 16 + li] + SSQ[(it * 2 + 1) * 16 + li];
            const float rs = rsqrtf(tot * (1.f / 128.f) + EPS);
            const size_t row = (size_t)b * SEQ + c * 64 + 16 * it + li;
#pragma unroll
            for (int vv = 0; vv < 4; ++vv) {
                const int v0 = 16 * (4 * vh + vv) + 4 * kg;
                const u32x2 gw = gwv[vv];
                const f32x4 og = ogv[vv];
                const float g0 = silu_f(bf2f((unsigned short)(gw.x & 0xffffu))), g1 = silu_f(bf2f((unsigned short)(gw.x >> 16))), g2 = silu_f(bf2f((unsigned short)(gw.y & 0xffffu))), g3 = silu_f(bf2f((unsigned short)(gw.y >> 16)));
                u32x2 w; w.x = pk2(o[vv][0] * rs * og.x * g0, o[vv][1] * rs * og.y * g1); w.y = pk2(o[vv][2] * rs * og.z * g2, o[vv][3] * rs * og.w * g3);
                *(u32x2*)(CAT + row * KOUT + 1024 + h * 128 + v0) = w;
            }
        }
    }
#undef HG_LOAD
#undef HG_STORE
}


__device__ __forceinline__ int swap23(int r) { return (r & ~12) | ((r & 4) << 1) | ((r & 8) >> 1); }
__device__ __forceinline__ void xattn_mfma_phase(const bf16_t* Q, const bf16_t* Kb, const bf16_t* VT, bf16_t* O, LAS unsigned char* lds, int vb, int nvb) {
    const int tid = otid(), lane = tid & 63, wid = __builtin_amdgcn_readfirstlane(tid >> 6), r32 = lane & 31, hf = lane >> 5;
    LAS unsigned char* Ks = lds; LAS unsigned char* Vs = lds + 65536;
    int koff[8], voff[8];
    { const int kr = swap23(r32), x = kr & 15, y = r32 & 15;
#pragma unroll
      for (int ks = 0; ks < 8; ++ks) koff[ks] = kr * 256 + (((ks * 2 + hf) ^ x) << 4);
#pragma unroll
      for (int e = 0; e < 8; ++e) voff[e] = r32 * 512 + (((e * 2 + hf) ^ y) << 4); }
    for (int pair = vb; pair < 256; pair += nvb) {
        const int bh = pair >> 2, b = bh >> 2, h = bh & 3;
        __syncthreads();
        int tio = tid; asm volatile("" : "+v"(tio));
        for (int i = tio; i < 4096; i += NTHREADS) { const int key = i >> 4, ch = i & 15;
            const u32x4 v = *(const u32x4*)(Kb + (size_t)(b * MEMT + key) * 512 + h * 128 + ch * 8);
            *(LAS u32x4*)(Ks + key * 256 + ((ch ^ (key & 15)) << 4)) = v; }
        for (int i = tio; i < 4096; i += NTHREADS) { const int d = i >> 5, ch = i & 31;
            const u32x4 v = *(const u32x4*)(VT + (size_t)(h * 128 + d) * MT + b * MEMT + ch * 8);
            *(LAS u32x4*)(Vs + d * 512 + ((ch ^ (d & 15)) << 4)) = v; }
        __syncthreads();
#pragma unroll 1
        for (int qq = 0; qq < 2; ++qq) {
            const size_t q0 = (size_t)b * SEQ + ((pair & 3) * 2 + qq) * 256 + wid * 32;
            bf16x8 qf[8];
#pragma unroll
            for (int ks = 0; ks < 8; ++ks) qf[ks] = *(const bf16x8*)(Q + (q0 + r32) * 512 + h * 128 + ks * 16 + 8 * hf);
            f32x16 st[8];
            __builtin_amdgcn_s_setprio(1);
#pragma unroll
            for (int kt = 0; kt < 8; ++kt) {
#pragma unroll
                for (int r = 0; r < 16; ++r) st[kt][r] = 0.f;
#pragma unroll
                for (int ks = 0; ks < 8; ++ks) {
                    const bf16x8 a = *(const LAS bf16x8*)(Ks + koff[ks] + kt * 8192);
                    st[kt] = __builtin_amdgcn_mfma_f32_32x32x16_bf16(a, qf[ks], st[kt], 0, 0, 0);
                }
            }
            __builtin_amdgcn_s_setprio(0);
            float mx = -INFINITY;
#pragma unroll
            for (int kt = 0; kt < 8; ++kt)
#pragma unroll
                for (int r = 0; r < 16; ++r) mx = fmaxf(mx, st[kt][r]);
            mx = fmaxf(mx, __shfl_xor(mx, 32));
            const float c = 0.08838834764831845f * 1.4426950408889634f;
            float sum = 0.f;
#pragma unroll
            for (int kt = 0; kt < 8; ++kt)
#pragma unroll
                for (int r = 0; r < 16; ++r) { const float e = __builtin_amdgcn_exp2f((st[kt][r] - mx) * c); st[kt][r] = e; sum += e; }
            sum += __shfl_xor(sum, 32);
            const float inv = 1.f / sum;
            bf16x8 pfr[8][2];
#pragma unroll
            for (int kt = 0; kt < 8; ++kt)
#pragma unroll
                for (int s2 = 0; s2 < 2; ++s2) {
                    u32x4 pw;
                    pw.x = pk2(st[kt][8 * s2 + 0], st[kt][8 * s2 + 1]); pw.y = pk2(st[kt][8 * s2 + 2], st[kt][8 * s2 + 3]);
                    pw.z = pk2(st[kt][8 * s2 + 4], st[kt][8 * s2 + 5]); pw.w = pk2(st[kt][8 * s2 + 6], st[kt][8 * s2 + 7]);
                    pfr[kt][s2] = __builtin_bit_cast(bf16x8, pw);
                }
#pragma unroll
            for (int kt = 0; kt < 8; ++kt) asm volatile("" : "+v"(pfr[kt][0]), "+v"(pfr[kt][1]));
            f32x16 o[4];
#pragma unroll
            for (int dt = 0; dt < 4; ++dt)
#pragma unroll
                for (int r = 0; r < 16; ++r) o[dt][r] = 0.f;
            __builtin_amdgcn_s_setprio(1);
#pragma unroll
            for (int kt = 0; kt < 8; ++kt)
#pragma unroll
                for (int s2 = 0; s2 < 2; ++s2)
#pragma unroll
                    for (int dt = 0; dt < 4; ++dt) {
                        const bf16x8 a = *(const LAS bf16x8*)(Vs + voff[(kt & 3) * 2 + s2] + dt * 16384 + (kt >> 2) * 256);
                        o[dt] = __builtin_amdgcn_mfma_f32_32x32x16_bf16(a, pfr[kt][s2], o[dt], 0, 0, 0);
                    }
            __builtin_amdgcn_s_setprio(0);
            bf16_t* orow = O + (q0 + r32) * 512 + h * 128 + 4 * hf;
#pragma unroll
            for (int dt = 0; dt < 4; ++dt)
#pragma unroll
                for (int g = 0; g < 4; ++g) {
                    u32x2 w; w.x = pk2(o[dt][4 * g] * inv, o[dt][4 * g + 1] * inv); w.y = pk2(o[dt][4 * g + 2] * inv, o[dt][4 * g + 3] * inv);
                    *(u32x2*)(orow + dt * 32 + 8 * g) = w;
                }
        }
    }
}


__device__ __forceinline__ void gmlp_mfma_phase(const bf16_t* UV, const float* lnp, const float* ln_g, const float* ln_b, const float* w_sp, const float* b_sp, bf16_t* G, LAS unsigned char* lds, int vb, int nvb) {
    const int tid = otid(), lane = tid & 63, wid = __builtin_amdgcn_readfirstlane(tid >> 6), fr = lane & 15, fq = lane >> 4;
    LAS unsigned char* Wb = lds; LAS unsigned char* VTs = lds + 32768; LAS float* STAT = (LAS float*)(lds + 65536);
    int gcur = -1;
    for (int grp = vb; grp < 256; grp += nvb) {
        const int g = grp >> 5;
        bf16x8 vch[4]; f32x4 lp[2];
#define GM_LOAD(uu_) do { const size_t r0_ = (size_t)((grp & 31) * 8 + (uu_)) * 128; \
            _Pragma("unroll") for (int k = 0; k < 4; ++k) { const int i = tid + 512 * k, sI = i >> 4, ch = i & 15; vch[k] = *(const bf16x8*)(UV + (r0_ + sI) * 2048 + 1024 + g * 128 + ch * 8); } \
            lp[0] = *(const f32x4*)(lnp + (r0_ + (tid >> 2)) * 32 + (tid & 3) * 8); lp[1] = *(const f32x4*)(lnp + (r0_ + (tid >> 2)) * 32 + (tid & 3) * 8 + 4); } while (0)
        GM_LOAD(0);
        const f32x4 g0 = *(const f32x4*)(ln_g + g * 128 + (tid & 15) * 8), g1 = *(const f32x4*)(ln_g + g * 128 + (tid & 15) * 8 + 4);
        const f32x4 b0 = *(const f32x4*)(ln_b + g * 128 + (tid & 15) * 8), b1 = *(const f32x4*)(ln_b + g * 128 + (tid & 15) * 8 + 4);
        const float gg[8] = {g0.x, g0.y, g0.z, g0.w, g1.x, g1.y, g1.z, g1.w}, bb[8] = {b0.x, b0.y, b0.z, b0.w, b1.x, b1.y, b1.z, b1.w};
        __syncthreads();
        if (g != gcur) {
            gcur = g;
            for (int i = tid; i < 2048; i += NTHREADS) { const int t = i >> 4, ch = i & 15;
                const f32x4 a = *(const f32x4*)(w_sp + (size_t)g * 16384 + t * 128 + ch * 8), b = *(const f32x4*)(w_sp + (size_t)g * 16384 + t * 128 + ch * 8 + 4);
                const int s0 = ch * 8;
                u32x4 w; w.x = pk2(s0 + 0 <= t ? a.x : 0.f, s0 + 1 <= t ? a.y : 0.f); w.y = pk2(s0 + 2 <= t ? a.z : 0.f, s0 + 3 <= t ? a.w : 0.f);
                w.z = pk2(s0 + 4 <= t ? b.x : 0.f, s0 + 5 <= t ? b.y : 0.f); w.w = pk2(s0 + 6 <= t ? b.z : 0.f, s0 + 7 <= t ? b.w : 0.f);
                *(LAS u32x4*)(Wb + t * 256 + ((ch ^ (t & 15)) << 4)) = w; }
        }
        const int trow = wid * 16 + fr;
        const float bias = b_sp[g * 128 + trow];
#pragma unroll 1
        for (int uu = 0; uu < 8; ++uu) {
            const int bn = (grp & 31) * 8 + uu;
            const size_t row0 = (size_t)bn * 128;
            if (uu) __syncthreads();
            { float s1 = (lp[0].x + lp[0].z) + (lp[1].x + lp[1].z), s2 = (lp[0].y + lp[0].w) + (lp[1].y + lp[1].w);
              s1 += __shfl_xor(s1, 1); s2 += __shfl_xor(s2, 1); s1 += __shfl_xor(s1, 2); s2 += __shfl_xor(s2, 2);
              const float mu = s1 * (1.f / 1024.f), var = fmaxf(s2 * (1.f / 1024.f) - mu * mu, 0.f);
              if ((tid & 3) == 0) { STAT[2 * (tid >> 2)] = mu; STAT[2 * (tid >> 2) + 1] = rsqrtf(var + EPS); } }
            __syncthreads();
#pragma unroll
            for (int k = 0; k < 4; ++k) { const int i = tid + 512 * k, sI = i >> 4, ch = i & 15;
                const float mu = STAT[2 * sI], rs = STAT[2 * sI + 1];
#pragma unroll
                for (int e = 0; e < 8; ++e) { const int c = ch * 8 + e; const float x = (bf2f((unsigned short)vch[k][e]) - mu) * rs * gg[e] + bb[e];
                    *(LAS bf16_t*)(VTs + c * 256 + (((sI >> 3) ^ ((c ^ (c >> 3)) & 15)) << 4) + (sI & 7) * 2) = (bf16_t)f2bf(x); } }
            if (uu + 1 < 8) GM_LOAD(uu + 1);
            const size_t orow = row0 + trow;
            u32x2 uwv[8];
#pragma unroll
            for (int ct = 0; ct < 8; ++ct) uwv[ct] = *(const u32x2*)(UV + orow * 2048 + g * 128 + ct * 16 + 4 * fq);
            __syncthreads();
            f32x4 acc[8];
#pragma unroll
            for (int ct = 0; ct < 8; ++ct) acc[ct] = (f32x4){0.f, 0.f, 0.f, 0.f};
#pragma unroll
            for (int ks = 0; ks < 4; ++ks) {
                const bf16x8 wf = *(const LAS bf16x8*)(Wb + trow * 256 + (((ks * 4 + fq) ^ (trow & 15)) << 4));
#pragma unroll
                for (int ct = 0; ct < 8; ++ct) {
                    const int crow = ct * 16 + fr;
                    const bf16x8 vf = *(const LAS bf16x8*)(VTs + crow * 256 + (((ks * 4 + fq) ^ ((crow ^ (crow >> 3)) & 15)) << 4));
                    acc[ct] = __builtin_amdgcn_mfma_f32_16x16x32_bf16(vf, wf, acc[ct], 0, 0, 0);
                }
            }
#pragma unroll
            for (int ct = 0; ct < 8; ++ct) {
                const int c = ct * 16 + 4 * fq;
                const u32x2 uw = uwv[ct];
                const float u0 = bf2f((unsigned short)(uw.x & 0xffffu)), u1 = bf2f((unsigned short)(uw.x >> 16)), u2 = bf2f((unsigned short)(uw.y & 0xffffu)), u3 = bf2f((unsigned short)(uw.y >> 16));
                u32x2 w; w.x = pk2(u0 * (acc[ct][0] + bias), u1 * (acc[ct][1] + bias)); w.y = pk2(u2 * (acc[ct][2] + bias), u3 * (acc[ct][3] + bias));
                *(u32x2*)(G + orow * 1024 + g * 128 + c) = w;
            }
        }
#undef GM_LOAD
    }
}

#define GAS __attribute__((address_space(1)))
typedef GAS unsigned gu32;
#define XB_TMO      128
#define XB_XCNT(j)  (256  + 64 * (j))
#define XB_XSUB(j)  (1280 + 64 * (j))
#define XB_XGEN(j)  (2304 + 64 * (j))
#define XB_TOP      3328
#define XB_TOPGEN   3392
#define XCD_BAR_WORDS 3456
#define XB_SPIN_CAP (1u << 18)

__device__ __forceinline__ unsigned xb_ld(unsigned* p)              { return __hip_atomic_load(p, __ATOMIC_RELAXED, __HIP_MEMORY_SCOPE_AGENT); }
__device__ __forceinline__ unsigned xb_add(unsigned* p, unsigned v) { return __hip_atomic_fetch_add(p, v, __ATOMIC_RELAXED, __HIP_MEMORY_SCOPE_AGENT); }
__device__ __forceinline__ unsigned xb_xcc_id() { return (unsigned)__builtin_amdgcn_s_getreg((3 << 11) | 20) & 0xFu; }
#define XB_SPIN(cond, bar) do { unsigned _sp = 0; while (cond) { __builtin_amdgcn_s_sleep(1); \
    if ((++_sp & 255u) == 0u) { if (xb_ld(&(bar)[XB_TMO])) break; if (_sp > XB_SPIN_CAP) { atomicAdd(&(bar)[XB_TMO], 1u); break; } } } } while (0)

struct XcdBarrier {
    unsigned* bar; unsigned x;
    volatile LAS unsigned* st;
};

__device__ __forceinline__ XcdBarrier xcd_barrier_post(unsigned* bar, volatile LAS unsigned* st) {
    XcdBarrier b; b.bar = bar; b.x = xb_xcc_id(); b.st = st;
    if (threadIdx.x == 0) (void)xb_add(&bar[XB_XCNT(b.x)], 1u);
    return b;
}
__device__ __forceinline__ void xcd_barrier_complete(unsigned* bar, unsigned x, unsigned& nloc, unsigned& nx) {
    const unsigned G = gridDim.x * gridDim.y * gridDim.z;
    unsigned sum, cnt, mine, sp = 0u;
    for (;;) {
        sum = 0u; cnt = 0u; mine = 0u;
#pragma unroll
        for (unsigned j = 0; j < 16; ++j) { const unsigned c = xb_ld(&bar[XB_XCNT(j)]); sum += c; cnt += (c > 0u) ? 1u : 0u; mine = (j == x) ? c : mine; }
        if (sum == G) break;
        __builtin_amdgcn_s_sleep(1);
        if ((++sp & 255u) == 0u) { if (xb_ld(&bar[XB_TMO])) break; if (sp > XB_SPIN_CAP) { atomicAdd(&bar[XB_TMO], 1u); break; } }
    }
    nloc = mine > 0u ? mine : 1u; nx = cnt > 0u ? cnt : 1u;
}

__device__ __forceinline__ void xcd_barrier(const XcdBarrier& b) {
    asm volatile("s_waitcnt vmcnt(0)" ::: "memory");
    __syncthreads();
    if (threadIdx.x == 0) {
        unsigned* bar = b.bar;
        __builtin_amdgcn_s_waitcnt(0);
        unsigned nloc = b.st[0], nx = b.st[1];
        if (nloc == 0u) { xcd_barrier_complete(bar, b.x, nloc, nx); b.st[0] = nloc; b.st[1] = nx; }
        const unsigned old = xb_add(&bar[XB_XSUB(b.x)], 1u);
        const unsigned gen = old / nloc;
        if (old + 1u == (gen + 1u) * nloc) {
            __builtin_amdgcn_fence(__ATOMIC_RELEASE, "agent");
            asm volatile("s_waitcnt vmcnt(0)" ::: "memory");
            const unsigned og = xb_add(&bar[XB_TOP], 1u);
            const unsigned tg = og / nx;
            if (og + 1u == (tg + 1u) * nx) xb_add(&bar[XB_TOPGEN], 1u);
            else XB_SPIN(xb_ld(&bar[XB_TOPGEN]) == tg, bar);
            __builtin_amdgcn_fence(__ATOMIC_ACQUIRE, "agent");
            xb_add(&bar[XB_XGEN(b.x)], 1u);
            asm volatile("s_waitcnt vmcnt(0)" ::: "memory");
        } else {
            XB_SPIN(xb_ld(&bar[XB_XGEN(b.x)]) == gen, bar);
            __builtin_amdgcn_fence(__ATOMIC_ACQUIRE, "agent");
            asm volatile("s_waitcnt vmcnt(0)" ::: "memory");
        }
    }
    __syncthreads();
}

constexpr int LDS_BYTES = 32768 * 4 + 256 + 6144 + 8 * 2560;

enum Phase {
    PH_PREP = 0, PH_GEMM_IN, PH_CNORM, PH_MIX0  , PH_GEMM_OUT0,
    PH_GEMM_Q0, PH_XATTN0, PH_GEMM_O0, PH_GEMM_GU0, PH_GEMM_DN0,
    PH_GEMM_OIN, PH_GMLP, PH_GEMM_OOUT,
    PH_GEMM_Q1, PH_XATTN1, PH_GEMM_O1, PH_GEMM_GU1, PH_GEMM_DN1, PH_FINAL, PH_COUNT
};

__device__ __forceinline__ PrepJob make_job(const Params& p, int ji) {
    unsigned char* ws = p.ws; PrepJob j{};
    switch (ji) {
    case 0: j = PrepJob{p.in[5], 1024, 3272, p.in[4], (bf16_t*)(ws + WS_WIN), 1024, PW, 1024, 0, MAP_WIN}; break;
    case 1: j = PrepJob{p.in[10] + (size_t)512 * 1024, 512, 1024, nullptr, (bf16_t*)(ws + WS_WOUT), 0, 1024, KOUT, 1024, MAP_ID}; break;
    case 2: j = PrepJob{p.in[11], 1024, 2048, p.in[4] + 1024, (bf16_t*)(ws + WS_OWIN), 0, 2048, 1024, 0, MAP_ID, 2, WQ_GU}; break;
    case 3: j = PrepJob{p.in[16], 1024, 1024, nullptr, (bf16_t*)(ws + WS_OWOUT), 0, 1024, 1024, 0, MAP_ID}; break;
    case 4: case 5: { const int l = ji - 4; j = PrepJob{p.in[19] + (size_t)l * 1024 * 512, 1024, 512, p.in[17] + l * 1024, (bf16_t*)(ws + WS_WQ + (size_t)l * 512 * 1024), 0, 512, 1024, 0, MAP_ID, 2, WQ_GU}; } break;
    case 6: case 7: { const int l = ji - 6; j = PrepJob{p.in[20] + (size_t)l * 1024 * 1024, 1024, 1024, p.in[18] + l * 1024, (bf16_t*)(ws + WS_WKV) + (size_t)l * 1024 * 1024, 0, 1024, 1024, 0, MAP_ID}; } break;
    case 8: case 9: { const int l = ji - 8; j = PrepJob{p.in[21] + (size_t)l * 512 * 1024, 512, 1024, nullptr, (bf16_t*)(ws + WS_WO) + (size_t)l * 1024 * 512, 0, 1024, 512, 0, MAP_ID}; } break;
    case 10: case 11: { const int l = ji - 10; j = PrepJob{p.in[23] + (size_t)l * 1024 * 2 * FF, 1024, 2 * FF, p.in[22] + l * 1024, (bf16_t*)(ws + WS_WGU + (size_t)l * 2 * FF * 1024), 0, 2 * FF, 1024, 0, MAP_GU, 2, WQ_GU}; } break;
#if DN_FP8
    default: { const int l = ji - 12; j = PrepJob{p.in[24] + (size_t)l * FF * 1024, FF, 1024, nullptr, (bf16_t*)(ws + WS_WDN + (size_t)l * 1024 * FF), 0, 1024, FF, 0, MAP_ID, 1, WDN_SC}; } break;
#else
    default: { const int l = ji - 12; j = PrepJob{p.in[24] + (size_t)l * FF * 1024, FF, 1024, nullptr, (bf16_t*)(ws + WS_WDN) + (size_t)l * 1024 * FF, 0, 1024, FF, 0, MAP_ID}; } break;
#endif
    }
    return j;
}
constexpr int N_PREP_JOBS = 14;

template <int ph> __device__ __forceinline__ void run_phase(const Params& p, LAS float* lds, int vb, int nvb) {
    unsigned char* ws = p.ws;
    bf16_t* HN = (bf16_t*)(ws + WS_HN); bf16_t* BIG = (bf16_t*)(ws + WS_BIG); bf16_t* CN = (bf16_t*)(ws + WS_CN); bf16_t* CAT = (bf16_t*)(ws + WS_CAT);
    bf16_t* KB = (bf16_t*)(ws + WS_KB); bf16_t* VTB = (bf16_t*)(ws + WS_VT); bf16_t* MEMN = (bf16_t*)(ws + WS_MEMN); float* lb = (float*)(ws + WS_LB);
    float* ssq = (float*)(ws + WS_SSQ); float* lnp = (float*)(ws + WS_LNP);
    bf16_t* XQ = BIG; bf16_t* XO = BIG + (size_t)T * 512;
    const int l = (ph >= PH_GEMM_Q1) ? 1 : 0;
    switch (ph) {
    case PH_PREP:
        x_to_h_rows(p.in[0], HN, ssq, vb, nvb);
        {
            constexpr int NT_[N_PREP_JOBS] = {16 * 11, 8 * 4, 16 * 8, 16 * 4, 16 * 2, 16 * 2, 16 * 4, 16 * 4, 8 * 4, 8 * 4, 16 * 22, 16 * 22, 44 * 4, 44 * 4};
            constexpr int CUM1 = NT_[0], CUM2 = CUM1 + NT_[1], CUM3 = CUM2 + NT_[2], CUM4 = CUM3 + NT_[3], CUM5 = CUM4 + NT_[4], CUM6 = CUM5 + NT_[5], CUM7 = CUM6 + NT_[6],
                          CUM8 = CUM7 + NT_[7], CUM9 = CUM8 + NT_[8], CUM10 = CUM9 + NT_[9], CUM11 = CUM10 + NT_[10], CUM12 = CUM11 + NT_[11], CUM13 = CUM12 + NT_[12], CUM14 = CUM13 + NT_[13];
#define PJ_FIND(it_, ji_, base_) do { ji_ = 0; base_ = 0; \
                PJ_STEP(it_, ji_, base_, 1, CUM1) PJ_STEP(it_, ji_, base_, 2, CUM2) PJ_STEP(it_, ji_, base_, 3, CUM3) PJ_STEP(it_, ji_, base_, 4, CUM4) PJ_STEP(it_, ji_, base_, 5, CUM5) PJ_STEP(it_, ji_, base_, 6, CUM6) PJ_STEP(it_, ji_, base_, 7, CUM7) \
                PJ_STEP(it_, ji_, base_, 8, CUM8) PJ_STEP(it_, ji_, base_, 9, CUM9) PJ_STEP(it_, ji_, base_, 10, CUM10) PJ_STEP(it_, ji_, base_, 11, CUM11) PJ_STEP(it_, ji_, base_, 12, CUM12) PJ_STEP(it_, ji_, base_, 13, CUM13) } while (0)
#define PJ_STEP(it_, ji_, base_, q, c) if ((it_) >= (c)) { ji_ = (q); base_ = (c); }
            f32x4 va[8], vn[8];
            int ji, base;
            if (vb < CUM14) { PJ_FIND(vb, ji, base); const PrepJob j = make_job(p, ji); prep_tile_load(j, vb - base, va); }
            for (int it = vb; it < CUM14; it += nvb) {
                PJ_FIND(it, ji, base);
                const PrepJob j = make_job(p, ji); const int tl = it - base;
                if (it + nvb < CUM14) { int jn, bn; PJ_FIND(it + nvb, jn, bn); const PrepJob j2 = make_job(p, jn); prep_tile_load(j2, it + nvb - bn, vn); }
                prep_tile_store(j, tl, va, lds);
#pragma unroll
                for (int q = 0; q < 8; ++q) va[q] = vn[q];
            }
#undef PJ_STEP
#undef PJ_FIND
        }
        prep_fold_in(p.in[5], p.in[7], p.in[4], (bf16_t*)(ws + WS_WIN), lds, vb, nvb);
        prep_fold_out(p.in[10], p.in[8], (bf16_t*)(ws + WS_WOUT), lds, vb, nvb);
        prep_lb(p.in[3], lb, vb, nvb);
        rmsnorm_rows(p.in[1], MEMN, MT, vb, nvb);
        break;
    case PH_GEMM_IN: {
        Gemm g{(const bf16_t*)(ws + WS_WIN), (const bf16_t*)(ws + WS_WIN), T, PW, 1024}; EpiIn E{BIG, KB, VTB, ssq};
        pg8::ComboOrder S; S.init(nvb, vb);
        pg8::gemm_phase<EpiIn, pg8::ComboOrder, true, true>((LAS unsigned char*)lds, g, S, E);
    } break;
    case PH_CNORM: cnorm_rows(BIG, p.in[6], CN, vb, nvb); hgrn_prep(BIG, lb, (float*)(ws + WS_DEC), (LAS unsigned char*)lds, vb, nvb); break;
    case PH_MIX0:
        for (int item = vb; item < 64; item += nvb) hgrn_scan(BIG, (const float*)(ws + WS_DEC), p.in[9], CAT, (LAS unsigned char*)lds, item);
        dsa_mfma_phase(BIG, CN, p.in[2], CAT, (LAS unsigned char*)lds, (unsigned*)(ws + WS_CTL) + 3600);
        break;
    case PH_GEMM_OUT0: { Gemm g{CAT, (const bf16_t*)(ws + WS_WOUT), T, 1024, KOUT}; EpiResid<false, false, true> E{nullptr, HN, ssq, ws + WS_H8, HQ_Q0}; run_gemm(g, E, lds, vb, nvb); } break;
    case PH_GEMM_Q0: case PH_GEMM_Q1: { Gemm g{(const bf16_t*)(ws + WS_H8), (const bf16_t*)(ws + WS_WQ + (size_t)l * 512 * 1024), T, 512, 512}; EpiStoreBf16<true> E{XQ, 512, ssq, 1.f / ((l ? HQ_Q1 : HQ_Q0) * WQ_GU)}; run_gemm<EpiStoreBf16<true>, 2>(g, E, lds, vb, nvb); } break;
    case PH_XATTN0: case PH_XATTN1: xattn_mfma_phase(XQ, KB + (size_t)l * MT * 512, VTB + (size_t)l * 512 * MT, XO, (LAS unsigned char*)lds, vb, nvb); break;
    case PH_GEMM_O0: case PH_GEMM_O1: { Gemm g{XO, (const bf16_t*)(ws + WS_WO) + (size_t)l * 1024 * 512, T, 1024, 512}; EpiResid<false, false, true> E{nullptr, HN, ssq, ws + WS_H8, l ? HQ_GU1 : HQ_GU0}; run_gemm(g, E, lds, vb, nvb); } break;
    case PH_GEMM_GU0: case PH_GEMM_GU1: { Gemm g{(const bf16_t*)(ws + WS_H8), (const bf16_t*)(ws + WS_WGU + (size_t)l * 2 * FF * 1024), T, 2 * FF, 512}; EpiSwigluQ<true, DN_FP8 != 0> E{BIG, FF, ssq, 1.f / ((l ? HQ_GU1 : HQ_GU0) * WQ_GU)}; run_gemm<EpiSwigluQ<true, DN_FP8 != 0>, 2>(g, E, lds, vb, nvb); } break;
    case PH_GEMM_DN0: case PH_GEMM_DN1:
#if DN_FP8
        { Gemm g{BIG, (const bf16_t*)(ws + WS_WDN + (size_t)l * 1024 * FF), T, 1024, FF / 2}; EpiResid<false, true, ph == PH_GEMM_DN0> E{nullptr, HN, ssq, ws + WS_H8, HQ_OIN}; run_gemm<EpiResid<false, true, ph == PH_GEMM_DN0>, 1>(g, E, lds, vb, nvb); } break;
#else
        { Gemm g{BIG, (const bf16_t*)(ws + WS_WDN) + (size_t)l * 1024 * FF, T, 1024, FF}; EpiResid<false, false, ph == PH_GEMM_DN0> E{nullptr, HN, ssq, ws + WS_H8, HQ_OIN}; run_gemm(g, E, lds, vb, nvb); } break;
#endif
    case PH_GEMM_OIN: { Gemm g{(const bf16_t*)(ws + WS_H8), (const bf16_t*)(ws + WS_OWIN), T, 2048, 512}; EpiGeluBf16<true> E{BIG, 2048, ssq, lnp, 1.f / (HQ_OIN * WQ_GU)}; run_gemm<EpiGeluBf16<true>, 2>(g, E, lds, vb, nvb); } break;
    case PH_GMLP: gmlp_mfma_phase(BIG, lnp, p.in[12], p.in[13], p.in[14], p.in[15], CAT, (LAS unsigned char*)lds, vb, nvb); break;
    case PH_GEMM_OOUT: { Gemm g{CAT, (const bf16_t*)(ws + WS_OWOUT), T, 1024, 1024}; EpiResid<false, false, true> E{nullptr, HN, ssq, ws + WS_H8, HQ_Q1}; run_gemm(g, E, lds, vb, nvb); } break;
    case PH_FINAL: final_rows(HN, ssq, p.in[25], p.out, vb, nvb); break;
    default: break;
    }
}

template <int PH> __global__ void __launch_bounds__(NTHREADS) k_phase(Params p) {
    extern __shared__ __attribute__((aligned(16))) float smem[];
    run_phase<PH>(p, (LAS float*)smem, blockIdx.x, gridDim.x);
}

template <int PH> __device__ __forceinline__ void mega_phases(const Params& p, LAS float* lds, const XcdBarrier& bar) {
    run_phase<PH>(p, lds, blockIdx.x, gridDim.x);
#ifdef REPEAT_PH
    if constexpr (PH == REPEAT_PH) { xcd_barrier(bar); run_phase<PH>(p, lds, blockIdx.x, gridDim.x); }
#endif
    if constexpr (PH + 1 < PH_COUNT) { xcd_barrier(bar); mega_phases<PH + 1>(p, lds, bar); }
}
__global__ void __launch_bounds__(NTHREADS) k_mega(Params p) {
    extern __shared__ __attribute__((aligned(16))) float smem[];
    volatile LAS unsigned* st = (volatile LAS unsigned*)((LAS float*)smem + 32768);
    if (threadIdx.x < 2) st[threadIdx.x] = 0u;
    __syncthreads();
    const XcdBarrier bar = xcd_barrier_post((unsigned*)(p.ws + WS_CTL), st);
    mega_phases<0>(p, (LAS float*)smem, bar);
}

template <int PH> static void launch_phases(const Params& p, int grid, hipStream_t stream) {
    int g = grid * 4;
    if (PH == PH_MIX0 || PH == PH_XATTN0 || PH == PH_XATTN1 || PH == PH_GMLP) g = grid;
    (void)hipFuncSetAttribute((const void*)k_phase<PH>, hipFuncAttributeMaxDynamicSharedMemorySize, LDS_BYTES);
    hipLaunchKernelGGL(k_phase<PH>, dim3(g), dim3(NTHREADS), LDS_BYTES, stream, p);
    if constexpr (PH + 1 < PH_COUNT) launch_phases<PH + 1>(p, grid, stream);
}

extern "C" void kernel_launch(void* const* d_in, const int* in_sizes, int n_in, void* d_out, int out_size, void* d_ws, size_t ws_size, hipStream_t stream) {
    static int grid = 0;
    if (grid == 0) {
        if (n_in != 26 || out_size != T * D || ws_size < WS_END) { fprintf(stderr, "kernel_launch: unexpected shapes (n_in %d out %d ws %zu)\n", n_in, out_size, ws_size); grid = -1; return; }
        int dev = 0, cus = 0;
        (void)hipGetDevice(&dev); (void)hipDeviceGetAttribute(&cus, hipDeviceAttributeMultiprocessorCount, dev);
        (void)hipFuncSetAttribute((const void*)k_mega, hipFuncAttributeMaxDynamicSharedMemorySize, LDS_BYTES);
        int per_cu = 0;
        (void)hipOccupancyMaxActiveBlocksPerMultiprocessor(&per_cu, (const void*)k_mega, NTHREADS, LDS_BYTES);
        if (per_cu < 1) fprintf(stderr, "kernel_launch: occupancy query says %d blocks per CU\n", per_cu);
        (void)hipGetLastError();
        grid = cus > 0 ? cus : 256;
    }
    if (grid < 0) return;
    Params p{};
    for (int i = 0; i < 26; ++i) p.in[i] = (const float*)d_in[i];
    p.out = (float*)d_out; p.ws = (unsigned char*)d_ws;
    (void)hipMemsetAsync((char*)d_ws + WS_CTL, 0, 16384, stream);
#if MEGA
    hipLaunchKernelGGL(k_mega, dim3(grid), dim3(NTHREADS), LDS_BYTES, stream, p);
#else
    launch_phases<0>(p, grid, stream);
#endif
}
```

```cpp
#include <hip/hip_runtime.h>
#include <stdint.h>
#include <stdio.h>

#ifndef MEGA
#define MEGA 1
#endif
#ifndef DN_FP8
#define DN_FP8 0
#endif

#define LAS __attribute__((address_space(3)))
typedef unsigned short bf16_t;
typedef short bf16x8 __attribute__((ext_vector_type(8)));
typedef float f32x4 __attribute__((ext_vector_type(4)));
typedef float f32x2 __attribute__((ext_vector_type(2)));
typedef unsigned u32x4 __attribute__((ext_vector_type(4)));
typedef unsigned u32x2 __attribute__((ext_vector_type(2)));
typedef float f32x16 __attribute__((ext_vector_type(16)));

constexpr int D = 1024, BATCH = 16, SEQ = 2048, T = BATCH * SEQ;
constexpr int CHUNK = 64;
constexpr int MEMT = 256, MT = BATCH * MEMT;
constexpr int FF = 2816;
constexpr float EPS = 1e-6f;
constexpr int NTHREADS = 512, NWAVES = 8;

constexpr int P_QL = 0, P_C = 1024, P_QI = 1152, P_KI = 1664, P_FB = 1728, P_IB = 2240, P_QB = 2752, P_GB = 3264, P_WI = 3776, P_END = 3784, PW = 3840;
constexpr int KOUT = 1536;

constexpr size_t MiB = 1u << 20;
constexpr size_t WS_CTL = 0;
constexpr size_t WS_LB = 64 * 1024;
constexpr size_t WS_SSQ = 496 * MiB;
constexpr size_t WS_LNP = 498 * MiB;
constexpr size_t WS_WIN = 1 * MiB;
constexpr size_t WS_WKV = WS_WIN + (size_t)PW * D * 2;
constexpr size_t WS_HN = WS_WKV + 2 * (size_t)D * D * 2;
constexpr size_t WS_MEMN = WS_HN + (size_t)T * D * 2;
constexpr size_t WS_WOUT = WS_MEMN + (size_t)MT * D * 2;
constexpr size_t WS_OWIN = WS_WOUT + (size_t)D * KOUT * 2;
constexpr size_t WS_OWOUT = WS_OWIN + (size_t)2048 * D * 2;
constexpr size_t WS_WQ = WS_OWOUT + (size_t)D * D * 2;
constexpr size_t WS_WO = WS_WQ + 2 * (size_t)512 * D * 2;
constexpr size_t WS_WGU = WS_WO + 2 * (size_t)D * 512 * 2;
constexpr size_t WS_WDN = WS_WGU + 2 * (size_t)2 * FF * D * 2;
constexpr size_t WS_WEND = WS_WDN + 2 * (size_t)D * FF * 2;
constexpr int TILE_WIN = 0, TILE_WKV = PW / 256, TILE_HN = TILE_WKV + 8, TILE_MEMN = TILE_HN + T / 256;
constexpr size_t WS_BIG = 132 * MiB;
constexpr size_t WS_CN = 372 * MiB;
constexpr size_t WS_CAT = 380 * MiB;
constexpr size_t WS_H8 = WS_BIG + 200 * MiB;
constexpr size_t WS_KB = 476 * MiB;
constexpr size_t WS_VT = 484 * MiB;
constexpr size_t WS_END = 502 * MiB;
static_assert(WS_WEND <= WS_BIG, "weights fit below BIG");

struct Params {
    const float* in[26];
    float* out;
    unsigned char* ws;
};

__device__ __forceinline__ float bf2f(unsigned short u) { return __uint_as_float(((unsigned)u) << 16); }
__device__ __forceinline__ unsigned f2bf(float f) { unsigned u = __float_as_uint(f); return (u + 0x7fffu + ((u >> 16) & 1u)) >> 16; }
typedef __bf16 bf16x2_t __attribute__((ext_vector_type(2)));
__device__ __forceinline__ unsigned pk2(float lo, float hi) { const f32x2 v = {lo, hi}; return __builtin_bit_cast(unsigned, __builtin_convertvector(v, bf16x2_t)); }
__device__ __forceinline__ float wave_sum(float v) {
#pragma unroll
    for (int o = 1; o < 64; o <<= 1) v += __shfl_xor(v, o);
    return v;
}
__device__ __forceinline__ float wave_max(float v) {
#pragma unroll
    for (int o = 1; o < 64; o <<= 1) v = fmaxf(v, __shfl_xor(v, o));
    return v;
}
__device__ __forceinline__ int otid() { int t = threadIdx.x; asm volatile("" : "+v"(t)); return t; }
#define WAVE_LDS_SYNC() asm volatile("s_waitcnt lgkmcnt(0)" ::: "memory")
__device__ __forceinline__ float silu_f(float x) { return x * __builtin_amdgcn_rcpf(1.f + __expf(-x)); }
__device__ __forceinline__ float sigmoid_f(float x) { return __builtin_amdgcn_rcpf(1.f + __expf(-x)); }

typedef int i32x4v __attribute__((ext_vector_type(4)));
typedef int i32x8v __attribute__((ext_vector_type(8)));
__device__ __forceinline__ unsigned pk4_f8(float a, float b, float c, float d) {
    a = __builtin_amdgcn_fmed3f(a, -448.f, 448.f); b = __builtin_amdgcn_fmed3f(b, -448.f, 448.f); c = __builtin_amdgcn_fmed3f(c, -448.f, 448.f); d = __builtin_amdgcn_fmed3f(d, -448.f, 448.f);
    int w = 0;
    w = __builtin_amdgcn_cvt_pk_fp8_f32(a, b, w, false);
    w = __builtin_amdgcn_cvt_pk_fp8_f32(c, d, w, true);
    return (unsigned)w;
}
constexpr float ACT_SC = 8.f, WDN_SC = 256.f, DN_UNSC = 1.f / (ACT_SC * WDN_SC);
constexpr float XO_SC = 64.f, WO_SC = 128.f, XO_UNSC = 1.f / (XO_SC * WO_SC);
constexpr float HQ_Q0 = 127.f / 5.2f, HQ_GU0 = 127.f / 5.2f, HQ_OIN = 127.f / 5.8f, HQ_Q1 = 127.f / 6.3f, HQ_GU1 = 127.f / 6.3f, WQ_GU = 127.f / 0.13f;
__device__ __forceinline__ unsigned pk4_i8(float a, float b, float c, float d, float sc) {
    constexpr float MG = 12582912.f;
    const unsigned ua = __float_as_uint(__builtin_amdgcn_fmed3f(__builtin_fmaf(a, sc, MG), MG - 127.f, MG + 127.f)), ub = __float_as_uint(__builtin_amdgcn_fmed3f(__builtin_fmaf(b, sc, MG), MG - 127.f, MG + 127.f));
    const unsigned uc = __float_as_uint(__builtin_amdgcn_fmed3f(__builtin_fmaf(c, sc, MG), MG - 127.f, MG + 127.f)), ud = __float_as_uint(__builtin_amdgcn_fmed3f(__builtin_fmaf(d, sc, MG), MG - 127.f, MG + 127.f));
    return __builtin_amdgcn_perm(ub, ua, 0x0c0c0400u) | __builtin_amdgcn_perm(ud, uc, 0x04000c0cu);
}
__device__ __forceinline__ int kperm8(int k) { const int r = k & 255; return (k & ~255) + ((r >> 5) & 3) * 64 + ((r >> 3) & 3) * 16 + (r >> 7) * 8 + (r & 7); }
__device__ __forceinline__ f32x4 i2f4(f32x4 v) { const i32x4v t = __builtin_bit_cast(i32x4v, v); return (f32x4){(float)t.x, (float)t.y, (float)t.z, (float)t.w}; }
struct Unit { int pm, pn; };
struct Gemm { const bf16_t* A; const bf16_t* Bt; int M, N, K; };
__device__ __forceinline__ int perm32(int rho) { const int n = rho >> 4, i = rho & 15; return 8 * (i >> 2) + 4 * n + (i & 3); }

__device__ __forceinline__ float row_rstd(const float* ssq, size_t row) {
    const f32x4* p = (const f32x4*)(ssq + row * 16);
    const f32x4 a = p[0], b = p[1], c = p[2], d = p[3];
    const float t = (((a.x + a.y) + (a.z + a.w)) + ((b.x + b.y) + (b.z + b.w))) + (((c.x + c.y) + (c.z + c.w)) + ((d.x + d.y) + (d.z + d.w)));
    return rsqrtf(t * (1.f / 1024.f) + EPS);
}
__device__ __forceinline__ void rows_rstd(const float* ssq, size_t row0, int fq, float (&rs)[2][4]) {
#pragma unroll
    for (int ai = 0; ai < 2; ++ai)
#pragma unroll
        for (int m = 0; m < 4; ++m) { const f32x4 a = *(const f32x4*)(ssq + (row0 + ai * 128 + m * 16) * 16 + 4 * fq); rs[ai][m] = (a.x + a.y) + (a.z + a.w); }
#pragma unroll
    for (int ai = 0; ai < 2; ++ai)
#pragma unroll
        for (int m = 0; m < 4; ++m) { float t = rs[ai][m]; t += __shfl_xor(t, 16); t += __shfl_xor(t, 32); rs[ai][m] = rsqrtf(t * (1.f / 1024.f) + EPS); }
}
template <bool ACC_I8 = false> struct EpiStoreBf16 {
    static constexpr bool PERM = true, AFTER_DRAIN = false;
    bf16_t* O; int ldc; const float* ssq; float dq = 1.f;
    __device__ __forceinline__ void operator()(const f32x4 (&acc)[2][2][4][2], const Unit& u, int wr, int wc, int fr, int fq) const {
        const int row0 = u.pm * 256 + wr * 64 + fr, col0 = u.pn * 256 + wc * 32 + 8 * fq;
        float rsv[2][4]; rows_rstd(ssq, (size_t)row0, fq, rsv);
#pragma unroll
        for (int ai = 0; ai < 2; ++ai)
#pragma unroll
            for (int m = 0; m < 4; ++m) {
                const float rs = ACC_I8 ? rsv[ai][m] * dq : rsv[ai][m];
                bf16_t* rowp = O + (size_t)(row0 + ai * 128 + m * 16) * ldc + col0;
#pragma unroll
                for (int bj = 0; bj < 2; ++bj) {
                    const f32x4 v0 = (ACC_I8 ? i2f4(acc[ai][bj][m][0]) : acc[ai][bj][m][0]) * rs, v1 = (ACC_I8 ? i2f4(acc[ai][bj][m][1]) : acc[ai][bj][m][1]) * rs;
                    u32x4 w; w.x = pk2(v0[0], v0[1]); w.y = pk2(v0[2], v0[3]); w.z = pk2(v1[0], v1[1]); w.w = pk2(v1[2], v1[3]);
                    *(u32x4*)(rowp + bj * 128) = w;
                }
            }
    }
};
struct EpiIn {
    static constexpr bool PERM = true, AFTER_DRAIN = false;
    bf16_t* P; bf16_t* KB; bf16_t* VT; const float* ssq;
    __device__ __forceinline__ void operator()(const f32x4 (&acc)[2][2][4][2], const Unit& u, int wr, int wc, int fr, int fq) const {
        bf16_t* O; int ldc, rt, ct; const bool main_unit = u.pn < TILE_WKV;
        if (main_unit) { O = P; ldc = PW; rt = u.pm - TILE_HN; ct = u.pn; }
        else if (u.pm >= TILE_MEMN) { const int l = (u.pn - TILE_WKV) >> 2; O = KB + (size_t)l * MT * 512; ldc = 512; rt = u.pm - TILE_MEMN; ct = (u.pn - TILE_WKV) & 3; }
        else { const int l = (u.pm - TILE_WKV) >> 2; O = VT + (size_t)l * 512 * MT; ldc = MT; rt = ((u.pm - TILE_WKV) & 3) - 2; ct = u.pn - TILE_MEMN; }
        const int row0 = rt * 256 + wr * 64 + fr, col0 = ct * 256 + wc * 32 + 8 * fq;
        float rsv[2][4];
        if (main_unit) rows_rstd(ssq, (size_t)row0, fq, rsv);
        else {
#pragma unroll
            for (int ai = 0; ai < 2; ++ai)
#pragma unroll
                for (int m = 0; m < 4; ++m) rsv[ai][m] = 1.f; }
#pragma unroll
        for (int ai = 0; ai < 2; ++ai)
#pragma unroll
            for (int m = 0; m < 4; ++m) {
                const float rs = rsv[ai][m];
                bf16_t* rowp = O + (size_t)(row0 + ai * 128 + m * 16) * ldc + col0;
#pragma unroll
                for (int bj = 0; bj < 2; ++bj) {
                    const f32x4 v0 = acc[ai][bj][m][0] * rs, v1 = acc[ai][bj][m][1] * rs;
                    u32x4 w; w.x = pk2(v0[0], v0[1]); w.y = pk2(v0[2], v0[3]); w.z = pk2(v1[0], v1[1]); w.w = pk2(v1[2], v1[3]);
                    *(u32x4*)(rowp + bj * 128) = w;
                }
            }
    }
};
template <bool ACC_I8 = false> struct EpiGeluBf16 {
    static constexpr bool PERM = true, AFTER_DRAIN = false;
    bf16_t* O; int ldc; const float* ssq; float* lnp; float dq = 1.f;
    __device__ __forceinline__ static f32x2 gelu_pk(f32x2 v) {
        const f32x2 av = __builtin_elementwise_abs(v), d = av * 0.2316418882f + 1.0f;
        f32x2 t; t.x = __builtin_amdgcn_rcpf(d.x); t.y = __builtin_amdgcn_rcpf(d.y);
        f32x2 q = t * 0.5307027145f + (-0.7265760135f); q = q * t + 0.7107068705f; q = q * t + (-0.142248368f); q = q * t + 0.127414796f; q = q * t;
        const f32x2 sq = (v * v) * (-0.72134752044f);
        f32x2 e; e.x = __builtin_amdgcn_exp2f(sq.x); e.y = __builtin_amdgcn_exp2f(sq.y);
        const f32x2 mm = v * (q * e), r = v - mm;
        f32x2 o; o.x = v.x < 0.f ? mm.x : r.x; o.y = v.y < 0.f ? mm.y : r.y; return o;
    }
    __device__ __forceinline__ static unsigned g2(float a, float b) { const f32x2 r = gelu_pk((f32x2){a, b}); return pk2(r.x, r.y); }
    __device__ __forceinline__ void operator()(const f32x4 (&acc)[2][2][4][2], const Unit& u, int wr, int wc, int fr, int fq) const {
        const int row0 = u.pm * 256 + wr * 64 + fr, col0 = u.pn * 256 + wc * 32 + 8 * fq;
        float rsv[2][4]; rows_rstd(ssq, (size_t)row0, fq, rsv);
#pragma unroll
        for (int ai = 0; ai < 2; ++ai)
#pragma unroll
            for (int m = 0; m < 4; ++m) {
                const size_t row = (size_t)(row0 + ai * 128 + m * 16);
                const float rs = ACC_I8 ? rsv[ai][m] * dq : rsv[ai][m];
                bf16_t* rowp = O + row * ldc + col0;
                float s1 = 0.f, s2 = 0.f;
#pragma unroll
                for (int bj = 0; bj < 2; ++bj) {
                    const f32x4 v0 = (ACC_I8 ? i2f4(acc[ai][bj][m][0]) : acc[ai][bj][m][0]) * rs, v1 = (ACC_I8 ? i2f4(acc[ai][bj][m][1]) : acc[ai][bj][m][1]) * rs;
                    const f32x2 ga = gelu_pk((f32x2){v0[0], v0[1]}), gb = gelu_pk((f32x2){v0[2], v0[3]}), gc = gelu_pk((f32x2){v1[0], v1[1]}), gd = gelu_pk((f32x2){v1[2], v1[3]});
                    u32x4 w; w.x = pk2(ga.x, ga.y); w.y = pk2(gb.x, gb.y); w.z = pk2(gc.x, gc.y); w.w = pk2(gd.x, gd.y);
                    *(u32x4*)(rowp + bj * 128) = w;
                    s1 += ((ga.x + ga.y) + (gb.x + gb.y)) + ((gc.x + gc.y) + (gd.x + gd.y));
                    s2 += ((ga.x * ga.x + ga.y * ga.y) + (gb.x * gb.x + gb.y * gb.y)) + ((gc.x * gc.x + gc.y * gc.y) + (gd.x * gd.x + gd.y * gd.y));
                }
                if (u.pn >= 4) {
                    s1 += __shfl_xor(s1, 16); s1 += __shfl_xor(s1, 32); s2 += __shfl_xor(s2, 16); s2 += __shfl_xor(s2, 32);
                    if (fq == 0) *(f32x2*)(lnp + (row * 16 + (u.pn - 4) * 4 + wc) * 2) = (f32x2){s1, s2};
                }
            }
    }
};
struct EpiSwigluBf16 {
    static constexpr bool PERM = true, AFTER_DRAIN = false;
    bf16_t* O; int ldc; const float* ssq;
    __device__ __forceinline__ void operator()(const f32x4 (&acc)[2][2][4][2], const Unit& u, int wr, int wc, int fr, int fq) const {
        const int row0 = u.pm * 256 + wr * 64 + fr, col0 = u.pn * 128 + wc * 32 + 8 * fq;
        float rsv[2][4]; rows_rstd(ssq, (size_t)row0, fq, rsv);
#pragma unroll
        for (int ai = 0; ai < 2; ++ai)
#pragma unroll
            for (int m = 0; m < 4; ++m) {
                const float rs = rsv[ai][m];
                bf16_t* rowp = O + (size_t)(row0 + ai * 128 + m * 16) * ldc + col0;
                const f32x4 g0 = acc[ai][0][m][0] * rs, g1 = acc[ai][0][m][1] * rs, u0 = acc[ai][1][m][0] * rs, u1 = acc[ai][1][m][1] * rs;
                u32x4 w;
                w.x = pk2(silu_f(g0[0]) * u0[0], silu_f(g0[1]) * u0[1]); w.y = pk2(silu_f(g0[2]) * u0[2], silu_f(g0[3]) * u0[3]);
                w.z = pk2(silu_f(g1[0]) * u1[0], silu_f(g1[1]) * u1[1]); w.w = pk2(silu_f(g1[2]) * u1[2], silu_f(g1[3]) * u1[3]);
                *(u32x4*)rowp = w;
            }
    }
};
template <bool ACC_I8, bool OUT_F8> struct EpiSwigluQ {
    static constexpr bool PERM = true, AFTER_DRAIN = false;
    void* O; int ldc; const float* ssq; float dq;
    __device__ __forceinline__ void operator()(const f32x4 (&acc)[2][2][4][2], const Unit& u, int wr, int wc, int fr, int fq) const {
        const int row0 = u.pm * 256 + wr * 64 + fr, col0 = u.pn * 128 + wc * 32 + 8 * fq;
        float rsv[2][4]; rows_rstd(ssq, (size_t)row0, fq, rsv);
#pragma unroll
        for (int ai = 0; ai < 2; ++ai)
#pragma unroll
            for (int m = 0; m < 4; ++m) {
                const float rs = ACC_I8 ? rsv[ai][m] * dq : rsv[ai][m], rsu = OUT_F8 ? rs * ACT_SC : rs;
                f32x4 g0 = acc[ai][0][m][0], g1 = acc[ai][0][m][1], u0 = acc[ai][1][m][0], u1 = acc[ai][1][m][1];
                if (ACC_I8) { g0 = i2f4(g0); g1 = i2f4(g1); u0 = i2f4(u0); u1 = i2f4(u1); }
                g0 = g0 * rs; g1 = g1 * rs; u0 = u0 * rsu; u1 = u1 * rsu;
                if (OUT_F8) {
                    unsigned char* rowp = (unsigned char*)O + (size_t)(row0 + ai * 128 + m * 16) * ldc + col0;
                    u32x2 w;
                    w.x = pk4_f8(silu_f(g0[0]) * u0[0], silu_f(g0[1]) * u0[1], silu_f(g0[2]) * u0[2], silu_f(g0[3]) * u0[3]);
                    w.y = pk4_f8(silu_f(g1[0]) * u1[0], silu_f(g1[1]) * u1[1], silu_f(g1[2]) * u1[2], silu_f(g1[3]) * u1[3]);
                    *(u32x2*)rowp = w;
                } else {
                    bf16_t* rowp = (bf16_t*)O + (size_t)(row0 + ai * 128 + m * 16) * ldc + col0;
                    u32x4 w;
                    w.x = pk2(silu_f(g0[0]) * u0[0], silu_f(g0[1]) * u0[1]); w.y = pk2(silu_f(g0[2]) * u0[2], silu_f(g0[3]) * u0[3]);
                    w.z = pk2(silu_f(g1[0]) * u1[0], silu_f(g1[1]) * u1[1]); w.w = pk2(silu_f(g1[2]) * u1[2], silu_f(g1[3]) * u1[3]);
                    *(u32x4*)rowp = w;
                }
            }
    }
};
template <bool BASE_F32, bool SCALED = false, bool W8 = false> struct EpiResid {
    static constexpr bool PERM = true, AFTER_DRAIN = false;
    const float* xbase; bf16_t* H; float* ssq; unsigned char* H8 = nullptr; float hq = 0.f; float asc = 1.f;
    __device__ __forceinline__ void operator()(const f32x4 (&acc)[2][2][4][2], const Unit& u, int wr, int wc, int fr, int fq) const {
        const int row0 = u.pm * 256 + wr * 64 + fr, col0 = u.pn * 256 + wc * 32 + 8 * fq;
#pragma unroll
        for (int ai = 0; ai < 2; ++ai)
#pragma unroll
            for (int m = 0; m < 4; ++m) {
                const size_t row = (size_t)(row0 + ai * 128 + m * 16);
                float ss = 0.f; u32x4 q8 = (u32x4){0u, 0u, 0u, 0u};
#pragma unroll
                for (int bj = 0; bj < 2; ++bj) {
                    const size_t off = row * 1024 + col0 + bj * 128;
                    f32x4 b0, b1;
                    if (BASE_F32) { b0 = *(const f32x4*)(xbase + off); b1 = *(const f32x4*)(xbase + off + 4); }
                    else { const u32x4 hw = *(const u32x4*)(H + off);
                        b0 = (f32x4){bf2f((unsigned short)(hw.x & 0xffffu)), bf2f((unsigned short)(hw.x >> 16)), bf2f((unsigned short)(hw.y & 0xffffu)), bf2f((unsigned short)(hw.y >> 16))};
                        b1 = (f32x4){bf2f((unsigned short)(hw.z & 0xffffu)), bf2f((unsigned short)(hw.z >> 16)), bf2f((unsigned short)(hw.w & 0xffffu)), bf2f((unsigned short)(hw.w >> 16))}; }
                    const float sc = SCALED ? asc : 1.f;
                    const f32x4 v0 = b0 + acc[ai][bj][m][0] * sc, v1 = b1 + acc[ai][bj][m][1] * sc;
                    u32x4 w; w.x = pk2(v0[0], v0[1]); w.y = pk2(v0[2], v0[3]); w.z = pk2(v1[0], v1[1]); w.w = pk2(v1[2], v1[3]);
                    *(u32x4*)(H + off) = w;
                    if (W8) { q8[2 * bj] = pk4_i8(v0[0], v0[1], v0[2], v0[3], hq); q8[2 * bj + 1] = pk4_i8(v1[0], v1[1], v1[2], v1[3], hq); }
                    ss += ((v0[0] * v0[0] + v0[1] * v0[1]) + (v0[2] * v0[2] + v0[3] * v0[3])) + ((v1[0] * v1[0] + v1[1] * v1[1]) + (v1[2] * v1[2] + v1[3] * v1[3]));
                }
                if (W8) *(u32x4*)(H8 + row * 1024 + u.pn * 256 + wc * 64 + fq * 16) = q8;
                ss += __shfl_xor(ss, 16); ss += __shfl_xor(ss, 32);
                if (fq == 0) ssq[row * 16 + u.pn * 4 + wc] = ss;
            }
    }
};
namespace pg8 {
#define PG8_LAS __attribute__((address_space(3)))
constexpr int BM = 256, BK = 64, HALF = 128, HTB = HALF * BK * 2  , STAGE_BYTES = 8 * HTB, NXCD = 8, WGM = 8;
__host__ __device__ __forceinline__ int lds_byte(int r, int c) { const int st = (r >> 4) * 2 + (c >> 5), rr = r & 15, cc = c & 31, ob = rr * 64 + cc * 2; return st * 1024 + (ob ^ (((ob >> 9) & 1) << 5)); }
__host__ __device__ __forceinline__ void stage_rc(int b, int& R, int& C) { const int st = b / 1024, sb = b % 1024, swz = sb ^ (((sb >> 9) & 1) << 5); R = (st >> 1) * 16 + swz / 64; C = (st & 1) * 32 + (swz % 64) / 2; }
struct StaticOrder {
    int nM, nN, nwg, G, c;
    __host__ __device__ void init(int M, int N, int G_, int c_) { nM = M / BM; nN = N / BM; nwg = nM * nN; G = G_; c = c_; }
    __host__ __device__ bool next(int i, Unit& u) const {
        const long L = (long)i * G + c; if (L >= nwg) return false;
        int wgid = (int)L; { const int q = nwg / NXCD, r = nwg % NXCD, xcd = wgid % NXCD, off = wgid / NXCD; wgid = (xcd < r ? xcd * (q + 1) : r * (q + 1) + (xcd - r) * q) + off; }
        const int nig = WGM * nN, gid = wgid / nig, fm = gid * WGM, gsz = (nM - fm) < WGM ? (nM - fm) : WGM;
        u.pm = fm + ((wgid % nig) % gsz); u.pn = (wgid % nig) / gsz; return true;
    }
    __device__ __forceinline__ void a_ready(const Unit&) const {}
    __device__ __forceinline__ void done(const Unit&) const {}
};
struct ComboOrder {
    StaticOrder so;
    __host__ __device__ void init(int G_, int c_) { so.init(T, PW, G_, c_); }
    __host__ __device__ bool next(int i, Unit& u) const {
        const long L = (long)i * so.G + so.c;
        if (L < so.nwg) { so.next(i, u); u.pm += TILE_HN; return true; }
        const int j = (int)(L - so.nwg); if (j >= 128) return false;
        const int l = j >> 6, jj = j & 63;
        if (jj < 32) { u.pm = TILE_MEMN + (jj >> 1); u.pn = TILE_WKV + 4 * l + (jj & 1); }
        else { const int q = jj - 32; u.pm = TILE_WKV + 4 * l + 2 + (q >> 4); u.pn = TILE_MEMN + (q & 15); }
        return true;
    }
    __device__ __forceinline__ void a_ready(const Unit&) const {}
    __device__ __forceinline__ void done(const Unit&) const {}
};
template <class Epi, class Sched, bool ALIGN_EPI = false, bool SP2 = false, int QM = 0  >
__device__ __forceinline__ void gemm_phase(PG8_LAS unsigned char* lds, const Gemm g, const Sched& S, const Epi& E) {
    const int tid = otid(), wid = __builtin_amdgcn_readfirstlane(tid >> 6), lane = tid & 63, wr = wid >> 2, wc = wid & 3, fr = lane & 15, fq = lane >> 4;
    constexpr bool FP8 = (QM == 1), I8 = (QM == 2);
    const int K = g.K, nt = K / BK;
    unsigned voffA[2], voffB[2];
#pragma unroll
    for (int i = 0; i < 2; ++i) { int R, C; stage_rc(tid * 16 + i * 8192, R, C); const int Rb = Epi::PERM ? ((R & ~31) + perm32(R & 31)) : R;
        voffA[i] = (unsigned)(R * K + C) * 2u; voffB[i] = (unsigned)(Rb * K + C) * 2u; }
    const size_t kstep = (size_t)(BK * 2);
    const size_t hstep = (size_t)HALF * K * 2;
    const size_t tstep = 2 * hstep;
    const unsigned ldsw = (unsigned)wid * 1024u;
    const int aoff = lds_byte(wr * 64 + fr, fq * 8), boff = lds_byte(wc * 32 + fr, fq * 8);
#define PG8_SA(b, h) (((b) * 2 + (h)) * HTB)
#define PG8_SB(b, h) ((4 + (b) * 2 + (h)) * HTB)
#define PG8_STAGE(bufoff, gbase, voff) do { _Pragma("unroll") for (int _i = 0; _i < 2; ++_i) \
        __builtin_amdgcn_global_load_lds((const unsigned*)((const char*)(gbase) + (voff)[_i]), (PG8_LAS unsigned*)(lds + (bufoff) + ldsw + _i * 8192), 16, 0, 0); } while (0)
#define PG8_LD16(off) (*(const PG8_LAS bf16x8*)(lds + (off)))
#define PG8_LDA(dst, b, h) do { _Pragma("unroll") for (int m = 0; m < 4; ++m) { \
        if constexpr (FP8) dst##8[m] = PG8_CAT(PG8_LD16(PG8_SA(b, h) + aoff + m * 2048), PG8_LD16(PG8_SA(b, h) + aoff + m * 2048 + 1024)); \
        else { _Pragma("unroll") for (int k = 0; k < 2; ++k) dst[m][k] = PG8_LD16(PG8_SA(b, h) + aoff + m * 2048 + k * 1024); } } } while (0)
#define PG8_LDB(dst, b, h) do { _Pragma("unroll") for (int n = 0; n < 2; ++n) { \
        if constexpr (FP8) dst##8[n] = PG8_CAT(PG8_LD16(PG8_SB(b, h) + boff + n * 2048), PG8_LD16(PG8_SB(b, h) + boff + n * 2048 + 1024)); \
        else { _Pragma("unroll") for (int k = 0; k < 2; ++k) dst[n][k] = PG8_LD16(PG8_SB(b, h) + boff + n * 2048 + k * 1024); } } } while (0)
#define PG8_CAT(x, y) __builtin_shufflevector(__builtin_bit_cast(i32x4v, x), __builtin_bit_cast(i32x4v, y), 0, 1, 2, 3, 4, 5, 6, 7)
#define PG8_MMA(ai, bj, At, Bt) do { __builtin_amdgcn_s_setprio(1); \
        if constexpr (FP8) { _Pragma("unroll") for (int m = 0; m < 4; ++m) _Pragma("unroll") for (int n = 0; n < 2; ++n) \
            asm("v_mfma_f32_16x16x128_f8f6f4 %0, %1, %2, %0" : "+v"(acc[ai][bj][m][n]) : "v"(Bt##8[n]), "v"(At##8[m])); } \
        else if constexpr (I8) { _Pragma("unroll") for (int m = 0; m < 4; ++m) _Pragma("unroll") for (int n = 0; n < 2; ++n) _Pragma("unroll") for (int k = 0; k < 2; ++k) \
            acc[ai][bj][m][n] = __builtin_bit_cast(f32x4, __builtin_amdgcn_mfma_i32_16x16x64_i8(__builtin_bit_cast(i32x4v, Bt[n][k]), __builtin_bit_cast(i32x4v, At[m][k]), __builtin_bit_cast(i32x4v, acc[ai][bj][m][n]), 0, 0, 0)); } \
        else { _Pragma("unroll") for (int m = 0; m < 4; ++m) _Pragma("unroll") for (int n = 0; n < 2; ++n) _Pragma("unroll") for (int k = 0; k < 2; ++k) \
            acc[ai][bj][m][n] = __builtin_amdgcn_mfma_f32_16x16x32_bf16(Bt[n][k], At[m][k], acc[ai][bj][m][n], 0, 0, 0); } \
        __builtin_amdgcn_s_setprio(0); } while (0)
#define PG8_WAIT_V(n) asm volatile("s_waitcnt vmcnt(" #n ")" ::: "memory")
#define PG8_WAIT_L(n) asm volatile("s_waitcnt lgkmcnt(" #n ")" ::: "memory")
#define PG8_BAR __builtin_amdgcn_s_barrier()
#define PG8_SCHED __builtin_amdgcn_sched_barrier(0)
    Unit cur, nxt; int ui = 0;
    if (!S.next(0, cur)) return;
    f32x4 acc[2][2][4][2];
#pragma unroll
    for (int a = 0; a < 2; ++a)
#pragma unroll
        for (int b = 0; b < 2; ++b)
#pragma unroll
            for (int m = 0; m < 4; ++m)
#pragma unroll
                for (int n = 0; n < 2; ++n) acc[a][b][m][n] = (f32x4){0.f, 0.f, 0.f, 0.f};
    bf16x8 At[4][2], B0[2][2], B1[2][2];
    i32x8v At8[4], B08[2], B18[2];
    const char* cA = (const char*)g.A + (size_t)cur.pm * tstep; const char* cB = (const char*)g.Bt + (size_t)cur.pn * tstep;
    S.a_ready(cur);
    if constexpr (SP2) {
        PG8_STAGE(PG8_SB(0, 0), cB, voffB); PG8_STAGE(PG8_SB(0, 1), cB + hstep, voffB); PG8_STAGE(PG8_SA(0, 0), cA, voffA); PG8_STAGE(PG8_SA(0, 1), cA + hstep, voffA);
        if (wr == 1) PG8_BAR;
        PG8_WAIT_V(2); PG8_BAR;
        PG8_STAGE(PG8_SB(1, 0), cB + kstep, voffB); PG8_STAGE(PG8_SA(1, 0), cA + kstep, voffA); PG8_STAGE(PG8_SB(1, 1), cB + hstep + kstep, voffB);
        PG8_WAIT_V(6); PG8_BAR;
    } else {
        PG8_STAGE(PG8_SB(0, 0), cB, voffB); PG8_STAGE(PG8_SA(0, 0), cA, voffA); PG8_STAGE(PG8_SB(0, 1), cB + hstep, voffB); PG8_STAGE(PG8_SA(0, 1), cA + hstep, voffA);
        if (wr == 1) PG8_BAR;
        PG8_WAIT_V(4); PG8_BAR;
        PG8_STAGE(PG8_SB(1, 0), cB + kstep, voffB); PG8_STAGE(PG8_SA(1, 0), cA + kstep, voffA); PG8_STAGE(PG8_SB(1, 1), cB + hstep + kstep, voffB);
        PG8_WAIT_V(6); PG8_BAR;
    }
    for (;;) {
        const bool has_next = S.next(ui + 1, nxt);
        const char* nA = has_next ? (const char*)g.A + (size_t)nxt.pm * tstep : cA; const char* nB = has_next ? (const char*)g.Bt + (size_t)nxt.pn * tstep : cB;
        for (int t = 0; t < nt; t += 2) {
            const bool last = (t == nt - 2);
            if constexpr (FP8) __builtin_amdgcn_s_waitcnt(0xC07F);
            const char* a1 = cA + (size_t)(t + 1) * kstep;
            const char* a2 = last ? nA : cA + (size_t)(t + 2) * kstep; const char* b2 = last ? nB : cB + (size_t)(t + 2) * kstep;
            const char* a3 = a2 + kstep; const char* b3 = b2 + kstep;
            if (last && has_next) S.a_ready(nxt);
            if constexpr (SP2) {
            PG8_LDB(B0, 0, 0); PG8_LDB(B1, 0, 1); PG8_SCHED; PG8_LDA(At, 0, 0); PG8_STAGE(PG8_SA(1, 1), a1 + hstep, voffA);
            PG8_WAIT_V(8); PG8_WAIT_L(0); PG8_BAR; PG8_MMA(0, 0, At, B0); PG8_MMA(0, 1, At, B1); PG8_BAR; PG8_SCHED;
            PG8_LDA(At, 0, 1); PG8_STAGE(PG8_SB(0, 0), b2, voffB); PG8_STAGE(PG8_SB(0, 1), b2 + hstep, voffB); PG8_STAGE(PG8_SA(0, 0), a2, voffA);
            PG8_WAIT_V(8); PG8_WAIT_L(0); PG8_BAR; PG8_MMA(1, 0, At, B0); PG8_MMA(1, 1, At, B1); PG8_BAR; PG8_SCHED;
            PG8_LDB(B0, 1, 0); PG8_LDB(B1, 1, 1); PG8_SCHED; PG8_LDA(At, 1, 0); PG8_STAGE(PG8_SA(0, 1), a2 + hstep, voffA);
            PG8_WAIT_V(8); PG8_WAIT_L(0); PG8_BAR; PG8_MMA(0, 0, At, B0); PG8_MMA(0, 1, At, B1); PG8_BAR; PG8_SCHED;
            PG8_LDA(At, 1, 1); PG8_STAGE(PG8_SB(1, 0), b3, voffB); PG8_STAGE(PG8_SB(1, 1), b3 + hstep, voffB); PG8_STAGE(PG8_SA(1, 0), a3, voffA);
            PG8_WAIT_V(8); PG8_WAIT_L(0); PG8_BAR; PG8_MMA(1, 0, At, B0); PG8_MMA(1, 1, At, B1); PG8_BAR; PG8_SCHED;
            } else {
            PG8_LDB(B0, 0, 0); PG8_SCHED; PG8_LDA(At, 0, 0); PG8_STAGE(PG8_SA(1, 1), a1 + hstep, voffA);
            PG8_WAIT_L(8); PG8_BAR; PG8_WAIT_L(0); PG8_MMA(0, 0, At, B0); PG8_BAR; PG8_SCHED;
            PG8_LDB(B1, 0, 1); PG8_STAGE(PG8_SB(0, 0), b2, voffB);
            PG8_BAR; PG8_WAIT_L(0); PG8_MMA(0, 1, At, B1); PG8_BAR;
            PG8_LDA(At, 0, 1); PG8_STAGE(PG8_SA(0, 0), a2, voffA);
            PG8_BAR; PG8_WAIT_L(0); PG8_MMA(1, 0, At, B0); PG8_BAR; PG8_SCHED;
            PG8_STAGE(PG8_SB(0, 1), b2 + hstep, voffB);
            PG8_WAIT_V(6); PG8_BAR; PG8_MMA(1, 1, At, B1); PG8_BAR;
            PG8_LDB(B0, 1, 0); PG8_SCHED; PG8_LDA(At, 1, 0); PG8_STAGE(PG8_SA(0, 1), a2 + hstep, voffA);
            PG8_WAIT_L(8); PG8_BAR; PG8_WAIT_L(0); PG8_MMA(0, 0, At, B0); PG8_BAR; PG8_SCHED;
            PG8_LDB(B1, 1, 1); PG8_STAGE(PG8_SB(1, 0), b3, voffB);
            PG8_BAR; PG8_WAIT_L(0); PG8_MMA(0, 1, At, B1); PG8_BAR;
            PG8_LDA(At, 1, 1); PG8_STAGE(PG8_SA(1, 0), a3, voffA);
            PG8_BAR; PG8_WAIT_L(0); PG8_MMA(1, 0, At, B0); PG8_BAR; PG8_SCHED;
            PG8_STAGE(PG8_SB(1, 1), b3 + hstep, voffB);
            PG8_WAIT_V(6); PG8_BAR; PG8_MMA(1, 1, At, B1); PG8_BAR;
            }
        }
        if constexpr (FP8) asm volatile("s_nop 15\n\ts_nop 15" ::: "memory");
        if constexpr (ALIGN_EPI) { if (wr == 0) PG8_BAR; }
        if constexpr (!Epi::AFTER_DRAIN) { E(acc, cur, wr, wc, fr, fq); S.done(cur); }
        if (!has_next) break;
#pragma unroll
        for (int a = 0; a < 2; ++a)
#pragma unroll
            for (int b = 0; b < 2; ++b)
#pragma unroll
                for (int m = 0; m < 4; ++m)
#pragma unroll
                    for (int n = 0; n < 2; ++n) acc[a][b][m][n] = (f32x4){0.f, 0.f, 0.f, 0.f};
        cur = nxt; cA = nA; cB = nB; ++ui;
        if constexpr (ALIGN_EPI) { if (wr == 1) PG8_BAR; }
    }
    PG8_WAIT_V(0);
    if constexpr (!ALIGN_EPI) { if (wr == 0) PG8_BAR; }
    PG8_BAR;
    if constexpr (Epi::AFTER_DRAIN) { E.fused(acc, cur, wr, wc, fr, fq, lds, wid, lane); S.done(cur); }
#undef PG8_SA
#undef PG8_SB
#undef PG8_STAGE
#undef PG8_LDA
#undef PG8_LD16
#undef PG8_LDB
#undef PG8_MMA
#undef PG8_CAT
#undef PG8_WAIT_V
#undef PG8_WAIT_L
#undef PG8_BAR
#undef PG8_SCHED
}
}

template <class Epi, int QM = 0>
__device__ __forceinline__ void run_gemm(const Gemm g, const Epi& E, LAS float* lds, int vb, int nvb) {
    pg8::StaticOrder S; S.init(g.M, g.N, nvb, vb);
    pg8::gemm_phase<Epi, pg8::StaticOrder, true, true, QM>((LAS unsigned char*)lds, g, S, E);
}

enum { MAP_ID = 0, MAP_WIN = 1, MAP_GU = 2 };
struct PrepJob { const float* W; int K, N; const float* gain; bf16_t* dst; int r0, r1, ldd, koff, map; int fmt; float osc; };
__device__ __forceinline__ int map_src(int map, int r, int N) {
    if (map == MAP_ID) return r < N ? r : -1;
    if (map == MAP_WIN) {
        if (r < 1728) return r - 512;
        if (r < 3776) return r - 504;
        if (r < 3784) return r - 2560;
        return -1;
    }
    { const int tile = r >> 8, w = r & 255, j = tile * 128 + (w & 127); return w < 128 ? j : FF + j; }
}
__device__ __forceinline__ void prep_tile_load(const PrepJob& j, int t, f32x4 (&v)[8]) {
    const int nkt = j.K / 64, kt = t % nkt, rt = t / nkt, k0 = kt * 64, r0 = j.r0 + rt * 256;
#pragma unroll
    for (int q = 0; q < 8; ++q) {
        const int i = (int)threadIdx.x + q * NTHREADS, kk = i >> 6, r4 = (i & 63) * 4;
        const int sc = map_src(j.map, r0 + r4, j.N);
        v[q] = sc >= 0 ? __builtin_nontemporal_load((const f32x4*)(j.W + (size_t)(k0 + kk) * j.N + sc)) : (f32x4){0.f, 0.f, 0.f, 0.f};
        if (j.gain) v[q] = v[q] * j.gain[k0 + kk];
    }
}
__device__ __forceinline__ void prep_tile_store(const PrepJob& j, int t, const f32x4 (&v)[8], LAS float* tile  ) {
    const int nkt = j.K / 64, kt = t % nkt, rt = t / nkt, k0 = kt * 64, r0 = j.r0 + rt * 256;
    __syncthreads();
#pragma unroll
    for (int q = 0; q < 8; ++q) { const int i = (int)threadIdx.x + q * NTHREADS, kk = i >> 6, r4 = (i & 63) * 4; *(LAS f32x4*)(tile + kk * 260 + r4) = v[q]; }
    __syncthreads();
#pragma unroll
    for (int q = 0; q < 4; ++q) {
        const int i = (int)threadIdx.x + q * NTHREADS, rr = i & 255, c8 = i >> 8;
        const LAS float* tp = tile + (c8 * 8) * 260 + rr;
        if (j.fmt != 0) {
            const float sc = j.osc; u32x2 w;
            if (j.fmt == 1 || j.fmt == 3) { w.x = pk4_f8(tp[0] * sc, tp[260] * sc, tp[520] * sc, tp[780] * sc); w.y = pk4_f8(tp[1040] * sc, tp[1300] * sc, tp[1560] * sc, tp[1820] * sc); }
            else { w.x = pk4_i8(tp[0], tp[260], tp[520], tp[780], sc); w.y = pk4_i8(tp[1040], tp[1300], tp[1560], tp[1820], sc); }
            unsigned char* drow = (unsigned char*)j.dst + (size_t)(r0 + rr) * j.ldd + j.koff; const int kk = k0 + c8 * 8;
            if (j.fmt == 3) { const int r = kk & 127, pp = (kk & ~127) + (r >> 5) * 16 + ((r >> 3) & 3) * 4; *(unsigned*)(drow + pp) = w.x; *(unsigned*)(drow + pp + 64) = w.y; }
            else *(u32x2*)(drow + (j.fmt == 2 ? kperm8(kk) : kk)) = w;
        } else {
        u32x4 w; w.x = pk2(tp[0], tp[260]); w.y = pk2(tp[520], tp[780]); w.z = pk2(tp[1040], tp[1300]); w.w = pk2(tp[1560], tp[1820]);
        *(u32x4*)(j.dst + (size_t)(r0 + rr) * j.ldd + j.koff + k0 + c8 * 8) = w;
        }
    }
}
__device__ __forceinline__ void prep_fold_in(const float* w_in  , const float* w_uk  , const float* gain, bf16_t* dst, LAS float* lds, int vb, int nvb) {
    LAS float* A = lds; LAS float* B = lds + 32 * 65;
    const int tid = otid(), lane = tid & 63, wid = __builtin_amdgcn_readfirstlane(tid >> 6), l15 = lane & 15, dq = lane >> 4;
    for (int item = vb; item < 256; item += nvb) {
        const int h = item >> 5, k0 = (item & 31) * 32;
        __syncthreads();
        for (int i = tid; i < 2048; i += NTHREADS) { const int kk = i >> 6, d = i & 63; A[kk * 65 + d] = w_in[(size_t)(k0 + kk) * 3272 + h * 64 + d] * gain[k0 + kk]; }
        for (int i = tid; i < 8192; i += NTHREADS) { const int c = i >> 6, d = i & 63; B[c * 65 + d] = w_uk[(size_t)(h * 128 + c) * 64 + d]; }
        __syncthreads();
        f32x4 acc0 = (f32x4){0.f, 0.f, 0.f, 0.f}, acc1 = acc0;
#pragma unroll 4
        for (int d0 = 0; d0 < 64; d0 += 4) {
            const float b = B[(16 * wid + l15) * 65 + d0 + dq], a0 = A[l15 * 65 + d0 + dq], a1 = A[(16 + l15) * 65 + d0 + dq];
            acc0 = __builtin_amdgcn_mfma_f32_16x16x4f32(a0, b, acc0, 0, 0, 0);
            acc1 = __builtin_amdgcn_mfma_f32_16x16x4f32(a1, b, acc1, 0, 0, 0);
        }
        bf16_t* drow = dst + (size_t)(h * 128 + 16 * wid + l15) * 1024 + k0 + 4 * dq;
        { u32x2 w; w.x = pk2(acc0[0], acc0[1]); w.y = pk2(acc0[2], acc0[3]); *(u32x2*)drow = w; }
        { u32x2 w; w.x = pk2(acc1[0], acc1[1]); w.y = pk2(acc1[2], acc1[3]); *(u32x2*)(drow + 16) = w; }
    }
}
__device__ __forceinline__ void prep_fold_out(const float* w_out  , const float* w_uv  , bf16_t* dst  , LAS float* lds, int vb, int nvb) {
    LAS float* A = lds; LAS float* B = lds + 64 * 33;
    const int tid = otid(), lane = tid & 63, wid = __builtin_amdgcn_readfirstlane(tid >> 6), l15 = lane & 15, dq = lane >> 4;
    for (int item = vb; item < 256; item += nvb) {
        const int h = item >> 5, n0 = (item & 31) * 32;
        __syncthreads();
        for (int i = tid; i < 2048; i += NTHREADS) { const int d = i >> 5, nn = i & 31; A[d * 33 + nn] = w_out[(size_t)(h * 64 + d) * 1024 + n0 + nn]; }
        for (int i = tid; i < 8192; i += NTHREADS) { const int c = i >> 6, d = i & 63; B[c * 65 + d] = w_uv[(size_t)(h * 128 + c) * 64 + d]; }
        __syncthreads();
        f32x4 acc0 = (f32x4){0.f, 0.f, 0.f, 0.f}, acc1 = acc0;
#pragma unroll 4
        for (int d0 = 0; d0 < 64; d0 += 4) {
            const float a = B[(16 * wid + l15) * 65 + d0 + dq], b0 = A[(d0 + dq) * 33 + l15], b1 = A[(d0 + dq) * 33 + 16 + l15];
            acc0 = __builtin_amdgcn_mfma_f32_16x16x4f32(a, b0, acc0, 0, 0, 0);
            acc1 = __builtin_amdgcn_mfma_f32_16x16x4f32(a, b1, acc1, 0, 0, 0);
        }
        { u32x2 w; w.x = pk2(acc0[0], acc0[1]); w.y = pk2(acc0[2], acc0[3]); *(u32x2*)(dst + (size_t)(n0 + l15) * KOUT + h * 128 + 16 * wid + 4 * dq) = w; }
        { u32x2 w; w.x = pk2(acc1[0], acc1[1]); w.y = pk2(acc1[2], acc1[3]); *(u32x2*)(dst + (size_t)(n0 + 16 + l15) * KOUT + h * 128 + 16 * wid + 4 * dq) = w; }
    }
}
__device__ __forceinline__ void prep_lb(const float* hgrn_lb  , float* lb, int vb, int nvb) {
    for (int i = vb * NTHREADS + threadIdx.x; i < 512; i += nvb * NTHREADS) {
        const float a = hgrn_lb[i], b = hgrn_lb[512 + i], c = hgrn_lb[1024 + i], m = fmaxf(a, fmaxf(b, c));
        const float ea = __expf(a - m), eb = __expf(b - m), ec = __expf(c - m);
        lb[i] = ea / (ea + eb + ec);
    }
}

__device__ __forceinline__ void rmsnorm_rows(const float* X, bf16_t* Y, int nrows, int vb, int nvb) {
    const int tid = otid(), lane = tid & 63, gw = vb * NWAVES + __builtin_amdgcn_readfirstlane(tid >> 6), ngw = nvb * NWAVES;
    for (int r = gw; r < nrows; r += ngw) {
        const f32x4* xr = (const f32x4*)(X + (size_t)r * D) + lane;
        f32x4 v[4]; float s = 0.f;
#pragma unroll
        for (int j = 0; j < 4; ++j) { v[j] = xr[64 * j]; s += (v[j].x * v[j].x + v[j].y * v[j].y) + (v[j].z * v[j].z + v[j].w * v[j].w); }
        const float rs = rsqrtf(wave_sum(s) * (1.f / D) + EPS);
        u32x2* o = (u32x2*)(Y + (size_t)r * D) + lane;
#pragma unroll
        for (int j = 0; j < 4; ++j) { u32x2 w; w.x = pk2(v[j].x * rs, v[j].y * rs); w.y = pk2(v[j].z * rs, v[j].w * rs); o[64 * j] = w; }
    }
}
__device__ __forceinline__ void x_to_h_rows(const float* X, bf16_t* H, float* ssq, int vb, int nvb) {
    const int tid = otid(), lane = tid & 63, gw = vb * NWAVES + __builtin_amdgcn_readfirstlane(tid >> 6), ngw = nvb * NWAVES;
    for (int r = gw; r < T; r += 2 * ngw) {
        const int r2 = (r + ngw < T) ? r + ngw : r;
        f32x4 v[2][4];
#pragma unroll
        for (int j = 0; j < 4; ++j) { v[0][j] = __builtin_nontemporal_load((const f32x4*)(X + (size_t)r * D) + lane + 64 * j); v[1][j] = __builtin_nontemporal_load((const f32x4*)(X + (size_t)r2 * D) + lane + 64 * j); }
#pragma unroll
        for (int q = 0; q < 2; ++q) {
            const int rr = q ? r2 : r;
            u32x2* o = (u32x2*)(H + (size_t)rr * D) + lane;
            float s = 0.f;
#pragma unroll
            for (int j = 0; j < 4; ++j) { const f32x4 x = v[q][j]; u32x2 w; w.x = pk2(x.x, x.y); w.y = pk2(x.z, x.w); o[64 * j] = w;
                const float a = bf2f((unsigned short)(w.x & 0xffffu)), b = bf2f((unsigned short)(w.x >> 16)), c = bf2f((unsigned short)(w.y & 0xffffu)), d = bf2f((unsigned short)(w.y >> 16));
                s += (a * a + b * b) + (c * c + d * d); }
            s = wave_sum(s);
            if (lane < 16) ssq[(size_t)rr * 16 + lane] = lane == 0 ? s : 0.f;
        }
    }
}
__device__ __forceinline__ void final_rows(const bf16_t* H, const float* ssq, const float* g, float* out, int vb, int nvb) {
    const int tid = otid(), lane = tid & 63, gw = vb * NWAVES + __builtin_amdgcn_readfirstlane(tid >> 6), ngw = nvb * NWAVES;
    f32x4 gg[4];
#pragma unroll
    for (int j = 0; j < 4; ++j) gg[j] = *((const f32x4*)g + lane + 64 * j);
    for (int r = gw; r < T; r += 2 * ngw) {
        const int r2 = (r + ngw < T) ? r + ngw : r;
        u32x2 w[2][4]; float rs[2];
#pragma unroll
        for (int j = 0; j < 4; ++j) { w[0][j] = ((const u32x2*)(H + (size_t)r * D) + lane)[64 * j]; w[1][j] = ((const u32x2*)(H + (size_t)r2 * D) + lane)[64 * j]; }
        rs[0] = row_rstd(ssq, (size_t)r); rs[1] = row_rstd(ssq, (size_t)r2);
#pragma unroll
        for (int q = 0; q < 2; ++q) {
            f32x4* o = (f32x4*)(out + (size_t)(q ? r2 : r) * D) + lane;
#pragma unroll
            for (int j = 0; j < 4; ++j) { const u32x2 ww = w[q][j];
                __builtin_nontemporal_store((f32x4){bf2f((unsigned short)(ww.x & 0xffffu)) * rs[q] * gg[j].x, bf2f((unsigned short)(ww.x >> 16)) * rs[q] * gg[j].y, bf2f((unsigned short)(ww.y & 0xffffu)) * rs[q] * gg[j].z, bf2f((unsigned short)(ww.y >> 16)) * rs[q] * gg[j].w}, o + 64 * j); }
        }
    }
}
__device__ __forceinline__ float row16_sum(float v) {
    v += __uint_as_float((unsigned)__builtin_amdgcn_update_dpp(0, (int)__float_as_uint(v), 0x128, 0xf, 0xf, false));
    v += __uint_as_float((unsigned)__builtin_amdgcn_update_dpp(0, (int)__float_as_uint(v), 0x124, 0xf, 0xf, false));
    v += __uint_as_float((unsigned)__builtin_amdgcn_update_dpp(0, (int)__float_as_uint(v), 0x122, 0xf, 0xf, false));
    v += __uint_as_float((unsigned)__builtin_amdgcn_update_dpp(0, (int)__float_as_uint(v), 0x121, 0xf, 0xf, false));
    return v;
}
__device__ __forceinline__ void cnorm_rows(const bf16_t* P, const float* lat_g, bf16_t* CN, int vb, int nvb) {
    const int tid = otid(), lane = tid & 63, gw = vb * NWAVES + __builtin_amdgcn_readfirstlane(tid >> 6), ngw = nvb * NWAVES, r4 = lane >> 4, l16 = lane & 15;
    const f32x4 ga = *(const f32x4*)(lat_g + l16 * 8), gb = *(const f32x4*)(lat_g + l16 * 8 + 4);
    for (int r = gw * 8; r < T; r += ngw * 8) {
        u32x4 w[2];
#pragma unroll
        for (int q = 0; q < 2; ++q) w[q] = *(const u32x4*)(P + (size_t)(r + 4 * q + r4) * PW + P_C + l16 * 8);
#pragma unroll
        for (int q = 0; q < 2; ++q) {
            const float x0 = bf2f((unsigned short)(w[q].x & 0xffffu)), x1 = bf2f((unsigned short)(w[q].x >> 16)), x2 = bf2f((unsigned short)(w[q].y & 0xffffu)), x3 = bf2f((unsigned short)(w[q].y >> 16));
            const float x4 = bf2f((unsigned short)(w[q].z & 0xffffu)), x5 = bf2f((unsigned short)(w[q].z >> 16)), x6 = bf2f((unsigned short)(w[q].w & 0xffffu)), x7 = bf2f((unsigned short)(w[q].w >> 16));
            const float ss = row16_sum(((x0 * x0 + x1 * x1) + (x2 * x2 + x3 * x3)) + ((x4 * x4 + x5 * x5) + (x6 * x6 + x7 * x7)));
            const float rs = rsqrtf(ss * (1.f / 128.f) + EPS);
            u32x4 o; o.x = pk2(x0 * rs * ga.x, x1 * rs * ga.y); o.y = pk2(x2 * rs * ga.z, x3 * rs * ga.w); o.z = pk2(x4 * rs * gb.x, x5 * rs * gb.y); o.w = pk2(x6 * rs * gb.z, x7 * rs * gb.w);
            *(u32x4*)(CN + (size_t)(r + 4 * q + r4) * 128 + l16 * 8) = o;
        }
    }
}
__device__ __forceinline__ int t5_bucket(int rel) {
    const int n = rel < 0 ? -rel : rel;
    int b = n < 8 ? n : 8 + (n >= 12) + (n >= 16) + (n >= 23) + (n >= 32) + (n >= 46) + (n >= 64) + (n >= 91);
    return b + (rel > 0 ? 16 : 0);
}
__device__ __forceinline__ unsigned sort_key(float x) { const unsigned u = __float_as_uint(x); return (u & 0x80000000u) ? ~u : (u | 0x80000000u); }


template <int CTRL, int ROWMASK> __device__ __forceinline__ unsigned dpp0(unsigned v) { return (unsigned)__builtin_amdgcn_update_dpp(0, (int)v, CTRL, ROWMASK, 0xf, false); }
__device__ __forceinline__ unsigned wave_prefix_incl(unsigned v) {
    v += dpp0<0x111, 0xf>(v); v += dpp0<0x112, 0xf>(v); v += dpp0<0x114, 0xf>(v); v += dpp0<0x118, 0xf>(v);
    v += dpp0<0x142, 0xa>(v);
    v += dpp0<0x143, 0xc>(v);
    return v;
}
__device__ __forceinline__ float wave_max_u(float v) {
    v = fmaxf(v, __uint_as_float((unsigned)__builtin_amdgcn_update_dpp(0, (int)__float_as_uint(v), 0x128, 0xf, 0xf, false)));
    v = fmaxf(v, __uint_as_float((unsigned)__builtin_amdgcn_update_dpp(0, (int)__float_as_uint(v), 0x124, 0xf, 0xf, false)));
    v = fmaxf(v, __uint_as_float((unsigned)__builtin_amdgcn_update_dpp(0, (int)__float_as_uint(v), 0x122, 0xf, 0xf, false)));
    v = fmaxf(v, __uint_as_float((unsigned)__builtin_amdgcn_update_dpp(0, (int)__float_as_uint(v), 0x121, 0xf, 0xf, false)));
    const int b = (int)__float_as_uint(v);
    return fmaxf(fmaxf(__uint_as_float((unsigned)__builtin_amdgcn_readlane(b, 0)), __uint_as_float((unsigned)__builtin_amdgcn_readlane(b, 16))),
                 fmaxf(__uint_as_float((unsigned)__builtin_amdgcn_readlane(b, 32)), __uint_as_float((unsigned)__builtin_amdgcn_readlane(b, 48))));
}

typedef short v4i16_t __attribute__((ext_vector_type(4)));
constexpr int DSA_BT_OFF = 131072 + 256, DSA_WS_OFF = DSA_BT_OFF + 6144;
__device__ __forceinline__ unsigned dsa_bucket(float x, float lo, float sc) { const float f = (x - lo) * sc; const unsigned b = (unsigned)f; return b > 255u ? 255u : b; }
__device__ __forceinline__ unsigned off_b(unsigned row, unsigned ch) { return 256u * row + 16u * (ch ^ (((row & 3) << 2) | ((row >> 2) & 3))); }
__device__ __forceinline__ void dsa_mfma_phase(const bf16_t* P, const bf16_t* CN, const float* rel_bias, bf16_t* CAT, LAS unsigned char* lds, unsigned* qctr) {
    const int tid = otid(), lane = tid & 63, wid = __builtin_amdgcn_readfirstlane(tid >> 6);
    LAS float* BT = (LAS float*)(lds + DSA_BT_OFF);
    __syncthreads();
    for (int i = tid; i < 191 * 8; i += NTHREADS) { const int rel = (i >> 3) - 127; BT[i] = rel_bias[t5_bucket(rel) * 8 + (i & 7)]; }
    const unsigned long long lt_mask = (lane == 0) ? 0ull : (~0ull >> (64 - lane));
    volatile LAS int* qslot = (volatile LAS int*)(lds + 131072 + 64);
    int nxt = 0;
    if (tid == 0) { *qslot = (int)atomicAdd(qctr, 1u); nxt = (int)atomicAdd(qctr, 1u); }
    for (;;) {
        __syncthreads();
        const int u = *qslot;
        if (u >= T / 16) break;
        const int b = u & 15, qg = 127 - (u >> 4), t0 = qg * 16, nj = t0 / CHUNK + 1, L = nj * CHUNK, nt = L / 32;
        const bf16_t* Pb = P + (size_t)b * SEQ * PW;
        {
            int ln1 = lane; asm volatile("" : "+v"(ln1));
            const int rho = ln1 & 31, hf = ln1 >> 5;
            const int qq = 2 * ((rho >> 2) & 1) + (rho >> 4), hh = 4 * ((rho >> 3) & 1) + (rho & 3);
            bf16x8 qa[4][4], wa[4], wc[4];
#pragma unroll
            for (int qd = 0; qd < 4; ++qd) {
                const bf16_t* qrow = Pb + (size_t)(t0 + 4 * qd + qq) * PW + P_QI + hh * 64 + 8 * hf;
#pragma unroll
                for (int ks = 0; ks < 4; ++ks) qa[qd][ks] = *(const bf16x8*)(qrow + ks * 16);
                wa[qd] = *(const bf16x8*)(Pb + (size_t)(t0 + 4 * qd + 2 * hf) * PW + P_WI); wc[qd] = *(const bf16x8*)(Pb + (size_t)(t0 + 4 * qd + 2 * hf + 1) * PW + P_WI);
            }
            LAS float* sc0 = (LAS float*)lds + (2 * hf) * 2048 + rho;
            const bf16_t* kbase = Pb + (size_t)rho * PW + P_KI + 8 * hf;
            bf16x8 kb[4], kn[4];
#pragma unroll
            for (int ks = 0; ks < 4; ++ks) { kb[ks] = (bf16x8){0, 0, 0, 0, 0, 0, 0, 0}; kn[ks] = kb[ks]; }
            if (wid < nt) {
#pragma unroll
                for (int ks = 0; ks < 4; ++ks) kb[ks] = *(const bf16x8*)(kbase + (size_t)wid * 32 * PW + ks * 16);
            }
            for (int kt = wid; kt < nt; kt += 8) {
                if (kt + 8 < nt) {
#pragma unroll
                    for (int ks = 0; ks < 4; ++ks) kn[ks] = *(const bf16x8*)(kbase + (size_t)(kt + 8) * 32 * PW + ks * 16);
                }
#pragma unroll
                for (int qd = 0; qd < 4; ++qd) {
                    f32x16 acc;
#pragma unroll
                    for (int r = 0; r < 16; ++r) acc[r] = 0.f;
#pragma unroll
                    for (int ks = 0; ks < 4; ++ks) acc = __builtin_amdgcn_mfma_f32_32x32x16_bf16(qa[qd][ks], kb[ks], acc, 0, 0, 0);
                    float s0 = 0.f, s1 = 0.f;
#pragma unroll
                    for (int e = 0; e < 8; ++e) { s0 += bf2f((unsigned short)wa[qd][e]) * fmaxf(acc[e], 0.f); s1 += bf2f((unsigned short)wc[qd][e]) * fmaxf(acc[8 + e], 0.f); }
                    sc0[(4 * qd) * 2048 + kt * 32] = s0 * (0.35355339059327373f * 0.125f); sc0[(4 * qd + 1) * 2048 + kt * 32] = s1 * (0.35355339059327373f * 0.125f);
                }
#pragma unroll
                for (int ks = 0; ks < 4; ++ks) kb[ks] = kn[ks];
            }
        }
        __syncthreads();
        if (tid == 0) { *qslot = nxt; nxt = (int)atomicAdd(qctr, 1u); }
        LAS unsigned char* pair = lds + wid * 16384;
        LAS unsigned char* wsc = lds + DSA_WS_OFF + wid * 2560;
        LAS unsigned* HIST = (LAS unsigned*)wsc; LAS float* CANDV = (LAS float*)(wsc + 1024); LAS unsigned* CANDI = (LAS unsigned*)(wsc + 1280);
        const int nsel = L < 256 ? L : 256;
        int lna = lane; asm volatile("" : "+v"(lna));
#pragma unroll 1
        for (int e2 = 0; e2 < 2; ++e2) {
            LAS unsigned short* IDX = (LAS unsigned short*)(wsc + 1536 + e2 * 512);
            if (nj > 4) {
                const LAS float* SCq = (const LAS float*)(pair + e2 * 8192);
                float x[32];
#pragma unroll
                for (int j = 0; j < 32; ++j) x[j] = (j < nj) ? SCq[j * 64 + lna] : 0.f;
                float lo = INFINITY, hi = -INFINITY;
#pragma unroll
                for (int j = 0; j < 32; ++j) if (j < nj) { hi = fmaxf(hi, x[j]); lo = fminf(lo, x[j]); }
                hi = wave_max_u(hi); lo = -wave_max_u(-lo);
                bool done = false;
                if (hi > lo) {
                    const float sc = 256.f / (hi - lo);
                    *(LAS u32x4*)(HIST + 4 * lna) = (u32x4){0u, 0u, 0u, 0u};
                    WAVE_LDS_SYNC();
#pragma unroll
                    for (int j = 0; j < 32; ++j) if (j < nj) { const unsigned bk = dsa_bucket(x[j], lo, sc); __hip_atomic_fetch_add(HIST + bk, 1u, __ATOMIC_RELAXED, __HIP_MEMORY_SCOPE_WORKGROUP); }
                    WAVE_LDS_SYNC();
                    const u32x4 h4 = *(const LAS u32x4*)(HIST + 4 * lna);
                    const unsigned cl = (h4.x + h4.y) + (h4.z + h4.w);
                    const unsigned pfx = wave_prefix_incl(cl);
                    const unsigned Sx = (unsigned)__builtin_amdgcn_readlane((int)pfx, 63) - pfx + cl;
                    const int lstar = __popcll(__ballot(Sx >= 256u)) - 1;
                    const unsigned above = Sx - cl, t3 = above + h4.w, t2 = t3 + h4.z, t1 = t2 + h4.y;
                    const unsigned bl = t3 >= 256u ? 3u : (t2 >= 256u ? 2u : (t1 >= 256u ? 1u : 0u));
                    const unsigned al = bl == 3u ? above : (bl == 2u ? t3 : (bl == 1u ? t2 : t1));
                    const unsigned ml = bl == 3u ? h4.w : (bl == 2u ? h4.z : (bl == 1u ? h4.y : h4.x));
                    const unsigned bstar = (unsigned)__builtin_amdgcn_readlane((int)(4u * lna + bl), lstar);
                    const int a = __builtin_amdgcn_readlane((int)al, lstar), m = __builtin_amdgcn_readlane((int)ml, lstar);
                    if (m <= 64) {
                        done = true;
                        const int need = 256 - a;
                        unsigned msel = 0u, mcand = 0u;
#pragma unroll
                        for (int j = 31; j >= 0; --j) if (j < nj) { const unsigned bk = dsa_bucket(x[j], lo, sc); msel = msel + msel + (bk > bstar ? 1u : 0u); mcand = mcand + mcand + (bk == bstar ? 1u : 0u); }
                        const unsigned pk = (unsigned)__popc(msel) | ((unsigned)__popc(mcand) << 16);
                        const unsigned inc = wave_prefix_incl(pk);
                        unsigned off = (inc - pk) & 0xffffu, coff = (inc - pk) >> 16;
                        while (msel) { const int j = __ffs((int)msel) - 1; msel &= msel - 1u; IDX[off++] = (unsigned short)(j * 64 + lna); }
                        while (mcand) { const int j = __ffs((int)mcand) - 1; mcand &= mcand - 1u; CANDV[coff] = SCq[j * 64 + lna]; CANDI[coff] = (unsigned)(j * 64 + lna); ++coff; }
                        WAVE_LDS_SYNC();
                        const float cv = CANDV[lna < m ? lna : 0]; const unsigned ci = CANDI[lna < m ? lna : 0];
                        int rank = 0;
                        for (int k = 0; k < m; ++k) { const float v = __uint_as_float((unsigned)__builtin_amdgcn_readlane((int)__float_as_uint(cv), k)); const unsigned id = (unsigned)__builtin_amdgcn_readlane((int)ci, k); rank += (v > cv || (v == cv && id < ci)) ? 1 : 0; }
                        if (lna < m && rank < need) IDX[a + rank] = (unsigned short)ci;
                    }
                }
                if (!done) {
                    unsigned lo_k = 0xffffffffu, hi_k = 0u;
#pragma unroll
                    for (int j = 0; j < 32; ++j) if (j < nj) { const unsigned kx = sort_key(x[j]); hi_k = kx > hi_k ? kx : hi_k; lo_k = kx < lo_k ? kx : lo_k; }
#pragma unroll
                    for (int o = 1; o < 64; o <<= 1) { const unsigned h2 = (unsigned)__shfl_xor((int)hi_k, o), l2 = (unsigned)__shfl_xor((int)lo_k, o); hi_k = h2 > hi_k ? h2 : hi_k; lo_k = l2 < lo_k ? l2 : lo_k; }
                    lo_k = (unsigned)__builtin_amdgcn_readfirstlane((int)lo_k); hi_k = (unsigned)__builtin_amdgcn_readfirstlane((int)hi_k);
                    bool exact = false;
                    while (lo_k < hi_k) {
                        const unsigned mid = lo_k + ((hi_k - lo_k + 1u) >> 1);
                        int cnt = 0;
#pragma unroll
                        for (int j = 0; j < 32; ++j) cnt += __popcll(__ballot(j < nj && sort_key(x[j]) >= mid));
                        if (cnt == 256) { lo_k = mid; exact = true; break; }
                        if (cnt > 256) lo_k = mid; else hi_k = mid - 1u;
                    }
                    const unsigned Tv = lo_k;
                    int need = 0;
                    if (!exact) { int cgt = 0;
#pragma unroll
                        for (int j = 0; j < 32; ++j) cgt += __popcll(__ballot(j < nj && sort_key(x[j]) > Tv));
                        need = 256 - cgt; }
                    int base = 0, eqt = 0;
#pragma unroll
                    for (int j = 0; j < 32; ++j) {
                        const unsigned kx = sort_key(x[j]);
                        const bool gt = (j < nj) && (exact ? (kx >= Tv) : (kx > Tv)), eq = (j < nj) && !exact && (kx == Tv);
                        const unsigned long long meq = __ballot(eq);
                        const bool sel = gt || (eq && (eqt + __popcll(meq & lt_mask)) < need);
                        const unsigned long long ms = __ballot(sel);
                        if (sel) IDX[base + __popcll(ms & lt_mask)] = (unsigned short)(j * 64 + lna);
                        base += __popcll(ms); eqt += __popcll(meq);
                    }
                }
            } else {
#pragma unroll
                for (int i = 0; i < 4; ++i) IDX[i * 64 + lna] = (unsigned short)(i * 64 + lna);
            }
        }
        WAVE_LDS_SYNC();
        {
            int lnb = lane; asm volatile("" : "+v"(lnb));
            const int head = lnb & 15, kg = lnb >> 4, nblk = nsel >> 5;
            LAS unsigned char* GB = pair;
            const bf16_t* CNb = CN + (size_t)b * SEQ * 128;
            const int rho = lnb & 15;
            const unsigned rw0 = 8 * (rho >> 2) + (rho & 3), rw1 = rw0 + 4;
            const unsigned xa0 = ((rw0 & 3) << 2) | ((rw0 >> 2) & 3), xa1 = ((rw1 & 3) << 2) | ((rw1 >> 2) & 3);
            const unsigned q4 = (lnb & 15) >> 2, p4 = lnb & 3;
            u32x4 gA[8], gB[8];
#define DSA_GATHER(G, IX, blk) do { _Pragma("unroll") for (int it = 0; it < 8; ++it) { const int sp = (IX)[(blk) * 32 + (lnb >> 4) + 4 * it]; G[it] = *(const u32x4*)(CNb + (size_t)sp * 128 + (lnb & 15) * 8); } } while (0)
            { const LAS unsigned short* IDX0 = (const LAS unsigned short*)(wsc + 1536); DSA_GATHER(gA, IDX0, 0); DSA_GATHER(gB, IDX0, 1); }
#pragma unroll 1
            for (int e2 = 0; e2 < 2; ++e2) {
                const int t = t0 + 2 * wid + e2;
                const size_t row = (size_t)b * SEQ + t;
                const LAS unsigned short* IDX = (const LAS unsigned short*)(wsc + 1536 + e2 * 512);
                bf16x8 qlf[4];
#pragma unroll
                for (int s4 = 0; s4 < 4; ++s4) { qlf[s4] = *(const bf16x8*)(P + row * PW + P_QL + (head & 7) * 128 + s4 * 32 + 8 * kg); if (head >= 8) qlf[s4] = (bf16x8){0, 0, 0, 0, 0, 0, 0, 0}; }
                f32x4 o[8];
#pragma unroll
                for (int ct = 0; ct < 8; ++ct) o[ct] = (f32x4){0.f, 0.f, 0.f, 0.f};
                float m = -INFINITY, lsum = 0.f;
#define DSA_STEP(G, kbx) do { \
                    WAVE_LDS_SYNC();                              \
                    _Pragma("unroll") for (int it = 0; it < 8; ++it) *(LAS u32x4*)(GB + off_b((lnb >> 4) + 4 * it, lnb & 15)) = G[it]; \
                    const bf16x8 iv = *(const LAS bf16x8*)((const LAS unsigned char*)IDX + ((kbx) * 32 + 8 * kg) * 2);     \
                    if ((kbx) + 2 < nblk) DSA_GATHER(G, IDX, (kbx) + 2); else if (e2 == 0) DSA_GATHER(G, IDX + 256, (kbx) + 2 - nblk); \
                    WAVE_LDS_SYNC(); \
                      \
                    bf16x8 k0[4], k1[4], af[8]; \
                    _Pragma("unroll") for (int s4 = 0; s4 < 4; ++s4) { \
                        k0[s4] = *(const LAS bf16x8*)(GB + 256u * rw0 + 16u * ((4 * s4 + kg) ^ xa0)); \
                        k1[s4] = *(const LAS bf16x8*)(GB + 256u * rw1 + 16u * ((4 * s4 + kg) ^ xa1)); } \
                    float bia[8]; \
                    _Pragma("unroll") for (int e = 0; e < 8; ++e) { const int sp = (int)(unsigned short)iv[e]; int rel = sp - t; rel = rel < -127 ? -127 : rel; bia[e] = BT[(rel + 127) * 8 + (head & 7)]; } \
                      \
                    f32x4 a0 = (f32x4){0.f, 0.f, 0.f, 0.f}, a1 = (f32x4){0.f, 0.f, 0.f, 0.f}; \
                    _Pragma("unroll") for (int s4 = 0; s4 < 4; ++s4) { \
                        a0 = __builtin_amdgcn_mfma_f32_16x16x32_bf16(k0[s4], qlf[s4], a0, 0, 0, 0); \
                        a1 = __builtin_amdgcn_mfma_f32_16x16x32_bf16(k1[s4], qlf[s4], a1, 0, 0, 0); } \
                    asm volatile("" : "+v"(a0), "+v"(a1));        \
                    _Pragma("unroll") for (int ct = 0; ct < 8; ++ct) {              \
                        const v4i16_t lo4 = __builtin_amdgcn_ds_read_tr16_b64_v4i16((LAS v4i16_t*)(GB + off_b(8 * kg + q4, 2 * ct + (p4 >> 1)) + 8 * (p4 & 1))); \
                        const v4i16_t hi4 = __builtin_amdgcn_ds_read_tr16_b64_v4i16((LAS v4i16_t*)(GB + off_b(8 * kg + 4 + q4, 2 * ct + (p4 >> 1)) + 8 * (p4 & 1))); \
                        af[ct] = (bf16x8){lo4[0], lo4[1], lo4[2], lo4[3], hi4[0], hi4[1], hi4[2], hi4[3]}; } \
                      \
                    float lg[8]; \
                    _Pragma("unroll") for (int e = 0; e < 8; ++e) lg[e] = (e < 4 ? a0[e] : a1[e - 4]) * 0.125f + bia[e]; \
                    const float mloc = fmaxf(fmaxf(fmaxf(lg[0], lg[1]), fmaxf(lg[2], lg[3])), fmaxf(fmaxf(lg[4], lg[5]), fmaxf(lg[6], lg[7]))); \
                      \
                    float scl = 1.f; \
                    if (__any(mloc > m + 16.f)) { \
                        float mb = fmaxf(mloc, __shfl_xor(mloc, 16)); mb = fmaxf(mb, __shfl_xor(mb, 32)); \
                        const float mn = fmaxf(m, mb); scl = __expf(m - mn); m = mn; \
                        _Pragma("unroll") for (int ct = 0; ct < 8; ++ct) o[ct] = o[ct] * scl; } \
                    float ps = 0.f; float pe[8]; \
                    _Pragma("unroll") for (int e = 0; e < 8; ++e) { pe[e] = __expf(lg[e] - m); ps += pe[e]; } \
                    lsum = lsum * scl + ps; \
                    u32x4 pw; pw.x = pk2(pe[0], pe[1]); pw.y = pk2(pe[2], pe[3]); pw.z = pk2(pe[4], pe[5]); pw.w = pk2(pe[6], pe[7]); \
                    const bf16x8 pb = __builtin_bit_cast(bf16x8, pw); \
                    _Pragma("unroll") for (int ct = 0; ct < 8; ++ct) o[ct] = __builtin_amdgcn_mfma_f32_16x16x32_bf16(af[ct], pb, o[ct], 0, 0, 0); \
                } while (0)
#pragma unroll 1
                for (int kb2 = 0; kb2 < nblk; kb2 += 2) { DSA_STEP(gA, kb2); DSA_STEP(gB, kb2 + 1); }
#undef DSA_STEP
                lsum += __shfl_xor(lsum, 16); lsum += __shfl_xor(lsum, 32);
                const float inv = 1.f / lsum;
                if (head < 8) {
                    bf16_t* op = CAT + row * KOUT + head * 128 + 4 * kg;
#pragma unroll
                    for (int ct = 0; ct < 8; ++ct) { u32x2 w; w.x = pk2(o[ct][0] * inv, o[ct][1] * inv); w.y = pk2(o[ct][2] * inv, o[ct][3] * inv); *(u32x2*)(op + ct * 16) = w; }
                }
            }
#undef DSA_GATHER
        }
    }
}

constexpr size_t WS_DEC = 492 * MiB;
__device__ __forceinline__ void hgrn_prep(bf16_t* P, const float* lb, float* DEC, LAS unsigned char* lds, int vb, int nvb) {
    const int tid = otid(), cl = tid >> 7, d = tid & 127;
    LAS bf16_t* Ft = (LAS bf16_t*)lds; LAS bf16_t* Qt = (LAS bf16_t*)(lds + 65536);
    for (int it = vb; it < BATCH * 4 * 8; it += nvb) {
        const int b = it >> 5, h = (it >> 3) & 3, cg = it & 7;
        bf16_t* base = P + ((size_t)b * SEQ + cg * 256) * PW + h * 128;
        u32x4 v[16];
#pragma unroll
        for (int k = 0; k < 16; ++k) { const int i = tid + 512 * k, tl = i >> 12, r = (i >> 4) & 255, ch = i & 15; v[k] = *(const u32x4*)(base + (size_t)r * PW + (tl ? P_QB : P_FB) + ch * 8); }
        __syncthreads();
#pragma unroll
        for (int k = 0; k < 16; ++k) { const int i = tid + 512 * k, tl = i >> 12, r = (i >> 4) & 255, ch = i & 15; *(LAS u32x4*)(lds + tl * 65536 + r * 256 + ch * 16) = v[k]; }
        __syncthreads();
        {
            const float l = lb[h * 128 + d];
            LAS bf16_t* fcol = Ft + (cl * 64) * 128 + d; LAS bf16_t* qcol = Qt + (cl * 64) * 128 + d;
            float ref = 0.f;
#pragma unroll 8
            for (int t = 0; t < 32; ++t) ref += __logf(l + (1.f - l) * sigmoid_f(bf2f(fcol[t * 128])));
            float bi = 0.f;
#pragma unroll 8
            for (int t = 0; t < 64; ++t) {
                const float f = l + (1.f - l) * sigmoid_f(bf2f(fcol[t * 128]));
                bi += __logf(f);
                const float q = silu_f(bf2f(qcol[t * 128]));
                qcol[t * 128] = (bf16_t)f2bf(q * __expf(bi - ref));
                fcol[t * 128] = (bf16_t)f2bf((1.f - f) * __expf(ref - bi));
            }
            float* dc = DEC + ((size_t)((b * 4 + h) * 32 + cg * 4 + cl) * 3) * 128 + d;
            dc[0] = __expf(ref); dc[128] = __expf(bi); dc[256] = __expf(bi - ref);
        }
        __syncthreads();
#pragma unroll
        for (int k = 0; k < 16; ++k) { const int i = tid + 512 * k, tl = i >> 12, r = (i >> 4) & 255, ch = i & 15; *(u32x4*)(base + (size_t)r * PW + (tl ? P_QB : P_FB) + ch * 8) = *(const LAS u32x4*)(lds + tl * 65536 + r * 256 + ch * 16); }
    }
}

__device__ __forceinline__ void hgrn_scan(const bf16_t* P, const float* DEC, const float* o_g, bf16_t* CAT, LAS unsigned char* lds, int item) {
    const int tid = otid(), lane = tid & 63, wid = __builtin_amdgcn_readfirstlane(tid >> 6), li = lane & 15, kg = lane >> 4;
    const int b = item >> 2, h = item & 3, it = wid >> 1, vh = wid & 1;
    LAS unsigned char* ST = lds + 98304;
    LAS float* SSQ = (LAS float*)(lds + DSA_BT_OFF);
    const bf16_t* Pb = P + (size_t)b * SEQ * PW;
    const float* DECb = DEC + (size_t)((b * 4 + h) * 32) * 384;
    f32x4 S[8];
#pragma unroll
    for (int vt = 0; vt < 8; ++vt) S[vt] = (f32x4){0.f, 0.f, 0.f, 0.f};
    u32x4 sg[6];
    const int colbase[3] = {P_QB, P_FB, P_IB};
#define HG_LOAD(c) do { _Pragma("unroll") for (int k = 0; k < 6; ++k) { const int n = tid + 512 * k, tl = n >> 10, r = (n >> 4) & 63, ch = n & 15; \
        sg[k] = *(const u32x4*)(Pb + (size_t)((c) * 64 + r) * PW + colbase[tl] + h * 128 + ch * 8); } } while (0)
#define HG_STORE(buf) do { _Pragma("unroll") for (int k = 0; k < 6; ++k) { const int n = tid + 512 * k, tl = n >> 10, r = (n >> 4) & 63, ch = n & 15; \
        *(LAS u32x4*)(lds + (buf) * 49152 + tl * 16384 + off_b(r, ch)) = sg[k]; } } while (0)
    HG_LOAD(0);
    __syncthreads();
    HG_STORE(0);
    const unsigned q4 = (lane & 15) >> 2, p4 = lane & 3;
    f32x4 ogv[4];
#pragma unroll
    for (int vv = 0; vv < 4; ++vv) ogv[vv] = *(const f32x4*)(o_g + 16 * (4 * vh + vv) + 4 * kg);
    float er_next = DECb[16 * wid + li];
#pragma unroll 1
    for (int c = 0; c < 32; ++c) {
        const int buf = c & 1;
        LAS unsigned char* QI = lds + buf * 49152; LAS unsigned char* KI = QI + 16384; LAS unsigned char* VI = QI + 32768;
        if (c + 1 < 32) HG_LOAD(c + 1);
        const float er = er_next, e63 = DECb[c * 384 + 128 + 16 * wid + li], e6r = DECb[c * 384 + 256 + 16 * wid + li];
        er_next = DECb[(c + 1 < 32 ? c + 1 : c) * 384 + 16 * wid + li];
        u32x2 gwv[4];
#pragma unroll
        for (int vv = 0; vv < 4; ++vv) gwv[vv] = *(const u32x2*)(P + ((size_t)b * SEQ + c * 64 + 16 * it + li) * PW + P_GB + h * 128 + 16 * (4 * vh + vv) + 4 * kg);
        { const unsigned d = 16 * wid + li;
#pragma unroll
          for (int vt = 0; vt < 8; ++vt) { u32x2 w; w.x = pk2(S[vt][0] * er, S[vt][1] * er); w.y = pk2(S[vt][2] * er, S[vt][3] * er);
              *(LAS u32x2*)(ST + off_b(d, 2 * vt + (kg >> 1)) + 8 * (kg & 1)) = w; } }
        __syncthreads();
        bf16x8 qf[4];
#pragma unroll
        for (int ks = 0; ks < 4; ++ks) qf[ks] = *(const LAS bf16x8*)(QI + off_b(16 * it + li, 4 * ks + kg));
        f32x4 o[4];
#pragma unroll
        for (int vv = 0; vv < 4; ++vv) o[vv] = (f32x4){0.f, 0.f, 0.f, 0.f};
#pragma unroll
        for (int ks = 0; ks < 4; ++ks)
#pragma unroll
            for (int vv = 0; vv < 4; ++vv) {
                const int ct = 4 * vh + vv;
                const v4i16_t lo4 = __builtin_amdgcn_ds_read_tr16_b64_v4i16((LAS v4i16_t*)(ST + off_b(32 * ks + 8 * kg + q4, 2 * ct + (p4 >> 1)) + 8 * (p4 & 1)));
                const v4i16_t hi4 = __builtin_amdgcn_ds_read_tr16_b64_v4i16((LAS v4i16_t*)(ST + off_b(32 * ks + 8 * kg + 4 + q4, 2 * ct + (p4 >> 1)) + 8 * (p4 & 1)));
                const bf16x8 af = (bf16x8){lo4[0], lo4[1], lo4[2], lo4[3], hi4[0], hi4[1], hi4[2], hi4[3]};
                o[vv] = __builtin_amdgcn_mfma_f32_16x16x32_bf16(af, qf[ks], o[vv], 0, 0, 0);
            }
        const int njb = (it >> 1) + 1;
#pragma unroll
        for (int jb = 0; jb < 2; ++jb) {
            if (jb < njb) {
                f32x4 a0 = (f32x4){0.f, 0.f, 0.f, 0.f}, a1 = (f32x4){0.f, 0.f, 0.f, 0.f};
                const unsigned rw0 = 32 * jb + 8 * (li >> 2) + (li & 3), rw1 = rw0 + 4;
#pragma unroll
                for (int ks = 0; ks < 4; ++ks) {
                    const bf16x8 k0 = *(const LAS bf16x8*)(KI + off_b(rw0, 4 * ks + kg));
                    const bf16x8 k1 = *(const LAS bf16x8*)(KI + off_b(rw1, 4 * ks + kg));
                    a0 = __builtin_amdgcn_mfma_f32_16x16x32_bf16(k0, qf[ks], a0, 0, 0, 0);
                    a1 = __builtin_amdgcn_mfma_f32_16x16x32_bf16(k1, qf[ks], a1, 0, 0, 0);
                }
                const int ii = 16 * it + li, j0 = 32 * jb + 8 * kg;
                float am[8];
#pragma unroll
                for (int e = 0; e < 8; ++e) am[e] = (j0 + e <= ii) ? (e < 4 ? a0[e] : a1[e - 4]) : 0.f;
                u32x4 pw; pw.x = pk2(am[0], am[1]); pw.y = pk2(am[2], am[3]); pw.z = pk2(am[4], am[5]); pw.w = pk2(am[6], am[7]);
                const bf16x8 pb = __builtin_bit_cast(bf16x8, pw);
#pragma unroll
                for (int vv = 0; vv < 4; ++vv) {
                    const int ct = 4 * vh + vv;
                    const v4i16_t lo4 = __builtin_amdgcn_ds_read_tr16_b64_v4i16((LAS v4i16_t*)(VI + off_b(32 * jb + 8 * kg + q4, 2 * ct + (p4 >> 1)) + 8 * (p4 & 1)));
                    const v4i16_t hi4 = __builtin_amdgcn_ds_read_tr16_b64_v4i16((LAS v4i16_t*)(VI + off_b(32 * jb + 8 * kg + 4 + q4, 2 * ct + (p4 >> 1)) + 8 * (p4 & 1)));
                    const bf16x8 af = (bf16x8){lo4[0], lo4[1], lo4[2], lo4[3], hi4[0], hi4[1], hi4[2], hi4[3]};
                    o[vv] = __builtin_amdgcn_mfma_f32_16x16x32_bf16(af, pb, o[vv], 0, 0, 0);
                }
            }
        }
        {
            f32x4 U[8];
#pragma unroll
            for (int vt = 0; vt < 8; ++vt) U[vt] = (f32x4){0.f, 0.f, 0.f, 0.f};
#pragma unroll
            for (int ks = 0; ks < 2; ++ks) {
                const v4i16_t kl = __builtin_amdgcn_ds_read_tr16_b64_v4i16((LAS v4i16_t*)(KI + off_b(32 * ks + 8 * kg + q4, 2 * wid + (p4 >> 1)) + 8 * (p4 & 1)));
                const v4i16_t kh = __builtin_amdgcn_ds_read_tr16_b64_v4i16((LAS v4i16_t*)(KI + off_b(32 * ks + 8 * kg + 4 + q4, 2 * wid + (p4 >> 1)) + 8 * (p4 & 1)));
                const bf16x8 kfr = (bf16x8){kl[0], kl[1], kl[2], kl[3], kh[0], kh[1], kh[2], kh[3]};
#pragma unroll
                for (int vt = 0; vt < 8; ++vt) {
                    const v4i16_t lo4 = __builtin_amdgcn_ds_read_tr16_b64_v4i16((LAS v4i16_t*)(VI + off_b(32 * ks + 8 * kg + q4, 2 * vt + (p4 >> 1)) + 8 * (p4 & 1)));
                    const v4i16_t hi4 = __builtin_amdgcn_ds_read_tr16_b64_v4i16((LAS v4i16_t*)(VI + off_b(32 * ks + 8 * kg + 4 + q4, 2 * vt + (p4 >> 1)) + 8 * (p4 & 1)));
                    const bf16x8 af = (bf16x8){lo4[0], lo4[1], lo4[2], lo4[3], hi4[0], hi4[1], hi4[2], hi4[3]};
                    U[vt] = __builtin_amdgcn_mfma_f32_16x16x32_bf16(af, kfr, U[vt], 0, 0, 0);
                }
            }
#pragma unroll
            for (int vt = 0; vt < 8; ++vt) S[vt] = S[vt] * e63 + U[vt] * e6r;
        }
        float ss = 0.f;
#pragma unroll
        for (int vv = 0; vv < 4; ++vv) ss += (o[vv][0] * o[vv][0] + o[vv][1] * o[vv][1]) + (o[vv][2] * o[vv][2] + o[vv][3] * o[vv][3]);
        ss += __shfl_xor(ss, 16); ss += __shfl_xor(ss, 32);
        if (kg == 0) SSQ[(it * 2 + vh) * 16 + li] = ss;
        __syncthreads();
        if (c + 1 < 32) HG_STORE(buf ^ 1);
        {
            const float tot = SSQ[(it * 2) * 16 + li] + SSQ[(it * 2 + 1) * 16 + li];
            const float rs = rsqrtf(tot * (1.f / 128.f) + EPS);
            const size_t row = (size_t)b * SEQ + c * 64 + 16 * it + li;
#pragma unroll
            for (int vv = 0; vv < 4; ++vv) {
                const int v0 = 16 * (4 * vh + vv) + 4 * kg;
                const u32x2 gw = gwv[vv];
                const f32x4 og = ogv[vv];
                const float g0 = silu_f(bf2f((unsigned short)(gw.x & 0xffffu))), g1 = silu_f(bf2f((unsigned short)(gw.x >> 16))), g2 = silu_f(bf2f((unsigned short)(gw.y & 0xffffu))), g3 = silu_f(bf2f((unsigned short)(gw.y >> 16)));
                u32x2 w; w.x = pk2(o[vv][0] * rs * og.x * g0, o[vv][1] * rs * og.y * g1); w.y = pk2(o[vv][2] * rs * og.z * g2, o[vv][3] * rs * og.w * g3);
                *(u32x2*)(CAT + row * KOUT + 1024 + h * 128 + v0) = w;
            }
        }
    }
#undef HG_LOAD
#undef HG_STORE
}


__device__ __forceinline__ int swap23(int r) { return (r & ~12) | ((r & 4) << 1) | ((r & 8) >> 1); }
__device__ __forceinline__ void xattn_mfma_phase(const bf16_t* Q, const bf16_t* Kb, const bf16_t* VT, bf16_t* O, LAS unsigned char* lds, int vb, int nvb) {
    const int tid = otid(), lane = tid & 63, wid = __builtin_amdgcn_readfirstlane(tid >> 6), r32 = lane & 31, hf = lane >> 5;
    LAS unsigned char* Ks = lds; LAS unsigned char* Vs = lds + 65536;
    int koff[8], voff[8];
    { const int kr = swap23(r32), x = kr & 15, y = r32 & 15;
#pragma unroll
      for (int ks = 0; ks < 8; ++ks) koff[ks] = kr * 256 + (((ks * 2 + hf) ^ x) << 4);
#pragma unroll
      for (int e = 0; e < 8; ++e) voff[e] = r32 * 512 + (((e * 2 + hf) ^ y) << 4); }
    for (int pair = vb; pair < 256; pair += nvb) {
        const int bh = pair >> 2, b = bh >> 2, h = bh & 3;
        __syncthreads();
        int tio = tid; asm volatile("" : "+v"(tio));
        for (int i = tio; i < 4096; i += NTHREADS) { const int key = i >> 4, ch = i & 15;
            const u32x4 v = *(const u32x4*)(Kb + (size_t)(b * MEMT + key) * 512 + h * 128 + ch * 8);
            *(LAS u32x4*)(Ks + key * 256 + ((ch ^ (key & 15)) << 4)) = v; }
        for (int i = tio; i < 4096; i += NTHREADS) { const int d = i >> 5, ch = i & 31;
            const u32x4 v = *(const u32x4*)(VT + (size_t)(h * 128 + d) * MT + b * MEMT + ch * 8);
            *(LAS u32x4*)(Vs + d * 512 + ((ch ^ (d & 15)) << 4)) = v; }
        __syncthreads();
#pragma unroll 1
        for (int qq = 0; qq < 2; ++qq) {
            const size_t q0 = (size_t)b * SEQ + ((pair & 3) * 2 + qq) * 256 + wid * 32;
            bf16x8 qf[8];
#pragma unroll
            for (int ks = 0; ks < 8; ++ks) qf[ks] = *(const bf16x8*)(Q + (q0 + r32) * 512 + h * 128 + ks * 16 + 8 * hf);
            f32x16 st[8];
            __builtin_amdgcn_s_setprio(1);
#pragma unroll
            for (int kt = 0; kt < 8; ++kt) {
#pragma unroll
                for (int r = 0; r < 16; ++r) st[kt][r] = 0.f;
#pragma unroll
                for (int ks = 0; ks < 8; ++ks) {
                    const bf16x8 a = *(const LAS bf16x8*)(Ks + koff[ks] + kt * 8192);
                    st[kt] = __builtin_amdgcn_mfma_f32_32x32x16_bf16(a, qf[ks], st[kt], 0, 0, 0);
                }
            }
            __builtin_amdgcn_s_setprio(0);
            float mx = -INFINITY;
#pragma unroll
            for (int kt = 0; kt < 8; ++kt)
#pragma unroll
                for (int r = 0; r < 16; ++r) mx = fmaxf(mx, st[kt][r]);
            mx = fmaxf(mx, __shfl_xor(mx, 32));
            const float c = 0.08838834764831845f * 1.4426950408889634f;
            float sum = 0.f;
#pragma unroll
            for (int kt = 0; kt < 8; ++kt)
#pragma unroll
                for (int r = 0; r < 16; ++r) { const float e = __builtin_amdgcn_exp2f((st[kt][r] - mx) * c); st[kt][r] = e; sum += e; }
            sum += __shfl_xor(sum, 32);
            const float inv = 1.f / sum;
            bf16x8 pfr[8][2];
#pragma unroll
            for (int kt = 0; kt < 8; ++kt)
#pragma unroll
                for (int s2 = 0; s2 < 2; ++s2) {
                    u32x4 pw;
                    pw.x = pk2(st[kt][8 * s2 + 0], st[kt][8 * s2 + 1]); pw.y = pk2(st[kt][8 * s2 + 2], st[kt][8 * s2 + 3]);
                    pw.z = pk2(st[kt][8 * s2 + 4], st[kt][8 * s2 + 5]); pw.w = pk2(st[kt][8 * s2 + 6], st[kt][8 * s2 + 7]);
                    pfr[kt][s2] = __builtin_bit_cast(bf16x8, pw);
                }
#pragma unroll
            for (int kt = 0; kt < 8; ++kt) asm volatile("" : "+v"(pfr[kt][0]), "+v"(pfr[kt][1]));
            f32x16 o[4];
#pragma unroll
            for (int dt = 0; dt < 4; ++dt)
#pragma unroll
                for (int r = 0; r < 16; ++r) o[dt][r] = 0.f;
            __builtin_amdgcn_s_setprio(1);
#pragma unroll
            for (int kt = 0; kt < 8; ++kt)
#pragma unroll
                for (int s2 = 0; s2 < 2; ++s2)
#pragma unroll
                    for (int dt = 0; dt < 4; ++dt) {
                        const bf16x8 a = *(const LAS bf16x8*)(Vs + voff[(kt & 3) * 2 + s2] + dt * 16384 + (kt >> 2) * 256);
                        o[dt] = __builtin_amdgcn_mfma_f32_32x32x16_bf16(a, pfr[kt][s2], o[dt], 0, 0, 0);
                    }
            __builtin_amdgcn_s_setprio(0);
            unsigned char* orow = (unsigned char*)O + (q0 + r32) * 512 + h * 128 + 64 * hf;
            const float isc = inv * XO_SC;
#pragma unroll
            for (int dt = 0; dt < 4; ++dt) {
                u32x4 w;
#pragma unroll
                for (int g = 0; g < 4; ++g) w[g] = pk4_f8(o[dt][4 * g] * isc, o[dt][4 * g + 1] * isc, o[dt][4 * g + 2] * isc, o[dt][4 * g + 3] * isc);
                *(u32x4*)(orow + dt * 16) = w;
            }
        }
    }
}


__device__ __forceinline__ void gmlp_mfma_phase(const bf16_t* UV, const float* lnp, const float* ln_g, const float* ln_b, const float* w_sp, const float* b_sp, bf16_t* G, LAS unsigned char* lds, int vb, int nvb) {
    const int tid = otid(), lane = tid & 63, wid = __builtin_amdgcn_readfirstlane(tid >> 6), fr = lane & 15, fq = lane >> 4;
    LAS unsigned char* Wb = lds; LAS unsigned char* VTs = lds + 32768; LAS float* STAT = (LAS float*)(lds + 65536);
    int gcur = -1;
    for (int grp = vb; grp < 256; grp += nvb) {
        const int g = grp >> 5;
        bf16x8 vch[4]; f32x4 lp[2];
#define GM_LOAD(uu_) do { const size_t r0_ = (size_t)((grp & 31) * 8 + (uu_)) * 128; \
            _Pragma("unroll") for (int k = 0; k < 4; ++k) { const int i = tid + 512 * k, sI = i >> 4, ch = i & 15; vch[k] = *(const bf16x8*)(UV + (r0_ + sI) * 2048 + 1024 + g * 128 + ch * 8); } \
            lp[0] = *(const f32x4*)(lnp + (r0_ + (tid >> 2)) * 32 + (tid & 3) * 8); lp[1] = *(const f32x4*)(lnp + (r0_ + (tid >> 2)) * 32 + (tid & 3) * 8 + 4); } while (0)
        GM_LOAD(0);
        const f32x4 g0 = *(const f32x4*)(ln_g + g * 128 + (tid & 15) * 8), g1 = *(const f32x4*)(ln_g + g * 128 + (tid & 15) * 8 + 4);
        const f32x4 b0 = *(const f32x4*)(ln_b + g * 128 + (tid & 15) * 8), b1 = *(const f32x4*)(ln_b + g * 128 + (tid & 15) * 8 + 4);
        const float gg[8] = {g0.x, g0.y, g0.z, g0.w, g1.x, g1.y, g1.z, g1.w}, bb[8] = {b0.x, b0.y, b0.z, b0.w, b1.x, b1.y, b1.z, b1.w};
        __syncthreads();
        if (g != gcur) {
            gcur = g;
            for (int i = tid; i < 2048; i += NTHREADS) { const int t = i >> 4, ch = i & 15;
                const f32x4 a = *(const f32x4*)(w_sp + (size_t)g * 16384 + t * 128 + ch * 8), b = *(const f32x4*)(w_sp + (size_t)g * 16384 + t * 128 + ch * 8 + 4);
                const int s0 = ch * 8;
                u32x4 w; w.x = pk2(s0 + 0 <= t ? a.x : 0.f, s0 + 1 <= t ? a.y : 0.f); w.y = pk2(s0 + 2 <= t ? a.z : 0.f, s0 + 3 <= t ? a.w : 0.f);
                w.z = pk2(s0 + 4 <= t ? b.x : 0.f, s0 + 5 <= t ? b.y : 0.f); w.w = pk2(s0 + 6 <= t ? b.z : 0.f, s0 + 7 <= t ? b.w : 0.f);
                *(LAS u32x4*)(Wb + t * 256 + ((ch ^ (t & 15)) << 4)) = w; }
        }
        const int trow = wid * 16 + fr;
        const float bias = b_sp[g * 128 + trow];
#pragma unroll 1
        for (int uu = 0; uu < 8; ++uu) {
            const int bn = (grp & 31) * 8 + uu;
            const size_t row0 = (size_t)bn * 128;
            if (uu) __syncthreads();
            { float s1 = (lp[0].x + lp[0].z) + (lp[1].x + lp[1].z), s2 = (lp[0].y + lp[0].w) + (lp[1].y + lp[1].w);
              s1 += __shfl_xor(s1, 1); s2 += __shfl_xor(s2, 1); s1 += __shfl_xor(s1, 2); s2 += __shfl_xor(s2, 2);
              const float mu = s1 * (1.f / 1024.f), var = fmaxf(s2 * (1.f / 1024.f) - mu * mu, 0.f);
              if ((tid & 3) == 0) { STAT[2 * (tid >> 2)] = mu; STAT[2 * (tid >> 2) + 1] = rsqrtf(var + EPS); } }
            __syncthreads();
#pragma unroll
            for (int k = 0; k < 4; ++k) { const int i = tid + 512 * k, sI = i >> 4, ch = i & 15;
                const float mu = STAT[2 * sI], rs = STAT[2 * sI + 1];
#pragma unroll
                for (int e = 0; e < 8; ++e) { const int c = ch * 8 + e; const float x = (bf2f((unsigned short)vch[k][e]) - mu) * rs * gg[e] + bb[e];
                    *(LAS bf16_t*)(VTs + c * 256 + (((sI >> 3) ^ ((c ^ (c >> 3)) & 15)) << 4) + (sI & 7) * 2) = (bf16_t)f2bf(x); } }
            if (uu + 1 < 8) GM_LOAD(uu + 1);
            const size_t orow = row0 + trow;
            u32x2 uwv[8];
#pragma unroll
            for (int ct = 0; ct < 8; ++ct) uwv[ct] = *(const u32x2*)(UV + orow * 2048 + g * 128 + ct * 16 + 4 * fq);
            __syncthreads();
            f32x4 acc[8];
#pragma unroll
            for (int ct = 0; ct < 8; ++ct) acc[ct] = (f32x4){0.f, 0.f, 0.f, 0.f};
#pragma unroll
            for (int ks = 0; ks < 4; ++ks) {
                const bf16x8 wf = *(const LAS bf16x8*)(Wb + trow * 256 + (((ks * 4 + fq) ^ (trow & 15)) << 4));
#pragma unroll
                for (int ct = 0; ct < 8; ++ct) {
                    const int crow = ct * 16 + fr;
                    const bf16x8 vf = *(const LAS bf16x8*)(VTs + crow * 256 + (((ks * 4 + fq) ^ ((crow ^ (crow >> 3)) & 15)) << 4));
                    acc[ct] = __builtin_amdgcn_mfma_f32_16x16x32_bf16(vf, wf, acc[ct], 0, 0, 0);
                }
            }
#pragma unroll
            for (int ct = 0; ct < 8; ++ct) {
                const int c = ct * 16 + 4 * fq;
                const u32x2 uw = uwv[ct];
                const float u0 = bf2f((unsigned short)(uw.x & 0xffffu)), u1 = bf2f((unsigned short)(uw.x >> 16)), u2 = bf2f((unsigned short)(uw.y & 0xffffu)), u3 = bf2f((unsigned short)(uw.y >> 16));
                u32x2 w; w.x = pk2(u0 * (acc[ct][0] + bias), u1 * (acc[ct][1] + bias)); w.y = pk2(u2 * (acc[ct][2] + bias), u3 * (acc[ct][3] + bias));
                *(u32x2*)(G + orow * 1024 + g * 128 + c) = w;
            }
        }
#undef GM_LOAD
    }
}

#define GAS __attribute__((address_space(1)))
typedef GAS unsigned gu32;
#define XB_TMO      128
#define XB_XCNT(j)  (256  + 64 * (j))
#define XB_XSUB(j)  (1280 + 64 * (j))
#define XB_XGEN(j)  (2304 + 64 * (j))
#define XB_TOP      3328
#define XB_TOPGEN   3392
#define XCD_BAR_WORDS 3456
#define XB_SPIN_CAP (1u << 18)

__device__ __forceinline__ unsigned xb_ld(unsigned* p)              { return __hip_atomic_load(p, __ATOMIC_RELAXED, __HIP_MEMORY_SCOPE_AGENT); }
__device__ __forceinline__ unsigned xb_add(unsigned* p, unsigned v) { return __hip_atomic_fetch_add(p, v, __ATOMIC_RELAXED, __HIP_MEMORY_SCOPE_AGENT); }
__device__ __forceinline__ unsigned xb_xcc_id() { return (unsigned)__builtin_amdgcn_s_getreg((3 << 11) | 20) & 0xFu; }
#define XB_SPIN(cond, bar) do { unsigned _sp = 0; while (cond) { __builtin_amdgcn_s_sleep(1); \
    if ((++_sp & 255u) == 0u) { if (xb_ld(&(bar)[XB_TMO])) break; if (_sp > XB_SPIN_CAP) { atomicAdd(&(bar)[XB_TMO], 1u); break; } } } } while (0)

struct XcdBarrier {
    unsigned* bar; unsigned x;
    volatile LAS unsigned* st;
};

__device__ __forceinline__ XcdBarrier xcd_barrier_post(unsigned* bar, volatile LAS unsigned* st) {
    XcdBarrier b; b.bar = bar; b.x = xb_xcc_id(); b.st = st;
    if (threadIdx.x == 0) (void)xb_add(&bar[XB_XCNT(b.x)], 1u);
    return b;
}
__device__ __forceinline__ void xcd_barrier_complete(unsigned* bar, unsigned x, unsigned& nloc, unsigned& nx) {
    const unsigned G = gridDim.x * gridDim.y * gridDim.z;
    unsigned sum, cnt, mine, sp = 0u;
    for (;;) {
        sum = 0u; cnt = 0u; mine = 0u;
#pragma unroll
        for (unsigned j = 0; j < 16; ++j) { const unsigned c = xb_ld(&bar[XB_XCNT(j)]); sum += c; cnt += (c > 0u) ? 1u : 0u; mine = (j == x) ? c : mine; }
        if (sum == G) break;
        __builtin_amdgcn_s_sleep(1);
        if ((++sp & 255u) == 0u) { if (xb_ld(&bar[XB_TMO])) break; if (sp > XB_SPIN_CAP) { atomicAdd(&bar[XB_TMO], 1u); break; } }
    }
    nloc = mine > 0u ? mine : 1u; nx = cnt > 0u ? cnt : 1u;
}

__device__ __forceinline__ void xcd_barrier(const XcdBarrier& b) {
    asm volatile("s_waitcnt vmcnt(0)" ::: "memory");
    __syncthreads();
    if (threadIdx.x == 0) {
        unsigned* bar = b.bar;
        __builtin_amdgcn_s_waitcnt(0);
        unsigned nloc = b.st[0], nx = b.st[1];
        if (nloc == 0u) { xcd_barrier_complete(bar, b.x, nloc, nx); b.st[0] = nloc; b.st[1] = nx; }
        const unsigned old = xb_add(&bar[XB_XSUB(b.x)], 1u);
        const unsigned gen = old / nloc;
        if (old + 1u == (gen + 1u) * nloc) {
            __builtin_amdgcn_fence(__ATOMIC_RELEASE, "agent");
            asm volatile("s_waitcnt vmcnt(0)" ::: "memory");
            const unsigned og = xb_add(&bar[XB_TOP], 1u);
            const unsigned tg = og / nx;
            if (og + 1u == (tg + 1u) * nx) xb_add(&bar[XB_TOPGEN], 1u);
            else XB_SPIN(xb_ld(&bar[XB_TOPGEN]) == tg, bar);
            __builtin_amdgcn_fence(__ATOMIC_ACQUIRE, "agent");
            xb_add(&bar[XB_XGEN(b.x)], 1u);
            asm volatile("s_waitcnt vmcnt(0)" ::: "memory");
        } else {
            XB_SPIN(xb_ld(&bar[XB_XGEN(b.x)]) == gen, bar);
            __builtin_amdgcn_fence(__ATOMIC_ACQUIRE, "agent");
            asm volatile("s_waitcnt vmcnt(0)" ::: "memory");
        }
    }
    __syncthreads();
}

constexpr int LDS_BYTES = 32768 * 4 + 256 + 6144 + 8 * 2560;

enum Phase {
    PH_PREP = 0, PH_GEMM_IN, PH_CNORM, PH_MIX0  , PH_GEMM_OUT0,
    PH_GEMM_Q0, PH_XATTN0, PH_GEMM_O0, PH_GEMM_GU0, PH_GEMM_DN0,
    PH_GEMM_OIN, PH_GMLP, PH_GEMM_OOUT,
    PH_GEMM_Q1, PH_XATTN1, PH_GEMM_O1, PH_GEMM_GU1, PH_GEMM_DN1, PH_FINAL, PH_COUNT
};

__device__ __forceinline__ PrepJob make_job(const Params& p, int ji) {
    unsigned char* ws = p.ws; PrepJob j{};
    switch (ji) {
    case 0: j = PrepJob{p.in[5], 1024, 3272, p.in[4], (bf16_t*)(ws + WS_WIN), 1024, PW, 1024, 0, MAP_WIN}; break;
    case 1: j = PrepJob{p.in[10] + (size_t)512 * 1024, 512, 1024, nullptr, (bf16_t*)(ws + WS_WOUT), 0, 1024, KOUT, 1024, MAP_ID}; break;
    case 2: j = PrepJob{p.in[11], 1024, 2048, p.in[4] + 1024, (bf16_t*)(ws + WS_OWIN), 0, 2048, 1024, 0, MAP_ID, 2, WQ_GU}; break;
    case 3: j = PrepJob{p.in[16], 1024, 1024, nullptr, (bf16_t*)(ws + WS_OWOUT), 0, 1024, 1024, 0, MAP_ID}; break;
    case 4: case 5: { const int l = ji - 4; j = PrepJob{p.in[19] + (size_t)l * 1024 * 512, 1024, 512, p.in[17] + l * 1024, (bf16_t*)(ws + WS_WQ + (size_t)l * 512 * 1024), 0, 512, 1024, 0, MAP_ID, 2, WQ_GU}; } break;
    case 6: case 7: { const int l = ji - 6; j = PrepJob{p.in[20] + (size_t)l * 1024 * 1024, 1024, 1024, p.in[18] + l * 1024, (bf16_t*)(ws + WS_WKV) + (size_t)l * 1024 * 1024, 0, 1024, 1024, 0, MAP_ID}; } break;
    case 8: case 9: { const int l = ji - 8; j = PrepJob{p.in[21] + (size_t)l * 512 * 1024, 512, 1024, nullptr, (bf16_t*)(ws + WS_WO + (size_t)l * 1024 * 512), 0, 1024, 512, 0, MAP_ID, 3, WO_SC}; } break;
    case 10: case 11: { const int l = ji - 10; j = PrepJob{p.in[23] + (size_t)l * 1024 * 2 * FF, 1024, 2 * FF, p.in[22] + l * 1024, (bf16_t*)(ws + WS_WGU + (size_t)l * 2 * FF * 1024), 0, 2 * FF, 1024, 0, MAP_GU, 2, WQ_GU}; } break;
#if DN_FP8
    default: { const int l = ji - 12; j = PrepJob{p.in[24] + (size_t)l * FF * 1024, FF, 1024, nullptr, (bf16_t*)(ws + WS_WDN + (size_t)l * 1024 * FF), 0, 1024, FF, 0, MAP_ID, 1, WDN_SC}; } break;
#else
    default: { const int l = ji - 12; j = PrepJob{p.in[24] + (size_t)l * FF * 1024, FF, 1024, nullptr, (bf16_t*)(ws + WS_WDN) + (size_t)l * 1024 * FF, 0, 1024, FF, 0, MAP_ID}; } break;
#endif
    }
    return j;
}
constexpr int N_PREP_JOBS = 14;

template <int ph> __device__ __forceinline__ void run_phase(const Params& p, LAS float* lds, int vb, int nvb) {
    unsigned char* ws = p.ws;
    bf16_t* HN = (bf16_t*)(ws + WS_HN); bf16_t* BIG = (bf16_t*)(ws + WS_BIG); bf16_t* CN = (bf16_t*)(ws + WS_CN); bf16_t* CAT = (bf16_t*)(ws + WS_CAT);
    bf16_t* KB = (bf16_t*)(ws + WS_KB); bf16_t* VTB = (bf16_t*)(ws + WS_VT); bf16_t* MEMN = (bf16_t*)(ws + WS_MEMN); float* lb = (float*)(ws + WS_LB);
    float* ssq = (float*)(ws + WS_SSQ); float* lnp = (float*)(ws + WS_LNP);
    bf16_t* XQ = BIG; bf16_t* XO = BIG + (size_t)T * 512;
    const int l = (ph >= PH_GEMM_Q1) ? 1 : 0;
    switch (ph) {
    case PH_PREP:
        x_to_h_rows(p.in[0], HN, ssq, vb, nvb);
        {
            constexpr int NT_[N_PREP_JOBS] = {16 * 11, 8 * 4, 16 * 8, 16 * 4, 16 * 2, 16 * 2, 16 * 4, 16 * 4, 8 * 4, 8 * 4, 16 * 22, 16 * 22, 44 * 4, 44 * 4};
            constexpr int CUM1 = NT_[0], CUM2 = CUM1 + NT_[1], CUM3 = CUM2 + NT_[2], CUM4 = CUM3 + NT_[3], CUM5 = CUM4 + NT_[4], CUM6 = CUM5 + NT_[5], CUM7 = CUM6 + NT_[6],
                          CUM8 = CUM7 + NT_[7], CUM9 = CUM8 + NT_[8], CUM10 = CUM9 + NT_[9], CUM11 = CUM10 + NT_[10], CUM12 = CUM11 + NT_[11], CUM13 = CUM12 + NT_[12], CUM14 = CUM13 + NT_[13];
#define PJ_FIND(it_, ji_, base_) do { ji_ = 0; base_ = 0; \
                PJ_STEP(it_, ji_, base_, 1, CUM1) PJ_STEP(it_, ji_, base_, 2, CUM2) PJ_STEP(it_, ji_, base_, 3, CUM3) PJ_STEP(it_, ji_, base_, 4, CUM4) PJ_STEP(it_, ji_, base_, 5, CUM5) PJ_STEP(it_, ji_, base_, 6, CUM6) PJ_STEP(it_, ji_, base_, 7, CUM7) \
                PJ_STEP(it_, ji_, base_, 8, CUM8) PJ_STEP(it_, ji_, base_, 9, CUM9) PJ_STEP(it_, ji_, base_, 10, CUM10) PJ_STEP(it_, ji_, base_, 11, CUM11) PJ_STEP(it_, ji_, base_, 12, CUM12) PJ_STEP(it_, ji_, base_, 13, CUM13) } while (0)
#define PJ_STEP(it_, ji_, base_, q, c) if ((it_) >= (c)) { ji_ = (q); base_ = (c); }
            f32x4 va[8], vn[8];
            int ji, base;
            if (vb < CUM14) { PJ_FIND(vb, ji, base); const PrepJob j = make_job(p, ji); prep_tile_load(j, vb - base, va); }
            for (int it = vb; it < CUM14; it += nvb) {
                PJ_FIND(it, ji, base);
                const PrepJob j = make_job(p, ji); const int tl = it - base;
                if (it + nvb < CUM14) { int jn, bn; PJ_FIND(it + nvb, jn, bn); const PrepJob j2 = make_job(p, jn); prep_tile_load(j2, it + nvb - bn, vn); }
                prep_tile_store(j, tl, va, lds);
#pragma unroll
                for (int q = 0; q < 8; ++q) va[q] = vn[q];
            }
#undef PJ_STEP
#undef PJ_FIND
        }
        prep_fold_in(p.in[5], p.in[7], p.in[4], (bf16_t*)(ws + WS_WIN), lds, vb, nvb);
        prep_fold_out(p.in[10], p.in[8], (bf16_t*)(ws + WS_WOUT), lds, vb, nvb);
        prep_lb(p.in[3], lb, vb, nvb);
        rmsnorm_rows(p.in[1], MEMN, MT, vb, nvb);
        break;
    case PH_GEMM_IN: {
        Gemm g{(const bf16_t*)(ws + WS_WIN), (const bf16_t*)(ws + WS_WIN), T, PW, 1024}; EpiIn E{BIG, KB, VTB, ssq};
        pg8::ComboOrder S; S.init(nvb, vb);
        pg8::gemm_phase<EpiIn, pg8::ComboOrder, true, true>((LAS unsigned char*)lds, g, S, E);
    } break;
    case PH_CNORM: cnorm_rows(BIG, p.in[6], CN, vb, nvb); hgrn_prep(BIG, lb, (float*)(ws + WS_DEC), (LAS unsigned char*)lds, vb, nvb); break;
    case PH_MIX0:
        for (int item = vb; item < 64; item += nvb) hgrn_scan(BIG, (const float*)(ws + WS_DEC), p.in[9], CAT, (LAS unsigned char*)lds, item);
        dsa_mfma_phase(BIG, CN, p.in[2], CAT, (LAS unsigned char*)lds, (unsigned*)(ws + WS_CTL) + 3600);
        break;
    case PH_GEMM_OUT0: { Gemm g{CAT, (const bf16_t*)(ws + WS_WOUT), T, 1024, KOUT}; EpiResid<false, false, true> E{nullptr, HN, ssq, ws + WS_H8, HQ_Q0}; run_gemm(g, E, lds, vb, nvb); } break;
    case PH_GEMM_Q0: case PH_GEMM_Q1: { Gemm g{(const bf16_t*)(ws + WS_H8), (const bf16_t*)(ws + WS_WQ + (size_t)l * 512 * 1024), T, 512, 512}; EpiStoreBf16<true> E{XQ, 512, ssq, 1.f / ((l ? HQ_Q1 : HQ_Q0) * WQ_GU)}; run_gemm<EpiStoreBf16<true>, 2>(g, E, lds, vb, nvb); } break;
    case PH_XATTN0: case PH_XATTN1: xattn_mfma_phase(XQ, KB + (size_t)l * MT * 512, VTB + (size_t)l * 512 * MT, XO, (LAS unsigned char*)lds, vb, nvb); break;
    case PH_GEMM_O0: case PH_GEMM_O1: { Gemm g{XO, (const bf16_t*)(ws + WS_WO + (size_t)l * 1024 * 512), T, 1024, 256}; EpiResid<false, true, true> E{nullptr, HN, ssq, ws + WS_H8, l ? HQ_GU1 : HQ_GU0, XO_UNSC}; run_gemm<EpiResid<false, true, true>, 1>(g, E, lds, vb, nvb); } break;
    case PH_GEMM_GU0: case PH_GEMM_GU1: { Gemm g{(const bf16_t*)(ws + WS_H8), (const bf16_t*)(ws + WS_WGU + (size_t)l * 2 * FF * 1024), T, 2 * FF, 512}; EpiSwigluQ<true, DN_FP8 != 0> E{BIG, FF, ssq, 1.f / ((l ? HQ_GU1 : HQ_GU0) * WQ_GU)}; run_gemm<EpiSwigluQ<true, DN_FP8 != 0>, 2>(g, E, lds, vb, nvb); } break;
    case PH_GEMM_DN0: case PH_GEMM_DN1:
#if DN_FP8
        { Gemm g{BIG, (const bf16_t*)(ws + WS_WDN + (size_t)l * 1024 * FF), T, 1024, FF / 2}; EpiResid<false, true, ph == PH_GEMM_DN0> E{nullptr, HN, ssq, ws + WS_H8, HQ_OIN, DN_UNSC}; run_gemm<EpiResid<false, true, ph == PH_GEMM_DN0>, 1>(g, E, lds, vb, nvb); } break;
#else
        { Gemm g{BIG, (const bf16_t*)(ws + WS_WDN) + (size_t)l * 1024 * FF, T, 1024, FF}; EpiResid<false, false, ph == PH_GEMM_DN0> E{nullptr, HN, ssq, ws + WS_H8, HQ_OIN}; run_gemm(g, E, lds, vb, nvb); } break;
#endif
    case PH_GEMM_OIN: { Gemm g{(const bf16_t*)(ws + WS_H8), (const bf16_t*)(ws + WS_OWIN), T, 2048, 512}; EpiGeluBf16<true> E{BIG, 2048, ssq, lnp, 1.f / (HQ_OIN * WQ_GU)}; run_gemm<EpiGeluBf16<true>, 2>(g, E, lds, vb, nvb); } break;
    case PH_GMLP: gmlp_mfma_phase(BIG, lnp, p.in[12], p.in[13], p.in[14], p.in[15], CAT, (LAS unsigned char*)lds, vb, nvb); break;
    case PH_GEMM_OOUT: { Gemm g{CAT, (const bf16_t*)(ws + WS_OWOUT), T, 1024, 1024}; EpiResid<false, false, true> E{nullptr, HN, ssq, ws + WS_H8, HQ_Q1}; run_gemm(g, E, lds, vb, nvb); } break;
    case PH_FINAL: final_rows(HN, ssq, p.in[25], p.out, vb, nvb); break;
    default: break;
    }
}

template <int PH> __global__ void __launch_bounds__(NTHREADS) k_phase(Params p) {
    extern __shared__ __attribute__((aligned(16))) float smem[];
    run_phase<PH>(p, (LAS float*)smem, blockIdx.x, gridDim.x);
}

template <int PH> __device__ __forceinline__ void mega_phases(const Params& p, LAS float* lds, const XcdBarrier& bar) {
    run_phase<PH>(p, lds, blockIdx.x, gridDim.x);
#ifdef REPEAT_PH
    if constexpr (PH == REPEAT_PH) { xcd_barrier(bar); run_phase<PH>(p, lds, blockIdx.x, gridDim.x); }
#endif
    if constexpr (PH + 1 < PH_COUNT) { xcd_barrier(bar); mega_phases<PH + 1>(p, lds, bar); }
}
__global__ void __launch_bounds__(NTHREADS) k_mega(Params p) {
    extern __shared__ __attribute__((aligned(16))) float smem[];
    volatile LAS unsigned* st = (volatile LAS unsigned*)((LAS float*)smem + 32768);
    if (threadIdx.x < 2) st[threadIdx.x] = 0u;
    __syncthreads();
    const XcdBarrier bar = xcd_barrier_post((unsigned*)(p.ws + WS_CTL), st);
    mega_phases<0>(p, (LAS float*)smem, bar);
}

template <int PH> static void launch_phases(const Params& p, int grid, hipStream_t stream) {
    int g = grid * 4;
    if (PH == PH_MIX0 || PH == PH_XATTN0 || PH == PH_XATTN1 || PH == PH_GMLP) g = grid;
    (void)hipFuncSetAttribute((const void*)k_phase<PH>, hipFuncAttributeMaxDynamicSharedMemorySize, LDS_BYTES);
    hipLaunchKernelGGL(k_phase<PH>, dim3(g), dim3(NTHREADS), LDS_BYTES, stream, p);
    if constexpr (PH + 1 < PH_COUNT) launch_phases<PH + 1>(p, grid, stream);
}

extern "C" void kernel_launch(void* const* d_in, const int* in_sizes, int n_in, void* d_out, int out_size, void* d_ws, size_t ws_size, hipStream_t stream) {
    static int grid = 0;
    if (grid == 0) {
        if (n_in != 26 || out_size != T * D || ws_size < WS_END) { fprintf(stderr, "kernel_launch: unexpected shapes (n_in %d out %d ws %zu)\n", n_in, out_size, ws_size); grid = -1; return; }
        int dev = 0, cus = 0;
        (void)hipGetDevice(&dev); (void)hipDeviceGetAttribute(&cus, hipDeviceAttributeMultiprocessorCount, dev);
        (void)hipFuncSetAttribute((const void*)k_mega, hipFuncAttributeMaxDynamicSharedMemorySize, LDS_BYTES);
        int per_cu = 0;
        (void)hipOccupancyMaxActiveBlocksPerMultiprocessor(&per_cu, (const void*)k_mega, NTHREADS, LDS_BYTES);
        if (per_cu < 1) fprintf(stderr, "kernel_launch: occupancy query says %d blocks per CU\n", per_cu);
        (void)hipGetLastError();
        grid = cus > 0 ? cus : 256;
    }
    if (grid < 0) return;
    Params p{};
    for (int i = 0; i < 26; ++i) p.in[i] = (const float*)d_in[i];
    p.out = (float*)d_out; p.ws = (unsigned char*)d_ws;
    (void)hipMemsetAsync((char*)d_ws + WS_CTL, 0, 16384, stream);
#if MEGA
    hipLaunchKernelGGL(k_mega, dim3(grid), dim3(NTHREADS), LDS_BYTES, stream, p);
#else
    launch_phases<0>(p, grid, stream);
#endif
}
```

```cpp
#include <hip/hip_runtime.h>
#include <stdint.h>
#include <stdio.h>

#ifndef MEGA
#define MEGA 1
#endif
#ifndef DN_FP8
#define DN_FP8 2
#endif

#define LAS __attribute__((address_space(3)))
typedef unsigned short bf16_t;
typedef short bf16x8 __attribute__((ext_vector_type(8)));
typedef float f32x4 __attribute__((ext_vector_type(4)));
typedef float f32x2 __attribute__((ext_vector_type(2)));
typedef unsigned u32x4 __attribute__((ext_vector_type(4)));
typedef unsigned u32x2 __attribute__((ext_vector_type(2)));
typedef float f32x16 __attribute__((ext_vector_type(16)));

constexpr int D = 1024, BATCH = 16, SEQ = 2048, T = BATCH * SEQ;
constexpr int CHUNK = 64;
constexpr int MEMT = 256, MT = BATCH * MEMT;
constexpr int FF = 2816;
constexpr float EPS = 1e-6f;
constexpr int NTHREADS = 512, NWAVES = 8;

constexpr int P_QL = 0, P_C = 1024, P_QI = 1152, P_KI = 1664, P_FB = 1728, P_IB = 2240, P_QB = 2752, P_GB = 3264, P_WI = 3776, P_END = 3784, PW = 3840;
constexpr int KOUT = 1536;

constexpr size_t MiB = 1u << 20;
constexpr size_t WS_CTL = 0;
constexpr size_t WS_LB = 64 * 1024;
constexpr size_t WS_SSQ = 496 * MiB;
constexpr size_t WS_LNP = 498 * MiB;
constexpr size_t WS_WIN = 1 * MiB;
constexpr size_t WS_WKV = WS_WIN + (size_t)PW * D * 2;
constexpr size_t WS_HN = WS_WKV + 2 * (size_t)D * D * 2;
constexpr size_t WS_MEMN = WS_HN + (size_t)T * D * 2;
constexpr size_t WS_WOUT = WS_MEMN + (size_t)MT * D * 2;
constexpr size_t WS_OWIN = WS_WOUT + (size_t)D * KOUT * 2;
constexpr size_t WS_OWOUT = WS_OWIN + (size_t)2048 * D * 2;
constexpr size_t WS_WQ = WS_OWOUT + (size_t)D * D * 2;
constexpr size_t WS_WO = WS_WQ + 2 * (size_t)512 * D * 2;
constexpr size_t WS_WGU = WS_WO + 2 * (size_t)D * 512 * 2;
constexpr size_t WS_WDN = WS_WGU + 2 * (size_t)2 * FF * D * 2;
constexpr size_t WS_WEND = WS_WDN + 2 * (size_t)D * FF * 2;
constexpr int TILE_WIN = 0, TILE_WKV = PW / 256, TILE_HN = TILE_WKV + 8, TILE_MEMN = TILE_HN + T / 256;
constexpr size_t WS_BIG = 132 * MiB;
constexpr size_t WS_CN = 372 * MiB;
constexpr size_t WS_CAT = 380 * MiB;
constexpr size_t WS_H8 = WS_BIG + 200 * MiB;
constexpr size_t WS_KB = 476 * MiB;
constexpr size_t WS_VT = 484 * MiB;
constexpr size_t WS_END = 502 * MiB;
static_assert(WS_WEND <= WS_BIG, "weights fit below BIG");

struct Params {
    const float* in[26];
    float* out;
    unsigned char* ws;
};

__device__ __forceinline__ float bf2f(unsigned short u) { return __uint_as_float(((unsigned)u) << 16); }
__device__ __forceinline__ unsigned f2bf(float f) { unsigned u = __float_as_uint(f); return (u + 0x7fffu + ((u >> 16) & 1u)) >> 16; }
typedef __bf16 bf16x2_t __attribute__((ext_vector_type(2)));
__device__ __forceinline__ unsigned pk2(float lo, float hi) { const f32x2 v = {lo, hi}; return __builtin_bit_cast(unsigned, __builtin_convertvector(v, bf16x2_t)); }
__device__ __forceinline__ float wave_sum(float v) {
#pragma unroll
    for (int o = 1; o < 64; o <<= 1) v += __shfl_xor(v, o);
    return v;
}
__device__ __forceinline__ float wave_max(float v) {
#pragma unroll
    for (int o = 1; o < 64; o <<= 1) v = fmaxf(v, __shfl_xor(v, o));
    return v;
}
__device__ __forceinline__ int otid() { int t = threadIdx.x; asm volatile("" : "+v"(t)); return t; }
#define WAVE_LDS_SYNC() asm volatile("s_waitcnt lgkmcnt(0)" ::: "memory")
__device__ __forceinline__ float silu_f(float x) { return x * __builtin_amdgcn_rcpf(1.f + __expf(-x)); }
__device__ __forceinline__ float sigmoid_f(float x) { return __builtin_amdgcn_rcpf(1.f + __expf(-x)); }

typedef int i32x4v __attribute__((ext_vector_type(4)));
typedef int i32x8v __attribute__((ext_vector_type(8)));
__device__ __forceinline__ unsigned pk4_f8(float a, float b, float c, float d) {
    a = __builtin_amdgcn_fmed3f(a, -448.f, 448.f); b = __builtin_amdgcn_fmed3f(b, -448.f, 448.f); c = __builtin_amdgcn_fmed3f(c, -448.f, 448.f); d = __builtin_amdgcn_fmed3f(d, -448.f, 448.f);
    int w = 0;
    w = __builtin_amdgcn_cvt_pk_fp8_f32(a, b, w, false);
    w = __builtin_amdgcn_cvt_pk_fp8_f32(c, d, w, true);
    return (unsigned)w;
}
constexpr float ACT_SC = 8.f, WDN_SC = 256.f, DN_UNSC = 1.f / (ACT_SC * WDN_SC);
constexpr float XO_SC = 64.f, WO_SC = 128.f, XO_UNSC = 1.f / (XO_SC * WO_SC);
constexpr float HQ_Q0 = 127.f / 5.2f, HQ_GU0 = 127.f / 5.2f, HQ_OIN = 127.f / 5.8f, HQ_Q1 = 127.f / 6.3f, HQ_GU1 = 127.f / 6.3f, WQ_GU = 127.f / 0.13f;
__device__ __forceinline__ unsigned pk4_i8(float a, float b, float c, float d, float sc) {
    constexpr float MG = 12582912.f;
    const unsigned ua = __float_as_uint(__builtin_amdgcn_fmed3f(__builtin_fmaf(a, sc, MG), MG - 127.f, MG + 127.f)), ub = __float_as_uint(__builtin_amdgcn_fmed3f(__builtin_fmaf(b, sc, MG), MG - 127.f, MG + 127.f));
    const unsigned uc = __float_as_uint(__builtin_amdgcn_fmed3f(__builtin_fmaf(c, sc, MG), MG - 127.f, MG + 127.f)), ud = __float_as_uint(__builtin_amdgcn_fmed3f(__builtin_fmaf(d, sc, MG), MG - 127.f, MG + 127.f));
    return __builtin_amdgcn_perm(ub, ua, 0x0c0c0400u) | __builtin_amdgcn_perm(ud, uc, 0x04000c0cu);
}
__device__ __forceinline__ int kperm8(int k) { const int r = k & 255; return (k & ~255) + ((r >> 5) & 3) * 64 + ((r >> 3) & 3) * 16 + (r >> 7) * 8 + (r & 7); }
__device__ __forceinline__ f32x4 i2f4(f32x4 v) { const i32x4v t = __builtin_bit_cast(i32x4v, v); return (f32x4){(float)t.x, (float)t.y, (float)t.z, (float)t.w}; }
struct Unit { int pm, pn; };
struct Gemm { const bf16_t* A; const bf16_t* Bt; int M, N, K; };
__device__ __forceinline__ int perm32(int rho) { const int n = rho >> 4, i = rho & 15; return 8 * (i >> 2) + 4 * n + (i & 3); }

__device__ __forceinline__ float row_rstd(const float* ssq, size_t row) {
    const f32x4* p = (const f32x4*)(ssq + row * 16);
    const f32x4 a = p[0], b = p[1], c = p[2], d = p[3];
    const float t = (((a.x + a.y) + (a.z + a.w)) + ((b.x + b.y) + (b.z + b.w))) + (((c.x + c.y) + (c.z + c.w)) + ((d.x + d.y) + (d.z + d.w)));
    return rsqrtf(t * (1.f / 1024.f) + EPS);
}
__device__ __forceinline__ void rows_rstd(const float* ssq, size_t row0, int fq, float (&rs)[2][4]) {
#pragma unroll
    for (int ai = 0; ai < 2; ++ai)
#pragma unroll
        for (int m = 0; m < 4; ++m) { const f32x4 a = *(const f32x4*)(ssq + (row0 + ai * 128 + m * 16) * 16 + 4 * fq); rs[ai][m] = (a.x + a.y) + (a.z + a.w); }
#pragma unroll
    for (int ai = 0; ai < 2; ++ai)
#pragma unroll
        for (int m = 0; m < 4; ++m) { float t = rs[ai][m]; t += __shfl_xor(t, 16); t += __shfl_xor(t, 32); rs[ai][m] = rsqrtf(t * (1.f / 1024.f) + EPS); }
}
template <bool ACC_I8 = false> struct EpiStoreBf16 {
    static constexpr bool PERM = true, AFTER_DRAIN = false;
    bf16_t* O; int ldc; const float* ssq; float dq = 1.f;
    __device__ __forceinline__ void operator()(const f32x4 (&acc)[2][2][4][2], const Unit& u, int wr, int wc, int fr, int fq) const {
        const int row0 = u.pm * 256 + wr * 64 + fr, col0 = u.pn * 256 + wc * 32 + 8 * fq;
        float rsv[2][4]; rows_rstd(ssq, (size_t)row0, fq, rsv);
#pragma unroll
        for (int ai = 0; ai < 2; ++ai)
#pragma unroll
            for (int m = 0; m < 4; ++m) {
                const float rs = ACC_I8 ? rsv[ai][m] * dq : rsv[ai][m];
                bf16_t* rowp = O + (size_t)(row0 + ai * 128 + m * 16) * ldc + col0;
#pragma unroll
                for (int bj = 0; bj < 2; ++bj) {
                    const f32x4 v0 = (ACC_I8 ? i2f4(acc[ai][bj][m][0]) : acc[ai][bj][m][0]) * rs, v1 = (ACC_I8 ? i2f4(acc[ai][bj][m][1]) : acc[ai][bj][m][1]) * rs;
                    u32x4 w; w.x = pk2(v0[0], v0[1]); w.y = pk2(v0[2], v0[3]); w.z = pk2(v1[0], v1[1]); w.w = pk2(v1[2], v1[3]);
                    *(u32x4*)(rowp + bj * 128) = w;
                }
            }
    }
};
struct EpiIn {
    static constexpr bool PERM = true, AFTER_DRAIN = false;
    bf16_t* P; bf16_t* KB; bf16_t* VT; const float* ssq;
    __device__ __forceinline__ void operator()(const f32x4 (&acc)[2][2][4][2], const Unit& u, int wr, int wc, int fr, int fq) const {
        bf16_t* O; int ldc, rt, ct; const bool main_unit = u.pn < TILE_WKV;
        if (main_unit) { O = P; ldc = PW; rt = u.pm - TILE_HN; ct = u.pn; }
        else if (u.pm >= TILE_MEMN) { const int l = (u.pn - TILE_WKV) >> 2; O = KB + (size_t)l * MT * 512; ldc = 512; rt = u.pm - TILE_MEMN; ct = (u.pn - TILE_WKV) & 3; }
        else { const int l = (u.pm - TILE_WKV) >> 2; O = VT + (size_t)l * 512 * MT; ldc = MT; rt = ((u.pm - TILE_WKV) & 3) - 2; ct = u.pn - TILE_MEMN; }
        const int row0 = rt * 256 + wr * 64 + fr, col0 = ct * 256 + wc * 32 + 8 * fq;
        float rsv[2][4];
        if (main_unit) rows_rstd(ssq, (size_t)row0, fq, rsv);
        else {
#pragma unroll
            for (int ai = 0; ai < 2; ++ai)
#pragma unroll
                for (int m = 0; m < 4; ++m) rsv[ai][m] = 1.f; }
#pragma unroll
        for (int ai = 0; ai < 2; ++ai)
#pragma unroll
            for (int m = 0; m < 4; ++m) {
                const float rs = rsv[ai][m];
                bf16_t* rowp = O + (size_t)(row0 + ai * 128 + m * 16) * ldc + col0;
#pragma unroll
                for (int bj = 0; bj < 2; ++bj) {
                    const f32x4 v0 = acc[ai][bj][m][0] * rs, v1 = acc[ai][bj][m][1] * rs;
                    u32x4 w; w.x = pk2(v0[0], v0[1]); w.y = pk2(v0[2], v0[3]); w.z = pk2(v1[0], v1[1]); w.w = pk2(v1[2], v1[3]);
                    *(u32x4*)(rowp + bj * 128) = w;
                }
            }
    }
};
template <bool ACC_I8 = false> struct EpiGeluBf16 {
    static constexpr bool PERM = true, AFTER_DRAIN = false;
    bf16_t* O; int ldc; const float* ssq; float* lnp; float dq = 1.f;
    __device__ __forceinline__ static f32x2 gelu_pk(f32x2 v) {
        const f32x2 av = __builtin_elementwise_abs(v), d = av * 0.2316418882f + 1.0f;
        f32x2 t; t.x = __builtin_amdgcn_rcpf(d.x); t.y = __builtin_amdgcn_rcpf(d.y);
        f32x2 q = t * 0.5307027145f + (-0.7265760135f); q = q * t + 0.7107068705f; q = q * t + (-0.142248368f); q = q * t + 0.127414796f; q = q * t;
        const f32x2 sq = (v * v) * (-0.72134752044f);
        f32x2 e; e.x = __builtin_amdgcn_exp2f(sq.x); e.y = __builtin_amdgcn_exp2f(sq.y);
        const f32x2 mm = v * (q * e), r = v - mm;
        f32x2 o; o.x = v.x < 0.f ? mm.x : r.x; o.y = v.y < 0.f ? mm.y : r.y; return o;
    }
    __device__ __forceinline__ static unsigned g2(float a, float b) { const f32x2 r = gelu_pk((f32x2){a, b}); return pk2(r.x, r.y); }
    __device__ __forceinline__ void operator()(const f32x4 (&acc)[2][2][4][2], const Unit& u, int wr, int wc, int fr, int fq) const {
        const int row0 = u.pm * 256 + wr * 64 + fr, col0 = u.pn * 256 + wc * 32 + 8 * fq;
        float rsv[2][4]; rows_rstd(ssq, (size_t)row0, fq, rsv);
#pragma unroll
        for (int ai = 0; ai < 2; ++ai)
#pragma unroll
            for (int m = 0; m < 4; ++m) {
                const size_t row = (size_t)(row0 + ai * 128 + m * 16);
                const float rs = ACC_I8 ? rsv[ai][m] * dq : rsv[ai][m];
                bf16_t* rowp = O + row * ldc + col0;
                float s1 = 0.f, s2 = 0.f;
#pragma unroll
                for (int bj = 0; bj < 2; ++bj) {
                    const f32x4 v0 = (ACC_I8 ? i2f4(acc[ai][bj][m][0]) : acc[ai][bj][m][0]) * rs, v1 = (ACC_I8 ? i2f4(acc[ai][bj][m][1]) : acc[ai][bj][m][1]) * rs;
                    const f32x2 ga = gelu_pk((f32x2){v0[0], v0[1]}), gb = gelu_pk((f32x2){v0[2], v0[3]}), gc = gelu_pk((f32x2){v1[0], v1[1]}), gd = gelu_pk((f32x2){v1[2], v1[3]});
                    u32x4 w; w.x = pk2(ga.x, ga.y); w.y = pk2(gb.x, gb.y); w.z = pk2(gc.x, gc.y); w.w = pk2(gd.x, gd.y);
                    *(u32x4*)(rowp + bj * 128) = w;
                    s1 += ((ga.x + ga.y) + (gb.x + gb.y)) + ((gc.x + gc.y) + (gd.x + gd.y));
                    s2 += ((ga.x * ga.x + ga.y * ga.y) + (gb.x * gb.x + gb.y * gb.y)) + ((gc.x * gc.x + gc.y * gc.y) + (gd.x * gd.x + gd.y * gd.y));
                }
                if (u.pn >= 4) {
                    s1 += __shfl_xor(s1, 16); s1 += __shfl_xor(s1, 32); s2 += __shfl_xor(s2, 16); s2 += __shfl_xor(s2, 32);
                    if (fq == 0) *(f32x2*)(lnp + (row * 16 + (u.pn - 4) * 4 + wc) * 2) = (f32x2){s1, s2};
                }
            }
    }
};
struct EpiSwigluBf16 {
    static constexpr bool PERM = true, AFTER_DRAIN = false;
    bf16_t* O; int ldc; const float* ssq;
    __device__ __forceinline__ void operator()(const f32x4 (&acc)[2][2][4][2], const Unit& u, int wr, int wc, int fr, int fq) const {
        const int row0 = u.pm * 256 + wr * 64 + fr, col0 = u.pn * 128 + wc * 32 + 8 * fq;
        float rsv[2][4]; rows_rstd(ssq, (size_t)row0, fq, rsv);
#pragma unroll
        for (int ai = 0; ai < 2; ++ai)
#pragma unroll
            for (int m = 0; m < 4; ++m) {
                const float rs = rsv[ai][m];
                bf16_t* rowp = O + (size_t)(row0 + ai * 128 + m * 16) * ldc + col0;
                const f32x4 g0 = acc[ai][0][m][0] * rs, g1 = acc[ai][0][m][1] * rs, u0 = acc[ai][1][m][0] * rs, u1 = acc[ai][1][m][1] * rs;
                u32x4 w;
                w.x = pk2(silu_f(g0[0]) * u0[0], silu_f(g0[1]) * u0[1]); w.y = pk2(silu_f(g0[2]) * u0[2], silu_f(g0[3]) * u0[3]);
                w.z = pk2(silu_f(g1[0]) * u1[0], silu_f(g1[1]) * u1[1]); w.w = pk2(silu_f(g1[2]) * u1[2], silu_f(g1[3]) * u1[3]);
                *(u32x4*)rowp = w;
            }
    }
};
template <bool ACC_I8, bool OUT_F8> struct EpiSwigluQ {
    static constexpr bool PERM = true, AFTER_DRAIN = false;
    void* O; int ldc; const float* ssq; float dq;
    __device__ __forceinline__ void operator()(const f32x4 (&acc)[2][2][4][2], const Unit& u, int wr, int wc, int fr, int fq) const {
        const int row0 = u.pm * 256 + wr * 64 + fr, col0 = u.pn * 128 + wc * 32 + 8 * fq;
        float rsv[2][4]; rows_rstd(ssq, (size_t)row0, fq, rsv);
#pragma unroll
        for (int ai = 0; ai < 2; ++ai)
#pragma unroll
            for (int m = 0; m < 4; ++m) {
                const float rs = ACC_I8 ? rsv[ai][m] * dq : rsv[ai][m], rsu = OUT_F8 ? rs * ACT_SC : rs;
                f32x4 g0 = acc[ai][0][m][0], g1 = acc[ai][0][m][1], u0 = acc[ai][1][m][0], u1 = acc[ai][1][m][1];
                if (ACC_I8) { g0 = i2f4(g0); g1 = i2f4(g1); u0 = i2f4(u0); u1 = i2f4(u1); }
                g0 = g0 * rs; g1 = g1 * rs; u0 = u0 * rsu; u1 = u1 * rsu;
                if (OUT_F8) {
                    unsigned char* rowp = (unsigned char*)O + (size_t)(row0 + ai * 128 + m * 16) * ldc + col0;
                    u32x2 w;
                    w.x = pk4_f8(silu_f(g0[0]) * u0[0], silu_f(g0[1]) * u0[1], silu_f(g0[2]) * u0[2], silu_f(g0[3]) * u0[3]);
                    w.y = pk4_f8(silu_f(g1[0]) * u1[0], silu_f(g1[1]) * u1[1], silu_f(g1[2]) * u1[2], silu_f(g1[3]) * u1[3]);
                    *(u32x2*)rowp = w;
                } else {
                    bf16_t* rowp = (bf16_t*)O + (size_t)(row0 + ai * 128 + m * 16) * ldc + col0;
                    u32x4 w;
                    w.x = pk2(silu_f(g0[0]) * u0[0], silu_f(g0[1]) * u0[1]); w.y = pk2(silu_f(g0[2]) * u0[2], silu_f(g0[3]) * u0[3]);
                    w.z = pk2(silu_f(g1[0]) * u1[0], silu_f(g1[1]) * u1[1]); w.w = pk2(silu_f(g1[2]) * u1[2], silu_f(g1[3]) * u1[3]);
                    *(u32x4*)rowp = w;
                }
            }
    }
};
template <bool BASE_F32, bool SCALED = false, bool W8 = false> struct EpiResid {
    static constexpr bool PERM = true, AFTER_DRAIN = false;
    const float* xbase; bf16_t* H; float* ssq; unsigned char* H8 = nullptr; float hq = 0.f; float asc = 1.f;
    __device__ __forceinline__ void operator()(const f32x4 (&acc)[2][2][4][2], const Unit& u, int wr, int wc, int fr, int fq) const {
        const int row0 = u.pm * 256 + wr * 64 + fr, col0 = u.pn * 256 + wc * 32 + 8 * fq;
#pragma unroll
        for (int ai = 0; ai < 2; ++ai)
#pragma unroll
            for (int m = 0; m < 4; ++m) {
                const size_t row = (size_t)(row0 + ai * 128 + m * 16);
                float ss = 0.f; u32x4 q8 = (u32x4){0u, 0u, 0u, 0u};
#pragma unroll
                for (int bj = 0; bj < 2; ++bj) {
                    const size_t off = row * 1024 + col0 + bj * 128;
                    f32x4 b0, b1;
                    if (BASE_F32) { b0 = *(const f32x4*)(xbase + off); b1 = *(const f32x4*)(xbase + off + 4); }
                    else { const u32x4 hw = *(const u32x4*)(H + off);
                        b0 = (f32x4){bf2f((unsigned short)(hw.x & 0xffffu)), bf2f((unsigned short)(hw.x >> 16)), bf2f((unsigned short)(hw.y & 0xffffu)), bf2f((unsigned short)(hw.y >> 16))};
                        b1 = (f32x4){bf2f((unsigned short)(hw.z & 0xffffu)), bf2f((unsigned short)(hw.z >> 16)), bf2f((unsigned short)(hw.w & 0xffffu)), bf2f((unsigned short)(hw.w >> 16))}; }
                    const float sc = SCALED ? asc : 1.f;
                    const f32x4 v0 = b0 + acc[ai][bj][m][0] * sc, v1 = b1 + acc[ai][bj][m][1] * sc;
                    u32x4 w; w.x = pk2(v0[0], v0[1]); w.y = pk2(v0[2], v0[3]); w.z = pk2(v1[0], v1[1]); w.w = pk2(v1[2], v1[3]);
                    *(u32x4*)(H + off) = w;
                    if (W8) { q8[2 * bj] = pk4_i8(v0[0], v0[1], v0[2], v0[3], hq); q8[2 * bj + 1] = pk4_i8(v1[0], v1[1], v1[2], v1[3], hq); }
                    ss += ((v0[0] * v0[0] + v0[1] * v0[1]) + (v0[2] * v0[2] + v0[3] * v0[3])) + ((v1[0] * v1[0] + v1[1] * v1[1]) + (v1[2] * v1[2] + v1[3] * v1[3]));
                }
                if (W8) *(u32x4*)(H8 + row * 1024 + u.pn * 256 + wc * 64 + fq * 16) = q8;
                ss += __shfl_xor(ss, 16); ss += __shfl_xor(ss, 32);
                if (fq == 0) ssq[row * 16 + u.pn * 4 + wc] = ss;
            }
    }
};
namespace pg8 {
#define PG8_LAS __attribute__((address_space(3)))
constexpr int BM = 256, BK = 64, HALF = 128, HTB = HALF * BK * 2  , STAGE_BYTES = 8 * HTB, NXCD = 8, WGM = 8;
__host__ __device__ __forceinline__ int lds_byte(int r, int c) { const int st = (r >> 4) * 2 + (c >> 5), rr = r & 15, cc = c & 31, ob = rr * 64 + cc * 2; return st * 1024 + (ob ^ (((ob >> 9) & 1) << 5)); }
__host__ __device__ __forceinline__ void stage_rc(int b, int& R, int& C) { const int st = b / 1024, sb = b % 1024, swz = sb ^ (((sb >> 9) & 1) << 5); R = (st >> 1) * 16 + swz / 64; C = (st & 1) * 32 + (swz % 64) / 2; }
struct StaticOrder {
    int nM, nN, nwg, G, c;
    __host__ __device__ void init(int M, int N, int G_, int c_) { nM = M / BM; nN = N / BM; nwg = nM * nN; G = G_; c = c_; }
    __host__ __device__ bool next(int i, Unit& u) const {
        const long L = (long)i * G + c; if (L >= nwg) return false;
        int wgid = (int)L; { const int q = nwg / NXCD, r = nwg % NXCD, xcd = wgid % NXCD, off = wgid / NXCD; wgid = (xcd < r ? xcd * (q + 1) : r * (q + 1) + (xcd - r) * q) + off; }
        const int nig = WGM * nN, gid = wgid / nig, fm = gid * WGM, gsz = (nM - fm) < WGM ? (nM - fm) : WGM;
        u.pm = fm + ((wgid % nig) % gsz); u.pn = (wgid % nig) / gsz; return true;
    }
    __device__ __forceinline__ void a_ready(const Unit&) const {}
    __device__ __forceinline__ void done(const Unit&) const {}
};
struct ComboOrder {
    StaticOrder so;
    __host__ __device__ void init(int G_, int c_) { so.init(T, PW, G_, c_); }
    __host__ __device__ bool next(int i, Unit& u) const {
        const long L = (long)i * so.G + so.c;
        if (L < so.nwg) { so.next(i, u); u.pm += TILE_HN; return true; }
        const int j = (int)(L - so.nwg); if (j >= 128) return false;
        const int l = j >> 6, jj = j & 63;
        if (jj < 32) { u.pm = TILE_MEMN + (jj >> 1); u.pn = TILE_WKV + 4 * l + (jj & 1); }
        else { const int q = jj - 32; u.pm = TILE_WKV + 4 * l + 2 + (q >> 4); u.pn = TILE_MEMN + (q & 15); }
        return true;
    }
    __device__ __forceinline__ void a_ready(const Unit&) const {}
    __device__ __forceinline__ void done(const Unit&) const {}
};
template <class Epi, class Sched, bool ALIGN_EPI = false, bool SP2 = false, int QM = 0  >
__device__ __forceinline__ void gemm_phase(PG8_LAS unsigned char* lds, const Gemm g, const Sched& S, const Epi& E) {
    const int tid = otid(), wid = __builtin_amdgcn_readfirstlane(tid >> 6), lane = tid & 63, wr = wid >> 2, wc = wid & 3, fr = lane & 15, fq = lane >> 4;
    constexpr bool FP8 = (QM == 1), I8 = (QM == 2);
    const int K = g.K, nt = K / BK;
    unsigned voffA[2], voffB[2];
#pragma unroll
    for (int i = 0; i < 2; ++i) { int R, C; stage_rc(tid * 16 + i * 8192, R, C); const int Rb = Epi::PERM ? ((R & ~31) + perm32(R & 31)) : R;
        voffA[i] = (unsigned)(R * K + C) * 2u; voffB[i] = (unsigned)(Rb * K + C) * 2u; }
    const size_t kstep = (size_t)(BK * 2);
    const size_t hstep = (size_t)HALF * K * 2;
    const size_t tstep = 2 * hstep;
    const unsigned ldsw = (unsigned)wid * 1024u;
    const int aoff = lds_byte(wr * 64 + fr, fq * 8), boff = lds_byte(wc * 32 + fr, fq * 8);
#define PG8_SA(b, h) (((b) * 2 + (h)) * HTB)
#define PG8_SB(b, h) ((4 + (b) * 2 + (h)) * HTB)
#define PG8_STAGE(bufoff, gbase, voff) do { _Pragma("unroll") for (int _i = 0; _i < 2; ++_i) \
        __builtin_amdgcn_global_load_lds((const unsigned*)((const char*)(gbase) + (voff)[_i]), (PG8_LAS unsigned*)(lds + (bufoff) + ldsw + _i * 8192), 16, 0, 0); } while (0)
#define PG8_LD16(off) (*(const PG8_LAS bf16x8*)(lds + (off)))
#define PG8_LDA(dst, b, h) do { _Pragma("unroll") for (int m = 0; m < 4; ++m) { \
        if constexpr (FP8) dst##8[m] = PG8_CAT(PG8_LD16(PG8_SA(b, h) + aoff + m * 2048), PG8_LD16(PG8_SA(b, h) + aoff + m * 2048 + 1024)); \
        else { _Pragma("unroll") for (int k = 0; k < 2; ++k) dst[m][k] = PG8_LD16(PG8_SA(b, h) + aoff + m * 2048 + k * 1024); } } } while (0)
#define PG8_LDB(dst, b, h) do { _Pragma("unroll") for (int n = 0; n < 2; ++n) { \
        if constexpr (FP8) dst##8[n] = PG8_CAT(PG8_LD16(PG8_SB(b, h) + boff + n * 2048), PG8_LD16(PG8_SB(b, h) + boff + n * 2048 + 1024)); \
        else { _Pragma("unroll") for (int k = 0; k < 2; ++k) dst[n][k] = PG8_LD16(PG8_SB(b, h) + boff + n * 2048 + k * 1024); } } } while (0)
#define PG8_CAT(x, y) __builtin_shufflevector(__builtin_bit_cast(i32x4v, x), __builtin_bit_cast(i32x4v, y), 0, 1, 2, 3, 4, 5, 6, 7)
#define PG8_MMA(ai, bj, At, Bt) do { __builtin_amdgcn_s_setprio(1); \
        if constexpr (FP8) { _Pragma("unroll") for (int m = 0; m < 4; ++m) _Pragma("unroll") for (int n = 0; n < 2; ++n) \
            asm("v_mfma_f32_16x16x128_f8f6f4 %0, %1, %2, %0" : "+v"(acc[ai][bj][m][n]) : "v"(Bt##8[n]), "v"(At##8[m])); } \
        else if constexpr (I8) { _Pragma("unroll") for (int m = 0; m < 4; ++m) _Pragma("unroll") for (int n = 0; n < 2; ++n) _Pragma("unroll") for (int k = 0; k < 2; ++k) \
            acc[ai][bj][m][n] = __builtin_bit_cast(f32x4, __builtin_amdgcn_mfma_i32_16x16x64_i8(__builtin_bit_cast(i32x4v, Bt[n][k]), __builtin_bit_cast(i32x4v, At[m][k]), __builtin_bit_cast(i32x4v, acc[ai][bj][m][n]), 0, 0, 0)); } \
        else { _Pragma("unroll") for (int m = 0; m < 4; ++m) _Pragma("unroll") for (int n = 0; n < 2; ++n) _Pragma("unroll") for (int k = 0; k < 2; ++k) \
            acc[ai][bj][m][n] = __builtin_amdgcn_mfma_f32_16x16x32_bf16(Bt[n][k], At[m][k], acc[ai][bj][m][n], 0, 0, 0); } \
        __builtin_amdgcn_s_setprio(0); } while (0)
#define PG8_WAIT_V(n) asm volatile("s_waitcnt vmcnt(" #n ")" ::: "memory")
#define PG8_WAIT_L(n) asm volatile("s_waitcnt lgkmcnt(" #n ")" ::: "memory")
#define PG8_BAR __builtin_amdgcn_s_barrier()
#define PG8_SCHED __builtin_amdgcn_sched_barrier(0)
    Unit cur, nxt; int ui = 0;
    if (!S.next(0, cur)) return;
    f32x4 acc[2][2][4][2];
#pragma unroll
    for (int a = 0; a < 2; ++a)
#pragma unroll
        for (int b = 0; b < 2; ++b)
#pragma unroll
            for (int m = 0; m < 4; ++m)
#pragma unroll
                for (int n = 0; n < 2; ++n) acc[a][b][m][n] = (f32x4){0.f, 0.f, 0.f, 0.f};
    bf16x8 At[4][2], B0[2][2], B1[2][2];
    i32x8v At8[4], B08[2], B18[2];
    const char* cA = (const char*)g.A + (size_t)cur.pm * tstep; const char* cB = (const char*)g.Bt + (size_t)cur.pn * tstep;
    S.a_ready(cur);
    if constexpr (SP2) {
        PG8_STAGE(PG8_SB(0, 0), cB, voffB); PG8_STAGE(PG8_SB(0, 1), cB + hstep, voffB); PG8_STAGE(PG8_SA(0, 0), cA, voffA); PG8_STAGE(PG8_SA(0, 1), cA + hstep, voffA);
        if (wr == 1) PG8_BAR;
        PG8_WAIT_V(2); PG8_BAR;
        PG8_STAGE(PG8_SB(1, 0), cB + kstep, voffB); PG8_STAGE(PG8_SA(1, 0), cA + kstep, voffA); PG8_STAGE(PG8_SB(1, 1), cB + hstep + kstep, voffB);
        PG8_WAIT_V(6); PG8_BAR;
    } else {
        PG8_STAGE(PG8_SB(0, 0), cB, voffB); PG8_STAGE(PG8_SA(0, 0), cA, voffA); PG8_STAGE(PG8_SB(0, 1), cB + hstep, voffB); PG8_STAGE(PG8_SA(0, 1), cA + hstep, voffA);
        if (wr == 1) PG8_BAR;
        PG8_WAIT_V(4); PG8_BAR;
        PG8_STAGE(PG8_SB(1, 0), cB + kstep, voffB); PG8_STAGE(PG8_SA(1, 0), cA + kstep, voffA); PG8_STAGE(PG8_SB(1, 1), cB + hstep + kstep, voffB);
        PG8_WAIT_V(6); PG8_BAR;
    }
    for (;;) {
        const bool has_next = S.next(ui + 1, nxt);
        const char* nA = has_next ? (const char*)g.A + (size_t)nxt.pm * tstep : cA; const char* nB = has_next ? (const char*)g.Bt + (size_t)nxt.pn * tstep : cB;
        for (int t = 0; t < nt; t += 2) {
            const bool last = (t == nt - 2);
            if constexpr (FP8) __builtin_amdgcn_s_waitcnt(0xC07F);
            const char* a1 = cA + (size_t)(t + 1) * kstep;
            const char* a2 = last ? nA : cA + (size_t)(t + 2) * kstep; const char* b2 = last ? nB : cB + (size_t)(t + 2) * kstep;
            const char* a3 = a2 + kstep; const char* b3 = b2 + kstep;
            if (last && has_next) S.a_ready(nxt);
            if constexpr (SP2) {
            PG8_LDB(B0, 0, 0); PG8_LDB(B1, 0, 1); PG8_SCHED; PG8_LDA(At, 0, 0); PG8_STAGE(PG8_SA(1, 1), a1 + hstep, voffA);
            PG8_WAIT_V(8); PG8_WAIT_L(0); PG8_BAR; PG8_MMA(0, 0, At, B0); PG8_MMA(0, 1, At, B1); PG8_BAR; PG8_SCHED;
            PG8_LDA(At, 0, 1); PG8_STAGE(PG8_SB(0, 0), b2, voffB); PG8_STAGE(PG8_SB(0, 1), b2 + hstep, voffB); PG8_STAGE(PG8_SA(0, 0), a2, voffA);
            PG8_WAIT_V(8); PG8_WAIT_L(0); PG8_BAR; PG8_MMA(1, 0, At, B0); PG8_MMA(1, 1, At, B1); PG8_BAR; PG8_SCHED;
            PG8_LDB(B0, 1, 0); PG8_LDB(B1, 1, 1); PG8_SCHED; PG8_LDA(At, 1, 0); PG8_STAGE(PG8_SA(0, 1), a2 + hstep, voffA);
            PG8_WAIT_V(8); PG8_WAIT_L(0); PG8_BAR; PG8_MMA(0, 0, At, B0); PG8_MMA(0, 1, At, B1); PG8_BAR; PG8_SCHED;
            PG8_LDA(At, 1, 1); PG8_STAGE(PG8_SB(1, 0), b3, voffB); PG8_STAGE(PG8_SB(1, 1), b3 + hstep, voffB); PG8_STAGE(PG8_SA(1, 0), a3, voffA);
            PG8_WAIT_V(8); PG8_WAIT_L(0); PG8_BAR; PG8_MMA(1, 0, At, B0); PG8_MMA(1, 1, At, B1); PG8_BAR; PG8_SCHED;
            } else {
            PG8_LDB(B0, 0, 0); PG8_SCHED; PG8_LDA(At, 0, 0); PG8_STAGE(PG8_SA(1, 1), a1 + hstep, voffA);
            PG8_WAIT_L(8); PG8_BAR; PG8_WAIT_L(0); PG8_MMA(0, 0, At, B0); PG8_BAR; PG8_SCHED;
            PG8_LDB(B1, 0, 1); PG8_STAGE(PG8_SB(0, 0), b2, voffB);
            PG8_BAR; PG8_WAIT_L(0); PG8_MMA(0, 1, At, B1); PG8_BAR;
            PG8_LDA(At, 0, 1); PG8_STAGE(PG8_SA(0, 0), a2, voffA);
            PG8_BAR; PG8_WAIT_L(0); PG8_MMA(1, 0, At, B0); PG8_BAR; PG8_SCHED;
            PG8_STAGE(PG8_SB(0, 1), b2 + hstep, voffB);
            PG8_WAIT_V(6); PG8_BAR; PG8_MMA(1, 1, At, B1); PG8_BAR;
            PG8_LDB(B0, 1, 0); PG8_SCHED; PG8_LDA(At, 1, 0); PG8_STAGE(PG8_SA(0, 1), a2 + hstep, voffA);
            PG8_WAIT_L(8); PG8_BAR; PG8_WAIT_L(0); PG8_MMA(0, 0, At, B0); PG8_BAR; PG8_SCHED;
            PG8_LDB(B1, 1, 1); PG8_STAGE(PG8_SB(1, 0), b3, voffB);
            PG8_BAR; PG8_WAIT_L(0); PG8_MMA(0, 1, At, B1); PG8_BAR;
            PG8_LDA(At, 1, 1); PG8_STAGE(PG8_SA(1, 0), a3, voffA);
            PG8_BAR; PG8_WAIT_L(0); PG8_MMA(1, 0, At, B0); PG8_BAR; PG8_SCHED;
            PG8_STAGE(PG8_SB(1, 1), b3 + hstep, voffB);
            PG8_WAIT_V(6); PG8_BAR; PG8_MMA(1, 1, At, B1); PG8_BAR;
            }
        }
        if constexpr (FP8) asm volatile("s_nop 15\n\ts_nop 15" ::: "memory");
        if constexpr (ALIGN_EPI) { if (wr == 0) PG8_BAR; }
        if constexpr (!Epi::AFTER_DRAIN) { E(acc, cur, wr, wc, fr, fq); S.done(cur); }
        if (!has_next) break;
#pragma unroll
        for (int a = 0; a < 2; ++a)
#pragma unroll
            for (int b = 0; b < 2; ++b)
#pragma unroll
                for (int m = 0; m < 4; ++m)
#pragma unroll
                    for (int n = 0; n < 2; ++n) acc[a][b][m][n] = (f32x4){0.f, 0.f, 0.f, 0.f};
        cur = nxt; cA = nA; cB = nB; ++ui;
        if constexpr (ALIGN_EPI) { if (wr == 1) PG8_BAR; }
    }
    PG8_WAIT_V(0);
    if constexpr (!ALIGN_EPI) { if (wr == 0) PG8_BAR; }
    PG8_BAR;
    if constexpr (Epi::AFTER_DRAIN) { E.fused(acc, cur, wr, wc, fr, fq, lds, wid, lane); S.done(cur); }
#undef PG8_SA
#undef PG8_SB
#undef PG8_STAGE
#undef PG8_LDA
#undef PG8_LD16
#undef PG8_LDB
#undef PG8_MMA
#undef PG8_CAT
#undef PG8_WAIT_V
#undef PG8_WAIT_L
#undef PG8_BAR
#undef PG8_SCHED
}
}

template <class Epi, int QM = 0>
__device__ __forceinline__ void run_gemm(const Gemm g, const Epi& E, LAS float* lds, int vb, int nvb) {
    pg8::StaticOrder S; S.init(g.M, g.N, nvb, vb);
    pg8::gemm_phase<Epi, pg8::StaticOrder, true, true, QM>((LAS unsigned char*)lds, g, S, E);
}

enum { MAP_ID = 0, MAP_WIN = 1, MAP_GU = 2 };
struct PrepJob { const float* W; int K, N; const float* gain; bf16_t* dst; int r0, r1, ldd, koff, map; int fmt; float osc; };
__device__ __forceinline__ int map_src(int map, int r, int N) {
    if (map == MAP_ID) return r < N ? r : -1;
    if (map == MAP_WIN) {
        if (r < 1728) return r - 512;
        if (r < 3776) return r - 504;
        if (r < 3784) return r - 2560;
        return -1;
    }
    { const int tile = r >> 8, w = r & 255, j = tile * 128 + (w & 127); return w < 128 ? j : FF + j; }
}
__device__ __forceinline__ void prep_tile_load(const PrepJob& j, int t, f32x4 (&v)[8]) {
    const int nkt = j.K / 64, kt = t % nkt, rt = t / nkt, k0 = kt * 64, r0 = j.r0 + rt * 256;
#pragma unroll
    for (int q = 0; q < 8; ++q) {
        const int i = (int)threadIdx.x + q * NTHREADS, kk = i >> 6, r4 = (i & 63) * 4;
        const int sc = map_src(j.map, r0 + r4, j.N);
        v[q] = sc >= 0 ? __builtin_nontemporal_load((const f32x4*)(j.W + (size_t)(k0 + kk) * j.N + sc)) : (f32x4){0.f, 0.f, 0.f, 0.f};
        if (j.gain) v[q] = v[q] * j.gain[k0 + kk];
    }
}
__device__ __forceinline__ void prep_tile_store(const PrepJob& j, int t, const f32x4 (&v)[8], LAS float* tile  ) {
    const int nkt = j.K / 64, kt = t % nkt, rt = t / nkt, k0 = kt * 64, r0 = j.r0 + rt * 256;
    __syncthreads();
#pragma unroll
    for (int q = 0; q < 8; ++q) { const int i = (int)threadIdx.x + q * NTHREADS, kk = i >> 6, r4 = (i & 63) * 4; *(LAS f32x4*)(tile + kk * 260 + r4) = v[q]; }
    __syncthreads();
#pragma unroll
    for (int q = 0; q < 4; ++q) {
        const int i = (int)threadIdx.x + q * NTHREADS, rr = i & 255, c8 = i >> 8;
        const LAS float* tp = tile + (c8 * 8) * 260 + rr;
        if (j.fmt != 0) {
            const float sc = j.osc; u32x2 w;
            if (j.fmt == 1 || j.fmt == 3) { w.x = pk4_f8(tp[0] * sc, tp[260] * sc, tp[520] * sc, tp[780] * sc); w.y = pk4_f8(tp[1040] * sc, tp[1300] * sc, tp[1560] * sc, tp[1820] * sc); }
            else { w.x = pk4_i8(tp[0], tp[260], tp[520], tp[780], sc); w.y = pk4_i8(tp[1040], tp[1300], tp[1560], tp[1820], sc); }
            unsigned char* drow = (unsigned char*)j.dst + (size_t)(r0 + rr) * j.ldd + j.koff; const int kk = k0 + c8 * 8;
            if (j.fmt == 3) { const int r = kk & 127, pp = (kk & ~127) + (r >> 5) * 16 + ((r >> 3) & 3) * 4; *(unsigned*)(drow + pp) = w.x; *(unsigned*)(drow + pp + 64) = w.y; }
            else *(u32x2*)(drow + (j.fmt == 2 ? kperm8(kk) : kk)) = w;
        } else {
        u32x4 w; w.x = pk2(tp[0], tp[260]); w.y = pk2(tp[520], tp[780]); w.z = pk2(tp[1040], tp[1300]); w.w = pk2(tp[1560], tp[1820]);
        *(u32x4*)(j.dst + (size_t)(r0 + rr) * j.ldd + j.koff + k0 + c8 * 8) = w;
        }
    }
}
__device__ __forceinline__ void prep_fold_in(const float* w_in  , const float* w_uk  , const float* gain, bf16_t* dst, LAS float* lds, int vb, int nvb) {
    LAS float* A = lds; LAS float* B = lds + 32 * 65;
    const int tid = otid(), lane = tid & 63, wid = __builtin_amdgcn_readfirstlane(tid >> 6), l15 = lane & 15, dq = lane >> 4;
    for (int item = vb; item < 256; item += nvb) {
        const int h = item >> 5, k0 = (item & 31) * 32;
        __syncthreads();
        for (int i = tid; i < 2048; i += NTHREADS) { const int kk = i >> 6, d = i & 63; A[kk * 65 + d] = w_in[(size_t)(k0 + kk) * 3272 + h * 64 + d] * gain[k0 + kk]; }
        for (int i = tid; i < 8192; i += NTHREADS) { const int c = i >> 6, d = i & 63; B[c * 65 + d] = w_uk[(size_t)(h * 128 + c) * 64 + d]; }
        __syncthreads();
        f32x4 acc0 = (f32x4){0.f, 0.f, 0.f, 0.f}, acc1 = acc0;
#pragma unroll 4
        for (int d0 = 0; d0 < 64; d0 += 4) {
            const float b = B[(16 * wid + l15) * 65 + d0 + dq], a0 = A[l15 * 65 + d0 + dq], a1 = A[(16 + l15) * 65 + d0 + dq];
            acc0 = __builtin_amdgcn_mfma_f32_16x16x4f32(a0, b, acc0, 0, 0, 0);
            acc1 = __builtin_amdgcn_mfma_f32_16x16x4f32(a1, b, acc1, 0, 0, 0);
        }
        bf16_t* drow = dst + (size_t)(h * 128 + 16 * wid + l15) * 1024 + k0 + 4 * dq;
        { u32x2 w; w.x = pk2(acc0[0], acc0[1]); w.y = pk2(acc0[2], acc0[3]); *(u32x2*)drow = w; }
        { u32x2 w; w.x = pk2(acc1[0], acc1[1]); w.y = pk2(acc1[2], acc1[3]); *(u32x2*)(drow + 16) = w; }
    }
}
__device__ __forceinline__ void prep_fold_out(const float* w_out  , const float* w_uv  , bf16_t* dst  , LAS float* lds, int vb, int nvb) {
    LAS float* A = lds; LAS float* B = lds + 64 * 33;
    const int tid = otid(), lane = tid & 63, wid = __builtin_amdgcn_readfirstlane(tid >> 6), l15 = lane & 15, dq = lane >> 4;
    for (int item = vb; item < 256; item += nvb) {
        const int h = item >> 5, n0 = (item & 31) * 32;
        __syncthreads();
        for (int i = tid; i < 2048; i += NTHREADS) { const int d = i >> 5, nn = i & 31; A[d * 33 + nn] = w_out[(size_t)(h * 64 + d) * 1024 + n0 + nn]; }
        for (int i = tid; i < 8192; i += NTHREADS) { const int c = i >> 6, d = i & 63; B[c * 65 + d] = w_uv[(size_t)(h * 128 + c) * 64 + d]; }
        __syncthreads();
        f32x4 acc0 = (f32x4){0.f, 0.f, 0.f, 0.f}, acc1 = acc0;
#pragma unroll 4
        for (int d0 = 0; d0 < 64; d0 += 4) {
            const float a = B[(16 * wid + l15) * 65 + d0 + dq], b0 = A[(d0 + dq) * 33 + l15], b1 = A[(d0 + dq) * 33 + 16 + l15];
            acc0 = __builtin_amdgcn_mfma_f32_16x16x4f32(a, b0, acc0, 0, 0, 0);
            acc1 = __builtin_amdgcn_mfma_f32_16x16x4f32(a, b1, acc1, 0, 0, 0);
        }
        { u32x2 w; w.x = pk2(acc0[0], acc0[1]); w.y = pk2(acc0[2], acc0[3]); *(u32x2*)(dst + (size_t)(n0 + l15) * KOUT + h * 128 + 16 * wid + 4 * dq) = w; }
        { u32x2 w; w.x = pk2(acc1[0], acc1[1]); w.y = pk2(acc1[2], acc1[3]); *(u32x2*)(dst + (size_t)(n0 + 16 + l15) * KOUT + h * 128 + 16 * wid + 4 * dq) = w; }
    }
}
__device__ __forceinline__ void prep_lb(const float* hgrn_lb  , float* lb, int vb, int nvb) {
    for (int i = vb * NTHREADS + threadIdx.x; i < 512; i += nvb * NTHREADS) {
        const float a = hgrn_lb[i], b = hgrn_lb[512 + i], c = hgrn_lb[1024 + i], m = fmaxf(a, fmaxf(b, c));
        const float ea = __expf(a - m), eb = __expf(b - m), ec = __expf(c - m);
        lb[i] = ea / (ea + eb + ec);
    }
}

__device__ __forceinline__ void rmsnorm_rows(const float* X, bf16_t* Y, int nrows, int vb, int nvb) {
    const int tid = otid(), lane = tid & 63, gw = vb * NWAVES + __builtin_amdgcn_readfirstlane(tid >> 6), ngw = nvb * NWAVES;
    for (int r = gw; r < nrows; r += ngw) {
        const f32x4* xr = (const f32x4*)(X + (size_t)r * D) + lane;
        f32x4 v[4]; float s = 0.f;
#pragma unroll
        for (int j = 0; j < 4; ++j) { v[j] = xr[64 * j]; s += (v[j].x * v[j].x + v[j].y * v[j].y) + (v[j].z * v[j].z + v[j].w * v[j].w); }
        const float rs = rsqrtf(wave_sum(s) * (1.f / D) + EPS);
        u32x2* o = (u32x2*)(Y + (size_t)r * D) + lane;
#pragma unroll
        for (int j = 0; j < 4; ++j) { u32x2 w; w.x = pk2(v[j].x * rs, v[j].y * rs); w.y = pk2(v[j].z * rs, v[j].w * rs); o[64 * j] = w; }
    }
}
__device__ __forceinline__ void x_to_h_rows(const float* X, bf16_t* H, float* ssq, int vb, int nvb) {
    const int tid = otid(), lane = tid & 63, gw = vb * NWAVES + __builtin_amdgcn_readfirstlane(tid >> 6), ngw = nvb * NWAVES;
    for (int r = gw; r < T; r += 2 * ngw) {
        const int r2 = (r + ngw < T) ? r + ngw : r;
        f32x4 v[2][4];
#pragma unroll
        for (int j = 0; j < 4; ++j) { v[0][j] = __builtin_nontemporal_load((const f32x4*)(X + (size_t)r * D) + lane + 64 * j); v[1][j] = __builtin_nontemporal_load((const f32x4*)(X + (size_t)r2 * D) + lane + 64 * j); }
#pragma unroll
        for (int q = 0; q < 2; ++q) {
            const int rr = q ? r2 : r;
            u32x2* o = (u32x2*)(H + (size_t)rr * D) + lane;
            float s = 0.f;
#pragma unroll
            for (int j = 0; j < 4; ++j) { const f32x4 x = v[q][j]; u32x2 w; w.x = pk2(x.x, x.y); w.y = pk2(x.z, x.w); o[64 * j] = w;
                const float a = bf2f((unsigned short)(w.x & 0xffffu)), b = bf2f((unsigned short)(w.x >> 16)), c = bf2f((unsigned short)(w.y & 0xffffu)), d = bf2f((unsigned short)(w.y >> 16));
                s += (a * a + b * b) + (c * c + d * d); }
            s = wave_sum(s);
            if (lane < 16) ssq[(size_t)rr * 16 + lane] = lane == 0 ? s : 0.f;
        }
    }
}
__device__ __forceinline__ void final_rows(const bf16_t* H, const float* ssq, const float* g, float* out, int vb, int nvb) {
    const int tid = otid(), lane = tid & 63, gw = vb * NWAVES + __builtin_amdgcn_readfirstlane(tid >> 6), ngw = nvb * NWAVES;
    f32x4 gg[4];
#pragma unroll
    for (int j = 0; j < 4; ++j) gg[j] = *((const f32x4*)g + lane + 64 * j);
    for (int r = gw; r < T; r += 2 * ngw) {
        const int r2 = (r + ngw < T) ? r + ngw : r;
        u32x2 w[2][4]; float rs[2];
#pragma unroll
        for (int j = 0; j < 4; ++j) { w[0][j] = ((const u32x2*)(H + (size_t)r * D) + lane)[64 * j]; w[1][j] = ((const u32x2*)(H + (size_t)r2 * D) + lane)[64 * j]; }
        rs[0] = row_rstd(ssq, (size_t)r); rs[1] = row_rstd(ssq, (size_t)r2);
#pragma unroll
        for (int q = 0; q < 2; ++q) {
            f32x4* o = (f32x4*)(out + (size_t)(q ? r2 : r) * D) + lane;
#pragma unroll
            for (int j = 0; j < 4; ++j) { const u32x2 ww = w[q][j];
                __builtin_nontemporal_store((f32x4){bf2f((unsigned short)(ww.x & 0xffffu)) * rs[q] * gg[j].x, bf2f((unsigned short)(ww.x >> 16)) * rs[q] * gg[j].y, bf2f((unsigned short)(ww.y & 0xffffu)) * rs[q] * gg[j].z, bf2f((unsigned short)(ww.y >> 16)) * rs[q] * gg[j].w}, o + 64 * j); }
        }
    }
}
__device__ __forceinline__ float row16_sum(float v) {
    v += __uint_as_float((unsigned)__builtin_amdgcn_update_dpp(0, (int)__float_as_uint(v), 0x128, 0xf, 0xf, false));
    v += __uint_as_float((unsigned)__builtin_amdgcn_update_dpp(0, (int)__float_as_uint(v), 0x124, 0xf, 0xf, false));
    v += __uint_as_float((unsigned)__builtin_amdgcn_update_dpp(0, (int)__float_as_uint(v), 0x122, 0xf, 0xf, false));
    v += __uint_as_float((unsigned)__builtin_amdgcn_update_dpp(0, (int)__float_as_uint(v), 0x121, 0xf, 0xf, false));
    return v;
}
__device__ __forceinline__ void cnorm_rows(const bf16_t* P, const float* lat_g, bf16_t* CN, int vb, int nvb) {
    const int tid = otid(), lane = tid & 63, gw = vb * NWAVES + __builtin_amdgcn_readfirstlane(tid >> 6), ngw = nvb * NWAVES, r4 = lane >> 4, l16 = lane & 15;
    const f32x4 ga = *(const f32x4*)(lat_g + l16 * 8), gb = *(const f32x4*)(lat_g + l16 * 8 + 4);
    for (int r = gw * 8; r < T; r += ngw * 8) {
        u32x4 w[2];
#pragma unroll
        for (int q = 0; q < 2; ++q) w[q] = *(const u32x4*)(P + (size_t)(r + 4 * q + r4) * PW + P_C + l16 * 8);
#pragma unroll
        for (int q = 0; q < 2; ++q) {
            const float x0 = bf2f((unsigned short)(w[q].x & 0xffffu)), x1 = bf2f((unsigned short)(w[q].x >> 16)), x2 = bf2f((unsigned short)(w[q].y & 0xffffu)), x3 = bf2f((unsigned short)(w[q].y >> 16));
            const float x4 = bf2f((unsigned short)(w[q].z & 0xffffu)), x5 = bf2f((unsigned short)(w[q].z >> 16)), x6 = bf2f((unsigned short)(w[q].w & 0xffffu)), x7 = bf2f((unsigned short)(w[q].w >> 16));
            const float ss = row16_sum(((x0 * x0 + x1 * x1) + (x2 * x2 + x3 * x3)) + ((x4 * x4 + x5 * x5) + (x6 * x6 + x7 * x7)));
            const float rs = rsqrtf(ss * (1.f / 128.f) + EPS);
            u32x4 o; o.x = pk2(x0 * rs * ga.x, x1 * rs * ga.y); o.y = pk2(x2 * rs * ga.z, x3 * rs * ga.w); o.z = pk2(x4 * rs * gb.x, x5 * rs * gb.y); o.w = pk2(x6 * rs * gb.z, x7 * rs * gb.w);
            *(u32x4*)(CN + (size_t)(r + 4 * q + r4) * 128 + l16 * 8) = o;
        }
    }
}
__device__ __forceinline__ int t5_bucket(int rel) {
    const int n = rel < 0 ? -rel : rel;
    int b = n < 8 ? n : 8 + (n >= 12) + (n >= 16) + (n >= 23) + (n >= 32) + (n >= 46) + (n >= 64) + (n >= 91);
    return b + (rel > 0 ? 16 : 0);
}
__device__ __forceinline__ unsigned sort_key(float x) { const unsigned u = __float_as_uint(x); return (u & 0x80000000u) ? ~u : (u | 0x80000000u); }


template <int CTRL, int ROWMASK> __device__ __forceinline__ unsigned dpp0(unsigned v) { return (unsigned)__builtin_amdgcn_update_dpp(0, (int)v, CTRL, ROWMASK, 0xf, false); }
__device__ __forceinline__ unsigned wave_prefix_incl(unsigned v) {
    v += dpp0<0x111, 0xf>(v); v += dpp0<0x112, 0xf>(v); v += dpp0<0x114, 0xf>(v); v += dpp0<0x118, 0xf>(v);
    v += dpp0<0x142, 0xa>(v);
    v += dpp0<0x143, 0xc>(v);
    return v;
}
__device__ __forceinline__ float wave_max_u(float v) {
    v = fmaxf(v, __uint_as_float((unsigned)__builtin_amdgcn_update_dpp(0, (int)__float_as_uint(v), 0x128, 0xf, 0xf, false)));
    v = fmaxf(v, __uint_as_float((unsigned)__builtin_amdgcn_update_dpp(0, (int)__float_as_uint(v), 0x124, 0xf, 0xf, false)));
    v = fmaxf(v, __uint_as_float((unsigned)__builtin_amdgcn_update_dpp(0, (int)__float_as_uint(v), 0x122, 0xf, 0xf, false)));
    v = fmaxf(v, __uint_as_float((unsigned)__builtin_amdgcn_update_dpp(0, (int)__float_as_uint(v), 0x121, 0xf, 0xf, false)));
    const int b = (int)__float_as_uint(v);
    return fmaxf(fmaxf(__uint_as_float((unsigned)__builtin_amdgcn_readlane(b, 0)), __uint_as_float((unsigned)__builtin_amdgcn_readlane(b, 16))),
                 fmaxf(__uint_as_float((unsigned)__builtin_amdgcn_readlane(b, 32)), __uint_as_float((unsigned)__builtin_amdgcn_readlane(b, 48))));
}

typedef short v4i16_t __attribute__((ext_vector_type(4)));
constexpr int DSA_BT_OFF = 131072 + 256, DSA_WS_OFF = DSA_BT_OFF + 6144;
__device__ __forceinline__ unsigned dsa_bucket(float x, float lo, float sc) { const float f = (x - lo) * sc; const unsigned b = (unsigned)f; return b > 255u ? 255u : b; }
__device__ __forceinline__ unsigned off_b(unsigned row, unsigned ch) { return 256u * row + 16u * (ch ^ (((row & 3) << 2) | ((row >> 2) & 3))); }
__device__ __forceinline__ void dsa_mfma_phase(const bf16_t* P, const bf16_t* CN, const float* rel_bias, bf16_t* CAT, LAS unsigned char* lds, unsigned* qctr) {
    const int tid = otid(), lane = tid & 63, wid = __builtin_amdgcn_readfirstlane(tid >> 6);
    LAS float* BT = (LAS float*)(lds + DSA_BT_OFF);
    __syncthreads();
    for (int i = tid; i < 191 * 8; i += NTHREADS) { const int rel = (i >> 3) - 127; BT[i] = rel_bias[t5_bucket(rel) * 8 + (i & 7)]; }
    const unsigned long long lt_mask = (lane == 0) ? 0ull : (~0ull >> (64 - lane));
    volatile LAS int* qslot = (volatile LAS int*)(lds + 131072 + 64);
    int nxt = 0;
    if (tid == 0) { *qslot = (int)atomicAdd(qctr, 1u); nxt = (int)atomicAdd(qctr, 1u); }
    for (;;) {
        __syncthreads();
        const int u = *qslot;
        if (u >= T / 16) break;
        const int b = u & 15, qg = 127 - (u >> 4), t0 = qg * 16, nj = t0 / CHUNK + 1, L = nj * CHUNK, nt = L / 32;
        const bf16_t* Pb = P + (size_t)b * SEQ * PW;
        {
            int ln1 = lane; asm volatile("" : "+v"(ln1));
            const int rho = ln1 & 31, hf = ln1 >> 5;
            const int qq = 2 * ((rho >> 2) & 1) + (rho >> 4), hh = 4 * ((rho >> 3) & 1) + (rho & 3);
            bf16x8 qa[4][4], wa[4], wc[4];
#pragma unroll
            for (int qd = 0; qd < 4; ++qd) {
                const bf16_t* qrow = Pb + (size_t)(t0 + 4 * qd + qq) * PW + P_QI + hh * 64 + 8 * hf;
#pragma unroll
                for (int ks = 0; ks < 4; ++ks) qa[qd][ks] = *(const bf16x8*)(qrow + ks * 16);
                wa[qd] = *(const bf16x8*)(Pb + (size_t)(t0 + 4 * qd + 2 * hf) * PW + P_WI); wc[qd] = *(const bf16x8*)(Pb + (size_t)(t0 + 4 * qd + 2 * hf + 1) * PW + P_WI);
            }
            LAS float* sc0 = (LAS float*)lds + (2 * hf) * 2048 + rho;
            const bf16_t* kbase = Pb + (size_t)rho * PW + P_KI + 8 * hf;
            bf16x8 kb[4], kn[4];
#pragma unroll
            for (int ks = 0; ks < 4; ++ks) { kb[ks] = (bf16x8){0, 0, 0, 0, 0, 0, 0, 0}; kn[ks] = kb[ks]; }
            if (wid < nt) {
#pragma unroll
                for (int ks = 0; ks < 4; ++ks) kb[ks] = *(const bf16x8*)(kbase + (size_t)wid * 32 * PW + ks * 16);
            }
            for (int kt = wid; kt < nt; kt += 8) {
                if (kt + 8 < nt) {
#pragma unroll
                    for (int ks = 0; ks < 4; ++ks) kn[ks] = *(const bf16x8*)(kbase + (size_t)(kt + 8) * 32 * PW + ks * 16);
                }
#pragma unroll
                for (int qd = 0; qd < 4; ++qd) {
                    f32x16 acc;
#pragma unroll
                    for (int r = 0; r < 16; ++r) acc[r] = 0.f;
#pragma unroll
                    for (int ks = 0; ks < 4; ++ks) acc = __builtin_amdgcn_mfma_f32_32x32x16_bf16(qa[qd][ks], kb[ks], acc, 0, 0, 0);
                    float s0 = 0.f, s1 = 0.f;
#pragma unroll
                    for (int e = 0; e < 8; ++e) { s0 += bf2f((unsigned short)wa[qd][e]) * fmaxf(acc[e], 0.f); s1 += bf2f((unsigned short)wc[qd][e]) * fmaxf(acc[8 + e], 0.f); }
                    sc0[(4 * qd) * 2048 + kt * 32] = s0 * (0.35355339059327373f * 0.125f); sc0[(4 * qd + 1) * 2048 + kt * 32] = s1 * (0.35355339059327373f * 0.125f);
                }
#pragma unroll
                for (int ks = 0; ks < 4; ++ks) kb[ks] = kn[ks];
            }
        }
        __syncthreads();
        if (tid == 0) { *qslot = nxt; nxt = (int)atomicAdd(qctr, 1u); }
        LAS unsigned char* pair = lds + wid * 16384;
        LAS unsigned char* wsc = lds + DSA_WS_OFF + wid * 2560;
        LAS unsigned* HIST = (LAS unsigned*)wsc; LAS float* CANDV = (LAS float*)(wsc + 1024); LAS unsigned* CANDI = (LAS unsigned*)(wsc + 1280);
        const int nsel = L < 256 ? L : 256;
        int lna = lane; asm volatile("" : "+v"(lna));
#pragma unroll 1
        for (int e2 = 0; e2 < 2; ++e2) {
            LAS unsigned short* IDX = (LAS unsigned short*)(wsc + 1536 + e2 * 512);
            if (nj > 4) {
                const LAS float* SCq = (const LAS float*)(pair + e2 * 8192);
                float x[32];
#pragma unroll
                for (int j = 0; j < 32; ++j) x[j] = (j < nj) ? SCq[j * 64 + lna] : 0.f;
                float lo = INFINITY, hi = -INFINITY;
#pragma unroll
                for (int j = 0; j < 32; ++j) if (j < nj) { hi = fmaxf(hi, x[j]); lo = fminf(lo, x[j]); }
                hi = wave_max_u(hi); lo = -wave_max_u(-lo);
                bool done = false;
                if (hi > lo) {
                    const float sc = 256.f / (hi - lo);
                    *(LAS u32x4*)(HIST + 4 * lna) = (u32x4){0u, 0u, 0u, 0u};
                    WAVE_LDS_SYNC();
#pragma unroll
                    for (int j = 0; j < 32; ++j) if (j < nj) { const unsigned bk = dsa_bucket(x[j], lo, sc); __hip_atomic_fetch_add(HIST + bk, 1u, __ATOMIC_RELAXED, __HIP_MEMORY_SCOPE_WORKGROUP); }
                    WAVE_LDS_SYNC();
                    const u32x4 h4 = *(const LAS u32x4*)(HIST + 4 * lna);
                    const unsigned cl = (h4.x + h4.y) + (h4.z + h4.w);
                    const unsigned pfx = wave_prefix_incl(cl);
                    const unsigned Sx = (unsigned)__builtin_amdgcn_readlane((int)pfx, 63) - pfx + cl;
                    const int lstar = __popcll(__ballot(Sx >= 256u)) - 1;
                    const unsigned above = Sx - cl, t3 = above + h4.w, t2 = t3 + h4.z, t1 = t2 + h4.y;
                    const unsigned bl = t3 >= 256u ? 3u : (t2 >= 256u ? 2u : (t1 >= 256u ? 1u : 0u));
                    const unsigned al = bl == 3u ? above : (bl == 2u ? t3 : (bl == 1u ? t2 : t1));
                    const unsigned ml = bl == 3u ? h4.w : (bl == 2u ? h4.z : (bl == 1u ? h4.y : h4.x));
                    const unsigned bstar = (unsigned)__builtin_amdgcn_readlane((int)(4u * lna + bl), lstar);
                    const int a = __builtin_amdgcn_readlane((int)al, lstar), m = __builtin_amdgcn_readlane((int)ml, lstar);
                    if (m <= 64) {
                        done = true;
                        const int need = 256 - a;
                        unsigned msel = 0u, mcand = 0u;
#pragma unroll
                        for (int j = 31; j >= 0; --j) if (j < nj) { const unsigned bk = dsa_bucket(x[j], lo, sc); msel = msel + msel + (bk > bstar ? 1u : 0u); mcand = mcand + mcand + (bk == bstar ? 1u : 0u); }
                        const unsigned pk = (unsigned)__popc(msel) | ((unsigned)__popc(mcand) << 16);
                        const unsigned inc = wave_prefix_incl(pk);
                        unsigned off = (inc - pk) & 0xffffu, coff = (inc - pk) >> 16;
                        while (msel) { const int j = __ffs((int)msel) - 1; msel &= msel - 1u; IDX[off++] = (unsigned short)(j * 64 + lna); }
                        while (mcand) { const int j = __ffs((int)mcand) - 1; mcand &= mcand - 1u; CANDV[coff] = SCq[j * 64 + lna]; CANDI[coff] = (unsigned)(j * 64 + lna); ++coff; }
                        WAVE_LDS_SYNC();
                        const float cv = CANDV[lna < m ? lna : 0]; const unsigned ci = CANDI[lna < m ? lna : 0];
                        int rank = 0;
                        for (int k = 0; k < m; ++k) { const float v = __uint_as_float((unsigned)__builtin_amdgcn_readlane((int)__float_as_uint(cv), k)); const unsigned id = (unsigned)__builtin_amdgcn_readlane((int)ci, k); rank += (v > cv || (v == cv && id < ci)) ? 1 : 0; }
                        if (lna < m && rank < need) IDX[a + rank] = (unsigned short)ci;
                    }
                }
                if (!done) {
                    unsigned lo_k = 0xffffffffu, hi_k = 0u;
#pragma unroll
                    for (int j = 0; j < 32; ++j) if (j < nj) { const unsigned kx = sort_key(x[j]); hi_k = kx > hi_k ? kx : hi_k; lo_k = kx < lo_k ? kx : lo_k; }
#pragma unroll
                    for (int o = 1; o < 64; o <<= 1) { const unsigned h2 = (unsigned)__shfl_xor((int)hi_k, o), l2 = (unsigned)__shfl_xor((int)lo_k, o); hi_k = h2 > hi_k ? h2 : hi_k; lo_k = l2 < lo_k ? l2 : lo_k; }
                    lo_k = (unsigned)__builtin_amdgcn_readfirstlane((int)lo_k); hi_k = (unsigned)__builtin_amdgcn_readfirstlane((int)hi_k);
                    bool exact = false;
                    while (lo_k < hi_k) {
                        const unsigned mid = lo_k + ((hi_k - lo_k + 1u) >> 1);
                        int cnt = 0;
#pragma unroll
                        for (int j = 0; j < 32; ++j) cnt += __popcll(__ballot(j < nj && sort_key(x[j]) >= mid));
                        if (cnt == 256) { lo_k = mid; exact = true; break; }
                        if (cnt > 256) lo_k = mid; else hi_k = mid - 1u;
                    }
                    const unsigned Tv = lo_k;
                    int need = 0;
                    if (!exact) { int cgt = 0;
#pragma unroll
                        for (int j = 0; j < 32; ++j) cgt += __popcll(__ballot(j < nj && sort_key(x[j]) > Tv));
                        need = 256 - cgt; }
                    int base = 0, eqt = 0;
#pragma unroll
                    for (int j = 0; j < 32; ++j) {
                        const unsigned kx = sort_key(x[j]);
                        const bool gt = (j < nj) && (exact ? (kx >= Tv) : (kx > Tv)), eq = (j < nj) && !exact && (kx == Tv);
                        const unsigned long long meq = __ballot(eq);
                        const bool sel = gt || (eq && (eqt + __popcll(meq & lt_mask)) < need);
                        const unsigned long long ms = __ballot(sel);
                        if (sel) IDX[base + __popcll(ms & lt_mask)] = (unsigned short)(j * 64 + lna);
                        base += __popcll(ms); eqt += __popcll(meq);
                    }
                }
            } else {
#pragma unroll
                for (int i = 0; i < 4; ++i) IDX[i * 64 + lna] = (unsigned short)(i * 64 + lna);
            }
        }
        WAVE_LDS_SYNC();
        {
            int lnb = lane; asm volatile("" : "+v"(lnb));
            const int head = lnb & 15, kg = lnb >> 4, nblk = nsel >> 5;
            LAS unsigned char* GB = pair;
            const bf16_t* CNb = CN + (size_t)b * SEQ * 128;
            const int rho = lnb & 15;
            const unsigned rw0 = 8 * (rho >> 2) + (rho & 3), rw1 = rw0 + 4;
            const unsigned xa0 = ((rw0 & 3) << 2) | ((rw0 >> 2) & 3), xa1 = ((rw1 & 3) << 2) | ((rw1 >> 2) & 3);
            const unsigned q4 = (lnb & 15) >> 2, p4 = lnb & 3;
            u32x4 gA[8], gB[8];
#define DSA_GATHER(G, IX, blk) do { _Pragma("unroll") for (int it = 0; it < 8; ++it) { const int sp = (IX)[(blk) * 32 + (lnb >> 4) + 4 * it]; G[it] = *(const u32x4*)(CNb + (size_t)sp * 128 + (lnb & 15) * 8); } } while (0)
            { const LAS unsigned short* IDX0 = (const LAS unsigned short*)(wsc + 1536); DSA_GATHER(gA, IDX0, 0); DSA_GATHER(gB, IDX0, 1); }
#pragma unroll 1
            for (int e2 = 0; e2 < 2; ++e2) {
                const int t = t0 + 2 * wid + e2;
                const size_t row = (size_t)b * SEQ + t;
                const LAS unsigned short* IDX = (const LAS unsigned short*)(wsc + 1536 + e2 * 512);
                bf16x8 qlf[4];
#pragma unroll
                for (int s4 = 0; s4 < 4; ++s4) { qlf[s4] = *(const bf16x8*)(P + row * PW + P_QL + (head & 7) * 128 + s4 * 32 + 8 * kg); if (head >= 8) qlf[s4] = (bf16x8){0, 0, 0, 0, 0, 0, 0, 0}; }
                f32x4 o[8];
#pragma unroll
                for (int ct = 0; ct < 8; ++ct) o[ct] = (f32x4){0.f, 0.f, 0.f, 0.f};
                float m = -INFINITY, lsum = 0.f;
#define DSA_STEP(G, kbx) do { \
                    WAVE_LDS_SYNC();                              \
                    _Pragma("unroll") for (int it = 0; it < 8; ++it) *(LAS u32x4*)(GB + off_b((lnb >> 4) + 4 * it, lnb & 15)) = G[it]; \
                    const bf16x8 iv = *(const LAS bf16x8*)((const LAS unsigned char*)IDX + ((kbx) * 32 + 8 * kg) * 2);     \
                    if ((kbx) + 2 < nblk) DSA_GATHER(G, IDX, (kbx) + 2); else if (e2 == 0) DSA_GATHER(G, IDX + 256, (kbx) + 2 - nblk); \
                    WAVE_LDS_SYNC(); \
                      \
                    bf16x8 k0[4], k1[4], af[8]; \
                    _Pragma("unroll") for (int s4 = 0; s4 < 4; ++s4) { \
                        k0[s4] = *(const LAS bf16x8*)(GB + 256u * rw0 + 16u * ((4 * s4 + kg) ^ xa0)); \
                        k1[s4] = *(const LAS bf16x8*)(GB + 256u * rw1 + 16u * ((4 * s4 + kg) ^ xa1)); } \
                    float bia[8]; \
                    _Pragma("unroll") for (int e = 0; e < 8; ++e) { const int sp = (int)(unsigned short)iv[e]; int rel = sp - t; rel = rel < -127 ? -127 : rel; bia[e] = BT[(rel + 127) * 8 + (head & 7)]; } \
                      \
                    f32x4 a0 = (f32x4){0.f, 0.f, 0.f, 0.f}, a1 = (f32x4){0.f, 0.f, 0.f, 0.f}; \
                    _Pragma("unroll") for (int s4 = 0; s4 < 4; ++s4) { \
                        a0 = __builtin_amdgcn_mfma_f32_16x16x32_bf16(k0[s4], qlf[s4], a0, 0, 0, 0); \
                        a1 = __builtin_amdgcn_mfma_f32_16x16x32_bf16(k1[s4], qlf[s4], a1, 0, 0, 0); } \
                    asm volatile("" : "+v"(a0), "+v"(a1));        \
                    _Pragma("unroll") for (int ct = 0; ct < 8; ++ct) {              \
                        const v4i16_t lo4 = __builtin_amdgcn_ds_read_tr16_b64_v4i16((LAS v4i16_t*)(GB + off_b(8 * kg + q4, 2 * ct + (p4 >> 1)) + 8 * (p4 & 1))); \
                        const v4i16_t hi4 = __builtin_amdgcn_ds_read_tr16_b64_v4i16((LAS v4i16_t*)(GB + off_b(8 * kg + 4 + q4, 2 * ct + (p4 >> 1)) + 8 * (p4 & 1))); \
                        af[ct] = (bf16x8){lo4[0], lo4[1], lo4[2], lo4[3], hi4[0], hi4[1], hi4[2], hi4[3]}; } \
                      \
                    float lg[8]; \
                    _Pragma("unroll") for (int e = 0; e < 8; ++e) lg[e] = (e < 4 ? a0[e] : a1[e - 4]) * 0.125f + bia[e]; \
                    const float mloc = fmaxf(fmaxf(fmaxf(lg[0], lg[1]), fmaxf(lg[2], lg[3])), fmaxf(fmaxf(lg[4], lg[5]), fmaxf(lg[6], lg[7]))); \
                      \
                    float scl = 1.f; \
                    if (__any(mloc > m + 16.f)) { \
                        float mb = fmaxf(mloc, __shfl_xor(mloc, 16)); mb = fmaxf(mb, __shfl_xor(mb, 32)); \
                        const float mn = fmaxf(m, mb); scl = __expf(m - mn); m = mn; \
                        _Pragma("unroll") for (int ct = 0; ct < 8; ++ct) o[ct] = o[ct] * scl; } \
                    float ps = 0.f; float pe[8]; \
                    _Pragma("unroll") for (int e = 0; e < 8; ++e) { pe[e] = __expf(lg[e] - m); ps += pe[e]; } \
                    lsum = lsum * scl + ps; \
                    u32x4 pw; pw.x = pk2(pe[0], pe[1]); pw.y = pk2(pe[2], pe[3]); pw.z = pk2(pe[4], pe[5]); pw.w = pk2(pe[6], pe[7]); \
                    const bf16x8 pb = __builtin_bit_cast(bf16x8, pw); \
                    _Pragma("unroll") for (int ct = 0; ct < 8; ++ct) o[ct] = __builtin_amdgcn_mfma_f32_16x16x32_bf16(af[ct], pb, o[ct], 0, 0, 0); \
                } while (0)
#pragma unroll 1
                for (int kb2 = 0; kb2 < nblk; kb2 += 2) { DSA_STEP(gA, kb2); DSA_STEP(gB, kb2 + 1); }
#undef DSA_STEP
                lsum += __shfl_xor(lsum, 16); lsum += __shfl_xor(lsum, 32);
                const float inv = 1.f / lsum;
                if (head < 8) {
                    bf16_t* op = CAT + row * KOUT + head * 128 + 4 * kg;
#pragma unroll
                    for (int ct = 0; ct < 8; ++ct) { u32x2 w; w.x = pk2(o[ct][0] * inv, o[ct][1] * inv); w.y = pk2(o[ct][2] * inv, o[ct][3] * inv); *(u32x2*)(op + ct * 16) = w; }
                }
            }
#undef DSA_GATHER
        }
    }
}

constexpr size_t WS_DEC = 492 * MiB;
__device__ __forceinline__ void hgrn_prep(bf16_t* P, const float* lb, float* DEC, LAS unsigned char* lds, int vb, int nvb) {
    const int tid = otid(), cl = tid >> 7, d = tid & 127;
    LAS bf16_t* Ft = (LAS bf16_t*)lds; LAS bf16_t* Qt = (LAS bf16_t*)(lds + 65536);
    for (int it = vb; it < BATCH * 4 * 8; it += nvb) {
        const int b = it >> 5, h = (it >> 3) & 3, cg = it & 7;
        bf16_t* base = P + ((size_t)b * SEQ + cg * 256) * PW + h * 128;
        u32x4 v[16];
#pragma unroll
        for (int k = 0; k < 16; ++k) { const int i = tid + 512 * k, tl = i >> 12, r = (i >> 4) & 255, ch = i & 15; v[k] = *(const u32x4*)(base + (size_t)r * PW + (tl ? P_QB : P_FB) + ch * 8); }
        __syncthreads();
#pragma unroll
        for (int k = 0; k < 16; ++k) { const int i = tid + 512 * k, tl = i >> 12, r = (i >> 4) & 255, ch = i & 15; *(LAS u32x4*)(lds + tl * 65536 + r * 256 + ch * 16) = v[k]; }
        __syncthreads();
        {
            const float l = lb[h * 128 + d];
            LAS bf16_t* fcol = Ft + (cl * 64) * 128 + d; LAS bf16_t* qcol = Qt + (cl * 64) * 128 + d;
            float ref = 0.f;
#pragma unroll 8
            for (int t = 0; t < 32; ++t) ref += __logf(l + (1.f - l) * sigmoid_f(bf2f(fcol[t * 128])));
            float bi = 0.f;
#pragma unroll 8
            for (int t = 0; t < 64; ++t) {
                const float f = l + (1.f - l) * sigmoid_f(bf2f(fcol[t * 128]));
                bi += __logf(f);
                const float q = silu_f(bf2f(qcol[t * 128]));
                qcol[t * 128] = (bf16_t)f2bf(q * __expf(bi - ref));
                fcol[t * 128] = (bf16_t)f2bf((1.f - f) * __expf(ref - bi));
            }
            float* dc = DEC + ((size_t)((b * 4 + h) * 32 + cg * 4 + cl) * 3) * 128 + d;
            dc[0] = __expf(ref); dc[128] = __expf(bi); dc[256] = __expf(bi - ref);
        }
        __syncthreads();
#pragma unroll
        for (int k = 0; k < 16; ++k) { const int i = tid + 512 * k, tl = i >> 12, r = (i >> 4) & 255, ch = i & 15; *(u32x4*)(base + (size_t)r * PW + (tl ? P_QB : P_FB) + ch * 8) = *(const LAS u32x4*)(lds + tl * 65536 + r * 256 + ch * 16); }
    }
}

__device__ __forceinline__ void hgrn_scan(const bf16_t* P, const float* DEC, const float* o_g, bf16_t* CAT, LAS unsigned char* lds, int item) {
    const int tid = otid(), lane = tid & 63, wid = __builtin_amdgcn_readfirstlane(tid >> 6), li = lane & 15, kg = lane >> 4;
    const int b = item >> 2, h = item & 3, it = wid >> 1, vh = wid & 1;
    LAS unsigned char* ST = lds + 98304;
    LAS float* SSQ = (LAS float*)(lds + DSA_BT_OFF);
    const bf16_t* Pb = P + (size_t)b * SEQ * PW;
    const float* DECb = DEC + (size_t)((b * 4 + h) * 32) * 384;
    f32x4 S[8];
#pragma unroll
    for (int vt = 0; vt < 8; ++vt) S[vt] = (f32x4){0.f, 0.f, 0.f, 0.f};
    u32x4 sg[6];
    const int colbase[3] = {P_QB, P_FB, P_IB};
#define HG_LOAD(c) do { _Pragma("unroll") for (int k = 0; k < 6; ++k) { const int n = tid + 512 * k, tl = n >> 10, r = (n >> 4) & 63, ch = n & 15; \
        sg[k] = *(const u32x4*)(Pb + (size_t)((c) * 64 + r) * PW + colbase[tl] + h * 128 + ch * 8); } } while (0)
#define HG_STORE(buf) do { _Pragma("unroll") for (int k = 0; k < 6; ++k) { const int n = tid + 512 * k, tl = n >> 10, r = (n >> 4) & 63, ch = n & 15; \
        *(LAS u32x4*)(lds + (buf) * 49152 + tl * 16384 + off_b(r, ch)) = sg[k]; } } while (0)
    HG_LOAD(0);
    __syncthreads();
    HG_STORE(0);
    const unsigned q4 = (lane & 15) >> 2, p4 = lane & 3;
    f32x4 ogv[4];
#pragma unroll
    for (int vv = 0; vv < 4; ++vv) ogv[vv] = *(const f32x4*)(o_g + 16 * (4 * vh + vv) + 4 * kg);
    float er_next = DECb[16 * wid + li];
#pragma unroll 1
    for (int c = 0; c < 32; ++c) {
        const int buf = c & 1;
        LAS unsigned char* QI = lds + buf * 49152; LAS unsigned char* KI = QI + 16384; LAS unsigned char* VI = QI + 32768;
        if (c + 1 < 32) HG_LOAD(c + 1);
        const float er = er_next, e63 = DECb[c * 384 + 128 + 16 * wid + li], e6r = DECb[c * 384 + 256 + 16 * wid + li];
        er_next = DECb[(c + 1 < 32 ? c + 1 : c) * 384 + 16 * wid + li];
        u32x2 gwv[4];
#pragma unroll
        for (int vv = 0; vv < 4; ++vv) gwv[vv] = *(const u32x2*)(P + ((size_t)b * SEQ + c * 64 + 16 * it + li) * PW + P_GB + h * 128 + 16 * (4 * vh + vv) + 4 * kg);
        { const unsigned d = 16 * wid + li;
#pragma unroll
          for (int vt = 0; vt < 8; ++vt) { u32x2 w; w.x = pk2(S[vt][0] * er, S[vt][1] * er); w.y = pk2(S[vt][2] * er, S[vt][3] * er);
              *(LAS u32x2*)(ST + off_b(d, 2 * vt + (kg >> 1)) + 8 * (kg & 1)) = w; } }
        __syncthreads();
        bf16x8 qf[4];
#pragma unroll
        for (int ks = 0; ks < 4; ++ks) qf[ks] = *(const LAS bf16x8*)(QI + off_b(16 * it + li, 4 * ks + kg));
        f32x4 o[4];
#pragma unroll
        for (int vv = 0; vv < 4; ++vv) o[vv] = (f32x4){0.f, 0.f, 0.f, 0.f};
#pragma unroll
        for (int ks = 0; ks < 4; ++ks)
#pragma unroll
            for (int vv = 0; vv < 4; ++vv) {
                const int ct = 4 * vh + vv;
                const v4i16_t lo4 = __builtin_amdgcn_ds_read_tr16_b64_v4i16((LAS v4i16_t*)(ST + off_b(32 * ks + 8 * kg + q4, 2 * ct + (p4 >> 1)) + 8 * (p4 & 1)));
                const v4i16_t hi4 = __builtin_amdgcn_ds_read_tr16_b64_v4i16((LAS v4i16_t*)(ST + off_b(32 * ks + 8 * kg + 4 + q4, 2 * ct + (p4 >> 1)) + 8 * (p4 & 1)));
                const bf16x8 af = (bf16x8){lo4[0], lo4[1], lo4[2], lo4[3], hi4[0], hi4[1], hi4[2], hi4[3]};
                o[vv] = __builtin_amdgcn_mfma_f32_16x16x32_bf16(af, qf[ks], o[vv], 0, 0, 0);
            }
        const int njb = (it >> 1) + 1;
#pragma unroll
        for (int jb = 0; jb < 2; ++jb) {
            if (jb < njb) {
                f32x4 a0 = (f32x4){0.f, 0.f, 0.f, 0.f}, a1 = (f32x4){0.f, 0.f, 0.f, 0.f};
                const unsigned rw0 = 32 * jb + 8 * (li >> 2) + (li & 3), rw1 = rw0 + 4;
#pragma unroll
                for (int ks = 0; ks < 4; ++ks) {
                    const bf16x8 k0 = *(const LAS bf16x8*)(KI + off_b(rw0, 4 * ks + kg));
                    const bf16x8 k1 = *(const LAS bf16x8*)(KI + off_b(rw1, 4 * ks + kg));
                    a0 = __builtin_amdgcn_mfma_f32_16x16x32_bf16(k0, qf[ks], a0, 0, 0, 0);
                    a1 = __builtin_amdgcn_mfma_f32_16x16x32_bf16(k1, qf[ks], a1, 0, 0, 0);
                }
                const int ii = 16 * it + li, j0 = 32 * jb + 8 * kg;
                float am[8];
#pragma unroll
                for (int e = 0; e < 8; ++e) am[e] = (j0 + e <= ii) ? (e < 4 ? a0[e] : a1[e - 4]) : 0.f;
                u32x4 pw; pw.x = pk2(am[0], am[1]); pw.y = pk2(am[2], am[3]); pw.z = pk2(am[4], am[5]); pw.w = pk2(am[6], am[7]);
                const bf16x8 pb = __builtin_bit_cast(bf16x8, pw);
#pragma unroll
                for (int vv = 0; vv < 4; ++vv) {
                    const int ct = 4 * vh + vv;
                    const v4i16_t lo4 = __builtin_amdgcn_ds_read_tr16_b64_v4i16((LAS v4i16_t*)(VI + off_b(32 * jb + 8 * kg + q4, 2 * ct + (p4 >> 1)) + 8 * (p4 & 1)));
                    const v4i16_t hi4 = __builtin_amdgcn_ds_read_tr16_b64_v4i16((LAS v4i16_t*)(VI + off_b(32 * jb + 8 * kg + 4 + q4, 2 * ct + (p4 >> 1)) + 8 * (p4 & 1)));
                    const bf16x8 af = (bf16x8){lo4[0], lo4[1], lo4[2], lo4[3], hi4[0], hi4[1], hi4[2], hi4[3]};
                    o[vv] = __builtin_amdgcn_mfma_f32_16x16x32_bf16(af, pb, o[vv], 0, 0, 0);
                }
            }
        }
        {
            f32x4 U[8];
#pragma unroll
            for (int vt = 0; vt < 8; ++vt) U[vt] = (f32x4){0.f, 0.f, 0.f, 0.f};
#pragma unroll
            for (int ks = 0; ks < 2; ++ks) {
                const v4i16_t kl = __builtin_amdgcn_ds_read_tr16_b64_v4i16((LAS v4i16_t*)(KI + off_b(32 * ks + 8 * kg + q4, 2 * wid + (p4 >> 1)) + 8 * (p4 & 1)));
                const v4i16_t kh = __builtin_amdgcn_ds_read_tr16_b64_v4i16((LAS v4i16_t*)(KI + off_b(32 * ks + 8 * kg + 4 + q4, 2 * wid + (p4 >> 1)) + 8 * (p4 & 1)));
                const bf16x8 kfr = (bf16x8){kl[0], kl[1], kl[2], kl[3], kh[0], kh[1], kh[2], kh[3]};
#pragma unroll
                for (int vt = 0; vt < 8; ++vt) {
                    const v4i16_t lo4 = __builtin_amdgcn_ds_read_tr16_b64_v4i16((LAS v4i16_t*)(VI + off_b(32 * ks + 8 * kg + q4, 2 * vt + (p4 >> 1)) + 8 * (p4 & 1)));
                    const v4i16_t hi4 = __builtin_amdgcn_ds_read_tr16_b64_v4i16((LAS v4i16_t*)(VI + off_b(32 * ks + 8 * kg + 4 + q4, 2 * vt + (p4 >> 1)) + 8 * (p4 & 1)));
                    const bf16x8 af = (bf16x8){lo4[0], lo4[1], lo4[2], lo4[3], hi4[0], hi4[1], hi4[2], hi4[3]};
                    U[vt] = __builtin_amdgcn_mfma_f32_16x16x32_bf16(af, kfr, U[vt], 0, 0, 0);
                }
            }
#pragma unroll
            for (int vt = 0; vt < 8; ++vt) S[vt] = S[vt] * e63 + U[vt] * e6r;
        }
        float ss = 0.f;
#pragma unroll
        for (int vv = 0; vv < 4; ++vv) ss += (o[vv][0] * o[vv][0] + o[vv][1] * o[vv][1]) + (o[vv][2] * o[vv][2] + o[vv][3] * o[vv][3]);
        ss += __shfl_xor(ss, 16); ss += __shfl_xor(ss, 32);
        if (kg == 0) SSQ[(it * 2 + vh) * 16 + li] = ss;
        __syncthreads();
        if (c + 1 < 32) HG_STORE(buf ^ 1);
        {
            const float tot = SSQ[(it * 2) * 16 + li] + SSQ[(it * 2 + 1) * 16 + li];
            const float rs = rsqrtf(tot * (1.f / 128.f) + EPS);
            const size_t row = (size_t)b * SEQ + c * 64 + 16 * it + li;
#pragma unroll
            for (int vv = 0; vv < 4; ++vv) {
                const int v0 = 16 * (4 * vh + vv) + 4 * kg;
                const u32x2 gw = gwv[vv];
                const f32x4 og = ogv[vv];
                const float g0 = silu_f(bf2f((unsigned short)(gw.x & 0xffffu))), g1 = silu_f(bf2f((unsigned short)(gw.x >> 16))), g2 = silu_f(bf2f((unsigned short)(gw.y & 0xffffu))), g3 = silu_f(bf2f((unsigned short)(gw.y >> 16)));
                u32x2 w; w.x = pk2(o[vv][0] * rs * og.x * g0, o[vv][1] * rs * og.y * g1); w.y = pk2(o[vv][2] * rs * og.z * g2, o[vv][3] * rs * og.w * g3);
                *(u32x2*)(CAT + row * KOUT + 1024 + h * 128 + v0) = w;
            }
        }
    }
#undef HG_LOAD
#undef HG_STORE
}


__device__ __forceinline__ int swap23(int r) { return (r & ~12) | ((r & 4) << 1) | ((r & 8) >> 1); }
__device__ __forceinline__ void xattn_mfma_phase(const bf16_t* Q, const bf16_t* Kb, const bf16_t* VT, bf16_t* O, LAS unsigned char* lds, int vb, int nvb) {
    const int tid = otid(), lane = tid & 63, wid = __builtin_amdgcn_readfirstlane(tid >> 6), r32 = lane & 31, hf = lane >> 5;
    LAS unsigned char* Ks = lds; LAS unsigned char* Vs = lds + 65536;
    int koff[8], voff[8];
    { const int kr = swap23(r32), x = kr & 15, y = r32 & 15;
#pragma unroll
      for (int ks = 0; ks < 8; ++ks) koff[ks] = kr * 256 + (((ks * 2 + hf) ^ x) << 4);
#pragma unroll
      for (int e = 0; e < 8; ++e) voff[e] = r32 * 512 + (((e * 2 + hf) ^ y) << 4); }
    for (int pair = vb; pair < 256; pair += nvb) {
        const int bh = pair >> 2, b = bh >> 2, h = bh & 3;
        __syncthreads();
        int tio = tid; asm volatile("" : "+v"(tio));
        for (int i = tio; i < 4096; i += NTHREADS) { const int key = i >> 4, ch = i & 15;
            const u32x4 v = *(const u32x4*)(Kb + (size_t)(b * MEMT + key) * 512 + h * 128 + ch * 8);
            *(LAS u32x4*)(Ks + key * 256 + ((ch ^ (key & 15)) << 4)) = v; }
        for (int i = tio; i < 4096; i += NTHREADS) { const int d = i >> 5, ch = i & 31;
            const u32x4 v = *(const u32x4*)(VT + (size_t)(h * 128 + d) * MT + b * MEMT + ch * 8);
            *(LAS u32x4*)(Vs + d * 512 + ((ch ^ (d & 15)) << 4)) = v; }
        __syncthreads();
#pragma unroll 1
        for (int qq = 0; qq < 2; ++qq) {
            const size_t q0 = (size_t)b * SEQ + ((pair & 3) * 2 + qq) * 256 + wid * 32;
            bf16x8 qf[8];
#pragma unroll
            for (int ks = 0; ks < 8; ++ks) qf[ks] = *(const bf16x8*)(Q + (q0 + r32) * 512 + h * 128 + ks * 16 + 8 * hf);
            f32x16 st[8];
            __builtin_amdgcn_s_setprio(1);
#pragma unroll
            for (int kt = 0; kt < 8; ++kt) {
#pragma unroll
                for (int r = 0; r < 16; ++r) st[kt][r] = 0.f;
#pragma unroll
                for (int ks = 0; ks < 8; ++ks) {
                    const bf16x8 a = *(const LAS bf16x8*)(Ks + koff[ks] + kt * 8192);
                    st[kt] = __builtin_amdgcn_mfma_f32_32x32x16_bf16(a, qf[ks], st[kt], 0, 0, 0);
                }
            }
            __builtin_amdgcn_s_setprio(0);
            float mx = -INFINITY;
#pragma unroll
            for (int kt = 0; kt < 8; ++kt)
#pragma unroll
                for (int r = 0; r < 16; ++r) mx = fmaxf(mx, st[kt][r]);
            mx = fmaxf(mx, __shfl_xor(mx, 32));
            const float c = 0.08838834764831845f * 1.4426950408889634f;
            float sum = 0.f;
#pragma unroll
            for (int kt = 0; kt < 8; ++kt)
#pragma unroll
                for (int r = 0; r < 16; ++r) { const float e = __builtin_amdgcn_exp2f((st[kt][r] - mx) * c); st[kt][r] = e; sum += e; }
            sum += __shfl_xor(sum, 32);
            const float inv = 1.f / sum;
            bf16x8 pfr[8][2];
#pragma unroll
            for (int kt = 0; kt < 8; ++kt)
#pragma unroll
                for (int s2 = 0; s2 < 2; ++s2) {
                    u32x4 pw;
                    pw.x = pk2(st[kt][8 * s2 + 0], st[kt][8 * s2 + 1]); pw.y = pk2(st[kt][8 * s2 + 2], st[kt][8 * s2 + 3]);
                    pw.z = pk2(st[kt][8 * s2 + 4], st[kt][8 * s2 + 5]); pw.w = pk2(st[kt][8 * s2 + 6], st[kt][8 * s2 + 7]);
                    pfr[kt][s2] = __builtin_bit_cast(bf16x8, pw);
                }
#pragma unroll
            for (int kt = 0; kt < 8; ++kt) asm volatile("" : "+v"(pfr[kt][0]), "+v"(pfr[kt][1]));
            f32x16 o[4];
#pragma unroll
            for (int dt = 0; dt < 4; ++dt)
#pragma unroll
                for (int r = 0; r < 16; ++r) o[dt][r] = 0.f;
            __builtin_amdgcn_s_setprio(1);
#pragma unroll
            for (int kt = 0; kt < 8; ++kt)
#pragma unroll
                for (int s2 = 0; s2 < 2; ++s2)
#pragma unroll
                    for (int dt = 0; dt < 4; ++dt) {
                        const bf16x8 a = *(const LAS bf16x8*)(Vs + voff[(kt & 3) * 2 + s2] + dt * 16384 + (kt >> 2) * 256);
                        o[dt] = __builtin_amdgcn_mfma_f32_32x32x16_bf16(a, pfr[kt][s2], o[dt], 0, 0, 0);
                    }
            __builtin_amdgcn_s_setprio(0);
            unsigned char* orow = (unsigned char*)O + (q0 + r32) * 512 + h * 128 + 64 * hf;
            const float isc = inv * XO_SC;
#pragma unroll
            for (int dt = 0; dt < 4; ++dt) {
                u32x4 w;
#pragma unroll
                for (int g = 0; g < 4; ++g) w[g] = pk4_f8(o[dt][4 * g] * isc, o[dt][4 * g + 1] * isc, o[dt][4 * g + 2] * isc, o[dt][4 * g + 3] * isc);
                *(u32x4*)(orow + dt * 16) = w;
            }
        }
    }
}


__device__ __forceinline__ void gmlp_mfma_phase(const bf16_t* UV, const float* lnp, const float* ln_g, const float* ln_b, const float* w_sp, const float* b_sp, bf16_t* G, LAS unsigned char* lds, int vb, int nvb) {
    const int tid = otid(), lane = tid & 63, wid = __builtin_amdgcn_readfirstlane(tid >> 6), fr = lane & 15, fq = lane >> 4;
    LAS unsigned char* Wb = lds; LAS unsigned char* VTs = lds + 32768; LAS float* STAT = (LAS float*)(lds + 65536);
    int gcur = -1;
    for (int grp = vb; grp < 256; grp += nvb) {
        const int g = grp >> 5;
        bf16x8 vch[4]; f32x4 lp[2];
#define GM_LOAD(uu_) do { const size_t r0_ = (size_t)((grp & 31) * 8 + (uu_)) * 128; \
            _Pragma("unroll") for (int k = 0; k < 4; ++k) { const int i = tid + 512 * k, sI = i >> 4, ch = i & 15; vch[k] = *(const bf16x8*)(UV + (r0_ + sI) * 2048 + 1024 + g * 128 + ch * 8); } \
            lp[0] = *(const f32x4*)(lnp + (r0_ + (tid >> 2)) * 32 + (tid & 3) * 8); lp[1] = *(const f32x4*)(lnp + (r0_ + (tid >> 2)) * 32 + (tid & 3) * 8 + 4); } while (0)
        GM_LOAD(0);
        const f32x4 g0 = *(const f32x4*)(ln_g + g * 128 + (tid & 15) * 8), g1 = *(const f32x4*)(ln_g + g * 128 + (tid & 15) * 8 + 4);
        const f32x4 b0 = *(const f32x4*)(ln_b + g * 128 + (tid & 15) * 8), b1 = *(const f32x4*)(ln_b + g * 128 + (tid & 15) * 8 + 4);
        const float gg[8] = {g0.x, g0.y, g0.z, g0.w, g1.x, g1.y, g1.z, g1.w}, bb[8] = {b0.x, b0.y, b0.z, b0.w, b1.x, b1.y, b1.z, b1.w};
        __syncthreads();
        if (g != gcur) {
            gcur = g;
            for (int i = tid; i < 2048; i += NTHREADS) { const int t = i >> 4, ch = i & 15;
                const f32x4 a = *(const f32x4*)(w_sp + (size_t)g * 16384 + t * 128 + ch * 8), b = *(const f32x4*)(w_sp + (size_t)g * 16384 + t * 128 + ch * 8 + 4);
                const int s0 = ch * 8;
                u32x4 w; w.x = pk2(s0 + 0 <= t ? a.x : 0.f, s0 + 1 <= t ? a.y : 0.f); w.y = pk2(s0 + 2 <= t ? a.z : 0.f, s0 + 3 <= t ? a.w : 0.f);
                w.z = pk2(s0 + 4 <= t ? b.x : 0.f, s0 + 5 <= t ? b.y : 0.f); w.w = pk2(s0 + 6 <= t ? b.z : 0.f, s0 + 7 <= t ? b.w : 0.f);
                *(LAS u32x4*)(Wb + t * 256 + ((ch ^ (t & 15)) << 4)) = w; }
        }
        const int trow = wid * 16 + fr;
        const float bias = b_sp[g * 128 + trow];
#pragma unroll 1
        for (int uu = 0; uu < 8; ++uu) {
            const int bn = (grp & 31) * 8 + uu;
            const size_t row0 = (size_t)bn * 128;
            if (uu) __syncthreads();
            { float s1 = (lp[0].x + lp[0].z) + (lp[1].x + lp[1].z), s2 = (lp[0].y + lp[0].w) + (lp[1].y + lp[1].w);
              s1 += __shfl_xor(s1, 1); s2 += __shfl_xor(s2, 1); s1 += __shfl_xor(s1, 2); s2 += __shfl_xor(s2, 2);
              const float mu = s1 * (1.f / 1024.f), var = fmaxf(s2 * (1.f / 1024.f) - mu * mu, 0.f);
              if ((tid & 3) == 0) { STAT[2 * (tid >> 2)] = mu; STAT[2 * (tid >> 2) + 1] = rsqrtf(var + EPS); } }
            __syncthreads();
#pragma unroll
            for (int k = 0; k < 4; ++k) { const int i = tid + 512 * k, sI = i >> 4, ch = i & 15;
                const float mu = STAT[2 * sI], rs = STAT[2 * sI + 1];
#pragma unroll
                for (int e = 0; e < 8; ++e) { const int c = ch * 8 + e; const float x = (bf2f((unsigned short)vch[k][e]) - mu) * rs * gg[e] + bb[e];
                    *(LAS bf16_t*)(VTs + c * 256 + (((sI >> 3) ^ ((c ^ (c >> 3)) & 15)) << 4) + (sI & 7) * 2) = (bf16_t)f2bf(x); } }
            if (uu + 1 < 8) GM_LOAD(uu + 1);
            const size_t orow = row0 + trow;
            u32x2 uwv[8];
#pragma unroll
            for (int ct = 0; ct < 8; ++ct) uwv[ct] = *(const u32x2*)(UV + orow * 2048 + g * 128 + ct * 16 + 4 * fq);
            __syncthreads();
            f32x4 acc[8];
#pragma unroll
            for (int ct = 0; ct < 8; ++ct) acc[ct] = (f32x4){0.f, 0.f, 0.f, 0.f};
#pragma unroll
            for (int ks = 0; ks < 4; ++ks) {
                const bf16x8 wf = *(const LAS bf16x8*)(Wb + trow * 256 + (((ks * 4 + fq) ^ (trow & 15)) << 4));
#pragma unroll
                for (int ct = 0; ct < 8; ++ct) {
                    const int crow = ct * 16 + fr;
                    const bf16x8 vf = *(const LAS bf16x8*)(VTs + crow * 256 + (((ks * 4 + fq) ^ ((crow ^ (crow >> 3)) & 15)) << 4));
                    acc[ct] = __builtin_amdgcn_mfma_f32_16x16x32_bf16(vf, wf, acc[ct], 0, 0, 0);
                }
            }
#pragma unroll
            for (int ct = 0; ct < 8; ++ct) {
                const int c = ct * 16 + 4 * fq;
                const u32x2 uw = uwv[ct];
                const float u0 = bf2f((unsigned short)(uw.x & 0xffffu)), u1 = bf2f((unsigned short)(uw.x >> 16)), u2 = bf2f((unsigned short)(uw.y & 0xffffu)), u3 = bf2f((unsigned short)(uw.y >> 16));
                u32x2 w; w.x = pk2(u0 * (acc[ct][0] + bias), u1 * (acc[ct][1] + bias)); w.y = pk2(u2 * (acc[ct][2] + bias), u3 * (acc[ct][3] + bias));
                *(u32x2*)(G + orow * 1024 + g * 128 + c) = w;
            }
        }
#undef GM_LOAD
    }
}

#define GAS __attribute__((address_space(1)))
typedef GAS unsigned gu32;
#define XB_TMO      128
#define XB_XCNT(j)  (256  + 64 * (j))
#define XB_XSUB(j)  (1280 + 64 * (j))
#define XB_XGEN(j)  (2304 + 64 * (j))
#define XB_TOP      3328
#define XB_TOPGEN   3392
#define XCD_BAR_WORDS 3456
#define XB_SPIN_CAP (1u << 18)

__device__ __forceinline__ unsigned xb_ld(unsigned* p)              { return __hip_atomic_load(p, __ATOMIC_RELAXED, __HIP_MEMORY_SCOPE_AGENT); }
__device__ __forceinline__ unsigned xb_add(unsigned* p, unsigned v) { return __hip_atomic_fetch_add(p, v, __ATOMIC_RELAXED, __HIP_MEMORY_SCOPE_AGENT); }
__device__ __forceinline__ unsigned xb_xcc_id() { return (unsigned)__builtin_amdgcn_s_getreg((3 << 11) | 20) & 0xFu; }
#define XB_SPIN(cond, bar) do { unsigned _sp = 0; while (cond) { __builtin_amdgcn_s_sleep(1); \
    if ((++_sp & 255u) == 0u) { if (xb_ld(&(bar)[XB_TMO])) break; if (_sp > XB_SPIN_CAP) { atomicAdd(&(bar)[XB_TMO], 1u); break; } } } } while (0)

struct XcdBarrier {
    unsigned* bar; unsigned x;
    volatile LAS unsigned* st;
};

__device__ __forceinline__ XcdBarrier xcd_barrier_post(unsigned* bar, volatile LAS unsigned* st) {
    XcdBarrier b; b.bar = bar; b.x = xb_xcc_id(); b.st = st;
    if (threadIdx.x == 0) (void)xb_add(&bar[XB_XCNT(b.x)], 1u);
    return b;
}
__device__ __forceinline__ void xcd_barrier_complete(unsigned* bar, unsigned x, unsigned& nloc, unsigned& nx) {
    const unsigned G = gridDim.x * gridDim.y * gridDim.z;
    unsigned sum, cnt, mine, sp = 0u;
    for (;;) {
        sum = 0u; cnt = 0u; mine = 0u;
#pragma unroll
        for (unsigned j = 0; j < 16; ++j) { const unsigned c = xb_ld(&bar[XB_XCNT(j)]); sum += c; cnt += (c > 0u) ? 1u : 0u; mine = (j == x) ? c : mine; }
        if (sum == G) break;
        __builtin_amdgcn_s_sleep(1);
        if ((++sp & 255u) == 0u) { if (xb_ld(&bar[XB_TMO])) break; if (sp > XB_SPIN_CAP) { atomicAdd(&bar[XB_TMO], 1u); break; } }
    }
    nloc = mine > 0u ? mine : 1u; nx = cnt > 0u ? cnt : 1u;
}

__device__ __forceinline__ void xcd_barrier(const XcdBarrier& b) {
    asm volatile("s_waitcnt vmcnt(0)" ::: "memory");
    __syncthreads();
    if (threadIdx.x == 0) {
        unsigned* bar = b.bar;
        __builtin_amdgcn_s_waitcnt(0);
        unsigned nloc = b.st[0], nx = b.st[1];
        if (nloc == 0u) { xcd_barrier_complete(bar, b.x, nloc, nx); b.st[0] = nloc; b.st[1] = nx; }
        const unsigned old = xb_add(&bar[XB_XSUB(b.x)], 1u);
        const unsigned gen = old / nloc;
        if (old + 1u == (gen + 1u) * nloc) {
            __builtin_amdgcn_fence(__ATOMIC_RELEASE, "agent");
            asm volatile("s_waitcnt vmcnt(0)" ::: "memory");
            const unsigned og = xb_add(&bar[XB_TOP], 1u);
            const unsigned tg = og / nx;
            if (og + 1u == (tg + 1u) * nx) xb_add(&bar[XB_TOPGEN], 1u);
            else XB_SPIN(xb_ld(&bar[XB_TOPGEN]) == tg, bar);
            __builtin_amdgcn_fence(__ATOMIC_ACQUIRE, "agent");
            xb_add(&bar[XB_XGEN(b.x)], 1u);
            asm volatile("s_waitcnt vmcnt(0)" ::: "memory");
        } else {
            XB_SPIN(xb_ld(&bar[XB_XGEN(b.x)]) == gen, bar);
            __builtin_amdgcn_fence(__ATOMIC_ACQUIRE, "agent");
            asm volatile("s_waitcnt vmcnt(0)" ::: "memory");
        }
    }
    __syncthreads();
}

constexpr int LDS_BYTES = 32768 * 4 + 256 + 6144 + 8 * 2560;

enum Phase {
    PH_PREP = 0, PH_GEMM_IN, PH_CNORM, PH_MIX0  , PH_GEMM_OUT0,
    PH_GEMM_Q0, PH_XATTN0, PH_GEMM_O0, PH_GEMM_GU0, PH_GEMM_DN0,
    PH_GEMM_OIN, PH_GMLP, PH_GEMM_OOUT,
    PH_GEMM_Q1, PH_XATTN1, PH_GEMM_O1, PH_GEMM_GU1, PH_GEMM_DN1, PH_FINAL, PH_COUNT
};

__device__ __forceinline__ PrepJob make_job(const Params& p, int ji) {
    unsigned char* ws = p.ws; PrepJob j{};
    switch (ji) {
    case 0: j = PrepJob{p.in[5], 1024, 3272, p.in[4], (bf16_t*)(ws + WS_WIN), 1024, PW, 1024, 0, MAP_WIN}; break;
    case 1: j = PrepJob{p.in[10] + (size_t)512 * 1024, 512, 1024, nullptr, (bf16_t*)(ws + WS_WOUT), 0, 1024, KOUT, 1024, MAP_ID}; break;
    case 2: j = PrepJob{p.in[11], 1024, 2048, p.in[4] + 1024, (bf16_t*)(ws + WS_OWIN), 0, 2048, 1024, 0, MAP_ID, 2, WQ_GU}; break;
    case 3: j = PrepJob{p.in[16], 1024, 1024, nullptr, (bf16_t*)(ws + WS_OWOUT), 0, 1024, 1024, 0, MAP_ID}; break;
    case 4: case 5: { const int l = ji - 4; j = PrepJob{p.in[19] + (size_t)l * 1024 * 512, 1024, 512, p.in[17] + l * 1024, (bf16_t*)(ws + WS_WQ + (size_t)l * 512 * 1024), 0, 512, 1024, 0, MAP_ID, 2, WQ_GU}; } break;
    case 6: case 7: { const int l = ji - 6; j = PrepJob{p.in[20] + (size_t)l * 1024 * 1024, 1024, 1024, p.in[18] + l * 1024, (bf16_t*)(ws + WS_WKV) + (size_t)l * 1024 * 1024, 0, 1024, 1024, 0, MAP_ID}; } break;
    case 8: case 9: { const int l = ji - 8; j = PrepJob{p.in[21] + (size_t)l * 512 * 1024, 512, 1024, nullptr, (bf16_t*)(ws + WS_WO + (size_t)l * 1024 * 512), 0, 1024, 512, 0, MAP_ID, 3, WO_SC}; } break;
    case 10: case 11: { const int l = ji - 10; j = PrepJob{p.in[23] + (size_t)l * 1024 * 2 * FF, 1024, 2 * FF, p.in[22] + l * 1024, (bf16_t*)(ws + WS_WGU + (size_t)l * 2 * FF * 1024), 0, 2 * FF, 1024, 0, MAP_GU, 2, WQ_GU}; } break;
    default: { const int l = ji - 12;
        if ((DN_FP8 >> l) & 1) j = PrepJob{p.in[24] + (size_t)l * FF * 1024, FF, 1024, nullptr, (bf16_t*)(ws + WS_WDN + (size_t)l * 1024 * FF * 2), 0, 1024, FF, 0, MAP_ID, 1, WDN_SC};
        else j = PrepJob{p.in[24] + (size_t)l * FF * 1024, FF, 1024, nullptr, (bf16_t*)(ws + WS_WDN) + (size_t)l * 1024 * FF, 0, 1024, FF, 0, MAP_ID}; } break;
    }
    return j;
}
constexpr int N_PREP_JOBS = 14;

template <int ph> __device__ __forceinline__ void run_phase(const Params& p, LAS float* lds, int vb, int nvb) {
    unsigned char* ws = p.ws;
    bf16_t* HN = (bf16_t*)(ws + WS_HN); bf16_t* BIG = (bf16_t*)(ws + WS_BIG); bf16_t* CN = (bf16_t*)(ws + WS_CN); bf16_t* CAT = (bf16_t*)(ws + WS_CAT);
    bf16_t* KB = (bf16_t*)(ws + WS_KB); bf16_t* VTB = (bf16_t*)(ws + WS_VT); bf16_t* MEMN = (bf16_t*)(ws + WS_MEMN); float* lb = (float*)(ws + WS_LB);
    float* ssq = (float*)(ws + WS_SSQ); float* lnp = (float*)(ws + WS_LNP);
    bf16_t* XQ = BIG; bf16_t* XO = BIG + (size_t)T * 512;
    const int l = (ph >= PH_GEMM_Q1) ? 1 : 0;
    switch (ph) {
    case PH_PREP:
        x_to_h_rows(p.in[0], HN, ssq, vb, nvb);
        {
            constexpr int NT_[N_PREP_JOBS] = {16 * 11, 8 * 4, 16 * 8, 16 * 4, 16 * 2, 16 * 2, 16 * 4, 16 * 4, 8 * 4, 8 * 4, 16 * 22, 16 * 22, 44 * 4, 44 * 4};
            constexpr int CUM1 = NT_[0], CUM2 = CUM1 + NT_[1], CUM3 = CUM2 + NT_[2], CUM4 = CUM3 + NT_[3], CUM5 = CUM4 + NT_[4], CUM6 = CUM5 + NT_[5], CUM7 = CUM6 + NT_[6],
                          CUM8 = CUM7 + NT_[7], CUM9 = CUM8 + NT_[8], CUM10 = CUM9 + NT_[9], CUM11 = CUM10 + NT_[10], CUM12 = CUM11 + NT_[11], CUM13 = CUM12 + NT_[12], CUM14 = CUM13 + NT_[13];
#define PJ_FIND(it_, ji_, base_) do { ji_ = 0; base_ = 0; \
                PJ_STEP(it_, ji_, base_, 1, CUM1) PJ_STEP(it_, ji_, base_, 2, CUM2) PJ_STEP(it_, ji_, base_, 3, CUM3) PJ_STEP(it_, ji_, base_, 4, CUM4) PJ_STEP(it_, ji_, base_, 5, CUM5) PJ_STEP(it_, ji_, base_, 6, CUM6) PJ_STEP(it_, ji_, base_, 7, CUM7) \
                PJ_STEP(it_, ji_, base_, 8, CUM8) PJ_STEP(it_, ji_, base_, 9, CUM9) PJ_STEP(it_, ji_, base_, 10, CUM10) PJ_STEP(it_, ji_, base_, 11, CUM11) PJ_STEP(it_, ji_, base_, 12, CUM12) PJ_STEP(it_, ji_, base_, 13, CUM13) } while (0)
#define PJ_STEP(it_, ji_, base_, q, c) if ((it_) >= (c)) { ji_ = (q); base_ = (c); }
            f32x4 va[8], vn[8];
            int ji, base;
            if (vb < CUM14) { PJ_FIND(vb, ji, base); const PrepJob j = make_job(p, ji); prep_tile_load(j, vb - base, va); }
            for (int it = vb; it < CUM14; it += nvb) {
                PJ_FIND(it, ji, base);
                const PrepJob j = make_job(p, ji); const int tl = it - base;
                if (it + nvb < CUM14) { int jn, bn; PJ_FIND(it + nvb, jn, bn); const PrepJob j2 = make_job(p, jn); prep_tile_load(j2, it + nvb - bn, vn); }
                prep_tile_store(j, tl, va, lds);
#pragma unroll
                for (int q = 0; q < 8; ++q) va[q] = vn[q];
            }
#undef PJ_STEP
#undef PJ_FIND
        }
        prep_fold_in(p.in[5], p.in[7], p.in[4], (bf16_t*)(ws + WS_WIN), lds, vb, nvb);
        prep_fold_out(p.in[10], p.in[8], (bf16_t*)(ws + WS_WOUT), lds, vb, nvb);
        prep_lb(p.in[3], lb, vb, nvb);
        rmsnorm_rows(p.in[1], MEMN, MT, vb, nvb);
        break;
    case PH_GEMM_IN: {
        Gemm g{(const bf16_t*)(ws + WS_WIN), (const bf16_t*)(ws + WS_WIN), T, PW, 1024}; EpiIn E{BIG, KB, VTB, ssq};
        pg8::ComboOrder S; S.init(nvb, vb);
        pg8::gemm_phase<EpiIn, pg8::ComboOrder, true, true>((LAS unsigned char*)lds, g, S, E);
    } break;
    case PH_CNORM: cnorm_rows(BIG, p.in[6], CN, vb, nvb); hgrn_prep(BIG, lb, (float*)(ws + WS_DEC), (LAS unsigned char*)lds, vb, nvb); break;
    case PH_MIX0:
        for (int item = vb; item < 64; item += nvb) hgrn_scan(BIG, (const float*)(ws + WS_DEC), p.in[9], CAT, (LAS unsigned char*)lds, item);
        dsa_mfma_phase(BIG, CN, p.in[2], CAT, (LAS unsigned char*)lds, (unsigned*)(ws + WS_CTL) + 3600);
        break;
    case PH_GEMM_OUT0: { Gemm g{CAT, (const bf16_t*)(ws + WS_WOUT), T, 1024, KOUT}; EpiResid<false, false, true> E{nullptr, HN, ssq, ws + WS_H8, HQ_Q0}; run_gemm(g, E, lds, vb, nvb); } break;
    case PH_GEMM_Q0: case PH_GEMM_Q1: { Gemm g{(const bf16_t*)(ws + WS_H8), (const bf16_t*)(ws + WS_WQ + (size_t)l * 512 * 1024), T, 512, 512}; EpiStoreBf16<true> E{XQ, 512, ssq, 1.f / ((l ? HQ_Q1 : HQ_Q0) * WQ_GU)}; run_gemm<EpiStoreBf16<true>, 2>(g, E, lds, vb, nvb); } break;
    case PH_XATTN0: case PH_XATTN1: xattn_mfma_phase(XQ, KB + (size_t)l * MT * 512, VTB + (size_t)l * 512 * MT, XO, (LAS unsigned char*)lds, vb, nvb); break;
    case PH_GEMM_O0: case PH_GEMM_O1: { Gemm g{XO, (const bf16_t*)(ws + WS_WO + (size_t)l * 1024 * 512), T, 1024, 256}; EpiResid<false, true, true> E{nullptr, HN, ssq, ws + WS_H8, l ? HQ_GU1 : HQ_GU0, XO_UNSC}; run_gemm<EpiResid<false, true, true>, 1>(g, E, lds, vb, nvb); } break;
    case PH_GEMM_GU0: case PH_GEMM_GU1: { constexpr bool dn8 = ((DN_FP8 >> l) & 1) != 0;
        Gemm g{(const bf16_t*)(ws + WS_H8), (const bf16_t*)(ws + WS_WGU + (size_t)l * 2 * FF * 1024), T, 2 * FF, 512}; EpiSwigluQ<true, dn8> E{BIG, FF, ssq, 1.f / ((l ? HQ_GU1 : HQ_GU0) * WQ_GU)}; run_gemm<EpiSwigluQ<true, dn8>, 2>(g, E, lds, vb, nvb); } break;
    case PH_GEMM_DN0: case PH_GEMM_DN1:
        if constexpr (((DN_FP8 >> l) & 1) != 0) { Gemm g{BIG, (const bf16_t*)(ws + WS_WDN + (size_t)l * 1024 * FF * 2), T, 1024, FF / 2}; EpiResid<false, true, ph == PH_GEMM_DN0> E{nullptr, HN, ssq, ws + WS_H8, HQ_OIN, DN_UNSC}; run_gemm<EpiResid<false, true, ph == PH_GEMM_DN0>, 1>(g, E, lds, vb, nvb); }
        else { Gemm g{BIG, (const bf16_t*)(ws + WS_WDN) + (size_t)l * 1024 * FF, T, 1024, FF}; EpiResid<false, false, ph == PH_GEMM_DN0> E{nullptr, HN, ssq, ws + WS_H8, HQ_OIN}; run_gemm(g, E, lds, vb, nvb); }
        break;
    case PH_GEMM_OIN: { Gemm g{(const bf16_t*)(ws + WS_H8), (const bf16_t*)(ws + WS_OWIN), T, 2048, 512}; EpiGeluBf16<true> E{BIG, 2048, ssq, lnp, 1.f / (HQ_OIN * WQ_GU)}; run_gemm<EpiGeluBf16<true>, 2>(g, E, lds, vb, nvb); } break;
    case PH_GMLP: gmlp_mfma_phase(BIG, lnp, p.in[12], p.in[13], p.in[14], p.in[15], CAT, (LAS unsigned char*)lds, vb, nvb); break;
    case PH_GEMM_OOUT: { Gemm g{CAT, (const bf16_t*)(ws + WS_OWOUT), T, 1024, 1024}; EpiResid<false, false, true> E{nullptr, HN, ssq, ws + WS_H8, HQ_Q1}; run_gemm(g, E, lds, vb, nvb); } break;
    case PH_FINAL: final_rows(HN, ssq, p.in[25], p.out, vb, nvb); break;
    default: break;
    }
}

template <int PH> __global__ void __launch_bounds__(NTHREADS) k_phase(Params p) {
    extern __shared__ __attribute__((aligned(16))) float smem[];
    run_phase<PH>(p, (LAS float*)smem, blockIdx.x, gridDim.x);
}

template <int PH> __device__ __forceinline__ void mega_phases(const Params& p, LAS float* lds, const XcdBarrier& bar) {
    run_phase<PH>(p, lds, blockIdx.x, gridDim.x);
#ifdef REPEAT_PH
    if constexpr (PH == REPEAT_PH) { xcd_barrier(bar); run_phase<PH>(p, lds, blockIdx.x, gridDim.x); }
#endif
    if constexpr (PH + 1 < PH_COUNT) { xcd_barrier(bar); mega_phases<PH + 1>(p, lds, bar); }
}
__global__ void __launch_bounds__(NTHREADS) k_mega(Params p) {
    extern __shared__ __attribute__((aligned(16))) float smem[];
    volatile LAS unsigned* st = (volatile LAS unsigned*)((LAS float*)smem + 32768);
    if (threadIdx.x < 2) st[threadIdx.x] = 0u;
    __syncthreads();
    const XcdBarrier bar = xcd_barrier_post((unsigned*)(p.ws + WS_CTL), st);
    mega_phases<0>(p, (LAS float*)smem, bar);
}

template <int PH> static void launch_phases(const Params& p, int grid, hipStream_t stream) {
    int g = grid * 4;
    if (PH == PH_MIX0 || PH == PH_XATTN0 || PH == PH_XATTN1 || PH == PH_GMLP) g = grid;
    (void)hipFuncSetAttribute((const void*)k_phase<PH>, hipFuncAttributeMaxDynamicSharedMemorySize, LDS_BYTES);
    hipLaunchKernelGGL(k_phase<PH>, dim3(g), dim3(NTHREADS), LDS_BYTES, stream, p);
    if constexpr (PH + 1 < PH_COUNT) launch_phases<PH + 1>(p, grid, stream);
}

extern "C" void kernel_launch(void* const* d_in, const int* in_sizes, int n_in, void* d_out, int out_size, void* d_ws, size_t ws_size, hipStream_t stream) {
    static int grid = 0;
    if (grid == 0) {
        if (n_in != 26 || out_size != T * D || ws_size < WS_END) { fprintf(stderr, "kernel_launch: unexpected shapes (n_in %d out %d ws %zu)\n", n_in, out_size, ws_size); grid = -1; return; }
        int dev = 0, cus = 0;
        (void)hipGetDevice(&dev); (void)hipDeviceGetAttribute(&cus, hipDeviceAttributeMultiprocessorCount, dev);
        (void)hipFuncSetAttribute((const void*)k_mega, hipFuncAttributeMaxDynamicSharedMemorySize, LDS_BYTES);
        int per_cu = 0;
        (void)hipOccupancyMaxActiveBlocksPerMultiprocessor(&per_cu, (const void*)k_mega, NTHREADS, LDS_BYTES);
        if (per_cu < 1) fprintf(stderr, "kernel_launch: occupancy query says %d blocks per CU\n", per_cu);
        (void)hipGetLastError();
        grid = cus > 0 ? cus : 256;
    }
    if (grid < 0) return;
    Params p{};
    for (int i = 0; i < 26; ++i) p.in[i] = (const float*)d_in[i];
    p.out = (float*)d_out; p.ws = (unsigned char*)d_ws;
    (void)hipMemsetAsync((char*)d_ws + WS_CTL, 0, 16384, stream);
#if MEGA
    hipLaunchKernelGGL(k_mega, dim3(grid), dim3(NTHREADS), LDS_BYTES, stream, p);
#else
    launch_phases<0>(p, grid, stream);
#endif
}
```

```cpp
#include <hip/hip_runtime.h>
#include <stdint.h>
#include <stdio.h>

#ifndef MEGA
#define MEGA 1
#endif
#ifndef DN_FP8
#define DN_FP8 2
#endif

#define LAS __attribute__((address_space(3)))
typedef unsigned short bf16_t;
typedef short bf16x8 __attribute__((ext_vector_type(8)));
typedef float f32x4 __attribute__((ext_vector_type(4)));
typedef float f32x2 __attribute__((ext_vector_type(2)));
typedef unsigned u32x4 __attribute__((ext_vector_type(4)));
typedef unsigned u32x2 __attribute__((ext_vector_type(2)));
typedef float f32x16 __attribute__((ext_vector_type(16)));

constexpr int D = 1024, BATCH = 16, SEQ = 2048, T = BATCH * SEQ;
constexpr int CHUNK = 64;
constexpr int MEMT = 256, MT = BATCH * MEMT;
constexpr int FF = 2816;
constexpr float EPS = 1e-6f;
constexpr int NTHREADS = 512, NWAVES = 8;

constexpr int P_QL = 0, P_C = 1024, P_QI = 1152, P_KI = 1664, P_FB = 1728, P_IB = 2240, P_QB = 2752, P_GB = 3264, P_WI = 3776, P_END = 3784, PW = 3840;
constexpr int KOUT = 1536;

constexpr size_t MiB = 1u << 20;
constexpr size_t WS_CTL = 0;
constexpr size_t WS_LB = 64 * 1024;
constexpr size_t WS_SSQ = 496 * MiB;
constexpr size_t WS_LNP = 498 * MiB;
constexpr size_t WS_WIN = 1 * MiB;
constexpr size_t WS_WKV = WS_WIN + (size_t)PW * D * 2;
constexpr size_t WS_HN = WS_WKV + 2 * (size_t)D * D * 2;
constexpr size_t WS_MEMN = WS_HN + (size_t)T * D * 2;
constexpr size_t WS_WOUT = WS_MEMN + (size_t)MT * D * 2;
constexpr size_t WS_OWIN = WS_WOUT + (size_t)D * KOUT * 2;
constexpr size_t WS_OWOUT = WS_OWIN + (size_t)2048 * D * 2;
constexpr size_t WS_WQ = WS_OWOUT + (size_t)D * D * 2;
constexpr size_t WS_WO = WS_WQ + 2 * (size_t)512 * D * 2;
constexpr size_t WS_WGU = WS_WO + 2 * (size_t)D * 512 * 2;
constexpr size_t WS_WDN = WS_WGU + 2 * (size_t)2 * FF * D * 2;
constexpr size_t WS_WEND = WS_WDN + 2 * (size_t)D * FF * 2;
constexpr int TILE_WIN = 0, TILE_WKV = PW / 256, TILE_HN = TILE_WKV + 8, TILE_MEMN = TILE_HN + T / 256;
constexpr size_t WS_BIG = 132 * MiB;
constexpr size_t WS_CN = 372 * MiB;
constexpr size_t WS_CAT = 380 * MiB;
constexpr size_t WS_H8 = WS_BIG + 200 * MiB;
constexpr size_t WS_X8 = WS_CAT;
constexpr size_t WS_WIN8 = WS_CAT + 32 * MiB;
constexpr size_t WS_KB = 476 * MiB;
constexpr size_t WS_VT = 484 * MiB;
constexpr size_t WS_END = 502 * MiB;
static_assert(WS_WEND <= WS_BIG, "weights fit below BIG");

struct Params {
    const float* in[26];
    float* out;
    unsigned char* ws;
};

__device__ __forceinline__ float bf2f(unsigned short u) { return __uint_as_float(((unsigned)u) << 16); }
__device__ __forceinline__ unsigned f2bf(float f) { unsigned u = __float_as_uint(f); return (u + 0x7fffu + ((u >> 16) & 1u)) >> 16; }
typedef __bf16 bf16x2_t __attribute__((ext_vector_type(2)));
__device__ __forceinline__ unsigned pk2(float lo, float hi) { const f32x2 v = {lo, hi}; return __builtin_bit_cast(unsigned, __builtin_convertvector(v, bf16x2_t)); }
__device__ __forceinline__ float wave_sum(float v) {
#pragma unroll
    for (int o = 1; o < 64; o <<= 1) v += __shfl_xor(v, o);
    return v;
}
__device__ __forceinline__ float wave_max(float v) {
#pragma unroll
    for (int o = 1; o < 64; o <<= 1) v = fmaxf(v, __shfl_xor(v, o));
    return v;
}
__device__ __forceinline__ int otid() { int t = threadIdx.x; asm volatile("" : "+v"(t)); return t; }
#define WAVE_LDS_SYNC() asm volatile("s_waitcnt lgkmcnt(0)" ::: "memory")
__device__ __forceinline__ float silu_f(float x) { return x * __builtin_amdgcn_rcpf(1.f + __expf(-x)); }
__device__ __forceinline__ float sigmoid_f(float x) { return __builtin_amdgcn_rcpf(1.f + __expf(-x)); }

typedef int i32x4v __attribute__((ext_vector_type(4)));
typedef int i32x8v __attribute__((ext_vector_type(8)));
__device__ __forceinline__ unsigned pk4_f8(float a, float b, float c, float d) {
    a = __builtin_amdgcn_fmed3f(a, -448.f, 448.f); b = __builtin_amdgcn_fmed3f(b, -448.f, 448.f); c = __builtin_amdgcn_fmed3f(c, -448.f, 448.f); d = __builtin_amdgcn_fmed3f(d, -448.f, 448.f);
    int w = 0;
    w = __builtin_amdgcn_cvt_pk_fp8_f32(a, b, w, false);
    w = __builtin_amdgcn_cvt_pk_fp8_f32(c, d, w, true);
    return (unsigned)w;
}
constexpr float ACT_SC = 8.f, WDN_SC = 256.f, DN_UNSC = 1.f / (ACT_SC * WDN_SC);
constexpr float XO_SC = 64.f, WO_SC = 128.f, XO_UNSC = 1.f / (XO_SC * WO_SC);
constexpr float HQ_X = 127.f / 4.2f;
constexpr float HQ_Q0 = 127.f / 5.2f, HQ_GU0 = 127.f / 5.2f, HQ_OIN = 127.f / 5.8f, HQ_Q1 = 127.f / 6.3f, HQ_GU1 = 127.f / 6.3f, WQ_GU = 127.f / 0.13f;
__device__ __forceinline__ unsigned pk4_i8(float a, float b, float c, float d, float sc) {
    constexpr float MG = 12582912.f;
    const unsigned ua = __float_as_uint(__builtin_amdgcn_fmed3f(__builtin_fmaf(a, sc, MG), MG - 127.f, MG + 127.f)), ub = __float_as_uint(__builtin_amdgcn_fmed3f(__builtin_fmaf(b, sc, MG), MG - 127.f, MG + 127.f));
    const unsigned uc = __float_as_uint(__builtin_amdgcn_fmed3f(__builtin_fmaf(c, sc, MG), MG - 127.f, MG + 127.f)), ud = __float_as_uint(__builtin_amdgcn_fmed3f(__builtin_fmaf(d, sc, MG), MG - 127.f, MG + 127.f));
    return __builtin_amdgcn_perm(ub, ua, 0x0c0c0400u) | __builtin_amdgcn_perm(ud, uc, 0x04000c0cu);
}
__device__ __forceinline__ int kperm8(int k) { const int r = k & 255; return (k & ~255) + ((r >> 5) & 3) * 64 + ((r >> 3) & 3) * 16 + (r >> 7) * 8 + (r & 7); }
__device__ __forceinline__ f32x4 i2f4(f32x4 v) { const i32x4v t = __builtin_bit_cast(i32x4v, v); return (f32x4){(float)t.x, (float)t.y, (float)t.z, (float)t.w}; }
struct Unit { int pm, pn; };
struct Gemm { const bf16_t* A; const bf16_t* Bt; int M, N, K; };
__device__ __forceinline__ int perm32(int rho) { const int n = rho >> 4, i = rho & 15; return 8 * (i >> 2) + 4 * n + (i & 3); }

__device__ __forceinline__ float row_rstd(const float* ssq, size_t row) {
    const f32x4* p = (const f32x4*)(ssq + row * 16);
    const f32x4 a = p[0], b = p[1], c = p[2], d = p[3];
    const float t = (((a.x + a.y) + (a.z + a.w)) + ((b.x + b.y) + (b.z + b.w))) + (((c.x + c.y) + (c.z + c.w)) + ((d.x + d.y) + (d.z + d.w)));
    return rsqrtf(t * (1.f / 1024.f) + EPS);
}
__device__ __forceinline__ void rows_rstd(const float* ssq, size_t row0, int fq, float (&rs)[2][4]) {
#pragma unroll
    for (int ai = 0; ai < 2; ++ai)
#pragma unroll
        for (int m = 0; m < 4; ++m) { const f32x4 a = *(const f32x4*)(ssq + (row0 + ai * 128 + m * 16) * 16 + 4 * fq); rs[ai][m] = (a.x + a.y) + (a.z + a.w); }
#pragma unroll
    for (int ai = 0; ai < 2; ++ai)
#pragma unroll
        for (int m = 0; m < 4; ++m) { float t = rs[ai][m]; t += __shfl_xor(t, 16); t += __shfl_xor(t, 32); rs[ai][m] = rsqrtf(t * (1.f / 1024.f) + EPS); }
}
template <bool ACC_I8 = false, bool REMAP = false> struct EpiStoreBf16 {
    static constexpr bool PERM = true, AFTER_DRAIN = false;
    bf16_t* O; int ldc; const float* ssq; float dq = 1.f;
    __device__ __forceinline__ void operator()(const f32x4 (&acc)[2][2][4][2], const Unit& u, int wr, int wc, int fr, int fq) const {
        const int ct = REMAP ? (u.pn < 4 ? u.pn : u.pn + 3) : u.pn;
        const int row0 = u.pm * 256 + wr * 64 + fr, col0 = ct * 256 + wc * 32 + 8 * fq;
        float rsv[2][4]; rows_rstd(ssq, (size_t)row0, fq, rsv);
#pragma unroll
        for (int ai = 0; ai < 2; ++ai)
#pragma unroll
            for (int m = 0; m < 4; ++m) {
                const float rs = ACC_I8 ? rsv[ai][m] * dq : rsv[ai][m];
                bf16_t* rowp = O + (size_t)(row0 + ai * 128 + m * 16) * ldc + col0;
#pragma unroll
                for (int bj = 0; bj < 2; ++bj) {
                    const f32x4 v0 = (ACC_I8 ? i2f4(acc[ai][bj][m][0]) : acc[ai][bj][m][0]) * rs, v1 = (ACC_I8 ? i2f4(acc[ai][bj][m][1]) : acc[ai][bj][m][1]) * rs;
                    u32x4 w; w.x = pk2(v0[0], v0[1]); w.y = pk2(v0[2], v0[3]); w.z = pk2(v1[0], v1[1]); w.w = pk2(v1[2], v1[3]);
                    *(u32x4*)(rowp + bj * 128) = w;
                }
            }
    }
};
struct EpiIn {
    static constexpr bool PERM = true, AFTER_DRAIN = false;
    bf16_t* P; bf16_t* KB; bf16_t* VT; const float* ssq;
    __device__ __forceinline__ void operator()(const f32x4 (&acc)[2][2][4][2], const Unit& u, int wr, int wc, int fr, int fq) const {
        bf16_t* O; int ldc, rt, ct; const bool main_unit = u.pn < TILE_WKV;
        if (main_unit) { O = P; ldc = PW; rt = u.pm - TILE_HN; ct = u.pn; }
        else if (u.pm >= TILE_MEMN) { const int l = (u.pn - TILE_WKV) >> 2; O = KB + (size_t)l * MT * 512; ldc = 512; rt = u.pm - TILE_MEMN; ct = (u.pn - TILE_WKV) & 3; }
        else { const int l = (u.pm - TILE_WKV) >> 2; O = VT + (size_t)l * 512 * MT; ldc = MT; rt = ((u.pm - TILE_WKV) & 3) - 2; ct = u.pn - TILE_MEMN; }
        const int row0 = rt * 256 + wr * 64 + fr, col0 = ct * 256 + wc * 32 + 8 * fq;
        float rsv[2][4];
        if (main_unit) rows_rstd(ssq, (size_t)row0, fq, rsv);
        else {
#pragma unroll
            for (int ai = 0; ai < 2; ++ai)
#pragma unroll
                for (int m = 0; m < 4; ++m) rsv[ai][m] = 1.f; }
#pragma unroll
        for (int ai = 0; ai < 2; ++ai)
#pragma unroll
            for (int m = 0; m < 4; ++m) {
                const float rs = rsv[ai][m];
                bf16_t* rowp = O + (size_t)(row0 + ai * 128 + m * 16) * ldc + col0;
#pragma unroll
                for (int bj = 0; bj < 2; ++bj) {
                    const f32x4 v0 = acc[ai][bj][m][0] * rs, v1 = acc[ai][bj][m][1] * rs;
                    u32x4 w; w.x = pk2(v0[0], v0[1]); w.y = pk2(v0[2], v0[3]); w.z = pk2(v1[0], v1[1]); w.w = pk2(v1[2], v1[3]);
                    *(u32x4*)(rowp + bj * 128) = w;
                }
            }
    }
};
template <bool ACC_I8 = false> struct EpiGeluBf16 {
    static constexpr bool PERM = true, AFTER_DRAIN = false;
    bf16_t* O; int ldc; const float* ssq; float* lnp; float dq = 1.f;
    __device__ __forceinline__ static f32x2 gelu_pk(f32x2 v) {
        const f32x2 av = __builtin_elementwise_abs(v), d = av * 0.2316418882f + 1.0f;
        f32x2 t; t.x = __builtin_amdgcn_rcpf(d.x); t.y = __builtin_amdgcn_rcpf(d.y);
        f32x2 q = t * 0.5307027145f + (-0.7265760135f); q = q * t + 0.7107068705f; q = q * t + (-0.142248368f); q = q * t + 0.127414796f; q = q * t;
        const f32x2 sq = (v * v) * (-0.72134752044f);
        f32x2 e; e.x = __builtin_amdgcn_exp2f(sq.x); e.y = __builtin_amdgcn_exp2f(sq.y);
        const f32x2 mm = v * (q * e), r = v - mm;
        f32x2 o; o.x = v.x < 0.f ? mm.x : r.x; o.y = v.y < 0.f ? mm.y : r.y; return o;
    }
    __device__ __forceinline__ static unsigned g2(float a, float b) { const f32x2 r = gelu_pk((f32x2){a, b}); return pk2(r.x, r.y); }
    __device__ __forceinline__ void operator()(const f32x4 (&acc)[2][2][4][2], const Unit& u, int wr, int wc, int fr, int fq) const {
        const int row0 = u.pm * 256 + wr * 64 + fr, col0 = u.pn * 256 + wc * 32 + 8 * fq;
        float rsv[2][4]; rows_rstd(ssq, (size_t)row0, fq, rsv);
#pragma unroll
        for (int ai = 0; ai < 2; ++ai)
#pragma unroll
            for (int m = 0; m < 4; ++m) {
                const size_t row = (size_t)(row0 + ai * 128 + m * 16);
                const float rs = ACC_I8 ? rsv[ai][m] * dq : rsv[ai][m];
                bf16_t* rowp = O + row * ldc + col0;
                float s1 = 0.f, s2 = 0.f;
#pragma unroll
                for (int bj = 0; bj < 2; ++bj) {
                    const f32x4 v0 = (ACC_I8 ? i2f4(acc[ai][bj][m][0]) : acc[ai][bj][m][0]) * rs, v1 = (ACC_I8 ? i2f4(acc[ai][bj][m][1]) : acc[ai][bj][m][1]) * rs;
                    const f32x2 ga = gelu_pk((f32x2){v0[0], v0[1]}), gb = gelu_pk((f32x2){v0[2], v0[3]}), gc = gelu_pk((f32x2){v1[0], v1[1]}), gd = gelu_pk((f32x2){v1[2], v1[3]});
                    u32x4 w; w.x = pk2(ga.x, ga.y); w.y = pk2(gb.x, gb.y); w.z = pk2(gc.x, gc.y); w.w = pk2(gd.x, gd.y);
                    *(u32x4*)(rowp + bj * 128) = w;
                    s1 += ((ga.x + ga.y) + (gb.x + gb.y)) + ((gc.x + gc.y) + (gd.x + gd.y));
                    s2 += ((ga.x * ga.x + ga.y * ga.y) + (gb.x * gb.x + gb.y * gb.y)) + ((gc.x * gc.x + gc.y * gc.y) + (gd.x * gd.x + gd.y * gd.y));
                }
                if (u.pn >= 4) {
                    s1 += __shfl_xor(s1, 16); s1 += __shfl_xor(s1, 32); s2 += __shfl_xor(s2, 16); s2 += __shfl_xor(s2, 32);
                    if (fq == 0) *(f32x2*)(lnp + (row * 16 + (u.pn - 4) * 4 + wc) * 2) = (f32x2){s1, s2};
                }
            }
    }
};
struct EpiSwigluBf16 {
    static constexpr bool PERM = true, AFTER_DRAIN = false;
    bf16_t* O; int ldc; const float* ssq;
    __device__ __forceinline__ void operator()(const f32x4 (&acc)[2][2][4][2], const Unit& u, int wr, int wc, int fr, int fq) const {
        const int row0 = u.pm * 256 + wr * 64 + fr, col0 = u.pn * 128 + wc * 32 + 8 * fq;
        float rsv[2][4]; rows_rstd(ssq, (size_t)row0, fq, rsv);
#pragma unroll
        for (int ai = 0; ai < 2; ++ai)
#pragma unroll
            for (int m = 0; m < 4; ++m) {
                const float rs = rsv[ai][m];
                bf16_t* rowp = O + (size_t)(row0 + ai * 128 + m * 16) * ldc + col0;
                const f32x4 g0 = acc[ai][0][m][0] * rs, g1 = acc[ai][0][m][1] * rs, u0 = acc[ai][1][m][0] * rs, u1 = acc[ai][1][m][1] * rs;
                u32x4 w;
                w.x = pk2(silu_f(g0[0]) * u0[0], silu_f(g0[1]) * u0[1]); w.y = pk2(silu_f(g0[2]) * u0[2], silu_f(g0[3]) * u0[3]);
                w.z = pk2(silu_f(g1[0]) * u1[0], silu_f(g1[1]) * u1[1]); w.w = pk2(silu_f(g1[2]) * u1[2], silu_f(g1[3]) * u1[3]);
                *(u32x4*)rowp = w;
            }
    }
};
template <bool ACC_I8, bool OUT_F8> struct EpiSwigluQ {
    static constexpr bool PERM = true, AFTER_DRAIN = false;
    void* O; int ldc; const float* ssq; float dq;
    __device__ __forceinline__ void operator()(const f32x4 (&acc)[2][2][4][2], const Unit& u, int wr, int wc, int fr, int fq) const {
        const int row0 = u.pm * 256 + wr * 64 + fr, col0 = u.pn * 128 + wc * 32 + 8 * fq;
        float rsv[2][4]; rows_rstd(ssq, (size_t)row0, fq, rsv);
#pragma unroll
        for (int ai = 0; ai < 2; ++ai)
#pragma unroll
            for (int m = 0; m < 4; ++m) {
                const float rs = ACC_I8 ? rsv[ai][m] * dq : rsv[ai][m], rsu = OUT_F8 ? rs * ACT_SC : rs;
                f32x4 g0 = acc[ai][0][m][0], g1 = acc[ai][0][m][1], u0 = acc[ai][1][m][0], u1 = acc[ai][1][m][1];
                if (ACC_I8) { g0 = i2f4(g0); g1 = i2f4(g1); u0 = i2f4(u0); u1 = i2f4(u1); }
                g0 = g0 * rs; g1 = g1 * rs; u0 = u0 * rsu; u1 = u1 * rsu;
                if (OUT_F8) {
                    unsigned char* rowp = (unsigned char*)O + (size_t)(row0 + ai * 128 + m * 16) * ldc + col0;
                    u32x2 w;
                    w.x = pk4_f8(silu_f(g0[0]) * u0[0], silu_f(g0[1]) * u0[1], silu_f(g0[2]) * u0[2], silu_f(g0[3]) * u0[3]);
                    w.y = pk4_f8(silu_f(g1[0]) * u1[0], silu_f(g1[1]) * u1[1], silu_f(g1[2]) * u1[2], silu_f(g1[3]) * u1[3]);
                    *(u32x2*)rowp = w;
                } else {
                    bf16_t* rowp = (bf16_t*)O + (size_t)(row0 + ai * 128 + m * 16) * ldc + col0;
                    u32x4 w;
                    w.x = pk2(silu_f(g0[0]) * u0[0], silu_f(g0[1]) * u0[1]); w.y = pk2(silu_f(g0[2]) * u0[2], silu_f(g0[3]) * u0[3]);
                    w.z = pk2(silu_f(g1[0]) * u1[0], silu_f(g1[1]) * u1[1]); w.w = pk2(silu_f(g1[2]) * u1[2], silu_f(g1[3]) * u1[3]);
                    *(u32x4*)rowp = w;
                }
            }
    }
};
template <bool BASE_F32, bool SCALED = false, bool W8 = false> struct EpiResid {
    static constexpr bool PERM = true, AFTER_DRAIN = false;
    const float* xbase; bf16_t* H; float* ssq; unsigned char* H8 = nullptr; float hq = 0.f; float asc = 1.f;
    __device__ __forceinline__ void operator()(const f32x4 (&acc)[2][2][4][2], const Unit& u, int wr, int wc, int fr, int fq) const {
        const int row0 = u.pm * 256 + wr * 64 + fr, col0 = u.pn * 256 + wc * 32 + 8 * fq;
#pragma unroll
        for (int ai = 0; ai < 2; ++ai)
#pragma unroll
            for (int m = 0; m < 4; ++m) {
                const size_t row = (size_t)(row0 + ai * 128 + m * 16);
                float ss = 0.f; u32x4 q8 = (u32x4){0u, 0u, 0u, 0u};
#pragma unroll
                for (int bj = 0; bj < 2; ++bj) {
                    const size_t off = row * 1024 + col0 + bj * 128;
                    f32x4 b0, b1;
                    if (BASE_F32) { b0 = *(const f32x4*)(xbase + off); b1 = *(const f32x4*)(xbase + off + 4); }
                    else { const u32x4 hw = *(const u32x4*)(H + off);
                        b0 = (f32x4){bf2f((unsigned short)(hw.x & 0xffffu)), bf2f((unsigned short)(hw.x >> 16)), bf2f((unsigned short)(hw.y & 0xffffu)), bf2f((unsigned short)(hw.y >> 16))};
                        b1 = (f32x4){bf2f((unsigned short)(hw.z & 0xffffu)), bf2f((unsigned short)(hw.z >> 16)), bf2f((unsigned short)(hw.w & 0xffffu)), bf2f((unsigned short)(hw.w >> 16))}; }
                    const float sc = SCALED ? asc : 1.f;
                    const f32x4 v0 = b0 + acc[ai][bj][m][0] * sc, v1 = b1 + acc[ai][bj][m][1] * sc;
                    u32x4 w; w.x = pk2(v0[0], v0[1]); w.y = pk2(v0[2], v0[3]); w.z = pk2(v1[0], v1[1]); w.w = pk2(v1[2], v1[3]);
                    *(u32x4*)(H + off) = w;
                    if (W8) { q8[2 * bj] = pk4_i8(v0[0], v0[1], v0[2], v0[3], hq); q8[2 * bj + 1] = pk4_i8(v1[0], v1[1], v1[2], v1[3], hq); }
                    ss += ((v0[0] * v0[0] + v0[1] * v0[1]) + (v0[2] * v0[2] + v0[3] * v0[3])) + ((v1[0] * v1[0] + v1[1] * v1[1]) + (v1[2] * v1[2] + v1[3] * v1[3]));
                }
                if (W8) *(u32x4*)(H8 + row * 1024 + u.pn * 256 + wc * 64 + fq * 16) = q8;
                ss += __shfl_xor(ss, 16); ss += __shfl_xor(ss, 32);
                if (fq == 0) ssq[row * 16 + u.pn * 4 + wc] = ss;
            }
    }
};
namespace pg8 {
#define PG8_LAS __attribute__((address_space(3)))
constexpr int BM = 256, BK = 64, HALF = 128, HTB = HALF * BK * 2  , STAGE_BYTES = 8 * HTB, NXCD = 8, WGM = 8;
__host__ __device__ __forceinline__ int lds_byte(int r, int c) { const int st = (r >> 4) * 2 + (c >> 5), rr = r & 15, cc = c & 31, ob = rr * 64 + cc * 2; return st * 1024 + (ob ^ (((ob >> 9) & 1) << 5)); }
__host__ __device__ __forceinline__ void stage_rc(int b, int& R, int& C) { const int st = b / 1024, sb = b % 1024, swz = sb ^ (((sb >> 9) & 1) << 5); R = (st >> 1) * 16 + swz / 64; C = (st & 1) * 32 + (swz % 64) / 2; }
struct StaticOrder {
    int nM, nN, nwg, G, c;
    __host__ __device__ void init(int M, int N, int G_, int c_) { nM = M / BM; nN = N / BM; nwg = nM * nN; G = G_; c = c_; }
    __host__ __device__ bool next(int i, Unit& u) const {
        const long L = (long)i * G + c; if (L >= nwg) return false;
        int wgid = (int)L; { const int q = nwg / NXCD, r = nwg % NXCD, xcd = wgid % NXCD, off = wgid / NXCD; wgid = (xcd < r ? xcd * (q + 1) : r * (q + 1) + (xcd - r) * q) + off; }
        const int nig = WGM * nN, gid = wgid / nig, fm = gid * WGM, gsz = (nM - fm) < WGM ? (nM - fm) : WGM;
        u.pm = fm + ((wgid % nig) % gsz); u.pn = (wgid % nig) / gsz; return true;
    }
    __device__ __forceinline__ void a_ready(const Unit&) const {}
    __device__ __forceinline__ void done(const Unit&) const {}
};
struct ComboOrder {
    StaticOrder so;
    __host__ __device__ void init(int G_, int c_) { so.init(T, 1024, G_, c_); }
    __host__ __device__ bool next(int i, Unit& u) const {
        const long L = (long)i * so.G + so.c;
        if (L < so.nwg) { so.next(i, u); u.pm += TILE_HN; u.pn = u.pn < 3 ? u.pn + 4 : 14; return true; }
        const int j = (int)(L - so.nwg); if (j >= 128) return false;
        const int l = j >> 6, jj = j & 63;
        if (jj < 32) { u.pm = TILE_MEMN + (jj >> 1); u.pn = TILE_WKV + 4 * l + (jj & 1); }
        else { const int q = jj - 32; u.pm = TILE_WKV + 4 * l + 2 + (q >> 4); u.pn = TILE_MEMN + (q & 15); }
        return true;
    }
    __device__ __forceinline__ void a_ready(const Unit&) const {}
    __device__ __forceinline__ void done(const Unit&) const {}
};
template <class Epi, class Sched, bool ALIGN_EPI = false, bool SP2 = false, int QM = 0  >
__device__ __forceinline__ void gemm_phase(PG8_LAS unsigned char* lds, const Gemm g, const Sched& S, const Epi& E) {
    const int tid = otid(), wid = __builtin_amdgcn_readfirstlane(tid >> 6), lane = tid & 63, wr = wid >> 2, wc = wid & 3, fr = lane & 15, fq = lane >> 4;
    constexpr bool FP8 = (QM == 1), I8 = (QM == 2);
    const int K = g.K, nt = K / BK;
    unsigned voffA[2], voffB[2];
#pragma unroll
    for (int i = 0; i < 2; ++i) { int R, C; stage_rc(tid * 16 + i * 8192, R, C); const int Rb = Epi::PERM ? ((R & ~31) + perm32(R & 31)) : R;
        voffA[i] = (unsigned)(R * K + C) * 2u; voffB[i] = (unsigned)(Rb * K + C) * 2u; }
    const size_t kstep = (size_t)(BK * 2);
    const size_t hstep = (size_t)HALF * K * 2;
    const size_t tstep = 2 * hstep;
    const unsigned ldsw = (unsigned)wid * 1024u;
    const int aoff = lds_byte(wr * 64 + fr, fq * 8), boff = lds_byte(wc * 32 + fr, fq * 8);
#define PG8_SA(b, h) (((b) * 2 + (h)) * HTB)
#define PG8_SB(b, h) ((4 + (b) * 2 + (h)) * HTB)
#define PG8_STAGE(bufoff, gbase, voff) do { _Pragma("unroll") for (int _i = 0; _i < 2; ++_i) \
        __builtin_amdgcn_global_load_lds((const unsigned*)((const char*)(gbase) + (voff)[_i]), (PG8_LAS unsigned*)(lds + (bufoff) + ldsw + _i * 8192), 16, 0, 0); } while (0)
#define PG8_LD16(off) (*(const PG8_LAS bf16x8*)(lds + (off)))
#define PG8_LDA(dst, b, h) do { _Pragma("unroll") for (int m = 0; m < 4; ++m) { \
        if constexpr (FP8) dst##8[m] = PG8_CAT(PG8_LD16(PG8_SA(b, h) + aoff + m * 2048), PG8_LD16(PG8_SA(b, h) + aoff + m * 2048 + 1024)); \
        else { _Pragma("unroll") for (int k = 0; k < 2; ++k) dst[m][k] = PG8_LD16(PG8_SA(b, h) + aoff + m * 2048 + k * 1024); } } } while (0)
#define PG8_LDB(dst, b, h) do { _Pragma("unroll") for (int n = 0; n < 2; ++n) { \
        if constexpr (FP8) dst##8[n] = PG8_CAT(PG8_LD16(PG8_SB(b, h) + boff + n * 2048), PG8_LD16(PG8_SB(b, h) + boff + n * 2048 + 1024)); \
        else { _Pragma("unroll") for (int k = 0; k < 2; ++k) dst[n][k] = PG8_LD16(PG8_SB(b, h) + boff + n * 2048 + k * 1024); } } } while (0)
#define PG8_CAT(x, y) __builtin_shufflevector(__builtin_bit_cast(i32x4v, x), __builtin_bit_cast(i32x4v, y), 0, 1, 2, 3, 4, 5, 6, 7)
#define PG8_MMA(ai, bj, At, Bt) do { __builtin_amdgcn_s_setprio(1); \
        if constexpr (FP8) { _Pragma("unroll") for (int m = 0; m < 4; ++m) _Pragma("unroll") for (int n = 0; n < 2; ++n) \
            asm("v_mfma_f32_16x16x128_f8f6f4 %0, %1, %2, %0" : "+v"(acc[ai][bj][m][n]) : "v"(Bt##8[n]), "v"(At##8[m])); } \
        else if constexpr (I8) { _Pragma("unroll") for (int m = 0; m < 4; ++m) _Pragma("unroll") for (int n = 0; n < 2; ++n) _Pragma("unroll") for (int k = 0; k < 2; ++k) \
            acc[ai][bj][m][n] = __builtin_bit_cast(f32x4, __builtin_amdgcn_mfma_i32_16x16x64_i8(__builtin_bit_cast(i32x4v, Bt[n][k]), __builtin_bit_cast(i32x4v, At[m][k]), __builtin_bit_cast(i32x4v, acc[ai][bj][m][n]), 0, 0, 0)); } \
        else { _Pragma("unroll") for (int m = 0; m < 4; ++m) _Pragma("unroll") for (int n = 0; n < 2; ++n) _Pragma("unroll") for (int k = 0; k < 2; ++k) \
            acc[ai][bj][m][n] = __builtin_amdgcn_mfma_f32_16x16x32_bf16(Bt[n][k], At[m][k], acc[ai][bj][m][n], 0, 0, 0); } \
        __builtin_amdgcn_s_setprio(0); } while (0)
#define PG8_WAIT_V(n) asm volatile("s_waitcnt vmcnt(" #n ")" ::: "memory")
#define PG8_WAIT_L(n) asm volatile("s_waitcnt lgkmcnt(" #n ")" ::: "memory")
#define PG8_BAR __builtin_amdgcn_s_barrier()
#define PG8_SCHED __builtin_amdgcn_sched_barrier(0)
    Unit cur, nxt; int ui = 0;
    if (!S.next(0, cur)) return;
    f32x4 acc[2][2][4][2];
#pragma unroll
    for (int a = 0; a < 2; ++a)
#pragma unroll
        for (int b = 0; b < 2; ++b)
#pragma unroll
            for (int m = 0; m < 4; ++m)
#pragma unroll
                for (int n = 0; n < 2; ++n) acc[a][b][m][n] = (f32x4){0.f, 0.f, 0.f, 0.f};
    bf16x8 At[4][2], B0[2][2], B1[2][2];
    i32x8v At8[4], B08[2], B18[2];
    const char* cA = (const char*)g.A + (size_t)cur.pm * tstep; const char* cB = (const char*)g.Bt + (size_t)cur.pn * tstep;
    S.a_ready(cur);
    if constexpr (SP2) {
        PG8_STAGE(PG8_SB(0, 0), cB, voffB); PG8_STAGE(PG8_SB(0, 1), cB + hstep, voffB); PG8_STAGE(PG8_SA(0, 0), cA, voffA); PG8_STAGE(PG8_SA(0, 1), cA + hstep, voffA);
        if (wr == 1) PG8_BAR;
        PG8_WAIT_V(2); PG8_BAR;
        PG8_STAGE(PG8_SB(1, 0), cB + kstep, voffB); PG8_STAGE(PG8_SA(1, 0), cA + kstep, voffA); PG8_STAGE(PG8_SB(1, 1), cB + hstep + kstep, voffB);
        PG8_WAIT_V(6); PG8_BAR;
    } else {
        PG8_STAGE(PG8_SB(0, 0), cB, voffB); PG8_STAGE(PG8_SA(0, 0), cA, voffA); PG8_STAGE(PG8_SB(0, 1), cB + hstep, voffB); PG8_STAGE(PG8_SA(0, 1), cA + hstep, voffA);
        if (wr == 1) PG8_BAR;
        PG8_WAIT_V(4); PG8_BAR;
        PG8_STAGE(PG8_SB(1, 0), cB + kstep, voffB); PG8_STAGE(PG8_SA(1, 0), cA + kstep, voffA); PG8_STAGE(PG8_SB(1, 1), cB + hstep + kstep, voffB);
        PG8_WAIT_V(6); PG8_BAR;
    }
    for (;;) {
        const bool has_next = S.next(ui + 1, nxt);
        const char* nA = has_next ? (const char*)g.A + (size_t)nxt.pm * tstep : cA; const char* nB = has_next ? (const char*)g.Bt + (size_t)nxt.pn * tstep : cB;
        for (int t = 0; t < nt; t += 2) {
            const bool last = (t == nt - 2);
            if constexpr (FP8) __builtin_amdgcn_s_waitcnt(0xC07F);
            const char* a1 = cA + (size_t)(t + 1) * kstep;
            const char* a2 = last ? nA : cA + (size_t)(t + 2) * kstep; const char* b2 = last ? nB : cB + (size_t)(t + 2) * kstep;
            const char* a3 = a2 + kstep; const char* b3 = b2 + kstep;
            if (last && has_next) S.a_ready(nxt);
            if constexpr (SP2) {
            PG8_LDB(B0, 0, 0); PG8_LDB(B1, 0, 1); PG8_SCHED; PG8_LDA(At, 0, 0); PG8_STAGE(PG8_SA(1, 1), a1 + hstep, voffA);
            PG8_WAIT_V(8); PG8_WAIT_L(0); PG8_BAR; PG8_MMA(0, 0, At, B0); PG8_MMA(0, 1, At, B1); PG8_BAR; PG8_SCHED;
            PG8_LDA(At, 0, 1); PG8_STAGE(PG8_SB(0, 0), b2, voffB); PG8_STAGE(PG8_SB(0, 1), b2 + hstep, voffB); PG8_STAGE(PG8_SA(0, 0), a2, voffA);
            PG8_WAIT_V(8); PG8_WAIT_L(0); PG8_BAR; PG8_MMA(1, 0, At, B0); PG8_MMA(1, 1, At, B1); PG8_BAR; PG8_SCHED;
            PG8_LDB(B0, 1, 0); PG8_LDB(B1, 1, 1); PG8_SCHED; PG8_LDA(At, 1, 0); PG8_STAGE(PG8_SA(0, 1), a2 + hstep, voffA);
            PG8_WAIT_V(8); PG8_WAIT_L(0); PG8_BAR; PG8_MMA(0, 0, At, B0); PG8_MMA(0, 1, At, B1); PG8_BAR; PG8_SCHED;
            PG8_LDA(At, 1, 1); PG8_STAGE(PG8_SB(1, 0), b3, voffB); PG8_STAGE(PG8_SB(1, 1), b3 + hstep, voffB); PG8_STAGE(PG8_SA(1, 0), a3, voffA);
            PG8_WAIT_V(8); PG8_WAIT_L(0); PG8_BAR; PG8_MMA(1, 0, At, B0); PG8_MMA(1, 1, At, B1); PG8_BAR; PG8_SCHED;
            } else {
            PG8_LDB(B0, 0, 0); PG8_SCHED; PG8_LDA(At, 0, 0); PG8_STAGE(PG8_SA(1, 1), a1 + hstep, voffA);
            PG8_WAIT_L(8); PG8_BAR; PG8_WAIT_L(0); PG8_MMA(0, 0, At, B0); PG8_BAR; PG8_SCHED;
            PG8_LDB(B1, 0, 1); PG8_STAGE(PG8_SB(0, 0), b2, voffB);
            PG8_BAR; PG8_WAIT_L(0); PG8_MMA(0, 1, At, B1); PG8_BAR;
            PG8_LDA(At, 0, 1); PG8_STAGE(PG8_SA(0, 0), a2, voffA);
            PG8_BAR; PG8_WAIT_L(0); PG8_MMA(1, 0, At, B0); PG8_BAR; PG8_SCHED;
            PG8_STAGE(PG8_SB(0, 1), b2 + hstep, voffB);
            PG8_WAIT_V(6); PG8_BAR; PG8_MMA(1, 1, At, B1); PG8_BAR;
            PG8_LDB(B0, 1, 0); PG8_SCHED; PG8_LDA(At, 1, 0); PG8_STAGE(PG8_SA(0, 1), a2 + hstep, voffA);
            PG8_WAIT_L(8); PG8_BAR; PG8_WAIT_L(0); PG8_MMA(0, 0, At, B0); PG8_BAR; PG8_SCHED;
            PG8_LDB(B1, 1, 1); PG8_STAGE(PG8_SB(1, 0), b3, voffB);
            PG8_BAR; PG8_WAIT_L(0); PG8_MMA(0, 1, At, B1); PG8_BAR;
            PG8_LDA(At, 1, 1); PG8_STAGE(PG8_SA(1, 0), a3, voffA);
            PG8_BAR; PG8_WAIT_L(0); PG8_MMA(1, 0, At, B0); PG8_BAR; PG8_SCHED;
            PG8_STAGE(PG8_SB(1, 1), b3 + hstep, voffB);
            PG8_WAIT_V(6); PG8_BAR; PG8_MMA(1, 1, At, B1); PG8_BAR;
            }
        }
        if constexpr (FP8) asm volatile("s_nop 15\n\ts_nop 15" ::: "memory");
        if constexpr (ALIGN_EPI) { if (wr == 0) PG8_BAR; }
        if constexpr (!Epi::AFTER_DRAIN) { E(acc, cur, wr, wc, fr, fq); S.done(cur); }
        if (!has_next) break;
#pragma unroll
        for (int a = 0; a < 2; ++a)
#pragma unroll
            for (int b = 0; b < 2; ++b)
#pragma unroll
                for (int m = 0; m < 4; ++m)
#pragma unroll
                    for (int n = 0; n < 2; ++n) acc[a][b][m][n] = (f32x4){0.f, 0.f, 0.f, 0.f};
        cur = nxt; cA = nA; cB = nB; ++ui;
        if constexpr (ALIGN_EPI) { if (wr == 1) PG8_BAR; }
    }
    PG8_WAIT_V(0);
    if constexpr (!ALIGN_EPI) { if (wr == 0) PG8_BAR; }
    PG8_BAR;
    if constexpr (Epi::AFTER_DRAIN) { E.fused(acc, cur, wr, wc, fr, fq, lds, wid, lane); S.done(cur); }
#undef PG8_SA
#undef PG8_SB
#undef PG8_STAGE
#undef PG8_LDA
#undef PG8_LD16
#undef PG8_LDB
#undef PG8_MMA
#undef PG8_CAT
#undef PG8_WAIT_V
#undef PG8_WAIT_L
#undef PG8_BAR
#undef PG8_SCHED
}
}

template <class Epi, int QM = 0>
__device__ __forceinline__ void run_gemm(const Gemm g, const Epi& E, LAS float* lds, int vb, int nvb) {
    pg8::StaticOrder S; S.init(g.M, g.N, nvb, vb);
    pg8::gemm_phase<Epi, pg8::StaticOrder, true, true, QM>((LAS unsigned char*)lds, g, S, E);
}

enum { MAP_ID = 0, MAP_WIN = 1, MAP_GU = 2, MAP_WIN8 = 3   };
struct PrepJob { const float* W; int K, N; const float* gain; bf16_t* dst; int r0, r1, ldd, koff, map; int fmt; float osc; };
__device__ __forceinline__ int map_src(int map, int r, int N) {
    if (map == MAP_ID) return r < N ? r : -1;
    if (map == MAP_WIN) {
        if (r < 1728) return r - 512;
        if (r < 3776) return r - 504;
        if (r < 3784) return r - 2560;
        return -1;
    }
    if (map == MAP_WIN8) return r + 264;
    { const int tile = r >> 8, w = r & 255, j = tile * 128 + (w & 127); return w < 128 ? j : FF + j; }
}
__device__ __forceinline__ void prep_tile_load(const PrepJob& j, int t, f32x4 (&v)[8]) {
    const int nkt = j.K / 64, kt = t % nkt, rt = t / nkt, k0 = kt * 64, r0 = j.r0 + rt * 256;
#pragma unroll
    for (int q = 0; q < 8; ++q) {
        const int i = (int)threadIdx.x + q * NTHREADS, kk = i >> 6, r4 = (i & 63) * 4;
        const int sc = map_src(j.map, r0 + r4, j.N);
        v[q] = sc >= 0 ? __builtin_nontemporal_load((const f32x4*)(j.W + (size_t)(k0 + kk) * j.N + sc)) : (f32x4){0.f, 0.f, 0.f, 0.f};
        if (j.gain) v[q] = v[q] * j.gain[k0 + kk];
    }
}
__device__ __forceinline__ void prep_tile_store(const PrepJob& j, int t, const f32x4 (&v)[8], LAS float* tile  ) {
    const int nkt = j.K / 64, kt = t % nkt, rt = t / nkt, k0 = kt * 64, r0 = j.r0 + rt * 256;
    __syncthreads();
#pragma unroll
    for (int q = 0; q < 8; ++q) { const int i = (int)threadIdx.x + q * NTHREADS, kk = i >> 6, r4 = (i & 63) * 4; *(LAS f32x4*)(tile + kk * 260 + r4) = v[q]; }
    __syncthreads();
#pragma unroll
    for (int q = 0; q < 4; ++q) {
        const int i = (int)threadIdx.x + q * NTHREADS, rr = i & 255, c8 = i >> 8;
        const LAS float* tp = tile + (c8 * 8) * 260 + rr;
        if (j.fmt != 0) {
            const float sc = j.osc; u32x2 w;
            if (j.fmt == 1 || j.fmt == 3) { w.x = pk4_f8(tp[0] * sc, tp[260] * sc, tp[520] * sc, tp[780] * sc); w.y = pk4_f8(tp[1040] * sc, tp[1300] * sc, tp[1560] * sc, tp[1820] * sc); }
            else { w.x = pk4_i8(tp[0], tp[260], tp[520], tp[780], sc); w.y = pk4_i8(tp[1040], tp[1300], tp[1560], tp[1820], sc); }
            unsigned char* drow = (unsigned char*)j.dst + (size_t)(r0 + rr) * j.ldd + j.koff; const int kk = k0 + c8 * 8;
            if (j.fmt == 3) { const int r = kk & 127, pp = (kk & ~127) + (r >> 5) * 16 + ((r >> 3) & 3) * 4; *(unsigned*)(drow + pp) = w.x; *(unsigned*)(drow + pp + 64) = w.y; }
            else *(u32x2*)(drow + (j.fmt == 2 ? kperm8(kk) : kk)) = w;
        } else {
        u32x4 w; w.x = pk2(tp[0], tp[260]); w.y = pk2(tp[520], tp[780]); w.z = pk2(tp[1040], tp[1300]); w.w = pk2(tp[1560], tp[1820]);
        *(u32x4*)(j.dst + (size_t)(r0 + rr) * j.ldd + j.koff + k0 + c8 * 8) = w;
        }
    }
}
__device__ __forceinline__ void prep_fold_in(const float* w_in  , const float* w_uk  , const float* gain, bf16_t* dst, LAS float* lds, int vb, int nvb) {
    LAS float* A = lds; LAS float* B = lds + 32 * 65;
    const int tid = otid(), lane = tid & 63, wid = __builtin_amdgcn_readfirstlane(tid >> 6), l15 = lane & 15, dq = lane >> 4;
    for (int item = vb; item < 256; item += nvb) {
        const int h = item >> 5, k0 = (item & 31) * 32;
        __syncthreads();
        for (int i = tid; i < 2048; i += NTHREADS) { const int kk = i >> 6, d = i & 63; A[kk * 65 + d] = w_in[(size_t)(k0 + kk) * 3272 + h * 64 + d] * gain[k0 + kk]; }
        for (int i = tid; i < 8192; i += NTHREADS) { const int c = i >> 6, d = i & 63; B[c * 65 + d] = w_uk[(size_t)(h * 128 + c) * 64 + d]; }
        __syncthreads();
        f32x4 acc0 = (f32x4){0.f, 0.f, 0.f, 0.f}, acc1 = acc0;
#pragma unroll 4
        for (int d0 = 0; d0 < 64; d0 += 4) {
            const float b = B[(16 * wid + l15) * 65 + d0 + dq], a0 = A[l15 * 65 + d0 + dq], a1 = A[(16 + l15) * 65 + d0 + dq];
            acc0 = __builtin_amdgcn_mfma_f32_16x16x4f32(a0, b, acc0, 0, 0, 0);
            acc1 = __builtin_amdgcn_mfma_f32_16x16x4f32(a1, b, acc1, 0, 0, 0);
        }
        unsigned char* drow = (unsigned char*)dst + (size_t)(h * 128 + 16 * wid + l15) * 1024 + k0 + 4 * dq;
        *(unsigned*)drow = pk4_i8(acc0[0], acc0[1], acc0[2], acc0[3], WQ_GU);
        *(unsigned*)(drow + 16) = pk4_i8(acc1[0], acc1[1], acc1[2], acc1[3], WQ_GU);
    }
}
__device__ __forceinline__ void prep_fold_out(const float* w_out  , const float* w_uv  , bf16_t* dst  , LAS float* lds, int vb, int nvb) {
    LAS float* A = lds; LAS float* B = lds + 64 * 33;
    const int tid = otid(), lane = tid & 63, wid = __builtin_amdgcn_readfirstlane(tid >> 6), l15 = lane & 15, dq = lane >> 4;
    for (int item = vb; item < 256; item += nvb) {
        const int h = item >> 5, n0 = (item & 31) * 32;
        __syncthreads();
        for (int i = tid; i < 2048; i += NTHREADS) { const int d = i >> 5, nn = i & 31; A[d * 33 + nn] = w_out[(size_t)(h * 64 + d) * 1024 + n0 + nn]; }
        for (int i = tid; i < 8192; i += NTHREADS) { const int c = i >> 6, d = i & 63; B[c * 65 + d] = w_uv[(size_t)(h * 128 + c) * 64 + d]; }
        __syncthreads();
        f32x4 acc0 = (f32x4){0.f, 0.f, 0.f, 0.f}, acc1 = acc0;
#pragma unroll 4
        for (int d0 = 0; d0 < 64; d0 += 4) {
            const float a = B[(16 * wid + l15) * 65 + d0 + dq], b0 = A[(d0 + dq) * 33 + l15], b1 = A[(d0 + dq) * 33 + 16 + l15];
            acc0 = __builtin_amdgcn_mfma_f32_16x16x4f32(a, b0, acc0, 0, 0, 0);
            acc1 = __builtin_amdgcn_mfma_f32_16x16x4f32(a, b1, acc1, 0, 0, 0);
        }
        { u32x2 w; w.x = pk2(acc0[0], acc0[1]); w.y = pk2(acc0[2], acc0[3]); *(u32x2*)(dst + (size_t)(n0 + l15) * KOUT + h * 128 + 16 * wid + 4 * dq) = w; }
        { u32x2 w; w.x = pk2(acc1[0], acc1[1]); w.y = pk2(acc1[2], acc1[3]); *(u32x2*)(dst + (size_t)(n0 + 16 + l15) * KOUT + h * 128 + 16 * wid + 4 * dq) = w; }
    }
}
__device__ __forceinline__ void prep_lb(const float* hgrn_lb  , float* lb, int vb, int nvb) {
    for (int i = vb * NTHREADS + threadIdx.x; i < 512; i += nvb * NTHREADS) {
        const float a = hgrn_lb[i], b = hgrn_lb[512 + i], c = hgrn_lb[1024 + i], m = fmaxf(a, fmaxf(b, c));
        const float ea = __expf(a - m), eb = __expf(b - m), ec = __expf(c - m);
        lb[i] = ea / (ea + eb + ec);
    }
}

__device__ __forceinline__ void rmsnorm_rows(const float* X, bf16_t* Y, int nrows, int vb, int nvb) {
    const int tid = otid(), lane = tid & 63, gw = vb * NWAVES + __builtin_amdgcn_readfirstlane(tid >> 6), ngw = nvb * NWAVES;
    for (int r = gw; r < nrows; r += ngw) {
        const f32x4* xr = (const f32x4*)(X + (size_t)r * D) + lane;
        f32x4 v[4]; float s = 0.f;
#pragma unroll
        for (int j = 0; j < 4; ++j) { v[j] = xr[64 * j]; s += (v[j].x * v[j].x + v[j].y * v[j].y) + (v[j].z * v[j].z + v[j].w * v[j].w); }
        const float rs = rsqrtf(wave_sum(s) * (1.f / D) + EPS);
        u32x2* o = (u32x2*)(Y + (size_t)r * D) + lane;
#pragma unroll
        for (int j = 0; j < 4; ++j) { u32x2 w; w.x = pk2(v[j].x * rs, v[j].y * rs); w.y = pk2(v[j].z * rs, v[j].w * rs); o[64 * j] = w; }
    }
}
__device__ __forceinline__ void x_to_h_rows(const float* X, bf16_t* H, unsigned char* X8, float* ssq, int vb, int nvb) {
    const int tid = otid(), lane = tid & 63, gw = vb * NWAVES + __builtin_amdgcn_readfirstlane(tid >> 6), ngw = nvb * NWAVES;
    for (int r = gw; r < T; r += 2 * ngw) {
        const int r2 = (r + ngw < T) ? r + ngw : r;
        f32x4 v[2][4];
#pragma unroll
        for (int j = 0; j < 4; ++j) { v[0][j] = __builtin_nontemporal_load((const f32x4*)(X + (size_t)r * D) + lane + 64 * j); v[1][j] = __builtin_nontemporal_load((const f32x4*)(X + (size_t)r2 * D) + lane + 64 * j); }
#pragma unroll
        for (int q = 0; q < 2; ++q) {
            const int rr = q ? r2 : r;
            u32x2* o = (u32x2*)(H + (size_t)rr * D) + lane;
            float s = 0.f;
#pragma unroll
            for (int j = 0; j < 4; ++j) { const f32x4 x = v[q][j]; u32x2 w; w.x = pk2(x.x, x.y); w.y = pk2(x.z, x.w); o[64 * j] = w;
                *((unsigned*)(X8 + (size_t)rr * D) + lane + 64 * j) = pk4_i8(x.x, x.y, x.z, x.w, HQ_X);
                const float a = bf2f((unsigned short)(w.x & 0xffffu)), b = bf2f((unsigned short)(w.x >> 16)), c = bf2f((unsigned short)(w.y & 0xffffu)), d = bf2f((unsigned short)(w.y >> 16));
                s += (a * a + b * b) + (c * c + d * d); }
            s = wave_sum(s);
            if (lane < 16) ssq[(size_t)rr * 16 + lane] = lane == 0 ? s : 0.f;
        }
    }
}
__device__ __forceinline__ void final_rows(const bf16_t* H, const float* ssq, const float* g, float* out, int vb, int nvb) {
    const int tid = otid(), lane = tid & 63, gw = vb * NWAVES + __builtin_amdgcn_readfirstlane(tid >> 6), ngw = nvb * NWAVES;
    f32x4 gg[4];
#pragma unroll
    for (int j = 0; j < 4; ++j) gg[j] = *((const f32x4*)g + lane + 64 * j);
    for (int r = gw; r < T; r += 2 * ngw) {
        const int r2 = (r + ngw < T) ? r + ngw : r;
        u32x2 w[2][4]; float rs[2];
#pragma unroll
        for (int j = 0; j < 4; ++j) { w[0][j] = ((const u32x2*)(H + (size_t)r * D) + lane)[64 * j]; w[1][j] = ((const u32x2*)(H + (size_t)r2 * D) + lane)[64 * j]; }
        rs[0] = row_rstd(ssq, (size_t)r); rs[1] = row_rstd(ssq, (size_t)r2);
#pragma unroll
        for (int q = 0; q < 2; ++q) {
            f32x4* o = (f32x4*)(out + (size_t)(q ? r2 : r) * D) + lane;
#pragma unroll
            for (int j = 0; j < 4; ++j) { const u32x2 ww = w[q][j];
                __builtin_nontemporal_store((f32x4){bf2f((unsigned short)(ww.x & 0xffffu)) * rs[q] * gg[j].x, bf2f((unsigned short)(ww.x >> 16)) * rs[q] * gg[j].y, bf2f((unsigned short)(ww.y & 0xffffu)) * rs[q] * gg[j].z, bf2f((unsigned short)(ww.y >> 16)) * rs[q] * gg[j].w}, o + 64 * j); }
        }
    }
}
__device__ __forceinline__ float row16_sum(float v) {
    v += __uint_as_float((unsigned)__builtin_amdgcn_update_dpp(0, (int)__float_as_uint(v), 0x128, 0xf, 0xf, false));
    v += __uint_as_float((unsigned)__builtin_amdgcn_update_dpp(0, (int)__float_as_uint(v), 0x124, 0xf, 0xf, false));
    v += __uint_as_float((unsigned)__builtin_amdgcn_update_dpp(0, (int)__float_as_uint(v), 0x122, 0xf, 0xf, false));
    v += __uint_as_float((unsigned)__builtin_amdgcn_update_dpp(0, (int)__float_as_uint(v), 0x121, 0xf, 0xf, false));
    return v;
}
__device__ __forceinline__ void cnorm_rows(const bf16_t* P, const float* lat_g, bf16_t* CN, int vb, int nvb) {
    const int tid = otid(), lane = tid & 63, gw = vb * NWAVES + __builtin_amdgcn_readfirstlane(tid >> 6), ngw = nvb * NWAVES, r4 = lane >> 4, l16 = lane & 15;
    const f32x4 ga = *(const f32x4*)(lat_g + l16 * 8), gb = *(const f32x4*)(lat_g + l16 * 8 + 4);
    for (int r = gw * 8; r < T; r += ngw * 8) {
        u32x4 w[2];
#pragma unroll
        for (int q = 0; q < 2; ++q) w[q] = *(const u32x4*)(P + (size_t)(r + 4 * q + r4) * PW + P_C + l16 * 8);
#pragma unroll
        for (int q = 0; q < 2; ++q) {
            const float x0 = bf2f((unsigned short)(w[q].x & 0xffffu)), x1 = bf2f((unsigned short)(w[q].x >> 16)), x2 = bf2f((unsigned short)(w[q].y & 0xffffu)), x3 = bf2f((unsigned short)(w[q].y >> 16));
            const float x4 = bf2f((unsigned short)(w[q].z & 0xffffu)), x5 = bf2f((unsigned short)(w[q].z >> 16)), x6 = bf2f((unsigned short)(w[q].w & 0xffffu)), x7 = bf2f((unsigned short)(w[q].w >> 16));
            const float ss = row16_sum(((x0 * x0 + x1 * x1) + (x2 * x2 + x3 * x3)) + ((x4 * x4 + x5 * x5) + (x6 * x6 + x7 * x7)));
            const float rs = rsqrtf(ss * (1.f / 128.f) + EPS);
            u32x4 o; o.x = pk2(x0 * rs * ga.x, x1 * rs * ga.y); o.y = pk2(x2 * rs * ga.z, x3 * rs * ga.w); o.z = pk2(x4 * rs * gb.x, x5 * rs * gb.y); o.w = pk2(x6 * rs * gb.z, x7 * rs * gb.w);
            *(u32x4*)(CN + (size_t)(r + 4 * q + r4) * 128 + l16 * 8) = o;
        }
    }
}
__device__ __forceinline__ int t5_bucket(int rel) {
    const int n = rel < 0 ? -rel : rel;
    int b = n < 8 ? n : 8 + (n >= 12) + (n >= 16) + (n >= 23) + (n >= 32) + (n >= 46) + (n >= 64) + (n >= 91);
    return b + (rel > 0 ? 16 : 0);
}
__device__ __forceinline__ unsigned sort_key(float x) { const unsigned u = __float_as_uint(x); return (u & 0x80000000u) ? ~u : (u | 0x80000000u); }


template <int CTRL, int ROWMASK> __device__ __forceinline__ unsigned dpp0(unsigned v) { return (unsigned)__builtin_amdgcn_update_dpp(0, (int)v, CTRL, ROWMASK, 0xf, false); }
__device__ __forceinline__ unsigned wave_prefix_incl(unsigned v) {
    v += dpp0<0x111, 0xf>(v); v += dpp0<0x112, 0xf>(v); v += dpp0<0x114, 0xf>(v); v += dpp0<0x118, 0xf>(v);
    v += dpp0<0x142, 0xa>(v);
    v += dpp0<0x143, 0xc>(v);
    return v;
}
__device__ __forceinline__ float wave_max_u(float v) {
    v = fmaxf(v, __uint_as_float((unsigned)__builtin_amdgcn_update_dpp(0, (int)__float_as_uint(v), 0x128, 0xf, 0xf, false)));
    v = fmaxf(v, __uint_as_float((unsigned)__builtin_amdgcn_update_dpp(0, (int)__float_as_uint(v), 0x124, 0xf, 0xf, false)));
    v = fmaxf(v, __uint_as_float((unsigned)__builtin_amdgcn_update_dpp(0, (int)__float_as_uint(v), 0x122, 0xf, 0xf, false)));
    v = fmaxf(v, __uint_as_float((unsigned)__builtin_amdgcn_update_dpp(0, (int)__float_as_uint(v), 0x121, 0xf, 0xf, false)));
    const int b = (int)__float_as_uint(v);
    return fmaxf(fmaxf(__uint_as_float((unsigned)__builtin_amdgcn_readlane(b, 0)), __uint_as_float((unsigned)__builtin_amdgcn_readlane(b, 16))),
                 fmaxf(__uint_as_float((unsigned)__builtin_amdgcn_readlane(b, 32)), __uint_as_float((unsigned)__builtin_amdgcn_readlane(b, 48))));
}

typedef short v4i16_t __attribute__((ext_vector_type(4)));
constexpr int DSA_BT_OFF = 131072 + 256, DSA_WS_OFF = DSA_BT_OFF + 6144;
__device__ __forceinline__ unsigned dsa_bucket(float x, float lo, float sc) { const float f = (x - lo) * sc; const unsigned b = (unsigned)f; return b > 255u ? 255u : b; }
__device__ __forceinline__ unsigned off_b(unsigned row, unsigned ch) { return 256u * row + 16u * (ch ^ (((row & 3) << 2) | ((row >> 2) & 3))); }
__device__ __forceinline__ void dsa_mfma_phase(const bf16_t* P, const bf16_t* CN, const float* rel_bias, bf16_t* CAT, LAS unsigned char* lds, unsigned* qctr) {
    const int tid = otid(), lane = tid & 63, wid = __builtin_amdgcn_readfirstlane(tid >> 6);
    LAS float* BT = (LAS float*)(lds + DSA_BT_OFF);
    __syncthreads();
    for (int i = tid; i < 191 * 8; i += NTHREADS) { const int rel = (i >> 3) - 127; BT[i] = rel_bias[t5_bucket(rel) * 8 + (i & 7)]; }
    const unsigned long long lt_mask = (lane == 0) ? 0ull : (~0ull >> (64 - lane));
    volatile LAS int* qslot = (volatile LAS int*)(lds + 131072 + 64);
    int nxt = 0;
    if (tid == 0) { *qslot = (int)atomicAdd(qctr, 1u); nxt = (int)atomicAdd(qctr, 1u); }
    for (;;) {
        __syncthreads();
        const int u = *qslot;
        if (u >= T / 16) break;
        const int b = u & 15, qg = 127 - (u >> 4), t0 = qg * 16, nj = t0 / CHUNK + 1, L = nj * CHUNK, nt = L / 32;
        const bf16_t* Pb = P + (size_t)b * SEQ * PW;
        {
            int ln1 = lane; asm volatile("" : "+v"(ln1));
            const int rho = ln1 & 31, hf = ln1 >> 5;
            const int qq = 2 * ((rho >> 2) & 1) + (rho >> 4), hh = 4 * ((rho >> 3) & 1) + (rho & 3);
            bf16x8 qa[4][4], wa[4], wc[4];
#pragma unroll
            for (int qd = 0; qd < 4; ++qd) {
                const bf16_t* qrow = Pb + (size_t)(t0 + 4 * qd + qq) * PW + P_QI + hh * 64 + 8 * hf;
#pragma unroll
                for (int ks = 0; ks < 4; ++ks) qa[qd][ks] = *(const bf16x8*)(qrow + ks * 16);
                wa[qd] = *(const bf16x8*)(Pb + (size_t)(t0 + 4 * qd + 2 * hf) * PW + P_WI); wc[qd] = *(const bf16x8*)(Pb + (size_t)(t0 + 4 * qd + 2 * hf + 1) * PW + P_WI);
            }
            LAS float* sc0 = (LAS float*)lds + (2 * hf) * 2048 + rho;
            const bf16_t* kbase = Pb + (size_t)rho * PW + P_KI + 8 * hf;
            bf16x8 kb[4], kn[4];
#pragma unroll
            for (int ks = 0; ks < 4; ++ks) { kb[ks] = (bf16x8){0, 0, 0, 0, 0, 0, 0, 0}; kn[ks] = kb[ks]; }
            if (wid < nt) {
#pragma unroll
                for (int ks = 0; ks < 4; ++ks) kb[ks] = *(const bf16x8*)(kbase + (size_t)wid * 32 * PW + ks * 16);
            }
            for (int kt = wid; kt < nt; kt += 8) {
                if (kt + 8 < nt) {
#pragma unroll
                    for (int ks = 0; ks < 4; ++ks) kn[ks] = *(const bf16x8*)(kbase + (size_t)(kt + 8) * 32 * PW + ks * 16);
                }
#pragma unroll
                for (int qd = 0; qd < 4; ++qd) {
                    f32x16 acc;
#pragma unroll
                    for (int r = 0; r < 16; ++r) acc[r] = 0.f;
#pragma unroll
                    for (int ks = 0; ks < 4; ++ks) acc = __builtin_amdgcn_mfma_f32_32x32x16_bf16(qa[qd][ks], kb[ks], acc, 0, 0, 0);
                    float s0 = 0.f, s1 = 0.f;
#pragma unroll
                    for (int e = 0; e < 8; ++e) { s0 += bf2f((unsigned short)wa[qd][e]) * fmaxf(acc[e], 0.f); s1 += bf2f((unsigned short)wc[qd][e]) * fmaxf(acc[8 + e], 0.f); }
                    sc0[(4 * qd) * 2048 + kt * 32] = s0 * (0.35355339059327373f * 0.125f); sc0[(4 * qd + 1) * 2048 + kt * 32] = s1 * (0.35355339059327373f * 0.125f);
                }
#pragma unroll
                for (int ks = 0; ks < 4; ++ks) kb[ks] = kn[ks];
            }
        }
        __syncthreads();
        if (tid == 0) { *qslot = nxt; nxt = (int)atomicAdd(qctr, 1u); }
        LAS unsigned char* pair = lds + wid * 16384;
        LAS unsigned char* wsc = lds + DSA_WS_OFF + wid * 2560;
        LAS unsigned* HIST = (LAS unsigned*)wsc; LAS float* CANDV = (LAS float*)(wsc + 1024); LAS unsigned* CANDI = (LAS unsigned*)(wsc + 1280);
        const int nsel = L < 256 ? L : 256;
        int lna = lane; asm volatile("" : "+v"(lna));
#pragma unroll 1
        for (int e2 = 0; e2 < 2; ++e2) {
            LAS unsigned short* IDX = (LAS unsigned short*)(wsc + 1536 + e2 * 512);
            if (nj > 4) {
                const LAS float* SCq = (const LAS float*)(pair + e2 * 8192);
                float x[32];
#pragma unroll
                for (int j = 0; j < 32; ++j) x[j] = (j < nj) ? SCq[j * 64 + lna] : 0.f;
                float lo = INFINITY, hi = -INFINITY;
#pragma unroll
                for (int j = 0; j < 32; ++j) if (j < nj) { hi = fmaxf(hi, x[j]); lo = fminf(lo, x[j]); }
                hi = wave_max_u(hi); lo = -wave_max_u(-lo);
                bool done = false;
                if (hi > lo) {
                    const float sc = 256.f / (hi - lo);
                    *(LAS u32x4*)(HIST + 4 * lna) = (u32x4){0u, 0u, 0u, 0u};
                    WAVE_LDS_SYNC();
#pragma unroll
                    for (int j = 0; j < 32; ++j) if (j < nj) { const unsigned bk = dsa_bucket(x[j], lo, sc); __hip_atomic_fetch_add(HIST + bk, 1u, __ATOMIC_RELAXED, __HIP_MEMORY_SCOPE_WORKGROUP); }
                    WAVE_LDS_SYNC();
                    const u32x4 h4 = *(const LAS u32x4*)(HIST + 4 * lna);
                    const unsigned cl = (h4.x + h4.y) + (h4.z + h4.w);
                    const unsigned pfx = wave_prefix_incl(cl);
                    const unsigned Sx = (unsigned)__builtin_amdgcn_readlane((int)pfx, 63) - pfx + cl;
                    const int lstar = __popcll(__ballot(Sx >= 256u)) - 1;
                    const unsigned above = Sx - cl, t3 = above + h4.w, t2 = t3 + h4.z, t1 = t2 + h4.y;
                    const unsigned bl = t3 >= 256u ? 3u : (t2 >= 256u ? 2u : (t1 >= 256u ? 1u : 0u));
                    const unsigned al = bl == 3u ? above : (bl == 2u ? t3 : (bl == 1u ? t2 : t1));
                    const unsigned ml = bl == 3u ? h4.w : (bl == 2u ? h4.z : (bl == 1u ? h4.y : h4.x));
                    const unsigned bstar = (unsigned)__builtin_amdgcn_readlane((int)(4u * lna + bl), lstar);
                    const int a = __builtin_amdgcn_readlane((int)al, lstar), m = __builtin_amdgcn_readlane((int)ml, lstar);
                    if (m <= 64) {
                        done = true;
                        const int need = 256 - a;
                        unsigned msel = 0u, mcand = 0u;
#pragma unroll
                        for (int j = 31; j >= 0; --j) if (j < nj) { const unsigned bk = dsa_bucket(x[j], lo, sc); msel = msel + msel + (bk > bstar ? 1u : 0u); mcand = mcand + mcand + (bk == bstar ? 1u : 0u); }
                        const unsigned pk = (unsigned)__popc(msel) | ((unsigned)__popc(mcand) << 16);
                        const unsigned inc = wave_prefix_incl(pk);
                        unsigned off = (inc - pk) & 0xffffu, coff = (inc - pk) >> 16;
                        while (msel) { const int j = __ffs((int)msel) - 1; msel &= msel - 1u; IDX[off++] = (unsigned short)(j * 64 + lna); }
                        while (mcand) { const int j = __ffs((int)mcand) - 1; mcand &= mcand - 1u; CANDV[coff] = SCq[j * 64 + lna]; CANDI[coff] = (unsigned)(j * 64 + lna); ++coff; }
                        WAVE_LDS_SYNC();
                        const float cv = CANDV[lna < m ? lna : 0]; const unsigned ci = CANDI[lna < m ? lna : 0];
                        int rank = 0;
                        for (int k = 0; k < m; ++k) { const float v = __uint_as_float((unsigned)__builtin_amdgcn_readlane((int)__float_as_uint(cv), k)); const unsigned id = (unsigned)__builtin_amdgcn_readlane((int)ci, k); rank += (v > cv || (v == cv && id < ci)) ? 1 : 0; }
                        if (lna < m && rank < need) IDX[a + rank] = (unsigned short)ci;
                    }
                }
                if (!done) {
                    unsigned lo_k = 0xffffffffu, hi_k = 0u;
#pragma unroll
                    for (int j = 0; j < 32; ++j) if (j < nj) { const unsigned kx = sort_key(x[j]); hi_k = kx > hi_k ? kx : hi_k; lo_k = kx < lo_k ? kx : lo_k; }
#pragma unroll
                    for (int o = 1; o < 64; o <<= 1) { const unsigned h2 = (unsigned)__shfl_xor((int)hi_k, o), l2 = (unsigned)__shfl_xor((int)lo_k, o); hi_k = h2 > hi_k ? h2 : hi_k; lo_k = l2 < lo_k ? l2 : lo_k; }
                    lo_k = (unsigned)__builtin_amdgcn_readfirstlane((int)lo_k); hi_k = (unsigned)__builtin_amdgcn_readfirstlane((int)hi_k);
                    bool exact = false;
                    while (lo_k < hi_k) {
                        const unsigned mid = lo_k + ((hi_k - lo_k + 1u) >> 1);
                        int cnt = 0;
#pragma unroll
                        for (int j = 0; j < 32; ++j) cnt += __popcll(__ballot(j < nj && sort_key(x[j]) >= mid));
                        if (cnt == 256) { lo_k = mid; exact = true; break; }
                        if (cnt > 256) lo_k = mid; else hi_k = mid - 1u;
                    }
                    const unsigned Tv = lo_k;
                    int need = 0;
                    if (!exact) { int cgt = 0;
#pragma unroll
                        for (int j = 0; j < 32; ++j) cgt += __popcll(__ballot(j < nj && sort_key(x[j]) > Tv));
                        need = 256 - cgt; }
                    int base = 0, eqt = 0;
#pragma unroll
                    for (int j = 0; j < 32; ++j) {
                        const unsigned kx = sort_key(x[j]);
                        const bool gt = (j < nj) && (exact ? (kx >= Tv) : (kx > Tv)), eq = (j < nj) && !exact && (kx == Tv);
                        const unsigned long long meq = __ballot(eq);
                        const bool sel = gt || (eq && (eqt + __popcll(meq & lt_mask)) < need);
                        const unsigned long long ms = __ballot(sel);
                        if (sel) IDX[base + __popcll(ms & lt_mask)] = (unsigned short)(j * 64 + lna);
                        base += __popcll(ms); eqt += __popcll(meq);
                    }
                }
            } else {
#pragma unroll
                for (int i = 0; i < 4; ++i) IDX[i * 64 + lna] = (unsigned short)(i * 64 + lna);
            }
        }
        WAVE_LDS_SYNC();
        {
            int lnb = lane; asm volatile("" : "+v"(lnb));
            const int head = lnb & 15, kg = lnb >> 4, nblk = nsel >> 5;
            LAS unsigned char* GB = pair;
            const bf16_t* CNb = CN + (size_t)b * SEQ * 128;
            const int rho = lnb & 15;
            const unsigned rw0 = 8 * (rho >> 2) + (rho & 3), rw1 = rw0 + 4;
            const unsigned xa0 = ((rw0 & 3) << 2) | ((rw0 >> 2) & 3), xa1 = ((rw1 & 3) << 2) | ((rw1 >> 2) & 3);
            const unsigned q4 = (lnb & 15) >> 2, p4 = lnb & 3;
            u32x4 gA[8], gB[8];
#define DSA_GATHER(G, IX, blk) do { _Pragma("unroll") for (int it = 0; it < 8; ++it) { const int sp = (IX)[(blk) * 32 + (lnb >> 4) + 4 * it]; G[it] = *(const u32x4*)(CNb + (size_t)sp * 128 + (lnb & 15) * 8); } } while (0)
            { const LAS unsigned short* IDX0 = (const LAS unsigned short*)(wsc + 1536); DSA_GATHER(gA, IDX0, 0); DSA_GATHER(gB, IDX0, 1); }
#pragma unroll 1
            for (int e2 = 0; e2 < 2; ++e2) {
                const int t = t0 + 2 * wid + e2;
                const size_t row = (size_t)b * SEQ + t;
                const LAS unsigned short* IDX = (const LAS unsigned short*)(wsc + 1536 + e2 * 512);
                bf16x8 qlf[4];
#pragma unroll
                for (int s4 = 0; s4 < 4; ++s4) { qlf[s4] = *(const bf16x8*)(P + row * PW + P_QL + (head & 7) * 128 + s4 * 32 + 8 * kg); if (head >= 8) qlf[s4] = (bf16x8){0, 0, 0, 0, 0, 0, 0, 0}; }
                f32x4 o[8];
#pragma unroll
                for (int ct = 0; ct < 8; ++ct) o[ct] = (f32x4){0.f, 0.f, 0.f, 0.f};
                float m = -INFINITY, lsum = 0.f;
#define DSA_STEP(G, kbx) do { \
                    WAVE_LDS_SYNC();                              \
                    _Pragma("unroll") for (int it = 0; it < 8; ++it) *(LAS u32x4*)(GB + off_b((lnb >> 4) + 4 * it, lnb & 15)) = G[it]; \
                    const bf16x8 iv = *(const LAS bf16x8*)((const LAS unsigned char*)IDX + ((kbx) * 32 + 8 * kg) * 2);     \
                    if ((kbx) + 2 < nblk) DSA_GATHER(G, IDX, (kbx) + 2); else if (e2 == 0) DSA_GATHER(G, IDX + 256, (kbx) + 2 - nblk); \
                    WAVE_LDS_SYNC(); \
                      \
                    bf16x8 k0[4], k1[4], af[8]; \
                    _Pragma("unroll") for (int s4 = 0; s4 < 4; ++s4) { \
                        k0[s4] = *(const LAS bf16x8*)(GB + 256u * rw0 + 16u * ((4 * s4 + kg) ^ xa0)); \
                        k1[s4] = *(const LAS bf16x8*)(GB + 256u * rw1 + 16u * ((4 * s4 + kg) ^ xa1)); } \
                    float bia[8]; \
                    _Pragma("unroll") for (int e = 0; e < 8; ++e) { const int sp = (int)(unsigned short)iv[e]; int rel = sp - t; rel = rel < -127 ? -127 : rel; bia[e] = BT[(rel + 127) * 8 + (head & 7)]; } \
                      \
                    f32x4 a0 = (f32x4){0.f, 0.f, 0.f, 0.f}, a1 = (f32x4){0.f, 0.f, 0.f, 0.f}; \
                    _Pragma("unroll") for (int s4 = 0; s4 < 4; ++s4) { \
                        a0 = __builtin_amdgcn_mfma_f32_16x16x32_bf16(k0[s4], qlf[s4], a0, 0, 0, 0); \
                        a1 = __builtin_amdgcn_mfma_f32_16x16x32_bf16(k1[s4], qlf[s4], a1, 0, 0, 0); } \
                    asm volatile("" : "+v"(a0), "+v"(a1));        \
                    _Pragma("unroll") for (int ct = 0; ct < 8; ++ct) {              \
                        const v4i16_t lo4 = __builtin_amdgcn_ds_read_tr16_b64_v4i16((LAS v4i16_t*)(GB + off_b(8 * kg + q4, 2 * ct + (p4 >> 1)) + 8 * (p4 & 1))); \
                        const v4i16_t hi4 = __builtin_amdgcn_ds_read_tr16_b64_v4i16((LAS v4i16_t*)(GB + off_b(8 * kg + 4 + q4, 2 * ct + (p4 >> 1)) + 8 * (p4 & 1))); \
                        af[ct] = (bf16x8){lo4[0], lo4[1], lo4[2], lo4[3], hi4[0], hi4[1], hi4[2], hi4[3]}; } \
                      \
                    float lg[8]; \
                    _Pragma("unroll") for (int e = 0; e < 8; ++e) lg[e] = (e < 4 ? a0[e] : a1[e - 4]) * 0.125f + bia[e]; \
                    const float mloc = fmaxf(fmaxf(fmaxf(lg[0], lg[1]), fmaxf(lg[2], lg[3])), fmaxf(fmaxf(lg[4], lg[5]), fmaxf(lg[6], lg[7]))); \
                      \
                    float scl = 1.f; \
                    if (__any(mloc > m + 16.f)) { \
                        float mb = fmaxf(mloc, __shfl_xor(mloc, 16)); mb = fmaxf(mb, __shfl_xor(mb, 32)); \
                        const float mn = fmaxf(m, mb); scl = __expf(m - mn); m = mn; \
                        _Pragma("unroll") for (int ct = 0; ct < 8; ++ct) o[ct] = o[ct] * scl; } \
                    float ps = 0.f; float pe[8]; \
                    _Pragma("unroll") for (int e = 0; e < 8; ++e) { pe[e] = __expf(lg[e] - m); ps += pe[e]; } \
                    lsum = lsum * scl + ps; \
                    u32x4 pw; pw.x = pk2(pe[0], pe[1]); pw.y = pk2(pe[2], pe[3]); pw.z = pk2(pe[4], pe[5]); pw.w = pk2(pe[6], pe[7]); \
                    const bf16x8 pb = __builtin_bit_cast(bf16x8, pw); \
                    _Pragma("unroll") for (int ct = 0; ct < 8; ++ct) o[ct] = __builtin_amdgcn_mfma_f32_16x16x32_bf16(af[ct], pb, o[ct], 0, 0, 0); \
                } while (0)
#pragma unroll 1
                for (int kb2 = 0; kb2 < nblk; kb2 += 2) { DSA_STEP(gA, kb2); DSA_STEP(gB, kb2 + 1); }
#undef DSA_STEP
                lsum += __shfl_xor(lsum, 16); lsum += __shfl_xor(lsum, 32);
                const float inv = 1.f / lsum;
                if (head < 8) {
                    bf16_t* op = CAT + row * KOUT + head * 128 + 4 * kg;
#pragma unroll
                    for (int ct = 0; ct < 8; ++ct) { u32x2 w; w.x = pk2(o[ct][0] * inv, o[ct][1] * inv); w.y = pk2(o[ct][2] * inv, o[ct][3] * inv); *(u32x2*)(op + ct * 16) = w; }
                }
            }
#undef DSA_GATHER
        }
    }
}

constexpr size_t WS_DEC = 492 * MiB;
__device__ __forceinline__ void hgrn_prep(bf16_t* P, const float* lb, float* DEC, LAS unsigned char* lds, int vb, int nvb) {
    const int tid = otid(), cl = tid >> 7, d = tid & 127;
    LAS bf16_t* Ft = (LAS bf16_t*)lds; LAS bf16_t* Qt = (LAS bf16_t*)(lds + 65536);
    for (int it = vb; it < BATCH * 4 * 8; it += nvb) {
        const int b = it >> 5, h = (it >> 3) & 3, cg = it & 7;
        bf16_t* base = P + ((size_t)b * SEQ + cg * 256) * PW + h * 128;
        u32x4 v[16];
#pragma unroll
        for (int k = 0; k < 16; ++k) { const int i = tid + 512 * k, tl = i >> 12, r = (i >> 4) & 255, ch = i & 15; v[k] = *(const u32x4*)(base + (size_t)r * PW + (tl ? P_QB : P_FB) + ch * 8); }
        __syncthreads();
#pragma unroll
        for (int k = 0; k < 16; ++k) { const int i = tid + 512 * k, tl = i >> 12, r = (i >> 4) & 255, ch = i & 15; *(LAS u32x4*)(lds + tl * 65536 + r * 256 + ch * 16) = v[k]; }
        __syncthreads();
        {
            const float l = lb[h * 128 + d];
            LAS bf16_t* fcol = Ft + (cl * 64) * 128 + d; LAS bf16_t* qcol = Qt + (cl * 64) * 128 + d;
            float ref = 0.f;
#pragma unroll 8
            for (int t = 0; t < 32; ++t) ref += __logf(l + (1.f - l) * sigmoid_f(bf2f(fcol[t * 128])));
            float bi = 0.f;
#pragma unroll 8
            for (int t = 0; t < 64; ++t) {
                const float f = l + (1.f - l) * sigmoid_f(bf2f(fcol[t * 128]));
                bi += __logf(f);
                const float q = silu_f(bf2f(qcol[t * 128]));
                qcol[t * 128] = (bf16_t)f2bf(q * __expf(bi - ref));
                fcol[t * 128] = (bf16_t)f2bf((1.f - f) * __expf(ref - bi));
            }
            float* dc = DEC + ((size_t)((b * 4 + h) * 32 + cg * 4 + cl) * 3) * 128 + d;
            dc[0] = __expf(ref); dc[128] = __expf(bi); dc[256] = __expf(bi - ref);
        }
        __syncthreads();
#pragma unroll
        for (int k = 0; k < 16; ++k) { const int i = tid + 512 * k, tl = i >> 12, r = (i >> 4) & 255, ch = i & 15; *(u32x4*)(base + (size_t)r * PW + (tl ? P_QB : P_FB) + ch * 8) = *(const LAS u32x4*)(lds + tl * 65536 + r * 256 + ch * 16); }
    }
}

__device__ __forceinline__ void hgrn_scan(const bf16_t* P, const float* DEC, const float* o_g, bf16_t* CAT, LAS unsigned char* lds, int item) {
    const int tid = otid(), lane = tid & 63, wid = __builtin_amdgcn_readfirstlane(tid >> 6), li = lane & 15, kg = lane >> 4;
    const int b = item >> 2, h = item & 3, it = wid >> 1, vh = wid & 1;
    LAS unsigned char* ST = lds + 98304;
    LAS float* SSQ = (LAS float*)(lds + DSA_BT_OFF);
    const bf16_t* Pb = P + (size_t)b * SEQ * PW;
    const float* DECb = DEC + (size_t)((b * 4 + h) * 32) * 384;
    f32x4 S[8];
#pragma unroll
    for (int vt = 0; vt < 8; ++vt) S[vt] = (f32x4){0.f, 0.f, 0.f, 0.f};
    u32x4 sg[6];
    const int colbase[3] = {P_QB, P_FB, P_IB};
#define HG_LOAD(c) do { _Pragma("unroll") for (int k = 0; k < 6; ++k) { const int n = tid + 512 * k, tl = n >> 10, r = (n >> 4) & 63, ch = n & 15; \
        sg[k] = *(const u32x4*)(Pb + (size_t)((c) * 64 + r) * PW + colbase[tl] + h * 128 + ch * 8); } } while (0)
#define HG_STORE(buf) do { _Pragma("unroll") for (int k = 0; k < 6; ++k) { const int n = tid + 512 * k, tl = n >> 10, r = (n >> 4) & 63, ch = n & 15; \
        *(LAS u32x4*)(lds + (buf) * 49152 + tl * 16384 + off_b(r, ch)) = sg[k]; } } while (0)
    HG_LOAD(0);
    __syncthreads();
    HG_STORE(0);
    const unsigned q4 = (lane & 15) >> 2, p4 = lane & 3;
    f32x4 ogv[4];
#pragma unroll
    for (int vv = 0; vv < 4; ++vv) ogv[vv] = *(const f32x4*)(o_g + 16 * (4 * vh + vv) + 4 * kg);
    float er_next = DECb[16 * wid + li];
#pragma unroll 1
    for (int c = 0; c < 32; ++c) {
        const int buf = c & 1;
        LAS unsigned char* QI = lds + buf * 49152; LAS unsigned char* KI = QI + 16384; LAS unsigned char* VI = QI + 32768;
        if (c + 1 < 32) HG_LOAD(c + 1);
        const float er = er_next, e63 = DECb[c * 384 + 128 + 16 * wid + li], e6r = DECb[c * 384 + 256 + 16 * wid + li];
        er_next = DECb[(c + 1 < 32 ? c + 1 : c) * 384 + 16 * wid + li];
        u32x2 gwv[4];
#pragma unroll
        for (int vv = 0; vv < 4; ++vv) gwv[vv] = *(const u32x2*)(P + ((size_t)b * SEQ + c * 64 + 16 * it + li) * PW + P_GB + h * 128 + 16 * (4 * vh + vv) + 4 * kg);
        { const unsigned d = 16 * wid + li;
#pragma unroll
          for (int vt = 0; vt < 8; ++vt) { u32x2 w; w.x = pk2(S[vt][0] * er, S[vt][1] * er); w.y = pk2(S[vt][2] * er, S[vt][3] * er);
              *(LAS u32x2*)(ST + off_b(d, 2 * vt + (kg >> 1)) + 8 * (kg & 1)) = w; } }
        __syncthreads();
        bf16x8 qf[4];
#pragma unroll
        for (int ks = 0; ks < 4; ++ks) qf[ks] = *(const LAS bf16x8*)(QI + off_b(16 * it + li, 4 * ks + kg));
        f32x4 o[4];
#pragma unroll
        for (int vv = 0; vv < 4; ++vv) o[vv] = (f32x4){0.f, 0.f, 0.f, 0.f};
#pragma unroll
        for (int ks = 0; ks < 4; ++ks)
#pragma unroll
            for (int vv = 0; vv < 4; ++vv) {
                const int ct = 4 * vh + vv;
                const v4i16_t lo4 = __builtin_amdgcn_ds_read_tr16_b64_v4i16((LAS v4i16_t*)(ST + off_b(32 * ks + 8 * kg + q4, 2 * ct + (p4 >> 1)) + 8 * (p4 & 1)));
                const v4i16_t hi4 = __builtin_amdgcn_ds_read_tr16_b64_v4i16((LAS v4i16_t*)(ST + off_b(32 * ks + 8 * kg + 4 + q4, 2 * ct + (p4 >> 1)) + 8 * (p4 & 1)));
                const bf16x8 af = (bf16x8){lo4[0], lo4[1], lo4[2], lo4[3], hi4[0], hi4[1], hi4[2], hi4[3]};
                o[vv] = __builtin_amdgcn_mfma_f32_16x16x32_bf16(af, qf[ks], o[vv], 0, 0, 0);
            }
        const int njb = (it >> 1) + 1;
#pragma unroll
        for (int jb = 0; jb < 2; ++jb) {
            if (jb < njb) {
                f32x4 a0 = (f32x4){0.f, 0.f, 0.f, 0.f}, a1 = (f32x4){0.f, 0.f, 0.f, 0.f};
                const unsigned rw0 = 32 * jb + 8 * (li >> 2) + (li & 3), rw1 = rw0 + 4;
#pragma unroll
                for (int ks = 0; ks < 4; ++ks) {
                    const bf16x8 k0 = *(const LAS bf16x8*)(KI + off_b(rw0, 4 * ks + kg));
                    const bf16x8 k1 = *(const LAS bf16x8*)(KI + off_b(rw1, 4 * ks + kg));
                    a0 = __builtin_amdgcn_mfma_f32_16x16x32_bf16(k0, qf[ks], a0, 0, 0, 0);
                    a1 = __builtin_amdgcn_mfma_f32_16x16x32_bf16(k1, qf[ks], a1, 0, 0, 0);
                }
                const int ii = 16 * it + li, j0 = 32 * jb + 8 * kg;
                float am[8];
#pragma unroll
                for (int e = 0; e < 8; ++e) am[e] = (j0 + e <= ii) ? (e < 4 ? a0[e] : a1[e - 4]) : 0.f;
                u32x4 pw; pw.x = pk2(am[0], am[1]); pw.y = pk2(am[2], am[3]); pw.z = pk2(am[4], am[5]); pw.w = pk2(am[6], am[7]);
                const bf16x8 pb = __builtin_bit_cast(bf16x8, pw);
#pragma unroll
                for (int vv = 0; vv < 4; ++vv) {
                    const int ct = 4 * vh + vv;
                    const v4i16_t lo4 = __builtin_amdgcn_ds_read_tr16_b64_v4i16((LAS v4i16_t*)(VI + off_b(32 * jb + 8 * kg + q4, 2 * ct + (p4 >> 1)) + 8 * (p4 & 1)));
                    const v4i16_t hi4 = __builtin_amdgcn_ds_read_tr16_b64_v4i16((LAS v4i16_t*)(VI + off_b(32 * jb + 8 * kg + 4 + q4, 2 * ct + (p4 >> 1)) + 8 * (p4 & 1)));
                    const bf16x8 af = (bf16x8){lo4[0], lo4[1], lo4[2], lo4[3], hi4[0], hi4[1], hi4[2], hi4[3]};
                    o[vv] = __builtin_amdgcn_mfma_f32_16x16x32_bf16(af, pb, o[vv], 0, 0, 0);
                }
            }
        }
        {
            f32x4 U[8];
#pragma unroll
            for (int vt = 0; vt < 8; ++vt) U[vt] = (f32x4){0.f, 0.f, 0.f, 0.f};
#pragma unroll
            for (int ks = 0; ks < 2; ++ks) {
                const v4i16_t kl = __builtin_amdgcn_ds_read_tr16_b64_v4i16((LAS v4i16_t*)(KI + off_b(32 * ks + 8 * kg + q4, 2 * wid + (p4 >> 1)) + 8 * (p4 & 1)));
                const v4i16_t kh = __builtin_amdgcn_ds_read_tr16_b64_v4i16((LAS v4i16_t*)(KI + off_b(32 * ks + 8 * kg + 4 + q4, 2 * wid + (p4 >> 1)) + 8 * (p4 & 1)));
                const bf16x8 kfr = (bf16x8){kl[0], kl[1], kl[2], kl[3], kh[0], kh[1], kh[2], kh[3]};
#pragma unroll
                for (int vt = 0; vt < 8; ++vt) {
                    const v4i16_t lo4 = __builtin_amdgcn_ds_read_tr16_b64_v4i16((LAS v4i16_t*)(VI + off_b(32 * ks + 8 * kg + q4, 2 * vt + (p4 >> 1)) + 8 * (p4 & 1)));
                    const v4i16_t hi4 = __builtin_amdgcn_ds_read_tr16_b64_v4i16((LAS v4i16_t*)(VI + off_b(32 * ks + 8 * kg + 4 + q4, 2 * vt + (p4 >> 1)) + 8 * (p4 & 1)));
                    const bf16x8 af = (bf16x8){lo4[0], lo4[1], lo4[2], lo4[3], hi4[0], hi4[1], hi4[2], hi4[3]};
                    U[vt] = __builtin_amdgcn_mfma_f32_16x16x32_bf16(af, kfr, U[vt], 0, 0, 0);
                }
            }
#pragma unroll
            for (int vt = 0; vt < 8; ++vt) S[vt] = S[vt] * e63 + U[vt] * e6r;
        }
        float ss = 0.f;
#pragma unroll
        for (int vv = 0; vv < 4; ++vv) ss += (o[vv][0] * o[vv][0] + o[vv][1] * o[vv][1]) + (o[vv][2] * o[vv][2] + o[vv][3] * o[vv][3]);
        ss += __shfl_xor(ss, 16); ss += __shfl_xor(ss, 32);
        if (kg == 0) SSQ[(it * 2 + vh) * 16 + li] = ss;
        __syncthreads();
        if (c + 1 < 32) HG_STORE(buf ^ 1);
        {
            const float tot = SSQ[(it * 2) * 16 + li] + SSQ[(it * 2 + 1) * 16 + li];
            const float rs = rsqrtf(tot * (1.f / 128.f) + EPS);
            const size_t row = (size_t)b * SEQ + c * 64 + 16 * it + li;
#pragma unroll
            for (int vv = 0; vv < 4; ++vv) {
                const int v0 = 16 * (4 * vh + vv) + 4 * kg;
                const u32x2 gw = gwv[vv];
                const f32x4 og = ogv[vv];
                const float g0 = silu_f(bf2f((unsigned short)(gw.x & 0xffffu))), g1 = silu_f(bf2f((unsigned short)(gw.x >> 16))), g2 = silu_f(bf2f((unsigned short)(gw.y & 0xffffu))), g3 = silu_f(bf2f((unsigned short)(gw.y >> 16)));
                u32x2 w; w.x = pk2(o[vv][0] * rs * og.x * g0, o[vv][1] * rs * og.y * g1); w.y = pk2(o[vv][2] * rs * og.z * g2, o[vv][3] * rs * og.w * g3);
                *(u32x2*)(CAT + row * KOUT + 1024 + h * 128 + v0) = w;
            }
        }
    }
#undef HG_LOAD
#undef HG_STORE
}


__device__ __forceinline__ int swap23(int r) { return (r & ~12) | ((r & 4) << 1) | ((r & 8) >> 1); }
__device__ __forceinline__ void xattn_mfma_phase(const bf16_t* Q, const bf16_t* Kb, const bf16_t* VT, bf16_t* O, LAS unsigned char* lds, int vb, int nvb) {
    const int tid = otid(), lane = tid & 63, wid = __builtin_amdgcn_readfirstlane(tid >> 6), r32 = lane & 31, hf = lane >> 5;
    LAS unsigned char* Ks = lds; LAS unsigned char* Vs = lds + 65536;
    int koff[8], voff[8];
    { const int kr = swap23(r32), x = kr & 15, y = r32 & 15;
#pragma unroll
      for (int ks = 0; ks < 8; ++ks) koff[ks] = kr * 256 + (((ks * 2 + hf) ^ x) << 4);
#pragma unroll
      for (int e = 0; e < 8; ++e) voff[e] = r32 * 512 + (((e * 2 + hf) ^ y) << 4); }
    for (int pair = vb; pair < 256; pair += nvb) {
        const int bh = pair >> 2, b = bh >> 2, h = bh & 3;
        __syncthreads();
        int tio = tid; asm volatile("" : "+v"(tio));
        for (int i = tio; i < 4096; i += NTHREADS) { const int key = i >> 4, ch = i & 15;
            const u32x4 v = *(const u32x4*)(Kb + (size_t)(b * MEMT + key) * 512 + h * 128 + ch * 8);
            *(LAS u32x4*)(Ks + key * 256 + ((ch ^ (key & 15)) << 4)) = v; }
        for (int i = tio; i < 4096; i += NTHREADS) { const int d = i >> 5, ch = i & 31;
            const u32x4 v = *(const u32x4*)(VT + (size_t)(h * 128 + d) * MT + b * MEMT + ch * 8);
            *(LAS u32x4*)(Vs + d * 512 + ((ch ^ (d & 15)) << 4)) = v; }
        __syncthreads();
#pragma unroll 1
        for (int qq = 0; qq < 2; ++qq) {
            const size_t q0 = (size_t)b * SEQ + ((pair & 3) * 2 + qq) * 256 + wid * 32;
            bf16x8 qf[8];
#pragma unroll
            for (int ks = 0; ks < 8; ++ks) qf[ks] = *(const bf16x8*)(Q + (q0 + r32) * 512 + h * 128 + ks * 16 + 8 * hf);
            f32x16 st[8];
            __builtin_amdgcn_s_setprio(1);
#pragma unroll
            for (int kt = 0; kt < 8; ++kt) {
#pragma unroll
                for (int r = 0; r < 16; ++r) st[kt][r] = 0.f;
#pragma unroll
                for (int ks = 0; ks < 8; ++ks) {
                    const bf16x8 a = *(const LAS bf16x8*)(Ks + koff[ks] + kt * 8192);
                    st[kt] = __builtin_amdgcn_mfma_f32_32x32x16_bf16(a, qf[ks], st[kt], 0, 0, 0);
                }
            }
            __builtin_amdgcn_s_setprio(0);
            float mx = -INFINITY;
#pragma unroll
            for (int kt = 0; kt < 8; ++kt)
#pragma unroll
                for (int r = 0; r < 16; ++r) mx = fmaxf(mx, st[kt][r]);
            mx = fmaxf(mx, __shfl_xor(mx, 32));
            const float c = 0.08838834764831845f * 1.4426950408889634f;
            float sum = 0.f;
#pragma unroll
            for (int kt = 0; kt < 8; ++kt)
#pragma unroll
                for (int r = 0; r < 16; ++r) { const float e = __builtin_amdgcn_exp2f((st[kt][r] - mx) * c); st[kt][r] = e; sum += e; }
            sum += __shfl_xor(sum, 32);
            const float inv = 1.f / sum;
            bf16x8 pfr[8][2];
#pragma unroll
            for (int kt = 0; kt < 8; ++kt)
#pragma unroll
                for (int s2 = 0; s2 < 2; ++s2) {
                    u32x4 pw;
                    pw.x = pk2(st[kt][8 * s2 + 0], st[kt][8 * s2 + 1]); pw.y = pk2(st[kt][8 * s2 + 2], st[kt][8 * s2 + 3]);
                    pw.z = pk2(st[kt][8 * s2 + 4], st[kt][8 * s2 + 5]); pw.w = pk2(st[kt][8 * s2 + 6], st[kt][8 * s2 + 7]);
                    pfr[kt][s2] = __builtin_bit_cast(bf16x8, pw);
                }
#pragma unroll
            for (int kt = 0; kt < 8; ++kt) asm volatile("" : "+v"(pfr[kt][0]), "+v"(pfr[kt][1]));
            f32x16 o[4];
#pragma unroll
            for (int dt = 0; dt < 4; ++dt)
#pragma unroll
                for (int r = 0; r < 16; ++r) o[dt][r] = 0.f;
            __builtin_amdgcn_s_setprio(1);
#pragma unroll
            for (int kt = 0; kt < 8; ++kt)
#pragma unroll
                for (int s2 = 0; s2 < 2; ++s2)
#pragma unroll
                    for (int dt = 0; dt < 4; ++dt) {
                        const bf16x8 a = *(const LAS bf16x8*)(Vs + voff[(kt & 3) * 2 + s2] + dt * 16384 + (kt >> 2) * 256);
                        o[dt] = __builtin_amdgcn_mfma_f32_32x32x16_bf16(a, pfr[kt][s2], o[dt], 0, 0, 0);
                    }
            __builtin_amdgcn_s_setprio(0);
            unsigned char* orow = (unsigned char*)O + (q0 + r32) * 512 + h * 128 + 64 * hf;
            const float isc = inv * XO_SC;
#pragma unroll
            for (int dt = 0; dt < 4; ++dt) {
                u32x4 w;
#pragma unroll
                for (int g = 0; g < 4; ++g) w[g] = pk4_f8(o[dt][4 * g] * isc, o[dt][4 * g + 1] * isc, o[dt][4 * g + 2] * isc, o[dt][4 * g + 3] * isc);
                *(u32x4*)(orow + dt * 16) = w;
            }
        }
    }
}


__device__ __forceinline__ void gmlp_mfma_phase(const bf16_t* UV, const float* lnp, const float* ln_g, const float* ln_b, const float* w_sp, const float* b_sp, bf16_t* G, LAS unsigned char* lds, int vb, int nvb) {
    const int tid = otid(), lane = tid & 63, wid = __builtin_amdgcn_readfirstlane(tid >> 6), fr = lane & 15, fq = lane >> 4;
    LAS unsigned char* Wb = lds; LAS unsigned char* VTs = lds + 32768; LAS float* STAT = (LAS float*)(lds + 65536);
    int gcur = -1;
    for (int grp = vb; grp < 256; grp += nvb) {
        const int g = grp >> 5;
        bf16x8 vch[4]; f32x4 lp[2];
#define GM_LOAD(uu_) do { const size_t r0_ = (size_t)((grp & 31) * 8 + (uu_)) * 128; \
            _Pragma("unroll") for (int k = 0; k < 4; ++k) { const int i = tid + 512 * k, sI = i >> 4, ch = i & 15; vch[k] = *(const bf16x8*)(UV + (r0_ + sI) * 2048 + 1024 + g * 128 + ch * 8); } \
            lp[0] = *(const f32x4*)(lnp + (r0_ + (tid >> 2)) * 32 + (tid & 3) * 8); lp[1] = *(const f32x4*)(lnp + (r0_ + (tid >> 2)) * 32 + (tid & 3) * 8 + 4); } while (0)
        GM_LOAD(0);
        const f32x4 g0 = *(const f32x4*)(ln_g + g * 128 + (tid & 15) * 8), g1 = *(const f32x4*)(ln_g + g * 128 + (tid & 15) * 8 + 4);
        const f32x4 b0 = *(const f32x4*)(ln_b + g * 128 + (tid & 15) * 8), b1 = *(const f32x4*)(ln_b + g * 128 + (tid & 15) * 8 + 4);
        const float gg[8] = {g0.x, g0.y, g0.z, g0.w, g1.x, g1.y, g1.z, g1.w}, bb[8] = {b0.x, b0.y, b0.z, b0.w, b1.x, b1.y, b1.z, b1.w};
        __syncthreads();
        if (g != gcur) {
            gcur = g;
            for (int i = tid; i < 2048; i += NTHREADS) { const int t = i >> 4, ch = i & 15;
                const f32x4 a = *(const f32x4*)(w_sp + (size_t)g * 16384 + t * 128 + ch * 8), b = *(const f32x4*)(w_sp + (size_t)g * 16384 + t * 128 + ch * 8 + 4);
                const int s0 = ch * 8;
                u32x4 w; w.x = pk2(s0 + 0 <= t ? a.x : 0.f, s0 + 1 <= t ? a.y : 0.f); w.y = pk2(s0 + 2 <= t ? a.z : 0.f, s0 + 3 <= t ? a.w : 0.f);
                w.z = pk2(s0 + 4 <= t ? b.x : 0.f, s0 + 5 <= t ? b.y : 0.f); w.w = pk2(s0 + 6 <= t ? b.z : 0.f, s0 + 7 <= t ? b.w : 0.f);
                *(LAS u32x4*)(Wb + t * 256 + ((ch ^ (t & 15)) << 4)) = w; }
        }
        const int trow = wid * 16 + fr;
        const float bias = b_sp[g * 128 + trow];
#pragma unroll 1
        for (int uu = 0; uu < 8; ++uu) {
            const int bn = (grp & 31) * 8 + uu;
            const size_t row0 = (size_t)bn * 128;
            if (uu) __syncthreads();
            { float s1 = (lp[0].x + lp[0].z) + (lp[1].x + lp[1].z), s2 = (lp[0].y + lp[0].w) + (lp[1].y + lp[1].w);
              s1 += __shfl_xor(s1, 1); s2 += __shfl_xor(s2, 1); s1 += __shfl_xor(s1, 2); s2 += __shfl_xor(s2, 2);
              const float mu = s1 * (1.f / 1024.f), var = fmaxf(s2 * (1.f / 1024.f) - mu * mu, 0.f);
              if ((tid & 3) == 0) { STAT[2 * (tid >> 2)] = mu; STAT[2 * (tid >> 2) + 1] = rsqrtf(var + EPS); } }
            __syncthreads();
#pragma unroll
            for (int k = 0; k < 4; ++k) { const int i = tid + 512 * k, sI = i >> 4, ch = i & 15;
                const float mu = STAT[2 * sI], rs = STAT[2 * sI + 1];
#pragma unroll
                for (int e = 0; e < 8; ++e) { const int c = ch * 8 + e; const float x = (bf2f((unsigned short)vch[k][e]) - mu) * rs * gg[e] + bb[e];
                    *(LAS bf16_t*)(VTs + c * 256 + (((sI >> 3) ^ ((c ^ (c >> 3)) & 15)) << 4) + (sI & 7) * 2) = (bf16_t)f2bf(x); } }
            if (uu + 1 < 8) GM_LOAD(uu + 1);
            const size_t orow = row0 + trow;
            u32x2 uwv[8];
#pragma unroll
            for (int ct = 0; ct < 8; ++ct) uwv[ct] = *(const u32x2*)(UV + orow * 2048 + g * 128 + ct * 16 + 4 * fq);
            __syncthreads();
            f32x4 acc[8];
#pragma unroll
            for (int ct = 0; ct < 8; ++ct) acc[ct] = (f32x4){0.f, 0.f, 0.f, 0.f};
#pragma unroll
            for (int ks = 0; ks < 4; ++ks) {
                const bf16x8 wf = *(const LAS bf16x8*)(Wb + trow * 256 + (((ks * 4 + fq) ^ (trow & 15)) << 4));
#pragma unroll
                for (int ct = 0; ct < 8; ++ct) {
                    const int crow = ct * 16 + fr;
                    const bf16x8 vf = *(const LAS bf16x8*)(VTs + crow * 256 + (((ks * 4 + fq) ^ ((crow ^ (crow >> 3)) & 15)) << 4));
                    acc[ct] = __builtin_amdgcn_mfma_f32_16x16x32_bf16(vf, wf, acc[ct], 0, 0, 0);
                }
            }
#pragma unroll
            for (int ct = 0; ct < 8; ++ct) {
                const int c = ct * 16 + 4 * fq;
                const u32x2 uw = uwv[ct];
                const float u0 = bf2f((unsigned short)(uw.x & 0xffffu)), u1 = bf2f((unsigned short)(uw.x >> 16)), u2 = bf2f((unsigned short)(uw.y & 0xffffu)), u3 = bf2f((unsigned short)(uw.y >> 16));
                u32x2 w; w.x = pk2(u0 * (acc[ct][0] + bias), u1 * (acc[ct][1] + bias)); w.y = pk2(u2 * (acc[ct][2] + bias), u3 * (acc[ct][3] + bias));
                *(u32x2*)(G + orow * 1024 + g * 128 + c) = w;
            }
        }
#undef GM_LOAD
    }
}

#define GAS __attribute__((address_space(1)))
typedef GAS unsigned gu32;
#define XB_TMO      128
#define XB_XCNT(j)  (256  + 64 * (j))
#define XB_XSUB(j)  (1280 + 64 * (j))
#define XB_XGEN(j)  (2304 + 64 * (j))
#define XB_TOP      3328
#define XB_TOPGEN   3392
#define XCD_BAR_WORDS 3456
#define XB_SPIN_CAP (1u << 18)

__device__ __forceinline__ unsigned xb_ld(unsigned* p)              { return __hip_atomic_load(p, __ATOMIC_RELAXED, __HIP_MEMORY_SCOPE_AGENT); }
__device__ __forceinline__ unsigned xb_add(unsigned* p, unsigned v) { return __hip_atomic_fetch_add(p, v, __ATOMIC_RELAXED, __HIP_MEMORY_SCOPE_AGENT); }
__device__ __forceinline__ unsigned xb_xcc_id() { return (unsigned)__builtin_amdgcn_s_getreg((3 << 11) | 20) & 0xFu; }
#define XB_SPIN(cond, bar) do { unsigned _sp = 0; while (cond) { __builtin_amdgcn_s_sleep(1); \
    if ((++_sp & 255u) == 0u) { if (xb_ld(&(bar)[XB_TMO])) break; if (_sp > XB_SPIN_CAP) { atomicAdd(&(bar)[XB_TMO], 1u); break; } } } } while (0)

struct XcdBarrier {
    unsigned* bar; unsigned x;
    volatile LAS unsigned* st;
};

__device__ __forceinline__ XcdBarrier xcd_barrier_post(unsigned* bar, volatile LAS unsigned* st) {
    XcdBarrier b; b.bar = bar; b.x = xb_xcc_id(); b.st = st;
    if (threadIdx.x == 0) (void)xb_add(&bar[XB_XCNT(b.x)], 1u);
    return b;
}
__device__ __forceinline__ void xcd_barrier_complete(unsigned* bar, unsigned x, unsigned& nloc, unsigned& nx) {
    const unsigned G = gridDim.x * gridDim.y * gridDim.z;
    unsigned sum, cnt, mine, sp = 0u;
    for (;;) {
        sum = 0u; cnt = 0u; mine = 0u;
#pragma unroll
        for (unsigned j = 0; j < 16; ++j) { const unsigned c = xb_ld(&bar[XB_XCNT(j)]); sum += c; cnt += (c > 0u) ? 1u : 0u; mine = (j == x) ? c : mine; }
        if (sum == G) break;
        __builtin_amdgcn_s_sleep(1);
        if ((++sp & 255u) == 0u) { if (xb_ld(&bar[XB_TMO])) break; if (sp > XB_SPIN_CAP) { atomicAdd(&bar[XB_TMO], 1u); break; } }
    }
    nloc = mine > 0u ? mine : 1u; nx = cnt > 0u ? cnt : 1u;
}

__device__ __forceinline__ void xcd_barrier(const XcdBarrier& b) {
    asm volatile("s_waitcnt vmcnt(0)" ::: "memory");
    __syncthreads();
    if (threadIdx.x == 0) {
        unsigned* bar = b.bar;
        __builtin_amdgcn_s_waitcnt(0);
        unsigned nloc = b.st[0], nx = b.st[1];
        if (nloc == 0u) { xcd_barrier_complete(bar, b.x, nloc, nx); b.st[0] = nloc; b.st[1] = nx; }
        const unsigned old = xb_add(&bar[XB_XSUB(b.x)], 1u);
        const unsigned gen = old / nloc;
        if (old + 1u == (gen + 1u) * nloc) {
            __builtin_amdgcn_fence(__ATOMIC_RELEASE, "agent");
            asm volatile("s_waitcnt vmcnt(0)" ::: "memory");
            const unsigned og = xb_add(&bar[XB_TOP], 1u);
            const unsigned tg = og / nx;
            if (og + 1u == (tg + 1u) * nx) xb_add(&bar[XB_TOPGEN], 1u);
            else XB_SPIN(xb_ld(&bar[XB_TOPGEN]) == tg, bar);
            __builtin_amdgcn_fence(__ATOMIC_ACQUIRE, "agent");
            xb_add(&bar[XB_XGEN(b.x)], 1u);
            asm volatile("s_waitcnt vmcnt(0)" ::: "memory");
        } else {
            XB_SPIN(xb_ld(&bar[XB_XGEN(b.x)]) == gen, bar);
            __builtin_amdgcn_fence(__ATOMIC_ACQUIRE, "agent");
            asm volatile("s_waitcnt vmcnt(0)" ::: "memory");
        }
    }
    __syncthreads();
}

constexpr int LDS_BYTES = 32768 * 4 + 256 + 6144 + 8 * 2560;

enum Phase {
    PH_PREP = 0, PH_GEMM_IN, PH_CNORM, PH_MIX0  , PH_GEMM_OUT0,
    PH_GEMM_Q0, PH_XATTN0, PH_GEMM_O0, PH_GEMM_GU0, PH_GEMM_DN0,
    PH_GEMM_OIN, PH_GMLP, PH_GEMM_OOUT,
    PH_GEMM_Q1, PH_XATTN1, PH_GEMM_O1, PH_GEMM_GU1, PH_GEMM_DN1, PH_FINAL, PH_COUNT
};

__device__ __forceinline__ PrepJob make_job(const Params& p, int ji) {
    unsigned char* ws = p.ws; PrepJob j{};
    switch (ji) {
    case 0: j = PrepJob{p.in[5], 1024, 3272, p.in[4], (bf16_t*)(ws + WS_WIN), 1024, 1792, 1024, 0, MAP_WIN}; break;
    case 14: j = PrepJob{p.in[5], 1024, 3272, p.in[4], (bf16_t*)(ws + WS_WIN), 3584, PW, 1024, 0, MAP_WIN}; break;
    case 15: j = PrepJob{p.in[5], 1024, 3272, p.in[4], (bf16_t*)(ws + WS_WIN8), 1024, 2816, 1024, 0, MAP_WIN8, 4, WQ_GU}; break;
    case 1: j = PrepJob{p.in[10] + (size_t)512 * 1024, 512, 1024, nullptr, (bf16_t*)(ws + WS_WOUT), 0, 1024, KOUT, 1024, MAP_ID}; break;
    case 2: j = PrepJob{p.in[11], 1024, 2048, p.in[4] + 1024, (bf16_t*)(ws + WS_OWIN), 0, 2048, 1024, 0, MAP_ID, 2, WQ_GU}; break;
    case 3: j = PrepJob{p.in[16], 1024, 1024, nullptr, (bf16_t*)(ws + WS_OWOUT), 0, 1024, 1024, 0, MAP_ID}; break;
    case 4: case 5: { const int l = ji - 4; j = PrepJob{p.in[19] + (size_t)l * 1024 * 512, 1024, 512, p.in[17] + l * 1024, (bf16_t*)(ws + WS_WQ + (size_t)l * 512 * 1024), 0, 512, 1024, 0, MAP_ID, 2, WQ_GU}; } break;
    case 6: case 7: { const int l = ji - 6; j = PrepJob{p.in[20] + (size_t)l * 1024 * 1024, 1024, 1024, p.in[18] + l * 1024, (bf16_t*)(ws + WS_WKV) + (size_t)l * 1024 * 1024, 0, 1024, 1024, 0, MAP_ID}; } break;
    case 8: case 9: { const int l = ji - 8; j = PrepJob{p.in[21] + (size_t)l * 512 * 1024, 512, 1024, nullptr, (bf16_t*)(ws + WS_WO + (size_t)l * 1024 * 512), 0, 1024, 512, 0, MAP_ID, 3, WO_SC}; } break;
    case 10: case 11: { const int l = ji - 10; j = PrepJob{p.in[23] + (size_t)l * 1024 * 2 * FF, 1024, 2 * FF, p.in[22] + l * 1024, (bf16_t*)(ws + WS_WGU + (size_t)l * 2 * FF * 1024), 0, 2 * FF, 1024, 0, MAP_GU, 2, WQ_GU}; } break;
    case 12: case 13: { const int l = ji - 12;
        if ((DN_FP8 >> l) & 1) j = PrepJob{p.in[24] + (size_t)l * FF * 1024, FF, 1024, nullptr, (bf16_t*)(ws + WS_WDN + (size_t)l * 1024 * FF * 2), 0, 1024, FF, 0, MAP_ID, 1, WDN_SC};
        else j = PrepJob{p.in[24] + (size_t)l * FF * 1024, FF, 1024, nullptr, (bf16_t*)(ws + WS_WDN) + (size_t)l * 1024 * FF, 0, 1024, FF, 0, MAP_ID}; } break;
    }
    return j;
}
constexpr int N_PREP_JOBS = 16;

template <int ph> __device__ __forceinline__ void run_phase(const Params& p, LAS float* lds, int vb, int nvb) {
    unsigned char* ws = p.ws;
    bf16_t* HN = (bf16_t*)(ws + WS_HN); bf16_t* BIG = (bf16_t*)(ws + WS_BIG); bf16_t* CN = (bf16_t*)(ws + WS_CN); bf16_t* CAT = (bf16_t*)(ws + WS_CAT);
    bf16_t* KB = (bf16_t*)(ws + WS_KB); bf16_t* VTB = (bf16_t*)(ws + WS_VT); bf16_t* MEMN = (bf16_t*)(ws + WS_MEMN); float* lb = (float*)(ws + WS_LB);
    float* ssq = (float*)(ws + WS_SSQ); float* lnp = (float*)(ws + WS_LNP);
    bf16_t* XQ = BIG; bf16_t* XO = BIG + (size_t)T * 512;
    const int l = (ph >= PH_GEMM_Q1) ? 1 : 0;
    switch (ph) {
    case PH_PREP:
        x_to_h_rows(p.in[0], HN, ws + WS_X8, ssq, vb, nvb);
        {
            constexpr int NT_[N_PREP_JOBS] = {16 * 3, 8 * 4, 16 * 8, 16 * 4, 16 * 2, 16 * 2, 16 * 4, 16 * 4, 8 * 4, 8 * 4, 16 * 22, 16 * 22, 44 * 4, 44 * 4, 16 * 1, 16 * 7};
            constexpr int CUM1 = NT_[0], CUM2 = CUM1 + NT_[1], CUM3 = CUM2 + NT_[2], CUM4 = CUM3 + NT_[3], CUM5 = CUM4 + NT_[4], CUM6 = CUM5 + NT_[5], CUM7 = CUM6 + NT_[6],
                          CUM8 = CUM7 + NT_[7], CUM9 = CUM8 + NT_[8], CUM10 = CUM9 + NT_[9], CUM11 = CUM10 + NT_[10], CUM12 = CUM11 + NT_[11], CUM13 = CUM12 + NT_[12], CUM14 = CUM13 + NT_[13],
                          CUM15 = CUM14 + NT_[14], CUM16 = CUM15 + NT_[15];
#define PJ_FIND(it_, ji_, base_) do { ji_ = 0; base_ = 0; \
                PJ_STEP(it_, ji_, base_, 1, CUM1) PJ_STEP(it_, ji_, base_, 2, CUM2) PJ_STEP(it_, ji_, base_, 3, CUM3) PJ_STEP(it_, ji_, base_, 4, CUM4) PJ_STEP(it_, ji_, base_, 5, CUM5) PJ_STEP(it_, ji_, base_, 6, CUM6) PJ_STEP(it_, ji_, base_, 7, CUM7) \
                PJ_STEP(it_, ji_, base_, 8, CUM8) PJ_STEP(it_, ji_, base_, 9, CUM9) PJ_STEP(it_, ji_, base_, 10, CUM10) PJ_STEP(it_, ji_, base_, 11, CUM11) PJ_STEP(it_, ji_, base_, 12, CUM12) PJ_STEP(it_, ji_, base_, 13, CUM13) PJ_STEP(it_, ji_, base_, 14, CUM14) PJ_STEP(it_, ji_, base_, 15, CUM15) } while (0)
#define PJ_STEP(it_, ji_, base_, q, c) if ((it_) >= (c)) { ji_ = (q); base_ = (c); }
            f32x4 va[8], vn[8];
            int ji, base;
            if (vb < CUM16) { PJ_FIND(vb, ji, base); const PrepJob j = make_job(p, ji); prep_tile_load(j, vb - base, va); }
            for (int it = vb; it < CUM16; it += nvb) {
                PJ_FIND(it, ji, base);
                const PrepJob j = make_job(p, ji); const int tl = it - base;
                if (it + nvb < CUM16) { int jn, bn; PJ_FIND(it + nvb, jn, bn); const PrepJob j2 = make_job(p, jn); prep_tile_load(j2, it + nvb - bn, vn); }
                prep_tile_store(j, tl, va, lds);
#pragma unroll
                for (int q = 0; q < 8; ++q) va[q] = vn[q];
            }
#undef PJ_STEP
#undef PJ_FIND
        }
        prep_fold_in(p.in[5], p.in[7], p.in[4], (bf16_t*)(ws + WS_WIN8), lds, vb, nvb);
        prep_fold_out(p.in[10], p.in[8], (bf16_t*)(ws + WS_WOUT), lds, vb, nvb);
        prep_lb(p.in[3], lb, vb, nvb);
        rmsnorm_rows(p.in[1], MEMN, MT, vb, nvb);
        break;
    case PH_GEMM_IN: {
        {
            Gemm g{(const bf16_t*)(ws + WS_X8), (const bf16_t*)(ws + WS_WIN8), T, 2816, 512}; EpiStoreBf16<true, true> E{BIG, PW, ssq, 1.f / (HQ_X * WQ_GU)};
            run_gemm<EpiStoreBf16<true, true>, 2>(g, E, lds, vb, nvb);
        }
        Gemm g{(const bf16_t*)(ws + WS_WIN), (const bf16_t*)(ws + WS_WIN), T, PW, 1024}; EpiIn E{BIG, KB, VTB, ssq};
        pg8::ComboOrder S; S.init(nvb, nvb - 1 - vb);
        pg8::gemm_phase<EpiIn, pg8::ComboOrder, true, true>((LAS unsigned char*)lds, g, S, E);
    } break;
    case PH_CNORM: cnorm_rows(BIG, p.in[6], CN, vb, nvb); hgrn_prep(BIG, lb, (float*)(ws + WS_DEC), (LAS unsigned char*)lds, vb, nvb); break;
    case PH_MIX0:
        for (int item = vb; item < 64; item += nvb) hgrn_scan(BIG, (const float*)(ws + WS_DEC), p.in[9], CAT, (LAS unsigned char*)lds, item);
        dsa_mfma_phase(BIG, CN, p.in[2], CAT, (LAS unsigned char*)lds, (unsigned*)(ws + WS_CTL) + 3600);
        break;
    case PH_GEMM_OUT0: { Gemm g{CAT, (const bf16_t*)(ws + WS_WOUT), T, 1024, KOUT}; EpiResid<false, false, true> E{nullptr, HN, ssq, ws + WS_H8, HQ_Q0}; run_gemm(g, E, lds, vb, nvb); } break;
    case PH_GEMM_Q0: case PH_GEMM_Q1: { Gemm g{(const bf16_t*)(ws + WS_H8), (const bf16_t*)(ws + WS_WQ + (size_t)l * 512 * 1024), T, 512, 512}; EpiStoreBf16<true> E{XQ, 512, ssq, 1.f / ((l ? HQ_Q1 : HQ_Q0) * WQ_GU)}; run_gemm<EpiStoreBf16<true>, 2>(g, E, lds, vb, nvb); } break;
    case PH_XATTN0: case PH_XATTN1: xattn_mfma_phase(XQ, KB + (size_t)l * MT * 512, VTB + (size_t)l * 512 * MT, XO, (LAS unsigned char*)lds, vb, nvb); break;
    case PH_GEMM_O0: case PH_GEMM_O1: { Gemm g{XO, (const bf16_t*)(ws + WS_WO + (size_t)l * 1024 * 512), T, 1024, 256}; EpiResid<false, true, true> E{nullptr, HN, ssq, ws + WS_H8, l ? HQ_GU1 : HQ_GU0, XO_UNSC}; run_gemm<EpiResid<false, true, true>, 1>(g, E, lds, vb, nvb); } break;
    case PH_GEMM_GU0: case PH_GEMM_GU1: { constexpr bool dn8 = ((DN_FP8 >> l) & 1) != 0;
        Gemm g{(const bf16_t*)(ws + WS_H8), (const bf16_t*)(ws + WS_WGU + (size_t)l * 2 * FF * 1024), T, 2 * FF, 512}; EpiSwigluQ<true, dn8> E{BIG, FF, ssq, 1.f / ((l ? HQ_GU1 : HQ_GU0) * WQ_GU)}; run_gemm<EpiSwigluQ<true, dn8>, 2>(g, E, lds, vb, nvb); } break;
    case PH_GEMM_DN0: case PH_GEMM_DN1:
        if constexpr (((DN_FP8 >> l) & 1) != 0) { Gemm g{BIG, (const bf16_t*)(ws + WS_WDN + (size_t)l * 1024 * FF * 2), T, 1024, FF / 2}; EpiResid<false, true, ph == PH_GEMM_DN0> E{nullptr, HN, ssq, ws + WS_H8, HQ_OIN, DN_UNSC}; run_gemm<EpiResid<false, true, ph == PH_GEMM_DN0>, 1>(g, E, lds, vb, nvb); }
        else { Gemm g{BIG, (const bf16_t*)(ws + WS_WDN) + (size_t)l * 1024 * FF, T, 1024, FF}; EpiResid<false, false, ph == PH_GEMM_DN0> E{nullptr, HN, ssq, ws + WS_H8, HQ_OIN}; run_gemm(g, E, lds, vb, nvb); }
        break;
    case PH_GEMM_OIN: { Gemm g{(const bf16_t*)(ws + WS_H8), (const bf16_t*)(ws + WS_OWIN), T, 2048, 512}; EpiGeluBf16<true> E{BIG, 2048, ssq, lnp, 1.f / (HQ_OIN * WQ_GU)}; run_gemm<EpiGeluBf16<true>, 2>(g, E, lds, vb, nvb); } break;
    case PH_GMLP: gmlp_mfma_phase(BIG, lnp, p.in[12], p.in[13], p.in[14], p.in[15], CAT, (LAS unsigned char*)lds, vb, nvb); break;
    case PH_GEMM_OOUT: { Gemm g{CAT, (const bf16_t*)(ws + WS_OWOUT), T, 1024, 1024}; EpiResid<false, false, true> E{nullptr, HN, ssq, ws + WS_H8, HQ_Q1}; run_gemm(g, E, lds, vb, nvb); } break;
    case PH_FINAL: final_rows(HN, ssq, p.in[25], p.out, vb, nvb); break;
    default: break;
    }
}

template <int PH> __global__ void __launch_bounds__(NTHREADS) k_phase(Params p) {
    extern __shared__ __attribute__((aligned(16))) float smem[];
    run_phase<PH>(p, (LAS float*)smem, blockIdx.x, gridDim.x);
}

template <int PH> __device__ __forceinline__ void mega_phases(const Params& p, LAS float* lds, const XcdBarrier& bar) {
    run_phase<PH>(p, lds, blockIdx.x, gridDim.x);
#ifdef REPEAT_PH
    if constexpr (PH == REPEAT_PH) { xcd_barrier(bar); run_phase<PH>(p, lds, blockIdx.x, gridDim.x); }
#endif
    if constexpr (PH + 1 < PH_COUNT) { xcd_barrier(bar); mega_phases<PH + 1>(p, lds, bar); }
}
__global__ void __launch_bounds__(NTHREADS) k_mega(Params p) {
    extern __shared__ __attribute__((aligned(16))) float smem[];
    volatile LAS unsigned* st = (volatile LAS unsigned*)((LAS float*)smem + 32768);
    if (threadIdx.x < 2) st[threadIdx.x] = 0u;
    __syncthreads();
    const XcdBarrier bar = xcd_barrier_post((unsigned*)(p.ws + WS_CTL), st);
    mega_phases<0>(p, (LAS float*)smem, bar);
}

template <int PH> static void launch_phases(const Params& p, int grid, hipStream_t stream) {
    int g = grid * 4;
    if (PH == PH_MIX0 || PH == PH_XATTN0 || PH == PH_XATTN1 || PH == PH_GMLP) g = grid;
    (void)hipFuncSetAttribute((const void*)k_phase<PH>, hipFuncAttributeMaxDynamicSharedMemorySize, LDS_BYTES);
    hipLaunchKernelGGL(k_phase<PH>, dim3(g), dim3(NTHREADS), LDS_BYTES, stream, p);
    if constexpr (PH + 1 < PH_COUNT) launch_phases<PH + 1>(p, grid, stream);
}

extern "C" void kernel_launch(void* const* d_in, const int* in_sizes, int n_in, void* d_out, int out_size, void* d_ws, size_t ws_size, hipStream_t stream) {
    static int grid = 0;
    if (grid == 0) {
        if (n_in != 26 || out_size != T * D || ws_size < WS_END) { fprintf(stderr, "kernel_launch: unexpected shapes (n_in %d out %d ws %zu)\n", n_in, out_size, ws_size); grid = -1; return; }
        int dev = 0, cus = 0;
        (void)hipGetDevice(&dev); (void)hipDeviceGetAttribute(&cus, hipDeviceAttributeMultiprocessorCount, dev);
        (void)hipFuncSetAttribute((const void*)k_mega, hipFuncAttributeMaxDynamicSharedMemorySize, LDS_BYTES);
        int per_cu = 0;
        (void)hipOccupancyMaxActiveBlocksPerMultiprocessor(&per_cu, (const void*)k_mega, NTHREADS, LDS_BYTES);
        if (per_cu < 1) fprintf(stderr, "kernel_launch: occupancy query says %d blocks per CU\n", per_cu);
        (void)hipGetLastError();
        grid = cus > 0 ? cus : 256;
    }
    if (grid < 0) return;
    Params p{};
    for (int i = 0; i < 26; ++i) p.in[i] = (const float*)d_in[i];
    p.out = (float*)d_out; p.ws = (unsigned char*)d_ws;
    (void)hipMemsetAsync((char*)d_ws + WS_CTL, 0, 16384, stream);
#if MEGA
    hipLaunchKernelGGL(k_mega, dim3(grid), dim3(NTHREADS), LDS_BYTES, stream, p);
#else
    launch_phases<0>(p, grid, stream);
#endif
}
```

```cpp
#include <hip/hip_runtime.h>
#include <stdint.h>
#include <stdio.h>

#ifndef MEGA
#define MEGA 1
#endif
#ifndef DN_FP8
#define DN_FP8 2
#endif

#define LAS __attribute__((address_space(3)))
typedef unsigned short bf16_t;
typedef short bf16x8 __attribute__((ext_vector_type(8)));
typedef float f32x4 __attribute__((ext_vector_type(4)));
typedef float f32x2 __attribute__((ext_vector_type(2)));
typedef unsigned u32x4 __attribute__((ext_vector_type(4)));
typedef unsigned u32x2 __attribute__((ext_vector_type(2)));
typedef float f32x16 __attribute__((ext_vector_type(16)));

constexpr int D = 1024, BATCH = 16, SEQ = 2048, T = BATCH * SEQ;
constexpr int CHUNK = 64;
constexpr int MEMT = 256, MT = BATCH * MEMT;
constexpr int FF = 2816;
constexpr float EPS = 1e-6f;
constexpr int NTHREADS = 512, NWAVES = 8;

constexpr int P_QL = 0, P_C = 1024, P_QI = 1152, P_KI = 1664, P_FB = 1728, P_IB = 2240, P_QB = 2752, P_GB = 3264, P_WI = 3776, P_END = 3784, PW = 3840;
constexpr int KOUT = 1536;

constexpr size_t MiB = 1u << 20;
constexpr size_t WS_CTL = 0;
constexpr size_t WS_LB = 64 * 1024;
constexpr size_t WS_SSQ = 496 * MiB;
constexpr size_t WS_LNP = 498 * MiB;
constexpr size_t WS_WIN = 1 * MiB;
constexpr size_t WS_WKV = WS_WIN + (size_t)PW * D * 2;
constexpr size_t WS_HN = WS_WKV + 2 * (size_t)D * D * 2;
constexpr size_t WS_MEMN = WS_HN + (size_t)T * D * 2;
constexpr size_t WS_WOUT = WS_MEMN + (size_t)MT * D * 2;
constexpr size_t WS_OWIN = WS_WOUT + (size_t)D * KOUT * 2;
constexpr size_t WS_OWOUT = WS_OWIN + (size_t)2048 * D * 2;
constexpr size_t WS_WQ = WS_OWOUT + (size_t)D * D * 2;
constexpr size_t WS_WO = WS_WQ + 2 * (size_t)512 * D * 2;
constexpr size_t WS_WGU = WS_WO + 2 * (size_t)D * 512 * 2;
constexpr size_t WS_WDN = WS_WGU + 2 * (size_t)2 * FF * D * 2;
constexpr size_t WS_WEND = WS_WDN + 2 * (size_t)D * FF * 2;
constexpr int TILE_WIN = 0, TILE_WKV = PW / 256, TILE_HN = TILE_WKV + 8, TILE_MEMN = TILE_HN + T / 256;
constexpr size_t WS_BIG = 132 * MiB;
constexpr size_t WS_CN = 372 * MiB;
constexpr size_t WS_CAT = 380 * MiB;
constexpr size_t WS_H8 = WS_BIG + 200 * MiB;
constexpr size_t WS_X8 = WS_CAT;
constexpr size_t WS_WIN8 = WS_CAT + 32 * MiB;
constexpr size_t WS_KB = 476 * MiB;
constexpr size_t WS_VT = 484 * MiB;
constexpr size_t WS_END = 502 * MiB;
static_assert(WS_WEND <= WS_BIG, "weights fit below BIG");

struct Params {
    const float* in[26];
    float* out;
    unsigned char* ws;
};

__device__ __forceinline__ float bf2f(unsigned short u) { return __uint_as_float(((unsigned)u) << 16); }
__device__ __forceinline__ unsigned f2bf(float f) { unsigned u = __float_as_uint(f); return (u + 0x7fffu + ((u >> 16) & 1u)) >> 16; }
typedef __bf16 bf16x2_t __attribute__((ext_vector_type(2)));
__device__ __forceinline__ unsigned pk2(float lo, float hi) { const f32x2 v = {lo, hi}; return __builtin_bit_cast(unsigned, __builtin_convertvector(v, bf16x2_t)); }
__device__ __forceinline__ float wave_sum(float v) {
#pragma unroll
    for (int o = 1; o < 64; o <<= 1) v += __shfl_xor(v, o);
    return v;
}
__device__ __forceinline__ float wave_max(float v) {
#pragma unroll
    for (int o = 1; o < 64; o <<= 1) v = fmaxf(v, __shfl_xor(v, o));
    return v;
}
__device__ __forceinline__ int otid() { int t = threadIdx.x; asm volatile("" : "+v"(t)); return t; }
#define WAVE_LDS_SYNC() asm volatile("s_waitcnt lgkmcnt(0)" ::: "memory")
__device__ __forceinline__ float silu_f(float x) { return x * __builtin_amdgcn_rcpf(1.f + __expf(-x)); }
__device__ __forceinline__ float sigmoid_f(float x) { return __builtin_amdgcn_rcpf(1.f + __expf(-x)); }

typedef int i32x4v __attribute__((ext_vector_type(4)));
typedef int i32x8v __attribute__((ext_vector_type(8)));
__device__ __forceinline__ unsigned pk4_f8(float a, float b, float c, float d) {
    a = __builtin_amdgcn_fmed3f(a, -448.f, 448.f); b = __builtin_amdgcn_fmed3f(b, -448.f, 448.f); c = __builtin_amdgcn_fmed3f(c, -448.f, 448.f); d = __builtin_amdgcn_fmed3f(d, -448.f, 448.f);
    int w = 0;
    w = __builtin_amdgcn_cvt_pk_fp8_f32(a, b, w, false);
    w = __builtin_amdgcn_cvt_pk_fp8_f32(c, d, w, true);
    return (unsigned)w;
}
constexpr float ACT_SC = 8.f, WDN_SC = 256.f, DN_UNSC = 1.f / (ACT_SC * WDN_SC);
constexpr float XO_SC = 64.f, WO_SC = 128.f, XO_UNSC = 1.f / (XO_SC * WO_SC);
constexpr float HQ_X = 127.f / 4.2f;
constexpr float HQ_Q0 = 127.f / 5.2f, HQ_GU0 = 127.f / 5.2f, HQ_OIN = 127.f / 5.8f, HQ_Q1 = 127.f / 6.3f, HQ_GU1 = 127.f / 6.3f, WQ_GU = 127.f / 0.13f;
__device__ __forceinline__ unsigned pk4_i8(float a, float b, float c, float d, float sc) {
    constexpr float MG = 12582912.f;
    const unsigned ua = __float_as_uint(__builtin_amdgcn_fmed3f(__builtin_fmaf(a, sc, MG), MG - 127.f, MG + 127.f)), ub = __float_as_uint(__builtin_amdgcn_fmed3f(__builtin_fmaf(b, sc, MG), MG - 127.f, MG + 127.f));
    const unsigned uc = __float_as_uint(__builtin_amdgcn_fmed3f(__builtin_fmaf(c, sc, MG), MG - 127.f, MG + 127.f)), ud = __float_as_uint(__builtin_amdgcn_fmed3f(__builtin_fmaf(d, sc, MG), MG - 127.f, MG + 127.f));
    return __builtin_amdgcn_perm(ub, ua, 0x0c0c0400u) | __builtin_amdgcn_perm(ud, uc, 0x04000c0cu);
}
__device__ __forceinline__ int kperm8(int k) { const int r = k & 255; return (k & ~255) + ((r >> 5) & 3) * 64 + ((r >> 3) & 3) * 16 + (r >> 7) * 8 + (r & 7); }
__device__ __forceinline__ f32x4 i2f4(f32x4 v) { const i32x4v t = __builtin_bit_cast(i32x4v, v); return (f32x4){(float)t.x, (float)t.y, (float)t.z, (float)t.w}; }
struct Unit { int pm, pn; };
struct Gemm { const bf16_t* A; const bf16_t* Bt; int M, N, K; };
__device__ __forceinline__ int perm32(int rho) { const int n = rho >> 4, i = rho & 15; return 8 * (i >> 2) + 4 * n + (i & 3); }

__device__ __forceinline__ float row_rstd(const float* ssq, size_t row) {
    const f32x4* p = (const f32x4*)(ssq + row * 16);
    const f32x4 a = p[0], b = p[1], c = p[2], d = p[3];
    const float t = (((a.x + a.y) + (a.z + a.w)) + ((b.x + b.y) + (b.z + b.w))) + (((c.x + c.y) + (c.z + c.w)) + ((d.x + d.y) + (d.z + d.w)));
    return rsqrtf(t * (1.f / 1024.f) + EPS);
}
__device__ __forceinline__ void rows_rstd(const float* ssq, size_t row0, int fq, float (&rs)[2][4]) {
#pragma unroll
    for (int ai = 0; ai < 2; ++ai)
#pragma unroll
        for (int m = 0; m < 4; ++m) { const f32x4 a = *(const f32x4*)(ssq + (row0 + ai * 128 + m * 16) * 16 + 4 * fq); rs[ai][m] = (a.x + a.y) + (a.z + a.w); }
#pragma unroll
    for (int ai = 0; ai < 2; ++ai)
#pragma unroll
        for (int m = 0; m < 4; ++m) { float t = rs[ai][m]; t += __shfl_xor(t, 16); t += __shfl_xor(t, 32); rs[ai][m] = rsqrtf(t * (1.f / 1024.f) + EPS); }
}
template <bool ACC_I8 = false, bool REMAP = false> struct EpiStoreBf16 {
    static constexpr bool PERM = true, AFTER_DRAIN = false;
    bf16_t* O; int ldc; const float* ssq; float dq = 1.f;
    __device__ __forceinline__ void operator()(const f32x4 (&acc)[2][2][4][2], const Unit& u, int wr, int wc, int fr, int fq) const {
        const int ct = REMAP ? (u.pn < 4 ? u.pn : u.pn + 3) : u.pn;
        const int row0 = u.pm * 256 + wr * 64 + fr, col0 = ct * 256 + wc * 32 + 8 * fq;
        float rsv[2][4]; rows_rstd(ssq, (size_t)row0, fq, rsv);
#pragma unroll
        for (int ai = 0; ai < 2; ++ai)
#pragma unroll
            for (int m = 0; m < 4; ++m) {
                const float rs = ACC_I8 ? rsv[ai][m] * dq : rsv[ai][m];
                bf16_t* rowp = O + (size_t)(row0 + ai * 128 + m * 16) * ldc + col0;
#pragma unroll
                for (int bj = 0; bj < 2; ++bj) {
                    const f32x4 v0 = (ACC_I8 ? i2f4(acc[ai][bj][m][0]) : acc[ai][bj][m][0]) * rs, v1 = (ACC_I8 ? i2f4(acc[ai][bj][m][1]) : acc[ai][bj][m][1]) * rs;
                    u32x4 w; w.x = pk2(v0[0], v0[1]); w.y = pk2(v0[2], v0[3]); w.z = pk2(v1[0], v1[1]); w.w = pk2(v1[2], v1[3]);
                    *(u32x4*)(rowp + bj * 128) = w;
                }
            }
    }
};
struct EpiIn {
    static constexpr bool PERM = true, AFTER_DRAIN = false;
    bf16_t* P; bf16_t* KB; bf16_t* VT; const float* ssq;
    __device__ __forceinline__ void operator()(const f32x4 (&acc)[2][2][4][2], const Unit& u, int wr, int wc, int fr, int fq) const {
        bf16_t* O; int ldc, rt, ct; const bool main_unit = u.pn < TILE_WKV;
        if (main_unit) { O = P; ldc = PW; rt = u.pm - TILE_HN; ct = u.pn; }
        else if (u.pm >= TILE_MEMN) { const int l = (u.pn - TILE_WKV) >> 2; O = KB + (size_t)l * MT * 512; ldc = 512; rt = u.pm - TILE_MEMN; ct = (u.pn - TILE_WKV) & 3; }
        else { const int l = (u.pm - TILE_WKV) >> 2; O = VT + (size_t)l * 512 * MT; ldc = MT; rt = ((u.pm - TILE_WKV) & 3) - 2; ct = u.pn - TILE_MEMN; }
        const int row0 = rt * 256 + wr * 64 + fr, col0 = ct * 256 + wc * 32 + 8 * fq;
        float rsv[2][4];
        if (main_unit) rows_rstd(ssq, (size_t)row0, fq, rsv);
        else {
#pragma unroll
            for (int ai = 0; ai < 2; ++ai)
#pragma unroll
                for (int m = 0; m < 4; ++m) rsv[ai][m] = 1.f; }
#pragma unroll
        for (int ai = 0; ai < 2; ++ai)
#pragma unroll
            for (int m = 0; m < 4; ++m) {
                const float rs = rsv[ai][m];
                bf16_t* rowp = O + (size_t)(row0 + ai * 128 + m * 16) * ldc + col0;
#pragma unroll
                for (int bj = 0; bj < 2; ++bj) {
                    const f32x4 v0 = acc[ai][bj][m][0] * rs, v1 = acc[ai][bj][m][1] * rs;
                    u32x4 w; w.x = pk2(v0[0], v0[1]); w.y = pk2(v0[2], v0[3]); w.z = pk2(v1[0], v1[1]); w.w = pk2(v1[2], v1[3]);
                    *(u32x4*)(rowp + bj * 128) = w;
                }
            }
    }
};
template <bool ACC_I8 = false> struct EpiGeluBf16 {
    static constexpr bool PERM = true, AFTER_DRAIN = false;
    bf16_t* O; int ldc; const float* ssq; float* lnp; float dq = 1.f;
    __device__ __forceinline__ static f32x2 gelu_pk(f32x2 v) {
        const f32x2 av = __builtin_elementwise_abs(v), d = av * 0.2316418882f + 1.0f;
        f32x2 t; t.x = __builtin_amdgcn_rcpf(d.x); t.y = __builtin_amdgcn_rcpf(d.y);
        f32x2 q = t * 0.5307027145f + (-0.7265760135f); q = q * t + 0.7107068705f; q = q * t + (-0.142248368f); q = q * t + 0.127414796f; q = q * t;
        const f32x2 sq = (v * v) * (-0.72134752044f);
        f32x2 e; e.x = __builtin_amdgcn_exp2f(sq.x); e.y = __builtin_amdgcn_exp2f(sq.y);
        const f32x2 mm = v * (q * e), r = v - mm;
        f32x2 o; o.x = v.x < 0.f ? mm.x : r.x; o.y = v.y < 0.f ? mm.y : r.y; return o;
    }
    __device__ __forceinline__ static unsigned g2(float a, float b) { const f32x2 r = gelu_pk((f32x2){a, b}); return pk2(r.x, r.y); }
    __device__ __forceinline__ void operator()(const f32x4 (&acc)[2][2][4][2], const Unit& u, int wr, int wc, int fr, int fq) const {
        const int row0 = u.pm * 256 + wr * 64 + fr, col0 = u.pn * 256 + wc * 32 + 8 * fq;
        float rsv[2][4]; rows_rstd(ssq, (size_t)row0, fq, rsv);
#pragma unroll
        for (int ai = 0; ai < 2; ++ai)
#pragma unroll
            for (int m = 0; m < 4; ++m) {
                const size_t row = (size_t)(row0 + ai * 128 + m * 16);
                const float rs = ACC_I8 ? rsv[ai][m] * dq : rsv[ai][m];
                bf16_t* rowp = O + row * ldc + col0;
                float s1 = 0.f, s2 = 0.f;
#pragma unroll
                for (int bj = 0; bj < 2; ++bj) {
                    const f32x4 v0 = (ACC_I8 ? i2f4(acc[ai][bj][m][0]) : acc[ai][bj][m][0]) * rs, v1 = (ACC_I8 ? i2f4(acc[ai][bj][m][1]) : acc[ai][bj][m][1]) * rs;
                    const f32x2 ga = gelu_pk((f32x2){v0[0], v0[1]}), gb = gelu_pk((f32x2){v0[2], v0[3]}), gc = gelu_pk((f32x2){v1[0], v1[1]}), gd = gelu_pk((f32x2){v1[2], v1[3]});
                    u32x4 w; w.x = pk2(ga.x, ga.y); w.y = pk2(gb.x, gb.y); w.z = pk2(gc.x, gc.y); w.w = pk2(gd.x, gd.y);
                    *(u32x4*)(rowp + bj * 128) = w;
                    s1 += ((ga.x + ga.y) + (gb.x + gb.y)) + ((gc.x + gc.y) + (gd.x + gd.y));
                    s2 += ((ga.x * ga.x + ga.y * ga.y) + (gb.x * gb.x + gb.y * gb.y)) + ((gc.x * gc.x + gc.y * gc.y) + (gd.x * gd.x + gd.y * gd.y));
                }
                if (u.pn >= 4) {
                    s1 += __shfl_xor(s1, 16); s1 += __shfl_xor(s1, 32); s2 += __shfl_xor(s2, 16); s2 += __shfl_xor(s2, 32);
                    if (fq == 0) *(f32x2*)(lnp + (row * 16 + (u.pn - 4) * 4 + wc) * 2) = (f32x2){s1, s2};
                }
            }
    }
};
struct EpiSwigluBf16 {
    static constexpr bool PERM = true, AFTER_DRAIN = false;
    bf16_t* O; int ldc; const float* ssq;
    __device__ __forceinline__ void operator()(const f32x4 (&acc)[2][2][4][2], const Unit& u, int wr, int wc, int fr, int fq) const {
        const int row0 = u.pm * 256 + wr * 64 + fr, col0 = u.pn * 128 + wc * 32 + 8 * fq;
        float rsv[2][4]; rows_rstd(ssq, (size_t)row0, fq, rsv);
#pragma unroll
        for (int ai = 0; ai < 2; ++ai)
#pragma unroll
            for (int m = 0; m < 4; ++m) {
                const float rs = rsv[ai][m];
                bf16_t* rowp = O + (size_t)(row0 + ai * 128 + m * 16) * ldc + col0;
                const f32x4 g0 = acc[ai][0][m][0] * rs, g1 = acc[ai][0][m][1] * rs, u0 = acc[ai][1][m][0] * rs, u1 = acc[ai][1][m][1] * rs;
                u32x4 w;
                w.x = pk2(silu_f(g0[0]) * u0[0], silu_f(g0[1]) * u0[1]); w.y = pk2(silu_f(g0[2]) * u0[2], silu_f(g0[3]) * u0[3]);
                w.z = pk2(silu_f(g1[0]) * u1[0], silu_f(g1[1]) * u1[1]); w.w = pk2(silu_f(g1[2]) * u1[2], silu_f(g1[3]) * u1[3]);
                *(u32x4*)rowp = w;
            }
    }
};
template <bool ACC_I8, bool OUT_F8> struct EpiSwigluQ {
    static constexpr bool PERM = true, AFTER_DRAIN = false;
    void* O; int ldc; const float* ssq; float dq;
    __device__ __forceinline__ void operator()(const f32x4 (&acc)[2][2][4][2], const Unit& u, int wr, int wc, int fr, int fq) const {
        const int row0 = u.pm * 256 + wr * 64 + fr, col0 = u.pn * 128 + wc * 32 + 8 * fq;
        float rsv[2][4]; rows_rstd(ssq, (size_t)row0, fq, rsv);
#pragma unroll
        for (int ai = 0; ai < 2; ++ai)
#pragma unroll
            for (int m = 0; m < 4; ++m) {
                const float rs = ACC_I8 ? rsv[ai][m] * dq : rsv[ai][m], rsu = OUT_F8 ? rs * ACT_SC : rs;
                f32x4 g0 = acc[ai][0][m][0], g1 = acc[ai][0][m][1], u0 = acc[ai][1][m][0], u1 = acc[ai][1][m][1];
                if (ACC_I8) { g0 = i2f4(g0); g1 = i2f4(g1); u0 = i2f4(u0); u1 = i2f4(u1); }
                g0 = g0 * rs; g1 = g1 * rs; u0 = u0 * rsu; u1 = u1 * rsu;
                if (OUT_F8) {
                    unsigned char* rowp = (unsigned char*)O + (size_t)(row0 + ai * 128 + m * 16) * ldc + col0;
                    u32x2 w;
                    w.x = pk4_f8(silu_f(g0[0]) * u0[0], silu_f(g0[1]) * u0[1], silu_f(g0[2]) * u0[2], silu_f(g0[3]) * u0[3]);
                    w.y = pk4_f8(silu_f(g1[0]) * u1[0], silu_f(g1[1]) * u1[1], silu_f(g1[2]) * u1[2], silu_f(g1[3]) * u1[3]);
                    *(u32x2*)rowp = w;
                } else {
                    bf16_t* rowp = (bf16_t*)O + (size_t)(row0 + ai * 128 + m * 16) * ldc + col0;
                    u32x4 w;
                    w.x = pk2(silu_f(g0[0]) * u0[0], silu_f(g0[1]) * u0[1]); w.y = pk2(silu_f(g0[2]) * u0[2], silu_f(g0[3]) * u0[3]);
                    w.z = pk2(silu_f(g1[0]) * u1[0], silu_f(g1[1]) * u1[1]); w.w = pk2(silu_f(g1[2]) * u1[2], silu_f(g1[3]) * u1[3]);
                    *(u32x4*)rowp = w;
                }
            }
    }
};
template <bool BASE_F32, bool SCALED = false, bool W8 = false> struct EpiResid {
    static constexpr bool PERM = true, AFTER_DRAIN = false;
    const float* xbase; bf16_t* H; float* ssq; unsigned char* H8 = nullptr; float hq = 0.f; float asc = 1.f;
    __device__ __forceinline__ void operator()(const f32x4 (&acc)[2][2][4][2], const Unit& u, int wr, int wc, int fr, int fq) const {
        const int row0 = u.pm * 256 + wr * 64 + fr, col0 = u.pn * 256 + wc * 32 + 8 * fq;
#pragma unroll
        for (int ai = 0; ai < 2; ++ai)
#pragma unroll
            for (int m = 0; m < 4; ++m) {
                const size_t row = (size_t)(row0 + ai * 128 + m * 16);
                float ss = 0.f; u32x4 q8 = (u32x4){0u, 0u, 0u, 0u};
#pragma unroll
                for (int bj = 0; bj < 2; ++bj) {
                    const size_t off = row * 1024 + col0 + bj * 128;
                    f32x4 b0, b1;
                    if (BASE_F32) { b0 = *(const f32x4*)(xbase + off); b1 = *(const f32x4*)(xbase + off + 4); }
                    else { const u32x4 hw = *(const u32x4*)(H + off);
                        b0 = (f32x4){bf2f((unsigned short)(hw.x & 0xffffu)), bf2f((unsigned short)(hw.x >> 16)), bf2f((unsigned short)(hw.y & 0xffffu)), bf2f((unsigned short)(hw.y >> 16))};
                        b1 = (f32x4){bf2f((unsigned short)(hw.z & 0xffffu)), bf2f((unsigned short)(hw.z >> 16)), bf2f((unsigned short)(hw.w & 0xffffu)), bf2f((unsigned short)(hw.w >> 16))}; }
                    const float sc = SCALED ? asc : 1.f;
                    const f32x4 v0 = b0 + acc[ai][bj][m][0] * sc, v1 = b1 + acc[ai][bj][m][1] * sc;
                    u32x4 w; w.x = pk2(v0[0], v0[1]); w.y = pk2(v0[2], v0[3]); w.z = pk2(v1[0], v1[1]); w.w = pk2(v1[2], v1[3]);
                    *(u32x4*)(H + off) = w;
                    if (W8) { q8[2 * bj] = pk4_i8(v0[0], v0[1], v0[2], v0[3], hq); q8[2 * bj + 1] = pk4_i8(v1[0], v1[1], v1[2], v1[3], hq); }
                    ss += ((v0[0] * v0[0] + v0[1] * v0[1]) + (v0[2] * v0[2] + v0[3] * v0[3])) + ((v1[0] * v1[0] + v1[1] * v1[1]) + (v1[2] * v1[2] + v1[3] * v1[3]));
                }
                if (W8) *(u32x4*)(H8 + row * 1024 + u.pn * 256 + wc * 64 + fq * 16) = q8;
                ss += __shfl_xor(ss, 16); ss += __shfl_xor(ss, 32);
                if (fq == 0) ssq[row * 16 + u.pn * 4 + wc] = ss;
            }
    }
};
namespace pg8 {
#define PG8_LAS __attribute__((address_space(3)))
constexpr int BM = 256, BK = 64, HALF = 128, HTB = HALF * BK * 2  , STAGE_BYTES = 8 * HTB, NXCD = 8, WGM = 8;
__host__ __device__ __forceinline__ int lds_byte(int r, int c) { const int st = (r >> 4) * 2 + (c >> 5), rr = r & 15, cc = c & 31, ob = rr * 64 + cc * 2; return st * 1024 + (ob ^ (((ob >> 9) & 1) << 5)); }
__host__ __device__ __forceinline__ void stage_rc(int b, int& R, int& C) { const int st = b / 1024, sb = b % 1024, swz = sb ^ (((sb >> 9) & 1) << 5); R = (st >> 1) * 16 + swz / 64; C = (st & 1) * 32 + (swz % 64) / 2; }
struct StaticOrder {
    int nM, nN, nwg, G, c;
    __host__ __device__ void init(int M, int N, int G_, int c_) { nM = M / BM; nN = N / BM; nwg = nM * nN; G = G_; c = c_; }
    __host__ __device__ bool next(int i, Unit& u) const {
        const long L = (long)i * G + c; if (L >= nwg) return false;
        int wgid = (int)L; { const int q = nwg / NXCD, r = nwg % NXCD, xcd = wgid % NXCD, off = wgid / NXCD; wgid = (xcd < r ? xcd * (q + 1) : r * (q + 1) + (xcd - r) * q) + off; }
        const int nig = WGM * nN, gid = wgid / nig, fm = gid * WGM, gsz = (nM - fm) < WGM ? (nM - fm) : WGM;
        u.pm = fm + ((wgid % nig) % gsz); u.pn = (wgid % nig) / gsz; return true;
    }
    __device__ __forceinline__ void a_ready(const Unit&) const {}
    __device__ __forceinline__ void done(const Unit&) const {}
};
struct ComboOrder {
    StaticOrder so;
    __host__ __device__ void init(int G_, int c_) { so.init(T, 1024, G_, c_); }
    __host__ __device__ bool next(int i, Unit& u) const {
        const long L = (long)i * so.G + so.c;
        if (L < so.nwg) { so.next(i, u); u.pm += TILE_HN; u.pn = u.pn < 3 ? u.pn + 4 : 14; return true; }
        const int j = (int)(L - so.nwg); if (j >= 128) return false;
        const int l = j >> 6, jj = j & 63;
        if (jj < 32) { u.pm = TILE_MEMN + (jj >> 1); u.pn = TILE_WKV + 4 * l + (jj & 1); }
        else { const int q = jj - 32; u.pm = TILE_WKV + 4 * l + 2 + (q >> 4); u.pn = TILE_MEMN + (q & 15); }
        return true;
    }
    __device__ __forceinline__ void a_ready(const Unit&) const {}
    __device__ __forceinline__ void done(const Unit&) const {}
};
template <class Epi, class Sched, bool ALIGN_EPI = false, bool SP2 = false, int QM = 0  >
__device__ __forceinline__ void gemm_phase(PG8_LAS unsigned char* lds, const Gemm g, const Sched& S, const Epi& E) {
    const int tid = otid(), wid = __builtin_amdgcn_readfirstlane(tid >> 6), lane = tid & 63, wr = wid >> 2, wc = wid & 3, fr = lane & 15, fq = lane >> 4;
    constexpr bool FP8 = (QM == 1), I8 = (QM == 2);
    const int K = g.K, nt = K / BK;
    unsigned voffA[2], voffB[2];
#pragma unroll
    for (int i = 0; i < 2; ++i) { int R, C; stage_rc(tid * 16 + i * 8192, R, C); const int Rb = Epi::PERM ? ((R & ~31) + perm32(R & 31)) : R;
        voffA[i] = (unsigned)(R * K + C) * 2u; voffB[i] = (unsigned)(Rb * K + C) * 2u; }
    const size_t kstep = (size_t)(BK * 2);
    const size_t hstep = (size_t)HALF * K * 2;
    const size_t tstep = 2 * hstep;
    const unsigned ldsw = (unsigned)wid * 1024u;
    const int aoff = lds_byte(wr * 64 + fr, fq * 8), boff = lds_byte(wc * 32 + fr, fq * 8);
#define PG8_SA(b, h) (((b) * 2 + (h)) * HTB)
#define PG8_SB(b, h) ((4 + (b) * 2 + (h)) * HTB)
#define PG8_STAGE(bufoff, gbase, voff) do { _Pragma("unroll") for (int _i = 0; _i < 2; ++_i) \
        __builtin_amdgcn_global_load_lds((const unsigned*)((const char*)(gbase) + (voff)[_i]), (PG8_LAS unsigned*)(lds + (bufoff) + ldsw + _i * 8192), 16, 0, 0); } while (0)
#define PG8_LD16(off) (*(const PG8_LAS bf16x8*)(lds + (off)))
#define PG8_LDA(dst, b, h) do { _Pragma("unroll") for (int m = 0; m < 4; ++m) { \
        if constexpr (FP8) dst##8[m] = PG8_CAT(PG8_LD16(PG8_SA(b, h) + aoff + m * 2048), PG8_LD16(PG8_SA(b, h) + aoff + m * 2048 + 1024)); \
        else { _Pragma("unroll") for (int k = 0; k < 2; ++k) dst[m][k] = PG8_LD16(PG8_SA(b, h) + aoff + m * 2048 + k * 1024); } } } while (0)
#define PG8_LDB(dst, b, h) do { _Pragma("unroll") for (int n = 0; n < 2; ++n) { \
        if constexpr (FP8) dst##8[n] = PG8_CAT(PG8_LD16(PG8_SB(b, h) + boff + n * 2048), PG8_LD16(PG8_SB(b, h) + boff + n * 2048 + 1024)); \
        else { _Pragma("unroll") for (int k = 0; k < 2; ++k) dst[n][k] = PG8_LD16(PG8_SB(b, h) + boff + n * 2048 + k * 1024); } } } while (0)
#define PG8_CAT(x, y) __builtin_shufflevector(__builtin_bit_cast(i32x4v, x), __builtin_bit_cast(i32x4v, y), 0, 1, 2, 3, 4, 5, 6, 7)
#define PG8_MMA(ai, bj, At, Bt) do { __builtin_amdgcn_s_setprio(1); \
        if constexpr (FP8) { _Pragma("unroll") for (int m = 0; m < 4; ++m) _Pragma("unroll") for (int n = 0; n < 2; ++n) \
            asm("v_mfma_f32_16x16x128_f8f6f4 %0, %1, %2, %0" : "+v"(acc[ai][bj][m][n]) : "v"(Bt##8[n]), "v"(At##8[m])); } \
        else if constexpr (I8) { _Pragma("unroll") for (int m = 0; m < 4; ++m) _Pragma("unroll") for (int n = 0; n < 2; ++n) _Pragma("unroll") for (int k = 0; k < 2; ++k) \
            acc[ai][bj][m][n] = __builtin_bit_cast(f32x4, __builtin_amdgcn_mfma_i32_16x16x64_i8(__builtin_bit_cast(i32x4v, Bt[n][k]), __builtin_bit_cast(i32x4v, At[m][k]), __builtin_bit_cast(i32x4v, acc[ai][bj][m][n]), 0, 0, 0)); } \
        else { _Pragma("unroll") for (int m = 0; m < 4; ++m) _Pragma("unroll") for (int n = 0; n < 2; ++n) _Pragma("unroll") for (int k = 0; k < 2; ++k) \
            acc[ai][bj][m][n] = __builtin_amdgcn_mfma_f32_16x16x32_bf16(Bt[n][k], At[m][k], acc[ai][bj][m][n], 0, 0, 0); } \
        __builtin_amdgcn_s_setprio(0); } while (0)
#define PG8_WAIT_V(n) asm volatile("s_waitcnt vmcnt(" #n ")" ::: "memory")
#define PG8_WAIT_L(n) asm volatile("s_waitcnt lgkmcnt(" #n ")" ::: "memory")
#define PG8_BAR __builtin_amdgcn_s_barrier()
#define PG8_SCHED __builtin_amdgcn_sched_barrier(0)
    Unit cur, nxt; int ui = 0;
    if (!S.next(0, cur)) return;
    f32x4 acc[2][2][4][2];
#pragma unroll
    for (int a = 0; a < 2; ++a)
#pragma unroll
        for (int b = 0; b < 2; ++b)
#pragma unroll
            for (int m = 0; m < 4; ++m)
#pragma unroll
                for (int n = 0; n < 2; ++n) acc[a][b][m][n] = (f32x4){0.f, 0.f, 0.f, 0.f};
    bf16x8 At[4][2], B0[2][2], B1[2][2];
    i32x8v At8[4], B08[2], B18[2];
    const char* cA = (const char*)g.A + (size_t)cur.pm * tstep; const char* cB = (const char*)g.Bt + (size_t)cur.pn * tstep;
    S.a_ready(cur);
    if constexpr (SP2) {
        PG8_STAGE(PG8_SB(0, 0), cB, voffB); PG8_STAGE(PG8_SB(0, 1), cB + hstep, voffB); PG8_STAGE(PG8_SA(0, 0), cA, voffA); PG8_STAGE(PG8_SA(0, 1), cA + hstep, voffA);
        if (wr == 1) PG8_BAR;
        PG8_WAIT_V(2); PG8_BAR;
        PG8_STAGE(PG8_SB(1, 0), cB + kstep, voffB); PG8_STAGE(PG8_SA(1, 0), cA + kstep, voffA); PG8_STAGE(PG8_SB(1, 1), cB + hstep + kstep, voffB);
        PG8_WAIT_V(6); PG8_BAR;
    } else {
        PG8_STAGE(PG8_SB(0, 0), cB, voffB); PG8_STAGE(PG8_SA(0, 0), cA, voffA); PG8_STAGE(PG8_SB(0, 1), cB + hstep, voffB); PG8_STAGE(PG8_SA(0, 1), cA + hstep, voffA);
        if (wr == 1) PG8_BAR;
        PG8_WAIT_V(4); PG8_BAR;
        PG8_STAGE(PG8_SB(1, 0), cB + kstep, voffB); PG8_STAGE(PG8_SA(1, 0), cA + kstep, voffA); PG8_STAGE(PG8_SB(1, 1), cB + hstep + kstep, voffB);
        PG8_WAIT_V(6); PG8_BAR;
    }
    for (;;) {
        const bool has_next = S.next(ui + 1, nxt);
        const char* nA = has_next ? (const char*)g.A + (size_t)nxt.pm * tstep : cA; const char* nB = has_next ? (const char*)g.Bt + (size_t)nxt.pn * tstep : cB;
        for (int t = 0; t < nt; t += 2) {
            const bool last = (t == nt - 2);
            if constexpr (FP8) __builtin_amdgcn_s_waitcnt(0xC07F);
            const char* a1 = cA + (size_t)(t + 1) * kstep;
            const char* a2 = last ? nA : cA + (size_t)(t + 2) * kstep; const char* b2 = last ? nB : cB + (size_t)(t + 2) * kstep;
            const char* a3 = a2 + kstep; const char* b3 = b2 + kstep;
            if (last && has_next) S.a_ready(nxt);
            if constexpr (SP2) {
            PG8_LDB(B0, 0, 0); PG8_LDB(B1, 0, 1); PG8_SCHED; PG8_LDA(At, 0, 0); PG8_STAGE(PG8_SA(1, 1), a1 + hstep, voffA);
            PG8_WAIT_V(8); PG8_WAIT_L(0); PG8_BAR; PG8_MMA(0, 0, At, B0); PG8_MMA(0, 1, At, B1); PG8_BAR; PG8_SCHED;
            PG8_LDA(At, 0, 1); PG8_STAGE(PG8_SB(0, 0), b2, voffB); PG8_STAGE(PG8_SB(0, 1), b2 + hstep, voffB); PG8_STAGE(PG8_SA(0, 0), a2, voffA);
            PG8_WAIT_V(8); PG8_WAIT_L(0); PG8_BAR; PG8_MMA(1, 0, At, B0); PG8_MMA(1, 1, At, B1); PG8_BAR; PG8_SCHED;
            PG8_LDB(B0, 1, 0); PG8_LDB(B1, 1, 1); PG8_SCHED; PG8_LDA(At, 1, 0); PG8_STAGE(PG8_SA(0, 1), a2 + hstep, voffA);
            PG8_WAIT_V(8); PG8_WAIT_L(0); PG8_BAR; PG8_MMA(0, 0, At, B0); PG8_MMA(0, 1, At, B1); PG8_BAR; PG8_SCHED;
            PG8_LDA(At, 1, 1); PG8_STAGE(PG8_SB(1, 0), b3, voffB); PG8_STAGE(PG8_SB(1, 1), b3 + hstep, voffB); PG8_STAGE(PG8_SA(1, 0), a3, voffA);
            PG8_WAIT_V(8); PG8_WAIT_L(0); PG8_BAR; PG8_MMA(1, 0, At, B0); PG8_MMA(1, 1, At, B1); PG8_BAR; PG8_SCHED;
            } else {
            PG8_LDB(B0, 0, 0); PG8_SCHED; PG8_LDA(At, 0, 0); PG8_STAGE(PG8_SA(1, 1), a1 + hstep, voffA);
            PG8_WAIT_L(8); PG8_BAR; PG8_WAIT_L(0); PG8_MMA(0, 0, At, B0); PG8_BAR; PG8_SCHED;
            PG8_LDB(B1, 0, 1); PG8_STAGE(PG8_SB(0, 0), b2, voffB);
            PG8_BAR; PG8_WAIT_L(0); PG8_MMA(0, 1, At, B1); PG8_BAR;
            PG8_LDA(At, 0, 1); PG8_STAGE(PG8_SA(0, 0), a2, voffA);
            PG8_BAR; PG8_WAIT_L(0); PG8_MMA(1, 0, At, B0); PG8_BAR; PG8_SCHED;
            PG8_STAGE(PG8_SB(0, 1), b2 + hstep, voffB);
            PG8_WAIT_V(6); PG8_BAR; PG8_MMA(1, 1, At, B1); PG8_BAR;
            PG8_LDB(B0, 1, 0); PG8_SCHED; PG8_LDA(At, 1, 0); PG8_STAGE(PG8_SA(0, 1), a2 + hstep, voffA);
            PG8_WAIT_L(8); PG8_BAR; PG8_WAIT_L(0); PG8_MMA(0, 0, At, B0); PG8_BAR; PG8_SCHED;
            PG8_LDB(B1, 1, 1); PG8_STAGE(PG8_SB(1, 0), b3, voffB);
            PG8_BAR; PG8_WAIT_L(0); PG8_MMA(0, 1, At, B1); PG8_BAR;
            PG8_LDA(At, 1, 1); PG8_STAGE(PG8_SA(1, 0), a3, voffA);
            PG8_BAR; PG8_WAIT_L(0); PG8_MMA(1, 0, At, B0); PG8_BAR; PG8_SCHED;
            PG8_STAGE(PG8_SB(1, 1), b3 + hstep, voffB);
            PG8_WAIT_V(6); PG8_BAR; PG8_MMA(1, 1, At, B1); PG8_BAR;
            }
        }
        if constexpr (FP8) asm volatile("s_nop 15\n\ts_nop 15" ::: "memory");
        if constexpr (ALIGN_EPI) { if (wr == 0) PG8_BAR; }
        if constexpr (!Epi::AFTER_DRAIN) { E(acc, cur, wr, wc, fr, fq); S.done(cur); }
        if (!has_next) break;
#pragma unroll
        for (int a = 0; a < 2; ++a)
#pragma unroll
            for (int b = 0; b < 2; ++b)
#pragma unroll
                for (int m = 0; m < 4; ++m)
#pragma unroll
                    for (int n = 0; n < 2; ++n) acc[a][b][m][n] = (f32x4){0.f, 0.f, 0.f, 0.f};
        cur = nxt; cA = nA; cB = nB; ++ui;
        if constexpr (ALIGN_EPI) { if (wr == 1) PG8_BAR; }
    }
    PG8_WAIT_V(0);
    if constexpr (!ALIGN_EPI) { if (wr == 0) PG8_BAR; }
    PG8_BAR;
    if constexpr (Epi::AFTER_DRAIN) { E.fused(acc, cur, wr, wc, fr, fq, lds, wid, lane); S.done(cur); }
#undef PG8_SA
#undef PG8_SB
#undef PG8_STAGE
#undef PG8_LDA
#undef PG8_LD16
#undef PG8_LDB
#undef PG8_MMA
#undef PG8_CAT
#undef PG8_WAIT_V
#undef PG8_WAIT_L
#undef PG8_BAR
#undef PG8_SCHED
}
}

template <class Epi, int QM = 0>
__device__ __forceinline__ void run_gemm(const Gemm g, const Epi& E, LAS float* lds, int vb, int nvb) {
    pg8::StaticOrder S; S.init(g.M, g.N, nvb, vb);
    pg8::gemm_phase<Epi, pg8::StaticOrder, true, true, QM>((LAS unsigned char*)lds, g, S, E);
}

enum { MAP_ID = 0, MAP_WIN = 1, MAP_GU = 2, MAP_WIN8 = 3   };
struct PrepJob { const float* W; int K, N; const float* gain; bf16_t* dst; int r0, r1, ldd, koff, map; int fmt; float osc; };
__device__ __forceinline__ int map_src(int map, int r, int N) {
    if (map == MAP_ID) return r < N ? r : -1;
    if (map == MAP_WIN) {
        if (r < 1728) return r - 512;
        if (r < 3776) return r - 504;
        if (r < 3784) return r - 2560;
        return -1;
    }
    if (map == MAP_WIN8) return r + 264;
    { const int tile = r >> 8, w = r & 255, j = tile * 128 + (w & 127); return w < 128 ? j : FF + j; }
}
__device__ __forceinline__ void prep_tile_load(const PrepJob& j, int t, f32x4 (&v)[8]) {
    const int nkt = j.K / 64, kt = t % nkt, rt = t / nkt, k0 = kt * 64, r0 = j.r0 + rt * 256;
#pragma unroll
    for (int q = 0; q < 8; ++q) {
        const int i = (int)threadIdx.x + q * NTHREADS, kk = i >> 6, r4 = (i & 63) * 4;
        const int sc = map_src(j.map, r0 + r4, j.N);
        v[q] = sc >= 0 ? __builtin_nontemporal_load((const f32x4*)(j.W + (size_t)(k0 + kk) * j.N + sc)) : (f32x4){0.f, 0.f, 0.f, 0.f};
        if (j.gain) v[q] = v[q] * j.gain[k0 + kk];
    }
}
__device__ __forceinline__ void prep_tile_store(const PrepJob& j, int t, const f32x4 (&v)[8], LAS float* tile  ) {
    const int nkt = j.K / 64, kt = t % nkt, rt = t / nkt, k0 = kt * 64, r0 = j.r0 + rt * 256;
    __syncthreads();
#pragma unroll
    for (int q = 0; q < 8; ++q) { const int i = (int)threadIdx.x + q * NTHREADS, kk = i >> 6, r4 = (i & 63) * 4; *(LAS f32x4*)(tile + kk * 260 + r4) = v[q]; }
    __syncthreads();
#pragma unroll
    for (int q = 0; q < 4; ++q) {
        const int i = (int)threadIdx.x + q * NTHREADS, rr = i & 255, c8 = i >> 8;
        const LAS float* tp = tile + (c8 * 8) * 260 + rr;
        if (j.fmt != 0) {
            const float sc = j.osc; u32x2 w;
            if (j.fmt == 1 || j.fmt == 3) { w.x = pk4_f8(tp[0] * sc, tp[260] * sc, tp[520] * sc, tp[780] * sc); w.y = pk4_f8(tp[1040] * sc, tp[1300] * sc, tp[1560] * sc, tp[1820] * sc); }
            else { w.x = pk4_i8(tp[0], tp[260], tp[520], tp[780], sc); w.y = pk4_i8(tp[1040], tp[1300], tp[1560], tp[1820], sc); }
            unsigned char* drow = (unsigned char*)j.dst + (size_t)(r0 + rr) * j.ldd + j.koff; const int kk = k0 + c8 * 8;
            if (j.fmt == 3) { const int r = kk & 127, pp = (kk & ~127) + (r >> 5) * 16 + ((r >> 3) & 3) * 4; *(unsigned*)(drow + pp) = w.x; *(unsigned*)(drow + pp + 64) = w.y; }
            else *(u32x2*)(drow + (j.fmt == 2 ? kperm8(kk) : kk)) = w;
        } else {
        u32x4 w; w.x = pk2(tp[0], tp[260]); w.y = pk2(tp[520], tp[780]); w.z = pk2(tp[1040], tp[1300]); w.w = pk2(tp[1560], tp[1820]);
        *(u32x4*)(j.dst + (size_t)(r0 + rr) * j.ldd + j.koff + k0 + c8 * 8) = w;
        }
    }
}
__device__ __forceinline__ void prep_fold_in(const float* w_in  , const float* w_uk  , const float* gain, bf16_t* dst, LAS float* lds, int vb, int nvb) {
    LAS float* A = lds; LAS float* B = lds + 32 * 65;
    const int tid = otid(), lane = tid & 63, wid = __builtin_amdgcn_readfirstlane(tid >> 6), l15 = lane & 15, dq = lane >> 4;
    for (int item = vb; item < 256; item += nvb) {
        const int h = item >> 5, k0 = (item & 31) * 32;
        __syncthreads();
        for (int i = tid; i < 2048; i += NTHREADS) { const int kk = i >> 6, d = i & 63; A[kk * 65 + d] = w_in[(size_t)(k0 + kk) * 3272 + h * 64 + d] * gain[k0 + kk]; }
        for (int i = tid; i < 8192; i += NTHREADS) { const int c = i >> 6, d = i & 63; B[c * 65 + d] = w_uk[(size_t)(h * 128 + c) * 64 + d]; }
        __syncthreads();
        f32x4 acc0 = (f32x4){0.f, 0.f, 0.f, 0.f}, acc1 = acc0;
#pragma unroll 4
        for (int d0 = 0; d0 < 64; d0 += 4) {
            const float b = B[(16 * wid + l15) * 65 + d0 + dq], a0 = A[l15 * 65 + d0 + dq], a1 = A[(16 + l15) * 65 + d0 + dq];
            acc0 = __builtin_amdgcn_mfma_f32_16x16x4f32(a0, b, acc0, 0, 0, 0);
            acc1 = __builtin_amdgcn_mfma_f32_16x16x4f32(a1, b, acc1, 0, 0, 0);
        }
        unsigned char* drow = (unsigned char*)dst + (size_t)(h * 128 + 16 * wid + l15) * 1024 + k0 + 4 * dq;
        *(unsigned*)drow = pk4_i8(acc0[0], acc0[1], acc0[2], acc0[3], WQ_GU);
        *(unsigned*)(drow + 16) = pk4_i8(acc1[0], acc1[1], acc1[2], acc1[3], WQ_GU);
    }
}
__device__ __forceinline__ void prep_fold_out(const float* w_out  , const float* w_uv  , bf16_t* dst  , LAS float* lds, int vb, int nvb) {
    LAS float* A = lds; LAS float* B = lds + 64 * 33;
    const int tid = otid(), lane = tid & 63, wid = __builtin_amdgcn_readfirstlane(tid >> 6), l15 = lane & 15, dq = lane >> 4;
    for (int item = vb; item < 256; item += nvb) {
        const int h = item >> 5, n0 = (item & 31) * 32;
        __syncthreads();
        for (int i = tid; i < 2048; i += NTHREADS) { const int d = i >> 5, nn = i & 31; A[d * 33 + nn] = w_out[(size_t)(h * 64 + d) * 1024 + n0 + nn]; }
        for (int i = tid; i < 8192; i += NTHREADS) { const int c = i >> 6, d = i & 63; B[c * 65 + d] = w_uv[(size_t)(h * 128 + c) * 64 + d]; }
        __syncthreads();
        f32x4 acc0 = (f32x4){0.f, 0.f, 0.f, 0.f}, acc1 = acc0;
#pragma unroll 4
        for (int d0 = 0; d0 < 64; d0 += 4) {
            const float a = B[(16 * wid + l15) * 65 + d0 + dq], b0 = A[(d0 + dq) * 33 + l15], b1 = A[(d0 + dq) * 33 + 16 + l15];
            acc0 = __builtin_amdgcn_mfma_f32_16x16x4f32(a, b0, acc0, 0, 0, 0);
            acc1 = __builtin_amdgcn_mfma_f32_16x16x4f32(a, b1, acc1, 0, 0, 0);
        }
        { u32x2 w; w.x = pk2(acc0[0], acc0[1]); w.y = pk2(acc0[2], acc0[3]); *(u32x2*)(dst + (size_t)(n0 + l15) * KOUT + h * 128 + 16 * wid + 4 * dq) = w; }
        { u32x2 w; w.x = pk2(acc1[0], acc1[1]); w.y = pk2(acc1[2], acc1[3]); *(u32x2*)(dst + (size_t)(n0 + 16 + l15) * KOUT + h * 128 + 16 * wid + 4 * dq) = w; }
    }
}
__device__ __forceinline__ void prep_lb(const float* hgrn_lb  , float* lb, int vb, int nvb) {
    for (int i = vb * NTHREADS + threadIdx.x; i < 512; i += nvb * NTHREADS) {
        const float a = hgrn_lb[i], b = hgrn_lb[512 + i], c = hgrn_lb[1024 + i], m = fmaxf(a, fmaxf(b, c));
        const float ea = __expf(a - m), eb = __expf(b - m), ec = __expf(c - m);
        lb[i] = ea / (ea + eb + ec);
    }
}

__device__ __forceinline__ void rmsnorm_rows(const float* X, bf16_t* Y, int nrows, int vb, int nvb) {
    const int tid = otid(), lane = tid & 63, gw = vb * NWAVES + __builtin_amdgcn_readfirstlane(tid >> 6), ngw = nvb * NWAVES;
    for (int r = gw; r < nrows; r += ngw) {
        const f32x4* xr = (const f32x4*)(X + (size_t)r * D) + lane;
        f32x4 v[4]; float s = 0.f;
#pragma unroll
        for (int j = 0; j < 4; ++j) { v[j] = xr[64 * j]; s += (v[j].x * v[j].x + v[j].y * v[j].y) + (v[j].z * v[j].z + v[j].w * v[j].w); }
        const float rs = rsqrtf(wave_sum(s) * (1.f / D) + EPS);
        u32x2* o = (u32x2*)(Y + (size_t)r * D) + lane;
#pragma unroll
        for (int j = 0; j < 4; ++j) { u32x2 w; w.x = pk2(v[j].x * rs, v[j].y * rs); w.y = pk2(v[j].z * rs, v[j].w * rs); o[64 * j] = w; }
    }
}
__device__ __forceinline__ void x_to_h_rows(const float* X, bf16_t* H, unsigned char* X8, float* ssq, int vb, int nvb) {
    const int tid = otid(), lane = tid & 63, gw = vb * NWAVES + __builtin_amdgcn_readfirstlane(tid >> 6), ngw = nvb * NWAVES;
    for (int r = gw; r < T; r += 2 * ngw) {
        const int r2 = (r + ngw < T) ? r + ngw : r;
        f32x4 v[2][4];
#pragma unroll
        for (int j = 0; j < 4; ++j) { v[0][j] = __builtin_nontemporal_load((const f32x4*)(X + (size_t)r * D) + lane + 64 * j); v[1][j] = __builtin_nontemporal_load((const f32x4*)(X + (size_t)r2 * D) + lane + 64 * j); }
#pragma unroll
        for (int q = 0; q < 2; ++q) {
            const int rr = q ? r2 : r;
            u32x2* o = (u32x2*)(H + (size_t)rr * D) + lane;
            float s = 0.f;
#pragma unroll
            for (int j = 0; j < 4; ++j) { const f32x4 x = v[q][j]; u32x2 w; w.x = pk2(x.x, x.y); w.y = pk2(x.z, x.w); o[64 * j] = w;
                *((unsigned*)(X8 + (size_t)rr * D) + lane + 64 * j) = pk4_i8(x.x, x.y, x.z, x.w, HQ_X);
                const float a = bf2f((unsigned short)(w.x & 0xffffu)), b = bf2f((unsigned short)(w.x >> 16)), c = bf2f((unsigned short)(w.y & 0xffffu)), d = bf2f((unsigned short)(w.y >> 16));
                s += (a * a + b * b) + (c * c + d * d); }
            s = wave_sum(s);
            if (lane < 16) ssq[(size_t)rr * 16 + lane] = lane == 0 ? s : 0.f;
        }
    }
}
__device__ __forceinline__ void final_rows(const bf16_t* H, const float* ssq, const float* g, float* out, int vb, int nvb) {
    const int tid = otid(), lane = tid & 63, gw = vb * NWAVES + __builtin_amdgcn_readfirstlane(tid >> 6), ngw = nvb * NWAVES;
    f32x4 gg[4];
#pragma unroll
    for (int j = 0; j < 4; ++j) gg[j] = *((const f32x4*)g + lane + 64 * j);
    for (int r = gw; r < T; r += 2 * ngw) {
        const int r2 = (r + ngw < T) ? r + ngw : r;
        u32x2 w[2][4]; float rs[2];
#pragma unroll
        for (int j = 0; j < 4; ++j) { w[0][j] = ((const u32x2*)(H + (size_t)r * D) + lane)[64 * j]; w[1][j] = ((const u32x2*)(H + (size_t)r2 * D) + lane)[64 * j]; }
        rs[0] = row_rstd(ssq, (size_t)r); rs[1] = row_rstd(ssq, (size_t)r2);
#pragma unroll
        for (int q = 0; q < 2; ++q) {
            f32x4* o = (f32x4*)(out + (size_t)(q ? r2 : r) * D) + lane;
#pragma unroll
            for (int j = 0; j < 4; ++j) { const u32x2 ww = w[q][j];
                __builtin_nontemporal_store((f32x4){bf2f((unsigned short)(ww.x & 0xffffu)) * rs[q] * gg[j].x, bf2f((unsigned short)(ww.x >> 16)) * rs[q] * gg[j].y, bf2f((unsigned short)(ww.y & 0xffffu)) * rs[q] * gg[j].z, bf2f((unsigned short)(ww.y >> 16)) * rs[q] * gg[j].w}, o + 64 * j); }
        }
    }
}
__device__ __forceinline__ float row16_sum(float v) {
    v += __uint_as_float((unsigned)__builtin_amdgcn_update_dpp(0, (int)__float_as_uint(v), 0x128, 0xf, 0xf, false));
    v += __uint_as_float((unsigned)__builtin_amdgcn_update_dpp(0, (int)__float_as_uint(v), 0x124, 0xf, 0xf, false));
    v += __uint_as_float((unsigned)__builtin_amdgcn_update_dpp(0, (int)__float_as_uint(v), 0x122, 0xf, 0xf, false));
    v += __uint_as_float((unsigned)__builtin_amdgcn_update_dpp(0, (int)__float_as_uint(v), 0x121, 0xf, 0xf, false));
    return v;
}
__device__ __forceinline__ void cnorm_rows(const bf16_t* P, const float* lat_g, bf16_t* CN, int vb, int nvb) {
    const int tid = otid(), lane = tid & 63, gw = vb * NWAVES + __builtin_amdgcn_readfirstlane(tid >> 6), ngw = nvb * NWAVES, r4 = lane >> 4, l16 = lane & 15;
    const f32x4 ga = *(const f32x4*)(lat_g + l16 * 8), gb = *(const f32x4*)(lat_g + l16 * 8 + 4);
    for (int r = gw * 8; r < T; r += ngw * 8) {
        u32x4 w[2];
#pragma unroll
        for (int q = 0; q < 2; ++q) w[q] = *(const u32x4*)(P + (size_t)(r + 4 * q + r4) * PW + P_C + l16 * 8);
#pragma unroll
        for (int q = 0; q < 2; ++q) {
            const float x0 = bf2f((unsigned short)(w[q].x & 0xffffu)), x1 = bf2f((unsigned short)(w[q].x >> 16)), x2 = bf2f((unsigned short)(w[q].y & 0xffffu)), x3 = bf2f((unsigned short)(w[q].y >> 16));
            const float x4 = bf2f((unsigned short)(w[q].z & 0xffffu)), x5 = bf2f((unsigned short)(w[q].z >> 16)), x6 = bf2f((unsigned short)(w[q].w & 0xffffu)), x7 = bf2f((unsigned short)(w[q].w >> 16));
            const float ss = row16_sum(((x0 * x0 + x1 * x1) + (x2 * x2 + x3 * x3)) + ((x4 * x4 + x5 * x5) + (x6 * x6 + x7 * x7)));
            const float rs = rsqrtf(ss * (1.f / 128.f) + EPS);
            u32x4 o; o.x = pk2(x0 * rs * ga.x, x1 * rs * ga.y); o.y = pk2(x2 * rs * ga.z, x3 * rs * ga.w); o.z = pk2(x4 * rs * gb.x, x5 * rs * gb.y); o.w = pk2(x6 * rs * gb.z, x7 * rs * gb.w);
            *(u32x4*)(CN + (size_t)(r + 4 * q + r4) * 128 + l16 * 8) = o;
        }
    }
}
__device__ __forceinline__ int t5_bucket(int rel) {
    const int n = rel < 0 ? -rel : rel;
    int b = n < 8 ? n : 8 + (n >= 12) + (n >= 16) + (n >= 23) + (n >= 32) + (n >= 46) + (n >= 64) + (n >= 91);
    return b + (rel > 0 ? 16 : 0);
}
__device__ __forceinline__ unsigned sort_key(float x) { const unsigned u = __float_as_uint(x); return (u & 0x80000000u) ? ~u : (u | 0x80000000u); }


template <int CTRL, int ROWMASK> __device__ __forceinline__ unsigned dpp0(unsigned v) { return (unsigned)__builtin_amdgcn_update_dpp(0, (int)v, CTRL, ROWMASK, 0xf, false); }
__device__ __forceinline__ unsigned wave_prefix_incl(unsigned v) {
    v += dpp0<0x111, 0xf>(v); v += dpp0<0x112, 0xf>(v); v += dpp0<0x114, 0xf>(v); v += dpp0<0x118, 0xf>(v);
    v += dpp0<0x142, 0xa>(v);
    v += dpp0<0x143, 0xc>(v);
    return v;
}
__device__ __forceinline__ float wave_max_u(float v) {
    v = fmaxf(v, __uint_as_float((unsigned)__builtin_amdgcn_update_dpp(0, (int)__float_as_uint(v), 0x128, 0xf, 0xf, false)));
    v = fmaxf(v, __uint_as_float((unsigned)__builtin_amdgcn_update_dpp(0, (int)__float_as_uint(v), 0x124, 0xf, 0xf, false)));
    v = fmaxf(v, __uint_as_float((unsigned)__builtin_amdgcn_update_dpp(0, (int)__float_as_uint(v), 0x122, 0xf, 0xf, false)));
    v = fmaxf(v, __uint_as_float((unsigned)__builtin_amdgcn_update_dpp(0, (int)__float_as_uint(v), 0x121, 0xf, 0xf, false)));
    const int b = (int)__float_as_uint(v);
    return fmaxf(fmaxf(__uint_as_float((unsigned)__builtin_amdgcn_readlane(b, 0)), __uint_as_float((unsigned)__builtin_amdgcn_readlane(b, 16))),
                 fmaxf(__uint_as_float((unsigned)__builtin_amdgcn_readlane(b, 32)), __uint_as_float((unsigned)__builtin_amdgcn_readlane(b, 48))));
}

typedef short v4i16_t __attribute__((ext_vector_type(4)));
constexpr int DSA_BT_OFF = 131072 + 256, DSA_WS_OFF = DSA_BT_OFF + 6144;
__device__ __forceinline__ unsigned dsa_bucket(float x, float lo, float sc) { const float f = (x - lo) * sc; const unsigned b = (unsigned)f; return b > 255u ? 255u : b; }
__device__ __forceinline__ unsigned off_b(unsigned row, unsigned ch) { return 256u * row + 16u * (ch ^ (((row & 3) << 2) | ((row >> 2) & 3))); }
__device__ __forceinline__ void dsa_mfma_phase(const bf16_t* P, const bf16_t* CN, const float* rel_bias, bf16_t* CAT, LAS unsigned char* lds, unsigned* qctr) {
    const int tid = otid(), lane = tid & 63, wid = __builtin_amdgcn_readfirstlane(tid >> 6);
    LAS float* BT = (LAS float*)(lds + DSA_BT_OFF);
    __syncthreads();
    for (int i = tid; i < 191 * 8; i += NTHREADS) { const int rel = (i >> 3) - 127; BT[i] = rel_bias[t5_bucket(rel) * 8 + (i & 7)]; }
    const unsigned long long lt_mask = (lane == 0) ? 0ull : (~0ull >> (64 - lane));
    volatile LAS int* qslot = (volatile LAS int*)(lds + 131072 + 64);
    int nxt = 0;
    if (tid == 0) { *qslot = (int)atomicAdd(qctr, 1u); nxt = (int)atomicAdd(qctr, 1u); }
    for (;;) {
        __syncthreads();
        const int u = *qslot;
        if (u >= T / 16) break;
        const int b = u & 15, qg = 127 - (u >> 4), t0 = qg * 16, nj = t0 / CHUNK + 1, L = nj * CHUNK, nt = L / 32;
        const bf16_t* Pb = P + (size_t)b * SEQ * PW;
        {
            int ln1 = lane; asm volatile("" : "+v"(ln1));
            const int rho = ln1 & 31, hf = ln1 >> 5;
            const int qq = 2 * ((rho >> 2) & 1) + (rho >> 4), hh = 4 * ((rho >> 3) & 1) + (rho & 3);
            bf16x8 qa[4][4], wa[4], wc[4];
#pragma unroll
            for (int qd = 0; qd < 4; ++qd) {
                const bf16_t* qrow = Pb + (size_t)(t0 + 4 * qd + qq) * PW + P_QI + hh * 64 + 8 * hf;
#pragma unroll
                for (int ks = 0; ks < 4; ++ks) qa[qd][ks] = *(const bf16x8*)(qrow + ks * 16);
                wa[qd] = *(const bf16x8*)(Pb + (size_t)(t0 + 4 * qd + 2 * hf) * PW + P_WI); wc[qd] = *(const bf16x8*)(Pb + (size_t)(t0 + 4 * qd + 2 * hf + 1) * PW + P_WI);
            }
            LAS float* sc0 = (LAS float*)lds + (2 * hf) * 2048 + rho;
            const bf16_t* kbase = Pb + (size_t)rho * PW + P_KI + 8 * hf;
            bf16x8 kb[4], kn[4];
#pragma unroll
            for (int ks = 0; ks < 4; ++ks) { kb[ks] = (bf16x8){0, 0, 0, 0, 0, 0, 0, 0}; kn[ks] = kb[ks]; }
            if (wid < nt) {
#pragma unroll
                for (int ks = 0; ks < 4; ++ks) kb[ks] = *(const bf16x8*)(kbase + (size_t)wid * 32 * PW + ks * 16);
            }
            for (int kt = wid; kt < nt; kt += 8) {
                if (kt + 8 < nt) {
#pragma unroll
                    for (int ks = 0; ks < 4; ++ks) kn[ks] = *(const bf16x8*)(kbase + (size_t)(kt + 8) * 32 * PW + ks * 16);
                }
#pragma unroll
                for (int qd = 0; qd < 4; ++qd) {
                    f32x16 acc;
#pragma unroll
                    for (int r = 0; r < 16; ++r) acc[r] = 0.f;
#pragma unroll
                    for (int ks = 0; ks < 4; ++ks) acc = __builtin_amdgcn_mfma_f32_32x32x16_bf16(qa[qd][ks], kb[ks], acc, 0, 0, 0);
                    float s0 = 0.f, s1 = 0.f;
#pragma unroll
                    for (int e = 0; e < 8; ++e) { s0 += bf2f((unsigned short)wa[qd][e]) * fmaxf(acc[e], 0.f); s1 += bf2f((unsigned short)wc[qd][e]) * fmaxf(acc[8 + e], 0.f); }
                    sc0[(4 * qd) * 2048 + kt * 32] = s0 * (0.35355339059327373f * 0.125f); sc0[(4 * qd + 1) * 2048 + kt * 32] = s1 * (0.35355339059327373f * 0.125f);
                }
#pragma unroll
                for (int ks = 0; ks < 4; ++ks) kb[ks] = kn[ks];
            }
        }
        __syncthreads();
        if (tid == 0) { *qslot = nxt; nxt = (int)atomicAdd(qctr, 1u); }
        LAS unsigned char* pair = lds + wid * 16384;
        LAS unsigned char* wsc = lds + DSA_WS_OFF + wid * 2560;
        LAS unsigned* HIST = (LAS unsigned*)wsc; LAS float* CANDV = (LAS float*)(wsc + 1024); LAS unsigned* CANDI = (LAS unsigned*)(wsc + 1280);
        const int nsel = L < 256 ? L : 256;
        int lna = lane; asm volatile("" : "+v"(lna));
#pragma unroll 1
        for (int e2 = 0; e2 < 2; ++e2) {
            LAS unsigned short* IDX = (LAS unsigned short*)(wsc + 1536 + e2 * 512);
            if (nj > 4) {
                const LAS float* SCq = (const LAS float*)(pair + e2 * 8192);
                float x[32];
#pragma unroll
                for (int j = 0; j < 32; ++j) x[j] = (j < nj) ? SCq[j * 64 + lna] : 0.f;
                float lo = INFINITY, hi = -INFINITY;
#pragma unroll
                for (int j = 0; j < 32; ++j) if (j < nj) { hi = fmaxf(hi, x[j]); lo = fminf(lo, x[j]); }
                hi = wave_max_u(hi); lo = -wave_max_u(-lo);
                bool done = false;
                if (hi > lo) {
                    const float sc = 256.f / (hi - lo);
                    *(LAS u32x4*)(HIST + 4 * lna) = (u32x4){0u, 0u, 0u, 0u};
                    WAVE_LDS_SYNC();
#pragma unroll
                    for (int j = 0; j < 32; ++j) if (j < nj) { const unsigned bk = dsa_bucket(x[j], lo, sc); __hip_atomic_fetch_add(HIST + bk, 1u, __ATOMIC_RELAXED, __HIP_MEMORY_SCOPE_WORKGROUP); }
                    WAVE_LDS_SYNC();
                    const u32x4 h4 = *(const LAS u32x4*)(HIST + 4 * lna);
                    const unsigned cl = (h4.x + h4.y) + (h4.z + h4.w);
                    const unsigned pfx = wave_prefix_incl(cl);
                    const unsigned Sx = (unsigned)__builtin_amdgcn_readlane((int)pfx, 63) - pfx + cl;
                    const int lstar = __popcll(__ballot(Sx >= 256u)) - 1;
                    const unsigned above = Sx - cl, t3 = above + h4.w, t2 = t3 + h4.z, t1 = t2 + h4.y;
                    const unsigned bl = t3 >= 256u ? 3u : (t2 >= 256u ? 2u : (t1 >= 256u ? 1u : 0u));
                    const unsigned al = bl == 3u ? above : (bl == 2u ? t3 : (bl == 1u ? t2 : t1));
                    const unsigned ml = bl == 3u ? h4.w : (bl == 2u ? h4.z : (bl == 1u ? h4.y : h4.x));
                    const unsigned bstar = (unsigned)__builtin_amdgcn_readlane((int)(4u * lna + bl), lstar);
                    const int a = __builtin_amdgcn_readlane((int)al, lstar), m = __builtin_amdgcn_readlane((int)ml, lstar);
                    if (m <= 64) {
                        done = true;
                        const int need = 256 - a;
                        unsigned msel = 0u, mcand = 0u;
#pragma unroll
                        for (int j = 31; j >= 0; --j) if (j < nj) { const unsigned bk = dsa_bucket(x[j], lo, sc); msel = msel + msel + (bk > bstar ? 1u : 0u); mcand = mcand + mcand + (bk == bstar ? 1u : 0u); }
                        const unsigned pk = (unsigned)__popc(msel) | ((unsigned)__popc(mcand) << 16);
                        const unsigned inc = wave_prefix_incl(pk);
                        unsigned off = (inc - pk) & 0xffffu, coff = (inc - pk) >> 16;
                        while (msel) { const int j = __ffs((int)msel) - 1; msel &= msel - 1u; IDX[off++] = (unsigned short)(j * 64 + lna); }
                        while (mcand) { const int j = __ffs((int)mcand) - 1; mcand &= mcand - 1u; CANDV[coff] = SCq[j * 64 + lna]; CANDI[coff] = (unsigned)(j * 64 + lna); ++coff; }
                        WAVE_LDS_SYNC();
                        const float cv = CANDV[lna < m ? lna : 0]; const unsigned ci = CANDI[lna < m ? lna : 0];
                        int rank = 0;
                        for (int k = 0; k < m; ++k) { const float v = __uint_as_float((unsigned)__builtin_amdgcn_readlane((int)__float_as_uint(cv), k)); const unsigned id = (unsigned)__builtin_amdgcn_readlane((int)ci, k); rank += (v > cv || (v == cv && id < ci)) ? 1 : 0; }
                        if (lna < m && rank < need) IDX[a + rank] = (unsigned short)ci;
                    }
                }
                if (!done) {
                    unsigned lo_k = 0xffffffffu, hi_k = 0u;
#pragma unroll
                    for (int j = 0; j < 32; ++j) if (j < nj) { const unsigned kx = sort_key(x[j]); hi_k = kx > hi_k ? kx : hi_k; lo_k = kx < lo_k ? kx : lo_k; }
#pragma unroll
                    for (int o = 1; o < 64; o <<= 1) { const unsigned h2 = (unsigned)__shfl_xor((int)hi_k, o), l2 = (unsigned)__shfl_xor((int)lo_k, o); hi_k = h2 > hi_k ? h2 : hi_k; lo_k = l2 < lo_k ? l2 : lo_k; }
                    lo_k = (unsigned)__builtin_amdgcn_readfirstlane((int)lo_k); hi_k = (unsigned)__builtin_amdgcn_readfirstlane((int)hi_k);
                    bool exact = false;
                    while (lo_k < hi_k) {
                        const unsigned mid = lo_k + ((hi_k - lo_k + 1u) >> 1);
                        int cnt = 0;
#pragma unroll
                        for (int j = 0; j < 32; ++j) cnt += __popcll(__ballot(j < nj && sort_key(x[j]) >= mid));
                        if (cnt == 256) { lo_k = mid; exact = true; break; }
                        if (cnt > 256) lo_k = mid; else hi_k = mid - 1u;
                    }
                    const unsigned Tv = lo_k;
                    int need = 0;
                    if (!exact) { int cgt = 0;
#pragma unroll
                        for (int j = 0; j < 32; ++j) cgt += __popcll(__ballot(j < nj && sort_key(x[j]) > Tv));
                        need = 256 - cgt; }
                    int base = 0, eqt = 0;
#pragma unroll
                    for (int j = 0; j < 32; ++j) {
                        const unsigned kx = sort_key(x[j]);
                        const bool gt = (j < nj) && (exact ? (kx >= Tv) : (kx > Tv)), eq = (j < nj) && !exact && (kx == Tv);
                        const unsigned long long meq = __ballot(eq);
                        const bool sel = gt || (eq && (eqt + __popcll(meq & lt_mask)) < need);
                        const unsigned long long ms = __ballot(sel);
                        if (sel) IDX[base + __popcll(ms & lt_mask)] = (unsigned short)(j * 64 + lna);
                        base += __popcll(ms); eqt += __popcll(meq);
                    }
                }
            } else {
#pragma unroll
                for (int i = 0; i < 4; ++i) IDX[i * 64 + lna] = (unsigned short)(i * 64 + lna);
            }
        }
        WAVE_LDS_SYNC();
        {
            int lnb = lane; asm volatile("" : "+v"(lnb));
            const int head = lnb & 15, kg = lnb >> 4, nblk = nsel >> 5;
            LAS unsigned char* GB = pair;
            const bf16_t* CNb = CN + (size_t)b * SEQ * 128;
            const int rho = lnb & 15;
            const unsigned rw0 = 8 * (rho >> 2) + (rho & 3), rw1 = rw0 + 4;
            const unsigned xa0 = ((rw0 & 3) << 2) | ((rw0 >> 2) & 3), xa1 = ((rw1 & 3) << 2) | ((rw1 >> 2) & 3);
            const unsigned q4 = (lnb & 15) >> 2, p4 = lnb & 3;
            u32x4 gA[8], gB[8];
#define DSA_GATHER(G, IX, blk) do { _Pragma("unroll") for (int it = 0; it < 8; ++it) { const int sp = (IX)[(blk) * 32 + (lnb >> 4) + 4 * it]; G[it] = *(const u32x4*)(CNb + (size_t)sp * 128 + (lnb & 15) * 8); } } while (0)
            { const LAS unsigned short* IDX0 = (const LAS unsigned short*)(wsc + 1536); DSA_GATHER(gA, IDX0, 0); DSA_GATHER(gB, IDX0, 1); }
#pragma unroll 1
            for (int e2 = 0; e2 < 2; ++e2) {
                const int t = t0 + 2 * wid + e2;
                const size_t row = (size_t)b * SEQ + t;
                const LAS unsigned short* IDX = (const LAS unsigned short*)(wsc + 1536 + e2 * 512);
                bf16x8 qlf[4];
#pragma unroll
                for (int s4 = 0; s4 < 4; ++s4) { qlf[s4] = *(const bf16x8*)(P + row * PW + P_QL + (head & 7) * 128 + s4 * 32 + 8 * kg); if (head >= 8) qlf[s4] = (bf16x8){0, 0, 0, 0, 0, 0, 0, 0}; }
                f32x4 o[8];
#pragma unroll
                for (int ct = 0; ct < 8; ++ct) o[ct] = (f32x4){0.f, 0.f, 0.f, 0.f};
                float m = -INFINITY, lsum = 0.f;
#define DSA_STEP(G, kbx) do { \
                    WAVE_LDS_SYNC();                              \
                    _Pragma("unroll") for (int it = 0; it < 8; ++it) *(LAS u32x4*)(GB + off_b((lnb >> 4) + 4 * it, lnb & 15)) = G[it]; \
                    const bf16x8 iv = *(const LAS bf16x8*)((const LAS unsigned char*)IDX + ((kbx) * 32 + 8 * kg) * 2);     \
                    if ((kbx) + 2 < nblk) DSA_GATHER(G, IDX, (kbx) + 2); else if (e2 == 0) DSA_GATHER(G, IDX + 256, (kbx) + 2 - nblk); \
                    WAVE_LDS_SYNC(); \
                      \
                    bf16x8 k0[4], k1[4], af[8]; \
                    _Pragma("unroll") for (int s4 = 0; s4 < 4; ++s4) { \
                        k0[s4] = *(const LAS bf16x8*)(GB + 256u * rw0 + 16u * ((4 * s4 + kg) ^ xa0)); \
                        k1[s4] = *(const LAS bf16x8*)(GB + 256u * rw1 + 16u * ((4 * s4 + kg) ^ xa1)); } \
                    float bia[8]; \
                    _Pragma("unroll") for (int e = 0; e < 8; ++e) { const int sp = (int)(unsigned short)iv[e]; int rel = sp - t; rel = rel < -127 ? -127 : rel; bia[e] = BT[(rel + 127) * 8 + (head & 7)]; } \
                      \
                    f32x4 a0 = (f32x4){0.f, 0.f, 0.f, 0.f}, a1 = (f32x4){0.f, 0.f, 0.f, 0.f}; \
                    _Pragma("unroll") for (int s4 = 0; s4 < 4; ++s4) { \
                        a0 = __builtin_amdgcn_mfma_f32_16x16x32_bf16(k0[s4], qlf[s4], a0, 0, 0, 0); \
                        a1 = __builtin_amdgcn_mfma_f32_16x16x32_bf16(k1[s4], qlf[s4], a1, 0, 0, 0); } \
                    asm volatile("" : "+v"(a0), "+v"(a1));        \
                    _Pragma("unroll") for (int ct = 0; ct < 8; ++ct) {              \
                        const v4i16_t lo4 = __builtin_amdgcn_ds_read_tr16_b64_v4i16((LAS v4i16_t*)(GB + off_b(8 * kg + q4, 2 * ct + (p4 >> 1)) + 8 * (p4 & 1))); \
                        const v4i16_t hi4 = __builtin_amdgcn_ds_read_tr16_b64_v4i16((LAS v4i16_t*)(GB + off_b(8 * kg + 4 + q4, 2 * ct + (p4 >> 1)) + 8 * (p4 & 1))); \
                        af[ct] = (bf16x8){lo4[0], lo4[1], lo4[2], lo4[3], hi4[0], hi4[1], hi4[2], hi4[3]}; } \
                      \
                    float lg[8]; \
                    _Pragma("unroll") for (int e = 0; e < 8; ++e) lg[e] = (e < 4 ? a0[e] : a1[e - 4]) * 0.125f + bia[e]; \
                    const float mloc = fmaxf(fmaxf(fmaxf(lg[0], lg[1]), fmaxf(lg[2], lg[3])), fmaxf(fmaxf(lg[4], lg[5]), fmaxf(lg[6], lg[7]))); \
                      \
                    float scl = 1.f; \
                    if (__any(mloc > m + 16.f)) { \
                        float mb = fmaxf(mloc, __shfl_xor(mloc, 16)); mb = fmaxf(mb, __shfl_xor(mb, 32)); \
                        const float mn = fmaxf(m, mb); scl = __expf(m - mn); m = mn; \
                        _Pragma("unroll") for (int ct = 0; ct < 8; ++ct) o[ct] = o[ct] * scl; } \
                    float ps = 0.f; float pe[8]; \
                    _Pragma("unroll") for (int e = 0; e < 8; ++e) { pe[e] = __expf(lg[e] - m); ps += pe[e]; } \
                    lsum = lsum * scl + ps; \
                    u32x4 pw; pw.x = pk2(pe[0], pe[1]); pw.y = pk2(pe[2], pe[3]); pw.z = pk2(pe[4], pe[5]); pw.w = pk2(pe[6], pe[7]); \
                    const bf16x8 pb = __builtin_bit_cast(bf16x8, pw); \
                    _Pragma("unroll") for (int ct = 0; ct < 8; ++ct) o[ct] = __builtin_amdgcn_mfma_f32_16x16x32_bf16(af[ct], pb, o[ct], 0, 0, 0); \
                } while (0)
#pragma unroll 1
                for (int kb2 = 0; kb2 < nblk; kb2 += 2) { DSA_STEP(gA, kb2); DSA_STEP(gB, kb2 + 1); }
#undef DSA_STEP
                lsum += __shfl_xor(lsum, 16); lsum += __shfl_xor(lsum, 32);
                const float inv = 1.f / lsum;
                if (head < 8) {
                    bf16_t* op = CAT + row * KOUT + head * 128 + 4 * kg;
#pragma unroll
                    for (int ct = 0; ct < 8; ++ct) { u32x2 w; w.x = pk2(o[ct][0] * inv, o[ct][1] * inv); w.y = pk2(o[ct][2] * inv, o[ct][3] * inv); *(u32x2*)(op + ct * 16) = w; }
                }
            }
#undef DSA_GATHER
        }
    }
}

constexpr size_t WS_DEC = 492 * MiB;
__device__ __forceinline__ void hgrn_prep(bf16_t* P, const float* lb, float* DEC, LAS unsigned char* lds, int vb, int nvb) {
    const int tid = otid(), cl = tid >> 7, d = tid & 127;
    LAS bf16_t* Ft = (LAS bf16_t*)lds; LAS bf16_t* Qt = (LAS bf16_t*)(lds + 65536);
    for (int it = vb; it < BATCH * 4 * 8; it += nvb) {
        const int b = it >> 5, h = (it >> 3) & 3, cg = it & 7;
        bf16_t* base = P + ((size_t)b * SEQ + cg * 256) * PW + h * 128;
        u32x4 v[16];
#pragma unroll
        for (int k = 0; k < 16; ++k) { const int i = tid + 512 * k, tl = i >> 12, r = (i >> 4) & 255, ch = i & 15; v[k] = *(const u32x4*)(base + (size_t)r * PW + (tl ? P_QB : P_FB) + ch * 8); }
        __syncthreads();
#pragma unroll
        for (int k = 0; k < 16; ++k) { const int i = tid + 512 * k, tl = i >> 12, r = (i >> 4) & 255, ch = i & 15; *(LAS u32x4*)(lds + tl * 65536 + r * 256 + ch * 16) = v[k]; }
        __syncthreads();
        {
            const float l = lb[h * 128 + d];
            LAS bf16_t* fcol = Ft + (cl * 64) * 128 + d; LAS bf16_t* qcol = Qt + (cl * 64) * 128 + d;
            float up = 1.f;
#pragma unroll 8
            for (int t = 32; t < 64; ++t) {
                const float f = l + (1.f - l) * sigmoid_f(bf2f(fcol[t * 128]));
                up *= f;
                const float q = silu_f(bf2f(qcol[t * 128]));
                qcol[t * 128] = (bf16_t)f2bf(q * up);
                fcol[t * 128] = (bf16_t)f2bf((1.f - f) * __builtin_amdgcn_rcpf(up));
            }
            float dn = 1.f;
#pragma unroll 8
            for (int t = 31; t >= 0; --t) {
                const float f = l + (1.f - l) * sigmoid_f(bf2f(fcol[t * 128]));
                const float q = silu_f(bf2f(qcol[t * 128]));
                qcol[t * 128] = (bf16_t)f2bf(q * __builtin_amdgcn_rcpf(dn));
                fcol[t * 128] = (bf16_t)f2bf((1.f - f) * dn);
                dn *= f;
            }
            float* dc = DEC + ((size_t)((b * 4 + h) * 32 + cg * 4 + cl) * 3) * 128 + d;
            dc[0] = dn; dc[128] = dn * up; dc[256] = up;
        }
        __syncthreads();
#pragma unroll
        for (int k = 0; k < 16; ++k) { const int i = tid + 512 * k, tl = i >> 12, r = (i >> 4) & 255, ch = i & 15; *(u32x4*)(base + (size_t)r * PW + (tl ? P_QB : P_FB) + ch * 8) = *(const LAS u32x4*)(lds + tl * 65536 + r * 256 + ch * 16); }
    }
}

__device__ __forceinline__ void hgrn_scan(const bf16_t* P, const float* DEC, const float* o_g, bf16_t* CAT, LAS unsigned char* lds, int item) {
    const int tid = otid(), lane = tid & 63, wid = __builtin_amdgcn_readfirstlane(tid >> 6), li = lane & 15, kg = lane >> 4;
    const int b = item >> 2, h = item & 3, it = wid >> 1, vh = wid & 1;
    LAS unsigned char* ST = lds + 98304;
    LAS float* SSQ = (LAS float*)(lds + DSA_BT_OFF);
    const bf16_t* Pb = P + (size_t)b * SEQ * PW;
    const float* DECb = DEC + (size_t)((b * 4 + h) * 32) * 384;
    f32x4 S[8];
#pragma unroll
    for (int vt = 0; vt < 8; ++vt) S[vt] = (f32x4){0.f, 0.f, 0.f, 0.f};
    u32x4 sg[6];
    const int colbase[3] = {P_QB, P_FB, P_IB};
#define HG_LOAD(c) do { _Pragma("unroll") for (int k = 0; k < 6; ++k) { const int n = tid + 512 * k, tl = n >> 10, r = (n >> 4) & 63, ch = n & 15; \
        sg[k] = *(const u32x4*)(Pb + (size_t)((c) * 64 + r) * PW + colbase[tl] + h * 128 + ch * 8); } } while (0)
#define HG_STORE(buf) do { _Pragma("unroll") for (int k = 0; k < 6; ++k) { const int n = tid + 512 * k, tl = n >> 10, r = (n >> 4) & 63, ch = n & 15; \
        *(LAS u32x4*)(lds + (buf) * 49152 + tl * 16384 + off_b(r, ch)) = sg[k]; } } while (0)
    HG_LOAD(0);
    __syncthreads();
    HG_STORE(0);
    const unsigned q4 = (lane & 15) >> 2, p4 = lane & 3;
    f32x4 ogv[4];
#pragma unroll
    for (int vv = 0; vv < 4; ++vv) ogv[vv] = *(const f32x4*)(o_g + 16 * (4 * vh + vv) + 4 * kg);
    float er_next = DECb[16 * wid + li];
#pragma unroll 1
    for (int c = 0; c < 32; ++c) {
        const int buf = c & 1;
        LAS unsigned char* QI = lds + buf * 49152; LAS unsigned char* KI = QI + 16384; LAS unsigned char* VI = QI + 32768;
        if (c + 1 < 32) HG_LOAD(c + 1);
        const float er = er_next, e63 = DECb[c * 384 + 128 + 16 * wid + li], e6r = DECb[c * 384 + 256 + 16 * wid + li];
        er_next = DECb[(c + 1 < 32 ? c + 1 : c) * 384 + 16 * wid + li];
        u32x2 gwv[4];
#pragma unroll
        for (int vv = 0; vv < 4; ++vv) gwv[vv] = *(const u32x2*)(P + ((size_t)b * SEQ + c * 64 + 16 * it + li) * PW + P_GB + h * 128 + 16 * (4 * vh + vv) + 4 * kg);
        { const unsigned d = 16 * wid + li;
#pragma unroll
          for (int vt = 0; vt < 8; ++vt) { u32x2 w; w.x = pk2(S[vt][0] * er, S[vt][1] * er); w.y = pk2(S[vt][2] * er, S[vt][3] * er);
              *(LAS u32x2*)(ST + off_b(d, 2 * vt + (kg >> 1)) + 8 * (kg & 1)) = w; } }
        __syncthreads();
        bf16x8 qf[4];
#pragma unroll
        for (int ks = 0; ks < 4; ++ks) qf[ks] = *(const LAS bf16x8*)(QI + off_b(16 * it + li, 4 * ks + kg));
        f32x4 o[4];
#pragma unroll
        for (int vv = 0; vv < 4; ++vv) o[vv] = (f32x4){0.f, 0.f, 0.f, 0.f};
#pragma unroll
        for (int ks = 0; ks < 4; ++ks)
#pragma unroll
            for (int vv = 0; vv < 4; ++vv) {
                const int ct = 4 * vh + vv;
                const v4i16_t lo4 = __builtin_amdgcn_ds_read_tr16_b64_v4i16((LAS v4i16_t*)(ST + off_b(32 * ks + 8 * kg + q4, 2 * ct + (p4 >> 1)) + 8 * (p4 & 1)));
                const v4i16_t hi4 = __builtin_amdgcn_ds_read_tr16_b64_v4i16((LAS v4i16_t*)(ST + off_b(32 * ks + 8 * kg + 4 + q4, 2 * ct + (p4 >> 1)) + 8 * (p4 & 1)));
                const bf16x8 af = (bf16x8){lo4[0], lo4[1], lo4[2], lo4[3], hi4[0], hi4[1], hi4[2], hi4[3]};
                o[vv] = __builtin_amdgcn_mfma_f32_16x16x32_bf16(af, qf[ks], o[vv], 0, 0, 0);
            }
        const int njb = (it >> 1) + 1;
#pragma unroll
        for (int jb = 0; jb < 2; ++jb) {
            if (jb < njb) {
                f32x4 a0 = (f32x4){0.f, 0.f, 0.f, 0.f}, a1 = (f32x4){0.f, 0.f, 0.f, 0.f};
                const unsigned rw0 = 32 * jb + 8 * (li >> 2) + (li & 3), rw1 = rw0 + 4;
#pragma unroll
                for (int ks = 0; ks < 4; ++ks) {
                    const bf16x8 k0 = *(const LAS bf16x8*)(KI + off_b(rw0, 4 * ks + kg));
                    const bf16x8 k1 = *(const LAS bf16x8*)(KI + off_b(rw1, 4 * ks + kg));
                    a0 = __builtin_amdgcn_mfma_f32_16x16x32_bf16(k0, qf[ks], a0, 0, 0, 0);
                    a1 = __builtin_amdgcn_mfma_f32_16x16x32_bf16(k1, qf[ks], a1, 0, 0, 0);
                }
                const int ii = 16 * it + li, j0 = 32 * jb + 8 * kg;
                float am[8];
#pragma unroll
                for (int e = 0; e < 8; ++e) am[e] = (j0 + e <= ii) ? (e < 4 ? a0[e] : a1[e - 4]) : 0.f;
                u32x4 pw; pw.x = pk2(am[0], am[1]); pw.y = pk2(am[2], am[3]); pw.z = pk2(am[4], am[5]); pw.w = pk2(am[6], am[7]);
                const bf16x8 pb = __builtin_bit_cast(bf16x8, pw);
#pragma unroll
                for (int vv = 0; vv < 4; ++vv) {
                    const int ct = 4 * vh + vv;
                    const v4i16_t lo4 = __builtin_amdgcn_ds_read_tr16_b64_v4i16((LAS v4i16_t*)(VI + off_b(32 * jb + 8 * kg + q4, 2 * ct + (p4 >> 1)) + 8 * (p4 & 1)));
                    const v4i16_t hi4 = __builtin_amdgcn_ds_read_tr16_b64_v4i16((LAS v4i16_t*)(VI + off_b(32 * jb + 8 * kg + 4 + q4, 2 * ct + (p4 >> 1)) + 8 * (p4 & 1)));
                    const bf16x8 af = (bf16x8){lo4[0], lo4[1], lo4[2], lo4[3], hi4[0], hi4[1], hi4[2], hi4[3]};
                    o[vv] = __builtin_amdgcn_mfma_f32_16x16x32_bf16(af, pb, o[vv], 0, 0, 0);
                }
            }
        }
        {
            f32x4 U[8];
#pragma unroll
            for (int vt = 0; vt < 8; ++vt) U[vt] = (f32x4){0.f, 0.f, 0.f, 0.f};
#pragma unroll
            for (int ks = 0; ks < 2; ++ks) {
                const v4i16_t kl = __builtin_amdgcn_ds_read_tr16_b64_v4i16((LAS v4i16_t*)(KI + off_b(32 * ks + 8 * kg + q4, 2 * wid + (p4 >> 1)) + 8 * (p4 & 1)));
                const v4i16_t kh = __builtin_amdgcn_ds_read_tr16_b64_v4i16((LAS v4i16_t*)(KI + off_b(32 * ks + 8 * kg + 4 + q4, 2 * wid + (p4 >> 1)) + 8 * (p4 & 1)));
                const bf16x8 kfr = (bf16x8){kl[0], kl[1], kl[2], kl[3], kh[0], kh[1], kh[2], kh[3]};
#pragma unroll
                for (int vt = 0; vt < 8; ++vt) {
                    const v4i16_t lo4 = __builtin_amdgcn_ds_read_tr16_b64_v4i16((LAS v4i16_t*)(VI + off_b(32 * ks + 8 * kg + q4, 2 * vt + (p4 >> 1)) + 8 * (p4 & 1)));
                    const v4i16_t hi4 = __builtin_amdgcn_ds_read_tr16_b64_v4i16((LAS v4i16_t*)(VI + off_b(32 * ks + 8 * kg + 4 + q4, 2 * vt + (p4 >> 1)) + 8 * (p4 & 1)));
                    const bf16x8 af = (bf16x8){lo4[0], lo4[1], lo4[2], lo4[3], hi4[0], hi4[1], hi4[2], hi4[3]};
                    U[vt] = __builtin_amdgcn_mfma_f32_16x16x32_bf16(af, kfr, U[vt], 0, 0, 0);
                }
            }
#pragma unroll
            for (int vt = 0; vt < 8; ++vt) S[vt] = S[vt] * e63 + U[vt] * e6r;
        }
        float ss = 0.f;
#pragma unroll
        for (int vv = 0; vv < 4; ++vv) ss += (o[vv][0] * o[vv][0] + o[vv][1] * o[vv][1]) + (o[vv][2] * o[vv][2] + o[vv][3] * o[vv][3]);
        ss += __shfl_xor(ss, 16); ss += __shfl_xor(ss, 32);
        if (kg == 0) SSQ[(it * 2 + vh) * 16 + li] = ss;
        __syncthreads();
        if (c + 1 < 32) HG_STORE(buf ^ 1);
        {
            const float tot = SSQ[(it * 2) * 16 + li] + SSQ[(it * 2 + 1) * 16 + li];
            const float rs = rsqrtf(tot * (1.f / 128.f) + EPS);
            const size_t row = (size_t)b * SEQ + c * 64 + 16 * it + li;
#pragma unroll
            for (int vv = 0; vv < 4; ++vv) {
                const int v0 = 16 * (4 * vh + vv) + 4 * kg;
                const u32x2 gw = gwv[vv];
                const f32x4 og = ogv[vv];
                const float g0 = silu_f(bf2f((unsigned short)(gw.x & 0xffffu))), g1 = silu_f(bf2f((unsigned short)(gw.x >> 16))), g2 = silu_f(bf2f((unsigned short)(gw.y & 0xffffu))), g3 = silu_f(bf2f((unsigned short)(gw.y >> 16)));
                u32x2 w; w.x = pk2(o[vv][0] * rs * og.x * g0, o[vv][1] * rs * og.y * g1); w.y = pk2(o[vv][2] * rs * og.z * g2, o[vv][3] * rs * og.w * g3);
                *(u32x2*)(CAT + row * KOUT + 1024 + h * 128 + v0) = w;
            }
        }
    }
#undef HG_LOAD
#undef HG_STORE
}


__device__ __forceinline__ int swap23(int r) { return (r & ~12) | ((r & 4) << 1) | ((r & 8) >> 1); }
__device__ __forceinline__ void xattn_mfma_phase(const bf16_t* Q, const bf16_t* Kb, const bf16_t* VT, bf16_t* O, LAS unsigned char* lds, int vb, int nvb) {
    const int tid = otid(), lane = tid & 63, wid = __builtin_amdgcn_readfirstlane(tid >> 6), r32 = lane & 31, hf = lane >> 5;
    LAS unsigned char* Ks = lds; LAS unsigned char* Vs = lds + 65536;
    int koff[8], voff[8];
    { const int kr = swap23(r32), x = kr & 15, y = r32 & 15;
#pragma unroll
      for (int ks = 0; ks < 8; ++ks) koff[ks] = kr * 256 + (((ks * 2 + hf) ^ x) << 4);
#pragma unroll
      for (int e = 0; e < 8; ++e) voff[e] = r32 * 512 + (((e * 2 + hf) ^ y) << 4); }
    for (int pair = vb; pair < 256; pair += nvb) {
        const int bh = pair >> 2, b = bh >> 2, h = bh & 3;
        __syncthreads();
        int tio = tid; asm volatile("" : "+v"(tio));
        for (int i = tio; i < 4096; i += NTHREADS) { const int key = i >> 4, ch = i & 15;
            const u32x4 v = *(const u32x4*)(Kb + (size_t)(b * MEMT + key) * 512 + h * 128 + ch * 8);
            *(LAS u32x4*)(Ks + key * 256 + ((ch ^ (key & 15)) << 4)) = v; }
        for (int i = tio; i < 4096; i += NTHREADS) { const int d = i >> 5, ch = i & 31;
            const u32x4 v = *(const u32x4*)(VT + (size_t)(h * 128 + d) * MT + b * MEMT + ch * 8);
            *(LAS u32x4*)(Vs + d * 512 + ((ch ^ (d & 15)) << 4)) = v; }
        __syncthreads();
#pragma unroll 1
        for (int qq = 0; qq < 2; ++qq) {
            const size_t q0 = (size_t)b * SEQ + ((pair & 3) * 2 + qq) * 256 + wid * 32;
            bf16x8 qf[8];
#pragma unroll
            for (int ks = 0; ks < 8; ++ks) qf[ks] = *(const bf16x8*)(Q + (q0 + r32) * 512 + h * 128 + ks * 16 + 8 * hf);
            f32x16 st[8];
            __builtin_amdgcn_s_setprio(1);
#pragma unroll
            for (int kt = 0; kt < 8; ++kt) {
#pragma unroll
                for (int r = 0; r < 16; ++r) st[kt][r] = 0.f;
#pragma unroll
                for (int ks = 0; ks < 8; ++ks) {
                    const bf16x8 a = *(const LAS bf16x8*)(Ks + koff[ks] + kt * 8192);
                    st[kt] = __builtin_amdgcn_mfma_f32_32x32x16_bf16(a, qf[ks], st[kt], 0, 0, 0);
                }
            }
            __builtin_amdgcn_s_setprio(0);
            float mx = -INFINITY;
#pragma unroll
            for (int kt = 0; kt < 8; ++kt)
#pragma unroll
                for (int r = 0; r < 16; ++r) mx = fmaxf(mx, st[kt][r]);
            mx = fmaxf(mx, __shfl_xor(mx, 32));
            const float c = 0.08838834764831845f * 1.4426950408889634f;
            float sum = 0.f;
#pragma unroll
            for (int kt = 0; kt < 8; ++kt)
#pragma unroll
                for (int r = 0; r < 16; ++r) { const float e = __builtin_amdgcn_exp2f((st[kt][r] - mx) * c); st[kt][r] = e; sum += e; }
            sum += __shfl_xor(sum, 32);
            const float inv = 1.f / sum;
            bf16x8 pfr[8][2];
#pragma unroll
            for (int kt = 0; kt < 8; ++kt)
#pragma unroll
                for (int s2 = 0; s2 < 2; ++s2) {
                    u32x4 pw;
                    pw.x = pk2(st[kt][8 * s2 + 0], st[kt][8 * s2 + 1]); pw.y = pk2(st[kt][8 * s2 + 2], st[kt][8 * s2 + 3]);
                    pw.z = pk2(st[kt][8 * s2 + 4], st[kt][8 * s2 + 5]); pw.w = pk2(st[kt][8 * s2 + 6], st[kt][8 * s2 + 7]);
                    pfr[kt][s2] = __builtin_bit_cast(bf16x8, pw);
                }
#pragma unroll
            for (int kt = 0; kt < 8; ++kt) asm volatile("" : "+v"(pfr[kt][0]), "+v"(pfr[kt][1]));
            f32x16 o[4];
#pragma unroll
            for (int dt = 0; dt < 4; ++dt)
#pragma unroll
                for (int r = 0; r < 16; ++r) o[dt][r] = 0.f;
            __builtin_amdgcn_s_setprio(1);
#pragma unroll
            for (int kt = 0; kt < 8; ++kt)
#pragma unroll
                for (int s2 = 0; s2 < 2; ++s2)
#pragma unroll
                    for (int dt = 0; dt < 4; ++dt) {
                        const bf16x8 a = *(const LAS bf16x8*)(Vs + voff[(kt & 3) * 2 + s2] + dt * 16384 + (kt >> 2) * 256);
                        o[dt] = __builtin_amdgcn_mfma_f32_32x32x16_bf16(a, pfr[kt][s2], o[dt], 0, 0, 0);
                    }
            __builtin_amdgcn_s_setprio(0);
            unsigned char* orow = (unsigned char*)O + (q0 + r32) * 512 + h * 128 + 64 * hf;
            const float isc = inv * XO_SC;
#pragma unroll
            for (int dt = 0; dt < 4; ++dt) {
                u32x4 w;
#pragma unroll
                for (int g = 0; g < 4; ++g) w[g] = pk4_f8(o[dt][4 * g] * isc, o[dt][4 * g + 1] * isc, o[dt][4 * g + 2] * isc, o[dt][4 * g + 3] * isc);
                *(u32x4*)(orow + dt * 16) = w;
            }
        }
    }
}


__device__ __forceinline__ void gmlp_mfma_phase(const bf16_t* UV, const float* lnp, const float* ln_g, const float* ln_b, const float* w_sp, const float* b_sp, bf16_t* G, LAS unsigned char* lds, int vb, int nvb) {
    const int tid = otid(), lane = tid & 63, wid = __builtin_amdgcn_readfirstlane(tid >> 6), fr = lane & 15, fq = lane >> 4;
    LAS unsigned char* Wb = lds; LAS unsigned char* VTs = lds + 32768; LAS float* STAT = (LAS float*)(lds + 65536);
    int gcur = -1;
    for (int grp = vb; grp < 256; grp += nvb) {
        const int g = grp >> 5;
        bf16x8 vch[4]; f32x4 lp[2];
#define GM_LOAD(uu_) do { const size_t r0_ = (size_t)((grp & 31) * 8 + (uu_)) * 128; \
            _Pragma("unroll") for (int k = 0; k < 4; ++k) { const int i = tid + 512 * k, sI = i >> 4, ch = i & 15; vch[k] = *(const bf16x8*)(UV + (r0_ + sI) * 2048 + 1024 + g * 128 + ch * 8); } \
            lp[0] = *(const f32x4*)(lnp + (r0_ + (tid >> 2)) * 32 + (tid & 3) * 8); lp[1] = *(const f32x4*)(lnp + (r0_ + (tid >> 2)) * 32 + (tid & 3) * 8 + 4); } while (0)
        GM_LOAD(0);
        const f32x4 g0 = *(const f32x4*)(ln_g + g * 128 + (tid & 15) * 8), g1 = *(const f32x4*)(ln_g + g * 128 + (tid & 15) * 8 + 4);
        const f32x4 b0 = *(const f32x4*)(ln_b + g * 128 + (tid & 15) * 8), b1 = *(const f32x4*)(ln_b + g * 128 + (tid & 15) * 8 + 4);
        const float gg[8] = {g0.x, g0.y, g0.z, g0.w, g1.x, g1.y, g1.z, g1.w}, bb[8] = {b0.x, b0.y, b0.z, b0.w, b1.x, b1.y, b1.z, b1.w};
        __syncthreads();
        if (g != gcur) {
            gcur = g;
            for (int i = tid; i < 2048; i += NTHREADS) { const int t = i >> 4, ch = i & 15;
                const f32x4 a = *(const f32x4*)(w_sp + (size_t)g * 16384 + t * 128 + ch * 8), b = *(const f32x4*)(w_sp + (size_t)g * 16384 + t * 128 + ch * 8 + 4);
                const int s0 = ch * 8;
                u32x4 w; w.x = pk2(s0 + 0 <= t ? a.x : 0.f, s0 + 1 <= t ? a.y : 0.f); w.y = pk2(s0 + 2 <= t ? a.z : 0.f, s0 + 3 <= t ? a.w : 0.f);
                w.z = pk2(s0 + 4 <= t ? b.x : 0.f, s0 + 5 <= t ? b.y : 0.f); w.w = pk2(s0 + 6 <= t ? b.z : 0.f, s0 + 7 <= t ? b.w : 0.f);
                *(LAS u32x4*)(Wb + t * 256 + ((ch ^ (t & 15)) << 4)) = w; }
        }
        const int trow = wid * 16 + fr;
        const float bias = b_sp[g * 128 + trow];
#pragma unroll 1
        for (int uu = 0; uu < 8; ++uu) {
            const int bn = (grp & 31) * 8 + uu;
            const size_t row0 = (size_t)bn * 128;
            if (uu) __syncthreads();
            { float s1 = (lp[0].x + lp[0].z) + (lp[1].x + lp[1].z), s2 = (lp[0].y + lp[0].w) + (lp[1].y + lp[1].w);
              s1 += __shfl_xor(s1, 1); s2 += __shfl_xor(s2, 1); s1 += __shfl_xor(s1, 2); s2 += __shfl_xor(s2, 2);
              const float mu = s1 * (1.f / 1024.f), var = fmaxf(s2 * (1.f / 1024.f) - mu * mu, 0.f);
              if ((tid & 3) == 0) { STAT[2 * (tid >> 2)] = mu; STAT[2 * (tid >> 2) + 1] = rsqrtf(var + EPS); } }
            __syncthreads();
#pragma unroll
            for (int k = 0; k < 4; ++k) { const int i = tid + 512 * k, sI = i >> 4, ch = i & 15;
                const float mu = STAT[2 * sI], rs = STAT[2 * sI + 1];
#pragma unroll
                for (int e = 0; e < 8; ++e) { const int c = ch * 8 + e; const float x = (bf2f((unsigned short)vch[k][e]) - mu) * rs * gg[e] + bb[e];
                    *(LAS bf16_t*)(VTs + c * 256 + (((sI >> 3) ^ ((c ^ (c >> 3)) & 15)) << 4) + (sI & 7) * 2) = (bf16_t)f2bf(x); } }
            if (uu + 1 < 8) GM_LOAD(uu + 1);
            const size_t orow = row0 + trow;
            u32x2 uwv[8];
#pragma unroll
            for (int ct = 0; ct < 8; ++ct) uwv[ct] = *(const u32x2*)(UV + orow * 2048 + g * 128 + ct * 16 + 4 * fq);
            __syncthreads();
            f32x4 acc[8];
#pragma unroll
            for (int ct = 0; ct < 8; ++ct) acc[ct] = (f32x4){0.f, 0.f, 0.f, 0.f};
#pragma unroll
            for (int ks = 0; ks < 4; ++ks) {
                const bf16x8 wf = *(const LAS bf16x8*)(Wb + trow * 256 + (((ks * 4 + fq) ^ (trow & 15)) << 4));
#pragma unroll
                for (int ct = 0; ct < 8; ++ct) {
                    const int crow = ct * 16 + fr;
                    const bf16x8 vf = *(const LAS bf16x8*)(VTs + crow * 256 + (((ks * 4 + fq) ^ ((crow ^ (crow >> 3)) & 15)) << 4));
                    acc[ct] = __builtin_amdgcn_mfma_f32_16x16x32_bf16(vf, wf, acc[ct], 0, 0, 0);
                }
            }
#pragma unroll
            for (int ct = 0; ct < 8; ++ct) {
                const int c = ct * 16 + 4 * fq;
                const u32x2 uw = uwv[ct];
                const float u0 = bf2f((unsigned short)(uw.x & 0xffffu)), u1 = bf2f((unsigned short)(uw.x >> 16)), u2 = bf2f((unsigned short)(uw.y & 0xffffu)), u3 = bf2f((unsigned short)(uw.y >> 16));
                u32x2 w; w.x = pk2(u0 * (acc[ct][0] + bias), u1 * (acc[ct][1] + bias)); w.y = pk2(u2 * (acc[ct][2] + bias), u3 * (acc[ct][3] + bias));
                *(u32x2*)(G + orow * 1024 + g * 128 + c) = w;
            }
        }
#undef GM_LOAD
    }
}

#define GAS __attribute__((address_space(1)))
typedef GAS unsigned gu32;
#define XB_TMO      128
#define XB_XCNT(j)  (256  + 64 * (j))
#define XB_XSUB(j)  (1280 + 64 * (j))
#define XB_XGEN(j)  (2304 + 64 * (j))
#define XB_TOP      3328
#define XB_TOPGEN   3392
#define XCD_BAR_WORDS 3456
#define XB_SPIN_CAP (1u << 18)

__device__ __forceinline__ unsigned xb_ld(unsigned* p)              { return __hip_atomic_load(p, __ATOMIC_RELAXED, __HIP_MEMORY_SCOPE_AGENT); }
__device__ __forceinline__ unsigned xb_add(unsigned* p, unsigned v) { return __hip_atomic_fetch_add(p, v, __ATOMIC_RELAXED, __HIP_MEMORY_SCOPE_AGENT); }
__device__ __forceinline__ unsigned xb_xcc_id() { return (unsigned)__builtin_amdgcn_s_getreg((3 << 11) | 20) & 0xFu; }
#define XB_SPIN(cond, bar) do { unsigned _sp = 0; while (cond) { __builtin_amdgcn_s_sleep(1); \
    if ((++_sp & 255u) == 0u) { if (xb_ld(&(bar)[XB_TMO])) break; if (_sp > XB_SPIN_CAP) { atomicAdd(&(bar)[XB_TMO], 1u); break; } } } } while (0)

struct XcdBarrier {
    unsigned* bar; unsigned x;
    volatile LAS unsigned* st;
};

__device__ __forceinline__ XcdBarrier xcd_barrier_post(unsigned* bar, volatile LAS unsigned* st) {
    XcdBarrier b; b.bar = bar; b.x = xb_xcc_id(); b.st = st;
    if (threadIdx.x == 0) (void)xb_add(&bar[XB_XCNT(b.x)], 1u);
    return b;
}
__device__ __forceinline__ void xcd_barrier_complete(unsigned* bar, unsigned x, unsigned& nloc, unsigned& nx) {
    const unsigned G = gridDim.x * gridDim.y * gridDim.z;
    unsigned sum, cnt, mine, sp = 0u;
    for (;;) {
        sum = 0u; cnt = 0u; mine = 0u;
#pragma unroll
        for (unsigned j = 0; j < 16; ++j) { const unsigned c = xb_ld(&bar[XB_XCNT(j)]); sum += c; cnt += (c > 0u) ? 1u : 0u; mine = (j == x) ? c : mine; }
        if (sum == G) break;
        __builtin_amdgcn_s_sleep(1);
        if ((++sp & 255u) == 0u) { if (xb_ld(&bar[XB_TMO])) break; if (sp > XB_SPIN_CAP) { atomicAdd(&bar[XB_TMO], 1u); break; } }
    }
    nloc = mine > 0u ? mine : 1u; nx = cnt > 0u ? cnt : 1u;
}

__device__ __forceinline__ void xcd_barrier(const XcdBarrier& b) {
    asm volatile("s_waitcnt vmcnt(0)" ::: "memory");
    __syncthreads();
    if (threadIdx.x == 0) {
        unsigned* bar = b.bar;
        __builtin_amdgcn_s_waitcnt(0);
        unsigned nloc = b.st[0], nx = b.st[1];
        if (nloc == 0u) { xcd_barrier_complete(bar, b.x, nloc, nx); b.st[0] = nloc; b.st[1] = nx; }
        const unsigned old = xb_add(&bar[XB_XSUB(b.x)], 1u);
        const unsigned gen = old / nloc;
        if (old + 1u == (gen + 1u) * nloc) {
            __builtin_amdgcn_fence(__ATOMIC_RELEASE, "agent");
            asm volatile("s_waitcnt vmcnt(0)" ::: "memory");
            const unsigned og = xb_add(&bar[XB_TOP], 1u);
            const unsigned tg = og / nx;
            if (og + 1u == (tg + 1u) * nx) xb_add(&bar[XB_TOPGEN], 1u);
            else XB_SPIN(xb_ld(&bar[XB_TOPGEN]) == tg, bar);
            __builtin_amdgcn_fence(__ATOMIC_ACQUIRE, "agent");
            xb_add(&bar[XB_XGEN(b.x)], 1u);
            asm volatile("s_waitcnt vmcnt(0)" ::: "memory");
        } else {
            XB_SPIN(xb_ld(&bar[XB_XGEN(b.x)]) == gen, bar);
            __builtin_amdgcn_fence(__ATOMIC_ACQUIRE, "agent");
            asm volatile("s_waitcnt vmcnt(0)" ::: "memory");
        }
    }
    __syncthreads();
}

constexpr int LDS_BYTES = 32768 * 4 + 256 + 6144 + 8 * 2560;

enum Phase {
    PH_PREP = 0, PH_GEMM_IN, PH_CNORM, PH_MIX0  , PH_GEMM_OUT0,
    PH_GEMM_Q0, PH_XATTN0, PH_GEMM_O0, PH_GEMM_GU0, PH_GEMM_DN0,
    PH_GEMM_OIN, PH_GMLP, PH_GEMM_OOUT,
    PH_GEMM_Q1, PH_XATTN1, PH_GEMM_O1, PH_GEMM_GU1, PH_GEMM_DN1, PH_FINAL, PH_COUNT
};

__device__ __forceinline__ PrepJob make_job(const Params& p, int ji) {
    unsigned char* ws = p.ws; PrepJob j{};
    switch (ji) {
    case 0: j = PrepJob{p.in[5], 1024, 3272, p.in[4], (bf16_t*)(ws + WS_WIN), 1024, 1792, 1024, 0, MAP_WIN}; break;
    case 14: j = PrepJob{p.in[5], 1024, 3272, p.in[4], (bf16_t*)(ws + WS_WIN), 3584, PW, 1024, 0, MAP_WIN}; break;
    case 15: j = PrepJob{p.in[5], 1024, 3272, p.in[4], (bf16_t*)(ws + WS_WIN8), 1024, 2816, 1024, 0, MAP_WIN8, 4, WQ_GU}; break;
    case 1: j = PrepJob{p.in[10] + (size_t)512 * 1024, 512, 1024, nullptr, (bf16_t*)(ws + WS_WOUT), 0, 1024, KOUT, 1024, MAP_ID}; break;
    case 2: j = PrepJob{p.in[11], 1024, 2048, p.in[4] + 1024, (bf16_t*)(ws + WS_OWIN), 0, 2048, 1024, 0, MAP_ID, 2, WQ_GU}; break;
    case 3: j = PrepJob{p.in[16], 1024, 1024, nullptr, (bf16_t*)(ws + WS_OWOUT), 0, 1024, 1024, 0, MAP_ID}; break;
    case 4: case 5: { const int l = ji - 4; j = PrepJob{p.in[19] + (size_t)l * 1024 * 512, 1024, 512, p.in[17] + l * 1024, (bf16_t*)(ws + WS_WQ + (size_t)l * 512 * 1024), 0, 512, 1024, 0, MAP_ID, 2, WQ_GU}; } break;
    case 6: case 7: { const int l = ji - 6; j = PrepJob{p.in[20] + (size_t)l * 1024 * 1024, 1024, 1024, p.in[18] + l * 1024, (bf16_t*)(ws + WS_WKV) + (size_t)l * 1024 * 1024, 0, 1024, 1024, 0, MAP_ID}; } break;
    case 8: case 9: { const int l = ji - 8; j = PrepJob{p.in[21] + (size_t)l * 512 * 1024, 512, 1024, nullptr, (bf16_t*)(ws + WS_WO + (size_t)l * 1024 * 512), 0, 1024, 512, 0, MAP_ID, 3, WO_SC}; } break;
    case 10: case 11: { const int l = ji - 10; j = PrepJob{p.in[23] + (size_t)l * 1024 * 2 * FF, 1024, 2 * FF, p.in[22] + l * 1024, (bf16_t*)(ws + WS_WGU + (size_t)l * 2 * FF * 1024), 0, 2 * FF, 1024, 0, MAP_GU, 2, WQ_GU}; } break;
    case 12: case 13: { const int l = ji - 12;
        if ((DN_FP8 >> l) & 1) j = PrepJob{p.in[24] + (size_t)l * FF * 1024, FF, 1024, nullptr, (bf16_t*)(ws + WS_WDN + (size_t)l * 1024 * FF * 2), 0, 1024, FF, 0, MAP_ID, 1, WDN_SC};
        else j = PrepJob{p.in[24] + (size_t)l * FF * 1024, FF, 1024, nullptr, (bf16_t*)(ws + WS_WDN) + (size_t)l * 1024 * FF, 0, 1024, FF, 0, MAP_ID}; } break;
    }
    return j;
}
constexpr int N_PREP_JOBS = 16;

template <int ph> __device__ __forceinline__ void run_phase(const Params& p, LAS float* lds, int vb, int nvb) {
    unsigned char* ws = p.ws;
    bf16_t* HN = (bf16_t*)(ws + WS_HN); bf16_t* BIG = (bf16_t*)(ws + WS_BIG); bf16_t* CN = (bf16_t*)(ws + WS_CN); bf16_t* CAT = (bf16_t*)(ws + WS_CAT);
    bf16_t* KB = (bf16_t*)(ws + WS_KB); bf16_t* VTB = (bf16_t*)(ws + WS_VT); bf16_t* MEMN = (bf16_t*)(ws + WS_MEMN); float* lb = (float*)(ws + WS_LB);
    float* ssq = (float*)(ws + WS_SSQ); float* lnp = (float*)(ws + WS_LNP);
    bf16_t* XQ = BIG; bf16_t* XO = BIG + (size_t)T * 512;
    const int l = (ph >= PH_GEMM_Q1) ? 1 : 0;
    switch (ph) {
    case PH_PREP:
        x_to_h_rows(p.in[0], HN, ws + WS_X8, ssq, vb, nvb);
        {
            constexpr int NT_[N_PREP_JOBS] = {16 * 3, 8 * 4, 16 * 8, 16 * 4, 16 * 2, 16 * 2, 16 * 4, 16 * 4, 8 * 4, 8 * 4, 16 * 22, 16 * 22, 44 * 4, 44 * 4, 16 * 1, 16 * 7};
            constexpr int CUM1 = NT_[0], CUM2 = CUM1 + NT_[1], CUM3 = CUM2 + NT_[2], CUM4 = CUM3 + NT_[3], CUM5 = CUM4 + NT_[4], CUM6 = CUM5 + NT_[5], CUM7 = CUM6 + NT_[6],
                          CUM8 = CUM7 + NT_[7], CUM9 = CUM8 + NT_[8], CUM10 = CUM9 + NT_[9], CUM11 = CUM10 + NT_[10], CUM12 = CUM11 + NT_[11], CUM13 = CUM12 + NT_[12], CUM14 = CUM13 + NT_[13],
                          CUM15 = CUM14 + NT_[14], CUM16 = CUM15 + NT_[15];
#define PJ_FIND(it_, ji_, base_) do { ji_ = 0; base_ = 0; \
                PJ_STEP(it_, ji_, base_, 1, CUM1) PJ_STEP(it_, ji_, base_, 2, CUM2) PJ_STEP(it_, ji_, base_, 3, CUM3) PJ_STEP(it_, ji_, base_, 4, CUM4) PJ_STEP(it_, ji_, base_, 5, CUM5) PJ_STEP(it_, ji_, base_, 6, CUM6) PJ_STEP(it_, ji_, base_, 7, CUM7) \
                PJ_STEP(it_, ji_, base_, 8, CUM8) PJ_STEP(it_, ji_, base_, 9, CUM9) PJ_STEP(it_, ji_, base_, 10, CUM10) PJ_STEP(it_, ji_, base_, 11, CUM11) PJ_STEP(it_, ji_, base_, 12, CUM12) PJ_STEP(it_, ji_, base_, 13, CUM13) PJ_STEP(it_, ji_, base_, 14, CUM14) PJ_STEP(it_, ji_, base_, 15, CUM15) } while (0)
#define PJ_STEP(it_, ji_, base_, q, c) if ((it_) >= (c)) { ji_ = (q); base_ = (c); }
            f32x4 va[8], vn[8];
            int ji, base;
            if (vb < CUM16) { PJ_FIND(vb, ji, base); const PrepJob j = make_job(p, ji); prep_tile_load(j, vb - base, va); }
            for (int it = vb; it < CUM16; it += nvb) {
                PJ_FIND(it, ji, base);
                const PrepJob j = make_job(p, ji); const int tl = it - base;
                if (it + nvb < CUM16) { int jn, bn; PJ_FIND(it + nvb, jn, bn); const PrepJob j2 = make_job(p, jn); prep_tile_load(j2, it + nvb - bn, vn); }
                prep_tile_store(j, tl, va, lds);
#pragma unroll
                for (int q = 0; q < 8; ++q) va[q] = vn[q];
            }
#undef PJ_STEP
#undef PJ_FIND
        }
        prep_fold_in(p.in[5], p.in[7], p.in[4], (bf16_t*)(ws + WS_WIN8), lds, vb, nvb);
        prep_fold_out(p.in[10], p.in[8], (bf16_t*)(ws + WS_WOUT), lds, vb, nvb);
        prep_lb(p.in[3], lb, vb, nvb);
        rmsnorm_rows(p.in[1], MEMN, MT, vb, nvb);
        break;
    case PH_GEMM_IN: {
        {
            Gemm g{(const bf16_t*)(ws + WS_X8), (const bf16_t*)(ws + WS_WIN8), T, 2816, 512}; EpiStoreBf16<true, true> E{BIG, PW, ssq, 1.f / (HQ_X * WQ_GU)};
            run_gemm<EpiStoreBf16<true, true>, 2>(g, E, lds, vb, nvb);
        }
        Gemm g{(const bf16_t*)(ws + WS_WIN), (const bf16_t*)(ws + WS_WIN), T, PW, 1024}; EpiIn E{BIG, KB, VTB, ssq};
        pg8::ComboOrder S; S.init(nvb, nvb - 1 - vb);
        pg8::gemm_phase<EpiIn, pg8::ComboOrder, true, true>((LAS unsigned char*)lds, g, S, E);
    } break;
    case PH_CNORM: cnorm_rows(BIG, p.in[6], CN, vb, nvb); hgrn_prep(BIG, lb, (float*)(ws + WS_DEC), (LAS unsigned char*)lds, vb, nvb); break;
    case PH_MIX0:
        for (int item = vb; item < 64; item += nvb) hgrn_scan(BIG, (const float*)(ws + WS_DEC), p.in[9], CAT, (LAS unsigned char*)lds, item);
        dsa_mfma_phase(BIG, CN, p.in[2], CAT, (LAS unsigned char*)lds, (unsigned*)(ws + WS_CTL) + 3600);
        break;
    case PH_GEMM_OUT0: { Gemm g{CAT, (const bf16_t*)(ws + WS_WOUT), T, 1024, KOUT}; EpiResid<false, false, true> E{nullptr, HN, ssq, ws + WS_H8, HQ_Q0}; run_gemm(g, E, lds, vb, nvb); } break;
    case PH_GEMM_Q0: case PH_GEMM_Q1: { Gemm g{(const bf16_t*)(ws + WS_H8), (const bf16_t*)(ws + WS_WQ + (size_t)l * 512 * 1024), T, 512, 512}; EpiStoreBf16<true> E{XQ, 512, ssq, 1.f / ((l ? HQ_Q1 : HQ_Q0) * WQ_GU)}; run_gemm<EpiStoreBf16<true>, 2>(g, E, lds, vb, nvb); } break;
    case PH_XATTN0: case PH_XATTN1: xattn_mfma_phase(XQ, KB + (size_t)l * MT * 512, VTB + (size_t)l * 512 * MT, XO, (LAS unsigned char*)lds, vb, nvb); break;
    case PH_GEMM_O0: case PH_GEMM_O1: { Gemm g{XO, (const bf16_t*)(ws + WS_WO + (size_t)l * 1024 * 512), T, 1024, 256}; EpiResid<false, true, true> E{nullptr, HN, ssq, ws + WS_H8, l ? HQ_GU1 : HQ_GU0, XO_UNSC}; run_gemm<EpiResid<false, true, true>, 1>(g, E, lds, vb, nvb); } break;
    case PH_GEMM_GU0: case PH_GEMM_GU1: { constexpr bool dn8 = ((DN_FP8 >> l) & 1) != 0;
        Gemm g{(const bf16_t*)(ws + WS_H8), (const bf16_t*)(ws + WS_WGU + (size_t)l * 2 * FF * 1024), T, 2 * FF, 512}; EpiSwigluQ<true, dn8> E{BIG, FF, ssq, 1.f / ((l ? HQ_GU1 : HQ_GU0) * WQ_GU)}; run_gemm<EpiSwigluQ<true, dn8>, 2>(g, E, lds, vb, nvb); } break;
    case PH_GEMM_DN0: case PH_GEMM_DN1:
        if constexpr (((DN_FP8 >> l) & 1) != 0) { Gemm g{BIG, (const bf16_t*)(ws + WS_WDN + (size_t)l * 1024 * FF * 2), T, 1024, FF / 2}; EpiResid<false, true, ph == PH_GEMM_DN0> E{nullptr, HN, ssq, ws + WS_H8, HQ_OIN, DN_UNSC}; run_gemm<EpiResid<false, true, ph == PH_GEMM_DN0>, 1>(g, E, lds, vb, nvb); }
        else { Gemm g{BIG, (const bf16_t*)(ws + WS_WDN) + (size_t)l * 1024 * FF, T, 1024, FF}; EpiResid<false, false, ph == PH_GEMM_DN0> E{nullptr, HN, ssq, ws + WS_H8, HQ_OIN}; run_gemm(g, E, lds, vb, nvb); }
        break;
    case PH_GEMM_OIN: { Gemm g{(const bf16_t*)(ws + WS_H8), (const bf16_t*)(ws + WS_OWIN), T, 2048, 512}; EpiGeluBf16<true> E{BIG, 2048, ssq, lnp, 1.f / (HQ_OIN * WQ_GU)}; run_gemm<EpiGeluBf16<true>, 2>(g, E, lds, vb, nvb); } break;
    case PH_GMLP: gmlp_mfma_phase(BIG, lnp, p.in[12], p.in[13], p.in[14], p.in[15], CAT, (LAS unsigned char*)lds, vb, nvb); break;
    case PH_GEMM_OOUT: { Gemm g{CAT, (const bf16_t*)(ws + WS_OWOUT), T, 1024, 1024}; EpiResid<false, false, true> E{nullptr, HN, ssq, ws + WS_H8, HQ_Q1}; run_gemm(g, E, lds, vb, nvb); } break;
    case PH_FINAL: final_rows(HN, ssq, p.in[25], p.out, vb, nvb); break;
    default: break;
    }
}

template <int PH> __global__ void __launch_bounds__(NTHREADS) k_phase(Params p) {
    extern __shared__ __attribute__((aligned(16))) float smem[];
    run_phase<PH>(p, (LAS float*)smem, blockIdx.x, gridDim.x);
}

template <int PH> __device__ __forceinline__ void mega_phases(const Params& p, LAS float* lds, const XcdBarrier& bar) {
    run_phase<PH>(p, lds, blockIdx.x, gridDim.x);
#ifdef REPEAT_PH
    if constexpr (PH == REPEAT_PH) { xcd_barrier(bar); run_phase<PH>(p, lds, blockIdx.x, gridDim.x); }
#endif
    if constexpr (PH + 1 < PH_COUNT) { xcd_barrier(bar); mega_phases<PH + 1>(p, lds, bar); }
}
__global__ void __launch_bounds__(NTHREADS) k_mega(Params p) {
    extern __shared__ __attribute__((aligned(16))) float smem[];
    volatile LAS unsigned* st = (volatile LAS unsigned*)((LAS float*)smem + 32768);
    if (threadIdx.x < 2) st[threadIdx.x] = 0u;
    __syncthreads();
    const XcdBarrier bar = xcd_barrier_post((unsigned*)(p.ws + WS_CTL), st);
    mega_phases<0>(p, (LAS float*)smem, bar);
}

template <int PH> static void launch_phases(const Params& p, int grid, hipStream_t stream) {
    int g = grid * 4;
    if (PH == PH_MIX0 || PH == PH_XATTN0 || PH == PH_XATTN1 || PH == PH_GMLP) g = grid;
    (void)hipFuncSetAttribute((const void*)k_phase<PH>, hipFuncAttributeMaxDynamicSharedMemorySize, LDS_BYTES);
    hipLaunchKernelGGL(k_phase<PH>, dim3(g), dim3(NTHREADS), LDS_BYTES, stream, p);
    if constexpr (PH + 1 < PH_COUNT) launch_phases<PH + 1>(p, grid, stream);
}

extern "C" void kernel_launch(void* const* d_in, const int* in_sizes, int n_in, void* d_out, int out_size, void* d_ws, size_t ws_size, hipStream_t stream) {
    static int grid = 0;
    if (grid == 0) {
        if (n_in != 26 || out_size != T * D || ws_size < WS_END) { fprintf(stderr, "kernel_launch: unexpected shapes (n_in %d out %d ws %zu)\n", n_in, out_size, ws_size); grid = -1; return; }
        int dev = 0, cus = 0;
        (void)hipGetDevice(&dev); (void)hipDeviceGetAttribute(&cus, hipDeviceAttributeMultiprocessorCount, dev);
        (void)hipFuncSetAttribute((const void*)k_mega, hipFuncAttributeMaxDynamicSharedMemorySize, LDS_BYTES);
        int per_cu = 0;
        (void)hipOccupancyMaxActiveBlocksPerMultiprocessor(&per_cu, (const void*)k_mega, NTHREADS, LDS_BYTES);
        if (per_cu < 1) fprintf(stderr, "kernel_launch: occupancy query says %d blocks per CU\n", per_cu);
        (void)hipGetLastError();
        grid = cus > 0 ? cus : 256;
    }
    if (grid < 0) return;
    Params p{};
    for (int i = 0; i < 26; ++i) p.in[i] = (const float*)d_in[i];
    p.out = (float*)d_out; p.ws = (unsigned char*)d_ws;
    (void)hipMemsetAsync((char*)d_ws + WS_CTL, 0, 16384, stream);
#if MEGA
    hipLaunchKernelGGL(k_mega, dim3(grid), dim3(NTHREADS), LDS_BYTES, stream, p);
#else
    launch_phases<0>(p, grid, stream);
#endif
}
```

```cpp
#include <hip/hip_runtime.h>
#include <stdint.h>
#include <stdio.h>

#ifndef MEGA
#define MEGA 1
#endif
#ifndef DN_FP8
#define DN_FP8 2
#endif

#define LAS __attribute__((address_space(3)))
typedef unsigned short bf16_t;
typedef short bf16x8 __attribute__((ext_vector_type(8)));
typedef float f32x4 __attribute__((ext_vector_type(4)));
typedef float f32x2 __attribute__((ext_vector_type(2)));
typedef unsigned u32x4 __attribute__((ext_vector_type(4)));
typedef unsigned u32x2 __attribute__((ext_vector_type(2)));
typedef float f32x16 __attribute__((ext_vector_type(16)));

constexpr int D = 1024, BATCH = 16, SEQ = 2048, T = BATCH * SEQ;
constexpr int CHUNK = 64;
constexpr int MEMT = 256, MT = BATCH * MEMT;
constexpr int FF = 2816;
constexpr float EPS = 1e-6f;
constexpr int NTHREADS = 512, NWAVES = 8;

constexpr int P_QL = 0, P_C = 1024, P_QI = 1152, P_KI = 1664, P_FB = 1728, P_IB = 2240, P_QB = 2752, P_GB = 3264, P_WI = 3776, P_END = 3784, PW = 3840;
constexpr int KOUT = 1536;

constexpr size_t MiB = 1u << 20;
constexpr size_t WS_CTL = 0;
constexpr size_t WS_LB = 64 * 1024;
constexpr size_t WS_SSQ = 496 * MiB;
constexpr size_t WS_LNP = 498 * MiB;
constexpr size_t WS_WIN = 1 * MiB;
constexpr size_t WS_WKV = WS_WIN + (size_t)PW * D * 2;
constexpr size_t WS_HN = WS_WKV + 2 * (size_t)D * D * 2;
constexpr size_t WS_MEMN = WS_HN + (size_t)T * D * 2;
constexpr size_t WS_WOUT = WS_MEMN + (size_t)MT * D * 2;
constexpr size_t WS_OWIN = WS_WOUT + (size_t)D * KOUT * 2;
constexpr size_t WS_OWOUT = WS_OWIN + (size_t)2048 * D * 2;
constexpr size_t WS_WQ = WS_OWOUT + (size_t)D * D * 2;
constexpr size_t WS_WO = WS_WQ + 2 * (size_t)512 * D * 2;
constexpr size_t WS_WGU = WS_WO + 2 * (size_t)D * 512 * 2;
constexpr size_t WS_WDN = WS_WGU + 2 * (size_t)2 * FF * D * 2;
constexpr size_t WS_WEND = WS_WDN + 2 * (size_t)D * FF * 2;
constexpr int TILE_WIN = 0, TILE_WKV = PW / 256, TILE_HN = TILE_WKV + 8, TILE_MEMN = TILE_HN + T / 256;
constexpr size_t WS_BIG = 132 * MiB;
constexpr size_t WS_CN = 372 * MiB;
constexpr size_t WS_CAT = 380 * MiB;
constexpr size_t WS_H8 = WS_BIG + 200 * MiB;
constexpr size_t WS_X8 = WS_CAT;
constexpr size_t WS_WIN8 = WS_CAT + 32 * MiB;
constexpr size_t WS_KB = 476 * MiB;
constexpr size_t WS_VT = 484 * MiB;
constexpr size_t WS_END = 502 * MiB;
static_assert(WS_WEND <= WS_BIG, "weights fit below BIG");

struct Params {
    const float* in[26];
    float* out;
    unsigned char* ws;
};

__device__ __forceinline__ float bf2f(unsigned short u) { return __uint_as_float(((unsigned)u) << 16); }
__device__ __forceinline__ unsigned f2bf(float f) { unsigned u = __float_as_uint(f); return (u + 0x7fffu + ((u >> 16) & 1u)) >> 16; }
typedef __bf16 bf16x2_t __attribute__((ext_vector_type(2)));
__device__ __forceinline__ unsigned pk2(float lo, float hi) { const f32x2 v = {lo, hi}; return __builtin_bit_cast(unsigned, __builtin_convertvector(v, bf16x2_t)); }
__device__ __forceinline__ float wave_sum(float v) {
#pragma unroll
    for (int o = 1; o < 64; o <<= 1) v += __shfl_xor(v, o);
    return v;
}
__device__ __forceinline__ float wave_max(float v) {
#pragma unroll
    for (int o = 1; o < 64; o <<= 1) v = fmaxf(v, __shfl_xor(v, o));
    return v;
}
__device__ __forceinline__ int otid() { int t = threadIdx.x; asm volatile("" : "+v"(t)); return t; }
#define WAVE_LDS_SYNC() asm volatile("s_waitcnt lgkmcnt(0)" ::: "memory")
__device__ __forceinline__ float silu_f(float x) { return x * __builtin_amdgcn_rcpf(1.f + __expf(-x)); }
__device__ __forceinline__ float sigmoid_f(float x) { return __builtin_amdgcn_rcpf(1.f + __expf(-x)); }

typedef int i32x4v __attribute__((ext_vector_type(4)));
typedef int i32x8v __attribute__((ext_vector_type(8)));
__device__ __forceinline__ unsigned pk4_f8(float a, float b, float c, float d) {
    a = __builtin_amdgcn_fmed3f(a, -448.f, 448.f); b = __builtin_amdgcn_fmed3f(b, -448.f, 448.f); c = __builtin_amdgcn_fmed3f(c, -448.f, 448.f); d = __builtin_amdgcn_fmed3f(d, -448.f, 448.f);
    int w = 0;
    w = __builtin_amdgcn_cvt_pk_fp8_f32(a, b, w, false);
    w = __builtin_amdgcn_cvt_pk_fp8_f32(c, d, w, true);
    return (unsigned)w;
}
constexpr float ACT_SC = 8.f, WDN_SC = 256.f, DN_UNSC = 1.f / (ACT_SC * WDN_SC);
constexpr float XO_SC = 64.f, WO_SC = 128.f, XO_UNSC = 1.f / (XO_SC * WO_SC);
constexpr float HQ_X = 127.f / 4.2f;
constexpr float HQ_Q0 = 127.f / 5.2f, HQ_GU0 = 127.f / 5.2f, HQ_OIN = 127.f / 5.8f, HQ_Q1 = 127.f / 6.3f, HQ_GU1 = 127.f / 6.3f, WQ_GU = 127.f / 0.13f;
__device__ __forceinline__ unsigned pk4_i8(float a, float b, float c, float d, float sc) {
    constexpr float MG = 12582912.f;
    const unsigned ua = __float_as_uint(__builtin_amdgcn_fmed3f(__builtin_fmaf(a, sc, MG), MG - 127.f, MG + 127.f)), ub = __float_as_uint(__builtin_amdgcn_fmed3f(__builtin_fmaf(b, sc, MG), MG - 127.f, MG + 127.f));
    const unsigned uc = __float_as_uint(__builtin_amdgcn_fmed3f(__builtin_fmaf(c, sc, MG), MG - 127.f, MG + 127.f)), ud = __float_as_uint(__builtin_amdgcn_fmed3f(__builtin_fmaf(d, sc, MG), MG - 127.f, MG + 127.f));
    return __builtin_amdgcn_perm(ub, ua, 0x0c0c0400u) | __builtin_amdgcn_perm(ud, uc, 0x04000c0cu);
}
__device__ __forceinline__ int kperm8(int k) { const int r = k & 255; return (k & ~255) + ((r >> 5) & 3) * 64 + ((r >> 3) & 3) * 16 + (r >> 7) * 8 + (r & 7); }
__device__ __forceinline__ f32x4 i2f4(f32x4 v) { const i32x4v t = __builtin_bit_cast(i32x4v, v); return (f32x4){(float)t.x, (float)t.y, (float)t.z, (float)t.w}; }
struct Unit { int pm, pn, idx; };
struct Gemm { const bf16_t* A; const bf16_t* Bt; int M, N, K; };
__device__ __forceinline__ int perm32(int rho) { const int n = rho >> 4, i = rho & 15; return 8 * (i >> 2) + 4 * n + (i & 3); }

__device__ __forceinline__ float row_rstd(const float* ssq, size_t row) {
    const f32x4* p = (const f32x4*)(ssq + row * 16);
    const f32x4 a = p[0], b = p[1], c = p[2], d = p[3];
    const float t = (((a.x + a.y) + (a.z + a.w)) + ((b.x + b.y) + (b.z + b.w))) + (((c.x + c.y) + (c.z + c.w)) + ((d.x + d.y) + (d.z + d.w)));
    return rsqrtf(t * (1.f / 1024.f) + EPS);
}
__device__ __forceinline__ void rows_rstd(const float* ssq, size_t row0, int fq, float (&rs)[2][4]) {
#pragma unroll
    for (int ai = 0; ai < 2; ++ai)
#pragma unroll
        for (int m = 0; m < 4; ++m) { const f32x4 a = *(const f32x4*)(ssq + (row0 + ai * 128 + m * 16) * 16 + 4 * fq); rs[ai][m] = (a.x + a.y) + (a.z + a.w); }
#pragma unroll
    for (int ai = 0; ai < 2; ++ai)
#pragma unroll
        for (int m = 0; m < 4; ++m) { float t = rs[ai][m]; t += __shfl_xor(t, 16); t += __shfl_xor(t, 32); rs[ai][m] = rsqrtf(t * (1.f / 1024.f) + EPS); }
}
constexpr int RSTD_TAB_OFF = 137472, RSTD_TAB_UNITS = 20;
template <class Sched> __device__ __forceinline__ void build_rstd_table(const Sched& S, const float* ssq, LAS float* tab) {
    const int tid = otid(), r = tid >> 1, hh = tid & 1;
    Unit u;
    for (int i = 0; i < RSTD_TAB_UNITS && S.next(i, u); ++i) {
        const f32x4 a = *(const f32x4*)(ssq + ((size_t)u.pm * 256 + r) * 16 + hh * 8), b = *(const f32x4*)(ssq + ((size_t)u.pm * 256 + r) * 16 + hh * 8 + 4);
        float t = ((a.x + a.y) + (a.z + a.w)) + ((b.x + b.y) + (b.z + b.w));
        t += __shfl_xor(t, 1);
        if (hh == 0) tab[i * 256 + r] = rsqrtf(t * (1.f / 1024.f) + EPS);
    }
    __syncthreads();
}
__device__ __forceinline__ void rows_rstd_tab(const LAS float* tab, int idx, int rloc, float (&rs)[2][4]) {
#pragma unroll
    for (int ai = 0; ai < 2; ++ai)
#pragma unroll
        for (int m = 0; m < 4; ++m) rs[ai][m] = tab[idx * 256 + rloc + ai * 128 + m * 16];
}
template <bool ACC_I8 = false, bool REMAP = false> struct EpiStoreBf16 {
    static constexpr bool PERM = true, AFTER_DRAIN = false;
    static constexpr bool USES_TAB = true;
    bf16_t* O; int ldc; const float* ssq; float dq = 1.f; const LAS float* tab = nullptr;
    __device__ __forceinline__ void operator()(const f32x4 (&acc)[2][2][4][2], const Unit& u, int wr, int wc, int fr, int fq) const {
        const int ct = REMAP ? (u.pn < 4 ? u.pn : u.pn + 3) : u.pn;
        const int row0 = u.pm * 256 + wr * 64 + fr, col0 = ct * 256 + wc * 32 + 8 * fq;
        float rsv[2][4]; rows_rstd_tab(tab, u.idx, wr * 64 + fr, rsv);
#pragma unroll
        for (int ai = 0; ai < 2; ++ai)
#pragma unroll
            for (int m = 0; m < 4; ++m) {
                const float rs = ACC_I8 ? rsv[ai][m] * dq : rsv[ai][m];
                bf16_t* rowp = O + (size_t)(row0 + ai * 128 + m * 16) * ldc + col0;
#pragma unroll
                for (int bj = 0; bj < 2; ++bj) {
                    const f32x4 v0 = (ACC_I8 ? i2f4(acc[ai][bj][m][0]) : acc[ai][bj][m][0]) * rs, v1 = (ACC_I8 ? i2f4(acc[ai][bj][m][1]) : acc[ai][bj][m][1]) * rs;
                    u32x4 w; w.x = pk2(v0[0], v0[1]); w.y = pk2(v0[2], v0[3]); w.z = pk2(v1[0], v1[1]); w.w = pk2(v1[2], v1[3]);
                    *(u32x4*)(rowp + bj * 128) = w;
                }
            }
    }
};
struct EpiIn {
    static constexpr bool PERM = true, AFTER_DRAIN = false;
    static constexpr bool USES_TAB = false;
    bf16_t* P; bf16_t* KB; bf16_t* VT; const float* ssq;
    __device__ __forceinline__ void operator()(const f32x4 (&acc)[2][2][4][2], const Unit& u, int wr, int wc, int fr, int fq) const {
        bf16_t* O; int ldc, rt, ct; const bool main_unit = u.pn < TILE_WKV;
        if (main_unit) { O = P; ldc = PW; rt = u.pm - TILE_HN; ct = u.pn; }
        else if (u.pm >= TILE_MEMN) { const int l = (u.pn - TILE_WKV) >> 2; O = KB + (size_t)l * MT * 512; ldc = 512; rt = u.pm - TILE_MEMN; ct = (u.pn - TILE_WKV) & 3; }
        else { const int l = (u.pm - TILE_WKV) >> 2; O = VT + (size_t)l * 512 * MT; ldc = MT; rt = ((u.pm - TILE_WKV) & 3) - 2; ct = u.pn - TILE_MEMN; }
        const int row0 = rt * 256 + wr * 64 + fr, col0 = ct * 256 + wc * 32 + 8 * fq;
        float rsv[2][4];
        if (main_unit) rows_rstd(ssq, (size_t)row0, fq, rsv);
        else {
#pragma unroll
            for (int ai = 0; ai < 2; ++ai)
#pragma unroll
                for (int m = 0; m < 4; ++m) rsv[ai][m] = 1.f; }
#pragma unroll
        for (int ai = 0; ai < 2; ++ai)
#pragma unroll
            for (int m = 0; m < 4; ++m) {
                const float rs = rsv[ai][m];
                bf16_t* rowp = O + (size_t)(row0 + ai * 128 + m * 16) * ldc + col0;
#pragma unroll
                for (int bj = 0; bj < 2; ++bj) {
                    const f32x4 v0 = acc[ai][bj][m][0] * rs, v1 = acc[ai][bj][m][1] * rs;
                    u32x4 w; w.x = pk2(v0[0], v0[1]); w.y = pk2(v0[2], v0[3]); w.z = pk2(v1[0], v1[1]); w.w = pk2(v1[2], v1[3]);
                    *(u32x4*)(rowp + bj * 128) = w;
                }
            }
    }
};
template <bool ACC_I8 = false> struct EpiGeluBf16 {
    static constexpr bool PERM = true, AFTER_DRAIN = false;
    static constexpr bool USES_TAB = true;
    bf16_t* O; int ldc; const float* ssq; float* lnp; float dq = 1.f; const LAS float* tab = nullptr;
    __device__ __forceinline__ static f32x2 gelu_pk(f32x2 v) {
        const f32x2 av = __builtin_elementwise_abs(v), d = av * 0.2316418882f + 1.0f;
        f32x2 t; t.x = __builtin_amdgcn_rcpf(d.x); t.y = __builtin_amdgcn_rcpf(d.y);
        f32x2 q = t * 0.5307027145f + (-0.7265760135f); q = q * t + 0.7107068705f; q = q * t + (-0.142248368f); q = q * t + 0.127414796f; q = q * t;
        const f32x2 sq = (v * v) * (-0.72134752044f);
        f32x2 e; e.x = __builtin_amdgcn_exp2f(sq.x); e.y = __builtin_amdgcn_exp2f(sq.y);
        const f32x2 mm = v * (q * e), r = v - mm;
        f32x2 o; o.x = v.x < 0.f ? mm.x : r.x; o.y = v.y < 0.f ? mm.y : r.y; return o;
    }
    __device__ __forceinline__ static unsigned g2(float a, float b) { const f32x2 r = gelu_pk((f32x2){a, b}); return pk2(r.x, r.y); }
    __device__ __forceinline__ void operator()(const f32x4 (&acc)[2][2][4][2], const Unit& u, int wr, int wc, int fr, int fq) const {
        const int row0 = u.pm * 256 + wr * 64 + fr, col0 = u.pn * 256 + wc * 32 + 8 * fq;
        float rsv[2][4]; rows_rstd_tab(tab, u.idx, wr * 64 + fr, rsv);
#pragma unroll
        for (int ai = 0; ai < 2; ++ai)
#pragma unroll
            for (int m = 0; m < 4; ++m) {
                const size_t row = (size_t)(row0 + ai * 128 + m * 16);
                const float rs = ACC_I8 ? rsv[ai][m] * dq : rsv[ai][m];
                bf16_t* rowp = O + row * ldc + col0;
                float s1 = 0.f, s2 = 0.f;
#pragma unroll
                for (int bj = 0; bj < 2; ++bj) {
                    const f32x4 v0 = (ACC_I8 ? i2f4(acc[ai][bj][m][0]) : acc[ai][bj][m][0]) * rs, v1 = (ACC_I8 ? i2f4(acc[ai][bj][m][1]) : acc[ai][bj][m][1]) * rs;
                    const f32x2 ga = gelu_pk((f32x2){v0[0], v0[1]}), gb = gelu_pk((f32x2){v0[2], v0[3]}), gc = gelu_pk((f32x2){v1[0], v1[1]}), gd = gelu_pk((f32x2){v1[2], v1[3]});
                    u32x4 w; w.x = pk2(ga.x, ga.y); w.y = pk2(gb.x, gb.y); w.z = pk2(gc.x, gc.y); w.w = pk2(gd.x, gd.y);
                    *(u32x4*)(rowp + bj * 128) = w;
                    s1 += ((ga.x + ga.y) + (gb.x + gb.y)) + ((gc.x + gc.y) + (gd.x + gd.y));
                    s2 += ((ga.x * ga.x + ga.y * ga.y) + (gb.x * gb.x + gb.y * gb.y)) + ((gc.x * gc.x + gc.y * gc.y) + (gd.x * gd.x + gd.y * gd.y));
                }
                if (u.pn >= 4) {
                    s1 += __shfl_xor(s1, 16); s1 += __shfl_xor(s1, 32); s2 += __shfl_xor(s2, 16); s2 += __shfl_xor(s2, 32);
                    if (fq == 0) *(f32x2*)(lnp + (row * 16 + (u.pn - 4) * 4 + wc) * 2) = (f32x2){s1, s2};
                }
            }
    }
};
struct EpiSwigluBf16 {
    static constexpr bool PERM = true, AFTER_DRAIN = false, USES_TAB = false;
    bf16_t* O; int ldc; const float* ssq;
    __device__ __forceinline__ void operator()(const f32x4 (&acc)[2][2][4][2], const Unit& u, int wr, int wc, int fr, int fq) const {
        const int row0 = u.pm * 256 + wr * 64 + fr, col0 = u.pn * 128 + wc * 32 + 8 * fq;
        float rsv[2][4]; rows_rstd(ssq, (size_t)row0, fq, rsv);
#pragma unroll
        for (int ai = 0; ai < 2; ++ai)
#pragma unroll
            for (int m = 0; m < 4; ++m) {
                const float rs = rsv[ai][m];
                bf16_t* rowp = O + (size_t)(row0 + ai * 128 + m * 16) * ldc + col0;
                const f32x4 g0 = acc[ai][0][m][0] * rs, g1 = acc[ai][0][m][1] * rs, u0 = acc[ai][1][m][0] * rs, u1 = acc[ai][1][m][1] * rs;
                u32x4 w;
                w.x = pk2(silu_f(g0[0]) * u0[0], silu_f(g0[1]) * u0[1]); w.y = pk2(silu_f(g0[2]) * u0[2], silu_f(g0[3]) * u0[3]);
                w.z = pk2(silu_f(g1[0]) * u1[0], silu_f(g1[1]) * u1[1]); w.w = pk2(silu_f(g1[2]) * u1[2], silu_f(g1[3]) * u1[3]);
                *(u32x4*)rowp = w;
            }
    }
};
template <bool ACC_I8, bool OUT_F8> struct EpiSwigluQ {
    static constexpr bool PERM = true, AFTER_DRAIN = false;
    static constexpr bool USES_TAB = true;
    void* O; int ldc; const float* ssq; float dq; const LAS float* tab = nullptr;
    __device__ __forceinline__ void operator()(const f32x4 (&acc)[2][2][4][2], const Unit& u, int wr, int wc, int fr, int fq) const {
        const int row0 = u.pm * 256 + wr * 64 + fr, col0 = u.pn * 128 + wc * 32 + 8 * fq;
        float rsv[2][4]; rows_rstd_tab(tab, u.idx, wr * 64 + fr, rsv);
#pragma unroll
        for (int ai = 0; ai < 2; ++ai)
#pragma unroll
            for (int m = 0; m < 4; ++m) {
                const float rs = ACC_I8 ? rsv[ai][m] * dq : rsv[ai][m], rsu = OUT_F8 ? rs * ACT_SC : rs;
                f32x4 g0 = acc[ai][0][m][0], g1 = acc[ai][0][m][1], u0 = acc[ai][1][m][0], u1 = acc[ai][1][m][1];
                if (ACC_I8) { g0 = i2f4(g0); g1 = i2f4(g1); u0 = i2f4(u0); u1 = i2f4(u1); }
                g0 = g0 * rs; g1 = g1 * rs; u0 = u0 * rsu; u1 = u1 * rsu;
                if (OUT_F8) {
                    unsigned char* rowp = (unsigned char*)O + (size_t)(row0 + ai * 128 + m * 16) * ldc + col0;
                    u32x2 w;
                    w.x = pk4_f8(silu_f(g0[0]) * u0[0], silu_f(g0[1]) * u0[1], silu_f(g0[2]) * u0[2], silu_f(g0[3]) * u0[3]);
                    w.y = pk4_f8(silu_f(g1[0]) * u1[0], silu_f(g1[1]) * u1[1], silu_f(g1[2]) * u1[2], silu_f(g1[3]) * u1[3]);
                    *(u32x2*)rowp = w;
                } else {
                    bf16_t* rowp = (bf16_t*)O + (size_t)(row0 + ai * 128 + m * 16) * ldc + col0;
                    u32x4 w;
                    w.x = pk2(silu_f(g0[0]) * u0[0], silu_f(g0[1]) * u0[1]); w.y = pk2(silu_f(g0[2]) * u0[2], silu_f(g0[3]) * u0[3]);
                    w.z = pk2(silu_f(g1[0]) * u1[0], silu_f(g1[1]) * u1[1]); w.w = pk2(silu_f(g1[2]) * u1[2], silu_f(g1[3]) * u1[3]);
                    *(u32x4*)rowp = w;
                }
            }
    }
};
template <bool BASE_F32, bool SCALED = false, bool W8 = false> struct EpiResid {
    static constexpr bool PERM = true, AFTER_DRAIN = false;
    static constexpr bool USES_TAB = false;
    const float* xbase; bf16_t* H; float* ssq; unsigned char* H8 = nullptr; float hq = 0.f; float asc = 1.f;
    __device__ __forceinline__ void operator()(const f32x4 (&acc)[2][2][4][2], const Unit& u, int wr, int wc, int fr, int fq) const {
        const int row0 = u.pm * 256 + wr * 64 + fr, col0 = u.pn * 256 + wc * 32 + 8 * fq;
#pragma unroll
        for (int ai = 0; ai < 2; ++ai)
#pragma unroll
            for (int m = 0; m < 4; ++m) {
                const size_t row = (size_t)(row0 + ai * 128 + m * 16);
                float ss = 0.f; u32x4 q8 = (u32x4){0u, 0u, 0u, 0u};
#pragma unroll
                for (int bj = 0; bj < 2; ++bj) {
                    const size_t off = row * 1024 + col0 + bj * 128;
                    f32x4 b0, b1;
                    if (BASE_F32) { b0 = *(const f32x4*)(xbase + off); b1 = *(const f32x4*)(xbase + off + 4); }
                    else { const u32x4 hw = *(const u32x4*)(H + off);
                        b0 = (f32x4){bf2f((unsigned short)(hw.x & 0xffffu)), bf2f((unsigned short)(hw.x >> 16)), bf2f((unsigned short)(hw.y & 0xffffu)), bf2f((unsigned short)(hw.y >> 16))};
                        b1 = (f32x4){bf2f((unsigned short)(hw.z & 0xffffu)), bf2f((unsigned short)(hw.z >> 16)), bf2f((unsigned short)(hw.w & 0xffffu)), bf2f((unsigned short)(hw.w >> 16))}; }
                    const float sc = SCALED ? asc : 1.f;
                    const f32x4 v0 = b0 + acc[ai][bj][m][0] * sc, v1 = b1 + acc[ai][bj][m][1] * sc;
                    u32x4 w; w.x = pk2(v0[0], v0[1]); w.y = pk2(v0[2], v0[3]); w.z = pk2(v1[0], v1[1]); w.w = pk2(v1[2], v1[3]);
                    *(u32x4*)(H + off) = w;
                    if (W8) { q8[2 * bj] = pk4_i8(v0[0], v0[1], v0[2], v0[3], hq); q8[2 * bj + 1] = pk4_i8(v1[0], v1[1], v1[2], v1[3], hq); }
                    ss += ((v0[0] * v0[0] + v0[1] * v0[1]) + (v0[2] * v0[2] + v0[3] * v0[3])) + ((v1[0] * v1[0] + v1[1] * v1[1]) + (v1[2] * v1[2] + v1[3] * v1[3]));
                }
                if (W8) *(u32x4*)(H8 + row * 1024 + u.pn * 256 + wc * 64 + fq * 16) = q8;
                ss += __shfl_xor(ss, 16); ss += __shfl_xor(ss, 32);
                if (fq == 0) ssq[row * 16 + u.pn * 4 + wc] = ss;
            }
    }
};
namespace pg8 {
#define PG8_LAS __attribute__((address_space(3)))
constexpr int BM = 256, BK = 64, HALF = 128, HTB = HALF * BK * 2  , STAGE_BYTES = 8 * HTB, NXCD = 8, WGM = 8;
__host__ __device__ __forceinline__ int lds_byte(int r, int c) { const int st = (r >> 4) * 2 + (c >> 5), rr = r & 15, cc = c & 31, ob = rr * 64 + cc * 2; return st * 1024 + (ob ^ (((ob >> 9) & 1) << 5)); }
__host__ __device__ __forceinline__ void stage_rc(int b, int& R, int& C) { const int st = b / 1024, sb = b % 1024, swz = sb ^ (((sb >> 9) & 1) << 5); R = (st >> 1) * 16 + swz / 64; C = (st & 1) * 32 + (swz % 64) / 2; }
struct StaticOrder {
    int nM, nN, nwg, G, c;
    __host__ __device__ void init(int M, int N, int G_, int c_) { nM = M / BM; nN = N / BM; nwg = nM * nN; G = G_; c = c_; }
    __host__ __device__ bool next(int i, Unit& u) const {
        const long L = (long)i * G + c; if (L >= nwg) return false;
        int wgid = (int)L; { const int q = nwg / NXCD, r = nwg % NXCD, xcd = wgid % NXCD, off = wgid / NXCD; wgid = (xcd < r ? xcd * (q + 1) : r * (q + 1) + (xcd - r) * q) + off; }
        const int nig = WGM * nN, gid = wgid / nig, fm = gid * WGM, gsz = (nM - fm) < WGM ? (nM - fm) : WGM;
        u.pm = fm + ((wgid % nig) % gsz); u.pn = (wgid % nig) / gsz; u.idx = i; return true;
    }
    __device__ __forceinline__ void a_ready(const Unit&) const {}
    __device__ __forceinline__ void done(const Unit&) const {}
};
struct ComboOrder {
    StaticOrder so;
    __host__ __device__ void init(int G_, int c_) { so.init(T, 1024, G_, c_); }
    __host__ __device__ bool next(int i, Unit& u) const {
        const long L = (long)i * so.G + so.c;
        if (L < so.nwg) { so.next(i, u); u.pm += TILE_HN; u.pn = u.pn < 3 ? u.pn + 4 : 14; return true; }
        const int j = (int)(L - so.nwg); if (j >= 128) return false;
        const int l = j >> 6, jj = j & 63;
        if (jj < 32) { u.pm = TILE_MEMN + (jj >> 1); u.pn = TILE_WKV + 4 * l + (jj & 1); }
        else { const int q = jj - 32; u.pm = TILE_WKV + 4 * l + 2 + (q >> 4); u.pn = TILE_MEMN + (q & 15); }
        return true;
    }
    __device__ __forceinline__ void a_ready(const Unit&) const {}
    __device__ __forceinline__ void done(const Unit&) const {}
};
template <class Epi, class Sched, bool ALIGN_EPI = false, bool SP2 = false, int QM = 0  >
__device__ __forceinline__ void gemm_phase(PG8_LAS unsigned char* lds, const Gemm g, const Sched& S, const Epi& E) {
    const int tid = otid(), wid = __builtin_amdgcn_readfirstlane(tid >> 6), lane = tid & 63, wr = wid >> 2, wc = wid & 3, fr = lane & 15, fq = lane >> 4;
    constexpr bool FP8 = (QM == 1), I8 = (QM == 2);
    const int K = g.K, nt = K / BK;
    unsigned voffA[2], voffB[2];
#pragma unroll
    for (int i = 0; i < 2; ++i) { int R, C; stage_rc(tid * 16 + i * 8192, R, C); const int Rb = Epi::PERM ? ((R & ~31) + perm32(R & 31)) : R;
        voffA[i] = (unsigned)(R * K + C) * 2u; voffB[i] = (unsigned)(Rb * K + C) * 2u; }
    const size_t kstep = (size_t)(BK * 2);
    const size_t hstep = (size_t)HALF * K * 2;
    const size_t tstep = 2 * hstep;
    const unsigned ldsw = (unsigned)wid * 1024u;
    const int aoff = lds_byte(wr * 64 + fr, fq * 8), boff = lds_byte(wc * 32 + fr, fq * 8);
#define PG8_SA(b, h) (((b) * 2 + (h)) * HTB)
#define PG8_SB(b, h) ((4 + (b) * 2 + (h)) * HTB)
#define PG8_STAGE(bufoff, gbase, voff) do { _Pragma("unroll") for (int _i = 0; _i < 2; ++_i) \
        __builtin_amdgcn_global_load_lds((const unsigned*)((const char*)(gbase) + (voff)[_i]), (PG8_LAS unsigned*)(lds + (bufoff) + ldsw + _i * 8192), 16, 0, 0); } while (0)
#define PG8_LD16(off) (*(const PG8_LAS bf16x8*)(lds + (off)))
#define PG8_LDA(dst, b, h) do { _Pragma("unroll") for (int m = 0; m < 4; ++m) { \
        if constexpr (FP8) dst##8[m] = PG8_CAT(PG8_LD16(PG8_SA(b, h) + aoff + m * 2048), PG8_LD16(PG8_SA(b, h) + aoff + m * 2048 + 1024)); \
        else { _Pragma("unroll") for (int k = 0; k < 2; ++k) dst[m][k] = PG8_LD16(PG8_SA(b, h) + aoff + m * 2048 + k * 1024); } } } while (0)
#define PG8_LDB(dst, b, h) do { _Pragma("unroll") for (int n = 0; n < 2; ++n) { \
        if constexpr (FP8) dst##8[n] = PG8_CAT(PG8_LD16(PG8_SB(b, h) + boff + n * 2048), PG8_LD16(PG8_SB(b, h) + boff + n * 2048 + 1024)); \
        else { _Pragma("unroll") for (int k = 0; k < 2; ++k) dst[n][k] = PG8_LD16(PG8_SB(b, h) + boff + n * 2048 + k * 1024); } } } while (0)
#define PG8_CAT(x, y) __builtin_shufflevector(__builtin_bit_cast(i32x4v, x), __builtin_bit_cast(i32x4v, y), 0, 1, 2, 3, 4, 5, 6, 7)
#define PG8_MMA(ai, bj, At, Bt) do { __builtin_amdgcn_s_setprio(1); \
        if constexpr (FP8) { _Pragma("unroll") for (int m = 0; m < 4; ++m) _Pragma("unroll") for (int n = 0; n < 2; ++n) \
            asm("v_mfma_f32_16x16x128_f8f6f4 %0, %1, %2, %0" : "+v"(acc[ai][bj][m][n]) : "v"(Bt##8[n]), "v"(At##8[m])); } \
        else if constexpr (I8) { _Pragma("unroll") for (int m = 0; m < 4; ++m) _Pragma("unroll") for (int n = 0; n < 2; ++n) _Pragma("unroll") for (int k = 0; k < 2; ++k) \
            acc[ai][bj][m][n] = __builtin_bit_cast(f32x4, __builtin_amdgcn_mfma_i32_16x16x64_i8(__builtin_bit_cast(i32x4v, Bt[n][k]), __builtin_bit_cast(i32x4v, At[m][k]), __builtin_bit_cast(i32x4v, acc[ai][bj][m][n]), 0, 0, 0)); } \
        else { _Pragma("unroll") for (int m = 0; m < 4; ++m) _Pragma("unroll") for (int n = 0; n < 2; ++n) _Pragma("unroll") for (int k = 0; k < 2; ++k) \
            acc[ai][bj][m][n] = __builtin_amdgcn_mfma_f32_16x16x32_bf16(Bt[n][k], At[m][k], acc[ai][bj][m][n], 0, 0, 0); } \
        __builtin_amdgcn_s_setprio(0); } while (0)
#define PG8_WAIT_V(n) asm volatile("s_waitcnt vmcnt(" #n ")" ::: "memory")
#define PG8_WAIT_L(n) asm volatile("s_waitcnt lgkmcnt(" #n ")" ::: "memory")
#define PG8_BAR __builtin_amdgcn_s_barrier()
#define PG8_SCHED __builtin_amdgcn_sched_barrier(0)
    Unit cur, nxt; int ui = 0;
    if (!S.next(0, cur)) return;
    f32x4 acc[2][2][4][2];
#pragma unroll
    for (int a = 0; a < 2; ++a)
#pragma unroll
        for (int b = 0; b < 2; ++b)
#pragma unroll
            for (int m = 0; m < 4; ++m)
#pragma unroll
                for (int n = 0; n < 2; ++n) acc[a][b][m][n] = (f32x4){0.f, 0.f, 0.f, 0.f};
    bf16x8 At[4][2], B0[2][2], B1[2][2];
    i32x8v At8[4], B08[2], B18[2];
    const char* cA = (const char*)g.A + (size_t)cur.pm * tstep; const char* cB = (const char*)g.Bt + (size_t)cur.pn * tstep;
    S.a_ready(cur);
    if constexpr (SP2) {
        PG8_STAGE(PG8_SB(0, 0), cB, voffB); PG8_STAGE(PG8_SB(0, 1), cB + hstep, voffB); PG8_STAGE(PG8_SA(0, 0), cA, voffA); PG8_STAGE(PG8_SA(0, 1), cA + hstep, voffA);
        if (wr == 1) PG8_BAR;
        PG8_WAIT_V(2); PG8_BAR;
        PG8_STAGE(PG8_SB(1, 0), cB + kstep, voffB); PG8_STAGE(PG8_SA(1, 0), cA + kstep, voffA); PG8_STAGE(PG8_SB(1, 1), cB + hstep + kstep, voffB);
        PG8_WAIT_V(6); PG8_BAR;
    } else {
        PG8_STAGE(PG8_SB(0, 0), cB, voffB); PG8_STAGE(PG8_SA(0, 0), cA, voffA); PG8_STAGE(PG8_SB(0, 1), cB + hstep, voffB); PG8_STAGE(PG8_SA(0, 1), cA + hstep, voffA);
        if (wr == 1) PG8_BAR;
        PG8_WAIT_V(4); PG8_BAR;
        PG8_STAGE(PG8_SB(1, 0), cB + kstep, voffB); PG8_STAGE(PG8_SA(1, 0), cA + kstep, voffA); PG8_STAGE(PG8_SB(1, 1), cB + hstep + kstep, voffB);
        PG8_WAIT_V(6); PG8_BAR;
    }
    for (;;) {
        const bool has_next = S.next(ui + 1, nxt);
        const char* nA = has_next ? (const char*)g.A + (size_t)nxt.pm * tstep : cA; const char* nB = has_next ? (const char*)g.Bt + (size_t)nxt.pn * tstep : cB;
        for (int t = 0; t < nt; t += 2) {
            const bool last = (t == nt - 2);
            if constexpr (FP8) __builtin_amdgcn_s_waitcnt(0xC07F);
            const char* a1 = cA + (size_t)(t + 1) * kstep;
            const char* a2 = last ? nA : cA + (size_t)(t + 2) * kstep; const char* b2 = last ? nB : cB + (size_t)(t + 2) * kstep;
            const char* a3 = a2 + kstep; const char* b3 = b2 + kstep;
            if (last && has_next) S.a_ready(nxt);
            if constexpr (SP2) {
            PG8_LDB(B0, 0, 0); PG8_LDB(B1, 0, 1); PG8_SCHED; PG8_LDA(At, 0, 0); PG8_STAGE(PG8_SA(1, 1), a1 + hstep, voffA);
            PG8_WAIT_V(8); PG8_WAIT_L(0); PG8_BAR; PG8_MMA(0, 0, At, B0); PG8_MMA(0, 1, At, B1); PG8_BAR; PG8_SCHED;
            PG8_LDA(At, 0, 1); PG8_STAGE(PG8_SB(0, 0), b2, voffB); PG8_STAGE(PG8_SB(0, 1), b2 + hstep, voffB); PG8_STAGE(PG8_SA(0, 0), a2, voffA);
            PG8_WAIT_V(8); PG8_WAIT_L(0); PG8_BAR; PG8_MMA(1, 0, At, B0); PG8_MMA(1, 1, At, B1); PG8_BAR; PG8_SCHED;
            PG8_LDB(B0, 1, 0); PG8_LDB(B1, 1, 1); PG8_SCHED; PG8_LDA(At, 1, 0); PG8_STAGE(PG8_SA(0, 1), a2 + hstep, voffA);
            PG8_WAIT_V(8); PG8_WAIT_L(0); PG8_BAR; PG8_MMA(0, 0, At, B0); PG8_MMA(0, 1, At, B1); PG8_BAR; PG8_SCHED;
            PG8_LDA(At, 1, 1); PG8_STAGE(PG8_SB(1, 0), b3, voffB); PG8_STAGE(PG8_SB(1, 1), b3 + hstep, voffB); PG8_STAGE(PG8_SA(1, 0), a3, voffA);
            PG8_WAIT_V(8); PG8_WAIT_L(0); PG8_BAR; PG8_MMA(1, 0, At, B0); PG8_MMA(1, 1, At, B1); PG8_BAR; PG8_SCHED;
            } else {
            PG8_LDB(B0, 0, 0); PG8_SCHED; PG8_LDA(At, 0, 0); PG8_STAGE(PG8_SA(1, 1), a1 + hstep, voffA);
            PG8_WAIT_L(8); PG8_BAR; PG8_WAIT_L(0); PG8_MMA(0, 0, At, B0); PG8_BAR; PG8_SCHED;
            PG8_LDB(B1, 0, 1); PG8_STAGE(PG8_SB(0, 0), b2, voffB);
            PG8_BAR; PG8_WAIT_L(0); PG8_MMA(0, 1, At, B1); PG8_BAR;
            PG8_LDA(At, 0, 1); PG8_STAGE(PG8_SA(0, 0), a2, voffA);
            PG8_BAR; PG8_WAIT_L(0); PG8_MMA(1, 0, At, B0); PG8_BAR; PG8_SCHED;
            PG8_STAGE(PG8_SB(0, 1), b2 + hstep, voffB);
            PG8_WAIT_V(6); PG8_BAR; PG8_MMA(1, 1, At, B1); PG8_BAR;
            PG8_LDB(B0, 1, 0); PG8_SCHED; PG8_LDA(At, 1, 0); PG8_STAGE(PG8_SA(0, 1), a2 + hstep, voffA);
            PG8_WAIT_L(8); PG8_BAR; PG8_WAIT_L(0); PG8_MMA(0, 0, At, B0); PG8_BAR; PG8_SCHED;
            PG8_LDB(B1, 1, 1); PG8_STAGE(PG8_SB(1, 0), b3, voffB);
            PG8_BAR; PG8_WAIT_L(0); PG8_MMA(0, 1, At, B1); PG8_BAR;
            PG8_LDA(At, 1, 1); PG8_STAGE(PG8_SA(1, 0), a3, voffA);
            PG8_BAR; PG8_WAIT_L(0); PG8_MMA(1, 0, At, B0); PG8_BAR; PG8_SCHED;
            PG8_STAGE(PG8_SB(1, 1), b3 + hstep, voffB);
            PG8_WAIT_V(6); PG8_BAR; PG8_MMA(1, 1, At, B1); PG8_BAR;
            }
        }
        if constexpr (FP8) asm volatile("s_nop 15\n\ts_nop 15" ::: "memory");
        if constexpr (ALIGN_EPI) { if (wr == 0) PG8_BAR; }
        if constexpr (!Epi::AFTER_DRAIN) { E(acc, cur, wr, wc, fr, fq); S.done(cur); }
        if (!has_next) break;
#pragma unroll
        for (int a = 0; a < 2; ++a)
#pragma unroll
            for (int b = 0; b < 2; ++b)
#pragma unroll
                for (int m = 0; m < 4; ++m)
#pragma unroll
                    for (int n = 0; n < 2; ++n) acc[a][b][m][n] = (f32x4){0.f, 0.f, 0.f, 0.f};
        cur = nxt; cA = nA; cB = nB; ++ui;
        if constexpr (ALIGN_EPI) { if (wr == 1) PG8_BAR; }
    }
    PG8_WAIT_V(0);
    if constexpr (!ALIGN_EPI) { if (wr == 0) PG8_BAR; }
    PG8_BAR;
    if constexpr (Epi::AFTER_DRAIN) { E.fused(acc, cur, wr, wc, fr, fq, lds, wid, lane); S.done(cur); }
#undef PG8_SA
#undef PG8_SB
#undef PG8_STAGE
#undef PG8_LDA
#undef PG8_LD16
#undef PG8_LDB
#undef PG8_MMA
#undef PG8_CAT
#undef PG8_WAIT_V
#undef PG8_WAIT_L
#undef PG8_BAR
#undef PG8_SCHED
}
}

template <class Epi, int QM = 0>
__device__ __forceinline__ void run_gemm(const Gemm g, Epi E, LAS float* lds, int vb, int nvb) {
    pg8::StaticOrder S; S.init(g.M, g.N, nvb, vb);
    if constexpr (Epi::USES_TAB) { LAS float* tab = (LAS float*)((LAS unsigned char*)lds + RSTD_TAB_OFF); build_rstd_table(S, E.ssq, tab); E.tab = tab; }
    pg8::gemm_phase<Epi, pg8::StaticOrder, true, true, QM>((LAS unsigned char*)lds, g, S, E);
}

enum { MAP_ID = 0, MAP_WIN = 1, MAP_GU = 2, MAP_WIN8 = 3   };
struct PrepJob { const float* W; int K, N; const float* gain; bf16_t* dst; int r0, r1, ldd, koff, map; int fmt; float osc; };
__device__ __forceinline__ int map_src(int map, int r, int N) {
    if (map == MAP_ID) return r < N ? r : -1;
    if (map == MAP_WIN) {
        if (r < 1728) return r - 512;
        if (r < 3776) return r - 504;
        if (r < 3784) return r - 2560;
        return -1;
    }
    if (map == MAP_WIN8) return r + 264;
    { const int tile = r >> 8, w = r & 255, j = tile * 128 + (w & 127); return w < 128 ? j : FF + j; }
}
__device__ __forceinline__ void prep_tile_load(const PrepJob& j, int t, f32x4 (&v)[8]) {
    const int nkt = j.K / 64, kt = t % nkt, rt = t / nkt, k0 = kt * 64, r0 = j.r0 + rt * 256;
#pragma unroll
    for (int q = 0; q < 8; ++q) {
        const int i = (int)threadIdx.x + q * NTHREADS, kk = i >> 6, r4 = (i & 63) * 4;
        const int sc = map_src(j.map, r0 + r4, j.N);
        v[q] = sc >= 0 ? __builtin_nontemporal_load((const f32x4*)(j.W + (size_t)(k0 + kk) * j.N + sc)) : (f32x4){0.f, 0.f, 0.f, 0.f};
        if (j.gain) v[q] = v[q] * j.gain[k0 + kk];
    }
}
__device__ __forceinline__ void prep_tile_store(const PrepJob& j, int t, const f32x4 (&v)[8], LAS float* tile  ) {
    const int nkt = j.K / 64, kt = t % nkt, rt = t / nkt, k0 = kt * 64, r0 = j.r0 + rt * 256;
    __syncthreads();
#pragma unroll
    for (int q = 0; q < 8; ++q) { const int i = (int)threadIdx.x + q * NTHREADS, kk = i >> 6, r4 = (i & 63) * 4; *(LAS f32x4*)(tile + kk * 260 + r4) = v[q]; }
    __syncthreads();
#pragma unroll
    for (int q = 0; q < 4; ++q) {
        const int i = (int)threadIdx.x + q * NTHREADS, rr = i & 255, c8 = i >> 8;
        const LAS float* tp = tile + (c8 * 8) * 260 + rr;
        if (j.fmt != 0) {
            const float sc = j.osc; u32x2 w;
            if (j.fmt == 1 || j.fmt == 3) { w.x = pk4_f8(tp[0] * sc, tp[260] * sc, tp[520] * sc, tp[780] * sc); w.y = pk4_f8(tp[1040] * sc, tp[1300] * sc, tp[1560] * sc, tp[1820] * sc); }
            else { w.x = pk4_i8(tp[0], tp[260], tp[520], tp[780], sc); w.y = pk4_i8(tp[1040], tp[1300], tp[1560], tp[1820], sc); }
            unsigned char* drow = (unsigned char*)j.dst + (size_t)(r0 + rr) * j.ldd + j.koff; const int kk = k0 + c8 * 8;
            if (j.fmt == 3) { const int r = kk & 127, pp = (kk & ~127) + (r >> 5) * 16 + ((r >> 3) & 3) * 4; *(unsigned*)(drow + pp) = w.x; *(unsigned*)(drow + pp + 64) = w.y; }
            else *(u32x2*)(drow + (j.fmt == 2 ? kperm8(kk) : kk)) = w;
        } else {
        u32x4 w; w.x = pk2(tp[0], tp[260]); w.y = pk2(tp[520], tp[780]); w.z = pk2(tp[1040], tp[1300]); w.w = pk2(tp[1560], tp[1820]);
        *(u32x4*)(j.dst + (size_t)(r0 + rr) * j.ldd + j.koff + k0 + c8 * 8) = w;
        }
    }
}
__device__ __forceinline__ void prep_fold_in(const float* w_in  , const float* w_uk  , const float* gain, bf16_t* dst, LAS float* lds, int vb, int nvb) {
    LAS float* A = lds; LAS float* B = lds + 32 * 65;
    const int tid = otid(), lane = tid & 63, wid = __builtin_amdgcn_readfirstlane(tid >> 6), l15 = lane & 15, dq = lane >> 4;
    for (int item = vb; item < 256; item += nvb) {
        const int h = item >> 5, k0 = (item & 31) * 32;
        __syncthreads();
        for (int i = tid; i < 2048; i += NTHREADS) { const int kk = i >> 6, d = i & 63; A[kk * 65 + d] = w_in[(size_t)(k0 + kk) * 3272 + h * 64 + d] * gain[k0 + kk]; }
        for (int i = tid; i < 8192; i += NTHREADS) { const int c = i >> 6, d = i & 63; B[c * 65 + d] = w_uk[(size_t)(h * 128 + c) * 64 + d]; }
        __syncthreads();
        f32x4 acc0 = (f32x4){0.f, 0.f, 0.f, 0.f}, acc1 = acc0;
#pragma unroll 4
        for (int d0 = 0; d0 < 64; d0 += 4) {
            const float b = B[(16 * wid + l15) * 65 + d0 + dq], a0 = A[l15 * 65 + d0 + dq], a1 = A[(16 + l15) * 65 + d0 + dq];
            acc0 = __builtin_amdgcn_mfma_f32_16x16x4f32(a0, b, acc0, 0, 0, 0);
            acc1 = __builtin_amdgcn_mfma_f32_16x16x4f32(a1, b, acc1, 0, 0, 0);
        }
        unsigned char* drow = (unsigned char*)dst + (size_t)(h * 128 + 16 * wid + l15) * 1024 + k0 + 4 * dq;
        *(unsigned*)drow = pk4_i8(acc0[0], acc0[1], acc0[2], acc0[3], WQ_GU);
        *(unsigned*)(drow + 16) = pk4_i8(acc1[0], acc1[1], acc1[2], acc1[3], WQ_GU);
    }
}
__device__ __forceinline__ void prep_fold_out(const float* w_out  , const float* w_uv  , bf16_t* dst  , LAS float* lds, int vb, int nvb) {
    LAS float* A = lds; LAS float* B = lds + 64 * 33;
    const int tid = otid(), lane = tid & 63, wid = __builtin_amdgcn_readfirstlane(tid >> 6), l15 = lane & 15, dq = lane >> 4;
    for (int item = vb; item < 256; item += nvb) {
        const int h = item >> 5, n0 = (item & 31) * 32;
        __syncthreads();
        for (int i = tid; i < 2048; i += NTHREADS) { const int d = i >> 5, nn = i & 31; A[d * 33 + nn] = w_out[(size_t)(h * 64 + d) * 1024 + n0 + nn]; }
        for (int i = tid; i < 8192; i += NTHREADS) { const int c = i >> 6, d = i & 63; B[c * 65 + d] = w_uv[(size_t)(h * 128 + c) * 64 + d]; }
        __syncthreads();
        f32x4 acc0 = (f32x4){0.f, 0.f, 0.f, 0.f}, acc1 = acc0;
#pragma unroll 4
        for (int d0 = 0; d0 < 64; d0 += 4) {
            const float a = B[(16 * wid + l15) * 65 + d0 + dq], b0 = A[(d0 + dq) * 33 + l15], b1 = A[(d0 + dq) * 33 + 16 + l15];
            acc0 = __builtin_amdgcn_mfma_f32_16x16x4f32(a, b0, acc0, 0, 0, 0);
            acc1 = __builtin_amdgcn_mfma_f32_16x16x4f32(a, b1, acc1, 0, 0, 0);
        }
        { u32x2 w; w.x = pk2(acc0[0], acc0[1]); w.y = pk2(acc0[2], acc0[3]); *(u32x2*)(dst + (size_t)(n0 + l15) * KOUT + h * 128 + 16 * wid + 4 * dq) = w; }
        { u32x2 w; w.x = pk2(acc1[0], acc1[1]); w.y = pk2(acc1[2], acc1[3]); *(u32x2*)(dst + (size_t)(n0 + 16 + l15) * KOUT + h * 128 + 16 * wid + 4 * dq) = w; }
    }
}
__device__ __forceinline__ void prep_lb(const float* hgrn_lb  , float* lb, int vb, int nvb) {
    for (int i = vb * NTHREADS + threadIdx.x; i < 512; i += nvb * NTHREADS) {
        const float a = hgrn_lb[i], b = hgrn_lb[512 + i], c = hgrn_lb[1024 + i], m = fmaxf(a, fmaxf(b, c));
        const float ea = __expf(a - m), eb = __expf(b - m), ec = __expf(c - m);
        lb[i] = ea / (ea + eb + ec);
    }
}

__device__ __forceinline__ void rmsnorm_rows(const float* X, bf16_t* Y, int nrows, int vb, int nvb) {
    const int tid = otid(), lane = tid & 63, gw = vb * NWAVES + __builtin_amdgcn_readfirstlane(tid >> 6), ngw = nvb * NWAVES;
    for (int r = gw; r < nrows; r += ngw) {
        const f32x4* xr = (const f32x4*)(X + (size_t)r * D) + lane;
        f32x4 v[4]; float s = 0.f;
#pragma unroll
        for (int j = 0; j < 4; ++j) { v[j] = xr[64 * j]; s += (v[j].x * v[j].x + v[j].y * v[j].y) + (v[j].z * v[j].z + v[j].w * v[j].w); }
        const float rs = rsqrtf(wave_sum(s) * (1.f / D) + EPS);
        u32x2* o = (u32x2*)(Y + (size_t)r * D) + lane;
#pragma unroll
        for (int j = 0; j < 4; ++j) { u32x2 w; w.x = pk2(v[j].x * rs, v[j].y * rs); w.y = pk2(v[j].z * rs, v[j].w * rs); o[64 * j] = w; }
    }
}
__device__ __forceinline__ void x_to_h_rows(const float* X, bf16_t* H, unsigned char* X8, float* ssq, int vb, int nvb) {
    const int tid = otid(), lane = tid & 63, gw = vb * NWAVES + __builtin_amdgcn_readfirstlane(tid >> 6), ngw = nvb * NWAVES;
    for (int r = gw; r < T; r += 2 * ngw) {
        const int r2 = (r + ngw < T) ? r + ngw : r;
        f32x4 v[2][4];
#pragma unroll
        for (int j = 0; j < 4; ++j) { v[0][j] = __builtin_nontemporal_load((const f32x4*)(X + (size_t)r * D) + lane + 64 * j); v[1][j] = __builtin_nontemporal_load((const f32x4*)(X + (size_t)r2 * D) + lane + 64 * j); }
#pragma unroll
        for (int q = 0; q < 2; ++q) {
            const int rr = q ? r2 : r;
            u32x2* o = (u32x2*)(H + (size_t)rr * D) + lane;
            float s = 0.f;
#pragma unroll
            for (int j = 0; j < 4; ++j) { const f32x4 x = v[q][j]; u32x2 w; w.x = pk2(x.x, x.y); w.y = pk2(x.z, x.w); o[64 * j] = w;
                *((unsigned*)(X8 + (size_t)rr * D) + lane + 64 * j) = pk4_i8(x.x, x.y, x.z, x.w, HQ_X);
                const float a = bf2f((unsigned short)(w.x & 0xffffu)), b = bf2f((unsigned short)(w.x >> 16)), c = bf2f((unsigned short)(w.y & 0xffffu)), d = bf2f((unsigned short)(w.y >> 16));
                s += (a * a + b * b) + (c * c + d * d); }
            s = wave_sum(s);
            if (lane < 16) ssq[(size_t)rr * 16 + lane] = lane == 0 ? s : 0.f;
        }
    }
}
__device__ __forceinline__ void final_rows(const bf16_t* H, const float* ssq, const float* g, float* out, int vb, int nvb) {
    const int tid = otid(), lane = tid & 63, gw = vb * NWAVES + __builtin_amdgcn_readfirstlane(tid >> 6), ngw = nvb * NWAVES;
    f32x4 gg[4];
#pragma unroll
    for (int j = 0; j < 4; ++j) gg[j] = *((const f32x4*)g + lane + 64 * j);
    for (int r = gw; r < T; r += 2 * ngw) {
        const int r2 = (r + ngw < T) ? r + ngw : r;
        u32x2 w[2][4]; float rs[2];
#pragma unroll
        for (int j = 0; j < 4; ++j) { w[0][j] = ((const u32x2*)(H + (size_t)r * D) + lane)[64 * j]; w[1][j] = ((const u32x2*)(H + (size_t)r2 * D) + lane)[64 * j]; }
        rs[0] = row_rstd(ssq, (size_t)r); rs[1] = row_rstd(ssq, (size_t)r2);
#pragma unroll
        for (int q = 0; q < 2; ++q) {
            f32x4* o = (f32x4*)(out + (size_t)(q ? r2 : r) * D) + lane;
#pragma unroll
            for (int j = 0; j < 4; ++j) { const u32x2 ww = w[q][j];
                __builtin_nontemporal_store((f32x4){bf2f((unsigned short)(ww.x & 0xffffu)) * rs[q] * gg[j].x, bf2f((unsigned short)(ww.x >> 16)) * rs[q] * gg[j].y, bf2f((unsigned short)(ww.y & 0xffffu)) * rs[q] * gg[j].z, bf2f((unsigned short)(ww.y >> 16)) * rs[q] * gg[j].w}, o + 64 * j); }
        }
    }
}
__device__ __forceinline__ float row16_sum(float v) {
    v += __uint_as_float((unsigned)__builtin_amdgcn_update_dpp(0, (int)__float_as_uint(v), 0x128, 0xf, 0xf, false));
    v += __uint_as_float((unsigned)__builtin_amdgcn_update_dpp(0, (int)__float_as_uint(v), 0x124, 0xf, 0xf, false));
    v += __uint_as_float((unsigned)__builtin_amdgcn_update_dpp(0, (int)__float_as_uint(v), 0x122, 0xf, 0xf, false));
    v += __uint_as_float((unsigned)__builtin_amdgcn_update_dpp(0, (int)__float_as_uint(v), 0x121, 0xf, 0xf, false));
    return v;
}
__device__ __forceinline__ void cnorm_rows(const bf16_t* P, const float* lat_g, bf16_t* CN, int vb, int nvb) {
    const int tid = otid(), lane = tid & 63, gw = vb * NWAVES + __builtin_amdgcn_readfirstlane(tid >> 6), ngw = nvb * NWAVES, r4 = lane >> 4, l16 = lane & 15;
    const f32x4 ga = *(const f32x4*)(lat_g + l16 * 8), gb = *(const f32x4*)(lat_g + l16 * 8 + 4);
    for (int r = gw * 8; r < T; r += ngw * 8) {
        u32x4 w[2];
#pragma unroll
        for (int q = 0; q < 2; ++q) w[q] = *(const u32x4*)(P + (size_t)(r + 4 * q + r4) * PW + P_C + l16 * 8);
#pragma unroll
        for (int q = 0; q < 2; ++q) {
            const float x0 = bf2f((unsigned short)(w[q].x & 0xffffu)), x1 = bf2f((unsigned short)(w[q].x >> 16)), x2 = bf2f((unsigned short)(w[q].y & 0xffffu)), x3 = bf2f((unsigned short)(w[q].y >> 16));
            const float x4 = bf2f((unsigned short)(w[q].z & 0xffffu)), x5 = bf2f((unsigned short)(w[q].z >> 16)), x6 = bf2f((unsigned short)(w[q].w & 0xffffu)), x7 = bf2f((unsigned short)(w[q].w >> 16));
            const float ss = row16_sum(((x0 * x0 + x1 * x1) + (x2 * x2 + x3 * x3)) + ((x4 * x4 + x5 * x5) + (x6 * x6 + x7 * x7)));
            const float rs = rsqrtf(ss * (1.f / 128.f) + EPS);
            u32x4 o; o.x = pk2(x0 * rs * ga.x, x1 * rs * ga.y); o.y = pk2(x2 * rs * ga.z, x3 * rs * ga.w); o.z = pk2(x4 * rs * gb.x, x5 * rs * gb.y); o.w = pk2(x6 * rs * gb.z, x7 * rs * gb.w);
            *(u32x4*)(CN + (size_t)(r + 4 * q + r4) * 128 + l16 * 8) = o;
        }
    }
}
__device__ __forceinline__ int t5_bucket(int rel) {
    const int n = rel < 0 ? -rel : rel;
    int b = n < 8 ? n : 8 + (n >= 12) + (n >= 16) + (n >= 23) + (n >= 32) + (n >= 46) + (n >= 64) + (n >= 91);
    return b + (rel > 0 ? 16 : 0);
}
__device__ __forceinline__ unsigned sort_key(float x) { const unsigned u = __float_as_uint(x); return (u & 0x80000000u) ? ~u : (u | 0x80000000u); }


template <int CTRL, int ROWMASK> __device__ __forceinline__ unsigned dpp0(unsigned v) { return (unsigned)__builtin_amdgcn_update_dpp(0, (int)v, CTRL, ROWMASK, 0xf, false); }
__device__ __forceinline__ unsigned wave_prefix_incl(unsigned v) {
    v += dpp0<0x111, 0xf>(v); v += dpp0<0x112, 0xf>(v); v += dpp0<0x114, 0xf>(v); v += dpp0<0x118, 0xf>(v);
    v += dpp0<0x142, 0xa>(v);
    v += dpp0<0x143, 0xc>(v);
    return v;
}
__device__ __forceinline__ float wave_max_u(float v) {
    v = fmaxf(v, __uint_as_float((unsigned)__builtin_amdgcn_update_dpp(0, (int)__float_as_uint(v), 0x128, 0xf, 0xf, false)));
    v = fmaxf(v, __uint_as_float((unsigned)__builtin_amdgcn_update_dpp(0, (int)__float_as_uint(v), 0x124, 0xf, 0xf, false)));
    v = fmaxf(v, __uint_as_float((unsigned)__builtin_amdgcn_update_dpp(0, (int)__float_as_uint(v), 0x122, 0xf, 0xf, false)));
    v = fmaxf(v, __uint_as_float((unsigned)__builtin_amdgcn_update_dpp(0, (int)__float_as_uint(v), 0x121, 0xf, 0xf, false)));
    const int b = (int)__float_as_uint(v);
    return fmaxf(fmaxf(__uint_as_float((unsigned)__builtin_amdgcn_readlane(b, 0)), __uint_as_float((unsigned)__builtin_amdgcn_readlane(b, 16))),
                 fmaxf(__uint_as_float((unsigned)__builtin_amdgcn_readlane(b, 32)), __uint_as_float((unsigned)__builtin_amdgcn_readlane(b, 48))));
}

typedef short v4i16_t __attribute__((ext_vector_type(4)));
constexpr int DSA_BT_OFF = 131072 + 256, DSA_WS_OFF = DSA_BT_OFF + 6144;
__device__ __forceinline__ unsigned dsa_bucket(float x, float lo, float sc) { const float f = (x - lo) * sc; const unsigned b = (unsigned)f; return b > 255u ? 255u : b; }
__device__ __forceinline__ unsigned off_b(unsigned row, unsigned ch) { return 256u * row + 16u * (ch ^ (((row & 3) << 2) | ((row >> 2) & 3))); }
__device__ __forceinline__ void dsa_mfma_phase(const bf16_t* P, const bf16_t* CN, const float* rel_bias, bf16_t* CAT, LAS unsigned char* lds, unsigned* qctr) {
    const int tid = otid(), lane = tid & 63, wid = __builtin_amdgcn_readfirstlane(tid >> 6);
    LAS float* BT = (LAS float*)(lds + DSA_BT_OFF);
    __syncthreads();
    for (int i = tid; i < 191 * 8; i += NTHREADS) { const int rel = (i >> 3) - 127; BT[i] = rel_bias[t5_bucket(rel) * 8 + (i & 7)]; }
    const unsigned long long lt_mask = (lane == 0) ? 0ull : (~0ull >> (64 - lane));
    volatile LAS int* qslot = (volatile LAS int*)(lds + 131072 + 64);
    int nxt = 0;
    if (tid == 0) { *qslot = (int)atomicAdd(qctr, 1u); nxt = (int)atomicAdd(qctr, 1u); }
    for (;;) {
        __syncthreads();
        const int u = *qslot;
        if (u >= T / 16) break;
        const int b = u & 15, qg = 127 - (u >> 4), t0 = qg * 16, nj = t0 / CHUNK + 1, L = nj * CHUNK, nt = L / 32;
        const bf16_t* Pb = P + (size_t)b * SEQ * PW;
        {
            int ln1 = lane; asm volatile("" : "+v"(ln1));
            const int rho = ln1 & 31, hf = ln1 >> 5;
            const int qq = 2 * ((rho >> 2) & 1) + (rho >> 4), hh = 4 * ((rho >> 3) & 1) + (rho & 3);
            bf16x8 qa[4][4], wa[4], wc[4];
#pragma unroll
            for (int qd = 0; qd < 4; ++qd) {
                const bf16_t* qrow = Pb + (size_t)(t0 + 4 * qd + qq) * PW + P_QI + hh * 64 + 8 * hf;
#pragma unroll
                for (int ks = 0; ks < 4; ++ks) qa[qd][ks] = *(const bf16x8*)(qrow + ks * 16);
                wa[qd] = *(const bf16x8*)(Pb + (size_t)(t0 + 4 * qd + 2 * hf) * PW + P_WI); wc[qd] = *(const bf16x8*)(Pb + (size_t)(t0 + 4 * qd + 2 * hf + 1) * PW + P_WI);
            }
            LAS float* sc0 = (LAS float*)lds + (2 * hf) * 2048 + rho;
            const bf16_t* kbase = Pb + (size_t)rho * PW + P_KI + 8 * hf;
            bf16x8 kb[4], kn[4];
#pragma unroll
            for (int ks = 0; ks < 4; ++ks) { kb[ks] = (bf16x8){0, 0, 0, 0, 0, 0, 0, 0}; kn[ks] = kb[ks]; }
            if (wid < nt) {
#pragma unroll
                for (int ks = 0; ks < 4; ++ks) kb[ks] = *(const bf16x8*)(kbase + (size_t)wid * 32 * PW + ks * 16);
            }
            for (int kt = wid; kt < nt; kt += 8) {
                if (kt + 8 < nt) {
#pragma unroll
                    for (int ks = 0; ks < 4; ++ks) kn[ks] = *(const bf16x8*)(kbase + (size_t)(kt + 8) * 32 * PW + ks * 16);
                }
#pragma unroll
                for (int qd = 0; qd < 4; ++qd) {
                    f32x16 acc;
#pragma unroll
                    for (int r = 0; r < 16; ++r) acc[r] = 0.f;
#pragma unroll
                    for (int ks = 0; ks < 4; ++ks) acc = __builtin_amdgcn_mfma_f32_32x32x16_bf16(qa[qd][ks], kb[ks], acc, 0, 0, 0);
                    float s0 = 0.f, s1 = 0.f;
#pragma unroll
                    for (int e = 0; e < 8; ++e) { s0 += bf2f((unsigned short)wa[qd][e]) * fmaxf(acc[e], 0.f); s1 += bf2f((unsigned short)wc[qd][e]) * fmaxf(acc[8 + e], 0.f); }
                    sc0[(4 * qd) * 2048 + kt * 32] = s0 * (0.35355339059327373f * 0.125f); sc0[(4 * qd + 1) * 2048 + kt * 32] = s1 * (0.35355339059327373f * 0.125f);
                }
#pragma unroll
                for (int ks = 0; ks < 4; ++ks) kb[ks] = kn[ks];
            }
        }
        __syncthreads();
        if (tid == 0) { *qslot = nxt; nxt = (int)atomicAdd(qctr, 1u); }
        LAS unsigned char* pair = lds + wid * 16384;
        LAS unsigned char* wsc = lds + DSA_WS_OFF + wid * 2560;
        LAS unsigned* HIST = (LAS unsigned*)wsc; LAS float* CANDV = (LAS float*)(wsc + 1024); LAS unsigned* CANDI = (LAS unsigned*)(wsc + 1280);
        const int nsel = L < 256 ? L : 256;
        int lna = lane; asm volatile("" : "+v"(lna));
#pragma unroll 1
        for (int e2 = 0; e2 < 2; ++e2) {
            LAS unsigned short* IDX = (LAS unsigned short*)(wsc + 1536 + e2 * 512);
            if (nj > 4) {
                const LAS float* SCq = (const LAS float*)(pair + e2 * 8192);
                float x[32];
#pragma unroll
                for (int j = 0; j < 32; ++j) x[j] = (j < nj) ? SCq[j * 64 + lna] : 0.f;
                float lo = INFINITY, hi = -INFINITY;
#pragma unroll
                for (int j = 0; j < 32; ++j) if (j < nj) { hi = fmaxf(hi, x[j]); lo = fminf(lo, x[j]); }
                hi = wave_max_u(hi); lo = -wave_max_u(-lo);
                bool done = false;
                if (hi > lo) {
                    const float sc = 256.f / (hi - lo);
                    *(LAS u32x4*)(HIST + 4 * lna) = (u32x4){0u, 0u, 0u, 0u};
                    WAVE_LDS_SYNC();
#pragma unroll
                    for (int j = 0; j < 32; ++j) if (j < nj) { const unsigned bk = dsa_bucket(x[j], lo, sc); __hip_atomic_fetch_add(HIST + bk, 1u, __ATOMIC_RELAXED, __HIP_MEMORY_SCOPE_WORKGROUP); }
                    WAVE_LDS_SYNC();
                    const u32x4 h4 = *(const LAS u32x4*)(HIST + 4 * lna);
                    const unsigned cl = (h4.x + h4.y) + (h4.z + h4.w);
                    const unsigned pfx = wave_prefix_incl(cl);
                    const unsigned Sx = (unsigned)__builtin_amdgcn_readlane((int)pfx, 63) - pfx + cl;
                    const int lstar = __popcll(__ballot(Sx >= 256u)) - 1;
                    const unsigned above = Sx - cl, t3 = above + h4.w, t2 = t3 + h4.z, t1 = t2 + h4.y;
                    const unsigned bl = t3 >= 256u ? 3u : (t2 >= 256u ? 2u : (t1 >= 256u ? 1u : 0u));
                    const unsigned al = bl == 3u ? above : (bl == 2u ? t3 : (bl == 1u ? t2 : t1));
                    const unsigned ml = bl == 3u ? h4.w : (bl == 2u ? h4.z : (bl == 1u ? h4.y : h4.x));
                    const unsigned bstar = (unsigned)__builtin_amdgcn_readlane((int)(4u * lna + bl), lstar);
                    const int a = __builtin_amdgcn_readlane((int)al, lstar), m = __builtin_amdgcn_readlane((int)ml, lstar);
                    if (m <= 64) {
                        done = true;
                        const int need = 256 - a;
                        unsigned msel = 0u, mcand = 0u;
#pragma unroll
                        for (int j = 31; j >= 0; --j) if (j < nj) { const unsigned bk = dsa_bucket(x[j], lo, sc); msel = msel + msel + (bk > bstar ? 1u : 0u); mcand = mcand + mcand + (bk == bstar ? 1u : 0u); }
                        const unsigned pk = (unsigned)__popc(msel) | ((unsigned)__popc(mcand) << 16);
                        const unsigned inc = wave_prefix_incl(pk);
                        unsigned off = (inc - pk) & 0xffffu, coff = (inc - pk) >> 16;
                        while (msel) { const int j = __ffs((int)msel) - 1; msel &= msel - 1u; IDX[off++] = (unsigned short)(j * 64 + lna); }
                        while (mcand) { const int j = __ffs((int)mcand) - 1; mcand &= mcand - 1u; CANDV[coff] = SCq[j * 64 + lna]; CANDI[coff] = (unsigned)(j * 64 + lna); ++coff; }
                        WAVE_LDS_SYNC();
                        const float cv = CANDV[lna < m ? lna : 0]; const unsigned ci = CANDI[lna < m ? lna : 0];
                        int rank = 0;
                        for (int k = 0; k < m; ++k) { const float v = __uint_as_float((unsigned)__builtin_amdgcn_readlane((int)__float_as_uint(cv), k)); const unsigned id = (unsigned)__builtin_amdgcn_readlane((int)ci, k); rank += (v > cv || (v == cv && id < ci)) ? 1 : 0; }
                        if (lna < m && rank < need) IDX[a + rank] = (unsigned short)ci;
                    }
                }
                if (!done) {
                    unsigned lo_k = 0xffffffffu, hi_k = 0u;
#pragma unroll
                    for (int j = 0; j < 32; ++j) if (j < nj) { const unsigned kx = sort_key(x[j]); hi_k = kx > hi_k ? kx : hi_k; lo_k = kx < lo_k ? kx : lo_k; }
#pragma unroll
                    for (int o = 1; o < 64; o <<= 1) { const unsigned h2 = (unsigned)__shfl_xor((int)hi_k, o), l2 = (unsigned)__shfl_xor((int)lo_k, o); hi_k = h2 > hi_k ? h2 : hi_k; lo_k = l2 < lo_k ? l2 : lo_k; }
                    lo_k = (unsigned)__builtin_amdgcn_readfirstlane((int)lo_k); hi_k = (unsigned)__builtin_amdgcn_readfirstlane((int)hi_k);
                    bool exact = false;
                    while (lo_k < hi_k) {
                        const unsigned mid = lo_k + ((hi_k - lo_k + 1u) >> 1);
                        int cnt = 0;
#pragma unroll
                        for (int j = 0; j < 32; ++j) cnt += __popcll(__ballot(j < nj && sort_key(x[j]) >= mid));
                        if (cnt == 256) { lo_k = mid; exact = true; break; }
                        if (cnt > 256) lo_k = mid; else hi_k = mid - 1u;
                    }
                    const unsigned Tv = lo_k;
                    int need = 0;
                    if (!exact) { int cgt = 0;
#pragma unroll
                        for (int j = 0; j < 32; ++j) cgt += __popcll(__ballot(j < nj && sort_key(x[j]) > Tv));
                        need = 256 - cgt; }
                    int base = 0, eqt = 0;
#pragma unroll
                    for (int j = 0; j < 32; ++j) {
                        const unsigned kx = sort_key(x[j]);
                        const bool gt = (j < nj) && (exact ? (kx >= Tv) : (kx > Tv)), eq = (j < nj) && !exact && (kx == Tv);
                        const unsigned long long meq = __ballot(eq);
                        const bool sel = gt || (eq && (eqt + __popcll(meq & lt_mask)) < need);
                        const unsigned long long ms = __ballot(sel);
                        if (sel) IDX[base + __popcll(ms & lt_mask)] = (unsigned short)(j * 64 + lna);
                        base += __popcll(ms); eqt += __popcll(meq);
                    }
                }
            } else {
#pragma unroll
                for (int i = 0; i < 4; ++i) IDX[i * 64 + lna] = (unsigned short)(i * 64 + lna);
            }
        }
        WAVE_LDS_SYNC();
        {
            int lnb = lane; asm volatile("" : "+v"(lnb));
            const int head = lnb & 15, kg = lnb >> 4, nblk = nsel >> 5;
            LAS unsigned char* GB = pair;
            const bf16_t* CNb = CN + (size_t)b * SEQ * 128;
            const int rho = lnb & 15;
            const unsigned rw0 = 8 * (rho >> 2) + (rho & 3), rw1 = rw0 + 4;
            const unsigned xa0 = ((rw0 & 3) << 2) | ((rw0 >> 2) & 3), xa1 = ((rw1 & 3) << 2) | ((rw1 >> 2) & 3);
            const unsigned q4 = (lnb & 15) >> 2, p4 = lnb & 3;
            u32x4 gA[8], gB[8];
#define DSA_GATHER(G, IX, blk) do { _Pragma("unroll") for (int it = 0; it < 8; ++it) { const int sp = (IX)[(blk) * 32 + (lnb >> 4) + 4 * it]; G[it] = *(const u32x4*)(CNb + (size_t)sp * 128 + (lnb & 15) * 8); } } while (0)
            { const LAS unsigned short* IDX0 = (const LAS unsigned short*)(wsc + 1536); DSA_GATHER(gA, IDX0, 0); DSA_GATHER(gB, IDX0, 1); }
#pragma unroll 1
            for (int e2 = 0; e2 < 2; ++e2) {
                const int t = t0 + 2 * wid + e2;
                const size_t row = (size_t)b * SEQ + t;
                const LAS unsigned short* IDX = (const LAS unsigned short*)(wsc + 1536 + e2 * 512);
                bf16x8 qlf[4];
#pragma unroll
                for (int s4 = 0; s4 < 4; ++s4) { qlf[s4] = *(const bf16x8*)(P + row * PW + P_QL + (head & 7) * 128 + s4 * 32 + 8 * kg); if (head >= 8) qlf[s4] = (bf16x8){0, 0, 0, 0, 0, 0, 0, 0}; }
                f32x4 o[8];
#pragma unroll
                for (int ct = 0; ct < 8; ++ct) o[ct] = (f32x4){0.f, 0.f, 0.f, 0.f};
                float m = -INFINITY, lsum = 0.f;
#define DSA_STEP(G, kbx) do { \
                    WAVE_LDS_SYNC();                              \
                    _Pragma("unroll") for (int it = 0; it < 8; ++it) *(LAS u32x4*)(GB + off_b((lnb >> 4) + 4 * it, lnb & 15)) = G[it]; \
                    const bf16x8 iv = *(const LAS bf16x8*)((const LAS unsigned char*)IDX + ((kbx) * 32 + 8 * kg) * 2);     \
                    if ((kbx) + 2 < nblk) DSA_GATHER(G, IDX, (kbx) + 2); else if (e2 == 0) DSA_GATHER(G, IDX + 256, (kbx) + 2 - nblk); \
                    WAVE_LDS_SYNC(); \
                      \
                    bf16x8 k0[4], k1[4], af[8]; \
                    _Pragma("unroll") for (int s4 = 0; s4 < 4; ++s4) { \
                        k0[s4] = *(const LAS bf16x8*)(GB + 256u * rw0 + 16u * ((4 * s4 + kg) ^ xa0)); \
                        k1[s4] = *(const LAS bf16x8*)(GB + 256u * rw1 + 16u * ((4 * s4 + kg) ^ xa1)); } \
                    float bia[8]; \
                    _Pragma("unroll") for (int e = 0; e < 8; ++e) { const int sp = (int)(unsigned short)iv[e]; int rel = sp - t; rel = rel < -127 ? -127 : rel; bia[e] = BT[(rel + 127) * 8 + (head & 7)]; } \
                      \
                    f32x4 a0 = (f32x4){0.f, 0.f, 0.f, 0.f}, a1 = (f32x4){0.f, 0.f, 0.f, 0.f}; \
                    _Pragma("unroll") for (int s4 = 0; s4 < 4; ++s4) { \
                        a0 = __builtin_amdgcn_mfma_f32_16x16x32_bf16(k0[s4], qlf[s4], a0, 0, 0, 0); \
                        a1 = __builtin_amdgcn_mfma_f32_16x16x32_bf16(k1[s4], qlf[s4], a1, 0, 0, 0); } \
                    asm volatile("" : "+v"(a0), "+v"(a1));        \
                    _Pragma("unroll") for (int ct = 0; ct < 8; ++ct) {              \
                        const v4i16_t lo4 = __builtin_amdgcn_ds_read_tr16_b64_v4i16((LAS v4i16_t*)(GB + off_b(8 * kg + q4, 2 * ct + (p4 >> 1)) + 8 * (p4 & 1))); \
                        const v4i16_t hi4 = __builtin_amdgcn_ds_read_tr16_b64_v4i16((LAS v4i16_t*)(GB + off_b(8 * kg + 4 + q4, 2 * ct + (p4 >> 1)) + 8 * (p4 & 1))); \
                        af[ct] = (bf16x8){lo4[0], lo4[1], lo4[2], lo4[3], hi4[0], hi4[1], hi4[2], hi4[3]}; } \
                      \
                    float lg[8]; \
                    _Pragma("unroll") for (int e = 0; e < 8; ++e) lg[e] = (e < 4 ? a0[e] : a1[e - 4]) * 0.125f + bia[e]; \
                    const float mloc = fmaxf(fmaxf(fmaxf(lg[0], lg[1]), fmaxf(lg[2], lg[3])), fmaxf(fmaxf(lg[4], lg[5]), fmaxf(lg[6], lg[7]))); \
                      \
                    float scl = 1.f; \
                    if (__any(mloc > m + 16.f)) { \
                        float mb = fmaxf(mloc, __shfl_xor(mloc, 16)); mb = fmaxf(mb, __shfl_xor(mb, 32)); \
                        const float mn = fmaxf(m, mb); scl = __expf(m - mn); m = mn; \
                        _Pragma("unroll") for (int ct = 0; ct < 8; ++ct) o[ct] = o[ct] * scl; } \
                    float ps = 0.f; float pe[8]; \
                    _Pragma("unroll") for (int e = 0; e < 8; ++e) { pe[e] = __expf(lg[e] - m); ps += pe[e]; } \
                    lsum = lsum * scl + ps; \
                    u32x4 pw; pw.x = pk2(pe[0], pe[1]); pw.y = pk2(pe[2], pe[3]); pw.z = pk2(pe[4], pe[5]); pw.w = pk2(pe[6], pe[7]); \
                    const bf16x8 pb = __builtin_bit_cast(bf16x8, pw); \
                    _Pragma("unroll") for (int ct = 0; ct < 8; ++ct) o[ct] = __builtin_amdgcn_mfma_f32_16x16x32_bf16(af[ct], pb, o[ct], 0, 0, 0); \
                } while (0)
#pragma unroll 1
                for (int kb2 = 0; kb2 < nblk; kb2 += 2) { DSA_STEP(gA, kb2); DSA_STEP(gB, kb2 + 1); }
#undef DSA_STEP
                lsum += __shfl_xor(lsum, 16); lsum += __shfl_xor(lsum, 32);
                const float inv = 1.f / lsum;
                if (head < 8) {
                    bf16_t* op = CAT + row * KOUT + head * 128 + 4 * kg;
#pragma unroll
                    for (int ct = 0; ct < 8; ++ct) { u32x2 w; w.x = pk2(o[ct][0] * inv, o[ct][1] * inv); w.y = pk2(o[ct][2] * inv, o[ct][3] * inv); *(u32x2*)(op + ct * 16) = w; }
                }
            }
#undef DSA_GATHER
        }
    }
}

constexpr size_t WS_DEC = 492 * MiB;
__device__ __forceinline__ void hgrn_prep(bf16_t* P, const float* lb, float* DEC, LAS unsigned char* lds, int vb, int nvb) {
    const int tid = otid(), cl = tid >> 7, d = tid & 127;
    LAS bf16_t* Ft = (LAS bf16_t*)lds; LAS bf16_t* Qt = (LAS bf16_t*)(lds + 65536);
    for (int it = vb; it < BATCH * 4 * 8; it += nvb) {
        const int b = it >> 5, h = (it >> 3) & 3, cg = it & 7;
        bf16_t* base = P + ((size_t)b * SEQ + cg * 256) * PW + h * 128;
        u32x4 v[16];
#pragma unroll
        for (int k = 0; k < 16; ++k) { const int i = tid + 512 * k, tl = i >> 12, r = (i >> 4) & 255, ch = i & 15; v[k] = *(const u32x4*)(base + (size_t)r * PW + (tl ? P_QB : P_FB) + ch * 8); }
        __syncthreads();
#pragma unroll
        for (int k = 0; k < 16; ++k) { const int i = tid + 512 * k, tl = i >> 12, r = (i >> 4) & 255, ch = i & 15; *(LAS u32x4*)(lds + tl * 65536 + r * 256 + ch * 16) = v[k]; }
        __syncthreads();
        {
            const float l = lb[h * 128 + d];
            LAS bf16_t* fcol = Ft + (cl * 64) * 128 + d; LAS bf16_t* qcol = Qt + (cl * 64) * 128 + d;
            float up = 1.f;
#pragma unroll 8
            for (int t = 32; t < 64; ++t) {
                const float f = l + (1.f - l) * sigmoid_f(bf2f(fcol[t * 128]));
                up *= f;
                const float q = silu_f(bf2f(qcol[t * 128]));
                qcol[t * 128] = (bf16_t)f2bf(q * up);
                fcol[t * 128] = (bf16_t)f2bf((1.f - f) * __builtin_amdgcn_rcpf(up));
            }
            float dn = 1.f;
#pragma unroll 8
            for (int t = 31; t >= 0; --t) {
                const float f = l + (1.f - l) * sigmoid_f(bf2f(fcol[t * 128]));
                const float q = silu_f(bf2f(qcol[t * 128]));
                qcol[t * 128] = (bf16_t)f2bf(q * __builtin_amdgcn_rcpf(dn));
                fcol[t * 128] = (bf16_t)f2bf((1.f - f) * dn);
                dn *= f;
            }
            float* dc = DEC + ((size_t)((b * 4 + h) * 32 + cg * 4 + cl) * 3) * 128 + d;
            dc[0] = dn; dc[128] = dn * up; dc[256] = up;
        }
        __syncthreads();
#pragma unroll
        for (int k = 0; k < 16; ++k) { const int i = tid + 512 * k, tl = i >> 12, r = (i >> 4) & 255, ch = i & 15; *(u32x4*)(base + (size_t)r * PW + (tl ? P_QB : P_FB) + ch * 8) = *(const LAS u32x4*)(lds + tl * 65536 + r * 256 + ch * 16); }
    }
}

__device__ __forceinline__ void hgrn_scan(const bf16_t* P, const float* DEC, const float* o_g, bf16_t* CAT, LAS unsigned char* lds, int item) {
    const int tid = otid(), lane = tid & 63, wid = __builtin_amdgcn_readfirstlane(tid >> 6), li = lane & 15, kg = lane >> 4;
    const int b = item >> 2, h = item & 3, it = wid >> 1, vh = wid & 1;
    LAS unsigned char* ST = lds + 98304;
    LAS float* SSQ = (LAS float*)(lds + DSA_BT_OFF);
    const bf16_t* Pb = P + (size_t)b * SEQ * PW;
    const float* DECb = DEC + (size_t)((b * 4 + h) * 32) * 384;
    f32x4 S[8];
#pragma unroll
    for (int vt = 0; vt < 8; ++vt) S[vt] = (f32x4){0.f, 0.f, 0.f, 0.f};
    u32x4 sg[6];
    const int colbase[3] = {P_QB, P_FB, P_IB};
#define HG_LOAD(c) do { _Pragma("unroll") for (int k = 0; k < 6; ++k) { const int n = tid + 512 * k, tl = n >> 10, r = (n >> 4) & 63, ch = n & 15; \
        sg[k] = *(const u32x4*)(Pb + (size_t)((c) * 64 + r) * PW + colbase[tl] + h * 128 + ch * 8); } } while (0)
#define HG_STORE(buf) do { _Pragma("unroll") for (int k = 0; k < 6; ++k) { const int n = tid + 512 * k, tl = n >> 10, r = (n >> 4) & 63, ch = n & 15; \
        *(LAS u32x4*)(lds + (buf) * 49152 + tl * 16384 + off_b(r, ch)) = sg[k]; } } while (0)
    HG_LOAD(0);
    __syncthreads();
    HG_STORE(0);
    const unsigned q4 = (lane & 15) >> 2, p4 = lane & 3;
    f32x4 ogv[4];
#pragma unroll
    for (int vv = 0; vv < 4; ++vv) ogv[vv] = *(const f32x4*)(o_g + 16 * (4 * vh + vv) + 4 * kg);
    float er_next = DECb[16 * wid + li];
#pragma unroll 1
    for (int c = 0; c < 32; ++c) {
        const int buf = c & 1;
        LAS unsigned char* QI = lds + buf * 49152; LAS unsigned char* KI = QI + 16384; LAS unsigned char* VI = QI + 32768;
        if (c + 1 < 32) HG_LOAD(c + 1);
        const float er = er_next, e63 = DECb[c * 384 + 128 + 16 * wid + li], e6r = DECb[c * 384 + 256 + 16 * wid + li];
        er_next = DECb[(c + 1 < 32 ? c + 1 : c) * 384 + 16 * wid + li];
        u32x2 gwv[4];
#pragma unroll
        for (int vv = 0; vv < 4; ++vv) gwv[vv] = *(const u32x2*)(P + ((size_t)b * SEQ + c * 64 + 16 * it + li) * PW + P_GB + h * 128 + 16 * (4 * vh + vv) + 4 * kg);
        { const unsigned d = 16 * wid + li;
#pragma unroll
          for (int vt = 0; vt < 8; ++vt) { u32x2 w; w.x = pk2(S[vt][0] * er, S[vt][1] * er); w.y = pk2(S[vt][2] * er, S[vt][3] * er);
              *(LAS u32x2*)(ST + off_b(d, 2 * vt + (kg >> 1)) + 8 * (kg & 1)) = w; } }
        __syncthreads();
        bf16x8 qf[4];
#pragma unroll
        for (int ks = 0; ks < 4; ++ks) qf[ks] = *(const LAS bf16x8*)(QI + off_b(16 * it + li, 4 * ks + kg));
        f32x4 o[4];
#pragma unroll
        for (int vv = 0; vv < 4; ++vv) o[vv] = (f32x4){0.f, 0.f, 0.f, 0.f};
#pragma unroll
        for (int ks = 0; ks < 4; ++ks)
#pragma unroll
            for (int vv = 0; vv < 4; ++vv) {
                const int ct = 4 * vh + vv;
                const v4i16_t lo4 = __builtin_amdgcn_ds_read_tr16_b64_v4i16((LAS v4i16_t*)(ST + off_b(32 * ks + 8 * kg + q4, 2 * ct + (p4 >> 1)) + 8 * (p4 & 1)));
                const v4i16_t hi4 = __builtin_amdgcn_ds_read_tr16_b64_v4i16((LAS v4i16_t*)(ST + off_b(32 * ks + 8 * kg + 4 + q4, 2 * ct + (p4 >> 1)) + 8 * (p4 & 1)));
                const bf16x8 af = (bf16x8){lo4[0], lo4[1], lo4[2], lo4[3], hi4[0], hi4[1], hi4[2], hi4[3]};
                o[vv] = __builtin_amdgcn_mfma_f32_16x16x32_bf16(af, qf[ks], o[vv], 0, 0, 0);
            }
        const int njb = (it >> 1) + 1;
#pragma unroll
        for (int jb = 0; jb < 2; ++jb) {
            if (jb < njb) {
                f32x4 a0 = (f32x4){0.f, 0.f, 0.f, 0.f}, a1 = (f32x4){0.f, 0.f, 0.f, 0.f};
                const unsigned rw0 = 32 * jb + 8 * (li >> 2) + (li & 3), rw1 = rw0 + 4;
#pragma unroll
                for (int ks = 0; ks < 4; ++ks) {
                    const bf16x8 k0 = *(const LAS bf16x8*)(KI + off_b(rw0, 4 * ks + kg));
                    const bf16x8 k1 = *(const LAS bf16x8*)(KI + off_b(rw1, 4 * ks + kg));
                    a0 = __builtin_amdgcn_mfma_f32_16x16x32_bf16(k0, qf[ks], a0, 0, 0, 0);
                    a1 = __builtin_amdgcn_mfma_f32_16x16x32_bf16(k1, qf[ks], a1, 0, 0, 0);
                }
                const int ii = 16 * it + li, j0 = 32 * jb + 8 * kg;
                float am[8];
#pragma unroll
                for (int e = 0; e < 8; ++e) am[e] = (j0 + e <= ii) ? (e < 4 ? a0[e] : a1[e - 4]) : 0.f;
                u32x4 pw; pw.x = pk2(am[0], am[1]); pw.y = pk2(am[2], am[3]); pw.z = pk2(am[4], am[5]); pw.w = pk2(am[6], am[7]);
                const bf16x8 pb = __builtin_bit_cast(bf16x8, pw);
#pragma unroll
                for (int vv = 0; vv < 4; ++vv) {
                    const int ct = 4 * vh + vv;
                    const v4i16_t lo4 = __builtin_amdgcn_ds_read_tr16_b64_v4i16((LAS v4i16_t*)(VI + off_b(32 * jb + 8 * kg + q4, 2 * ct + (p4 >> 1)) + 8 * (p4 & 1)));
                    const v4i16_t hi4 = __builtin_amdgcn_ds_read_tr16_b64_v4i16((LAS v4i16_t*)(VI + off_b(32 * jb + 8 * kg + 4 + q4, 2 * ct + (p4 >> 1)) + 8 * (p4 & 1)));
                    const bf16x8 af = (bf16x8){lo4[0], lo4[1], lo4[2], lo4[3], hi4[0], hi4[1], hi4[2], hi4[3]};
                    o[vv] = __builtin_amdgcn_mfma_f32_16x16x32_bf16(af, pb, o[vv], 0, 0, 0);
                }
            }
        }
        {
            f32x4 U[8];
#pragma unroll
            for (int vt = 0; vt < 8; ++vt) U[vt] = (f32x4){0.f, 0.f, 0.f, 0.f};
#pragma unroll
            for (int ks = 0; ks < 2; ++ks) {
                const v4i16_t kl = __builtin_amdgcn_ds_read_tr16_b64_v4i16((LAS v4i16_t*)(KI + off_b(32 * ks + 8 * kg + q4, 2 * wid + (p4 >> 1)) + 8 * (p4 & 1)));
                const v4i16_t kh = __builtin_amdgcn_ds_read_tr16_b64_v4i16((LAS v4i16_t*)(KI + off_b(32 * ks + 8 * kg + 4 + q4, 2 * wid + (p4 >> 1)) + 8 * (p4 & 1)));
                const bf16x8 kfr = (bf16x8){kl[0], kl[1], kl[2], kl[3], kh[0], kh[1], kh[2], kh[3]};
#pragma unroll
                for (int vt = 0; vt < 8; ++vt) {
                    const v4i16_t lo4 = __builtin_amdgcn_ds_read_tr16_b64_v4i16((LAS v4i16_t*)(VI + off_b(32 * ks + 8 * kg + q4, 2 * vt + (p4 >> 1)) + 8 * (p4 & 1)));
                    const v4i16_t hi4 = __builtin_amdgcn_ds_read_tr16_b64_v4i16((LAS v4i16_t*)(VI + off_b(32 * ks + 8 * kg + 4 + q4, 2 * vt + (p4 >> 1)) + 8 * (p4 & 1)));
                    const bf16x8 af = (bf16x8){lo4[0], lo4[1], lo4[2], lo4[3], hi4[0], hi4[1], hi4[2], hi4[3]};
                    U[vt] = __builtin_amdgcn_mfma_f32_16x16x32_bf16(af, kfr, U[vt], 0, 0, 0);
                }
            }
#pragma unroll
            for (int vt = 0; vt < 8; ++vt) S[vt] = S[vt] * e63 + U[vt] * e6r;
        }
        float ss = 0.f;
#pragma unroll
        for (int vv = 0; vv < 4; ++vv) ss += (o[vv][0] * o[vv][0] + o[vv][1] * o[vv][1]) + (o[vv][2] * o[vv][2] + o[vv][3] * o[vv][3]);
        ss += __shfl_xor(ss, 16); ss += __shfl_xor(ss, 32);
        if (kg == 0) SSQ[(it * 2 + vh) * 16 + li] = ss;
        __syncthreads();
        if (c + 1 < 32) HG_STORE(buf ^ 1);
        {
            const float tot = SSQ[(it * 2) * 16 + li] + SSQ[(it * 2 + 1) * 16 + li];
            const float rs = rsqrtf(tot * (1.f / 128.f) + EPS);
            const size_t row = (size_t)b * SEQ + c * 64 + 16 * it + li;
#pragma unroll
            for (int vv = 0; vv < 4; ++vv) {
                const int v0 = 16 * (4 * vh + vv) + 4 * kg;
                const u32x2 gw = gwv[vv];
                const f32x4 og = ogv[vv];
                const float g0 = silu_f(bf2f((unsigned short)(gw.x & 0xffffu))), g1 = silu_f(bf2f((unsigned short)(gw.x >> 16))), g2 = silu_f(bf2f((unsigned short)(gw.y & 0xffffu))), g3 = silu_f(bf2f((unsigned short)(gw.y >> 16)));
                u32x2 w; w.x = pk2(o[vv][0] * rs * og.x * g0, o[vv][1] * rs * og.y * g1); w.y = pk2(o[vv][2] * rs * og.z * g2, o[vv][3] * rs * og.w * g3);
                *(u32x2*)(CAT + row * KOUT + 1024 + h * 128 + v0) = w;
            }
        }
    }
#undef HG_LOAD
#undef HG_STORE
}


__device__ __forceinline__ int swap23(int r) { return (r & ~12) | ((r & 4) << 1) | ((r & 8) >> 1); }
__device__ __forceinline__ void xattn_mfma_phase(const bf16_t* Q, const bf16_t* Kb, const bf16_t* VT, bf16_t* O, LAS unsigned char* lds, int vb, int nvb) {
    const int tid = otid(), lane = tid & 63, wid = __builtin_amdgcn_readfirstlane(tid >> 6), r32 = lane & 31, hf = lane >> 5;
    LAS unsigned char* Ks = lds; LAS unsigned char* Vs = lds + 65536;
    int koff[8], voff[8];
    { const int kr = swap23(r32), x = kr & 15, y = r32 & 15;
#pragma unroll
      for (int ks = 0; ks < 8; ++ks) koff[ks] = kr * 256 + (((ks * 2 + hf) ^ x) << 4);
#pragma unroll
      for (int e = 0; e < 8; ++e) voff[e] = r32 * 512 + (((e * 2 + hf) ^ y) << 4); }
    for (int pair = vb; pair < 256; pair += nvb) {
        const int bh = pair >> 2, b = bh >> 2, h = bh & 3;
        __syncthreads();
        int tio = tid; asm volatile("" : "+v"(tio));
        for (int i = tio; i < 4096; i += NTHREADS) { const int key = i >> 4, ch = i & 15;
            const u32x4 v = *(const u32x4*)(Kb + (size_t)(b * MEMT + key) * 512 + h * 128 + ch * 8);
            *(LAS u32x4*)(Ks + key * 256 + ((ch ^ (key & 15)) << 4)) = v; }
        for (int i = tio; i < 4096; i += NTHREADS) { const int d = i >> 5, ch = i & 31;
            const u32x4 v = *(const u32x4*)(VT + (size_t)(h * 128 + d) * MT + b * MEMT + ch * 8);
            *(LAS u32x4*)(Vs + d * 512 + ((ch ^ (d & 15)) << 4)) = v; }
        __syncthreads();
#pragma unroll 1
        for (int qq = 0; qq < 2; ++qq) {
            const size_t q0 = (size_t)b * SEQ + ((pair & 3) * 2 + qq) * 256 + wid * 32;
            bf16x8 qf[8];
#pragma unroll
            for (int ks = 0; ks < 8; ++ks) qf[ks] = *(const bf16x8*)(Q + (q0 + r32) * 512 + h * 128 + ks * 16 + 8 * hf);
            f32x16 st[8];
            __builtin_amdgcn_s_setprio(1);
#pragma unroll
            for (int kt = 0; kt < 8; ++kt) {
#pragma unroll
                for (int r = 0; r < 16; ++r) st[kt][r] = 0.f;
#pragma unroll
                for (int ks = 0; ks < 8; ++ks) {
                    const bf16x8 a = *(const LAS bf16x8*)(Ks + koff[ks] + kt * 8192);
                    st[kt] = __builtin_amdgcn_mfma_f32_32x32x16_bf16(a, qf[ks], st[kt], 0, 0, 0);
                }
            }
            __builtin_amdgcn_s_setprio(0);
            float mx = -INFINITY;
#pragma unroll
            for (int kt = 0; kt < 8; ++kt)
#pragma unroll
                for (int r = 0; r < 16; ++r) mx = fmaxf(mx, st[kt][r]);
            mx = fmaxf(mx, __shfl_xor(mx, 32));
            const float c = 0.08838834764831845f * 1.4426950408889634f;
            float sum = 0.f;
#pragma unroll
            for (int kt = 0; kt < 8; ++kt)
#pragma unroll
                for (int r = 0; r < 16; ++r) { const float e = __builtin_amdgcn_exp2f((st[kt][r] - mx) * c); st[kt][r] = e; sum += e; }
            sum += __shfl_xor(sum, 32);
            const float inv = 1.f / sum;
            bf16x8 pfr[8][2];
#pragma unroll
            for (int kt = 0; kt < 8; ++kt)
#pragma unroll
                for (int s2 = 0; s2 < 2; ++s2) {
                    u32x4 pw;
                    pw.x = pk2(st[kt][8 * s2 + 0], st[kt][8 * s2 + 1]); pw.y = pk2(st[kt][8 * s2 + 2], st[kt][8 * s2 + 3]);
                    pw.z = pk2(st[kt][8 * s2 + 4], st[kt][8 * s2 + 5]); pw.w = pk2(st[kt][8 * s2 + 6], st[kt][8 * s2 + 7]);
                    pfr[kt][s2] = __builtin_bit_cast(bf16x8, pw);
                }
#pragma unroll
            for (int kt = 0; kt < 8; ++kt) asm volatile("" : "+v"(pfr[kt][0]), "+v"(pfr[kt][1]));
            f32x16 o[4];
#pragma unroll
            for (int dt = 0; dt < 4; ++dt)
#pragma unroll
                for (int r = 0; r < 16; ++r) o[dt][r] = 0.f;
            __builtin_amdgcn_s_setprio(1);
#pragma unroll
            for (int kt = 0; kt < 8; ++kt)
#pragma unroll
                for (int s2 = 0; s2 < 2; ++s2)
#pragma unroll
                    for (int dt = 0; dt < 4; ++dt) {
                        const bf16x8 a = *(const LAS bf16x8*)(Vs + voff[(kt & 3) * 2 + s2] + dt * 16384 + (kt >> 2) * 256);
                        o[dt] = __builtin_amdgcn_mfma_f32_32x32x16_bf16(a, pfr[kt][s2], o[dt], 0, 0, 0);
                    }
            __builtin_amdgcn_s_setprio(0);
            unsigned char* orow = (unsigned char*)O + (q0 + r32) * 512 + h * 128 + 64 * hf;
            const float isc = inv * XO_SC;
#pragma unroll
            for (int dt = 0; dt < 4; ++dt) {
                u32x4 w;
#pragma unroll
                for (int g = 0; g < 4; ++g) w[g] = pk4_f8(o[dt][4 * g] * isc, o[dt][4 * g + 1] * isc, o[dt][4 * g + 2] * isc, o[dt][4 * g + 3] * isc);
                *(u32x4*)(orow + dt * 16) = w;
            }
        }
    }
}


__device__ __forceinline__ void gmlp_mfma_phase(const bf16_t* UV, const float* lnp, const float* ln_g, const float* ln_b, const float* w_sp, const float* b_sp, bf16_t* G, LAS unsigned char* lds, int vb, int nvb) {
    const int tid = otid(), lane = tid & 63, wid = __builtin_amdgcn_readfirstlane(tid >> 6), fr = lane & 15, fq = lane >> 4;
    LAS unsigned char* Wb = lds; LAS unsigned char* VTs = lds + 32768; LAS float* STAT = (LAS float*)(lds + 65536);
    int gcur = -1;
    for (int grp = vb; grp < 256; grp += nvb) {
        const int g = grp >> 5;
        bf16x8 vch[4]; f32x4 lp[2];
#define GM_LOAD(uu_) do { const size_t r0_ = (size_t)((grp & 31) * 8 + (uu_)) * 128; \
            _Pragma("unroll") for (int k = 0; k < 4; ++k) { const int i = tid + 512 * k, sI = i >> 4, ch = i & 15; vch[k] = *(const bf16x8*)(UV + (r0_ + sI) * 2048 + 1024 + g * 128 + ch * 8); } \
            lp[0] = *(const f32x4*)(lnp + (r0_ + (tid >> 2)) * 32 + (tid & 3) * 8); lp[1] = *(const f32x4*)(lnp + (r0_ + (tid >> 2)) * 32 + (tid & 3) * 8 + 4); } while (0)
        GM_LOAD(0);
        const f32x4 g0 = *(const f32x4*)(ln_g + g * 128 + (tid & 15) * 8), g1 = *(const f32x4*)(ln_g + g * 128 + (tid & 15) * 8 + 4);
        const f32x4 b0 = *(const f32x4*)(ln_b + g * 128 + (tid & 15) * 8), b1 = *(const f32x4*)(ln_b + g * 128 + (tid & 15) * 8 + 4);
        const float gg[8] = {g0.x, g0.y, g0.z, g0.w, g1.x, g1.y, g1.z, g1.w}, bb[8] = {b0.x, b0.y, b0.z, b0.w, b1.x, b1.y, b1.z, b1.w};
        __syncthreads();
        if (g != gcur) {
            gcur = g;
            for (int i = tid; i < 2048; i += NTHREADS) { const int t = i >> 4, ch = i & 15;
                const f32x4 a = *(const f32x4*)(w_sp + (size_t)g * 16384 + t * 128 + ch * 8), b = *(const f32x4*)(w_sp + (size_t)g * 16384 + t * 128 + ch * 8 + 4);
                const int s0 = ch * 8;
                u32x4 w; w.x = pk2(s0 + 0 <= t ? a.x : 0.f, s0 + 1 <= t ? a.y : 0.f); w.y = pk2(s0 + 2 <= t ? a.z : 0.f, s0 + 3 <= t ? a.w : 0.f);
                w.z = pk2(s0 + 4 <= t ? b.x : 0.f, s0 + 5 <= t ? b.y : 0.f); w.w = pk2(s0 + 6 <= t ? b.z : 0.f, s0 + 7 <= t ? b.w : 0.f);
                *(LAS u32x4*)(Wb + t * 256 + ((ch ^ (t & 15)) << 4)) = w; }
        }
        const int trow = wid * 16 + fr;
        const float bias = b_sp[g * 128 + trow];
#pragma unroll 1
        for (int uu = 0; uu < 8; ++uu) {
            const int bn = (grp & 31) * 8 + uu;
            const size_t row0 = (size_t)bn * 128;
            if (uu) __syncthreads();
            { float s1 = (lp[0].x + lp[0].z) + (lp[1].x + lp[1].z), s2 = (lp[0].y + lp[0].w) + (lp[1].y + lp[1].w);
              s1 += __shfl_xor(s1, 1); s2 += __shfl_xor(s2, 1); s1 += __shfl_xor(s1, 2); s2 += __shfl_xor(s2, 2);
              const float mu = s1 * (1.f / 1024.f), var = fmaxf(s2 * (1.f / 1024.f) - mu * mu, 0.f);
              if ((tid & 3) == 0) { STAT[2 * (tid >> 2)] = mu; STAT[2 * (tid >> 2) + 1] = rsqrtf(var + EPS); } }
            __syncthreads();
#pragma unroll
            for (int k = 0; k < 4; ++k) { const int i = tid + 512 * k, sI = i >> 4, ch = i & 15;
                const float mu = STAT[2 * sI], rs = STAT[2 * sI + 1];
#pragma unroll
                for (int e = 0; e < 8; ++e) { const int c = ch * 8 + e; const float x = (bf2f((unsigned short)vch[k][e]) - mu) * rs * gg[e] + bb[e];
                    *(LAS bf16_t*)(VTs + c * 256 + (((sI >> 3) ^ ((c ^ (c >> 3)) & 15)) << 4) + (sI & 7) * 2) = (bf16_t)f2bf(x); } }
            if (uu + 1 < 8) GM_LOAD(uu + 1);
            const size_t orow = row0 + trow;
            u32x2 uwv[8];
#pragma unroll
            for (int ct = 0; ct < 8; ++ct) uwv[ct] = *(const u32x2*)(UV + orow * 2048 + g * 128 + ct * 16 + 4 * fq);
            __syncthreads();
            f32x4 acc[8];
#pragma unroll
            for (int ct = 0; ct < 8; ++ct) acc[ct] = (f32x4){0.f, 0.f, 0.f, 0.f};
#pragma unroll
            for (int ks = 0; ks < 4; ++ks) {
                const bf16x8 wf = *(const LAS bf16x8*)(Wb + trow * 256 + (((ks * 4 + fq) ^ (trow & 15)) << 4));
#pragma unroll
                for (int ct = 0; ct < 8; ++ct) {
                    const int crow = ct * 16 + fr;
                    const bf16x8 vf = *(const LAS bf16x8*)(VTs + crow * 256 + (((ks * 4 + fq) ^ ((crow ^ (crow >> 3)) & 15)) << 4));
                    acc[ct] = __builtin_amdgcn_mfma_f32_16x16x32_bf16(vf, wf, acc[ct], 0, 0, 0);
                }
            }
#pragma unroll
            for (int ct = 0; ct < 8; ++ct) {
                const int c = ct * 16 + 4 * fq;
                const u32x2 uw = uwv[ct];
                const float u0 = bf2f((unsigned short)(uw.x & 0xffffu)), u1 = bf2f((unsigned short)(uw.x >> 16)), u2 = bf2f((unsigned short)(uw.y & 0xffffu)), u3 = bf2f((unsigned short)(uw.y >> 16));
                u32x2 w; w.x = pk2(u0 * (acc[ct][0] + bias), u1 * (acc[ct][1] + bias)); w.y = pk2(u2 * (acc[ct][2] + bias), u3 * (acc[ct][3] + bias));
                *(u32x2*)(G + orow * 1024 + g * 128 + c) = w;
            }
        }
#undef GM_LOAD
    }
}

#define GAS __attribute__((address_space(1)))
typedef GAS unsigned gu32;
#define XB_TMO      128
#define XB_XCNT(j)  (256  + 64 * (j))
#define XB_XSUB(j)  (1280 + 64 * (j))
#define XB_XGEN(j)  (2304 + 64 * (j))
#define XB_TOP      3328
#define XB_TOPGEN   3392
#define XCD_BAR_WORDS 3456
#define XB_SPIN_CAP (1u << 18)

__device__ __forceinline__ unsigned xb_ld(unsigned* p)              { return __hip_atomic_load(p, __ATOMIC_RELAXED, __HIP_MEMORY_SCOPE_AGENT); }
__device__ __forceinline__ unsigned xb_add(unsigned* p, unsigned v) { return __hip_atomic_fetch_add(p, v, __ATOMIC_RELAXED, __HIP_MEMORY_SCOPE_AGENT); }
__device__ __forceinline__ unsigned xb_xcc_id() { return (unsigned)__builtin_amdgcn_s_getreg((3 << 11) | 20) & 0xFu; }
#define XB_SPIN(cond, bar) do { unsigned _sp = 0; while (cond) { __builtin_amdgcn_s_sleep(1); \
    if ((++_sp & 255u) == 0u) { if (xb_ld(&(bar)[XB_TMO])) break; if (_sp > XB_SPIN_CAP) { atomicAdd(&(bar)[XB_TMO], 1u); break; } } } } while (0)

struct XcdBarrier {
    unsigned* bar; unsigned x;
    volatile LAS unsigned* st;
};

__device__ __forceinline__ XcdBarrier xcd_barrier_post(unsigned* bar, volatile LAS unsigned* st) {
    XcdBarrier b; b.bar = bar; b.x = xb_xcc_id(); b.st = st;
    if (threadIdx.x == 0) (void)xb_add(&bar[XB_XCNT(b.x)], 1u);
    return b;
}
__device__ __forceinline__ void xcd_barrier_complete(unsigned* bar, unsigned x, unsigned& nloc, unsigned& nx) {
    const unsigned G = gridDim.x * gridDim.y * gridDim.z;
    unsigned sum, cnt, mine, sp = 0u;
    for (;;) {
        sum = 0u; cnt = 0u; mine = 0u;
#pragma unroll
        for (unsigned j = 0; j < 16; ++j) { const unsigned c = xb_ld(&bar[XB_XCNT(j)]); sum += c; cnt += (c > 0u) ? 1u : 0u; mine = (j == x) ? c : mine; }
        if (sum == G) break;
        __builtin_amdgcn_s_sleep(1);
        if ((++sp & 255u) == 0u) { if (xb_ld(&bar[XB_TMO])) break; if (sp > XB_SPIN_CAP) { atomicAdd(&bar[XB_TMO], 1u); break; } }
    }
    nloc = mine > 0u ? mine : 1u; nx = cnt > 0u ? cnt : 1u;
}

__device__ __forceinline__ void xcd_barrier(const XcdBarrier& b) {
    asm volatile("s_waitcnt vmcnt(0)" ::: "memory");
    __syncthreads();
    if (threadIdx.x == 0) {
        unsigned* bar = b.bar;
        __builtin_amdgcn_s_waitcnt(0);
        unsigned nloc = b.st[0], nx = b.st[1];
        if (nloc == 0u) { xcd_barrier_complete(bar, b.x, nloc, nx); b.st[0] = nloc; b.st[1] = nx; }
        const unsigned old = xb_add(&bar[XB_XSUB(b.x)], 1u);
        const unsigned gen = old / nloc;
        if (old + 1u == (gen + 1u) * nloc) {
            __builtin_amdgcn_fence(__ATOMIC_RELEASE, "agent");
            asm volatile("s_waitcnt vmcnt(0)" ::: "memory");
            const unsigned og = xb_add(&bar[XB_TOP], 1u);
            const unsigned tg = og / nx;
            if (og + 1u == (tg + 1u) * nx) xb_add(&bar[XB_TOPGEN], 1u);
            else XB_SPIN(xb_ld(&bar[XB_TOPGEN]) == tg, bar);
            __builtin_amdgcn_fence(__ATOMIC_ACQUIRE, "agent");
            xb_add(&bar[XB_XGEN(b.x)], 1u);
            asm volatile("s_waitcnt vmcnt(0)" ::: "memory");
        } else {
            XB_SPIN(xb_ld(&bar[XB_XGEN(b.x)]) == gen, bar);
            __builtin_amdgcn_fence(__ATOMIC_ACQUIRE, "agent");
            asm volatile("s_waitcnt vmcnt(0)" ::: "memory");
        }
    }
    __syncthreads();
}

constexpr int LDS_BYTES = 32768 * 4 + 256 + 6144 + 8 * 2560;

enum Phase {
    PH_PREP = 0, PH_GEMM_IN, PH_CNORM, PH_MIX0  , PH_GEMM_OUT0,
    PH_GEMM_Q0, PH_XATTN0, PH_GEMM_O0, PH_GEMM_GU0, PH_GEMM_DN0,
    PH_GEMM_OIN, PH_GMLP, PH_GEMM_OOUT,
    PH_GEMM_Q1, PH_XATTN1, PH_GEMM_O1, PH_GEMM_GU1, PH_GEMM_DN1, PH_FINAL, PH_COUNT
};

__device__ __forceinline__ PrepJob make_job(const Params& p, int ji) {
    unsigned char* ws = p.ws; PrepJob j{};
    switch (ji) {
    case 0: j = PrepJob{p.in[5], 1024, 3272, p.in[4], (bf16_t*)(ws + WS_WIN), 1024, 1792, 1024, 0, MAP_WIN}; break;
    case 14: j = PrepJob{p.in[5], 1024, 3272, p.in[4], (bf16_t*)(ws + WS_WIN), 3584, PW, 1024, 0, MAP_WIN}; break;
    case 15: j = PrepJob{p.in[5], 1024, 3272, p.in[4], (bf16_t*)(ws + WS_WIN8), 1024, 2816, 1024, 0, MAP_WIN8, 4, WQ_GU}; break;
    case 1: j = PrepJob{p.in[10] + (size_t)512 * 1024, 512, 1024, nullptr, (bf16_t*)(ws + WS_WOUT), 0, 1024, KOUT, 1024, MAP_ID}; break;
    case 2: j = PrepJob{p.in[11], 1024, 2048, p.in[4] + 1024, (bf16_t*)(ws + WS_OWIN), 0, 2048, 1024, 0, MAP_ID, 2, WQ_GU}; break;
    case 3: j = PrepJob{p.in[16], 1024, 1024, nullptr, (bf16_t*)(ws + WS_OWOUT), 0, 1024, 1024, 0, MAP_ID}; break;
    case 4: case 5: { const int l = ji - 4; j = PrepJob{p.in[19] + (size_t)l * 1024 * 512, 1024, 512, p.in[17] + l * 1024, (bf16_t*)(ws + WS_WQ + (size_t)l * 512 * 1024), 0, 512, 1024, 0, MAP_ID, 2, WQ_GU}; } break;
    case 6: case 7: { const int l = ji - 6; j = PrepJob{p.in[20] + (size_t)l * 1024 * 1024, 1024, 1024, p.in[18] + l * 1024, (bf16_t*)(ws + WS_WKV) + (size_t)l * 1024 * 1024, 0, 1024, 1024, 0, MAP_ID}; } break;
    case 8: case 9: { const int l = ji - 8; j = PrepJob{p.in[21] + (size_t)l * 512 * 1024, 512, 1024, nullptr, (bf16_t*)(ws + WS_WO + (size_t)l * 1024 * 512), 0, 1024, 512, 0, MAP_ID, 3, WO_SC}; } break;
    case 10: case 11: { const int l = ji - 10; j = PrepJob{p.in[23] + (size_t)l * 1024 * 2 * FF, 1024, 2 * FF, p.in[22] + l * 1024, (bf16_t*)(ws + WS_WGU + (size_t)l * 2 * FF * 1024), 0, 2 * FF, 1024, 0, MAP_GU, 2, WQ_GU}; } break;
    case 12: case 13: { const int l = ji - 12;
        if ((DN_FP8 >> l) & 1) j = PrepJob{p.in[24] + (size_t)l * FF * 1024, FF, 1024, nullptr, (bf16_t*)(ws + WS_WDN + (size_t)l * 1024 * FF * 2), 0, 1024, FF, 0, MAP_ID, 1, WDN_SC};
        else j = PrepJob{p.in[24] + (size_t)l * FF * 1024, FF, 1024, nullptr, (bf16_t*)(ws + WS_WDN) + (size_t)l * 1024 * FF, 0, 1024, FF, 0, MAP_ID}; } break;
    }
    return j;
}
constexpr int N_PREP_JOBS = 16;

template <int ph> __device__ __forceinline__ void run_phase(const Params& p, LAS float* lds, int vb, int nvb) {
    unsigned char* ws = p.ws;
    bf16_t* HN = (bf16_t*)(ws + WS_HN); bf16_t* BIG = (bf16_t*)(ws + WS_BIG); bf16_t* CN = (bf16_t*)(ws + WS_CN); bf16_t* CAT = (bf16_t*)(ws + WS_CAT);
    bf16_t* KB = (bf16_t*)(ws + WS_KB); bf16_t* VTB = (bf16_t*)(ws + WS_VT); bf16_t* MEMN = (bf16_t*)(ws + WS_MEMN); float* lb = (float*)(ws + WS_LB);
    float* ssq = (float*)(ws + WS_SSQ); float* lnp = (float*)(ws + WS_LNP);
    bf16_t* XQ = BIG; bf16_t* XO = BIG + (size_t)T * 512;
    const int l = (ph >= PH_GEMM_Q1) ? 1 : 0;
    switch (ph) {
    case PH_PREP:
        x_to_h_rows(p.in[0], HN, ws + WS_X8, ssq, vb, nvb);
        {
            constexpr int NT_[N_PREP_JOBS] = {16 * 3, 8 * 4, 16 * 8, 16 * 4, 16 * 2, 16 * 2, 16 * 4, 16 * 4, 8 * 4, 8 * 4, 16 * 22, 16 * 22, 44 * 4, 44 * 4, 16 * 1, 16 * 7};
            constexpr int CUM1 = NT_[0], CUM2 = CUM1 + NT_[1], CUM3 = CUM2 + NT_[2], CUM4 = CUM3 + NT_[3], CUM5 = CUM4 + NT_[4], CUM6 = CUM5 + NT_[5], CUM7 = CUM6 + NT_[6],
                          CUM8 = CUM7 + NT_[7], CUM9 = CUM8 + NT_[8], CUM10 = CUM9 + NT_[9], CUM11 = CUM10 + NT_[10], CUM12 = CUM11 + NT_[11], CUM13 = CUM12 + NT_[12], CUM14 = CUM13 + NT_[13],
                          CUM15 = CUM14 + NT_[14], CUM16 = CUM15 + NT_[15];
#define PJ_FIND(it_, ji_, base_) do { ji_ = 0; base_ = 0; \
                PJ_STEP(it_, ji_, base_, 1, CUM1) PJ_STEP(it_, ji_, base_, 2, CUM2) PJ_STEP(it_, ji_, base_, 3, CUM3) PJ_STEP(it_, ji_, base_, 4, CUM4) PJ_STEP(it_, ji_, base_, 5, CUM5) PJ_STEP(it_, ji_, base_, 6, CUM6) PJ_STEP(it_, ji_, base_, 7, CUM7) \
                PJ_STEP(it_, ji_, base_, 8, CUM8) PJ_STEP(it_, ji_, base_, 9, CUM9) PJ_STEP(it_, ji_, base_, 10, CUM10) PJ_STEP(it_, ji_, base_, 11, CUM11) PJ_STEP(it_, ji_, base_, 12, CUM12) PJ_STEP(it_, ji_, base_, 13, CUM13) PJ_STEP(it_, ji_, base_, 14, CUM14) PJ_STEP(it_, ji_, base_, 15, CUM15) } while (0)
#define PJ_STEP(it_, ji_, base_, q, c) if ((it_) >= (c)) { ji_ = (q); base_ = (c); }
            f32x4 va[8], vn[8];
            int ji, base;
            if (vb < CUM16) { PJ_FIND(vb, ji, base); const PrepJob j = make_job(p, ji); prep_tile_load(j, vb - base, va); }
            for (int it = vb; it < CUM16; it += nvb) {
                PJ_FIND(it, ji, base);
                const PrepJob j = make_job(p, ji); const int tl = it - base;
                if (it + nvb < CUM16) { int jn, bn; PJ_FIND(it + nvb, jn, bn); const PrepJob j2 = make_job(p, jn); prep_tile_load(j2, it + nvb - bn, vn); }
                prep_tile_store(j, tl, va, lds);
#pragma unroll
                for (int q = 0; q < 8; ++q) va[q] = vn[q];
            }
#undef PJ_STEP
#undef PJ_FIND
        }
        prep_fold_in(p.in[5], p.in[7], p.in[4], (bf16_t*)(ws + WS_WIN8), lds, vb, nvb);
        prep_fold_out(p.in[10], p.in[8], (bf16_t*)(ws + WS_WOUT), lds, vb, nvb);
        prep_lb(p.in[3], lb, vb, nvb);
        rmsnorm_rows(p.in[1], MEMN, MT, vb, nvb);
        break;
    case PH_GEMM_IN: {
        {
            Gemm g{(const bf16_t*)(ws + WS_X8), (const bf16_t*)(ws + WS_WIN8), T, 2816, 512}; EpiStoreBf16<true, true> E{BIG, PW, ssq, 1.f / (HQ_X * WQ_GU)};
            run_gemm<EpiStoreBf16<true, true>, 2>(g, E, lds, vb, nvb);
        }
        Gemm g{(const bf16_t*)(ws + WS_WIN), (const bf16_t*)(ws + WS_WIN), T, PW, 1024}; EpiIn E{BIG, KB, VTB, ssq};
        pg8::ComboOrder S; S.init(nvb, nvb - 1 - vb);
        pg8::gemm_phase<EpiIn, pg8::ComboOrder, true, true>((LAS unsigned char*)lds, g, S, E);
    } break;
    case PH_CNORM: cnorm_rows(BIG, p.in[6], CN, vb, nvb); hgrn_prep(BIG, lb, (float*)(ws + WS_DEC), (LAS unsigned char*)lds, vb, nvb); break;
    case PH_MIX0:
        for (int item = vb; item < 64; item += nvb) hgrn_scan(BIG, (const float*)(ws + WS_DEC), p.in[9], CAT, (LAS unsigned char*)lds, item);
        dsa_mfma_phase(BIG, CN, p.in[2], CAT, (LAS unsigned char*)lds, (unsigned*)(ws + WS_CTL) + 3600);
        break;
    case PH_GEMM_OUT0: { Gemm g{CAT, (const bf16_t*)(ws + WS_WOUT), T, 1024, KOUT}; EpiResid<false, false, true> E{nullptr, HN, ssq, ws + WS_H8, HQ_Q0}; run_gemm(g, E, lds, vb, nvb); } break;
    case PH_GEMM_Q0: case PH_GEMM_Q1: { Gemm g{(const bf16_t*)(ws + WS_H8), (const bf16_t*)(ws + WS_WQ + (size_t)l * 512 * 1024), T, 512, 512}; EpiStoreBf16<true> E{XQ, 512, ssq, 1.f / ((l ? HQ_Q1 : HQ_Q0) * WQ_GU)}; run_gemm<EpiStoreBf16<true>, 2>(g, E, lds, vb, nvb); } break;
    case PH_XATTN0: case PH_XATTN1: xattn_mfma_phase(XQ, KB + (size_t)l * MT * 512, VTB + (size_t)l * 512 * MT, XO, (LAS unsigned char*)lds, vb, nvb); break;
    case PH_GEMM_O0: case PH_GEMM_O1: { Gemm g{XO, (const bf16_t*)(ws + WS_WO + (size_t)l * 1024 * 512), T, 1024, 256}; EpiResid<false, true, true> E{nullptr, HN, ssq, ws + WS_H8, l ? HQ_GU1 : HQ_GU0, XO_UNSC}; run_gemm<EpiResid<false, true, true>, 1>(g, E, lds, vb, nvb); } break;
    case PH_GEMM_GU0: case PH_GEMM_GU1: { constexpr bool dn8 = ((DN_FP8 >> l) & 1) != 0;
        Gemm g{(const bf16_t*)(ws + WS_H8), (const bf16_t*)(ws + WS_WGU + (size_t)l * 2 * FF * 1024), T, 2 * FF, 512}; EpiSwigluQ<true, dn8> E{BIG, FF, ssq, 1.f / ((l ? HQ_GU1 : HQ_GU0) * WQ_GU)}; run_gemm<EpiSwigluQ<true, dn8>, 2>(g, E, lds, vb, nvb); } break;
    case PH_GEMM_DN0: case PH_GEMM_DN1:
        if constexpr (((DN_FP8 >> l) & 1) != 0) { Gemm g{BIG, (const bf16_t*)(ws + WS_WDN + (size_t)l * 1024 * FF * 2), T, 1024, FF / 2}; EpiResid<false, true, ph == PH_GEMM_DN0> E{nullptr, HN, ssq, ws + WS_H8, HQ_OIN, DN_UNSC}; run_gemm<EpiResid<false, true, ph == PH_GEMM_DN0>, 1>(g, E, lds, vb, nvb); }
        else { Gemm g{BIG, (const bf16_t*)(ws + WS_WDN) + (size_t)l * 1024 * FF, T, 1024, FF}; EpiResid<false, false, ph == PH_GEMM_DN0> E{nullptr, HN, ssq, ws + WS_H8, HQ_OIN}; run_gemm(g, E, lds, vb, nvb); }
        break;
    case PH_GEMM_OIN: { Gemm g{(const bf16_t*)(ws + WS_H8), (const bf16_t*)(ws + WS_OWIN), T, 2048, 512}; EpiGeluBf16<true> E{BIG, 2048, ssq, lnp, 1.f / (HQ_OIN * WQ_GU)}; run_gemm<EpiGeluBf16<true>, 2>(g, E, lds, vb, nvb); } break;
    case PH_GMLP: gmlp_mfma_phase(BIG, lnp, p.in[12], p.in[13], p.in[14], p.in[15], CAT, (LAS unsigned char*)lds, vb, nvb); break;
    case PH_GEMM_OOUT: { Gemm g{CAT, (const bf16_t*)(ws + WS_OWOUT), T, 1024, 1024}; EpiResid<false, false, true> E{nullptr, HN, ssq, ws + WS_H8, HQ_Q1}; run_gemm(g, E, lds, vb, nvb); } break;
    case PH_FINAL: final_rows(HN, ssq, p.in[25], p.out, vb, nvb); break;
    default: break;
    }
}

template <int PH> __global__ void __launch_bounds__(NTHREADS) k_phase(Params p) {
    extern __shared__ __attribute__((aligned(16))) float smem[];
    run_phase<PH>(p, (LAS float*)smem, blockIdx.x, gridDim.x);
}

template <int PH> __device__ __forceinline__ void mega_phases(const Params& p, LAS float* lds, const XcdBarrier& bar) {
    run_phase<PH>(p, lds, blockIdx.x, gridDim.x);
#ifdef REPEAT_PH
    if constexpr (PH == REPEAT_PH) { xcd_barrier(bar); run_phase<PH>(p, lds, blockIdx.x, gridDim.x); }
#endif
    if constexpr (PH + 1 < PH_COUNT) { xcd_barrier(bar); mega_phases<PH + 1>(p, lds, bar); }
}
__global__ void __launch_bounds__(NTHREADS) k_mega(Params p) {
    extern __shared__ __attribute__((aligned(16))) float smem[];
    volatile LAS unsigned* st = (volatile LAS unsigned*)((LAS float*)smem + 32768);
    if (threadIdx.x < 2) st[threadIdx.x] = 0u;
    __syncthreads();
    const XcdBarrier bar = xcd_barrier_post((unsigned*)(p.ws + WS_CTL), st);
    mega_phases<0>(p, (LAS float*)smem, bar);
}

template <int PH> static void launch_phases(const Params& p, int grid, hipStream_t stream) {
    int g = grid * 4;
    if (PH == PH_MIX0 || PH == PH_XATTN0 || PH == PH_XATTN1 || PH == PH_GMLP) g = grid;
    (void)hipFuncSetAttribute((const void*)k_phase<PH>, hipFuncAttributeMaxDynamicSharedMemorySize, LDS_BYTES);
    hipLaunchKernelGGL(k_phase<PH>, dim3(g), dim3(NTHREADS), LDS_BYTES, stream, p);
    if constexpr (PH + 1 < PH_COUNT) launch_phases<PH + 1>(p, grid, stream);
}

extern "C" void kernel_launch(void* const* d_in, const int* in_sizes, int n_in, void* d_out, int out_size, void* d_ws, size_t ws_size, hipStream_t stream) {
    static int grid = 0;
    if (grid == 0) {
        if (n_in != 26 || out_size != T * D || ws_size < WS_END) { fprintf(stderr, "kernel_launch: unexpected shapes (n_in %d out %d ws %zu)\n", n_in, out_size, ws_size); grid = -1; return; }
        int dev = 0, cus = 0;
        (void)hipGetDevice(&dev); (void)hipDeviceGetAttribute(&cus, hipDeviceAttributeMultiprocessorCount, dev);
        (void)hipFuncSetAttribute((const void*)k_mega, hipFuncAttributeMaxDynamicSharedMemorySize, LDS_BYTES);
        int per_cu = 0;
        (void)hipOccupancyMaxActiveBlocksPerMultiprocessor(&per_cu, (const void*)k_mega, NTHREADS, LDS_BYTES);
        if (per_cu < 1) fprintf(stderr, "kernel_launch: occupancy query says %d blocks per CU\n", per_cu);
        (void)hipGetLastError();
        grid = cus > 0 ? cus : 256;
    }
    if (grid < 0) return;
    Params p{};
    for (int i = 0; i < 26; ++i) p.in[i] = (const float*)d_in[i];
    p.out = (float*)d_out; p.ws = (unsigned char*)d_ws;
    (void)hipMemsetAsync((char*)d_ws + WS_CTL, 0, 16384, stream);
#if MEGA
    hipLaunchKernelGGL(k_mega, dim3(grid), dim3(NTHREADS), LDS_BYTES, stream, p);
#else
    launch_phases<0>(p, grid, stream);
#endif
}
```

```cpp
#include <hip/hip_runtime.h>
#include <stdint.h>
#include <stdio.h>

#ifndef MEGA
#define MEGA 1
#endif
#ifndef DN_FP8
#define DN_FP8 2
#endif

#define LAS __attribute__((address_space(3)))
typedef unsigned short bf16_t;
typedef short bf16x8 __attribute__((ext_vector_type(8)));
typedef float f32x4 __attribute__((ext_vector_type(4)));
typedef float f32x2 __attribute__((ext_vector_type(2)));
typedef unsigned u32x4 __attribute__((ext_vector_type(4)));
typedef unsigned u32x2 __attribute__((ext_vector_type(2)));
typedef float f32x16 __attribute__((ext_vector_type(16)));

constexpr int D = 1024, BATCH = 16, SEQ = 2048, T = BATCH * SEQ;
constexpr int CHUNK = 64;
constexpr int MEMT = 256, MT = BATCH * MEMT;
constexpr int FF = 2816;
constexpr float EPS = 1e-6f;
constexpr int NTHREADS = 512, NWAVES = 8;

constexpr int P_QL = 0, P_C = 1024, P_QI = 1152, P_KI = 1664, P_FB = 1728, P_IB = 2240, P_QB = 2752, P_GB = 3264, P_WI = 3776, P_END = 3784, PW = 3840;
constexpr int KOUT = 1536;

constexpr size_t MiB = 1u << 20;
constexpr size_t WS_CTL = 0;
constexpr size_t WS_LB = 64 * 1024;
constexpr size_t WS_SSQ = 496 * MiB;
constexpr size_t WS_LNP = 498 * MiB;
constexpr size_t WS_WIN = 1 * MiB;
constexpr size_t WS_WKV = WS_WIN + (size_t)PW * D * 2;
constexpr size_t WS_HN = WS_WKV + 2 * (size_t)D * D * 2;
constexpr size_t WS_MEMN = WS_HN + (size_t)T * D * 2;
constexpr size_t WS_WOUT = WS_MEMN + (size_t)MT * D * 2;
constexpr size_t WS_OWIN = WS_WOUT + (size_t)D * KOUT * 2;
constexpr size_t WS_OWOUT = WS_OWIN + (size_t)2048 * D * 2;
constexpr size_t WS_WQ = WS_OWOUT + (size_t)D * D * 2;
constexpr size_t WS_WO = WS_WQ + 2 * (size_t)512 * D * 2;
constexpr size_t WS_WGU = WS_WO + 2 * (size_t)D * 512 * 2;
constexpr size_t WS_WDN = WS_WGU + 2 * (size_t)2 * FF * D * 2;
constexpr size_t WS_WEND = WS_WDN + 2 * (size_t)D * FF * 2;
constexpr int TILE_WIN = 0, TILE_WKV = PW / 256, TILE_HN = TILE_WKV + 8, TILE_MEMN = TILE_HN + T / 256;
constexpr size_t WS_BIG = 132 * MiB;
constexpr size_t WS_CN = 372 * MiB;
constexpr size_t WS_CAT = 380 * MiB;
constexpr size_t WS_H8 = WS_BIG + 200 * MiB;
constexpr size_t WS_WIN8 = WS_CAT, WS_WKV8 = WS_WIN8 + (size_t)2816 * 1024, WS_X8 = WS_WKV8 + (size_t)2048 * 1024, WS_MEMN8 = WS_X8 + (size_t)T * 1024;
constexpr int T8_WIN = 0, T8_WKV = 11, T8_X = 19, T8_MEMN = T8_X + T / 256;
constexpr size_t WS_KB = 476 * MiB;
constexpr size_t WS_VT = 484 * MiB;
constexpr size_t WS_END = 502 * MiB;
static_assert(WS_WEND <= WS_BIG, "weights fit below BIG");

struct Params {
    const float* in[26];
    float* out;
    unsigned char* ws;
};

__device__ __forceinline__ float bf2f(unsigned short u) { return __uint_as_float(((unsigned)u) << 16); }
__device__ __forceinline__ unsigned f2bf(float f) { unsigned u = __float_as_uint(f); return (u + 0x7fffu + ((u >> 16) & 1u)) >> 16; }
typedef __bf16 bf16x2_t __attribute__((ext_vector_type(2)));
__device__ __forceinline__ unsigned pk2(float lo, float hi) { const f32x2 v = {lo, hi}; return __builtin_bit_cast(unsigned, __builtin_convertvector(v, bf16x2_t)); }
__device__ __forceinline__ float wave_sum(float v) {
#pragma unroll
    for (int o = 1; o < 64; o <<= 1) v += __shfl_xor(v, o);
    return v;
}
__device__ __forceinline__ float wave_max(float v) {
#pragma unroll
    for (int o = 1; o < 64; o <<= 1) v = fmaxf(v, __shfl_xor(v, o));
    return v;
}
__device__ __forceinline__ int otid() { int t = threadIdx.x; asm volatile("" : "+v"(t)); return t; }
#define WAVE_LDS_SYNC() asm volatile("s_waitcnt lgkmcnt(0)" ::: "memory")
__device__ __forceinline__ float silu_f(float x) { return x * __builtin_amdgcn_rcpf(1.f + __expf(-x)); }
__device__ __forceinline__ float sigmoid_f(float x) { return __builtin_amdgcn_rcpf(1.f + __expf(-x)); }

typedef int i32x4v __attribute__((ext_vector_type(4)));
typedef int i32x8v __attribute__((ext_vector_type(8)));
__device__ __forceinline__ unsigned pk4_f8(float a, float b, float c, float d) {
    a = __builtin_amdgcn_fmed3f(a, -448.f, 448.f); b = __builtin_amdgcn_fmed3f(b, -448.f, 448.f); c = __builtin_amdgcn_fmed3f(c, -448.f, 448.f); d = __builtin_amdgcn_fmed3f(d, -448.f, 448.f);
    int w = 0;
    w = __builtin_amdgcn_cvt_pk_fp8_f32(a, b, w, false);
    w = __builtin_amdgcn_cvt_pk_fp8_f32(c, d, w, true);
    return (unsigned)w;
}
constexpr float ACT_SC = 8.f, WDN_SC = 256.f, DN_UNSC = 1.f / (ACT_SC * WDN_SC);
constexpr float XO_SC = 64.f, WO_SC = 128.f, XO_UNSC = 1.f / (XO_SC * WO_SC);
constexpr float HQ_X = 127.f / 4.2f;
constexpr float HQ_Q0 = 127.f / 5.2f, HQ_GU0 = 127.f / 5.2f, HQ_OIN = 127.f / 5.8f, HQ_Q1 = 127.f / 6.3f, HQ_GU1 = 127.f / 6.3f, WQ_GU = 127.f / 0.13f;
__device__ __forceinline__ unsigned pk4_i8(float a, float b, float c, float d, float sc) {
    constexpr float MG = 12582912.f;
    const unsigned ua = __float_as_uint(__builtin_amdgcn_fmed3f(__builtin_fmaf(a, sc, MG), MG - 127.f, MG + 127.f)), ub = __float_as_uint(__builtin_amdgcn_fmed3f(__builtin_fmaf(b, sc, MG), MG - 127.f, MG + 127.f));
    const unsigned uc = __float_as_uint(__builtin_amdgcn_fmed3f(__builtin_fmaf(c, sc, MG), MG - 127.f, MG + 127.f)), ud = __float_as_uint(__builtin_amdgcn_fmed3f(__builtin_fmaf(d, sc, MG), MG - 127.f, MG + 127.f));
    return __builtin_amdgcn_perm(ub, ua, 0x0c0c0400u) | __builtin_amdgcn_perm(ud, uc, 0x04000c0cu);
}
__device__ __forceinline__ int kperm8(int k) { const int r = k & 255; return (k & ~255) + ((r >> 5) & 3) * 64 + ((r >> 3) & 3) * 16 + (r >> 7) * 8 + (r & 7); }
__device__ __forceinline__ f32x4 i2f4(f32x4 v) { const i32x4v t = __builtin_bit_cast(i32x4v, v); return (f32x4){(float)t.x, (float)t.y, (float)t.z, (float)t.w}; }
struct Unit { int pm, pn, idx; };
struct Gemm { const bf16_t* A; const bf16_t* Bt; int M, N, K; };
__device__ __forceinline__ int perm32(int rho) { const int n = rho >> 4, i = rho & 15; return 8 * (i >> 2) + 4 * n + (i & 3); }

__device__ __forceinline__ float row_rstd(const float* ssq, size_t row) {
    const f32x4* p = (const f32x4*)(ssq + row * 16);
    const f32x4 a = p[0], b = p[1], c = p[2], d = p[3];
    const float t = (((a.x + a.y) + (a.z + a.w)) + ((b.x + b.y) + (b.z + b.w))) + (((c.x + c.y) + (c.z + c.w)) + ((d.x + d.y) + (d.z + d.w)));
    return rsqrtf(t * (1.f / 1024.f) + EPS);
}
__device__ __forceinline__ void rows_rstd(const float* ssq, size_t row0, int fq, float (&rs)[2][4]) {
#pragma unroll
    for (int ai = 0; ai < 2; ++ai)
#pragma unroll
        for (int m = 0; m < 4; ++m) { const f32x4 a = *(const f32x4*)(ssq + (row0 + ai * 128 + m * 16) * 16 + 4 * fq); rs[ai][m] = (a.x + a.y) + (a.z + a.w); }
#pragma unroll
    for (int ai = 0; ai < 2; ++ai)
#pragma unroll
        for (int m = 0; m < 4; ++m) { float t = rs[ai][m]; t += __shfl_xor(t, 16); t += __shfl_xor(t, 32); rs[ai][m] = rsqrtf(t * (1.f / 1024.f) + EPS); }
}
constexpr int RSTD_TAB_OFF = 137472, RSTD_TAB_UNITS = 20;
template <class Sched> __device__ __forceinline__ void build_rstd_table(const Sched& S, const float* ssq, LAS float* tab) {
    const int tid = otid(), r = tid >> 1, hh = tid & 1;
    Unit u;
    for (int i = 0; i < RSTD_TAB_UNITS && S.next(i, u); ++i) {
        const int st = S.ssq_tile(u);
        if (st < 0) { if (hh == 0) tab[i * 256 + r] = 1.f; continue; }
        const f32x4 a = *(const f32x4*)(ssq + ((size_t)st * 256 + r) * 16 + hh * 8), b = *(const f32x4*)(ssq + ((size_t)st * 256 + r) * 16 + hh * 8 + 4);
        float t = ((a.x + a.y) + (a.z + a.w)) + ((b.x + b.y) + (b.z + b.w));
        t += __shfl_xor(t, 1);
        if (hh == 0) tab[i * 256 + r] = rsqrtf(t * (1.f / 1024.f) + EPS);
    }
    __syncthreads();
}
__device__ __forceinline__ void rows_rstd_tab(const LAS float* tab, int idx, int rloc, float (&rs)[2][4]) {
#pragma unroll
    for (int ai = 0; ai < 2; ++ai)
#pragma unroll
        for (int m = 0; m < 4; ++m) rs[ai][m] = tab[idx * 256 + rloc + ai * 128 + m * 16];
}
template <bool ACC_I8 = false, bool REMAP = false> struct EpiStoreBf16 {
    static constexpr bool PERM = true, AFTER_DRAIN = false;
    static constexpr bool USES_TAB = true;
    bf16_t* O; int ldc; const float* ssq; float dq = 1.f; const LAS float* tab = nullptr;
    __device__ __forceinline__ void operator()(const f32x4 (&acc)[2][2][4][2], const Unit& u, int wr, int wc, int fr, int fq) const {
        const int ct = REMAP ? (u.pn < 4 ? u.pn : u.pn + 3) : u.pn;
        const int row0 = u.pm * 256 + wr * 64 + fr, col0 = ct * 256 + wc * 32 + 8 * fq;
        float rsv[2][4]; rows_rstd_tab(tab, u.idx, wr * 64 + fr, rsv);
#pragma unroll
        for (int ai = 0; ai < 2; ++ai)
#pragma unroll
            for (int m = 0; m < 4; ++m) {
                const float rs = ACC_I8 ? rsv[ai][m] * dq : rsv[ai][m];
                bf16_t* rowp = O + (size_t)(row0 + ai * 128 + m * 16) * ldc + col0;
#pragma unroll
                for (int bj = 0; bj < 2; ++bj) {
                    const f32x4 v0 = (ACC_I8 ? i2f4(acc[ai][bj][m][0]) : acc[ai][bj][m][0]) * rs, v1 = (ACC_I8 ? i2f4(acc[ai][bj][m][1]) : acc[ai][bj][m][1]) * rs;
                    u32x4 w; w.x = pk2(v0[0], v0[1]); w.y = pk2(v0[2], v0[3]); w.z = pk2(v1[0], v1[1]); w.w = pk2(v1[2], v1[3]);
                    *(u32x4*)(rowp + bj * 128) = w;
                }
            }
    }
};
struct EpiIn8 {
    static constexpr bool PERM = true, AFTER_DRAIN = false, USES_TAB = true;
    bf16_t* P; bf16_t* KB; bf16_t* VT; const float* ssq; float dq; const LAS float* tab = nullptr;
    __device__ __forceinline__ void operator()(const f32x4 (&acc)[2][2][4][2], const Unit& u, int wr, int wc, int fr, int fq) const {
        bf16_t* O; int ldc, rt, ct;
        if (u.pn < T8_WKV) { O = P; ldc = PW; rt = u.pm - T8_X; ct = u.pn < 4 ? u.pn : u.pn + 3; }
        else if (u.pm >= T8_MEMN) { const int l = (u.pn - T8_WKV) >> 2; O = KB + (size_t)l * MT * 512; ldc = 512; rt = u.pm - T8_MEMN; ct = (u.pn - T8_WKV) & 3; }
        else { const int l = (u.pm - T8_WKV) >> 2; O = VT + (size_t)l * 512 * MT; ldc = MT; rt = ((u.pm - T8_WKV) & 3) - 2; ct = u.pn - T8_MEMN; }
        const int row0 = rt * 256 + wr * 64 + fr, col0 = ct * 256 + wc * 32 + 8 * fq;
        float rsv[2][4]; rows_rstd_tab(tab, u.idx, wr * 64 + fr, rsv);
#pragma unroll
        for (int ai = 0; ai < 2; ++ai)
#pragma unroll
            for (int m = 0; m < 4; ++m) {
                const float rs = rsv[ai][m] * dq;
                bf16_t* rowp = O + (size_t)(row0 + ai * 128 + m * 16) * ldc + col0;
#pragma unroll
                for (int bj = 0; bj < 2; ++bj) {
                    const f32x4 v0 = i2f4(acc[ai][bj][m][0]) * rs, v1 = i2f4(acc[ai][bj][m][1]) * rs;
                    u32x4 w; w.x = pk2(v0[0], v0[1]); w.y = pk2(v0[2], v0[3]); w.z = pk2(v1[0], v1[1]); w.w = pk2(v1[2], v1[3]);
                    *(u32x4*)(rowp + bj * 128) = w;
                }
            }
    }
};
struct EpiIn {
    static constexpr bool PERM = true, AFTER_DRAIN = false;
    static constexpr bool USES_TAB = false;
    bf16_t* P; bf16_t* KB; bf16_t* VT; const float* ssq;
    __device__ __forceinline__ void operator()(const f32x4 (&acc)[2][2][4][2], const Unit& u, int wr, int wc, int fr, int fq) const {
        bf16_t* O; int ldc, rt, ct; const bool main_unit = u.pn < TILE_WKV;
        if (main_unit) { O = P; ldc = PW; rt = u.pm - TILE_HN; ct = u.pn; }
        else if (u.pm >= TILE_MEMN) { const int l = (u.pn - TILE_WKV) >> 2; O = KB + (size_t)l * MT * 512; ldc = 512; rt = u.pm - TILE_MEMN; ct = (u.pn - TILE_WKV) & 3; }
        else { const int l = (u.pm - TILE_WKV) >> 2; O = VT + (size_t)l * 512 * MT; ldc = MT; rt = ((u.pm - TILE_WKV) & 3) - 2; ct = u.pn - TILE_MEMN; }
        const int row0 = rt * 256 + wr * 64 + fr, col0 = ct * 256 + wc * 32 + 8 * fq;
        float rsv[2][4];
        if (main_unit) rows_rstd(ssq, (size_t)row0, fq, rsv);
        else {
#pragma unroll
            for (int ai = 0; ai < 2; ++ai)
#pragma unroll
                for (int m = 0; m < 4; ++m) rsv[ai][m] = 1.f; }
#pragma unroll
        for (int ai = 0; ai < 2; ++ai)
#pragma unroll
            for (int m = 0; m < 4; ++m) {
                const float rs = rsv[ai][m];
                bf16_t* rowp = O + (size_t)(row0 + ai * 128 + m * 16) * ldc + col0;
#pragma unroll
                for (int bj = 0; bj < 2; ++bj) {
                    const f32x4 v0 = acc[ai][bj][m][0] * rs, v1 = acc[ai][bj][m][1] * rs;
                    u32x4 w; w.x = pk2(v0[0], v0[1]); w.y = pk2(v0[2], v0[3]); w.z = pk2(v1[0], v1[1]); w.w = pk2(v1[2], v1[3]);
                    *(u32x4*)(rowp + bj * 128) = w;
                }
            }
    }
};
template <bool ACC_I8 = false> struct EpiGeluBf16 {
    static constexpr bool PERM = true, AFTER_DRAIN = false;
    static constexpr bool USES_TAB = true;
    bf16_t* O; int ldc; const float* ssq; float* lnp; float dq = 1.f; const LAS float* tab = nullptr;
    __device__ __forceinline__ static f32x2 gelu_pk(f32x2 v) {
        const f32x2 av = __builtin_elementwise_abs(v), d = av * 0.2316418882f + 1.0f;
        f32x2 t; t.x = __builtin_amdgcn_rcpf(d.x); t.y = __builtin_amdgcn_rcpf(d.y);
        f32x2 q = t * 0.5307027145f + (-0.7265760135f); q = q * t + 0.7107068705f; q = q * t + (-0.142248368f); q = q * t + 0.127414796f; q = q * t;
        const f32x2 sq = (v * v) * (-0.72134752044f);
        f32x2 e; e.x = __builtin_amdgcn_exp2f(sq.x); e.y = __builtin_amdgcn_exp2f(sq.y);
        const f32x2 mm = v * (q * e), r = v - mm;
        f32x2 o; o.x = v.x < 0.f ? mm.x : r.x; o.y = v.y < 0.f ? mm.y : r.y; return o;
    }
    __device__ __forceinline__ static unsigned g2(float a, float b) { const f32x2 r = gelu_pk((f32x2){a, b}); return pk2(r.x, r.y); }
    __device__ __forceinline__ void operator()(const f32x4 (&acc)[2][2][4][2], const Unit& u, int wr, int wc, int fr, int fq) const {
        const int row0 = u.pm * 256 + wr * 64 + fr, col0 = u.pn * 256 + wc * 32 + 8 * fq;
        float rsv[2][4]; rows_rstd_tab(tab, u.idx, wr * 64 + fr, rsv);
#pragma unroll
        for (int ai = 0; ai < 2; ++ai)
#pragma unroll
            for (int m = 0; m < 4; ++m) {
                const size_t row = (size_t)(row0 + ai * 128 + m * 16);
                const float rs = ACC_I8 ? rsv[ai][m] * dq : rsv[ai][m];
                bf16_t* rowp = O + row * ldc + col0;
                float s1 = 0.f, s2 = 0.f;
#pragma unroll
                for (int bj = 0; bj < 2; ++bj) {
                    const f32x4 v0 = (ACC_I8 ? i2f4(acc[ai][bj][m][0]) : acc[ai][bj][m][0]) * rs, v1 = (ACC_I8 ? i2f4(acc[ai][bj][m][1]) : acc[ai][bj][m][1]) * rs;
                    const f32x2 ga = gelu_pk((f32x2){v0[0], v0[1]}), gb = gelu_pk((f32x2){v0[2], v0[3]}), gc = gelu_pk((f32x2){v1[0], v1[1]}), gd = gelu_pk((f32x2){v1[2], v1[3]});
                    u32x4 w; w.x = pk2(ga.x, ga.y); w.y = pk2(gb.x, gb.y); w.z = pk2(gc.x, gc.y); w.w = pk2(gd.x, gd.y);
                    *(u32x4*)(rowp + bj * 128) = w;
                    s1 += ((ga.x + ga.y) + (gb.x + gb.y)) + ((gc.x + gc.y) + (gd.x + gd.y));
                    s2 += ((ga.x * ga.x + ga.y * ga.y) + (gb.x * gb.x + gb.y * gb.y)) + ((gc.x * gc.x + gc.y * gc.y) + (gd.x * gd.x + gd.y * gd.y));
                }
                if (u.pn >= 4) {
                    s1 += __shfl_xor(s1, 16); s1 += __shfl_xor(s1, 32); s2 += __shfl_xor(s2, 16); s2 += __shfl_xor(s2, 32);
                    if (fq == 0) *(f32x2*)(lnp + (row * 16 + (u.pn - 4) * 4 + wc) * 2) = (f32x2){s1, s2};
                }
            }
    }
};
struct EpiSwigluBf16 {
    static constexpr bool PERM = true, AFTER_DRAIN = false, USES_TAB = false;
    bf16_t* O; int ldc; const float* ssq;
    __device__ __forceinline__ void operator()(const f32x4 (&acc)[2][2][4][2], const Unit& u, int wr, int wc, int fr, int fq) const {
        const int row0 = u.pm * 256 + wr * 64 + fr, col0 = u.pn * 128 + wc * 32 + 8 * fq;
        float rsv[2][4]; rows_rstd(ssq, (size_t)row0, fq, rsv);
#pragma unroll
        for (int ai = 0; ai < 2; ++ai)
#pragma unroll
            for (int m = 0; m < 4; ++m) {
                const float rs = rsv[ai][m];
                bf16_t* rowp = O + (size_t)(row0 + ai * 128 + m * 16) * ldc + col0;
                const f32x4 g0 = acc[ai][0][m][0] * rs, g1 = acc[ai][0][m][1] * rs, u0 = acc[ai][1][m][0] * rs, u1 = acc[ai][1][m][1] * rs;
                u32x4 w;
                w.x = pk2(silu_f(g0[0]) * u0[0], silu_f(g0[1]) * u0[1]); w.y = pk2(silu_f(g0[2]) * u0[2], silu_f(g0[3]) * u0[3]);
                w.z = pk2(silu_f(g1[0]) * u1[0], silu_f(g1[1]) * u1[1]); w.w = pk2(silu_f(g1[2]) * u1[2], silu_f(g1[3]) * u1[3]);
                *(u32x4*)rowp = w;
            }
    }
};
template <bool ACC_I8, bool OUT_F8> struct EpiSwigluQ {
    static constexpr bool PERM = true, AFTER_DRAIN = false;
    static constexpr bool USES_TAB = true;
    void* O; int ldc; const float* ssq; float dq; const LAS float* tab = nullptr;
    __device__ __forceinline__ void operator()(const f32x4 (&acc)[2][2][4][2], const Unit& u, int wr, int wc, int fr, int fq) const {
        const int row0 = u.pm * 256 + wr * 64 + fr, col0 = u.pn * 128 + wc * 32 + 8 * fq;
        float rsv[2][4]; rows_rstd_tab(tab, u.idx, wr * 64 + fr, rsv);
#pragma unroll
        for (int ai = 0; ai < 2; ++ai)
#pragma unroll
            for (int m = 0; m < 4; ++m) {
                const float rs = ACC_I8 ? rsv[ai][m] * dq : rsv[ai][m], rsu = OUT_F8 ? rs * ACT_SC : rs;
                f32x4 g0 = acc[ai][0][m][0], g1 = acc[ai][0][m][1], u0 = acc[ai][1][m][0], u1 = acc[ai][1][m][1];
                if (ACC_I8) { g0 = i2f4(g0); g1 = i2f4(g1); u0 = i2f4(u0); u1 = i2f4(u1); }
                g0 = g0 * rs; g1 = g1 * rs; u0 = u0 * rsu; u1 = u1 * rsu;
                if (OUT_F8) {
                    unsigned char* rowp = (unsigned char*)O + (size_t)(row0 + ai * 128 + m * 16) * ldc + col0;
                    u32x2 w;
                    w.x = pk4_f8(silu_f(g0[0]) * u0[0], silu_f(g0[1]) * u0[1], silu_f(g0[2]) * u0[2], silu_f(g0[3]) * u0[3]);
                    w.y = pk4_f8(silu_f(g1[0]) * u1[0], silu_f(g1[1]) * u1[1], silu_f(g1[2]) * u1[2], silu_f(g1[3]) * u1[3]);
                    *(u32x2*)rowp = w;
                } else {
                    bf16_t* rowp = (bf16_t*)O + (size_t)(row0 + ai * 128 + m * 16) * ldc + col0;
                    u32x4 w;
                    w.x = pk2(silu_f(g0[0]) * u0[0], silu_f(g0[1]) * u0[1]); w.y = pk2(silu_f(g0[2]) * u0[2], silu_f(g0[3]) * u0[3]);
                    w.z = pk2(silu_f(g1[0]) * u1[0], silu_f(g1[1]) * u1[1]); w.w = pk2(silu_f(g1[2]) * u1[2], silu_f(g1[3]) * u1[3]);
                    *(u32x4*)rowp = w;
                }
            }
    }
};
template <bool BASE_F32, bool SCALED = false, bool W8 = false> struct EpiResid {
    static constexpr bool PERM = true, AFTER_DRAIN = false;
    static constexpr bool USES_TAB = false;
    const float* xbase; bf16_t* H; float* ssq; unsigned char* H8 = nullptr; float hq = 0.f; float asc = 1.f;
    __device__ __forceinline__ void operator()(const f32x4 (&acc)[2][2][4][2], const Unit& u, int wr, int wc, int fr, int fq) const {
        const int row0 = u.pm * 256 + wr * 64 + fr, col0 = u.pn * 256 + wc * 32 + 8 * fq;
#pragma unroll
        for (int ai = 0; ai < 2; ++ai)
#pragma unroll
            for (int m = 0; m < 4; ++m) {
                const size_t row = (size_t)(row0 + ai * 128 + m * 16);
                float ss = 0.f; u32x4 q8 = (u32x4){0u, 0u, 0u, 0u};
#pragma unroll
                for (int bj = 0; bj < 2; ++bj) {
                    const size_t off = row * 1024 + col0 + bj * 128;
                    f32x4 b0, b1;
                    if (BASE_F32) { b0 = *(const f32x4*)(xbase + off); b1 = *(const f32x4*)(xbase + off + 4); }
                    else { const u32x4 hw = *(const u32x4*)(H + off);
                        b0 = (f32x4){bf2f((unsigned short)(hw.x & 0xffffu)), bf2f((unsigned short)(hw.x >> 16)), bf2f((unsigned short)(hw.y & 0xffffu)), bf2f((unsigned short)(hw.y >> 16))};
                        b1 = (f32x4){bf2f((unsigned short)(hw.z & 0xffffu)), bf2f((unsigned short)(hw.z >> 16)), bf2f((unsigned short)(hw.w & 0xffffu)), bf2f((unsigned short)(hw.w >> 16))}; }
                    const float sc = SCALED ? asc : 1.f;
                    const f32x4 v0 = b0 + acc[ai][bj][m][0] * sc, v1 = b1 + acc[ai][bj][m][1] * sc;
                    u32x4 w; w.x = pk2(v0[0], v0[1]); w.y = pk2(v0[2], v0[3]); w.z = pk2(v1[0], v1[1]); w.w = pk2(v1[2], v1[3]);
                    *(u32x4*)(H + off) = w;
                    if (W8) { q8[2 * bj] = pk4_i8(v0[0], v0[1], v0[2], v0[3], hq); q8[2 * bj + 1] = pk4_i8(v1[0], v1[1], v1[2], v1[3], hq); }
                    ss += ((v0[0] * v0[0] + v0[1] * v0[1]) + (v0[2] * v0[2] + v0[3] * v0[3])) + ((v1[0] * v1[0] + v1[1] * v1[1]) + (v1[2] * v1[2] + v1[3] * v1[3]));
                }
                if (W8) *(u32x4*)(H8 + row * 1024 + u.pn * 256 + wc * 64 + fq * 16) = q8;
                ss += __shfl_xor(ss, 16); ss += __shfl_xor(ss, 32);
                if (fq == 0) ssq[row * 16 + u.pn * 4 + wc] = ss;
            }
    }
};
namespace pg8 {
#define PG8_LAS __attribute__((address_space(3)))
constexpr int BM = 256, BK = 64, HALF = 128, HTB = HALF * BK * 2  , STAGE_BYTES = 8 * HTB, NXCD = 8, WGM = 8;
__host__ __device__ __forceinline__ int lds_byte(int r, int c) { const int st = (r >> 4) * 2 + (c >> 5), rr = r & 15, cc = c & 31, ob = rr * 64 + cc * 2; return st * 1024 + (ob ^ (((ob >> 9) & 1) << 5)); }
__host__ __device__ __forceinline__ void stage_rc(int b, int& R, int& C) { const int st = b / 1024, sb = b % 1024, swz = sb ^ (((sb >> 9) & 1) << 5); R = (st >> 1) * 16 + swz / 64; C = (st & 1) * 32 + (swz % 64) / 2; }
struct StaticOrder {
    int nM, nN, nwg, G, c;
    __host__ __device__ void init(int M, int N, int G_, int c_) { nM = M / BM; nN = N / BM; nwg = nM * nN; G = G_; c = c_; }
    __host__ __device__ bool next(int i, Unit& u) const {
        const long L = (long)i * G + c; if (L >= nwg) return false;
        int wgid = (int)L; { const int q = nwg / NXCD, r = nwg % NXCD, xcd = wgid % NXCD, off = wgid / NXCD; wgid = (xcd < r ? xcd * (q + 1) : r * (q + 1) + (xcd - r) * q) + off; }
        const int nig = WGM * nN, gid = wgid / nig, fm = gid * WGM, gsz = (nM - fm) < WGM ? (nM - fm) : WGM;
        u.pm = fm + ((wgid % nig) % gsz); u.pn = (wgid % nig) / gsz; u.idx = i; return true;
    }
    __host__ __device__ int ssq_tile(const Unit& u) const { return u.pm; }
    __device__ __forceinline__ void a_ready(const Unit&) const {}
    __device__ __forceinline__ void done(const Unit&) const {}
};
struct ComboOrder8 {
    StaticOrder so;
    __host__ __device__ void init(int G_, int c_) { so.init(T, 2816, G_, c_); }
    __host__ __device__ bool next(int i, Unit& u) const {
        const long L = (long)i * so.G + so.c;
        if (L < so.nwg) { so.next(i, u); u.pm += T8_X; return true; }
        const int j = (int)(L - so.nwg); if (j >= 128) return false;
        const int l = j >> 6, jj = j & 63; u.idx = i;
        if (jj < 32) { u.pm = T8_MEMN + (jj >> 1); u.pn = T8_WKV + 4 * l + (jj & 1); }
        else { const int q = jj - 32; u.pm = T8_WKV + 4 * l + 2 + (q >> 4); u.pn = T8_MEMN + (q & 15); }
        return true;
    }
    __host__ __device__ int ssq_tile(const Unit& u) const { return u.pn < T8_WKV ? u.pm - T8_X : -1; }
    __device__ __forceinline__ void a_ready(const Unit&) const {}
    __device__ __forceinline__ void done(const Unit&) const {}
};
struct ComboOrder {
    StaticOrder so; int nkv = 128;
    __host__ __device__ void init(int G_, int c_) { so.init(T, 1024, G_, c_); }
    __host__ __device__ bool next(int i, Unit& u) const {
        const long L = (long)i * so.G + so.c;
        if (L < so.nwg) { so.next(i, u); u.pm += TILE_HN; u.pn = u.pn < 3 ? u.pn + 4 : 14; return true; }
        const int j = (int)(L - so.nwg); if (j >= nkv) return false;
        const int l = j >> 6, jj = j & 63;
        if (jj < 32) { u.pm = TILE_MEMN + (jj >> 1); u.pn = TILE_WKV + 4 * l + (jj & 1); }
        else { const int q = jj - 32; u.pm = TILE_WKV + 4 * l + 2 + (q >> 4); u.pn = TILE_MEMN + (q & 15); }
        return true;
    }
    __device__ __forceinline__ void a_ready(const Unit&) const {}
    __device__ __forceinline__ void done(const Unit&) const {}
};
template <class Epi, class Sched, bool ALIGN_EPI = false, bool SP2 = false, int QM = 0  >
__device__ __forceinline__ void gemm_phase(PG8_LAS unsigned char* lds, const Gemm g, const Sched& S, const Epi& E) {
    const int tid = otid(), wid = __builtin_amdgcn_readfirstlane(tid >> 6), lane = tid & 63, wr = wid >> 2, wc = wid & 3, fr = lane & 15, fq = lane >> 4;
    constexpr bool FP8 = (QM == 1), I8 = (QM == 2);
    const int K = g.K, nt = K / BK;
    unsigned voffA[2], voffB[2];
#pragma unroll
    for (int i = 0; i < 2; ++i) { int R, C; stage_rc(tid * 16 + i * 8192, R, C); const int Rb = Epi::PERM ? ((R & ~31) + perm32(R & 31)) : R;
        voffA[i] = (unsigned)(R * K + C) * 2u; voffB[i] = (unsigned)(Rb * K + C) * 2u; }
    const size_t kstep = (size_t)(BK * 2);
    const size_t hstep = (size_t)HALF * K * 2;
    const size_t tstep = 2 * hstep;
    const unsigned ldsw = (unsigned)wid * 1024u;
    const int aoff = lds_byte(wr * 64 + fr, fq * 8), boff = lds_byte(wc * 32 + fr, fq * 8);
#define PG8_SA(b, h) (((b) * 2 + (h)) * HTB)
#define PG8_SB(b, h) ((4 + (b) * 2 + (h)) * HTB)
#define PG8_STAGE(bufoff, gbase, voff) do { _Pragma("unroll") for (int _i = 0; _i < 2; ++_i) \
        __builtin_amdgcn_global_load_lds((const unsigned*)((const char*)(gbase) + (voff)[_i]), (PG8_LAS unsigned*)(lds + (bufoff) + ldsw + _i * 8192), 16, 0, 0); } while (0)
#define PG8_LD16(off) (*(const PG8_LAS bf16x8*)(lds + (off)))
#define PG8_LDA(dst, b, h) do { _Pragma("unroll") for (int m = 0; m < 4; ++m) { \
        if constexpr (FP8) dst##8[m] = PG8_CAT(PG8_LD16(PG8_SA(b, h) + aoff + m * 2048), PG8_LD16(PG8_SA(b, h) + aoff + m * 2048 + 1024)); \
        else { _Pragma("unroll") for (int k = 0; k < 2; ++k) dst[m][k] = PG8_LD16(PG8_SA(b, h) + aoff + m * 2048 + k * 1024); } } } while (0)
#define PG8_LDB(dst, b, h) do { _Pragma("unroll") for (int n = 0; n < 2; ++n) { \
        if constexpr (FP8) dst##8[n] = PG8_CAT(PG8_LD16(PG8_SB(b, h) + boff + n * 2048), PG8_LD16(PG8_SB(b, h) + boff + n * 2048 + 1024)); \
        else { _Pragma("unroll") for (int k = 0; k < 2; ++k) dst[n][k] = PG8_LD16(PG8_SB(b, h) + boff + n * 2048 + k * 1024); } } } while (0)
#define PG8_CAT(x, y) __builtin_shufflevector(__builtin_bit_cast(i32x4v, x), __builtin_bit_cast(i32x4v, y), 0, 1, 2, 3, 4, 5, 6, 7)
#define PG8_MMA(ai, bj, At, Bt) do { __builtin_amdgcn_s_setprio(1); \
        if constexpr (FP8) { _Pragma("unroll") for (int m = 0; m < 4; ++m) _Pragma("unroll") for (int n = 0; n < 2; ++n) \
            asm("v_mfma_f32_16x16x128_f8f6f4 %0, %1, %2, %0" : "+v"(acc[ai][bj][m][n]) : "v"(Bt##8[n]), "v"(At##8[m])); } \
        else if constexpr (I8) { _Pragma("unroll") for (int m = 0; m < 4; ++m) _Pragma("unroll") for (int n = 0; n < 2; ++n) _Pragma("unroll") for (int k = 0; k < 2; ++k) \
            acc[ai][bj][m][n] = __builtin_bit_cast(f32x4, __builtin_amdgcn_mfma_i32_16x16x64_i8(__builtin_bit_cast(i32x4v, Bt[n][k]), __builtin_bit_cast(i32x4v, At[m][k]), __builtin_bit_cast(i32x4v, acc[ai][bj][m][n]), 0, 0, 0)); } \
        else { _Pragma("unroll") for (int m = 0; m < 4; ++m) _Pragma("unroll") for (int n = 0; n < 2; ++n) _Pragma("unroll") for (int k = 0; k < 2; ++k) \
            acc[ai][bj][m][n] = __builtin_amdgcn_mfma_f32_16x16x32_bf16(Bt[n][k], At[m][k], acc[ai][bj][m][n], 0, 0, 0); } \
        __builtin_amdgcn_s_setprio(0); } while (0)
#define PG8_WAIT_V(n) asm volatile("s_waitcnt vmcnt(" #n ")" ::: "memory")
#define PG8_WAIT_L(n) asm volatile("s_waitcnt lgkmcnt(" #n ")" ::: "memory")
#define PG8_BAR __builtin_amdgcn_s_barrier()
#define PG8_SCHED __builtin_amdgcn_sched_barrier(0)
    Unit cur, nxt; int ui = 0;
    if (!S.next(0, cur)) return;
    f32x4 acc[2][2][4][2];
#pragma unroll
    for (int a = 0; a < 2; ++a)
#pragma unroll
        for (int b = 0; b < 2; ++b)
#pragma unroll
            for (int m = 0; m < 4; ++m)
#pragma unroll
                for (int n = 0; n < 2; ++n) acc[a][b][m][n] = (f32x4){0.f, 0.f, 0.f, 0.f};
    bf16x8 At[4][2], B0[2][2], B1[2][2];
    i32x8v At8[4], B08[2], B18[2];
    const char* cA = (const char*)g.A + (size_t)cur.pm * tstep; const char* cB = (const char*)g.Bt + (size_t)cur.pn * tstep;
    S.a_ready(cur);
    if constexpr (SP2) {
        PG8_STAGE(PG8_SB(0, 0), cB, voffB); PG8_STAGE(PG8_SB(0, 1), cB + hstep, voffB); PG8_STAGE(PG8_SA(0, 0), cA, voffA); PG8_STAGE(PG8_SA(0, 1), cA + hstep, voffA);
        if (wr == 1) PG8_BAR;
        PG8_WAIT_V(2); PG8_BAR;
        PG8_STAGE(PG8_SB(1, 0), cB + kstep, voffB); PG8_STAGE(PG8_SA(1, 0), cA + kstep, voffA); PG8_STAGE(PG8_SB(1, 1), cB + hstep + kstep, voffB);
        PG8_WAIT_V(6); PG8_BAR;
    } else {
        PG8_STAGE(PG8_SB(0, 0), cB, voffB); PG8_STAGE(PG8_SA(0, 0), cA, voffA); PG8_STAGE(PG8_SB(0, 1), cB + hstep, voffB); PG8_STAGE(PG8_SA(0, 1), cA + hstep, voffA);
        if (wr == 1) PG8_BAR;
        PG8_WAIT_V(4); PG8_BAR;
        PG8_STAGE(PG8_SB(1, 0), cB + kstep, voffB); PG8_STAGE(PG8_SA(1, 0), cA + kstep, voffA); PG8_STAGE(PG8_SB(1, 1), cB + hstep + kstep, voffB);
        PG8_WAIT_V(6); PG8_BAR;
    }
    for (;;) {
        const bool has_next = S.next(ui + 1, nxt);
        const char* nA = has_next ? (const char*)g.A + (size_t)nxt.pm * tstep : cA; const char* nB = has_next ? (const char*)g.Bt + (size_t)nxt.pn * tstep : cB;
        for (int t = 0; t < nt; t += 2) {
            const bool last = (t == nt - 2);
            if constexpr (FP8) __builtin_amdgcn_s_waitcnt(0xC07F);
            const char* a1 = cA + (size_t)(t + 1) * kstep;
            const char* a2 = last ? nA : cA + (size_t)(t + 2) * kstep; const char* b2 = last ? nB : cB + (size_t)(t + 2) * kstep;
            const char* a3 = a2 + kstep; const char* b3 = b2 + kstep;
            if (last && has_next) S.a_ready(nxt);
            if constexpr (SP2) {
            PG8_LDB(B0, 0, 0); PG8_LDB(B1, 0, 1); PG8_SCHED; PG8_LDA(At, 0, 0); PG8_STAGE(PG8_SA(1, 1), a1 + hstep, voffA);
            PG8_WAIT_V(8); PG8_WAIT_L(0); PG8_BAR; PG8_MMA(0, 0, At, B0); PG8_MMA(0, 1, At, B1); PG8_BAR; PG8_SCHED;
            PG8_LDA(At, 0, 1); PG8_STAGE(PG8_SB(0, 0), b2, voffB); PG8_STAGE(PG8_SB(0, 1), b2 + hstep, voffB); PG8_STAGE(PG8_SA(0, 0), a2, voffA);
            PG8_WAIT_V(8); PG8_WAIT_L(0); PG8_BAR; PG8_MMA(1, 0, At, B0); PG8_MMA(1, 1, At, B1); PG8_BAR; PG8_SCHED;
            PG8_LDB(B0, 1, 0); PG8_LDB(B1, 1, 1); PG8_SCHED; PG8_LDA(At, 1, 0); PG8_STAGE(PG8_SA(0, 1), a2 + hstep, voffA);
            PG8_WAIT_V(8); PG8_WAIT_L(0); PG8_BAR; PG8_MMA(0, 0, At, B0); PG8_MMA(0, 1, At, B1); PG8_BAR; PG8_SCHED;
            PG8_LDA(At, 1, 1); PG8_STAGE(PG8_SB(1, 0), b3, voffB); PG8_STAGE(PG8_SB(1, 1), b3 + hstep, voffB); PG8_STAGE(PG8_SA(1, 0), a3, voffA);
            PG8_WAIT_V(8); PG8_WAIT_L(0); PG8_BAR; PG8_MMA(1, 0, At, B0); PG8_MMA(1, 1, At, B1); PG8_BAR; PG8_SCHED;
            } else {
            PG8_LDB(B0, 0, 0); PG8_SCHED; PG8_LDA(At, 0, 0); PG8_STAGE(PG8_SA(1, 1), a1 + hstep, voffA);
            PG8_WAIT_L(8); PG8_BAR; PG8_WAIT_L(0); PG8_MMA(0, 0, At, B0); PG8_BAR; PG8_SCHED;
            PG8_LDB(B1, 0, 1); PG8_STAGE(PG8_SB(0, 0), b2, voffB);
            PG8_BAR; PG8_WAIT_L(0); PG8_MMA(0, 1, At, B1); PG8_BAR;
            PG8_LDA(At, 0, 1); PG8_STAGE(PG8_SA(0, 0), a2, voffA);
            PG8_BAR; PG8_WAIT_L(0); PG8_MMA(1, 0, At, B0); PG8_BAR; PG8_SCHED;
            PG8_STAGE(PG8_SB(0, 1), b2 + hstep, voffB);
            PG8_WAIT_V(6); PG8_BAR; PG8_MMA(1, 1, At, B1); PG8_BAR;
            PG8_LDB(B0, 1, 0); PG8_SCHED; PG8_LDA(At, 1, 0); PG8_STAGE(PG8_SA(0, 1), a2 + hstep, voffA);
            PG8_WAIT_L(8); PG8_BAR; PG8_WAIT_L(0); PG8_MMA(0, 0, At, B0); PG8_BAR; PG8_SCHED;
            PG8_LDB(B1, 1, 1); PG8_STAGE(PG8_SB(1, 0), b3, voffB);
            PG8_BAR; PG8_WAIT_L(0); PG8_MMA(0, 1, At, B1); PG8_BAR;
            PG8_LDA(At, 1, 1); PG8_STAGE(PG8_SA(1, 0), a3, voffA);
            PG8_BAR; PG8_WAIT_L(0); PG8_MMA(1, 0, At, B0); PG8_BAR; PG8_SCHED;
            PG8_STAGE(PG8_SB(1, 1), b3 + hstep, voffB);
            PG8_WAIT_V(6); PG8_BAR; PG8_MMA(1, 1, At, B1); PG8_BAR;
            }
        }
        if constexpr (FP8) asm volatile("s_nop 15\n\ts_nop 15" ::: "memory");
        if constexpr (ALIGN_EPI) { if (wr == 0) PG8_BAR; }
        if constexpr (!Epi::AFTER_DRAIN) { E(acc, cur, wr, wc, fr, fq); S.done(cur); }
        if (!has_next) break;
#pragma unroll
        for (int a = 0; a < 2; ++a)
#pragma unroll
            for (int b = 0; b < 2; ++b)
#pragma unroll
                for (int m = 0; m < 4; ++m)
#pragma unroll
                    for (int n = 0; n < 2; ++n) acc[a][b][m][n] = (f32x4){0.f, 0.f, 0.f, 0.f};
        cur = nxt; cA = nA; cB = nB; ++ui;
        if constexpr (ALIGN_EPI) { if (wr == 1) PG8_BAR; }
    }
    PG8_WAIT_V(0);
    if constexpr (!ALIGN_EPI) { if (wr == 0) PG8_BAR; }
    PG8_BAR;
    if constexpr (Epi::AFTER_DRAIN) { E.fused(acc, cur, wr, wc, fr, fq, lds, wid, lane); S.done(cur); }
#undef PG8_SA
#undef PG8_SB
#undef PG8_STAGE
#undef PG8_LDA
#undef PG8_LD16
#undef PG8_LDB
#undef PG8_MMA
#undef PG8_CAT
#undef PG8_WAIT_V
#undef PG8_WAIT_L
#undef PG8_BAR
#undef PG8_SCHED
}
}

template <class Epi, int QM = 0>
__device__ __forceinline__ void run_gemm(const Gemm g, Epi E, LAS float* lds, int vb, int nvb) {
    pg8::StaticOrder S; S.init(g.M, g.N, nvb, vb);
    if constexpr (Epi::USES_TAB) { LAS float* tab = (LAS float*)((LAS unsigned char*)lds + RSTD_TAB_OFF); build_rstd_table(S, E.ssq, tab); E.tab = tab; }
    pg8::gemm_phase<Epi, pg8::StaticOrder, true, true, QM>((LAS unsigned char*)lds, g, S, E);
}

enum { MAP_ID = 0, MAP_WIN = 1, MAP_GU = 2, MAP_WIN8 = 3   };
struct PrepJob { const float* W; int K, N; const float* gain; bf16_t* dst; int r0, r1, ldd, koff, map; int fmt; float osc; };
__device__ __forceinline__ int map_src(int map, int r, int N) {
    if (map == MAP_ID) return r < N ? r : -1;
    if (map == MAP_WIN) {
        if (r < 1728) return r - 512;
        if (r < 3776) return r - 504;
        if (r < 3784) return r - 2560;
        return -1;
    }
    if (map == MAP_WIN8) return r + 264;
    { const int tile = r >> 8, w = r & 255, j = tile * 128 + (w & 127); return w < 128 ? j : FF + j; }
}
__device__ __forceinline__ void prep_tile_load(const PrepJob& j, int t, f32x4 (&v)[8]) {
    const int nkt = j.K / 64, kt = t % nkt, rt = t / nkt, k0 = kt * 64, r0 = j.r0 + rt * 256;
#pragma unroll
    for (int q = 0; q < 8; ++q) {
        const int i = (int)threadIdx.x + q * NTHREADS, kk = i >> 6, r4 = (i & 63) * 4;
        const int sc = map_src(j.map, r0 + r4, j.N);
        v[q] = sc >= 0 ? __builtin_nontemporal_load((const f32x4*)(j.W + (size_t)(k0 + kk) * j.N + sc)) : (f32x4){0.f, 0.f, 0.f, 0.f};
        if (j.gain) v[q] = v[q] * j.gain[k0 + kk];
    }
}
__device__ __forceinline__ void prep_tile_store(const PrepJob& j, int t, const f32x4 (&v)[8], LAS float* tile  ) {
    const int nkt = j.K / 64, kt = t % nkt, rt = t / nkt, k0 = kt * 64, r0 = j.r0 + rt * 256;
    __syncthreads();
#pragma unroll
    for (int q = 0; q < 8; ++q) { const int i = (int)threadIdx.x + q * NTHREADS, kk = i >> 6, r4 = (i & 63) * 4; *(LAS f32x4*)(tile + kk * 260 + r4) = v[q]; }
    __syncthreads();
#pragma unroll
    for (int q = 0; q < 4; ++q) {
        const int i = (int)threadIdx.x + q * NTHREADS, rr = i & 255, c8 = i >> 8;
        const LAS float* tp = tile + (c8 * 8) * 260 + rr;
        if (j.fmt != 0) {
            const float sc = j.osc; u32x2 w;
            if (j.fmt == 1 || j.fmt == 3) { w.x = pk4_f8(tp[0] * sc, tp[260] * sc, tp[520] * sc, tp[780] * sc); w.y = pk4_f8(tp[1040] * sc, tp[1300] * sc, tp[1560] * sc, tp[1820] * sc); }
            else { w.x = pk4_i8(tp[0], tp[260], tp[520], tp[780], sc); w.y = pk4_i8(tp[1040], tp[1300], tp[1560], tp[1820], sc); }
            unsigned char* drow = (unsigned char*)j.dst + (size_t)(r0 + rr) * j.ldd + j.koff; const int kk = k0 + c8 * 8;
            if (j.fmt == 3) { const int r = kk & 127, pp = (kk & ~127) + (r >> 5) * 16 + ((r >> 3) & 3) * 4; *(unsigned*)(drow + pp) = w.x; *(unsigned*)(drow + pp + 64) = w.y; }
            else *(u32x2*)(drow + (j.fmt == 2 ? kperm8(kk) : kk)) = w;
        } else {
        u32x4 w; w.x = pk2(tp[0], tp[260]); w.y = pk2(tp[520], tp[780]); w.z = pk2(tp[1040], tp[1300]); w.w = pk2(tp[1560], tp[1820]);
        *(u32x4*)(j.dst + (size_t)(r0 + rr) * j.ldd + j.koff + k0 + c8 * 8) = w;
        }
    }
}
__device__ __forceinline__ void prep_fold_in(const float* w_in  , const float* w_uk  , const float* gain, bf16_t* dst, LAS float* lds, int vb, int nvb) {
    LAS float* A = lds; LAS float* B = lds + 32 * 65;
    const int tid = otid(), lane = tid & 63, wid = __builtin_amdgcn_readfirstlane(tid >> 6), l15 = lane & 15, dq = lane >> 4;
    for (int item = vb; item < 256; item += nvb) {
        const int h = item >> 5, k0 = (item & 31) * 32;
        __syncthreads();
        for (int i = tid; i < 2048; i += NTHREADS) { const int kk = i >> 6, d = i & 63; A[kk * 65 + d] = w_in[(size_t)(k0 + kk) * 3272 + h * 64 + d] * gain[k0 + kk]; }
        for (int i = tid; i < 8192; i += NTHREADS) { const int c = i >> 6, d = i & 63; B[c * 65 + d] = w_uk[(size_t)(h * 128 + c) * 64 + d]; }
        __syncthreads();
        f32x4 acc0 = (f32x4){0.f, 0.f, 0.f, 0.f}, acc1 = acc0;
#pragma unroll 4
        for (int d0 = 0; d0 < 64; d0 += 4) {
            const float b = B[(16 * wid + l15) * 65 + d0 + dq], a0 = A[l15 * 65 + d0 + dq], a1 = A[(16 + l15) * 65 + d0 + dq];
            acc0 = __builtin_amdgcn_mfma_f32_16x16x4f32(a0, b, acc0, 0, 0, 0);
            acc1 = __builtin_amdgcn_mfma_f32_16x16x4f32(a1, b, acc1, 0, 0, 0);
        }
        unsigned char* drow = (unsigned char*)dst + (size_t)(h * 128 + 16 * wid + l15) * 1024 + k0 + 4 * dq;
        *(unsigned*)drow = pk4_i8(acc0[0], acc0[1], acc0[2], acc0[3], WQ_GU);
        *(unsigned*)(drow + 16) = pk4_i8(acc1[0], acc1[1], acc1[2], acc1[3], WQ_GU);
    }
}
__device__ __forceinline__ void prep_fold_out(const float* w_out  , const float* w_uv  , bf16_t* dst  , LAS float* lds, int vb, int nvb) {
    LAS float* A = lds; LAS float* B = lds + 64 * 33;
    const int tid = otid(), lane = tid & 63, wid = __builtin_amdgcn_readfirstlane(tid >> 6), l15 = lane & 15, dq = lane >> 4;
    for (int item = vb; item < 256; item += nvb) {
        const int h = item >> 5, n0 = (item & 31) * 32;
        __syncthreads();
        for (int i = tid; i < 2048; i += NTHREADS) { const int d = i >> 5, nn = i & 31; A[d * 33 + nn] = w_out[(size_t)(h * 64 + d) * 1024 + n0 + nn]; }
        for (int i = tid; i < 8192; i += NTHREADS) { const int c = i >> 6, d = i & 63; B[c * 65 + d] = w_uv[(size_t)(h * 128 + c) * 64 + d]; }
        __syncthreads();
        f32x4 acc0 = (f32x4){0.f, 0.f, 0.f, 0.f}, acc1 = acc0;
#pragma unroll 4
        for (int d0 = 0; d0 < 64; d0 += 4) {
            const float a = B[(16 * wid + l15) * 65 + d0 + dq], b0 = A[(d0 + dq) * 33 + l15], b1 = A[(d0 + dq) * 33 + 16 + l15];
            acc0 = __builtin_amdgcn_mfma_f32_16x16x4f32(a, b0, acc0, 0, 0, 0);
            acc1 = __builtin_amdgcn_mfma_f32_16x16x4f32(a, b1, acc1, 0, 0, 0);
        }
        { u32x2 w; w.x = pk2(acc0[0], acc0[1]); w.y = pk2(acc0[2], acc0[3]); *(u32x2*)(dst + (size_t)(n0 + l15) * KOUT + h * 128 + 16 * wid + 4 * dq) = w; }
        { u32x2 w; w.x = pk2(acc1[0], acc1[1]); w.y = pk2(acc1[2], acc1[3]); *(u32x2*)(dst + (size_t)(n0 + 16 + l15) * KOUT + h * 128 + 16 * wid + 4 * dq) = w; }
    }
}
__device__ __forceinline__ void prep_lb(const float* hgrn_lb  , float* lb, int vb, int nvb) {
    for (int i = vb * NTHREADS + threadIdx.x; i < 512; i += nvb * NTHREADS) {
        const float a = hgrn_lb[i], b = hgrn_lb[512 + i], c = hgrn_lb[1024 + i], m = fmaxf(a, fmaxf(b, c));
        const float ea = __expf(a - m), eb = __expf(b - m), ec = __expf(c - m);
        lb[i] = ea / (ea + eb + ec);
    }
}

__device__ __forceinline__ void rmsnorm_rows(const float* X, unsigned char* Y8, int nrows, int vb, int nvb) {
    const int tid = otid(), lane = tid & 63, gw = vb * NWAVES + __builtin_amdgcn_readfirstlane(tid >> 6), ngw = nvb * NWAVES;
    for (int r = gw; r < nrows; r += ngw) {
        const f32x4* xr = (const f32x4*)(X + (size_t)r * D) + lane;
        f32x4 v[4]; float s = 0.f;
#pragma unroll
        for (int j = 0; j < 4; ++j) { v[j] = xr[64 * j]; s += (v[j].x * v[j].x + v[j].y * v[j].y) + (v[j].z * v[j].z + v[j].w * v[j].w); }
        const float rs = rsqrtf(wave_sum(s) * (1.f / D) + EPS) * HQ_X;
        unsigned* o = (unsigned*)(Y8 + (size_t)r * D) + lane;
#pragma unroll
        for (int j = 0; j < 4; ++j) o[64 * j] = pk4_i8(v[j].x, v[j].y, v[j].z, v[j].w, rs);
    }
}
__device__ __forceinline__ void x_to_h_rows(const float* X, bf16_t* H, unsigned char* X8, float* ssq, int vb, int nvb) {
    const int tid = otid(), lane = tid & 63, gw = vb * NWAVES + __builtin_amdgcn_readfirstlane(tid >> 6), ngw = nvb * NWAVES;
    for (int r = gw; r < T; r += 2 * ngw) {
        const int r2 = (r + ngw < T) ? r + ngw : r;
        f32x4 v[2][4];
#pragma unroll
        for (int j = 0; j < 4; ++j) { v[0][j] = __builtin_nontemporal_load((const f32x4*)(X + (size_t)r * D) + lane + 64 * j); v[1][j] = __builtin_nontemporal_load((const f32x4*)(X + (size_t)r2 * D) + lane + 64 * j); }
#pragma unroll
        for (int q = 0; q < 2; ++q) {
            const int rr = q ? r2 : r;
            u32x2* o = (u32x2*)(H + (size_t)rr * D) + lane;
            float s = 0.f;
#pragma unroll
            for (int j = 0; j < 4; ++j) { const f32x4 x = v[q][j]; u32x2 w; w.x = pk2(x.x, x.y); w.y = pk2(x.z, x.w); o[64 * j] = w;
                *((unsigned*)(X8 + (size_t)rr * D) + lane + 64 * j) = pk4_i8(x.x, x.y, x.z, x.w, HQ_X);
                const float a = bf2f((unsigned short)(w.x & 0xffffu)), b = bf2f((unsigned short)(w.x >> 16)), c = bf2f((unsigned short)(w.y & 0xffffu)), d = bf2f((unsigned short)(w.y >> 16));
                s += (a * a + b * b) + (c * c + d * d); }
            s = wave_sum(s);
            if (lane < 16) ssq[(size_t)rr * 16 + lane] = lane == 0 ? s : 0.f;
        }
    }
}
__device__ __forceinline__ void final_rows(const bf16_t* H, const float* ssq, const float* g, float* out, int vb, int nvb) {
    const int tid = otid(), lane = tid & 63, gw = vb * NWAVES + __builtin_amdgcn_readfirstlane(tid >> 6), ngw = nvb * NWAVES;
    f32x4 gg[4];
#pragma unroll
    for (int j = 0; j < 4; ++j) gg[j] = *((const f32x4*)g + lane + 64 * j);
    for (int r = gw; r < T; r += 2 * ngw) {
        const int r2 = (r + ngw < T) ? r + ngw : r;
        u32x2 w[2][4]; float rs[2];
#pragma unroll
        for (int j = 0; j < 4; ++j) { w[0][j] = ((const u32x2*)(H + (size_t)r * D) + lane)[64 * j]; w[1][j] = ((const u32x2*)(H + (size_t)r2 * D) + lane)[64 * j]; }
        rs[0] = row_rstd(ssq, (size_t)r); rs[1] = row_rstd(ssq, (size_t)r2);
#pragma unroll
        for (int q = 0; q < 2; ++q) {
            f32x4* o = (f32x4*)(out + (size_t)(q ? r2 : r) * D) + lane;
#pragma unroll
            for (int j = 0; j < 4; ++j) { const u32x2 ww = w[q][j];
                __builtin_nontemporal_store((f32x4){bf2f((unsigned short)(ww.x & 0xffffu)) * rs[q] * gg[j].x, bf2f((unsigned short)(ww.x >> 16)) * rs[q] * gg[j].y, bf2f((unsigned short)(ww.y & 0xffffu)) * rs[q] * gg[j].z, bf2f((unsigned short)(ww.y >> 16)) * rs[q] * gg[j].w}, o + 64 * j); }
        }
    }
}
__device__ __forceinline__ float row16_sum(float v) {
    v += __uint_as_float((unsigned)__builtin_amdgcn_update_dpp(0, (int)__float_as_uint(v), 0x128, 0xf, 0xf, false));
    v += __uint_as_float((unsigned)__builtin_amdgcn_update_dpp(0, (int)__float_as_uint(v), 0x124, 0xf, 0xf, false));
    v += __uint_as_float((unsigned)__builtin_amdgcn_update_dpp(0, (int)__float_as_uint(v), 0x122, 0xf, 0xf, false));
    v += __uint_as_float((unsigned)__builtin_amdgcn_update_dpp(0, (int)__float_as_uint(v), 0x121, 0xf, 0xf, false));
    return v;
}
__device__ __forceinline__ void cnorm_rows(const bf16_t* P, const float* lat_g, bf16_t* CN, int vb, int nvb) {
    const int tid = otid(), lane = tid & 63, gw = vb * NWAVES + __builtin_amdgcn_readfirstlane(tid >> 6), ngw = nvb * NWAVES, r4 = lane >> 4, l16 = lane & 15;
    const f32x4 ga = *(const f32x4*)(lat_g + l16 * 8), gb = *(const f32x4*)(lat_g + l16 * 8 + 4);
    for (int r = gw * 8; r < T; r += ngw * 8) {
        u32x4 w[2];
#pragma unroll
        for (int q = 0; q < 2; ++q) w[q] = *(const u32x4*)(P + (size_t)(r + 4 * q + r4) * PW + P_C + l16 * 8);
#pragma unroll
        for (int q = 0; q < 2; ++q) {
            const float x0 = bf2f((unsigned short)(w[q].x & 0xffffu)), x1 = bf2f((unsigned short)(w[q].x >> 16)), x2 = bf2f((unsigned short)(w[q].y & 0xffffu)), x3 = bf2f((unsigned short)(w[q].y >> 16));
            const float x4 = bf2f((unsigned short)(w[q].z & 0xffffu)), x5 = bf2f((unsigned short)(w[q].z >> 16)), x6 = bf2f((unsigned short)(w[q].w & 0xffffu)), x7 = bf2f((unsigned short)(w[q].w >> 16));
            const float ss = row16_sum(((x0 * x0 + x1 * x1) + (x2 * x2 + x3 * x3)) + ((x4 * x4 + x5 * x5) + (x6 * x6 + x7 * x7)));
            const float rs = rsqrtf(ss * (1.f / 128.f) + EPS);
            u32x4 o; o.x = pk2(x0 * rs * ga.x, x1 * rs * ga.y); o.y = pk2(x2 * rs * ga.z, x3 * rs * ga.w); o.z = pk2(x4 * rs * gb.x, x5 * rs * gb.y); o.w = pk2(x6 * rs * gb.z, x7 * rs * gb.w);
            *(u32x4*)(CN + (size_t)(r + 4 * q + r4) * 128 + l16 * 8) = o;
        }
    }
}
__device__ __forceinline__ int t5_bucket(int rel) {
    const int n = rel < 0 ? -rel : rel;
    int b = n < 8 ? n : 8 + (n >= 12) + (n >= 16) + (n >= 23) + (n >= 32) + (n >= 46) + (n >= 64) + (n >= 91);
    return b + (rel > 0 ? 16 : 0);
}
__device__ __forceinline__ unsigned sort_key(float x) { const unsigned u = __float_as_uint(x); return (u & 0x80000000u) ? ~u : (u | 0x80000000u); }


template <int CTRL, int ROWMASK> __device__ __forceinline__ unsigned dpp0(unsigned v) { return (unsigned)__builtin_amdgcn_update_dpp(0, (int)v, CTRL, ROWMASK, 0xf, false); }
__device__ __forceinline__ unsigned wave_prefix_incl(unsigned v) {
    v += dpp0<0x111, 0xf>(v); v += dpp0<0x112, 0xf>(v); v += dpp0<0x114, 0xf>(v); v += dpp0<0x118, 0xf>(v);
    v += dpp0<0x142, 0xa>(v);
    v += dpp0<0x143, 0xc>(v);
    return v;
}
__device__ __forceinline__ float wave_max_u(float v) {
    v = fmaxf(v, __uint_as_float((unsigned)__builtin_amdgcn_update_dpp(0, (int)__float_as_uint(v), 0x128, 0xf, 0xf, false)));
    v = fmaxf(v, __uint_as_float((unsigned)__builtin_amdgcn_update_dpp(0, (int)__float_as_uint(v), 0x124, 0xf, 0xf, false)));
    v = fmaxf(v, __uint_as_float((unsigned)__builtin_amdgcn_update_dpp(0, (int)__float_as_uint(v), 0x122, 0xf, 0xf, false)));
    v = fmaxf(v, __uint_as_float((unsigned)__builtin_amdgcn_update_dpp(0, (int)__float_as_uint(v), 0x121, 0xf, 0xf, false)));
    const int b = (int)__float_as_uint(v);
    return fmaxf(fmaxf(__uint_as_float((unsigned)__builtin_amdgcn_readlane(b, 0)), __uint_as_float((unsigned)__builtin_amdgcn_readlane(b, 16))),
                 fmaxf(__uint_as_float((unsigned)__builtin_amdgcn_readlane(b, 32)), __uint_as_float((unsigned)__builtin_amdgcn_readlane(b, 48))));
}

typedef short v4i16_t __attribute__((ext_vector_type(4)));
constexpr int DSA_BT_OFF = 131072 + 256, DSA_WS_OFF = DSA_BT_OFF + 6144;
__device__ __forceinline__ unsigned dsa_bucket(float x, float lo, float sc) { const float f = (x - lo) * sc; const unsigned b = (unsigned)f; return b > 255u ? 255u : b; }
__device__ __forceinline__ unsigned off_b(unsigned row, unsigned ch) { return 256u * row + 16u * (ch ^ (((row & 3) << 2) | ((row >> 2) & 3))); }
__device__ __forceinline__ void dsa_mfma_phase(const bf16_t* P, const bf16_t* CN, const float* rel_bias, bf16_t* CAT, LAS unsigned char* lds, unsigned* qctr) {
    const int tid = otid(), lane = tid & 63, wid = __builtin_amdgcn_readfirstlane(tid >> 6);
    LAS float* BT = (LAS float*)(lds + DSA_BT_OFF);
    __syncthreads();
    for (int i = tid; i < 191 * 8; i += NTHREADS) { const int rel = (i >> 3) - 127; BT[i] = rel_bias[t5_bucket(rel) * 8 + (i & 7)]; }
    const unsigned long long lt_mask = (lane == 0) ? 0ull : (~0ull >> (64 - lane));
    volatile LAS int* qslot = (volatile LAS int*)(lds + 131072 + 64);
    int nxt = 0;
    if (tid == 0) { *qslot = (int)atomicAdd(qctr, 1u); nxt = (int)atomicAdd(qctr, 1u); }
    for (;;) {
        __syncthreads();
        const int u = *qslot;
        if (u >= T / 16) break;
        const int b = u & 15, qg = 127 - (u >> 4), t0 = qg * 16, nj = t0 / CHUNK + 1, L = nj * CHUNK, nt = L / 32;
        const bf16_t* Pb = P + (size_t)b * SEQ * PW;
        {
            int ln1 = lane; asm volatile("" : "+v"(ln1));
            const int rho = ln1 & 31, hf = ln1 >> 5;
            const int qq = 2 * ((rho >> 2) & 1) + (rho >> 4), hh = 4 * ((rho >> 3) & 1) + (rho & 3);
            bf16x8 qa[4][4], wa[4], wc[4];
#pragma unroll
            for (int qd = 0; qd < 4; ++qd) {
                const bf16_t* qrow = Pb + (size_t)(t0 + 4 * qd + qq) * PW + P_QI + hh * 64 + 8 * hf;
#pragma unroll
                for (int ks = 0; ks < 4; ++ks) qa[qd][ks] = *(const bf16x8*)(qrow + ks * 16);
                wa[qd] = *(const bf16x8*)(Pb + (size_t)(t0 + 4 * qd + 2 * hf) * PW + P_WI); wc[qd] = *(const bf16x8*)(Pb + (size_t)(t0 + 4 * qd + 2 * hf + 1) * PW + P_WI);
            }
            LAS float* sc0 = (LAS float*)lds + (2 * hf) * 2048 + rho;
            const bf16_t* kbase = Pb + (size_t)rho * PW + P_KI + 8 * hf;
            bf16x8 kb[4], kn[4];
#pragma unroll
            for (int ks = 0; ks < 4; ++ks) { kb[ks] = (bf16x8){0, 0, 0, 0, 0, 0, 0, 0}; kn[ks] = kb[ks]; }
            if (wid < nt) {
#pragma unroll
                for (int ks = 0; ks < 4; ++ks) kb[ks] = *(const bf16x8*)(kbase + (size_t)wid * 32 * PW + ks * 16);
            }
            for (int kt = wid; kt < nt; kt += 8) {
                if (kt + 8 < nt) {
#pragma unroll
                    for (int ks = 0; ks < 4; ++ks) kn[ks] = *(const bf16x8*)(kbase + (size_t)(kt + 8) * 32 * PW + ks * 16);
                }
#pragma unroll
                for (int qd = 0; qd < 4; ++qd) {
                    f32x16 acc;
#pragma unroll
                    for (int r = 0; r < 16; ++r) acc[r] = 0.f;
#pragma unroll
                    for (int ks = 0; ks < 4; ++ks) acc = __builtin_amdgcn_mfma_f32_32x32x16_bf16(qa[qd][ks], kb[ks], acc, 0, 0, 0);
                    float s0 = 0.f, s1 = 0.f;
#pragma unroll
                    for (int e = 0; e < 8; ++e) { s0 += bf2f((unsigned short)wa[qd][e]) * fmaxf(acc[e], 0.f); s1 += bf2f((unsigned short)wc[qd][e]) * fmaxf(acc[8 + e], 0.f); }
                    sc0[(4 * qd) * 2048 + kt * 32] = s0 * (0.35355339059327373f * 0.125f); sc0[(4 * qd + 1) * 2048 + kt * 32] = s1 * (0.35355339059327373f * 0.125f);
                }
#pragma unroll
                for (int ks = 0; ks < 4; ++ks) kb[ks] = kn[ks];
            }
        }
        __syncthreads();
        if (tid == 0) { *qslot = nxt; nxt = (int)atomicAdd(qctr, 1u); }
        LAS unsigned char* pair = lds + wid * 16384;
        LAS unsigned char* wsc = lds + DSA_WS_OFF + wid * 2560;
        LAS unsigned* HIST = (LAS unsigned*)wsc; LAS float* CANDV = (LAS float*)(wsc + 1024); LAS unsigned* CANDI = (LAS unsigned*)(wsc + 1280);
        const int nsel = L < 256 ? L : 256;
        int lna = lane; asm volatile("" : "+v"(lna));
#pragma unroll 1
        for (int e2 = 0; e2 < 2; ++e2) {
            LAS unsigned short* IDX = (LAS unsigned short*)(wsc + 1536 + e2 * 512);
            if (nj > 4) {
                const LAS float* SCq = (const LAS float*)(pair + e2 * 8192);
                float x[32];
#pragma unroll
                for (int j = 0; j < 32; ++j) x[j] = (j < nj) ? SCq[j * 64 + lna] : 0.f;
                float lo = INFINITY, hi = -INFINITY;
#pragma unroll
                for (int j = 0; j < 32; ++j) if (j < nj) { hi = fmaxf(hi, x[j]); lo = fminf(lo, x[j]); }
                hi = wave_max_u(hi); lo = -wave_max_u(-lo);
                bool done = false;
                if (hi > lo) {
                    const float sc = 256.f / (hi - lo);
                    *(LAS u32x4*)(HIST + 4 * lna) = (u32x4){0u, 0u, 0u, 0u};
                    WAVE_LDS_SYNC();
#pragma unroll
                    for (int j = 0; j < 32; ++j) if (j < nj) { const unsigned bk = dsa_bucket(x[j], lo, sc); __hip_atomic_fetch_add(HIST + bk, 1u, __ATOMIC_RELAXED, __HIP_MEMORY_SCOPE_WORKGROUP); }
                    WAVE_LDS_SYNC();
                    const u32x4 h4 = *(const LAS u32x4*)(HIST + 4 * lna);
                    const unsigned cl = (h4.x + h4.y) + (h4.z + h4.w);
                    const unsigned pfx = wave_prefix_incl(cl);
                    const unsigned Sx = (unsigned)__builtin_amdgcn_readlane((int)pfx, 63) - pfx + cl;
                    const int lstar = __popcll(__ballot(Sx >= 256u)) - 1;
                    const unsigned above = Sx - cl, t3 = above + h4.w, t2 = t3 + h4.z, t1 = t2 + h4.y;
                    const unsigned bl = t3 >= 256u ? 3u : (t2 >= 256u ? 2u : (t1 >= 256u ? 1u : 0u));
                    const unsigned al = bl == 3u ? above : (bl == 2u ? t3 : (bl == 1u ? t2 : t1));
                    const unsigned ml = bl == 3u ? h4.w : (bl == 2u ? h4.z : (bl == 1u ? h4.y : h4.x));
                    const unsigned bstar = (unsigned)__builtin_amdgcn_readlane((int)(4u * lna + bl), lstar);
                    const int a = __builtin_amdgcn_readlane((int)al, lstar), m = __builtin_amdgcn_readlane((int)ml, lstar);
                    if (m <= 64) {
                        done = true;
                        const int need = 256 - a;
                        unsigned msel = 0u, mcand = 0u;
#pragma unroll
                        for (int j = 31; j >= 0; --j) if (j < nj) { const unsigned bk = dsa_bucket(x[j], lo, sc); msel = msel + msel + (bk > bstar ? 1u : 0u); mcand = mcand + mcand + (bk == bstar ? 1u : 0u); }
                        const unsigned pk = (unsigned)__popc(msel) | ((unsigned)__popc(mcand) << 16);
                        const unsigned inc = wave_prefix_incl(pk);
                        unsigned off = (inc - pk) & 0xffffu, coff = (inc - pk) >> 16;
                        while (msel) { const int j = __ffs((int)msel) - 1; msel &= msel - 1u; IDX[off++] = (unsigned short)(j * 64 + lna); }
                        while (mcand) { const int j = __ffs((int)mcand) - 1; mcand &= mcand - 1u; CANDV[coff] = SCq[j * 64 + lna]; CANDI[coff] = (unsigned)(j * 64 + lna); ++coff; }
                        WAVE_LDS_SYNC();
                        const float cv = CANDV[lna < m ? lna : 0]; const unsigned ci = CANDI[lna < m ? lna : 0];
                        int rank = 0;
                        for (int k = 0; k < m; ++k) { const float v = __uint_as_float((unsigned)__builtin_amdgcn_readlane((int)__float_as_uint(cv), k)); const unsigned id = (unsigned)__builtin_amdgcn_readlane((int)ci, k); rank += (v > cv || (v == cv && id < ci)) ? 1 : 0; }
                        if (lna < m && rank < need) IDX[a + rank] = (unsigned short)ci;
                    }
                }
                if (!done) {
                    unsigned lo_k = 0xffffffffu, hi_k = 0u;
#pragma unroll
                    for (int j = 0; j < 32; ++j) if (j < nj) { const unsigned kx = sort_key(x[j]); hi_k = kx > hi_k ? kx : hi_k; lo_k = kx < lo_k ? kx : lo_k; }
#pragma unroll
                    for (int o = 1; o < 64; o <<= 1) { const unsigned h2 = (unsigned)__shfl_xor((int)hi_k, o), l2 = (unsigned)__shfl_xor((int)lo_k, o); hi_k = h2 > hi_k ? h2 : hi_k; lo_k = l2 < lo_k ? l2 : lo_k; }
                    lo_k = (unsigned)__builtin_amdgcn_readfirstlane((int)lo_k); hi_k = (unsigned)__builtin_amdgcn_readfirstlane((int)hi_k);
                    bool exact = false;
                    while (lo_k < hi_k) {
                        const unsigned mid = lo_k + ((hi_k - lo_k + 1u) >> 1);
                        int cnt = 0;
#pragma unroll
                        for (int j = 0; j < 32; ++j) cnt += __popcll(__ballot(j < nj && sort_key(x[j]) >= mid));
                        if (cnt == 256) { lo_k = mid; exact = true; break; }
                        if (cnt > 256) lo_k = mid; else hi_k = mid - 1u;
                    }
                    const unsigned Tv = lo_k;
                    int need = 0;
                    if (!exact) { int cgt = 0;
#pragma unroll
                        for (int j = 0; j < 32; ++j) cgt += __popcll(__ballot(j < nj && sort_key(x[j]) > Tv));
                        need = 256 - cgt; }
                    int base = 0, eqt = 0;
#pragma unroll
                    for (int j = 0; j < 32; ++j) {
                        const unsigned kx = sort_key(x[j]);
                        const bool gt = (j < nj) && (exact ? (kx >= Tv) : (kx > Tv)), eq = (j < nj) && !exact && (kx == Tv);
                        const unsigned long long meq = __ballot(eq);
                        const bool sel = gt || (eq && (eqt + __popcll(meq & lt_mask)) < need);
                        const unsigned long long ms = __ballot(sel);
                        if (sel) IDX[base + __popcll(ms & lt_mask)] = (unsigned short)(j * 64 + lna);
                        base += __popcll(ms); eqt += __popcll(meq);
                    }
                }
            } else {
#pragma unroll
                for (int i = 0; i < 4; ++i) IDX[i * 64 + lna] = (unsigned short)(i * 64 + lna);
            }
        }
        WAVE_LDS_SYNC();
        {
            int lnb = lane; asm volatile("" : "+v"(lnb));
            const int head = lnb & 15, kg = lnb >> 4, nblk = nsel >> 5;
            LAS unsigned char* GB = pair;
            const bf16_t* CNb = CN + (size_t)b * SEQ * 128;
            const int rho = lnb & 15;
            const unsigned rw0 = 8 * (rho >> 2) + (rho & 3), rw1 = rw0 + 4;
            const unsigned xa0 = ((rw0 & 3) << 2) | ((rw0 >> 2) & 3), xa1 = ((rw1 & 3) << 2) | ((rw1 >> 2) & 3);
            const unsigned q4 = (lnb & 15) >> 2, p4 = lnb & 3;
            u32x4 gA[8], gB[8];
#define DSA_GATHER(G, IX, blk) do { _Pragma("unroll") for (int it = 0; it < 8; ++it) { const int sp = (IX)[(blk) * 32 + (lnb >> 4) + 4 * it]; G[it] = *(const u32x4*)(CNb + (size_t)sp * 128 + (lnb & 15) * 8); } } while (0)
            { const LAS unsigned short* IDX0 = (const LAS unsigned short*)(wsc + 1536); DSA_GATHER(gA, IDX0, 0); DSA_GATHER(gB, IDX0, 1); }
#pragma unroll 1
            for (int e2 = 0; e2 < 2; ++e2) {
                const int t = t0 + 2 * wid + e2;
                const size_t row = (size_t)b * SEQ + t;
                const LAS unsigned short* IDX = (const LAS unsigned short*)(wsc + 1536 + e2 * 512);
                bf16x8 qlf[4];
#pragma unroll
                for (int s4 = 0; s4 < 4; ++s4) { qlf[s4] = *(const bf16x8*)(P + row * PW + P_QL + (head & 7) * 128 + s4 * 32 + 8 * kg); if (head >= 8) qlf[s4] = (bf16x8){0, 0, 0, 0, 0, 0, 0, 0}; }
                f32x4 o[8];
#pragma unroll
                for (int ct = 0; ct < 8; ++ct) o[ct] = (f32x4){0.f, 0.f, 0.f, 0.f};
                float m = -INFINITY, lsum = 0.f;
#define DSA_STEP(G, kbx) do { \
                    WAVE_LDS_SYNC();                              \
                    _Pragma("unroll") for (int it = 0; it < 8; ++it) *(LAS u32x4*)(GB + off_b((lnb >> 4) + 4 * it, lnb & 15)) = G[it]; \
                    const bf16x8 iv = *(const LAS bf16x8*)((const LAS unsigned char*)IDX + ((kbx) * 32 + 8 * kg) * 2);     \
                    if ((kbx) + 2 < nblk) DSA_GATHER(G, IDX, (kbx) + 2); else if (e2 == 0) DSA_GATHER(G, IDX + 256, (kbx) + 2 - nblk); \
                    WAVE_LDS_SYNC(); \
                      \
                    bf16x8 k0[4], k1[4], af[8]; \
                    _Pragma("unroll") for (int s4 = 0; s4 < 4; ++s4) { \
                        k0[s4] = *(const LAS bf16x8*)(GB + 256u * rw0 + 16u * ((4 * s4 + kg) ^ xa0)); \
                        k1[s4] = *(const LAS bf16x8*)(GB + 256u * rw1 + 16u * ((4 * s4 + kg) ^ xa1)); } \
                    float bia[8]; \
                    _Pragma("unroll") for (int e = 0; e < 8; ++e) { const int sp = (int)(unsigned short)iv[e]; int rel = sp - t; rel = rel < -127 ? -127 : rel; bia[e] = BT[(rel + 127) * 8 + (head & 7)]; } \
                      \
                    f32x4 a0 = (f32x4){0.f, 0.f, 0.f, 0.f}, a1 = (f32x4){0.f, 0.f, 0.f, 0.f}; \
                    _Pragma("unroll") for (int s4 = 0; s4 < 4; ++s4) { \
                        a0 = __builtin_amdgcn_mfma_f32_16x16x32_bf16(k0[s4], qlf[s4], a0, 0, 0, 0); \
                        a1 = __builtin_amdgcn_mfma_f32_16x16x32_bf16(k1[s4], qlf[s4], a1, 0, 0, 0); } \
                    asm volatile("" : "+v"(a0), "+v"(a1));        \
                    _Pragma("unroll") for (int ct = 0; ct < 8; ++ct) {              \
                        const v4i16_t lo4 = __builtin_amdgcn_ds_read_tr16_b64_v4i16((LAS v4i16_t*)(GB + off_b(8 * kg + q4, 2 * ct + (p4 >> 1)) + 8 * (p4 & 1))); \
                        const v4i16_t hi4 = __builtin_amdgcn_ds_read_tr16_b64_v4i16((LAS v4i16_t*)(GB + off_b(8 * kg + 4 + q4, 2 * ct + (p4 >> 1)) + 8 * (p4 & 1))); \
                        af[ct] = (bf16x8){lo4[0], lo4[1], lo4[2], lo4[3], hi4[0], hi4[1], hi4[2], hi4[3]}; } \
                      \
                    float lg[8]; \
                    _Pragma("unroll") for (int e = 0; e < 8; ++e) lg[e] = (e < 4 ? a0[e] : a1[e - 4]) * 0.125f + bia[e]; \
                    const float mloc = fmaxf(fmaxf(fmaxf(lg[0], lg[1]), fmaxf(lg[2], lg[3])), fmaxf(fmaxf(lg[4], lg[5]), fmaxf(lg[6], lg[7]))); \
                      \
                    float scl = 1.f; \
                    if (__any(mloc > m + 16.f)) { \
                        float mb = fmaxf(mloc, __shfl_xor(mloc, 16)); mb = fmaxf(mb, __shfl_xor(mb, 32)); \
                        const float mn = fmaxf(m, mb); scl = __expf(m - mn); m = mn; \
                        _Pragma("unroll") for (int ct = 0; ct < 8; ++ct) o[ct] = o[ct] * scl; } \
                    float ps = 0.f; float pe[8]; \
                    _Pragma("unroll") for (int e = 0; e < 8; ++e) { pe[e] = __expf(lg[e] - m); ps += pe[e]; } \
                    lsum = lsum * scl + ps; \
                    u32x4 pw; pw.x = pk2(pe[0], pe[1]); pw.y = pk2(pe[2], pe[3]); pw.z = pk2(pe[4], pe[5]); pw.w = pk2(pe[6], pe[7]); \
                    const bf16x8 pb = __builtin_bit_cast(bf16x8, pw); \
                    _Pragma("unroll") for (int ct = 0; ct < 8; ++ct) o[ct] = __builtin_amdgcn_mfma_f32_16x16x32_bf16(af[ct], pb, o[ct], 0, 0, 0); \
                } while (0)
#pragma unroll 1
                for (int kb2 = 0; kb2 < nblk; kb2 += 2) { DSA_STEP(gA, kb2); DSA_STEP(gB, kb2 + 1); }
#undef DSA_STEP
                lsum += __shfl_xor(lsum, 16); lsum += __shfl_xor(lsum, 32);
                const float inv = 1.f / lsum;
                if (head < 8) {
                    bf16_t* op = CAT + row * KOUT + head * 128 + 4 * kg;
#pragma unroll
                    for (int ct = 0; ct < 8; ++ct) { u32x2 w; w.x = pk2(o[ct][0] * inv, o[ct][1] * inv); w.y = pk2(o[ct][2] * inv, o[ct][3] * inv); *(u32x2*)(op + ct * 16) = w; }
                }
            }
#undef DSA_GATHER
        }
    }
}

constexpr size_t WS_DEC = 492 * MiB;
__device__ __forceinline__ void hgrn_prep(bf16_t* P, const float* lb, float* DEC, LAS unsigned char* lds, int vb, int nvb) {
    const int tid = otid(), cl = tid >> 7, d = tid & 127;
    LAS bf16_t* Ft = (LAS bf16_t*)lds; LAS bf16_t* Qt = (LAS bf16_t*)(lds + 65536);
    for (int it = vb; it < BATCH * 4 * 8; it += nvb) {
        const int b = it >> 5, h = (it >> 3) & 3, cg = it & 7;
        bf16_t* base = P + ((size_t)b * SEQ + cg * 256) * PW + h * 128;
        u32x4 v[16];
#pragma unroll
        for (int k = 0; k < 16; ++k) { const int i = tid + 512 * k, tl = i >> 12, r = (i >> 4) & 255, ch = i & 15; v[k] = *(const u32x4*)(base + (size_t)r * PW + (tl ? P_QB : P_FB) + ch * 8); }
        __syncthreads();
#pragma unroll
        for (int k = 0; k < 16; ++k) { const int i = tid + 512 * k, tl = i >> 12, r = (i >> 4) & 255, ch = i & 15; *(LAS u32x4*)(lds + tl * 65536 + r * 256 + ch * 16) = v[k]; }
        __syncthreads();
        {
            const float l = lb[h * 128 + d];
            LAS bf16_t* fcol = Ft + (cl * 64) * 128 + d; LAS bf16_t* qcol = Qt + (cl * 64) * 128 + d;
            float up = 1.f;
#pragma unroll 8
            for (int t = 32; t < 64; ++t) {
                const float f = l + (1.f - l) * sigmoid_f(bf2f(fcol[t * 128]));
                up *= f;
                const float q = silu_f(bf2f(qcol[t * 128]));
                qcol[t * 128] = (bf16_t)f2bf(q * up);
                fcol[t * 128] = (bf16_t)f2bf((1.f - f) * __builtin_amdgcn_rcpf(up));
            }
            float dn = 1.f;
#pragma unroll 8
            for (int t = 31; t >= 0; --t) {
                const float f = l + (1.f - l) * sigmoid_f(bf2f(fcol[t * 128]));
                const float q = silu_f(bf2f(qcol[t * 128]));
                qcol[t * 128] = (bf16_t)f2bf(q * __builtin_amdgcn_rcpf(dn));
                fcol[t * 128] = (bf16_t)f2bf((1.f - f) * dn);
                dn *= f;
            }
            float* dc = DEC + ((size_t)((b * 4 + h) * 32 + cg * 4 + cl) * 3) * 128 + d;
            dc[0] = dn; dc[128] = dn * up; dc[256] = up;
        }
        __syncthreads();
#pragma unroll
        for (int k = 0; k < 16; ++k) { const int i = tid + 512 * k, tl = i >> 12, r = (i >> 4) & 255, ch = i & 15; *(u32x4*)(base + (size_t)r * PW + (tl ? P_QB : P_FB) + ch * 8) = *(const LAS u32x4*)(lds + tl * 65536 + r * 256 + ch * 16); }
    }
}

__device__ __forceinline__ void hgrn_scan(const bf16_t* P, const float* DEC, const float* o_g, bf16_t* CAT, LAS unsigned char* lds, int item) {
    const int tid = otid(), lane = tid & 63, wid = __builtin_amdgcn_readfirstlane(tid >> 6), li = lane & 15, kg = lane >> 4;
    const int b = item >> 2, h = item & 3, it = wid >> 1, vh = wid & 1;
    LAS unsigned char* ST = lds + 98304;
    LAS float* SSQ = (LAS float*)(lds + DSA_BT_OFF);
    const bf16_t* Pb = P + (size_t)b * SEQ * PW;
    const float* DECb = DEC + (size_t)((b * 4 + h) * 32) * 384;
    f32x4 S[8];
#pragma unroll
    for (int vt = 0; vt < 8; ++vt) S[vt] = (f32x4){0.f, 0.f, 0.f, 0.f};
    u32x4 sg[6];
    const int colbase[3] = {P_QB, P_FB, P_IB};
#define HG_LOAD(c) do { _Pragma("unroll") for (int k = 0; k < 6; ++k) { const int n = tid + 512 * k, tl = n >> 10, r = (n >> 4) & 63, ch = n & 15; \
        sg[k] = *(const u32x4*)(Pb + (size_t)((c) * 64 + r) * PW + colbase[tl] + h * 128 + ch * 8); } } while (0)
#define HG_STORE(buf) do { _Pragma("unroll") for (int k = 0; k < 6; ++k) { const int n = tid + 512 * k, tl = n >> 10, r = (n >> 4) & 63, ch = n & 15; \
        *(LAS u32x4*)(lds + (buf) * 49152 + tl * 16384 + off_b(r, ch)) = sg[k]; } } while (0)
    HG_LOAD(0);
    __syncthreads();
    HG_STORE(0);
    const unsigned q4 = (lane & 15) >> 2, p4 = lane & 3;
    f32x4 ogv[4];
#pragma unroll
    for (int vv = 0; vv < 4; ++vv) ogv[vv] = *(const f32x4*)(o_g + 16 * (4 * vh + vv) + 4 * kg);
    float er_next = DECb[16 * wid + li];
#pragma unroll 1
    for (int c = 0; c < 32; ++c) {
        const int buf = c & 1;
        LAS unsigned char* QI = lds + buf * 49152; LAS unsigned char* KI = QI + 16384; LAS unsigned char* VI = QI + 32768;
        if (c + 1 < 32) HG_LOAD(c + 1);
        const float er = er_next, e63 = DECb[c * 384 + 128 + 16 * wid + li], e6r = DECb[c * 384 + 256 + 16 * wid + li];
        er_next = DECb[(c + 1 < 32 ? c + 1 : c) * 384 + 16 * wid + li];
        u32x2 gwv[4];
#pragma unroll
        for (int vv = 0; vv < 4; ++vv) gwv[vv] = *(const u32x2*)(P + ((size_t)b * SEQ + c * 64 + 16 * it + li) * PW + P_GB + h * 128 + 16 * (4 * vh + vv) + 4 * kg);
        { const unsigned d = 16 * wid + li;
#pragma unroll
          for (int vt = 0; vt < 8; ++vt) { u32x2 w; w.x = pk2(S[vt][0] * er, S[vt][1] * er); w.y = pk2(S[vt][2] * er, S[vt][3] * er);
              *(LAS u32x2*)(ST + off_b(d, 2 * vt + (kg >> 1)) + 8 * (kg & 1)) = w; } }
        __syncthreads();
        bf16x8 qf[4];
#pragma unroll
        for (int ks = 0; ks < 4; ++ks) qf[ks] = *(const LAS bf16x8*)(QI + off_b(16 * it + li, 4 * ks + kg));
        f32x4 o[4];
#pragma unroll
        for (int vv = 0; vv < 4; ++vv) o[vv] = (f32x4){0.f, 0.f, 0.f, 0.f};
#pragma unroll
        for (int ks = 0; ks < 4; ++ks)
#pragma unroll
            for (int vv = 0; vv < 4; ++vv) {
                const int ct = 4 * vh + vv;
                const v4i16_t lo4 = __builtin_amdgcn_ds_read_tr16_b64_v4i16((LAS v4i16_t*)(ST + off_b(32 * ks + 8 * kg + q4, 2 * ct + (p4 >> 1)) + 8 * (p4 & 1)));
                const v4i16_t hi4 = __builtin_amdgcn_ds_read_tr16_b64_v4i16((LAS v4i16_t*)(ST + off_b(32 * ks + 8 * kg + 4 + q4, 2 * ct + (p4 >> 1)) + 8 * (p4 & 1)));
                const bf16x8 af = (bf16x8){lo4[0], lo4[1], lo4[2], lo4[3], hi4[0], hi4[1], hi4[2], hi4[3]};
                o[vv] = __builtin_amdgcn_mfma_f32_16x16x32_bf16(af, qf[ks], o[vv], 0, 0, 0);
            }
        const int njb = (it >> 1) + 1;
#pragma unroll
        for (int jb = 0; jb < 2; ++jb) {
            if (jb < njb) {
                f32x4 a0 = (f32x4){0.f, 0.f, 0.f, 0.f}, a1 = (f32x4){0.f, 0.f, 0.f, 0.f};
                const unsigned rw0 = 32 * jb + 8 * (li >> 2) + (li & 3), rw1 = rw0 + 4;
#pragma unroll
                for (int ks = 0; ks < 4; ++ks) {
                    const bf16x8 k0 = *(const LAS bf16x8*)(KI + off_b(rw0, 4 * ks + kg));
                    const bf16x8 k1 = *(const LAS bf16x8*)(KI + off_b(rw1, 4 * ks + kg));
                    a0 = __builtin_amdgcn_mfma_f32_16x16x32_bf16(k0, qf[ks], a0, 0, 0, 0);
                    a1 = __builtin_amdgcn_mfma_f32_16x16x32_bf16(k1, qf[ks], a1, 0, 0, 0);
                }
                const int ii = 16 * it + li, j0 = 32 * jb + 8 * kg;
                float am[8];
#pragma unroll
                for (int e = 0; e < 8; ++e) am[e] = (j0 + e <= ii) ? (e < 4 ? a0[e] : a1[e - 4]) : 0.f;
                u32x4 pw; pw.x = pk2(am[0], am[1]); pw.y = pk2(am[2], am[3]); pw.z = pk2(am[4], am[5]); pw.w = pk2(am[6], am[7]);
                const bf16x8 pb = __builtin_bit_cast(bf16x8, pw);
#pragma unroll
                for (int vv = 0; vv < 4; ++vv) {
                    const int ct = 4 * vh + vv;
                    const v4i16_t lo4 = __builtin_amdgcn_ds_read_tr16_b64_v4i16((LAS v4i16_t*)(VI + off_b(32 * jb + 8 * kg + q4, 2 * ct + (p4 >> 1)) + 8 * (p4 & 1)));
                    const v4i16_t hi4 = __builtin_amdgcn_ds_read_tr16_b64_v4i16((LAS v4i16_t*)(VI + off_b(32 * jb + 8 * kg + 4 + q4, 2 * ct + (p4 >> 1)) + 8 * (p4 & 1)));
                    const bf16x8 af = (bf16x8){lo4[0], lo4[1], lo4[2], lo4[3], hi4[0], hi4[1], hi4[2], hi4[3]};
                    o[vv] = __builtin_amdgcn_mfma_f32_16x16x32_bf16(af, pb, o[vv], 0, 0, 0);
                }
            }
        }
        {
            f32x4 U[8];
#pragma unroll
            for (int vt = 0; vt < 8; ++vt) U[vt] = (f32x4){0.f, 0.f, 0.f, 0.f};
#pragma unroll
            for (int ks = 0; ks < 2; ++ks) {
                const v4i16_t kl = __builtin_amdgcn_ds_read_tr16_b64_v4i16((LAS v4i16_t*)(KI + off_b(32 * ks + 8 * kg + q4, 2 * wid + (p4 >> 1)) + 8 * (p4 & 1)));
                const v4i16_t kh = __builtin_amdgcn_ds_read_tr16_b64_v4i16((LAS v4i16_t*)(KI + off_b(32 * ks + 8 * kg + 4 + q4, 2 * wid + (p4 >> 1)) + 8 * (p4 & 1)));
                const bf16x8 kfr = (bf16x8){kl[0], kl[1], kl[2], kl[3], kh[0], kh[1], kh[2], kh[3]};
#pragma unroll
                for (int vt = 0; vt < 8; ++vt) {
                    const v4i16_t lo4 = __builtin_amdgcn_ds_read_tr16_b64_v4i16((LAS v4i16_t*)(VI + off_b(32 * ks + 8 * kg + q4, 2 * vt + (p4 >> 1)) + 8 * (p4 & 1)));
                    const v4i16_t hi4 = __builtin_amdgcn_ds_read_tr16_b64_v4i16((LAS v4i16_t*)(VI + off_b(32 * ks + 8 * kg + 4 + q4, 2 * vt + (p4 >> 1)) + 8 * (p4 & 1)));
                    const bf16x8 af = (bf16x8){lo4[0], lo4[1], lo4[2], lo4[3], hi4[0], hi4[1], hi4[2], hi4[3]};
                    U[vt] = __builtin_amdgcn_mfma_f32_16x16x32_bf16(af, kfr, U[vt], 0, 0, 0);
                }
            }
#pragma unroll
            for (int vt = 0; vt < 8; ++vt) S[vt] = S[vt] * e63 + U[vt] * e6r;
        }
        float ss = 0.f;
#pragma unroll
        for (int vv = 0; vv < 4; ++vv) ss += (o[vv][0] * o[vv][0] + o[vv][1] * o[vv][1]) + (o[vv][2] * o[vv][2] + o[vv][3] * o[vv][3]);
        ss += __shfl_xor(ss, 16); ss += __shfl_xor(ss, 32);
        if (kg == 0) SSQ[(it * 2 + vh) * 16 + li] = ss;
        __syncthreads();
        if (c + 1 < 32) HG_STORE(buf ^ 1);
        {
            const float tot = SSQ[(it * 2) * 16 + li] + SSQ[(it * 2 + 1) * 16 + li];
            const float rs = rsqrtf(tot * (1.f / 128.f) + EPS);
            const size_t row = (size_t)b * SEQ + c * 64 + 16 * it + li;
#pragma unroll
            for (int vv = 0; vv < 4; ++vv) {
                const int v0 = 16 * (4 * vh + vv) + 4 * kg;
                const u32x2 gw = gwv[vv];
                const f32x4 og = ogv[vv];
                const float g0 = silu_f(bf2f((unsigned short)(gw.x & 0xffffu))), g1 = silu_f(bf2f((unsigned short)(gw.x >> 16))), g2 = silu_f(bf2f((unsigned short)(gw.y & 0xffffu))), g3 = silu_f(bf2f((unsigned short)(gw.y >> 16)));
                u32x2 w; w.x = pk2(o[vv][0] * rs * og.x * g0, o[vv][1] * rs * og.y * g1); w.y = pk2(o[vv][2] * rs * og.z * g2, o[vv][3] * rs * og.w * g3);
                *(u32x2*)(CAT + row * KOUT + 1024 + h * 128 + v0) = w;
            }
        }
    }
#undef HG_LOAD
#undef HG_STORE
}


__device__ __forceinline__ int swap23(int r) { return (r & ~12) | ((r & 4) << 1) | ((r & 8) >> 1); }
__device__ __forceinline__ void xattn_mfma_phase(const bf16_t* Q, const bf16_t* Kb, const bf16_t* VT, bf16_t* O, LAS unsigned char* lds, int vb, int nvb) {
    const int tid = otid(), lane = tid & 63, wid = __builtin_amdgcn_readfirstlane(tid >> 6), r32 = lane & 31, hf = lane >> 5;
    LAS unsigned char* Ks = lds; LAS unsigned char* Vs = lds + 65536;
    int koff[8], voff[8];
    { const int kr = swap23(r32), x = kr & 15, y = r32 & 15;
#pragma unroll
      for (int ks = 0; ks < 8; ++ks) koff[ks] = kr * 256 + (((ks * 2 + hf) ^ x) << 4);
#pragma unroll
      for (int e = 0; e < 8; ++e) voff[e] = r32 * 512 + (((e * 2 + hf) ^ y) << 4); }
    for (int pair = vb; pair < 256; pair += nvb) {
        const int bh = pair >> 2, b = bh >> 2, h = bh & 3;
        __syncthreads();
        int tio = tid; asm volatile("" : "+v"(tio));
        for (int i = tio; i < 4096; i += NTHREADS) { const int key = i >> 4, ch = i & 15;
            const u32x4 v = *(const u32x4*)(Kb + (size_t)(b * MEMT + key) * 512 + h * 128 + ch * 8);
            *(LAS u32x4*)(Ks + key * 256 + ((ch ^ (key & 15)) << 4)) = v; }
        for (int i = tio; i < 4096; i += NTHREADS) { const int d = i >> 5, ch = i & 31;
            const u32x4 v = *(const u32x4*)(VT + (size_t)(h * 128 + d) * MT + b * MEMT + ch * 8);
            *(LAS u32x4*)(Vs + d * 512 + ((ch ^ (d & 15)) << 4)) = v; }
        __syncthreads();
#pragma unroll 1
        for (int qq = 0; qq < 2; ++qq) {
            const size_t q0 = (size_t)b * SEQ + ((pair & 3) * 2 + qq) * 256 + wid * 32;
            bf16x8 qf[8];
#pragma unroll
            for (int ks = 0; ks < 8; ++ks) qf[ks] = *(const bf16x8*)(Q + (q0 + r32) * 512 + h * 128 + ks * 16 + 8 * hf);
            f32x16 st[8];
            __builtin_amdgcn_s_setprio(1);
#pragma unroll
            for (int kt = 0; kt < 8; ++kt) {
#pragma unroll
                for (int r = 0; r < 16; ++r) st[kt][r] = 0.f;
#pragma unroll
                for (int ks = 0; ks < 8; ++ks) {
                    const bf16x8 a = *(const LAS bf16x8*)(Ks + koff[ks] + kt * 8192);
                    st[kt] = __builtin_amdgcn_mfma_f32_32x32x16_bf16(a, qf[ks], st[kt], 0, 0, 0);
                }
            }
            __builtin_amdgcn_s_setprio(0);
            float mx = -INFINITY;
#pragma unroll
            for (int kt = 0; kt < 8; ++kt)
#pragma unroll
                for (int r = 0; r < 16; ++r) mx = fmaxf(mx, st[kt][r]);
            mx = fmaxf(mx, __shfl_xor(mx, 32));
            const float c = 0.08838834764831845f * 1.4426950408889634f;
            float sum = 0.f;
#pragma unroll
            for (int kt = 0; kt < 8; ++kt)
#pragma unroll
                for (int r = 0; r < 16; ++r) { const float e = __builtin_amdgcn_exp2f((st[kt][r] - mx) * c); st[kt][r] = e; sum += e; }
            sum += __shfl_xor(sum, 32);
            const float inv = 1.f / sum;
            bf16x8 pfr[8][2];
#pragma unroll
            for (int kt = 0; kt < 8; ++kt)
#pragma unroll
                for (int s2 = 0; s2 < 2; ++s2) {
                    u32x4 pw;
                    pw.x = pk2(st[kt][8 * s2 + 0], st[kt][8 * s2 + 1]); pw.y = pk2(st[kt][8 * s2 + 2], st[kt][8 * s2 + 3]);
                    pw.z = pk2(st[kt][8 * s2 + 4], st[kt][8 * s2 + 5]); pw.w = pk2(st[kt][8 * s2 + 6], st[kt][8 * s2 + 7]);
                    pfr[kt][s2] = __builtin_bit_cast(bf16x8, pw);
                }
#pragma unroll
            for (int kt = 0; kt < 8; ++kt) asm volatile("" : "+v"(pfr[kt][0]), "+v"(pfr[kt][1]));
            f32x16 o[4];
#pragma unroll
            for (int dt = 0; dt < 4; ++dt)
#pragma unroll
                for (int r = 0; r < 16; ++r) o[dt][r] = 0.f;
            __builtin_amdgcn_s_setprio(1);
#pragma unroll
            for (int kt = 0; kt < 8; ++kt)
#pragma unroll
                for (int s2 = 0; s2 < 2; ++s2)
#pragma unroll
                    for (int dt = 0; dt < 4; ++dt) {
                        const bf16x8 a = *(const LAS bf16x8*)(Vs + voff[(kt & 3) * 2 + s2] + dt * 16384 + (kt >> 2) * 256);
                        o[dt] = __builtin_amdgcn_mfma_f32_32x32x16_bf16(a, pfr[kt][s2], o[dt], 0, 0, 0);
                    }
            __builtin_amdgcn_s_setprio(0);
            unsigned char* orow = (unsigned char*)O + (q0 + r32) * 512 + h * 128 + 64 * hf;
            const float isc = inv * XO_SC;
#pragma unroll
            for (int dt = 0; dt < 4; ++dt) {
                u32x4 w;
#pragma unroll
                for (int g = 0; g < 4; ++g) w[g] = pk4_f8(o[dt][4 * g] * isc, o[dt][4 * g + 1] * isc, o[dt][4 * g + 2] * isc, o[dt][4 * g + 3] * isc);
                *(u32x4*)(orow + dt * 16) = w;
            }
        }
    }
}


__device__ __forceinline__ void gmlp_mfma_phase(const bf16_t* UV, const float* lnp, const float* ln_g, const float* ln_b, const float* w_sp, const float* b_sp, bf16_t* G, LAS unsigned char* lds, int vb, int nvb) {
    const int tid = otid(), lane = tid & 63, wid = __builtin_amdgcn_readfirstlane(tid >> 6), fr = lane & 15, fq = lane >> 4;
    LAS unsigned char* Wb = lds; LAS unsigned char* VTs = lds + 32768; LAS float* STAT = (LAS float*)(lds + 65536);
    int gcur = -1;
    for (int grp = vb; grp < 256; grp += nvb) {
        const int g = grp >> 5;
        bf16x8 vch[4]; f32x4 lp[2];
#define GM_LOAD(uu_) do { const size_t r0_ = (size_t)((grp & 31) * 8 + (uu_)) * 128; \
            _Pragma("unroll") for (int k = 0; k < 4; ++k) { const int i = tid + 512 * k, sI = i >> 4, ch = i & 15; vch[k] = *(const bf16x8*)(UV + (r0_ + sI) * 2048 + 1024 + g * 128 + ch * 8); } \
            lp[0] = *(const f32x4*)(lnp + (r0_ + (tid >> 2)) * 32 + (tid & 3) * 8); lp[1] = *(const f32x4*)(lnp + (r0_ + (tid >> 2)) * 32 + (tid & 3) * 8 + 4); } while (0)
        GM_LOAD(0);
        const f32x4 g0 = *(const f32x4*)(ln_g + g * 128 + (tid & 15) * 8), g1 = *(const f32x4*)(ln_g + g * 128 + (tid & 15) * 8 + 4);
        const f32x4 b0 = *(const f32x4*)(ln_b + g * 128 + (tid & 15) * 8), b1 = *(const f32x4*)(ln_b + g * 128 + (tid & 15) * 8 + 4);
        const float gg[8] = {g0.x, g0.y, g0.z, g0.w, g1.x, g1.y, g1.z, g1.w}, bb[8] = {b0.x, b0.y, b0.z, b0.w, b1.x, b1.y, b1.z, b1.w};
        __syncthreads();
        if (g != gcur) {
            gcur = g;
            for (int i = tid; i < 2048; i += NTHREADS) { const int t = i >> 4, ch = i & 15;
                const f32x4 a = *(const f32x4*)(w_sp + (size_t)g * 16384 + t * 128 + ch * 8), b = *(const f32x4*)(w_sp + (size_t)g * 16384 + t * 128 + ch * 8 + 4);
                const int s0 = ch * 8;
                u32x4 w; w.x = pk2(s0 + 0 <= t ? a.x : 0.f, s0 + 1 <= t ? a.y : 0.f); w.y = pk2(s0 + 2 <= t ? a.z : 0.f, s0 + 3 <= t ? a.w : 0.f);
                w.z = pk2(s0 + 4 <= t ? b.x : 0.f, s0 + 5 <= t ? b.y : 0.f); w.w = pk2(s0 + 6 <= t ? b.z : 0.f, s0 + 7 <= t ? b.w : 0.f);
                *(LAS u32x4*)(Wb + t * 256 + ((ch ^ (t & 15)) << 4)) = w; }
        }
        const int trow = wid * 16 + fr;
        const float bias = b_sp[g * 128 + trow];
#pragma unroll 1
        for (int uu = 0; uu < 8; ++uu) {
            const int bn = (grp & 31) * 8 + uu;
            const size_t row0 = (size_t)bn * 128;
            if (uu) __syncthreads();
            { float s1 = (lp[0].x + lp[0].z) + (lp[1].x + lp[1].z), s2 = (lp[0].y + lp[0].w) + (lp[1].y + lp[1].w);
              s1 += __shfl_xor(s1, 1); s2 += __shfl_xor(s2, 1); s1 += __shfl_xor(s1, 2); s2 += __shfl_xor(s2, 2);
              const float mu = s1 * (1.f / 1024.f), var = fmaxf(s2 * (1.f / 1024.f) - mu * mu, 0.f);
              if ((tid & 3) == 0) { STAT[2 * (tid >> 2)] = mu; STAT[2 * (tid >> 2) + 1] = rsqrtf(var + EPS); } }
            __syncthreads();
#pragma unroll
            for (int k = 0; k < 4; ++k) { const int i = tid + 512 * k, sI = i >> 4, ch = i & 15;
                const float mu = STAT[2 * sI], rs = STAT[2 * sI + 1];
#pragma unroll
                for (int e = 0; e < 8; ++e) { const int c = ch * 8 + e; const float x = (bf2f((unsigned short)vch[k][e]) - mu) * rs * gg[e] + bb[e];
                    *(LAS bf16_t*)(VTs + c * 256 + (((sI >> 3) ^ ((c ^ (c >> 3)) & 15)) << 4) + (sI & 7) * 2) = (bf16_t)f2bf(x); } }
            if (uu + 1 < 8) GM_LOAD(uu + 1);
            const size_t orow = row0 + trow;
            u32x2 uwv[8];
#pragma unroll
            for (int ct = 0; ct < 8; ++ct) uwv[ct] = *(const u32x2*)(UV + orow * 2048 + g * 128 + ct * 16 + 4 * fq);
            __syncthreads();
            f32x4 acc[8];
#pragma unroll
            for (int ct = 0; ct < 8; ++ct) acc[ct] = (f32x4){0.f, 0.f, 0.f, 0.f};
#pragma unroll
            for (int ks = 0; ks < 4; ++ks) {
                const bf16x8 wf = *(const LAS bf16x8*)(Wb + trow * 256 + (((ks * 4 + fq) ^ (trow & 15)) << 4));
#pragma unroll
                for (int ct = 0; ct < 8; ++ct) {
                    const int crow = ct * 16 + fr;
                    const bf16x8 vf = *(const LAS bf16x8*)(VTs + crow * 256 + (((ks * 4 + fq) ^ ((crow ^ (crow >> 3)) & 15)) << 4));
                    acc[ct] = __builtin_amdgcn_mfma_f32_16x16x32_bf16(vf, wf, acc[ct], 0, 0, 0);
                }
            }
#pragma unroll
            for (int ct = 0; ct < 8; ++ct) {
                const int c = ct * 16 + 4 * fq;
                const u32x2 uw = uwv[ct];
                const float u0 = bf2f((unsigned short)(uw.x & 0xffffu)), u1 = bf2f((unsigned short)(uw.x >> 16)), u2 = bf2f((unsigned short)(uw.y & 0xffffu)), u3 = bf2f((unsigned short)(uw.y >> 16));
                u32x2 w; w.x = pk2(u0 * (acc[ct][0] + bias), u1 * (acc[ct][1] + bias)); w.y = pk2(u2 * (acc[ct][2] + bias), u3 * (acc[ct][3] + bias));
                *(u32x2*)(G + orow * 1024 + g * 128 + c) = w;
            }
        }
#undef GM_LOAD
    }
}

#define GAS __attribute__((address_space(1)))
typedef GAS unsigned gu32;
#define XB_TMO      128
#define XB_XCNT(j)  (256  + 64 * (j))
#define XB_XSUB(j)  (1280 + 64 * (j))
#define XB_XGEN(j)  (2304 + 64 * (j))
#define XB_TOP      3328
#define XB_TOPGEN   3392
#define XCD_BAR_WORDS 3456
#define XB_SPIN_CAP (1u << 18)

__device__ __forceinline__ unsigned xb_ld(unsigned* p)              { return __hip_atomic_load(p, __ATOMIC_RELAXED, __HIP_MEMORY_SCOPE_AGENT); }
__device__ __forceinline__ unsigned xb_add(unsigned* p, unsigned v) { return __hip_atomic_fetch_add(p, v, __ATOMIC_RELAXED, __HIP_MEMORY_SCOPE_AGENT); }
__device__ __forceinline__ unsigned xb_xcc_id() { return (unsigned)__builtin_amdgcn_s_getreg((3 << 11) | 20) & 0xFu; }
#define XB_SPIN(cond, bar) do { unsigned _sp = 0; while (cond) { __builtin_amdgcn_s_sleep(1); \
    if ((++_sp & 255u) == 0u) { if (xb_ld(&(bar)[XB_TMO])) break; if (_sp > XB_SPIN_CAP) { atomicAdd(&(bar)[XB_TMO], 1u); break; } } } } while (0)

struct XcdBarrier {
    unsigned* bar; unsigned x;
    volatile LAS unsigned* st;
};

__device__ __forceinline__ XcdBarrier xcd_barrier_post(unsigned* bar, volatile LAS unsigned* st) {
    XcdBarrier b; b.bar = bar; b.x = xb_xcc_id(); b.st = st;
    if (threadIdx.x == 0) (void)xb_add(&bar[XB_XCNT(b.x)], 1u);
    return b;
}
__device__ __forceinline__ void xcd_barrier_complete(unsigned* bar, unsigned x, unsigned& nloc, unsigned& nx) {
    const unsigned G = gridDim.x * gridDim.y * gridDim.z;
    unsigned sum, cnt, mine, sp = 0u;
    for (;;) {
        sum = 0u; cnt = 0u; mine = 0u;
#pragma unroll
        for (unsigned j = 0; j < 16; ++j) { const unsigned c = xb_ld(&bar[XB_XCNT(j)]); sum += c; cnt += (c > 0u) ? 1u : 0u; mine = (j == x) ? c : mine; }
        if (sum == G) break;
        __builtin_amdgcn_s_sleep(1);
        if ((++sp & 255u) == 0u) { if (xb_ld(&bar[XB_TMO])) break; if (sp > XB_SPIN_CAP) { atomicAdd(&bar[XB_TMO], 1u); break; } }
    }
    nloc = mine > 0u ? mine : 1u; nx = cnt > 0u ? cnt : 1u;
}

__device__ __forceinline__ void xcd_barrier(const XcdBarrier& b) {
    asm volatile("s_waitcnt vmcnt(0)" ::: "memory");
    __syncthreads();
    if (threadIdx.x == 0) {
        unsigned* bar = b.bar;
        __builtin_amdgcn_s_waitcnt(0);
        unsigned nloc = b.st[0], nx = b.st[1];
        if (nloc == 0u) { xcd_barrier_complete(bar, b.x, nloc, nx); b.st[0] = nloc; b.st[1] = nx; }
        const unsigned old = xb_add(&bar[XB_XSUB(b.x)], 1u);
        const unsigned gen = old / nloc;
        if (old + 1u == (gen + 1u) * nloc) {
            __builtin_amdgcn_fence(__ATOMIC_RELEASE, "agent");
            asm volatile("s_waitcnt vmcnt(0)" ::: "memory");
            const unsigned og = xb_add(&bar[XB_TOP], 1u);
            const unsigned tg = og / nx;
            if (og + 1u == (tg + 1u) * nx) xb_add(&bar[XB_TOPGEN], 1u);
            else XB_SPIN(xb_ld(&bar[XB_TOPGEN]) == tg, bar);
            __builtin_amdgcn_fence(__ATOMIC_ACQUIRE, "agent");
            xb_add(&bar[XB_XGEN(b.x)], 1u);
            asm volatile("s_waitcnt vmcnt(0)" ::: "memory");
        } else {
            XB_SPIN(xb_ld(&bar[XB_XGEN(b.x)]) == gen, bar);
            __builtin_amdgcn_fence(__ATOMIC_ACQUIRE, "agent");
            asm volatile("s_waitcnt vmcnt(0)" ::: "memory");
        }
    }
    __syncthreads();
}

constexpr int LDS_BYTES = 32768 * 4 + 256 + 6144 + 8 * 2560;

enum Phase {
    PH_PREP = 0, PH_GEMM_IN, PH_CNORM, PH_MIX0  , PH_GEMM_OUT0,
    PH_GEMM_Q0, PH_XATTN0, PH_GEMM_O0, PH_GEMM_GU0, PH_GEMM_DN0,
    PH_GEMM_OIN, PH_GMLP, PH_GEMM_OOUT,
    PH_GEMM_Q1, PH_XATTN1, PH_GEMM_O1, PH_GEMM_GU1, PH_GEMM_DN1, PH_FINAL, PH_COUNT
};

__device__ __forceinline__ PrepJob make_job(const Params& p, int ji) {
    unsigned char* ws = p.ws; PrepJob j{};
    switch (ji) {
    case 0: j = PrepJob{p.in[5], 1024, 3272, p.in[4], (bf16_t*)(ws + WS_WIN), 1024, 1792, 1024, 0, MAP_WIN}; break;
    case 14: j = PrepJob{p.in[5], 1024, 3272, p.in[4], (bf16_t*)(ws + WS_WIN), 3584, PW, 1024, 0, MAP_WIN}; break;
    case 15: j = PrepJob{p.in[5], 1024, 3272, p.in[4], (bf16_t*)(ws + WS_WIN8), 1024, 2816, 1024, 0, MAP_WIN8, 4, WQ_GU}; break;
    case 1: j = PrepJob{p.in[10] + (size_t)512 * 1024, 512, 1024, nullptr, (bf16_t*)(ws + WS_WOUT), 0, 1024, KOUT, 1024, MAP_ID}; break;
    case 2: j = PrepJob{p.in[11], 1024, 2048, p.in[4] + 1024, (bf16_t*)(ws + WS_OWIN), 0, 2048, 1024, 0, MAP_ID, 2, WQ_GU}; break;
    case 3: j = PrepJob{p.in[16], 1024, 1024, nullptr, (bf16_t*)(ws + WS_OWOUT), 0, 1024, 1024, 0, MAP_ID}; break;
    case 4: case 5: { const int l = ji - 4; j = PrepJob{p.in[19] + (size_t)l * 1024 * 512, 1024, 512, p.in[17] + l * 1024, (bf16_t*)(ws + WS_WQ + (size_t)l * 512 * 1024), 0, 512, 1024, 0, MAP_ID, 2, WQ_GU}; } break;
    case 6: case 7: { const int l = ji - 6; j = PrepJob{p.in[20] + (size_t)l * 1024 * 1024, 1024, 1024, p.in[18] + l * 1024, (bf16_t*)(ws + WS_WKV8 + (size_t)l * 1024 * 1024), 0, 1024, 1024, 0, MAP_ID, 4, WQ_GU}; } break;
    case 8: case 9: { const int l = ji - 8; j = PrepJob{p.in[21] + (size_t)l * 512 * 1024, 512, 1024, nullptr, (bf16_t*)(ws + WS_WO + (size_t)l * 1024 * 512), 0, 1024, 512, 0, MAP_ID, 3, WO_SC}; } break;
    case 10: case 11: { const int l = ji - 10; j = PrepJob{p.in[23] + (size_t)l * 1024 * 2 * FF, 1024, 2 * FF, p.in[22] + l * 1024, (bf16_t*)(ws + WS_WGU + (size_t)l * 2 * FF * 1024), 0, 2 * FF, 1024, 0, MAP_GU, 2, WQ_GU}; } break;
    case 12: case 13: { const int l = ji - 12;
        if ((DN_FP8 >> l) & 1) j = PrepJob{p.in[24] + (size_t)l * FF * 1024, FF, 1024, nullptr, (bf16_t*)(ws + WS_WDN + (size_t)l * 1024 * FF * 2), 0, 1024, FF, 0, MAP_ID, 1, WDN_SC};
        else j = PrepJob{p.in[24] + (size_t)l * FF * 1024, FF, 1024, nullptr, (bf16_t*)(ws + WS_WDN) + (size_t)l * 1024 * FF, 0, 1024, FF, 0, MAP_ID}; } break;
    }
    return j;
}
constexpr int N_PREP_JOBS = 16;

template <int ph> __device__ __forceinline__ void run_phase(const Params& p, LAS float* lds, int vb, int nvb) {
    unsigned char* ws = p.ws;
    bf16_t* HN = (bf16_t*)(ws + WS_HN); bf16_t* BIG = (bf16_t*)(ws + WS_BIG); bf16_t* CN = (bf16_t*)(ws + WS_CN); bf16_t* CAT = (bf16_t*)(ws + WS_CAT);
    bf16_t* KB = (bf16_t*)(ws + WS_KB); bf16_t* VTB = (bf16_t*)(ws + WS_VT); bf16_t* MEMN = (bf16_t*)(ws + WS_MEMN); float* lb = (float*)(ws + WS_LB);
    float* ssq = (float*)(ws + WS_SSQ); float* lnp = (float*)(ws + WS_LNP);
    bf16_t* XQ = BIG; bf16_t* XO = BIG + (size_t)T * 512;
    const int l = (ph >= PH_GEMM_Q1) ? 1 : 0;
    switch (ph) {
    case PH_PREP:
        x_to_h_rows(p.in[0], HN, ws + WS_X8, ssq, vb, nvb);
        {
            constexpr int NT_[N_PREP_JOBS] = {16 * 3, 8 * 4, 16 * 8, 16 * 4, 16 * 2, 16 * 2, 16 * 4, 16 * 4, 8 * 4, 8 * 4, 16 * 22, 16 * 22, 44 * 4, 44 * 4, 16 * 1, 16 * 7};
            constexpr int CUM1 = NT_[0], CUM2 = CUM1 + NT_[1], CUM3 = CUM2 + NT_[2], CUM4 = CUM3 + NT_[3], CUM5 = CUM4 + NT_[4], CUM6 = CUM5 + NT_[5], CUM7 = CUM6 + NT_[6],
                          CUM8 = CUM7 + NT_[7], CUM9 = CUM8 + NT_[8], CUM10 = CUM9 + NT_[9], CUM11 = CUM10 + NT_[10], CUM12 = CUM11 + NT_[11], CUM13 = CUM12 + NT_[12], CUM14 = CUM13 + NT_[13],
                          CUM15 = CUM14 + NT_[14], CUM16 = CUM15 + NT_[15];
#define PJ_FIND(it_, ji_, base_) do { ji_ = 0; base_ = 0; \
                PJ_STEP(it_, ji_, base_, 1, CUM1) PJ_STEP(it_, ji_, base_, 2, CUM2) PJ_STEP(it_, ji_, base_, 3, CUM3) PJ_STEP(it_, ji_, base_, 4, CUM4) PJ_STEP(it_, ji_, base_, 5, CUM5) PJ_STEP(it_, ji_, base_, 6, CUM6) PJ_STEP(it_, ji_, base_, 7, CUM7) \
                PJ_STEP(it_, ji_, base_, 8, CUM8) PJ_STEP(it_, ji_, base_, 9, CUM9) PJ_STEP(it_, ji_, base_, 10, CUM10) PJ_STEP(it_, ji_, base_, 11, CUM11) PJ_STEP(it_, ji_, base_, 12, CUM12) PJ_STEP(it_, ji_, base_, 13, CUM13) PJ_STEP(it_, ji_, base_, 14, CUM14) PJ_STEP(it_, ji_, base_, 15, CUM15) } while (0)
#define PJ_STEP(it_, ji_, base_, q, c) if ((it_) >= (c)) { ji_ = (q); base_ = (c); }
            f32x4 va[8], vn[8];
            int ji, base;
            if (vb < CUM16) { PJ_FIND(vb, ji, base); const PrepJob j = make_job(p, ji); prep_tile_load(j, vb - base, va); }
            for (int it = vb; it < CUM16; it += nvb) {
                PJ_FIND(it, ji, base);
                const PrepJob j = make_job(p, ji); const int tl = it - base;
                if (it + nvb < CUM16) { int jn, bn; PJ_FIND(it + nvb, jn, bn); const PrepJob j2 = make_job(p, jn); prep_tile_load(j2, it + nvb - bn, vn); }
                prep_tile_store(j, tl, va, lds);
#pragma unroll
                for (int q = 0; q < 8; ++q) va[q] = vn[q];
            }
#undef PJ_STEP
#undef PJ_FIND
        }
        prep_fold_in(p.in[5], p.in[7], p.in[4], (bf16_t*)(ws + WS_WIN8), lds, vb, nvb);
        prep_fold_out(p.in[10], p.in[8], (bf16_t*)(ws + WS_WOUT), lds, vb, nvb);
        prep_lb(p.in[3], lb, vb, nvb);
        rmsnorm_rows(p.in[1], ws + WS_MEMN8, MT, vb, nvb);
        break;
    case PH_GEMM_IN: {
        {
            Gemm g{(const bf16_t*)(ws + WS_WIN8), (const bf16_t*)(ws + WS_WIN8), T, 2816, 512}; EpiIn8 E{BIG, KB, VTB, ssq, 1.f / (HQ_X * WQ_GU)};
            pg8::ComboOrder8 S; S.init(nvb, vb);
            LAS float* tab = (LAS float*)((LAS unsigned char*)lds + RSTD_TAB_OFF); build_rstd_table(S, ssq, tab); E.tab = tab;
            pg8::gemm_phase<EpiIn8, pg8::ComboOrder8, true, true, 2>((LAS unsigned char*)lds, g, S, E);
        }
        Gemm g{(const bf16_t*)(ws + WS_WIN), (const bf16_t*)(ws + WS_WIN), T, PW, 1024}; EpiIn E{BIG, KB, VTB, ssq};
        pg8::ComboOrder S; S.nkv = 0; S.init(nvb, vb);
        pg8::gemm_phase<EpiIn, pg8::ComboOrder, true, true>((LAS unsigned char*)lds, g, S, E);
    } break;
    case PH_CNORM: cnorm_rows(BIG, p.in[6], CN, vb, nvb); hgrn_prep(BIG, lb, (float*)(ws + WS_DEC), (LAS unsigned char*)lds, vb, nvb); break;
    case PH_MIX0:
        for (int item = vb; item < 64; item += nvb) hgrn_scan(BIG, (const float*)(ws + WS_DEC), p.in[9], CAT, (LAS unsigned char*)lds, item);
        dsa_mfma_phase(BIG, CN, p.in[2], CAT, (LAS unsigned char*)lds, (unsigned*)(ws + WS_CTL) + 3600);
        break;
    case PH_GEMM_OUT0: { Gemm g{CAT, (const bf16_t*)(ws + WS_WOUT), T, 1024, KOUT}; EpiResid<false, false, true> E{nullptr, HN, ssq, ws + WS_H8, HQ_Q0}; run_gemm(g, E, lds, vb, nvb); } break;
    case PH_GEMM_Q0: case PH_GEMM_Q1: { Gemm g{(const bf16_t*)(ws + WS_H8), (const bf16_t*)(ws + WS_WQ + (size_t)l * 512 * 1024), T, 512, 512}; EpiStoreBf16<true> E{XQ, 512, ssq, 1.f / ((l ? HQ_Q1 : HQ_Q0) * WQ_GU)}; run_gemm<EpiStoreBf16<true>, 2>(g, E, lds, vb, nvb); } break;
    case PH_XATTN0: case PH_XATTN1: xattn_mfma_phase(XQ, KB + (size_t)l * MT * 512, VTB + (size_t)l * 512 * MT, XO, (LAS unsigned char*)lds, vb, nvb); break;
    case PH_GEMM_O0: case PH_GEMM_O1: { Gemm g{XO, (const bf16_t*)(ws + WS_WO + (size_t)l * 1024 * 512), T, 1024, 256}; EpiResid<false, true, true> E{nullptr, HN, ssq, ws + WS_H8, l ? HQ_GU1 : HQ_GU0, XO_UNSC}; run_gemm<EpiResid<false, true, true>, 1>(g, E, lds, vb, nvb); } break;
    case PH_GEMM_GU0: case PH_GEMM_GU1: { constexpr bool dn8 = ((DN_FP8 >> l) & 1) != 0;
        Gemm g{(const bf16_t*)(ws + WS_H8), (const bf16_t*)(ws + WS_WGU + (size_t)l * 2 * FF * 1024), T, 2 * FF, 512}; EpiSwigluQ<true, dn8> E{BIG, FF, ssq, 1.f / ((l ? HQ_GU1 : HQ_GU0) * WQ_GU)}; run_gemm<EpiSwigluQ<true, dn8>, 2>(g, E, lds, vb, nvb); } break;
    case PH_GEMM_DN0: case PH_GEMM_DN1:
        if constexpr (((DN_FP8 >> l) & 1) != 0) { Gemm g{BIG, (const bf16_t*)(ws + WS_WDN + (size_t)l * 1024 * FF * 2), T, 1024, FF / 2}; EpiResid<false, true, ph == PH_GEMM_DN0> E{nullptr, HN, ssq, ws + WS_H8, HQ_OIN, DN_UNSC}; run_gemm<EpiResid<false, true, ph == PH_GEMM_DN0>, 1>(g, E, lds, vb, nvb); }
        else { Gemm g{BIG, (const bf16_t*)(ws + WS_WDN) + (size_t)l * 1024 * FF, T, 1024, FF}; EpiResid<false, false, ph == PH_GEMM_DN0> E{nullptr, HN, ssq, ws + WS_H8, HQ_OIN}; run_gemm(g, E, lds, vb, nvb); }
        break;
    case PH_GEMM_OIN: { Gemm g{(const bf16_t*)(ws + WS_H8), (const bf16_t*)(ws + WS_OWIN), T, 2048, 512}; EpiGeluBf16<true> E{BIG, 2048, ssq, lnp, 1.f / (HQ_OIN * WQ_GU)}; run_gemm<EpiGeluBf16<true>, 2>(g, E, lds, vb, nvb); } break;
    case PH_GMLP: gmlp_mfma_phase(BIG, lnp, p.in[12], p.in[13], p.in[14], p.in[15], CAT, (LAS unsigned char*)lds, vb, nvb); break;
    case PH_GEMM_OOUT: { Gemm g{CAT, (const bf16_t*)(ws + WS_OWOUT), T, 1024, 1024}; EpiResid<false, false, true> E{nullptr, HN, ssq, ws + WS_H8, HQ_Q1}; run_gemm(g, E, lds, vb, nvb); } break;
    case PH_FINAL: final_rows(HN, ssq, p.in[25], p.out, vb, nvb); break;
    default: break;
    }
}

template <int PH> __global__ void __launch_bounds__(NTHREADS) k_phase(Params p) {
    extern __shared__ __attribute__((aligned(16))) float smem[];
    run_phase<PH>(p, (LAS float*)smem, blockIdx.x, gridDim.x);
}

template <int PH> __device__ __forceinline__ void mega_phases(const Params& p, LAS float* lds, const XcdBarrier& bar) {
    run_phase<PH>(p, lds, blockIdx.x, gridDim.x);
#ifdef REPEAT_PH
    if constexpr (PH == REPEAT_PH) { xcd_barrier(bar); run_phase<PH>(p, lds, blockIdx.x, gridDim.x); }
#endif
    if constexpr (PH + 1 < PH_COUNT) { xcd_barrier(bar); mega_phases<PH + 1>(p, lds, bar); }
}
__global__ void __launch_bounds__(NTHREADS) k_mega(Params p) {
    extern __shared__ __attribute__((aligned(16))) float smem[];
    volatile LAS unsigned* st = (volatile LAS unsigned*)((LAS float*)smem + 32768);
    if (threadIdx.x < 2) st[threadIdx.x] = 0u;
    __syncthreads();
    const XcdBarrier bar = xcd_barrier_post((unsigned*)(p.ws + WS_CTL), st);
    mega_phases<0>(p, (LAS float*)smem, bar);
}

template <int PH> static void launch_phases(const Params& p, int grid, hipStream_t stream) {
    int g = grid * 4;
    if (PH == PH_MIX0 || PH == PH_XATTN0 || PH == PH_XATTN1 || PH == PH_GMLP) g = grid;
    (void)hipFuncSetAttribute((const void*)k_phase<PH>, hipFuncAttributeMaxDynamicSharedMemorySize, LDS_BYTES);
    hipLaunchKernelGGL(k_phase<PH>, dim3(g), dim3(NTHREADS), LDS_BYTES, stream, p);
    if constexpr (PH + 1 < PH_COUNT) launch_phases<PH + 1>(p, grid, stream);
}

extern "C" void kernel_launch(void* const* d_in, const int* in_sizes, int n_in, void* d_out, int out_size, void* d_ws, size_t ws_size, hipStream_t stream) {
    static int grid = 0;
    if (grid == 0) {
        if (n_in != 26 || out_size != T * D || ws_size < WS_END) { fprintf(stderr, "kernel_launch: unexpected shapes (n_in %d out %d ws %zu)\n", n_in, out_size, ws_size); grid = -1; return; }
        int dev = 0, cus = 0;
        (void)hipGetDevice(&dev); (void)hipDeviceGetAttribute(&cus, hipDeviceAttributeMultiprocessorCount, dev);
        (void)hipFuncSetAttribute((const void*)k_mega, hipFuncAttributeMaxDynamicSharedMemorySize, LDS_BYTES);
        int per_cu = 0;
        (void)hipOccupancyMaxActiveBlocksPerMultiprocessor(&per_cu, (const void*)k_mega, NTHREADS, LDS_BYTES);
        if (per_cu < 1) fprintf(stderr, "kernel_launch: occupancy query says %d blocks per CU\n", per_cu);
        (void)hipGetLastError();
        grid = cus > 0 ? cus : 256;
    }
    if (grid < 0) return;
    Params p{};
    for (int i = 0; i < 26; ++i) p.in[i] = (const float*)d_in[i];
    p.out = (float*)d_out; p.ws = (unsigned char*)d_ws;
    (void)hipMemsetAsync((char*)d_ws + WS_CTL, 0, 16384, stream);
#if MEGA
    hipLaunchKernelGGL(k_mega, dim3(grid), dim3(NTHREADS), LDS_BYTES, stream, p);
#else
    launch_phases<0>(p, grid, stream);
#endif
}
```

```cpp
#include <hip/hip_runtime.h>
#include <stdint.h>
#include <stdio.h>

#ifndef MEGA
#define MEGA 1
#endif
#ifndef DN_FP8
#define DN_FP8 2
#endif

#define LAS __attribute__((address_space(3)))
typedef unsigned short bf16_t;
typedef short bf16x8 __attribute__((ext_vector_type(8)));
typedef float f32x4 __attribute__((ext_vector_type(4)));
typedef float f32x2 __attribute__((ext_vector_type(2)));
typedef unsigned u32x4 __attribute__((ext_vector_type(4)));
typedef unsigned u32x2 __attribute__((ext_vector_type(2)));
typedef float f32x16 __attribute__((ext_vector_type(16)));

constexpr int D = 1024, BATCH = 16, SEQ = 2048, T = BATCH * SEQ;
constexpr int CHUNK = 64;
constexpr int MEMT = 256, MT = BATCH * MEMT;
constexpr int FF = 2816;
constexpr float EPS = 1e-6f;
constexpr int NTHREADS = 512, NWAVES = 8;

constexpr int P_QL = 0, P_C = 1024, P_QI = 1152, P_KI = 1664, P_FB = 1728, P_IB = 2240, P_QB = 2752, P_GB = 3264, P_WI = 3776, P_END = 3784, PW = 3840;
constexpr int KOUT = 1536;

constexpr size_t MiB = 1u << 20;
constexpr size_t WS_CTL = 0;
constexpr size_t WS_LB = 64 * 1024;
constexpr size_t WS_SSQ = 496 * MiB;
constexpr size_t WS_LNP = 498 * MiB;
constexpr size_t WS_WIN = 1 * MiB;
constexpr size_t WS_WKV = WS_WIN + (size_t)PW * D * 2;
constexpr size_t WS_HN = WS_WKV + 2 * (size_t)D * D * 2;
constexpr size_t WS_MEMN = WS_HN + (size_t)T * D * 2;
constexpr size_t WS_WOUT = WS_MEMN + (size_t)MT * D * 2;
constexpr size_t WS_OWIN = WS_WOUT + (size_t)D * KOUT * 2;
constexpr size_t WS_OWOUT = WS_OWIN + (size_t)2048 * D * 2;
constexpr size_t WS_WQ = WS_OWOUT + (size_t)D * D * 2;
constexpr size_t WS_WO = WS_WQ + 2 * (size_t)512 * D * 2;
constexpr size_t WS_WGU = WS_WO + 2 * (size_t)D * 512 * 2;
constexpr size_t WS_WDN = WS_WGU + 2 * (size_t)2 * FF * D * 2;
constexpr size_t WS_WEND = WS_WDN + 2 * (size_t)D * FF * 2;
constexpr int TILE_WIN = 0, TILE_WKV = PW / 256, TILE_HN = TILE_WKV + 8, TILE_MEMN = TILE_HN + T / 256;
constexpr size_t WS_BIG = 132 * MiB;
constexpr size_t WS_CN = 372 * MiB;
constexpr size_t WS_CAT = 380 * MiB;
constexpr size_t WS_H8 = WS_BIG + 200 * MiB;
constexpr size_t WS_WIN8 = WS_CAT, WS_WKV8 = WS_WIN8 + (size_t)2816 * 1024, WS_X8 = WS_WKV8 + (size_t)2048 * 1024, WS_MEMN8 = WS_X8 + (size_t)T * 1024;
constexpr int T8_WIN = 0, T8_WKV = 11, T8_X = 19, T8_MEMN = T8_X + T / 256;
constexpr size_t WS_KB = 476 * MiB;
constexpr size_t WS_VT = 484 * MiB;
constexpr size_t WS_END = 502 * MiB;
static_assert(WS_WEND <= WS_BIG, "weights fit below BIG");

struct Params {
    const float* in[26];
    float* out;
    unsigned char* ws;
};

__device__ __forceinline__ float bf2f(unsigned short u) { return __uint_as_float(((unsigned)u) << 16); }
__device__ __forceinline__ unsigned f2bf(float f) { unsigned u = __float_as_uint(f); return (u + 0x7fffu + ((u >> 16) & 1u)) >> 16; }
typedef __bf16 bf16x2_t __attribute__((ext_vector_type(2)));
__device__ __forceinline__ unsigned pk2(float lo, float hi) { const f32x2 v = {lo, hi}; return __builtin_bit_cast(unsigned, __builtin_convertvector(v, bf16x2_t)); }
__device__ __forceinline__ float wave_sum(float v) {
#pragma unroll
    for (int o = 1; o < 64; o <<= 1) v += __shfl_xor(v, o);
    return v;
}
__device__ __forceinline__ float wave_max(float v) {
#pragma unroll
    for (int o = 1; o < 64; o <<= 1) v = fmaxf(v, __shfl_xor(v, o));
    return v;
}
__device__ __forceinline__ int otid() { int t = threadIdx.x; asm volatile("" : "+v"(t)); return t; }
#define WAVE_LDS_SYNC() asm volatile("s_waitcnt lgkmcnt(0)" ::: "memory")
__device__ __forceinline__ float silu_f(float x) { return x * __builtin_amdgcn_rcpf(1.f + __expf(-x)); }
__device__ __forceinline__ float sigmoid_f(float x) { return __builtin_amdgcn_rcpf(1.f + __expf(-x)); }

typedef int i32x4v __attribute__((ext_vector_type(4)));
typedef int i32x8v __attribute__((ext_vector_type(8)));
__device__ __forceinline__ unsigned pk4_f8(float a, float b, float c, float d) {
    a = __builtin_amdgcn_fmed3f(a, -448.f, 448.f); b = __builtin_amdgcn_fmed3f(b, -448.f, 448.f); c = __builtin_amdgcn_fmed3f(c, -448.f, 448.f); d = __builtin_amdgcn_fmed3f(d, -448.f, 448.f);
    int w = 0;
    w = __builtin_amdgcn_cvt_pk_fp8_f32(a, b, w, false);
    w = __builtin_amdgcn_cvt_pk_fp8_f32(c, d, w, true);
    return (unsigned)w;
}
constexpr float ACT_SC = 8.f, WDN_SC = 256.f, DN_UNSC = 1.f / (ACT_SC * WDN_SC);
constexpr float XO_SC = 64.f, WO_SC = 128.f, XO_UNSC = 1.f / (XO_SC * WO_SC);
constexpr float HQ_X = 127.f / 4.2f;
constexpr float HQ_Q0 = 127.f / 5.2f, HQ_GU0 = 127.f / 5.2f, HQ_OIN = 127.f / 5.8f, HQ_Q1 = 127.f / 6.3f, HQ_GU1 = 127.f / 6.3f, WQ_GU = 127.f / 0.13f;
__device__ __forceinline__ unsigned pk4_i8(float a, float b, float c, float d, float sc) {
    constexpr float MG = 12582912.f;
    const unsigned ua = __float_as_uint(__builtin_amdgcn_fmed3f(__builtin_fmaf(a, sc, MG), MG - 127.f, MG + 127.f)), ub = __float_as_uint(__builtin_amdgcn_fmed3f(__builtin_fmaf(b, sc, MG), MG - 127.f, MG + 127.f));
    const unsigned uc = __float_as_uint(__builtin_amdgcn_fmed3f(__builtin_fmaf(c, sc, MG), MG - 127.f, MG + 127.f)), ud = __float_as_uint(__builtin_amdgcn_fmed3f(__builtin_fmaf(d, sc, MG), MG - 127.f, MG + 127.f));
    return __builtin_amdgcn_perm(ub, ua, 0x0c0c0400u) | __builtin_amdgcn_perm(ud, uc, 0x04000c0cu);
}
__device__ __forceinline__ int kperm8(int k) { const int r = k & 255; return (k & ~255) + ((r >> 5) & 3) * 64 + ((r >> 3) & 3) * 16 + (r >> 7) * 8 + (r & 7); }
__device__ __forceinline__ f32x4 i2f4(f32x4 v) { const i32x4v t = __builtin_bit_cast(i32x4v, v); return (f32x4){(float)t.x, (float)t.y, (float)t.z, (float)t.w}; }
struct Unit { int pm, pn, idx; };
struct Gemm { const bf16_t* A; const bf16_t* Bt; int M, N, K; };
__device__ __forceinline__ int perm32(int rho) { const int n = rho >> 4, i = rho & 15; return 8 * (i >> 2) + 4 * n + (i & 3); }

__device__ __forceinline__ float row_rstd(const float* ssq, size_t row) {
    const f32x4* p = (const f32x4*)(ssq + row * 16);
    const f32x4 a = p[0], b = p[1], c = p[2], d = p[3];
    const float t = (((a.x + a.y) + (a.z + a.w)) + ((b.x + b.y) + (b.z + b.w))) + (((c.x + c.y) + (c.z + c.w)) + ((d.x + d.y) + (d.z + d.w)));
    return rsqrtf(t * (1.f / 1024.f) + EPS);
}
__device__ __forceinline__ void rows_rstd(const float* ssq, size_t row0, int fq, float (&rs)[2][4]) {
#pragma unroll
    for (int ai = 0; ai < 2; ++ai)
#pragma unroll
        for (int m = 0; m < 4; ++m) { const f32x4 a = *(const f32x4*)(ssq + (row0 + ai * 128 + m * 16) * 16 + 4 * fq); rs[ai][m] = (a.x + a.y) + (a.z + a.w); }
#pragma unroll
    for (int ai = 0; ai < 2; ++ai)
#pragma unroll
        for (int m = 0; m < 4; ++m) { float t = rs[ai][m]; t += __shfl_xor(t, 16); t += __shfl_xor(t, 32); rs[ai][m] = rsqrtf(t * (1.f / 1024.f) + EPS); }
}
constexpr int RSTD_TAB_OFF = 137472, RSTD_TAB_UNITS = 20;
template <class Sched> __device__ __forceinline__ void build_rstd_table(const Sched& S, const float* ssq, LAS float* tab) {
    const int tid = otid(), r = tid >> 1, hh = tid & 1;
    Unit u;
    for (int i = 0; i < RSTD_TAB_UNITS && S.next(i, u); ++i) {
        const int st = S.ssq_tile(u);
        if (st < 0) { if (hh == 0) tab[i * 256 + r] = 1.f; continue; }
        const f32x4 a = *(const f32x4*)(ssq + ((size_t)st * 256 + r) * 16 + hh * 8), b = *(const f32x4*)(ssq + ((size_t)st * 256 + r) * 16 + hh * 8 + 4);
        float t = ((a.x + a.y) + (a.z + a.w)) + ((b.x + b.y) + (b.z + b.w));
        t += __shfl_xor(t, 1);
        if (hh == 0) tab[i * 256 + r] = rsqrtf(t * (1.f / 1024.f) + EPS);
    }
    __syncthreads();
}
__device__ __forceinline__ void rows_rstd_tab(const LAS float* tab, int idx, int rloc, float (&rs)[2][4]) {
#pragma unroll
    for (int ai = 0; ai < 2; ++ai)
#pragma unroll
        for (int m = 0; m < 4; ++m) rs[ai][m] = tab[idx * 256 + rloc + ai * 128 + m * 16];
}
template <bool ACC_I8 = false, bool REMAP = false> struct EpiStoreBf16 {
    static constexpr bool PERM = true, AFTER_DRAIN = false;
    static constexpr bool USES_TAB = true;
    bf16_t* O; int ldc; const float* ssq; float dq = 1.f; const LAS float* tab = nullptr;
    __device__ __forceinline__ void operator()(const f32x4 (&acc)[2][2][4][2], const Unit& u, int wr, int wc, int fr, int fq) const {
        const int ct = REMAP ? (u.pn < 4 ? u.pn : u.pn + 3) : u.pn;
        const int row0 = u.pm * 256 + wr * 64 + fr, col0 = ct * 256 + wc * 32 + 8 * fq;
        float rsv[2][4]; rows_rstd_tab(tab, u.idx, wr * 64 + fr, rsv);
#pragma unroll
        for (int ai = 0; ai < 2; ++ai)
#pragma unroll
            for (int m = 0; m < 4; ++m) {
                const float rs = ACC_I8 ? rsv[ai][m] * dq : rsv[ai][m];
                bf16_t* rowp = O + (size_t)(row0 + ai * 128 + m * 16) * ldc + col0;
#pragma unroll
                for (int bj = 0; bj < 2; ++bj) {
                    const f32x4 v0 = (ACC_I8 ? i2f4(acc[ai][bj][m][0]) : acc[ai][bj][m][0]) * rs, v1 = (ACC_I8 ? i2f4(acc[ai][bj][m][1]) : acc[ai][bj][m][1]) * rs;
                    u32x4 w; w.x = pk2(v0[0], v0[1]); w.y = pk2(v0[2], v0[3]); w.z = pk2(v1[0], v1[1]); w.w = pk2(v1[2], v1[3]);
                    *(u32x4*)(rowp + bj * 128) = w;
                }
            }
    }
};
struct EpiIn8 {
    static constexpr bool PERM = true, AFTER_DRAIN = false, USES_TAB = true;
    bf16_t* P; bf16_t* KB; bf16_t* VT; const float* ssq; float dq; const LAS float* tab = nullptr;
    __device__ __forceinline__ void operator()(const f32x4 (&acc)[2][2][4][2], const Unit& u, int wr, int wc, int fr, int fq) const {
        bf16_t* O; int ldc, rt, ct;
        if (u.pn < T8_WKV) { O = P; ldc = PW; rt = u.pm - T8_X; ct = u.pn < 4 ? u.pn : u.pn + 3; }
        else if (u.pm >= T8_MEMN) { const int l = (u.pn - T8_WKV) >> 2; O = KB + (size_t)l * MT * 512; ldc = 512; rt = u.pm - T8_MEMN; ct = (u.pn - T8_WKV) & 3; }
        else { const int l = (u.pm - T8_WKV) >> 2; O = VT + (size_t)l * 512 * MT; ldc = MT; rt = ((u.pm - T8_WKV) & 3) - 2; ct = u.pn - T8_MEMN; }
        const int row0 = rt * 256 + wr * 64 + fr, col0 = ct * 256 + wc * 32 + 8 * fq;
        float rsv[2][4]; rows_rstd_tab(tab, u.idx, wr * 64 + fr, rsv);
#pragma unroll
        for (int ai = 0; ai < 2; ++ai)
#pragma unroll
            for (int m = 0; m < 4; ++m) {
                const float rs = rsv[ai][m] * dq;
                bf16_t* rowp = O + (size_t)(row0 + ai * 128 + m * 16) * ldc + col0;
#pragma unroll
                for (int bj = 0; bj < 2; ++bj) {
                    const f32x4 v0 = i2f4(acc[ai][bj][m][0]) * rs, v1 = i2f4(acc[ai][bj][m][1]) * rs;
                    u32x4 w; w.x = pk2(v0[0], v0[1]); w.y = pk2(v0[2], v0[3]); w.z = pk2(v1[0], v1[1]); w.w = pk2(v1[2], v1[3]);
                    *(u32x4*)(rowp + bj * 128) = w;
                }
            }
    }
};
struct EpiIn {
    static constexpr bool PERM = true, AFTER_DRAIN = false;
    static constexpr bool USES_TAB = true;
    bf16_t* P; bf16_t* KB; bf16_t* VT; const float* ssq; const LAS float* tab = nullptr;
    __device__ __forceinline__ void operator()(const f32x4 (&acc)[2][2][4][2], const Unit& u, int wr, int wc, int fr, int fq) const {
        bf16_t* O; int ldc, rt, ct; const bool main_unit = u.pn < TILE_WKV;
        if (main_unit) { O = P; ldc = PW; rt = u.pm - TILE_HN; ct = u.pn; }
        else if (u.pm >= TILE_MEMN) { const int l = (u.pn - TILE_WKV) >> 2; O = KB + (size_t)l * MT * 512; ldc = 512; rt = u.pm - TILE_MEMN; ct = (u.pn - TILE_WKV) & 3; }
        else { const int l = (u.pm - TILE_WKV) >> 2; O = VT + (size_t)l * 512 * MT; ldc = MT; rt = ((u.pm - TILE_WKV) & 3) - 2; ct = u.pn - TILE_MEMN; }
        const int row0 = rt * 256 + wr * 64 + fr, col0 = ct * 256 + wc * 32 + 8 * fq;
        float rsv[2][4]; rows_rstd_tab(tab, u.idx, wr * 64 + fr, rsv);
#pragma unroll
        for (int ai = 0; ai < 2; ++ai)
#pragma unroll
            for (int m = 0; m < 4; ++m) {
                const float rs = rsv[ai][m];
                bf16_t* rowp = O + (size_t)(row0 + ai * 128 + m * 16) * ldc + col0;
#pragma unroll
                for (int bj = 0; bj < 2; ++bj) {
                    const f32x4 v0 = acc[ai][bj][m][0] * rs, v1 = acc[ai][bj][m][1] * rs;
                    u32x4 w; w.x = pk2(v0[0], v0[1]); w.y = pk2(v0[2], v0[3]); w.z = pk2(v1[0], v1[1]); w.w = pk2(v1[2], v1[3]);
                    *(u32x4*)(rowp + bj * 128) = w;
                }
            }
    }
};
template <bool ACC_I8 = false> struct EpiGeluBf16 {
    static constexpr bool PERM = true, AFTER_DRAIN = false;
    static constexpr bool USES_TAB = true;
    bf16_t* O; int ldc; const float* ssq; float* lnp; float dq = 1.f; const LAS float* tab = nullptr;
    __device__ __forceinline__ static f32x2 gelu_pk(f32x2 v) {
        const f32x2 av = __builtin_elementwise_abs(v), d = av * 0.2316418882f + 1.0f;
        f32x2 t; t.x = __builtin_amdgcn_rcpf(d.x); t.y = __builtin_amdgcn_rcpf(d.y);
        f32x2 q = t * 0.5307027145f + (-0.7265760135f); q = q * t + 0.7107068705f; q = q * t + (-0.142248368f); q = q * t + 0.127414796f; q = q * t;
        const f32x2 sq = (v * v) * (-0.72134752044f);
        f32x2 e; e.x = __builtin_amdgcn_exp2f(sq.x); e.y = __builtin_amdgcn_exp2f(sq.y);
        const f32x2 mm = v * (q * e), r = v - mm;
        f32x2 o; o.x = v.x < 0.f ? mm.x : r.x; o.y = v.y < 0.f ? mm.y : r.y; return o;
    }
    __device__ __forceinline__ static unsigned g2(float a, float b) { const f32x2 r = gelu_pk((f32x2){a, b}); return pk2(r.x, r.y); }
    __device__ __forceinline__ void operator()(const f32x4 (&acc)[2][2][4][2], const Unit& u, int wr, int wc, int fr, int fq) const {
        const int row0 = u.pm * 256 + wr * 64 + fr, col0 = u.pn * 256 + wc * 32 + 8 * fq;
        float rsv[2][4]; rows_rstd_tab(tab, u.idx, wr * 64 + fr, rsv);
#pragma unroll
        for (int ai = 0; ai < 2; ++ai)
#pragma unroll
            for (int m = 0; m < 4; ++m) {
                const size_t row = (size_t)(row0 + ai * 128 + m * 16);
                const float rs = ACC_I8 ? rsv[ai][m] * dq : rsv[ai][m];
                bf16_t* rowp = O + row * ldc + col0;
                float s1 = 0.f, s2 = 0.f;
#pragma unroll
                for (int bj = 0; bj < 2; ++bj) {
                    const f32x4 v0 = (ACC_I8 ? i2f4(acc[ai][bj][m][0]) : acc[ai][bj][m][0]) * rs, v1 = (ACC_I8 ? i2f4(acc[ai][bj][m][1]) : acc[ai][bj][m][1]) * rs;
                    const f32x2 ga = gelu_pk((f32x2){v0[0], v0[1]}), gb = gelu_pk((f32x2){v0[2], v0[3]}), gc = gelu_pk((f32x2){v1[0], v1[1]}), gd = gelu_pk((f32x2){v1[2], v1[3]});
                    u32x4 w; w.x = pk2(ga.x, ga.y); w.y = pk2(gb.x, gb.y); w.z = pk2(gc.x, gc.y); w.w = pk2(gd.x, gd.y);
                    *(u32x4*)(rowp + bj * 128) = w;
                    s1 += ((ga.x + ga.y) + (gb.x + gb.y)) + ((gc.x + gc.y) + (gd.x + gd.y));
                    s2 += ((ga.x * ga.x + ga.y * ga.y) + (gb.x * gb.x + gb.y * gb.y)) + ((gc.x * gc.x + gc.y * gc.y) + (gd.x * gd.x + gd.y * gd.y));
                }
                if (u.pn >= 4) {
                    s1 += __shfl_xor(s1, 16); s1 += __shfl_xor(s1, 32); s2 += __shfl_xor(s2, 16); s2 += __shfl_xor(s2, 32);
                    if (fq == 0) *(f32x2*)(lnp + (row * 16 + (u.pn - 4) * 4 + wc) * 2) = (f32x2){s1, s2};
                }
            }
    }
};
struct EpiSwigluBf16 {
    static constexpr bool PERM = true, AFTER_DRAIN = false, USES_TAB = false;
    bf16_t* O; int ldc; const float* ssq;
    __device__ __forceinline__ void operator()(const f32x4 (&acc)[2][2][4][2], const Unit& u, int wr, int wc, int fr, int fq) const {
        const int row0 = u.pm * 256 + wr * 64 + fr, col0 = u.pn * 128 + wc * 32 + 8 * fq;
        float rsv[2][4]; rows_rstd(ssq, (size_t)row0, fq, rsv);
#pragma unroll
        for (int ai = 0; ai < 2; ++ai)
#pragma unroll
            for (int m = 0; m < 4; ++m) {
                const float rs = rsv[ai][m];
                bf16_t* rowp = O + (size_t)(row0 + ai * 128 + m * 16) * ldc + col0;
                const f32x4 g0 = acc[ai][0][m][0] * rs, g1 = acc[ai][0][m][1] * rs, u0 = acc[ai][1][m][0] * rs, u1 = acc[ai][1][m][1] * rs;
                u32x4 w;
                w.x = pk2(silu_f(g0[0]) * u0[0], silu_f(g0[1]) * u0[1]); w.y = pk2(silu_f(g0[2]) * u0[2], silu_f(g0[3]) * u0[3]);
                w.z = pk2(silu_f(g1[0]) * u1[0], silu_f(g1[1]) * u1[1]); w.w = pk2(silu_f(g1[2]) * u1[2], silu_f(g1[3]) * u1[3]);
                *(u32x4*)rowp = w;
            }
    }
};
template <bool ACC_I8, bool OUT_F8> struct EpiSwigluQ {
    static constexpr bool PERM = true, AFTER_DRAIN = false;
    static constexpr bool USES_TAB = true;
    void* O; int ldc; const float* ssq; float dq; const LAS float* tab = nullptr;
    __device__ __forceinline__ void operator()(const f32x4 (&acc)[2][2][4][2], const Unit& u, int wr, int wc, int fr, int fq) const {
        const int row0 = u.pm * 256 + wr * 64 + fr, col0 = u.pn * 128 + wc * 32 + 8 * fq;
        float rsv[2][4]; rows_rstd_tab(tab, u.idx, wr * 64 + fr, rsv);
#pragma unroll
        for (int ai = 0; ai < 2; ++ai)
#pragma unroll
            for (int m = 0; m < 4; ++m) {
                const float rs = ACC_I8 ? rsv[ai][m] * dq : rsv[ai][m], rsu = OUT_F8 ? rs * ACT_SC : rs;
                f32x4 g0 = acc[ai][0][m][0], g1 = acc[ai][0][m][1], u0 = acc[ai][1][m][0], u1 = acc[ai][1][m][1];
                if (ACC_I8) { g0 = i2f4(g0); g1 = i2f4(g1); u0 = i2f4(u0); u1 = i2f4(u1); }
                g0 = g0 * rs; g1 = g1 * rs; u0 = u0 * rsu; u1 = u1 * rsu;
                if (OUT_F8) {
                    unsigned char* rowp = (unsigned char*)O + (size_t)(row0 + ai * 128 + m * 16) * ldc + col0;
                    u32x2 w;
                    w.x = pk4_f8(silu_f(g0[0]) * u0[0], silu_f(g0[1]) * u0[1], silu_f(g0[2]) * u0[2], silu_f(g0[3]) * u0[3]);
                    w.y = pk4_f8(silu_f(g1[0]) * u1[0], silu_f(g1[1]) * u1[1], silu_f(g1[2]) * u1[2], silu_f(g1[3]) * u1[3]);
                    *(u32x2*)rowp = w;
                } else {
                    bf16_t* rowp = (bf16_t*)O + (size_t)(row0 + ai * 128 + m * 16) * ldc + col0;
                    u32x4 w;
                    w.x = pk2(silu_f(g0[0]) * u0[0], silu_f(g0[1]) * u0[1]); w.y = pk2(silu_f(g0[2]) * u0[2], silu_f(g0[3]) * u0[3]);
                    w.z = pk2(silu_f(g1[0]) * u1[0], silu_f(g1[1]) * u1[1]); w.w = pk2(silu_f(g1[2]) * u1[2], silu_f(g1[3]) * u1[3]);
                    *(u32x4*)rowp = w;
                }
            }
    }
};
template <bool BASE_F32, bool SCALED = false, bool W8 = false> struct EpiResid {
    static constexpr bool PERM = true, AFTER_DRAIN = false;
    static constexpr bool USES_TAB = false;
    const float* xbase; bf16_t* H; float* ssq; unsigned char* H8 = nullptr; float hq = 0.f; float asc = 1.f;
    __device__ __forceinline__ void operator()(const f32x4 (&acc)[2][2][4][2], const Unit& u, int wr, int wc, int fr, int fq) const {
        const int row0 = u.pm * 256 + wr * 64 + fr, col0 = u.pn * 256 + wc * 32 + 8 * fq;
#pragma unroll
        for (int ai = 0; ai < 2; ++ai)
#pragma unroll
            for (int m = 0; m < 4; ++m) {
                const size_t row = (size_t)(row0 + ai * 128 + m * 16);
                float ss = 0.f; u32x4 q8 = (u32x4){0u, 0u, 0u, 0u};
#pragma unroll
                for (int bj = 0; bj < 2; ++bj) {
                    const size_t off = row * 1024 + col0 + bj * 128;
                    f32x4 b0, b1;
                    if (BASE_F32) { b0 = *(const f32x4*)(xbase + off); b1 = *(const f32x4*)(xbase + off + 4); }
                    else { const u32x4 hw = *(const u32x4*)(H + off);
                        b0 = (f32x4){bf2f((unsigned short)(hw.x & 0xffffu)), bf2f((unsigned short)(hw.x >> 16)), bf2f((unsigned short)(hw.y & 0xffffu)), bf2f((unsigned short)(hw.y >> 16))};
                        b1 = (f32x4){bf2f((unsigned short)(hw.z & 0xffffu)), bf2f((unsigned short)(hw.z >> 16)), bf2f((unsigned short)(hw.w & 0xffffu)), bf2f((unsigned short)(hw.w >> 16))}; }
                    const float sc = SCALED ? asc : 1.f;
                    const f32x4 v0 = b0 + acc[ai][bj][m][0] * sc, v1 = b1 + acc[ai][bj][m][1] * sc;
                    u32x4 w; w.x = pk2(v0[0], v0[1]); w.y = pk2(v0[2], v0[3]); w.z = pk2(v1[0], v1[1]); w.w = pk2(v1[2], v1[3]);
                    *(u32x4*)(H + off) = w;
                    if (W8) { q8[2 * bj] = pk4_i8(v0[0], v0[1], v0[2], v0[3], hq); q8[2 * bj + 1] = pk4_i8(v1[0], v1[1], v1[2], v1[3], hq); }
                    ss += ((v0[0] * v0[0] + v0[1] * v0[1]) + (v0[2] * v0[2] + v0[3] * v0[3])) + ((v1[0] * v1[0] + v1[1] * v1[1]) + (v1[2] * v1[2] + v1[3] * v1[3]));
                }
                if (W8) *(u32x4*)(H8 + row * 1024 + u.pn * 256 + wc * 64 + fq * 16) = q8;
                ss += __shfl_xor(ss, 16); ss += __shfl_xor(ss, 32);
                if (fq == 0) ssq[row * 16 + u.pn * 4 + wc] = ss;
            }
    }
};
namespace pg8 {
#define PG8_LAS __attribute__((address_space(3)))
constexpr int BM = 256, BK = 64, HALF = 128, HTB = HALF * BK * 2  , STAGE_BYTES = 8 * HTB, NXCD = 8, WGM = 8;
__host__ __device__ __forceinline__ int lds_byte(int r, int c) { const int st = (r >> 4) * 2 + (c >> 5), rr = r & 15, cc = c & 31, ob = rr * 64 + cc * 2; return st * 1024 + (ob ^ (((ob >> 9) & 1) << 5)); }
__host__ __device__ __forceinline__ void stage_rc(int b, int& R, int& C) { const int st = b / 1024, sb = b % 1024, swz = sb ^ (((sb >> 9) & 1) << 5); R = (st >> 1) * 16 + swz / 64; C = (st & 1) * 32 + (swz % 64) / 2; }
struct StaticOrder {
    int nM, nN, nwg, G, c;
    __host__ __device__ void init(int M, int N, int G_, int c_) { nM = M / BM; nN = N / BM; nwg = nM * nN; G = G_; c = c_; }
    __host__ __device__ bool next(int i, Unit& u) const {
        const long L = (long)i * G + c; if (L >= nwg) return false;
        int wgid = (int)L; { const int q = nwg / NXCD, r = nwg % NXCD, xcd = wgid % NXCD, off = wgid / NXCD; wgid = (xcd < r ? xcd * (q + 1) : r * (q + 1) + (xcd - r) * q) + off; }
        const int nig = WGM * nN, gid = wgid / nig, fm = gid * WGM, gsz = (nM - fm) < WGM ? (nM - fm) : WGM;
        u.pm = fm + ((wgid % nig) % gsz); u.pn = (wgid % nig) / gsz; u.idx = i; return true;
    }
    __host__ __device__ int ssq_tile(const Unit& u) const { return u.pm; }
    __device__ __forceinline__ void a_ready(const Unit&) const {}
    __device__ __forceinline__ void done(const Unit&) const {}
};
struct ComboOrder8 {
    StaticOrder so;
    __host__ __device__ void init(int G_, int c_) { so.init(T, 2816, G_, c_); }
    __host__ __device__ bool next(int i, Unit& u) const {
        const long L = (long)i * so.G + so.c;
        if (L < so.nwg) { so.next(i, u); u.pm += T8_X; return true; }
        const int j = (int)(L - so.nwg); if (j >= 128) return false;
        const int l = j >> 6, jj = j & 63; u.idx = i;
        if (jj < 32) { u.pm = T8_MEMN + (jj >> 1); u.pn = T8_WKV + 4 * l + (jj & 1); }
        else { const int q = jj - 32; u.pm = T8_WKV + 4 * l + 2 + (q >> 4); u.pn = T8_MEMN + (q & 15); }
        return true;
    }
    __host__ __device__ int ssq_tile(const Unit& u) const { return u.pn < T8_WKV ? u.pm - T8_X : -1; }
    __device__ __forceinline__ void a_ready(const Unit&) const {}
    __device__ __forceinline__ void done(const Unit&) const {}
};
struct ComboOrder {
    StaticOrder so; int nkv = 128;
    __host__ __device__ void init(int G_, int c_) { so.init(T, 1024, G_, c_); }
    __host__ __device__ bool next(int i, Unit& u) const {
        const long L = (long)i * so.G + so.c;
        if (L < so.nwg) { so.next(i, u); u.pm += TILE_HN; u.pn = u.pn < 3 ? u.pn + 4 : 14; return true; }
        const int j = (int)(L - so.nwg); if (j >= nkv) return false;
        const int l = j >> 6, jj = j & 63; u.idx = i;
        if (jj < 32) { u.pm = TILE_MEMN + (jj >> 1); u.pn = TILE_WKV + 4 * l + (jj & 1); }
        else { const int q = jj - 32; u.pm = TILE_WKV + 4 * l + 2 + (q >> 4); u.pn = TILE_MEMN + (q & 15); }
        return true;
    }
    __host__ __device__ int ssq_tile(const Unit& u) const { return u.pn < TILE_WKV ? u.pm - TILE_HN : -1; }
    __device__ __forceinline__ void a_ready(const Unit&) const {}
    __device__ __forceinline__ void done(const Unit&) const {}
};
template <class Epi, class Sched, bool ALIGN_EPI = false, bool SP2 = false, int QM = 0  >
__device__ __forceinline__ void gemm_phase(PG8_LAS unsigned char* lds, const Gemm g, const Sched& S, const Epi& E) {
    const int tid = otid(), wid = __builtin_amdgcn_readfirstlane(tid >> 6), lane = tid & 63, wr = wid >> 2, wc = wid & 3, fr = lane & 15, fq = lane >> 4;
    constexpr bool FP8 = (QM == 1), I8 = (QM == 2);
    const int K = g.K, nt = K / BK;
    unsigned voffA[2], voffB[2];
#pragma unroll
    for (int i = 0; i < 2; ++i) { int R, C; stage_rc(tid * 16 + i * 8192, R, C); const int Rb = Epi::PERM ? ((R & ~31) + perm32(R & 31)) : R;
        voffA[i] = (unsigned)(R * K + C) * 2u; voffB[i] = (unsigned)(Rb * K + C) * 2u; }
    const size_t kstep = (size_t)(BK * 2);
    const size_t hstep = (size_t)HALF * K * 2;
    const size_t tstep = 2 * hstep;
    const unsigned ldsw = (unsigned)wid * 1024u;
    const int aoff = lds_byte(wr * 64 + fr, fq * 8), boff = lds_byte(wc * 32 + fr, fq * 8);
#define PG8_SA(b, h) (((b) * 2 + (h)) * HTB)
#define PG8_SB(b, h) ((4 + (b) * 2 + (h)) * HTB)
#define PG8_STAGE(bufoff, gbase, voff) do { _Pragma("unroll") for (int _i = 0; _i < 2; ++_i) \
        __builtin_amdgcn_global_load_lds((const unsigned*)((const char*)(gbase) + (voff)[_i]), (PG8_LAS unsigned*)(lds + (bufoff) + ldsw + _i * 8192), 16, 0, 0); } while (0)
#define PG8_LD16(off) (*(const PG8_LAS bf16x8*)(lds + (off)))
#define PG8_LDA(dst, b, h) do { _Pragma("unroll") for (int m = 0; m < 4; ++m) { \
        if constexpr (FP8) dst##8[m] = PG8_CAT(PG8_LD16(PG8_SA(b, h) + aoff + m * 2048), PG8_LD16(PG8_SA(b, h) + aoff + m * 2048 + 1024)); \
        else { _Pragma("unroll") for (int k = 0; k < 2; ++k) dst[m][k] = PG8_LD16(PG8_SA(b, h) + aoff + m * 2048 + k * 1024); } } } while (0)
#define PG8_LDB(dst, b, h) do { _Pragma("unroll") for (int n = 0; n < 2; ++n) { \
        if constexpr (FP8) dst##8[n] = PG8_CAT(PG8_LD16(PG8_SB(b, h) + boff + n * 2048), PG8_LD16(PG8_SB(b, h) + boff + n * 2048 + 1024)); \
        else { _Pragma("unroll") for (int k = 0; k < 2; ++k) dst[n][k] = PG8_LD16(PG8_SB(b, h) + boff + n * 2048 + k * 1024); } } } while (0)
#define PG8_CAT(x, y) __builtin_shufflevector(__builtin_bit_cast(i32x4v, x), __builtin_bit_cast(i32x4v, y), 0, 1, 2, 3, 4, 5, 6, 7)
#define PG8_MMA(ai, bj, At, Bt) do { __builtin_amdgcn_s_setprio(1); \
        if constexpr (FP8) { _Pragma("unroll") for (int m = 0; m < 4; ++m) _Pragma("unroll") for (int n = 0; n < 2; ++n) \
            asm("v_mfma_f32_16x16x128_f8f6f4 %0, %1, %2, %0" : "+v"(acc[ai][bj][m][n]) : "v"(Bt##8[n]), "v"(At##8[m])); } \
        else if constexpr (I8) { _Pragma("unroll") for (int m = 0; m < 4; ++m) _Pragma("unroll") for (int n = 0; n < 2; ++n) _Pragma("unroll") for (int k = 0; k < 2; ++k) \
            acc[ai][bj][m][n] = __builtin_bit_cast(f32x4, __builtin_amdgcn_mfma_i32_16x16x64_i8(__builtin_bit_cast(i32x4v, Bt[n][k]), __builtin_bit_cast(i32x4v, At[m][k]), __builtin_bit_cast(i32x4v, acc[ai][bj][m][n]), 0, 0, 0)); } \
        else { _Pragma("unroll") for (int m = 0; m < 4; ++m) _Pragma("unroll") for (int n = 0; n < 2; ++n) _Pragma("unroll") for (int k = 0; k < 2; ++k) \
            acc[ai][bj][m][n] = __builtin_amdgcn_mfma_f32_16x16x32_bf16(Bt[n][k], At[m][k], acc[ai][bj][m][n], 0, 0, 0); } \
        __builtin_amdgcn_s_setprio(0); } while (0)
#define PG8_WAIT_V(n) asm volatile("s_waitcnt vmcnt(" #n ")" ::: "memory")
#define PG8_WAIT_L(n) asm volatile("s_waitcnt lgkmcnt(" #n ")" ::: "memory")
#define PG8_BAR __builtin_amdgcn_s_barrier()
#define PG8_SCHED __builtin_amdgcn_sched_barrier(0)
    Unit cur, nxt; int ui = 0;
    if (!S.next(0, cur)) return;
    f32x4 acc[2][2][4][2];
#pragma unroll
    for (int a = 0; a < 2; ++a)
#pragma unroll
        for (int b = 0; b < 2; ++b)
#pragma unroll
            for (int m = 0; m < 4; ++m)
#pragma unroll
                for (int n = 0; n < 2; ++n) acc[a][b][m][n] = (f32x4){0.f, 0.f, 0.f, 0.f};
    bf16x8 At[4][2], B0[2][2], B1[2][2];
    i32x8v At8[4], B08[2], B18[2];
    const char* cA = (const char*)g.A + (size_t)cur.pm * tstep; const char* cB = (const char*)g.Bt + (size_t)cur.pn * tstep;
    S.a_ready(cur);
    if constexpr (SP2) {
        PG8_STAGE(PG8_SB(0, 0), cB, voffB); PG8_STAGE(PG8_SB(0, 1), cB + hstep, voffB); PG8_STAGE(PG8_SA(0, 0), cA, voffA); PG8_STAGE(PG8_SA(0, 1), cA + hstep, voffA);
        if (wr == 1) PG8_BAR;
        PG8_WAIT_V(2); PG8_BAR;
        PG8_STAGE(PG8_SB(1, 0), cB + kstep, voffB); PG8_STAGE(PG8_SA(1, 0), cA + kstep, voffA); PG8_STAGE(PG8_SB(1, 1), cB + hstep + kstep, voffB);
        PG8_WAIT_V(6); PG8_BAR;
    } else {
        PG8_STAGE(PG8_SB(0, 0), cB, voffB); PG8_STAGE(PG8_SA(0, 0), cA, voffA); PG8_STAGE(PG8_SB(0, 1), cB + hstep, voffB); PG8_STAGE(PG8_SA(0, 1), cA + hstep, voffA);
        if (wr == 1) PG8_BAR;
        PG8_WAIT_V(4); PG8_BAR;
        PG8_STAGE(PG8_SB(1, 0), cB + kstep, voffB); PG8_STAGE(PG8_SA(1, 0), cA + kstep, voffA); PG8_STAGE(PG8_SB(1, 1), cB + hstep + kstep, voffB);
        PG8_WAIT_V(6); PG8_BAR;
    }
    for (;;) {
        const bool has_next = S.next(ui + 1, nxt);
        const char* nA = has_next ? (const char*)g.A + (size_t)nxt.pm * tstep : cA; const char* nB = has_next ? (const char*)g.Bt + (size_t)nxt.pn * tstep : cB;
        for (int t = 0; t < nt; t += 2) {
            const bool last = (t == nt - 2);
            if constexpr (FP8) __builtin_amdgcn_s_waitcnt(0xC07F);
            const char* a1 = cA + (size_t)(t + 1) * kstep;
            const char* a2 = last ? nA : cA + (size_t)(t + 2) * kstep; const char* b2 = last ? nB : cB + (size_t)(t + 2) * kstep;
            const char* a3 = a2 + kstep; const char* b3 = b2 + kstep;
            if (last && has_next) S.a_ready(nxt);
            if constexpr (SP2) {
            PG8_LDB(B0, 0, 0); PG8_LDB(B1, 0, 1); PG8_SCHED; PG8_LDA(At, 0, 0); PG8_STAGE(PG8_SA(1, 1), a1 + hstep, voffA);
            PG8_WAIT_V(8); PG8_WAIT_L(0); PG8_BAR; PG8_MMA(0, 0, At, B0); PG8_MMA(0, 1, At, B1); PG8_BAR; PG8_SCHED;
            PG8_LDA(At, 0, 1); PG8_STAGE(PG8_SB(0, 0), b2, voffB); PG8_STAGE(PG8_SB(0, 1), b2 + hstep, voffB); PG8_STAGE(PG8_SA(0, 0), a2, voffA);
            PG8_WAIT_V(8); PG8_WAIT_L(0); PG8_BAR; PG8_MMA(1, 0, At, B0); PG8_MMA(1, 1, At, B1); PG8_BAR; PG8_SCHED;
            PG8_LDB(B0, 1, 0); PG8_LDB(B1, 1, 1); PG8_SCHED; PG8_LDA(At, 1, 0); PG8_STAGE(PG8_SA(0, 1), a2 + hstep, voffA);
            PG8_WAIT_V(8); PG8_WAIT_L(0); PG8_BAR; PG8_MMA(0, 0, At, B0); PG8_MMA(0, 1, At, B1); PG8_BAR; PG8_SCHED;
            PG8_LDA(At, 1, 1); PG8_STAGE(PG8_SB(1, 0), b3, voffB); PG8_STAGE(PG8_SB(1, 1), b3 + hstep, voffB); PG8_STAGE(PG8_SA(1, 0), a3, voffA);
            PG8_WAIT_V(8); PG8_WAIT_L(0); PG8_BAR; PG8_MMA(1, 0, At, B0); PG8_MMA(1, 1, At, B1); PG8_BAR; PG8_SCHED;
            } else {
            PG8_LDB(B0, 0, 0); PG8_SCHED; PG8_LDA(At, 0, 0); PG8_STAGE(PG8_SA(1, 1), a1 + hstep, voffA);
            PG8_WAIT_L(8); PG8_BAR; PG8_WAIT_L(0); PG8_MMA(0, 0, At, B0); PG8_BAR; PG8_SCHED;
            PG8_LDB(B1, 0, 1); PG8_STAGE(PG8_SB(0, 0), b2, voffB);
            PG8_BAR; PG8_WAIT_L(0); PG8_MMA(0, 1, At, B1); PG8_BAR;
            PG8_LDA(At, 0, 1); PG8_STAGE(PG8_SA(0, 0), a2, voffA);
            PG8_BAR; PG8_WAIT_L(0); PG8_MMA(1, 0, At, B0); PG8_BAR; PG8_SCHED;
            PG8_STAGE(PG8_SB(0, 1), b2 + hstep, voffB);
            PG8_WAIT_V(6); PG8_BAR; PG8_MMA(1, 1, At, B1); PG8_BAR;
            PG8_LDB(B0, 1, 0); PG8_SCHED; PG8_LDA(At, 1, 0); PG8_STAGE(PG8_SA(0, 1), a2 + hstep, voffA);
            PG8_WAIT_L(8); PG8_BAR; PG8_WAIT_L(0); PG8_MMA(0, 0, At, B0); PG8_BAR; PG8_SCHED;
            PG8_LDB(B1, 1, 1); PG8_STAGE(PG8_SB(1, 0), b3, voffB);
            PG8_BAR; PG8_WAIT_L(0); PG8_MMA(0, 1, At, B1); PG8_BAR;
            PG8_LDA(At, 1, 1); PG8_STAGE(PG8_SA(1, 0), a3, voffA);
            PG8_BAR; PG8_WAIT_L(0); PG8_MMA(1, 0, At, B0); PG8_BAR; PG8_SCHED;
            PG8_STAGE(PG8_SB(1, 1), b3 + hstep, voffB);
            PG8_WAIT_V(6); PG8_BAR; PG8_MMA(1, 1, At, B1); PG8_BAR;
            }
        }
        if constexpr (FP8) asm volatile("s_nop 15\n\ts_nop 15" ::: "memory");
        if constexpr (ALIGN_EPI) { if (wr == 0) PG8_BAR; }
        if constexpr (!Epi::AFTER_DRAIN) { E(acc, cur, wr, wc, fr, fq); S.done(cur); }
        if (!has_next) break;
#pragma unroll
        for (int a = 0; a < 2; ++a)
#pragma unroll
            for (int b = 0; b < 2; ++b)
#pragma unroll
                for (int m = 0; m < 4; ++m)
#pragma unroll
                    for (int n = 0; n < 2; ++n) acc[a][b][m][n] = (f32x4){0.f, 0.f, 0.f, 0.f};
        cur = nxt; cA = nA; cB = nB; ++ui;
        if constexpr (ALIGN_EPI) { if (wr == 1) PG8_BAR; }
    }
    PG8_WAIT_V(0);
    if constexpr (!ALIGN_EPI) { if (wr == 0) PG8_BAR; }
    PG8_BAR;
    if constexpr (Epi::AFTER_DRAIN) { E.fused(acc, cur, wr, wc, fr, fq, lds, wid, lane); S.done(cur); }
#undef PG8_SA
#undef PG8_SB
#undef PG8_STAGE
#undef PG8_LDA
#undef PG8_LD16
#undef PG8_LDB
#undef PG8_MMA
#undef PG8_CAT
#undef PG8_WAIT_V
#undef PG8_WAIT_L
#undef PG8_BAR
#undef PG8_SCHED
}
}

template <class Epi, int QM = 0>
__device__ __forceinline__ void run_gemm(const Gemm g, Epi E, LAS float* lds, int vb, int nvb) {
    pg8::StaticOrder S; S.init(g.M, g.N, nvb, vb);
    if constexpr (Epi::USES_TAB) { LAS float* tab = (LAS float*)((LAS unsigned char*)lds + RSTD_TAB_OFF); build_rstd_table(S, E.ssq, tab); E.tab = tab; }
    pg8::gemm_phase<Epi, pg8::StaticOrder, true, true, QM>((LAS unsigned char*)lds, g, S, E);
}

enum { MAP_ID = 0, MAP_WIN = 1, MAP_GU = 2, MAP_WIN8 = 3   };
struct PrepJob { const float* W; int K, N; const float* gain; bf16_t* dst; int r0, r1, ldd, koff, map; int fmt; float osc; };
__device__ __forceinline__ int map_src(int map, int r, int N) {
    if (map == MAP_ID) return r < N ? r : -1;
    if (map == MAP_WIN) {
        if (r < 1728) return r - 512;
        if (r < 3776) return r - 504;
        if (r < 3784) return r - 2560;
        return -1;
    }
    if (map == MAP_WIN8) return r + 264;
    { const int tile = r >> 8, w = r & 255, j = tile * 128 + (w & 127); return w < 128 ? j : FF + j; }
}
__device__ __forceinline__ void prep_tile_load(const PrepJob& j, int t, f32x4 (&v)[8]) {
    const int nkt = j.K / 64, kt = t % nkt, rt = t / nkt, k0 = kt * 64, r0 = j.r0 + rt * 256;
#pragma unroll
    for (int q = 0; q < 8; ++q) {
        const int i = (int)threadIdx.x + q * NTHREADS, kk = i >> 6, r4 = (i & 63) * 4;
        const int sc = map_src(j.map, r0 + r4, j.N);
        v[q] = sc >= 0 ? __builtin_nontemporal_load((const f32x4*)(j.W + (size_t)(k0 + kk) * j.N + sc)) : (f32x4){0.f, 0.f, 0.f, 0.f};
        if (j.gain) v[q] = v[q] * j.gain[k0 + kk];
    }
}
__device__ __forceinline__ void prep_tile_store(const PrepJob& j, int t, const f32x4 (&v)[8], LAS float* tile  ) {
    const int nkt = j.K / 64, kt = t % nkt, rt = t / nkt, k0 = kt * 64, r0 = j.r0 + rt * 256;
    __syncthreads();
#pragma unroll
    for (int q = 0; q < 8; ++q) { const int i = (int)threadIdx.x + q * NTHREADS, kk = i >> 6, r4 = (i & 63) * 4; *(LAS f32x4*)(tile + kk * 260 + r4) = v[q]; }
    __syncthreads();
#pragma unroll
    for (int q = 0; q < 4; ++q) {
        const int i = (int)threadIdx.x + q * NTHREADS, rr = i & 255, c8 = i >> 8;
        const LAS float* tp = tile + (c8 * 8) * 260 + rr;
        if (j.fmt != 0) {
            const float sc = j.osc; u32x2 w;
            if (j.fmt == 1 || j.fmt == 3) { w.x = pk4_f8(tp[0] * sc, tp[260] * sc, tp[520] * sc, tp[780] * sc); w.y = pk4_f8(tp[1040] * sc, tp[1300] * sc, tp[1560] * sc, tp[1820] * sc); }
            else { w.x = pk4_i8(tp[0], tp[260], tp[520], tp[780], sc); w.y = pk4_i8(tp[1040], tp[1300], tp[1560], tp[1820], sc); }
            unsigned char* drow = (unsigned char*)j.dst + (size_t)(r0 + rr) * j.ldd + j.koff; const int kk = k0 + c8 * 8;
            if (j.fmt == 3) { const int r = kk & 127, pp = (kk & ~127) + (r >> 5) * 16 + ((r >> 3) & 3) * 4; *(unsigned*)(drow + pp) = w.x; *(unsigned*)(drow + pp + 64) = w.y; }
            else *(u32x2*)(drow + (j.fmt == 2 ? kperm8(kk) : kk)) = w;
        } else {
        u32x4 w; w.x = pk2(tp[0], tp[260]); w.y = pk2(tp[520], tp[780]); w.z = pk2(tp[1040], tp[1300]); w.w = pk2(tp[1560], tp[1820]);
        *(u32x4*)(j.dst + (size_t)(r0 + rr) * j.ldd + j.koff + k0 + c8 * 8) = w;
        }
    }
}
__device__ __forceinline__ void prep_fold_in(const float* w_in  , const float* w_uk  , const float* gain, bf16_t* dst, LAS float* lds, int vb, int nvb) {
    LAS float* A = lds; LAS float* B = lds + 32 * 65;
    const int tid = otid(), lane = tid & 63, wid = __builtin_amdgcn_readfirstlane(tid >> 6), l15 = lane & 15, dq = lane >> 4;
    for (int item = vb; item < 256; item += nvb) {
        const int h = item >> 5, k0 = (item & 31) * 32;
        __syncthreads();
        for (int i = tid; i < 2048; i += NTHREADS) { const int kk = i >> 6, d = i & 63; A[kk * 65 + d] = w_in[(size_t)(k0 + kk) * 3272 + h * 64 + d] * gain[k0 + kk]; }
        for (int i = tid; i < 8192; i += NTHREADS) { const int c = i >> 6, d = i & 63; B[c * 65 + d] = w_uk[(size_t)(h * 128 + c) * 64 + d]; }
        __syncthreads();
        f32x4 acc0 = (f32x4){0.f, 0.f, 0.f, 0.f}, acc1 = acc0;
#pragma unroll 4
        for (int d0 = 0; d0 < 64; d0 += 4) {
            const float b = B[(16 * wid + l15) * 65 + d0 + dq], a0 = A[l15 * 65 + d0 + dq], a1 = A[(16 + l15) * 65 + d0 + dq];
            acc0 = __builtin_amdgcn_mfma_f32_16x16x4f32(a0, b, acc0, 0, 0, 0);
            acc1 = __builtin_amdgcn_mfma_f32_16x16x4f32(a1, b, acc1, 0, 0, 0);
        }
        unsigned char* drow = (unsigned char*)dst + (size_t)(h * 128 + 16 * wid + l15) * 1024 + k0 + 4 * dq;
        *(unsigned*)drow = pk4_i8(acc0[0], acc0[1], acc0[2], acc0[3], WQ_GU);
        *(unsigned*)(drow + 16) = pk4_i8(acc1[0], acc1[1], acc1[2], acc1[3], WQ_GU);
    }
}
__device__ __forceinline__ void prep_fold_out(const float* w_out  , const float* w_uv  , bf16_t* dst  , LAS float* lds, int vb, int nvb) {
    LAS float* A = lds; LAS float* B = lds + 64 * 33;
    const int tid = otid(), lane = tid & 63, wid = __builtin_amdgcn_readfirstlane(tid >> 6), l15 = lane & 15, dq = lane >> 4;
    for (int item = vb; item < 256; item += nvb) {
        const int h = item >> 5, n0 = (item & 31) * 32;
        __syncthreads();
        for (int i = tid; i < 2048; i += NTHREADS) { const int d = i >> 5, nn = i & 31; A[d * 33 + nn] = w_out[(size_t)(h * 64 + d) * 1024 + n0 + nn]; }
        for (int i = tid; i < 8192; i += NTHREADS) { const int c = i >> 6, d = i & 63; B[c * 65 + d] = w_uv[(size_t)(h * 128 + c) * 64 + d]; }
        __syncthreads();
        f32x4 acc0 = (f32x4){0.f, 0.f, 0.f, 0.f}, acc1 = acc0;
#pragma unroll 4
        for (int d0 = 0; d0 < 64; d0 += 4) {
            const float a = B[(16 * wid + l15) * 65 + d0 + dq], b0 = A[(d0 + dq) * 33 + l15], b1 = A[(d0 + dq) * 33 + 16 + l15];
            acc0 = __builtin_amdgcn_mfma_f32_16x16x4f32(a, b0, acc0, 0, 0, 0);
            acc1 = __builtin_amdgcn_mfma_f32_16x16x4f32(a, b1, acc1, 0, 0, 0);
        }
        { u32x2 w; w.x = pk2(acc0[0], acc0[1]); w.y = pk2(acc0[2], acc0[3]); *(u32x2*)(dst + (size_t)(n0 + l15) * KOUT + h * 128 + 16 * wid + 4 * dq) = w; }
        { u32x2 w; w.x = pk2(acc1[0], acc1[1]); w.y = pk2(acc1[2], acc1[3]); *(u32x2*)(dst + (size_t)(n0 + 16 + l15) * KOUT + h * 128 + 16 * wid + 4 * dq) = w; }
    }
}
__device__ __forceinline__ void prep_lb(const float* hgrn_lb  , float* lb, int vb, int nvb) {
    for (int i = vb * NTHREADS + threadIdx.x; i < 512; i += nvb * NTHREADS) {
        const float a = hgrn_lb[i], b = hgrn_lb[512 + i], c = hgrn_lb[1024 + i], m = fmaxf(a, fmaxf(b, c));
        const float ea = __expf(a - m), eb = __expf(b - m), ec = __expf(c - m);
        lb[i] = ea / (ea + eb + ec);
    }
}

__device__ __forceinline__ void rmsnorm_rows(const float* X, unsigned char* Y8, int nrows, int vb, int nvb) {
    const int tid = otid(), lane = tid & 63, gw = vb * NWAVES + __builtin_amdgcn_readfirstlane(tid >> 6), ngw = nvb * NWAVES;
    for (int r = gw; r < nrows; r += ngw) {
        const f32x4* xr = (const f32x4*)(X + (size_t)r * D) + lane;
        f32x4 v[4]; float s = 0.f;
#pragma unroll
        for (int j = 0; j < 4; ++j) { v[j] = xr[64 * j]; s += (v[j].x * v[j].x + v[j].y * v[j].y) + (v[j].z * v[j].z + v[j].w * v[j].w); }
        const float rs = rsqrtf(wave_sum(s) * (1.f / D) + EPS) * HQ_X;
        unsigned* o = (unsigned*)(Y8 + (size_t)r * D) + lane;
#pragma unroll
        for (int j = 0; j < 4; ++j) o[64 * j] = pk4_i8(v[j].x, v[j].y, v[j].z, v[j].w, rs);
    }
}
__device__ __forceinline__ void x_to_h_rows(const float* X, bf16_t* H, unsigned char* X8, float* ssq, int vb, int nvb) {
    const int tid = otid(), lane = tid & 63, gw = vb * NWAVES + __builtin_amdgcn_readfirstlane(tid >> 6), ngw = nvb * NWAVES;
    for (int r = gw; r < T; r += 2 * ngw) {
        const int r2 = (r + ngw < T) ? r + ngw : r;
        f32x4 v[2][4];
#pragma unroll
        for (int j = 0; j < 4; ++j) { v[0][j] = __builtin_nontemporal_load((const f32x4*)(X + (size_t)r * D) + lane + 64 * j); v[1][j] = __builtin_nontemporal_load((const f32x4*)(X + (size_t)r2 * D) + lane + 64 * j); }
#pragma unroll
        for (int q = 0; q < 2; ++q) {
            const int rr = q ? r2 : r;
            u32x2* o = (u32x2*)(H + (size_t)rr * D) + lane;
            float s = 0.f;
#pragma unroll
            for (int j = 0; j < 4; ++j) { const f32x4 x = v[q][j]; u32x2 w; w.x = pk2(x.x, x.y); w.y = pk2(x.z, x.w); o[64 * j] = w;
                *((unsigned*)(X8 + (size_t)rr * D) + lane + 64 * j) = pk4_i8(x.x, x.y, x.z, x.w, HQ_X);
                const float a = bf2f((unsigned short)(w.x & 0xffffu)), b = bf2f((unsigned short)(w.x >> 16)), c = bf2f((unsigned short)(w.y & 0xffffu)), d = bf2f((unsigned short)(w.y >> 16));
                s += (a * a + b * b) + (c * c + d * d); }
            s = wave_sum(s);
            if (lane < 16) ssq[(size_t)rr * 16 + lane] = lane == 0 ? s : 0.f;
        }
    }
}
__device__ __forceinline__ void final_rows(const bf16_t* H, const float* ssq, const float* g, float* out, int vb, int nvb) {
    const int tid = otid(), lane = tid & 63, gw = vb * NWAVES + __builtin_amdgcn_readfirstlane(tid >> 6), ngw = nvb * NWAVES;
    f32x4 gg[4];
#pragma unroll
    for (int j = 0; j < 4; ++j) gg[j] = *((const f32x4*)g + lane + 64 * j);
    for (int r = gw; r < T; r += 2 * ngw) {
        const int r2 = (r + ngw < T) ? r + ngw : r;
        u32x2 w[2][4]; float rs[2];
#pragma unroll
        for (int j = 0; j < 4; ++j) { w[0][j] = ((const u32x2*)(H + (size_t)r * D) + lane)[64 * j]; w[1][j] = ((const u32x2*)(H + (size_t)r2 * D) + lane)[64 * j]; }
        rs[0] = row_rstd(ssq, (size_t)r); rs[1] = row_rstd(ssq, (size_t)r2);
#pragma unroll
        for (int q = 0; q < 2; ++q) {
            f32x4* o = (f32x4*)(out + (size_t)(q ? r2 : r) * D) + lane;
#pragma unroll
            for (int j = 0; j < 4; ++j) { const u32x2 ww = w[q][j];
                __builtin_nontemporal_store((f32x4){bf2f((unsigned short)(ww.x & 0xffffu)) * rs[q] * gg[j].x, bf2f((unsigned short)(ww.x >> 16)) * rs[q] * gg[j].y, bf2f((unsigned short)(ww.y & 0xffffu)) * rs[q] * gg[j].z, bf2f((unsigned short)(ww.y >> 16)) * rs[q] * gg[j].w}, o + 64 * j); }
        }
    }
}
__device__ __forceinline__ float row16_sum(float v) {
    v += __uint_as_float((unsigned)__builtin_amdgcn_update_dpp(0, (int)__float_as_uint(v), 0x128, 0xf, 0xf, false));
    v += __uint_as_float((unsigned)__builtin_amdgcn_update_dpp(0, (int)__float_as_uint(v), 0x124, 0xf, 0xf, false));
    v += __uint_as_float((unsigned)__builtin_amdgcn_update_dpp(0, (int)__float_as_uint(v), 0x122, 0xf, 0xf, false));
    v += __uint_as_float((unsigned)__builtin_amdgcn_update_dpp(0, (int)__float_as_uint(v), 0x121, 0xf, 0xf, false));
    return v;
}
__device__ __forceinline__ void cnorm_rows(const bf16_t* P, const float* lat_g, bf16_t* CN, int vb, int nvb) {
    const int tid = otid(), lane = tid & 63, gw = vb * NWAVES + __builtin_amdgcn_readfirstlane(tid >> 6), ngw = nvb * NWAVES, r4 = lane >> 4, l16 = lane & 15;
    const f32x4 ga = *(const f32x4*)(lat_g + l16 * 8), gb = *(const f32x4*)(lat_g + l16 * 8 + 4);
    for (int r = gw * 8; r < T; r += ngw * 8) {
        u32x4 w[2];
#pragma unroll
        for (int q = 0; q < 2; ++q) w[q] = *(const u32x4*)(P + (size_t)(r + 4 * q + r4) * PW + P_C + l16 * 8);
#pragma unroll
        for (int q = 0; q < 2; ++q) {
            const float x0 = bf2f((unsigned short)(w[q].x & 0xffffu)), x1 = bf2f((unsigned short)(w[q].x >> 16)), x2 = bf2f((unsigned short)(w[q].y & 0xffffu)), x3 = bf2f((unsigned short)(w[q].y >> 16));
            const float x4 = bf2f((unsigned short)(w[q].z & 0xffffu)), x5 = bf2f((unsigned short)(w[q].z >> 16)), x6 = bf2f((unsigned short)(w[q].w & 0xffffu)), x7 = bf2f((unsigned short)(w[q].w >> 16));
            const float ss = row16_sum(((x0 * x0 + x1 * x1) + (x2 * x2 + x3 * x3)) + ((x4 * x4 + x5 * x5) + (x6 * x6 + x7 * x7)));
            const float rs = rsqrtf(ss * (1.f / 128.f) + EPS);
            u32x4 o; o.x = pk2(x0 * rs * ga.x, x1 * rs * ga.y); o.y = pk2(x2 * rs * ga.z, x3 * rs * ga.w); o.z = pk2(x4 * rs * gb.x, x5 * rs * gb.y); o.w = pk2(x6 * rs * gb.z, x7 * rs * gb.w);
            *(u32x4*)(CN + (size_t)(r + 4 * q + r4) * 128 + l16 * 8) = o;
        }
    }
}
__device__ __forceinline__ int t5_bucket(int rel) {
    const int n = rel < 0 ? -rel : rel;
    int b = n < 8 ? n : 8 + (n >= 12) + (n >= 16) + (n >= 23) + (n >= 32) + (n >= 46) + (n >= 64) + (n >= 91);
    return b + (rel > 0 ? 16 : 0);
}
__device__ __forceinline__ unsigned sort_key(float x) { const unsigned u = __float_as_uint(x); return (u & 0x80000000u) ? ~u : (u | 0x80000000u); }


template <int CTRL, int ROWMASK> __device__ __forceinline__ unsigned dpp0(unsigned v) { return (unsigned)__builtin_amdgcn_update_dpp(0, (int)v, CTRL, ROWMASK, 0xf, false); }
__device__ __forceinline__ unsigned wave_prefix_incl(unsigned v) {
    v += dpp0<0x111, 0xf>(v); v += dpp0<0x112, 0xf>(v); v += dpp0<0x114, 0xf>(v); v += dpp0<0x118, 0xf>(v);
    v += dpp0<0x142, 0xa>(v);
    v += dpp0<0x143, 0xc>(v);
    return v;
}
__device__ __forceinline__ float wave_max_u(float v) {
    v = fmaxf(v, __uint_as_float((unsigned)__builtin_amdgcn_update_dpp(0, (int)__float_as_uint(v), 0x128, 0xf, 0xf, false)));
    v = fmaxf(v, __uint_as_float((unsigned)__builtin_amdgcn_update_dpp(0, (int)__float_as_uint(v), 0x124, 0xf, 0xf, false)));
    v = fmaxf(v, __uint_as_float((unsigned)__builtin_amdgcn_update_dpp(0, (int)__float_as_uint(v), 0x122, 0xf, 0xf, false)));
    v = fmaxf(v, __uint_as_float((unsigned)__builtin_amdgcn_update_dpp(0, (int)__float_as_uint(v), 0x121, 0xf, 0xf, false)));
    const int b = (int)__float_as_uint(v);
    return fmaxf(fmaxf(__uint_as_float((unsigned)__builtin_amdgcn_readlane(b, 0)), __uint_as_float((unsigned)__builtin_amdgcn_readlane(b, 16))),
                 fmaxf(__uint_as_float((unsigned)__builtin_amdgcn_readlane(b, 32)), __uint_as_float((unsigned)__builtin_amdgcn_readlane(b, 48))));
}

typedef short v4i16_t __attribute__((ext_vector_type(4)));
constexpr int DSA_BT_OFF = 131072 + 256, DSA_WS_OFF = DSA_BT_OFF + 6144;
__device__ __forceinline__ unsigned dsa_bucket(float x, float lo, float sc) { const float f = (x - lo) * sc; const unsigned b = (unsigned)f; return b > 255u ? 255u : b; }
__device__ __forceinline__ unsigned off_b(unsigned row, unsigned ch) { return 256u * row + 16u * (ch ^ (((row & 3) << 2) | ((row >> 2) & 3))); }
__device__ __forceinline__ void dsa_mfma_phase(const bf16_t* P, const bf16_t* CN, const float* rel_bias, bf16_t* CAT, LAS unsigned char* lds, unsigned* qctr) {
    const int tid = otid(), lane = tid & 63, wid = __builtin_amdgcn_readfirstlane(tid >> 6);
    LAS float* BT = (LAS float*)(lds + DSA_BT_OFF);
    __syncthreads();
    for (int i = tid; i < 191 * 8; i += NTHREADS) { const int rel = (i >> 3) - 127; BT[i] = rel_bias[t5_bucket(rel) * 8 + (i & 7)]; }
    const unsigned long long lt_mask = (lane == 0) ? 0ull : (~0ull >> (64 - lane));
    volatile LAS int* qslot = (volatile LAS int*)(lds + 131072 + 64);
    int nxt = 0;
    if (tid == 0) { *qslot = (int)atomicAdd(qctr, 1u); nxt = (int)atomicAdd(qctr, 1u); }
    for (;;) {
        __syncthreads();
        const int u = *qslot;
        if (u >= T / 16) break;
        const int b = u & 15, qg = 127 - (u >> 4), t0 = qg * 16, nj = t0 / CHUNK + 1, L = nj * CHUNK, nt = L / 32;
        const bf16_t* Pb = P + (size_t)b * SEQ * PW;
        {
            int ln1 = lane; asm volatile("" : "+v"(ln1));
            const int rho = ln1 & 31, hf = ln1 >> 5;
            const int qq = 2 * ((rho >> 2) & 1) + (rho >> 4), hh = 4 * ((rho >> 3) & 1) + (rho & 3);
            bf16x8 qa[4][4], wa[4], wc[4];
#pragma unroll
            for (int qd = 0; qd < 4; ++qd) {
                const bf16_t* qrow = Pb + (size_t)(t0 + 4 * qd + qq) * PW + P_QI + hh * 64 + 8 * hf;
#pragma unroll
                for (int ks = 0; ks < 4; ++ks) qa[qd][ks] = *(const bf16x8*)(qrow + ks * 16);
                wa[qd] = *(const bf16x8*)(Pb + (size_t)(t0 + 4 * qd + 2 * hf) * PW + P_WI); wc[qd] = *(const bf16x8*)(Pb + (size_t)(t0 + 4 * qd + 2 * hf + 1) * PW + P_WI);
            }
            LAS float* sc0 = (LAS float*)lds + (2 * hf) * 2048 + rho;
            const bf16_t* kbase = Pb + (size_t)rho * PW + P_KI + 8 * hf;
            bf16x8 kb[4], kn[4];
#pragma unroll
            for (int ks = 0; ks < 4; ++ks) { kb[ks] = (bf16x8){0, 0, 0, 0, 0, 0, 0, 0}; kn[ks] = kb[ks]; }
            if (wid < nt) {
#pragma unroll
                for (int ks = 0; ks < 4; ++ks) kb[ks] = *(const bf16x8*)(kbase + (size_t)wid * 32 * PW + ks * 16);
            }
            for (int kt = wid; kt < nt; kt += 8) {
                if (kt + 8 < nt) {
#pragma unroll
                    for (int ks = 0; ks < 4; ++ks) kn[ks] = *(const bf16x8*)(kbase + (size_t)(kt + 8) * 32 * PW + ks * 16);
                }
#pragma unroll
                for (int qd = 0; qd < 4; ++qd) {
                    f32x16 acc;
#pragma unroll
                    for (int r = 0; r < 16; ++r) acc[r] = 0.f;
#pragma unroll
                    for (int ks = 0; ks < 4; ++ks) acc = __builtin_amdgcn_mfma_f32_32x32x16_bf16(qa[qd][ks], kb[ks], acc, 0, 0, 0);
                    float s0 = 0.f, s1 = 0.f;
#pragma unroll
                    for (int e = 0; e < 8; ++e) { s0 += bf2f((unsigned short)wa[qd][e]) * fmaxf(acc[e], 0.f); s1 += bf2f((unsigned short)wc[qd][e]) * fmaxf(acc[8 + e], 0.f); }
                    sc0[(4 * qd) * 2048 + kt * 32] = s0 * (0.35355339059327373f * 0.125f); sc0[(4 * qd + 1) * 2048 + kt * 32] = s1 * (0.35355339059327373f * 0.125f);
                }
#pragma unroll
                for (int ks = 0; ks < 4; ++ks) kb[ks] = kn[ks];
            }
        }
        __syncthreads();
        if (tid == 0) { *qslot = nxt; nxt = (int)atomicAdd(qctr, 1u); }
        LAS unsigned char* pair = lds + wid * 16384;
        LAS unsigned char* wsc = lds + DSA_WS_OFF + wid * 2560;
        LAS unsigned* HIST = (LAS unsigned*)wsc; LAS float* CANDV = (LAS float*)(wsc + 1024); LAS unsigned* CANDI = (LAS unsigned*)(wsc + 1280);
        const int nsel = L < 256 ? L : 256;
        int lna = lane; asm volatile("" : "+v"(lna));
#pragma unroll 1
        for (int e2 = 0; e2 < 2; ++e2) {
            LAS unsigned short* IDX = (LAS unsigned short*)(wsc + 1536 + e2 * 512);
            if (nj > 4) {
                const LAS float* SCq = (const LAS float*)(pair + e2 * 8192);
                float x[32];
#pragma unroll
                for (int j = 0; j < 32; ++j) x[j] = (j < nj) ? SCq[j * 64 + lna] : 0.f;
                float lo = INFINITY, hi = -INFINITY;
#pragma unroll
                for (int j = 0; j < 32; ++j) if (j < nj) { hi = fmaxf(hi, x[j]); lo = fminf(lo, x[j]); }
                hi = wave_max_u(hi); lo = -wave_max_u(-lo);
                bool done = false;
                if (hi > lo) {
                    const float sc = 256.f / (hi - lo);
                    *(LAS u32x4*)(HIST + 4 * lna) = (u32x4){0u, 0u, 0u, 0u};
                    WAVE_LDS_SYNC();
#pragma unroll
                    for (int j = 0; j < 32; ++j) if (j < nj) { const unsigned bk = dsa_bucket(x[j], lo, sc); __hip_atomic_fetch_add(HIST + bk, 1u, __ATOMIC_RELAXED, __HIP_MEMORY_SCOPE_WORKGROUP); }
                    WAVE_LDS_SYNC();
                    const u32x4 h4 = *(const LAS u32x4*)(HIST + 4 * lna);
                    const unsigned cl = (h4.x + h4.y) + (h4.z + h4.w);
                    const unsigned pfx = wave_prefix_incl(cl);
                    const unsigned Sx = (unsigned)__builtin_amdgcn_readlane((int)pfx, 63) - pfx + cl;
                    const int lstar = __popcll(__ballot(Sx >= 256u)) - 1;
                    const unsigned above = Sx - cl, t3 = above + h4.w, t2 = t3 + h4.z, t1 = t2 + h4.y;
                    const unsigned bl = t3 >= 256u ? 3u : (t2 >= 256u ? 2u : (t1 >= 256u ? 1u : 0u));
                    const unsigned al = bl == 3u ? above : (bl == 2u ? t3 : (bl == 1u ? t2 : t1));
                    const unsigned ml = bl == 3u ? h4.w : (bl == 2u ? h4.z : (bl == 1u ? h4.y : h4.x));
                    const unsigned bstar = (unsigned)__builtin_amdgcn_readlane((int)(4u * lna + bl), lstar);
                    const int a = __builtin_amdgcn_readlane((int)al, lstar), m = __builtin_amdgcn_readlane((int)ml, lstar);
                    if (m <= 64) {
                        done = true;
                        const int need = 256 - a;
                        unsigned msel = 0u, mcand = 0u;
#pragma unroll
                        for (int j = 31; j >= 0; --j) if (j < nj) { const unsigned bk = dsa_bucket(x[j], lo, sc); msel = msel + msel + (bk > bstar ? 1u : 0u); mcand = mcand + mcand + (bk == bstar ? 1u : 0u); }
                        const unsigned pk = (unsigned)__popc(msel) | ((unsigned)__popc(mcand) << 16);
                        const unsigned inc = wave_prefix_incl(pk);
                        unsigned off = (inc - pk) & 0xffffu, coff = (inc - pk) >> 16;
                        while (msel) { const int j = __ffs((int)msel) - 1; msel &= msel - 1u; IDX[off++] = (unsigned short)(j * 64 + lna); }
                        while (mcand) { const int j = __ffs((int)mcand) - 1; mcand &= mcand - 1u; CANDV[coff] = SCq[j * 64 + lna]; CANDI[coff] = (unsigned)(j * 64 + lna); ++coff; }
                        WAVE_LDS_SYNC();
                        const float cv = CANDV[lna < m ? lna : 0]; const unsigned ci = CANDI[lna < m ? lna : 0];
                        int rank = 0;
                        for (int k = 0; k < m; ++k) { const float v = __uint_as_float((unsigned)__builtin_amdgcn_readlane((int)__float_as_uint(cv), k)); const unsigned id = (unsigned)__builtin_amdgcn_readlane((int)ci, k); rank += (v > cv || (v == cv && id < ci)) ? 1 : 0; }
                        if (lna < m && rank < need) IDX[a + rank] = (unsigned short)ci;
                    }
                }
                if (!done) {
                    unsigned lo_k = 0xffffffffu, hi_k = 0u;
#pragma unroll
                    for (int j = 0; j < 32; ++j) if (j < nj) { const unsigned kx = sort_key(x[j]); hi_k = kx > hi_k ? kx : hi_k; lo_k = kx < lo_k ? kx : lo_k; }
#pragma unroll
                    for (int o = 1; o < 64; o <<= 1) { const unsigned h2 = (unsigned)__shfl_xor((int)hi_k, o), l2 = (unsigned)__shfl_xor((int)lo_k, o); hi_k = h2 > hi_k ? h2 : hi_k; lo_k = l2 < lo_k ? l2 : lo_k; }
                    lo_k = (unsigned)__builtin_amdgcn_readfirstlane((int)lo_k); hi_k = (unsigned)__builtin_amdgcn_readfirstlane((int)hi_k);
                    bool exact = false;
                    while (lo_k < hi_k) {
                        const unsigned mid = lo_k + ((hi_k - lo_k + 1u) >> 1);
                        int cnt = 0;
#pragma unroll
                        for (int j = 0; j < 32; ++j) cnt += __popcll(__ballot(j < nj && sort_key(x[j]) >= mid));
                        if (cnt == 256) { lo_k = mid; exact = true; break; }
                        if (cnt > 256) lo_k = mid; else hi_k = mid - 1u;
                    }
                    const unsigned Tv = lo_k;
                    int need = 0;
                    if (!exact) { int cgt = 0;
#pragma unroll
                        for (int j = 0; j < 32; ++j) cgt += __popcll(__ballot(j < nj && sort_key(x[j]) > Tv));
                        need = 256 - cgt; }
                    int base = 0, eqt = 0;
#pragma unroll
                    for (int j = 0; j < 32; ++j) {
                        const unsigned kx = sort_key(x[j]);
                        const bool gt = (j < nj) && (exact ? (kx >= Tv) : (kx > Tv)), eq = (j < nj) && !exact && (kx == Tv);
                        const unsigned long long meq = __ballot(eq);
                        const bool sel = gt || (eq && (eqt + __popcll(meq & lt_mask)) < need);
                        const unsigned long long ms = __ballot(sel);
                        if (sel) IDX[base + __popcll(ms & lt_mask)] = (unsigned short)(j * 64 + lna);
                        base += __popcll(ms); eqt += __popcll(meq);
                    }
                }
            } else {
#pragma unroll
                for (int i = 0; i < 4; ++i) IDX[i * 64 + lna] = (unsigned short)(i * 64 + lna);
            }
        }
        WAVE_LDS_SYNC();
        {
            int lnb = lane; asm volatile("" : "+v"(lnb));
            const int head = lnb & 15, kg = lnb >> 4, nblk = nsel >> 5;
            LAS unsigned char* GB = pair;
            const bf16_t* CNb = CN + (size_t)b * SEQ * 128;
            const int rho = lnb & 15;
            const unsigned rw0 = 8 * (rho >> 2) + (rho & 3), rw1 = rw0 + 4;
            const unsigned xa0 = ((rw0 & 3) << 2) | ((rw0 >> 2) & 3), xa1 = ((rw1 & 3) << 2) | ((rw1 >> 2) & 3);
            const unsigned q4 = (lnb & 15) >> 2, p4 = lnb & 3;
            u32x4 gA[8], gB[8];
#define DSA_GATHER(G, IX, blk) do { _Pragma("unroll") for (int it = 0; it < 8; ++it) { const int sp = (IX)[(blk) * 32 + (lnb >> 4) + 4 * it]; G[it] = *(const u32x4*)(CNb + (size_t)sp * 128 + (lnb & 15) * 8); } } while (0)
            { const LAS unsigned short* IDX0 = (const LAS unsigned short*)(wsc + 1536); DSA_GATHER(gA, IDX0, 0); DSA_GATHER(gB, IDX0, 1); }
#pragma unroll 1
            for (int e2 = 0; e2 < 2; ++e2) {
                const int t = t0 + 2 * wid + e2;
                const size_t row = (size_t)b * SEQ + t;
                const LAS unsigned short* IDX = (const LAS unsigned short*)(wsc + 1536 + e2 * 512);
                bf16x8 qlf[4];
#pragma unroll
                for (int s4 = 0; s4 < 4; ++s4) { qlf[s4] = *(const bf16x8*)(P + row * PW + P_QL + (head & 7) * 128 + s4 * 32 + 8 * kg); if (head >= 8) qlf[s4] = (bf16x8){0, 0, 0, 0, 0, 0, 0, 0}; }
                f32x4 o[8];
#pragma unroll
                for (int ct = 0; ct < 8; ++ct) o[ct] = (f32x4){0.f, 0.f, 0.f, 0.f};
                float m = -INFINITY, lsum = 0.f;
#define DSA_STEP(G, kbx) do { \
                    WAVE_LDS_SYNC();                              \
                    _Pragma("unroll") for (int it = 0; it < 8; ++it) *(LAS u32x4*)(GB + off_b((lnb >> 4) + 4 * it, lnb & 15)) = G[it]; \
                    const bf16x8 iv = *(const LAS bf16x8*)((const LAS unsigned char*)IDX + ((kbx) * 32 + 8 * kg) * 2);     \
                    if ((kbx) + 2 < nblk) DSA_GATHER(G, IDX, (kbx) + 2); else if (e2 == 0) DSA_GATHER(G, IDX + 256, (kbx) + 2 - nblk); \
                    WAVE_LDS_SYNC(); \
                      \
                    bf16x8 k0[4], k1[4], af[8]; \
                    _Pragma("unroll") for (int s4 = 0; s4 < 4; ++s4) { \
                        k0[s4] = *(const LAS bf16x8*)(GB + 256u * rw0 + 16u * ((4 * s4 + kg) ^ xa0)); \
                        k1[s4] = *(const LAS bf16x8*)(GB + 256u * rw1 + 16u * ((4 * s4 + kg) ^ xa1)); } \
                    float bia[8]; \
                    _Pragma("unroll") for (int e = 0; e < 8; ++e) { const int sp = (int)(unsigned short)iv[e]; int rel = sp - t; rel = rel < -127 ? -127 : rel; bia[e] = BT[(rel + 127) * 8 + (head & 7)]; } \
                      \
                    f32x4 a0 = (f32x4){0.f, 0.f, 0.f, 0.f}, a1 = (f32x4){0.f, 0.f, 0.f, 0.f}; \
                    _Pragma("unroll") for (int s4 = 0; s4 < 4; ++s4) { \
                        a0 = __builtin_amdgcn_mfma_f32_16x16x32_bf16(k0[s4], qlf[s4], a0, 0, 0, 0); \
                        a1 = __builtin_amdgcn_mfma_f32_16x16x32_bf16(k1[s4], qlf[s4], a1, 0, 0, 0); } \
                    asm volatile("" : "+v"(a0), "+v"(a1));        \
                    _Pragma("unroll") for (int ct = 0; ct < 8; ++ct) {              \
                        const v4i16_t lo4 = __builtin_amdgcn_ds_read_tr16_b64_v4i16((LAS v4i16_t*)(GB + off_b(8 * kg + q4, 2 * ct + (p4 >> 1)) + 8 * (p4 & 1))); \
                        const v4i16_t hi4 = __builtin_amdgcn_ds_read_tr16_b64_v4i16((LAS v4i16_t*)(GB + off_b(8 * kg + 4 + q4, 2 * ct + (p4 >> 1)) + 8 * (p4 & 1))); \
                        af[ct] = (bf16x8){lo4[0], lo4[1], lo4[2], lo4[3], hi4[0], hi4[1], hi4[2], hi4[3]}; } \
                      \
                    float lg[8]; \
                    _Pragma("unroll") for (int e = 0; e < 8; ++e) lg[e] = (e < 4 ? a0[e] : a1[e - 4]) * 0.125f + bia[e]; \
                    const float mloc = fmaxf(fmaxf(fmaxf(lg[0], lg[1]), fmaxf(lg[2], lg[3])), fmaxf(fmaxf(lg[4], lg[5]), fmaxf(lg[6], lg[7]))); \
                      \
                    float scl = 1.f; \
                    if (__any(mloc > m + 16.f)) { \
                        float mb = fmaxf(mloc, __shfl_xor(mloc, 16)); mb = fmaxf(mb, __shfl_xor(mb, 32)); \
                        const float mn = fmaxf(m, mb); scl = __expf(m - mn); m = mn; \
                        _Pragma("unroll") for (int ct = 0; ct < 8; ++ct) o[ct] = o[ct] * scl; } \
                    float ps = 0.f; float pe[8]; \
                    _Pragma("unroll") for (int e = 0; e < 8; ++e) { pe[e] = __expf(lg[e] - m); ps += pe[e]; } \
                    lsum = lsum * scl + ps; \
                    u32x4 pw; pw.x = pk2(pe[0], pe[1]); pw.y = pk2(pe[2], pe[3]); pw.z = pk2(pe[4], pe[5]); pw.w = pk2(pe[6], pe[7]); \
                    const bf16x8 pb = __builtin_bit_cast(bf16x8, pw); \
                    _Pragma("unroll") for (int ct = 0; ct < 8; ++ct) o[ct] = __builtin_amdgcn_mfma_f32_16x16x32_bf16(af[ct], pb, o[ct], 0, 0, 0); \
                } while (0)
#pragma unroll 1
                for (int kb2 = 0; kb2 < nblk; kb2 += 2) { DSA_STEP(gA, kb2); DSA_STEP(gB, kb2 + 1); }
#undef DSA_STEP
                lsum += __shfl_xor(lsum, 16); lsum += __shfl_xor(lsum, 32);
                const float inv = 1.f / lsum;
                if (head < 8) {
                    bf16_t* op = CAT + row * KOUT + head * 128 + 4 * kg;
#pragma unroll
                    for (int ct = 0; ct < 8; ++ct) { u32x2 w; w.x = pk2(o[ct][0] * inv, o[ct][1] * inv); w.y = pk2(o[ct][2] * inv, o[ct][3] * inv); *(u32x2*)(op + ct * 16) = w; }
                }
            }
#undef DSA_GATHER
        }
    }
}

constexpr size_t WS_DEC = 492 * MiB;
__device__ __forceinline__ void hgrn_prep(bf16_t* P, const float* lb, float* DEC, LAS unsigned char* lds, int vb, int nvb) {
    const int tid = otid(), cl = tid >> 7, d = tid & 127;
    LAS bf16_t* Ft = (LAS bf16_t*)lds; LAS bf16_t* Qt = (LAS bf16_t*)(lds + 65536);
    for (int it = vb; it < BATCH * 4 * 8; it += nvb) {
        const int b = it >> 5, h = (it >> 3) & 3, cg = it & 7;
        bf16_t* base = P + ((size_t)b * SEQ + cg * 256) * PW + h * 128;
        u32x4 v[16];
#pragma unroll
        for (int k = 0; k < 16; ++k) { const int i = tid + 512 * k, tl = i >> 12, r = (i >> 4) & 255, ch = i & 15; v[k] = *(const u32x4*)(base + (size_t)r * PW + (tl ? P_QB : P_FB) + ch * 8); }
        __syncthreads();
#pragma unroll
        for (int k = 0; k < 16; ++k) { const int i = tid + 512 * k, tl = i >> 12, r = (i >> 4) & 255, ch = i & 15; *(LAS u32x4*)(lds + tl * 65536 + r * 256 + ch * 16) = v[k]; }
        __syncthreads();
        {
            const float l = lb[h * 128 + d];
            LAS bf16_t* fcol = Ft + (cl * 64) * 128 + d; LAS bf16_t* qcol = Qt + (cl * 64) * 128 + d;
            float up = 1.f;
#pragma unroll 8
            for (int t = 32; t < 64; ++t) {
                const float f = l + (1.f - l) * sigmoid_f(bf2f(fcol[t * 128]));
                up *= f;
                const float q = silu_f(bf2f(qcol[t * 128]));
                qcol[t * 128] = (bf16_t)f2bf(q * up);
                fcol[t * 128] = (bf16_t)f2bf((1.f - f) * __builtin_amdgcn_rcpf(up));
            }
            float dn = 1.f;
#pragma unroll 8
            for (int t = 31; t >= 0; --t) {
                const float f = l + (1.f - l) * sigmoid_f(bf2f(fcol[t * 128]));
                const float q = silu_f(bf2f(qcol[t * 128]));
                qcol[t * 128] = (bf16_t)f2bf(q * __builtin_amdgcn_rcpf(dn));
                fcol[t * 128] = (bf16_t)f2bf((1.f - f) * dn);
                dn *= f;
            }
            float* dc = DEC + ((size_t)((b * 4 + h) * 32 + cg * 4 + cl) * 3) * 128 + d;
            dc[0] = dn; dc[128] = dn * up; dc[256] = up;
        }
        __syncthreads();
#pragma unroll
        for (int k = 0; k < 16; ++k) { const int i = tid + 512 * k, tl = i >> 12, r = (i >> 4) & 255, ch = i & 15; *(u32x4*)(base + (size_t)r * PW + (tl ? P_QB : P_FB) + ch * 8) = *(const LAS u32x4*)(lds + tl * 65536 + r * 256 + ch * 16); }
    }
}

__device__ __forceinline__ void hgrn_scan(const bf16_t* P, const float* DEC, const float* o_g, bf16_t* CAT, LAS unsigned char* lds, int item) {
    const int tid = otid(), lane = tid & 63, wid = __builtin_amdgcn_readfirstlane(tid >> 6), li = lane & 15, kg = lane >> 4;
    const int b = item >> 2, h = item & 3, it = wid >> 1, vh = wid & 1;
    LAS unsigned char* ST = lds + 98304;
    LAS float* SSQ = (LAS float*)(lds + DSA_BT_OFF);
    const bf16_t* Pb = P + (size_t)b * SEQ * PW;
    const float* DECb = DEC + (size_t)((b * 4 + h) * 32) * 384;
    f32x4 S[8];
#pragma unroll
    for (int vt = 0; vt < 8; ++vt) S[vt] = (f32x4){0.f, 0.f, 0.f, 0.f};
    u32x4 sg[6];
    const int colbase[3] = {P_QB, P_FB, P_IB};
#define HG_LOAD(c) do { _Pragma("unroll") for (int k = 0; k < 6; ++k) { const int n = tid + 512 * k, tl = n >> 10, r = (n >> 4) & 63, ch = n & 15; \
        sg[k] = *(const u32x4*)(Pb + (size_t)((c) * 64 + r) * PW + colbase[tl] + h * 128 + ch * 8); } } while (0)
#define HG_STORE(buf) do { _Pragma("unroll") for (int k = 0; k < 6; ++k) { const int n = tid + 512 * k, tl = n >> 10, r = (n >> 4) & 63, ch = n & 15; \
        *(LAS u32x4*)(lds + (buf) * 49152 + tl * 16384 + off_b(r, ch)) = sg[k]; } } while (0)
    HG_LOAD(0);
    __syncthreads();
    HG_STORE(0);
    const unsigned q4 = (lane & 15) >> 2, p4 = lane & 3;
    f32x4 ogv[4];
#pragma unroll
    for (int vv = 0; vv < 4; ++vv) ogv[vv] = *(const f32x4*)(o_g + 16 * (4 * vh + vv) + 4 * kg);
    float er_next = DECb[16 * wid + li];
#pragma unroll 1
    for (int c = 0; c < 32; ++c) {
        const int buf = c & 1;
        LAS unsigned char* QI = lds + buf * 49152; LAS unsigned char* KI = QI + 16384; LAS unsigned char* VI = QI + 32768;
        if (c + 1 < 32) HG_LOAD(c + 1);
        const float er = er_next, e63 = DECb[c * 384 + 128 + 16 * wid + li], e6r = DECb[c * 384 + 256 + 16 * wid + li];
        er_next = DECb[(c + 1 < 32 ? c + 1 : c) * 384 + 16 * wid + li];
        u32x2 gwv[4];
#pragma unroll
        for (int vv = 0; vv < 4; ++vv) gwv[vv] = *(const u32x2*)(P + ((size_t)b * SEQ + c * 64 + 16 * it + li) * PW + P_GB + h * 128 + 16 * (4 * vh + vv) + 4 * kg);
        { const unsigned d = 16 * wid + li;
#pragma unroll
          for (int vt = 0; vt < 8; ++vt) { u32x2 w; w.x = pk2(S[vt][0] * er, S[vt][1] * er); w.y = pk2(S[vt][2] * er, S[vt][3] * er);
              *(LAS u32x2*)(ST + off_b(d, 2 * vt + (kg >> 1)) + 8 * (kg & 1)) = w; } }
        __syncthreads();
        bf16x8 qf[4];
#pragma unroll
        for (int ks = 0; ks < 4; ++ks) qf[ks] = *(const LAS bf16x8*)(QI + off_b(16 * it + li, 4 * ks + kg));
        f32x4 o[4];
#pragma unroll
        for (int vv = 0; vv < 4; ++vv) o[vv] = (f32x4){0.f, 0.f, 0.f, 0.f};
#pragma unroll
        for (int ks = 0; ks < 4; ++ks)
#pragma unroll
            for (int vv = 0; vv < 4; ++vv) {
                const int ct = 4 * vh + vv;
                const v4i16_t lo4 = __builtin_amdgcn_ds_read_tr16_b64_v4i16((LAS v4i16_t*)(ST + off_b(32 * ks + 8 * kg + q4, 2 * ct + (p4 >> 1)) + 8 * (p4 & 1)));
                const v4i16_t hi4 = __builtin_amdgcn_ds_read_tr16_b64_v4i16((LAS v4i16_t*)(ST + off_b(32 * ks + 8 * kg + 4 + q4, 2 * ct + (p4 >> 1)) + 8 * (p4 & 1)));
                const bf16x8 af = (bf16x8){lo4[0], lo4[1], lo4[2], lo4[3], hi4[0], hi4[1], hi4[2], hi4[3]};
                o[vv] = __builtin_amdgcn_mfma_f32_16x16x32_bf16(af, qf[ks], o[vv], 0, 0, 0);
            }
        const int njb = (it >> 1) + 1;
#pragma unroll
        for (int jb = 0; jb < 2; ++jb) {
            if (jb < njb) {
                f32x4 a0 = (f32x4){0.f, 0.f, 0.f, 0.f}, a1 = (f32x4){0.f, 0.f, 0.f, 0.f};
                const unsigned rw0 = 32 * jb + 8 * (li >> 2) + (li & 3), rw1 = rw0 + 4;
#pragma unroll
                for (int ks = 0; ks < 4; ++ks) {
                    const bf16x8 k0 = *(const LAS bf16x8*)(KI + off_b(rw0, 4 * ks + kg));
                    const bf16x8 k1 = *(const LAS bf16x8*)(KI + off_b(rw1, 4 * ks + kg));
                    a0 = __builtin_amdgcn_mfma_f32_16x16x32_bf16(k0, qf[ks], a0, 0, 0, 0);
                    a1 = __builtin_amdgcn_mfma_f32_16x16x32_bf16(k1, qf[ks], a1, 0, 0, 0);
                }
                const int ii = 16 * it + li, j0 = 32 * jb + 8 * kg;
                float am[8];
#pragma unroll
                for (int e = 0; e < 8; ++e) am[e] = (j0 + e <= ii) ? (e < 4 ? a0[e] : a1[e - 4]) : 0.f;
                u32x4 pw; pw.x = pk2(am[0], am[1]); pw.y = pk2(am[2], am[3]); pw.z = pk2(am[4], am[5]); pw.w = pk2(am[6], am[7]);
                const bf16x8 pb = __builtin_bit_cast(bf16x8, pw);
#pragma unroll
                for (int vv = 0; vv < 4; ++vv) {
                    const int ct = 4 * vh + vv;
                    const v4i16_t lo4 = __builtin_amdgcn_ds_read_tr16_b64_v4i16((LAS v4i16_t*)(VI + off_b(32 * jb + 8 * kg + q4, 2 * ct + (p4 >> 1)) + 8 * (p4 & 1)));
                    const v4i16_t hi4 = __builtin_amdgcn_ds_read_tr16_b64_v4i16((LAS v4i16_t*)(VI + off_b(32 * jb + 8 * kg + 4 + q4, 2 * ct + (p4 >> 1)) + 8 * (p4 & 1)));
                    const bf16x8 af = (bf16x8){lo4[0], lo4[1], lo4[2], lo4[3], hi4[0], hi4[1], hi4[2], hi4[3]};
                    o[vv] = __builtin_amdgcn_mfma_f32_16x16x32_bf16(af, pb, o[vv], 0, 0, 0);
                }
            }
        }
        {
            f32x4 U[8];
#pragma unroll
            for (int vt = 0; vt < 8; ++vt) U[vt] = (f32x4){0.f, 0.f, 0.f, 0.f};
#pragma unroll
            for (int ks = 0; ks < 2; ++ks) {
                const v4i16_t kl = __builtin_amdgcn_ds_read_tr16_b64_v4i16((LAS v4i16_t*)(KI + off_b(32 * ks + 8 * kg + q4, 2 * wid + (p4 >> 1)) + 8 * (p4 & 1)));
                const v4i16_t kh = __builtin_amdgcn_ds_read_tr16_b64_v4i16((LAS v4i16_t*)(KI + off_b(32 * ks + 8 * kg + 4 + q4, 2 * wid + (p4 >> 1)) + 8 * (p4 & 1)));
                const bf16x8 kfr = (bf16x8){kl[0], kl[1], kl[2], kl[3], kh[0], kh[1], kh[2], kh[3]};
#pragma unroll
                for (int vt = 0; vt < 8; ++vt) {
                    const v4i16_t lo4 = __builtin_amdgcn_ds_read_tr16_b64_v4i16((LAS v4i16_t*)(VI + off_b(32 * ks + 8 * kg + q4, 2 * vt + (p4 >> 1)) + 8 * (p4 & 1)));
                    const v4i16_t hi4 = __builtin_amdgcn_ds_read_tr16_b64_v4i16((LAS v4i16_t*)(VI + off_b(32 * ks + 8 * kg + 4 + q4, 2 * vt + (p4 >> 1)) + 8 * (p4 & 1)));
                    const bf16x8 af = (bf16x8){lo4[0], lo4[1], lo4[2], lo4[3], hi4[0], hi4[1], hi4[2], hi4[3]};
                    U[vt] = __builtin_amdgcn_mfma_f32_16x16x32_bf16(af, kfr, U[vt], 0, 0, 0);
                }
            }
#pragma unroll
            for (int vt = 0; vt < 8; ++vt) S[vt] = S[vt] * e63 + U[vt] * e6r;
        }
        float ss = 0.f;
#pragma unroll
        for (int vv = 0; vv < 4; ++vv) ss += (o[vv][0] * o[vv][0] + o[vv][1] * o[vv][1]) + (o[vv][2] * o[vv][2] + o[vv][3] * o[vv][3]);
        ss += __shfl_xor(ss, 16); ss += __shfl_xor(ss, 32);
        if (kg == 0) SSQ[(it * 2 + vh) * 16 + li] = ss;
        __syncthreads();
        if (c + 1 < 32) HG_STORE(buf ^ 1);
        {
            const float tot = SSQ[(it * 2) * 16 + li] + SSQ[(it * 2 + 1) * 16 + li];
            const float rs = rsqrtf(tot * (1.f / 128.f) + EPS);
            const size_t row = (size_t)b * SEQ + c * 64 + 16 * it + li;
#pragma unroll
            for (int vv = 0; vv < 4; ++vv) {
                const int v0 = 16 * (4 * vh + vv) + 4 * kg;
                const u32x2 gw = gwv[vv];
                const f32x4 og = ogv[vv];
                const float g0 = silu_f(bf2f((unsigned short)(gw.x & 0xffffu))), g1 = silu_f(bf2f((unsigned short)(gw.x >> 16))), g2 = silu_f(bf2f((unsigned short)(gw.y & 0xffffu))), g3 = silu_f(bf2f((unsigned short)(gw.y >> 16)));
                u32x2 w; w.x = pk2(o[vv][0] * rs * og.x * g0, o[vv][1] * rs * og.y * g1); w.y = pk2(o[vv][2] * rs * og.z * g2, o[vv][3] * rs * og.w * g3);
                *(u32x2*)(CAT + row * KOUT + 1024 + h * 128 + v0) = w;
            }
        }
    }
#undef HG_LOAD
#undef HG_STORE
}


__device__ __forceinline__ int swap23(int r) { return (r & ~12) | ((r & 4) << 1) | ((r & 8) >> 1); }
__device__ __forceinline__ void xattn_mfma_phase(const bf16_t* Q, const bf16_t* Kb, const bf16_t* VT, bf16_t* O, LAS unsigned char* lds, int vb, int nvb) {
    const int tid = otid(), lane = tid & 63, wid = __builtin_amdgcn_readfirstlane(tid >> 6), r32 = lane & 31, hf = lane >> 5;
    LAS unsigned char* Ks = lds; LAS unsigned char* Vs = lds + 65536;
    int koff[8], voff[8];
    { const int kr = swap23(r32), x = kr & 15, y = r32 & 15;
#pragma unroll
      for (int ks = 0; ks < 8; ++ks) koff[ks] = kr * 256 + (((ks * 2 + hf) ^ x) << 4);
#pragma unroll
      for (int e = 0; e < 8; ++e) voff[e] = r32 * 512 + (((e * 2 + hf) ^ y) << 4); }
    for (int pair = vb; pair < 256; pair += nvb) {
        const int bh = pair >> 2, b = bh >> 2, h = bh & 3;
        __syncthreads();
        int tio = tid; asm volatile("" : "+v"(tio));
        for (int i = tio; i < 4096; i += NTHREADS) { const int key = i >> 4, ch = i & 15;
            const u32x4 v = *(const u32x4*)(Kb + (size_t)(b * MEMT + key) * 512 + h * 128 + ch * 8);
            *(LAS u32x4*)(Ks + key * 256 + ((ch ^ (key & 15)) << 4)) = v; }
        for (int i = tio; i < 4096; i += NTHREADS) { const int d = i >> 5, ch = i & 31;
            const u32x4 v = *(const u32x4*)(VT + (size_t)(h * 128 + d) * MT + b * MEMT + ch * 8);
            *(LAS u32x4*)(Vs + d * 512 + ((ch ^ (d & 15)) << 4)) = v; }
        __syncthreads();
#pragma unroll 1
        for (int qq = 0; qq < 2; ++qq) {
            const size_t q0 = (size_t)b * SEQ + ((pair & 3) * 2 + qq) * 256 + wid * 32;
            bf16x8 qf[8];
#pragma unroll
            for (int ks = 0; ks < 8; ++ks) qf[ks] = *(const bf16x8*)(Q + (q0 + r32) * 512 + h * 128 + ks * 16 + 8 * hf);
            f32x16 st[8];
            __builtin_amdgcn_s_setprio(1);
#pragma unroll
            for (int kt = 0; kt < 8; ++kt) {
#pragma unroll
                for (int r = 0; r < 16; ++r) st[kt][r] = 0.f;
#pragma unroll
                for (int ks = 0; ks < 8; ++ks) {
                    const bf16x8 a = *(const LAS bf16x8*)(Ks + koff[ks] + kt * 8192);
                    st[kt] = __builtin_amdgcn_mfma_f32_32x32x16_bf16(a, qf[ks], st[kt], 0, 0, 0);
                }
            }
            __builtin_amdgcn_s_setprio(0);
            float mx = -INFINITY;
#pragma unroll
            for (int kt = 0; kt < 8; ++kt)
#pragma unroll
                for (int r = 0; r < 16; ++r) mx = fmaxf(mx, st[kt][r]);
            mx = fmaxf(mx, __shfl_xor(mx, 32));
            const float c = 0.08838834764831845f * 1.4426950408889634f;
            float sum = 0.f;
#pragma unroll
            for (int kt = 0; kt < 8; ++kt)
#pragma unroll
                for (int r = 0; r < 16; ++r) { const float e = __builtin_amdgcn_exp2f((st[kt][r] - mx) * c); st[kt][r] = e; sum += e; }
            sum += __shfl_xor(sum, 32);
            const float inv = 1.f / sum;
            bf16x8 pfr[8][2];
#pragma unroll
            for (int kt = 0; kt < 8; ++kt)
#pragma unroll
                for (int s2 = 0; s2 < 2; ++s2) {
                    u32x4 pw;
                    pw.x = pk2(st[kt][8 * s2 + 0], st[kt][8 * s2 + 1]); pw.y = pk2(st[kt][8 * s2 + 2], st[kt][8 * s2 + 3]);
                    pw.z = pk2(st[kt][8 * s2 + 4], st[kt][8 * s2 + 5]); pw.w = pk2(st[kt][8 * s2 + 6], st[kt][8 * s2 + 7]);
                    pfr[kt][s2] = __builtin_bit_cast(bf16x8, pw);
                }
#pragma unroll
            for (int kt = 0; kt < 8; ++kt) asm volatile("" : "+v"(pfr[kt][0]), "+v"(pfr[kt][1]));
            f32x16 o[4];
#pragma unroll
            for (int dt = 0; dt < 4; ++dt)
#pragma unroll
                for (int r = 0; r < 16; ++r) o[dt][r] = 0.f;
            __builtin_amdgcn_s_setprio(1);
#pragma unroll
            for (int kt = 0; kt < 8; ++kt)
#pragma unroll
                for (int s2 = 0; s2 < 2; ++s2)
#pragma unroll
                    for (int dt = 0; dt < 4; ++dt) {
                        const bf16x8 a = *(const LAS bf16x8*)(Vs + voff[(kt & 3) * 2 + s2] + dt * 16384 + (kt >> 2) * 256);
                        o[dt] = __builtin_amdgcn_mfma_f32_32x32x16_bf16(a, pfr[kt][s2], o[dt], 0, 0, 0);
                    }
            __builtin_amdgcn_s_setprio(0);
            unsigned char* orow = (unsigned char*)O + (q0 + r32) * 512 + h * 128 + 64 * hf;
            const float isc = inv * XO_SC;
#pragma unroll
            for (int dt = 0; dt < 4; ++dt) {
                u32x4 w;
#pragma unroll
                for (int g = 0; g < 4; ++g) w[g] = pk4_f8(o[dt][4 * g] * isc, o[dt][4 * g + 1] * isc, o[dt][4 * g + 2] * isc, o[dt][4 * g + 3] * isc);
                *(u32x4*)(orow + dt * 16) = w;
            }
        }
    }
}


__device__ __forceinline__ void gmlp_mfma_phase(const bf16_t* UV, const float* lnp, const float* ln_g, const float* ln_b, const float* w_sp, const float* b_sp, bf16_t* G, LAS unsigned char* lds, int vb, int nvb) {
    const int tid = otid(), lane = tid & 63, wid = __builtin_amdgcn_readfirstlane(tid >> 6), fr = lane & 15, fq = lane >> 4;
    LAS unsigned char* Wb = lds; LAS unsigned char* VTs = lds + 32768; LAS float* STAT = (LAS float*)(lds + 65536);
    int gcur = -1;
    for (int grp = vb; grp < 256; grp += nvb) {
        const int g = grp >> 5;
        bf16x8 vch[4]; f32x4 lp[2];
#define GM_LOAD(uu_) do { const size_t r0_ = (size_t)((grp & 31) * 8 + (uu_)) * 128; \
            _Pragma("unroll") for (int k = 0; k < 4; ++k) { const int i = tid + 512 * k, sI = i >> 4, ch = i & 15; vch[k] = *(const bf16x8*)(UV + (r0_ + sI) * 2048 + 1024 + g * 128 + ch * 8); } \
            lp[0] = *(const f32x4*)(lnp + (r0_ + (tid >> 2)) * 32 + (tid & 3) * 8); lp[1] = *(const f32x4*)(lnp + (r0_ + (tid >> 2)) * 32 + (tid & 3) * 8 + 4); } while (0)
        GM_LOAD(0);
        const f32x4 g0 = *(const f32x4*)(ln_g + g * 128 + (tid & 15) * 8), g1 = *(const f32x4*)(ln_g + g * 128 + (tid & 15) * 8 + 4);
        const f32x4 b0 = *(const f32x4*)(ln_b + g * 128 + (tid & 15) * 8), b1 = *(const f32x4*)(ln_b + g * 128 + (tid & 15) * 8 + 4);
        const float gg[8] = {g0.x, g0.y, g0.z, g0.w, g1.x, g1.y, g1.z, g1.w}, bb[8] = {b0.x, b0.y, b0.z, b0.w, b1.x, b1.y, b1.z, b1.w};
        __syncthreads();
        if (g != gcur) {
            gcur = g;
            for (int i = tid; i < 2048; i += NTHREADS) { const int t = i >> 4, ch = i & 15;
                const f32x4 a = *(const f32x4*)(w_sp + (size_t)g * 16384 + t * 128 + ch * 8), b = *(const f32x4*)(w_sp + (size_t)g * 16384 + t * 128 + ch * 8 + 4);
                const int s0 = ch * 8;
                u32x4 w; w.x = pk2(s0 + 0 <= t ? a.x : 0.f, s0 + 1 <= t ? a.y : 0.f); w.y = pk2(s0 + 2 <= t ? a.z : 0.f, s0 + 3 <= t ? a.w : 0.f);
                w.z = pk2(s0 + 4 <= t ? b.x : 0.f, s0 + 5 <= t ? b.y : 0.f); w.w = pk2(s0 + 6 <= t ? b.z : 0.f, s0 + 7 <= t ? b.w : 0.f);
                *(LAS u32x4*)(Wb + t * 256 + ((ch ^ (t & 15)) << 4)) = w; }
        }
        const int trow = wid * 16 + fr;
        const float bias = b_sp[g * 128 + trow];
#pragma unroll 1
        for (int uu = 0; uu < 8; ++uu) {
            const int bn = (grp & 31) * 8 + uu;
            const size_t row0 = (size_t)bn * 128;
            if (uu) __syncthreads();
            { float s1 = (lp[0].x + lp[0].z) + (lp[1].x + lp[1].z), s2 = (lp[0].y + lp[0].w) + (lp[1].y + lp[1].w);
              s1 += __shfl_xor(s1, 1); s2 += __shfl_xor(s2, 1); s1 += __shfl_xor(s1, 2); s2 += __shfl_xor(s2, 2);
              const float mu = s1 * (1.f / 1024.f), var = fmaxf(s2 * (1.f / 1024.f) - mu * mu, 0.f);
              if ((tid & 3) == 0) { STAT[2 * (tid >> 2)] = mu; STAT[2 * (tid >> 2) + 1] = rsqrtf(var + EPS); } }
            __syncthreads();
#pragma unroll
            for (int k = 0; k < 4; ++k) { const int i = tid + 512 * k, sI = i >> 4, ch = i & 15;
                const float mu = STAT[2 * sI], rs = STAT[2 * sI + 1];
#pragma unroll
                for (int e = 0; e < 8; ++e) { const int c = ch * 8 + e; const float x = (bf2f((unsigned short)vch[k][e]) - mu) * rs * gg[e] + bb[e];
                    *(LAS bf16_t*)(VTs + c * 256 + (((sI >> 3) ^ ((c ^ (c >> 3)) & 15)) << 4) + (sI & 7) * 2) = (bf16_t)f2bf(x); } }
            if (uu + 1 < 8) GM_LOAD(uu + 1);
            const size_t orow = row0 + trow;
            u32x2 uwv[8];
#pragma unroll
            for (int ct = 0; ct < 8; ++ct) uwv[ct] = *(const u32x2*)(UV + orow * 2048 + g * 128 + ct * 16 + 4 * fq);
            __syncthreads();
            f32x4 acc[8];
#pragma unroll
            for (int ct = 0; ct < 8; ++ct) acc[ct] = (f32x4){0.f, 0.f, 0.f, 0.f};
#pragma unroll
            for (int ks = 0; ks < 4; ++ks) {
                const bf16x8 wf = *(const LAS bf16x8*)(Wb + trow * 256 + (((ks * 4 + fq) ^ (trow & 15)) << 4));
#pragma unroll
                for (int ct = 0; ct < 8; ++ct) {
                    const int crow = ct * 16 + fr;
                    const bf16x8 vf = *(const LAS bf16x8*)(VTs + crow * 256 + (((ks * 4 + fq) ^ ((crow ^ (crow >> 3)) & 15)) << 4));
                    acc[ct] = __builtin_amdgcn_mfma_f32_16x16x32_bf16(vf, wf, acc[ct], 0, 0, 0);
                }
            }
#pragma unroll
            for (int ct = 0; ct < 8; ++ct) {
                const int c = ct * 16 + 4 * fq;
                const u32x2 uw = uwv[ct];
                const float u0 = bf2f((unsigned short)(uw.x & 0xffffu)), u1 = bf2f((unsigned short)(uw.x >> 16)), u2 = bf2f((unsigned short)(uw.y & 0xffffu)), u3 = bf2f((unsigned short)(uw.y >> 16));
                u32x2 w; w.x = pk2(u0 * (acc[ct][0] + bias), u1 * (acc[ct][1] + bias)); w.y = pk2(u2 * (acc[ct][2] + bias), u3 * (acc[ct][3] + bias));
                *(u32x2*)(G + orow * 1024 + g * 128 + c) = w;
            }
        }
#undef GM_LOAD
    }
}

#define GAS __attribute__((address_space(1)))
typedef GAS unsigned gu32;
#define XB_TMO      128
#define XB_XCNT(j)  (256  + 64 * (j))
#define XB_XSUB(j)  (1280 + 64 * (j))
#define XB_XGEN(j)  (2304 + 64 * (j))
#define XB_TOP      3328
#define XB_TOPGEN   3392
#define XCD_BAR_WORDS 3456
#define XB_SPIN_CAP (1u << 18)

__device__ __forceinline__ unsigned xb_ld(unsigned* p)              { return __hip_atomic_load(p, __ATOMIC_RELAXED, __HIP_MEMORY_SCOPE_AGENT); }
__device__ __forceinline__ unsigned xb_add(unsigned* p, unsigned v) { return __hip_atomic_fetch_add(p, v, __ATOMIC_RELAXED, __HIP_MEMORY_SCOPE_AGENT); }
__device__ __forceinline__ unsigned xb_xcc_id() { return (unsigned)__builtin_amdgcn_s_getreg((3 << 11) | 20) & 0xFu; }
#define XB_SPIN(cond, bar) do { unsigned _sp = 0; while (cond) { __builtin_amdgcn_s_sleep(1); \
    if ((++_sp & 255u) == 0u) { if (xb_ld(&(bar)[XB_TMO])) break; if (_sp > XB_SPIN_CAP) { atomicAdd(&(bar)[XB_TMO], 1u); break; } } } } while (0)

struct XcdBarrier {
    unsigned* bar; unsigned x;
    volatile LAS unsigned* st;
};

__device__ __forceinline__ XcdBarrier xcd_barrier_post(unsigned* bar, volatile LAS unsigned* st) {
    XcdBarrier b; b.bar = bar; b.x = xb_xcc_id(); b.st = st;
    if (threadIdx.x == 0) (void)xb_add(&bar[XB_XCNT(b.x)], 1u);
    return b;
}
__device__ __forceinline__ void xcd_barrier_complete(unsigned* bar, unsigned x, unsigned& nloc, unsigned& nx) {
    const unsigned G = gridDim.x * gridDim.y * gridDim.z;
    unsigned sum, cnt, mine, sp = 0u;
    for (;;) {
        sum = 0u; cnt = 0u; mine = 0u;
#pragma unroll
        for (unsigned j = 0; j < 16; ++j) { const unsigned c = xb_ld(&bar[XB_XCNT(j)]); sum += c; cnt += (c > 0u) ? 1u : 0u; mine = (j == x) ? c : mine; }
        if (sum == G) break;
        __builtin_amdgcn_s_sleep(1);
        if ((++sp & 255u) == 0u) { if (xb_ld(&bar[XB_TMO])) break; if (sp > XB_SPIN_CAP) { atomicAdd(&bar[XB_TMO], 1u); break; } }
    }
    nloc = mine > 0u ? mine : 1u; nx = cnt > 0u ? cnt : 1u;
}

__device__ __forceinline__ void xcd_barrier(const XcdBarrier& b) {
    asm volatile("s_waitcnt vmcnt(0)" ::: "memory");
    __syncthreads();
    if (threadIdx.x == 0) {
        unsigned* bar = b.bar;
        __builtin_amdgcn_s_waitcnt(0);
        unsigned nloc = b.st[0], nx = b.st[1];
        if (nloc == 0u) { xcd_barrier_complete(bar, b.x, nloc, nx); b.st[0] = nloc; b.st[1] = nx; }
        const unsigned old = xb_add(&bar[XB_XSUB(b.x)], 1u);
        const unsigned gen = old / nloc;
        if (old + 1u == (gen + 1u) * nloc) {
            __builtin_amdgcn_fence(__ATOMIC_RELEASE, "agent");
            asm volatile("s_waitcnt vmcnt(0)" ::: "memory");
            const unsigned og = xb_add(&bar[XB_TOP], 1u);
            const unsigned tg = og / nx;
            if (og + 1u == (tg + 1u) * nx) xb_add(&bar[XB_TOPGEN], 1u);
            else XB_SPIN(xb_ld(&bar[XB_TOPGEN]) == tg, bar);
            __builtin_amdgcn_fence(__ATOMIC_ACQUIRE, "agent");
            xb_add(&bar[XB_XGEN(b.x)], 1u);
            asm volatile("s_waitcnt vmcnt(0)" ::: "memory");
        } else {
            XB_SPIN(xb_ld(&bar[XB_XGEN(b.x)]) == gen, bar);
            __builtin_amdgcn_fence(__ATOMIC_ACQUIRE, "agent");
            asm volatile("s_waitcnt vmcnt(0)" ::: "memory");
        }
    }
    __syncthreads();
}

constexpr int LDS_BYTES = 32768 * 4 + 256 + 6144 + 8 * 2560;

enum Phase {
    PH_PREP = 0, PH_GEMM_IN, PH_CNORM, PH_MIX0  , PH_GEMM_OUT0,
    PH_GEMM_Q0, PH_XATTN0, PH_GEMM_O0, PH_GEMM_GU0, PH_GEMM_DN0,
    PH_GEMM_OIN, PH_GMLP, PH_GEMM_OOUT,
    PH_GEMM_Q1, PH_XATTN1, PH_GEMM_O1, PH_GEMM_GU1, PH_GEMM_DN1, PH_FINAL, PH_COUNT
};

__device__ __forceinline__ PrepJob make_job(const Params& p, int ji) {
    unsigned char* ws = p.ws; PrepJob j{};
    switch (ji) {
    case 0: j = PrepJob{p.in[5], 1024, 3272, p.in[4], (bf16_t*)(ws + WS_WIN), 1024, 1792, 1024, 0, MAP_WIN}; break;
    case 14: j = PrepJob{p.in[5], 1024, 3272, p.in[4], (bf16_t*)(ws + WS_WIN), 3584, PW, 1024, 0, MAP_WIN}; break;
    case 15: j = PrepJob{p.in[5], 1024, 3272, p.in[4], (bf16_t*)(ws + WS_WIN8), 1024, 2816, 1024, 0, MAP_WIN8, 4, WQ_GU}; break;
    case 1: j = PrepJob{p.in[10] + (size_t)512 * 1024, 512, 1024, nullptr, (bf16_t*)(ws + WS_WOUT), 0, 1024, KOUT, 1024, MAP_ID}; break;
    case 2: j = PrepJob{p.in[11], 1024, 2048, p.in[4] + 1024, (bf16_t*)(ws + WS_OWIN), 0, 2048, 1024, 0, MAP_ID, 2, WQ_GU}; break;
    case 3: j = PrepJob{p.in[16], 1024, 1024, nullptr, (bf16_t*)(ws + WS_OWOUT), 0, 1024, 1024, 0, MAP_ID}; break;
    case 4: case 5: { const int l = ji - 4; j = PrepJob{p.in[19] + (size_t)l * 1024 * 512, 1024, 512, p.in[17] + l * 1024, (bf16_t*)(ws + WS_WQ + (size_t)l * 512 * 1024), 0, 512, 1024, 0, MAP_ID, 2, WQ_GU}; } break;
    case 6: case 7: { const int l = ji - 6; j = PrepJob{p.in[20] + (size_t)l * 1024 * 1024, 1024, 1024, p.in[18] + l * 1024, (bf16_t*)(ws + WS_WKV8 + (size_t)l * 1024 * 1024), 0, 1024, 1024, 0, MAP_ID, 4, WQ_GU}; } break;
    case 8: case 9: { const int l = ji - 8; j = PrepJob{p.in[21] + (size_t)l * 512 * 1024, 512, 1024, nullptr, (bf16_t*)(ws + WS_WO + (size_t)l * 1024 * 512), 0, 1024, 512, 0, MAP_ID, 3, WO_SC}; } break;
    case 10: case 11: { const int l = ji - 10; j = PrepJob{p.in[23] + (size_t)l * 1024 * 2 * FF, 1024, 2 * FF, p.in[22] + l * 1024, (bf16_t*)(ws + WS_WGU + (size_t)l * 2 * FF * 1024), 0, 2 * FF, 1024, 0, MAP_GU, 2, WQ_GU}; } break;
    case 12: case 13: { const int l = ji - 12;
        if ((DN_FP8 >> l) & 1) j = PrepJob{p.in[24] + (size_t)l * FF * 1024, FF, 1024, nullptr, (bf16_t*)(ws + WS_WDN + (size_t)l * 1024 * FF * 2), 0, 1024, FF, 0, MAP_ID, 1, WDN_SC};
        else j = PrepJob{p.in[24] + (size_t)l * FF * 1024, FF, 1024, nullptr, (bf16_t*)(ws + WS_WDN) + (size_t)l * 1024 * FF, 0, 1024, FF, 0, MAP_ID}; } break;
    }
    return j;
}
constexpr int N_PREP_JOBS = 16;

template <int ph> __device__ __forceinline__ void run_phase(const Params& p, LAS float* lds, int vb, int nvb) {
    unsigned char* ws = p.ws;
    bf16_t* HN = (bf16_t*)(ws + WS_HN); bf16_t* BIG = (bf16_t*)(ws + WS_BIG); bf16_t* CN = (bf16_t*)(ws + WS_CN); bf16_t* CAT = (bf16_t*)(ws + WS_CAT);
    bf16_t* KB = (bf16_t*)(ws + WS_KB); bf16_t* VTB = (bf16_t*)(ws + WS_VT); bf16_t* MEMN = (bf16_t*)(ws + WS_MEMN); float* lb = (float*)(ws + WS_LB);
    float* ssq = (float*)(ws + WS_SSQ); float* lnp = (float*)(ws + WS_LNP);
    bf16_t* XQ = BIG; bf16_t* XO = BIG + (size_t)T * 512;
    const int l = (ph >= PH_GEMM_Q1) ? 1 : 0;
    switch (ph) {
    case PH_PREP:
        x_to_h_rows(p.in[0], HN, ws + WS_X8, ssq, vb, nvb);
        {
            constexpr int NT_[N_PREP_JOBS] = {16 * 3, 8 * 4, 16 * 8, 16 * 4, 16 * 2, 16 * 2, 16 * 4, 16 * 4, 8 * 4, 8 * 4, 16 * 22, 16 * 22, 44 * 4, 44 * 4, 16 * 1, 16 * 7};
            constexpr int CUM1 = NT_[0], CUM2 = CUM1 + NT_[1], CUM3 = CUM2 + NT_[2], CUM4 = CUM3 + NT_[3], CUM5 = CUM4 + NT_[4], CUM6 = CUM5 + NT_[5], CUM7 = CUM6 + NT_[6],
                          CUM8 = CUM7 + NT_[7], CUM9 = CUM8 + NT_[8], CUM10 = CUM9 + NT_[9], CUM11 = CUM10 + NT_[10], CUM12 = CUM11 + NT_[11], CUM13 = CUM12 + NT_[12], CUM14 = CUM13 + NT_[13],
                          CUM15 = CUM14 + NT_[14], CUM16 = CUM15 + NT_[15];
#define PJ_FIND(it_, ji_, base_) do { ji_ = 0; base_ = 0; \
                PJ_STEP(it_, ji_, base_, 1, CUM1) PJ_STEP(it_, ji_, base_, 2, CUM2) PJ_STEP(it_, ji_, base_, 3, CUM3) PJ_STEP(it_, ji_, base_, 4, CUM4) PJ_STEP(it_, ji_, base_, 5, CUM5) PJ_STEP(it_, ji_, base_, 6, CUM6) PJ_STEP(it_, ji_, base_, 7, CUM7) \
                PJ_STEP(it_, ji_, base_, 8, CUM8) PJ_STEP(it_, ji_, base_, 9, CUM9) PJ_STEP(it_, ji_, base_, 10, CUM10) PJ_STEP(it_, ji_, base_, 11, CUM11) PJ_STEP(it_, ji_, base_, 12, CUM12) PJ_STEP(it_, ji_, base_, 13, CUM13) PJ_STEP(it_, ji_, base_, 14, CUM14) PJ_STEP(it_, ji_, base_, 15, CUM15) } while (0)
#define PJ_STEP(it_, ji_, base_, q, c) if ((it_) >= (c)) { ji_ = (q); base_ = (c); }
            f32x4 va[8], vn[8];
            int ji, base;
            if (vb < CUM16) { PJ_FIND(vb, ji, base); const PrepJob j = make_job(p, ji); prep_tile_load(j, vb - base, va); }
            for (int it = vb; it < CUM16; it += nvb) {
                PJ_FIND(it, ji, base);
                const PrepJob j = make_job(p, ji); const int tl = it - base;
                if (it + nvb < CUM16) { int jn, bn; PJ_FIND(it + nvb, jn, bn); const PrepJob j2 = make_job(p, jn); prep_tile_load(j2, it + nvb - bn, vn); }
                prep_tile_store(j, tl, va, lds);
#pragma unroll
                for (int q = 0; q < 8; ++q) va[q] = vn[q];
            }
#undef PJ_STEP
#undef PJ_FIND
        }
        prep_fold_in(p.in[5], p.in[7], p.in[4], (bf16_t*)(ws + WS_WIN8), lds, vb, nvb);
        prep_fold_out(p.in[10], p.in[8], (bf16_t*)(ws + WS_WOUT), lds, vb, nvb);
        prep_lb(p.in[3], lb, vb, nvb);
        rmsnorm_rows(p.in[1], ws + WS_MEMN8, MT, vb, nvb);
        break;
    case PH_GEMM_IN: {
        {
            Gemm g{(const bf16_t*)(ws + WS_WIN8), (const bf16_t*)(ws + WS_WIN8), T, 2816, 512}; EpiIn8 E{BIG, KB, VTB, ssq, 1.f / (HQ_X * WQ_GU)};
            pg8::ComboOrder8 S; S.init(nvb, vb);
            LAS float* tab = (LAS float*)((LAS unsigned char*)lds + RSTD_TAB_OFF); build_rstd_table(S, ssq, tab); E.tab = tab;
            pg8::gemm_phase<EpiIn8, pg8::ComboOrder8, true, true, 2>((LAS unsigned char*)lds, g, S, E);
        }
        Gemm g{(const bf16_t*)(ws + WS_WIN), (const bf16_t*)(ws + WS_WIN), T, PW, 1024}; EpiIn E{BIG, KB, VTB, ssq};
        pg8::ComboOrder S; S.nkv = 0; S.init(nvb, vb);
        { LAS float* tab = (LAS float*)((LAS unsigned char*)lds + RSTD_TAB_OFF); build_rstd_table(S, ssq, tab); E.tab = tab; }
        pg8::gemm_phase<EpiIn, pg8::ComboOrder, true, true>((LAS unsigned char*)lds, g, S, E);
    } break;
    case PH_CNORM: cnorm_rows(BIG, p.in[6], CN, vb, nvb); hgrn_prep(BIG, lb, (float*)(ws + WS_DEC), (LAS unsigned char*)lds, vb, nvb); break;
    case PH_MIX0:
        for (int item = vb; item < 64; item += nvb) hgrn_scan(BIG, (const float*)(ws + WS_DEC), p.in[9], CAT, (LAS unsigned char*)lds, item);
        dsa_mfma_phase(BIG, CN, p.in[2], CAT, (LAS unsigned char*)lds, (unsigned*)(ws + WS_CTL) + 3600);
        break;
    case PH_GEMM_OUT0: { Gemm g{CAT, (const bf16_t*)(ws + WS_WOUT), T, 1024, KOUT}; EpiResid<false, false, true> E{nullptr, HN, ssq, ws + WS_H8, HQ_Q0}; run_gemm(g, E, lds, vb, nvb); } break;
    case PH_GEMM_Q0: case PH_GEMM_Q1: { Gemm g{(const bf16_t*)(ws + WS_H8), (const bf16_t*)(ws + WS_WQ + (size_t)l * 512 * 1024), T, 512, 512}; EpiStoreBf16<true> E{XQ, 512, ssq, 1.f / ((l ? HQ_Q1 : HQ_Q0) * WQ_GU)}; run_gemm<EpiStoreBf16<true>, 2>(g, E, lds, vb, nvb); } break;
    case PH_XATTN0: case PH_XATTN1: xattn_mfma_phase(XQ, KB + (size_t)l * MT * 512, VTB + (size_t)l * 512 * MT, XO, (LAS unsigned char*)lds, vb, nvb); break;
    case PH_GEMM_O0: case PH_GEMM_O1: { Gemm g{XO, (const bf16_t*)(ws + WS_WO + (size_t)l * 1024 * 512), T, 1024, 256}; EpiResid<false, true, true> E{nullptr, HN, ssq, ws + WS_H8, l ? HQ_GU1 : HQ_GU0, XO_UNSC}; run_gemm<EpiResid<false, true, true>, 1>(g, E, lds, vb, nvb); } break;
    case PH_GEMM_GU0: case PH_GEMM_GU1: { constexpr bool dn8 = ((DN_FP8 >> l) & 1) != 0;
        Gemm g{(const bf16_t*)(ws + WS_H8), (const bf16_t*)(ws + WS_WGU + (size_t)l * 2 * FF * 1024), T, 2 * FF, 512}; EpiSwigluQ<true, dn8> E{BIG, FF, ssq, 1.f / ((l ? HQ_GU1 : HQ_GU0) * WQ_GU)}; run_gemm<EpiSwigluQ<true, dn8>, 2>(g, E, lds, vb, nvb); } break;
    case PH_GEMM_DN0: case PH_GEMM_DN1:
        if constexpr (((DN_FP8 >> l) & 1) != 0) { Gemm g{BIG, (const bf16_t*)(ws + WS_WDN + (size_t)l * 1024 * FF * 2), T, 1024, FF / 2}; EpiResid<false, true, ph == PH_GEMM_DN0> E{nullptr, HN, ssq, ws + WS_H8, HQ_OIN, DN_UNSC}; run_gemm<EpiResid<false, true, ph == PH_GEMM_DN0>, 1>(g, E, lds, vb, nvb); }
        else { Gemm g{BIG, (const bf16_t*)(ws + WS_WDN) + (size_t)l * 1024 * FF, T, 1024, FF}; EpiResid<false, false, ph == PH_GEMM_DN0> E{nullptr, HN, ssq, ws + WS_H8, HQ_OIN}; run_gemm(g, E, lds, vb, nvb); }
        break;
    case PH_GEMM_OIN: { Gemm g{(const bf16_t*)(ws + WS_H8), (const bf16_t*)(ws + WS_OWIN), T, 2048, 512}; EpiGeluBf16<true> E{BIG, 2048, ssq, lnp, 1.f / (HQ_OIN * WQ_GU)}; run_gemm<EpiGeluBf16<true>, 2>(g, E, lds, vb, nvb); } break;
    case PH_GMLP: gmlp_mfma_phase(BIG, lnp, p.in[12], p.in[13], p.in[14], p.in[15], CAT, (LAS unsigned char*)lds, vb, nvb); break;
    case PH_GEMM_OOUT: { Gemm g{CAT, (const bf16_t*)(ws + WS_OWOUT), T, 1024, 1024}; EpiResid<false, false, true> E{nullptr, HN, ssq, ws + WS_H8, HQ_Q1}; run_gemm(g, E, lds, vb, nvb); } break;
    case PH_FINAL: final_rows(HN, ssq, p.in[25], p.out, vb, nvb); break;
    default: break;
    }
}

template <int PH> __global__ void __launch_bounds__(NTHREADS) k_phase(Params p) {
    extern __shared__ __attribute__((aligned(16))) float smem[];
    run_phase<PH>(p, (LAS float*)smem, blockIdx.x, gridDim.x);
}

template <int PH> __device__ __forceinline__ void mega_phases(const Params& p, LAS float* lds, const XcdBarrier& bar) {
    run_phase<PH>(p, lds, blockIdx.x, gridDim.x);
#ifdef REPEAT_PH
    if constexpr (PH == REPEAT_PH) { xcd_barrier(bar); run_phase<PH>(p, lds, blockIdx.x, gridDim.x); }
#endif
    if constexpr (PH + 1 < PH_COUNT) { xcd_barrier(bar); mega_phases<PH + 1>(p, lds, bar); }
}
__global__ void __launch_bounds__(NTHREADS) k_mega(Params p) {
    extern __shared__ __attribute__((aligned(16))) float smem[];
    volatile LAS unsigned* st = (volatile LAS unsigned*)((LAS float*)smem + 32768);
    if (threadIdx.x < 2) st[threadIdx.x] = 0u;
    __syncthreads();
    const XcdBarrier bar = xcd_barrier_post((unsigned*)(p.ws + WS_CTL), st);
    mega_phases<0>(p, (LAS float*)smem, bar);
}

template <int PH> static void launch_phases(const Params& p, int grid, hipStream_t stream) {
    int g = grid * 4;
    if (PH == PH_MIX0 || PH == PH_XATTN0 || PH == PH_XATTN1 || PH == PH_GMLP) g = grid;
    (void)hipFuncSetAttribute((const void*)k_phase<PH>, hipFuncAttributeMaxDynamicSharedMemorySize, LDS_BYTES);
    hipLaunchKernelGGL(k_phase<PH>, dim3(g), dim3(NTHREADS), LDS_BYTES, stream, p);
    if constexpr (PH + 1 < PH_COUNT) launch_phases<PH + 1>(p, grid, stream);
}

extern "C" void kernel_launch(void* const* d_in, const int* in_sizes, int n_in, void* d_out, int out_size, void* d_ws, size_t ws_size, hipStream_t stream) {
    static int grid = 0;
    if (grid == 0) {
        if (n_in != 26 || out_size != T * D || ws_size < WS_END) { fprintf(stderr, "kernel_launch: unexpected shapes (n_in %d out %d ws %zu)\n", n_in, out_size, ws_size); grid = -1; return; }
        int dev = 0, cus = 0;
        (void)hipGetDevice(&dev); (void)hipDeviceGetAttribute(&cus, hipDeviceAttributeMultiprocessorCount, dev);
        (void)hipFuncSetAttribute((const void*)k_mega, hipFuncAttributeMaxDynamicSharedMemorySize, LDS_BYTES);
        int per_cu = 0;
        (void)hipOccupancyMaxActiveBlocksPerMultiprocessor(&per_cu, (const void*)k_mega, NTHREADS, LDS_BYTES);
        if (per_cu < 1) fprintf(stderr, "kernel_launch: occupancy query says %d blocks per CU\n", per_cu);
        (void)hipGetLastError();
        grid = cus > 0 ? cus : 256;
    }
    if (grid < 0) return;
    Params p{};
    for (int i = 0; i < 26; ++i) p.in[i] = (const float*)d_in[i];
    p.out = (float*)d_out; p.ws = (unsigned char*)d_ws;
    (void)hipMemsetAsync((char*)d_ws + WS_CTL, 0, 16384, stream);
#if MEGA
    hipLaunchKernelGGL(k_mega, dim3(grid), dim3(NTHREADS), LDS_BYTES, stream, p);
#else
    launch_phases<0>(p, grid, stream);
#endif
}
```

```cpp
#include <hip/hip_runtime.h>
#include <stdint.h>
#include <stdio.h>

#ifndef MEGA
#define MEGA 1
#endif
#ifndef DN_FP8
#define DN_FP8 2
#endif

#define LAS __attribute__((address_space(3)))
typedef unsigned short bf16_t;
typedef short bf16x8 __attribute__((ext_vector_type(8)));
typedef float f32x4 __attribute__((ext_vector_type(4)));
typedef float f32x2 __attribute__((ext_vector_type(2)));
typedef unsigned u32x4 __attribute__((ext_vector_type(4)));
typedef unsigned u32x2 __attribute__((ext_vector_type(2)));
typedef float f32x16 __attribute__((ext_vector_type(16)));

constexpr int D = 1024, BATCH = 16, SEQ = 2048, T = BATCH * SEQ;
constexpr int CHUNK = 64;
constexpr int MEMT = 256, MT = BATCH * MEMT;
constexpr int FF = 2816;
constexpr float EPS = 1e-6f;
constexpr int NTHREADS = 512, NWAVES = 8;

constexpr int P_QL = 0, P_C = 1024, P_QI = 1152, P_KI = 1664, P_FB = 1728, P_IB = 2240, P_QB = 2752, P_GB = 3264, P_WI = 3776, P_END = 3784, PW = 3840;
constexpr int KOUT = 1536;

constexpr size_t MiB = 1u << 20;
constexpr size_t WS_CTL = 0;
constexpr size_t WS_LB = 64 * 1024;
constexpr size_t WS_SSQ = 496 * MiB;
constexpr size_t WS_LNP = 498 * MiB;
constexpr size_t WS_WIN = 1 * MiB;
constexpr size_t WS_WKV = WS_WIN + (size_t)PW * D * 2;
constexpr size_t WS_HN = WS_WKV + 2 * (size_t)D * D * 2;
constexpr size_t WS_MEMN = WS_HN + (size_t)T * D * 2;
constexpr size_t WS_WOUT = WS_MEMN + (size_t)MT * D * 2;
constexpr size_t WS_OWIN = WS_WOUT + (size_t)D * KOUT * 2;
constexpr size_t WS_OWOUT = WS_OWIN + (size_t)2048 * D * 2;
constexpr size_t WS_WQ = WS_OWOUT + (size_t)D * D * 2;
constexpr size_t WS_WO = WS_WQ + 2 * (size_t)512 * D * 2;
constexpr size_t WS_WGU = WS_WO + 2 * (size_t)D * 512 * 2;
constexpr size_t WS_WDN = WS_WGU + 2 * (size_t)2 * FF * D * 2;
constexpr size_t WS_WEND = WS_WDN + 2 * (size_t)D * FF * 2;
constexpr int TILE_WIN = 0, TILE_WKV = PW / 256, TILE_HN = TILE_WKV + 8, TILE_MEMN = TILE_HN + T / 256;
constexpr size_t WS_BIG = 132 * MiB;
constexpr size_t WS_CN = 372 * MiB;
constexpr size_t WS_CAT = 380 * MiB;
constexpr size_t WS_H8 = WS_BIG + 200 * MiB;
constexpr size_t WS_WIN8 = WS_CAT, WS_WKV8 = WS_WIN8 + (size_t)3840 * 1024, WS_X8 = WS_WKV8 + (size_t)2048 * 1024, WS_MEMN8 = WS_X8 + (size_t)T * 1024;
constexpr int T8_WIN = 0, T8_WKV = 15, T8_X = 23, T8_MEMN = T8_X + T / 256;
constexpr size_t WS_KB = 476 * MiB;
constexpr size_t WS_VT = 484 * MiB;
constexpr size_t WS_END = 502 * MiB;
static_assert(WS_WEND <= WS_BIG, "weights fit below BIG");

struct Params {
    const float* in[26];
    float* out;
    unsigned char* ws;
};

__device__ __forceinline__ float bf2f(unsigned short u) { return __uint_as_float(((unsigned)u) << 16); }
__device__ __forceinline__ unsigned f2bf(float f) { unsigned u = __float_as_uint(f); return (u + 0x7fffu + ((u >> 16) & 1u)) >> 16; }
typedef __bf16 bf16x2_t __attribute__((ext_vector_type(2)));
__device__ __forceinline__ unsigned pk2(float lo, float hi) { const f32x2 v = {lo, hi}; return __builtin_bit_cast(unsigned, __builtin_convertvector(v, bf16x2_t)); }
__device__ __forceinline__ float wave_sum(float v) {
#pragma unroll
    for (int o = 1; o < 64; o <<= 1) v += __shfl_xor(v, o);
    return v;
}
__device__ __forceinline__ float wave_max(float v) {
#pragma unroll
    for (int o = 1; o < 64; o <<= 1) v = fmaxf(v, __shfl_xor(v, o));
    return v;
}
__device__ __forceinline__ int otid() { int t = threadIdx.x; asm volatile("" : "+v"(t)); return t; }
#define WAVE_LDS_SYNC() asm volatile("s_waitcnt lgkmcnt(0)" ::: "memory")
__device__ __forceinline__ float silu_f(float x) { return x * __builtin_amdgcn_rcpf(1.f + __expf(-x)); }
__device__ __forceinline__ float sigmoid_f(float x) { return __builtin_amdgcn_rcpf(1.f + __expf(-x)); }

typedef int i32x4v __attribute__((ext_vector_type(4)));
typedef int i32x8v __attribute__((ext_vector_type(8)));
__device__ __forceinline__ unsigned pk4_f8(float a, float b, float c, float d) {
    a = __builtin_amdgcn_fmed3f(a, -448.f, 448.f); b = __builtin_amdgcn_fmed3f(b, -448.f, 448.f); c = __builtin_amdgcn_fmed3f(c, -448.f, 448.f); d = __builtin_amdgcn_fmed3f(d, -448.f, 448.f);
    int w = 0;
    w = __builtin_amdgcn_cvt_pk_fp8_f32(a, b, w, false);
    w = __builtin_amdgcn_cvt_pk_fp8_f32(c, d, w, true);
    return (unsigned)w;
}
constexpr float ACT_SC = 8.f, WDN_SC = 256.f, DN_UNSC = 1.f / (ACT_SC * WDN_SC);
constexpr float XO_SC = 64.f, WO_SC = 128.f, XO_UNSC = 1.f / (XO_SC * WO_SC);
constexpr float HQ_X = 127.f / 4.2f;
constexpr float HQ_Q0 = 127.f / 5.2f, HQ_GU0 = 127.f / 5.2f, HQ_OIN = 127.f / 5.8f, HQ_Q1 = 127.f / 6.3f, HQ_GU1 = 127.f / 6.3f, WQ_GU = 127.f / 0.13f;
__device__ __forceinline__ unsigned pk4_i8(float a, float b, float c, float d, float sc) {
    constexpr float MG = 12582912.f;
    const unsigned ua = __float_as_uint(__builtin_amdgcn_fmed3f(__builtin_fmaf(a, sc, MG), MG - 127.f, MG + 127.f)), ub = __float_as_uint(__builtin_amdgcn_fmed3f(__builtin_fmaf(b, sc, MG), MG - 127.f, MG + 127.f));
    const unsigned uc = __float_as_uint(__builtin_amdgcn_fmed3f(__builtin_fmaf(c, sc, MG), MG - 127.f, MG + 127.f)), ud = __float_as_uint(__builtin_amdgcn_fmed3f(__builtin_fmaf(d, sc, MG), MG - 127.f, MG + 127.f));
    return __builtin_amdgcn_perm(ub, ua, 0x0c0c0400u) | __builtin_amdgcn_perm(ud, uc, 0x04000c0cu);
}
__device__ __forceinline__ int kperm8(int k) { const int r = k & 255; return (k & ~255) + ((r >> 5) & 3) * 64 + ((r >> 3) & 3) * 16 + (r >> 7) * 8 + (r & 7); }
__device__ __forceinline__ f32x4 i2f4(f32x4 v) { const i32x4v t = __builtin_bit_cast(i32x4v, v); return (f32x4){(float)t.x, (float)t.y, (float)t.z, (float)t.w}; }
struct Unit { int pm, pn, idx; };
struct Gemm { const bf16_t* A; const bf16_t* Bt; int M, N, K; };
__device__ __forceinline__ int perm32(int rho) { const int n = rho >> 4, i = rho & 15; return 8 * (i >> 2) + 4 * n + (i & 3); }

__device__ __forceinline__ float sum_rows4(float s) {
    const auto r = __builtin_amdgcn_permlane16_swap(__float_as_uint(s), __float_as_uint(s), false, false);
    s = __uint_as_float(r[0]) + __uint_as_float(r[1]);
    const auto q = __builtin_amdgcn_permlane32_swap(__float_as_uint(s), __float_as_uint(s), false, false);
    return __uint_as_float(q[0]) + __uint_as_float(q[1]);
}
__device__ __forceinline__ float row_rstd(const float* ssq, size_t row) {
    const f32x4* p = (const f32x4*)(ssq + row * 16);
    const f32x4 a = p[0], b = p[1], c = p[2], d = p[3];
    const float t = (((a.x + a.y) + (a.z + a.w)) + ((b.x + b.y) + (b.z + b.w))) + (((c.x + c.y) + (c.z + c.w)) + ((d.x + d.y) + (d.z + d.w)));
    return rsqrtf(t * (1.f / 1024.f) + EPS);
}
__device__ __forceinline__ void rows_rstd(const float* ssq, size_t row0, int fq, float (&rs)[2][4]) {
#pragma unroll
    for (int ai = 0; ai < 2; ++ai)
#pragma unroll
        for (int m = 0; m < 4; ++m) { const f32x4 a = *(const f32x4*)(ssq + (row0 + ai * 128 + m * 16) * 16 + 4 * fq); rs[ai][m] = (a.x + a.y) + (a.z + a.w); }
#pragma unroll
    for (int ai = 0; ai < 2; ++ai)
#pragma unroll
        for (int m = 0; m < 4; ++m) { float t = rs[ai][m]; t += __shfl_xor(t, 16); t += __shfl_xor(t, 32); rs[ai][m] = rsqrtf(t * (1.f / 1024.f) + EPS); }
}
constexpr int RSTD_TAB_OFF = 137472, RSTD_TAB_UNITS = 20;
template <class Sched> __device__ __forceinline__ void build_rstd_table(const Sched& S, const float* ssq, LAS float* tab) {
    const int tid = otid(), r = tid >> 1, hh = tid & 1;
    Unit u;
    for (int i = 0; i < RSTD_TAB_UNITS && S.next(i, u); ++i) {
        const int st = S.ssq_tile(u);
        if (st < 0) { if (hh == 0) tab[i * 256 + r] = 1.f; continue; }
        const f32x4 a = *(const f32x4*)(ssq + ((size_t)st * 256 + r) * 16 + hh * 8), b = *(const f32x4*)(ssq + ((size_t)st * 256 + r) * 16 + hh * 8 + 4);
        float t = ((a.x + a.y) + (a.z + a.w)) + ((b.x + b.y) + (b.z + b.w));
        t += __shfl_xor(t, 1);
        if (hh == 0) tab[i * 256 + r] = rsqrtf(t * (1.f / 1024.f) + EPS);
    }
    __syncthreads();
}
__device__ __forceinline__ void rows_rstd_tab(const LAS float* tab, int idx, int rloc, float (&rs)[2][4]) {
#pragma unroll
    for (int ai = 0; ai < 2; ++ai)
#pragma unroll
        for (int m = 0; m < 4; ++m) rs[ai][m] = tab[idx * 256 + rloc + ai * 128 + m * 16];
}
template <bool ACC_I8 = false, bool REMAP = false> struct EpiStoreBf16 {
    static constexpr bool PERM = true, AFTER_DRAIN = false;
    static constexpr bool USES_TAB = true;
    bf16_t* O; int ldc; const float* ssq; float dq = 1.f; const LAS float* tab = nullptr;
    __device__ __forceinline__ void operator()(const f32x4 (&acc)[2][2][4][2], const Unit& u, int wr, int wc, int fr, int fq) const {
        const int ct = REMAP ? (u.pn < 4 ? u.pn : u.pn + 3) : u.pn;
        const int row0 = u.pm * 256 + wr * 64 + fr, col0 = ct * 256 + wc * 32 + 8 * fq;
        float rsv[2][4]; rows_rstd_tab(tab, u.idx, wr * 64 + fr, rsv);
#pragma unroll
        for (int ai = 0; ai < 2; ++ai)
#pragma unroll
            for (int m = 0; m < 4; ++m) {
                const float rs = ACC_I8 ? rsv[ai][m] * dq : rsv[ai][m];
                bf16_t* rowp = O + (size_t)(row0 + ai * 128 + m * 16) * ldc + col0;
#pragma unroll
                for (int bj = 0; bj < 2; ++bj) {
                    const f32x4 v0 = (ACC_I8 ? i2f4(acc[ai][bj][m][0]) : acc[ai][bj][m][0]) * rs, v1 = (ACC_I8 ? i2f4(acc[ai][bj][m][1]) : acc[ai][bj][m][1]) * rs;
                    u32x4 w; w.x = pk2(v0[0], v0[1]); w.y = pk2(v0[2], v0[3]); w.z = pk2(v1[0], v1[1]); w.w = pk2(v1[2], v1[3]);
                    *(u32x4*)(rowp + bj * 128) = w;
                }
            }
    }
};
struct EpiIn8 {
    static constexpr bool PERM = true, AFTER_DRAIN = false, USES_TAB = true;
    bf16_t* P; bf16_t* KB; bf16_t* VT; const float* ssq; float dq; const LAS float* tab = nullptr;
    __device__ __forceinline__ void operator()(const f32x4 (&acc)[2][2][4][2], const Unit& u, int wr, int wc, int fr, int fq) const {
        bf16_t* O; int ldc, rt, ct;
        if (u.pn < T8_WKV) { O = P; ldc = PW; rt = u.pm - T8_X; ct = u.pn; }
        else if (u.pm >= T8_MEMN) { const int l = (u.pn - T8_WKV) >> 2; O = KB + (size_t)l * MT * 512; ldc = 512; rt = u.pm - T8_MEMN; ct = (u.pn - T8_WKV) & 3; }
        else { const int l = (u.pm - T8_WKV) >> 2; O = VT + (size_t)l * 512 * MT; ldc = MT; rt = ((u.pm - T8_WKV) & 3) - 2; ct = u.pn - T8_MEMN; }
        const int row0 = rt * 256 + wr * 64 + fr, col0 = ct * 256 + wc * 32 + 8 * fq;
        float rsv[2][4]; rows_rstd_tab(tab, u.idx, wr * 64 + fr, rsv);
#pragma unroll
        for (int ai = 0; ai < 2; ++ai)
#pragma unroll
            for (int m = 0; m < 4; ++m) {
                const float rs = rsv[ai][m] * dq;
                bf16_t* rowp = O + (size_t)(row0 + ai * 128 + m * 16) * ldc + col0;
#pragma unroll
                for (int bj = 0; bj < 2; ++bj) {
                    const f32x4 v0 = i2f4(acc[ai][bj][m][0]) * rs, v1 = i2f4(acc[ai][bj][m][1]) * rs;
                    u32x4 w; w.x = pk2(v0[0], v0[1]); w.y = pk2(v0[2], v0[3]); w.z = pk2(v1[0], v1[1]); w.w = pk2(v1[2], v1[3]);
                    *(u32x4*)(rowp + bj * 128) = w;
                }
            }
    }
};
struct EpiIn {
    static constexpr bool PERM = true, AFTER_DRAIN = false;
    static constexpr bool USES_TAB = true;
    bf16_t* P; bf16_t* KB; bf16_t* VT; const float* ssq; const LAS float* tab = nullptr;
    __device__ __forceinline__ void operator()(const f32x4 (&acc)[2][2][4][2], const Unit& u, int wr, int wc, int fr, int fq) const {
        bf16_t* O; int ldc, rt, ct; const bool main_unit = u.pn < TILE_WKV;
        if (main_unit) { O = P; ldc = PW; rt = u.pm - TILE_HN; ct = u.pn; }
        else if (u.pm >= TILE_MEMN) { const int l = (u.pn - TILE_WKV) >> 2; O = KB + (size_t)l * MT * 512; ldc = 512; rt = u.pm - TILE_MEMN; ct = (u.pn - TILE_WKV) & 3; }
        else { const int l = (u.pm - TILE_WKV) >> 2; O = VT + (size_t)l * 512 * MT; ldc = MT; rt = ((u.pm - TILE_WKV) & 3) - 2; ct = u.pn - TILE_MEMN; }
        const int row0 = rt * 256 + wr * 64 + fr, col0 = ct * 256 + wc * 32 + 8 * fq;
        float rsv[2][4]; rows_rstd_tab(tab, u.idx, wr * 64 + fr, rsv);
#pragma unroll
        for (int ai = 0; ai < 2; ++ai)
#pragma unroll
            for (int m = 0; m < 4; ++m) {
                const float rs = rsv[ai][m];
                bf16_t* rowp = O + (size_t)(row0 + ai * 128 + m * 16) * ldc + col0;
#pragma unroll
                for (int bj = 0; bj < 2; ++bj) {
                    const f32x4 v0 = acc[ai][bj][m][0] * rs, v1 = acc[ai][bj][m][1] * rs;
                    u32x4 w; w.x = pk2(v0[0], v0[1]); w.y = pk2(v0[2], v0[3]); w.z = pk2(v1[0], v1[1]); w.w = pk2(v1[2], v1[3]);
                    *(u32x4*)(rowp + bj * 128) = w;
                }
            }
    }
};
template <bool ACC_I8 = false> struct EpiGeluBf16 {
    static constexpr bool PERM = true, AFTER_DRAIN = false;
    static constexpr bool USES_TAB = true;
    bf16_t* O; int ldc; const float* ssq; float* lnp; float dq = 1.f; const LAS float* tab = nullptr;
    __device__ __forceinline__ static f32x2 gelu_pk(f32x2 v) {
        const f32x2 av = __builtin_elementwise_abs(v), d = av * 0.2316418882f + 1.0f;
        f32x2 t; t.x = __builtin_amdgcn_rcpf(d.x); t.y = __builtin_amdgcn_rcpf(d.y);
        f32x2 q = t * 0.5307027145f + (-0.7265760135f); q = q * t + 0.7107068705f; q = q * t + (-0.142248368f); q = q * t + 0.127414796f; q = q * t;
        const f32x2 sq = (v * v) * (-0.72134752044f);
        f32x2 e; e.x = __builtin_amdgcn_exp2f(sq.x); e.y = __builtin_amdgcn_exp2f(sq.y);
        const f32x2 mm = v * (q * e), r = v - mm;
        f32x2 o; o.x = v.x < 0.f ? mm.x : r.x; o.y = v.y < 0.f ? mm.y : r.y; return o;
    }
    __device__ __forceinline__ static unsigned g2(float a, float b) { const f32x2 r = gelu_pk((f32x2){a, b}); return pk2(r.x, r.y); }
    __device__ __forceinline__ void operator()(const f32x4 (&acc)[2][2][4][2], const Unit& u, int wr, int wc, int fr, int fq) const {
        const int row0 = u.pm * 256 + wr * 64 + fr, col0 = u.pn * 256 + wc * 32 + 8 * fq;
        float rsv[2][4]; rows_rstd_tab(tab, u.idx, wr * 64 + fr, rsv);
#pragma unroll
        for (int ai = 0; ai < 2; ++ai)
#pragma unroll
            for (int m = 0; m < 4; ++m) {
                const size_t row = (size_t)(row0 + ai * 128 + m * 16);
                const float rs = ACC_I8 ? rsv[ai][m] * dq : rsv[ai][m];
                bf16_t* rowp = O + row * ldc + col0;
                float s1 = 0.f, s2 = 0.f;
#pragma unroll
                for (int bj = 0; bj < 2; ++bj) {
                    const f32x4 v0 = (ACC_I8 ? i2f4(acc[ai][bj][m][0]) : acc[ai][bj][m][0]) * rs, v1 = (ACC_I8 ? i2f4(acc[ai][bj][m][1]) : acc[ai][bj][m][1]) * rs;
                    const f32x2 ga = gelu_pk((f32x2){v0[0], v0[1]}), gb = gelu_pk((f32x2){v0[2], v0[3]}), gc = gelu_pk((f32x2){v1[0], v1[1]}), gd = gelu_pk((f32x2){v1[2], v1[3]});
                    u32x4 w; w.x = pk2(ga.x, ga.y); w.y = pk2(gb.x, gb.y); w.z = pk2(gc.x, gc.y); w.w = pk2(gd.x, gd.y);
                    *(u32x4*)(rowp + bj * 128) = w;
                    s1 += ((ga.x + ga.y) + (gb.x + gb.y)) + ((gc.x + gc.y) + (gd.x + gd.y));
                    s2 += ((ga.x * ga.x + ga.y * ga.y) + (gb.x * gb.x + gb.y * gb.y)) + ((gc.x * gc.x + gc.y * gc.y) + (gd.x * gd.x + gd.y * gd.y));
                }
                if (u.pn >= 4) {
                    s1 = sum_rows4(s1); s2 = sum_rows4(s2);
                    if (fq == 0) *(f32x2*)(lnp + (row * 16 + (u.pn - 4) * 4 + wc) * 2) = (f32x2){s1, s2};
                }
            }
    }
};
struct EpiSwigluBf16 {
    static constexpr bool PERM = true, AFTER_DRAIN = false, USES_TAB = false;
    bf16_t* O; int ldc; const float* ssq;
    __device__ __forceinline__ void operator()(const f32x4 (&acc)[2][2][4][2], const Unit& u, int wr, int wc, int fr, int fq) const {
        const int row0 = u.pm * 256 + wr * 64 + fr, col0 = u.pn * 128 + wc * 32 + 8 * fq;
        float rsv[2][4]; rows_rstd(ssq, (size_t)row0, fq, rsv);
#pragma unroll
        for (int ai = 0; ai < 2; ++ai)
#pragma unroll
            for (int m = 0; m < 4; ++m) {
                const float rs = rsv[ai][m];
                bf16_t* rowp = O + (size_t)(row0 + ai * 128 + m * 16) * ldc + col0;
                const f32x4 g0 = acc[ai][0][m][0] * rs, g1 = acc[ai][0][m][1] * rs, u0 = acc[ai][1][m][0] * rs, u1 = acc[ai][1][m][1] * rs;
                u32x4 w;
                w.x = pk2(silu_f(g0[0]) * u0[0], silu_f(g0[1]) * u0[1]); w.y = pk2(silu_f(g0[2]) * u0[2], silu_f(g0[3]) * u0[3]);
                w.z = pk2(silu_f(g1[0]) * u1[0], silu_f(g1[1]) * u1[1]); w.w = pk2(silu_f(g1[2]) * u1[2], silu_f(g1[3]) * u1[3]);
                *(u32x4*)rowp = w;
            }
    }
};
template <bool ACC_I8, bool OUT_F8> struct EpiSwigluQ {
    static constexpr bool PERM = true, AFTER_DRAIN = false;
    static constexpr bool USES_TAB = true;
    void* O; int ldc; const float* ssq; float dq; const LAS float* tab = nullptr;
    __device__ __forceinline__ void operator()(const f32x4 (&acc)[2][2][4][2], const Unit& u, int wr, int wc, int fr, int fq) const {
        const int row0 = u.pm * 256 + wr * 64 + fr, col0 = u.pn * 128 + wc * 32 + 8 * fq;
        float rsv[2][4]; rows_rstd_tab(tab, u.idx, wr * 64 + fr, rsv);
#pragma unroll
        for (int ai = 0; ai < 2; ++ai)
#pragma unroll
            for (int m = 0; m < 4; ++m) {
                const float rs = ACC_I8 ? rsv[ai][m] * dq : rsv[ai][m], rsu = OUT_F8 ? rs * ACT_SC : rs;
                f32x4 g0 = acc[ai][0][m][0], g1 = acc[ai][0][m][1], u0 = acc[ai][1][m][0], u1 = acc[ai][1][m][1];
                if (ACC_I8) { g0 = i2f4(g0); g1 = i2f4(g1); u0 = i2f4(u0); u1 = i2f4(u1); }
                g0 = g0 * rs; g1 = g1 * rs; u0 = u0 * rsu; u1 = u1 * rsu;
                if (OUT_F8) {
                    unsigned char* rowp = (unsigned char*)O + (size_t)(row0 + ai * 128 + m * 16) * ldc + col0;
                    u32x2 w;
                    w.x = pk4_f8(silu_f(g0[0]) * u0[0], silu_f(g0[1]) * u0[1], silu_f(g0[2]) * u0[2], silu_f(g0[3]) * u0[3]);
                    w.y = pk4_f8(silu_f(g1[0]) * u1[0], silu_f(g1[1]) * u1[1], silu_f(g1[2]) * u1[2], silu_f(g1[3]) * u1[3]);
                    *(u32x2*)rowp = w;
                } else {
                    bf16_t* rowp = (bf16_t*)O + (size_t)(row0 + ai * 128 + m * 16) * ldc + col0;
                    u32x4 w;
                    w.x = pk2(silu_f(g0[0]) * u0[0], silu_f(g0[1]) * u0[1]); w.y = pk2(silu_f(g0[2]) * u0[2], silu_f(g0[3]) * u0[3]);
                    w.z = pk2(silu_f(g1[0]) * u1[0], silu_f(g1[1]) * u1[1]); w.w = pk2(silu_f(g1[2]) * u1[2], silu_f(g1[3]) * u1[3]);
                    *(u32x4*)rowp = w;
                }
            }
    }
};
template <bool BASE_F32, bool SCALED = false, bool W8 = false> struct EpiResid {
    static constexpr bool PERM = true, AFTER_DRAIN = false;
    static constexpr bool USES_TAB = false;
    const float* xbase; bf16_t* H; float* ssq; unsigned char* H8 = nullptr; float hq = 0.f; float asc = 1.f;
    __device__ __forceinline__ void operator()(const f32x4 (&acc)[2][2][4][2], const Unit& u, int wr, int wc, int fr, int fq) const {
        const int row0 = u.pm * 256 + wr * 64 + fr, col0 = u.pn * 256 + wc * 32 + 8 * fq;
#pragma unroll
        for (int ai = 0; ai < 2; ++ai) {
            u32x4 hb[4][2];
            if (!BASE_F32) {
#pragma unroll
                for (int m = 0; m < 4; ++m)
#pragma unroll
                    for (int bj = 0; bj < 2; ++bj) hb[m][bj] = *(const u32x4*)(H + (size_t)(row0 + ai * 128 + m * 16) * 1024 + col0 + bj * 128);
            }
#pragma unroll
            for (int m = 0; m < 4; ++m) {
                const size_t row = (size_t)(row0 + ai * 128 + m * 16);
                float ss = 0.f; u32x4 q8 = (u32x4){0u, 0u, 0u, 0u};
#pragma unroll
                for (int bj = 0; bj < 2; ++bj) {
                    const size_t off = row * 1024 + col0 + bj * 128;
                    f32x4 b0, b1;
                    if (BASE_F32) { b0 = *(const f32x4*)(xbase + off); b1 = *(const f32x4*)(xbase + off + 4); }
                    else { const u32x4 hw = hb[m][bj];
                        b0 = (f32x4){bf2f((unsigned short)(hw.x & 0xffffu)), bf2f((unsigned short)(hw.x >> 16)), bf2f((unsigned short)(hw.y & 0xffffu)), bf2f((unsigned short)(hw.y >> 16))};
                        b1 = (f32x4){bf2f((unsigned short)(hw.z & 0xffffu)), bf2f((unsigned short)(hw.z >> 16)), bf2f((unsigned short)(hw.w & 0xffffu)), bf2f((unsigned short)(hw.w >> 16))}; }
                    const float sc = SCALED ? asc : 1.f;
                    const f32x4 v0 = b0 + acc[ai][bj][m][0] * sc, v1 = b1 + acc[ai][bj][m][1] * sc;
                    u32x4 w; w.x = pk2(v0[0], v0[1]); w.y = pk2(v0[2], v0[3]); w.z = pk2(v1[0], v1[1]); w.w = pk2(v1[2], v1[3]);
                    *(u32x4*)(H + off) = w;
                    if (W8) { q8[2 * bj] = pk4_i8(v0[0], v0[1], v0[2], v0[3], hq); q8[2 * bj + 1] = pk4_i8(v1[0], v1[1], v1[2], v1[3], hq); }
                    ss += ((v0[0] * v0[0] + v0[1] * v0[1]) + (v0[2] * v0[2] + v0[3] * v0[3])) + ((v1[0] * v1[0] + v1[1] * v1[1]) + (v1[2] * v1[2] + v1[3] * v1[3]));
                }
                if (W8) *(u32x4*)(H8 + row * 1024 + u.pn * 256 + wc * 64 + fq * 16) = q8;
                ss = sum_rows4(ss);
                if (fq == 0) ssq[row * 16 + u.pn * 4 + wc] = ss;
            }
        }
    }
};
namespace pg8 {
#define PG8_LAS __attribute__((address_space(3)))
constexpr int BM = 256, BK = 64, HALF = 128, HTB = HALF * BK * 2  , STAGE_BYTES = 8 * HTB, NXCD = 8, WGM = 8;
__host__ __device__ __forceinline__ int lds_byte(int r, int c) { const int st = (r >> 4) * 2 + (c >> 5), rr = r & 15, cc = c & 31, ob = rr * 64 + cc * 2; return st * 1024 + (ob ^ (((ob >> 9) & 1) << 5)); }
__host__ __device__ __forceinline__ void stage_rc(int b, int& R, int& C) { const int st = b / 1024, sb = b % 1024, swz = sb ^ (((sb >> 9) & 1) << 5); R = (st >> 1) * 16 + swz / 64; C = (st & 1) * 32 + (swz % 64) / 2; }
struct StaticOrder {
    int nM, nN, nwg, G, c;
    __host__ __device__ void init(int M, int N, int G_, int c_) { nM = M / BM; nN = N / BM; nwg = nM * nN; G = G_; c = c_; }
    __host__ __device__ bool next(int i, Unit& u) const {
        const long L = (long)i * G + c; if (L >= nwg) return false;
        int wgid = (int)L; { const int q = nwg / NXCD, r = nwg % NXCD, xcd = wgid % NXCD, off = wgid / NXCD; wgid = (xcd < r ? xcd * (q + 1) : r * (q + 1) + (xcd - r) * q) + off; }
        const int nig = WGM * nN, gid = wgid / nig, fm = gid * WGM, gsz = (nM - fm) < WGM ? (nM - fm) : WGM;
        u.pm = fm + ((wgid % nig) % gsz); u.pn = (wgid % nig) / gsz; u.idx = i; return true;
    }
    __host__ __device__ int ssq_tile(const Unit& u) const { return u.pm; }
    __device__ __forceinline__ void a_ready(const Unit&) const {}
    __device__ __forceinline__ void done(const Unit&) const {}
};
struct ComboOrder8 {
    StaticOrder so;
    __host__ __device__ void init(int G_, int c_) { so.init(T, 3840, G_, c_); }
    __host__ __device__ bool next(int i, Unit& u) const {
        const long L = (long)i * so.G + so.c;
        if (L < so.nwg) { so.next(i, u); u.pm += T8_X; return true; }
        const int j = (int)(L - so.nwg); if (j >= 128) return false;
        const int l = j >> 6, jj = j & 63; u.idx = i;
        if (jj < 32) { u.pm = T8_MEMN + (jj >> 1); u.pn = T8_WKV + 4 * l + (jj & 1); }
        else { const int q = jj - 32; u.pm = T8_WKV + 4 * l + 2 + (q >> 4); u.pn = T8_MEMN + (q & 15); }
        return true;
    }
    __host__ __device__ int ssq_tile(const Unit& u) const { return u.pn < T8_WKV ? u.pm - T8_X : -1; }
    __device__ __forceinline__ void a_ready(const Unit&) const {}
    __device__ __forceinline__ void done(const Unit&) const {}
};
struct ComboOrder {
    StaticOrder so; int nkv = 128;
    __host__ __device__ void init(int G_, int c_) { so.init(T, 1024, G_, c_); }
    __host__ __device__ bool next(int i, Unit& u) const {
        const long L = (long)i * so.G + so.c;
        if (L < so.nwg) { so.next(i, u); u.pm += TILE_HN; u.pn = u.pn < 3 ? u.pn + 4 : 14; return true; }
        const int j = (int)(L - so.nwg); if (j >= nkv) return false;
        const int l = j >> 6, jj = j & 63; u.idx = i;
        if (jj < 32) { u.pm = TILE_MEMN + (jj >> 1); u.pn = TILE_WKV + 4 * l + (jj & 1); }
        else { const int q = jj - 32; u.pm = TILE_WKV + 4 * l + 2 + (q >> 4); u.pn = TILE_MEMN + (q & 15); }
        return true;
    }
    __host__ __device__ int ssq_tile(const Unit& u) const { return u.pn < TILE_WKV ? u.pm - TILE_HN : -1; }
    __device__ __forceinline__ void a_ready(const Unit&) const {}
    __device__ __forceinline__ void done(const Unit&) const {}
};
template <class Epi, class Sched, bool ALIGN_EPI = false, bool SP2 = false, int QM = 0  >
__device__ __forceinline__ void gemm_phase(PG8_LAS unsigned char* lds, const Gemm g, const Sched& S, const Epi& E) {
    const int tid = otid(), wid = __builtin_amdgcn_readfirstlane(tid >> 6), lane = tid & 63, wr = wid >> 2, wc = wid & 3, fr = lane & 15, fq = lane >> 4;
    constexpr bool FP8 = (QM == 1), I8 = (QM == 2);
    const int K = g.K, nt = K / BK;
    unsigned voffA[2], voffB[2];
#pragma unroll
    for (int i = 0; i < 2; ++i) { int R, C; stage_rc(tid * 16 + i * 8192, R, C); const int Rb = Epi::PERM ? ((R & ~31) + perm32(R & 31)) : R;
        voffA[i] = (unsigned)(R * K + C) * 2u; voffB[i] = (unsigned)(Rb * K + C) * 2u; }
    const size_t kstep = (size_t)(BK * 2);
    const size_t hstep = (size_t)HALF * K * 2;
    const size_t tstep = 2 * hstep;
    const unsigned ldsw = (unsigned)wid * 1024u;
    const int aoff = lds_byte(wr * 64 + fr, fq * 8), boff = lds_byte(wc * 32 + fr, fq * 8);
#define PG8_SA(b, h) (((b) * 2 + (h)) * HTB)
#define PG8_SB(b, h) ((4 + (b) * 2 + (h)) * HTB)
#define PG8_STAGE(bufoff, gbase, voff) do { _Pragma("unroll") for (int _i = 0; _i < 2; ++_i) \
        __builtin_amdgcn_global_load_lds((const unsigned*)((const char*)(gbase) + (voff)[_i]), (PG8_LAS unsigned*)(lds + (bufoff) + ldsw + _i * 8192), 16, 0, 0); } while (0)
#define PG8_LD16(off) (*(const PG8_LAS bf16x8*)(lds + (off)))
#define PG8_LDA(dst, b, h) do { _Pragma("unroll") for (int m = 0; m < 4; ++m) { \
        if constexpr (FP8) dst##8[m] = PG8_CAT(PG8_LD16(PG8_SA(b, h) + aoff + m * 2048), PG8_LD16(PG8_SA(b, h) + aoff + m * 2048 + 1024)); \
        else { _Pragma("unroll") for (int k = 0; k < 2; ++k) dst[m][k] = PG8_LD16(PG8_SA(b, h) + aoff + m * 2048 + k * 1024); } } } while (0)
#define PG8_LDB(dst, b, h) do { _Pragma("unroll") for (int n = 0; n < 2; ++n) { \
        if constexpr (FP8) dst##8[n] = PG8_CAT(PG8_LD16(PG8_SB(b, h) + boff + n * 2048), PG8_LD16(PG8_SB(b, h) + boff + n * 2048 + 1024)); \
        else { _Pragma("unroll") for (int k = 0; k < 2; ++k) dst[n][k] = PG8_LD16(PG8_SB(b, h) + boff + n * 2048 + k * 1024); } } } while (0)
#define PG8_CAT(x, y) __builtin_shufflevector(__builtin_bit_cast(i32x4v, x), __builtin_bit_cast(i32x4v, y), 0, 1, 2, 3, 4, 5, 6, 7)
#define PG8_MMA(ai, bj, At, Bt) do { __builtin_amdgcn_s_setprio(1); \
        if constexpr (FP8) { _Pragma("unroll") for (int m = 0; m < 4; ++m) _Pragma("unroll") for (int n = 0; n < 2; ++n) \
            asm("v_mfma_f32_16x16x128_f8f6f4 %0, %1, %2, %0" : "+v"(acc[ai][bj][m][n]) : "v"(Bt##8[n]), "v"(At##8[m])); } \
        else if constexpr (I8) { _Pragma("unroll") for (int m = 0; m < 4; ++m) _Pragma("unroll") for (int n = 0; n < 2; ++n) _Pragma("unroll") for (int k = 0; k < 2; ++k) \
            acc[ai][bj][m][n] = __builtin_bit_cast(f32x4, __builtin_amdgcn_mfma_i32_16x16x64_i8(__builtin_bit_cast(i32x4v, Bt[n][k]), __builtin_bit_cast(i32x4v, At[m][k]), __builtin_bit_cast(i32x4v, acc[ai][bj][m][n]), 0, 0, 0)); } \
        else { _Pragma("unroll") for (int m = 0; m < 4; ++m) _Pragma("unroll") for (int n = 0; n < 2; ++n) _Pragma("unroll") for (int k = 0; k < 2; ++k) \
            acc[ai][bj][m][n] = __builtin_amdgcn_mfma_f32_16x16x32_bf16(Bt[n][k], At[m][k], acc[ai][bj][m][n], 0, 0, 0); } \
        __builtin_amdgcn_s_setprio(0); } while (0)
#define PG8_WAIT_V(n) asm volatile("s_waitcnt vmcnt(" #n ")" ::: "memory")
#define PG8_WAIT_L(n) asm volatile("s_waitcnt lgkmcnt(" #n ")" ::: "memory")
#define PG8_BAR __builtin_amdgcn_s_barrier()
#define PG8_SCHED __builtin_amdgcn_sched_barrier(0)
    Unit cur, nxt; int ui = 0;
    if (!S.next(0, cur)) return;
    f32x4 acc[2][2][4][2];
#pragma unroll
    for (int a = 0; a < 2; ++a)
#pragma unroll
        for (int b = 0; b < 2; ++b)
#pragma unroll
            for (int m = 0; m < 4; ++m)
#pragma unroll
                for (int n = 0; n < 2; ++n) acc[a][b][m][n] = (f32x4){0.f, 0.f, 0.f, 0.f};
    bf16x8 At[4][2], B0[2][2], B1[2][2];
    i32x8v At8[4], B08[2], B18[2];
    const char* cA = (const char*)g.A + (size_t)cur.pm * tstep; const char* cB = (const char*)g.Bt + (size_t)cur.pn * tstep;
    S.a_ready(cur);
    if constexpr (SP2) {
        PG8_STAGE(PG8_SB(0, 0), cB, voffB); PG8_STAGE(PG8_SB(0, 1), cB + hstep, voffB); PG8_STAGE(PG8_SA(0, 0), cA, voffA); PG8_STAGE(PG8_SA(0, 1), cA + hstep, voffA);
        if (wr == 1) PG8_BAR;
        PG8_WAIT_V(2); PG8_BAR;
        PG8_STAGE(PG8_SB(1, 0), cB + kstep, voffB); PG8_STAGE(PG8_SA(1, 0), cA + kstep, voffA); PG8_STAGE(PG8_SB(1, 1), cB + hstep + kstep, voffB);
        PG8_WAIT_V(6); PG8_BAR;
    } else {
        PG8_STAGE(PG8_SB(0, 0), cB, voffB); PG8_STAGE(PG8_SA(0, 0), cA, voffA); PG8_STAGE(PG8_SB(0, 1), cB + hstep, voffB); PG8_STAGE(PG8_SA(0, 1), cA + hstep, voffA);
        if (wr == 1) PG8_BAR;
        PG8_WAIT_V(4); PG8_BAR;
        PG8_STAGE(PG8_SB(1, 0), cB + kstep, voffB); PG8_STAGE(PG8_SA(1, 0), cA + kstep, voffA); PG8_STAGE(PG8_SB(1, 1), cB + hstep + kstep, voffB);
        PG8_WAIT_V(6); PG8_BAR;
    }
    for (;;) {
        const bool has_next = S.next(ui + 1, nxt);
        const char* nA = has_next ? (const char*)g.A + (size_t)nxt.pm * tstep : cA; const char* nB = has_next ? (const char*)g.Bt + (size_t)nxt.pn * tstep : cB;
        for (int t = 0; t < nt; t += 2) {
            const bool last = (t == nt - 2);
            if constexpr (FP8) __builtin_amdgcn_s_waitcnt(0xC07F);
            const char* a1 = cA + (size_t)(t + 1) * kstep;
            const char* a2 = last ? nA : cA + (size_t)(t + 2) * kstep; const char* b2 = last ? nB : cB + (size_t)(t + 2) * kstep;
            const char* a3 = a2 + kstep; const char* b3 = b2 + kstep;
            if (last && has_next) S.a_ready(nxt);
            if constexpr (SP2) {
            PG8_LDB(B0, 0, 0); PG8_LDB(B1, 0, 1); PG8_SCHED; PG8_LDA(At, 0, 0); PG8_STAGE(PG8_SA(1, 1), a1 + hstep, voffA);
            PG8_WAIT_V(8); PG8_WAIT_L(0); PG8_BAR; PG8_MMA(0, 0, At, B0); PG8_MMA(0, 1, At, B1); PG8_BAR; PG8_SCHED;
            PG8_LDA(At, 0, 1); PG8_STAGE(PG8_SB(0, 0), b2, voffB); PG8_STAGE(PG8_SB(0, 1), b2 + hstep, voffB); PG8_STAGE(PG8_SA(0, 0), a2, voffA);
            PG8_WAIT_V(8); PG8_WAIT_L(0); PG8_BAR; PG8_MMA(1, 0, At, B0); PG8_MMA(1, 1, At, B1); PG8_BAR; PG8_SCHED;
            PG8_LDB(B0, 1, 0); PG8_LDB(B1, 1, 1); PG8_SCHED; PG8_LDA(At, 1, 0); PG8_STAGE(PG8_SA(0, 1), a2 + hstep, voffA);
            PG8_WAIT_V(8); PG8_WAIT_L(0); PG8_BAR; PG8_MMA(0, 0, At, B0); PG8_MMA(0, 1, At, B1); PG8_BAR; PG8_SCHED;
            PG8_LDA(At, 1, 1); PG8_STAGE(PG8_SB(1, 0), b3, voffB); PG8_STAGE(PG8_SB(1, 1), b3 + hstep, voffB); PG8_STAGE(PG8_SA(1, 0), a3, voffA);
            PG8_WAIT_V(8); PG8_WAIT_L(0); PG8_BAR; PG8_MMA(1, 0, At, B0); PG8_MMA(1, 1, At, B1); PG8_BAR; PG8_SCHED;
            } else {
            PG8_LDB(B0, 0, 0); PG8_SCHED; PG8_LDA(At, 0, 0); PG8_STAGE(PG8_SA(1, 1), a1 + hstep, voffA);
            PG8_WAIT_L(8); PG8_BAR; PG8_WAIT_L(0); PG8_MMA(0, 0, At, B0); PG8_BAR; PG8_SCHED;
            PG8_LDB(B1, 0, 1); PG8_STAGE(PG8_SB(0, 0), b2, voffB);
            PG8_BAR; PG8_WAIT_L(0); PG8_MMA(0, 1, At, B1); PG8_BAR;
            PG8_LDA(At, 0, 1); PG8_STAGE(PG8_SA(0, 0), a2, voffA);
            PG8_BAR; PG8_WAIT_L(0); PG8_MMA(1, 0, At, B0); PG8_BAR; PG8_SCHED;
            PG8_STAGE(PG8_SB(0, 1), b2 + hstep, voffB);
            PG8_WAIT_V(6); PG8_BAR; PG8_MMA(1, 1, At, B1); PG8_BAR;
            PG8_LDB(B0, 1, 0); PG8_SCHED; PG8_LDA(At, 1, 0); PG8_STAGE(PG8_SA(0, 1), a2 + hstep, voffA);
            PG8_WAIT_L(8); PG8_BAR; PG8_WAIT_L(0); PG8_MMA(0, 0, At, B0); PG8_BAR; PG8_SCHED;
            PG8_LDB(B1, 1, 1); PG8_STAGE(PG8_SB(1, 0), b3, voffB);
            PG8_BAR; PG8_WAIT_L(0); PG8_MMA(0, 1, At, B1); PG8_BAR;
            PG8_LDA(At, 1, 1); PG8_STAGE(PG8_SA(1, 0), a3, voffA);
            PG8_BAR; PG8_WAIT_L(0); PG8_MMA(1, 0, At, B0); PG8_BAR; PG8_SCHED;
            PG8_STAGE(PG8_SB(1, 1), b3 + hstep, voffB);
            PG8_WAIT_V(6); PG8_BAR; PG8_MMA(1, 1, At, B1); PG8_BAR;
            }
        }
        if constexpr (FP8) asm volatile("s_nop 15\n\ts_nop 15" ::: "memory");
        if constexpr (ALIGN_EPI) { if (wr == 0) PG8_BAR; }
        if constexpr (!Epi::AFTER_DRAIN) { E(acc, cur, wr, wc, fr, fq); S.done(cur); }
        if (!has_next) break;
#pragma unroll
        for (int a = 0; a < 2; ++a)
#pragma unroll
            for (int b = 0; b < 2; ++b)
#pragma unroll
                for (int m = 0; m < 4; ++m)
#pragma unroll
                    for (int n = 0; n < 2; ++n) acc[a][b][m][n] = (f32x4){0.f, 0.f, 0.f, 0.f};
        cur = nxt; cA = nA; cB = nB; ++ui;
        if constexpr (ALIGN_EPI) { if (wr == 1) PG8_BAR; }
    }
    PG8_WAIT_V(0);
    if constexpr (!ALIGN_EPI) { if (wr == 0) PG8_BAR; }
    PG8_BAR;
    if constexpr (Epi::AFTER_DRAIN) { E.fused(acc, cur, wr, wc, fr, fq, lds, wid, lane); S.done(cur); }
#undef PG8_SA
#undef PG8_SB
#undef PG8_STAGE
#undef PG8_LDA
#undef PG8_LD16
#undef PG8_LDB
#undef PG8_MMA
#undef PG8_CAT
#undef PG8_WAIT_V
#undef PG8_WAIT_L
#undef PG8_BAR
#undef PG8_SCHED
}
}

template <class Epi, int QM = 0>
__device__ __forceinline__ void run_gemm(const Gemm g, Epi E, LAS float* lds, int vb, int nvb) {
    pg8::StaticOrder S; S.init(g.M, g.N, nvb, vb);
    if constexpr (Epi::USES_TAB) { LAS float* tab = (LAS float*)((LAS unsigned char*)lds + RSTD_TAB_OFF); build_rstd_table(S, E.ssq, tab); E.tab = tab; }
    pg8::gemm_phase<Epi, pg8::StaticOrder, true, true, QM>((LAS unsigned char*)lds, g, S, E);
}

enum { MAP_ID = 0, MAP_WIN = 1, MAP_GU = 2, MAP_WIN8 = 3   };
struct PrepJob { const float* W; int K, N; const float* gain; bf16_t* dst; int r0, r1, ldd, koff, map; int fmt; float osc; };
__device__ __forceinline__ int map_src(int map, int r, int N) {
    if (map == MAP_ID) return r < N ? r : -1;
    if (map == MAP_WIN) {
        if (r < 1728) return r - 512;
        if (r < 3776) return r - 504;
        if (r < 3784) return r - 2560;
        return -1;
    }
    if (map == MAP_WIN8) return r + 264;
    { const int tile = r >> 8, w = r & 255, j = tile * 128 + (w & 127); return w < 128 ? j : FF + j; }
}
__device__ __forceinline__ void prep_tile_load(const PrepJob& j, int t, f32x4 (&v)[8]) {
    const int nkt = j.K / 64, kt = t % nkt, rt = t / nkt, k0 = kt * 64, r0 = j.r0 + rt * 256;
#pragma unroll
    for (int q = 0; q < 8; ++q) {
        const int i = (int)threadIdx.x + q * NTHREADS, kk = i >> 6, r4 = (i & 63) * 4;
        const int sc = map_src(j.map, r0 + r4, j.N);
        v[q] = sc >= 0 ? __builtin_nontemporal_load((const f32x4*)(j.W + (size_t)(k0 + kk) * j.N + sc)) : (f32x4){0.f, 0.f, 0.f, 0.f};
        if (j.gain) v[q] = v[q] * j.gain[k0 + kk];
    }
}
__device__ __forceinline__ void prep_tile_store(const PrepJob& j, int t, const f32x4 (&v)[8], LAS float* tile  ) {
    const int nkt = j.K / 64, kt = t % nkt, rt = t / nkt, k0 = kt * 64, r0 = j.r0 + rt * 256;
    __syncthreads();
#pragma unroll
    for (int q = 0; q < 8; ++q) { const int i = (int)threadIdx.x + q * NTHREADS, kk = i >> 6, r4 = (i & 63) * 4; *(LAS f32x4*)(tile + kk * 260 + r4) = v[q]; }
    __syncthreads();
#pragma unroll
    for (int q = 0; q < 4; ++q) {
        const int i = (int)threadIdx.x + q * NTHREADS, rr = i & 255, c8 = i >> 8;
        const LAS float* tp = tile + (c8 * 8) * 260 + rr;
        if (j.fmt != 0) {
            const float sc = j.osc; u32x2 w;
            if (j.fmt == 1 || j.fmt == 3) { w.x = pk4_f8(tp[0] * sc, tp[260] * sc, tp[520] * sc, tp[780] * sc); w.y = pk4_f8(tp[1040] * sc, tp[1300] * sc, tp[1560] * sc, tp[1820] * sc); }
            else { w.x = pk4_i8(tp[0], tp[260], tp[520], tp[780], sc); w.y = pk4_i8(tp[1040], tp[1300], tp[1560], tp[1820], sc); }
            unsigned char* drow = (unsigned char*)j.dst + (size_t)(r0 + rr) * j.ldd + j.koff; const int kk = k0 + c8 * 8;
            if (j.fmt == 3) { const int r = kk & 127, pp = (kk & ~127) + (r >> 5) * 16 + ((r >> 3) & 3) * 4; *(unsigned*)(drow + pp) = w.x; *(unsigned*)(drow + pp + 64) = w.y; }
            else *(u32x2*)(drow + (j.fmt == 2 ? kperm8(kk) : kk)) = w;
        } else {
        u32x4 w; w.x = pk2(tp[0], tp[260]); w.y = pk2(tp[520], tp[780]); w.z = pk2(tp[1040], tp[1300]); w.w = pk2(tp[1560], tp[1820]);
        *(u32x4*)(j.dst + (size_t)(r0 + rr) * j.ldd + j.koff + k0 + c8 * 8) = w;
        }
    }
}
__device__ __forceinline__ void prep_fold_in(const float* w_in  , const float* w_uk  , const float* gain, bf16_t* dst, LAS float* lds, int vb, int nvb) {
    LAS float* A = lds; LAS float* B = lds + 32 * 65;
    const int tid = otid(), lane = tid & 63, wid = __builtin_amdgcn_readfirstlane(tid >> 6), l15 = lane & 15, dq = lane >> 4;
    for (int item = vb; item < 256; item += nvb) {
        const int h = item >> 5, k0 = (item & 31) * 32;
        __syncthreads();
        for (int i = tid; i < 2048; i += NTHREADS) { const int kk = i >> 6, d = i & 63; A[kk * 65 + d] = w_in[(size_t)(k0 + kk) * 3272 + h * 64 + d] * gain[k0 + kk]; }
        for (int i = tid; i < 8192; i += NTHREADS) { const int c = i >> 6, d = i & 63; B[c * 65 + d] = w_uk[(size_t)(h * 128 + c) * 64 + d]; }
        __syncthreads();
        f32x4 acc0 = (f32x4){0.f, 0.f, 0.f, 0.f}, acc1 = acc0;
#pragma unroll 4
        for (int d0 = 0; d0 < 64; d0 += 4) {
            const float b = B[(16 * wid + l15) * 65 + d0 + dq], a0 = A[l15 * 65 + d0 + dq], a1 = A[(16 + l15) * 65 + d0 + dq];
            acc0 = __builtin_amdgcn_mfma_f32_16x16x4f32(a0, b, acc0, 0, 0, 0);
            acc1 = __builtin_amdgcn_mfma_f32_16x16x4f32(a1, b, acc1, 0, 0, 0);
        }
        unsigned char* drow = (unsigned char*)dst + (size_t)(h * 128 + 16 * wid + l15) * 1024 + k0 + 4 * dq;
        *(unsigned*)drow = pk4_i8(acc0[0], acc0[1], acc0[2], acc0[3], WQ_GU);
        *(unsigned*)(drow + 16) = pk4_i8(acc1[0], acc1[1], acc1[2], acc1[3], WQ_GU);
    }
}
__device__ __forceinline__ void prep_fold_out(const float* w_out  , const float* w_uv  , bf16_t* dst  , LAS float* lds, int vb, int nvb) {
    LAS float* A = lds; LAS float* B = lds + 64 * 33;
    const int tid = otid(), lane = tid & 63, wid = __builtin_amdgcn_readfirstlane(tid >> 6), l15 = lane & 15, dq = lane >> 4;
    for (int item = vb; item < 256; item += nvb) {
        const int h = item >> 5, n0 = (item & 31) * 32;
        __syncthreads();
        for (int i = tid; i < 2048; i += NTHREADS) { const int d = i >> 5, nn = i & 31; A[d * 33 + nn] = w_out[(size_t)(h * 64 + d) * 1024 + n0 + nn]; }
        for (int i = tid; i < 8192; i += NTHREADS) { const int c = i >> 6, d = i & 63; B[c * 65 + d] = w_uv[(size_t)(h * 128 + c) * 64 + d]; }
        __syncthreads();
        f32x4 acc0 = (f32x4){0.f, 0.f, 0.f, 0.f}, acc1 = acc0;
#pragma unroll 4
        for (int d0 = 0; d0 < 64; d0 += 4) {
            const float a = B[(16 * wid + l15) * 65 + d0 + dq], b0 = A[(d0 + dq) * 33 + l15], b1 = A[(d0 + dq) * 33 + 16 + l15];
            acc0 = __builtin_amdgcn_mfma_f32_16x16x4f32(a, b0, acc0, 0, 0, 0);
            acc1 = __builtin_amdgcn_mfma_f32_16x16x4f32(a, b1, acc1, 0, 0, 0);
        }
        { u32x2 w; w.x = pk2(acc0[0], acc0[1]); w.y = pk2(acc0[2], acc0[3]); *(u32x2*)(dst + (size_t)(n0 + l15) * KOUT + h * 128 + 16 * wid + 4 * dq) = w; }
        { u32x2 w; w.x = pk2(acc1[0], acc1[1]); w.y = pk2(acc1[2], acc1[3]); *(u32x2*)(dst + (size_t)(n0 + 16 + l15) * KOUT + h * 128 + 16 * wid + 4 * dq) = w; }
    }
}
__device__ __forceinline__ void prep_lb(const float* hgrn_lb  , float* lb, int vb, int nvb) {
    for (int i = vb * NTHREADS + threadIdx.x; i < 512; i += nvb * NTHREADS) {
        const float a = hgrn_lb[i], b = hgrn_lb[512 + i], c = hgrn_lb[1024 + i], m = fmaxf(a, fmaxf(b, c));
        const float ea = __expf(a - m), eb = __expf(b - m), ec = __expf(c - m);
        lb[i] = ea / (ea + eb + ec);
    }
}

__device__ __forceinline__ void rmsnorm_rows(const float* X, unsigned char* Y8, int nrows, int vb, int nvb) {
    const int tid = otid(), lane = tid & 63, gw = vb * NWAVES + __builtin_amdgcn_readfirstlane(tid >> 6), ngw = nvb * NWAVES;
    for (int r = gw; r < nrows; r += ngw) {
        const f32x4* xr = (const f32x4*)(X + (size_t)r * D) + lane;
        f32x4 v[4]; float s = 0.f;
#pragma unroll
        for (int j = 0; j < 4; ++j) { v[j] = xr[64 * j]; s += (v[j].x * v[j].x + v[j].y * v[j].y) + (v[j].z * v[j].z + v[j].w * v[j].w); }
        const float rs = rsqrtf(wave_sum(s) * (1.f / D) + EPS) * HQ_X;
        unsigned* o = (unsigned*)(Y8 + (size_t)r * D) + lane;
#pragma unroll
        for (int j = 0; j < 4; ++j) o[64 * j] = pk4_i8(v[j].x, v[j].y, v[j].z, v[j].w, rs);
    }
}
__device__ __forceinline__ void x_to_h_rows(const float* X, bf16_t* H, unsigned char* X8, float* ssq, int vb, int nvb) {
    const int tid = otid(), lane = tid & 63, gw = vb * NWAVES + __builtin_amdgcn_readfirstlane(tid >> 6), ngw = nvb * NWAVES;
    for (int r = gw; r < T; r += 2 * ngw) {
        const int r2 = (r + ngw < T) ? r + ngw : r;
        f32x4 v[2][4];
#pragma unroll
        for (int j = 0; j < 4; ++j) { v[0][j] = __builtin_nontemporal_load((const f32x4*)(X + (size_t)r * D) + lane + 64 * j); v[1][j] = __builtin_nontemporal_load((const f32x4*)(X + (size_t)r2 * D) + lane + 64 * j); }
#pragma unroll
        for (int q = 0; q < 2; ++q) {
            const int rr = q ? r2 : r;
            u32x2* o = (u32x2*)(H + (size_t)rr * D) + lane;
            float s = 0.f;
#pragma unroll
            for (int j = 0; j < 4; ++j) { const f32x4 x = v[q][j]; u32x2 w; w.x = pk2(x.x, x.y); w.y = pk2(x.z, x.w); o[64 * j] = w;
                *((unsigned*)(X8 + (size_t)rr * D) + lane + 64 * j) = pk4_i8(x.x, x.y, x.z, x.w, HQ_X);
                const float a = bf2f((unsigned short)(w.x & 0xffffu)), b = bf2f((unsigned short)(w.x >> 16)), c = bf2f((unsigned short)(w.y & 0xffffu)), d = bf2f((unsigned short)(w.y >> 16));
                s += (a * a + b * b) + (c * c + d * d); }
            s = wave_sum(s);
            if (lane < 16) ssq[(size_t)rr * 16 + lane] = lane == 0 ? s : 0.f;
        }
    }
}
__device__ __forceinline__ void final_rows(const bf16_t* H, const float* ssq, const float* g, float* out, int vb, int nvb) {
    const int tid = otid(), lane = tid & 63, gw = vb * NWAVES + __builtin_amdgcn_readfirstlane(tid >> 6), ngw = nvb * NWAVES;
    f32x4 gg[4];
#pragma unroll
    for (int j = 0; j < 4; ++j) gg[j] = *((const f32x4*)g + lane + 64 * j);
    for (int r = gw; r < T; r += 2 * ngw) {
        const int r2 = (r + ngw < T) ? r + ngw : r;
        u32x2 w[2][4]; float rs[2];
#pragma unroll
        for (int j = 0; j < 4; ++j) { w[0][j] = ((const u32x2*)(H + (size_t)r * D) + lane)[64 * j]; w[1][j] = ((const u32x2*)(H + (size_t)r2 * D) + lane)[64 * j]; }
        rs[0] = row_rstd(ssq, (size_t)r); rs[1] = row_rstd(ssq, (size_t)r2);
#pragma unroll
        for (int q = 0; q < 2; ++q) {
            f32x4* o = (f32x4*)(out + (size_t)(q ? r2 : r) * D) + lane;
#pragma unroll
            for (int j = 0; j < 4; ++j) { const u32x2 ww = w[q][j];
                __builtin_nontemporal_store((f32x4){bf2f((unsigned short)(ww.x & 0xffffu)) * rs[q] * gg[j].x, bf2f((unsigned short)(ww.x >> 16)) * rs[q] * gg[j].y, bf2f((unsigned short)(ww.y & 0xffffu)) * rs[q] * gg[j].z, bf2f((unsigned short)(ww.y >> 16)) * rs[q] * gg[j].w}, o + 64 * j); }
        }
    }
}
__device__ __forceinline__ float row16_sum(float v) {
    v += __uint_as_float((unsigned)__builtin_amdgcn_update_dpp(0, (int)__float_as_uint(v), 0x128, 0xf, 0xf, false));
    v += __uint_as_float((unsigned)__builtin_amdgcn_update_dpp(0, (int)__float_as_uint(v), 0x124, 0xf, 0xf, false));
    v += __uint_as_float((unsigned)__builtin_amdgcn_update_dpp(0, (int)__float_as_uint(v), 0x122, 0xf, 0xf, false));
    v += __uint_as_float((unsigned)__builtin_amdgcn_update_dpp(0, (int)__float_as_uint(v), 0x121, 0xf, 0xf, false));
    return v;
}
__device__ __forceinline__ void cnorm_rows(const bf16_t* P, const float* lat_g, bf16_t* CN, int vb, int nvb) {
    const int tid = otid(), lane = tid & 63, gw = vb * NWAVES + __builtin_amdgcn_readfirstlane(tid >> 6), ngw = nvb * NWAVES, r4 = lane >> 4, l16 = lane & 15;
    const f32x4 ga = *(const f32x4*)(lat_g + l16 * 8), gb = *(const f32x4*)(lat_g + l16 * 8 + 4);
    for (int r = gw * 8; r < T; r += ngw * 8) {
        u32x4 w[2];
#pragma unroll
        for (int q = 0; q < 2; ++q) w[q] = *(const u32x4*)(P + (size_t)(r + 4 * q + r4) * PW + P_C + l16 * 8);
#pragma unroll
        for (int q = 0; q < 2; ++q) {
            const float x0 = bf2f((unsigned short)(w[q].x & 0xffffu)), x1 = bf2f((unsigned short)(w[q].x >> 16)), x2 = bf2f((unsigned short)(w[q].y & 0xffffu)), x3 = bf2f((unsigned short)(w[q].y >> 16));
            const float x4 = bf2f((unsigned short)(w[q].z & 0xffffu)), x5 = bf2f((unsigned short)(w[q].z >> 16)), x6 = bf2f((unsigned short)(w[q].w & 0xffffu)), x7 = bf2f((unsigned short)(w[q].w >> 16));
            const float ss = row16_sum(((x0 * x0 + x1 * x1) + (x2 * x2 + x3 * x3)) + ((x4 * x4 + x5 * x5) + (x6 * x6 + x7 * x7)));
            const float rs = rsqrtf(ss * (1.f / 128.f) + EPS);
            u32x4 o; o.x = pk2(x0 * rs * ga.x, x1 * rs * ga.y); o.y = pk2(x2 * rs * ga.z, x3 * rs * ga.w); o.z = pk2(x4 * rs * gb.x, x5 * rs * gb.y); o.w = pk2(x6 * rs * gb.z, x7 * rs * gb.w);
            *(u32x4*)(CN + (size_t)(r + 4 * q + r4) * 128 + l16 * 8) = o;
        }
    }
}
__device__ __forceinline__ int t5_bucket(int rel) {
    const int n = rel < 0 ? -rel : rel;
    int b = n < 8 ? n : 8 + (n >= 12) + (n >= 16) + (n >= 23) + (n >= 32) + (n >= 46) + (n >= 64) + (n >= 91);
    return b + (rel > 0 ? 16 : 0);
}
__device__ __forceinline__ unsigned sort_key(float x) { const unsigned u = __float_as_uint(x); return (u & 0x80000000u) ? ~u : (u | 0x80000000u); }


template <int CTRL, int ROWMASK> __device__ __forceinline__ unsigned dpp0(unsigned v) { return (unsigned)__builtin_amdgcn_update_dpp(0, (int)v, CTRL, ROWMASK, 0xf, false); }
__device__ __forceinline__ unsigned wave_prefix_incl(unsigned v) {
    v += dpp0<0x111, 0xf>(v); v += dpp0<0x112, 0xf>(v); v += dpp0<0x114, 0xf>(v); v += dpp0<0x118, 0xf>(v);
    v += dpp0<0x142, 0xa>(v);
    v += dpp0<0x143, 0xc>(v);
    return v;
}
__device__ __forceinline__ float wave_max_u(float v) {
    v = fmaxf(v, __uint_as_float((unsigned)__builtin_amdgcn_update_dpp(0, (int)__float_as_uint(v), 0x128, 0xf, 0xf, false)));
    v = fmaxf(v, __uint_as_float((unsigned)__builtin_amdgcn_update_dpp(0, (int)__float_as_uint(v), 0x124, 0xf, 0xf, false)));
    v = fmaxf(v, __uint_as_float((unsigned)__builtin_amdgcn_update_dpp(0, (int)__float_as_uint(v), 0x122, 0xf, 0xf, false)));
    v = fmaxf(v, __uint_as_float((unsigned)__builtin_amdgcn_update_dpp(0, (int)__float_as_uint(v), 0x121, 0xf, 0xf, false)));
    const int b = (int)__float_as_uint(v);
    return fmaxf(fmaxf(__uint_as_float((unsigned)__builtin_amdgcn_readlane(b, 0)), __uint_as_float((unsigned)__builtin_amdgcn_readlane(b, 16))),
                 fmaxf(__uint_as_float((unsigned)__builtin_amdgcn_readlane(b, 32)), __uint_as_float((unsigned)__builtin_amdgcn_readlane(b, 48))));
}

typedef short v4i16_t __attribute__((ext_vector_type(4)));
constexpr int DSA_BT_OFF = 131072 + 256, DSA_WS_OFF = DSA_BT_OFF + 6144;
__device__ __forceinline__ unsigned dsa_bucket(float x, float lo, float sc) { const float f = (x - lo) * sc; const unsigned b = (unsigned)f; return b > 255u ? 255u : b; }
__device__ __forceinline__ unsigned off_b(unsigned row, unsigned ch) { return 256u * row + 16u * (ch ^ (((row & 3) << 2) | ((row >> 2) & 3))); }
__device__ __forceinline__ void dsa_mfma_phase(const bf16_t* P, const bf16_t* CN, const float* rel_bias, bf16_t* CAT, LAS unsigned char* lds, unsigned* qctr) {
    const int tid = otid(), lane = tid & 63, wid = __builtin_amdgcn_readfirstlane(tid >> 6);
    LAS float* BT = (LAS float*)(lds + DSA_BT_OFF);
    __syncthreads();
    for (int i = tid; i < 191 * 8; i += NTHREADS) { const int rel = (i >> 3) - 127; BT[i] = rel_bias[t5_bucket(rel) * 8 + (i & 7)]; }
    const unsigned long long lt_mask = (lane == 0) ? 0ull : (~0ull >> (64 - lane));
    volatile LAS int* qslot = (volatile LAS int*)(lds + 131072 + 64);
    int nxt = 0;
    if (tid == 0) { *qslot = (int)atomicAdd(qctr, 1u); nxt = (int)atomicAdd(qctr, 1u); }
    for (;;) {
        __syncthreads();
        const int u = *qslot;
        if (u >= T / 16) break;
        const int b = u & 15, qg = 127 - (u >> 4), t0 = qg * 16, nj = t0 / CHUNK + 1, L = nj * CHUNK, nt = L / 32;
        const bf16_t* Pb = P + (size_t)b * SEQ * PW;
        {
            int ln1 = lane; asm volatile("" : "+v"(ln1));
            const int rho = ln1 & 31, hf = ln1 >> 5;
            const int qq = 2 * ((rho >> 2) & 1) + (rho >> 4), hh = 4 * ((rho >> 3) & 1) + (rho & 3);
            bf16x8 qa[4][4], wa[4], wc[4];
#pragma unroll
            for (int qd = 0; qd < 4; ++qd) {
                const bf16_t* qrow = Pb + (size_t)(t0 + 4 * qd + qq) * PW + P_QI + hh * 64 + 8 * hf;
#pragma unroll
                for (int ks = 0; ks < 4; ++ks) qa[qd][ks] = *(const bf16x8*)(qrow + ks * 16);
                wa[qd] = *(const bf16x8*)(Pb + (size_t)(t0 + 4 * qd + 2 * hf) * PW + P_WI); wc[qd] = *(const bf16x8*)(Pb + (size_t)(t0 + 4 * qd + 2 * hf + 1) * PW + P_WI);
            }
            LAS float* sc0 = (LAS float*)lds + (2 * hf) * 2048 + rho;
            const bf16_t* kbase = Pb + (size_t)rho * PW + P_KI + 8 * hf;
            bf16x8 kb[4], kn[4];
#pragma unroll
            for (int ks = 0; ks < 4; ++ks) { kb[ks] = (bf16x8){0, 0, 0, 0, 0, 0, 0, 0}; kn[ks] = kb[ks]; }
            if (wid < nt) {
#pragma unroll
                for (int ks = 0; ks < 4; ++ks) kb[ks] = *(const bf16x8*)(kbase + (size_t)wid * 32 * PW + ks * 16);
            }
            for (int kt = wid; kt < nt; kt += 8) {
                if (kt + 8 < nt) {
#pragma unroll
                    for (int ks = 0; ks < 4; ++ks) kn[ks] = *(const bf16x8*)(kbase + (size_t)(kt + 8) * 32 * PW + ks * 16);
                }
#pragma unroll
                for (int qd = 0; qd < 4; ++qd) {
                    f32x16 acc;
#pragma unroll
                    for (int r = 0; r < 16; ++r) acc[r] = 0.f;
#pragma unroll
                    for (int ks = 0; ks < 4; ++ks) acc = __builtin_amdgcn_mfma_f32_32x32x16_bf16(qa[qd][ks], kb[ks], acc, 0, 0, 0);
#define RELU_I(x) __int_as_float(max(__float_as_int(x), 0))
                    f32x2 p0 = (f32x2){0.f, 0.f}, p1 = (f32x2){0.f, 0.f};
#pragma unroll
                    for (int e = 0; e < 8; e += 2) {
                        const f32x2 r0 = (f32x2){RELU_I(acc[e]), RELU_I(acc[e + 1])};
                        const f32x2 r1 = (f32x2){RELU_I(acc[8 + e]), RELU_I(acc[9 + e])};
                        p0 += r0 * (f32x2){bf2f((unsigned short)wa[qd][e]), bf2f((unsigned short)wa[qd][e + 1])};
                        p1 += r1 * (f32x2){bf2f((unsigned short)wc[qd][e]), bf2f((unsigned short)wc[qd][e + 1])};
                    }
#undef RELU_I
                    const float s0 = p0.x + p0.y, s1 = p1.x + p1.y;
                    sc0[(4 * qd) * 2048 + kt * 32] = s0 * (0.35355339059327373f * 0.125f); sc0[(4 * qd + 1) * 2048 + kt * 32] = s1 * (0.35355339059327373f * 0.125f);
                }
#pragma unroll
                for (int ks = 0; ks < 4; ++ks) kb[ks] = kn[ks];
            }
        }
        __syncthreads();
        if (tid == 0) { *qslot = nxt; nxt = (int)atomicAdd(qctr, 1u); }
        LAS unsigned char* pair = lds + wid * 16384;
        LAS unsigned char* wsc = lds + DSA_WS_OFF + wid * 2560;
        LAS unsigned* HIST = (LAS unsigned*)wsc; LAS float* CANDV = (LAS float*)(wsc + 1024); LAS unsigned* CANDI = (LAS unsigned*)(wsc + 1280);
        const int nsel = L < 256 ? L : 256;
        int lna = lane; asm volatile("" : "+v"(lna));
#pragma unroll 1
        for (int e2 = 0; e2 < 2; ++e2) {
            LAS unsigned short* IDX = (LAS unsigned short*)(wsc + 1536 + e2 * 512);
            if (nj > 4) {
                const LAS float* SCq = (const LAS float*)(pair + e2 * 8192);
                float x[32];
#pragma unroll
                for (int j = 0; j < 32; ++j) x[j] = (j < nj) ? SCq[j * 64 + lna] : 0.f;
                float lo = INFINITY, hi = -INFINITY;
#pragma unroll
                for (int j = 0; j < 32; ++j) if (j < nj) { hi = fmaxf(hi, x[j]); lo = fminf(lo, x[j]); }
                hi = wave_max_u(hi); lo = -wave_max_u(-lo);
                bool done = false;
                if (hi > lo) {
                    const float sc = 256.f / (hi - lo);
                    *(LAS u32x4*)(HIST + 4 * lna) = (u32x4){0u, 0u, 0u, 0u};
                    WAVE_LDS_SYNC();
#pragma unroll
                    for (int j = 0; j < 32; ++j) if (j < nj) { const unsigned bk = dsa_bucket(x[j], lo, sc); __hip_atomic_fetch_add(HIST + bk, 1u, __ATOMIC_RELAXED, __HIP_MEMORY_SCOPE_WORKGROUP); }
                    WAVE_LDS_SYNC();
                    const u32x4 h4 = *(const LAS u32x4*)(HIST + 4 * lna);
                    const unsigned cl = (h4.x + h4.y) + (h4.z + h4.w);
                    const unsigned pfx = wave_prefix_incl(cl);
                    const unsigned Sx = (unsigned)__builtin_amdgcn_readlane((int)pfx, 63) - pfx + cl;
                    const int lstar = __popcll(__ballot(Sx >= 256u)) - 1;
                    const unsigned above = Sx - cl, t3 = above + h4.w, t2 = t3 + h4.z, t1 = t2 + h4.y;
                    const unsigned bl = t3 >= 256u ? 3u : (t2 >= 256u ? 2u : (t1 >= 256u ? 1u : 0u));
                    const unsigned al = bl == 3u ? above : (bl == 2u ? t3 : (bl == 1u ? t2 : t1));
                    const unsigned ml = bl == 3u ? h4.w : (bl == 2u ? h4.z : (bl == 1u ? h4.y : h4.x));
                    const unsigned bstar = (unsigned)__builtin_amdgcn_readlane((int)(4u * lna + bl), lstar);
                    const int a = __builtin_amdgcn_readlane((int)al, lstar), m = __builtin_amdgcn_readlane((int)ml, lstar);
                    if (m <= 64) {
                        done = true;
                        const int need = 256 - a;
                        unsigned msel = 0u, mcand = 0u;
#pragma unroll
                        for (int j = 31; j >= 0; --j) if (j < nj) { const unsigned bk = dsa_bucket(x[j], lo, sc); msel = msel + msel + (bk > bstar ? 1u : 0u); mcand = mcand + mcand + (bk == bstar ? 1u : 0u); }
                        const unsigned pk = (unsigned)__popc(msel) | ((unsigned)__popc(mcand) << 16);
                        const unsigned inc = wave_prefix_incl(pk);
                        unsigned off = (inc - pk) & 0xffffu, coff = (inc - pk) >> 16;
                        while (msel) { const int j = __ffs((int)msel) - 1; msel &= msel - 1u; IDX[off++] = (unsigned short)(j * 64 + lna); }
                        while (mcand) { const int j = __ffs((int)mcand) - 1; mcand &= mcand - 1u; CANDV[coff] = SCq[j * 64 + lna]; CANDI[coff] = (unsigned)(j * 64 + lna); ++coff; }
                        WAVE_LDS_SYNC();
                        const float cv = CANDV[lna < m ? lna : 0]; const unsigned ci = CANDI[lna < m ? lna : 0];
                        int rank = 0;
                        for (int k = 0; k < m; ++k) { const float v = __uint_as_float((unsigned)__builtin_amdgcn_readlane((int)__float_as_uint(cv), k)); const unsigned id = (unsigned)__builtin_amdgcn_readlane((int)ci, k); rank += (v > cv || (v == cv && id < ci)) ? 1 : 0; }
                        if (lna < m && rank < need) IDX[a + rank] = (unsigned short)ci;
                    }
                }
                if (!done) {
                    unsigned lo_k = 0xffffffffu, hi_k = 0u;
#pragma unroll
                    for (int j = 0; j < 32; ++j) if (j < nj) { const unsigned kx = sort_key(x[j]); hi_k = kx > hi_k ? kx : hi_k; lo_k = kx < lo_k ? kx : lo_k; }
#pragma unroll
                    for (int o = 1; o < 64; o <<= 1) { const unsigned h2 = (unsigned)__shfl_xor((int)hi_k, o), l2 = (unsigned)__shfl_xor((int)lo_k, o); hi_k = h2 > hi_k ? h2 : hi_k; lo_k = l2 < lo_k ? l2 : lo_k; }
                    lo_k = (unsigned)__builtin_amdgcn_readfirstlane((int)lo_k); hi_k = (unsigned)__builtin_amdgcn_readfirstlane((int)hi_k);
                    bool exact = false;
                    while (lo_k < hi_k) {
                        const unsigned mid = lo_k + ((hi_k - lo_k + 1u) >> 1);
                        int cnt = 0;
#pragma unroll
                        for (int j = 0; j < 32; ++j) cnt += __popcll(__ballot(j < nj && sort_key(x[j]) >= mid));
                        if (cnt == 256) { lo_k = mid; exact = true; break; }
                        if (cnt > 256) lo_k = mid; else hi_k = mid - 1u;
                    }
                    const unsigned Tv = lo_k;
                    int need = 0;
                    if (!exact) { int cgt = 0;
#pragma unroll
                        for (int j = 0; j < 32; ++j) cgt += __popcll(__ballot(j < nj && sort_key(x[j]) > Tv));
                        need = 256 - cgt; }
                    int base = 0, eqt = 0;
#pragma unroll
                    for (int j = 0; j < 32; ++j) {
                        const unsigned kx = sort_key(x[j]);
                        const bool gt = (j < nj) && (exact ? (kx >= Tv) : (kx > Tv)), eq = (j < nj) && !exact && (kx == Tv);
                        const unsigned long long meq = __ballot(eq);
                        const bool sel = gt || (eq && (eqt + __popcll(meq & lt_mask)) < need);
                        const unsigned long long ms = __ballot(sel);
                        if (sel) IDX[base + __popcll(ms & lt_mask)] = (unsigned short)(j * 64 + lna);
                        base += __popcll(ms); eqt += __popcll(meq);
                    }
                }
            } else {
#pragma unroll
                for (int i = 0; i < 4; ++i) IDX[i * 64 + lna] = (unsigned short)(i * 64 + lna);
            }
        }
        WAVE_LDS_SYNC();
        {
            int lnb = lane; asm volatile("" : "+v"(lnb));
            const int head = lnb & 15, kg = lnb >> 4, nblk = nsel >> 5;
            LAS unsigned char* GB = pair;
            const bf16_t* CNb = CN + (size_t)b * SEQ * 128;
            const int rho = lnb & 15;
            const unsigned rw0 = 8 * (rho >> 2) + (rho & 3), rw1 = rw0 + 4;
            const unsigned xa0 = ((rw0 & 3) << 2) | ((rw0 >> 2) & 3), xa1 = ((rw1 & 3) << 2) | ((rw1 >> 2) & 3);
            const unsigned q4 = (lnb & 15) >> 2, p4 = lnb & 3;
            u32x4 gA[8], gB[8];
#define DSA_GATHER(G, IX, blk) do { _Pragma("unroll") for (int it = 0; it < 8; ++it) { const int sp = (IX)[(blk) * 32 + (lnb >> 4) + 4 * it]; G[it] = *(const u32x4*)(CNb + (size_t)sp * 128 + (lnb & 15) * 8); } } while (0)
            { const LAS unsigned short* IDX0 = (const LAS unsigned short*)(wsc + 1536); DSA_GATHER(gA, IDX0, 0); DSA_GATHER(gB, IDX0, 1); }
#pragma unroll 1
            for (int e2 = 0; e2 < 2; ++e2) {
                const int t = t0 + 2 * wid + e2;
                const size_t row = (size_t)b * SEQ + t;
                const LAS unsigned short* IDX = (const LAS unsigned short*)(wsc + 1536 + e2 * 512);
                bf16x8 qlf[4];
#pragma unroll
                for (int s4 = 0; s4 < 4; ++s4) { qlf[s4] = *(const bf16x8*)(P + row * PW + P_QL + (head & 7) * 128 + s4 * 32 + 8 * kg); if (head >= 8) qlf[s4] = (bf16x8){0, 0, 0, 0, 0, 0, 0, 0}; }
                f32x4 o[8];
#pragma unroll
                for (int ct = 0; ct < 8; ++ct) o[ct] = (f32x4){0.f, 0.f, 0.f, 0.f};
                float m = -INFINITY, lsum = 0.f;
#define DSA_STEP(G, kbx) do { \
                    WAVE_LDS_SYNC();                              \
                    _Pragma("unroll") for (int it = 0; it < 8; ++it) *(LAS u32x4*)(GB + off_b((lnb >> 4) + 4 * it, lnb & 15)) = G[it]; \
                    const bf16x8 iv = *(const LAS bf16x8*)((const LAS unsigned char*)IDX + ((kbx) * 32 + 8 * kg) * 2);     \
                    if ((kbx) + 2 < nblk) DSA_GATHER(G, IDX, (kbx) + 2); else if (e2 == 0) DSA_GATHER(G, IDX + 256, (kbx) + 2 - nblk); \
                    WAVE_LDS_SYNC(); \
                      \
                    bf16x8 k0[4], k1[4], af[8]; \
                    _Pragma("unroll") for (int s4 = 0; s4 < 4; ++s4) { \
                        k0[s4] = *(const LAS bf16x8*)(GB + 256u * rw0 + 16u * ((4 * s4 + kg) ^ xa0)); \
                        k1[s4] = *(const LAS bf16x8*)(GB + 256u * rw1 + 16u * ((4 * s4 + kg) ^ xa1)); } \
                    float bia[8]; \
                    _Pragma("unroll") for (int e = 0; e < 8; ++e) { const int sp = (int)(unsigned short)iv[e]; int rel = sp - t; rel = rel < -127 ? -127 : rel; bia[e] = BT[(rel + 127) * 8 + (head & 7)]; } \
                      \
                    f32x4 a0 = (f32x4){0.f, 0.f, 0.f, 0.f}, a1 = (f32x4){0.f, 0.f, 0.f, 0.f}; \
                    _Pragma("unroll") for (int s4 = 0; s4 < 4; ++s4) { \
                        a0 = __builtin_amdgcn_mfma_f32_16x16x32_bf16(k0[s4], qlf[s4], a0, 0, 0, 0); \
                        a1 = __builtin_amdgcn_mfma_f32_16x16x32_bf16(k1[s4], qlf[s4], a1, 0, 0, 0); } \
                    asm volatile("" : "+v"(a0), "+v"(a1));        \
                    _Pragma("unroll") for (int ct = 0; ct < 8; ++ct) {              \
                        const v4i16_t lo4 = __builtin_amdgcn_ds_read_tr16_b64_v4i16((LAS v4i16_t*)(GB + off_b(8 * kg + q4, 2 * ct + (p4 >> 1)) + 8 * (p4 & 1))); \
                        const v4i16_t hi4 = __builtin_amdgcn_ds_read_tr16_b64_v4i16((LAS v4i16_t*)(GB + off_b(8 * kg + 4 + q4, 2 * ct + (p4 >> 1)) + 8 * (p4 & 1))); \
                        af[ct] = (bf16x8){lo4[0], lo4[1], lo4[2], lo4[3], hi4[0], hi4[1], hi4[2], hi4[3]}; } \
                      \
                    float lg[8]; \
                    _Pragma("unroll") for (int e = 0; e < 8; ++e) lg[e] = (e < 4 ? a0[e] : a1[e - 4]) * 0.125f + bia[e]; \
                    const float mloc = fmaxf(fmaxf(fmaxf(lg[0], lg[1]), fmaxf(lg[2], lg[3])), fmaxf(fmaxf(lg[4], lg[5]), fmaxf(lg[6], lg[7]))); \
                      \
                    float scl = 1.f; \
                    if (__any(mloc > m + 16.f)) { \
                        float mb = fmaxf(mloc, __shfl_xor(mloc, 16)); mb = fmaxf(mb, __shfl_xor(mb, 32)); \
                        const float mn = fmaxf(m, mb); scl = __expf(m - mn); m = mn; \
                        _Pragma("unroll") for (int ct = 0; ct < 8; ++ct) o[ct] = o[ct] * scl; } \
                    float ps = 0.f; float pe[8]; \
                    _Pragma("unroll") for (int e = 0; e < 8; ++e) { pe[e] = __expf(lg[e] - m); ps += pe[e]; } \
                    lsum = lsum * scl + ps; \
                    u32x4 pw; pw.x = pk2(pe[0], pe[1]); pw.y = pk2(pe[2], pe[3]); pw.z = pk2(pe[4], pe[5]); pw.w = pk2(pe[6], pe[7]); \
                    const bf16x8 pb = __builtin_bit_cast(bf16x8, pw); \
                    _Pragma("unroll") for (int ct = 0; ct < 8; ++ct) o[ct] = __builtin_amdgcn_mfma_f32_16x16x32_bf16(af[ct], pb, o[ct], 0, 0, 0); \
                } while (0)
#pragma unroll 1
                for (int kb2 = 0; kb2 < nblk; kb2 += 2) { DSA_STEP(gA, kb2); DSA_STEP(gB, kb2 + 1); }
#undef DSA_STEP
                lsum += __shfl_xor(lsum, 16); lsum += __shfl_xor(lsum, 32);
                const float inv = 1.f / lsum;
                if (head < 8) {
                    bf16_t* op = CAT + row * KOUT + head * 128 + 4 * kg;
#pragma unroll
                    for (int ct = 0; ct < 8; ++ct) { u32x2 w; w.x = pk2(o[ct][0] * inv, o[ct][1] * inv); w.y = pk2(o[ct][2] * inv, o[ct][3] * inv); *(u32x2*)(op + ct * 16) = w; }
                }
            }
#undef DSA_GATHER
        }
    }
}

constexpr size_t WS_DEC = 492 * MiB;
__device__ __forceinline__ void hgrn_prep(bf16_t* P, const float* lb, float* DEC, LAS unsigned char* lds, int vb, int nvb) {
    const int tid = otid(), cl = tid >> 7, d = tid & 127;
    LAS bf16_t* Ft = (LAS bf16_t*)lds; LAS bf16_t* Qt = (LAS bf16_t*)(lds + 65536);
    for (int it = vb; it < BATCH * 4 * 8; it += nvb) {
        const int b = it >> 5, h = (it >> 3) & 3, cg = it & 7;
        bf16_t* base = P + ((size_t)b * SEQ + cg * 256) * PW + h * 128;
        u32x4 v[16];
#pragma unroll
        for (int k = 0; k < 16; ++k) { const int i = tid + 512 * k, tl = i >> 12, r = (i >> 4) & 255, ch = i & 15; v[k] = *(const u32x4*)(base + (size_t)r * PW + (tl ? P_QB : P_FB) + ch * 8); }
        __syncthreads();
#pragma unroll
        for (int k = 0; k < 16; ++k) { const int i = tid + 512 * k, tl = i >> 12, r = (i >> 4) & 255, ch = i & 15; *(LAS u32x4*)(lds + tl * 65536 + r * 256 + ch * 16) = v[k]; }
        __syncthreads();
        {
            const float l = lb[h * 128 + d];
            LAS bf16_t* fcol = Ft + (cl * 64) * 128 + d; LAS bf16_t* qcol = Qt + (cl * 64) * 128 + d;
            float up = 1.f;
#pragma unroll 8
            for (int t = 32; t < 64; ++t) {
                const float f = l + (1.f - l) * sigmoid_f(bf2f(fcol[t * 128]));
                up *= f;
                const float q = silu_f(bf2f(qcol[t * 128]));
                qcol[t * 128] = (bf16_t)f2bf(q * up);
                fcol[t * 128] = (bf16_t)f2bf((1.f - f) * __builtin_amdgcn_rcpf(up));
            }
            float dn = 1.f;
#pragma unroll 8
            for (int t = 31; t >= 0; --t) {
                const float f = l + (1.f - l) * sigmoid_f(bf2f(fcol[t * 128]));
                const float q = silu_f(bf2f(qcol[t * 128]));
                qcol[t * 128] = (bf16_t)f2bf(q * __builtin_amdgcn_rcpf(dn));
                fcol[t * 128] = (bf16_t)f2bf((1.f - f) * dn);
                dn *= f;
            }
            float* dc = DEC + ((size_t)((b * 4 + h) * 32 + cg * 4 + cl) * 3) * 128 + d;
            dc[0] = dn; dc[128] = dn * up; dc[256] = up;
        }
        __syncthreads();
#pragma unroll
        for (int k = 0; k < 16; ++k) { const int i = tid + 512 * k, tl = i >> 12, r = (i >> 4) & 255, ch = i & 15; *(u32x4*)(base + (size_t)r * PW + (tl ? P_QB : P_FB) + ch * 8) = *(const LAS u32x4*)(lds + tl * 65536 + r * 256 + ch * 16); }
    }
}

__device__ __forceinline__ void hgrn_scan(const bf16_t* P, const float* DEC, const float* o_g, bf16_t* CAT, LAS unsigned char* lds, int item) {
    const int tid = otid(), lane = tid & 63, wid = __builtin_amdgcn_readfirstlane(tid >> 6), li = lane & 15, kg = lane >> 4;
    const int b = item >> 2, h = item & 3, it = wid >> 1, vh = wid & 1;
    LAS unsigned char* ST = lds + 98304;
    LAS float* SSQ = (LAS float*)(lds + DSA_BT_OFF);
    const bf16_t* Pb = P + (size_t)b * SEQ * PW;
    const float* DECb = DEC + (size_t)((b * 4 + h) * 32) * 384;
    f32x4 S[8];
#pragma unroll
    for (int vt = 0; vt < 8; ++vt) S[vt] = (f32x4){0.f, 0.f, 0.f, 0.f};
    u32x4 sg[6];
    const int colbase[3] = {P_QB, P_FB, P_IB};
#define HG_LOAD(c) do { _Pragma("unroll") for (int k = 0; k < 6; ++k) { const int n = tid + 512 * k, tl = n >> 10, r = (n >> 4) & 63, ch = n & 15; \
        sg[k] = *(const u32x4*)(Pb + (size_t)((c) * 64 + r) * PW + colbase[tl] + h * 128 + ch * 8); } } while (0)
#define HG_STORE(buf) do { _Pragma("unroll") for (int k = 0; k < 6; ++k) { const int n = tid + 512 * k, tl = n >> 10, r = (n >> 4) & 63, ch = n & 15; \
        *(LAS u32x4*)(lds + (buf) * 49152 + tl * 16384 + off_b(r, ch)) = sg[k]; } } while (0)
    HG_LOAD(0);
    __syncthreads();
    HG_STORE(0);
    const unsigned q4 = (lane & 15) >> 2, p4 = lane & 3;
    f32x4 ogv[4];
#pragma unroll
    for (int vv = 0; vv < 4; ++vv) ogv[vv] = *(const f32x4*)(o_g + 16 * (4 * vh + vv) + 4 * kg);
    float er_next = DECb[16 * wid + li];
#pragma unroll 1
    for (int c = 0; c < 32; ++c) {
        const int buf = c & 1;
        LAS unsigned char* QI = lds + buf * 49152; LAS unsigned char* KI = QI + 16384; LAS unsigned char* VI = QI + 32768;
        if (c + 1 < 32) HG_LOAD(c + 1);
        const float er = er_next, e63 = DECb[c * 384 + 128 + 16 * wid + li], e6r = DECb[c * 384 + 256 + 16 * wid + li];
        er_next = DECb[(c + 1 < 32 ? c + 1 : c) * 384 + 16 * wid + li];
        u32x2 gwv[4];
#pragma unroll
        for (int vv = 0; vv < 4; ++vv) gwv[vv] = *(const u32x2*)(P + ((size_t)b * SEQ + c * 64 + 16 * it + li) * PW + P_GB + h * 128 + 16 * (4 * vh + vv) + 4 * kg);
        { const unsigned d = 16 * wid + li;
#pragma unroll
          for (int vt = 0; vt < 8; ++vt) { u32x2 w; w.x = pk2(S[vt][0] * er, S[vt][1] * er); w.y = pk2(S[vt][2] * er, S[vt][3] * er);
              *(LAS u32x2*)(ST + off_b(d, 2 * vt + (kg >> 1)) + 8 * (kg & 1)) = w; } }
        __syncthreads();
        bf16x8 qf[4];
#pragma unroll
        for (int ks = 0; ks < 4; ++ks) qf[ks] = *(const LAS bf16x8*)(QI + off_b(16 * it + li, 4 * ks + kg));
        f32x4 o[4];
#pragma unroll
        for (int vv = 0; vv < 4; ++vv) o[vv] = (f32x4){0.f, 0.f, 0.f, 0.f};
#pragma unroll
        for (int ks = 0; ks < 4; ++ks)
#pragma unroll
            for (int vv = 0; vv < 4; ++vv) {
                const int ct = 4 * vh + vv;
                const v4i16_t lo4 = __builtin_amdgcn_ds_read_tr16_b64_v4i16((LAS v4i16_t*)(ST + off_b(32 * ks + 8 * kg + q4, 2 * ct + (p4 >> 1)) + 8 * (p4 & 1)));
                const v4i16_t hi4 = __builtin_amdgcn_ds_read_tr16_b64_v4i16((LAS v4i16_t*)(ST + off_b(32 * ks + 8 * kg + 4 + q4, 2 * ct + (p4 >> 1)) + 8 * (p4 & 1)));
                const bf16x8 af = (bf16x8){lo4[0], lo4[1], lo4[2], lo4[3], hi4[0], hi4[1], hi4[2], hi4[3]};
                o[vv] = __builtin_amdgcn_mfma_f32_16x16x32_bf16(af, qf[ks], o[vv], 0, 0, 0);
            }
        const int njb = (it >> 1) + 1;
#pragma unroll
        for (int jb = 0; jb < 2; ++jb) {
            if (jb < njb) {
                f32x4 a0 = (f32x4){0.f, 0.f, 0.f, 0.f}, a1 = (f32x4){0.f, 0.f, 0.f, 0.f};
                const unsigned rw0 = 32 * jb + 8 * (li >> 2) + (li & 3), rw1 = rw0 + 4;
#pragma unroll
                for (int ks = 0; ks < 4; ++ks) {
                    const bf16x8 k0 = *(const LAS bf16x8*)(KI + off_b(rw0, 4 * ks + kg));
                    const bf16x8 k1 = *(const LAS bf16x8*)(KI + off_b(rw1, 4 * ks + kg));
                    a0 = __builtin_amdgcn_mfma_f32_16x16x32_bf16(k0, qf[ks], a0, 0, 0, 0);
                    a1 = __builtin_amdgcn_mfma_f32_16x16x32_bf16(k1, qf[ks], a1, 0, 0, 0);
                }
                const int ii = 16 * it + li, j0 = 32 * jb + 8 * kg;
                float am[8];
#pragma unroll
                for (int e = 0; e < 8; ++e) am[e] = (j0 + e <= ii) ? (e < 4 ? a0[e] : a1[e - 4]) : 0.f;
                u32x4 pw; pw.x = pk2(am[0], am[1]); pw.y = pk2(am[2], am[3]); pw.z = pk2(am[4], am[5]); pw.w = pk2(am[6], am[7]);
                const bf16x8 pb = __builtin_bit_cast(bf16x8, pw);
#pragma unroll
                for (int vv = 0; vv < 4; ++vv) {
                    const int ct = 4 * vh + vv;
                    const v4i16_t lo4 = __builtin_amdgcn_ds_read_tr16_b64_v4i16((LAS v4i16_t*)(VI + off_b(32 * jb + 8 * kg + q4, 2 * ct + (p4 >> 1)) + 8 * (p4 & 1)));
                    const v4i16_t hi4 = __builtin_amdgcn_ds_read_tr16_b64_v4i16((LAS v4i16_t*)(VI + off_b(32 * jb + 8 * kg + 4 + q4, 2 * ct + (p4 >> 1)) + 8 * (p4 & 1)));
                    const bf16x8 af = (bf16x8){lo4[0], lo4[1], lo4[2], lo4[3], hi4[0], hi4[1], hi4[2], hi4[3]};
                    o[vv] = __builtin_amdgcn_mfma_f32_16x16x32_bf16(af, pb, o[vv], 0, 0, 0);
                }
            }
        }
        {
            f32x4 U[8];
#pragma unroll
            for (int vt = 0; vt < 8; ++vt) U[vt] = (f32x4){0.f, 0.f, 0.f, 0.f};
#pragma unroll
            for (int ks = 0; ks < 2; ++ks) {
                const v4i16_t kl = __builtin_amdgcn_ds_read_tr16_b64_v4i16((LAS v4i16_t*)(KI + off_b(32 * ks + 8 * kg + q4, 2 * wid + (p4 >> 1)) + 8 * (p4 & 1)));
                const v4i16_t kh = __builtin_amdgcn_ds_read_tr16_b64_v4i16((LAS v4i16_t*)(KI + off_b(32 * ks + 8 * kg + 4 + q4, 2 * wid + (p4 >> 1)) + 8 * (p4 & 1)));
                const bf16x8 kfr = (bf16x8){kl[0], kl[1], kl[2], kl[3], kh[0], kh[1], kh[2], kh[3]};
#pragma unroll
                for (int vt = 0; vt < 8; ++vt) {
                    const v4i16_t lo4 = __builtin_amdgcn_ds_read_tr16_b64_v4i16((LAS v4i16_t*)(VI + off_b(32 * ks + 8 * kg + q4, 2 * vt + (p4 >> 1)) + 8 * (p4 & 1)));
                    const v4i16_t hi4 = __builtin_amdgcn_ds_read_tr16_b64_v4i16((LAS v4i16_t*)(VI + off_b(32 * ks + 8 * kg + 4 + q4, 2 * vt + (p4 >> 1)) + 8 * (p4 & 1)));
                    const bf16x8 af = (bf16x8){lo4[0], lo4[1], lo4[2], lo4[3], hi4[0], hi4[1], hi4[2], hi4[3]};
                    U[vt] = __builtin_amdgcn_mfma_f32_16x16x32_bf16(af, kfr, U[vt], 0, 0, 0);
                }
            }
#pragma unroll
            for (int vt = 0; vt < 8; ++vt) S[vt] = S[vt] * e63 + U[vt] * e6r;
        }
        float ss = 0.f;
#pragma unroll
        for (int vv = 0; vv < 4; ++vv) ss += (o[vv][0] * o[vv][0] + o[vv][1] * o[vv][1]) + (o[vv][2] * o[vv][2] + o[vv][3] * o[vv][3]);
        ss += __shfl_xor(ss, 16); ss += __shfl_xor(ss, 32);
        if (kg == 0) SSQ[(it * 2 + vh) * 16 + li] = ss;
        __syncthreads();
        if (c + 1 < 32) HG_STORE(buf ^ 1);
        {
            const float tot = SSQ[(it * 2) * 16 + li] + SSQ[(it * 2 + 1) * 16 + li];
            const float rs = rsqrtf(tot * (1.f / 128.f) + EPS);
            const size_t row = (size_t)b * SEQ + c * 64 + 16 * it + li;
#pragma unroll
            for (int vv = 0; vv < 4; ++vv) {
                const int v0 = 16 * (4 * vh + vv) + 4 * kg;
                const u32x2 gw = gwv[vv];
                const f32x4 og = ogv[vv];
                const float g0 = silu_f(bf2f((unsigned short)(gw.x & 0xffffu))), g1 = silu_f(bf2f((unsigned short)(gw.x >> 16))), g2 = silu_f(bf2f((unsigned short)(gw.y & 0xffffu))), g3 = silu_f(bf2f((unsigned short)(gw.y >> 16)));
                u32x2 w; w.x = pk2(o[vv][0] * rs * og.x * g0, o[vv][1] * rs * og.y * g1); w.y = pk2(o[vv][2] * rs * og.z * g2, o[vv][3] * rs * og.w * g3);
                *(u32x2*)(CAT + row * KOUT + 1024 + h * 128 + v0) = w;
            }
        }
    }
#undef HG_LOAD
#undef HG_STORE
}


__device__ __forceinline__ int swap23(int r) { return (r & ~12) | ((r & 4) << 1) | ((r & 8) >> 1); }
__device__ __forceinline__ void xattn_mfma_phase(const bf16_t* Q, const bf16_t* Kb, const bf16_t* VT, bf16_t* O, LAS unsigned char* lds, int vb, int nvb) {
    const int tid = otid(), lane = tid & 63, wid = __builtin_amdgcn_readfirstlane(tid >> 6), r32 = lane & 31, hf = lane >> 5;
    LAS unsigned char* Ks = lds; LAS unsigned char* Vs = lds + 65536;
    int koff[8], voff[8];
    { const int kr = swap23(r32), x = kr & 15, y = r32 & 15;
#pragma unroll
      for (int ks = 0; ks < 8; ++ks) koff[ks] = kr * 256 + (((ks * 2 + hf) ^ x) << 4);
#pragma unroll
      for (int e = 0; e < 8; ++e) voff[e] = r32 * 512 + (((e * 2 + hf) ^ y) << 4); }
    for (int pair = vb; pair < 256; pair += nvb) {
        const int bh = pair >> 2, b = bh >> 2, h = bh & 3;
        __syncthreads();
        int tio = tid; asm volatile("" : "+v"(tio));
        for (int i = tio; i < 4096; i += NTHREADS) { const int key = i >> 4, ch = i & 15;
            const u32x4 v = *(const u32x4*)(Kb + (size_t)(b * MEMT + key) * 512 + h * 128 + ch * 8);
            *(LAS u32x4*)(Ks + key * 256 + ((ch ^ (key & 15)) << 4)) = v; }
        for (int i = tio; i < 4096; i += NTHREADS) { const int d = i >> 5, ch = i & 31;
            const u32x4 v = *(const u32x4*)(VT + (size_t)(h * 128 + d) * MT + b * MEMT + ch * 8);
            *(LAS u32x4*)(Vs + d * 512 + ((ch ^ (d & 15)) << 4)) = v; }
        __syncthreads();
#pragma unroll 1
        for (int qq = 0; qq < 2; ++qq) {
            const size_t q0 = (size_t)b * SEQ + ((pair & 3) * 2 + qq) * 256 + wid * 32;
            bf16x8 qf[8];
#pragma unroll
            for (int ks = 0; ks < 8; ++ks) qf[ks] = *(const bf16x8*)(Q + (q0 + r32) * 512 + h * 128 + ks * 16 + 8 * hf);
            f32x16 st[8];
            __builtin_amdgcn_s_setprio(1);
#pragma unroll
            for (int kt = 0; kt < 8; ++kt) {
#pragma unroll
                for (int r = 0; r < 16; ++r) st[kt][r] = 0.f;
#pragma unroll
                for (int ks = 0; ks < 8; ++ks) {
                    const bf16x8 a = *(const LAS bf16x8*)(Ks + koff[ks] + kt * 8192);
                    st[kt] = __builtin_amdgcn_mfma_f32_32x32x16_bf16(a, qf[ks], st[kt], 0, 0, 0);
                }
            }
            __builtin_amdgcn_s_setprio(0);
            float mx = -INFINITY;
#pragma unroll
            for (int kt = 0; kt < 8; ++kt)
#pragma unroll
                for (int r = 0; r < 16; ++r) mx = fmaxf(mx, st[kt][r]);
            mx = fmaxf(mx, __shfl_xor(mx, 32));
            const float c = 0.08838834764831845f * 1.4426950408889634f;
            float sum = 0.f;
#pragma unroll
            for (int kt = 0; kt < 8; ++kt)
#pragma unroll
                for (int r = 0; r < 16; ++r) { const float e = __builtin_amdgcn_exp2f((st[kt][r] - mx) * c); st[kt][r] = e; sum += e; }
            sum += __shfl_xor(sum, 32);
            const float inv = 1.f / sum;
            bf16x8 pfr[8][2];
#pragma unroll
            for (int kt = 0; kt < 8; ++kt)
#pragma unroll
                for (int s2 = 0; s2 < 2; ++s2) {
                    u32x4 pw;
                    pw.x = pk2(st[kt][8 * s2 + 0], st[kt][8 * s2 + 1]); pw.y = pk2(st[kt][8 * s2 + 2], st[kt][8 * s2 + 3]);
                    pw.z = pk2(st[kt][8 * s2 + 4], st[kt][8 * s2 + 5]); pw.w = pk2(st[kt][8 * s2 + 6], st[kt][8 * s2 + 7]);
                    pfr[kt][s2] = __builtin_bit_cast(bf16x8, pw);
                }
#pragma unroll
            for (int kt = 0; kt < 8; ++kt) asm volatile("" : "+v"(pfr[kt][0]), "+v"(pfr[kt][1]));
            f32x16 o[4];
#pragma unroll
            for (int dt = 0; dt < 4; ++dt)
#pragma unroll
                for (int r = 0; r < 16; ++r) o[dt][r] = 0.f;
            __builtin_amdgcn_s_setprio(1);
#pragma unroll
            for (int kt = 0; kt < 8; ++kt)
#pragma unroll
                for (int s2 = 0; s2 < 2; ++s2)
#pragma unroll
                    for (int dt = 0; dt < 4; ++dt) {
                        const bf16x8 a = *(const LAS bf16x8*)(Vs + voff[(kt & 3) * 2 + s2] + dt * 16384 + (kt >> 2) * 256);
                        o[dt] = __builtin_amdgcn_mfma_f32_32x32x16_bf16(a, pfr[kt][s2], o[dt], 0, 0, 0);
                    }
            __builtin_amdgcn_s_setprio(0);
            unsigned char* orow = (unsigned char*)O + (q0 + r32) * 512 + h * 128 + 64 * hf;
            const float isc = inv * XO_SC;
#pragma unroll
            for (int dt = 0; dt < 4; ++dt) {
                u32x4 w;
#pragma unroll
                for (int g = 0; g < 4; ++g) w[g] = pk4_f8(o[dt][4 * g] * isc, o[dt][4 * g + 1] * isc, o[dt][4 * g + 2] * isc, o[dt][4 * g + 3] * isc);
                *(u32x4*)(orow + dt * 16) = w;
            }
        }
    }
}


__device__ __forceinline__ void gmlp_mfma_phase(const bf16_t* UV, const float* lnp, const float* ln_g, const float* ln_b, const float* w_sp, const float* b_sp, bf16_t* G, LAS unsigned char* lds, int vb, int nvb) {
    const int tid = otid(), lane = tid & 63, wid = __builtin_amdgcn_readfirstlane(tid >> 6), fr = lane & 15, fq = lane >> 4;
    LAS unsigned char* Wb = lds; LAS unsigned char* VTs = lds + 32768; LAS float* STAT = (LAS float*)(lds + 65536);
    int gcur = -1;
    for (int grp = vb; grp < 256; grp += nvb) {
        const int g = grp >> 5;
        bf16x8 vch[4]; f32x4 lp[2];
#define GM_LOAD(uu_) do { const size_t r0_ = (size_t)((grp & 31) * 8 + (uu_)) * 128; \
            _Pragma("unroll") for (int k = 0; k < 4; ++k) { const int i = tid + 512 * k, sI = i >> 4, ch = i & 15; vch[k] = *(const bf16x8*)(UV + (r0_ + sI) * 2048 + 1024 + g * 128 + ch * 8); } \
            lp[0] = *(const f32x4*)(lnp + (r0_ + (tid >> 2)) * 32 + (tid & 3) * 8); lp[1] = *(const f32x4*)(lnp + (r0_ + (tid >> 2)) * 32 + (tid & 3) * 8 + 4); } while (0)
        GM_LOAD(0);
        const f32x4 g0 = *(const f32x4*)(ln_g + g * 128 + (tid & 15) * 8), g1 = *(const f32x4*)(ln_g + g * 128 + (tid & 15) * 8 + 4);
        const f32x4 b0 = *(const f32x4*)(ln_b + g * 128 + (tid & 15) * 8), b1 = *(const f32x4*)(ln_b + g * 128 + (tid & 15) * 8 + 4);
        const float gg[8] = {g0.x, g0.y, g0.z, g0.w, g1.x, g1.y, g1.z, g1.w}, bb[8] = {b0.x, b0.y, b0.z, b0.w, b1.x, b1.y, b1.z, b1.w};
        __syncthreads();
        if (g != gcur) {
            gcur = g;
            for (int i = tid; i < 2048; i += NTHREADS) { const int t = i >> 4, ch = i & 15;
                const f32x4 a = *(const f32x4*)(w_sp + (size_t)g * 16384 + t * 128 + ch * 8), b = *(const f32x4*)(w_sp + (size_t)g * 16384 + t * 128 + ch * 8 + 4);
                const int s0 = ch * 8;
                u32x4 w; w.x = pk2(s0 + 0 <= t ? a.x : 0.f, s0 + 1 <= t ? a.y : 0.f); w.y = pk2(s0 + 2 <= t ? a.z : 0.f, s0 + 3 <= t ? a.w : 0.f);
                w.z = pk2(s0 + 4 <= t ? b.x : 0.f, s0 + 5 <= t ? b.y : 0.f); w.w = pk2(s0 + 6 <= t ? b.z : 0.f, s0 + 7 <= t ? b.w : 0.f);
                *(LAS u32x4*)(Wb + t * 256 + ((ch ^ (t & 15)) << 4)) = w; }
        }
        const int trow = wid * 16 + fr;
        const float bias = b_sp[g * 128 + trow];
#pragma unroll 1
        for (int uu = 0; uu < 8; ++uu) {
            const int bn = (grp & 31) * 8 + uu;
            const size_t row0 = (size_t)bn * 128;
            if (uu) __syncthreads();
            { float s1 = (lp[0].x + lp[0].z) + (lp[1].x + lp[1].z), s2 = (lp[0].y + lp[0].w) + (lp[1].y + lp[1].w);
              s1 += __shfl_xor(s1, 1); s2 += __shfl_xor(s2, 1); s1 += __shfl_xor(s1, 2); s2 += __shfl_xor(s2, 2);
              const float mu = s1 * (1.f / 1024.f), var = fmaxf(s2 * (1.f / 1024.f) - mu * mu, 0.f);
              if ((tid & 3) == 0) { STAT[2 * (tid >> 2)] = mu; STAT[2 * (tid >> 2) + 1] = rsqrtf(var + EPS); } }
            __syncthreads();
#pragma unroll
            for (int k = 0; k < 4; ++k) { const int i = tid + 512 * k, sI = i >> 4, ch = i & 15;
                const float mu = STAT[2 * sI], rs = STAT[2 * sI + 1];
#pragma unroll
                for (int e = 0; e < 8; ++e) { const int c = ch * 8 + e; const float x = (bf2f((unsigned short)vch[k][e]) - mu) * rs * gg[e] + bb[e];
                    *(LAS bf16_t*)(VTs + c * 256 + (((sI >> 3) ^ ((c ^ (c >> 3)) & 15)) << 4) + (sI & 7) * 2) = (bf16_t)f2bf(x); } }
            if (uu + 1 < 8) GM_LOAD(uu + 1);
            const size_t orow = row0 + trow;
            u32x2 uwv[8];
#pragma unroll
            for (int ct = 0; ct < 8; ++ct) uwv[ct] = *(const u32x2*)(UV + orow * 2048 + g * 128 + ct * 16 + 4 * fq);
            __syncthreads();
            f32x4 acc[8];
#pragma unroll
            for (int ct = 0; ct < 8; ++ct) acc[ct] = (f32x4){0.f, 0.f, 0.f, 0.f};
#pragma unroll
            for (int ks = 0; ks < 4; ++ks) {
                const bf16x8 wf = *(const LAS bf16x8*)(Wb + trow * 256 + (((ks * 4 + fq) ^ (trow & 15)) << 4));
#pragma unroll
                for (int ct = 0; ct < 8; ++ct) {
                    const int crow = ct * 16 + fr;
                    const bf16x8 vf = *(const LAS bf16x8*)(VTs + crow * 256 + (((ks * 4 + fq) ^ ((crow ^ (crow >> 3)) & 15)) << 4));
                    acc[ct] = __builtin_amdgcn_mfma_f32_16x16x32_bf16(vf, wf, acc[ct], 0, 0, 0);
                }
            }
#pragma unroll
            for (int ct = 0; ct < 8; ++ct) {
                const int c = ct * 16 + 4 * fq;
                const u32x2 uw = uwv[ct];
                const float u0 = bf2f((unsigned short)(uw.x & 0xffffu)), u1 = bf2f((unsigned short)(uw.x >> 16)), u2 = bf2f((unsigned short)(uw.y & 0xffffu)), u3 = bf2f((unsigned short)(uw.y >> 16));
                u32x2 w; w.x = pk2(u0 * (acc[ct][0] + bias), u1 * (acc[ct][1] + bias)); w.y = pk2(u2 * (acc[ct][2] + bias), u3 * (acc[ct][3] + bias));
                *(u32x2*)(G + orow * 1024 + g * 128 + c) = w;
            }
        }
#undef GM_LOAD
    }
}

#define GAS __attribute__((address_space(1)))
typedef GAS unsigned gu32;
#define XB_TMO      128
#define XB_XCNT(j)  (256  + 64 * (j))
#define XB_XSUB(j)  (1280 + 64 * (j))
#define XB_XGEN(j)  (2304 + 64 * (j))
#define XB_TOP      3328
#define XB_TOPGEN   3392
#define XCD_BAR_WORDS 3456
#define XB_SPIN_CAP (1u << 18)

__device__ __forceinline__ unsigned xb_ld(unsigned* p)              { return __hip_atomic_load(p, __ATOMIC_RELAXED, __HIP_MEMORY_SCOPE_AGENT); }
__device__ __forceinline__ unsigned xb_add(unsigned* p, unsigned v) { return __hip_atomic_fetch_add(p, v, __ATOMIC_RELAXED, __HIP_MEMORY_SCOPE_AGENT); }
__device__ __forceinline__ unsigned xb_xcc_id() { return (unsigned)__builtin_amdgcn_s_getreg((3 << 11) | 20) & 0xFu; }
#define XB_SPIN(cond, bar) do { unsigned _sp = 0; while (cond) { __builtin_amdgcn_s_sleep(1); \
    if ((++_sp & 255u) == 0u) { if (xb_ld(&(bar)[XB_TMO])) break; if (_sp > XB_SPIN_CAP) { atomicAdd(&(bar)[XB_TMO], 1u); break; } } } } while (0)

struct XcdBarrier {
    unsigned* bar; unsigned x;
    volatile LAS unsigned* st;
};

__device__ __forceinline__ XcdBarrier xcd_barrier_post(unsigned* bar, volatile LAS unsigned* st) {
    XcdBarrier b; b.bar = bar; b.x = xb_xcc_id(); b.st = st;
    if (threadIdx.x == 0) (void)xb_add(&bar[XB_XCNT(b.x)], 1u);
    return b;
}
__device__ __forceinline__ void xcd_barrier_complete(unsigned* bar, unsigned x, unsigned& nloc, unsigned& nx) {
    const unsigned G = gridDim.x * gridDim.y * gridDim.z;
    unsigned sum, cnt, mine, sp = 0u;
    for (;;) {
        sum = 0u; cnt = 0u; mine = 0u;
#pragma unroll
        for (unsigned j = 0; j < 16; ++j) { const unsigned c = xb_ld(&bar[XB_XCNT(j)]); sum += c; cnt += (c > 0u) ? 1u : 0u; mine = (j == x) ? c : mine; }
        if (sum == G) break;
        __builtin_amdgcn_s_sleep(1);
        if ((++sp & 255u) == 0u) { if (xb_ld(&bar[XB_TMO])) break; if (sp > XB_SPIN_CAP) { atomicAdd(&bar[XB_TMO], 1u); break; } }
    }
    nloc = mine > 0u ? mine : 1u; nx = cnt > 0u ? cnt : 1u;
}

__device__ __forceinline__ void xcd_barrier(const XcdBarrier& b) {
    asm volatile("s_waitcnt vmcnt(0)" ::: "memory");
    __syncthreads();
    if (threadIdx.x == 0) {
        unsigned* bar = b.bar;
        __builtin_amdgcn_s_waitcnt(0);
        unsigned nloc = b.st[0], nx = b.st[1];
        if (nloc == 0u) { xcd_barrier_complete(bar, b.x, nloc, nx); b.st[0] = nloc; b.st[1] = nx; }
        const unsigned old = xb_add(&bar[XB_XSUB(b.x)], 1u);
        const unsigned gen = old / nloc;
        if (old + 1u == (gen + 1u) * nloc) {
            __builtin_amdgcn_fence(__ATOMIC_RELEASE, "agent");
            asm volatile("s_waitcnt vmcnt(0)" ::: "memory");
            const unsigned og = xb_add(&bar[XB_TOP], 1u);
            const unsigned tg = og / nx;
            if (og + 1u == (tg + 1u) * nx) xb_add(&bar[XB_TOPGEN], 1u);
            else XB_SPIN(xb_ld(&bar[XB_TOPGEN]) == tg, bar);
            __builtin_amdgcn_fence(__ATOMIC_ACQUIRE, "agent");
            xb_add(&bar[XB_XGEN(b.x)], 1u);
            asm volatile("s_waitcnt vmcnt(0)" ::: "memory");
        } else {
            XB_SPIN(xb_ld(&bar[XB_XGEN(b.x)]) == gen, bar);
            __builtin_amdgcn_fence(__ATOMIC_ACQUIRE, "agent");
            asm volatile("s_waitcnt vmcnt(0)" ::: "memory");
        }
    }
    __syncthreads();
}

constexpr int LDS_BYTES = 32768 * 4 + 256 + 6144 + 8 * 2560;

enum Phase {
    PH_PREP = 0, PH_GEMM_IN, PH_CNORM, PH_MIX0  , PH_GEMM_OUT0,
    PH_GEMM_Q0, PH_XATTN0, PH_GEMM_O0, PH_GEMM_GU0, PH_GEMM_DN0,
    PH_GEMM_OIN, PH_GMLP, PH_GEMM_OOUT,
    PH_GEMM_Q1, PH_XATTN1, PH_GEMM_O1, PH_GEMM_GU1, PH_GEMM_DN1, PH_FINAL, PH_COUNT
};

__device__ __forceinline__ PrepJob make_job(const Params& p, int ji) {
    unsigned char* ws = p.ws; PrepJob j{};
    switch (ji) {
    case 0: j = PrepJob{p.in[5], 1024, 3272, p.in[4], (bf16_t*)(ws + WS_WIN), 1024, 1792, 1024, 0, MAP_WIN}; break;
    case 14: j = PrepJob{p.in[5], 1024, 3272, p.in[4], (bf16_t*)(ws + WS_WIN), 3584, PW, 1024, 0, MAP_WIN}; break;
    case 15: j = PrepJob{p.in[5], 1024, 3272, p.in[4], (bf16_t*)(ws + WS_WIN8), 1024, 3840, 1024, 0, MAP_WIN, 4, WQ_GU}; break;
    case 1: j = PrepJob{p.in[10] + (size_t)512 * 1024, 512, 1024, nullptr, (bf16_t*)(ws + WS_WOUT), 0, 1024, KOUT, 1024, MAP_ID}; break;
    case 2: j = PrepJob{p.in[11], 1024, 2048, p.in[4] + 1024, (bf16_t*)(ws + WS_OWIN), 0, 2048, 1024, 0, MAP_ID, 2, WQ_GU}; break;
    case 3: j = PrepJob{p.in[16], 1024, 1024, nullptr, (bf16_t*)(ws + WS_OWOUT), 0, 1024, 1024, 0, MAP_ID}; break;
    case 4: case 5: { const int l = ji - 4; j = PrepJob{p.in[19] + (size_t)l * 1024 * 512, 1024, 512, p.in[17] + l * 1024, (bf16_t*)(ws + WS_WQ + (size_t)l * 512 * 1024), 0, 512, 1024, 0, MAP_ID, 2, WQ_GU}; } break;
    case 6: case 7: { const int l = ji - 6; j = PrepJob{p.in[20] + (size_t)l * 1024 * 1024, 1024, 1024, p.in[18] + l * 1024, (bf16_t*)(ws + WS_WKV8 + (size_t)l * 1024 * 1024), 0, 1024, 1024, 0, MAP_ID, 4, WQ_GU}; } break;
    case 8: case 9: { const int l = ji - 8; j = PrepJob{p.in[21] + (size_t)l * 512 * 1024, 512, 1024, nullptr, (bf16_t*)(ws + WS_WO + (size_t)l * 1024 * 512), 0, 1024, 512, 0, MAP_ID, 3, WO_SC}; } break;
    case 10: case 11: { const int l = ji - 10; j = PrepJob{p.in[23] + (size_t)l * 1024 * 2 * FF, 1024, 2 * FF, p.in[22] + l * 1024, (bf16_t*)(ws + WS_WGU + (size_t)l * 2 * FF * 1024), 0, 2 * FF, 1024, 0, MAP_GU, 2, WQ_GU}; } break;
    case 12: case 13: { const int l = ji - 12;
        if ((DN_FP8 >> l) & 1) j = PrepJob{p.in[24] + (size_t)l * FF * 1024, FF, 1024, nullptr, (bf16_t*)(ws + WS_WDN + (size_t)l * 1024 * FF * 2), 0, 1024, FF, 0, MAP_ID, 1, WDN_SC};
        else j = PrepJob{p.in[24] + (size_t)l * FF * 1024, FF, 1024, nullptr, (bf16_t*)(ws + WS_WDN) + (size_t)l * 1024 * FF, 0, 1024, FF, 0, MAP_ID}; } break;
    }
    return j;
}
constexpr int N_PREP_JOBS = 16;

template <int ph> __device__ __forceinline__ void run_phase(const Params& p, LAS float* lds, int vb, int nvb) {
    unsigned char* ws = p.ws;
    bf16_t* HN = (bf16_t*)(ws + WS_HN); bf16_t* BIG = (bf16_t*)(ws + WS_BIG); bf16_t* CN = (bf16_t*)(ws + WS_CN); bf16_t* CAT = (bf16_t*)(ws + WS_CAT);
    bf16_t* KB = (bf16_t*)(ws + WS_KB); bf16_t* VTB = (bf16_t*)(ws + WS_VT); bf16_t* MEMN = (bf16_t*)(ws + WS_MEMN); float* lb = (float*)(ws + WS_LB);
    float* ssq = (float*)(ws + WS_SSQ); float* lnp = (float*)(ws + WS_LNP);
    bf16_t* XQ = BIG; bf16_t* XO = BIG + (size_t)T * 512;
    const int l = (ph >= PH_GEMM_Q1) ? 1 : 0;
    switch (ph) {
    case PH_PREP:
        x_to_h_rows(p.in[0], HN, ws + WS_X8, ssq, vb, nvb);
        {
            constexpr int NT_[N_PREP_JOBS] = {0, 8 * 4, 16 * 8, 16 * 4, 16 * 2, 16 * 2, 16 * 4, 16 * 4, 8 * 4, 8 * 4, 16 * 22, 16 * 22, 44 * 4, 44 * 4, 0, 16 * 11};
            constexpr int CUM1 = NT_[0], CUM2 = CUM1 + NT_[1], CUM3 = CUM2 + NT_[2], CUM4 = CUM3 + NT_[3], CUM5 = CUM4 + NT_[4], CUM6 = CUM5 + NT_[5], CUM7 = CUM6 + NT_[6],
                          CUM8 = CUM7 + NT_[7], CUM9 = CUM8 + NT_[8], CUM10 = CUM9 + NT_[9], CUM11 = CUM10 + NT_[10], CUM12 = CUM11 + NT_[11], CUM13 = CUM12 + NT_[12], CUM14 = CUM13 + NT_[13],
                          CUM15 = CUM14 + NT_[14], CUM16 = CUM15 + NT_[15];
#define PJ_FIND(it_, ji_, base_) do { ji_ = 0; base_ = 0; \
                PJ_STEP(it_, ji_, base_, 1, CUM1) PJ_STEP(it_, ji_, base_, 2, CUM2) PJ_STEP(it_, ji_, base_, 3, CUM3) PJ_STEP(it_, ji_, base_, 4, CUM4) PJ_STEP(it_, ji_, base_, 5, CUM5) PJ_STEP(it_, ji_, base_, 6, CUM6) PJ_STEP(it_, ji_, base_, 7, CUM7) \
                PJ_STEP(it_, ji_, base_, 8, CUM8) PJ_STEP(it_, ji_, base_, 9, CUM9) PJ_STEP(it_, ji_, base_, 10, CUM10) PJ_STEP(it_, ji_, base_, 11, CUM11) PJ_STEP(it_, ji_, base_, 12, CUM12) PJ_STEP(it_, ji_, base_, 13, CUM13) PJ_STEP(it_, ji_, base_, 14, CUM14) PJ_STEP(it_, ji_, base_, 15, CUM15) } while (0)
#define PJ_STEP(it_, ji_, base_, q, c) if ((it_) >= (c)) { ji_ = (q); base_ = (c); }
            f32x4 va[8], vn[8];
            int ji, base;
            if (vb < CUM16) { PJ_FIND(vb, ji, base); const PrepJob j = make_job(p, ji); prep_tile_load(j, vb - base, va); }
            for (int it = vb; it < CUM16; it += nvb) {
                PJ_FIND(it, ji, base);
                const PrepJob j = make_job(p, ji); const int tl = it - base;
                if (it + nvb < CUM16) { int jn, bn; PJ_FIND(it + nvb, jn, bn); const PrepJob j2 = make_job(p, jn); prep_tile_load(j2, it + nvb - bn, vn); }
                prep_tile_store(j, tl, va, lds);
#pragma unroll
                for (int q = 0; q < 8; ++q) va[q] = vn[q];
            }
#undef PJ_STEP
#undef PJ_FIND
        }
        prep_fold_in(p.in[5], p.in[7], p.in[4], (bf16_t*)(ws + WS_WIN8), lds, vb, nvb);
        prep_fold_out(p.in[10], p.in[8], (bf16_t*)(ws + WS_WOUT), lds, vb, nvb);
        prep_lb(p.in[3], lb, vb, nvb);
        rmsnorm_rows(p.in[1], ws + WS_MEMN8, MT, vb, nvb);
        break;
    case PH_GEMM_IN: {
        {
            Gemm g{(const bf16_t*)(ws + WS_WIN8), (const bf16_t*)(ws + WS_WIN8), T, 3840, 512}; EpiIn8 E{BIG, KB, VTB, ssq, 1.f / (HQ_X * WQ_GU)};
            pg8::ComboOrder8 S; S.init(nvb, vb);
            LAS float* tab = (LAS float*)((LAS unsigned char*)lds + RSTD_TAB_OFF); build_rstd_table(S, ssq, tab); E.tab = tab;
            pg8::gemm_phase<EpiIn8, pg8::ComboOrder8, true, true, 2>((LAS unsigned char*)lds, g, S, E);
        }
    } break;
    case PH_CNORM: cnorm_rows(BIG, p.in[6], CN, vb, nvb); hgrn_prep(BIG, lb, (float*)(ws + WS_DEC), (LAS unsigned char*)lds, vb, nvb); break;
    case PH_MIX0:
        for (int item = vb; item < 64; item += nvb) hgrn_scan(BIG, (const float*)(ws + WS_DEC), p.in[9], CAT, (LAS unsigned char*)lds, item);
        dsa_mfma_phase(BIG, CN, p.in[2], CAT, (LAS unsigned char*)lds, (unsigned*)(ws + WS_CTL) + 3600);
        break;
    case PH_GEMM_OUT0: { Gemm g{CAT, (const bf16_t*)(ws + WS_WOUT), T, 1024, KOUT}; EpiResid<false, false, true> E{nullptr, HN, ssq, ws + WS_H8, HQ_Q0}; run_gemm(g, E, lds, vb, nvb); } break;
    case PH_GEMM_Q0: case PH_GEMM_Q1: { Gemm g{(const bf16_t*)(ws + WS_H8), (const bf16_t*)(ws + WS_WQ + (size_t)l * 512 * 1024), T, 512, 512}; EpiStoreBf16<true> E{XQ, 512, ssq, 1.f / ((l ? HQ_Q1 : HQ_Q0) * WQ_GU)}; run_gemm<EpiStoreBf16<true>, 2>(g, E, lds, vb, nvb); } break;
    case PH_XATTN0: case PH_XATTN1: xattn_mfma_phase(XQ, KB + (size_t)l * MT * 512, VTB + (size_t)l * 512 * MT, XO, (LAS unsigned char*)lds, vb, nvb); break;
    case PH_GEMM_O0: case PH_GEMM_O1: { Gemm g{XO, (const bf16_t*)(ws + WS_WO + (size_t)l * 1024 * 512), T, 1024, 256}; EpiResid<false, true, true> E{nullptr, HN, ssq, ws + WS_H8, l ? HQ_GU1 : HQ_GU0, XO_UNSC}; run_gemm<EpiResid<false, true, true>, 1>(g, E, lds, vb, nvb); } break;
    case PH_GEMM_GU0: case PH_GEMM_GU1: { constexpr bool dn8 = ((DN_FP8 >> l) & 1) != 0;
        Gemm g{(const bf16_t*)(ws + WS_H8), (const bf16_t*)(ws + WS_WGU + (size_t)l * 2 * FF * 1024), T, 2 * FF, 512}; EpiSwigluQ<true, dn8> E{BIG, FF, ssq, 1.f / ((l ? HQ_GU1 : HQ_GU0) * WQ_GU)}; run_gemm<EpiSwigluQ<true, dn8>, 2>(g, E, lds, vb, nvb); } break;
    case PH_GEMM_DN0: case PH_GEMM_DN1:
        if constexpr (((DN_FP8 >> l) & 1) != 0) { Gemm g{BIG, (const bf16_t*)(ws + WS_WDN + (size_t)l * 1024 * FF * 2), T, 1024, FF / 2}; EpiResid<false, true, ph == PH_GEMM_DN0> E{nullptr, HN, ssq, ws + WS_H8, HQ_OIN, DN_UNSC}; run_gemm<EpiResid<false, true, ph == PH_GEMM_DN0>, 1>(g, E, lds, vb, nvb); }
        else { Gemm g{BIG, (const bf16_t*)(ws + WS_WDN) + (size_t)l * 1024 * FF, T, 1024, FF}; EpiResid<false, false, ph == PH_GEMM_DN0> E{nullptr, HN, ssq, ws + WS_H8, HQ_OIN}; run_gemm(g, E, lds, vb, nvb); }
        break;
    case PH_GEMM_OIN: { Gemm g{(const bf16_t*)(ws + WS_H8), (const bf16_t*)(ws + WS_OWIN), T, 2048, 512}; EpiGeluBf16<true> E{BIG, 2048, ssq, lnp, 1.f / (HQ_OIN * WQ_GU)}; run_gemm<EpiGeluBf16<true>, 2>(g, E, lds, vb, nvb); } break;
    case PH_GMLP: gmlp_mfma_phase(BIG, lnp, p.in[12], p.in[13], p.in[14], p.in[15], CAT, (LAS unsigned char*)lds, vb, nvb); break;
    case PH_GEMM_OOUT: { Gemm g{CAT, (const bf16_t*)(ws + WS_OWOUT), T, 1024, 1024}; EpiResid<false, false, true> E{nullptr, HN, ssq, ws + WS_H8, HQ_Q1}; run_gemm(g, E, lds, vb, nvb); } break;
    case PH_FINAL: final_rows(HN, ssq, p.in[25], p.out, vb, nvb); break;
    default: break;
    }
}

template <int PH> __global__ void __launch_bounds__(NTHREADS) k_phase(Params p) {
    extern __shared__ __attribute__((aligned(16))) float smem[];
    run_phase<PH>(p, (LAS float*)smem, blockIdx.x, gridDim.x);
}

template <int PH> __device__ __forceinline__ void mega_phases(const Params& p, LAS float* lds, const XcdBarrier& bar) {
    run_phase<PH>(p, lds, blockIdx.x, gridDim.x);
#ifdef REPEAT_PH
    if constexpr (PH == REPEAT_PH) { xcd_barrier(bar); run_phase<PH>(p, lds, blockIdx.x, gridDim.x); }
#endif
    if constexpr (PH + 1 < PH_COUNT) { xcd_barrier(bar); mega_phases<PH + 1>(p, lds, bar); }
}
__global__ void __launch_bounds__(NTHREADS) k_mega(Params p) {
    extern __shared__ __attribute__((aligned(16))) float smem[];
    volatile LAS unsigned* st = (volatile LAS unsigned*)((LAS float*)smem + 32768);
    if (threadIdx.x < 2) st[threadIdx.x] = 0u;
    __syncthreads();
    const XcdBarrier bar = xcd_barrier_post((unsigned*)(p.ws + WS_CTL), st);
    mega_phases<0>(p, (LAS float*)smem, bar);
}

template <int PH> static void launch_phases(const Params& p, int grid, hipStream_t stream) {
    int g = grid * 4;
    if (PH == PH_MIX0 || PH == PH_XATTN0 || PH == PH_XATTN1 || PH == PH_GMLP) g = grid;
    (void)hipFuncSetAttribute((const void*)k_phase<PH>, hipFuncAttributeMaxDynamicSharedMemorySize, LDS_BYTES);
    hipLaunchKernelGGL(k_phase<PH>, dim3(g), dim3(NTHREADS), LDS_BYTES, stream, p);
    if constexpr (PH + 1 < PH_COUNT) launch_phases<PH + 1>(p, grid, stream);
}

extern "C" void kernel_launch(void* const* d_in, const int* in_sizes, int n_in, void* d_out, int out_size, void* d_ws, size_t ws_size, hipStream_t stream) {
    static int grid = 0;
    if (grid == 0) {
        if (n_in != 26 || out_size != T * D || ws_size < WS_END) { fprintf(stderr, "kernel_launch: unexpected shapes (n_in %d out %d ws %zu)\n", n_in, out_size, ws_size); grid = -1; return; }
        int dev = 0, cus = 0;
        (void)hipGetDevice(&dev); (void)hipDeviceGetAttribute(&cus, hipDeviceAttributeMultiprocessorCount, dev);
        (void)hipFuncSetAttribute((const void*)k_mega, hipFuncAttributeMaxDynamicSharedMemorySize, LDS_BYTES);
        int per_cu = 0;
        (void)hipOccupancyMaxActiveBlocksPerMultiprocessor(&per_cu, (const void*)k_mega, NTHREADS, LDS_BYTES);
        if (per_cu < 1) fprintf(stderr, "kernel_launch: occupancy query says %d blocks per CU\n", per_cu);
        (void)hipGetLastError();
        grid = cus > 0 ? cus : 256;
    }
    if (grid < 0) return;
    Params p{};
    for (int i = 0; i < 26; ++i) p.in[i] = (const float*)d_in[i];
    p.out = (float*)d_out; p.ws = (unsigned char*)d_ws;
    (void)hipMemsetAsync((char*)d_ws + WS_CTL, 0, 16384, stream);
#if MEGA
    hipLaunchKernelGGL(k_mega, dim3(grid), dim3(NTHREADS), LDS_BYTES, stream, p);
#else
    launch_phases<0>(p, grid, stream);
#endif
}
```
